# Optimizing an MI355X kernel written in HIP

```python
import math
import jax, jax.numpy as jnp
from jax import lax
import numpy as np

D_MODEL = 1024
BATCH = 8
SEQ = 4096
DEPTH = 1

GRID_W = 64
CTX_LEN = 256

N_FOURIER_GROUPS = 4
FOURIER_GROUP = 128
D_FOURIER = N_FOURIER_GROUPS * FOURIER_GROUP

D_RNN = D_MODEL
N_RNN_HEADS = 8
RNN_HEAD = D_RNN // N_RNN_HEADS
CONV_W = 4
CONV_LEFT = 2
LRU_C = 8.0
N_DIRS = 2

COL_F = D_FOURIER
COL_X = COL_F + D_RNN
COL_G = COL_X + D_RNN
COL_A = COL_G + D_MODEL
D_IN = COL_A + D_MODEL

N_EXPERTS = 16
CAPACITY_FACTOR = 2
D_EXPERT = 1536

N_MOD = 6
EPS = 1e-6
POS_MAX_PERIOD = 10000.0

kernel_name = 'hybrid_fourier_rglru_ec_moe_dit'


def rmsnorm(x, g):
    xf = x.astype(jnp.float32)
    y = xf * lax.rsqrt(jnp.mean(xf * xf, axis=-1, keepdims=True) + EPS)
    return (y * g.astype(jnp.float32)).astype(x.dtype)


def ada_params(cvec, w_ada, b_ada):
    m = jnp.einsum('nd,de->ne', jax.nn.silu(cvec), w_ada) + b_ada
    return [t[:, None, :] for t in jnp.split(m, N_MOD, axis=-1)]


def modulate(h, shift, scale):
    return h * (1.0 + scale) + shift


def grid_pos_embed(n_tokens, dtype):
    rows = n_tokens // GRID_W
    quarter = D_MODEL // 4
    freqs = jnp.exp(-math.log(POS_MAX_PERIOD) * jnp.arange(quarter, dtype=jnp.float32) / quarter)
    ang_r = jnp.arange(rows, dtype=jnp.float32)[:, None] * freqs
    ang_c = jnp.arange(GRID_W, dtype=jnp.float32)[:, None] * freqs
    emb_r = jnp.concatenate([jnp.sin(ang_r), jnp.cos(ang_r)], axis=-1)
    emb_c = jnp.concatenate([jnp.sin(ang_c), jnp.cos(ang_c)], axis=-1)
    emb = jnp.concatenate([
        jnp.broadcast_to(emb_r[:, None, :], (rows, GRID_W, D_MODEL // 2)),
        jnp.broadcast_to(emb_c[None, :, :], (rows, GRID_W, D_MODEL // 2)),
    ], axis=-1)
    return emb.reshape(rows * GRID_W, D_MODEL).astype(dtype)


def fourier_mix(u):
    B, T, _ = u.shape
    g = u.reshape(B, T, N_FOURIER_GROUPS, FOURIER_GROUP).astype(jnp.float32)
    f = jnp.fft.fft2(g, axes=(1, 3), norm='ortho').real
    return f.reshape(B, T, D_FOURIER).astype(u.dtype)


def dwconv(u, w, b):
    T = u.shape[1]
    up = jnp.pad(u, ((0, 0), (CONV_LEFT, CONV_W - 1 - CONV_LEFT), (0, 0)))
    out = b
    for k in range(CONV_W):
        out = out + w[k] * up[:, k:k + T]
    return out


def lru_coeffs(u, lam, wa, ba, wi, bi):
    B, T, _ = u.shape
    uh = u.reshape(B, T, N_RNN_HEADS, RNN_HEAD)
    r = jax.nn.sigmoid(jnp.einsum('bthi,hij->bthj', uh, wa).reshape(B, T, D_RNN) + ba)
    i = jax.nn.sigmoid(jnp.einsum('bthi,hij->bthj', uh, wi).reshape(B, T, D_RNN) + bi)
    log_a = -LRU_C * r.astype(jnp.float32) * jax.nn.softplus(-lam.astype(jnp.float32))
    a = jnp.exp(log_a)
    b = jnp.sqrt(-jnp.expm1(2.0 * log_a)) * (i * u).astype(jnp.float32)
    return a, b


def _combine(left, right):
    a_l, b_l = left
    a_r, b_r = right
    return a_l * a_r, a_r * b_l + b_r


def linear_scan(a, b, h0):
    b = b.at[:, 0].add(a[:, 0] * h0)
    _, h = lax.associative_scan(_combine, (a, b), axis=1)
    return h


def rglru_bidir(u_lat, u_ctx, lam, wa, ba, wi, bi, ctx_out):
    y_lat = None
    y_ctx = None
    h0 = jnp.zeros((u_ctx.shape[0], D_RNN), jnp.float32)
    for d in range(N_DIRS):
        a_c, b_c = lru_coeffs(u_ctx, lam[d], wa[d], ba[d], wi[d], bi[d])
        a_l, b_l = lru_coeffs(u_lat, lam[d], wa[d], ba[d], wi[d], bi[d])
        if d == 1:
            a_c, b_c, a_l, b_l = [jnp.flip(t, axis=1) for t in (a_c, b_c, a_l, b_l)]
        h_c = linear_scan(a_c, b_c, h0)
        h_l = linear_scan(a_l, b_l, h_c[:, -1])
        if d == 1:
            h_c = jnp.flip(h_c, axis=1)
            h_l = jnp.flip(h_l, axis=1)
        y_lat = h_l if y_lat is None else y_lat + h_l
        if ctx_out:
            y_ctx = h_c if y_ctx is None else y_ctx + h_c
    y_lat = y_lat.astype(u_lat.dtype)
    if ctx_out:
        y_ctx = y_ctx.astype(u_ctx.dtype)
    return y_lat, y_ctx


def merge_branches(z, r, w_four, w_lru, w_out):
    y_four = jnp.einsum('btf,fd->btd', fourier_mix(z[..., :COL_F]), w_four)
    y_rnn = jnp.einsum('btr,rd->btd', jax.nn.gelu(z[..., COL_X:COL_G]) * r, w_lru)
    g_four = jax.nn.sigmoid(z[..., COL_G:COL_A])
    g_rnn = jax.nn.sigmoid(z[..., COL_A:])
    return jnp.einsum('btd,de->bte', g_four * y_four + g_rnn * y_rnn, w_out)


def token_mixer(h_lat, h_ctx, w_in, w_four, conv_w, conv_b, lam, wa, ba, wi, bi, w_lru, w_out, ctx_out):
    z_lat = jnp.einsum('btd,de->bte', h_lat, w_in)
    if ctx_out:
        z_ctx = jnp.einsum('btd,de->bte', h_ctx, w_in)
        x_ctx = z_ctx[..., COL_F:COL_X]
    else:
        z_ctx = None
        x_ctx = jnp.einsum('btd,de->bte', h_ctx, w_in[:, COL_F:COL_X])
    u_lat = dwconv(z_lat[..., COL_F:COL_X], conv_w, conv_b)
    u_ctx = dwconv(x_ctx, conv_w, conv_b)
    r_lat, r_ctx = rglru_bidir(u_lat, u_ctx, lam, wa, ba, wi, bi, ctx_out)
    y_lat = merge_branches(z_lat, r_lat, w_four, w_lru, w_out)
    y_ctx = merge_branches(z_ctx, r_ctx, w_four, w_lru, w_out) if ctx_out else None
    return y_lat, y_ctx


def expert_choice_ffn(h, w_router, w_gate, w_up, w_down):
    B, T, D = h.shape
    cap = CAPACITY_FACTOR * T // N_EXPERTS
    scores = jax.nn.softmax(jnp.einsum('btd,de->bte', h, w_router).astype(jnp.float32), axis=-1)
    g, idx = lax.top_k(jnp.swapaxes(scores, 1, 2), cap)
    xg = jax.vmap(lambda hb, ib: hb[ib])(h, idx)
    hid = jax.nn.silu(jnp.einsum('becd,edf->becf', xg, w_gate)) * jnp.einsum('becd,edf->becf', xg, w_up)
    out = jnp.einsum('becf,efd->becd', hid, w_down) * g[..., None].astype(h.dtype)
    return jax.vmap(lambda ib, ob: jnp.zeros((T, D), h.dtype).at[ib.reshape(-1)].add(ob.reshape(-1, D)))(idx, out)


def setup_inputs(seed: int = 0) -> dict:
    key = jax.random.key(seed)
    ks = jax.random.split(key, 24)
    f32 = jnp.float32

    def nrm(k, shape, fan_in):
        return jax.random.normal(k, shape, f32) * (fan_in ** -0.5)

    u = jax.random.uniform(ks[10], (DEPTH, N_DIRS, D_RNN), f32, 0.9, 0.999)
    s = u ** (1.0 / LRU_C)
    lru_lambda = jnp.log(s) - jnp.log1p(-s)
    return {
        'x': jax.random.normal(ks[0], (BATCH, SEQ, D_MODEL), f32),
        'c': jax.random.normal(ks[1], (BATCH, D_MODEL), f32),
        'ctx': jax.random.normal(ks[2], (BATCH, CTX_LEN, D_MODEL), f32),
        'c_ctx': jax.random.normal(ks[3], (D_MODEL,), f32),
        'w_ada': nrm(ks[4], (DEPTH, D_MODEL, N_MOD * D_MODEL), D_MODEL),
        'b_ada': 0.01 * jax.random.normal(ks[5], (DEPTH, N_MOD * D_MODEL), f32),
        'norm1_g': 1.0 + 0.02 * jax.random.normal(ks[6], (DEPTH, D_MODEL), f32),
        'norm2_g': 1.0 + 0.02 * jax.random.normal(ks[7], (DEPTH, D_MODEL), f32),
        'w_in': nrm(ks[8], (DEPTH, D_MODEL, D_IN), D_MODEL),
        'w_four': nrm(ks[9], (DEPTH, D_FOURIER, D_MODEL), D_FOURIER),
        'conv_w': nrm(ks[11], (DEPTH, CONV_W, D_RNN), CONV_W),
        'conv_b': 0.01 * jax.random.normal(ks[12], (DEPTH, D_RNN), f32),
        'lru_lambda': lru_lambda,
        'lru_wa': nrm(ks[13], (DEPTH, N_DIRS, N_RNN_HEADS, RNN_HEAD, RNN_HEAD), RNN_HEAD),
        'lru_ba': 0.01 * jax.random.normal(ks[14], (DEPTH, N_DIRS, D_RNN), f32),
        'lru_wi': nrm(ks[15], (DEPTH, N_DIRS, N_RNN_HEADS, RNN_HEAD, RNN_HEAD), RNN_HEAD),
        'lru_bi': 0.01 * jax.random.normal(ks[16], (DEPTH, N_DIRS, D_RNN), f32),
        'w_lru': nrm(ks[17], (DEPTH, D_RNN, D_MODEL), D_RNN),
        'w_out': nrm(ks[18], (DEPTH, D_MODEL, D_MODEL), D_MODEL),
        'w_router': nrm(ks[19], (DEPTH, D_MODEL, N_EXPERTS), D_MODEL),
        'w_gate_e': nrm(ks[20], (DEPTH, N_EXPERTS, D_MODEL, D_EXPERT), D_MODEL),
        'w_up_e': nrm(ks[21], (DEPTH, N_EXPERTS, D_MODEL, D_EXPERT), D_MODEL),
        'w_down_e': nrm(ks[22], (DEPTH, N_EXPERTS, D_EXPERT, D_MODEL), D_EXPERT),
        'final_g': 1.0 + 0.02 * jax.random.normal(ks[23], (D_MODEL,), f32),
    }


def reference(x, c, ctx, c_ctx, w_ada, b_ada, norm1_g, norm2_g, w_in, w_four, conv_w, conv_b,
              lru_lambda, lru_wa, lru_ba, lru_wi, lru_bi, w_lru, w_out, w_router,
              w_gate_e, w_up_e, w_down_e, final_g):
    x = x + grid_pos_embed(x.shape[1], x.dtype)[None]
    for l in range(DEPTH):
        ctx_out = l < DEPTH - 1
        sh1, sc1, g1, sh2, sc2, g2 = ada_params(c, w_ada[l], b_ada[l])
        csh1, csc1, cg1, csh2, csc2, cg2 = ada_params(c_ctx[None], w_ada[l], b_ada[l])

        h_lat = modulate(rmsnorm(x, norm1_g[l]), sh1, sc1)
        h_ctx = modulate(rmsnorm(ctx, norm1_g[l]), csh1, csc1)
        y_lat, y_ctx = token_mixer(h_lat, h_ctx, w_in[l], w_four[l], conv_w[l], conv_b[l],
                                   lru_lambda[l], lru_wa[l], lru_ba[l], lru_wi[l], lru_bi[l],
                                   w_lru[l], w_out[l], ctx_out)
        x = x + g1 * y_lat
        if ctx_out:
            ctx = ctx + cg1 * y_ctx

        h_lat = modulate(rmsnorm(x, norm2_g[l]), sh2, sc2)
        x = x + g2 * expert_choice_ffn(h_lat, w_router[l], w_gate_e[l], w_up_e[l], w_down_e[l])
        if ctx_out:
            h_ctx = modulate(rmsnorm(ctx, norm2_g[l]), csh2, csc2)
            ctx = ctx + cg2 * expert_choice_ffn(h_ctx, w_router[l], w_gate_e[l], w_up_e[l], w_down_e[l])
    return rmsnorm(x, final_g)
```

```cpp
#include <hip/hip_runtime.h>
#include <hip/hip_cooperative_groups.h>
#include <cstdio>
namespace cg = cooperative_groups;

#define LAS __attribute__((address_space(3)))
typedef unsigned short bf16_t;
typedef short bf16x8 __attribute__((ext_vector_type(8)));
typedef float f32x4 __attribute__((ext_vector_type(4)));
typedef float f32x16 __attribute__((ext_vector_type(16)));
typedef unsigned u32x4 __attribute__((ext_vector_type(4)));
typedef unsigned u32x2 __attribute__((ext_vector_type(2)));

constexpr int NB = 8, TT = 4096, DM = 1024, CTXL = 256, MLAT = NB * TT, MCTX = NB * CTXL;
constexpr int NE = 16, CAP = 512, DE = 1536, MMOE = NE * NB * CAP;
constexpr int NSEQ = 34;
constexpr int NTHR = 512;
constexpr int LDS_BYTES = 144 * 1024;

constexpr size_t KiB = 1024, MiB = 1024 * 1024;
constexpr size_t WS_ADA = 0;
constexpr size_t WS_POS = 256 * KiB;
constexpr size_t WS_AGG = 512 * KiB;
constexpr size_t WS_WPQ = 5 * MiB;
constexpr size_t WS_WIN = 7 * MiB;
constexpr size_t WS_WFOUR = 15 * MiB;
constexpr size_t WS_WLRU = 16 * MiB;
constexpr size_t WS_WOUT = 18 * MiB;
constexpr size_t WS_WAT = 20 * MiB;
constexpr size_t WS_WIT = 20 * MiB + 512 * KiB;
constexpr size_t WS_SCORES = 21 * MiB;
constexpr size_t WS_IDX = 23 * MiB;
constexpr size_t WS_GATE = 23 * MiB + 256 * KiB;
constexpr size_t WS_SLOT = 23 * MiB + 512 * KiB;
constexpr size_t WS_HCTX = 26 * MiB;
constexpr size_t WS_ZXC = 30 * MiB;
constexpr size_t WS_R1 = 40 * MiB;
constexpr size_t WS_RPQ = 104 * MiB;
constexpr size_t WS_R2 = 168 * MiB;
constexpr size_t WS_RZ = 232 * MiB;
constexpr size_t WS_END = 488 * MiB;
constexpr size_t WS_HID = WS_RZ, WS_WD = WS_RZ + 192 * MiB, WS_WGU = WS_RPQ, WS_OUTE = WS_R1;
constexpr size_t OUT_DFT = 0, OUT_F = 64 * MiB;

struct Params {
    const float *x, *c, *ctx, *c_ctx, *w_ada, *b_ada, *norm1_g, *norm2_g, *w_in, *w_four, *conv_w, *conv_b, *lru_lambda,
        *lru_wa, *lru_ba, *lru_wi, *lru_bi, *w_lru, *w_out, *w_router, *w_gate_e, *w_up_e, *w_down_e, *final_g;
    float* out; unsigned char* ws; int ph_lo, ph_hi;
};

__device__ __forceinline__ unsigned cvt_pk_bf16(float lo, float hi) { unsigned r; asm volatile("v_cvt_pk_bf16_f32 %0, %1, %2" : "=v"(r) : "v"(lo), "v"(hi)); return r; }
__device__ __forceinline__ float bf_lo(unsigned w) { return __uint_as_float(w << 16); }
__device__ __forceinline__ float bf_hi(unsigned w) { return __uint_as_float(w & 0xffff0000u); }
__device__ __forceinline__ float bf2f(bf16_t h) { return __uint_as_float(((unsigned)h) << 16); }
__device__ __forceinline__ float sigmoidf_(float v) { return __builtin_amdgcn_rcpf(1.0f + __expf(-v)); }
__device__ __forceinline__ float gelu_tanh(float v) { const float y = 1.5957691216f * (v + 0.044715f * v * v * v); return v * sigmoidf_(y); }
__device__ __forceinline__ float wave_sum(float v) {
#pragma unroll
    for (int o = 32; o >= 1; o >>= 1) v += __shfl_xor(v, o);
    return v;
}
__device__ __forceinline__ void unpack8(const u32x4 w, float (&f)[8]) { f[0] = bf_lo(w.x); f[1] = bf_hi(w.x); f[2] = bf_lo(w.y); f[3] = bf_hi(w.y); f[4] = bf_lo(w.z); f[5] = bf_hi(w.z); f[6] = bf_lo(w.w); f[7] = bf_hi(w.w); }

namespace pg8 {
constexpr int BM = 256, BK = 64, HALF = 128, HTB = HALF * BK * 2, STAGE_BYTES = 8 * HTB, NXCD = 8, WGM = 8;
__device__ __forceinline__ int lds_byte(int r, int c) { const int st = (r >> 4) * 2 + (c >> 5), rr = r & 15, cc = c & 31, ob = rr * 64 + cc * 2; return st * 1024 + (ob ^ (((ob >> 9) & 1) << 5)); }
__device__ __forceinline__ void stage_rc(int b, int& R, int& C) { const int st = b / 1024, sb = b % 1024, swz = sb ^ (((sb >> 9) & 1) << 5); R = (st >> 1) * 16 + swz / 64; C = (st & 1) * 32 + (swz % 64) / 2; }
__device__ __forceinline__ int perm32(int rho) { const int n = rho >> 4, i = rho & 15; return 8 * (i >> 2) + 4 * n + (i & 3); }
struct Unit { int pm, pn; };
struct Order {
    int nM, nN, nwg, G, c;
    __device__ void init(int nM_, int nN_, int G_, int c_) { nM = nM_; nN = nN_; nwg = nM * nN; G = G_; c = c_; }
    __device__ bool next(int i, Unit& u) const {
        const long L = (long)i * G + c; if (L >= nwg) return false;
        int wgid = (int)L; { const int q = nwg / NXCD, r = nwg % NXCD, xcd = wgid % NXCD, off = wgid / NXCD; wgid = (xcd < r ? xcd * (q + 1) : r * (q + 1) + (xcd - r) * q) + off; }
        const int nig = WGM * nN, gid = wgid / nig, fm = gid * WGM, gsz = (nM - fm) < WGM ? (nM - fm) : WGM;
        u.pm = fm + ((wgid % nig) % gsz); u.pn = (wgid % nig) / gsz; return true;
    }
};
template <class P, class Epi>
__device__ __forceinline__ void gemm_phase(LAS unsigned char* lds, const P& pr, const Order& S, const Epi& E) {
    const int tid = threadIdx.x, wid = __builtin_amdgcn_readfirstlane(tid >> 6), lane = tid & 63, wr = wid >> 2, wc = wid & 3, fr = lane & 15, fq = lane >> 4;
    const int nt = pr.K / BK;
    int RA[2], CA[2]; unsigned voffB[2];
#pragma unroll
    for (int i = 0; i < 2; ++i) { int R, C; stage_rc(tid * 16 + i * 8192, R, C); RA[i] = R; CA[i] = C; const int Rb = Epi::PERM ? ((R & ~31) + perm32(R & 31)) : R; voffB[i] = (unsigned)(Rb * pr.ldb + C) * 2u; }
    const size_t kstep = (size_t)(BK * 2);
    const size_t hstepB = (size_t)HALF * pr.ldb * 2;
    const unsigned ldsw = (unsigned)wid * 1024u;
    const int aoff = lds_byte(wr * 64 + fr, fq * 8), boff = lds_byte(wc * 32 + fr, fq * 8);
#define PG8_SA(b, h) (((b) * 2 + (h)) * HTB)
#define PG8_SB(b, h) ((4 + (b) * 2 + (h)) * HTB)
#define PG8_STAGE(bufoff, gbase, voff) do { _Pragma("unroll") for (int _i = 0; _i < 2; ++_i) \
        __builtin_amdgcn_global_load_lds((const unsigned*)((const char*)(gbase) + (voff)[_i]), (LAS unsigned*)(lds + (bufoff) + ldsw + _i * 8192), 16, 0, 0); } while (0)
#define PG8_LDA(dst, b, h) do { _Pragma("unroll") for (int m = 0; m < 4; ++m) _Pragma("unroll") for (int k = 0; k < 2; ++k) dst[m][k] = *(const LAS bf16x8*)(lds + PG8_SA(b, h) + aoff + m * 2048 + k * 1024); } while (0)
#define PG8_LDB(dst, b, h) do { _Pragma("unroll") for (int n = 0; n < 2; ++n) _Pragma("unroll") for (int k = 0; k < 2; ++k) dst[n][k] = *(const LAS bf16x8*)(lds + PG8_SB(b, h) + boff + n * 2048 + k * 1024); } while (0)
#define PG8_MMA(ai, bj, At, Bt) do { __builtin_amdgcn_s_setprio(1); _Pragma("unroll") for (int m = 0; m < 4; ++m) _Pragma("unroll") for (int n = 0; n < 2; ++n) _Pragma("unroll") for (int k = 0; k < 2; ++k) \
        acc[ai][bj][m][n] = __builtin_amdgcn_mfma_f32_16x16x32_bf16(Bt[n][k], At[m][k], acc[ai][bj][m][n], 0, 0, 0); __builtin_amdgcn_s_setprio(0); } while (0)
#define PG8_WAIT_V(n) asm volatile("s_waitcnt vmcnt(" #n ")" ::: "memory")
#define PG8_WAIT_L(n) asm volatile("s_waitcnt lgkmcnt(" #n ")" ::: "memory")
#define PG8_BAR __builtin_amdgcn_s_barrier()
#define PG8_SCHED __builtin_amdgcn_sched_barrier(0)
    Unit cur, nxt; int ui = 0;
    if (!S.next(0, cur)) return;
    f32x4 acc[2][2][4][2];
#pragma unroll
    for (int a = 0; a < 2; ++a)
#pragma unroll
        for (int b = 0; b < 2; ++b)
#pragma unroll
            for (int m = 0; m < 4; ++m)
#pragma unroll
                for (int n = 0; n < 2; ++n) acc[a][b][m][n] = (f32x4){0.f, 0.f, 0.f, 0.f};
    bf16x8 At[4][2], B0[2][2], B1[2][2];
    unsigned vA[2][2], vN[2][2];
    pr.avoff(cur, RA, CA, vA);
#pragma unroll
    for (int h = 0; h < 2; ++h)
#pragma unroll
        for (int i = 0; i < 2; ++i) vN[h][i] = vA[h][i];
    const char* cA = pr.abase(cur); const char* cB = pr.bbase(cur);
    PG8_STAGE(PG8_SB(0, 0), cB, voffB); PG8_STAGE(PG8_SA(0, 0), cA, vA[0]); PG8_STAGE(PG8_SB(0, 1), cB + hstepB, voffB); PG8_STAGE(PG8_SA(0, 1), cA, vA[1]);
    if (wr == 1) PG8_BAR;
    PG8_WAIT_V(4); PG8_BAR;
    PG8_STAGE(PG8_SB(1, 0), cB + kstep, voffB); PG8_STAGE(PG8_SA(1, 0), cA + kstep, vA[0]); PG8_STAGE(PG8_SB(1, 1), cB + hstepB + kstep, voffB);
    PG8_WAIT_V(6); PG8_BAR;
    for (;;) {
        const bool has_next = S.next(ui + 1, nxt);
        const char* nA = has_next ? pr.abase(nxt) : cA; const char* nB = has_next ? pr.bbase(nxt) : cB;
        if (P::GATHER) { if (has_next) pr.avoff(nxt, RA, CA, vN); }
        for (int t = 0; t < nt; t += 2) {
            const bool last = (t == nt - 2);
            const char* a1 = cA + (size_t)(t + 1) * kstep;
            const char* a2 = last ? nA : cA + (size_t)(t + 2) * kstep; const char* b2 = last ? nB : cB + (size_t)(t + 2) * kstep;
            const char* a3 = a2 + kstep; const char* b3 = b2 + kstep;
            unsigned v2[2][2];
#pragma unroll
            for (int h = 0; h < 2; ++h)
#pragma unroll
                for (int i = 0; i < 2; ++i) v2[h][i] = (P::GATHER && last) ? vN[h][i] : vA[h][i];
            PG8_LDB(B0, 0, 0); PG8_SCHED; PG8_LDA(At, 0, 0); PG8_STAGE(PG8_SA(1, 1), a1, vA[1]);
            PG8_WAIT_L(8); PG8_BAR; PG8_WAIT_L(0); PG8_MMA(0, 0, At, B0); PG8_BAR; PG8_SCHED;
            PG8_LDB(B1, 0, 1); PG8_STAGE(PG8_SB(0, 0), b2, voffB);
            PG8_BAR; PG8_WAIT_L(0); PG8_MMA(0, 1, At, B1); PG8_BAR;
            PG8_LDA(At, 0, 1); PG8_STAGE(PG8_SA(0, 0), a2, v2[0]);
            PG8_BAR; PG8_WAIT_L(0); PG8_MMA(1, 0, At, B0); PG8_BAR; PG8_SCHED;
            PG8_STAGE(PG8_SB(0, 1), b2 + hstepB, voffB);
            PG8_WAIT_V(6); PG8_BAR; PG8_MMA(1, 1, At, B1); PG8_BAR;
            PG8_LDB(B0, 1, 0); PG8_SCHED; PG8_LDA(At, 1, 0); PG8_STAGE(PG8_SA(0, 1), a2, v2[1]);
            PG8_WAIT_L(8); PG8_BAR; PG8_WAIT_L(0); PG8_MMA(0, 0, At, B0); PG8_BAR; PG8_SCHED;
            PG8_LDB(B1, 1, 1); PG8_STAGE(PG8_SB(1, 0), b3, voffB);
            PG8_BAR; PG8_WAIT_L(0); PG8_MMA(0, 1, At, B1); PG8_BAR;
            PG8_LDA(At, 1, 1); PG8_STAGE(PG8_SA(1, 0), a3, v2[0]);
            PG8_BAR; PG8_WAIT_L(0); PG8_MMA(1, 0, At, B0); PG8_BAR; PG8_SCHED;
            PG8_STAGE(PG8_SB(1, 1), b3 + hstepB, voffB);
            PG8_WAIT_V(6); PG8_BAR; PG8_MMA(1, 1, At, B1); PG8_BAR;
            if (P::GATHER && last) {
#pragma unroll
                for (int h = 0; h < 2; ++h)
#pragma unroll
                    for (int i = 0; i < 2; ++i) vA[h][i] = vN[h][i];
            }
        }
        E(acc, cur, wr, wc, fr, fq);
        if (!has_next) break;
#pragma unroll
        for (int a = 0; a < 2; ++a)
#pragma unroll
            for (int b = 0; b < 2; ++b)
#pragma unroll
                for (int m = 0; m < 4; ++m)
#pragma unroll
                    for (int n = 0; n < 2; ++n) acc[a][b][m][n] = (f32x4){0.f, 0.f, 0.f, 0.f};
        cur = nxt; cA = nA; cB = nB; ++ui;
    }
    PG8_WAIT_V(0);
    if (wr == 0) PG8_BAR;
    PG8_BAR;
#undef PG8_SA
#undef PG8_SB
#undef PG8_STAGE
#undef PG8_LDA
#undef PG8_LDB
#undef PG8_MMA
#undef PG8_WAIT_V
#undef PG8_WAIT_L
#undef PG8_BAR
#undef PG8_SCHED
}
}
using pg8::Unit;

struct ProbPlain {
    static constexpr bool GATHER = false;
    const bf16_t* A; const bf16_t* B; int K, lda, ldb;
    __device__ __forceinline__ const char* abase(const Unit& u) const { return (const char*)(A + (size_t)u.pm * 256 * lda); }
    __device__ __forceinline__ const char* bbase(const Unit& u) const { return (const char*)(B + (size_t)u.pn * 256 * ldb); }
    __device__ __forceinline__ void avoff(const Unit&, const int (&RA)[2], const int (&CA)[2], unsigned (&v)[2][2]) const {
#pragma unroll
        for (int h = 0; h < 2; ++h)
#pragma unroll
            for (int i = 0; i < 2; ++i) v[h][i] = (unsigned)((h * 128 + RA[i]) * lda + CA[i]) * 2u;
    }
};
struct ProbMoeUp {
    static constexpr bool GATHER = true;
    const bf16_t* A; const bf16_t* B; const int* idx; int K, lda, ldb;
    __device__ __forceinline__ const char* abase(const Unit&) const { return (const char*)A; }
    __device__ __forceinline__ const char* bbase(const Unit& u) const { return (const char*)(B + ((size_t)(u.pm >> 4) * 3072 + (size_t)u.pn * 256) * ldb); }
    __device__ __forceinline__ void avoff(const Unit& u, const int (&RA)[2], const int (&CA)[2], unsigned (&v)[2][2]) const {
#pragma unroll
        for (int h = 0; h < 2; ++h)
#pragma unroll
            for (int i = 0; i < 2; ++i) { const int g = idx[u.pm * 256 + h * 128 + RA[i]]; v[h][i] = (unsigned)(g * lda + CA[i]) * 2u; }
    }
};
struct ProbMoeDown {
    static constexpr bool GATHER = false;
    const bf16_t* A; const bf16_t* B; int K, lda, ldb;
    __device__ __forceinline__ const char* abase(const Unit& u) const { return (const char*)(A + (size_t)u.pm * 256 * lda); }
    __device__ __forceinline__ const char* bbase(const Unit& u) const { return (const char*)(B + ((size_t)(u.pm >> 4) * 1024 + (size_t)u.pn * 256) * ldb); }
    __device__ __forceinline__ void avoff(const Unit&, const int (&RA)[2], const int (&CA)[2], unsigned (&v)[2][2]) const {
#pragma unroll
        for (int h = 0; h < 2; ++h)
#pragma unroll
            for (int i = 0; i < 2; ++i) v[h][i] = (unsigned)((h * 128 + RA[i]) * lda + CA[i]) * 2u;
    }
};

#define EPI_ROWS(...) _Pragma("unroll") for (int ai = 0; ai < 2; ++ai) _Pragma("unroll") for (int m = 0; m < 4; ++m) { const int row = u.pm * 256 + ai * 128 + wr * 64 + m * 16 + fr; __VA_ARGS__ }
__device__ __forceinline__ u32x4 pack8(const f32x4 v0, const f32x4 v1) { u32x4 w; w.x = cvt_pk_bf16(v0[0], v0[1]); w.y = cvt_pk_bf16(v0[2], v0[3]); w.z = cvt_pk_bf16(v1[0], v1[1]); w.w = cvt_pk_bf16(v1[2], v1[3]); return w; }

struct EpiPQ {
    static constexpr bool PERM = true; bf16_t* O;
    __device__ __forceinline__ void operator()(const f32x4 (&acc)[2][2][4][2], const Unit& u, int wr, int wc, int fr, int fq) const {
        const int tg0 = u.pn * 256 + wc * 32 + 8 * fq, b = tg0 >> 12;
        EPI_ROWS(
            bf16_t* rp = O + ((size_t)(b * 1024 + row) * 4096 + (tg0 & 4095));
            _Pragma("unroll") for (int bj = 0; bj < 2; ++bj) *(u32x4*)(rp + bj * 128) = pack8(acc[ai][bj][m][0], acc[ai][bj][m][1]);
        )
    }
};
struct EpiZ {
    static constexpr bool PERM = true; bf16_t* O; int ldc; int fixed_act;
    __device__ __forceinline__ void operator()(const f32x4 (&acc)[2][2][4][2], const Unit& u, int wr, int wc, int fr, int fq) const {
        const int col0 = u.pn * 256 + wc * 32 + 8 * fq; const int act = fixed_act >= 0 ? fixed_act : (u.pn >> 2);
        EPI_ROWS(
            bf16_t* rp = O + (size_t)row * ldc + col0;
            _Pragma("unroll") for (int bj = 0; bj < 2; ++bj) {
                f32x4 v0 = acc[ai][bj][m][0], v1 = acc[ai][bj][m][1];
                if (act == 1) { _Pragma("unroll") for (int j = 0; j < 4; ++j) { v0[j] = gelu_tanh(v0[j]); v1[j] = gelu_tanh(v1[j]); } }
                else if (act >= 2) { _Pragma("unroll") for (int j = 0; j < 4; ++j) { v0[j] = sigmoidf_(v0[j]); v1[j] = sigmoidf_(v1[j]); } }
                *(u32x4*)(rp + bj * 128) = pack8(v0, v1); }
        )
    }
};
struct EpiF {
    static constexpr bool PERM = true; bf16_t* O;
    __device__ __forceinline__ void operator()(const f32x4 (&acc)[2][2][4][2], const Unit& u, int wr, int wc, int fr, int fq) const {
        const int b = u.pn >> 1, ch0 = (u.pn & 1) * 256 + wc * 32 + 8 * fq;
        EPI_ROWS(
            bf16_t* rp = O + ((size_t)(b * 4096 + row) * 512 + ch0);
            _Pragma("unroll") for (int bj = 0; bj < 2; ++bj) *(u32x4*)(rp + bj * 128) = pack8(acc[ai][bj][m][0], acc[ai][bj][m][1]);
        )
    }
};
struct EpiY1 {
    static constexpr bool PERM = true; bf16_t* O; const bf16_t* Z;
    __device__ __forceinline__ void operator()(const f32x4 (&acc)[2][2][4][2], const Unit& u, int wr, int wc, int fr, int fq) const {
        const int col0 = u.pn * 256 + wc * 32 + 8 * fq;
        EPI_ROWS(
            _Pragma("unroll") for (int bj = 0; bj < 2; ++bj) {
                const int col = col0 + bj * 128; float g[8]; unpack8(*(const u32x4*)(Z + (size_t)row * 4096 + 2048 + col), g);
                f32x4 v0 = acc[ai][bj][m][0], v1 = acc[ai][bj][m][1];
                _Pragma("unroll") for (int j = 0; j < 4; ++j) { v0[j] *= g[j]; v1[j] *= g[4 + j]; }
                *(u32x4*)(O + (size_t)row * 1024 + col) = pack8(v0, v1); }
        )
    }
};
struct EpiY2 {
    static constexpr bool PERM = true; bf16_t* O; const bf16_t* Z;
    __device__ __forceinline__ void operator()(const f32x4 (&acc)[2][2][4][2], const Unit& u, int wr, int wc, int fr, int fq) const {
        const int col0 = u.pn * 256 + wc * 32 + 8 * fq;
        EPI_ROWS(
            _Pragma("unroll") for (int bj = 0; bj < 2; ++bj) {
                const int col = col0 + bj * 128; float g[8], t1[8]; unpack8(*(const u32x4*)(Z + (size_t)row * 4096 + 3072 + col), g); unpack8(*(const u32x4*)(O + (size_t)row * 1024 + col), t1);
                f32x4 v0 = acc[ai][bj][m][0], v1 = acc[ai][bj][m][1];
                _Pragma("unroll") for (int j = 0; j < 4; ++j) { v0[j] = t1[j] + v0[j] * g[j]; v1[j] = t1[4 + j] + v1[j] * g[4 + j]; }
                *(u32x4*)(O + (size_t)row * 1024 + col) = pack8(v0, v1); }
        )
    }
};
struct EpiOut {
    static constexpr bool PERM = false; float* O; const float* X; const float* pos; const float* ada;
    __device__ __forceinline__ void operator()(const f32x4 (&acc)[2][2][4][2], const Unit& u, int wr, int wc, int fr, int fq) const {
        const int col0 = u.pn * 256 + wc * 32 + 4 * fq; const int b = u.pm >> 4;
        EPI_ROWS(
            const int t = row & 4095;
            _Pragma("unroll") for (int bj = 0; bj < 2; ++bj) _Pragma("unroll") for (int n = 0; n < 2; ++n) {
                const int col = col0 + bj * 128 + n * 16;
                const f32x4 xv = *(const f32x4*)(X + (size_t)row * 1024 + col);
                const f32x4 pv = *(const f32x4*)(pos + (col < 512 ? (t >> 6) * 512 + col : (t & 63) * 512 + (col - 512)));
                const f32x4 gv = *(const f32x4*)(ada + b * 6144 + 2048 + col);
                *(f32x4*)(O + (size_t)row * 1024 + col) = xv + pv + gv * acc[ai][bj][m][n]; }
        )
    }
};
struct EpiGU {
    static constexpr bool PERM = true; bf16_t* O;
    __device__ __forceinline__ void operator()(const f32x4 (&acc)[2][2][4][2], const Unit& u, int wr, int wc, int fr, int fq) const {
        const int col0 = u.pn * 128 + wc * 32 + 8 * fq;
        EPI_ROWS(
            f32x4 v0, v1;
            _Pragma("unroll") for (int j = 0; j < 4; ++j) { const float g0 = acc[ai][0][m][0][j], g1 = acc[ai][0][m][1][j];
                v0[j] = g0 * sigmoidf_(g0) * acc[ai][1][m][0][j]; v1[j] = g1 * sigmoidf_(g1) * acc[ai][1][m][1][j]; }
            *(u32x4*)(O + (size_t)row * DE + col0) = pack8(v0, v1);
        )
    }
};
struct EpiDown {
    static constexpr bool PERM = true; bf16_t* O; const float* gate;
    __device__ __forceinline__ void operator()(const f32x4 (&acc)[2][2][4][2], const Unit& u, int wr, int wc, int fr, int fq) const {
        const int col0 = u.pn * 256 + wc * 32 + 8 * fq;
        EPI_ROWS(
            const float g = gate[row];
            _Pragma("unroll") for (int bj = 0; bj < 2; ++bj) *(u32x4*)(O + (size_t)row * 1024 + col0 + bj * 128) = pack8(acc[ai][bj][m][0] * g, acc[ai][bj][m][1] * g);
        )
    }
};

__device__ void p0_ada(const Params& p, LAS unsigned char* lds, int item) {
    const int tid = threadIdx.x;
    LAS float* s = (LAS float*)lds; LAS float* red = s + 9 * 1024;
    for (int i = tid; i < 9 * 1024; i += NTHR) { const int r = i >> 10, d = i & 1023; const float v = r < 8 ? p.c[r * 1024 + d] : p.c_ctx[d]; s[i] = v / (1.0f + expf(-v)); }
    __syncthreads();
    const int col = tid & 63, ds = tid >> 6; float a[9];
#pragma unroll
    for (int r = 0; r < 9; ++r) a[r] = 0.f;
    const float* w = p.w_ada + (size_t)(ds * 128) * 6144 + item * 64 + col;
    for (int d = 0; d < 128; ++d) { const float wv = w[(size_t)d * 6144];
#pragma unroll
        for (int r = 0; r < 9; ++r) a[r] += s[r * 1024 + ds * 128 + d] * wv; }
#pragma unroll
    for (int r = 0; r < 9; ++r) red[(ds * 9 + r) * 64 + col] = a[r];
    __syncthreads();
    float* ada = (float*)(p.ws + WS_ADA);
    for (int i = tid; i < 9 * 64; i += NTHR) { const int r = i >> 6, cc = i & 63; float v = 0.f;
#pragma unroll
        for (int k = 0; k < 8; ++k) v += red[(k * 9 + r) * 64 + cc];
        ada[r * 6144 + item * 64 + cc] = v + p.b_ada[item * 64 + cc]; }
    __syncthreads();
}
template <int NS>
__device__ __forceinline__ void xpose_item(const float* src, int ldsrc, bf16_t* dst, int lddst, int k0, int n0, int mode) {
    const int tid = threadIdx.x, nl = tid & 63, k8 = tid >> 6;
    float v[NS][8];
#pragma unroll
    for (int s = 0; s < NS; ++s)
#pragma unroll
        for (int j = 0; j < 8; ++j) v[s][j] = src[(size_t)(k0 + 8 * k8 + j) * ldsrc + n0 + 64 * s + nl];
#pragma unroll
    for (int s = 0; s < NS; ++s) { const int n = n0 + 64 * s + nl; int row = n;
        if (mode) row = (n >> 7) * 256 + (n & 127) + (mode == 2 ? 128 : 0);
        u32x4 w; w.x = cvt_pk_bf16(v[s][0], v[s][1]); w.y = cvt_pk_bf16(v[s][2], v[s][3]); w.z = cvt_pk_bf16(v[s][4], v[s][5]); w.w = cvt_pk_bf16(v[s][6], v[s][7]);
        *(u32x4*)(dst + (size_t)row * lddst + k0 + 8 * k8) = w; }
}
__device__ void p0_wpq(const Params& p, LAS unsigned char* lds, int item) {
    const int tid = threadIdx.x, g = item >> 4, db = item & 15;
    LAS float* wl = (LAS float*)lds; LAS float* ct = wl + 64 * 129;
    for (int i = tid; i < 64 * 128; i += NTHR) { const int d = i >> 7, cc = i & 127; wl[d * 129 + cc] = p.w_in[(size_t)(db * 64 + d) * 4608 + g * 128 + cc]; }
    if (tid < 128) { float sn, cs; sincospif((float)tid * (1.0f / 64.0f), &sn, &cs); ct[tid] = cs; ct[128 + tid] = sn; }
    __syncthreads();
    const int q = tid & 255, kc = q >> 1, pq = q & 1, dh = tid >> 8; const int n = (g * 128 + kc) * 2 + pq;
    bf16_t* dst = (bf16_t*)(p.ws + WS_WPQ) + (size_t)n * 1024 + db * 64 + dh * 32;
    const float scale = 0.001381067932f;
    for (int d8 = 0; d8 < 4; ++d8) { float a[8];
#pragma unroll
        for (int j = 0; j < 8; ++j) a[j] = 0.f;
        for (int cc = 0; cc < 128; ++cc) { const float tv = ct[pq * 128 + ((cc * kc) & 127)];
#pragma unroll
            for (int j = 0; j < 8; ++j) a[j] += wl[(dh * 32 + d8 * 8 + j) * 129 + cc] * tv; }
        u32x4 w; w.x = cvt_pk_bf16(a[0] * scale, a[1] * scale); w.y = cvt_pk_bf16(a[2] * scale, a[3] * scale); w.z = cvt_pk_bf16(a[4] * scale, a[5] * scale); w.w = cvt_pk_bf16(a[6] * scale, a[7] * scale);
        *(u32x4*)(dst + d8 * 8) = w; }
    __syncthreads();
}
__device__ void p0_dft_row(const Params& p, int tp) {
    bf16_t* dst = (bf16_t*)((unsigned char*)p.out + OUT_DFT) + (size_t)tp * 8192;
#pragma unroll
    for (int ps = 0; ps < 2; ++ps) { const int k8 = (ps * NTHR + threadIdx.x) * 8; const bool hi = k8 >= 4096; const int t0 = k8 & 4095; float v[8];
#pragma unroll
        for (int j = 0; j < 8; ++j) { const int mm = (tp * (t0 + j)) & 4095; float sn, cs; sincospif((float)mm * (1.0f / 2048.0f), &sn, &cs); v[j] = hi ? -sn : cs; }
        u32x4 w; w.x = cvt_pk_bf16(v[0], v[1]); w.y = cvt_pk_bf16(v[2], v[3]); w.z = cvt_pk_bf16(v[4], v[5]); w.w = cvt_pk_bf16(v[6], v[7]);
        *(u32x4*)(dst + k8) = w; }
}
__device__ void p0_pos(const Params& p) {
    float* tab = (float*)(p.ws + WS_POS);
    for (int i = threadIdx.x; i < 64 * 512; i += NTHR) { const int ii = i >> 9, j = i & 511, jj = j & 255; const float f = expf(-9.210340371976184f * (float)jj / 256.0f); const float a = (float)ii * f; tab[i] = j < 256 ? sinf(a) : cosf(a); }
}
__device__ void phase0(const Params& p, LAS unsigned char* lds) {
    constexpr int N_ADA = 96, N_WIN = 16 * 16, N_WFOUR = 8 * 4, N_SQ = 16 * 4, N_LRU = 16 * 2, N_WPQ = 64, N_DFT = 4096, N_POS = 1;
    constexpr int O1 = N_ADA, O2 = O1 + N_WIN, O3 = O2 + N_WFOUR, O4 = O3 + N_SQ, O5 = O4 + N_SQ, O6 = O5 + N_LRU, O7 = O6 + N_LRU, O8 = O7 + N_WPQ, O9 = O8 + N_DFT, O10 = O9 + N_POS;
    for (int it = blockIdx.x; it < O10; it += gridDim.x) {
        if (it < O1) p0_ada(p, lds, it);
        else if (it < O2) { const int j = it - O1; xpose_item<4>(p.w_in + 512, 4608, (bf16_t*)(p.ws + WS_WIN), 1024, (j >> 4) * 64, (j & 15) * 256, 0); }
        else if (it < O3) { const int j = it - O2; xpose_item<4>(p.w_four, 1024, (bf16_t*)(p.ws + WS_WFOUR), 512, (j >> 2) * 64, (j & 3) * 256, 0); }
        else if (it < O4) { const int j = it - O3; xpose_item<4>(p.w_lru, 1024, (bf16_t*)(p.ws + WS_WLRU), 1024, (j >> 2) * 64, (j & 3) * 256, 0); }
        else if (it < O5) { const int j = it - O4; xpose_item<4>(p.w_out, 1024, (bf16_t*)(p.ws + WS_WOUT), 1024, (j >> 2) * 64, (j & 3) * 256, 0); }
        else if (it < O6) { const int j = it - O5, mtx = j >> 1; xpose_item<2>(p.lru_wa + (size_t)mtx * 16384, 128, (bf16_t*)(p.ws + WS_WAT) + (size_t)mtx * 16384, 128, (j & 1) * 64, 0, 0); }
        else if (it < O7) { const int j = it - O6, mtx = j >> 1; xpose_item<2>(p.lru_wi + (size_t)mtx * 16384, 128, (bf16_t*)(p.ws + WS_WIT) + (size_t)mtx * 16384, 128, (j & 1) * 64, 0, 0); }
        else if (it < O8) p0_wpq(p, lds, it - O7);
        else if (it < O9) p0_dft_row(p, it - O8);
        else p0_pos(p);
    }
}

__device__ void phase1(const Params& p) {
    const int lane = threadIdx.x & 63, wid = threadIdx.x >> 6;
    const float* ada = (const float*)(p.ws + WS_ADA); const float* tab = (const float*)(p.ws + WS_POS);
    bf16_t* h1 = (bf16_t*)(p.ws + WS_R1); bf16_t* hc = (bf16_t*)(p.ws + WS_HCTX);
    for (int row = blockIdx.x * 8 + wid; row < MLAT + MCTX; row += gridDim.x * 8) {
        const bool lat = row < MLAT; const int rc = row - MLAT; const int t = row & 4095; const int mrow = lat ? (row >> 12) : 8;
        const float* xr = lat ? p.x + (size_t)row * 1024 : p.ctx + (size_t)rc * 1024;
        f32x4 v[4]; float ss = 0.f;
#pragma unroll
        for (int i = 0; i < 4; ++i) { const int d = 256 * i + 4 * lane; v[i] = *(const f32x4*)(xr + d);
            if (lat) v[i] += *(const f32x4*)(tab + (i < 2 ? (t >> 6) * 512 + d : (t & 63) * 512 + d - 512));
            ss += v[i][0] * v[i][0] + v[i][1] * v[i][1] + v[i][2] * v[i][2] + v[i][3] * v[i][3]; }
        ss = wave_sum(ss); const float rs = rsqrtf(ss * (1.0f / 1024.0f) + 1e-6f);
        bf16_t* dst = lat ? h1 + (size_t)row * 1024 : hc + (size_t)rc * 1024;
#pragma unroll
        for (int i = 0; i < 4; ++i) { const int d = 256 * i + 4 * lane;
            const f32x4 g = *(const f32x4*)(p.norm1_g + d), sh = *(const f32x4*)(ada + mrow * 6144 + d), sc = *(const f32x4*)(ada + mrow * 6144 + 1024 + d);
            const f32x4 h = v[i] * rs * g * (sc + 1.0f) + sh;
            u32x2 w; w.x = cvt_pk_bf16(h[0], h[1]); w.y = cvt_pk_bf16(h[2], h[3]); *(u32x2*)(dst + d) = w; }
    }
}

#define LRU_CST(mb, r) (32 * (mb) + 8 * ((r) >> 2) + ((r) & 3))
template <bool FINAL, int DIR>
__device__ __forceinline__ void lru_wave(const Params& p, LAS unsigned char* ul, int b, int sc, int head, int cb, int lane, f32x16 (&accI)[4]) {
    constexpr int SG = DIR ? -1 : 1;
    const int lr = lane & 31, lh = lane >> 5;
    const int chl = cb * 32 + lr, ch = head * 128 + chl;
    const int tbase = DIR ? 127 - 4 * lh : 4 * lh;
    f32x16 accA[4];
#pragma unroll
    for (int mb = 0; mb < 4; ++mb)
#pragma unroll
        for (int r = 0; r < 16; ++r) { accA[mb][r] = 0.f; accI[mb][r] = 0.f; }
    {
        const bf16_t* wa = (const bf16_t*)(p.ws + WS_WAT) + ((size_t)(DIR * 8 + head) * 128 + chl) * 128 + 8 * lh;
        const bf16_t* wi = (const bf16_t*)(p.ws + WS_WIT) + ((size_t)(DIR * 8 + head) * 128 + chl) * 128 + 8 * lh;
        LAS unsigned char* arow0 = ul + (DIR ? 127 - lr : lr) * 272 + lh * 16;
#pragma unroll
        for (int kc = 0; kc < 2; ++kc) { bf16x8 bA[4], bI[4];
#pragma unroll
            for (int k4 = 0; k4 < 4; ++k4) { bA[k4] = *(const bf16x8*)(wa + 16 * (kc * 4 + k4)); bI[k4] = *(const bf16x8*)(wi + 16 * (kc * 4 + k4)); }
#pragma unroll
            for (int mb = 0; mb < 4; ++mb)
#pragma unroll
                for (int k4 = 0; k4 < 4; ++k4) { const bf16x8 af = *(const LAS bf16x8*)(arow0 + SG * 32 * mb * 272 + 32 * (kc * 4 + k4));
                    accA[mb] = __builtin_amdgcn_mfma_f32_32x32x16_bf16(af, bA[k4], accA[mb], 0, 0, 0);
                    accI[mb] = __builtin_amdgcn_mfma_f32_32x32x16_bf16(af, bI[k4], accI[mb], 0, 0, 0); }
            __builtin_amdgcn_sched_barrier(0); }
    }
    {
        const float lam = p.lru_lambda[DIR * 1024 + ch]; const float sp8 = 8.0f * log1pf(expf(-lam));
        const float ba = p.lru_ba[DIR * 1024 + ch], bi = p.lru_bi[DIR * 1024 + ch];
        LAS unsigned char* up = ul + tbase * 272 + chl * 2;
#pragma unroll
        for (int mb = 0; mb < 4; ++mb) {
#pragma unroll
            for (int r = 0; r < 16; ++r) {
                const float uv = bf2f(*(const LAS bf16_t*)(up + SG * LRU_CST(mb, r) * 272));
                const float rg = sigmoidf_(accA[mb][r] + ba), ig = sigmoidf_(accI[mb][r] + bi);
                const float a = __expf(-sp8 * rg); accA[mb][r] = a; accI[mb][r] = sqrtf(fmaxf(1.0f - a * a, 0.f)) * ig * uv; }
            __builtin_amdgcn_sched_barrier(0); }
    }
    float rA[16], rH[16];
#pragma unroll
    for (int mb = 0; mb < 4; ++mb)
#pragma unroll
        for (int q = 0; q < 4; ++q) { float pa = 1.f, hh = 0.f;
#pragma unroll
            for (int j = 0; j < 4; ++j) { const int r = 4 * q + j; const float a = accA[mb][r], bb = accI[mb][r]; hh = a * hh + bb; pa *= a; accA[mb][r] = pa; accI[mb][r] = hh; }
            rA[mb * 4 + q] = pa; rH[mb * 4 + q] = hh; }
    const int agg_dir_off = ((b * NSEQ) * 2 + DIR) * 1024 + ch;
    const float* agg = (const float*)(p.ws + WS_AGG);
    float carry = 0.f;
    if (FINAL) {
        if (DIR == 0) { for (int q = 0; q < sc; ++q) { const float* a2 = agg + (size_t)(agg_dir_off + q * 2048) * 2; carry = a2[0] * carry + a2[1]; } }
        else { { const float* a2 = agg + (size_t)(agg_dir_off + 1 * 2048) * 2; carry = a2[0] * carry + a2[1]; } { const float* a2 = agg + (size_t)(agg_dir_off + 0 * 2048) * 2; carry = a2[0] * carry + a2[1]; }
            for (int q = NSEQ - 1; q > sc; --q) { const float* a2 = agg + (size_t)(agg_dir_off + q * 2048) * 2; carry = a2[0] * carry + a2[1]; } }
    }
    float cin[16];
#pragma unroll
    for (int i = 0; i < 16; ++i) cin[i] = 0.f;
    float s = carry, At = 1.f;
#pragma unroll
    for (int i = 0; i < 16; ++i) { const float oA = __shfl_xor(rA[i], 32), oH = __shfl_xor(rH[i], 32);
        { const bool mine = (lh == 0); const float a = mine ? rA[i] : oA, hh = mine ? rH[i] : oH; cin[i] = mine ? s : cin[i]; s = a * s + hh; At *= a; }
        { const bool mine = (lh == 1); const float a = mine ? rA[i] : oA, hh = mine ? rH[i] : oH; cin[i] = mine ? s : cin[i]; s = a * s + hh; At *= a; } }
    if (!FINAL) {
        if (lh == 0) { float* o = (float*)(p.ws + WS_AGG) + (size_t)(agg_dir_off + sc * 2048) * 2; o[0] = At; o[1] = s; }
        return;
    }
#pragma unroll
    for (int mb = 0; mb < 4; ++mb)
#pragma unroll
        for (int r = 0; r < 16; ++r) accI[mb][r] += accA[mb][r] * cin[mb * 4 + (r >> 2)];
}
template <bool FINAL>
__device__ void lru_tile(const Params& p, LAS unsigned char* lds, int item) {
    const int tid = threadIdx.x, lane = tid & 63, wid = __builtin_amdgcn_readfirstlane(tid >> 6);
    int b, sc, head;
    if (FINAL) { head = item & 7; sc = 2 + ((item >> 3) & 31); b = item >> 8; }
    else { head = item & 7; const int r = item >> 3; sc = r % NSEQ; b = r / NSEQ; }
    const bf16_t* src; int Tseq, t0, ld;
    if (sc < 2) { src = (const bf16_t*)(p.ws + WS_ZXC) + (size_t)b * 256 * 1024; Tseq = 256; t0 = sc * 128; ld = 1024; }
    else { src = (const bf16_t*)(p.ws + WS_RZ) + (size_t)b * 4096 * 4096; Tseq = 4096; t0 = (sc - 2) * 128; ld = 4096; }
    LAS unsigned char* ul = lds;
    LAS float* ybuf = (LAS float*)(lds + 36 * 1024);
    {
        const int c8 = tid & 15, tb = tid >> 4; const int ch0 = head * 128 + 8 * c8;
        float w[4][8], bias[8];
#pragma unroll
        for (int k = 0; k < 4; ++k) { const f32x4 a = *(const f32x4*)(p.conv_w + k * 1024 + ch0), c2 = *(const f32x4*)(p.conv_w + k * 1024 + ch0 + 4);
#pragma unroll
            for (int j = 0; j < 4; ++j) { w[k][j] = a[j]; w[k][4 + j] = c2[j]; } }
        { const f32x4 a = *(const f32x4*)(p.conv_b + ch0), c2 = *(const f32x4*)(p.conv_b + ch0 + 4);
#pragma unroll
            for (int j = 0; j < 4; ++j) { bias[j] = a[j]; bias[4 + j] = c2[j]; } }
#pragma unroll
        for (int i = 0; i < 4; ++i) { const int t = tb + 32 * i; float a[8];
#pragma unroll
            for (int j = 0; j < 8; ++j) a[j] = bias[j];
#pragma unroll
            for (int k = 0; k < 4; ++k) { const int tt = t0 + t + k - 2;
                if (tt >= 0 && tt < Tseq) { float f[8]; unpack8(*(const u32x4*)(src + (size_t)tt * ld + ch0), f);
#pragma unroll
                    for (int j = 0; j < 8; ++j) a[j] += w[k][j] * f[j]; } }
            u32x4 wv; wv.x = cvt_pk_bf16(a[0], a[1]); wv.y = cvt_pk_bf16(a[2], a[3]); wv.z = cvt_pk_bf16(a[4], a[5]); wv.w = cvt_pk_bf16(a[6], a[7]);
            *(LAS u32x4*)(ul + t * 272 + c8 * 16) = wv; }
    }
    __syncthreads();
    f32x16 hacc[4];
    if (wid < 4) lru_wave<FINAL, 0>(p, ul, b, sc, head, wid & 3, lane, hacc);
    else lru_wave<FINAL, 1>(p, ul, b, sc, head, wid & 3, lane, hacc);
    if (FINAL) {
        const int lr = lane & 31, lh = lane >> 5, chl = (wid & 3) * 32 + lr;
        if (wid >= 4) { LAS float* yp = ybuf + (127 - 4 * lh) * 129 + chl;
#pragma unroll
            for (int mb = 0; mb < 4; ++mb)
#pragma unroll
                for (int r = 0; r < 16; ++r) yp[-LRU_CST(mb, r) * 129] = hacc[mb][r]; }
        __syncthreads();
        if (wid < 4) {
            const LAS float* yp = ybuf + (4 * lh) * 129 + chl;
            const bf16_t* Zu = (const bf16_t*)(p.ws + WS_RZ) + ((size_t)(b * 4096 + t0) * 4096 + 1024 + head * 128);
            bf16_t* Ou = (bf16_t*)(p.ws + WS_R1) + ((size_t)(b * 4096 + t0) * 1024 + head * 128);
            const unsigned zo = (unsigned)(4 * lh * 4096 + chl), oo = (unsigned)(4 * lh * 1024 + chl);
#pragma unroll
            for (int mb = 0; mb < 4; ++mb) {
#pragma unroll
                for (int r = 0; r < 16; ++r) {
                    const float y = hacc[mb][r] + yp[LRU_CST(mb, r) * 129];
                    const float gz = bf2f(Zu[zo + LRU_CST(mb, r) * 4096]);
                    Ou[oo + LRU_CST(mb, r) * 1024] = (bf16_t)(cvt_pk_bf16(gz * y, 0.f) & 0xffffu);
                    if ((r & 7) == 7) __builtin_amdgcn_sched_barrier(0); } }
        }
    }
    __syncthreads();
}

__device__ void phase7_rows(const Params& p, LAS unsigned char* lds) {
    const int tid = threadIdx.x, lane = tid & 63, wid = tid >> 6;
    LAS float* wrt = (LAS float*)lds;
    for (int i = tid; i < 16 * 1024; i += NTHR) { const int d = i >> 4, e = i & 15; wrt[e * 1024 + d] = p.w_router[i]; }
    __syncthreads();
    const float* ada = (const float*)(p.ws + WS_ADA); bf16_t* h2 = (bf16_t*)(p.ws + WS_R1); float* scores = (float*)(p.ws + WS_SCORES);
    for (int row = blockIdx.x * 8 + wid; row < MLAT; row += gridDim.x * 8) {
        const int b = row >> 12, t = row & 4095; const float* xr = p.out + (size_t)row * 1024;
        f32x4 v[4]; float ss = 0.f;
#pragma unroll
        for (int i = 0; i < 4; ++i) { v[i] = *(const f32x4*)(xr + 256 * i + 4 * lane); ss += v[i][0] * v[i][0] + v[i][1] * v[i][1] + v[i][2] * v[i][2] + v[i][3] * v[i][3]; }
        ss = wave_sum(ss); const float rs = rsqrtf(ss * (1.0f / 1024.0f) + 1e-6f);
#pragma unroll
        for (int i = 0; i < 4; ++i) { const int d = 256 * i + 4 * lane;
            const f32x4 g = *(const f32x4*)(p.norm2_g + d), sh = *(const f32x4*)(ada + b * 6144 + 3072 + d), sc = *(const f32x4*)(ada + b * 6144 + 4096 + d);
            v[i] = v[i] * rs * g * (sc + 1.0f) + sh;
            u32x2 w; w.x = cvt_pk_bf16(v[i][0], v[i][1]); w.y = cvt_pk_bf16(v[i][2], v[i][3]); *(u32x2*)(h2 + (size_t)row * 1024 + d) = w; }
        float lg[16];
#pragma unroll
        for (int e = 0; e < 16; ++e) { float a = 0.f;
#pragma unroll
            for (int i = 0; i < 4; ++i) { const f32x4 w = *(const LAS f32x4*)(wrt + e * 1024 + 256 * i + 4 * lane); a += v[i][0] * w[0] + v[i][1] * w[1] + v[i][2] * w[2] + v[i][3] * w[3]; }
            lg[e] = wave_sum(a); }
        float mx = lg[0];
#pragma unroll
        for (int e = 1; e < 16; ++e) mx = fmaxf(mx, lg[e]);
        float sum = 0.f;
#pragma unroll
        for (int e = 0; e < 16; ++e) { lg[e] = expf(lg[e] - mx); sum += lg[e]; }
        const float inv = 1.0f / sum; float mine = 0.f;
#pragma unroll
        for (int e = 0; e < 16; ++e) mine = (lane == e) ? lg[e] * inv : mine;
        if (lane < 16) scores[((size_t)b * 16 + lane) * 4096 + t] = mine;
    }
    __syncthreads();
}
__device__ void phase7_weights(const Params& p) {
    constexpr int N_G = 16 * 16 * 6, N_D = 16 * 24 * 4;
    for (int it = blockIdx.x; it < 2 * N_G + N_D; it += gridDim.x) {
        if (it < 2 * N_G) { const int up = it >= N_G, j = up ? it - N_G : it, e = j / 96, r = j % 96, kb = r / 6, nb = r % 6;
            xpose_item<4>((up ? p.w_up_e : p.w_gate_e) + (size_t)e * 1024 * 1536, 1536, (bf16_t*)(p.ws + WS_WGU) + (size_t)e * 3072 * 1024, 1024, kb * 64, nb * 256, up ? 2 : 1); }
        else { const int j = it - 2 * N_G, e = j / 96, r = j % 96, kb = r >> 2, nb = r & 3;
            xpose_item<4>(p.w_down_e + (size_t)e * 1536 * 1024, 1024, (bf16_t*)(p.ws + WS_WD) + (size_t)e * 1024 * 1536, 1536, kb * 64, nb * 256, 0); }
    }
}

__device__ void phase8_topk(const Params& p, LAS unsigned char* lds) {
    const int tid = threadIdx.x, lane = tid & 63, wid = tid >> 6;
    LAS unsigned* hist = (LAS unsigned*)lds;
    LAS unsigned* ctl = hist + 256;
    LAS unsigned* wsum = hist + 320;
    const float* scores = (const float*)(p.ws + WS_SCORES);
    int* idx = (int*)(p.ws + WS_IDX); float* gate = (float*)(p.ws + WS_GATE); int* slot_of = (int*)(p.ws + WS_SLOT);
    for (int it = blockIdx.x; it < NB * NE; it += gridDim.x) {
        const int b = it >> 4, e = it & 15;
        unsigned key[8];
        { const u32x4* sp = (const u32x4*)(scores + (size_t)it * 4096 + tid * 8); const u32x4 a = sp[0], c2 = sp[1]; key[0] = a.x; key[1] = a.y; key[2] = a.z; key[3] = a.w; key[4] = c2.x; key[5] = c2.y; key[6] = c2.z; key[7] = c2.w; }
        unsigned prefix = 0, krem = CAP;
        for (int ps = 3; ps >= 0; --ps) {
            if (tid < 256) hist[tid] = 0;
            __syncthreads();
            const int sh = ps * 8;
#pragma unroll
            for (int j = 0; j < 8; ++j) { const bool ok = (ps == 3) || ((key[j] >> (sh + 8)) == (prefix >> (sh + 8))); if (ok) atomicAdd((unsigned*)&hist[(key[j] >> sh) & 255u], 1u); }
            __syncthreads();
            if (tid < 256) { unsigned above = 0; for (int j = tid + 1; j < 256; ++j) above += hist[j]; const unsigned h = hist[tid];
                if (above < krem && krem <= above + h) { ctl[0] = (unsigned)tid; ctl[1] = krem - above; } }
            __syncthreads();
            prefix |= ctl[0] << sh; krem = ctl[1];
            __syncthreads();
        }
        unsigned cg_ = 0, ce = 0;
#pragma unroll
        for (int j = 0; j < 8; ++j) { cg_ += key[j] > prefix; ce += key[j] == prefix; }
        unsigned pk = cg_ | (ce << 16), incl = pk;
#pragma unroll
        for (int o = 1; o < 64; o <<= 1) { const unsigned n = __shfl_up(incl, o); if (lane >= o) incl += n; }
        if (lane == 63) wsum[wid] = incl;
        __syncthreads();
        unsigned base = 0, total = 0;
#pragma unroll
        for (int w = 0; w < 8; ++w) { const unsigned s = wsum[w]; if (w < wid) base += s; total += s; }
        const unsigned excl = base + incl - pk; unsigned og = excl & 0xffffu, oe = excl >> 16; const unsigned ngt = total & 0xffffu;
#pragma unroll
        for (int j = 0; j < 8; ++j) { const int t = tid * 8 + j; int m = -1;
            if (key[j] > prefix) { m = (e * 8 + b) * 512 + (int)og; ++og; }
            else if (key[j] == prefix) { if (oe < krem) m = (e * 8 + b) * 512 + (int)(ngt + oe); ++oe; }
            slot_of[((size_t)b * 4096 + t) * 16 + e] = m;
            if (m >= 0) { idx[m] = b * 4096 + t; gate[m] = __uint_as_float(key[j]); } }
        __syncthreads();
    }
}

__device__ void phase11(const Params& p) {
    const int lane = threadIdx.x & 63, wid = threadIdx.x >> 6;
    const float* ada = (const float*)(p.ws + WS_ADA); const int* slot_of = (const int*)(p.ws + WS_SLOT); const bf16_t* oute = (const bf16_t*)(p.ws + WS_OUTE);
    for (int row = blockIdx.x * 8 + wid; row < MLAT; row += gridDim.x * 8) {
        const int b = row >> 12; float* xr = p.out + (size_t)row * 1024;
        f32x4 acc[4];
#pragma unroll
        for (int i = 0; i < 4; ++i) acc[i] = (f32x4){0.f, 0.f, 0.f, 0.f};
        const int myslot = slot_of[(size_t)row * 16 + (lane & 15)];
#pragma unroll
        for (int e = 0; e < 16; ++e) { const int m = __builtin_amdgcn_readlane(myslot, e);
            if (m >= 0) { const bf16_t* er = oute + (size_t)m * 1024;
#pragma unroll
                for (int i = 0; i < 4; ++i) { const u32x2 w = *(const u32x2*)(er + 256 * i + 4 * lane); acc[i][0] += bf_lo(w.x); acc[i][1] += bf_hi(w.x); acc[i][2] += bf_lo(w.y); acc[i][3] += bf_hi(w.y); } } }
        f32x4 v[4]; float ss = 0.f;
#pragma unroll
        for (int i = 0; i < 4; ++i) { const int d = 256 * i + 4 * lane; const f32x4 g2 = *(const f32x4*)(ada + b * 6144 + 5120 + d); v[i] = *(const f32x4*)(xr + d) + g2 * acc[i];
            ss += v[i][0] * v[i][0] + v[i][1] * v[i][1] + v[i][2] * v[i][2] + v[i][3] * v[i][3]; }
        ss = wave_sum(ss); const float rs = rsqrtf(ss * (1.0f / 1024.0f) + 1e-6f);
#pragma unroll
        for (int i = 0; i < 4; ++i) { const int d = 256 * i + 4 * lane; *(f32x4*)(xr + d) = v[i] * rs * *(const f32x4*)(p.final_g + d); }
    }
}

__global__ void __launch_bounds__(NTHR, 2) fwd_megakernel(Params p) {
    extern __shared__ __attribute__((aligned(16))) unsigned char lds_raw[];
    LAS unsigned char* lds = (LAS unsigned char*)lds_raw;
    cg::grid_group grid = cg::this_grid();
    const int G = gridDim.x, bid = blockIdx.x;
    unsigned char* ws = p.ws;
    bf16_t* const R1 = (bf16_t*)(ws + WS_R1); bf16_t* const Zb = (bf16_t*)(ws + WS_RZ); bf16_t* const PQt = (bf16_t*)(ws + WS_RPQ); bf16_t* const MRG = (bf16_t*)(ws + WS_R2);
    bf16_t* const Fb = (bf16_t*)((unsigned char*)p.out + OUT_F); const bf16_t* const DFT = (const bf16_t*)((unsigned char*)p.out + OUT_DFT);
#ifdef ONLY_PH
#define PH(k) ((k) == ONLY_PH && p.ph_lo <= (k) && (k) < p.ph_hi)
#else
#define PH(k) (p.ph_lo <= (k) && (k) < p.ph_hi)
#endif
#define SYNC(k) do { if (PH(k) && PH((k) + 1)) grid.sync(); } while (0)
    if (PH(0)) phase0(p, lds);
    SYNC(0);
    if (PH(1)) phase1(p);
    SYNC(1);
    if (PH(2)) {
        { ProbPlain pr{(const bf16_t*)(ws + WS_WPQ), R1, 1024, 1024, 1024}; pg8::Order S; S.init(4, 128, G, bid); EpiPQ E{PQt}; pg8::gemm_phase(lds, pr, S, E); }
        { ProbPlain pr{R1, (const bf16_t*)(ws + WS_WIN), 1024, 1024, 1024}; pg8::Order S; S.init(128, 16, G, bid); EpiZ E{Zb, 4096, -1}; pg8::gemm_phase(lds, pr, S, E); }
        { ProbPlain pr{(const bf16_t*)(ws + WS_HCTX), (const bf16_t*)(ws + WS_WIN), 1024, 1024, 1024}; pg8::Order S; S.init(8, 4, G, bid); EpiZ E{(bf16_t*)(ws + WS_ZXC), 1024, 0}; pg8::gemm_phase(lds, pr, S, E); }
    }
    SYNC(2);
    if (PH(3)) {
        { ProbPlain pr{DFT, PQt, 8192, 8192, 8192}; pg8::Order S; S.init(16, 16, G, bid); EpiF E{Fb}; pg8::gemm_phase(lds, pr, S, E); }
        for (int it = bid; it < NB * NSEQ * 8; it += G) lru_tile<false>(p, lds, it);
    }
    SYNC(3);
    if (PH(4)) { for (int it = bid; it < NB * 32 * 8; it += G) lru_tile<true>(p, lds, it); }
    SYNC(4);
    if (PH(5)) {
        { ProbPlain pr{Fb, (const bf16_t*)(ws + WS_WFOUR), 512, 512, 512}; pg8::Order S; S.init(128, 4, G, bid); EpiY1 E{MRG, Zb}; pg8::gemm_phase(lds, pr, S, E); }
        { ProbPlain pr{R1, (const bf16_t*)(ws + WS_WLRU), 1024, 1024, 1024}; pg8::Order S; S.init(128, 4, G, bid); EpiY2 E{MRG, Zb}; pg8::gemm_phase(lds, pr, S, E); }
    }
    SYNC(5);
    if (PH(6)) { ProbPlain pr{MRG, (const bf16_t*)(ws + WS_WOUT), 1024, 1024, 1024}; pg8::Order S; S.init(128, 4, G, bid);
        EpiOut E{p.out, p.x, (const float*)(ws + WS_POS), (const float*)(ws + WS_ADA)}; pg8::gemm_phase(lds, pr, S, E); }
    SYNC(6);
    if (PH(7)) { phase7_rows(p, lds); phase7_weights(p); }
    SYNC(7);
    if (PH(8)) phase8_topk(p, lds);
    SYNC(8);
    if (PH(9)) { ProbMoeUp pr{R1, (const bf16_t*)(ws + WS_WGU), (const int*)(ws + WS_IDX), 1024, 1024, 1024}; pg8::Order S; S.init(256, 12, G, bid); EpiGU E{(bf16_t*)(ws + WS_HID)}; pg8::gemm_phase(lds, pr, S, E); }
    SYNC(9);
    if (PH(10)) { ProbMoeDown pr{(const bf16_t*)(ws + WS_HID), (const bf16_t*)(ws + WS_WD), 1536, 1536, 1536}; pg8::Order S; S.init(256, 4, G, bid); EpiDown E{(bf16_t*)(ws + WS_OUTE), (const float*)(ws + WS_GATE)}; pg8::gemm_phase(lds, pr, S, E); }
    SYNC(10);
    if (PH(11)) phase11(p);
}

#ifndef N_LAUNCHES
#define N_LAUNCHES 1
#endif
extern "C" void kernel_launch(void* const* d_in, const int* in_sizes, int n_in, void* d_out, int out_size, void* d_ws, size_t ws_size, hipStream_t stream) {
    static int grid = 0;
    if (grid == 0) {
        if (n_in != 24 || out_size != MLAT * DM || ws_size < WS_END) { fprintf(stderr, "kernel_launch: unexpected shapes (n_in %d out %d ws %zu)\n", n_in, out_size, ws_size); grid = -1; return; }
        int dev = 0, cus = 0, per_cu = 0;
        hipGetDevice(&dev); hipDeviceGetAttribute(&cus, hipDeviceAttributeMultiprocessorCount, dev);
        hipFuncSetAttribute((const void*)fwd_megakernel, hipFuncAttributeMaxDynamicSharedMemorySize, LDS_BYTES);
        hipOccupancyMaxActiveBlocksPerMultiprocessor(&per_cu, (const void*)fwd_megakernel, NTHR, LDS_BYTES);
        if (per_cu < 1) { fprintf(stderr, "kernel_launch: occupancy query reports %d blocks per CU\n", per_cu); per_cu = 1; }
        grid = cus * 1;
        (void)hipGetLastError();
    }
    if (grid < 0) return;
    Params p{};
    const float** f = (const float**)&p;
    for (int i = 0; i < 24; ++i) f[i] = (const float*)d_in[i];
    p.out = (float*)d_out; p.ws = (unsigned char*)d_ws;
#if N_LAUNCHES == 1
    p.ph_lo = 0; p.ph_hi = 12;
    void* args[] = {&p};
    hipError_t e = hipLaunchCooperativeKernel((const void*)fwd_megakernel, dim3(grid), dim3(NTHR), args, LDS_BYTES, stream);
    if (e != hipSuccess) fprintf(stderr, "cooperative launch failed: %s (grid %d)\n", hipGetErrorString(e), grid);
#else
    for (int k = 0; k < 12; ++k) { p.ph_lo = k; p.ph_hi = k + 1; hipLaunchKernelGGL(fwd_megakernel, dim3(grid), dim3(NTHR), LDS_BYTES, stream, p); }
#endif
}
```

```cpp
#include <hip/hip_runtime.h>
#include <hip/hip_cooperative_groups.h>
#include <cstdio>
namespace cg = cooperative_groups;

#define LAS __attribute__((address_space(3)))
typedef unsigned short bf16_t;
typedef short bf16x8 __attribute__((ext_vector_type(8)));
typedef float f32x4 __attribute__((ext_vector_type(4)));
typedef float f32x16 __attribute__((ext_vector_type(16)));
typedef unsigned u32x4 __attribute__((ext_vector_type(4)));
typedef unsigned u32x2 __attribute__((ext_vector_type(2)));

constexpr int NB = 8, TT = 4096, DM = 1024, CTXL = 256, MLAT = NB * TT, MCTX = NB * CTXL;
constexpr int NE = 16, CAP = 512, DE = 1536, MMOE = NE * NB * CAP;
constexpr int NSEQ = 34;
constexpr int NTHR = 512;
constexpr int LDS_BYTES = 144 * 1024;

constexpr size_t KiB = 1024, MiB = 1024 * 1024;
constexpr size_t WS_ADA = 0;
constexpr size_t WS_POS = 256 * KiB;
constexpr size_t WS_AGG = 512 * KiB;
constexpr size_t WS_WPQ = 5 * MiB;
constexpr size_t WS_WIN = 7 * MiB;
constexpr size_t WS_WFOUR = 15 * MiB;
constexpr size_t WS_WLRU = 16 * MiB;
constexpr size_t WS_WOUT = 18 * MiB;
constexpr size_t WS_WAT = 20 * MiB;
constexpr size_t WS_WIT = 20 * MiB + 512 * KiB;
constexpr size_t WS_SCORES = 21 * MiB;
constexpr size_t WS_IDX = 23 * MiB;
constexpr size_t WS_GATE = 23 * MiB + 256 * KiB;
constexpr size_t WS_SLOT = 23 * MiB + 512 * KiB;
constexpr size_t WS_BAR = 25 * MiB + 512 * KiB;
constexpr size_t WS_HCTX = 26 * MiB;
constexpr size_t WS_ZXC = 30 * MiB;
constexpr size_t WS_R1 = 40 * MiB;
constexpr size_t WS_RPQ = 104 * MiB;
constexpr size_t WS_R2 = 168 * MiB;
constexpr size_t WS_RZ = 232 * MiB;
constexpr size_t WS_END = 488 * MiB;
constexpr size_t WS_HID = WS_RZ, WS_WD = WS_RZ + 192 * MiB, WS_WGU = WS_RPQ, WS_OUTE = WS_R1;
constexpr size_t OUT_DFT = 0, OUT_F = 64 * MiB;

struct Params {
    const float *x, *c, *ctx, *c_ctx, *w_ada, *b_ada, *norm1_g, *norm2_g, *w_in, *w_four, *conv_w, *conv_b, *lru_lambda,
        *lru_wa, *lru_ba, *lru_wi, *lru_bi, *w_lru, *w_out, *w_router, *w_gate_e, *w_up_e, *w_down_e, *final_g;
    float* out; unsigned char* ws; int ph_lo, ph_hi;
};

__device__ __forceinline__ unsigned cvt_pk_bf16(float lo, float hi) { unsigned r; asm volatile("v_cvt_pk_bf16_f32 %0, %1, %2" : "=v"(r) : "v"(lo), "v"(hi)); return r; }
__device__ __forceinline__ float bf_lo(unsigned w) { return __uint_as_float(w << 16); }
__device__ __forceinline__ float bf_hi(unsigned w) { return __uint_as_float(w & 0xffff0000u); }
__device__ __forceinline__ float bf2f(bf16_t h) { return __uint_as_float(((unsigned)h) << 16); }
__device__ __forceinline__ float sigmoidf_(float v) { return __builtin_amdgcn_rcpf(1.0f + __expf(-v)); }
__device__ __forceinline__ float gelu_tanh(float v) { const float y = 1.5957691216f * (v + 0.044715f * v * v * v); return v * sigmoidf_(y); }
__device__ __forceinline__ float wave_sum(float v) {
#pragma unroll
    for (int o = 32; o >= 1; o >>= 1) v += __shfl_xor(v, o);
    return v;
}
__device__ __forceinline__ void unpack8(const u32x4 w, float (&f)[8]) { f[0] = bf_lo(w.x); f[1] = bf_hi(w.x); f[2] = bf_lo(w.y); f[3] = bf_hi(w.y); f[4] = bf_lo(w.z); f[5] = bf_hi(w.z); f[6] = bf_lo(w.w); f[7] = bf_hi(w.w); }

namespace pg8 {
constexpr int BM = 256, BK = 64, HALF = 128, HTB = HALF * BK * 2, STAGE_BYTES = 8 * HTB, NXCD = 8, WGM = 8;
__device__ __forceinline__ int lds_byte(int r, int c) { const int st = (r >> 4) * 2 + (c >> 5), rr = r & 15, cc = c & 31, ob = rr * 64 + cc * 2; return st * 1024 + (ob ^ (((ob >> 9) & 1) << 5)); }
__device__ __forceinline__ void stage_rc(int b, int& R, int& C) { const int st = b / 1024, sb = b % 1024, swz = sb ^ (((sb >> 9) & 1) << 5); R = (st >> 1) * 16 + swz / 64; C = (st & 1) * 32 + (swz % 64) / 2; }
__device__ __forceinline__ int perm32(int rho) { const int n = rho >> 4, i = rho & 15; return 8 * (i >> 2) + 4 * n + (i & 3); }
struct Unit { int pm, pn; };
struct Order {
    int nM, nN, nwg, G, c;
    __device__ void init(int nM_, int nN_, int G_, int c_) { nM = nM_; nN = nN_; nwg = nM * nN; G = G_; c = c_; }
    __device__ bool next(int i, Unit& u) const {
        const long L = (long)i * G + c; if (L >= nwg) return false;
        int wgid = (int)L; { const int q = nwg / NXCD, r = nwg % NXCD, xcd = wgid % NXCD, off = wgid / NXCD; wgid = (xcd < r ? xcd * (q + 1) : r * (q + 1) + (xcd - r) * q) + off; }
        const int nig = WGM * nN, gid = wgid / nig, fm = gid * WGM, gsz = (nM - fm) < WGM ? (nM - fm) : WGM;
        u.pm = fm + ((wgid % nig) % gsz); u.pn = (wgid % nig) / gsz; return true;
    }
};
template <class P, class Epi>
__device__ __forceinline__ void gemm_phase(LAS unsigned char* lds, const P& pr, const Order& S, const Epi& E) {
    const int tid = threadIdx.x, wid = __builtin_amdgcn_readfirstlane(tid >> 6), lane = tid & 63, wr = wid >> 2, wc = wid & 3, fr = lane & 15, fq = lane >> 4;
    const int nt = pr.K / BK;
    int RA[2], CA[2]; unsigned voffB[2];
#pragma unroll
    for (int i = 0; i < 2; ++i) { int R, C; stage_rc(tid * 16 + i * 8192, R, C); RA[i] = R; CA[i] = C; const int Rb = Epi::PERM ? ((R & ~31) + perm32(R & 31)) : R; voffB[i] = (unsigned)(Rb * pr.ldb + C) * 2u; }
    const size_t kstep = (size_t)(BK * 2);
    const size_t hstepB = (size_t)HALF * pr.ldb * 2;
    const unsigned ldsw = (unsigned)wid * 1024u;
    const int aoff = lds_byte(wr * 64 + fr, fq * 8), boff = lds_byte(wc * 32 + fr, fq * 8);
#define PG8_SA(b, h) (((b) * 2 + (h)) * HTB)
#define PG8_SB(b, h) ((4 + (b) * 2 + (h)) * HTB)
#define PG8_STAGE(bufoff, gbase, voff) do { _Pragma("unroll") for (int _i = 0; _i < 2; ++_i) \
        __builtin_amdgcn_global_load_lds((const unsigned*)((const char*)(gbase) + (voff)[_i]), (LAS unsigned*)(lds + (bufoff) + ldsw + _i * 8192), 16, 0, 0); } while (0)
#define PG8_LDA(dst, b, h) do { _Pragma("unroll") for (int m = 0; m < 4; ++m) _Pragma("unroll") for (int k = 0; k < 2; ++k) dst[m][k] = *(const LAS bf16x8*)(lds + PG8_SA(b, h) + aoff + m * 2048 + k * 1024); } while (0)
#define PG8_LDB(dst, b, h) do { _Pragma("unroll") for (int n = 0; n < 2; ++n) _Pragma("unroll") for (int k = 0; k < 2; ++k) dst[n][k] = *(const LAS bf16x8*)(lds + PG8_SB(b, h) + boff + n * 2048 + k * 1024); } while (0)
#define PG8_MMA(ai, bj, At, Bt) do { __builtin_amdgcn_s_setprio(1); _Pragma("unroll") for (int m = 0; m < 4; ++m) _Pragma("unroll") for (int n = 0; n < 2; ++n) _Pragma("unroll") for (int k = 0; k < 2; ++k) \
        acc[ai][bj][m][n] = __builtin_amdgcn_mfma_f32_16x16x32_bf16(Bt[n][k], At[m][k], acc[ai][bj][m][n], 0, 0, 0); __builtin_amdgcn_s_setprio(0); } while (0)
#define PG8_WAIT_V(n) asm volatile("s_waitcnt vmcnt(" #n ")" ::: "memory")
#define PG8_WAIT_L(n) asm volatile("s_waitcnt lgkmcnt(" #n ")" ::: "memory")
#define PG8_BAR __builtin_amdgcn_s_barrier()
#define PG8_SCHED __builtin_amdgcn_sched_barrier(0)
    Unit cur, nxt; int ui = 0;
    if (!S.next(0, cur)) return;
    f32x4 acc[2][2][4][2];
#pragma unroll
    for (int a = 0; a < 2; ++a)
#pragma unroll
        for (int b = 0; b < 2; ++b)
#pragma unroll
            for (int m = 0; m < 4; ++m)
#pragma unroll
                for (int n = 0; n < 2; ++n) acc[a][b][m][n] = (f32x4){0.f, 0.f, 0.f, 0.f};
    bf16x8 At[4][2], B0[2][2], B1[2][2];
    unsigned vA[2][2], vN[2][2];
    pr.avoff(cur, RA, CA, vA);
#pragma unroll
    for (int h = 0; h < 2; ++h)
#pragma unroll
        for (int i = 0; i < 2; ++i) vN[h][i] = vA[h][i];
    const char* cA = pr.abase(cur); const char* cB = pr.bbase(cur);
    PG8_STAGE(PG8_SB(0, 0), cB, voffB); PG8_STAGE(PG8_SA(0, 0), cA, vA[0]); PG8_STAGE(PG8_SB(0, 1), cB + hstepB, voffB); PG8_STAGE(PG8_SA(0, 1), cA, vA[1]);
    if (wr == 1) PG8_BAR;
    PG8_WAIT_V(4); PG8_BAR;
    PG8_STAGE(PG8_SB(1, 0), cB + kstep, voffB); PG8_STAGE(PG8_SA(1, 0), cA + kstep, vA[0]); PG8_STAGE(PG8_SB(1, 1), cB + hstepB + kstep, voffB);
    PG8_WAIT_V(6); PG8_BAR;
    for (;;) {
        const bool has_next = S.next(ui + 1, nxt);
        const char* nA = has_next ? pr.abase(nxt) : cA; const char* nB = has_next ? pr.bbase(nxt) : cB;
        if (P::GATHER) { if (has_next) pr.avoff(nxt, RA, CA, vN); }
        for (int t = 0; t < nt; t += 2) {
            const bool last = (t == nt - 2);
            const char* a1 = cA + (size_t)(t + 1) * kstep;
            const char* a2 = last ? nA : cA + (size_t)(t + 2) * kstep; const char* b2 = last ? nB : cB + (size_t)(t + 2) * kstep;
            const char* a3 = a2 + kstep; const char* b3 = b2 + kstep;
            unsigned v2[2][2];
#pragma unroll
            for (int h = 0; h < 2; ++h)
#pragma unroll
                for (int i = 0; i < 2; ++i) v2[h][i] = (P::GATHER && last) ? vN[h][i] : vA[h][i];
            PG8_LDB(B0, 0, 0); PG8_SCHED; PG8_LDA(At, 0, 0); PG8_STAGE(PG8_SA(1, 1), a1, vA[1]);
            PG8_WAIT_L(8); PG8_BAR; PG8_WAIT_L(0); PG8_MMA(0, 0, At, B0); PG8_BAR; PG8_SCHED;
            PG8_LDB(B1, 0, 1); PG8_STAGE(PG8_SB(0, 0), b2, voffB);
            PG8_BAR; PG8_WAIT_L(0); PG8_MMA(0, 1, At, B1); PG8_BAR;
            PG8_LDA(At, 0, 1); PG8_STAGE(PG8_SA(0, 0), a2, v2[0]);
            PG8_BAR; PG8_WAIT_L(0); PG8_MMA(1, 0, At, B0); PG8_BAR; PG8_SCHED;
            PG8_STAGE(PG8_SB(0, 1), b2 + hstepB, voffB);
            PG8_WAIT_V(6); PG8_BAR; PG8_MMA(1, 1, At, B1); PG8_BAR;
            PG8_LDB(B0, 1, 0); PG8_SCHED; PG8_LDA(At, 1, 0); PG8_STAGE(PG8_SA(0, 1), a2, v2[1]);
            PG8_WAIT_L(8); PG8_BAR; PG8_WAIT_L(0); PG8_MMA(0, 0, At, B0); PG8_BAR; PG8_SCHED;
            PG8_LDB(B1, 1, 1); PG8_STAGE(PG8_SB(1, 0), b3, voffB);
            PG8_BAR; PG8_WAIT_L(0); PG8_MMA(0, 1, At, B1); PG8_BAR;
            PG8_LDA(At, 1, 1); PG8_STAGE(PG8_SA(1, 0), a3, v2[0]);
            PG8_BAR; PG8_WAIT_L(0); PG8_MMA(1, 0, At, B0); PG8_BAR; PG8_SCHED;
            PG8_STAGE(PG8_SB(1, 1), b3 + hstepB, voffB);
            PG8_WAIT_V(6); PG8_BAR; PG8_MMA(1, 1, At, B1); PG8_BAR;
            if (P::GATHER && last) {
#pragma unroll
                for (int h = 0; h < 2; ++h)
#pragma unroll
                    for (int i = 0; i < 2; ++i) vA[h][i] = vN[h][i];
            }
        }
        E(acc, cur, wr, wc, fr, fq);
        if (!has_next) break;
#pragma unroll
        for (int a = 0; a < 2; ++a)
#pragma unroll
            for (int b = 0; b < 2; ++b)
#pragma unroll
                for (int m = 0; m < 4; ++m)
#pragma unroll
                    for (int n = 0; n < 2; ++n) acc[a][b][m][n] = (f32x4){0.f, 0.f, 0.f, 0.f};
        cur = nxt; cA = nA; cB = nB; ++ui;
    }
    PG8_WAIT_V(0);
    if (wr == 0) PG8_BAR;
    PG8_BAR;
#undef PG8_SA
#undef PG8_SB
#undef PG8_STAGE
#undef PG8_LDA
#undef PG8_LDB
#undef PG8_MMA
#undef PG8_WAIT_V
#undef PG8_WAIT_L
#undef PG8_BAR
#undef PG8_SCHED
}
}
using pg8::Unit;

struct ProbPlain {
    static constexpr bool GATHER = false;
    const bf16_t* A; const bf16_t* B; int K, lda, ldb;
    __device__ __forceinline__ const char* abase(const Unit& u) const { return (const char*)(A + (size_t)u.pm * 256 * lda); }
    __device__ __forceinline__ const char* bbase(const Unit& u) const { return (const char*)(B + (size_t)u.pn * 256 * ldb); }
    __device__ __forceinline__ void avoff(const Unit&, const int (&RA)[2], const int (&CA)[2], unsigned (&v)[2][2]) const {
#pragma unroll
        for (int h = 0; h < 2; ++h)
#pragma unroll
            for (int i = 0; i < 2; ++i) v[h][i] = (unsigned)((h * 128 + RA[i]) * lda + CA[i]) * 2u;
    }
};
struct ProbMoeUp {
    static constexpr bool GATHER = true;
    const bf16_t* A; const bf16_t* B; const int* idx; int K, lda, ldb;
    __device__ __forceinline__ const char* abase(const Unit&) const { return (const char*)A; }
    __device__ __forceinline__ const char* bbase(const Unit& u) const { return (const char*)(B + ((size_t)(u.pm >> 4) * 3072 + (size_t)u.pn * 256) * ldb); }
    __device__ __forceinline__ void avoff(const Unit& u, const int (&RA)[2], const int (&CA)[2], unsigned (&v)[2][2]) const {
#pragma unroll
        for (int h = 0; h < 2; ++h)
#pragma unroll
            for (int i = 0; i < 2; ++i) { const int g = idx[u.pm * 256 + h * 128 + RA[i]]; v[h][i] = (unsigned)(g * lda + CA[i]) * 2u; }
    }
};
struct ProbMoeDown {
    static constexpr bool GATHER = false;
    const bf16_t* A; const bf16_t* B; int K, lda, ldb;
    __device__ __forceinline__ const char* abase(const Unit& u) const { return (const char*)(A + (size_t)u.pm * 256 * lda); }
    __device__ __forceinline__ const char* bbase(const Unit& u) const { return (const char*)(B + ((size_t)(u.pm >> 4) * 1024 + (size_t)u.pn * 256) * ldb); }
    __device__ __forceinline__ void avoff(const Unit&, const int (&RA)[2], const int (&CA)[2], unsigned (&v)[2][2]) const {
#pragma unroll
        for (int h = 0; h < 2; ++h)
#pragma unroll
            for (int i = 0; i < 2; ++i) v[h][i] = (unsigned)((h * 128 + RA[i]) * lda + CA[i]) * 2u;
    }
};

#define EPI_ROWS(...) _Pragma("unroll") for (int ai = 0; ai < 2; ++ai) _Pragma("unroll") for (int m = 0; m < 4; ++m) { const int row = u.pm * 256 + ai * 128 + wr * 64 + m * 16 + fr; __VA_ARGS__ }
__device__ __forceinline__ u32x4 pack8(const f32x4 v0, const f32x4 v1) { u32x4 w; w.x = cvt_pk_bf16(v0[0], v0[1]); w.y = cvt_pk_bf16(v0[2], v0[3]); w.z = cvt_pk_bf16(v1[0], v1[1]); w.w = cvt_pk_bf16(v1[2], v1[3]); return w; }

struct EpiPQ {
    static constexpr bool PERM = true; bf16_t* O;
    __device__ __forceinline__ void operator()(const f32x4 (&acc)[2][2][4][2], const Unit& u, int wr, int wc, int fr, int fq) const {
        const int tg0 = u.pn * 256 + wc * 32 + 8 * fq, b = tg0 >> 12;
        EPI_ROWS(
            bf16_t* rp = O + ((size_t)(b * 1024 + row) * 4096 + (tg0 & 4095));
            _Pragma("unroll") for (int bj = 0; bj < 2; ++bj) *(u32x4*)(rp + bj * 128) = pack8(acc[ai][bj][m][0], acc[ai][bj][m][1]);
        )
    }
};
struct EpiZ {
    static constexpr bool PERM = true; bf16_t* O; int ldc; int fixed_act;
    __device__ __forceinline__ void operator()(const f32x4 (&acc)[2][2][4][2], const Unit& u, int wr, int wc, int fr, int fq) const {
        const int col0 = u.pn * 256 + wc * 32 + 8 * fq; const int act = fixed_act >= 0 ? fixed_act : (u.pn >> 2);
        EPI_ROWS(
            bf16_t* rp = O + (size_t)row * ldc + col0;
            _Pragma("unroll") for (int bj = 0; bj < 2; ++bj) {
                f32x4 v0 = acc[ai][bj][m][0], v1 = acc[ai][bj][m][1];
                if (act == 1) { _Pragma("unroll") for (int j = 0; j < 4; ++j) { v0[j] = gelu_tanh(v0[j]); v1[j] = gelu_tanh(v1[j]); } }
                else if (act >= 2) { _Pragma("unroll") for (int j = 0; j < 4; ++j) { v0[j] = sigmoidf_(v0[j]); v1[j] = sigmoidf_(v1[j]); } }
                *(u32x4*)(rp + bj * 128) = pack8(v0, v1); }
        )
    }
};
struct EpiF {
    static constexpr bool PERM = true; bf16_t* O;
    __device__ __forceinline__ void operator()(const f32x4 (&acc)[2][2][4][2], const Unit& u, int wr, int wc, int fr, int fq) const {
        const int b = u.pn >> 1, ch0 = (u.pn & 1) * 256 + wc * 32 + 8 * fq;
        EPI_ROWS(
            bf16_t* rp = O + ((size_t)(b * 4096 + row) * 512 + ch0);
            _Pragma("unroll") for (int bj = 0; bj < 2; ++bj) *(u32x4*)(rp + bj * 128) = pack8(acc[ai][bj][m][0], acc[ai][bj][m][1]);
        )
    }
};
struct EpiY1 {
    static constexpr bool PERM = true; bf16_t* O; const bf16_t* Z;
    __device__ __forceinline__ void operator()(const f32x4 (&acc)[2][2][4][2], const Unit& u, int wr, int wc, int fr, int fq) const {
        const int col0 = u.pn * 256 + wc * 32 + 8 * fq;
        EPI_ROWS(
            _Pragma("unroll") for (int bj = 0; bj < 2; ++bj) {
                const int col = col0 + bj * 128; float g[8]; unpack8(*(const u32x4*)(Z + (size_t)row * 4096 + 2048 + col), g);
                f32x4 v0 = acc[ai][bj][m][0], v1 = acc[ai][bj][m][1];
                _Pragma("unroll") for (int j = 0; j < 4; ++j) { v0[j] *= g[j]; v1[j] *= g[4 + j]; }
                *(u32x4*)(O + (size_t)row * 1024 + col) = pack8(v0, v1); }
        )
    }
};
struct EpiY2 {
    static constexpr bool PERM = true; bf16_t* O; const bf16_t* Z;
    __device__ __forceinline__ void operator()(const f32x4 (&acc)[2][2][4][2], const Unit& u, int wr, int wc, int fr, int fq) const {
        const int col0 = u.pn * 256 + wc * 32 + 8 * fq;
        EPI_ROWS(
            _Pragma("unroll") for (int bj = 0; bj < 2; ++bj) {
                const int col = col0 + bj * 128; float g[8], t1[8]; unpack8(*(const u32x4*)(Z + (size_t)row * 4096 + 3072 + col), g); unpack8(*(const u32x4*)(O + (size_t)row * 1024 + col), t1);
                f32x4 v0 = acc[ai][bj][m][0], v1 = acc[ai][bj][m][1];
                _Pragma("unroll") for (int j = 0; j < 4; ++j) { v0[j] = t1[j] + v0[j] * g[j]; v1[j] = t1[4 + j] + v1[j] * g[4 + j]; }
                *(u32x4*)(O + (size_t)row * 1024 + col) = pack8(v0, v1); }
        )
    }
};
struct EpiOut {
    static constexpr bool PERM = false; float* O; const float* X; const float* pos; const float* ada;
    __device__ __forceinline__ void operator()(const f32x4 (&acc)[2][2][4][2], const Unit& u, int wr, int wc, int fr, int fq) const {
        const int col0 = u.pn * 256 + wc * 32 + 4 * fq; const int b = u.pm >> 4;
        EPI_ROWS(
            const int t = row & 4095;
            _Pragma("unroll") for (int bj = 0; bj < 2; ++bj) _Pragma("unroll") for (int n = 0; n < 2; ++n) {
                const int col = col0 + bj * 128 + n * 16;
                const f32x4 xv = *(const f32x4*)(X + (size_t)row * 1024 + col);
                const f32x4 pv = *(const f32x4*)(pos + (col < 512 ? (t >> 6) * 512 + col : (t & 63) * 512 + (col - 512)));
                const f32x4 gv = *(const f32x4*)(ada + b * 6144 + 2048 + col);
                *(f32x4*)(O + (size_t)row * 1024 + col) = xv + pv + gv * acc[ai][bj][m][n]; }
        )
    }
};
struct EpiGU {
    static constexpr bool PERM = true; bf16_t* O;
    __device__ __forceinline__ void operator()(const f32x4 (&acc)[2][2][4][2], const Unit& u, int wr, int wc, int fr, int fq) const {
        const int col0 = u.pn * 128 + wc * 32 + 8 * fq;
        EPI_ROWS(
            f32x4 v0, v1;
            _Pragma("unroll") for (int j = 0; j < 4; ++j) { const float g0 = acc[ai][0][m][0][j], g1 = acc[ai][0][m][1][j];
                v0[j] = g0 * sigmoidf_(g0) * acc[ai][1][m][0][j]; v1[j] = g1 * sigmoidf_(g1) * acc[ai][1][m][1][j]; }
            *(u32x4*)(O + (size_t)row * DE + col0) = pack8(v0, v1);
        )
    }
};
struct EpiDown {
    static constexpr bool PERM = true; bf16_t* O; const float* gate;
    __device__ __forceinline__ void operator()(const f32x4 (&acc)[2][2][4][2], const Unit& u, int wr, int wc, int fr, int fq) const {
        const int col0 = u.pn * 256 + wc * 32 + 8 * fq;
        EPI_ROWS(
            const float g = gate[row];
            _Pragma("unroll") for (int bj = 0; bj < 2; ++bj) *(u32x4*)(O + (size_t)row * 1024 + col0 + bj * 128) = pack8(acc[ai][bj][m][0] * g, acc[ai][bj][m][1] * g);
        )
    }
};

__device__ void p0_ada(const Params& p, LAS unsigned char* lds, int item) {
    const int tid = threadIdx.x;
    LAS float* s = (LAS float*)lds; LAS float* red = s + 9 * 1024;
    for (int i = tid; i < 9 * 1024; i += NTHR) { const int r = i >> 10, d = i & 1023; const float v = r < 8 ? p.c[r * 1024 + d] : p.c_ctx[d]; s[i] = v / (1.0f + expf(-v)); }
    __syncthreads();
    const int col = tid & 63, ds = tid >> 6; float a[9];
#pragma unroll
    for (int r = 0; r < 9; ++r) a[r] = 0.f;
    const float* w = p.w_ada + (size_t)(ds * 128) * 6144 + item * 64 + col;
    for (int d = 0; d < 128; ++d) { const float wv = w[(size_t)d * 6144];
#pragma unroll
        for (int r = 0; r < 9; ++r) a[r] += s[r * 1024 + ds * 128 + d] * wv; }
#pragma unroll
    for (int r = 0; r < 9; ++r) red[(ds * 9 + r) * 64 + col] = a[r];
    __syncthreads();
    float* ada = (float*)(p.ws + WS_ADA);
    for (int i = tid; i < 9 * 64; i += NTHR) { const int r = i >> 6, cc = i & 63; float v = 0.f;
#pragma unroll
        for (int k = 0; k < 8; ++k) v += red[(k * 9 + r) * 64 + cc];
        ada[r * 6144 + item * 64 + cc] = v + p.b_ada[item * 64 + cc]; }
    __syncthreads();
}
template <int NS>
__device__ __forceinline__ void xpose_item(const float* src, int ldsrc, bf16_t* dst, int lddst, int k0, int n0, int mode) {
    const int tid = threadIdx.x, nl = tid & 63, k8 = tid >> 6;
    float v[NS][8];
#pragma unroll
    for (int s = 0; s < NS; ++s)
#pragma unroll
        for (int j = 0; j < 8; ++j) v[s][j] = src[(size_t)(k0 + 8 * k8 + j) * ldsrc + n0 + 64 * s + nl];
#pragma unroll
    for (int s = 0; s < NS; ++s) { const int n = n0 + 64 * s + nl; int row = n;
        if (mode) row = (n >> 7) * 256 + (n & 127) + (mode == 2 ? 128 : 0);
        u32x4 w; w.x = cvt_pk_bf16(v[s][0], v[s][1]); w.y = cvt_pk_bf16(v[s][2], v[s][3]); w.z = cvt_pk_bf16(v[s][4], v[s][5]); w.w = cvt_pk_bf16(v[s][6], v[s][7]);
        *(u32x4*)(dst + (size_t)row * lddst + k0 + 8 * k8) = w; }
}
__device__ void p0_wpq(const Params& p, LAS unsigned char* lds, int item) {
    const int tid = threadIdx.x, g = item >> 4, db = item & 15;
    LAS float* wl = (LAS float*)lds; LAS float* ct = wl + 64 * 129;
    for (int i = tid; i < 64 * 128; i += NTHR) { const int d = i >> 7, cc = i & 127; wl[d * 129 + cc] = p.w_in[(size_t)(db * 64 + d) * 4608 + g * 128 + cc]; }
    if (tid < 128) { float sn, cs; sincospif((float)tid * (1.0f / 64.0f), &sn, &cs); ct[tid] = cs; ct[128 + tid] = sn; }
    __syncthreads();
    const int q = tid & 255, kc = q >> 1, pq = q & 1, dh = tid >> 8; const int n = (g * 128 + kc) * 2 + pq;
    bf16_t* dst = (bf16_t*)(p.ws + WS_WPQ) + (size_t)n * 1024 + db * 64 + dh * 32;
    const float scale = 0.001381067932f;
    for (int d8 = 0; d8 < 4; ++d8) { float a[8];
#pragma unroll
        for (int j = 0; j < 8; ++j) a[j] = 0.f;
        for (int cc = 0; cc < 128; ++cc) { const float tv = ct[pq * 128 + ((cc * kc) & 127)];
#pragma unroll
            for (int j = 0; j < 8; ++j) a[j] += wl[(dh * 32 + d8 * 8 + j) * 129 + cc] * tv; }
        u32x4 w; w.x = cvt_pk_bf16(a[0] * scale, a[1] * scale); w.y = cvt_pk_bf16(a[2] * scale, a[3] * scale); w.z = cvt_pk_bf16(a[4] * scale, a[5] * scale); w.w = cvt_pk_bf16(a[6] * scale, a[7] * scale);
        *(u32x4*)(dst + d8 * 8) = w; }
    __syncthreads();
}
__device__ void p0_dft_row(const Params& p, int tp) {
    bf16_t* dst = (bf16_t*)((unsigned char*)p.out + OUT_DFT) + (size_t)tp * 8192;
#pragma unroll
    for (int ps = 0; ps < 2; ++ps) { const int k8 = (ps * NTHR + threadIdx.x) * 8; const bool hi = k8 >= 4096; const int t0 = k8 & 4095; float v[8];
#pragma unroll
        for (int j = 0; j < 8; ++j) { const int mm = (tp * (t0 + j)) & 4095; float sn, cs; sincospif((float)mm * (1.0f / 2048.0f), &sn, &cs); v[j] = hi ? -sn : cs; }
        u32x4 w; w.x = cvt_pk_bf16(v[0], v[1]); w.y = cvt_pk_bf16(v[2], v[3]); w.z = cvt_pk_bf16(v[4], v[5]); w.w = cvt_pk_bf16(v[6], v[7]);
        *(u32x4*)(dst + k8) = w; }
}
__device__ void p0_pos(const Params& p) {
    float* tab = (float*)(p.ws + WS_POS);
    for (int i = threadIdx.x; i < 64 * 512; i += NTHR) { const int ii = i >> 9, j = i & 511, jj = j & 255; const float f = expf(-9.210340371976184f * (float)jj / 256.0f); const float a = (float)ii * f; tab[i] = j < 256 ? sinf(a) : cosf(a); }
}
__device__ void phase0(const Params& p, LAS unsigned char* lds) {
    constexpr int N_ADA = 96, N_WIN = 16 * 16, N_WFOUR = 8 * 4, N_SQ = 16 * 4, N_LRU = 16 * 2, N_WPQ = 64, N_DFT = 4096, N_POS = 1;
    constexpr int O1 = N_ADA, O2 = O1 + N_WIN, O3 = O2 + N_WFOUR, O4 = O3 + N_SQ, O5 = O4 + N_SQ, O6 = O5 + N_LRU, O7 = O6 + N_LRU, O8 = O7 + N_WPQ, O9 = O8 + N_DFT, O10 = O9 + N_POS;
    for (int it = blockIdx.x; it < O10; it += gridDim.x) {
        if (it < O1) p0_ada(p, lds, it);
        else if (it < O2) { const int j = it - O1; xpose_item<4>(p.w_in + 512, 4608, (bf16_t*)(p.ws + WS_WIN), 1024, (j >> 4) * 64, (j & 15) * 256, 0); }
        else if (it < O3) { const int j = it - O2; xpose_item<4>(p.w_four, 1024, (bf16_t*)(p.ws + WS_WFOUR), 512, (j >> 2) * 64, (j & 3) * 256, 0); }
        else if (it < O4) { const int j = it - O3; xpose_item<4>(p.w_lru, 1024, (bf16_t*)(p.ws + WS_WLRU), 1024, (j >> 2) * 64, (j & 3) * 256, 0); }
        else if (it < O5) { const int j = it - O4; xpose_item<4>(p.w_out, 1024, (bf16_t*)(p.ws + WS_WOUT), 1024, (j >> 2) * 64, (j & 3) * 256, 0); }
        else if (it < O6) { const int j = it - O5, mtx = j >> 1; xpose_item<2>(p.lru_wa + (size_t)mtx * 16384, 128, (bf16_t*)(p.ws + WS_WAT) + (size_t)mtx * 16384, 128, (j & 1) * 64, 0, 0); }
        else if (it < O7) { const int j = it - O6, mtx = j >> 1; xpose_item<2>(p.lru_wi + (size_t)mtx * 16384, 128, (bf16_t*)(p.ws + WS_WIT) + (size_t)mtx * 16384, 128, (j & 1) * 64, 0, 0); }
        else if (it < O8) p0_wpq(p, lds, it - O7);
        else if (it < O9) p0_dft_row(p, it - O8);
        else p0_pos(p);
    }
}

__device__ void phase1(const Params& p) {
    const int lane = threadIdx.x & 63, wid = threadIdx.x >> 6;
    const float* ada = (const float*)(p.ws + WS_ADA); const float* tab = (const float*)(p.ws + WS_POS);
    bf16_t* h1 = (bf16_t*)(p.ws + WS_R1); bf16_t* hc = (bf16_t*)(p.ws + WS_HCTX);
    for (int row = blockIdx.x * 8 + wid; row < MLAT + MCTX; row += gridDim.x * 8) {
        const bool lat = row < MLAT; const int rc = row - MLAT; const int t = row & 4095; const int mrow = lat ? (row >> 12) : 8;
        const float* xr = lat ? p.x + (size_t)row * 1024 : p.ctx + (size_t)rc * 1024;
        f32x4 v[4]; float ss = 0.f;
#pragma unroll
        for (int i = 0; i < 4; ++i) { const int d = 256 * i + 4 * lane; v[i] = *(const f32x4*)(xr + d);
            if (lat) v[i] += *(const f32x4*)(tab + (i < 2 ? (t >> 6) * 512 + d : (t & 63) * 512 + d - 512));
            ss += v[i][0] * v[i][0] + v[i][1] * v[i][1] + v[i][2] * v[i][2] + v[i][3] * v[i][3]; }
        ss = wave_sum(ss); const float rs = rsqrtf(ss * (1.0f / 1024.0f) + 1e-6f);
        bf16_t* dst = lat ? h1 + (size_t)row * 1024 : hc + (size_t)rc * 1024;
#pragma unroll
        for (int i = 0; i < 4; ++i) { const int d = 256 * i + 4 * lane;
            const f32x4 g = *(const f32x4*)(p.norm1_g + d), sh = *(const f32x4*)(ada + mrow * 6144 + d), sc = *(const f32x4*)(ada + mrow * 6144 + 1024 + d);
            const f32x4 h = v[i] * rs * g * (sc + 1.0f) + sh;
            u32x2 w; w.x = cvt_pk_bf16(h[0], h[1]); w.y = cvt_pk_bf16(h[2], h[3]); *(u32x2*)(dst + d) = w; }
    }
}

#define LRU_CST(mb, r) (32 * (mb) + 8 * ((r) >> 2) + ((r) & 3))
template <bool FINAL, int DIR>
__device__ __forceinline__ void lru_wave(const Params& p, LAS unsigned char* ul, int b, int sc, int head, int cb, int lane, f32x16 (&accI)[4]) {
    constexpr int SG = DIR ? -1 : 1;
    const int lr = lane & 31, lh = lane >> 5;
    const int chl = cb * 32 + lr, ch = head * 128 + chl;
    const int tbase = DIR ? 127 - 4 * lh : 4 * lh;
    f32x16 accA[4];
#pragma unroll
    for (int mb = 0; mb < 4; ++mb)
#pragma unroll
        for (int r = 0; r < 16; ++r) { accA[mb][r] = 0.f; accI[mb][r] = 0.f; }
    {
        const bf16_t* wa = (const bf16_t*)(p.ws + WS_WAT) + ((size_t)(DIR * 8 + head) * 128 + chl) * 128 + 8 * lh;
        const bf16_t* wi = (const bf16_t*)(p.ws + WS_WIT) + ((size_t)(DIR * 8 + head) * 128 + chl) * 128 + 8 * lh;
        LAS unsigned char* arow0 = ul + (DIR ? 127 - lr : lr) * 272 + lh * 16;
#pragma unroll
        for (int kc = 0; kc < 2; ++kc) { bf16x8 bA[4], bI[4];
#pragma unroll
            for (int k4 = 0; k4 < 4; ++k4) { bA[k4] = *(const bf16x8*)(wa + 16 * (kc * 4 + k4)); bI[k4] = *(const bf16x8*)(wi + 16 * (kc * 4 + k4)); }
#pragma unroll
            for (int mb = 0; mb < 4; ++mb)
#pragma unroll
                for (int k4 = 0; k4 < 4; ++k4) { const bf16x8 af = *(const LAS bf16x8*)(arow0 + SG * 32 * mb * 272 + 32 * (kc * 4 + k4));
                    accA[mb] = __builtin_amdgcn_mfma_f32_32x32x16_bf16(af, bA[k4], accA[mb], 0, 0, 0);
                    accI[mb] = __builtin_amdgcn_mfma_f32_32x32x16_bf16(af, bI[k4], accI[mb], 0, 0, 0); }
            __builtin_amdgcn_sched_barrier(0); }
    }
    {
        const float lam = p.lru_lambda[DIR * 1024 + ch]; const float sp8 = 8.0f * log1pf(expf(-lam));
        const float ba = p.lru_ba[DIR * 1024 + ch], bi = p.lru_bi[DIR * 1024 + ch];
        LAS unsigned char* up = ul + tbase * 272 + chl * 2;
#pragma unroll
        for (int mb = 0; mb < 4; ++mb) {
#pragma unroll
            for (int r = 0; r < 16; ++r) {
                const float uv = bf2f(*(const LAS bf16_t*)(up + SG * LRU_CST(mb, r) * 272));
                const float rg = sigmoidf_(accA[mb][r] + ba), ig = sigmoidf_(accI[mb][r] + bi);
                const float a = __expf(-sp8 * rg); accA[mb][r] = a; accI[mb][r] = sqrtf(fmaxf(1.0f - a * a, 0.f)) * ig * uv; }
            __builtin_amdgcn_sched_barrier(0); }
    }
    float rA[16], rH[16];
#pragma unroll
    for (int mb = 0; mb < 4; ++mb)
#pragma unroll
        for (int q = 0; q < 4; ++q) { float pa = 1.f, hh = 0.f;
#pragma unroll
            for (int j = 0; j < 4; ++j) { const int r = 4 * q + j; const float a = accA[mb][r], bb = accI[mb][r]; hh = a * hh + bb; pa *= a; accA[mb][r] = pa; accI[mb][r] = hh; }
            rA[mb * 4 + q] = pa; rH[mb * 4 + q] = hh; }
    const int agg_dir_off = ((b * NSEQ) * 2 + DIR) * 1024 + ch;
    const float* agg = (const float*)(p.ws + WS_AGG);
    float carry = 0.f;
    if (FINAL) {
        if (DIR == 0) { for (int q = 0; q < sc; ++q) { const float* a2 = agg + (size_t)(agg_dir_off + q * 2048) * 2; carry = a2[0] * carry + a2[1]; } }
        else { { const float* a2 = agg + (size_t)(agg_dir_off + 1 * 2048) * 2; carry = a2[0] * carry + a2[1]; } { const float* a2 = agg + (size_t)(agg_dir_off + 0 * 2048) * 2; carry = a2[0] * carry + a2[1]; }
            for (int q = NSEQ - 1; q > sc; --q) { const float* a2 = agg + (size_t)(agg_dir_off + q * 2048) * 2; carry = a2[0] * carry + a2[1]; } }
    }
    float cin[16];
#pragma unroll
    for (int i = 0; i < 16; ++i) cin[i] = 0.f;
    float s = carry, At = 1.f;
#pragma unroll
    for (int i = 0; i < 16; ++i) { const float oA = __shfl_xor(rA[i], 32), oH = __shfl_xor(rH[i], 32);
        { const bool mine = (lh == 0); const float a = mine ? rA[i] : oA, hh = mine ? rH[i] : oH; cin[i] = mine ? s : cin[i]; s = a * s + hh; At *= a; }
        { const bool mine = (lh == 1); const float a = mine ? rA[i] : oA, hh = mine ? rH[i] : oH; cin[i] = mine ? s : cin[i]; s = a * s + hh; At *= a; } }
    if (!FINAL) {
        if (lh == 0) { float* o = (float*)(p.ws + WS_AGG) + (size_t)(agg_dir_off + sc * 2048) * 2; o[0] = At; o[1] = s; }
        return;
    }
#pragma unroll
    for (int mb = 0; mb < 4; ++mb)
#pragma unroll
        for (int r = 0; r < 16; ++r) accI[mb][r] += accA[mb][r] * cin[mb * 4 + (r >> 2)];
}
template <bool FINAL>
__device__ void lru_tile(const Params& p, LAS unsigned char* lds, int item) {
    const int tid = threadIdx.x, lane = tid & 63, wid = __builtin_amdgcn_readfirstlane(tid >> 6);
    int b, sc, head;
    if (FINAL) { head = item & 7; sc = 2 + ((item >> 3) & 31); b = item >> 8; }
    else { head = item & 7; const int r = item >> 3; sc = r % NSEQ; b = r / NSEQ; }
    const bf16_t* src; int Tseq, t0, ld;
    if (sc < 2) { src = (const bf16_t*)(p.ws + WS_ZXC) + (size_t)b * 256 * 1024; Tseq = 256; t0 = sc * 128; ld = 1024; }
    else { src = (const bf16_t*)(p.ws + WS_RZ) + (size_t)b * 4096 * 4096; Tseq = 4096; t0 = (sc - 2) * 128; ld = 4096; }
    LAS unsigned char* ul = lds;
    LAS float* ybuf = (LAS float*)(lds + 36 * 1024);
    {
        const int c8 = tid & 15, tb = tid >> 4; const int ch0 = head * 128 + 8 * c8;
        float w[4][8], bias[8];
#pragma unroll
        for (int k = 0; k < 4; ++k) { const f32x4 a = *(const f32x4*)(p.conv_w + k * 1024 + ch0), c2 = *(const f32x4*)(p.conv_w + k * 1024 + ch0 + 4);
#pragma unroll
            for (int j = 0; j < 4; ++j) { w[k][j] = a[j]; w[k][4 + j] = c2[j]; } }
        { const f32x4 a = *(const f32x4*)(p.conv_b + ch0), c2 = *(const f32x4*)(p.conv_b + ch0 + 4);
#pragma unroll
            for (int j = 0; j < 4; ++j) { bias[j] = a[j]; bias[4 + j] = c2[j]; } }
#pragma unroll
        for (int i = 0; i < 4; ++i) { const int t = tb + 32 * i; float a[8];
#pragma unroll
            for (int j = 0; j < 8; ++j) a[j] = bias[j];
#pragma unroll
            for (int k = 0; k < 4; ++k) { const int tt = t0 + t + k - 2;
                if (tt >= 0 && tt < Tseq) { float f[8]; unpack8(*(const u32x4*)(src + (size_t)tt * ld + ch0), f);
#pragma unroll
                    for (int j = 0; j < 8; ++j) a[j] += w[k][j] * f[j]; } }
            u32x4 wv; wv.x = cvt_pk_bf16(a[0], a[1]); wv.y = cvt_pk_bf16(a[2], a[3]); wv.z = cvt_pk_bf16(a[4], a[5]); wv.w = cvt_pk_bf16(a[6], a[7]);
            *(LAS u32x4*)(ul + t * 272 + c8 * 16) = wv; }
    }
    __syncthreads();
    f32x16 hacc[4];
    if (wid < 4) lru_wave<FINAL, 0>(p, ul, b, sc, head, wid & 3, lane, hacc);
    else lru_wave<FINAL, 1>(p, ul, b, sc, head, wid & 3, lane, hacc);
    if (FINAL) {
        const int lr = lane & 31, lh = lane >> 5, chl = (wid & 3) * 32 + lr;
        if (wid >= 4) { LAS float* yp = ybuf + (127 - 4 * lh) * 129 + chl;
#pragma unroll
            for (int mb = 0; mb < 4; ++mb)
#pragma unroll
                for (int r = 0; r < 16; ++r) yp[-LRU_CST(mb, r) * 129] = hacc[mb][r]; }
        __syncthreads();
        if (wid < 4) {
            const LAS float* yp = ybuf + (4 * lh) * 129 + chl;
            const bf16_t* Zu = (const bf16_t*)(p.ws + WS_RZ) + ((size_t)(b * 4096 + t0) * 4096 + 1024 + head * 128);
            bf16_t* Ou = (bf16_t*)(p.ws + WS_R1) + ((size_t)(b * 4096 + t0) * 1024 + head * 128);
            const unsigned zo = (unsigned)(4 * lh * 4096 + chl), oo = (unsigned)(4 * lh * 1024 + chl);
#pragma unroll
            for (int mb = 0; mb < 4; ++mb) {
#pragma unroll
                for (int r = 0; r < 16; ++r) {
                    const float y = hacc[mb][r] + yp[LRU_CST(mb, r) * 129];
                    const float gz = bf2f(Zu[zo + LRU_CST(mb, r) * 4096]);
                    Ou[oo + LRU_CST(mb, r) * 1024] = (bf16_t)(cvt_pk_bf16(gz * y, 0.f) & 0xffffu);
                    if ((r & 7) == 7) __builtin_amdgcn_sched_barrier(0); } }
        }
    }
    __syncthreads();
}

__device__ void phase7_rows(const Params& p, LAS unsigned char* lds) {
    const int tid = threadIdx.x, lane = tid & 63, wid = tid >> 6;
    LAS float* wrt = (LAS float*)lds;
    for (int i = tid; i < 16 * 1024; i += NTHR) { const int d = i >> 4, e = i & 15; wrt[e * 1024 + d] = p.w_router[i]; }
    __syncthreads();
    const float* ada = (const float*)(p.ws + WS_ADA); bf16_t* h2 = (bf16_t*)(p.ws + WS_R1); float* scores = (float*)(p.ws + WS_SCORES);
    for (int row = blockIdx.x * 8 + wid; row < MLAT; row += gridDim.x * 8) {
        const int b = row >> 12, t = row & 4095; const float* xr = p.out + (size_t)row * 1024;
        f32x4 v[4]; float ss = 0.f;
#pragma unroll
        for (int i = 0; i < 4; ++i) { v[i] = *(const f32x4*)(xr + 256 * i + 4 * lane); ss += v[i][0] * v[i][0] + v[i][1] * v[i][1] + v[i][2] * v[i][2] + v[i][3] * v[i][3]; }
        ss = wave_sum(ss); const float rs = rsqrtf(ss * (1.0f / 1024.0f) + 1e-6f);
#pragma unroll
        for (int i = 0; i < 4; ++i) { const int d = 256 * i + 4 * lane;
            const f32x4 g = *(const f32x4*)(p.norm2_g + d), sh = *(const f32x4*)(ada + b * 6144 + 3072 + d), sc = *(const f32x4*)(ada + b * 6144 + 4096 + d);
            v[i] = v[i] * rs * g * (sc + 1.0f) + sh;
            u32x2 w; w.x = cvt_pk_bf16(v[i][0], v[i][1]); w.y = cvt_pk_bf16(v[i][2], v[i][3]); *(u32x2*)(h2 + (size_t)row * 1024 + d) = w; }
        float lg[16];
#pragma unroll
        for (int e = 0; e < 16; ++e) { float a = 0.f;
#pragma unroll
            for (int i = 0; i < 4; ++i) { const f32x4 w = *(const LAS f32x4*)(wrt + e * 1024 + 256 * i + 4 * lane); a += v[i][0] * w[0] + v[i][1] * w[1] + v[i][2] * w[2] + v[i][3] * w[3]; }
            lg[e] = wave_sum(a); }
        float mx = lg[0];
#pragma unroll
        for (int e = 1; e < 16; ++e) mx = fmaxf(mx, lg[e]);
        float sum = 0.f;
#pragma unroll
        for (int e = 0; e < 16; ++e) { lg[e] = expf(lg[e] - mx); sum += lg[e]; }
        const float inv = 1.0f / sum; float mine = 0.f;
#pragma unroll
        for (int e = 0; e < 16; ++e) mine = (lane == e) ? lg[e] * inv : mine;
        if (lane < 16) scores[((size_t)b * 16 + lane) * 4096 + t] = mine;
    }
    __syncthreads();
}
__device__ void phase7_weights(const Params& p) {
    constexpr int N_G = 16 * 16 * 6, N_D = 16 * 24 * 4;
    for (int it = blockIdx.x; it < 2 * N_G + N_D; it += gridDim.x) {
        if (it < 2 * N_G) { const int up = it >= N_G, j = up ? it - N_G : it, e = j / 96, r = j % 96, kb = r / 6, nb = r % 6;
            xpose_item<4>((up ? p.w_up_e : p.w_gate_e) + (size_t)e * 1024 * 1536, 1536, (bf16_t*)(p.ws + WS_WGU) + (size_t)e * 3072 * 1024, 1024, kb * 64, nb * 256, up ? 2 : 1); }
        else { const int j = it - 2 * N_G, e = j / 96, r = j % 96, kb = r >> 2, nb = r & 3;
            xpose_item<4>(p.w_down_e + (size_t)e * 1536 * 1024, 1024, (bf16_t*)(p.ws + WS_WD) + (size_t)e * 1024 * 1536, 1536, kb * 64, nb * 256, 0); }
    }
}

__device__ void phase8_topk(const Params& p, LAS unsigned char* lds) {
    const int tid = threadIdx.x, lane = tid & 63, wid = tid >> 6;
    LAS unsigned* cnt = (LAS unsigned*)lds;
    LAS unsigned* wsum = cnt + 16;
    const float* scores = (const float*)(p.ws + WS_SCORES);
    int* idx = (int*)(p.ws + WS_IDX); float* gate = (float*)(p.ws + WS_GATE); int* slot_of = (int*)(p.ws + WS_SLOT);
    for (int it = blockIdx.x; it < NB * NE; it += gridDim.x) {
        const int b = it >> 4, e = it & 15;
        unsigned key[8];
        { const u32x4* sp = (const u32x4*)(scores + (size_t)it * 4096 + tid * 8); const u32x4 a = sp[0], c2 = sp[1]; key[0] = a.x; key[1] = a.y; key[2] = a.z; key[3] = a.w; key[4] = c2.x; key[5] = c2.y; key[6] = c2.z; key[7] = c2.w; }
        unsigned thr = 0;
        for (int bit = 30; bit >= 0; --bit) {
            const unsigned cand = thr | (1u << bit); unsigned c = 0;
#pragma unroll
            for (int j = 0; j < 8; ++j) c += (unsigned)__popcll(__ballot(key[j] >= cand));
            LAS unsigned* cb = cnt + (bit & 1) * 8;
            if (lane == 0) cb[wid] = c;
            __syncthreads();
            unsigned tot = 0;
#pragma unroll
            for (int w = 0; w < 8; ++w) tot += cb[w];
            if (tot >= (unsigned)CAP) thr = cand;
        }
        unsigned cg_ = 0, ce = 0;
#pragma unroll
        for (int j = 0; j < 8; ++j) { cg_ += key[j] > thr; ce += key[j] == thr; }
        unsigned pk = cg_ | (ce << 16), incl = pk;
#pragma unroll
        for (int o = 1; o < 64; o <<= 1) { const unsigned n = __shfl_up(incl, o); if (lane >= o) incl += n; }
        if (lane == 63) wsum[wid] = incl;
        __syncthreads();
        unsigned base = 0, total = 0;
#pragma unroll
        for (int w = 0; w < 8; ++w) { const unsigned s = wsum[w]; if (w < wid) base += s; total += s; }
        const unsigned excl = base + incl - pk; unsigned og = excl & 0xffffu, oe = excl >> 16; const unsigned ngt = total & 0xffffu, krem = (unsigned)CAP - ngt;
#pragma unroll
        for (int j = 0; j < 8; ++j) { const int t = tid * 8 + j; int m = -1;
            if (key[j] > thr) { m = (e * 8 + b) * 512 + (int)og; ++og; }
            else if (key[j] == thr) { if (oe < krem) m = (e * 8 + b) * 512 + (int)(ngt + oe); ++oe; }
            slot_of[((size_t)b * 4096 + t) * 16 + e] = m;
            if (m >= 0) { idx[m] = b * 4096 + t; gate[m] = __uint_as_float(key[j]); } }
        __syncthreads();
    }
}

__device__ void phase11(const Params& p, float* dst) {
    const int lane = threadIdx.x & 63, wid = threadIdx.x >> 6;
    const float* ada = (const float*)(p.ws + WS_ADA); const int* slot_of = (const int*)(p.ws + WS_SLOT); const bf16_t* oute = (const bf16_t*)(p.ws + WS_OUTE);
    const int stride = gridDim.x * 8;
    int row = blockIdx.x * 8 + wid;
    int myslot = row < MLAT ? slot_of[(size_t)row * 16 + (lane & 15)] : -1;
    for (; row < MLAT; row += stride) {
        const int b = row >> 12; float* xr = p.out + (size_t)row * 1024;
        const int nrow = row + stride; const int nslot = nrow < MLAT ? slot_of[(size_t)nrow * 16 + (lane & 15)] : -1;
        f32x4 xv[4];
#pragma unroll
        for (int i = 0; i < 4; ++i) xv[i] = *(const f32x4*)(xr + 256 * i + 4 * lane);
        f32x4 acc[4];
#pragma unroll
        for (int i = 0; i < 4; ++i) acc[i] = (f32x4){0.f, 0.f, 0.f, 0.f};
        unsigned long long mask = __ballot(myslot >= 0) & 0xffffull;
        while (mask) {
            int m[4];
#pragma unroll
            for (int j = 0; j < 4; ++j) { if (mask) { const int e = __builtin_ctzll(mask); mask &= mask - 1; m[j] = __builtin_amdgcn_readlane(myslot, e); } else m[j] = MMOE; }
            u32x2 w[4][4];
#pragma unroll
            for (int j = 0; j < 4; ++j)
#pragma unroll
                for (int i = 0; i < 4; ++i) w[j][i] = *(const u32x2*)(oute + (size_t)m[j] * 1024 + 256 * i + 4 * lane);
#pragma unroll
            for (int j = 0; j < 4; ++j)
#pragma unroll
                for (int i = 0; i < 4; ++i) { acc[i][0] += bf_lo(w[j][i].x); acc[i][1] += bf_hi(w[j][i].x); acc[i][2] += bf_lo(w[j][i].y); acc[i][3] += bf_hi(w[j][i].y); }
        }
        f32x4 v[4]; float ss = 0.f;
#pragma unroll
        for (int i = 0; i < 4; ++i) { const int d = 256 * i + 4 * lane; const f32x4 g2 = *(const f32x4*)(ada + b * 6144 + 5120 + d); v[i] = xv[i] + g2 * acc[i];
            ss += v[i][0] * v[i][0] + v[i][1] * v[i][1] + v[i][2] * v[i][2] + v[i][3] * v[i][3]; }
        ss = wave_sum(ss); const float rs = rsqrtf(ss * (1.0f / 1024.0f) + 1e-6f);
#pragma unroll
        for (int i = 0; i < 4; ++i) { const int d = 256 * i + 4 * lane; *(f32x4*)(dst + (size_t)row * 1024 + d) = v[i] * rs * *(const f32x4*)(p.final_g + d); }
        myslot = nslot;
    }
}

#define XB_TMO      128
#define XB_XCNT(j)  (256  + 64 * (j))
#define XB_XSUB(j)  (1280 + 64 * (j))
#define XB_XGEN(j)  (2304 + 64 * (j))
#define XB_TOP      3328
#define XB_TOPGEN   3392
#define XCD_BAR_WORDS 3456
#define XB_SPIN_CAP (1u << 22)
__device__ __forceinline__ unsigned xb_ld(unsigned* p)              { return __hip_atomic_load(p, __ATOMIC_RELAXED, __HIP_MEMORY_SCOPE_AGENT); }
__device__ __forceinline__ unsigned xb_add(unsigned* p, unsigned v) { return __hip_atomic_fetch_add(p, v, __ATOMIC_RELAXED, __HIP_MEMORY_SCOPE_AGENT); }
__device__ __forceinline__ unsigned xb_xcc_id() { return (unsigned)__builtin_amdgcn_s_getreg((3 << 11) | 20) & 0xFu; }
#define XB_SPIN(cond, bar) do { unsigned _sp = 0; while (cond) { __builtin_amdgcn_s_sleep(1); \
    if ((++_sp & 255u) == 0u) { if (xb_ld(&(bar)[XB_TMO])) break; if (_sp > XB_SPIN_CAP) { atomicAdd(&(bar)[XB_TMO], 1u); break; } } } } while (0)
struct XcdBarrier { unsigned* bar; unsigned x; volatile LAS unsigned* st; };
__device__ __forceinline__ XcdBarrier xcd_barrier_post(unsigned* bar, volatile LAS unsigned* st) {
    XcdBarrier b; b.bar = bar; b.x = xb_xcc_id(); b.st = st;
    if (threadIdx.x == 0) (void)xb_add(&bar[XB_XCNT(b.x)], 1u);
    return b;
}
__device__ __forceinline__ void xcd_barrier_complete(unsigned* bar, unsigned x, unsigned& nloc, unsigned& nx) {
    const unsigned G = gridDim.x * gridDim.y * gridDim.z;
    unsigned sum, cnt, mine, sp = 0u;
    for (;;) {
        sum = 0u; cnt = 0u; mine = 0u;
#pragma unroll
        for (unsigned j = 0; j < 16; ++j) { const unsigned c = xb_ld(&bar[XB_XCNT(j)]); sum += c; cnt += (c > 0u) ? 1u : 0u; mine = (j == x) ? c : mine; }
        if (sum == G) break;
        __builtin_amdgcn_s_sleep(1);
        if ((++sp & 255u) == 0u) { if (xb_ld(&bar[XB_TMO])) break; if (sp > XB_SPIN_CAP) { atomicAdd(&bar[XB_TMO], 1u); break; } }
    }
    nloc = mine > 0u ? mine : 1u; nx = cnt > 0u ? cnt : 1u;
}
__device__ __forceinline__ void xcd_barrier(const XcdBarrier& b) {
    asm volatile("s_waitcnt vmcnt(0)" ::: "memory");
    __syncthreads();
    if (threadIdx.x == 0) {
        unsigned* bar = b.bar;
        __builtin_amdgcn_s_waitcnt(0);
        unsigned nloc = b.st[0], nx = b.st[1];
        if (nloc == 0u) { xcd_barrier_complete(bar, b.x, nloc, nx); b.st[0] = nloc; b.st[1] = nx; }
        const unsigned old = xb_add(&bar[XB_XSUB(b.x)], 1u);
        const unsigned gen = old / nloc;
        if (old + 1u == (gen + 1u) * nloc) {
            __builtin_amdgcn_fence(__ATOMIC_RELEASE, "agent");
            asm volatile("s_waitcnt vmcnt(0)" ::: "memory");
            const unsigned og = xb_add(&bar[XB_TOP], 1u);
            const unsigned tg = og / nx;
            if (og + 1u == (tg + 1u) * nx) xb_add(&bar[XB_TOPGEN], 1u);
            else XB_SPIN(xb_ld(&bar[XB_TOPGEN]) == tg, bar);
            __builtin_amdgcn_fence(__ATOMIC_ACQUIRE, "agent");
            xb_add(&bar[XB_XGEN(b.x)], 1u);
            asm volatile("s_waitcnt vmcnt(0)" ::: "memory");
        } else {
            XB_SPIN(xb_ld(&bar[XB_XGEN(b.x)]) == gen, bar);
            __builtin_amdgcn_fence(__ATOMIC_ACQUIRE, "agent");
            asm volatile("s_waitcnt vmcnt(0)" ::: "memory");
        }
    }
    __syncthreads();
}

__global__ void __launch_bounds__(NTHR, 2) fwd_megakernel(Params p) {
    extern __shared__ __attribute__((aligned(16))) unsigned char lds_raw[];
    LAS unsigned char* lds = (LAS unsigned char*)lds_raw;
    cg::grid_group grid = cg::this_grid();
    const int G = gridDim.x, bid = blockIdx.x;
    unsigned char* ws = p.ws;
    bf16_t* const R1 = (bf16_t*)(ws + WS_R1); bf16_t* const Zb = (bf16_t*)(ws + WS_RZ); bf16_t* const PQt = (bf16_t*)(ws + WS_RPQ); bf16_t* const MRG = (bf16_t*)(ws + WS_R2);
    bf16_t* const Fb = (bf16_t*)((unsigned char*)p.out + OUT_F); const bf16_t* const DFT = (const bf16_t*)((unsigned char*)p.out + OUT_DFT);
#ifdef ONLY_PH
#define PH(k) ((k) == ONLY_PH && p.ph_lo <= (k) && (k) < p.ph_hi)
#else
#define PH(k) (p.ph_lo <= (k) && (k) < p.ph_hi)
#endif
    volatile LAS unsigned* xst = (volatile LAS unsigned*)(lds + LDS_BYTES - 16);
    if (threadIdx.x < 4) xst[threadIdx.x] = 0u;
    __syncthreads();
    XcdBarrier xbar = xcd_barrier_post((unsigned*)(ws + WS_BAR), xst);
#define SYNC(k) do { if (PH(k) && PH((k) + 1)) { if ((k) == 0) grid.sync(); else xcd_barrier(xbar); } } while (0)
#ifndef REPMASK
#define REPMASK 0
#endif
#define REP(k) for (int rep_ = 0; rep_ <= ((REPMASK >> (k)) & 1); ++rep_)
    if (PH(0)) REP(0) phase0(p, lds);
    SYNC(0);
    if (PH(1)) REP(1) phase1(p);
    SYNC(1);
    if (PH(2)) REP(2) {
        { ProbPlain pr{(const bf16_t*)(ws + WS_WPQ), R1, 1024, 1024, 1024}; pg8::Order S; S.init(4, 128, G, bid); EpiPQ E{PQt}; pg8::gemm_phase(lds, pr, S, E); }
        { ProbPlain pr{R1, (const bf16_t*)(ws + WS_WIN), 1024, 1024, 1024}; pg8::Order S; S.init(128, 16, G, bid); EpiZ E{Zb, 4096, -1}; pg8::gemm_phase(lds, pr, S, E); }
        { ProbPlain pr{(const bf16_t*)(ws + WS_HCTX), (const bf16_t*)(ws + WS_WIN), 1024, 1024, 1024}; pg8::Order S; S.init(8, 4, G, bid); EpiZ E{(bf16_t*)(ws + WS_ZXC), 1024, 0}; pg8::gemm_phase(lds, pr, S, E); }
    }
    SYNC(2);
    if (PH(3)) REP(3) {
        { ProbPlain pr{DFT, PQt, 8192, 8192, 8192}; pg8::Order S; S.init(16, 16, G, bid); EpiF E{Fb}; pg8::gemm_phase(lds, pr, S, E); }
        for (int it = bid; it < NB * NSEQ * 8; it += G) lru_tile<false>(p, lds, it);
    }
    SYNC(3);
    if (PH(4)) REP(4) { for (int it = bid; it < NB * 32 * 8; it += G) lru_tile<true>(p, lds, it); }
    SYNC(4);
    if (PH(5)) REP(5) {
        { ProbPlain pr{Fb, (const bf16_t*)(ws + WS_WFOUR), 512, 512, 512}; pg8::Order S; S.init(128, 4, G, bid); EpiY1 E{MRG, Zb}; pg8::gemm_phase(lds, pr, S, E); }
        { ProbPlain pr{R1, (const bf16_t*)(ws + WS_WLRU), 1024, 1024, 1024}; pg8::Order S; S.init(128, 4, G, bid); EpiY2 E{MRG, Zb}; pg8::gemm_phase(lds, pr, S, E); }
    }
    SYNC(5);
    if (PH(6)) REP(6) { ProbPlain pr{MRG, (const bf16_t*)(ws + WS_WOUT), 1024, 1024, 1024}; pg8::Order S; S.init(128, 4, G, bid);
        EpiOut E{p.out, p.x, (const float*)(ws + WS_POS), (const float*)(ws + WS_ADA)}; pg8::gemm_phase(lds, pr, S, E); }
    SYNC(6);
    if (PH(7)) REP(7) { phase7_rows(p, lds); phase7_weights(p); }
    SYNC(7);
    if (PH(8)) REP(8) phase8_topk(p, lds);
    SYNC(8);
    if (PH(9)) REP(9) { ProbMoeUp pr{R1, (const bf16_t*)(ws + WS_WGU), (const int*)(ws + WS_IDX), 1024, 1024, 1024}; pg8::Order S; S.init(256, 12, G, bid); EpiGU E{(bf16_t*)(ws + WS_HID)}; pg8::gemm_phase(lds, pr, S, E); }
    SYNC(9);
    if (PH(10)) { if (bid == 0 && threadIdx.x < 128) *(u32x4*)(ws + WS_OUTE + (size_t)MMOE * 2048 + threadIdx.x * 16) = (u32x4){0u, 0u, 0u, 0u}; }
    if (PH(10)) REP(10) { ProbMoeDown pr{(const bf16_t*)(ws + WS_HID), (const bf16_t*)(ws + WS_WD), 1536, 1536, 1536}; pg8::Order S; S.init(256, 4, G, bid); EpiDown E{(bf16_t*)(ws + WS_OUTE), (const float*)(ws + WS_GATE)}; pg8::gemm_phase(lds, pr, S, E); }
    SYNC(10);
    if (PH(12)) phase11(p, (float*)(ws + WS_HID));
    if (PH(11)) phase11(p, p.out);
}

#ifndef N_LAUNCHES
#define N_LAUNCHES 1
#endif
#ifndef PROBE_DUP
#define PROBE_DUP 0x0
#endif
extern "C" void kernel_launch(void* const* d_in, const int* in_sizes, int n_in, void* d_out, int out_size, void* d_ws, size_t ws_size, hipStream_t stream) {
    static int grid = 0;
    if (grid == 0) {
        if (n_in != 24 || out_size != MLAT * DM || ws_size < WS_END) { fprintf(stderr, "kernel_launch: unexpected shapes (n_in %d out %d ws %zu)\n", n_in, out_size, ws_size); grid = -1; return; }
        int dev = 0, cus = 0, per_cu = 0;
        hipGetDevice(&dev); hipDeviceGetAttribute(&cus, hipDeviceAttributeMultiprocessorCount, dev);
        hipFuncSetAttribute((const void*)fwd_megakernel, hipFuncAttributeMaxDynamicSharedMemorySize, LDS_BYTES);
        hipOccupancyMaxActiveBlocksPerMultiprocessor(&per_cu, (const void*)fwd_megakernel, NTHR, LDS_BYTES);
        if (per_cu < 1) { fprintf(stderr, "kernel_launch: occupancy query reports %d blocks per CU\n", per_cu); per_cu = 1; }
        grid = cus * 1;
        (void)hipGetLastError();
    }
    if (grid < 0) return;
    Params p{};
    const float** f = (const float**)&p;
    for (int i = 0; i < 24; ++i) f[i] = (const float*)d_in[i];
    p.out = (float*)d_out; p.ws = (unsigned char*)d_ws;
    (void)hipMemsetAsync((unsigned char*)d_ws + WS_BAR, 0, XCD_BAR_WORDS * 4, stream);
#if N_LAUNCHES == 1
    p.ph_lo = 0; p.ph_hi = 12;
    void* args[] = {&p};
    hipError_t e = hipLaunchCooperativeKernel((const void*)fwd_megakernel, dim3(grid), dim3(NTHR), args, LDS_BYTES, stream);
    if (e != hipSuccess) fprintf(stderr, "cooperative launch failed: %s (grid %d)\n", hipGetErrorString(e), grid);
#else
    for (int k = 0; k < 12; ++k) for (int r = 0; r <= ((PROBE_DUP >> k) & 1); ++r) { p.ph_lo = k; p.ph_hi = k + 1; if (k == 11 && r == 0 && ((PROBE_DUP >> 11) & 1)) { p.ph_lo = 12; p.ph_hi = 13; } hipLaunchKernelGGL(fwd_megakernel, dim3(grid), dim3(NTHR), LDS_BYTES, stream, p); }
#endif
}
```

```cpp
#include <hip/hip_runtime.h>
#include <hip/hip_cooperative_groups.h>
#include <cstdio>
namespace cg = cooperative_groups;

#define LAS __attribute__((address_space(3)))
typedef unsigned short bf16_t;
typedef short bf16x8 __attribute__((ext_vector_type(8)));
typedef float f32x4 __attribute__((ext_vector_type(4)));
typedef float f32x16 __attribute__((ext_vector_type(16)));
typedef unsigned u32x4 __attribute__((ext_vector_type(4)));
typedef unsigned u32x2 __attribute__((ext_vector_type(2)));

constexpr int NB = 8, TT = 4096, DM = 1024, CTXL = 256, MLAT = NB * TT, MCTX = NB * CTXL;
constexpr int NE = 16, CAP = 512, DE = 1536, MMOE = NE * NB * CAP;
constexpr int NSEQ = 34;
constexpr int NTHR = 512;
constexpr int LDS_BYTES = 144 * 1024;

constexpr size_t KiB = 1024, MiB = 1024 * 1024;
constexpr size_t WS_ADA = 0;
constexpr size_t WS_POS = 256 * KiB;
constexpr size_t WS_AGG = 512 * KiB;
constexpr size_t WS_WPQ = 5 * MiB;
constexpr size_t WS_WIN = 7 * MiB;
constexpr size_t WS_WFOUR = 15 * MiB;
constexpr size_t WS_WLRU = 16 * MiB;
constexpr size_t WS_WOUT = 18 * MiB;
constexpr size_t WS_WAT = 20 * MiB;
constexpr size_t WS_WIT = 20 * MiB + 512 * KiB;
constexpr size_t WS_SCORES = 21 * MiB;
constexpr size_t WS_IDX = 23 * MiB;
constexpr size_t WS_GATE = 23 * MiB + 256 * KiB;
constexpr size_t WS_SLOT = 23 * MiB + 512 * KiB;
constexpr size_t WS_BAR = 25 * MiB + 512 * KiB;
constexpr size_t WS_HCTX = 26 * MiB;
constexpr size_t WS_ZXC = 30 * MiB;
constexpr size_t WS_R1 = 40 * MiB;
constexpr size_t WS_RPQ = 104 * MiB;
constexpr size_t WS_R2 = 168 * MiB;
constexpr size_t WS_RZ = 232 * MiB;
constexpr size_t WS_END = 488 * MiB;
constexpr size_t WS_HID = WS_RZ, WS_WD = WS_RZ + 192 * MiB, WS_WGU = WS_RPQ, WS_OUTE = WS_R1;
constexpr size_t OUT_DFT = 0, OUT_F = 64 * MiB;

struct Params {
    const float *x, *c, *ctx, *c_ctx, *w_ada, *b_ada, *norm1_g, *norm2_g, *w_in, *w_four, *conv_w, *conv_b, *lru_lambda,
        *lru_wa, *lru_ba, *lru_wi, *lru_bi, *w_lru, *w_out, *w_router, *w_gate_e, *w_up_e, *w_down_e, *final_g;
    float* out; unsigned char* ws; int ph_lo, ph_hi;
};

__device__ __forceinline__ unsigned cvt_pk_bf16(float lo, float hi) { unsigned r; asm volatile("v_cvt_pk_bf16_f32 %0, %1, %2" : "=v"(r) : "v"(lo), "v"(hi)); return r; }
__device__ __forceinline__ float bf_lo(unsigned w) { return __uint_as_float(w << 16); }
__device__ __forceinline__ float bf_hi(unsigned w) { return __uint_as_float(w & 0xffff0000u); }
__device__ __forceinline__ float bf2f(bf16_t h) { return __uint_as_float(((unsigned)h) << 16); }
__device__ __forceinline__ float sigmoidf_(float v) { return __builtin_amdgcn_rcpf(1.0f + __expf(-v)); }
__device__ __forceinline__ float gelu_tanh(float v) { const float y = 1.5957691216f * (v + 0.044715f * v * v * v); return v * sigmoidf_(y); }
__device__ __forceinline__ float wave_sum(float v) {
#pragma unroll
    for (int o = 32; o >= 1; o >>= 1) v += __shfl_xor(v, o);
    return v;
}
__device__ __forceinline__ void unpack8(const u32x4 w, float (&f)[8]) { f[0] = bf_lo(w.x); f[1] = bf_hi(w.x); f[2] = bf_lo(w.y); f[3] = bf_hi(w.y); f[4] = bf_lo(w.z); f[5] = bf_hi(w.z); f[6] = bf_lo(w.w); f[7] = bf_hi(w.w); }

namespace pg8 {
constexpr int BM = 256, BK = 64, HALF = 128, HTB = HALF * BK * 2, STAGE_BYTES = 8 * HTB, NXCD = 8, WGM = 8;
__device__ __forceinline__ int lds_byte(int r, int c) { const int st = (r >> 4) * 2 + (c >> 5), rr = r & 15, cc = c & 31, ob = rr * 64 + cc * 2; return st * 1024 + (ob ^ (((ob >> 9) & 1) << 5)); }
__device__ __forceinline__ void stage_rc(int b, int& R, int& C) { const int st = b / 1024, sb = b % 1024, swz = sb ^ (((sb >> 9) & 1) << 5); R = (st >> 1) * 16 + swz / 64; C = (st & 1) * 32 + (swz % 64) / 2; }
__device__ __forceinline__ int perm32(int rho) { const int n = rho >> 4, i = rho & 15; return 8 * (i >> 2) + 4 * n + (i & 3); }
struct Unit { int pm, pn; };
struct Order {
    int nM, nN, nwg, G, c;
    __device__ void init(int nM_, int nN_, int G_, int c_) { nM = nM_; nN = nN_; nwg = nM * nN; G = G_; c = c_; }
    __device__ bool next(int i, Unit& u) const {
        const long L = (long)i * G + c; if (L >= nwg) return false;
        int wgid = (int)L; { const int q = nwg / NXCD, r = nwg % NXCD, xcd = wgid % NXCD, off = wgid / NXCD; wgid = (xcd < r ? xcd * (q + 1) : r * (q + 1) + (xcd - r) * q) + off; }
        const int nig = WGM * nN, gid = wgid / nig, fm = gid * WGM, gsz = (nM - fm) < WGM ? (nM - fm) : WGM;
        u.pm = fm + ((wgid % nig) % gsz); u.pn = (wgid % nig) / gsz; return true;
    }
};
template <class P, class Epi>
__device__ __forceinline__ void gemm_phase(LAS unsigned char* lds, const P& pr, const Order& S, const Epi& E) {
    const int tid = threadIdx.x, wid = __builtin_amdgcn_readfirstlane(tid >> 6), lane = tid & 63, wr = wid >> 2, wc = wid & 3, fr = lane & 15, fq = lane >> 4;
    const int nt = pr.K / BK;
    int RA[2], CA[2]; unsigned voffB[2];
#pragma unroll
    for (int i = 0; i < 2; ++i) { int R, C; stage_rc(tid * 16 + i * 8192, R, C); RA[i] = R; CA[i] = C; const int Rb = Epi::PERM ? ((R & ~31) + perm32(R & 31)) : R; voffB[i] = (unsigned)(Rb * pr.ldb + C) * 2u; }
    const size_t kstep = (size_t)(BK * 2);
    const size_t hstepB = (size_t)HALF * pr.ldb * 2;
    const unsigned ldsw = (unsigned)wid * 1024u;
    const int aoff = lds_byte(wr * 64 + fr, fq * 8), boff = lds_byte(wc * 32 + fr, fq * 8);
#define PG8_SA(b, h) (((b) * 2 + (h)) * HTB)
#define PG8_SB(b, h) ((4 + (b) * 2 + (h)) * HTB)
#define PG8_STAGE(bufoff, gbase, voff) do { _Pragma("unroll") for (int _i = 0; _i < 2; ++_i) \
        __builtin_amdgcn_global_load_lds((const unsigned*)((const char*)(gbase) + (voff)[_i]), (LAS unsigned*)(lds + (bufoff) + ldsw + _i * 8192), 16, 0, 0); } while (0)
#define PG8_LDA(dst, b, h) do { _Pragma("unroll") for (int m = 0; m < 4; ++m) _Pragma("unroll") for (int k = 0; k < 2; ++k) dst[m][k] = *(const LAS bf16x8*)(lds + PG8_SA(b, h) + aoff + m * 2048 + k * 1024); } while (0)
#define PG8_LDB(dst, b, h) do { _Pragma("unroll") for (int n = 0; n < 2; ++n) _Pragma("unroll") for (int k = 0; k < 2; ++k) dst[n][k] = *(const LAS bf16x8*)(lds + PG8_SB(b, h) + boff + n * 2048 + k * 1024); } while (0)
#define PG8_MMA(ai, bj, At, Bt) do { __builtin_amdgcn_s_setprio(1); _Pragma("unroll") for (int m = 0; m < 4; ++m) _Pragma("unroll") for (int n = 0; n < 2; ++n) _Pragma("unroll") for (int k = 0; k < 2; ++k) \
        acc[ai][bj][m][n] = __builtin_amdgcn_mfma_f32_16x16x32_bf16(Bt[n][k], At[m][k], acc[ai][bj][m][n], 0, 0, 0); __builtin_amdgcn_s_setprio(0); } while (0)
#define PG8_WAIT_V(n) asm volatile("s_waitcnt vmcnt(" #n ")" ::: "memory")
#define PG8_WAIT_L(n) asm volatile("s_waitcnt lgkmcnt(" #n ")" ::: "memory")
#define PG8_BAR __builtin_amdgcn_s_barrier()
#define PG8_SCHED __builtin_amdgcn_sched_barrier(0)
    Unit cur, nxt; int ui = 0;
    if (!S.next(0, cur)) return;
    f32x4 acc[2][2][4][2];
#pragma unroll
    for (int a = 0; a < 2; ++a)
#pragma unroll
        for (int b = 0; b < 2; ++b)
#pragma unroll
            for (int m = 0; m < 4; ++m)
#pragma unroll
                for (int n = 0; n < 2; ++n) acc[a][b][m][n] = (f32x4){0.f, 0.f, 0.f, 0.f};
    bf16x8 At[4][2], B0[2][2], B1[2][2];
    unsigned vA[2][2], vN[2][2];
    pr.avoff(cur, RA, CA, vA);
#pragma unroll
    for (int h = 0; h < 2; ++h)
#pragma unroll
        for (int i = 0; i < 2; ++i) vN[h][i] = vA[h][i];
    const char* cA = pr.abase(cur); const char* cB = pr.bbase(cur);
    PG8_STAGE(PG8_SB(0, 0), cB, voffB); PG8_STAGE(PG8_SA(0, 0), cA, vA[0]); PG8_STAGE(PG8_SB(0, 1), cB + hstepB, voffB); PG8_STAGE(PG8_SA(0, 1), cA, vA[1]);
    if (wr == 1) PG8_BAR;
    PG8_WAIT_V(4); PG8_BAR;
    PG8_STAGE(PG8_SB(1, 0), cB + kstep, voffB); PG8_STAGE(PG8_SA(1, 0), cA + kstep, vA[0]); PG8_STAGE(PG8_SB(1, 1), cB + hstepB + kstep, voffB);
    PG8_WAIT_V(6); PG8_BAR;
    for (;;) {
        const bool has_next = S.next(ui + 1, nxt);
        const char* nA = has_next ? pr.abase(nxt) : cA; const char* nB = has_next ? pr.bbase(nxt) : cB;
        if (P::GATHER) { if (has_next) pr.avoff(nxt, RA, CA, vN); }
        for (int t = 0; t < nt; t += 2) {
            const bool last = (t == nt - 2);
            const char* a1 = cA + (size_t)(t + 1) * kstep;
            const char* a2 = last ? nA : cA + (size_t)(t + 2) * kstep; const char* b2 = last ? nB : cB + (size_t)(t + 2) * kstep;
            const char* a3 = a2 + kstep; const char* b3 = b2 + kstep;
            unsigned v2[2][2];
#pragma unroll
            for (int h = 0; h < 2; ++h)
#pragma unroll
                for (int i = 0; i < 2; ++i) v2[h][i] = (P::GATHER && last) ? vN[h][i] : vA[h][i];
            PG8_LDB(B0, 0, 0); PG8_SCHED; PG8_LDA(At, 0, 0); PG8_STAGE(PG8_SA(1, 1), a1, vA[1]);
            PG8_WAIT_L(8); PG8_BAR; PG8_WAIT_L(0); PG8_MMA(0, 0, At, B0); PG8_BAR; PG8_SCHED;
            PG8_LDB(B1, 0, 1); PG8_STAGE(PG8_SB(0, 0), b2, voffB);
            PG8_BAR; PG8_WAIT_L(0); PG8_MMA(0, 1, At, B1); PG8_BAR;
            PG8_LDA(At, 0, 1); PG8_STAGE(PG8_SA(0, 0), a2, v2[0]);
            PG8_BAR; PG8_WAIT_L(0); PG8_MMA(1, 0, At, B0); PG8_BAR; PG8_SCHED;
            PG8_STAGE(PG8_SB(0, 1), b2 + hstepB, voffB);
            PG8_WAIT_V(6); PG8_BAR; PG8_MMA(1, 1, At, B1); PG8_BAR;
            PG8_LDB(B0, 1, 0); PG8_SCHED; PG8_LDA(At, 1, 0); PG8_STAGE(PG8_SA(0, 1), a2, v2[1]);
            PG8_WAIT_L(8); PG8_BAR; PG8_WAIT_L(0); PG8_MMA(0, 0, At, B0); PG8_BAR; PG8_SCHED;
            PG8_LDB(B1, 1, 1); PG8_STAGE(PG8_SB(1, 0), b3, voffB);
            PG8_BAR; PG8_WAIT_L(0); PG8_MMA(0, 1, At, B1); PG8_BAR;
            PG8_LDA(At, 1, 1); PG8_STAGE(PG8_SA(1, 0), a3, v2[0]);
            PG8_BAR; PG8_WAIT_L(0); PG8_MMA(1, 0, At, B0); PG8_BAR; PG8_SCHED;
            PG8_STAGE(PG8_SB(1, 1), b3 + hstepB, voffB);
            PG8_WAIT_V(6); PG8_BAR; PG8_MMA(1, 1, At, B1); PG8_BAR;
            if (P::GATHER && last) {
#pragma unroll
                for (int h = 0; h < 2; ++h)
#pragma unroll
                    for (int i = 0; i < 2; ++i) vA[h][i] = vN[h][i];
            }
        }
        E(acc, cur, wr, wc, fr, fq);
        if (!has_next) break;
#pragma unroll
        for (int a = 0; a < 2; ++a)
#pragma unroll
            for (int b = 0; b < 2; ++b)
#pragma unroll
                for (int m = 0; m < 4; ++m)
#pragma unroll
                    for (int n = 0; n < 2; ++n) acc[a][b][m][n] = (f32x4){0.f, 0.f, 0.f, 0.f};
        cur = nxt; cA = nA; cB = nB; ++ui;
    }
    PG8_WAIT_V(0);
    if (wr == 0) PG8_BAR;
    PG8_BAR;
#undef PG8_SA
#undef PG8_SB
#undef PG8_STAGE
#undef PG8_LDA
#undef PG8_LDB
#undef PG8_MMA
#undef PG8_WAIT_V
#undef PG8_WAIT_L
#undef PG8_BAR
#undef PG8_SCHED
}
}
using pg8::Unit;

struct ProbPlain {
    static constexpr bool GATHER = false;
    const bf16_t* A; const bf16_t* B; int K, lda, ldb;
    __device__ __forceinline__ const char* abase(const Unit& u) const { return (const char*)(A + (size_t)u.pm * 256 * lda); }
    __device__ __forceinline__ const char* bbase(const Unit& u) const { return (const char*)(B + (size_t)u.pn * 256 * ldb); }
    __device__ __forceinline__ void avoff(const Unit&, const int (&RA)[2], const int (&CA)[2], unsigned (&v)[2][2]) const {
#pragma unroll
        for (int h = 0; h < 2; ++h)
#pragma unroll
            for (int i = 0; i < 2; ++i) v[h][i] = (unsigned)((h * 128 + RA[i]) * lda + CA[i]) * 2u;
    }
};
struct ProbMoeUp {
    static constexpr bool GATHER = true;
    const bf16_t* A; const bf16_t* B; const int* idx; int K, lda, ldb;
    __device__ __forceinline__ const char* abase(const Unit&) const { return (const char*)A; }
    __device__ __forceinline__ const char* bbase(const Unit& u) const { return (const char*)(B + ((size_t)(u.pm >> 4) * 3072 + (size_t)u.pn * 256) * ldb); }
    __device__ __forceinline__ void avoff(const Unit& u, const int (&RA)[2], const int (&CA)[2], unsigned (&v)[2][2]) const {
#pragma unroll
        for (int h = 0; h < 2; ++h)
#pragma unroll
            for (int i = 0; i < 2; ++i) { const int g = idx[u.pm * 256 + h * 128 + RA[i]]; v[h][i] = (unsigned)(g * lda + CA[i]) * 2u; }
    }
};
struct ProbMoeDown {
    static constexpr bool GATHER = false;
    const bf16_t* A; const bf16_t* B; int K, lda, ldb;
    __device__ __forceinline__ const char* abase(const Unit& u) const { return (const char*)(A + (size_t)u.pm * 256 * lda); }
    __device__ __forceinline__ const char* bbase(const Unit& u) const { return (const char*)(B + ((size_t)(u.pm >> 4) * 1024 + (size_t)u.pn * 256) * ldb); }
    __device__ __forceinline__ void avoff(const Unit&, const int (&RA)[2], const int (&CA)[2], unsigned (&v)[2][2]) const {
#pragma unroll
        for (int h = 0; h < 2; ++h)
#pragma unroll
            for (int i = 0; i < 2; ++i) v[h][i] = (unsigned)((h * 128 + RA[i]) * lda + CA[i]) * 2u;
    }
};

#define EPI_ROWS(...) _Pragma("unroll") for (int ai = 0; ai < 2; ++ai) _Pragma("unroll") for (int m = 0; m < 4; ++m) { const int row = u.pm * 256 + ai * 128 + wr * 64 + m * 16 + fr; __VA_ARGS__ }
__device__ __forceinline__ u32x4 pack8(const f32x4 v0, const f32x4 v1) { u32x4 w; w.x = cvt_pk_bf16(v0[0], v0[1]); w.y = cvt_pk_bf16(v0[2], v0[3]); w.z = cvt_pk_bf16(v1[0], v1[1]); w.w = cvt_pk_bf16(v1[2], v1[3]); return w; }

struct EpiPQ {
    static constexpr bool PERM = true; bf16_t* O;
    __device__ __forceinline__ void operator()(const f32x4 (&acc)[2][2][4][2], const Unit& u, int wr, int wc, int fr, int fq) const {
        const int tg0 = u.pn * 256 + wc * 32 + 8 * fq, b = tg0 >> 12;
        EPI_ROWS(
            bf16_t* rp = O + ((size_t)(b * 1024 + row) * 4096 + (tg0 & 4095));
            _Pragma("unroll") for (int bj = 0; bj < 2; ++bj) *(u32x4*)(rp + bj * 128) = pack8(acc[ai][bj][m][0], acc[ai][bj][m][1]);
        )
    }
};
struct EpiZ {
    static constexpr bool PERM = true; bf16_t* O; int ldc; int fixed_act;
    __device__ __forceinline__ void operator()(const f32x4 (&acc)[2][2][4][2], const Unit& u, int wr, int wc, int fr, int fq) const {
        const int col0 = u.pn * 256 + wc * 32 + 8 * fq; const int act = fixed_act >= 0 ? fixed_act : (u.pn >> 2);
        EPI_ROWS(
            bf16_t* rp = O + (size_t)row * ldc + col0;
            _Pragma("unroll") for (int bj = 0; bj < 2; ++bj) {
                f32x4 v0 = acc[ai][bj][m][0], v1 = acc[ai][bj][m][1];
                if (act == 1) { _Pragma("unroll") for (int j = 0; j < 4; ++j) { v0[j] = gelu_tanh(v0[j]); v1[j] = gelu_tanh(v1[j]); } }
                else if (act >= 2) { _Pragma("unroll") for (int j = 0; j < 4; ++j) { v0[j] = sigmoidf_(v0[j]); v1[j] = sigmoidf_(v1[j]); } }
                *(u32x4*)(rp + bj * 128) = pack8(v0, v1); }
        )
    }
};
struct EpiF {
    static constexpr bool PERM = true; bf16_t* O;
    __device__ __forceinline__ void operator()(const f32x4 (&acc)[2][2][4][2], const Unit& u, int wr, int wc, int fr, int fq) const {
        const int b = u.pn >> 1, ch0 = (u.pn & 1) * 256 + wc * 32 + 8 * fq;
        EPI_ROWS(
            bf16_t* rp = O + ((size_t)(b * 4096 + row) * 512 + ch0);
            _Pragma("unroll") for (int bj = 0; bj < 2; ++bj) *(u32x4*)(rp + bj * 128) = pack8(acc[ai][bj][m][0], acc[ai][bj][m][1]);
        )
    }
};
struct EpiY1 {
    static constexpr bool PERM = true; bf16_t* O; const bf16_t* Z;
    __device__ __forceinline__ void operator()(const f32x4 (&acc)[2][2][4][2], const Unit& u, int wr, int wc, int fr, int fq) const {
        const int col0 = u.pn * 256 + wc * 32 + 8 * fq;
        EPI_ROWS(
            _Pragma("unroll") for (int bj = 0; bj < 2; ++bj) {
                const int col = col0 + bj * 128; float g[8]; unpack8(*(const u32x4*)(Z + (size_t)row * 4096 + 2048 + col), g);
                f32x4 v0 = acc[ai][bj][m][0], v1 = acc[ai][bj][m][1];
                _Pragma("unroll") for (int j = 0; j < 4; ++j) { v0[j] *= g[j]; v1[j] *= g[4 + j]; }
                *(u32x4*)(O + (size_t)row * 1024 + col) = pack8(v0, v1); }
        )
    }
};
struct EpiY2 {
    static constexpr bool PERM = true; bf16_t* O; const bf16_t* Z;
    __device__ __forceinline__ void operator()(const f32x4 (&acc)[2][2][4][2], const Unit& u, int wr, int wc, int fr, int fq) const {
        const int col0 = u.pn * 256 + wc * 32 + 8 * fq;
        EPI_ROWS(
            _Pragma("unroll") for (int bj = 0; bj < 2; ++bj) {
                const int col = col0 + bj * 128; float g[8], t1[8]; unpack8(*(const u32x4*)(Z + (size_t)row * 4096 + 3072 + col), g); unpack8(*(const u32x4*)(O + (size_t)row * 1024 + col), t1);
                f32x4 v0 = acc[ai][bj][m][0], v1 = acc[ai][bj][m][1];
                _Pragma("unroll") for (int j = 0; j < 4; ++j) { v0[j] = t1[j] + v0[j] * g[j]; v1[j] = t1[4 + j] + v1[j] * g[4 + j]; }
                *(u32x4*)(O + (size_t)row * 1024 + col) = pack8(v0, v1); }
        )
    }
};
struct EpiOut {
    static constexpr bool PERM = false; float* O; const float* X; const float* pos; const float* ada;
    __device__ __forceinline__ void operator()(const f32x4 (&acc)[2][2][4][2], const Unit& u, int wr, int wc, int fr, int fq) const {
        const int col0 = u.pn * 256 + wc * 32 + 4 * fq; const int b = u.pm >> 4;
        EPI_ROWS(
            const int t = row & 4095;
            _Pragma("unroll") for (int bj = 0; bj < 2; ++bj) _Pragma("unroll") for (int n = 0; n < 2; ++n) {
                const int col = col0 + bj * 128 + n * 16;
                const f32x4 xv = *(const f32x4*)(X + (size_t)row * 1024 + col);
                const f32x4 pv = *(const f32x4*)(pos + (col < 512 ? (t >> 6) * 512 + col : (t & 63) * 512 + (col - 512)));
                const f32x4 gv = *(const f32x4*)(ada + b * 6144 + 2048 + col);
                *(f32x4*)(O + (size_t)row * 1024 + col) = xv + pv + gv * acc[ai][bj][m][n]; }
        )
    }
};
struct EpiGU {
    static constexpr bool PERM = true; bf16_t* O;
    __device__ __forceinline__ void operator()(const f32x4 (&acc)[2][2][4][2], const Unit& u, int wr, int wc, int fr, int fq) const {
        const int col0 = u.pn * 128 + wc * 32 + 8 * fq;
        EPI_ROWS(
            f32x4 v0, v1;
            _Pragma("unroll") for (int j = 0; j < 4; ++j) { const float g0 = acc[ai][0][m][0][j], g1 = acc[ai][0][m][1][j];
                v0[j] = g0 * sigmoidf_(g0) * acc[ai][1][m][0][j]; v1[j] = g1 * sigmoidf_(g1) * acc[ai][1][m][1][j]; }
            *(u32x4*)(O + (size_t)row * DE + col0) = pack8(v0, v1);
        )
    }
};
struct EpiDown {
    static constexpr bool PERM = true; bf16_t* O; const float* gate;
    __device__ __forceinline__ void operator()(const f32x4 (&acc)[2][2][4][2], const Unit& u, int wr, int wc, int fr, int fq) const {
        const int col0 = u.pn * 256 + wc * 32 + 8 * fq;
        EPI_ROWS(
            const float g = gate[row];
            _Pragma("unroll") for (int bj = 0; bj < 2; ++bj) *(u32x4*)(O + (size_t)row * 1024 + col0 + bj * 128) = pack8(acc[ai][bj][m][0] * g, acc[ai][bj][m][1] * g);
        )
    }
};

__device__ void p0_ada(const Params& p, LAS unsigned char* lds, int item) {
    const int tid = threadIdx.x;
    LAS float* s = (LAS float*)lds; LAS float* red = s + 9 * 1024;
    for (int i = tid; i < 9 * 1024; i += NTHR) { const int r = i >> 10, d = i & 1023; const float v = r < 8 ? p.c[r * 1024 + d] : p.c_ctx[d]; s[i] = v / (1.0f + expf(-v)); }
    __syncthreads();
    const int col = tid & 63, ds = tid >> 6; float a[9];
#pragma unroll
    for (int r = 0; r < 9; ++r) a[r] = 0.f;
    const float* w = p.w_ada + (size_t)(ds * 128) * 6144 + item * 64 + col;
    for (int d = 0; d < 128; ++d) { const float wv = w[(size_t)d * 6144];
#pragma unroll
        for (int r = 0; r < 9; ++r) a[r] += s[r * 1024 + ds * 128 + d] * wv; }
#pragma unroll
    for (int r = 0; r < 9; ++r) red[(ds * 9 + r) * 64 + col] = a[r];
    __syncthreads();
    float* ada = (float*)(p.ws + WS_ADA);
    for (int i = tid; i < 9 * 64; i += NTHR) { const int r = i >> 6, cc = i & 63; float v = 0.f;
#pragma unroll
        for (int k = 0; k < 8; ++k) v += red[(k * 9 + r) * 64 + cc];
        ada[r * 6144 + item * 64 + cc] = v + p.b_ada[item * 64 + cc]; }
    __syncthreads();
}
template <int NS>
__device__ __forceinline__ void xpose_item(const float* src, int ldsrc, bf16_t* dst, int lddst, int k0, int n0, int mode) {
    const int tid = threadIdx.x, nl = tid & 63, k8 = tid >> 6;
    float v[NS][8];
#pragma unroll
    for (int s = 0; s < NS; ++s)
#pragma unroll
        for (int j = 0; j < 8; ++j) v[s][j] = src[(size_t)(k0 + 8 * k8 + j) * ldsrc + n0 + 64 * s + nl];
#pragma unroll
    for (int s = 0; s < NS; ++s) { const int n = n0 + 64 * s + nl; int row = n;
        if (mode) row = (n >> 7) * 256 + (n & 127) + (mode == 2 ? 128 : 0);
        u32x4 w; w.x = cvt_pk_bf16(v[s][0], v[s][1]); w.y = cvt_pk_bf16(v[s][2], v[s][3]); w.z = cvt_pk_bf16(v[s][4], v[s][5]); w.w = cvt_pk_bf16(v[s][6], v[s][7]);
        *(u32x4*)(dst + (size_t)row * lddst + k0 + 8 * k8) = w; }
}
__device__ void p0_wpq(const Params& p, LAS unsigned char* lds, int item) {
    const int tid = threadIdx.x, g = item >> 4, db = item & 15;
    LAS float* wl = (LAS float*)lds; LAS float* ct = wl + 64 * 129;
    for (int i = tid; i < 64 * 128; i += NTHR) { const int d = i >> 7, cc = i & 127; wl[d * 129 + cc] = p.w_in[(size_t)(db * 64 + d) * 4608 + g * 128 + cc]; }
    if (tid < 128) { float sn, cs; sincospif((float)tid * (1.0f / 64.0f), &sn, &cs); ct[tid] = cs; ct[128 + tid] = sn; }
    __syncthreads();
    const int q = tid & 255, kc = q >> 1, pq = q & 1, dh = tid >> 8; const int n = (g * 128 + kc) * 2 + pq;
    bf16_t* dst = (bf16_t*)(p.ws + WS_WPQ) + (size_t)n * 1024 + db * 64 + dh * 32;
    const float scale = 0.001381067932f;
    for (int d8 = 0; d8 < 4; ++d8) { float a[8];
#pragma unroll
        for (int j = 0; j < 8; ++j) a[j] = 0.f;
        for (int cc = 0; cc < 128; ++cc) { const float tv = ct[pq * 128 + ((cc * kc) & 127)];
#pragma unroll
            for (int j = 0; j < 8; ++j) a[j] += wl[(dh * 32 + d8 * 8 + j) * 129 + cc] * tv; }
        u32x4 w; w.x = cvt_pk_bf16(a[0] * scale, a[1] * scale); w.y = cvt_pk_bf16(a[2] * scale, a[3] * scale); w.z = cvt_pk_bf16(a[4] * scale, a[5] * scale); w.w = cvt_pk_bf16(a[6] * scale, a[7] * scale);
        *(u32x4*)(dst + d8 * 8) = w; }
    __syncthreads();
}
__device__ void p0_dft_row(const Params& p, int tp) {
    bf16_t* dst = (bf16_t*)((unsigned char*)p.out + OUT_DFT) + (size_t)tp * 8192;
#pragma unroll
    for (int ps = 0; ps < 2; ++ps) { const int k8 = (ps * NTHR + threadIdx.x) * 8; const bool hi = k8 >= 4096; const int t0 = k8 & 4095; float v[8];
#pragma unroll
        for (int j = 0; j < 8; ++j) { const int mm = (tp * (t0 + j)) & 4095; float sn, cs; sincospif((float)mm * (1.0f / 2048.0f), &sn, &cs); v[j] = hi ? -sn : cs; }
        u32x4 w; w.x = cvt_pk_bf16(v[0], v[1]); w.y = cvt_pk_bf16(v[2], v[3]); w.z = cvt_pk_bf16(v[4], v[5]); w.w = cvt_pk_bf16(v[6], v[7]);
        *(u32x4*)(dst + k8) = w; }
}
__device__ void p0_pos(const Params& p) {
    float* tab = (float*)(p.ws + WS_POS);
    for (int i = threadIdx.x; i < 64 * 512; i += NTHR) { const int ii = i >> 9, j = i & 511, jj = j & 255; const float f = expf(-9.210340371976184f * (float)jj / 256.0f); const float a = (float)ii * f; tab[i] = j < 256 ? sinf(a) : cosf(a); }
}
__device__ void phase0(const Params& p, LAS unsigned char* lds) {
    constexpr int N_ADA = 96, N_WIN = 16 * 16, N_WFOUR = 8 * 4, N_SQ = 16 * 4, N_LRU = 16 * 2, N_WPQ = 64, N_DFT = 4096, N_POS = 1;
    constexpr int O1 = N_ADA, O2 = O1 + N_WIN, O3 = O2 + N_WFOUR, O4 = O3 + N_SQ, O5 = O4 + N_SQ, O6 = O5 + N_LRU, O7 = O6 + N_LRU, O8 = O7 + N_WPQ, O9 = O8 + N_DFT, O10 = O9 + N_POS;
    for (int it = blockIdx.x; it < O10; it += gridDim.x) {
        if (it < O1) p0_ada(p, lds, it);
        else if (it < O2) { const int j = it - O1; xpose_item<4>(p.w_in + 512, 4608, (bf16_t*)(p.ws + WS_WIN), 1024, (j >> 4) * 64, (j & 15) * 256, 0); }
        else if (it < O3) { const int j = it - O2; xpose_item<4>(p.w_four, 1024, (bf16_t*)(p.ws + WS_WFOUR), 512, (j >> 2) * 64, (j & 3) * 256, 0); }
        else if (it < O4) { const int j = it - O3; xpose_item<4>(p.w_lru, 1024, (bf16_t*)(p.ws + WS_WLRU), 1024, (j >> 2) * 64, (j & 3) * 256, 0); }
        else if (it < O5) { const int j = it - O4; xpose_item<4>(p.w_out, 1024, (bf16_t*)(p.ws + WS_WOUT), 1024, (j >> 2) * 64, (j & 3) * 256, 0); }
        else if (it < O6) { const int j = it - O5, mtx = j >> 1; xpose_item<2>(p.lru_wa + (size_t)mtx * 16384, 128, (bf16_t*)(p.ws + WS_WAT) + (size_t)mtx * 16384, 128, (j & 1) * 64, 0, 0); }
        else if (it < O7) { const int j = it - O6, mtx = j >> 1; xpose_item<2>(p.lru_wi + (size_t)mtx * 16384, 128, (bf16_t*)(p.ws + WS_WIT) + (size_t)mtx * 16384, 128, (j & 1) * 64, 0, 0); }
        else if (it < O8) p0_wpq(p, lds, it - O7);
        else if (it < O9) p0_dft_row(p, it - O8);
        else p0_pos(p);
    }
}

__device__ void phase1(const Params& p) {
    const int lane = threadIdx.x & 63, wid = threadIdx.x >> 6;
    const float* ada = (const float*)(p.ws + WS_ADA); const float* tab = (const float*)(p.ws + WS_POS);
    bf16_t* h1 = (bf16_t*)(p.ws + WS_R1); bf16_t* hc = (bf16_t*)(p.ws + WS_HCTX);
    for (int row = blockIdx.x * 8 + wid; row < MLAT + MCTX; row += gridDim.x * 8) {
        const bool lat = row < MLAT; const int rc = row - MLAT; const int t = row & 4095; const int mrow = lat ? (row >> 12) : 8;
        const float* xr = lat ? p.x + (size_t)row * 1024 : p.ctx + (size_t)rc * 1024;
        f32x4 v[4]; float ss = 0.f;
#pragma unroll
        for (int i = 0; i < 4; ++i) { const int d = 256 * i + 4 * lane; v[i] = *(const f32x4*)(xr + d);
            if (lat) v[i] += *(const f32x4*)(tab + (i < 2 ? (t >> 6) * 512 + d : (t & 63) * 512 + d - 512));
            ss += v[i][0] * v[i][0] + v[i][1] * v[i][1] + v[i][2] * v[i][2] + v[i][3] * v[i][3]; }
        ss = wave_sum(ss); const float rs = rsqrtf(ss * (1.0f / 1024.0f) + 1e-6f);
        bf16_t* dst = lat ? h1 + (size_t)row * 1024 : hc + (size_t)rc * 1024;
#pragma unroll
        for (int i = 0; i < 4; ++i) { const int d = 256 * i + 4 * lane;
            const f32x4 g = *(const f32x4*)(p.norm1_g + d), sh = *(const f32x4*)(ada + mrow * 6144 + d), sc = *(const f32x4*)(ada + mrow * 6144 + 1024 + d);
            const f32x4 h = v[i] * rs * g * (sc + 1.0f) + sh;
            u32x2 w; w.x = cvt_pk_bf16(h[0], h[1]); w.y = cvt_pk_bf16(h[2], h[3]); *(u32x2*)(dst + d) = w; }
    }
}

#define LRU_CST(mb, r) (32 * (mb) + 8 * ((r) >> 2) + ((r) & 3))
template <bool FINAL, int DIR>
__device__ __forceinline__ void lru_wave(const Params& p, LAS unsigned char* ul, int b, int sc, int head, int cb, int lane, f32x16 (&accI)[4]) {
    constexpr int SG = DIR ? -1 : 1;
    const int lr = lane & 31, lh = lane >> 5;
    const int chl = cb * 32 + lr, ch = head * 128 + chl;
    const int tbase = DIR ? 127 - 4 * lh : 4 * lh;
    f32x16 accA[4];
#pragma unroll
    for (int mb = 0; mb < 4; ++mb)
#pragma unroll
        for (int r = 0; r < 16; ++r) { accA[mb][r] = 0.f; accI[mb][r] = 0.f; }
    {
        const bf16_t* wa = (const bf16_t*)(p.ws + WS_WAT) + ((size_t)(DIR * 8 + head) * 128 + chl) * 128 + 8 * lh;
        const bf16_t* wi = (const bf16_t*)(p.ws + WS_WIT) + ((size_t)(DIR * 8 + head) * 128 + chl) * 128 + 8 * lh;
        LAS unsigned char* arow0 = ul + (DIR ? 127 - lr : lr) * 272 + lh * 16;
#pragma unroll
        for (int kc = 0; kc < 2; ++kc) { bf16x8 bA[4], bI[4];
#pragma unroll
            for (int k4 = 0; k4 < 4; ++k4) { bA[k4] = *(const bf16x8*)(wa + 16 * (kc * 4 + k4)); bI[k4] = *(const bf16x8*)(wi + 16 * (kc * 4 + k4)); }
#pragma unroll
            for (int mb = 0; mb < 4; ++mb)
#pragma unroll
                for (int k4 = 0; k4 < 4; ++k4) { const bf16x8 af = *(const LAS bf16x8*)(arow0 + SG * 32 * mb * 272 + 32 * (kc * 4 + k4));
                    accA[mb] = __builtin_amdgcn_mfma_f32_32x32x16_bf16(af, bA[k4], accA[mb], 0, 0, 0);
                    accI[mb] = __builtin_amdgcn_mfma_f32_32x32x16_bf16(af, bI[k4], accI[mb], 0, 0, 0); }
            __builtin_amdgcn_sched_barrier(0); }
    }
    {
        const float lam = p.lru_lambda[DIR * 1024 + ch]; const float sp8 = 8.0f * log1pf(expf(-lam));
        const float ba = p.lru_ba[DIR * 1024 + ch], bi = p.lru_bi[DIR * 1024 + ch];
        LAS unsigned char* up = ul + tbase * 272 + chl * 2;
#pragma unroll
        for (int mb = 0; mb < 4; ++mb) {
#pragma unroll
            for (int r = 0; r < 16; ++r) {
                const float uv = bf2f(*(const LAS bf16_t*)(up + SG * LRU_CST(mb, r) * 272));
                const float rg = sigmoidf_(accA[mb][r] + ba), ig = sigmoidf_(accI[mb][r] + bi);
                const float a = __expf(-sp8 * rg); accA[mb][r] = a; accI[mb][r] = sqrtf(fmaxf(1.0f - a * a, 0.f)) * ig * uv; }
            __builtin_amdgcn_sched_barrier(0); }
    }
    float rA[16], rH[16];
#pragma unroll
    for (int mb = 0; mb < 4; ++mb)
#pragma unroll
        for (int q = 0; q < 4; ++q) { float pa = 1.f, hh = 0.f;
#pragma unroll
            for (int j = 0; j < 4; ++j) { const int r = 4 * q + j; const float a = accA[mb][r], bb = accI[mb][r]; hh = a * hh + bb; pa *= a; accA[mb][r] = pa; accI[mb][r] = hh; }
            rA[mb * 4 + q] = pa; rH[mb * 4 + q] = hh; }
    const int agg_dir_off = ((b * NSEQ) * 2 + DIR) * 1024 + ch;
    const float* agg = (const float*)(p.ws + WS_AGG);
    float carry = 0.f;
    if (FINAL) {
        if (DIR == 0) { for (int q = 0; q < sc; ++q) { const float* a2 = agg + (size_t)(agg_dir_off + q * 2048) * 2; carry = a2[0] * carry + a2[1]; } }
        else { { const float* a2 = agg + (size_t)(agg_dir_off + 1 * 2048) * 2; carry = a2[0] * carry + a2[1]; } { const float* a2 = agg + (size_t)(agg_dir_off + 0 * 2048) * 2; carry = a2[0] * carry + a2[1]; }
            for (int q = NSEQ - 1; q > sc; --q) { const float* a2 = agg + (size_t)(agg_dir_off + q * 2048) * 2; carry = a2[0] * carry + a2[1]; } }
    }
    float cin[16];
#pragma unroll
    for (int i = 0; i < 16; ++i) cin[i] = 0.f;
    float s = carry, At = 1.f;
#pragma unroll
    for (int i = 0; i < 16; ++i) { const float oA = __shfl_xor(rA[i], 32), oH = __shfl_xor(rH[i], 32);
        { const bool mine = (lh == 0); const float a = mine ? rA[i] : oA, hh = mine ? rH[i] : oH; cin[i] = mine ? s : cin[i]; s = a * s + hh; At *= a; }
        { const bool mine = (lh == 1); const float a = mine ? rA[i] : oA, hh = mine ? rH[i] : oH; cin[i] = mine ? s : cin[i]; s = a * s + hh; At *= a; } }
    if (!FINAL) {
        if (lh == 0) { float* o = (float*)(p.ws + WS_AGG) + (size_t)(agg_dir_off + sc * 2048) * 2; o[0] = At; o[1] = s; }
        return;
    }
#pragma unroll
    for (int mb = 0; mb < 4; ++mb)
#pragma unroll
        for (int r = 0; r < 16; ++r) accI[mb][r] += accA[mb][r] * cin[mb * 4 + (r >> 2)];
}
template <bool FINAL>
__device__ void lru_tile(const Params& p, LAS unsigned char* lds, int item) {
    const int tid = threadIdx.x, lane = tid & 63, wid = __builtin_amdgcn_readfirstlane(tid >> 6);
    int b, sc, head;
    if (FINAL) { head = item & 7; sc = 2 + ((item >> 3) & 31); b = item >> 8; }
    else { head = item & 7; const int r = item >> 3; sc = r & 1; b = r >> 1; }
    const bf16_t* src; int Tseq, t0, ld;
    if (sc < 2) { src = (const bf16_t*)(p.ws + WS_ZXC) + (size_t)b * 256 * 1024; Tseq = 256; t0 = sc * 128; ld = 1024; }
    else { src = (const bf16_t*)(p.ws + WS_RZ) + (size_t)b * 4096 * 4096; Tseq = 4096; t0 = (sc - 2) * 128; ld = 4096; }
    LAS unsigned char* ul = lds;
    LAS float* ybuf = (LAS float*)(lds + 36 * 1024);
    {
        const int c8 = tid & 15, tb = tid >> 4; const int ch0 = head * 128 + 8 * c8;
        float w[4][8], bias[8];
#pragma unroll
        for (int k = 0; k < 4; ++k) { const f32x4 a = *(const f32x4*)(p.conv_w + k * 1024 + ch0), c2 = *(const f32x4*)(p.conv_w + k * 1024 + ch0 + 4);
#pragma unroll
            for (int j = 0; j < 4; ++j) { w[k][j] = a[j]; w[k][4 + j] = c2[j]; } }
        { const f32x4 a = *(const f32x4*)(p.conv_b + ch0), c2 = *(const f32x4*)(p.conv_b + ch0 + 4);
#pragma unroll
            for (int j = 0; j < 4; ++j) { bias[j] = a[j]; bias[4 + j] = c2[j]; } }
#pragma unroll
        for (int i = 0; i < 4; ++i) { const int t = tb + 32 * i; float a[8];
#pragma unroll
            for (int j = 0; j < 8; ++j) a[j] = bias[j];
#pragma unroll
            for (int k = 0; k < 4; ++k) { const int tt = t0 + t + k - 2;
                if (tt >= 0 && tt < Tseq) { float f[8]; unpack8(*(const u32x4*)(src + (size_t)tt * ld + ch0), f);
#pragma unroll
                    for (int j = 0; j < 8; ++j) a[j] += w[k][j] * f[j]; } }
            u32x4 wv; wv.x = cvt_pk_bf16(a[0], a[1]); wv.y = cvt_pk_bf16(a[2], a[3]); wv.z = cvt_pk_bf16(a[4], a[5]); wv.w = cvt_pk_bf16(a[6], a[7]);
            *(LAS u32x4*)(ul + t * 272 + c8 * 16) = wv; }
    }
    __syncthreads();
    f32x16 hacc[4];
    if (wid < 4) lru_wave<FINAL, 0>(p, ul, b, sc, head, wid & 3, lane, hacc);
    else lru_wave<FINAL, 1>(p, ul, b, sc, head, wid & 3, lane, hacc);
    if (FINAL) {
        const int lr = lane & 31, lh = lane >> 5, chl = (wid & 3) * 32 + lr;
        if (wid >= 4) { LAS float* yp = ybuf + (127 - 4 * lh) * 129 + chl;
#pragma unroll
            for (int mb = 0; mb < 4; ++mb)
#pragma unroll
                for (int r = 0; r < 16; ++r) yp[-LRU_CST(mb, r) * 129] = hacc[mb][r]; }
        __syncthreads();
        if (wid < 4) {
            const LAS float* yp = ybuf + (4 * lh) * 129 + chl;
            const bf16_t* Zu = (const bf16_t*)(p.ws + WS_RZ) + ((size_t)(b * 4096 + t0) * 4096 + 1024 + head * 128);
            bf16_t* Ou = (bf16_t*)(p.ws + WS_R1) + ((size_t)(b * 4096 + t0) * 1024 + head * 128);
            const unsigned zo = (unsigned)(4 * lh * 4096 + chl), oo = (unsigned)(4 * lh * 1024 + chl);
#pragma unroll
            for (int mb = 0; mb < 4; ++mb) {
#pragma unroll
                for (int r = 0; r < 16; ++r) {
                    const float y = hacc[mb][r] + yp[LRU_CST(mb, r) * 129];
                    const float gz = bf2f(Zu[zo + LRU_CST(mb, r) * 4096]);
                    Ou[oo + LRU_CST(mb, r) * 1024] = (bf16_t)(cvt_pk_bf16(gz * y, 0.f) & 0xffffu);
                    if ((r & 7) == 7) __builtin_amdgcn_sched_barrier(0); } }
        }
    }
    __syncthreads();
}

typedef unsigned long long u64_t;
template <int DIR>
__device__ __forceinline__ void lru2_dir(const Params& p, LAS unsigned char* ul, int head, int w, int lane, f32x4 (&hl)[8], f32x4 (&pp)[8], float& Atot, float& Htot) {
    constexpr int SG = DIR ? -1 : 1;
    const int fr = lane & 15, fq = lane >> 4, chl = 16 * w + fr, ch = head * 128 + chl;
    f32x4 accA[8], accI[8];
#pragma unroll
    for (int rb = 0; rb < 8; ++rb) { accA[rb] = (f32x4){0.f, 0.f, 0.f, 0.f}; accI[rb] = (f32x4){0.f, 0.f, 0.f, 0.f}; }
    {
        const bf16_t* wa = (const bf16_t*)(p.ws + WS_WAT) + ((size_t)(DIR * 8 + head) * 128 + chl) * 128 + 8 * fq;
        const bf16_t* wi = (const bf16_t*)(p.ws + WS_WIT) + ((size_t)(DIR * 8 + head) * 128 + chl) * 128 + 8 * fq;
        bf16x8 bA[4], bI[4];
#pragma unroll
        for (int ks = 0; ks < 4; ++ks) { bA[ks] = *(const bf16x8*)(wa + 32 * ks); bI[ks] = *(const bf16x8*)(wi + 32 * ks); }
        LAS unsigned char* arow0 = ul + (DIR ? 127 - fr : fr) * 272 + fq * 16;
#pragma unroll
        for (int rb = 0; rb < 8; ++rb)
#pragma unroll
            for (int ks = 0; ks < 4; ++ks) { const bf16x8 af = *(const LAS bf16x8*)(arow0 + SG * 16 * rb * 272 + 64 * ks);
                accA[rb] = __builtin_amdgcn_mfma_f32_16x16x32_bf16(af, bA[ks], accA[rb], 0, 0, 0);
                accI[rb] = __builtin_amdgcn_mfma_f32_16x16x32_bf16(af, bI[ks], accI[rb], 0, 0, 0); }
    }
    {
        const float lam = p.lru_lambda[DIR * 1024 + ch]; const float sp8 = 8.0f * log1pf(expf(-lam));
        const float ba = p.lru_ba[DIR * 1024 + ch], bi = p.lru_bi[DIR * 1024 + ch];
        LAS unsigned char* up = ul + (DIR ? 127 - 4 * fq : 4 * fq) * 272 + chl * 2;
#pragma unroll
        for (int rb = 0; rb < 8; ++rb)
#pragma unroll
            for (int r = 0; r < 4; ++r) {
                const float uv = bf2f(*(const LAS bf16_t*)(up + SG * (16 * rb + r) * 272));
                const float rg = sigmoidf_(accA[rb][r] + ba), ig = sigmoidf_(accI[rb][r] + bi);
                const float a = __expf(-sp8 * rg); accA[rb][r] = a; accI[rb][r] = sqrtf(fmaxf(1.0f - a * a, 0.f)) * ig * uv;
                if (r == 3 && (rb & 1)) __builtin_amdgcn_sched_barrier(0); }
    }
    float rA[8], rH[8];
#pragma unroll
    for (int rb = 0; rb < 8; ++rb) { float pa = 1.f, hh = 0.f;
#pragma unroll
        for (int r = 0; r < 4; ++r) { const float a = accA[rb][r], bb = accI[rb][r]; hh = a * hh + bb; pa *= a; accA[rb][r] = pa; accI[rb][r] = hh; }
        rA[rb] = pa; rH[rb] = hh; }
    float Pc = 1.f, s = 0.f;
#pragma unroll
    for (int rb = 0; rb < 8; ++rb) { float Pin = 1.f, Hin = 0.f;
#pragma unroll
        for (int q = 0; q < 4; ++q) { const float a = __shfl(rA[rb], fr + 16 * q), hh = __shfl(rH[rb], fr + 16 * q);
            if (q == fq) { Pin = Pc; Hin = s; }
            s = a * s + hh; Pc *= a; }
#pragma unroll
        for (int r = 0; r < 4; ++r) { hl[rb][r] = accI[rb][r] + accA[rb][r] * Hin; pp[rb][r] = accA[rb][r] * Pin; }
        __builtin_amdgcn_sched_barrier(0); }
    Atot = Pc; Htot = s;
}
__device__ __forceinline__ u64_t agg_ld(const u64_t* a) { return __hip_atomic_load(a, __ATOMIC_RELAXED, __HIP_MEMORY_SCOPE_AGENT); }
template <int DIR>
__device__ __forceinline__ float lru2_carry(const u64_t* aggc, int n, int fr, int fq) {
    float Ap = 1.f, Hp = 0.f; u64_t v[9];
#pragma unroll
    for (int k = 0; k < 9; ++k) { const int j = fq * 9 + k; const int seq = DIR ? (j == 0 ? 1 : (j == 1 ? 0 : 35 - j)) : j;
        v[k] = (j < n) ? agg_ld(aggc + (size_t)seq * 2048) : 0x000000003f800000ull; }
#pragma unroll
    for (int k = 0; k < 9; ++k) { const float a = __uint_as_float((unsigned)v[k]), hh = __uint_as_float((unsigned)(v[k] >> 32)); Hp = a * Hp + hh; Ap *= a; }
    float s = 0.f;
#pragma unroll
    for (int q = 0; q < 4; ++q) { const float a = __shfl(Ap, fr + 16 * q), hh = __shfl(Hp, fr + 16 * q); s = a * s + hh; }
    return s;
}
__device__ void lru2_tile(const Params& p, LAS unsigned char* lds, int g, int c, unsigned* gcnt) {
    const int tid = threadIdx.x, lane = tid & 63, wid = __builtin_amdgcn_readfirstlane(tid >> 6);
    const int b = g >> 3, head = g & 7, sc = c + 2, t0 = c * 128;
    LAS unsigned char* raw = lds;
    LAS unsigned char* ul = lds + 33792;
    LAS unsigned char* gzl = lds + 68608;
    LAS unsigned char* outl = lds + 103424;
    const bf16_t* Zb = (const bf16_t*)(p.ws + WS_RZ) + (size_t)b * 4096 * 4096 + head * 128;
#pragma unroll
    for (int k = 0; k < 5; ++k) { const int pc = tid + NTHR * k;
        if (pc < 131 * 16) { const int row = pc >> 4, c8 = pc & 15, tt = t0 - 2 + row; u32x4 v = (u32x4){0u, 0u, 0u, 0u};
            if (tt >= 0 && tt < TT) v = *(const u32x4*)(Zb + (size_t)tt * 4096 + c8 * 8);
            *(LAS u32x4*)(raw + row * 256 + c8 * 16) = v; } }
#pragma unroll
    for (int k = 0; k < 4; ++k) { const int pc = tid + NTHR * k, row = pc >> 4, c8 = pc & 15;
        *(LAS u32x4*)(gzl + row * 272 + c8 * 16) = *(const u32x4*)(Zb + (size_t)(t0 + row) * 4096 + 1024 + c8 * 8); }
    __syncthreads();
    {
        const int c8 = tid & 15, tb = tid >> 4; const int ch0 = head * 128 + 8 * c8;
        float w[4][8], bias[8];
#pragma unroll
        for (int k = 0; k < 4; ++k) { const f32x4 a = *(const f32x4*)(p.conv_w + k * 1024 + ch0), c2 = *(const f32x4*)(p.conv_w + k * 1024 + ch0 + 4);
#pragma unroll
            for (int j = 0; j < 4; ++j) { w[k][j] = a[j]; w[k][4 + j] = c2[j]; } }
        { const f32x4 a = *(const f32x4*)(p.conv_b + ch0), c2 = *(const f32x4*)(p.conv_b + ch0 + 4);
#pragma unroll
            for (int j = 0; j < 4; ++j) { bias[j] = a[j]; bias[4 + j] = c2[j]; } }
#pragma unroll
        for (int i = 0; i < 4; ++i) { const int t = tb + 32 * i; float a[8];
#pragma unroll
            for (int j = 0; j < 8; ++j) a[j] = bias[j];
#pragma unroll
            for (int k = 0; k < 4; ++k) { float f[8]; unpack8(*(const LAS u32x4*)(raw + (t + k) * 256 + c8 * 16), f);
#pragma unroll
                for (int j = 0; j < 8; ++j) a[j] += w[k][j] * f[j]; }
            u32x4 wv; wv.x = cvt_pk_bf16(a[0], a[1]); wv.y = cvt_pk_bf16(a[2], a[3]); wv.z = cvt_pk_bf16(a[4], a[5]); wv.w = cvt_pk_bf16(a[6], a[7]);
            *(LAS u32x4*)(ul + t * 272 + c8 * 16) = wv; }
    }
    __syncthreads();
    const int fr = lane & 15, fq = lane >> 4, chl = 16 * wid + fr, ch = head * 128 + chl;
    float A0, H0, A1, H1;
    {
        f32x4 hl1[8], pp1[8];
        lru2_dir<1>(p, ul, head, wid, lane, hl1, pp1, A1, H1);
        LAS unsigned char* hp = outl + (127 - 4 * fq) * 272 + chl * 2; LAS unsigned char* qp = raw + (127 - 4 * fq) * 256 + chl * 2;
#pragma unroll
        for (int rb = 0; rb < 8; ++rb)
#pragma unroll
            for (int r = 0; r < 4; ++r) { *(LAS bf16_t*)(hp - (16 * rb + r) * 272) = (bf16_t)(cvt_pk_bf16(hl1[rb][r], 0.f) & 0xffffu); *(LAS bf16_t*)(qp - (16 * rb + r) * 256) = (bf16_t)(cvt_pk_bf16(pp1[rb][r], 0.f) & 0xffffu); }
    }
    __builtin_amdgcn_sched_barrier(0);
    f32x4 hl0[8], pp0[8];
    lru2_dir<0>(p, ul, head, wid, lane, hl0, pp0, A0, H0);
    u64_t* agg = (u64_t*)(p.ws + WS_AGG);
    const size_t ai0 = ((size_t)(b * NSEQ) * 2 + 0) * 1024 + ch, ai1 = ((size_t)(b * NSEQ) * 2 + 1) * 1024 + ch;
    if (fq == 0) {
        __hip_atomic_store(agg + ai0 + (size_t)sc * 2048, ((u64_t)__float_as_uint(H0) << 32) | __float_as_uint(A0), __ATOMIC_RELAXED, __HIP_MEMORY_SCOPE_AGENT);
        __hip_atomic_store(agg + ai1 + (size_t)sc * 2048, ((u64_t)__float_as_uint(H1) << 32) | __float_as_uint(A1), __ATOMIC_RELAXED, __HIP_MEMORY_SCOPE_AGENT); }
    asm volatile("s_waitcnt vmcnt(0)" ::: "memory");
    __syncthreads();
    if (tid == 0) (void)__hip_atomic_fetch_add(gcnt, 1u, __ATOMIC_RELAXED, __HIP_MEMORY_SCOPE_AGENT);
    if (wid == 0) { unsigned sp = 0;
        while ((unsigned)__builtin_amdgcn_readfirstlane(__hip_atomic_load(gcnt, __ATOMIC_RELAXED, __HIP_MEMORY_SCOPE_AGENT)) < 32u) { __builtin_amdgcn_s_sleep(1); if (++sp > (1u << 22)) break; }
        __builtin_amdgcn_fence(__ATOMIC_ACQUIRE, "agent");
        asm volatile("s_waitcnt vmcnt(0)" ::: "memory"); }
    __syncthreads();
    const float C0 = lru2_carry<0>(agg + ai0, sc, fr, fq);
    const float C1 = lru2_carry<1>(agg + ai1, 2 + (NSEQ - 1 - sc), fr, fq);
    LAS unsigned char* gp = gzl + (4 * fq) * 272 + chl * 2; LAS unsigned char* op = outl + (4 * fq) * 272 + chl * 2; LAS unsigned char* qp0 = raw + (4 * fq) * 256 + chl * 2;
#pragma unroll
    for (int rb = 0; rb < 8; ++rb)
#pragma unroll
        for (int r = 0; r < 4; ++r) { const float h1 = bf2f(*(const LAS bf16_t*)(op + (16 * rb + r) * 272)) + bf2f(*(const LAS bf16_t*)(qp0 + (16 * rb + r) * 256)) * C1;
            const float y = hl0[rb][r] + pp0[rb][r] * C0 + h1;
            const float gz = bf2f(*(const LAS bf16_t*)(gp + (16 * rb + r) * 272));
            *(LAS bf16_t*)(op + (16 * rb + r) * 272) = (bf16_t)(cvt_pk_bf16(gz * y, 0.f) & 0xffffu); }
    __syncthreads();
    bf16_t* Ob = (bf16_t*)(p.ws + WS_R1) + ((size_t)(b * 4096 + t0)) * 1024 + head * 128;
#pragma unroll
    for (int k = 0; k < 4; ++k) { const int pc = tid + NTHR * k, row = pc >> 4, c8 = pc & 15;
        *(u32x4*)(Ob + (size_t)row * 1024 + c8 * 8) = *(const LAS u32x4*)(outl + row * 272 + c8 * 16); }
    __syncthreads();
}

__device__ void phase7_rows(const Params& p, LAS unsigned char* lds) {
    const int tid = threadIdx.x, lane = tid & 63, wid = tid >> 6;
    LAS float* wrt = (LAS float*)lds;
    for (int i = tid; i < 16 * 1024; i += NTHR) { const int d = i >> 4, e = i & 15; wrt[e * 1024 + d] = p.w_router[i]; }
    __syncthreads();
    const float* ada = (const float*)(p.ws + WS_ADA); bf16_t* h2 = (bf16_t*)(p.ws + WS_R1); float* scores = (float*)(p.ws + WS_SCORES);
    for (int row = blockIdx.x * 8 + wid; row < MLAT; row += gridDim.x * 8) {
        const int b = row >> 12, t = row & 4095; const float* xr = p.out + (size_t)row * 1024;
        f32x4 v[4]; float ss = 0.f;
#pragma unroll
        for (int i = 0; i < 4; ++i) { v[i] = *(const f32x4*)(xr + 256 * i + 4 * lane); ss += v[i][0] * v[i][0] + v[i][1] * v[i][1] + v[i][2] * v[i][2] + v[i][3] * v[i][3]; }
        ss = wave_sum(ss); const float rs = rsqrtf(ss * (1.0f / 1024.0f) + 1e-6f);
#pragma unroll
        for (int i = 0; i < 4; ++i) { const int d = 256 * i + 4 * lane;
            const f32x4 g = *(const f32x4*)(p.norm2_g + d), sh = *(const f32x4*)(ada + b * 6144 + 3072 + d), sc = *(const f32x4*)(ada + b * 6144 + 4096 + d);
            v[i] = v[i] * rs * g * (sc + 1.0f) + sh;
            u32x2 w; w.x = cvt_pk_bf16(v[i][0], v[i][1]); w.y = cvt_pk_bf16(v[i][2], v[i][3]); *(u32x2*)(h2 + (size_t)row * 1024 + d) = w; }
        float lg[16];
#pragma unroll
        for (int e = 0; e < 16; ++e) { float a = 0.f;
#pragma unroll
            for (int i = 0; i < 4; ++i) { const f32x4 w = *(const LAS f32x4*)(wrt + e * 1024 + 256 * i + 4 * lane); a += v[i][0] * w[0] + v[i][1] * w[1] + v[i][2] * w[2] + v[i][3] * w[3]; }
            lg[e] = wave_sum(a); }
        float mx = lg[0];
#pragma unroll
        for (int e = 1; e < 16; ++e) mx = fmaxf(mx, lg[e]);
        float sum = 0.f;
#pragma unroll
        for (int e = 0; e < 16; ++e) { lg[e] = expf(lg[e] - mx); sum += lg[e]; }
        const float inv = 1.0f / sum; float mine = 0.f;
#pragma unroll
        for (int e = 0; e < 16; ++e) mine = (lane == e) ? lg[e] * inv : mine;
        if (lane < 16) scores[((size_t)b * 16 + lane) * 4096 + t] = mine;
    }
    __syncthreads();
}
__device__ void phase7_weights(const Params& p) {
    constexpr int N_G = 16 * 16 * 6, N_D = 16 * 24 * 4;
    for (int it = blockIdx.x; it < 2 * N_G + N_D; it += gridDim.x) {
        if (it < 2 * N_G) { const int up = it >= N_G, j = up ? it - N_G : it, e = j / 96, r = j % 96, kb = r / 6, nb = r % 6;
            xpose_item<4>((up ? p.w_up_e : p.w_gate_e) + (size_t)e * 1024 * 1536, 1536, (bf16_t*)(p.ws + WS_WGU) + (size_t)e * 3072 * 1024, 1024, kb * 64, nb * 256, up ? 2 : 1); }
        else { const int j = it - 2 * N_G, e = j / 96, r = j % 96, kb = r >> 2, nb = r & 3;
            xpose_item<4>(p.w_down_e + (size_t)e * 1536 * 1024, 1024, (bf16_t*)(p.ws + WS_WD) + (size_t)e * 1024 * 1536, 1536, kb * 64, nb * 256, 0); }
    }
}

__device__ void phase8_topk(const Params& p, LAS unsigned char* lds) {
    const int tid = threadIdx.x, lane = tid & 63, wid = tid >> 6;
    LAS unsigned* cnt = (LAS unsigned*)lds;
    LAS unsigned* wsum = cnt + 16;
    const float* scores = (const float*)(p.ws + WS_SCORES);
    int* idx = (int*)(p.ws + WS_IDX); float* gate = (float*)(p.ws + WS_GATE); int* slot_of = (int*)(p.ws + WS_SLOT);
    for (int it = blockIdx.x; it < NB * NE; it += gridDim.x) {
        const int b = it >> 4, e = it & 15;
        unsigned key[8];
        { const u32x4* sp = (const u32x4*)(scores + (size_t)it * 4096 + tid * 8); const u32x4 a = sp[0], c2 = sp[1]; key[0] = a.x; key[1] = a.y; key[2] = a.z; key[3] = a.w; key[4] = c2.x; key[5] = c2.y; key[6] = c2.z; key[7] = c2.w; }
        unsigned thr = 0;
        for (int bit = 30; bit >= 0; --bit) {
            const unsigned cand = thr | (1u << bit); unsigned c = 0;
#pragma unroll
            for (int j = 0; j < 8; ++j) c += (unsigned)__popcll(__ballot(key[j] >= cand));
            LAS unsigned* cb = cnt + (bit & 1) * 8;
            if (lane == 0) cb[wid] = c;
            __syncthreads();
            unsigned tot = 0;
#pragma unroll
            for (int w = 0; w < 8; ++w) tot += cb[w];
            if (tot >= (unsigned)CAP) thr = cand;
        }
        unsigned cg_ = 0, ce = 0;
#pragma unroll
        for (int j = 0; j < 8; ++j) { cg_ += key[j] > thr; ce += key[j] == thr; }
        unsigned pk = cg_ | (ce << 16), incl = pk;
#pragma unroll
        for (int o = 1; o < 64; o <<= 1) { const unsigned n = __shfl_up(incl, o); if (lane >= o) incl += n; }
        if (lane == 63) wsum[wid] = incl;
        __syncthreads();
        unsigned base = 0, total = 0;
#pragma unroll
        for (int w = 0; w < 8; ++w) { const unsigned s = wsum[w]; if (w < wid) base += s; total += s; }
        const unsigned excl = base + incl - pk; unsigned og = excl & 0xffffu, oe = excl >> 16; const unsigned ngt = total & 0xffffu, krem = (unsigned)CAP - ngt;
#pragma unroll
        for (int j = 0; j < 8; ++j) { const int t = tid * 8 + j; int m = -1;
            if (key[j] > thr) { m = (e * 8 + b) * 512 + (int)og; ++og; }
            else if (key[j] == thr) { if (oe < krem) m = (e * 8 + b) * 512 + (int)(ngt + oe); ++oe; }
            slot_of[((size_t)b * 4096 + t) * 16 + e] = m;
            if (m >= 0) { idx[m] = b * 4096 + t; gate[m] = __uint_as_float(key[j]); } }
        __syncthreads();
    }
}

__device__ void phase11(const Params& p, float* dst) {
    const int lane = threadIdx.x & 63, wid = threadIdx.x >> 6;
    const float* ada = (const float*)(p.ws + WS_ADA); const int* slot_of = (const int*)(p.ws + WS_SLOT); const bf16_t* oute = (const bf16_t*)(p.ws + WS_OUTE);
    const int stride = gridDim.x * 8;
    int row = blockIdx.x * 8 + wid;
    int myslot = row < MLAT ? slot_of[(size_t)row * 16 + (lane & 15)] : -1;
    for (; row < MLAT; row += stride) {
        const int b = row >> 12; float* xr = p.out + (size_t)row * 1024;
        const int nrow = row + stride; const int nslot = nrow < MLAT ? slot_of[(size_t)nrow * 16 + (lane & 15)] : -1;
        f32x4 xv[4];
#pragma unroll
        for (int i = 0; i < 4; ++i) xv[i] = *(const f32x4*)(xr + 256 * i + 4 * lane);
        f32x4 acc[4];
#pragma unroll
        for (int i = 0; i < 4; ++i) acc[i] = (f32x4){0.f, 0.f, 0.f, 0.f};
        unsigned long long mask = __ballot(myslot >= 0) & 0xffffull;
        while (mask) {
            int m[4];
#pragma unroll
            for (int j = 0; j < 4; ++j) { if (mask) { const int e = __builtin_ctzll(mask); mask &= mask - 1; m[j] = __builtin_amdgcn_readlane(myslot, e); } else m[j] = MMOE; }
            u32x2 w[4][4];
#pragma unroll
            for (int j = 0; j < 4; ++j)
#pragma unroll
                for (int i = 0; i < 4; ++i) w[j][i] = *(const u32x2*)(oute + (size_t)m[j] * 1024 + 256 * i + 4 * lane);
#pragma unroll
            for (int j = 0; j < 4; ++j)
#pragma unroll
                for (int i = 0; i < 4; ++i) { acc[i][0] += bf_lo(w[j][i].x); acc[i][1] += bf_hi(w[j][i].x); acc[i][2] += bf_lo(w[j][i].y); acc[i][3] += bf_hi(w[j][i].y); }
        }
        f32x4 v[4]; float ss = 0.f;
#pragma unroll
        for (int i = 0; i < 4; ++i) { const int d = 256 * i + 4 * lane; const f32x4 g2 = *(const f32x4*)(ada + b * 6144 + 5120 + d); v[i] = xv[i] + g2 * acc[i];
            ss += v[i][0] * v[i][0] + v[i][1] * v[i][1] + v[i][2] * v[i][2] + v[i][3] * v[i][3]; }
        ss = wave_sum(ss); const float rs = rsqrtf(ss * (1.0f / 1024.0f) + 1e-6f);
#pragma unroll
        for (int i = 0; i < 4; ++i) { const int d = 256 * i + 4 * lane; *(f32x4*)(dst + (size_t)row * 1024 + d) = v[i] * rs * *(const f32x4*)(p.final_g + d); }
        myslot = nslot;
    }
}

#define XB_TMO      128
#define XB_XCNT(j)  (256  + 64 * (j))
#define XB_XSUB(j)  (1280 + 64 * (j))
#define XB_XGEN(j)  (2304 + 64 * (j))
#define XB_TOP      3328
#define XB_TOPGEN   3392
#define XCD_BAR_WORDS 3456
#define XB_SPIN_CAP (1u << 22)
__device__ __forceinline__ unsigned xb_ld(unsigned* p)              { return __hip_atomic_load(p, __ATOMIC_RELAXED, __HIP_MEMORY_SCOPE_AGENT); }
__device__ __forceinline__ unsigned xb_add(unsigned* p, unsigned v) { return __hip_atomic_fetch_add(p, v, __ATOMIC_RELAXED, __HIP_MEMORY_SCOPE_AGENT); }
__device__ __forceinline__ unsigned xb_xcc_id() { return (unsigned)__builtin_amdgcn_s_getreg((3 << 11) | 20) & 0xFu; }
#define XB_SPIN(cond, bar) do { unsigned _sp = 0; while (cond) { __builtin_amdgcn_s_sleep(1); \
    if ((++_sp & 255u) == 0u) { if (xb_ld(&(bar)[XB_TMO])) break; if (_sp > XB_SPIN_CAP) { atomicAdd(&(bar)[XB_TMO], 1u); break; } } } } while (0)
struct XcdBarrier { unsigned* bar; unsigned x; volatile LAS unsigned* st; };
__device__ __forceinline__ XcdBarrier xcd_barrier_post(unsigned* bar, volatile LAS unsigned* st) {
    XcdBarrier b; b.bar = bar; b.x = xb_xcc_id(); b.st = st;
    if (threadIdx.x == 0) (void)xb_add(&bar[XB_XCNT(b.x)], 1u);
    return b;
}
__device__ __forceinline__ void xcd_barrier_complete(unsigned* bar, unsigned x, unsigned& nloc, unsigned& nx) {
    const unsigned G = gridDim.x * gridDim.y * gridDim.z;
    unsigned sum, cnt, mine, sp = 0u;
    for (;;) {
        sum = 0u; cnt = 0u; mine = 0u;
#pragma unroll
        for (unsigned j = 0; j < 16; ++j) { const unsigned c = xb_ld(&bar[XB_XCNT(j)]); sum += c; cnt += (c > 0u) ? 1u : 0u; mine = (j == x) ? c : mine; }
        if (sum == G) break;
        __builtin_amdgcn_s_sleep(1);
        if ((++sp & 255u) == 0u) { if (xb_ld(&bar[XB_TMO])) break; if (sp > XB_SPIN_CAP) { atomicAdd(&bar[XB_TMO], 1u); break; } }
    }
    nloc = mine > 0u ? mine : 1u; nx = cnt > 0u ? cnt : 1u;
}
__device__ __forceinline__ void xcd_barrier(const XcdBarrier& b) {
    asm volatile("s_waitcnt vmcnt(0)" ::: "memory");
    __syncthreads();
    if (threadIdx.x == 0) {
        unsigned* bar = b.bar;
        __builtin_amdgcn_s_waitcnt(0);
        unsigned nloc = b.st[0], nx = b.st[1];
        if (nloc == 0u) { xcd_barrier_complete(bar, b.x, nloc, nx); b.st[0] = nloc; b.st[1] = nx; }
        const unsigned old = xb_add(&bar[XB_XSUB(b.x)], 1u);
        const unsigned gen = old / nloc;
        if (old + 1u == (gen + 1u) * nloc) {
            __builtin_amdgcn_fence(__ATOMIC_RELEASE, "agent");
            asm volatile("s_waitcnt vmcnt(0)" ::: "memory");
            const unsigned og = xb_add(&bar[XB_TOP], 1u);
            const unsigned tg = og / nx;
            if (og + 1u == (tg + 1u) * nx) xb_add(&bar[XB_TOPGEN], 1u);
            else XB_SPIN(xb_ld(&bar[XB_TOPGEN]) == tg, bar);
            __builtin_amdgcn_fence(__ATOMIC_ACQUIRE, "agent");
            xb_add(&bar[XB_XGEN(b.x)], 1u);
            asm volatile("s_waitcnt vmcnt(0)" ::: "memory");
        } else {
            XB_SPIN(xb_ld(&bar[XB_XGEN(b.x)]) == gen, bar);
            __builtin_amdgcn_fence(__ATOMIC_ACQUIRE, "agent");
            asm volatile("s_waitcnt vmcnt(0)" ::: "memory");
        }
    }
    __syncthreads();
}

__global__ void __launch_bounds__(NTHR, 2) fwd_megakernel(Params p) {
    extern __shared__ __attribute__((aligned(16))) unsigned char lds_raw[];
    LAS unsigned char* lds = (LAS unsigned char*)lds_raw;
    cg::grid_group grid = cg::this_grid();
    const int G = gridDim.x, bid = blockIdx.x;
    unsigned char* ws = p.ws;
    bf16_t* const R1 = (bf16_t*)(ws + WS_R1); bf16_t* const Zb = (bf16_t*)(ws + WS_RZ); bf16_t* const PQt = (bf16_t*)(ws + WS_RPQ); bf16_t* const MRG = (bf16_t*)(ws + WS_R2);
    bf16_t* const Fb = (bf16_t*)((unsigned char*)p.out + OUT_F); const bf16_t* const DFT = (const bf16_t*)((unsigned char*)p.out + OUT_DFT);
#ifdef ONLY_PH
#define PH(k) ((k) == ONLY_PH && p.ph_lo <= (k) && (k) < p.ph_hi)
#else
#define PH(k) (p.ph_lo <= (k) && (k) < p.ph_hi)
#endif
    volatile LAS unsigned* xst = (volatile LAS unsigned*)(lds + LDS_BYTES - 16);
    if (threadIdx.x < 4) xst[threadIdx.x] = 0u;
    __syncthreads();
    XcdBarrier xbar = xcd_barrier_post((unsigned*)(ws + WS_BAR), xst);
#define SYNC(k) do { if (PH(k) && PH((k) + 1)) { if ((k) == 0) grid.sync(); else xcd_barrier(xbar); } } while (0)
#ifndef REPMASK
#define REPMASK 0
#endif
#define REP(k) for (int rep_ = 0; rep_ <= ((REPMASK >> (k)) & 1); ++rep_)
    if (PH(0)) REP(0) phase0(p, lds);
    SYNC(0);
    if (PH(1)) REP(1) phase1(p);
    SYNC(1);
    if (PH(2)) REP(2) {
        { ProbPlain pr{(const bf16_t*)(ws + WS_WPQ), R1, 1024, 1024, 1024}; pg8::Order S; S.init(4, 128, G, bid); EpiPQ E{PQt}; pg8::gemm_phase(lds, pr, S, E); }
        { ProbPlain pr{R1, (const bf16_t*)(ws + WS_WIN), 1024, 1024, 1024}; pg8::Order S; S.init(128, 16, G, bid); EpiZ E{Zb, 4096, -1}; pg8::gemm_phase(lds, pr, S, E); }
        { ProbPlain pr{(const bf16_t*)(ws + WS_HCTX), (const bf16_t*)(ws + WS_WIN), 1024, 1024, 1024}; pg8::Order S; S.init(8, 4, G, bid); EpiZ E{(bf16_t*)(ws + WS_ZXC), 1024, 0}; pg8::gemm_phase(lds, pr, S, E); }
    }
    SYNC(2);
    if (PH(3)) REP(3) {
        { ProbPlain pr{DFT, PQt, 8192, 8192, 8192}; pg8::Order S; S.init(16, 16, G, bid); EpiF E{Fb}; pg8::gemm_phase(lds, pr, S, E); }
        for (int it = bid; it < NB * 2 * 8; it += G) lru_tile<false>(p, lds, it);
    }
    SYNC(3);
    if (PH(4)) {
        const int ngr = G >> 5;
        if (ngr > 0 && bid < ngr * 32) { const int slot = bid % ngr, c = bid / ngr;
            for (int g = slot; g < NB * 8; g += ngr) lru2_tile(p, lds, g, c, (unsigned*)(ws + WS_BAR + 16 * KiB) + g * 64); }
    }
    SYNC(4);
    if (PH(5)) REP(5) {
        { ProbPlain pr{Fb, (const bf16_t*)(ws + WS_WFOUR), 512, 512, 512}; pg8::Order S; S.init(128, 4, G, bid); EpiY1 E{MRG, Zb}; pg8::gemm_phase(lds, pr, S, E); }
        { ProbPlain pr{R1, (const bf16_t*)(ws + WS_WLRU), 1024, 1024, 1024}; pg8::Order S; S.init(128, 4, G, bid); EpiY2 E{MRG, Zb}; pg8::gemm_phase(lds, pr, S, E); }
    }
    SYNC(5);
    if (PH(6)) REP(6) { ProbPlain pr{MRG, (const bf16_t*)(ws + WS_WOUT), 1024, 1024, 1024}; pg8::Order S; S.init(128, 4, G, bid);
        EpiOut E{p.out, p.x, (const float*)(ws + WS_POS), (const float*)(ws + WS_ADA)}; pg8::gemm_phase(lds, pr, S, E); }
    SYNC(6);
    if (PH(7)) REP(7) { phase7_rows(p, lds); phase7_weights(p); }
    SYNC(7);
    if (PH(8)) REP(8) phase8_topk(p, lds);
    SYNC(8);
    if (PH(9)) REP(9) { ProbMoeUp pr{R1, (const bf16_t*)(ws + WS_WGU), (const int*)(ws + WS_IDX), 1024, 1024, 1024}; pg8::Order S; S.init(256, 12, G, bid); EpiGU E{(bf16_t*)(ws + WS_HID)}; pg8::gemm_phase(lds, pr, S, E); }
    SYNC(9);
    if (PH(10)) { if (bid == 0 && threadIdx.x < 128) *(u32x4*)(ws + WS_OUTE + (size_t)MMOE * 2048 + threadIdx.x * 16) = (u32x4){0u, 0u, 0u, 0u}; }
    if (PH(10)) REP(10) { ProbMoeDown pr{(const bf16_t*)(ws + WS_HID), (const bf16_t*)(ws + WS_WD), 1536, 1536, 1536}; pg8::Order S; S.init(256, 4, G, bid); EpiDown E{(bf16_t*)(ws + WS_OUTE), (const float*)(ws + WS_GATE)}; pg8::gemm_phase(lds, pr, S, E); }
    SYNC(10);
    if (PH(12)) phase11(p, (float*)(ws + WS_HID));
    if (PH(11)) phase11(p, p.out);
}

#ifndef N_LAUNCHES
#define N_LAUNCHES 1
#endif
#ifndef PROBE_DUP
#define PROBE_DUP 0x0
#endif
extern "C" void kernel_launch(void* const* d_in, const int* in_sizes, int n_in, void* d_out, int out_size, void* d_ws, size_t ws_size, hipStream_t stream) {
    static int grid = 0;
    if (grid == 0) {
        if (n_in != 24 || out_size != MLAT * DM || ws_size < WS_END) { fprintf(stderr, "kernel_launch: unexpected shapes (n_in %d out %d ws %zu)\n", n_in, out_size, ws_size); grid = -1; return; }
        int dev = 0, cus = 0, per_cu = 0;
        hipGetDevice(&dev); hipDeviceGetAttribute(&cus, hipDeviceAttributeMultiprocessorCount, dev);
        hipFuncSetAttribute((const void*)fwd_megakernel, hipFuncAttributeMaxDynamicSharedMemorySize, LDS_BYTES);
        hipOccupancyMaxActiveBlocksPerMultiprocessor(&per_cu, (const void*)fwd_megakernel, NTHR, LDS_BYTES);
        if (per_cu < 1) { fprintf(stderr, "kernel_launch: occupancy query reports %d blocks per CU\n", per_cu); per_cu = 1; }
        grid = cus * 1;
        (void)hipGetLastError();
    }
    if (grid < 0) return;
    Params p{};
    const float** f = (const float**)&p;
    for (int i = 0; i < 24; ++i) f[i] = (const float*)d_in[i];
    p.out = (float*)d_out; p.ws = (unsigned char*)d_ws;
    (void)hipMemsetAsync((unsigned char*)d_ws + WS_BAR, 0, 32 * KiB, stream);
#if N_LAUNCHES == 1
    p.ph_lo = 0; p.ph_hi = 12;
    void* args[] = {&p};
    hipError_t e = hipLaunchCooperativeKernel((const void*)fwd_megakernel, dim3(grid), dim3(NTHR), args, LDS_BYTES, stream);
    if (e != hipSuccess) fprintf(stderr, "cooperative launch failed: %s (grid %d)\n", hipGetErrorString(e), grid);
#else
    for (int k = 0; k < 12; ++k) for (int r = 0; r <= ((PROBE_DUP >> k) & 1); ++r) { p.ph_lo = k; p.ph_hi = k + 1; if (k == 11 && r == 0 && ((PROBE_DUP >> 11) & 1)) { p.ph_lo = 12; p.ph_hi = 13; } hipLaunchKernelGGL(fwd_megakernel, dim3(grid), dim3(NTHR), LDS_BYTES, stream, p); }
#endif
}
```

```cpp
#include <hip/hip_runtime.h>
#include <hip/hip_cooperative_groups.h>
#include <cstdio>
namespace cg = cooperative_groups;

#define LAS __attribute__((address_space(3)))
typedef unsigned short bf16_t;
typedef short bf16x8 __attribute__((ext_vector_type(8)));
typedef float f32x4 __attribute__((ext_vector_type(4)));
typedef float f32x16 __attribute__((ext_vector_type(16)));
typedef unsigned u32x4 __attribute__((ext_vector_type(4)));
typedef unsigned u32x2 __attribute__((ext_vector_type(2)));

constexpr int NB = 8, TT = 4096, DM = 1024, CTXL = 256, MLAT = NB * TT, MCTX = NB * CTXL;
constexpr int NE = 16, CAP = 512, DE = 1536, MMOE = NE * NB * CAP;
constexpr int NSEQ = 34;
constexpr int NTHR = 512;
constexpr int LDS_BYTES = 144 * 1024;

constexpr size_t KiB = 1024, MiB = 1024 * 1024;
constexpr size_t WS_ADA = 0;
constexpr size_t WS_POS = 256 * KiB;
constexpr size_t WS_AGG = 512 * KiB;
constexpr size_t WS_WPQ = 5 * MiB;
constexpr size_t WS_WIN = 7 * MiB;
constexpr size_t WS_WFOUR = 15 * MiB;
constexpr size_t WS_WLRU = 16 * MiB;
constexpr size_t WS_WOUT = 18 * MiB;
constexpr size_t WS_WAT = 20 * MiB;
constexpr size_t WS_WIT = 20 * MiB + 512 * KiB;
constexpr size_t WS_SCORES = 21 * MiB;
constexpr size_t WS_IDX = 23 * MiB;
constexpr size_t WS_GATE = 23 * MiB + 256 * KiB;
constexpr size_t WS_SLOT = 23 * MiB + 512 * KiB;
constexpr size_t WS_BAR = 25 * MiB + 512 * KiB;
constexpr size_t WS_D1T = 34 * MiB;
constexpr size_t WS_HCTX = 26 * MiB;
constexpr size_t WS_ZXC = 30 * MiB;
constexpr size_t WS_R1 = 40 * MiB;
constexpr size_t WS_RPQ = 104 * MiB;
constexpr size_t WS_R2 = 168 * MiB;
constexpr size_t WS_RZ = 232 * MiB;
constexpr size_t WS_END = 488 * MiB;
constexpr size_t WS_HID = WS_RZ, WS_WD = WS_RZ + 192 * MiB, WS_WGU = WS_RPQ, WS_OUTE = WS_R1;
constexpr size_t OUT_YT = 0, OUT_F = 64 * MiB;

struct Params {
    const float *x, *c, *ctx, *c_ctx, *w_ada, *b_ada, *norm1_g, *norm2_g, *w_in, *w_four, *conv_w, *conv_b, *lru_lambda,
        *lru_wa, *lru_ba, *lru_wi, *lru_bi, *w_lru, *w_out, *w_router, *w_gate_e, *w_up_e, *w_down_e, *final_g;
    float* out; unsigned char* ws; int ph_lo, ph_hi;
};

__device__ __forceinline__ unsigned cvt_pk_bf16(float lo, float hi) { unsigned r; asm volatile("v_cvt_pk_bf16_f32 %0, %1, %2" : "=v"(r) : "v"(lo), "v"(hi)); return r; }
__device__ __forceinline__ float bf_lo(unsigned w) { return __uint_as_float(w << 16); }
__device__ __forceinline__ float bf_hi(unsigned w) { return __uint_as_float(w & 0xffff0000u); }
__device__ __forceinline__ float bf2f(bf16_t h) { return __uint_as_float(((unsigned)h) << 16); }
__device__ __forceinline__ float sigmoidf_(float v) { return __builtin_amdgcn_rcpf(1.0f + __expf(-v)); }
__device__ __forceinline__ float gelu_tanh(float v) { const float y = 1.5957691216f * (v + 0.044715f * v * v * v); return v * sigmoidf_(y); }
__device__ __forceinline__ float wave_sum(float v) {
#pragma unroll
    for (int o = 32; o >= 1; o >>= 1) v += __shfl_xor(v, o);
    return v;
}
__device__ __forceinline__ void unpack8(const u32x4 w, float (&f)[8]) { f[0] = bf_lo(w.x); f[1] = bf_hi(w.x); f[2] = bf_lo(w.y); f[3] = bf_hi(w.y); f[4] = bf_lo(w.z); f[5] = bf_hi(w.z); f[6] = bf_lo(w.w); f[7] = bf_hi(w.w); }

namespace pg8 {
constexpr int BM = 256, BK = 64, HALF = 128, HTB = HALF * BK * 2, STAGE_BYTES = 8 * HTB, NXCD = 8, WGM = 8;
__device__ __forceinline__ int lds_byte(int r, int c) { const int st = (r >> 4) * 2 + (c >> 5), rr = r & 15, cc = c & 31, ob = rr * 64 + cc * 2; return st * 1024 + (ob ^ (((ob >> 9) & 1) << 5)); }
__device__ __forceinline__ void stage_rc(int b, int& R, int& C) { const int st = b / 1024, sb = b % 1024, swz = sb ^ (((sb >> 9) & 1) << 5); R = (st >> 1) * 16 + swz / 64; C = (st & 1) * 32 + (swz % 64) / 2; }
__device__ __forceinline__ int perm32(int rho) { const int n = rho >> 4, i = rho & 15; return 8 * (i >> 2) + 4 * n + (i & 3); }
struct Unit { int pm, pn; };
struct Order {
    int nM, nN, nwg, G, c;
    __device__ void init(int nM_, int nN_, int G_, int c_) { nM = nM_; nN = nN_; nwg = nM * nN; G = G_; c = c_; }
    __device__ bool next(int i, Unit& u) const {
        const long L = (long)i * G + c; if (L >= nwg) return false;
        int wgid = (int)L; { const int q = nwg / NXCD, r = nwg % NXCD, xcd = wgid % NXCD, off = wgid / NXCD; wgid = (xcd < r ? xcd * (q + 1) : r * (q + 1) + (xcd - r) * q) + off; }
        const int nig = WGM * nN, gid = wgid / nig, fm = gid * WGM, gsz = (nM - fm) < WGM ? (nM - fm) : WGM;
        u.pm = fm + ((wgid % nig) % gsz); u.pn = (wgid % nig) / gsz; return true;
    }
};
template <class P, class Epi>
__device__ __forceinline__ void gemm_phase(LAS unsigned char* lds, const P& pr, const Order& S, const Epi& E) {
    const int tid = threadIdx.x, wid = __builtin_amdgcn_readfirstlane(tid >> 6), lane = tid & 63, wr = wid >> 2, wc = wid & 3, fr = lane & 15, fq = lane >> 4;
    const int nt = pr.K / BK;
    int RA[2], CA[2]; unsigned voffB[2];
#pragma unroll
    for (int i = 0; i < 2; ++i) { int R, C; stage_rc(tid * 16 + i * 8192, R, C); RA[i] = R; CA[i] = C; const int Rb = Epi::PERM ? ((R & ~31) + perm32(R & 31)) : R; voffB[i] = (unsigned)(Rb * pr.ldb + C) * 2u; }
    const size_t kstep = (size_t)(BK * 2);
    const size_t hstepB = (size_t)HALF * pr.ldb * 2;
    const unsigned ldsw = (unsigned)wid * 1024u;
    const int aoff = lds_byte(wr * 64 + fr, fq * 8), boff = lds_byte(wc * 32 + fr, fq * 8);
#define PG8_SA(b, h) (((b) * 2 + (h)) * HTB)
#define PG8_SB(b, h) ((4 + (b) * 2 + (h)) * HTB)
#define PG8_STAGE(bufoff, gbase, voff) do { _Pragma("unroll") for (int _i = 0; _i < 2; ++_i) \
        __builtin_amdgcn_global_load_lds((const unsigned*)((const char*)(gbase) + (voff)[_i]), (LAS unsigned*)(lds + (bufoff) + ldsw + _i * 8192), 16, 0, 0); } while (0)
#define PG8_LDA(dst, b, h) do { _Pragma("unroll") for (int m = 0; m < 4; ++m) _Pragma("unroll") for (int k = 0; k < 2; ++k) dst[m][k] = *(const LAS bf16x8*)(lds + PG8_SA(b, h) + aoff + m * 2048 + k * 1024); } while (0)
#define PG8_LDB(dst, b, h) do { _Pragma("unroll") for (int n = 0; n < 2; ++n) _Pragma("unroll") for (int k = 0; k < 2; ++k) dst[n][k] = *(const LAS bf16x8*)(lds + PG8_SB(b, h) + boff + n * 2048 + k * 1024); } while (0)
#define PG8_MMA(ai, bj, At, Bt) do { __builtin_amdgcn_s_setprio(1); _Pragma("unroll") for (int m = 0; m < 4; ++m) _Pragma("unroll") for (int n = 0; n < 2; ++n) _Pragma("unroll") for (int k = 0; k < 2; ++k) \
        acc[ai][bj][m][n] = __builtin_amdgcn_mfma_f32_16x16x32_bf16(Bt[n][k], At[m][k], acc[ai][bj][m][n], 0, 0, 0); __builtin_amdgcn_s_setprio(0); } while (0)
#define PG8_WAIT_V(n) asm volatile("s_waitcnt vmcnt(" #n ")" ::: "memory")
#define PG8_WAIT_L(n) asm volatile("s_waitcnt lgkmcnt(" #n ")" ::: "memory")
#define PG8_BAR __builtin_amdgcn_s_barrier()
#define PG8_SCHED __builtin_amdgcn_sched_barrier(0)
    Unit cur, nxt; int ui = 0;
    if (!S.next(0, cur)) return;
    f32x4 acc[2][2][4][2];
#pragma unroll
    for (int a = 0; a < 2; ++a)
#pragma unroll
        for (int b = 0; b < 2; ++b)
#pragma unroll
            for (int m = 0; m < 4; ++m)
#pragma unroll
                for (int n = 0; n < 2; ++n) acc[a][b][m][n] = (f32x4){0.f, 0.f, 0.f, 0.f};
    bf16x8 At[4][2], B0[2][2], B1[2][2];
    unsigned vA[2][2], vN[2][2];
    pr.avoff(cur, RA, CA, vA);
#pragma unroll
    for (int h = 0; h < 2; ++h)
#pragma unroll
        for (int i = 0; i < 2; ++i) vN[h][i] = vA[h][i];
    const char* cA = pr.abase(cur); const char* cB = pr.bbase(cur);
    PG8_STAGE(PG8_SB(0, 0), cB, voffB); PG8_STAGE(PG8_SA(0, 0), cA, vA[0]); PG8_STAGE(PG8_SB(0, 1), cB + hstepB, voffB); PG8_STAGE(PG8_SA(0, 1), cA, vA[1]);
    if (wr == 1) PG8_BAR;
    PG8_WAIT_V(4); PG8_BAR;
    PG8_STAGE(PG8_SB(1, 0), cB + kstep, voffB); PG8_STAGE(PG8_SA(1, 0), cA + kstep, vA[0]); PG8_STAGE(PG8_SB(1, 1), cB + hstepB + kstep, voffB);
    PG8_WAIT_V(6); PG8_BAR;
    for (;;) {
        const bool has_next = S.next(ui + 1, nxt);
        const char* nA = has_next ? pr.abase(nxt) : cA; const char* nB = has_next ? pr.bbase(nxt) : cB;
        if (P::GATHER) { if (has_next) pr.avoff(nxt, RA, CA, vN); }
        for (int t = 0; t < nt; t += 2) {
            const bool last = (t == nt - 2);
            const char* a1 = cA + (size_t)(t + 1) * kstep;
            const char* a2 = last ? nA : cA + (size_t)(t + 2) * kstep; const char* b2 = last ? nB : cB + (size_t)(t + 2) * kstep;
            const char* a3 = a2 + kstep; const char* b3 = b2 + kstep;
            unsigned v2[2][2];
#pragma unroll
            for (int h = 0; h < 2; ++h)
#pragma unroll
                for (int i = 0; i < 2; ++i) v2[h][i] = (P::GATHER && last) ? vN[h][i] : vA[h][i];
            PG8_LDB(B0, 0, 0); PG8_SCHED; PG8_LDA(At, 0, 0); PG8_STAGE(PG8_SA(1, 1), a1, vA[1]);
            PG8_WAIT_L(8); PG8_BAR; PG8_WAIT_L(0); PG8_MMA(0, 0, At, B0); PG8_BAR; PG8_SCHED;
            PG8_LDB(B1, 0, 1); PG8_STAGE(PG8_SB(0, 0), b2, voffB);
            PG8_BAR; PG8_WAIT_L(0); PG8_MMA(0, 1, At, B1); PG8_BAR;
            PG8_LDA(At, 0, 1); PG8_STAGE(PG8_SA(0, 0), a2, v2[0]);
            PG8_BAR; PG8_WAIT_L(0); PG8_MMA(1, 0, At, B0); PG8_BAR; PG8_SCHED;
            PG8_STAGE(PG8_SB(0, 1), b2 + hstepB, voffB);
            PG8_WAIT_V(6); PG8_BAR; PG8_MMA(1, 1, At, B1); PG8_BAR;
            PG8_LDB(B0, 1, 0); PG8_SCHED; PG8_LDA(At, 1, 0); PG8_STAGE(PG8_SA(0, 1), a2, v2[1]);
            PG8_WAIT_L(8); PG8_BAR; PG8_WAIT_L(0); PG8_MMA(0, 0, At, B0); PG8_BAR; PG8_SCHED;
            PG8_LDB(B1, 1, 1); PG8_STAGE(PG8_SB(1, 0), b3, voffB);
            PG8_BAR; PG8_WAIT_L(0); PG8_MMA(0, 1, At, B1); PG8_BAR;
            PG8_LDA(At, 1, 1); PG8_STAGE(PG8_SA(1, 0), a3, v2[0]);
            PG8_BAR; PG8_WAIT_L(0); PG8_MMA(1, 0, At, B0); PG8_BAR; PG8_SCHED;
            PG8_STAGE(PG8_SB(1, 1), b3 + hstepB, voffB);
            PG8_WAIT_V(6); PG8_BAR; PG8_MMA(1, 1, At, B1); PG8_BAR;
            if (P::GATHER && last) {
#pragma unroll
                for (int h = 0; h < 2; ++h)
#pragma unroll
                    for (int i = 0; i < 2; ++i) vA[h][i] = vN[h][i];
            }
        }
        E(acc, cur, wr, wc, fr, fq);
        if (!has_next) break;
#pragma unroll
        for (int a = 0; a < 2; ++a)
#pragma unroll
            for (int b = 0; b < 2; ++b)
#pragma unroll
                for (int m = 0; m < 4; ++m)
#pragma unroll
                    for (int n = 0; n < 2; ++n) acc[a][b][m][n] = (f32x4){0.f, 0.f, 0.f, 0.f};
        cur = nxt; cA = nA; cB = nB; ++ui;
    }
    PG8_WAIT_V(0);
    if (wr == 0) PG8_BAR;
    PG8_BAR;
#undef PG8_SA
#undef PG8_SB
#undef PG8_STAGE
#undef PG8_LDA
#undef PG8_LDB
#undef PG8_MMA
#undef PG8_WAIT_V
#undef PG8_WAIT_L
#undef PG8_BAR
#undef PG8_SCHED
}
}
using pg8::Unit;

struct ProbPlain {
    static constexpr bool GATHER = false;
    const bf16_t* A; const bf16_t* B; int K, lda, ldb;
    __device__ __forceinline__ const char* abase(const Unit& u) const { return (const char*)(A + (size_t)u.pm * 256 * lda); }
    __device__ __forceinline__ const char* bbase(const Unit& u) const { return (const char*)(B + (size_t)u.pn * 256 * ldb); }
    __device__ __forceinline__ void avoff(const Unit&, const int (&RA)[2], const int (&CA)[2], unsigned (&v)[2][2]) const {
#pragma unroll
        for (int h = 0; h < 2; ++h)
#pragma unroll
            for (int i = 0; i < 2; ++i) v[h][i] = (unsigned)((h * 128 + RA[i]) * lda + CA[i]) * 2u;
    }
};
struct ProbPQ {
    static constexpr bool GATHER = false;
    const bf16_t* A; const bf16_t* B; int K, lda, ldb;
    __device__ __forceinline__ const char* abase(const Unit& u) const { return (const char*)(A + (size_t)u.pm * 256 * lda); }
    __device__ __forceinline__ const char* bbase(const Unit& u) const { return (const char*)(B + ((size_t)(u.pn >> 4) * 4096 + (u.pn & 15)) * 1024); }
    __device__ __forceinline__ void avoff(const Unit&, const int (&RA)[2], const int (&CA)[2], unsigned (&v)[2][2]) const {
#pragma unroll
        for (int h = 0; h < 2; ++h)
#pragma unroll
            for (int i = 0; i < 2; ++i) v[h][i] = (unsigned)((h * 128 + RA[i]) * lda + CA[i]) * 2u;
    }
};
struct ProbMoeUp {
    static constexpr bool GATHER = true;
    const bf16_t* A; const bf16_t* B; const int* idx; int K, lda, ldb;
    __device__ __forceinline__ const char* abase(const Unit&) const { return (const char*)A; }
    __device__ __forceinline__ const char* bbase(const Unit& u) const { return (const char*)(B + ((size_t)(u.pm >> 4) * 3072 + (size_t)u.pn * 256) * ldb); }
    __device__ __forceinline__ void avoff(const Unit& u, const int (&RA)[2], const int (&CA)[2], unsigned (&v)[2][2]) const {
#pragma unroll
        for (int h = 0; h < 2; ++h)
#pragma unroll
            for (int i = 0; i < 2; ++i) { const int g = idx[u.pm * 256 + h * 128 + RA[i]]; v[h][i] = (unsigned)(g * lda + CA[i]) * 2u; }
    }
};
struct ProbMoeDown {
    static constexpr bool GATHER = false;
    const bf16_t* A; const bf16_t* B; int K, lda, ldb;
    __device__ __forceinline__ const char* abase(const Unit& u) const { return (const char*)(A + (size_t)u.pm * 256 * lda); }
    __device__ __forceinline__ const char* bbase(const Unit& u) const { return (const char*)(B + ((size_t)(u.pm >> 4) * 1024 + (size_t)u.pn * 256) * ldb); }
    __device__ __forceinline__ void avoff(const Unit&, const int (&RA)[2], const int (&CA)[2], unsigned (&v)[2][2]) const {
#pragma unroll
        for (int h = 0; h < 2; ++h)
#pragma unroll
            for (int i = 0; i < 2; ++i) v[h][i] = (unsigned)((h * 128 + RA[i]) * lda + CA[i]) * 2u;
    }
};

#define EPI_ROWS(...) _Pragma("unroll") for (int ai = 0; ai < 2; ++ai) _Pragma("unroll") for (int m = 0; m < 4; ++m) { const int row = u.pm * 256 + ai * 128 + wr * 64 + m * 16 + fr; __VA_ARGS__ }
__device__ __forceinline__ u32x4 pack8(const f32x4 v0, const f32x4 v1) { u32x4 w; w.x = cvt_pk_bf16(v0[0], v0[1]); w.y = cvt_pk_bf16(v0[2], v0[3]); w.z = cvt_pk_bf16(v1[0], v1[1]); w.w = cvt_pk_bf16(v1[2], v1[3]); return w; }

struct EpiPQ {
    static constexpr bool PERM = true; bf16_t* O;
    __device__ __forceinline__ void operator()(const f32x4 (&acc)[2][2][4][2], const Unit& u, int wr, int wc, int fr, int fq) const {
        const int t10 = wc * 32 + 8 * fq, b = u.pn >> 4, t2 = u.pn & 15;
        EPI_ROWS(
            bf16_t* rp = O + ((size_t)((b * 512 + (row >> 1)) * 16 + t2) * 512 + (row & 1) * 256 + t10);
            _Pragma("unroll") for (int bj = 0; bj < 2; ++bj) *(u32x4*)(rp + bj * 128) = pack8(acc[ai][bj][m][0], acc[ai][bj][m][1]);
        )
    }
};
struct EpiPlain {
    static constexpr bool PERM = true; bf16_t* O; size_t ldc;
    __device__ __forceinline__ void operator()(const f32x4 (&acc)[2][2][4][2], const Unit& u, int wr, int wc, int fr, int fq) const {
        const int col0 = u.pn * 256 + wc * 32 + 8 * fq;
        EPI_ROWS(
            bf16_t* rp = O + (size_t)row * ldc + col0;
            _Pragma("unroll") for (int bj = 0; bj < 2; ++bj) *(u32x4*)(rp + bj * 128) = pack8(acc[ai][bj][m][0], acc[ai][bj][m][1]);
        )
    }
};
struct EpiZ {
    static constexpr bool PERM = true; bf16_t* O; int ldc; int fixed_act;
    __device__ __forceinline__ void operator()(const f32x4 (&acc)[2][2][4][2], const Unit& u, int wr, int wc, int fr, int fq) const {
        const int col0 = u.pn * 256 + wc * 32 + 8 * fq; const int act = fixed_act >= 0 ? fixed_act : (u.pn >> 2);
        EPI_ROWS(
            bf16_t* rp = O + (size_t)row * ldc + col0;
            _Pragma("unroll") for (int bj = 0; bj < 2; ++bj) {
                f32x4 v0 = acc[ai][bj][m][0], v1 = acc[ai][bj][m][1];
                if (act == 1) { _Pragma("unroll") for (int j = 0; j < 4; ++j) { v0[j] = gelu_tanh(v0[j]); v1[j] = gelu_tanh(v1[j]); } }
                else if (act >= 2) { _Pragma("unroll") for (int j = 0; j < 4; ++j) { v0[j] = sigmoidf_(v0[j]); v1[j] = sigmoidf_(v1[j]); } }
                *(u32x4*)(rp + bj * 128) = pack8(v0, v1); }
        )
    }
};
struct EpiY1 {
    static constexpr bool PERM = true; bf16_t* O; const bf16_t* Z;
    __device__ __forceinline__ void operator()(const f32x4 (&acc)[2][2][4][2], const Unit& u, int wr, int wc, int fr, int fq) const {
        const int col0 = u.pn * 256 + wc * 32 + 8 * fq;
        EPI_ROWS(
            _Pragma("unroll") for (int bj = 0; bj < 2; ++bj) {
                const int col = col0 + bj * 128; float g[8]; unpack8(*(const u32x4*)(Z + (size_t)row * 4096 + 2048 + col), g);
                f32x4 v0 = acc[ai][bj][m][0], v1 = acc[ai][bj][m][1];
                _Pragma("unroll") for (int j = 0; j < 4; ++j) { v0[j] *= g[j]; v1[j] *= g[4 + j]; }
                *(u32x4*)(O + (size_t)row * 1024 + col) = pack8(v0, v1); }
        )
    }
};
struct EpiY2 {
    static constexpr bool PERM = true; bf16_t* O; const bf16_t* Z;
    __device__ __forceinline__ void operator()(const f32x4 (&acc)[2][2][4][2], const Unit& u, int wr, int wc, int fr, int fq) const {
        const int col0 = u.pn * 256 + wc * 32 + 8 * fq;
        EPI_ROWS(
            _Pragma("unroll") for (int bj = 0; bj < 2; ++bj) {
                const int col = col0 + bj * 128; float g[8], t1[8]; unpack8(*(const u32x4*)(Z + (size_t)row * 4096 + 3072 + col), g); unpack8(*(const u32x4*)(O + (size_t)row * 1024 + col), t1);
                f32x4 v0 = acc[ai][bj][m][0], v1 = acc[ai][bj][m][1];
                _Pragma("unroll") for (int j = 0; j < 4; ++j) { v0[j] = t1[j] + v0[j] * g[j]; v1[j] = t1[4 + j] + v1[j] * g[4 + j]; }
                *(u32x4*)(O + (size_t)row * 1024 + col) = pack8(v0, v1); }
        )
    }
};
struct EpiOut {
    static constexpr bool PERM = false; float* O; const float* X; const float* pos; const float* ada;
    __device__ __forceinline__ void operator()(const f32x4 (&acc)[2][2][4][2], const Unit& u, int wr, int wc, int fr, int fq) const {
        const int col0 = u.pn * 256 + wc * 32 + 4 * fq; const int b = u.pm >> 4;
        EPI_ROWS(
            const int t = row & 4095;
            _Pragma("unroll") for (int bj = 0; bj < 2; ++bj) _Pragma("unroll") for (int n = 0; n < 2; ++n) {
                const int col = col0 + bj * 128 + n * 16;
                const f32x4 xv = *(const f32x4*)(X + (size_t)row * 1024 + col);
                const f32x4 pv = *(const f32x4*)(pos + (col < 512 ? (t >> 6) * 512 + col : (t & 63) * 512 + (col - 512)));
                const f32x4 gv = *(const f32x4*)(ada + b * 6144 + 2048 + col);
                *(f32x4*)(O + (size_t)row * 1024 + col) = xv + pv + gv * acc[ai][bj][m][n]; }
        )
    }
};
struct EpiGU {
    static constexpr bool PERM = true; bf16_t* O;
    __device__ __forceinline__ void operator()(const f32x4 (&acc)[2][2][4][2], const Unit& u, int wr, int wc, int fr, int fq) const {
        const int col0 = u.pn * 128 + wc * 32 + 8 * fq;
        EPI_ROWS(
            f32x4 v0, v1;
            _Pragma("unroll") for (int j = 0; j < 4; ++j) { const float g0 = acc[ai][0][m][0][j], g1 = acc[ai][0][m][1][j];
                v0[j] = g0 * sigmoidf_(g0) * acc[ai][1][m][0][j]; v1[j] = g1 * sigmoidf_(g1) * acc[ai][1][m][1][j]; }
            *(u32x4*)(O + (size_t)row * DE + col0) = pack8(v0, v1);
        )
    }
};
struct EpiDown {
    static constexpr bool PERM = true; bf16_t* O; const float* gate;
    __device__ __forceinline__ void operator()(const f32x4 (&acc)[2][2][4][2], const Unit& u, int wr, int wc, int fr, int fq) const {
        const int col0 = u.pn * 256 + wc * 32 + 8 * fq;
        EPI_ROWS(
            const float g = gate[row];
            _Pragma("unroll") for (int bj = 0; bj < 2; ++bj) *(u32x4*)(O + (size_t)row * 1024 + col0 + bj * 128) = pack8(acc[ai][bj][m][0] * g, acc[ai][bj][m][1] * g);
        )
    }
};

__device__ void p0_ada(const Params& p, LAS unsigned char* lds, int item) {
    const int tid = threadIdx.x;
    LAS float* s = (LAS float*)lds; LAS float* red = s + 9 * 1024;
    for (int i = tid; i < 9 * 1024; i += NTHR) { const int r = i >> 10, d = i & 1023; const float v = r < 8 ? p.c[r * 1024 + d] : p.c_ctx[d]; s[i] = v / (1.0f + expf(-v)); }
    __syncthreads();
    const int col = tid & 63, ds = tid >> 6; float a[9];
#pragma unroll
    for (int r = 0; r < 9; ++r) a[r] = 0.f;
    const float* w = p.w_ada + (size_t)(ds * 128) * 6144 + item * 64 + col;
    for (int d = 0; d < 128; ++d) { const float wv = w[(size_t)d * 6144];
#pragma unroll
        for (int r = 0; r < 9; ++r) a[r] += s[r * 1024 + ds * 128 + d] * wv; }
#pragma unroll
    for (int r = 0; r < 9; ++r) red[(ds * 9 + r) * 64 + col] = a[r];
    __syncthreads();
    float* ada = (float*)(p.ws + WS_ADA);
    for (int i = tid; i < 9 * 64; i += NTHR) { const int r = i >> 6, cc = i & 63; float v = 0.f;
#pragma unroll
        for (int k = 0; k < 8; ++k) v += red[(k * 9 + r) * 64 + cc];
        ada[r * 6144 + item * 64 + cc] = v + p.b_ada[item * 64 + cc]; }
    __syncthreads();
}
template <int NS>
__device__ __forceinline__ void xpose_item(const float* src, int ldsrc, bf16_t* dst, int lddst, int k0, int n0, int mode) {
    const int tid = threadIdx.x, nl = tid & 63, k8 = tid >> 6;
    float v[NS][8];
#pragma unroll
    for (int s = 0; s < NS; ++s)
#pragma unroll
        for (int j = 0; j < 8; ++j) v[s][j] = src[(size_t)(k0 + 8 * k8 + j) * ldsrc + n0 + 64 * s + nl];
#pragma unroll
    for (int s = 0; s < NS; ++s) { const int n = n0 + 64 * s + nl; int row = n;
        if (mode) row = (n >> 7) * 256 + (n & 127) + (mode == 2 ? 128 : 0);
        u32x4 w; w.x = cvt_pk_bf16(v[s][0], v[s][1]); w.y = cvt_pk_bf16(v[s][2], v[s][3]); w.z = cvt_pk_bf16(v[s][4], v[s][5]); w.w = cvt_pk_bf16(v[s][6], v[s][7]);
        *(u32x4*)(dst + (size_t)row * lddst + k0 + 8 * k8) = w; }
}
__device__ void p0_wpq(const Params& p, LAS unsigned char* lds, int item) {
    const int tid = threadIdx.x, g = item >> 4, db = item & 15;
    LAS float* wl = (LAS float*)lds; LAS float* ct = wl + 64 * 129;
    for (int i = tid; i < 64 * 128; i += NTHR) { const int d = i >> 7, cc = i & 127; wl[d * 129 + cc] = p.w_in[(size_t)(db * 64 + d) * 4608 + g * 128 + cc]; }
    if (tid < 128) { float sn, cs; sincospif((float)tid * (1.0f / 64.0f), &sn, &cs); ct[tid] = cs; ct[128 + tid] = sn; }
    __syncthreads();
    const int q = tid & 255, kc = q >> 1, pq = q & 1, dh = tid >> 8; const int n = (g * 128 + kc) * 2 + pq;
    bf16_t* dst = (bf16_t*)(p.ws + WS_WPQ) + (size_t)n * 1024 + db * 64 + dh * 32;
    const float scale = 0.001381067932f;
    for (int d8 = 0; d8 < 4; ++d8) { float a[8];
#pragma unroll
        for (int j = 0; j < 8; ++j) a[j] = 0.f;
        for (int cc = 0; cc < 128; ++cc) { const float tv = ct[pq * 128 + ((cc * kc) & 127)];
#pragma unroll
            for (int j = 0; j < 8; ++j) a[j] += wl[(dh * 32 + d8 * 8 + j) * 129 + cc] * tv; }
        u32x4 w; w.x = cvt_pk_bf16(a[0] * scale, a[1] * scale); w.y = cvt_pk_bf16(a[2] * scale, a[3] * scale); w.z = cvt_pk_bf16(a[4] * scale, a[5] * scale); w.w = cvt_pk_bf16(a[6] * scale, a[7] * scale);
        *(u32x4*)(dst + d8 * 8) = w; }
    __syncthreads();
}
__device__ void p0_d1t(const Params& p, int item) {
    bf16_t* dst = (bf16_t*)(p.ws + WS_D1T);
    const int row = item * 64 + (threadIdx.x >> 3), k1 = row >> 1, ri = row & 1, c0 = (threadIdx.x & 7) * 64;
    for (int c8 = 0; c8 < 64; c8 += 8) { float v[8];
#pragma unroll
        for (int j = 0; j < 8; ++j) { const int col = c0 + c8 + j, pq = col >> 8, t1 = col & 255; float sn, cs; sincospif((float)((k1 * t1) & 255) * (1.0f / 128.0f), &sn, &cs);
            v[j] = (ri == 0) ? (pq == 0 ? cs : -sn) : (pq == 0 ? -sn : -cs); }
        u32x4 w; w.x = cvt_pk_bf16(v[0], v[1]); w.y = cvt_pk_bf16(v[2], v[3]); w.z = cvt_pk_bf16(v[4], v[5]); w.w = cvt_pk_bf16(v[6], v[7]);
        *(u32x4*)(dst + (size_t)row * 512 + c0 + c8) = w; }
}
__device__ void p0_pos(const Params& p) {
    float* tab = (float*)(p.ws + WS_POS);
    for (int i = threadIdx.x; i < 64 * 512; i += NTHR) { const int ii = i >> 9, j = i & 511, jj = j & 255; const float f = expf(-9.210340371976184f * (float)jj / 256.0f); const float a = (float)ii * f; tab[i] = j < 256 ? sinf(a) : cosf(a); }
}
__device__ void phase0(const Params& p, LAS unsigned char* lds) {
    constexpr int N_ADA = 96, N_WIN = 16 * 16, N_WFOUR = 8 * 4, N_SQ = 16 * 4, N_LRU = 16 * 2, N_WPQ = 64, N_DFT = 8, N_POS = 1;
    constexpr int O1 = N_ADA, O2 = O1 + N_WIN, O3 = O2 + N_WFOUR, O4 = O3 + N_SQ, O5 = O4 + N_SQ, O6 = O5 + N_LRU, O7 = O6 + N_LRU, O8 = O7 + N_WPQ, O9 = O8 + N_DFT, O10 = O9 + N_POS;
    for (int it = blockIdx.x; it < O10; it += gridDim.x) {
        if (it < O1) p0_ada(p, lds, it);
        else if (it < O2) { const int j = it - O1; xpose_item<4>(p.w_in + 512, 4608, (bf16_t*)(p.ws + WS_WIN), 1024, (j >> 4) * 64, (j & 15) * 256, 0); }
        else if (it < O3) { const int j = it - O2; xpose_item<4>(p.w_four, 1024, (bf16_t*)(p.ws + WS_WFOUR), 512, (j >> 2) * 64, (j & 3) * 256, 0); }
        else if (it < O4) { const int j = it - O3; xpose_item<4>(p.w_lru, 1024, (bf16_t*)(p.ws + WS_WLRU), 1024, (j >> 2) * 64, (j & 3) * 256, 0); }
        else if (it < O5) { const int j = it - O4; xpose_item<4>(p.w_out, 1024, (bf16_t*)(p.ws + WS_WOUT), 1024, (j >> 2) * 64, (j & 3) * 256, 0); }
        else if (it < O6) { const int j = it - O5, mtx = j >> 1; xpose_item<2>(p.lru_wa + (size_t)mtx * 16384, 128, (bf16_t*)(p.ws + WS_WAT) + (size_t)mtx * 16384, 128, (j & 1) * 64, 0, 0); }
        else if (it < O7) { const int j = it - O6, mtx = j >> 1; xpose_item<2>(p.lru_wi + (size_t)mtx * 16384, 128, (bf16_t*)(p.ws + WS_WIT) + (size_t)mtx * 16384, 128, (j & 1) * 64, 0, 0); }
        else if (it < O8) p0_wpq(p, lds, it - O7);
        else if (it < O9) p0_d1t(p, it - O8);
        else p0_pos(p);
    }
}

__device__ void phase1(const Params& p) {
    const int lane = threadIdx.x & 63, wid = threadIdx.x >> 6;
    const float* ada = (const float*)(p.ws + WS_ADA); const float* tab = (const float*)(p.ws + WS_POS);
    bf16_t* h1 = (bf16_t*)(p.ws + WS_R1); bf16_t* hc = (bf16_t*)(p.ws + WS_HCTX);
    for (int row = blockIdx.x * 8 + wid; row < MLAT + MCTX; row += gridDim.x * 8) {
        const bool lat = row < MLAT; const int rc = row - MLAT; const int t = row & 4095; const int mrow = lat ? (row >> 12) : 8;
        const float* xr = lat ? p.x + (size_t)row * 1024 : p.ctx + (size_t)rc * 1024;
        f32x4 v[4]; float ss = 0.f;
#pragma unroll
        for (int i = 0; i < 4; ++i) { const int d = 256 * i + 4 * lane; v[i] = *(const f32x4*)(xr + d);
            if (lat) v[i] += *(const f32x4*)(tab + (i < 2 ? (t >> 6) * 512 + d : (t & 63) * 512 + d - 512));
            ss += v[i][0] * v[i][0] + v[i][1] * v[i][1] + v[i][2] * v[i][2] + v[i][3] * v[i][3]; }
        ss = wave_sum(ss); const float rs = rsqrtf(ss * (1.0f / 1024.0f) + 1e-6f);
        bf16_t* dst = lat ? h1 + (size_t)row * 1024 : hc + (size_t)rc * 1024;
#pragma unroll
        for (int i = 0; i < 4; ++i) { const int d = 256 * i + 4 * lane;
            const f32x4 g = *(const f32x4*)(p.norm1_g + d), sh = *(const f32x4*)(ada + mrow * 6144 + d), sc = *(const f32x4*)(ada + mrow * 6144 + 1024 + d);
            const f32x4 h = v[i] * rs * g * (sc + 1.0f) + sh;
            u32x2 w; w.x = cvt_pk_bf16(h[0], h[1]); w.y = cvt_pk_bf16(h[2], h[3]); *(u32x2*)(dst + d) = w; }
    }
}

#define LRU_CST(mb, r) (32 * (mb) + 8 * ((r) >> 2) + ((r) & 3))
template <bool FINAL, int DIR>
__device__ __forceinline__ void lru_wave(const Params& p, LAS unsigned char* ul, int b, int sc, int head, int cb, int lane, f32x16 (&accI)[4]) {
    constexpr int SG = DIR ? -1 : 1;
    const int lr = lane & 31, lh = lane >> 5;
    const int chl = cb * 32 + lr, ch = head * 128 + chl;
    const int tbase = DIR ? 127 - 4 * lh : 4 * lh;
    f32x16 accA[4];
#pragma unroll
    for (int mb = 0; mb < 4; ++mb)
#pragma unroll
        for (int r = 0; r < 16; ++r) { accA[mb][r] = 0.f; accI[mb][r] = 0.f; }
    {
        const bf16_t* wa = (const bf16_t*)(p.ws + WS_WAT) + ((size_t)(DIR * 8 + head) * 128 + chl) * 128 + 8 * lh;
        const bf16_t* wi = (const bf16_t*)(p.ws + WS_WIT) + ((size_t)(DIR * 8 + head) * 128 + chl) * 128 + 8 * lh;
        LAS unsigned char* arow0 = ul + (DIR ? 127 - lr : lr) * 272 + lh * 16;
#pragma unroll
        for (int kc = 0; kc < 2; ++kc) { bf16x8 bA[4], bI[4];
#pragma unroll
            for (int k4 = 0; k4 < 4; ++k4) { bA[k4] = *(const bf16x8*)(wa + 16 * (kc * 4 + k4)); bI[k4] = *(const bf16x8*)(wi + 16 * (kc * 4 + k4)); }
#pragma unroll
            for (int mb = 0; mb < 4; ++mb)
#pragma unroll
                for (int k4 = 0; k4 < 4; ++k4) { const bf16x8 af = *(const LAS bf16x8*)(arow0 + SG * 32 * mb * 272 + 32 * (kc * 4 + k4));
                    accA[mb] = __builtin_amdgcn_mfma_f32_32x32x16_bf16(af, bA[k4], accA[mb], 0, 0, 0);
                    accI[mb] = __builtin_amdgcn_mfma_f32_32x32x16_bf16(af, bI[k4], accI[mb], 0, 0, 0); }
            __builtin_amdgcn_sched_barrier(0); }
    }
    {
        const float lam = p.lru_lambda[DIR * 1024 + ch]; const float sp8 = 8.0f * log1pf(expf(-lam));
        const float ba = p.lru_ba[DIR * 1024 + ch], bi = p.lru_bi[DIR * 1024 + ch];
        LAS unsigned char* up = ul + tbase * 272 + chl * 2;
#pragma unroll
        for (int mb = 0; mb < 4; ++mb) {
#pragma unroll
            for (int r = 0; r < 16; ++r) {
                const float uv = bf2f(*(const LAS bf16_t*)(up + SG * LRU_CST(mb, r) * 272));
                const float rg = sigmoidf_(accA[mb][r] + ba), ig = sigmoidf_(accI[mb][r] + bi);
                const float a = __expf(-sp8 * rg); accA[mb][r] = a; accI[mb][r] = sqrtf(fmaxf(1.0f - a * a, 0.f)) * ig * uv; }
            __builtin_amdgcn_sched_barrier(0); }
    }
    float rA[16], rH[16];
#pragma unroll
    for (int mb = 0; mb < 4; ++mb)
#pragma unroll
        for (int q = 0; q < 4; ++q) { float pa = 1.f, hh = 0.f;
#pragma unroll
            for (int j = 0; j < 4; ++j) { const int r = 4 * q + j; const float a = accA[mb][r], bb = accI[mb][r]; hh = a * hh + bb; pa *= a; accA[mb][r] = pa; accI[mb][r] = hh; }
            rA[mb * 4 + q] = pa; rH[mb * 4 + q] = hh; }
    const int agg_dir_off = ((b * NSEQ) * 2 + DIR) * 1024 + ch;
    const float* agg = (const float*)(p.ws + WS_AGG);
    float carry = 0.f;
    if (FINAL) {
        if (DIR == 0) { for (int q = 0; q < sc; ++q) { const float* a2 = agg + (size_t)(agg_dir_off + q * 2048) * 2; carry = a2[0] * carry + a2[1]; } }
        else { { const float* a2 = agg + (size_t)(agg_dir_off + 1 * 2048) * 2; carry = a2[0] * carry + a2[1]; } { const float* a2 = agg + (size_t)(agg_dir_off + 0 * 2048) * 2; carry = a2[0] * carry + a2[1]; }
            for (int q = NSEQ - 1; q > sc; --q) { const float* a2 = agg + (size_t)(agg_dir_off + q * 2048) * 2; carry = a2[0] * carry + a2[1]; } }
    }
    float cin[16];
#pragma unroll
    for (int i = 0; i < 16; ++i) cin[i] = 0.f;
    float s = carry, At = 1.f;
#pragma unroll
    for (int i = 0; i < 16; ++i) { const float oA = __shfl_xor(rA[i], 32), oH = __shfl_xor(rH[i], 32);
        { const bool mine = (lh == 0); const float a = mine ? rA[i] : oA, hh = mine ? rH[i] : oH; cin[i] = mine ? s : cin[i]; s = a * s + hh; At *= a; }
        { const bool mine = (lh == 1); const float a = mine ? rA[i] : oA, hh = mine ? rH[i] : oH; cin[i] = mine ? s : cin[i]; s = a * s + hh; At *= a; } }
    if (!FINAL) {
        if (lh == 0) { float* o = (float*)(p.ws + WS_AGG) + (size_t)(agg_dir_off + sc * 2048) * 2; o[0] = At; o[1] = s; }
        return;
    }
#pragma unroll
    for (int mb = 0; mb < 4; ++mb)
#pragma unroll
        for (int r = 0; r < 16; ++r) accI[mb][r] += accA[mb][r] * cin[mb * 4 + (r >> 2)];
}
template <bool FINAL>
__device__ void lru_tile(const Params& p, LAS unsigned char* lds, int item) {
    const int tid = threadIdx.x, lane = tid & 63, wid = __builtin_amdgcn_readfirstlane(tid >> 6);
    int b, sc, head;
    if (FINAL) { head = item & 7; sc = 2 + ((item >> 3) & 31); b = item >> 8; }
    else { head = item & 7; const int r = item >> 3; sc = r & 1; b = r >> 1; }
    const bf16_t* src; int Tseq, t0, ld;
    if (sc < 2) { src = (const bf16_t*)(p.ws + WS_ZXC) + (size_t)b * 256 * 1024; Tseq = 256; t0 = sc * 128; ld = 1024; }
    else { src = (const bf16_t*)(p.ws + WS_RZ) + (size_t)b * 4096 * 4096; Tseq = 4096; t0 = (sc - 2) * 128; ld = 4096; }
    LAS unsigned char* ul = lds;
    LAS float* ybuf = (LAS float*)(lds + 36 * 1024);
    {
        const int c8 = tid & 15, tb = tid >> 4; const int ch0 = head * 128 + 8 * c8;
        float w[4][8], bias[8];
#pragma unroll
        for (int k = 0; k < 4; ++k) { const f32x4 a = *(const f32x4*)(p.conv_w + k * 1024 + ch0), c2 = *(const f32x4*)(p.conv_w + k * 1024 + ch0 + 4);
#pragma unroll
            for (int j = 0; j < 4; ++j) { w[k][j] = a[j]; w[k][4 + j] = c2[j]; } }
        { const f32x4 a = *(const f32x4*)(p.conv_b + ch0), c2 = *(const f32x4*)(p.conv_b + ch0 + 4);
#pragma unroll
            for (int j = 0; j < 4; ++j) { bias[j] = a[j]; bias[4 + j] = c2[j]; } }
#pragma unroll
        for (int i = 0; i < 4; ++i) { const int t = tb + 32 * i; float a[8];
#pragma unroll
            for (int j = 0; j < 8; ++j) a[j] = bias[j];
#pragma unroll
            for (int k = 0; k < 4; ++k) { const int tt = t0 + t + k - 2;
                if (tt >= 0 && tt < Tseq) { float f[8]; unpack8(*(const u32x4*)(src + (size_t)tt * ld + ch0), f);
#pragma unroll
                    for (int j = 0; j < 8; ++j) a[j] += w[k][j] * f[j]; } }
            u32x4 wv; wv.x = cvt_pk_bf16(a[0], a[1]); wv.y = cvt_pk_bf16(a[2], a[3]); wv.z = cvt_pk_bf16(a[4], a[5]); wv.w = cvt_pk_bf16(a[6], a[7]);
            *(LAS u32x4*)(ul + t * 272 + c8 * 16) = wv; }
    }
    __syncthreads();
    f32x16 hacc[4];
    if (wid < 4) lru_wave<FINAL, 0>(p, ul, b, sc, head, wid & 3, lane, hacc);
    else lru_wave<FINAL, 1>(p, ul, b, sc, head, wid & 3, lane, hacc);
    if (FINAL) {
        const int lr = lane & 31, lh = lane >> 5, chl = (wid & 3) * 32 + lr;
        if (wid >= 4) { LAS float* yp = ybuf + (127 - 4 * lh) * 129 + chl;
#pragma unroll
            for (int mb = 0; mb < 4; ++mb)
#pragma unroll
                for (int r = 0; r < 16; ++r) yp[-LRU_CST(mb, r) * 129] = hacc[mb][r]; }
        __syncthreads();
        if (wid < 4) {
            const LAS float* yp = ybuf + (4 * lh) * 129 + chl;
            const bf16_t* Zu = (const bf16_t*)(p.ws + WS_RZ) + ((size_t)(b * 4096 + t0) * 4096 + 1024 + head * 128);
            bf16_t* Ou = (bf16_t*)(p.ws + WS_R1) + ((size_t)(b * 4096 + t0) * 1024 + head * 128);
            const unsigned zo = (unsigned)(4 * lh * 4096 + chl), oo = (unsigned)(4 * lh * 1024 + chl);
#pragma unroll
            for (int mb = 0; mb < 4; ++mb) {
#pragma unroll
                for (int r = 0; r < 16; ++r) {
                    const float y = hacc[mb][r] + yp[LRU_CST(mb, r) * 129];
                    const float gz = bf2f(Zu[zo + LRU_CST(mb, r) * 4096]);
                    Ou[oo + LRU_CST(mb, r) * 1024] = (bf16_t)(cvt_pk_bf16(gz * y, 0.f) & 0xffffu);
                    if ((r & 7) == 7) __builtin_amdgcn_sched_barrier(0); } }
        }
    }
    __syncthreads();
}

typedef unsigned long long u64_t;
template <int DIR>
__device__ __forceinline__ void lru2_dir(const Params& p, LAS unsigned char* ul, int head, int w, int lane, f32x4 (&hl)[8], f32x4 (&pp)[8], float& Atot, float& Htot) {
    constexpr int SG = DIR ? -1 : 1;
    const int fr = lane & 15, fq = lane >> 4, chl = 16 * w + fr, ch = head * 128 + chl;
    f32x4 accA[8], accI[8];
#pragma unroll
    for (int rb = 0; rb < 8; ++rb) { accA[rb] = (f32x4){0.f, 0.f, 0.f, 0.f}; accI[rb] = (f32x4){0.f, 0.f, 0.f, 0.f}; }
    {
        const bf16_t* wa = (const bf16_t*)(p.ws + WS_WAT) + ((size_t)(DIR * 8 + head) * 128 + chl) * 128 + 8 * fq;
        const bf16_t* wi = (const bf16_t*)(p.ws + WS_WIT) + ((size_t)(DIR * 8 + head) * 128 + chl) * 128 + 8 * fq;
        bf16x8 bA[4], bI[4];
#pragma unroll
        for (int ks = 0; ks < 4; ++ks) { bA[ks] = *(const bf16x8*)(wa + 32 * ks); bI[ks] = *(const bf16x8*)(wi + 32 * ks); }
        LAS unsigned char* arow0 = ul + (DIR ? 127 - fr : fr) * 272 + fq * 16;
#pragma unroll
        for (int rb = 0; rb < 8; ++rb)
#pragma unroll
            for (int ks = 0; ks < 4; ++ks) { const bf16x8 af = *(const LAS bf16x8*)(arow0 + SG * 16 * rb * 272 + 64 * ks);
                accA[rb] = __builtin_amdgcn_mfma_f32_16x16x32_bf16(af, bA[ks], accA[rb], 0, 0, 0);
                accI[rb] = __builtin_amdgcn_mfma_f32_16x16x32_bf16(af, bI[ks], accI[rb], 0, 0, 0); }
    }
    {
        const float lam = p.lru_lambda[DIR * 1024 + ch]; const float sp8 = 8.0f * log1pf(expf(-lam));
        const float ba = p.lru_ba[DIR * 1024 + ch], bi = p.lru_bi[DIR * 1024 + ch];
        LAS unsigned char* up = ul + (DIR ? 127 - 4 * fq : 4 * fq) * 272 + chl * 2;
#pragma unroll
        for (int rb = 0; rb < 8; ++rb)
#pragma unroll
            for (int r = 0; r < 4; ++r) {
                const float uv = bf2f(*(const LAS bf16_t*)(up + SG * (16 * rb + r) * 272));
                const float rg = sigmoidf_(accA[rb][r] + ba), ig = sigmoidf_(accI[rb][r] + bi);
                const float a = __expf(-sp8 * rg); accA[rb][r] = a; accI[rb][r] = sqrtf(fmaxf(1.0f - a * a, 0.f)) * ig * uv;
                if (r == 3 && (rb & 1)) __builtin_amdgcn_sched_barrier(0); }
    }
    float rA[8], rH[8];
#pragma unroll
    for (int rb = 0; rb < 8; ++rb) { float pa = 1.f, hh = 0.f;
#pragma unroll
        for (int r = 0; r < 4; ++r) { const float a = accA[rb][r], bb = accI[rb][r]; hh = a * hh + bb; pa *= a; accA[rb][r] = pa; accI[rb][r] = hh; }
        rA[rb] = pa; rH[rb] = hh; }
    float Pc = 1.f, s = 0.f;
#pragma unroll
    for (int rb = 0; rb < 8; ++rb) { float Pin = 1.f, Hin = 0.f;
#pragma unroll
        for (int q = 0; q < 4; ++q) { const float a = __shfl(rA[rb], fr + 16 * q), hh = __shfl(rH[rb], fr + 16 * q);
            if (q == fq) { Pin = Pc; Hin = s; }
            s = a * s + hh; Pc *= a; }
#pragma unroll
        for (int r = 0; r < 4; ++r) { hl[rb][r] = accI[rb][r] + accA[rb][r] * Hin; pp[rb][r] = accA[rb][r] * Pin; }
        __builtin_amdgcn_sched_barrier(0); }
    Atot = Pc; Htot = s;
}
__device__ __forceinline__ u64_t agg_ld(const u64_t* a) { return __hip_atomic_load(a, __ATOMIC_RELAXED, __HIP_MEMORY_SCOPE_AGENT); }
template <int DIR>
__device__ __forceinline__ float lru2_carry(const u64_t* aggc, int n, int fr, int fq) {
    float Ap = 1.f, Hp = 0.f; u64_t v[9];
#pragma unroll
    for (int k = 0; k < 9; ++k) { const int j = fq * 9 + k; const int seq = DIR ? (j == 0 ? 1 : (j == 1 ? 0 : 35 - j)) : j;
        v[k] = (j < n) ? agg_ld(aggc + (size_t)seq * 2048) : 0x000000003f800000ull; }
#pragma unroll
    for (int k = 0; k < 9; ++k) { const float a = __uint_as_float((unsigned)v[k]), hh = __uint_as_float((unsigned)(v[k] >> 32)); Hp = a * Hp + hh; Ap *= a; }
    float s = 0.f;
#pragma unroll
    for (int q = 0; q < 4; ++q) { const float a = __shfl(Ap, fr + 16 * q), hh = __shfl(Hp, fr + 16 * q); s = a * s + hh; }
    return s;
}
__device__ void lru2_tile(const Params& p, LAS unsigned char* lds, int g, int c, unsigned* gcnt) {
    const int tid = threadIdx.x, lane = tid & 63, wid = __builtin_amdgcn_readfirstlane(tid >> 6);
    const int b = g >> 3, head = g & 7, sc = c + 2, t0 = c * 128;
    LAS unsigned char* raw = lds;
    LAS unsigned char* ul = lds + 33792;
    LAS unsigned char* gzl = lds + 68608;
    LAS unsigned char* outl = lds + 103424;
    const bf16_t* Zb = (const bf16_t*)(p.ws + WS_RZ) + (size_t)b * 4096 * 4096 + head * 128;
#pragma unroll
    for (int k = 0; k < 5; ++k) { const int pc = tid + NTHR * k;
        if (pc < 131 * 16) { const int row = pc >> 4, c8 = pc & 15, tt = t0 - 2 + row; u32x4 v = (u32x4){0u, 0u, 0u, 0u};
            if (tt >= 0 && tt < TT) v = *(const u32x4*)(Zb + (size_t)tt * 4096 + c8 * 8);
            *(LAS u32x4*)(raw + row * 256 + c8 * 16) = v; } }
#pragma unroll
    for (int k = 0; k < 4; ++k) { const int pc = tid + NTHR * k, row = pc >> 4, c8 = pc & 15;
        *(LAS u32x4*)(gzl + row * 272 + c8 * 16) = *(const u32x4*)(Zb + (size_t)(t0 + row) * 4096 + 1024 + c8 * 8); }
    __syncthreads();
    {
        const int c8 = tid & 15, tb = tid >> 4; const int ch0 = head * 128 + 8 * c8;
        float w[4][8], bias[8];
#pragma unroll
        for (int k = 0; k < 4; ++k) { const f32x4 a = *(const f32x4*)(p.conv_w + k * 1024 + ch0), c2 = *(const f32x4*)(p.conv_w + k * 1024 + ch0 + 4);
#pragma unroll
            for (int j = 0; j < 4; ++j) { w[k][j] = a[j]; w[k][4 + j] = c2[j]; } }
        { const f32x4 a = *(const f32x4*)(p.conv_b + ch0), c2 = *(const f32x4*)(p.conv_b + ch0 + 4);
#pragma unroll
            for (int j = 0; j < 4; ++j) { bias[j] = a[j]; bias[4 + j] = c2[j]; } }
#pragma unroll
        for (int i = 0; i < 4; ++i) { const int t = tb + 32 * i; float a[8];
#pragma unroll
            for (int j = 0; j < 8; ++j) a[j] = bias[j];
#pragma unroll
            for (int k = 0; k < 4; ++k) { float f[8]; unpack8(*(const LAS u32x4*)(raw + (t + k) * 256 + c8 * 16), f);
#pragma unroll
                for (int j = 0; j < 8; ++j) a[j] += w[k][j] * f[j]; }
            u32x4 wv; wv.x = cvt_pk_bf16(a[0], a[1]); wv.y = cvt_pk_bf16(a[2], a[3]); wv.z = cvt_pk_bf16(a[4], a[5]); wv.w = cvt_pk_bf16(a[6], a[7]);
            *(LAS u32x4*)(ul + t * 272 + c8 * 16) = wv; }
    }
    __syncthreads();
    const int fr = lane & 15, fq = lane >> 4, chl = 16 * wid + fr, ch = head * 128 + chl;
    float A0, H0, A1, H1;
    {
        f32x4 hl1[8], pp1[8];
        lru2_dir<1>(p, ul, head, wid, lane, hl1, pp1, A1, H1);
        LAS unsigned char* hp = outl + (127 - 4 * fq) * 272 + chl * 2; LAS unsigned char* qp = raw + (127 - 4 * fq) * 256 + chl * 2;
#pragma unroll
        for (int rb = 0; rb < 8; ++rb)
#pragma unroll
            for (int r = 0; r < 4; ++r) { *(LAS bf16_t*)(hp - (16 * rb + r) * 272) = (bf16_t)(cvt_pk_bf16(hl1[rb][r], 0.f) & 0xffffu); *(LAS bf16_t*)(qp - (16 * rb + r) * 256) = (bf16_t)(cvt_pk_bf16(pp1[rb][r], 0.f) & 0xffffu); }
    }
    __builtin_amdgcn_sched_barrier(0);
    f32x4 hl0[8], pp0[8];
    lru2_dir<0>(p, ul, head, wid, lane, hl0, pp0, A0, H0);
    u64_t* agg = (u64_t*)(p.ws + WS_AGG);
    const size_t ai0 = ((size_t)(b * NSEQ) * 2 + 0) * 1024 + ch, ai1 = ((size_t)(b * NSEQ) * 2 + 1) * 1024 + ch;
    if (fq == 0) {
        __hip_atomic_store(agg + ai0 + (size_t)sc * 2048, ((u64_t)__float_as_uint(H0) << 32) | __float_as_uint(A0), __ATOMIC_RELAXED, __HIP_MEMORY_SCOPE_AGENT);
        __hip_atomic_store(agg + ai1 + (size_t)sc * 2048, ((u64_t)__float_as_uint(H1) << 32) | __float_as_uint(A1), __ATOMIC_RELAXED, __HIP_MEMORY_SCOPE_AGENT); }
    asm volatile("s_waitcnt vmcnt(0)" ::: "memory");
    __syncthreads();
    if (tid == 0) (void)__hip_atomic_fetch_add(gcnt, 1u, __ATOMIC_RELAXED, __HIP_MEMORY_SCOPE_AGENT);
    if (wid == 0) { unsigned sp = 0;
        while ((unsigned)__builtin_amdgcn_readfirstlane(__hip_atomic_load(gcnt, __ATOMIC_RELAXED, __HIP_MEMORY_SCOPE_AGENT)) < 32u) { __builtin_amdgcn_s_sleep(1); if (++sp > (1u << 22)) break; }
        __builtin_amdgcn_fence(__ATOMIC_ACQUIRE, "agent");
        asm volatile("s_waitcnt vmcnt(0)" ::: "memory"); }
    __syncthreads();
    const float C0 = lru2_carry<0>(agg + ai0, sc, fr, fq);
    const float C1 = lru2_carry<1>(agg + ai1, 2 + (NSEQ - 1 - sc), fr, fq);
    LAS unsigned char* gp = gzl + (4 * fq) * 272 + chl * 2; LAS unsigned char* op = outl + (4 * fq) * 272 + chl * 2; LAS unsigned char* qp0 = raw + (4 * fq) * 256 + chl * 2;
#pragma unroll
    for (int rb = 0; rb < 8; ++rb)
#pragma unroll
        for (int r = 0; r < 4; ++r) { const float h1 = bf2f(*(const LAS bf16_t*)(op + (16 * rb + r) * 272)) + bf2f(*(const LAS bf16_t*)(qp0 + (16 * rb + r) * 256)) * C1;
            const float y = hl0[rb][r] + pp0[rb][r] * C0 + h1;
            const float gz = bf2f(*(const LAS bf16_t*)(gp + (16 * rb + r) * 272));
            *(LAS bf16_t*)(op + (16 * rb + r) * 272) = (bf16_t)(cvt_pk_bf16(gz * y, 0.f) & 0xffffu); }
    __syncthreads();
    bf16_t* Ob = (bf16_t*)(p.ws + WS_R1) + ((size_t)(b * 4096 + t0)) * 1024 + head * 128;
#pragma unroll
    for (int k = 0; k < 4; ++k) { const int pc = tid + NTHR * k, row = pc >> 4, c8 = pc & 15;
        *(u32x4*)(Ob + (size_t)row * 1024 + c8 * 8) = *(const LAS u32x4*)(outl + row * 272 + c8 * 16); }
    __syncthreads();
}

__device__ void fft_stage2(const Params& p, LAS unsigned char* lds, int item) {
    const int tid = threadIdx.x, b = item >> 8, k1 = item & 255;
    LAS unsigned char* yl = lds;
    LAS float* cf = (LAS float*)(lds + 32768);
    const bf16_t* Yt = (const bf16_t*)((const unsigned char*)p.out + OUT_YT);
#pragma unroll
    for (int k = 0; k < 4; ++k) { const int pc = tid + NTHR * k, ri = pc >> 10, o = (pc & 1023) * 8;
        *(LAS u32x4*)(yl + ri * 16384 + o * 2) = *(const u32x4*)(Yt + (size_t)(k1 * 2 + ri) * 65536 + (size_t)b * 8192 + o); }
    if (tid < 256) { const int k2 = tid >> 4, t2 = tid & 15; float sn, cs; sincospif((float)(((k1 + 256 * k2) * t2) & 4095) * (1.0f / 2048.0f), &sn, &cs); cf[tid * 2] = cs; cf[tid * 2 + 1] = sn; }
    __syncthreads();
    float yr[16], yi[16];
    { float f[8]; unpack8(*(const LAS u32x4*)(yl + tid * 32), f);
#pragma unroll
      for (int j = 0; j < 8; ++j) yr[j] = f[j];
      unpack8(*(const LAS u32x4*)(yl + tid * 32 + 16), f);
#pragma unroll
      for (int j = 0; j < 8; ++j) yr[8 + j] = f[j];
      unpack8(*(const LAS u32x4*)(yl + 16384 + tid * 32), f);
#pragma unroll
      for (int j = 0; j < 8; ++j) yi[j] = f[j];
      unpack8(*(const LAS u32x4*)(yl + 16384 + tid * 32 + 16), f);
#pragma unroll
      for (int j = 0; j < 8; ++j) yi[8 + j] = f[j]; }
    bf16_t* Fo = (bf16_t*)((unsigned char*)p.out + OUT_F) + ((size_t)b * 4096 + k1) * 512 + tid;
#pragma unroll
    for (int k2 = 0; k2 < 16; ++k2) { float a = 0.f;
#pragma unroll
        for (int t2 = 0; t2 < 16; ++t2) { const float cs = cf[(k2 * 16 + t2) * 2], sn = cf[(k2 * 16 + t2) * 2 + 1]; a += cs * yr[t2] + sn * yi[t2]; }
        Fo[(size_t)k2 * 256 * 512] = (bf16_t)(cvt_pk_bf16(a, 0.f) & 0xffffu); }
    __syncthreads();
}

__device__ void phase7_rows(const Params& p, LAS unsigned char* lds) {
    const int tid = threadIdx.x, lane = tid & 63, wid = tid >> 6;
    LAS float* wrt = (LAS float*)lds;
    for (int i = tid; i < 16 * 1024; i += NTHR) { const int d = i >> 4, e = i & 15; wrt[e * 1024 + d] = p.w_router[i]; }
    __syncthreads();
    const float* ada = (const float*)(p.ws + WS_ADA); bf16_t* h2 = (bf16_t*)(p.ws + WS_R1); float* scores = (float*)(p.ws + WS_SCORES);
    for (int row = blockIdx.x * 8 + wid; row < MLAT; row += gridDim.x * 8) {
        const int b = row >> 12, t = row & 4095; const float* xr = p.out + (size_t)row * 1024;
        f32x4 v[4]; float ss = 0.f;
#pragma unroll
        for (int i = 0; i < 4; ++i) { v[i] = *(const f32x4*)(xr + 256 * i + 4 * lane); ss += v[i][0] * v[i][0] + v[i][1] * v[i][1] + v[i][2] * v[i][2] + v[i][3] * v[i][3]; }
        ss = wave_sum(ss); const float rs = rsqrtf(ss * (1.0f / 1024.0f) + 1e-6f);
#pragma unroll
        for (int i = 0; i < 4; ++i) { const int d = 256 * i + 4 * lane;
            const f32x4 g = *(const f32x4*)(p.norm2_g + d), sh = *(const f32x4*)(ada + b * 6144 + 3072 + d), sc = *(const f32x4*)(ada + b * 6144 + 4096 + d);
            v[i] = v[i] * rs * g * (sc + 1.0f) + sh;
            u32x2 w; w.x = cvt_pk_bf16(v[i][0], v[i][1]); w.y = cvt_pk_bf16(v[i][2], v[i][3]); *(u32x2*)(h2 + (size_t)row * 1024 + d) = w; }
        float lg[16];
#pragma unroll
        for (int e = 0; e < 16; ++e) { float a = 0.f;
#pragma unroll
            for (int i = 0; i < 4; ++i) { const f32x4 w = *(const LAS f32x4*)(wrt + e * 1024 + 256 * i + 4 * lane); a += v[i][0] * w[0] + v[i][1] * w[1] + v[i][2] * w[2] + v[i][3] * w[3]; }
            lg[e] = wave_sum(a); }
        float mx = lg[0];
#pragma unroll
        for (int e = 1; e < 16; ++e) mx = fmaxf(mx, lg[e]);
        float sum = 0.f;
#pragma unroll
        for (int e = 0; e < 16; ++e) { lg[e] = expf(lg[e] - mx); sum += lg[e]; }
        const float inv = 1.0f / sum; float mine = 0.f;
#pragma unroll
        for (int e = 0; e < 16; ++e) mine = (lane == e) ? lg[e] * inv : mine;
        if (lane < 16) scores[((size_t)b * 16 + lane) * 4096 + t] = mine;
    }
    __syncthreads();
}
__device__ void phase7_weights(const Params& p) {
    constexpr int N_G = 16 * 16 * 6, N_D = 16 * 24 * 4;
    for (int it = blockIdx.x; it < 2 * N_G + N_D; it += gridDim.x) {
        if (it < 2 * N_G) { const int up = it >= N_G, j = up ? it - N_G : it, e = j / 96, r = j % 96, kb = r / 6, nb = r % 6;
            xpose_item<4>((up ? p.w_up_e : p.w_gate_e) + (size_t)e * 1024 * 1536, 1536, (bf16_t*)(p.ws + WS_WGU) + (size_t)e * 3072 * 1024, 1024, kb * 64, nb * 256, up ? 2 : 1); }
        else { const int j = it - 2 * N_G, e = j / 96, r = j % 96, kb = r >> 2, nb = r & 3;
            xpose_item<4>(p.w_down_e + (size_t)e * 1536 * 1024, 1024, (bf16_t*)(p.ws + WS_WD) + (size_t)e * 1024 * 1536, 1536, kb * 64, nb * 256, 0); }
    }
}

__device__ void phase8_topk(const Params& p, LAS unsigned char* lds) {
    const int tid = threadIdx.x, lane = tid & 63, wid = tid >> 6;
    LAS unsigned* cnt = (LAS unsigned*)lds;
    LAS unsigned* wsum = cnt + 16;
    const float* scores = (const float*)(p.ws + WS_SCORES);
    int* idx = (int*)(p.ws + WS_IDX); float* gate = (float*)(p.ws + WS_GATE); int* slot_of = (int*)(p.ws + WS_SLOT);
    for (int it = blockIdx.x; it < NB * NE; it += gridDim.x) {
        const int b = it >> 4, e = it & 15;
        unsigned key[8];
        { const u32x4* sp = (const u32x4*)(scores + (size_t)it * 4096 + tid * 8); const u32x4 a = sp[0], c2 = sp[1]; key[0] = a.x; key[1] = a.y; key[2] = a.z; key[3] = a.w; key[4] = c2.x; key[5] = c2.y; key[6] = c2.z; key[7] = c2.w; }
        unsigned thr = 0;
        for (int bit = 30; bit >= 0; --bit) {
            const unsigned cand = thr | (1u << bit); unsigned c = 0;
#pragma unroll
            for (int j = 0; j < 8; ++j) c += (unsigned)__popcll(__ballot(key[j] >= cand));
            LAS unsigned* cb = cnt + (bit & 1) * 8;
            if (lane == 0) cb[wid] = c;
            __syncthreads();
            unsigned tot = 0;
#pragma unroll
            for (int w = 0; w < 8; ++w) tot += cb[w];
            if (tot >= (unsigned)CAP) thr = cand;
        }
        unsigned cg_ = 0, ce = 0;
#pragma unroll
        for (int j = 0; j < 8; ++j) { cg_ += key[j] > thr; ce += key[j] == thr; }
        unsigned pk = cg_ | (ce << 16), incl = pk;
#pragma unroll
        for (int o = 1; o < 64; o <<= 1) { const unsigned n = __shfl_up(incl, o); if (lane >= o) incl += n; }
        if (lane == 63) wsum[wid] = incl;
        __syncthreads();
        unsigned base = 0, total = 0;
#pragma unroll
        for (int w = 0; w < 8; ++w) { const unsigned s = wsum[w]; if (w < wid) base += s; total += s; }
        const unsigned excl = base + incl - pk; unsigned og = excl & 0xffffu, oe = excl >> 16; const unsigned ngt = total & 0xffffu, krem = (unsigned)CAP - ngt;
#pragma unroll
        for (int j = 0; j < 8; ++j) { const int t = tid * 8 + j; int m = -1;
            if (key[j] > thr) { m = (e * 8 + b) * 512 + (int)og; ++og; }
            else if (key[j] == thr) { if (oe < krem) m = (e * 8 + b) * 512 + (int)(ngt + oe); ++oe; }
            slot_of[((size_t)b * 4096 + t) * 16 + e] = m;
            if (m >= 0) { idx[m] = b * 4096 + t; gate[m] = __uint_as_float(key[j]); } }
        __syncthreads();
    }
}

__device__ void phase11(const Params& p, float* dst) {
    const int lane = threadIdx.x & 63, wid = threadIdx.x >> 6;
    const float* ada = (const float*)(p.ws + WS_ADA); const int* slot_of = (const int*)(p.ws + WS_SLOT); const bf16_t* oute = (const bf16_t*)(p.ws + WS_OUTE);
    const int stride = gridDim.x * 8;
    int row = blockIdx.x * 8 + wid;
    int myslot = row < MLAT ? slot_of[(size_t)row * 16 + (lane & 15)] : -1;
    for (; row < MLAT; row += stride) {
        const int b = row >> 12; float* xr = p.out + (size_t)row * 1024;
        const int nrow = row + stride; const int nslot = nrow < MLAT ? slot_of[(size_t)nrow * 16 + (lane & 15)] : -1;
        f32x4 xv[4];
#pragma unroll
        for (int i = 0; i < 4; ++i) xv[i] = *(const f32x4*)(xr + 256 * i + 4 * lane);
        f32x4 acc[4];
#pragma unroll
        for (int i = 0; i < 4; ++i) acc[i] = (f32x4){0.f, 0.f, 0.f, 0.f};
        unsigned long long mask = __ballot(myslot >= 0) & 0xffffull;
        while (mask) {
            int m[4];
#pragma unroll
            for (int j = 0; j < 4; ++j) { if (mask) { const int e = __builtin_ctzll(mask); mask &= mask - 1; m[j] = __builtin_amdgcn_readlane(myslot, e); } else m[j] = MMOE; }
            u32x2 w[4][4];
#pragma unroll
            for (int j = 0; j < 4; ++j)
#pragma unroll
                for (int i = 0; i < 4; ++i) w[j][i] = *(const u32x2*)(oute + (size_t)m[j] * 1024 + 256 * i + 4 * lane);
#pragma unroll
            for (int j = 0; j < 4; ++j)
#pragma unroll
                for (int i = 0; i < 4; ++i) { acc[i][0] += bf_lo(w[j][i].x); acc[i][1] += bf_hi(w[j][i].x); acc[i][2] += bf_lo(w[j][i].y); acc[i][3] += bf_hi(w[j][i].y); }
        }
        f32x4 v[4]; float ss = 0.f;
#pragma unroll
        for (int i = 0; i < 4; ++i) { const int d = 256 * i + 4 * lane; const f32x4 g2 = *(const f32x4*)(ada + b * 6144 + 5120 + d); v[i] = xv[i] + g2 * acc[i];
            ss += v[i][0] * v[i][0] + v[i][1] * v[i][1] + v[i][2] * v[i][2] + v[i][3] * v[i][3]; }
        ss = wave_sum(ss); const float rs = rsqrtf(ss * (1.0f / 1024.0f) + 1e-6f);
#pragma unroll
        for (int i = 0; i < 4; ++i) { const int d = 256 * i + 4 * lane; *(f32x4*)(dst + (size_t)row * 1024 + d) = v[i] * rs * *(const f32x4*)(p.final_g + d); }
        myslot = nslot;
    }
}

#define XB_TMO      128
#define XB_XCNT(j)  (256  + 64 * (j))
#define XB_XSUB(j)  (1280 + 64 * (j))
#define XB_XGEN(j)  (2304 + 64 * (j))
#define XB_TOP      3328
#define XB_TOPGEN   3392
#define XCD_BAR_WORDS 3456
#define XB_SPIN_CAP (1u << 22)
__device__ __forceinline__ unsigned xb_ld(unsigned* p)              { return __hip_atomic_load(p, __ATOMIC_RELAXED, __HIP_MEMORY_SCOPE_AGENT); }
__device__ __forceinline__ unsigned xb_add(unsigned* p, unsigned v) { return __hip_atomic_fetch_add(p, v, __ATOMIC_RELAXED, __HIP_MEMORY_SCOPE_AGENT); }
__device__ __forceinline__ unsigned xb_xcc_id() { return (unsigned)__builtin_amdgcn_s_getreg((3 << 11) | 20) & 0xFu; }
#define XB_SPIN(cond, bar) do { unsigned _sp = 0; while (cond) { __builtin_amdgcn_s_sleep(1); \
    if ((++_sp & 255u) == 0u) { if (xb_ld(&(bar)[XB_TMO])) break; if (_sp > XB_SPIN_CAP) { atomicAdd(&(bar)[XB_TMO], 1u); break; } } } } while (0)
struct XcdBarrier { unsigned* bar; unsigned x; volatile LAS unsigned* st; };
__device__ __forceinline__ XcdBarrier xcd_barrier_post(unsigned* bar, volatile LAS unsigned* st) {
    XcdBarrier b; b.bar = bar; b.x = xb_xcc_id(); b.st = st;
    if (threadIdx.x == 0) (void)xb_add(&bar[XB_XCNT(b.x)], 1u);
    return b;
}
__device__ __forceinline__ void xcd_barrier_complete(unsigned* bar, unsigned x, unsigned& nloc, unsigned& nx) {
    const unsigned G = gridDim.x * gridDim.y * gridDim.z;
    unsigned sum, cnt, mine, sp = 0u;
    for (;;) {
        sum = 0u; cnt = 0u; mine = 0u;
#pragma unroll
        for (unsigned j = 0; j < 16; ++j) { const unsigned c = xb_ld(&bar[XB_XCNT(j)]); sum += c; cnt += (c > 0u) ? 1u : 0u; mine = (j == x) ? c : mine; }
        if (sum == G) break;
        __builtin_amdgcn_s_sleep(1);
        if ((++sp & 255u) == 0u) { if (xb_ld(&bar[XB_TMO])) break; if (sp > XB_SPIN_CAP) { atomicAdd(&bar[XB_TMO], 1u); break; } }
    }
    nloc = mine > 0u ? mine : 1u; nx = cnt > 0u ? cnt : 1u;
}
__device__ __forceinline__ void xcd_barrier(const XcdBarrier& b) {
    asm volatile("s_waitcnt vmcnt(0)" ::: "memory");
    __syncthreads();
    if (threadIdx.x == 0) {
        unsigned* bar = b.bar;
        __builtin_amdgcn_s_waitcnt(0);
        unsigned nloc = b.st[0], nx = b.st[1];
        if (nloc == 0u) { xcd_barrier_complete(bar, b.x, nloc, nx); b.st[0] = nloc; b.st[1] = nx; }
        const unsigned old = xb_add(&bar[XB_XSUB(b.x)], 1u);
        const unsigned gen = old / nloc;
        if (old + 1u == (gen + 1u) * nloc) {
            __builtin_amdgcn_fence(__ATOMIC_RELEASE, "agent");
            asm volatile("s_waitcnt vmcnt(0)" ::: "memory");
            const unsigned og = xb_add(&bar[XB_TOP], 1u);
            const unsigned tg = og / nx;
            if (og + 1u == (tg + 1u) * nx) xb_add(&bar[XB_TOPGEN], 1u);
            else XB_SPIN(xb_ld(&bar[XB_TOPGEN]) == tg, bar);
            __builtin_amdgcn_fence(__ATOMIC_ACQUIRE, "agent");
            xb_add(&bar[XB_XGEN(b.x)], 1u);
            asm volatile("s_waitcnt vmcnt(0)" ::: "memory");
        } else {
            XB_SPIN(xb_ld(&bar[XB_XGEN(b.x)]) == gen, bar);
            __builtin_amdgcn_fence(__ATOMIC_ACQUIRE, "agent");
            asm volatile("s_waitcnt vmcnt(0)" ::: "memory");
        }
    }
    __syncthreads();
}

__global__ void __launch_bounds__(NTHR, 2) fwd_megakernel(Params p) {
    extern __shared__ __attribute__((aligned(16))) unsigned char lds_raw[];
    LAS unsigned char* lds = (LAS unsigned char*)lds_raw;
    cg::grid_group grid = cg::this_grid();
    const int G = gridDim.x, bid = blockIdx.x;
    unsigned char* ws = p.ws;
    bf16_t* const R1 = (bf16_t*)(ws + WS_R1); bf16_t* const Zb = (bf16_t*)(ws + WS_RZ); bf16_t* const PQt = (bf16_t*)(ws + WS_RPQ); bf16_t* const MRG = (bf16_t*)(ws + WS_R2);
    bf16_t* const Fb = (bf16_t*)((unsigned char*)p.out + OUT_F); bf16_t* const Ytb = (bf16_t*)((unsigned char*)p.out + OUT_YT);
#ifdef ONLY_PH
#define PH(k) ((k) == ONLY_PH && p.ph_lo <= (k) && (k) < p.ph_hi)
#else
#define PH(k) (p.ph_lo <= (k) && (k) < p.ph_hi)
#endif
    volatile LAS unsigned* xst = (volatile LAS unsigned*)(lds + LDS_BYTES - 16);
    if (threadIdx.x < 4) xst[threadIdx.x] = 0u;
    __syncthreads();
    XcdBarrier xbar = xcd_barrier_post((unsigned*)(ws + WS_BAR), xst);
#define SYNC(k) do { if (PH(k) && PH((k) + 1)) { if ((k) == 0) grid.sync(); else xcd_barrier(xbar); } } while (0)
#ifndef REPMASK
#define REPMASK 0
#endif
#define REP(k) for (int rep_ = 0; rep_ <= ((REPMASK >> (k)) & 1); ++rep_)
    if (PH(0)) REP(0) phase0(p, lds);
    SYNC(0);
    if (PH(1)) REP(1) phase1(p);
    SYNC(1);
    if (PH(2)) REP(2) {
        { ProbPQ pr{(const bf16_t*)(ws + WS_WPQ), R1, 1024, 1024, 16384}; pg8::Order S; S.init(4, 128, G, bid); EpiPQ E{PQt}; pg8::gemm_phase(lds, pr, S, E); }
        { ProbPlain pr{R1, (const bf16_t*)(ws + WS_WIN), 1024, 1024, 1024}; pg8::Order S; S.init(128, 16, G, bid); EpiZ E{Zb, 4096, -1}; pg8::gemm_phase(lds, pr, S, E); }
        { ProbPlain pr{(const bf16_t*)(ws + WS_HCTX), (const bf16_t*)(ws + WS_WIN), 1024, 1024, 1024}; pg8::Order S; S.init(8, 4, G, bid); EpiZ E{(bf16_t*)(ws + WS_ZXC), 1024, 0}; pg8::gemm_phase(lds, pr, S, E); }
    }
    SYNC(2);
    if (PH(3)) REP(3) {
        { ProbPlain pr{(const bf16_t*)(ws + WS_D1T), PQt, 512, 512, 512}; pg8::Order S; S.init(2, 256, G, bid); EpiPlain E{Ytb, 65536}; pg8::gemm_phase(lds, pr, S, E); }
        for (int it = bid; it < NB * 2 * 8; it += G) lru_tile<false>(p, lds, it);
    }
    SYNC(3);
    if (PH(4)) {
        for (int it = bid; it < NB * 256; it += G) fft_stage2(p, lds, it);
        const int ngr = G >> 5;
        if (ngr > 0 && bid < ngr * 32) { const int slot = bid % ngr, c = bid / ngr;
            for (int g = slot; g < NB * 8; g += ngr) lru2_tile(p, lds, g, c, (unsigned*)(ws + WS_BAR + 16 * KiB) + g * 64); }
    }
    SYNC(4);
    if (PH(5)) REP(5) {
        { ProbPlain pr{Fb, (const bf16_t*)(ws + WS_WFOUR), 512, 512, 512}; pg8::Order S; S.init(128, 4, G, bid); EpiY1 E{MRG, Zb}; pg8::gemm_phase(lds, pr, S, E); }
        { ProbPlain pr{R1, (const bf16_t*)(ws + WS_WLRU), 1024, 1024, 1024}; pg8::Order S; S.init(128, 4, G, bid); EpiY2 E{MRG, Zb}; pg8::gemm_phase(lds, pr, S, E); }
    }
    SYNC(5);
    if (PH(6)) REP(6) { ProbPlain pr{MRG, (const bf16_t*)(ws + WS_WOUT), 1024, 1024, 1024}; pg8::Order S; S.init(128, 4, G, bid);
        EpiOut E{p.out, p.x, (const float*)(ws + WS_POS), (const float*)(ws + WS_ADA)}; pg8::gemm_phase(lds, pr, S, E); }
    SYNC(6);
    if (PH(7)) REP(7) { phase7_rows(p, lds); phase7_weights(p); }
    SYNC(7);
    if (PH(8)) REP(8) phase8_topk(p, lds);
    SYNC(8);
    if (PH(9)) REP(9) { ProbMoeUp pr{R1, (const bf16_t*)(ws + WS_WGU), (const int*)(ws + WS_IDX), 1024, 1024, 1024}; pg8::Order S; S.init(256, 12, G, bid); EpiGU E{(bf16_t*)(ws + WS_HID)}; pg8::gemm_phase(lds, pr, S, E); }
    SYNC(9);
    if (PH(10)) { if (bid == 0 && threadIdx.x < 128) *(u32x4*)(ws + WS_OUTE + (size_t)MMOE * 2048 + threadIdx.x * 16) = (u32x4){0u, 0u, 0u, 0u}; }
    if (PH(10)) REP(10) { ProbMoeDown pr{(const bf16_t*)(ws + WS_HID), (const bf16_t*)(ws + WS_WD), 1536, 1536, 1536}; pg8::Order S; S.init(256, 4, G, bid); EpiDown E{(bf16_t*)(ws + WS_OUTE), (const float*)(ws + WS_GATE)}; pg8::gemm_phase(lds, pr, S, E); }
    SYNC(10);
    if (PH(12)) phase11(p, (float*)(ws + WS_HID));
    if (PH(11)) phase11(p, p.out);
}

#ifndef N_LAUNCHES
#define N_LAUNCHES 1
#endif
#ifndef PROBE_DUP
#define PROBE_DUP 0x0
#endif
extern "C" void kernel_launch(void* const* d_in, const int* in_sizes, int n_in, void* d_out, int out_size, void* d_ws, size_t ws_size, hipStream_t stream) {
    static int grid = 0;
    if (grid == 0) {
        if (n_in != 24 || out_size != MLAT * DM || ws_size < WS_END) { fprintf(stderr, "kernel_launch: unexpected shapes (n_in %d out %d ws %zu)\n", n_in, out_size, ws_size); grid = -1; return; }
        int dev = 0, cus = 0, per_cu = 0;
        hipGetDevice(&dev); hipDeviceGetAttribute(&cus, hipDeviceAttributeMultiprocessorCount, dev);
        hipFuncSetAttribute((const void*)fwd_megakernel, hipFuncAttributeMaxDynamicSharedMemorySize, LDS_BYTES);
        hipOccupancyMaxActiveBlocksPerMultiprocessor(&per_cu, (const void*)fwd_megakernel, NTHR, LDS_BYTES);
        if (per_cu < 1) { fprintf(stderr, "kernel_launch: occupancy query reports %d blocks per CU\n", per_cu); per_cu = 1; }
        grid = cus * 1;
        (void)hipGetLastError();
    }
    if (grid < 0) return;
    Params p{};
    const float** f = (const float**)&p;
    for (int i = 0; i < 24; ++i) f[i] = (const float*)d_in[i];
    p.out = (float*)d_out; p.ws = (unsigned char*)d_ws;
    (void)hipMemsetAsync((unsigned char*)d_ws + WS_BAR, 0, 32 * KiB, stream);
#if N_LAUNCHES == 1
    p.ph_lo = 0; p.ph_hi = 12;
    void* args[] = {&p};
    hipError_t e = hipLaunchCooperativeKernel((const void*)fwd_megakernel, dim3(grid), dim3(NTHR), args, LDS_BYTES, stream);
    if (e != hipSuccess) fprintf(stderr, "cooperative launch failed: %s (grid %d)\n", hipGetErrorString(e), grid);
#else
    for (int k = 0; k < 12; ++k) for (int r = 0; r <= ((PROBE_DUP >> k) & 1); ++r) { p.ph_lo = k; p.ph_hi = k + 1; if (k == 11 && r == 0 && ((PROBE_DUP >> 11) & 1)) { p.ph_lo = 12; p.ph_hi = 13; } hipLaunchKernelGGL(fwd_megakernel, dim3(grid), dim3(NTHR), LDS_BYTES, stream, p); }
#endif
}
```

```cpp
#include <hip/hip_runtime.h>
#include <hip/hip_cooperative_groups.h>
#include <cstdio>
namespace cg = cooperative_groups;

#define LAS __attribute__((address_space(3)))
typedef unsigned short bf16_t;
typedef short bf16x8 __attribute__((ext_vector_type(8)));
typedef float f32x4 __attribute__((ext_vector_type(4)));
typedef float f32x16 __attribute__((ext_vector_type(16)));
typedef unsigned u32x4 __attribute__((ext_vector_type(4)));
typedef unsigned u32x2 __attribute__((ext_vector_type(2)));

constexpr int NB = 8, TT = 4096, DM = 1024, CTXL = 256, MLAT = NB * TT, MCTX = NB * CTXL;
constexpr int NE = 16, CAP = 512, DE = 1536, MMOE = NE * NB * CAP;
constexpr int NSEQ = 34;
constexpr int NTHR = 512;
constexpr int LDS_BYTES = 144 * 1024;

constexpr size_t KiB = 1024, MiB = 1024 * 1024;
constexpr size_t WS_ADA = 0;
constexpr size_t WS_POS = 256 * KiB;
constexpr size_t WS_AGG = 512 * KiB;
constexpr size_t WS_WPQ = 5 * MiB;
constexpr size_t WS_WIN = 7 * MiB;
constexpr size_t WS_WFOUR = 15 * MiB;
constexpr size_t WS_WLRU = 16 * MiB;
constexpr size_t WS_WOUT = 18 * MiB;
constexpr size_t WS_WAT = 20 * MiB;
constexpr size_t WS_WIT = 20 * MiB + 512 * KiB;
constexpr size_t WS_SCORES = 21 * MiB;
constexpr size_t WS_IDX = 23 * MiB;
constexpr size_t WS_GATE = 23 * MiB + 256 * KiB;
constexpr size_t WS_SLOT = 23 * MiB + 512 * KiB;
constexpr size_t WS_BAR = 25 * MiB + 512 * KiB;
constexpr size_t WS_D1T = 34 * MiB;
constexpr size_t WS_HCTX = 26 * MiB;
constexpr size_t WS_ZXC = 30 * MiB;
constexpr size_t WS_R1 = 40 * MiB;
constexpr size_t WS_RPQ = 104 * MiB;
constexpr size_t WS_R2 = 168 * MiB;
constexpr size_t WS_RZ = 232 * MiB;
constexpr size_t WS_END = 488 * MiB;
constexpr size_t WS_HID = WS_RZ, WS_WD = WS_RZ + 192 * MiB, WS_WGU = WS_RPQ, WS_OUTE = WS_R1;
constexpr size_t OUT_YT = 0, OUT_F = 64 * MiB;

struct Params {
    const float *x, *c, *ctx, *c_ctx, *w_ada, *b_ada, *norm1_g, *norm2_g, *w_in, *w_four, *conv_w, *conv_b, *lru_lambda,
        *lru_wa, *lru_ba, *lru_wi, *lru_bi, *w_lru, *w_out, *w_router, *w_gate_e, *w_up_e, *w_down_e, *final_g;
    float* out; unsigned char* ws; int ph_lo, ph_hi;
};

__device__ __forceinline__ unsigned cvt_pk_bf16(float lo, float hi) { unsigned r; asm volatile("v_cvt_pk_bf16_f32 %0, %1, %2" : "=v"(r) : "v"(lo), "v"(hi)); return r; }
__device__ __forceinline__ float bf_lo(unsigned w) { return __uint_as_float(w << 16); }
__device__ __forceinline__ float bf_hi(unsigned w) { return __uint_as_float(w & 0xffff0000u); }
__device__ __forceinline__ float bf2f(bf16_t h) { return __uint_as_float(((unsigned)h) << 16); }
__device__ __forceinline__ float sigmoidf_(float v) { return __builtin_amdgcn_rcpf(1.0f + __expf(-v)); }
__device__ __forceinline__ float gelu_tanh(float v) { const float y = 1.5957691216f * (v + 0.044715f * v * v * v); return v * sigmoidf_(y); }
__device__ __forceinline__ float wave_sum(float v) {
#pragma unroll
    for (int o = 32; o >= 1; o >>= 1) v += __shfl_xor(v, o);
    return v;
}
__device__ __forceinline__ void unpack8(const u32x4 w, float (&f)[8]) { f[0] = bf_lo(w.x); f[1] = bf_hi(w.x); f[2] = bf_lo(w.y); f[3] = bf_hi(w.y); f[4] = bf_lo(w.z); f[5] = bf_hi(w.z); f[6] = bf_lo(w.w); f[7] = bf_hi(w.w); }

namespace pg8 {
constexpr int BM = 256, BK = 64, HALF = 128, HTB = HALF * BK * 2, STAGE_BYTES = 8 * HTB, NXCD = 8, WGM = 8;
__device__ __forceinline__ int lds_byte(int r, int c) { const int st = (r >> 4) * 2 + (c >> 5), rr = r & 15, cc = c & 31, ob = rr * 64 + cc * 2; return st * 1024 + (ob ^ (((ob >> 9) & 1) << 5)); }
__device__ __forceinline__ void stage_rc(int b, int& R, int& C) { const int st = b / 1024, sb = b % 1024, swz = sb ^ (((sb >> 9) & 1) << 5); R = (st >> 1) * 16 + swz / 64; C = (st & 1) * 32 + (swz % 64) / 2; }
__device__ __forceinline__ int perm32(int rho) { const int n = rho >> 4, i = rho & 15; return 8 * (i >> 2) + 4 * n + (i & 3); }
struct Unit { int pm, pn; };
struct Order {
    int nM, nN, nwg, G, c;
    __device__ void init(int nM_, int nN_, int G_, int c_) { nM = nM_; nN = nN_; nwg = nM * nN; G = G_; c = c_; }
    __device__ bool next(int i, Unit& u) const {
        const long L = (long)i * G + c; if (L >= nwg) return false;
        int wgid = (int)L; { const int q = nwg / NXCD, r = nwg % NXCD, xcd = wgid % NXCD, off = wgid / NXCD; wgid = (xcd < r ? xcd * (q + 1) : r * (q + 1) + (xcd - r) * q) + off; }
        const int nig = WGM * nN, gid = wgid / nig, fm = gid * WGM, gsz = (nM - fm) < WGM ? (nM - fm) : WGM;
        u.pm = fm + ((wgid % nig) % gsz); u.pn = (wgid % nig) / gsz; return true;
    }
};
template <class P, class Epi>
__device__ __forceinline__ void gemm_phase(LAS unsigned char* lds, const P& pr, const Order& S, const Epi& E) {
    const int tid = threadIdx.x, wid = __builtin_amdgcn_readfirstlane(tid >> 6), lane = tid & 63, wr = wid >> 2, wc = wid & 3, fr = lane & 15, fq = lane >> 4;
    const int nt = pr.K / BK;
    int RA[2], CA[2]; unsigned voffB[2];
#pragma unroll
    for (int i = 0; i < 2; ++i) { int R, C; stage_rc(tid * 16 + i * 8192, R, C); RA[i] = R; CA[i] = C; const int Rb = Epi::PERM ? ((R & ~31) + perm32(R & 31)) : R; voffB[i] = (unsigned)(Rb * pr.ldb + C) * 2u; }
    const size_t kstep = (size_t)(BK * 2);
    const size_t hstepB = (size_t)HALF * pr.ldb * 2;
    const unsigned ldsw = (unsigned)wid * 1024u;
    const int aoff = lds_byte(wr * 64 + fr, fq * 8), boff = lds_byte(wc * 32 + fr, fq * 8);
#define PG8_SA(b, h) (((b) * 2 + (h)) * HTB)
#define PG8_SB(b, h) ((4 + (b) * 2 + (h)) * HTB)
#define PG8_STAGE(bufoff, gbase, voff) do { _Pragma("unroll") for (int _i = 0; _i < 2; ++_i) \
        __builtin_amdgcn_global_load_lds((const unsigned*)((const char*)(gbase) + (voff)[_i]), (LAS unsigned*)(lds + (bufoff) + ldsw + _i * 8192), 16, 0, 0); } while (0)
#define PG8_LDA(dst, b, h) do { _Pragma("unroll") for (int m = 0; m < 4; ++m) _Pragma("unroll") for (int k = 0; k < 2; ++k) dst[m][k] = *(const LAS bf16x8*)(lds + PG8_SA(b, h) + aoff + m * 2048 + k * 1024); } while (0)
#define PG8_LDB(dst, b, h) do { _Pragma("unroll") for (int n = 0; n < 2; ++n) _Pragma("unroll") for (int k = 0; k < 2; ++k) dst[n][k] = *(const LAS bf16x8*)(lds + PG8_SB(b, h) + boff + n * 2048 + k * 1024); } while (0)
#define PG8_MMA(ai, bj, At, Bt) do { __builtin_amdgcn_s_setprio(1); _Pragma("unroll") for (int m = 0; m < 4; ++m) _Pragma("unroll") for (int n = 0; n < 2; ++n) _Pragma("unroll") for (int k = 0; k < 2; ++k) \
        acc[ai][bj][m][n] = __builtin_amdgcn_mfma_f32_16x16x32_bf16(Bt[n][k], At[m][k], acc[ai][bj][m][n], 0, 0, 0); __builtin_amdgcn_s_setprio(0); } while (0)
#define PG8_WAIT_V(n) asm volatile("s_waitcnt vmcnt(" #n ")" ::: "memory")
#define PG8_WAIT_L(n) asm volatile("s_waitcnt lgkmcnt(" #n ")" ::: "memory")
#define PG8_BAR __builtin_amdgcn_s_barrier()
#define PG8_SCHED __builtin_amdgcn_sched_barrier(0)
    Unit cur, nxt; int ui = 0;
    if (!S.next(0, cur)) return;
    f32x4 acc[2][2][4][2];
#pragma unroll
    for (int a = 0; a < 2; ++a)
#pragma unroll
        for (int b = 0; b < 2; ++b)
#pragma unroll
            for (int m = 0; m < 4; ++m)
#pragma unroll
                for (int n = 0; n < 2; ++n) acc[a][b][m][n] = (f32x4){0.f, 0.f, 0.f, 0.f};
    bf16x8 At[4][2], B0[2][2], B1[2][2];
    unsigned vA[2][2], vN[2][2];
    pr.avoff(cur, RA, CA, vA);
#pragma unroll
    for (int h = 0; h < 2; ++h)
#pragma unroll
        for (int i = 0; i < 2; ++i) vN[h][i] = vA[h][i];
    const char* cA = pr.abase(cur); const char* cB = pr.bbase(cur);
    PG8_STAGE(PG8_SB(0, 0), cB, voffB); PG8_STAGE(PG8_SA(0, 0), cA, vA[0]); PG8_STAGE(PG8_SB(0, 1), cB + hstepB, voffB); PG8_STAGE(PG8_SA(0, 1), cA, vA[1]);
    if (wr == 1) PG8_BAR;
    PG8_WAIT_V(4); PG8_BAR;
    PG8_STAGE(PG8_SB(1, 0), cB + kstep, voffB); PG8_STAGE(PG8_SA(1, 0), cA + kstep, vA[0]); PG8_STAGE(PG8_SB(1, 1), cB + hstepB + kstep, voffB);
    PG8_WAIT_V(6); PG8_BAR;
    for (;;) {
        const bool has_next = S.next(ui + 1, nxt);
        const char* nA = has_next ? pr.abase(nxt) : cA; const char* nB = has_next ? pr.bbase(nxt) : cB;
        if (P::GATHER) { if (has_next) pr.avoff(nxt, RA, CA, vN); }
        for (int t = 0; t < nt; t += 2) {
            const bool last = (t == nt - 2);
            const char* a1 = cA + (size_t)(t + 1) * kstep;
            const char* a2 = last ? nA : cA + (size_t)(t + 2) * kstep; const char* b2 = last ? nB : cB + (size_t)(t + 2) * kstep;
            const char* a3 = a2 + kstep; const char* b3 = b2 + kstep;
            unsigned v2[2][2];
#pragma unroll
            for (int h = 0; h < 2; ++h)
#pragma unroll
                for (int i = 0; i < 2; ++i) v2[h][i] = (P::GATHER && last) ? vN[h][i] : vA[h][i];
            PG8_LDB(B0, 0, 0); PG8_SCHED; PG8_LDA(At, 0, 0); PG8_STAGE(PG8_SA(1, 1), a1, vA[1]);
            PG8_WAIT_L(8); PG8_BAR; PG8_WAIT_L(0); PG8_MMA(0, 0, At, B0); PG8_BAR; PG8_SCHED;
            PG8_LDB(B1, 0, 1); PG8_STAGE(PG8_SB(0, 0), b2, voffB);
            PG8_BAR; PG8_WAIT_L(0); PG8_MMA(0, 1, At, B1); PG8_BAR;
            PG8_LDA(At, 0, 1); PG8_STAGE(PG8_SA(0, 0), a2, v2[0]);
            PG8_BAR; PG8_WAIT_L(0); PG8_MMA(1, 0, At, B0); PG8_BAR; PG8_SCHED;
            PG8_STAGE(PG8_SB(0, 1), b2 + hstepB, voffB);
            PG8_WAIT_V(6); PG8_BAR; PG8_MMA(1, 1, At, B1); PG8_BAR;
            PG8_LDB(B0, 1, 0); PG8_SCHED; PG8_LDA(At, 1, 0); PG8_STAGE(PG8_SA(0, 1), a2, v2[1]);
            PG8_WAIT_L(8); PG8_BAR; PG8_WAIT_L(0); PG8_MMA(0, 0, At, B0); PG8_BAR; PG8_SCHED;
            PG8_LDB(B1, 1, 1); PG8_STAGE(PG8_SB(1, 0), b3, voffB);
            PG8_BAR; PG8_WAIT_L(0); PG8_MMA(0, 1, At, B1); PG8_BAR;
            PG8_LDA(At, 1, 1); PG8_STAGE(PG8_SA(1, 0), a3, v2[0]);
            PG8_BAR; PG8_WAIT_L(0); PG8_MMA(1, 0, At, B0); PG8_BAR; PG8_SCHED;
            PG8_STAGE(PG8_SB(1, 1), b3 + hstepB, voffB);
            PG8_WAIT_V(6); PG8_BAR; PG8_MMA(1, 1, At, B1); PG8_BAR;
            if (P::GATHER && last) {
#pragma unroll
                for (int h = 0; h < 2; ++h)
#pragma unroll
                    for (int i = 0; i < 2; ++i) vA[h][i] = vN[h][i];
            }
        }
        E(acc, cur, wr, wc, fr, fq);
        if (!has_next) break;
#pragma unroll
        for (int a = 0; a < 2; ++a)
#pragma unroll
            for (int b = 0; b < 2; ++b)
#pragma unroll
                for (int m = 0; m < 4; ++m)
#pragma unroll
                    for (int n = 0; n < 2; ++n) acc[a][b][m][n] = (f32x4){0.f, 0.f, 0.f, 0.f};
        cur = nxt; cA = nA; cB = nB; ++ui;
    }
    PG8_WAIT_V(0);
    if (wr == 0) PG8_BAR;
    PG8_BAR;
#undef PG8_SA
#undef PG8_SB
#undef PG8_STAGE
#undef PG8_LDA
#undef PG8_LDB
#undef PG8_MMA
#undef PG8_WAIT_V
#undef PG8_WAIT_L
#undef PG8_BAR
#undef PG8_SCHED
}
}
using pg8::Unit;

struct ProbPlain {
    static constexpr bool GATHER = false;
    const bf16_t* A; const bf16_t* B; int K, lda, ldb;
    __device__ __forceinline__ const char* abase(const Unit& u) const { return (const char*)(A + (size_t)u.pm * 256 * lda); }
    __device__ __forceinline__ const char* bbase(const Unit& u) const { return (const char*)(B + (size_t)u.pn * 256 * ldb); }
    __device__ __forceinline__ void avoff(const Unit&, const int (&RA)[2], const int (&CA)[2], unsigned (&v)[2][2]) const {
#pragma unroll
        for (int h = 0; h < 2; ++h)
#pragma unroll
            for (int i = 0; i < 2; ++i) v[h][i] = (unsigned)((h * 128 + RA[i]) * lda + CA[i]) * 2u;
    }
};
struct ProbPQ {
    static constexpr bool GATHER = false;
    const bf16_t* A; const bf16_t* B; int K, lda, ldb;
    __device__ __forceinline__ const char* abase(const Unit& u) const { return (const char*)(A + (size_t)u.pm * 256 * lda); }
    __device__ __forceinline__ const char* bbase(const Unit& u) const { return (const char*)(B + ((size_t)(u.pn >> 4) * 4096 + (u.pn & 15)) * 1024); }
    __device__ __forceinline__ void avoff(const Unit&, const int (&RA)[2], const int (&CA)[2], unsigned (&v)[2][2]) const {
#pragma unroll
        for (int h = 0; h < 2; ++h)
#pragma unroll
            for (int i = 0; i < 2; ++i) v[h][i] = (unsigned)((h * 128 + RA[i]) * lda + CA[i]) * 2u;
    }
};
struct ProbMoeUp {
    static constexpr bool GATHER = true;
    const bf16_t* A; const bf16_t* B; const int* idx; int K, lda, ldb;
    __device__ __forceinline__ const char* abase(const Unit&) const { return (const char*)A; }
    __device__ __forceinline__ const char* bbase(const Unit& u) const { return (const char*)(B + ((size_t)(u.pm >> 4) * 3072 + (size_t)u.pn * 256) * ldb); }
    __device__ __forceinline__ void avoff(const Unit& u, const int (&RA)[2], const int (&CA)[2], unsigned (&v)[2][2]) const {
#pragma unroll
        for (int h = 0; h < 2; ++h)
#pragma unroll
            for (int i = 0; i < 2; ++i) { const int g = idx[u.pm * 256 + h * 128 + RA[i]]; v[h][i] = (unsigned)(g * lda + CA[i]) * 2u; }
    }
};
struct ProbMoeDown {
    static constexpr bool GATHER = false;
    const bf16_t* A; const bf16_t* B; int K, lda, ldb;
    __device__ __forceinline__ const char* abase(const Unit& u) const { return (const char*)(A + (size_t)u.pm * 256 * lda); }
    __device__ __forceinline__ const char* bbase(const Unit& u) const { return (const char*)(B + ((size_t)(u.pm >> 4) * 1024 + (size_t)u.pn * 256) * ldb); }
    __device__ __forceinline__ void avoff(const Unit&, const int (&RA)[2], const int (&CA)[2], unsigned (&v)[2][2]) const {
#pragma unroll
        for (int h = 0; h < 2; ++h)
#pragma unroll
            for (int i = 0; i < 2; ++i) v[h][i] = (unsigned)((h * 128 + RA[i]) * lda + CA[i]) * 2u;
    }
};

#define EPI_ROWS(...) _Pragma("unroll") for (int ai = 0; ai < 2; ++ai) _Pragma("unroll") for (int m = 0; m < 4; ++m) { const int row = u.pm * 256 + ai * 128 + wr * 64 + m * 16 + fr; __VA_ARGS__ }
__device__ __forceinline__ u32x4 pack8(const f32x4 v0, const f32x4 v1) { u32x4 w; w.x = cvt_pk_bf16(v0[0], v0[1]); w.y = cvt_pk_bf16(v0[2], v0[3]); w.z = cvt_pk_bf16(v1[0], v1[1]); w.w = cvt_pk_bf16(v1[2], v1[3]); return w; }

struct EpiPQ {
    static constexpr bool PERM = true; bf16_t* O;
    __device__ __forceinline__ void operator()(const f32x4 (&acc)[2][2][4][2], const Unit& u, int wr, int wc, int fr, int fq) const {
        const int t10 = wc * 32 + 8 * fq, b = u.pn >> 4, t2 = u.pn & 15;
        EPI_ROWS(
            bf16_t* rp = O + ((size_t)((b * 512 + (row >> 1)) * 16 + t2) * 512 + (row & 1) * 256 + t10);
            _Pragma("unroll") for (int bj = 0; bj < 2; ++bj) *(u32x4*)(rp + bj * 128) = pack8(acc[ai][bj][m][0], acc[ai][bj][m][1]);
        )
    }
};
struct EpiPlain {
    static constexpr bool PERM = true; bf16_t* O; size_t ldc;
    __device__ __forceinline__ void operator()(const f32x4 (&acc)[2][2][4][2], const Unit& u, int wr, int wc, int fr, int fq) const {
        const int col0 = u.pn * 256 + wc * 32 + 8 * fq;
        EPI_ROWS(
            bf16_t* rp = O + (size_t)row * ldc + col0;
            _Pragma("unroll") for (int bj = 0; bj < 2; ++bj) *(u32x4*)(rp + bj * 128) = pack8(acc[ai][bj][m][0], acc[ai][bj][m][1]);
        )
    }
};
struct EpiZ {
    static constexpr bool PERM = true; bf16_t* O; int ldc; int fixed_act;
    __device__ __forceinline__ void operator()(const f32x4 (&acc)[2][2][4][2], const Unit& u, int wr, int wc, int fr, int fq) const {
        const int col0 = u.pn * 256 + wc * 32 + 8 * fq; const int act = fixed_act >= 0 ? fixed_act : (u.pn >> 2);
        EPI_ROWS(
            bf16_t* rp = O + (size_t)row * ldc + col0;
            _Pragma("unroll") for (int bj = 0; bj < 2; ++bj) {
                f32x4 v0 = acc[ai][bj][m][0], v1 = acc[ai][bj][m][1];
                if (act == 1) { _Pragma("unroll") for (int j = 0; j < 4; ++j) { v0[j] = gelu_tanh(v0[j]); v1[j] = gelu_tanh(v1[j]); } }
                else if (act >= 2) { _Pragma("unroll") for (int j = 0; j < 4; ++j) { v0[j] = sigmoidf_(v0[j]); v1[j] = sigmoidf_(v1[j]); } }
                *(u32x4*)(rp + bj * 128) = pack8(v0, v1); }
        )
    }
};
struct EpiY1 {
    static constexpr bool PERM = true; bf16_t* O; const bf16_t* Z;
    __device__ __forceinline__ void operator()(const f32x4 (&acc)[2][2][4][2], const Unit& u, int wr, int wc, int fr, int fq) const {
        const int col0 = u.pn * 256 + wc * 32 + 8 * fq;
        EPI_ROWS(
            _Pragma("unroll") for (int bj = 0; bj < 2; ++bj) {
                const int col = col0 + bj * 128; float g[8]; unpack8(*(const u32x4*)(Z + (size_t)row * 4096 + 2048 + col), g);
                f32x4 v0 = acc[ai][bj][m][0], v1 = acc[ai][bj][m][1];
                _Pragma("unroll") for (int j = 0; j < 4; ++j) { v0[j] *= g[j]; v1[j] *= g[4 + j]; }
                *(u32x4*)(O + (size_t)row * 1024 + col) = pack8(v0, v1); }
        )
    }
};
struct EpiY2 {
    static constexpr bool PERM = true; bf16_t* O; const bf16_t* Z;
    __device__ __forceinline__ void operator()(const f32x4 (&acc)[2][2][4][2], const Unit& u, int wr, int wc, int fr, int fq) const {
        const int col0 = u.pn * 256 + wc * 32 + 8 * fq;
        EPI_ROWS(
            _Pragma("unroll") for (int bj = 0; bj < 2; ++bj) {
                const int col = col0 + bj * 128; float g[8], t1[8]; unpack8(*(const u32x4*)(Z + (size_t)row * 4096 + 3072 + col), g); unpack8(*(const u32x4*)(O + (size_t)row * 1024 + col), t1);
                f32x4 v0 = acc[ai][bj][m][0], v1 = acc[ai][bj][m][1];
                _Pragma("unroll") for (int j = 0; j < 4; ++j) { v0[j] = t1[j] + v0[j] * g[j]; v1[j] = t1[4 + j] + v1[j] * g[4 + j]; }
                *(u32x4*)(O + (size_t)row * 1024 + col) = pack8(v0, v1); }
        )
    }
};
struct EpiOut {
    static constexpr bool PERM = false; float* O; const float* X; const float* pos; const float* ada;
    __device__ __forceinline__ void operator()(const f32x4 (&acc)[2][2][4][2], const Unit& u, int wr, int wc, int fr, int fq) const {
        const int col0 = u.pn * 256 + wc * 32 + 4 * fq; const int b = u.pm >> 4;
        EPI_ROWS(
            const int t = row & 4095;
            _Pragma("unroll") for (int bj = 0; bj < 2; ++bj) _Pragma("unroll") for (int n = 0; n < 2; ++n) {
                const int col = col0 + bj * 128 + n * 16;
                const f32x4 xv = *(const f32x4*)(X + (size_t)row * 1024 + col);
                const f32x4 pv = *(const f32x4*)(pos + (col < 512 ? (t >> 6) * 512 + col : (t & 63) * 512 + (col - 512)));
                const f32x4 gv = *(const f32x4*)(ada + b * 6144 + 2048 + col);
                *(f32x4*)(O + (size_t)row * 1024 + col) = xv + pv + gv * acc[ai][bj][m][n]; }
        )
    }
};
struct EpiGU {
    static constexpr bool PERM = true; bf16_t* O;
    __device__ __forceinline__ void operator()(const f32x4 (&acc)[2][2][4][2], const Unit& u, int wr, int wc, int fr, int fq) const {
        const int col0 = u.pn * 128 + wc * 32 + 8 * fq;
        EPI_ROWS(
            f32x4 v0, v1;
            _Pragma("unroll") for (int j = 0; j < 4; ++j) { const float g0 = acc[ai][0][m][0][j], g1 = acc[ai][0][m][1][j];
                v0[j] = g0 * sigmoidf_(g0) * acc[ai][1][m][0][j]; v1[j] = g1 * sigmoidf_(g1) * acc[ai][1][m][1][j]; }
            *(u32x4*)(O + (size_t)row * DE + col0) = pack8(v0, v1);
        )
    }
};
struct EpiDown {
    static constexpr bool PERM = true; bf16_t* O; const float* gate;
    __device__ __forceinline__ void operator()(const f32x4 (&acc)[2][2][4][2], const Unit& u, int wr, int wc, int fr, int fq) const {
        const int col0 = u.pn * 256 + wc * 32 + 8 * fq;
        EPI_ROWS(
            const float g = gate[row];
            _Pragma("unroll") for (int bj = 0; bj < 2; ++bj) *(u32x4*)(O + (size_t)row * 1024 + col0 + bj * 128) = pack8(acc[ai][bj][m][0] * g, acc[ai][bj][m][1] * g);
        )
    }
};

__device__ void p0_ada(const Params& p, LAS unsigned char* lds, int item) {
    const int tid = threadIdx.x;
    LAS float* s = (LAS float*)lds; LAS float* red = s + 9 * 1024;
    for (int i = tid; i < 9 * 1024; i += NTHR) { const int r = i >> 10, d = i & 1023; const float v = r < 8 ? p.c[r * 1024 + d] : p.c_ctx[d]; s[i] = v / (1.0f + expf(-v)); }
    __syncthreads();
    const int col = tid & 63, ds = tid >> 6; float a[9];
#pragma unroll
    for (int r = 0; r < 9; ++r) a[r] = 0.f;
    const float* w = p.w_ada + (size_t)(ds * 128) * 6144 + item * 64 + col;
    for (int d = 0; d < 128; ++d) { const float wv = w[(size_t)d * 6144];
#pragma unroll
        for (int r = 0; r < 9; ++r) a[r] += s[r * 1024 + ds * 128 + d] * wv; }
#pragma unroll
    for (int r = 0; r < 9; ++r) red[(ds * 9 + r) * 64 + col] = a[r];
    __syncthreads();
    float* ada = (float*)(p.ws + WS_ADA);
    for (int i = tid; i < 9 * 64; i += NTHR) { const int r = i >> 6, cc = i & 63; float v = 0.f;
#pragma unroll
        for (int k = 0; k < 8; ++k) v += red[(k * 9 + r) * 64 + cc];
        ada[r * 6144 + item * 64 + cc] = v + p.b_ada[item * 64 + cc]; }
    __syncthreads();
}
template <int NS>
__device__ __forceinline__ void xpose_item(const float* src, int ldsrc, bf16_t* dst, int lddst, int k0, int n0, int mode) {
    const int tid = threadIdx.x, nl = tid & 63, k8 = tid >> 6;
    float v[NS][8];
#pragma unroll
    for (int s = 0; s < NS; ++s)
#pragma unroll
        for (int j = 0; j < 8; ++j) v[s][j] = src[(size_t)(k0 + 8 * k8 + j) * ldsrc + n0 + 64 * s + nl];
#pragma unroll
    for (int s = 0; s < NS; ++s) { const int n = n0 + 64 * s + nl; int row = n;
        if (mode) row = (n >> 7) * 256 + (n & 127) + (mode == 2 ? 128 : 0);
        u32x4 w; w.x = cvt_pk_bf16(v[s][0], v[s][1]); w.y = cvt_pk_bf16(v[s][2], v[s][3]); w.z = cvt_pk_bf16(v[s][4], v[s][5]); w.w = cvt_pk_bf16(v[s][6], v[s][7]);
        *(u32x4*)(dst + (size_t)row * lddst + k0 + 8 * k8) = w; }
}
__device__ void p0_wpq(const Params& p, LAS unsigned char* lds, int item) {
    const int tid = threadIdx.x, g = item >> 4, db = item & 15;
    LAS float* wl = (LAS float*)lds; LAS float* ct = wl + 64 * 129;
    for (int i = tid; i < 64 * 128; i += NTHR) { const int d = i >> 7, cc = i & 127; wl[d * 129 + cc] = p.w_in[(size_t)(db * 64 + d) * 4608 + g * 128 + cc]; }
    if (tid < 128) { float sn, cs; sincospif((float)tid * (1.0f / 64.0f), &sn, &cs); ct[tid] = cs; ct[128 + tid] = sn; }
    __syncthreads();
    const int q = tid & 255, kc = q >> 1, pq = q & 1, dh = tid >> 8; const int n = (g * 128 + kc) * 2 + pq;
    bf16_t* dst = (bf16_t*)(p.ws + WS_WPQ) + (size_t)n * 1024 + db * 64 + dh * 32;
    const float scale = 0.001381067932f;
    for (int d8 = 0; d8 < 4; ++d8) { float a[8];
#pragma unroll
        for (int j = 0; j < 8; ++j) a[j] = 0.f;
        for (int cc = 0; cc < 128; ++cc) { const float tv = ct[pq * 128 + ((cc * kc) & 127)];
#pragma unroll
            for (int j = 0; j < 8; ++j) a[j] += wl[(dh * 32 + d8 * 8 + j) * 129 + cc] * tv; }
        u32x4 w; w.x = cvt_pk_bf16(a[0] * scale, a[1] * scale); w.y = cvt_pk_bf16(a[2] * scale, a[3] * scale); w.z = cvt_pk_bf16(a[4] * scale, a[5] * scale); w.w = cvt_pk_bf16(a[6] * scale, a[7] * scale);
        *(u32x4*)(dst + d8 * 8) = w; }
    __syncthreads();
}
__device__ void p0_d1t(const Params& p, int item) {
    bf16_t* dst = (bf16_t*)(p.ws + WS_D1T);
    const int row = item * 64 + (threadIdx.x >> 3), k1 = row >> 1, ri = row & 1, c0 = (threadIdx.x & 7) * 64;
    for (int c8 = 0; c8 < 64; c8 += 8) { float v[8];
#pragma unroll
        for (int j = 0; j < 8; ++j) { const int col = c0 + c8 + j, pq = col >> 8, t1 = col & 255; float sn, cs; sincospif((float)((k1 * t1) & 255) * (1.0f / 128.0f), &sn, &cs);
            v[j] = (ri == 0) ? (pq == 0 ? cs : -sn) : (pq == 0 ? -sn : -cs); }
        u32x4 w; w.x = cvt_pk_bf16(v[0], v[1]); w.y = cvt_pk_bf16(v[2], v[3]); w.z = cvt_pk_bf16(v[4], v[5]); w.w = cvt_pk_bf16(v[6], v[7]);
        *(u32x4*)(dst + (size_t)row * 512 + c0 + c8) = w; }
}
__device__ void p0_pos(const Params& p) {
    float* tab = (float*)(p.ws + WS_POS);
    for (int i = threadIdx.x; i < 64 * 512; i += NTHR) { const int ii = i >> 9, j = i & 511, jj = j & 255; const float f = expf(-9.210340371976184f * (float)jj / 256.0f); const float a = (float)ii * f; tab[i] = j < 256 ? sinf(a) : cosf(a); }
}
__device__ void phase0(const Params& p, LAS unsigned char* lds) {
    constexpr int N_ADA = 96, N_WIN = 16 * 16, N_WFOUR = 8 * 4, N_SQ = 16 * 4, N_LRU = 16 * 2, N_WPQ = 64, N_DFT = 8, N_POS = 1;
    constexpr int O1 = N_ADA, O2 = O1 + N_WIN, O3 = O2 + N_WFOUR, O4 = O3 + N_SQ, O5 = O4 + N_SQ, O6 = O5 + N_LRU, O7 = O6 + N_LRU, O8 = O7 + N_WPQ, O9 = O8 + N_DFT, O10 = O9 + N_POS;
    for (int it = blockIdx.x; it < O10; it += gridDim.x) {
        if (it < O1) p0_ada(p, lds, it);
        else if (it < O2) { const int j = it - O1; xpose_item<4>(p.w_in + 512, 4608, (bf16_t*)(p.ws + WS_WIN), 1024, (j >> 4) * 64, (j & 15) * 256, 0); }
        else if (it < O3) { const int j = it - O2; xpose_item<4>(p.w_four, 1024, (bf16_t*)(p.ws + WS_WFOUR), 512, (j >> 2) * 64, (j & 3) * 256, 0); }
        else if (it < O4) { const int j = it - O3; xpose_item<4>(p.w_lru, 1024, (bf16_t*)(p.ws + WS_WLRU), 1024, (j >> 2) * 64, (j & 3) * 256, 0); }
        else if (it < O5) { const int j = it - O4; xpose_item<4>(p.w_out, 1024, (bf16_t*)(p.ws + WS_WOUT), 1024, (j >> 2) * 64, (j & 3) * 256, 0); }
        else if (it < O6) { const int j = it - O5, mtx = j >> 1; xpose_item<2>(p.lru_wa + (size_t)mtx * 16384, 128, (bf16_t*)(p.ws + WS_WAT) + (size_t)mtx * 16384, 128, (j & 1) * 64, 0, 0); }
        else if (it < O7) { const int j = it - O6, mtx = j >> 1; xpose_item<2>(p.lru_wi + (size_t)mtx * 16384, 128, (bf16_t*)(p.ws + WS_WIT) + (size_t)mtx * 16384, 128, (j & 1) * 64, 0, 0); }
        else if (it < O8) p0_wpq(p, lds, it - O7);
        else if (it < O9) p0_d1t(p, it - O8);
        else p0_pos(p);
    }
}

__device__ void phase1(const Params& p) {
    const int lane = threadIdx.x & 63, wid = threadIdx.x >> 6;
    const float* ada = (const float*)(p.ws + WS_ADA); const float* tab = (const float*)(p.ws + WS_POS);
    bf16_t* h1 = (bf16_t*)(p.ws + WS_R1); bf16_t* hc = (bf16_t*)(p.ws + WS_HCTX);
    const int NR = MLAT + MCTX;
    for (int row0 = (blockIdx.x * 8 + wid) * 2; row0 < NR; row0 += gridDim.x * 16) {
        f32x4 v[2][4]; float ss[2];
#pragma unroll
        for (int r = 0; r < 2; ++r) { const int row = row0 + r; const bool lat = row < MLAT; const float* xr = lat ? p.x + (size_t)row * 1024 : p.ctx + (size_t)(row - MLAT) * 1024;
#pragma unroll
            for (int i = 0; i < 4; ++i) v[r][i] = *(const f32x4*)(xr + 256 * i + 4 * lane); }
#pragma unroll
        for (int r = 0; r < 2; ++r) { const int row = row0 + r; const bool lat = row < MLAT; const int t = row & 4095; float a = 0.f;
#pragma unroll
            for (int i = 0; i < 4; ++i) { const int d = 256 * i + 4 * lane;
                if (lat) v[r][i] += *(const f32x4*)(tab + (i < 2 ? (t >> 6) * 512 + d : (t & 63) * 512 + d - 512));
                a += v[r][i][0] * v[r][i][0] + v[r][i][1] * v[r][i][1] + v[r][i][2] * v[r][i][2] + v[r][i][3] * v[r][i][3]; }
            ss[r] = a; }
#pragma unroll
        for (int o = 32; o >= 1; o >>= 1) { ss[0] += __shfl_xor(ss[0], o); ss[1] += __shfl_xor(ss[1], o); }
#pragma unroll
        for (int r = 0; r < 2; ++r) { const int row = row0 + r; const bool lat = row < MLAT; const int mrow = lat ? (row >> 12) : 8;
            const float rs = rsqrtf(ss[r] * (1.0f / 1024.0f) + 1e-6f);
            bf16_t* dst = lat ? h1 + (size_t)row * 1024 : hc + (size_t)(row - MLAT) * 1024;
#pragma unroll
            for (int i = 0; i < 4; ++i) { const int d = 256 * i + 4 * lane;
                const f32x4 g = *(const f32x4*)(p.norm1_g + d), sh = *(const f32x4*)(ada + mrow * 6144 + d), sc = *(const f32x4*)(ada + mrow * 6144 + 1024 + d);
                const f32x4 h = v[r][i] * rs * g * (sc + 1.0f) + sh;
                u32x2 w; w.x = cvt_pk_bf16(h[0], h[1]); w.y = cvt_pk_bf16(h[2], h[3]); *(u32x2*)(dst + d) = w; } }
    }
}

#define LRU_CST(mb, r) (32 * (mb) + 8 * ((r) >> 2) + ((r) & 3))
template <bool FINAL, int DIR>
__device__ __forceinline__ void lru_wave(const Params& p, LAS unsigned char* ul, int b, int sc, int head, int cb, int lane, f32x16 (&accI)[4]) {
    constexpr int SG = DIR ? -1 : 1;
    const int lr = lane & 31, lh = lane >> 5;
    const int chl = cb * 32 + lr, ch = head * 128 + chl;
    const int tbase = DIR ? 127 - 4 * lh : 4 * lh;
    f32x16 accA[4];
#pragma unroll
    for (int mb = 0; mb < 4; ++mb)
#pragma unroll
        for (int r = 0; r < 16; ++r) { accA[mb][r] = 0.f; accI[mb][r] = 0.f; }
    {
        const bf16_t* wa = (const bf16_t*)(p.ws + WS_WAT) + ((size_t)(DIR * 8 + head) * 128 + chl) * 128 + 8 * lh;
        const bf16_t* wi = (const bf16_t*)(p.ws + WS_WIT) + ((size_t)(DIR * 8 + head) * 128 + chl) * 128 + 8 * lh;
        LAS unsigned char* arow0 = ul + (DIR ? 127 - lr : lr) * 272 + lh * 16;
#pragma unroll
        for (int kc = 0; kc < 2; ++kc) { bf16x8 bA[4], bI[4];
#pragma unroll
            for (int k4 = 0; k4 < 4; ++k4) { bA[k4] = *(const bf16x8*)(wa + 16 * (kc * 4 + k4)); bI[k4] = *(const bf16x8*)(wi + 16 * (kc * 4 + k4)); }
#pragma unroll
            for (int mb = 0; mb < 4; ++mb)
#pragma unroll
                for (int k4 = 0; k4 < 4; ++k4) { const bf16x8 af = *(const LAS bf16x8*)(arow0 + SG * 32 * mb * 272 + 32 * (kc * 4 + k4));
                    accA[mb] = __builtin_amdgcn_mfma_f32_32x32x16_bf16(af, bA[k4], accA[mb], 0, 0, 0);
                    accI[mb] = __builtin_amdgcn_mfma_f32_32x32x16_bf16(af, bI[k4], accI[mb], 0, 0, 0); }
            __builtin_amdgcn_sched_barrier(0); }
    }
    {
        const float lam = p.lru_lambda[DIR * 1024 + ch]; const float sp8 = 8.0f * log1pf(expf(-lam));
        const float ba = p.lru_ba[DIR * 1024 + ch], bi = p.lru_bi[DIR * 1024 + ch];
        LAS unsigned char* up = ul + tbase * 272 + chl * 2;
#pragma unroll
        for (int mb = 0; mb < 4; ++mb) {
#pragma unroll
            for (int r = 0; r < 16; ++r) {
                const float uv = bf2f(*(const LAS bf16_t*)(up + SG * LRU_CST(mb, r) * 272));
                const float rg = sigmoidf_(accA[mb][r] + ba), ig = sigmoidf_(accI[mb][r] + bi);
                const float a = __expf(-sp8 * rg); accA[mb][r] = a; accI[mb][r] = __builtin_amdgcn_sqrtf(fmaxf(1.0f - a * a, 0.f)) * ig * uv; }
            __builtin_amdgcn_sched_barrier(0); }
    }
    float rA[16], rH[16];
#pragma unroll
    for (int mb = 0; mb < 4; ++mb)
#pragma unroll
        for (int q = 0; q < 4; ++q) { float pa = 1.f, hh = 0.f;
#pragma unroll
            for (int j = 0; j < 4; ++j) { const int r = 4 * q + j; const float a = accA[mb][r], bb = accI[mb][r]; hh = a * hh + bb; pa *= a; accA[mb][r] = pa; accI[mb][r] = hh; }
            rA[mb * 4 + q] = pa; rH[mb * 4 + q] = hh; }
    const int agg_dir_off = ((b * NSEQ) * 2 + DIR) * 1024 + ch;
    const float* agg = (const float*)(p.ws + WS_AGG);
    float carry = 0.f;
    if (FINAL) {
        if (DIR == 0) { for (int q = 0; q < sc; ++q) { const float* a2 = agg + (size_t)(agg_dir_off + q * 2048) * 2; carry = a2[0] * carry + a2[1]; } }
        else { { const float* a2 = agg + (size_t)(agg_dir_off + 1 * 2048) * 2; carry = a2[0] * carry + a2[1]; } { const float* a2 = agg + (size_t)(agg_dir_off + 0 * 2048) * 2; carry = a2[0] * carry + a2[1]; }
            for (int q = NSEQ - 1; q > sc; --q) { const float* a2 = agg + (size_t)(agg_dir_off + q * 2048) * 2; carry = a2[0] * carry + a2[1]; } }
    }
    float cin[16];
#pragma unroll
    for (int i = 0; i < 16; ++i) cin[i] = 0.f;
    float s = carry, At = 1.f;
#pragma unroll
    for (int i = 0; i < 16; ++i) { const float oA = __shfl_xor(rA[i], 32), oH = __shfl_xor(rH[i], 32);
        { const bool mine = (lh == 0); const float a = mine ? rA[i] : oA, hh = mine ? rH[i] : oH; cin[i] = mine ? s : cin[i]; s = a * s + hh; At *= a; }
        { const bool mine = (lh == 1); const float a = mine ? rA[i] : oA, hh = mine ? rH[i] : oH; cin[i] = mine ? s : cin[i]; s = a * s + hh; At *= a; } }
    if (!FINAL) {
        if (lh == 0) { float* o = (float*)(p.ws + WS_AGG) + (size_t)(agg_dir_off + sc * 2048) * 2; o[0] = At; o[1] = s; }
        return;
    }
#pragma unroll
    for (int mb = 0; mb < 4; ++mb)
#pragma unroll
        for (int r = 0; r < 16; ++r) accI[mb][r] += accA[mb][r] * cin[mb * 4 + (r >> 2)];
}
template <bool FINAL>
__device__ void lru_tile(const Params& p, LAS unsigned char* lds, int item) {
    const int tid = threadIdx.x, lane = tid & 63, wid = __builtin_amdgcn_readfirstlane(tid >> 6);
    int b, sc, head;
    if (FINAL) { head = item & 7; sc = 2 + ((item >> 3) & 31); b = item >> 8; }
    else { head = item & 7; const int r = item >> 3; sc = r & 1; b = r >> 1; }
    const bf16_t* src; int Tseq, t0, ld;
    if (sc < 2) { src = (const bf16_t*)(p.ws + WS_ZXC) + (size_t)b * 256 * 1024; Tseq = 256; t0 = sc * 128; ld = 1024; }
    else { src = (const bf16_t*)(p.ws + WS_RZ) + (size_t)b * 4096 * 4096; Tseq = 4096; t0 = (sc - 2) * 128; ld = 4096; }
    LAS unsigned char* ul = lds;
    LAS float* ybuf = (LAS float*)(lds + 36 * 1024);
    {
        const int c8 = tid & 15, tb = tid >> 4; const int ch0 = head * 128 + 8 * c8;
        float w[4][8], bias[8];
#pragma unroll
        for (int k = 0; k < 4; ++k) { const f32x4 a = *(const f32x4*)(p.conv_w + k * 1024 + ch0), c2 = *(const f32x4*)(p.conv_w + k * 1024 + ch0 + 4);
#pragma unroll
            for (int j = 0; j < 4; ++j) { w[k][j] = a[j]; w[k][4 + j] = c2[j]; } }
        { const f32x4 a = *(const f32x4*)(p.conv_b + ch0), c2 = *(const f32x4*)(p.conv_b + ch0 + 4);
#pragma unroll
            for (int j = 0; j < 4; ++j) { bias[j] = a[j]; bias[4 + j] = c2[j]; } }
#pragma unroll
        for (int i = 0; i < 4; ++i) { const int t = tb + 32 * i; float a[8];
#pragma unroll
            for (int j = 0; j < 8; ++j) a[j] = bias[j];
#pragma unroll
            for (int k = 0; k < 4; ++k) { const int tt = t0 + t + k - 2;
                if (tt >= 0 && tt < Tseq) { float f[8]; unpack8(*(const u32x4*)(src + (size_t)tt * ld + ch0), f);
#pragma unroll
                    for (int j = 0; j < 8; ++j) a[j] += w[k][j] * f[j]; } }
            u32x4 wv; wv.x = cvt_pk_bf16(a[0], a[1]); wv.y = cvt_pk_bf16(a[2], a[3]); wv.z = cvt_pk_bf16(a[4], a[5]); wv.w = cvt_pk_bf16(a[6], a[7]);
            *(LAS u32x4*)(ul + t * 272 + c8 * 16) = wv; }
    }
    __syncthreads();
    f32x16 hacc[4];
    if (wid < 4) lru_wave<FINAL, 0>(p, ul, b, sc, head, wid & 3, lane, hacc);
    else lru_wave<FINAL, 1>(p, ul, b, sc, head, wid & 3, lane, hacc);
    if (FINAL) {
        const int lr = lane & 31, lh = lane >> 5, chl = (wid & 3) * 32 + lr;
        if (wid >= 4) { LAS float* yp = ybuf + (127 - 4 * lh) * 129 + chl;
#pragma unroll
            for (int mb = 0; mb < 4; ++mb)
#pragma unroll
                for (int r = 0; r < 16; ++r) yp[-LRU_CST(mb, r) * 129] = hacc[mb][r]; }
        __syncthreads();
        if (wid < 4) {
            const LAS float* yp = ybuf + (4 * lh) * 129 + chl;
            const bf16_t* Zu = (const bf16_t*)(p.ws + WS_RZ) + ((size_t)(b * 4096 + t0) * 4096 + 1024 + head * 128);
            bf16_t* Ou = (bf16_t*)(p.ws + WS_R1) + ((size_t)(b * 4096 + t0) * 1024 + head * 128);
            const unsigned zo = (unsigned)(4 * lh * 4096 + chl), oo = (unsigned)(4 * lh * 1024 + chl);
#pragma unroll
            for (int mb = 0; mb < 4; ++mb) {
#pragma unroll
                for (int r = 0; r < 16; ++r) {
                    const float y = hacc[mb][r] + yp[LRU_CST(mb, r) * 129];
                    const float gz = bf2f(Zu[zo + LRU_CST(mb, r) * 4096]);
                    Ou[oo + LRU_CST(mb, r) * 1024] = (bf16_t)(cvt_pk_bf16(gz * y, 0.f) & 0xffffu);
                    if ((r & 7) == 7) __builtin_amdgcn_sched_barrier(0); } }
        }
    }
    __syncthreads();
}

#ifndef LRU_PF_FRAG
#define LRU_PF_FRAG true
#endif
#ifndef LRU_PF_TILE
#define LRU_PF_TILE true
#endif
typedef unsigned long long u64_t;
template <int DIR, bool PREF>
__device__ __forceinline__ void lru2_dir(const Params& p, LAS unsigned char* ul, int head, int w, int lane, const bf16x8 (&bA)[4], const bf16x8 (&bI)[4], bf16x8 (&nA)[4], bf16x8 (&nI)[4],
                                         f32x4 (&hl)[8], f32x4 (&pp)[8], float& Atot, float& Htot) {
    constexpr int SG = DIR ? -1 : 1;
    const int fr = lane & 15, fq = lane >> 4, chl = 16 * w + fr, ch = head * 128 + chl;
    f32x4 accA[8], accI[8];
#pragma unroll
    for (int rb = 0; rb < 8; ++rb) { accA[rb] = (f32x4){0.f, 0.f, 0.f, 0.f}; accI[rb] = (f32x4){0.f, 0.f, 0.f, 0.f}; }
    {
        LAS unsigned char* arow0 = ul + (DIR ? 127 - fr : fr) * 272 + fq * 16;
#pragma unroll
        for (int rb = 0; rb < 8; ++rb)
#pragma unroll
            for (int ks = 0; ks < 4; ++ks) { const bf16x8 af = *(const LAS bf16x8*)(arow0 + SG * 16 * rb * 272 + 64 * ks);
                accA[rb] = __builtin_amdgcn_mfma_f32_16x16x32_bf16(af, bA[ks], accA[rb], 0, 0, 0);
                accI[rb] = __builtin_amdgcn_mfma_f32_16x16x32_bf16(af, bI[ks], accI[rb], 0, 0, 0); }
    }
    if (PREF) {
        const bf16_t* wa = (const bf16_t*)(p.ws + WS_WAT) + ((size_t)((1 - DIR) * 8 + head) * 128 + chl) * 128 + 8 * fq;
        const bf16_t* wi = (const bf16_t*)(p.ws + WS_WIT) + ((size_t)((1 - DIR) * 8 + head) * 128 + chl) * 128 + 8 * fq;
#pragma unroll
        for (int ks = 0; ks < 4; ++ks) { nA[ks] = *(const bf16x8*)(wa + 32 * ks); nI[ks] = *(const bf16x8*)(wi + 32 * ks); }
    }
    {
        const float lam = p.lru_lambda[DIR * 1024 + ch]; const float sp8 = 8.0f * log1pf(expf(-lam));
        const float ba = p.lru_ba[DIR * 1024 + ch], bi = p.lru_bi[DIR * 1024 + ch];
        LAS unsigned char* up = ul + (DIR ? 127 - 4 * fq : 4 * fq) * 272 + chl * 2;
#pragma unroll
        for (int rb = 0; rb < 8; ++rb)
#pragma unroll
            for (int r = 0; r < 4; ++r) {
                const float uv = bf2f(*(const LAS bf16_t*)(up + SG * (16 * rb + r) * 272));
                const float rg = sigmoidf_(accA[rb][r] + ba), ig = sigmoidf_(accI[rb][r] + bi);
                const float a = __expf(-sp8 * rg); accA[rb][r] = a; accI[rb][r] = __builtin_amdgcn_sqrtf(fmaxf(1.0f - a * a, 0.f)) * ig * uv;
                if (r == 3 && (rb & 1)) __builtin_amdgcn_sched_barrier(0); }
    }
    float rA[8], rH[8];
#pragma unroll
    for (int rb = 0; rb < 8; ++rb) { float pa = 1.f, hh = 0.f;
#pragma unroll
        for (int r = 0; r < 4; ++r) { const float a = accA[rb][r], bb = accI[rb][r]; hh = a * hh + bb; pa *= a; accA[rb][r] = pa; accI[rb][r] = hh; }
        rA[rb] = pa; rH[rb] = hh; }
    float Pc = 1.f, s = 0.f;
#pragma unroll
    for (int rb = 0; rb < 8; ++rb) { float Pin = 1.f, Hin = 0.f;
#pragma unroll
        for (int q = 0; q < 4; ++q) { const float a = __shfl(rA[rb], fr + 16 * q), hh = __shfl(rH[rb], fr + 16 * q);
            if (q == fq) { Pin = Pc; Hin = s; }
            s = a * s + hh; Pc *= a; }
#pragma unroll
        for (int r = 0; r < 4; ++r) { hl[rb][r] = accI[rb][r] + accA[rb][r] * Hin; pp[rb][r] = accA[rb][r] * Pin; }
        __builtin_amdgcn_sched_barrier(0); }
    Atot = Pc; Htot = s;
}
__device__ __forceinline__ u64_t agg_ld(const u64_t* a) { return __hip_atomic_load(a, __ATOMIC_RELAXED, __HIP_MEMORY_SCOPE_AGENT); }
template <int DIR>
__device__ __forceinline__ float lru2_carry(const u64_t* aggc, int n, int fr, int fq) {
    float Ap = 1.f, Hp = 0.f; u64_t v[9];
#pragma unroll
    for (int k = 0; k < 9; ++k) { const int j = fq * 9 + k; const int seq = DIR ? (j == 0 ? 1 : (j == 1 ? 0 : 35 - j)) : j;
        v[k] = (j < n) ? agg_ld(aggc + (size_t)seq * 2048) : 0x000000003f800000ull; }
#pragma unroll
    for (int k = 0; k < 9; ++k) { const float a = __uint_as_float((unsigned)v[k]), hh = __uint_as_float((unsigned)(v[k] >> 32)); Hp = a * Hp + hh; Ap *= a; }
    float s = 0.f;
#pragma unroll
    for (int q = 0; q < 4; ++q) { const float a = __shfl(Ap, fr + 16 * q), hh = __shfl(Hp, fr + 16 * q); s = a * s + hh; }
    return s;
}
__device__ void lru2_block(const Params& p, LAS unsigned char* lds, int slot, int c, int ngr) {
    const int tid = threadIdx.x, lane = tid & 63, wid = __builtin_amdgcn_readfirstlane(tid >> 6);
    const int sc = c + 2, t0 = c * 128;
    LAS unsigned char* raw = lds;
    LAS unsigned char* ul = lds + 33792;
    LAS unsigned char* gzl = lds + 68608;
    LAS unsigned char* outl = lds + 103424;
    const int fr = lane & 15, fq = lane >> 4, chl = 16 * wid + fr;
    u32x4 nr[5], ng[4];
#define LRU2_LOAD(gg) do { const bf16_t* Zb_ = (const bf16_t*)(p.ws + WS_RZ) + (size_t)((gg) >> 3) * 4096 * 4096 + ((gg) & 7) * 128; \
        _Pragma("unroll") for (int k = 0; k < 5; ++k) { const int pc = tid + NTHR * k; nr[k] = (u32x4){0u, 0u, 0u, 0u}; \
            if (pc < 131 * 16) { const int row = pc >> 4, c8 = pc & 15, tt = t0 - 2 + row; if (tt >= 0 && tt < TT) nr[k] = *(const u32x4*)(Zb_ + (size_t)tt * 4096 + c8 * 8); } } \
        _Pragma("unroll") for (int k = 0; k < 4; ++k) { const int pc = tid + NTHR * k, row = pc >> 4, c8 = pc & 15; ng[k] = *(const u32x4*)(Zb_ + (size_t)(t0 + row) * 4096 + 1024 + c8 * 8); } } while (0)
    LRU2_LOAD(slot);
    for (int g = slot; g < NB * 8; g += ngr) {
        const int b = g >> 3, head = g & 7, ch = head * 128 + chl;
        unsigned* gcnt = (unsigned*)(p.ws + WS_BAR + 16 * KiB) + g * 64;
        bf16x8 bA1[4], bI1[4], bA0[4], bI0[4];
        { const bf16_t* wa = (const bf16_t*)(p.ws + WS_WAT) + ((size_t)(8 + head) * 128 + chl) * 128 + 8 * fq; const bf16_t* wi = (const bf16_t*)(p.ws + WS_WIT) + ((size_t)(8 + head) * 128 + chl) * 128 + 8 * fq;
#pragma unroll
          for (int ks = 0; ks < 4; ++ks) { bA1[ks] = *(const bf16x8*)(wa + 32 * ks); bI1[ks] = *(const bf16x8*)(wi + 32 * ks); } }
#pragma unroll
        for (int k = 0; k < 5; ++k) { const int pc = tid + NTHR * k; if (pc < 131 * 16) *(LAS u32x4*)(raw + (pc >> 4) * 256 + (pc & 15) * 16) = nr[k]; }
#pragma unroll
        for (int k = 0; k < 4; ++k) { const int pc = tid + NTHR * k; *(LAS u32x4*)(gzl + (pc >> 4) * 272 + (pc & 15) * 16) = ng[k]; }
        __syncthreads();
        {
            const int c8 = tid & 15, tb = tid >> 4; const int ch0 = head * 128 + 8 * c8;
            float w[4][8], bias[8];
#pragma unroll
            for (int k = 0; k < 4; ++k) { const f32x4 a = *(const f32x4*)(p.conv_w + k * 1024 + ch0), c2 = *(const f32x4*)(p.conv_w + k * 1024 + ch0 + 4);
#pragma unroll
                for (int j = 0; j < 4; ++j) { w[k][j] = a[j]; w[k][4 + j] = c2[j]; } }
            { const f32x4 a = *(const f32x4*)(p.conv_b + ch0), c2 = *(const f32x4*)(p.conv_b + ch0 + 4);
#pragma unroll
                for (int j = 0; j < 4; ++j) { bias[j] = a[j]; bias[4 + j] = c2[j]; } }
#pragma unroll
            for (int i = 0; i < 4; ++i) { const int t = tb + 32 * i; float a[8];
#pragma unroll
                for (int j = 0; j < 8; ++j) a[j] = bias[j];
#pragma unroll
                for (int k = 0; k < 4; ++k) { float f[8]; unpack8(*(const LAS u32x4*)(raw + (t + k) * 256 + c8 * 16), f);
#pragma unroll
                    for (int j = 0; j < 8; ++j) a[j] += w[k][j] * f[j]; }
                u32x4 wv; wv.x = cvt_pk_bf16(a[0], a[1]); wv.y = cvt_pk_bf16(a[2], a[3]); wv.z = cvt_pk_bf16(a[4], a[5]); wv.w = cvt_pk_bf16(a[6], a[7]);
                *(LAS u32x4*)(ul + t * 272 + c8 * 16) = wv; }
        }
        __syncthreads();
        float A0, H0, A1, H1;
        {
            f32x4 hl1[8], pp1[8];
            lru2_dir<1, LRU_PF_FRAG>(p, ul, head, wid, lane, bA1, bI1, bA0, bI0, hl1, pp1, A1, H1);
            LAS unsigned char* hp = outl + (127 - 4 * fq) * 272 + chl * 2; LAS unsigned char* qp = raw + (127 - 4 * fq) * 256 + chl * 2;
#pragma unroll
            for (int rb = 0; rb < 8; ++rb)
#pragma unroll
                for (int r = 0; r < 4; ++r) { *(LAS bf16_t*)(hp - (16 * rb + r) * 272) = (bf16_t)(cvt_pk_bf16(hl1[rb][r], 0.f) & 0xffffu); *(LAS bf16_t*)(qp - (16 * rb + r) * 256) = (bf16_t)(cvt_pk_bf16(pp1[rb][r], 0.f) & 0xffffu); }
        }
        __builtin_amdgcn_sched_barrier(0);
        if (!LRU_PF_FRAG) { const bf16_t* wa = (const bf16_t*)(p.ws + WS_WAT) + ((size_t)(head) * 128 + chl) * 128 + 8 * fq; const bf16_t* wi = (const bf16_t*)(p.ws + WS_WIT) + ((size_t)(head) * 128 + chl) * 128 + 8 * fq;
#pragma unroll
          for (int ks = 0; ks < 4; ++ks) { bA0[ks] = *(const bf16x8*)(wa + 32 * ks); bI0[ks] = *(const bf16x8*)(wi + 32 * ks); } }
        f32x4 hl0[8], pp0[8];
        lru2_dir<0, false>(p, ul, head, wid, lane, bA0, bI0, bA1, bI1, hl0, pp0, A0, H0);
        u64_t* agg = (u64_t*)(p.ws + WS_AGG);
        const size_t ai0 = ((size_t)(b * NSEQ) * 2 + 0) * 1024 + ch, ai1 = ((size_t)(b * NSEQ) * 2 + 1) * 1024 + ch;
        if (fq == 0) {
            __hip_atomic_store(agg + ai0 + (size_t)sc * 2048, ((u64_t)__float_as_uint(H0) << 32) | __float_as_uint(A0), __ATOMIC_RELAXED, __HIP_MEMORY_SCOPE_AGENT);
            __hip_atomic_store(agg + ai1 + (size_t)sc * 2048, ((u64_t)__float_as_uint(H1) << 32) | __float_as_uint(A1), __ATOMIC_RELAXED, __HIP_MEMORY_SCOPE_AGENT); }
        asm volatile("s_waitcnt vmcnt(0)" ::: "memory");
        __syncthreads();
        if (tid == 0) (void)__hip_atomic_fetch_add(gcnt, 1u, __ATOMIC_RELAXED, __HIP_MEMORY_SCOPE_AGENT);
        if (wid == 0) { unsigned sp = 0;
            while ((unsigned)__builtin_amdgcn_readfirstlane(__hip_atomic_load(gcnt, __ATOMIC_RELAXED, __HIP_MEMORY_SCOPE_AGENT)) < 32u) { __builtin_amdgcn_s_sleep(1); if (++sp > (1u << 22)) break; }
            __builtin_amdgcn_fence(__ATOMIC_ACQUIRE, "agent");
            asm volatile("s_waitcnt vmcnt(0)" ::: "memory"); }
        __syncthreads();
        const float C0 = lru2_carry<0>(agg + ai0, sc, fr, fq);
        const float C1 = lru2_carry<1>(agg + ai1, 2 + (NSEQ - 1 - sc), fr, fq);
        __builtin_amdgcn_sched_barrier(0);
        if (LRU_PF_TILE) { const int gn = (g + ngr < NB * 8) ? g + ngr : g; LRU2_LOAD(gn); }
        __builtin_amdgcn_sched_barrier(0);
        LAS unsigned char* gp = gzl + (4 * fq) * 272 + chl * 2; LAS unsigned char* op = outl + (4 * fq) * 272 + chl * 2; LAS unsigned char* qp0 = raw + (4 * fq) * 256 + chl * 2;
#pragma unroll
        for (int rb = 0; rb < 8; ++rb)
#pragma unroll
            for (int r = 0; r < 4; ++r) { const float h1 = bf2f(*(const LAS bf16_t*)(op + (16 * rb + r) * 272)) + bf2f(*(const LAS bf16_t*)(qp0 + (16 * rb + r) * 256)) * C1;
                const float y = hl0[rb][r] + pp0[rb][r] * C0 + h1;
                const float gz = bf2f(*(const LAS bf16_t*)(gp + (16 * rb + r) * 272));
                *(LAS bf16_t*)(op + (16 * rb + r) * 272) = (bf16_t)(cvt_pk_bf16(gz * y, 0.f) & 0xffffu); }
        __syncthreads();
        bf16_t* Ob = (bf16_t*)(p.ws + WS_R1) + ((size_t)(b * 4096 + t0)) * 1024 + head * 128;
#pragma unroll
        for (int k = 0; k < 4; ++k) { const int pc = tid + NTHR * k, row = pc >> 4, c8 = pc & 15;
            *(u32x4*)(Ob + (size_t)row * 1024 + c8 * 8) = *(const LAS u32x4*)(outl + row * 272 + c8 * 16); }
        __syncthreads();
        if (!LRU_PF_TILE && g + ngr < NB * 8) LRU2_LOAD(g + ngr);
    }
#undef LRU2_LOAD
}

__device__ void fft_stage2(const Params& p, LAS unsigned char* lds, int item) {
    const int tid = threadIdx.x, b = item >> 8, k1 = item & 255;
    LAS unsigned char* yl = lds;
    LAS float* cf = (LAS float*)(lds + 32768);
    const bf16_t* Yt = (const bf16_t*)((const unsigned char*)p.out + OUT_YT);
#pragma unroll
    for (int k = 0; k < 4; ++k) { const int pc = tid + NTHR * k, ri = pc >> 10, o = (pc & 1023) * 8;
        *(LAS u32x4*)(yl + ri * 16384 + o * 2) = *(const u32x4*)(Yt + (size_t)(k1 * 2 + ri) * 65536 + (size_t)b * 8192 + o); }
    if (tid < 256) { const int k2 = tid >> 4, t2 = tid & 15; float sn, cs; sincospif((float)(((k1 + 256 * k2) * t2) & 4095) * (1.0f / 2048.0f), &sn, &cs); cf[tid * 2] = cs; cf[tid * 2 + 1] = sn; }
    __syncthreads();
    float yr[16], yi[16];
    { float f[8]; unpack8(*(const LAS u32x4*)(yl + tid * 32), f);
#pragma unroll
      for (int j = 0; j < 8; ++j) yr[j] = f[j];
      unpack8(*(const LAS u32x4*)(yl + tid * 32 + 16), f);
#pragma unroll
      for (int j = 0; j < 8; ++j) yr[8 + j] = f[j];
      unpack8(*(const LAS u32x4*)(yl + 16384 + tid * 32), f);
#pragma unroll
      for (int j = 0; j < 8; ++j) yi[j] = f[j];
      unpack8(*(const LAS u32x4*)(yl + 16384 + tid * 32 + 16), f);
#pragma unroll
      for (int j = 0; j < 8; ++j) yi[8 + j] = f[j]; }
    bf16_t* Fo = (bf16_t*)((unsigned char*)p.out + OUT_F) + ((size_t)b * 4096 + k1) * 512 + tid;
#pragma unroll
    for (int k2 = 0; k2 < 16; ++k2) { float a = 0.f;
#pragma unroll
        for (int t2 = 0; t2 < 16; ++t2) { const float cs = cf[(k2 * 16 + t2) * 2], sn = cf[(k2 * 16 + t2) * 2 + 1]; a += cs * yr[t2] + sn * yi[t2]; }
        Fo[(size_t)k2 * 256 * 512] = (bf16_t)(cvt_pk_bf16(a, 0.f) & 0xffffu); }
    __syncthreads();
}

__device__ void phase7_rows(const Params& p, LAS unsigned char* lds) {
    const int tid = threadIdx.x, lane = tid & 63, wid = tid >> 6;
    LAS float* wrt = (LAS float*)lds;
    for (int i = tid; i < 16 * 1024; i += NTHR) { const int d = i >> 4, e = i & 15; wrt[e * 1024 + d] = p.w_router[i]; }
    __syncthreads();
    const float* ada = (const float*)(p.ws + WS_ADA); bf16_t* h2 = (bf16_t*)(p.ws + WS_R1); float* scores = (float*)(p.ws + WS_SCORES);
    for (int row0 = (blockIdx.x * 8 + wid) * 2; row0 < MLAT; row0 += gridDim.x * 16) {
        const int b = row0 >> 12;
        f32x4 v[2][4]; float ss[2];
#pragma unroll
        for (int r = 0; r < 2; ++r)
#pragma unroll
            for (int i = 0; i < 4; ++i) v[r][i] = *(const f32x4*)(p.out + (size_t)(row0 + r) * 1024 + 256 * i + 4 * lane);
#pragma unroll
        for (int r = 0; r < 2; ++r) { float a = 0.f;
#pragma unroll
            for (int i = 0; i < 4; ++i) a += v[r][i][0] * v[r][i][0] + v[r][i][1] * v[r][i][1] + v[r][i][2] * v[r][i][2] + v[r][i][3] * v[r][i][3];
            ss[r] = a; }
#pragma unroll
        for (int o = 32; o >= 1; o >>= 1) { ss[0] += __shfl_xor(ss[0], o); ss[1] += __shfl_xor(ss[1], o); }
#pragma unroll
        for (int i = 0; i < 4; ++i) { const int d = 256 * i + 4 * lane;
            const f32x4 g = *(const f32x4*)(p.norm2_g + d), sh = *(const f32x4*)(ada + b * 6144 + 3072 + d), sc = *(const f32x4*)(ada + b * 6144 + 4096 + d);
#pragma unroll
            for (int r = 0; r < 2; ++r) { const float rs = rsqrtf(ss[r] * (1.0f / 1024.0f) + 1e-6f);
                v[r][i] = v[r][i] * rs * g * (sc + 1.0f) + sh;
                u32x2 w; w.x = cvt_pk_bf16(v[r][i][0], v[r][i][1]); w.y = cvt_pk_bf16(v[r][i][2], v[r][i][3]); *(u32x2*)(h2 + (size_t)(row0 + r) * 1024 + d) = w; } }
        float q[32];
#pragma unroll
        for (int e = 0; e < 16; ++e) { float a0 = 0.f, a1 = 0.f;
#pragma unroll
            for (int i = 0; i < 4; ++i) { const f32x4 w = *(const LAS f32x4*)(wrt + e * 1024 + 256 * i + 4 * lane);
                a0 += v[0][i][0] * w[0] + v[0][i][1] * w[1] + v[0][i][2] * w[2] + v[0][i][3] * w[3];
                a1 += v[1][i][0] * w[0] + v[1][i][1] * w[1] + v[1][i][2] * w[2] + v[1][i][3] * w[3]; }
            q[e] = a0; q[16 + e] = a1; }
#pragma unroll
        for (int j = 0; j < 16; ++j) { const bool up = (lane & 32) != 0; const float send = up ? q[j] : q[16 + j], keep = up ? q[16 + j] : q[j]; q[j] = keep + __shfl_xor(send, 32); }
#pragma unroll
        for (int j = 0; j < 8; ++j) { const bool up = (lane & 16) != 0; const float send = up ? q[j] : q[8 + j], keep = up ? q[8 + j] : q[j]; q[j] = keep + __shfl_xor(send, 16); }
#pragma unroll
        for (int j = 0; j < 4; ++j) { const bool up = (lane & 8) != 0; const float send = up ? q[j] : q[4 + j], keep = up ? q[4 + j] : q[j]; q[j] = keep + __shfl_xor(send, 8); }
#pragma unroll
        for (int j = 0; j < 2; ++j) { const bool up = (lane & 4) != 0; const float send = up ? q[j] : q[2 + j], keep = up ? q[2 + j] : q[j]; q[j] = keep + __shfl_xor(send, 4); }
        { const bool up = (lane & 2) != 0; const float send = up ? q[0] : q[1], keep = up ? q[1] : q[0]; q[0] = keep + __shfl_xor(send, 2); }
        float lg = q[0] + __shfl_xor(q[0], 1);
        float mx = lg;
#pragma unroll
        for (int o = 2; o <= 16; o <<= 1) mx = fmaxf(mx, __shfl_xor(mx, o));
        const float ex = expf(lg - mx); float sum = ex;
#pragma unroll
        for (int o = 2; o <= 16; o <<= 1) sum += __shfl_xor(sum, o);
        if ((lane & 1) == 0) scores[((size_t)b * 16 + ((lane >> 1) & 15)) * 4096 + ((row0 + (lane >> 5)) & 4095)] = ex / sum;
    }
    __syncthreads();
}
__device__ void phase7_weights(const Params& p) {
    constexpr int N_G = 16 * 16 * 6, N_D = 16 * 24 * 4;
    for (int it = blockIdx.x; it < 2 * N_G + N_D; it += gridDim.x) {
        if (it < 2 * N_G) { const int up = it >= N_G, j = up ? it - N_G : it, e = j / 96, r = j % 96, kb = r / 6, nb = r % 6;
            xpose_item<4>((up ? p.w_up_e : p.w_gate_e) + (size_t)e * 1024 * 1536, 1536, (bf16_t*)(p.ws + WS_WGU) + (size_t)e * 3072 * 1024, 1024, kb * 64, nb * 256, up ? 2 : 1); }
        else { const int j = it - 2 * N_G, e = j / 96, r = j % 96, kb = r >> 2, nb = r & 3;
            xpose_item<4>(p.w_down_e + (size_t)e * 1536 * 1024, 1024, (bf16_t*)(p.ws + WS_WD) + (size_t)e * 1024 * 1536, 1536, kb * 64, nb * 256, 0); }
    }
}

__device__ void phase8_topk(const Params& p, LAS unsigned char* lds) {
    const int tid = threadIdx.x, lane = tid & 63, wid = tid >> 6;
    LAS unsigned* cnt = (LAS unsigned*)lds;
    LAS unsigned* wsum = cnt + 16;
    const float* scores = (const float*)(p.ws + WS_SCORES);
    int* idx = (int*)(p.ws + WS_IDX); float* gate = (float*)(p.ws + WS_GATE); int* slot_of = (int*)(p.ws + WS_SLOT);
    for (int it = blockIdx.x; it < NB * NE; it += gridDim.x) {
        const int b = it >> 4, e = it & 15;
        unsigned key[8];
        { const u32x4* sp = (const u32x4*)(scores + (size_t)it * 4096 + tid * 8); const u32x4 a = sp[0], c2 = sp[1]; key[0] = a.x; key[1] = a.y; key[2] = a.z; key[3] = a.w; key[4] = c2.x; key[5] = c2.y; key[6] = c2.z; key[7] = c2.w; }
        unsigned thr = 0;
        for (int bit = 30; bit >= 0; --bit) {
            const unsigned cand = thr | (1u << bit); unsigned c = 0;
#pragma unroll
            for (int j = 0; j < 8; ++j) c += (unsigned)__popcll(__ballot(key[j] >= cand));
            LAS unsigned* cb = cnt + (bit & 1) * 8;
            if (lane == 0) cb[wid] = c;
            __syncthreads();
            unsigned tot = 0;
#pragma unroll
            for (int w = 0; w < 8; ++w) tot += cb[w];
            if (tot >= (unsigned)CAP) thr = cand;
        }
        unsigned cg_ = 0, ce = 0;
#pragma unroll
        for (int j = 0; j < 8; ++j) { cg_ += key[j] > thr; ce += key[j] == thr; }
        unsigned pk = cg_ | (ce << 16), incl = pk;
#pragma unroll
        for (int o = 1; o < 64; o <<= 1) { const unsigned n = __shfl_up(incl, o); if (lane >= o) incl += n; }
        if (lane == 63) wsum[wid] = incl;
        __syncthreads();
        unsigned base = 0, total = 0;
#pragma unroll
        for (int w = 0; w < 8; ++w) { const unsigned s = wsum[w]; if (w < wid) base += s; total += s; }
        const unsigned excl = base + incl - pk; unsigned og = excl & 0xffffu, oe = excl >> 16; const unsigned ngt = total & 0xffffu, krem = (unsigned)CAP - ngt;
#pragma unroll
        for (int j = 0; j < 8; ++j) { const int t = tid * 8 + j; int m = -1;
            if (key[j] > thr) { m = (e * 8 + b) * 512 + (int)og; ++og; }
            else if (key[j] == thr) { if (oe < krem) m = (e * 8 + b) * 512 + (int)(ngt + oe); ++oe; }
            slot_of[((size_t)b * 4096 + t) * 16 + e] = m;
            if (m >= 0) { idx[m] = b * 4096 + t; gate[m] = __uint_as_float(key[j]); } }
        __syncthreads();
    }
}

__device__ void phase11(const Params& p, float* dst) {
    const int lane = threadIdx.x & 63, wid = threadIdx.x >> 6;
    const float* ada = (const float*)(p.ws + WS_ADA); const int* slot_of = (const int*)(p.ws + WS_SLOT); const bf16_t* oute = (const bf16_t*)(p.ws + WS_OUTE);
    const int stride = gridDim.x * 8;
    int row = blockIdx.x * 8 + wid;
    int myslot = row < MLAT ? slot_of[(size_t)row * 16 + (lane & 15)] : -1;
    for (; row < MLAT; row += stride) {
        const int b = row >> 12; float* xr = p.out + (size_t)row * 1024;
        const int nrow = row + stride; const int nslot = nrow < MLAT ? slot_of[(size_t)nrow * 16 + (lane & 15)] : -1;
        f32x4 xv[4];
#pragma unroll
        for (int i = 0; i < 4; ++i) xv[i] = *(const f32x4*)(xr + 256 * i + 4 * lane);
        f32x4 acc[4];
#pragma unroll
        for (int i = 0; i < 4; ++i) acc[i] = (f32x4){0.f, 0.f, 0.f, 0.f};
        unsigned long long mask = __ballot(myslot >= 0) & 0xffffull;
        while (mask) {
            int m[4];
#pragma unroll
            for (int j = 0; j < 4; ++j) { if (mask) { const int e = __builtin_ctzll(mask); mask &= mask - 1; m[j] = __builtin_amdgcn_readlane(myslot, e); } else m[j] = MMOE; }
            u32x2 w[4][4];
#pragma unroll
            for (int j = 0; j < 4; ++j)
#pragma unroll
                for (int i = 0; i < 4; ++i) w[j][i] = *(const u32x2*)(oute + (size_t)m[j] * 1024 + 256 * i + 4 * lane);
#pragma unroll
            for (int j = 0; j < 4; ++j)
#pragma unroll
                for (int i = 0; i < 4; ++i) { acc[i][0] += bf_lo(w[j][i].x); acc[i][1] += bf_hi(w[j][i].x); acc[i][2] += bf_lo(w[j][i].y); acc[i][3] += bf_hi(w[j][i].y); }
        }
        f32x4 v[4]; float ss = 0.f;
#pragma unroll
        for (int i = 0; i < 4; ++i) { const int d = 256 * i + 4 * lane; const f32x4 g2 = *(const f32x4*)(ada + b * 6144 + 5120 + d); v[i] = xv[i] + g2 * acc[i];
            ss += v[i][0] * v[i][0] + v[i][1] * v[i][1] + v[i][2] * v[i][2] + v[i][3] * v[i][3]; }
        ss = wave_sum(ss); const float rs = rsqrtf(ss * (1.0f / 1024.0f) + 1e-6f);
#pragma unroll
        for (int i = 0; i < 4; ++i) { const int d = 256 * i + 4 * lane; *(f32x4*)(dst + (size_t)row * 1024 + d) = v[i] * rs * *(const f32x4*)(p.final_g + d); }
        myslot = nslot;
    }
}

#define XB_TMO      128
#define XB_XCNT(j)  (256  + 64 * (j))
#define XB_XSUB(j)  (1280 + 64 * (j))
#define XB_XGEN(j)  (2304 + 64 * (j))
#define XB_TOP      3328
#define XB_TOPGEN   3392
#define XCD_BAR_WORDS 3456
#define XB_SPIN_CAP (1u << 22)
__device__ __forceinline__ unsigned xb_ld(unsigned* p)              { return __hip_atomic_load(p, __ATOMIC_RELAXED, __HIP_MEMORY_SCOPE_AGENT); }
__device__ __forceinline__ unsigned xb_add(unsigned* p, unsigned v) { return __hip_atomic_fetch_add(p, v, __ATOMIC_RELAXED, __HIP_MEMORY_SCOPE_AGENT); }
__device__ __forceinline__ unsigned xb_xcc_id() { return (unsigned)__builtin_amdgcn_s_getreg((3 << 11) | 20) & 0xFu; }
#define XB_SPIN(cond, bar) do { unsigned _sp = 0; while (cond) { __builtin_amdgcn_s_sleep(1); \
    if ((++_sp & 255u) == 0u) { if (xb_ld(&(bar)[XB_TMO])) break; if (_sp > XB_SPIN_CAP) { atomicAdd(&(bar)[XB_TMO], 1u); break; } } } } while (0)
struct XcdBarrier { unsigned* bar; unsigned x; volatile LAS unsigned* st; };
__device__ __forceinline__ XcdBarrier xcd_barrier_post(unsigned* bar, volatile LAS unsigned* st) {
    XcdBarrier b; b.bar = bar; b.x = xb_xcc_id(); b.st = st;
    if (threadIdx.x == 0) (void)xb_add(&bar[XB_XCNT(b.x)], 1u);
    return b;
}
__device__ __forceinline__ void xcd_barrier_complete(unsigned* bar, unsigned x, unsigned& nloc, unsigned& nx) {
    const unsigned G = gridDim.x * gridDim.y * gridDim.z;
    unsigned sum, cnt, mine, sp = 0u;
    for (;;) {
        sum = 0u; cnt = 0u; mine = 0u;
#pragma unroll
        for (unsigned j = 0; j < 16; ++j) { const unsigned c = xb_ld(&bar[XB_XCNT(j)]); sum += c; cnt += (c > 0u) ? 1u : 0u; mine = (j == x) ? c : mine; }
        if (sum == G) break;
        __builtin_amdgcn_s_sleep(1);
        if ((++sp & 255u) == 0u) { if (xb_ld(&bar[XB_TMO])) break; if (sp > XB_SPIN_CAP) { atomicAdd(&bar[XB_TMO], 1u); break; } }
    }
    nloc = mine > 0u ? mine : 1u; nx = cnt > 0u ? cnt : 1u;
}
__device__ __forceinline__ void xcd_barrier(const XcdBarrier& b) {
    asm volatile("s_waitcnt vmcnt(0)" ::: "memory");
    __syncthreads();
    if (threadIdx.x == 0) {
        unsigned* bar = b.bar;
        __builtin_amdgcn_s_waitcnt(0);
        unsigned nloc = b.st[0], nx = b.st[1];
        if (nloc == 0u) { xcd_barrier_complete(bar, b.x, nloc, nx); b.st[0] = nloc; b.st[1] = nx; }
        const unsigned old = xb_add(&bar[XB_XSUB(b.x)], 1u);
        const unsigned gen = old / nloc;
        if (old + 1u == (gen + 1u) * nloc) {
            __builtin_amdgcn_fence(__ATOMIC_RELEASE, "agent");
            asm volatile("s_waitcnt vmcnt(0)" ::: "memory");
            const unsigned og = xb_add(&bar[XB_TOP], 1u);
            const unsigned tg = og / nx;
            if (og + 1u == (tg + 1u) * nx) xb_add(&bar[XB_TOPGEN], 1u);
            else XB_SPIN(xb_ld(&bar[XB_TOPGEN]) == tg, bar);
            __builtin_amdgcn_fence(__ATOMIC_ACQUIRE, "agent");
            xb_add(&bar[XB_XGEN(b.x)], 1u);
            asm volatile("s_waitcnt vmcnt(0)" ::: "memory");
        } else {
            XB_SPIN(xb_ld(&bar[XB_XGEN(b.x)]) == gen, bar);
            __builtin_amdgcn_fence(__ATOMIC_ACQUIRE, "agent");
            asm volatile("s_waitcnt vmcnt(0)" ::: "memory");
        }
    }
    __syncthreads();
}

__global__ void __launch_bounds__(NTHR, 2) fwd_megakernel(Params p) {
    extern __shared__ __attribute__((aligned(16))) unsigned char lds_raw[];
    LAS unsigned char* lds = (LAS unsigned char*)lds_raw;
    cg::grid_group grid = cg::this_grid();
    const int G = gridDim.x, bid = blockIdx.x;
    unsigned char* ws = p.ws;
    bf16_t* const R1 = (bf16_t*)(ws + WS_R1); bf16_t* const Zb = (bf16_t*)(ws + WS_RZ); bf16_t* const PQt = (bf16_t*)(ws + WS_RPQ); bf16_t* const MRG = (bf16_t*)(ws + WS_R2);
    bf16_t* const Fb = (bf16_t*)((unsigned char*)p.out + OUT_F); bf16_t* const Ytb = (bf16_t*)((unsigned char*)p.out + OUT_YT);
#ifdef ONLY_PH
#define PH(k) ((k) == ONLY_PH && p.ph_lo <= (k) && (k) < p.ph_hi)
#else
#define PH(k) (p.ph_lo <= (k) && (k) < p.ph_hi)
#endif
    volatile LAS unsigned* xst = (volatile LAS unsigned*)(lds + LDS_BYTES - 16);
    if (threadIdx.x < 4) xst[threadIdx.x] = 0u;
    __syncthreads();
    XcdBarrier xbar = xcd_barrier_post((unsigned*)(ws + WS_BAR), xst);
    if (p.ph_lo < 0) grid.sync();
#define SYNC(k) do { if (PH(k) && PH((k) + 1)) xcd_barrier(xbar); } while (0)
#ifndef REPMASK
#define REPMASK 0
#endif
#define REP(k) for (int rep_ = 0; rep_ <= ((REPMASK >> (k)) & 1); ++rep_)
    if (PH(0)) REP(0) phase0(p, lds);
    SYNC(0);
    if (PH(1)) REP(1) phase1(p);
    SYNC(1);
    if (PH(2)) REP(2) {
        { ProbPQ pr{(const bf16_t*)(ws + WS_WPQ), R1, 1024, 1024, 16384}; pg8::Order S; S.init(4, 128, G, bid); EpiPQ E{PQt}; pg8::gemm_phase(lds, pr, S, E); }
        { ProbPlain pr{R1, (const bf16_t*)(ws + WS_WIN), 1024, 1024, 1024}; pg8::Order S; S.init(128, 16, G, bid); EpiZ E{Zb, 4096, -1}; pg8::gemm_phase(lds, pr, S, E); }
        { ProbPlain pr{(const bf16_t*)(ws + WS_HCTX), (const bf16_t*)(ws + WS_WIN), 1024, 1024, 1024}; pg8::Order S; S.init(8, 4, G, bid); EpiZ E{(bf16_t*)(ws + WS_ZXC), 1024, 0}; pg8::gemm_phase(lds, pr, S, E); }
    }
    SYNC(2);
    if (PH(3)) REP(3) {
        { ProbPlain pr{(const bf16_t*)(ws + WS_D1T), PQt, 512, 512, 512}; pg8::Order S; S.init(2, 256, G, bid); EpiPlain E{Ytb, 65536}; pg8::gemm_phase(lds, pr, S, E); }
        for (int it = bid; it < NB * 2 * 8; it += G) lru_tile<false>(p, lds, it);
    }
    SYNC(3);
    if (PH(4)) {
        for (int it = bid; it < NB * 256; it += G) fft_stage2(p, lds, it);
        const int ngr = G >> 5;
        if (ngr > 0 && bid < ngr * 32) lru2_block(p, lds, bid % ngr, bid / ngr, ngr);
    }
    SYNC(4);
    if (PH(5)) REP(5) {
        { ProbPlain pr{Fb, (const bf16_t*)(ws + WS_WFOUR), 512, 512, 512}; pg8::Order S; S.init(128, 4, G, bid); EpiY1 E{MRG, Zb}; pg8::gemm_phase(lds, pr, S, E); }
        { ProbPlain pr{R1, (const bf16_t*)(ws + WS_WLRU), 1024, 1024, 1024}; pg8::Order S; S.init(128, 4, G, bid); EpiY2 E{MRG, Zb}; pg8::gemm_phase(lds, pr, S, E); }
    }
    SYNC(5);
    if (PH(6)) REP(6) { ProbPlain pr{MRG, (const bf16_t*)(ws + WS_WOUT), 1024, 1024, 1024}; pg8::Order S; S.init(128, 4, G, bid);
        EpiOut E{p.out, p.x, (const float*)(ws + WS_POS), (const float*)(ws + WS_ADA)}; pg8::gemm_phase(lds, pr, S, E); }
    SYNC(6);
    if (PH(7)) REP(7) { phase7_rows(p, lds); phase7_weights(p); }
    SYNC(7);
    if (PH(8)) REP(8) phase8_topk(p, lds);
    SYNC(8);
    if (PH(9)) REP(9) { ProbMoeUp pr{R1, (const bf16_t*)(ws + WS_WGU), (const int*)(ws + WS_IDX), 1024, 1024, 1024}; pg8::Order S; S.init(256, 12, G, bid); EpiGU E{(bf16_t*)(ws + WS_HID)}; pg8::gemm_phase(lds, pr, S, E); }
    SYNC(9);
    if (PH(10)) { if (bid == 0 && threadIdx.x < 128) *(u32x4*)(ws + WS_OUTE + (size_t)MMOE * 2048 + threadIdx.x * 16) = (u32x4){0u, 0u, 0u, 0u}; }
    if (PH(10)) REP(10) { ProbMoeDown pr{(const bf16_t*)(ws + WS_HID), (const bf16_t*)(ws + WS_WD), 1536, 1536, 1536}; pg8::Order S; S.init(256, 4, G, bid); EpiDown E{(bf16_t*)(ws + WS_OUTE), (const float*)(ws + WS_GATE)}; pg8::gemm_phase(lds, pr, S, E); }
    SYNC(10);
    if (PH(12)) phase11(p, (float*)(ws + WS_HID));
    if (PH(11)) phase11(p, p.out);
}

#ifndef N_LAUNCHES
#define N_LAUNCHES 1
#endif
#ifndef PROBE_DUP
#define PROBE_DUP 0x0
#endif
extern "C" void kernel_launch(void* const* d_in, const int* in_sizes, int n_in, void* d_out, int out_size, void* d_ws, size_t ws_size, hipStream_t stream) {
    static int grid = 0;
    if (grid == 0) {
        if (n_in != 24 || out_size != MLAT * DM || ws_size < WS_END) { fprintf(stderr, "kernel_launch: unexpected shapes (n_in %d out %d ws %zu)\n", n_in, out_size, ws_size); grid = -1; return; }
        int dev = 0, cus = 0, per_cu = 0;
        hipGetDevice(&dev); hipDeviceGetAttribute(&cus, hipDeviceAttributeMultiprocessorCount, dev);
        hipFuncSetAttribute((const void*)fwd_megakernel, hipFuncAttributeMaxDynamicSharedMemorySize, LDS_BYTES);
        hipOccupancyMaxActiveBlocksPerMultiprocessor(&per_cu, (const void*)fwd_megakernel, NTHR, LDS_BYTES);
        if (per_cu < 1) { fprintf(stderr, "kernel_launch: occupancy query reports %d blocks per CU\n", per_cu); per_cu = 1; }
        grid = cus * 1;
        (void)hipGetLastError();
    }
    if (grid < 0) return;
    Params p{};
    const float** f = (const float**)&p;
    for (int i = 0; i < 24; ++i) f[i] = (const float*)d_in[i];
    p.out = (float*)d_out; p.ws = (unsigned char*)d_ws;
    (void)hipMemsetAsync((unsigned char*)d_ws + WS_BAR, 0, 32 * KiB, stream);
#if N_LAUNCHES == 1
    p.ph_lo = 0; p.ph_hi = 12;
    void* args[] = {&p};
    hipError_t e = hipLaunchCooperativeKernel((const void*)fwd_megakernel, dim3(grid), dim3(NTHR), args, LDS_BYTES, stream);
    if (e != hipSuccess) fprintf(stderr, "cooperative launch failed: %s (grid %d)\n", hipGetErrorString(e), grid);
#else
    for (int k = 0; k < 12; ++k) for (int r = 0; r <= ((PROBE_DUP >> k) & 1); ++r) { p.ph_lo = k; p.ph_hi = k + 1; if (k == 11 && r == 0 && ((PROBE_DUP >> 11) & 1)) { p.ph_lo = 12; p.ph_hi = 13; } hipLaunchKernelGGL(fwd_megakernel, dim3(grid), dim3(NTHR), LDS_BYTES, stream, p); }
#endif
}
```

```cpp
#include <hip/hip_runtime.h>
#include <hip/hip_cooperative_groups.h>
#include <cstdio>
namespace cg = cooperative_groups;

#define LAS __attribute__((address_space(3)))
typedef unsigned short bf16_t;
typedef short bf16x8 __attribute__((ext_vector_type(8)));
typedef float f32x4 __attribute__((ext_vector_type(4)));
typedef float f32x16 __attribute__((ext_vector_type(16)));
typedef unsigned u32x4 __attribute__((ext_vector_type(4)));
typedef unsigned u32x2 __attribute__((ext_vector_type(2)));

constexpr int NB = 8, TT = 4096, DM = 1024, CTXL = 256, MLAT = NB * TT, MCTX = NB * CTXL;
constexpr int NE = 16, CAP = 512, DE = 1536, MMOE = NE * NB * CAP;
constexpr int NSEQ = 34;
constexpr int NTHR = 512;
constexpr int LDS_BYTES = 144 * 1024;

constexpr size_t KiB = 1024, MiB = 1024 * 1024;
constexpr size_t WS_ADA = 0;
constexpr size_t WS_POS = 256 * KiB;
constexpr size_t WS_AGG = 512 * KiB;
constexpr size_t WS_WPQ = 5 * MiB;
constexpr size_t WS_WIN = 7 * MiB;
constexpr size_t WS_WFOUR = 15 * MiB;
constexpr size_t WS_WLRU = 16 * MiB;
constexpr size_t WS_WOUT = 18 * MiB;
constexpr size_t WS_WAT = 20 * MiB;
constexpr size_t WS_WIT = 20 * MiB + 512 * KiB;
constexpr size_t WS_SCORES = 21 * MiB;
constexpr size_t WS_IDX = 23 * MiB;
constexpr size_t WS_GATE = 23 * MiB + 256 * KiB;
constexpr size_t WS_SLOT = 23 * MiB + 512 * KiB;
constexpr size_t WS_BAR = 25 * MiB + 512 * KiB;
constexpr size_t WS_D1T = 34 * MiB;
constexpr size_t WS_HCTX = 26 * MiB;
constexpr size_t WS_ZXC = 30 * MiB;
constexpr size_t WS_R1 = 40 * MiB;
constexpr size_t WS_RPQ = 104 * MiB;
constexpr size_t WS_R2 = 168 * MiB;
constexpr size_t WS_RZ = 232 * MiB;
constexpr size_t WS_END = 488 * MiB;
constexpr size_t WS_HID = WS_RZ, WS_WD = WS_RZ + 192 * MiB, WS_WGU = WS_RPQ, WS_OUTE = WS_R1;
constexpr size_t OUT_YT = 0, OUT_F = 64 * MiB;

struct Params {
    const float *x, *c, *ctx, *c_ctx, *w_ada, *b_ada, *norm1_g, *norm2_g, *w_in, *w_four, *conv_w, *conv_b, *lru_lambda,
        *lru_wa, *lru_ba, *lru_wi, *lru_bi, *w_lru, *w_out, *w_router, *w_gate_e, *w_up_e, *w_down_e, *final_g;
    float* out; unsigned char* ws; int ph_lo, ph_hi;
};

__device__ __forceinline__ int tid_opaque() { int t = threadIdx.x; asm volatile("" : "+v"(t)); return t; }
__device__ __forceinline__ unsigned cvt_pk_bf16(float lo, float hi) { unsigned r; asm volatile("v_cvt_pk_bf16_f32 %0, %1, %2" : "=v"(r) : "v"(lo), "v"(hi)); return r; }
__device__ __forceinline__ float bf_lo(unsigned w) { return __uint_as_float(w << 16); }
__device__ __forceinline__ float bf_hi(unsigned w) { return __uint_as_float(w & 0xffff0000u); }
__device__ __forceinline__ float bf2f(bf16_t h) { return __uint_as_float(((unsigned)h) << 16); }
__device__ __forceinline__ float sigmoidf_(float v) { return __builtin_amdgcn_rcpf(1.0f + __expf(-v)); }
__device__ __forceinline__ float gelu_tanh(float v) { const float y = 1.5957691216f * (v + 0.044715f * v * v * v); return v * sigmoidf_(y); }
__device__ __forceinline__ float wave_sum(float v) {
#pragma unroll
    for (int o = 32; o >= 1; o >>= 1) v += __shfl_xor(v, o);
    return v;
}
__device__ __forceinline__ void unpack8(const u32x4 w, float (&f)[8]) { f[0] = bf_lo(w.x); f[1] = bf_hi(w.x); f[2] = bf_lo(w.y); f[3] = bf_hi(w.y); f[4] = bf_lo(w.z); f[5] = bf_hi(w.z); f[6] = bf_lo(w.w); f[7] = bf_hi(w.w); }

namespace pg8 {
constexpr int BM = 256, BK = 64, HALF = 128, HTB = HALF * BK * 2, STAGE_BYTES = 8 * HTB, NXCD = 8, WGM = 8;
__device__ __forceinline__ int lds_byte(int r, int c) { const int st = (r >> 4) * 2 + (c >> 5), rr = r & 15, cc = c & 31, ob = rr * 64 + cc * 2; return st * 1024 + (ob ^ (((ob >> 9) & 1) << 5)); }
__device__ __forceinline__ void stage_rc(int b, int& R, int& C) { const int st = b / 1024, sb = b % 1024, swz = sb ^ (((sb >> 9) & 1) << 5); R = (st >> 1) * 16 + swz / 64; C = (st & 1) * 32 + (swz % 64) / 2; }
__device__ __forceinline__ int perm32(int rho) { const int n = rho >> 4, i = rho & 15; return 8 * (i >> 2) + 4 * n + (i & 3); }
struct Unit { int pm, pn; };
struct Order {
    int nM, nN, nwg, G, c;
    __device__ void init(int nM_, int nN_, int G_, int c_) { nM = nM_; nN = nN_; nwg = nM * nN; G = G_; c = c_; }
    __device__ bool next(int i, Unit& u) const {
        const long L = (long)i * G + c; if (L >= nwg) return false;
        int wgid = (int)L; { const int q = nwg / NXCD, r = nwg % NXCD, xcd = wgid % NXCD, off = wgid / NXCD; wgid = (xcd < r ? xcd * (q + 1) : r * (q + 1) + (xcd - r) * q) + off; }
        const int nig = WGM * nN, gid = wgid / nig, fm = gid * WGM, gsz = (nM - fm) < WGM ? (nM - fm) : WGM;
        u.pm = fm + ((wgid % nig) % gsz); u.pn = (wgid % nig) / gsz; return true;
    }
};
template <class P, class Epi>
__device__ __forceinline__ void gemm_phase(LAS unsigned char* lds, const P& pr, const Order& S, const Epi& E) {
    const int tid = threadIdx.x, wid = __builtin_amdgcn_readfirstlane(tid >> 6), lane = tid & 63, wr = wid >> 2, wc = wid & 3, fr = lane & 15, fq = lane >> 4;
    const int nt = pr.K / BK;
    int RA[2], CA[2]; unsigned voffB[2];
#pragma unroll
    for (int i = 0; i < 2; ++i) { int R, C; stage_rc(tid * 16 + i * 8192, R, C); RA[i] = R; CA[i] = C; const int Rb = Epi::PERM ? ((R & ~31) + perm32(R & 31)) : R; voffB[i] = (unsigned)(Rb * pr.ldb + C) * 2u; }
    const size_t kstep = (size_t)(BK * 2);
    const size_t hstepB = (size_t)HALF * pr.ldb * 2;
    const unsigned ldsw = (unsigned)wid * 1024u;
    const int aoff = lds_byte(wr * 64 + fr, fq * 8), boff = lds_byte(wc * 32 + fr, fq * 8);
#define PG8_SA(b, h) (((b) * 2 + (h)) * HTB)
#define PG8_SB(b, h) ((4 + (b) * 2 + (h)) * HTB)
#define PG8_STAGE(bufoff, gbase, voff) do { _Pragma("unroll") for (int _i = 0; _i < 2; ++_i) \
        __builtin_amdgcn_global_load_lds((const unsigned*)((const char*)(gbase) + (voff)[_i]), (LAS unsigned*)(lds + (bufoff) + ldsw + _i * 8192), 16, 0, 0); } while (0)
#define PG8_LDA(dst, b, h) do { _Pragma("unroll") for (int m = 0; m < 4; ++m) _Pragma("unroll") for (int k = 0; k < 2; ++k) dst[m][k] = *(const LAS bf16x8*)(lds + PG8_SA(b, h) + aoff + m * 2048 + k * 1024); } while (0)
#define PG8_LDB(dst, b, h) do { _Pragma("unroll") for (int n = 0; n < 2; ++n) _Pragma("unroll") for (int k = 0; k < 2; ++k) dst[n][k] = *(const LAS bf16x8*)(lds + PG8_SB(b, h) + boff + n * 2048 + k * 1024); } while (0)
#define PG8_MMA(ai, bj, At, Bt) do { __builtin_amdgcn_s_setprio(1); _Pragma("unroll") for (int m = 0; m < 4; ++m) _Pragma("unroll") for (int n = 0; n < 2; ++n) _Pragma("unroll") for (int k = 0; k < 2; ++k) \
        acc[ai][bj][m][n] = __builtin_amdgcn_mfma_f32_16x16x32_bf16(Bt[n][k], At[m][k], acc[ai][bj][m][n], 0, 0, 0); __builtin_amdgcn_s_setprio(0); } while (0)
#define PG8_WAIT_V(n) asm volatile("s_waitcnt vmcnt(" #n ")" ::: "memory")
#define PG8_WAIT_L(n) asm volatile("s_waitcnt lgkmcnt(" #n ")" ::: "memory")
#define PG8_BAR __builtin_amdgcn_s_barrier()
#define PG8_SCHED __builtin_amdgcn_sched_barrier(0)
    Unit cur, nxt; int ui = 0;
    if (!S.next(0, cur)) return;
    f32x4 acc[2][2][4][2];
#pragma unroll
    for (int a = 0; a < 2; ++a)
#pragma unroll
        for (int b = 0; b < 2; ++b)
#pragma unroll
            for (int m = 0; m < 4; ++m)
#pragma unroll
                for (int n = 0; n < 2; ++n) acc[a][b][m][n] = (f32x4){0.f, 0.f, 0.f, 0.f};
    bf16x8 At[4][2], B0[2][2], B1[2][2];
    unsigned vA[2][2], vN[2][2];
    pr.avoff(cur, RA, CA, vA);
#pragma unroll
    for (int h = 0; h < 2; ++h)
#pragma unroll
        for (int i = 0; i < 2; ++i) vN[h][i] = vA[h][i];
    const char* cA = pr.abase(cur); const char* cB = pr.bbase(cur);
    PG8_STAGE(PG8_SB(0, 0), cB, voffB); PG8_STAGE(PG8_SA(0, 0), cA, vA[0]); PG8_STAGE(PG8_SB(0, 1), cB + hstepB, voffB); PG8_STAGE(PG8_SA(0, 1), cA, vA[1]);
    if (wr == 1) PG8_BAR;
    PG8_WAIT_V(4); PG8_BAR;
    PG8_STAGE(PG8_SB(1, 0), cB + kstep, voffB); PG8_STAGE(PG8_SA(1, 0), cA + kstep, vA[0]); PG8_STAGE(PG8_SB(1, 1), cB + hstepB + kstep, voffB);
    PG8_WAIT_V(6); PG8_BAR;
    for (;;) {
        const bool has_next = S.next(ui + 1, nxt);
        const char* nA = has_next ? pr.abase(nxt) : cA; const char* nB = has_next ? pr.bbase(nxt) : cB;
        if (P::GATHER) { if (has_next) pr.avoff(nxt, RA, CA, vN); }
        for (int t = 0; t < nt; t += 2) {
            const bool last = (t == nt - 2);
            const char* a1 = cA + (size_t)(t + 1) * kstep;
            const char* a2 = last ? nA : cA + (size_t)(t + 2) * kstep; const char* b2 = last ? nB : cB + (size_t)(t + 2) * kstep;
            const char* a3 = a2 + kstep; const char* b3 = b2 + kstep;
            unsigned v2[2][2];
#pragma unroll
            for (int h = 0; h < 2; ++h)
#pragma unroll
                for (int i = 0; i < 2; ++i) v2[h][i] = (P::GATHER && last) ? vN[h][i] : vA[h][i];
            PG8_LDB(B0, 0, 0); PG8_SCHED; PG8_LDA(At, 0, 0); PG8_STAGE(PG8_SA(1, 1), a1, vA[1]);
            PG8_WAIT_L(8); PG8_BAR; PG8_WAIT_L(0); PG8_MMA(0, 0, At, B0); PG8_BAR; PG8_SCHED;
            PG8_LDB(B1, 0, 1); PG8_STAGE(PG8_SB(0, 0), b2, voffB);
            PG8_BAR; PG8_WAIT_L(0); PG8_MMA(0, 1, At, B1); PG8_BAR;
            PG8_LDA(At, 0, 1); PG8_STAGE(PG8_SA(0, 0), a2, v2[0]);
            PG8_BAR; PG8_WAIT_L(0); PG8_MMA(1, 0, At, B0); PG8_BAR; PG8_SCHED;
            PG8_STAGE(PG8_SB(0, 1), b2 + hstepB, voffB);
            PG8_WAIT_V(6); PG8_BAR; PG8_MMA(1, 1, At, B1); PG8_BAR;
            PG8_LDB(B0, 1, 0); PG8_SCHED; PG8_LDA(At, 1, 0); PG8_STAGE(PG8_SA(0, 1), a2, v2[1]);
            PG8_WAIT_L(8); PG8_BAR; PG8_WAIT_L(0); PG8_MMA(0, 0, At, B0); PG8_BAR; PG8_SCHED;
            PG8_LDB(B1, 1, 1); PG8_STAGE(PG8_SB(1, 0), b3, voffB);
            PG8_BAR; PG8_WAIT_L(0); PG8_MMA(0, 1, At, B1); PG8_BAR;
            PG8_LDA(At, 1, 1); PG8_STAGE(PG8_SA(1, 0), a3, v2[0]);
            PG8_BAR; PG8_WAIT_L(0); PG8_MMA(1, 0, At, B0); PG8_BAR; PG8_SCHED;
            PG8_STAGE(PG8_SB(1, 1), b3 + hstepB, voffB);
            PG8_WAIT_V(6); PG8_BAR; PG8_MMA(1, 1, At, B1); PG8_BAR;
            if (P::GATHER && last) {
#pragma unroll
                for (int h = 0; h < 2; ++h)
#pragma unroll
                    for (int i = 0; i < 2; ++i) vA[h][i] = vN[h][i];
            }
        }
        E(acc, cur, wr, wc, fr, fq);
        if (!has_next) break;
#pragma unroll
        for (int a = 0; a < 2; ++a)
#pragma unroll
            for (int b = 0; b < 2; ++b)
#pragma unroll
                for (int m = 0; m < 4; ++m)
#pragma unroll
                    for (int n = 0; n < 2; ++n) acc[a][b][m][n] = (f32x4){0.f, 0.f, 0.f, 0.f};
        cur = nxt; cA = nA; cB = nB; ++ui;
    }
    PG8_WAIT_V(0);
    if (wr == 0) PG8_BAR;
    PG8_BAR;
#undef PG8_SA
#undef PG8_SB
#undef PG8_STAGE
#undef PG8_LDA
#undef PG8_LDB
#undef PG8_MMA
#undef PG8_WAIT_V
#undef PG8_WAIT_L
#undef PG8_BAR
#undef PG8_SCHED
}
}
using pg8::Unit;

struct ProbPlain {
    static constexpr bool GATHER = false;
    const bf16_t* A; const bf16_t* B; int K, lda, ldb;
    __device__ __forceinline__ const char* abase(const Unit& u) const { return (const char*)(A + (size_t)u.pm * 256 * lda); }
    __device__ __forceinline__ const char* bbase(const Unit& u) const { return (const char*)(B + (size_t)u.pn * 256 * ldb); }
    __device__ __forceinline__ void avoff(const Unit&, const int (&RA)[2], const int (&CA)[2], unsigned (&v)[2][2]) const {
#pragma unroll
        for (int h = 0; h < 2; ++h)
#pragma unroll
            for (int i = 0; i < 2; ++i) v[h][i] = (unsigned)((h * 128 + RA[i]) * lda + CA[i]) * 2u;
    }
};
struct ProbPQ {
    static constexpr bool GATHER = false;
    const bf16_t* A; const bf16_t* B; int K, lda, ldb;
    __device__ __forceinline__ const char* abase(const Unit& u) const { return (const char*)(A + (size_t)u.pm * 256 * lda); }
    __device__ __forceinline__ const char* bbase(const Unit& u) const { return (const char*)(B + ((size_t)(u.pn >> 4) * 4096 + (u.pn & 15)) * 1024); }
    __device__ __forceinline__ void avoff(const Unit&, const int (&RA)[2], const int (&CA)[2], unsigned (&v)[2][2]) const {
#pragma unroll
        for (int h = 0; h < 2; ++h)
#pragma unroll
            for (int i = 0; i < 2; ++i) v[h][i] = (unsigned)((h * 128 + RA[i]) * lda + CA[i]) * 2u;
    }
};
struct ProbMoeUp {
    static constexpr bool GATHER = true;
    const bf16_t* A; const bf16_t* B; const int* idx; int K, lda, ldb;
    __device__ __forceinline__ const char* abase(const Unit&) const { return (const char*)A; }
    __device__ __forceinline__ const char* bbase(const Unit& u) const { return (const char*)(B + ((size_t)(u.pm >> 4) * 3072 + (size_t)u.pn * 256) * ldb); }
    __device__ __forceinline__ void avoff(const Unit& u, const int (&RA)[2], const int (&CA)[2], unsigned (&v)[2][2]) const {
#pragma unroll
        for (int h = 0; h < 2; ++h)
#pragma unroll
            for (int i = 0; i < 2; ++i) { const int g = idx[u.pm * 256 + h * 128 + RA[i]]; v[h][i] = (unsigned)(g * lda + CA[i]) * 2u; }
    }
};
struct ProbMoeDown {
    static constexpr bool GATHER = false;
    const bf16_t* A; const bf16_t* B; int K, lda, ldb;
    __device__ __forceinline__ const char* abase(const Unit& u) const { return (const char*)(A + (size_t)u.pm * 256 * lda); }
    __device__ __forceinline__ const char* bbase(const Unit& u) const { return (const char*)(B + ((size_t)(u.pm >> 4) * 1024 + (size_t)u.pn * 256) * ldb); }
    __device__ __forceinline__ void avoff(const Unit&, const int (&RA)[2], const int (&CA)[2], unsigned (&v)[2][2]) const {
#pragma unroll
        for (int h = 0; h < 2; ++h)
#pragma unroll
            for (int i = 0; i < 2; ++i) v[h][i] = (unsigned)((h * 128 + RA[i]) * lda + CA[i]) * 2u;
    }
};

#define EPI_ROWS(...) _Pragma("unroll") for (int ai = 0; ai < 2; ++ai) _Pragma("unroll") for (int m = 0; m < 4; ++m) { const int row = u.pm * 256 + ai * 128 + wr * 64 + m * 16 + fr; __VA_ARGS__ }
__device__ __forceinline__ u32x4 pack8(const f32x4 v0, const f32x4 v1) { u32x4 w; w.x = cvt_pk_bf16(v0[0], v0[1]); w.y = cvt_pk_bf16(v0[2], v0[3]); w.z = cvt_pk_bf16(v1[0], v1[1]); w.w = cvt_pk_bf16(v1[2], v1[3]); return w; }

struct EpiPQ {
    static constexpr bool PERM = true; bf16_t* O;
    __device__ __forceinline__ void operator()(const f32x4 (&acc)[2][2][4][2], const Unit& u, int wr, int wc, int fr, int fq) const {
        const int t10 = wc * 32 + 8 * fq, b = u.pn >> 4, t2 = u.pn & 15;
        EPI_ROWS(
            bf16_t* rp = O + ((size_t)((b * 512 + (row >> 1)) * 16 + t2) * 512 + (row & 1) * 256 + t10);
            _Pragma("unroll") for (int bj = 0; bj < 2; ++bj) *(u32x4*)(rp + bj * 128) = pack8(acc[ai][bj][m][0], acc[ai][bj][m][1]);
        )
    }
};
struct EpiPlain {
    static constexpr bool PERM = true; bf16_t* O; size_t ldc;
    __device__ __forceinline__ void operator()(const f32x4 (&acc)[2][2][4][2], const Unit& u, int wr, int wc, int fr, int fq) const {
        const int col0 = u.pn * 256 + wc * 32 + 8 * fq;
        EPI_ROWS(
            bf16_t* rp = O + (size_t)row * ldc + col0;
            _Pragma("unroll") for (int bj = 0; bj < 2; ++bj) *(u32x4*)(rp + bj * 128) = pack8(acc[ai][bj][m][0], acc[ai][bj][m][1]);
        )
    }
};
struct EpiZ {
    static constexpr bool PERM = true; bf16_t* O; int ldc; int fixed_act;
    __device__ __forceinline__ void operator()(const f32x4 (&acc)[2][2][4][2], const Unit& u, int wr, int wc, int fr, int fq) const {
        const int col0 = u.pn * 256 + wc * 32 + 8 * fq; const int act = fixed_act >= 0 ? fixed_act : (u.pn >> 2);
        EPI_ROWS(
            bf16_t* rp = O + (size_t)row * ldc + col0;
            _Pragma("unroll") for (int bj = 0; bj < 2; ++bj) {
                f32x4 v0 = acc[ai][bj][m][0], v1 = acc[ai][bj][m][1];
                if (act == 1) { _Pragma("unroll") for (int j = 0; j < 4; ++j) { v0[j] = gelu_tanh(v0[j]); v1[j] = gelu_tanh(v1[j]); } }
                else if (act >= 2) { _Pragma("unroll") for (int j = 0; j < 4; ++j) { v0[j] = sigmoidf_(v0[j]); v1[j] = sigmoidf_(v1[j]); } }
                *(u32x4*)(rp + bj * 128) = pack8(v0, v1); }
        )
    }
};
struct EpiY1 {
    static constexpr bool PERM = true; bf16_t* O; const bf16_t* Z;
    __device__ __forceinline__ void operator()(const f32x4 (&acc)[2][2][4][2], const Unit& u, int wr, int wc, int fr, int fq) const {
        const int col0 = u.pn * 256 + wc * 32 + 8 * fq;
        EPI_ROWS(
            _Pragma("unroll") for (int bj = 0; bj < 2; ++bj) {
                const int col = col0 + bj * 128; float g[8]; unpack8(*(const u32x4*)(Z + (size_t)row * 4096 + 2048 + col), g);
                f32x4 v0 = acc[ai][bj][m][0], v1 = acc[ai][bj][m][1];
                _Pragma("unroll") for (int j = 0; j < 4; ++j) { v0[j] *= g[j]; v1[j] *= g[4 + j]; }
                *(u32x4*)(O + (size_t)row * 1024 + col) = pack8(v0, v1); }
        )
    }
};
struct EpiY2 {
    static constexpr bool PERM = true; bf16_t* O; const bf16_t* Z;
    __device__ __forceinline__ void operator()(const f32x4 (&acc)[2][2][4][2], const Unit& u, int wr, int wc, int fr, int fq) const {
        const int col0 = u.pn * 256 + wc * 32 + 8 * fq;
        EPI_ROWS(
            _Pragma("unroll") for (int bj = 0; bj < 2; ++bj) {
                const int col = col0 + bj * 128; float g[8], t1[8]; unpack8(*(const u32x4*)(Z + (size_t)row * 4096 + 3072 + col), g); unpack8(*(const u32x4*)(O + (size_t)row * 1024 + col), t1);
                f32x4 v0 = acc[ai][bj][m][0], v1 = acc[ai][bj][m][1];
                _Pragma("unroll") for (int j = 0; j < 4; ++j) { v0[j] = t1[j] + v0[j] * g[j]; v1[j] = t1[4 + j] + v1[j] * g[4 + j]; }
                *(u32x4*)(O + (size_t)row * 1024 + col) = pack8(v0, v1); }
        )
    }
};
struct EpiOut {
    static constexpr bool PERM = false; float* O; const float* X; const float* pos; const float* ada;
    __device__ __forceinline__ void operator()(const f32x4 (&acc)[2][2][4][2], const Unit& u, int wr, int wc, int fr, int fq) const {
        const int col0 = u.pn * 256 + wc * 32 + 4 * fq; const int b = u.pm >> 4;
        EPI_ROWS(
            const int t = row & 4095;
            _Pragma("unroll") for (int bj = 0; bj < 2; ++bj) _Pragma("unroll") for (int n = 0; n < 2; ++n) {
                const int col = col0 + bj * 128 + n * 16;
                const f32x4 xv = *(const f32x4*)(X + (size_t)row * 1024 + col);
                const f32x4 pv = *(const f32x4*)(pos + (col < 512 ? (t >> 6) * 512 + col : (t & 63) * 512 + (col - 512)));
                const f32x4 gv = *(const f32x4*)(ada + b * 6144 + 2048 + col);
                *(f32x4*)(O + (size_t)row * 1024 + col) = xv + pv + gv * acc[ai][bj][m][n]; }
        )
    }
};
struct EpiGU {
    static constexpr bool PERM = true; bf16_t* O;
    __device__ __forceinline__ void operator()(const f32x4 (&acc)[2][2][4][2], const Unit& u, int wr, int wc, int fr, int fq) const {
        const int col0 = u.pn * 128 + wc * 32 + 8 * fq;
        EPI_ROWS(
            f32x4 v0, v1;
            _Pragma("unroll") for (int j = 0; j < 4; ++j) { const float g0 = acc[ai][0][m][0][j], g1 = acc[ai][0][m][1][j];
                v0[j] = g0 * sigmoidf_(g0) * acc[ai][1][m][0][j]; v1[j] = g1 * sigmoidf_(g1) * acc[ai][1][m][1][j]; }
            *(u32x4*)(O + (size_t)row * DE + col0) = pack8(v0, v1);
        )
    }
};
struct EpiDown {
    static constexpr bool PERM = true; bf16_t* O; const float* gate;
    __device__ __forceinline__ void operator()(const f32x4 (&acc)[2][2][4][2], const Unit& u, int wr, int wc, int fr, int fq) const {
        const int col0 = u.pn * 256 + wc * 32 + 8 * fq;
        EPI_ROWS(
            const float g = gate[row];
            _Pragma("unroll") for (int bj = 0; bj < 2; ++bj) *(u32x4*)(O + (size_t)row * 1024 + col0 + bj * 128) = pack8(acc[ai][bj][m][0] * g, acc[ai][bj][m][1] * g);
        )
    }
};

__device__ void p0_ada(const Params& p, LAS unsigned char* lds, int item) {
    const int tid = threadIdx.x;
    LAS float* s = (LAS float*)lds; LAS float* red = s + 9 * 1024;
    for (int i = tid; i < 9 * 1024; i += NTHR) { const int r = i >> 10, d = i & 1023; const float v = r < 8 ? p.c[r * 1024 + d] : p.c_ctx[d]; s[i] = v / (1.0f + expf(-v)); }
    __syncthreads();
    const int col = tid & 63, ds = tid >> 6; float a[9];
#pragma unroll
    for (int r = 0; r < 9; ++r) a[r] = 0.f;
    const float* w = p.w_ada + (size_t)(ds * 128) * 6144 + item * 64 + col;
    for (int d = 0; d < 128; ++d) { const float wv = w[(size_t)d * 6144];
#pragma unroll
        for (int r = 0; r < 9; ++r) a[r] += s[r * 1024 + ds * 128 + d] * wv; }
#pragma unroll
    for (int r = 0; r < 9; ++r) red[(ds * 9 + r) * 64 + col] = a[r];
    __syncthreads();
    float* ada = (float*)(p.ws + WS_ADA);
    for (int i = tid; i < 9 * 64; i += NTHR) { const int r = i >> 6, cc = i & 63; float v = 0.f;
#pragma unroll
        for (int k = 0; k < 8; ++k) v += red[(k * 9 + r) * 64 + cc];
        ada[r * 6144 + item * 64 + cc] = v + p.b_ada[item * 64 + cc]; }
    __syncthreads();
}
template <int NS>
__device__ __forceinline__ void xpose_item(const float* src, int ldsrc, bf16_t* dst, int lddst, int k0, int n0, int mode) {
    const int tid = threadIdx.x, nl = tid & 63, k8 = tid >> 6;
    float v[NS][8];
#pragma unroll
    for (int s = 0; s < NS; ++s)
#pragma unroll
        for (int j = 0; j < 8; ++j) v[s][j] = src[(size_t)(k0 + 8 * k8 + j) * ldsrc + n0 + 64 * s + nl];
#pragma unroll
    for (int s = 0; s < NS; ++s) { const int n = n0 + 64 * s + nl; int row = n;
        if (mode) row = (n >> 7) * 256 + (n & 127) + (mode == 2 ? 128 : 0);
        u32x4 w; w.x = cvt_pk_bf16(v[s][0], v[s][1]); w.y = cvt_pk_bf16(v[s][2], v[s][3]); w.z = cvt_pk_bf16(v[s][4], v[s][5]); w.w = cvt_pk_bf16(v[s][6], v[s][7]);
        *(u32x4*)(dst + (size_t)row * lddst + k0 + 8 * k8) = w; }
}
__device__ void p0_wpq(const Params& p, LAS unsigned char* lds, int item) {
    const int tid = threadIdx.x, g = item >> 4, db = item & 15;
    LAS float* wl = (LAS float*)lds; LAS float* ct = wl + 64 * 129;
    for (int i = tid; i < 64 * 128; i += NTHR) { const int d = i >> 7, cc = i & 127; wl[d * 129 + cc] = p.w_in[(size_t)(db * 64 + d) * 4608 + g * 128 + cc]; }
    if (tid < 128) { float sn, cs; sincospif((float)tid * (1.0f / 64.0f), &sn, &cs); ct[tid] = cs; ct[128 + tid] = sn; }
    __syncthreads();
    const int q = tid & 255, kc = q >> 1, pq = q & 1, dh = tid >> 8; const int n = (g * 128 + kc) * 2 + pq;
    bf16_t* dst = (bf16_t*)(p.ws + WS_WPQ) + (size_t)n * 1024 + db * 64 + dh * 32;
    const float scale = 0.001381067932f;
    for (int d8 = 0; d8 < 4; ++d8) { float a[8];
#pragma unroll
        for (int j = 0; j < 8; ++j) a[j] = 0.f;
        for (int cc = 0; cc < 128; ++cc) { const float tv = ct[pq * 128 + ((cc * kc) & 127)];
#pragma unroll
            for (int j = 0; j < 8; ++j) a[j] += wl[(dh * 32 + d8 * 8 + j) * 129 + cc] * tv; }
        u32x4 w; w.x = cvt_pk_bf16(a[0] * scale, a[1] * scale); w.y = cvt_pk_bf16(a[2] * scale, a[3] * scale); w.z = cvt_pk_bf16(a[4] * scale, a[5] * scale); w.w = cvt_pk_bf16(a[6] * scale, a[7] * scale);
        *(u32x4*)(dst + d8 * 8) = w; }
    __syncthreads();
}
__device__ void p0_d1t(const Params& p, int item) {
    bf16_t* dst = (bf16_t*)(p.ws + WS_D1T);
    const int row = item * 64 + (threadIdx.x >> 3), k1 = row >> 1, ri = row & 1, c0 = (threadIdx.x & 7) * 64;
    for (int c8 = 0; c8 < 64; c8 += 8) { float v[8];
#pragma unroll
        for (int j = 0; j < 8; ++j) { const int col = c0 + c8 + j, pq = col >> 8, t1 = col & 255; float sn, cs; sincospif((float)((k1 * t1) & 255) * (1.0f / 128.0f), &sn, &cs);
            v[j] = (ri == 0) ? (pq == 0 ? cs : -sn) : (pq == 0 ? -sn : -cs); }
        u32x4 w; w.x = cvt_pk_bf16(v[0], v[1]); w.y = cvt_pk_bf16(v[2], v[3]); w.z = cvt_pk_bf16(v[4], v[5]); w.w = cvt_pk_bf16(v[6], v[7]);
        *(u32x4*)(dst + (size_t)row * 512 + c0 + c8) = w; }
}
__device__ void p0_pos(const Params& p) {
    float* tab = (float*)(p.ws + WS_POS);
    for (int i = threadIdx.x; i < 64 * 512; i += NTHR) { const int ii = i >> 9, j = i & 511, jj = j & 255; const float f = expf(-9.210340371976184f * (float)jj / 256.0f); const float a = (float)ii * f; tab[i] = j < 256 ? sinf(a) : cosf(a); }
}
__device__ void phase0(const Params& p, LAS unsigned char* lds) {
    constexpr int N_ADA = 96, N_WIN = 16 * 16, N_WFOUR = 8 * 4, N_SQ = 16 * 4, N_LRU = 16 * 2, N_WPQ = 64, N_DFT = 8, N_POS = 1;
    constexpr int O1 = N_ADA, O2 = O1 + N_WIN, O3 = O2 + N_WFOUR, O4 = O3 + N_SQ, O5 = O4 + N_SQ, O6 = O5 + N_LRU, O7 = O6 + N_LRU, O8 = O7 + N_WPQ, O9 = O8 + N_DFT, O10 = O9 + N_POS;
    for (int it = blockIdx.x; it < O10; it += gridDim.x) {
        if (it < O1) p0_ada(p, lds, it);
        else if (it < O2) { const int j = it - O1; xpose_item<4>(p.w_in + 512, 4608, (bf16_t*)(p.ws + WS_WIN), 1024, (j >> 4) * 64, (j & 15) * 256, 0); }
        else if (it < O3) { const int j = it - O2; xpose_item<4>(p.w_four, 1024, (bf16_t*)(p.ws + WS_WFOUR), 512, (j >> 2) * 64, (j & 3) * 256, 0); }
        else if (it < O4) { const int j = it - O3; xpose_item<4>(p.w_lru, 1024, (bf16_t*)(p.ws + WS_WLRU), 1024, (j >> 2) * 64, (j & 3) * 256, 0); }
        else if (it < O5) { const int j = it - O4; xpose_item<4>(p.w_out, 1024, (bf16_t*)(p.ws + WS_WOUT), 1024, (j >> 2) * 64, (j & 3) * 256, 0); }
        else if (it < O6) { const int j = it - O5, mtx = j >> 1; xpose_item<2>(p.lru_wa + (size_t)mtx * 16384, 128, (bf16_t*)(p.ws + WS_WAT) + (size_t)mtx * 16384, 128, (j & 1) * 64, 0, 0); }
        else if (it < O7) { const int j = it - O6, mtx = j >> 1; xpose_item<2>(p.lru_wi + (size_t)mtx * 16384, 128, (bf16_t*)(p.ws + WS_WIT) + (size_t)mtx * 16384, 128, (j & 1) * 64, 0, 0); }
        else if (it < O8) p0_wpq(p, lds, it - O7);
        else if (it < O9) p0_d1t(p, it - O8);
        else p0_pos(p);
    }
}

__device__ void phase1(const Params& p) {
    const int lane = threadIdx.x & 63, wid = threadIdx.x >> 6;
    const float* ada = (const float*)(p.ws + WS_ADA); const float* tab = (const float*)(p.ws + WS_POS);
    bf16_t* h1 = (bf16_t*)(p.ws + WS_R1); bf16_t* hc = (bf16_t*)(p.ws + WS_HCTX);
    const int NR = MLAT + MCTX;
    for (int row0 = (blockIdx.x * 8 + wid) * 2; row0 < NR; row0 += gridDim.x * 16) {
        f32x4 v[2][4]; float ss[2];
#pragma unroll
        for (int r = 0; r < 2; ++r) { const int row = row0 + r; const bool lat = row < MLAT; const float* xr = lat ? p.x + (size_t)row * 1024 : p.ctx + (size_t)(row - MLAT) * 1024;
#pragma unroll
            for (int i = 0; i < 4; ++i) v[r][i] = *(const f32x4*)(xr + 256 * i + 4 * lane); }
#pragma unroll
        for (int r = 0; r < 2; ++r) { const int row = row0 + r; const bool lat = row < MLAT; const int t = row & 4095; float a = 0.f;
#pragma unroll
            for (int i = 0; i < 4; ++i) { const int d = 256 * i + 4 * lane;
                if (lat) v[r][i] += *(const f32x4*)(tab + (i < 2 ? (t >> 6) * 512 + d : (t & 63) * 512 + d - 512));
                a += v[r][i][0] * v[r][i][0] + v[r][i][1] * v[r][i][1] + v[r][i][2] * v[r][i][2] + v[r][i][3] * v[r][i][3]; }
            ss[r] = a; }
#pragma unroll
        for (int o = 32; o >= 1; o >>= 1) { ss[0] += __shfl_xor(ss[0], o); ss[1] += __shfl_xor(ss[1], o); }
#pragma unroll
        for (int r = 0; r < 2; ++r) { const int row = row0 + r; const bool lat = row < MLAT; const int mrow = lat ? (row >> 12) : 8;
            const float rs = rsqrtf(ss[r] * (1.0f / 1024.0f) + 1e-6f);
            bf16_t* dst = lat ? h1 + (size_t)row * 1024 : hc + (size_t)(row - MLAT) * 1024;
#pragma unroll
            for (int i = 0; i < 4; ++i) { const int d = 256 * i + 4 * lane;
                const f32x4 g = *(const f32x4*)(p.norm1_g + d), sh = *(const f32x4*)(ada + mrow * 6144 + d), sc = *(const f32x4*)(ada + mrow * 6144 + 1024 + d);
                const f32x4 h = v[r][i] * rs * g * (sc + 1.0f) + sh;
                u32x2 w; w.x = cvt_pk_bf16(h[0], h[1]); w.y = cvt_pk_bf16(h[2], h[3]); *(u32x2*)(dst + d) = w; } }
    }
}

#define LRU_CST(mb, r) (32 * (mb) + 8 * ((r) >> 2) + ((r) & 3))
template <bool FINAL, int DIR>
__device__ __forceinline__ void lru_wave(const Params& p, LAS unsigned char* ul, int b, int sc, int head, int cb, int lane, f32x16 (&accI)[4]) {
    constexpr int SG = DIR ? -1 : 1;
    const int lr = lane & 31, lh = lane >> 5;
    const int chl = cb * 32 + lr, ch = head * 128 + chl;
    const int tbase = DIR ? 127 - 4 * lh : 4 * lh;
    f32x16 accA[4];
#pragma unroll
    for (int mb = 0; mb < 4; ++mb)
#pragma unroll
        for (int r = 0; r < 16; ++r) { accA[mb][r] = 0.f; accI[mb][r] = 0.f; }
    {
        const bf16_t* wa = (const bf16_t*)(p.ws + WS_WAT) + ((size_t)(DIR * 8 + head) * 128 + chl) * 128 + 8 * lh;
        const bf16_t* wi = (const bf16_t*)(p.ws + WS_WIT) + ((size_t)(DIR * 8 + head) * 128 + chl) * 128 + 8 * lh;
        LAS unsigned char* arow0 = ul + (DIR ? 127 - lr : lr) * 272 + lh * 16;
#pragma unroll
        for (int kc = 0; kc < 2; ++kc) { bf16x8 bA[4], bI[4];
#pragma unroll
            for (int k4 = 0; k4 < 4; ++k4) { bA[k4] = *(const bf16x8*)(wa + 16 * (kc * 4 + k4)); bI[k4] = *(const bf16x8*)(wi + 16 * (kc * 4 + k4)); }
#pragma unroll
            for (int mb = 0; mb < 4; ++mb)
#pragma unroll
                for (int k4 = 0; k4 < 4; ++k4) { const bf16x8 af = *(const LAS bf16x8*)(arow0 + SG * 32 * mb * 272 + 32 * (kc * 4 + k4));
                    accA[mb] = __builtin_amdgcn_mfma_f32_32x32x16_bf16(af, bA[k4], accA[mb], 0, 0, 0);
                    accI[mb] = __builtin_amdgcn_mfma_f32_32x32x16_bf16(af, bI[k4], accI[mb], 0, 0, 0); }
            __builtin_amdgcn_sched_barrier(0); }
    }
    {
        const float lam = p.lru_lambda[DIR * 1024 + ch]; const float sp8 = 8.0f * log1pf(expf(-lam));
        const float ba = p.lru_ba[DIR * 1024 + ch], bi = p.lru_bi[DIR * 1024 + ch];
        LAS unsigned char* up = ul + tbase * 272 + chl * 2;
#pragma unroll
        for (int mb = 0; mb < 4; ++mb) {
#pragma unroll
            for (int r = 0; r < 16; ++r) {
                const float uv = bf2f(*(const LAS bf16_t*)(up + SG * LRU_CST(mb, r) * 272));
                const float rg = sigmoidf_(accA[mb][r] + ba), ig = sigmoidf_(accI[mb][r] + bi);
                const float a = __expf(-sp8 * rg); accA[mb][r] = a; accI[mb][r] = __builtin_amdgcn_sqrtf(fmaxf(1.0f - a * a, 0.f)) * ig * uv; }
            __builtin_amdgcn_sched_barrier(0); }
    }
    float rA[16], rH[16];
#pragma unroll
    for (int mb = 0; mb < 4; ++mb)
#pragma unroll
        for (int q = 0; q < 4; ++q) { float pa = 1.f, hh = 0.f;
#pragma unroll
            for (int j = 0; j < 4; ++j) { const int r = 4 * q + j; const float a = accA[mb][r], bb = accI[mb][r]; hh = a * hh + bb; pa *= a; accA[mb][r] = pa; accI[mb][r] = hh; }
            rA[mb * 4 + q] = pa; rH[mb * 4 + q] = hh; }
    const int agg_dir_off = ((b * NSEQ) * 2 + DIR) * 1024 + ch;
    const float* agg = (const float*)(p.ws + WS_AGG);
    float carry = 0.f;
    if (FINAL) {
        if (DIR == 0) { for (int q = 0; q < sc; ++q) { const float* a2 = agg + (size_t)(agg_dir_off + q * 2048) * 2; carry = a2[0] * carry + a2[1]; } }
        else { { const float* a2 = agg + (size_t)(agg_dir_off + 1 * 2048) * 2; carry = a2[0] * carry + a2[1]; } { const float* a2 = agg + (size_t)(agg_dir_off + 0 * 2048) * 2; carry = a2[0] * carry + a2[1]; }
            for (int q = NSEQ - 1; q > sc; --q) { const float* a2 = agg + (size_t)(agg_dir_off + q * 2048) * 2; carry = a2[0] * carry + a2[1]; } }
    }
    float cin[16];
#pragma unroll
    for (int i = 0; i < 16; ++i) cin[i] = 0.f;
    float s = carry, At = 1.f;
#pragma unroll
    for (int i = 0; i < 16; ++i) { const float oA = __shfl_xor(rA[i], 32), oH = __shfl_xor(rH[i], 32);
        { const bool mine = (lh == 0); const float a = mine ? rA[i] : oA, hh = mine ? rH[i] : oH; cin[i] = mine ? s : cin[i]; s = a * s + hh; At *= a; }
        { const bool mine = (lh == 1); const float a = mine ? rA[i] : oA, hh = mine ? rH[i] : oH; cin[i] = mine ? s : cin[i]; s = a * s + hh; At *= a; } }
    if (!FINAL) {
        if (lh == 0) { float* o = (float*)(p.ws + WS_AGG) + (size_t)(agg_dir_off + sc * 2048) * 2; o[0] = At; o[1] = s; }
        return;
    }
#pragma unroll
    for (int mb = 0; mb < 4; ++mb)
#pragma unroll
        for (int r = 0; r < 16; ++r) accI[mb][r] += accA[mb][r] * cin[mb * 4 + (r >> 2)];
}
template <bool FINAL>
__device__ void lru_tile(const Params& p, LAS unsigned char* lds, int item) {
    const int tid = threadIdx.x, lane = tid & 63, wid = __builtin_amdgcn_readfirstlane(tid >> 6);
    int b, sc, head;
    if (FINAL) { head = item & 7; sc = 2 + ((item >> 3) & 31); b = item >> 8; }
    else { head = item & 7; const int r = item >> 3; sc = r & 1; b = r >> 1; }
    const bf16_t* src; int Tseq, t0, ld;
    if (sc < 2) { src = (const bf16_t*)(p.ws + WS_ZXC) + (size_t)b * 256 * 1024; Tseq = 256; t0 = sc * 128; ld = 1024; }
    else { src = (const bf16_t*)(p.ws + WS_RZ) + (size_t)b * 4096 * 4096; Tseq = 4096; t0 = (sc - 2) * 128; ld = 4096; }
    LAS unsigned char* ul = lds;
    LAS float* ybuf = (LAS float*)(lds + 36 * 1024);
    {
        const int c8 = tid & 15, tb = tid >> 4; const int ch0 = head * 128 + 8 * c8;
        float w[4][8], bias[8];
#pragma unroll
        for (int k = 0; k < 4; ++k) { const f32x4 a = *(const f32x4*)(p.conv_w + k * 1024 + ch0), c2 = *(const f32x4*)(p.conv_w + k * 1024 + ch0 + 4);
#pragma unroll
            for (int j = 0; j < 4; ++j) { w[k][j] = a[j]; w[k][4 + j] = c2[j]; } }
        { const f32x4 a = *(const f32x4*)(p.conv_b + ch0), c2 = *(const f32x4*)(p.conv_b + ch0 + 4);
#pragma unroll
            for (int j = 0; j < 4; ++j) { bias[j] = a[j]; bias[4 + j] = c2[j]; } }
#pragma unroll
        for (int i = 0; i < 4; ++i) { const int t = tb + 32 * i; float a[8];
#pragma unroll
            for (int j = 0; j < 8; ++j) a[j] = bias[j];
#pragma unroll
            for (int k = 0; k < 4; ++k) { const int tt = t0 + t + k - 2;
                if (tt >= 0 && tt < Tseq) { float f[8]; unpack8(*(const u32x4*)(src + (size_t)tt * ld + ch0), f);
#pragma unroll
                    for (int j = 0; j < 8; ++j) a[j] += w[k][j] * f[j]; } }
            u32x4 wv; wv.x = cvt_pk_bf16(a[0], a[1]); wv.y = cvt_pk_bf16(a[2], a[3]); wv.z = cvt_pk_bf16(a[4], a[5]); wv.w = cvt_pk_bf16(a[6], a[7]);
            *(LAS u32x4*)(ul + t * 272 + c8 * 16) = wv; }
    }
    __syncthreads();
    f32x16 hacc[4];
    if (wid < 4) lru_wave<FINAL, 0>(p, ul, b, sc, head, wid & 3, lane, hacc);
    else lru_wave<FINAL, 1>(p, ul, b, sc, head, wid & 3, lane, hacc);
    if (FINAL) {
        const int lr = lane & 31, lh = lane >> 5, chl = (wid & 3) * 32 + lr;
        if (wid >= 4) { LAS float* yp = ybuf + (127 - 4 * lh) * 129 + chl;
#pragma unroll
            for (int mb = 0; mb < 4; ++mb)
#pragma unroll
                for (int r = 0; r < 16; ++r) yp[-LRU_CST(mb, r) * 129] = hacc[mb][r]; }
        __syncthreads();
        if (wid < 4) {
            const LAS float* yp = ybuf + (4 * lh) * 129 + chl;
            const bf16_t* Zu = (const bf16_t*)(p.ws + WS_RZ) + ((size_t)(b * 4096 + t0) * 4096 + 1024 + head * 128);
            bf16_t* Ou = (bf16_t*)(p.ws + WS_R1) + ((size_t)(b * 4096 + t0) * 1024 + head * 128);
            const unsigned zo = (unsigned)(4 * lh * 4096 + chl), oo = (unsigned)(4 * lh * 1024 + chl);
#pragma unroll
            for (int mb = 0; mb < 4; ++mb) {
#pragma unroll
                for (int r = 0; r < 16; ++r) {
                    const float y = hacc[mb][r] + yp[LRU_CST(mb, r) * 129];
                    const float gz = bf2f(Zu[zo + LRU_CST(mb, r) * 4096]);
                    Ou[oo + LRU_CST(mb, r) * 1024] = (bf16_t)(cvt_pk_bf16(gz * y, 0.f) & 0xffffu);
                    if ((r & 7) == 7) __builtin_amdgcn_sched_barrier(0); } }
        }
    }
    __syncthreads();
}

#ifndef LRU_PF_FRAG
#define LRU_PF_FRAG true
#endif
#ifndef LRU_PF_TILE
#define LRU_PF_TILE true
#endif
typedef unsigned long long u64_t;
template <int DIR, bool PREF>
__device__ __forceinline__ void lru2_dir(const Params& p, LAS unsigned char* ul, int head, int w, int lane, const bf16x8 (&bA)[4], const bf16x8 (&bI)[4], bf16x8 (&nA)[4], bf16x8 (&nI)[4],
                                         f32x4 (&hl)[8], f32x4 (&pp)[8], float& Atot, float& Htot) {
    constexpr int SG = DIR ? -1 : 1;
    const int fr = lane & 15, fq = lane >> 4, chl = 16 * w + fr, ch = head * 128 + chl;
    f32x4 accA[8], accI[8];
#pragma unroll
    for (int rb = 0; rb < 8; ++rb) { accA[rb] = (f32x4){0.f, 0.f, 0.f, 0.f}; accI[rb] = (f32x4){0.f, 0.f, 0.f, 0.f}; }
    {
        LAS unsigned char* arow0 = ul + (DIR ? 127 - fr : fr) * 272 + fq * 16;
#pragma unroll
        for (int rb = 0; rb < 8; ++rb)
#pragma unroll
            for (int ks = 0; ks < 4; ++ks) { const bf16x8 af = *(const LAS bf16x8*)(arow0 + SG * 16 * rb * 272 + 64 * ks);
                accA[rb] = __builtin_amdgcn_mfma_f32_16x16x32_bf16(af, bA[ks], accA[rb], 0, 0, 0);
                accI[rb] = __builtin_amdgcn_mfma_f32_16x16x32_bf16(af, bI[ks], accI[rb], 0, 0, 0); }
    }
    if (PREF) {
        const bf16_t* wa = (const bf16_t*)(p.ws + WS_WAT) + ((size_t)((1 - DIR) * 8 + head) * 128 + chl) * 128 + 8 * fq;
        const bf16_t* wi = (const bf16_t*)(p.ws + WS_WIT) + ((size_t)((1 - DIR) * 8 + head) * 128 + chl) * 128 + 8 * fq;
#pragma unroll
        for (int ks = 0; ks < 4; ++ks) { nA[ks] = *(const bf16x8*)(wa + 32 * ks); nI[ks] = *(const bf16x8*)(wi + 32 * ks); }
    }
    {
        const float lam = p.lru_lambda[DIR * 1024 + ch]; const float sp8 = 8.0f * log1pf(expf(-lam));
        const float ba = p.lru_ba[DIR * 1024 + ch], bi = p.lru_bi[DIR * 1024 + ch];
        LAS unsigned char* up = ul + (DIR ? 127 - 4 * fq : 4 * fq) * 272 + chl * 2;
#pragma unroll
        for (int rb = 0; rb < 8; ++rb)
#pragma unroll
            for (int r = 0; r < 4; ++r) {
                const float uv = bf2f(*(const LAS bf16_t*)(up + SG * (16 * rb + r) * 272));
                const float rg = sigmoidf_(accA[rb][r] + ba), ig = sigmoidf_(accI[rb][r] + bi);
                const float a = __expf(-sp8 * rg); accA[rb][r] = a; accI[rb][r] = __builtin_amdgcn_sqrtf(fmaxf(1.0f - a * a, 0.f)) * ig * uv;
                if (r == 3 && (rb & 1)) __builtin_amdgcn_sched_barrier(0); }
    }
    float rA[8], rH[8];
#pragma unroll
    for (int rb = 0; rb < 8; ++rb) { float pa = 1.f, hh = 0.f;
#pragma unroll
        for (int r = 0; r < 4; ++r) { const float a = accA[rb][r], bb = accI[rb][r]; hh = a * hh + bb; pa *= a; accA[rb][r] = pa; accI[rb][r] = hh; }
        rA[rb] = pa; rH[rb] = hh; }
    float Pc = 1.f, s = 0.f;
#pragma unroll
    for (int rb = 0; rb < 8; ++rb) { float Pin = 1.f, Hin = 0.f;
#pragma unroll
        for (int q = 0; q < 4; ++q) { const float a = __shfl(rA[rb], fr + 16 * q), hh = __shfl(rH[rb], fr + 16 * q);
            if (q == fq) { Pin = Pc; Hin = s; }
            s = a * s + hh; Pc *= a; }
#pragma unroll
        for (int r = 0; r < 4; ++r) { hl[rb][r] = accI[rb][r] + accA[rb][r] * Hin; pp[rb][r] = accA[rb][r] * Pin; }
        __builtin_amdgcn_sched_barrier(0); }
    Atot = Pc; Htot = s;
}
__device__ __forceinline__ u64_t agg_ld(const u64_t* a) { return __hip_atomic_load(a, __ATOMIC_RELAXED, __HIP_MEMORY_SCOPE_AGENT); }
template <int DIR>
__device__ __forceinline__ float lru2_carry(const u64_t* aggc, int n, int fr, int fq) {
    float Ap = 1.f, Hp = 0.f; u64_t v[9];
#pragma unroll
    for (int k = 0; k < 9; ++k) { const int j = fq * 9 + k; const int seq = DIR ? (j == 0 ? 1 : (j == 1 ? 0 : 35 - j)) : j;
        v[k] = (j < n) ? agg_ld(aggc + (size_t)seq * 2048) : 0x000000003f800000ull; }
#pragma unroll
    for (int k = 0; k < 9; ++k) { const float a = __uint_as_float((unsigned)v[k]), hh = __uint_as_float((unsigned)(v[k] >> 32)); Hp = a * Hp + hh; Ap *= a; }
    float s = 0.f;
#pragma unroll
    for (int q = 0; q < 4; ++q) { const float a = __shfl(Ap, fr + 16 * q), hh = __shfl(Hp, fr + 16 * q); s = a * s + hh; }
    return s;
}
__device__ void lru2_block(const Params& p, LAS unsigned char* lds, int slot, int c, int ngr) {
    const int tid = threadIdx.x, lane = tid & 63, wid = __builtin_amdgcn_readfirstlane(tid >> 6);
    const int sc = c + 2, t0 = c * 128;
    LAS unsigned char* raw = lds;
    LAS unsigned char* ul = lds + 33792;
    LAS unsigned char* gzl = lds + 68608;
    LAS unsigned char* outl = lds + 103424;
    const int fr = lane & 15, fq = lane >> 4, chl = 16 * wid + fr;
    u32x4 nr[5], ng[4];
#define LRU2_LOAD(gg) do { const bf16_t* Zb_ = (const bf16_t*)(p.ws + WS_RZ) + (size_t)((gg) >> 3) * 4096 * 4096 + ((gg) & 7) * 128; \
        _Pragma("unroll") for (int k = 0; k < 5; ++k) { const int pc = tid + NTHR * k; nr[k] = (u32x4){0u, 0u, 0u, 0u}; \
            if (pc < 131 * 16) { const int row = pc >> 4, c8 = pc & 15, tt = t0 - 2 + row; if (tt >= 0 && tt < TT) nr[k] = *(const u32x4*)(Zb_ + (size_t)tt * 4096 + c8 * 8); } } \
        _Pragma("unroll") for (int k = 0; k < 4; ++k) { const int pc = tid + NTHR * k, row = pc >> 4, c8 = pc & 15; ng[k] = *(const u32x4*)(Zb_ + (size_t)(t0 + row) * 4096 + 1024 + c8 * 8); } } while (0)
    LRU2_LOAD(slot);
    for (int g = slot; g < NB * 8; g += ngr) {
        const int b = g >> 3, head = g & 7, ch = head * 128 + chl;
        unsigned* gcnt = (unsigned*)(p.ws + WS_BAR + 16 * KiB) + g * 64;
        bf16x8 bA1[4], bI1[4], bA0[4], bI0[4];
        { const bf16_t* wa = (const bf16_t*)(p.ws + WS_WAT) + ((size_t)(8 + head) * 128 + chl) * 128 + 8 * fq; const bf16_t* wi = (const bf16_t*)(p.ws + WS_WIT) + ((size_t)(8 + head) * 128 + chl) * 128 + 8 * fq;
#pragma unroll
          for (int ks = 0; ks < 4; ++ks) { bA1[ks] = *(const bf16x8*)(wa + 32 * ks); bI1[ks] = *(const bf16x8*)(wi + 32 * ks); } }
#pragma unroll
        for (int k = 0; k < 5; ++k) { const int pc = tid + NTHR * k; if (pc < 131 * 16) *(LAS u32x4*)(raw + (pc >> 4) * 256 + (pc & 15) * 16) = nr[k]; }
#pragma unroll
        for (int k = 0; k < 4; ++k) { const int pc = tid + NTHR * k; *(LAS u32x4*)(gzl + (pc >> 4) * 272 + (pc & 15) * 16) = ng[k]; }
        __syncthreads();
        {
            const int c8 = tid & 15, tb = tid >> 4; const int ch0 = head * 128 + 8 * c8;
            float w[4][8], bias[8];
#pragma unroll
            for (int k = 0; k < 4; ++k) { const f32x4 a = *(const f32x4*)(p.conv_w + k * 1024 + ch0), c2 = *(const f32x4*)(p.conv_w + k * 1024 + ch0 + 4);
#pragma unroll
                for (int j = 0; j < 4; ++j) { w[k][j] = a[j]; w[k][4 + j] = c2[j]; } }
            { const f32x4 a = *(const f32x4*)(p.conv_b + ch0), c2 = *(const f32x4*)(p.conv_b + ch0 + 4);
#pragma unroll
                for (int j = 0; j < 4; ++j) { bias[j] = a[j]; bias[4 + j] = c2[j]; } }
#pragma unroll
            for (int i = 0; i < 4; ++i) { const int t = tb + 32 * i; float a[8];
#pragma unroll
                for (int j = 0; j < 8; ++j) a[j] = bias[j];
#pragma unroll
                for (int k = 0; k < 4; ++k) { float f[8]; unpack8(*(const LAS u32x4*)(raw + (t + k) * 256 + c8 * 16), f);
#pragma unroll
                    for (int j = 0; j < 8; ++j) a[j] += w[k][j] * f[j]; }
                u32x4 wv; wv.x = cvt_pk_bf16(a[0], a[1]); wv.y = cvt_pk_bf16(a[2], a[3]); wv.z = cvt_pk_bf16(a[4], a[5]); wv.w = cvt_pk_bf16(a[6], a[7]);
                *(LAS u32x4*)(ul + t * 272 + c8 * 16) = wv; }
        }
        __syncthreads();
        float A0, H0, A1, H1;
        {
            f32x4 hl1[8], pp1[8];
            lru2_dir<1, LRU_PF_FRAG>(p, ul, head, wid, lane, bA1, bI1, bA0, bI0, hl1, pp1, A1, H1);
            LAS unsigned char* hp = outl + (127 - 4 * fq) * 272 + chl * 2; LAS unsigned char* qp = raw + (127 - 4 * fq) * 256 + chl * 2;
#pragma unroll
            for (int rb = 0; rb < 8; ++rb)
#pragma unroll
                for (int r = 0; r < 4; ++r) { *(LAS bf16_t*)(hp - (16 * rb + r) * 272) = (bf16_t)(cvt_pk_bf16(hl1[rb][r], 0.f) & 0xffffu); *(LAS bf16_t*)(qp - (16 * rb + r) * 256) = (bf16_t)(cvt_pk_bf16(pp1[rb][r], 0.f) & 0xffffu); }
        }
        __builtin_amdgcn_sched_barrier(0);
        if (!LRU_PF_FRAG) { const bf16_t* wa = (const bf16_t*)(p.ws + WS_WAT) + ((size_t)(head) * 128 + chl) * 128 + 8 * fq; const bf16_t* wi = (const bf16_t*)(p.ws + WS_WIT) + ((size_t)(head) * 128 + chl) * 128 + 8 * fq;
#pragma unroll
          for (int ks = 0; ks < 4; ++ks) { bA0[ks] = *(const bf16x8*)(wa + 32 * ks); bI0[ks] = *(const bf16x8*)(wi + 32 * ks); } }
        f32x4 hl0[8], pp0[8];
        lru2_dir<0, false>(p, ul, head, wid, lane, bA0, bI0, bA1, bI1, hl0, pp0, A0, H0);
        u64_t* agg = (u64_t*)(p.ws + WS_AGG);
        const size_t ai0 = ((size_t)(b * NSEQ) * 2 + 0) * 1024 + ch, ai1 = ((size_t)(b * NSEQ) * 2 + 1) * 1024 + ch;
        if (fq == 0) {
            __hip_atomic_store(agg + ai0 + (size_t)sc * 2048, ((u64_t)__float_as_uint(H0) << 32) | __float_as_uint(A0), __ATOMIC_RELAXED, __HIP_MEMORY_SCOPE_AGENT);
            __hip_atomic_store(agg + ai1 + (size_t)sc * 2048, ((u64_t)__float_as_uint(H1) << 32) | __float_as_uint(A1), __ATOMIC_RELAXED, __HIP_MEMORY_SCOPE_AGENT); }
        asm volatile("s_waitcnt vmcnt(0)" ::: "memory");
        __syncthreads();
        if (tid == 0) (void)__hip_atomic_fetch_add(gcnt, 1u, __ATOMIC_RELAXED, __HIP_MEMORY_SCOPE_AGENT);
        if (wid == 0) { unsigned sp = 0;
            while ((unsigned)__builtin_amdgcn_readfirstlane(__hip_atomic_load(gcnt, __ATOMIC_RELAXED, __HIP_MEMORY_SCOPE_AGENT)) < 32u) { __builtin_amdgcn_s_sleep(1); if (++sp > (1u << 22)) break; }
            __builtin_amdgcn_fence(__ATOMIC_ACQUIRE, "agent");
            asm volatile("s_waitcnt vmcnt(0)" ::: "memory"); }
        __syncthreads();
        const float C0 = lru2_carry<0>(agg + ai0, sc, fr, fq);
        const float C1 = lru2_carry<1>(agg + ai1, 2 + (NSEQ - 1 - sc), fr, fq);
        __builtin_amdgcn_sched_barrier(0);
        if (LRU_PF_TILE) { const int gn = (g + ngr < NB * 8) ? g + ngr : g; LRU2_LOAD(gn); }
        __builtin_amdgcn_sched_barrier(0);
        LAS unsigned char* gp = gzl + (4 * fq) * 272 + chl * 2; LAS unsigned char* op = outl + (4 * fq) * 272 + chl * 2; LAS unsigned char* qp0 = raw + (4 * fq) * 256 + chl * 2;
#pragma unroll
        for (int rb = 0; rb < 8; ++rb)
#pragma unroll
            for (int r = 0; r < 4; ++r) { const float h1 = bf2f(*(const LAS bf16_t*)(op + (16 * rb + r) * 272)) + bf2f(*(const LAS bf16_t*)(qp0 + (16 * rb + r) * 256)) * C1;
                const float y = hl0[rb][r] + pp0[rb][r] * C0 + h1;
                const float gz = bf2f(*(const LAS bf16_t*)(gp + (16 * rb + r) * 272));
                *(LAS bf16_t*)(op + (16 * rb + r) * 272) = (bf16_t)(cvt_pk_bf16(gz * y, 0.f) & 0xffffu); }
        __syncthreads();
        bf16_t* Ob = (bf16_t*)(p.ws + WS_R1) + ((size_t)(b * 4096 + t0)) * 1024 + head * 128;
#pragma unroll
        for (int k = 0; k < 4; ++k) { const int pc = tid + NTHR * k, row = pc >> 4, c8 = pc & 15;
            *(u32x4*)(Ob + (size_t)row * 1024 + c8 * 8) = *(const LAS u32x4*)(outl + row * 272 + c8 * 16); }
        __syncthreads();
        if (!LRU_PF_TILE && g + ngr < NB * 8) LRU2_LOAD(g + ngr);
    }
#undef LRU2_LOAD
}

__device__ void fft_stage2(const Params& p, LAS unsigned char* lds, int item) {
    const int tid = threadIdx.x, b = item >> 8, k1 = item & 255;
    LAS unsigned char* yl = lds;
    LAS float* cf = (LAS float*)(lds + 32768);
    const bf16_t* Yt = (const bf16_t*)((const unsigned char*)p.out + OUT_YT);
#pragma unroll
    for (int k = 0; k < 4; ++k) { const int pc = tid + NTHR * k, ri = pc >> 10, o = (pc & 1023) * 8;
        *(LAS u32x4*)(yl + ri * 16384 + o * 2) = *(const u32x4*)(Yt + (size_t)(k1 * 2 + ri) * 65536 + (size_t)b * 8192 + o); }
    if (tid < 256) { const int k2 = tid >> 4, t2 = tid & 15; float sn, cs; sincospif((float)(((k1 + 256 * k2) * t2) & 4095) * (1.0f / 2048.0f), &sn, &cs); cf[tid * 2] = cs; cf[tid * 2 + 1] = sn; }
    __syncthreads();
    float yr[16], yi[16];
    { float f[8]; unpack8(*(const LAS u32x4*)(yl + tid * 32), f);
#pragma unroll
      for (int j = 0; j < 8; ++j) yr[j] = f[j];
      unpack8(*(const LAS u32x4*)(yl + tid * 32 + 16), f);
#pragma unroll
      for (int j = 0; j < 8; ++j) yr[8 + j] = f[j];
      unpack8(*(const LAS u32x4*)(yl + 16384 + tid * 32), f);
#pragma unroll
      for (int j = 0; j < 8; ++j) yi[j] = f[j];
      unpack8(*(const LAS u32x4*)(yl + 16384 + tid * 32 + 16), f);
#pragma unroll
      for (int j = 0; j < 8; ++j) yi[8 + j] = f[j]; }
    bf16_t* Fo = (bf16_t*)((unsigned char*)p.out + OUT_F) + ((size_t)b * 4096 + k1) * 512 + tid;
#pragma unroll
    for (int k2 = 0; k2 < 16; ++k2) { float a = 0.f;
#pragma unroll
        for (int t2 = 0; t2 < 16; ++t2) { const float cs = cf[(k2 * 16 + t2) * 2], sn = cf[(k2 * 16 + t2) * 2 + 1]; a += cs * yr[t2] + sn * yi[t2]; }
        Fo[(size_t)k2 * 256 * 512] = (bf16_t)(cvt_pk_bf16(a, 0.f) & 0xffffu); }
    __syncthreads();
}

__device__ void phase7_rows(const Params& p, LAS unsigned char* lds) {
    const int tid = threadIdx.x, lane = tid & 63, wid = tid >> 6;
    LAS float* wrt = (LAS float*)lds;
    for (int i = tid; i < 16 * 1024; i += NTHR) { const int d = i >> 4, e = i & 15; wrt[e * 1024 + d] = p.w_router[i]; }
    __syncthreads();
    const float* ada = (const float*)(p.ws + WS_ADA); bf16_t* h2 = (bf16_t*)(p.ws + WS_R1); float* scores = (float*)(p.ws + WS_SCORES);
    for (int row0 = (blockIdx.x * 8 + wid) * 2; row0 < MLAT; row0 += gridDim.x * 16) {
        const int b = row0 >> 12;
        f32x4 v[2][4]; float ss[2];
#pragma unroll
        for (int r = 0; r < 2; ++r)
#pragma unroll
            for (int i = 0; i < 4; ++i) v[r][i] = *(const f32x4*)(p.out + (size_t)(row0 + r) * 1024 + 256 * i + 4 * lane);
#pragma unroll
        for (int r = 0; r < 2; ++r) { float a = 0.f;
#pragma unroll
            for (int i = 0; i < 4; ++i) a += v[r][i][0] * v[r][i][0] + v[r][i][1] * v[r][i][1] + v[r][i][2] * v[r][i][2] + v[r][i][3] * v[r][i][3];
            ss[r] = a; }
#pragma unroll
        for (int o = 32; o >= 1; o >>= 1) { ss[0] += __shfl_xor(ss[0], o); ss[1] += __shfl_xor(ss[1], o); }
#pragma unroll
        for (int i = 0; i < 4; ++i) { const int d = 256 * i + 4 * lane;
            const f32x4 g = *(const f32x4*)(p.norm2_g + d), sh = *(const f32x4*)(ada + b * 6144 + 3072 + d), sc = *(const f32x4*)(ada + b * 6144 + 4096 + d);
#pragma unroll
            for (int r = 0; r < 2; ++r) { const float rs = rsqrtf(ss[r] * (1.0f / 1024.0f) + 1e-6f);
                v[r][i] = v[r][i] * rs * g * (sc + 1.0f) + sh;
                u32x2 w; w.x = cvt_pk_bf16(v[r][i][0], v[r][i][1]); w.y = cvt_pk_bf16(v[r][i][2], v[r][i][3]); *(u32x2*)(h2 + (size_t)(row0 + r) * 1024 + d) = w; } }
        float q[32];
#pragma unroll
        for (int e = 0; e < 16; ++e) { float a0 = 0.f, a1 = 0.f;
#pragma unroll
            for (int i = 0; i < 4; ++i) { const f32x4 w = *(const LAS f32x4*)(wrt + e * 1024 + 256 * i + 4 * lane);
                a0 += v[0][i][0] * w[0] + v[0][i][1] * w[1] + v[0][i][2] * w[2] + v[0][i][3] * w[3];
                a1 += v[1][i][0] * w[0] + v[1][i][1] * w[1] + v[1][i][2] * w[2] + v[1][i][3] * w[3]; }
            q[e] = a0; q[16 + e] = a1; }
#pragma unroll
        for (int j = 0; j < 16; ++j) { const bool up = (lane & 32) != 0; const float send = up ? q[j] : q[16 + j], keep = up ? q[16 + j] : q[j]; q[j] = keep + __shfl_xor(send, 32); }
#pragma unroll
        for (int j = 0; j < 8; ++j) { const bool up = (lane & 16) != 0; const float send = up ? q[j] : q[8 + j], keep = up ? q[8 + j] : q[j]; q[j] = keep + __shfl_xor(send, 16); }
#pragma unroll
        for (int j = 0; j < 4; ++j) { const bool up = (lane & 8) != 0; const float send = up ? q[j] : q[4 + j], keep = up ? q[4 + j] : q[j]; q[j] = keep + __shfl_xor(send, 8); }
#pragma unroll
        for (int j = 0; j < 2; ++j) { const bool up = (lane & 4) != 0; const float send = up ? q[j] : q[2 + j], keep = up ? q[2 + j] : q[j]; q[j] = keep + __shfl_xor(send, 4); }
        { const bool up = (lane & 2) != 0; const float send = up ? q[0] : q[1], keep = up ? q[1] : q[0]; q[0] = keep + __shfl_xor(send, 2); }
        float lg = q[0] + __shfl_xor(q[0], 1);
        float mx = lg;
#pragma unroll
        for (int o = 2; o <= 16; o <<= 1) mx = fmaxf(mx, __shfl_xor(mx, o));
        const float ex = expf(lg - mx); float sum = ex;
#pragma unroll
        for (int o = 2; o <= 16; o <<= 1) sum += __shfl_xor(sum, o);
        if ((lane & 1) == 0) scores[((size_t)b * 16 + ((lane >> 1) & 15)) * 4096 + ((row0 + (lane >> 5)) & 4095)] = ex / sum;
    }
    __syncthreads();
}
__device__ void phase7_weights(const Params& p) {
    constexpr int N_G = 16 * 16 * 6, N_D = 16 * 24 * 4;
    for (int it = blockIdx.x; it < 2 * N_G + N_D; it += gridDim.x) {
        if (it < 2 * N_G) { const int up = it >= N_G, j = up ? it - N_G : it, e = j / 96, r = j % 96, kb = r / 6, nb = r % 6;
            xpose_item<4>((up ? p.w_up_e : p.w_gate_e) + (size_t)e * 1024 * 1536, 1536, (bf16_t*)(p.ws + WS_WGU) + (size_t)e * 3072 * 1024, 1024, kb * 64, nb * 256, up ? 2 : 1); }
        else { const int j = it - 2 * N_G, e = j / 96, r = j % 96, kb = r >> 2, nb = r & 3;
            xpose_item<4>(p.w_down_e + (size_t)e * 1536 * 1024, 1024, (bf16_t*)(p.ws + WS_WD) + (size_t)e * 1024 * 1536, 1536, kb * 64, nb * 256, 0); }
    }
}

__device__ void phase8_topk(const Params& p, LAS unsigned char* lds) {
    const int tid = threadIdx.x, lane = tid & 63, wid = tid >> 6;
    LAS unsigned* cnt = (LAS unsigned*)lds;
    LAS unsigned* wsum = cnt + 16;
    const float* scores = (const float*)(p.ws + WS_SCORES);
    int* idx = (int*)(p.ws + WS_IDX); float* gate = (float*)(p.ws + WS_GATE); int* slot_of = (int*)(p.ws + WS_SLOT);
    for (int it = blockIdx.x; it < NB * NE; it += gridDim.x) {
        const int b = it >> 4, e = it & 15;
        unsigned key[8];
        { const u32x4* sp = (const u32x4*)(scores + (size_t)it * 4096 + tid * 8); const u32x4 a = sp[0], c2 = sp[1]; key[0] = a.x; key[1] = a.y; key[2] = a.z; key[3] = a.w; key[4] = c2.x; key[5] = c2.y; key[6] = c2.z; key[7] = c2.w; }
        unsigned thr = 0;
        for (int bit = 30; bit >= 0; --bit) {
            const unsigned cand = thr | (1u << bit); unsigned c = 0;
#pragma unroll
            for (int j = 0; j < 8; ++j) c += (unsigned)__popcll(__ballot(key[j] >= cand));
            LAS unsigned* cb = cnt + (bit & 1) * 8;
            if (lane == 0) cb[wid] = c;
            __syncthreads();
            unsigned tot = 0;
#pragma unroll
            for (int w = 0; w < 8; ++w) tot += cb[w];
            if (tot >= (unsigned)CAP) thr = cand;
        }
        unsigned cg_ = 0, ce = 0;
#pragma unroll
        for (int j = 0; j < 8; ++j) { cg_ += key[j] > thr; ce += key[j] == thr; }
        unsigned pk = cg_ | (ce << 16), incl = pk;
#pragma unroll
        for (int o = 1; o < 64; o <<= 1) { const unsigned n = __shfl_up(incl, o); if (lane >= o) incl += n; }
        if (lane == 63) wsum[wid] = incl;
        __syncthreads();
        unsigned base = 0, total = 0;
#pragma unroll
        for (int w = 0; w < 8; ++w) { const unsigned s = wsum[w]; if (w < wid) base += s; total += s; }
        const unsigned excl = base + incl - pk; unsigned og = excl & 0xffffu, oe = excl >> 16; const unsigned ngt = total & 0xffffu, krem = (unsigned)CAP - ngt;
#pragma unroll
        for (int j = 0; j < 8; ++j) { const int t = tid * 8 + j; int m = -1;
            if (key[j] > thr) { m = (e * 8 + b) * 512 + (int)og; ++og; }
            else if (key[j] == thr) { if (oe < krem) m = (e * 8 + b) * 512 + (int)(ngt + oe); ++oe; }
            slot_of[((size_t)b * 4096 + t) * 16 + e] = m;
            if (m >= 0) { idx[m] = b * 4096 + t; gate[m] = __uint_as_float(key[j]); } }
        __syncthreads();
    }
}

__device__ void phase11(const Params& p, float* dst) {
    const int tid = tid_opaque(), lane = tid & 63, wid = tid >> 6;
    const float* ada = (const float*)(p.ws + WS_ADA); const int* slot_of = (const int*)(p.ws + WS_SLOT); const bf16_t* oute = (const bf16_t*)(p.ws + WS_OUTE);
    const int stride = gridDim.x * 16;
    int row0 = (blockIdx.x * 8 + wid) * 2;
    int myslot = row0 < MLAT ? slot_of[(size_t)row0 * 16 + (lane & 31)] : -1;
    for (; row0 < MLAT; row0 += stride) {
        const int b = row0 >> 12;
        const int nrow = row0 + stride; const int nslot = nrow < MLAT ? slot_of[(size_t)nrow * 16 + (lane & 31)] : -1;
        f32x4 xv[2][4], acc[2][4];
#pragma unroll
        for (int r = 0; r < 2; ++r)
#pragma unroll
            for (int i = 0; i < 4; ++i) { xv[r][i] = *(const f32x4*)(p.out + (size_t)(row0 + r) * 1024 + 256 * i + 4 * lane); acc[r][i] = (f32x4){0.f, 0.f, 0.f, 0.f}; }
        const unsigned long long bal = __ballot(myslot >= 0);
        unsigned mask0 = (unsigned)(bal & 0xffffull), mask1 = (unsigned)((bal >> 16) & 0xffffull);
        while (mask0 | mask1) {
            int m[2][2];
#pragma unroll
            for (int j = 0; j < 2; ++j) { if (mask0) { const int e = __builtin_ctz(mask0); mask0 &= mask0 - 1; m[0][j] = __builtin_amdgcn_readlane(myslot, e); } else m[0][j] = MMOE;
                                          if (mask1) { const int e = __builtin_ctz(mask1); mask1 &= mask1 - 1; m[1][j] = __builtin_amdgcn_readlane(myslot, 16 + e); } else m[1][j] = MMOE; }
            u32x2 w[2][2][4];
#pragma unroll
            for (int r = 0; r < 2; ++r)
#pragma unroll
                for (int j = 0; j < 2; ++j)
#pragma unroll
                    for (int i = 0; i < 4; ++i) w[r][j][i] = *(const u32x2*)(oute + (size_t)m[r][j] * 1024 + 256 * i + 4 * lane);
#pragma unroll
            for (int r = 0; r < 2; ++r)
#pragma unroll
                for (int j = 0; j < 2; ++j)
#pragma unroll
                    for (int i = 0; i < 4; ++i) { acc[r][i][0] += bf_lo(w[r][j][i].x); acc[r][i][1] += bf_hi(w[r][j][i].x); acc[r][i][2] += bf_lo(w[r][j][i].y); acc[r][i][3] += bf_hi(w[r][j][i].y); }
        }
        float ss[2];
#pragma unroll
        for (int r = 0; r < 2; ++r) { float a = 0.f;
#pragma unroll
            for (int i = 0; i < 4; ++i) { const int d = 256 * i + 4 * lane; const f32x4 g2 = *(const f32x4*)(ada + b * 6144 + 5120 + d); xv[r][i] += g2 * acc[r][i];
                a += xv[r][i][0] * xv[r][i][0] + xv[r][i][1] * xv[r][i][1] + xv[r][i][2] * xv[r][i][2] + xv[r][i][3] * xv[r][i][3]; }
            ss[r] = a; }
#pragma unroll
        for (int o = 32; o >= 1; o >>= 1) { ss[0] += __shfl_xor(ss[0], o); ss[1] += __shfl_xor(ss[1], o); }
#pragma unroll
        for (int r = 0; r < 2; ++r) { const float rs = rsqrtf(ss[r] * (1.0f / 1024.0f) + 1e-6f);
#pragma unroll
            for (int i = 0; i < 4; ++i) { const int d = 256 * i + 4 * lane; *(f32x4*)(dst + (size_t)(row0 + r) * 1024 + d) = xv[r][i] * rs * *(const f32x4*)(p.final_g + d); } }
        myslot = nslot;
    }
}

#define XB_TMO      128
#define XB_XCNT(j)  (256  + 64 * (j))
#define XB_XSUB(j)  (1280 + 64 * (j))
#define XB_XGEN(j)  (2304 + 64 * (j))
#define XB_TOP      3328
#define XB_TOPGEN   3392
#define XCD_BAR_WORDS 3456
#define XB_SPIN_CAP (1u << 22)
__device__ __forceinline__ unsigned xb_ld(unsigned* p)              { return __hip_atomic_load(p, __ATOMIC_RELAXED, __HIP_MEMORY_SCOPE_AGENT); }
__device__ __forceinline__ unsigned xb_add(unsigned* p, unsigned v) { return __hip_atomic_fetch_add(p, v, __ATOMIC_RELAXED, __HIP_MEMORY_SCOPE_AGENT); }
__device__ __forceinline__ unsigned xb_xcc_id() { return (unsigned)__builtin_amdgcn_s_getreg((3 << 11) | 20) & 0xFu; }
#define XB_SPIN(cond, bar) do { unsigned _sp = 0; while (cond) { __builtin_amdgcn_s_sleep(1); \
    if ((++_sp & 255u) == 0u) { if (xb_ld(&(bar)[XB_TMO])) break; if (_sp > XB_SPIN_CAP) { atomicAdd(&(bar)[XB_TMO], 1u); break; } } } } while (0)
struct XcdBarrier { unsigned* bar; unsigned x; volatile LAS unsigned* st; };
__device__ __forceinline__ XcdBarrier xcd_barrier_post(unsigned* bar, volatile LAS unsigned* st) {
    XcdBarrier b; b.bar = bar; b.x = xb_xcc_id(); b.st = st;
    if (threadIdx.x == 0) (void)xb_add(&bar[XB_XCNT(b.x)], 1u);
    return b;
}
__device__ __forceinline__ void xcd_barrier_complete(unsigned* bar, unsigned x, unsigned& nloc, unsigned& nx) {
    const unsigned G = gridDim.x * gridDim.y * gridDim.z;
    unsigned sum, cnt, mine, sp = 0u;
    for (;;) {
        sum = 0u; cnt = 0u; mine = 0u;
#pragma unroll
        for (unsigned j = 0; j < 16; ++j) { const unsigned c = xb_ld(&bar[XB_XCNT(j)]); sum += c; cnt += (c > 0u) ? 1u : 0u; mine = (j == x) ? c : mine; }
        if (sum == G) break;
        __builtin_amdgcn_s_sleep(1);
        if ((++sp & 255u) == 0u) { if (xb_ld(&bar[XB_TMO])) break; if (sp > XB_SPIN_CAP) { atomicAdd(&bar[XB_TMO], 1u); break; } }
    }
    nloc = mine > 0u ? mine : 1u; nx = cnt > 0u ? cnt : 1u;
}
__device__ __forceinline__ void xcd_barrier(const XcdBarrier& b) {
    asm volatile("s_waitcnt vmcnt(0)" ::: "memory");
    __syncthreads();
    if (threadIdx.x == 0) {
        unsigned* bar = b.bar;
        __builtin_amdgcn_s_waitcnt(0);
        unsigned nloc = b.st[0], nx = b.st[1];
        if (nloc == 0u) { xcd_barrier_complete(bar, b.x, nloc, nx); b.st[0] = nloc; b.st[1] = nx; }
        const unsigned old = xb_add(&bar[XB_XSUB(b.x)], 1u);
        const unsigned gen = old / nloc;
        if (old + 1u == (gen + 1u) * nloc) {
            __builtin_amdgcn_fence(__ATOMIC_RELEASE, "agent");
            asm volatile("s_waitcnt vmcnt(0)" ::: "memory");
            const unsigned og = xb_add(&bar[XB_TOP], 1u);
            const unsigned tg = og / nx;
            if (og + 1u == (tg + 1u) * nx) xb_add(&bar[XB_TOPGEN], 1u);
            else XB_SPIN(xb_ld(&bar[XB_TOPGEN]) == tg, bar);
            __builtin_amdgcn_fence(__ATOMIC_ACQUIRE, "agent");
            xb_add(&bar[XB_XGEN(b.x)], 1u);
            asm volatile("s_waitcnt vmcnt(0)" ::: "memory");
        } else {
            XB_SPIN(xb_ld(&bar[XB_XGEN(b.x)]) == gen, bar);
            __builtin_amdgcn_fence(__ATOMIC_ACQUIRE, "agent");
            asm volatile("s_waitcnt vmcnt(0)" ::: "memory");
        }
    }
    __syncthreads();
}

__global__ void __launch_bounds__(NTHR, 2) fwd_megakernel(Params p) {
    extern __shared__ __attribute__((aligned(16))) unsigned char lds_raw[];
    LAS unsigned char* lds = (LAS unsigned char*)lds_raw;
    cg::grid_group grid = cg::this_grid();
    const int G = gridDim.x, bid = blockIdx.x;
    unsigned char* ws = p.ws;
    bf16_t* const R1 = (bf16_t*)(ws + WS_R1); bf16_t* const Zb = (bf16_t*)(ws + WS_RZ); bf16_t* const PQt = (bf16_t*)(ws + WS_RPQ); bf16_t* const MRG = (bf16_t*)(ws + WS_R2);
    bf16_t* const Fb = (bf16_t*)((unsigned char*)p.out + OUT_F); bf16_t* const Ytb = (bf16_t*)((unsigned char*)p.out + OUT_YT);
#ifdef ONLY_PH
#define PH(k) ((k) == ONLY_PH && p.ph_lo <= (k) && (k) < p.ph_hi)
#else
#define PH(k) (p.ph_lo <= (k) && (k) < p.ph_hi)
#endif
    volatile LAS unsigned* xst = (volatile LAS unsigned*)(lds + LDS_BYTES - 16);
    if (threadIdx.x < 4) xst[threadIdx.x] = 0u;
    __syncthreads();
    XcdBarrier xbar = xcd_barrier_post((unsigned*)(ws + WS_BAR), xst);
    if (p.ph_lo < 0) grid.sync();
#define SYNC(k) do { if (PH(k) && PH((k) + 1)) xcd_barrier(xbar); } while (0)
#ifndef REPMASK
#define REPMASK 0
#endif
#define REP(k) for (int rep_ = 0; rep_ <= ((REPMASK >> (k)) & 1); ++rep_)
    if (PH(0)) REP(0) phase0(p, lds);
    SYNC(0);
    if (PH(1)) REP(1) phase1(p);
    SYNC(1);
    if (PH(2)) REP(2) {
        { ProbPQ pr{(const bf16_t*)(ws + WS_WPQ), R1, 1024, 1024, 16384}; pg8::Order S; S.init(4, 128, G, bid); EpiPQ E{PQt}; pg8::gemm_phase(lds, pr, S, E); }
        { ProbPlain pr{R1, (const bf16_t*)(ws + WS_WIN), 1024, 1024, 1024}; pg8::Order S; S.init(128, 16, G, bid); EpiZ E{Zb, 4096, -1}; pg8::gemm_phase(lds, pr, S, E); }
        { ProbPlain pr{(const bf16_t*)(ws + WS_HCTX), (const bf16_t*)(ws + WS_WIN), 1024, 1024, 1024}; pg8::Order S; S.init(8, 4, G, bid); EpiZ E{(bf16_t*)(ws + WS_ZXC), 1024, 0}; pg8::gemm_phase(lds, pr, S, E); }
    }
    SYNC(2);
    if (PH(3)) REP(3) {
        { ProbPlain pr{(const bf16_t*)(ws + WS_D1T), PQt, 512, 512, 512}; pg8::Order S; S.init(2, 256, G, bid); EpiPlain E{Ytb, 65536}; pg8::gemm_phase(lds, pr, S, E); }
        for (int it = bid; it < NB * 2 * 8; it += G) lru_tile<false>(p, lds, it);
    }
    SYNC(3);
    if (PH(4)) {
        for (int it = bid; it < NB * 256; it += G) fft_stage2(p, lds, it);
        const int ngr = G >> 5;
        if (ngr > 0 && bid < ngr * 32) lru2_block(p, lds, bid % ngr, bid / ngr, ngr);
    }
    SYNC(4);
    if (PH(5)) REP(5) {
        { ProbPlain pr{Fb, (const bf16_t*)(ws + WS_WFOUR), 512, 512, 512}; pg8::Order S; S.init(128, 4, G, bid); EpiY1 E{MRG, Zb}; pg8::gemm_phase(lds, pr, S, E); }
        { ProbPlain pr{R1, (const bf16_t*)(ws + WS_WLRU), 1024, 1024, 1024}; pg8::Order S; S.init(128, 4, G, bid); EpiY2 E{MRG, Zb}; pg8::gemm_phase(lds, pr, S, E); }
    }
    SYNC(5);
    if (PH(6)) REP(6) { ProbPlain pr{MRG, (const bf16_t*)(ws + WS_WOUT), 1024, 1024, 1024}; pg8::Order S; S.init(128, 4, G, bid);
        EpiOut E{p.out, p.x, (const float*)(ws + WS_POS), (const float*)(ws + WS_ADA)}; pg8::gemm_phase(lds, pr, S, E); }
    SYNC(6);
    if (PH(7)) REP(7) { phase7_rows(p, lds); phase7_weights(p); }
    SYNC(7);
    if (PH(8)) REP(8) phase8_topk(p, lds);
    SYNC(8);
    if (PH(9)) REP(9) { ProbMoeUp pr{R1, (const bf16_t*)(ws + WS_WGU), (const int*)(ws + WS_IDX), 1024, 1024, 1024}; pg8::Order S; S.init(256, 12, G, bid); EpiGU E{(bf16_t*)(ws + WS_HID)}; pg8::gemm_phase(lds, pr, S, E); }
    SYNC(9);
    if (PH(10)) { if (bid == 0 && threadIdx.x < 128) *(u32x4*)(ws + WS_OUTE + (size_t)MMOE * 2048 + threadIdx.x * 16) = (u32x4){0u, 0u, 0u, 0u}; }
    if (PH(10)) REP(10) { ProbMoeDown pr{(const bf16_t*)(ws + WS_HID), (const bf16_t*)(ws + WS_WD), 1536, 1536, 1536}; pg8::Order S; S.init(256, 4, G, bid); EpiDown E{(bf16_t*)(ws + WS_OUTE), (const float*)(ws + WS_GATE)}; pg8::gemm_phase(lds, pr, S, E); }
    SYNC(10);
    if (PH(12)) phase11(p, (float*)(ws + WS_HID));
    if (PH(11)) phase11(p, p.out);
}

#ifndef N_LAUNCHES
#define N_LAUNCHES 1
#endif
#ifndef PROBE_DUP
#define PROBE_DUP 0x0
#endif
extern "C" void kernel_launch(void* const* d_in, const int* in_sizes, int n_in, void* d_out, int out_size, void* d_ws, size_t ws_size, hipStream_t stream) {
    static int grid = 0;
    if (grid == 0) {
        if (n_in != 24 || out_size != MLAT * DM || ws_size < WS_END) { fprintf(stderr, "kernel_launch: unexpected shapes (n_in %d out %d ws %zu)\n", n_in, out_size, ws_size); grid = -1; return; }
        int dev = 0, cus = 0, per_cu = 0;
        hipGetDevice(&dev); hipDeviceGetAttribute(&cus, hipDeviceAttributeMultiprocessorCount, dev);
        hipFuncSetAttribute((const void*)fwd_megakernel, hipFuncAttributeMaxDynamicSharedMemorySize, LDS_BYTES);
        hipOccupancyMaxActiveBlocksPerMultiprocessor(&per_cu, (const void*)fwd_megakernel, NTHR, LDS_BYTES);
        if (per_cu < 1) { fprintf(stderr, "kernel_launch: occupancy query reports %d blocks per CU\n", per_cu); per_cu = 1; }
        grid = cus * 1;
        (void)hipGetLastError();
    }
    if (grid < 0) return;
    Params p{};
    const float** f = (const float**)&p;
    for (int i = 0; i < 24; ++i) f[i] = (const float*)d_in[i];
    p.out = (float*)d_out; p.ws = (unsigned char*)d_ws;
    (void)hipMemsetAsync((unsigned char*)d_ws + WS_BAR, 0, 32 * KiB, stream);
#if N_LAUNCHES == 1
    p.ph_lo = 0; p.ph_hi = 12;
    void* args[] = {&p};
    hipError_t e = hipLaunchCooperativeKernel((const void*)fwd_megakernel, dim3(grid), dim3(NTHR), args, LDS_BYTES, stream);
    if (e != hipSuccess) fprintf(stderr, "cooperative launch failed: %s (grid %d)\n", hipGetErrorString(e), grid);
#else
    for (int k = 0; k < 12; ++k) for (int r = 0; r <= ((PROBE_DUP >> k) & 1); ++r) { p.ph_lo = k; p.ph_hi = k + 1; if (k == 11 && r == 0 && ((PROBE_DUP >> 11) & 1)) { p.ph_lo = 12; p.ph_hi = 13; } hipLaunchKernelGGL(fwd_megakernel, dim3(grid), dim3(NTHR), LDS_BYTES, stream, p); }
#endif
}
```

```cpp
#include <hip/hip_runtime.h>
#include <hip/hip_cooperative_groups.h>
#include <cstdio>
namespace cg = cooperative_groups;

#define LAS __attribute__((address_space(3)))
typedef unsigned short bf16_t;
typedef short bf16x8 __attribute__((ext_vector_type(8)));
typedef float f32x4 __attribute__((ext_vector_type(4)));
typedef float f32x16 __attribute__((ext_vector_type(16)));
typedef unsigned u32x4 __attribute__((ext_vector_type(4)));
typedef unsigned u32x2 __attribute__((ext_vector_type(2)));

constexpr int NB = 8, TT = 4096, DM = 1024, CTXL = 256, MLAT = NB * TT, MCTX = NB * CTXL;
constexpr int NE = 16, CAP = 512, DE = 1536, MMOE = NE * NB * CAP;
constexpr int NSEQ = 34;
constexpr int NTHR = 512;
constexpr int LDS_BYTES = 144 * 1024;

constexpr size_t KiB = 1024, MiB = 1024 * 1024;
constexpr size_t WS_ADA = 0;
constexpr size_t WS_POS = 256 * KiB;
constexpr size_t WS_AGG = 512 * KiB;
constexpr size_t WS_WPQ = 5 * MiB;
constexpr size_t WS_WIN = 7 * MiB;
constexpr size_t WS_WFOUR = 15 * MiB;
constexpr size_t WS_WLRU = 16 * MiB;
constexpr size_t WS_WOUT = 18 * MiB;
constexpr size_t WS_WAT = 20 * MiB;
constexpr size_t WS_WIT = 20 * MiB + 512 * KiB;
constexpr size_t WS_SCORES = 21 * MiB;
constexpr size_t WS_IDX = 23 * MiB;
constexpr size_t WS_GATE = 23 * MiB + 256 * KiB;
constexpr size_t WS_SLOT = 23 * MiB + 512 * KiB;
constexpr size_t WS_BAR = 25 * MiB + 512 * KiB;
constexpr size_t WS_D1T = 34 * MiB;
constexpr size_t WS_HCTX = 26 * MiB;
constexpr size_t WS_ZXC = 30 * MiB;
constexpr size_t WS_R1 = 40 * MiB;
constexpr size_t WS_RPQ = 104 * MiB;
constexpr size_t WS_R2 = 168 * MiB;
constexpr size_t WS_RZ = 232 * MiB;
constexpr size_t WS_END = 488 * MiB;
constexpr size_t WS_HID = WS_RZ, WS_WD = WS_RZ + 192 * MiB, WS_WGU = WS_RPQ, WS_OUTE = WS_R1;
constexpr size_t OUT_YT = 0, OUT_F = 64 * MiB;

struct Params {
    const float *x, *c, *ctx, *c_ctx, *w_ada, *b_ada, *norm1_g, *norm2_g, *w_in, *w_four, *conv_w, *conv_b, *lru_lambda,
        *lru_wa, *lru_ba, *lru_wi, *lru_bi, *w_lru, *w_out, *w_router, *w_gate_e, *w_up_e, *w_down_e, *final_g;
    float* out; unsigned char* ws; int ph_lo, ph_hi;
};

__device__ __forceinline__ int tid_opaque() { int t = threadIdx.x; asm volatile("" : "+v"(t)); return t; }
__device__ __forceinline__ unsigned cvt_pk_bf16(float lo, float hi) { unsigned r; asm volatile("v_cvt_pk_bf16_f32 %0, %1, %2" : "=v"(r) : "v"(lo), "v"(hi)); return r; }
__device__ __forceinline__ float bf_lo(unsigned w) { return __uint_as_float(w << 16); }
__device__ __forceinline__ float bf_hi(unsigned w) { return __uint_as_float(w & 0xffff0000u); }
__device__ __forceinline__ float bf2f(bf16_t h) { return __uint_as_float(((unsigned)h) << 16); }
__device__ __forceinline__ float sigmoidf_(float v) { return __builtin_amdgcn_rcpf(1.0f + __expf(-v)); }
__device__ __forceinline__ float gelu_tanh(float v) { const float y = 1.5957691216f * (v + 0.044715f * v * v * v); return v * sigmoidf_(y); }
__device__ __forceinline__ float wave_sum(float v) {
#pragma unroll
    for (int o = 32; o >= 1; o >>= 1) v += __shfl_xor(v, o);
    return v;
}
__device__ __forceinline__ void unpack8(const u32x4 w, float (&f)[8]) { f[0] = bf_lo(w.x); f[1] = bf_hi(w.x); f[2] = bf_lo(w.y); f[3] = bf_hi(w.y); f[4] = bf_lo(w.z); f[5] = bf_hi(w.z); f[6] = bf_lo(w.w); f[7] = bf_hi(w.w); }

namespace pg8 {
constexpr int BM = 256, BK = 64, HALF = 128, HTB = HALF * BK * 2, STAGE_BYTES = 8 * HTB, NXCD = 8, WGM = 8;
__device__ __forceinline__ int lds_byte(int r, int c) { const int st = (r >> 4) * 2 + (c >> 5), rr = r & 15, cc = c & 31, ob = rr * 64 + cc * 2; return st * 1024 + (ob ^ (((ob >> 9) & 1) << 5)); }
__device__ __forceinline__ void stage_rc(int b, int& R, int& C) { const int st = b / 1024, sb = b % 1024, swz = sb ^ (((sb >> 9) & 1) << 5); R = (st >> 1) * 16 + swz / 64; C = (st & 1) * 32 + (swz % 64) / 2; }
__device__ __forceinline__ int perm32(int rho) { const int n = rho >> 4, i = rho & 15; return 8 * (i >> 2) + 4 * n + (i & 3); }
struct Unit { int pm, pn; };
struct Order {
    int nM, nN, nwg, G, c;
    __device__ void init(int nM_, int nN_, int G_, int c_) { nM = nM_; nN = nN_; nwg = nM * nN; G = G_; c = c_; }
    __device__ bool next(int i, Unit& u) const {
        const long L = (long)i * G + c; if (L >= nwg) return false;
        int wgid = (int)L; { const int q = nwg / NXCD, r = nwg % NXCD, xcd = wgid % NXCD, off = wgid / NXCD; wgid = (xcd < r ? xcd * (q + 1) : r * (q + 1) + (xcd - r) * q) + off; }
        const int nig = WGM * nN, gid = wgid / nig, fm = gid * WGM, gsz = (nM - fm) < WGM ? (nM - fm) : WGM;
        u.pm = fm + ((wgid % nig) % gsz); u.pn = (wgid % nig) / gsz; return true;
    }
};
template <class P, class Epi>
__device__ __forceinline__ void gemm_phase(LAS unsigned char* lds, const P& pr, const Order& S, const Epi& E) {
    const int tid = threadIdx.x, wid = __builtin_amdgcn_readfirstlane(tid >> 6), lane = tid & 63, wr = wid >> 2, wc = wid & 3, fr = lane & 15, fq = lane >> 4;
    const int nt = pr.K / BK;
    int RA[2], CA[2]; unsigned voffB[2];
#pragma unroll
    for (int i = 0; i < 2; ++i) { int R, C; stage_rc(tid * 16 + i * 8192, R, C); RA[i] = R; CA[i] = C; const int Rb = Epi::PERM ? ((R & ~31) + perm32(R & 31)) : R; voffB[i] = (unsigned)(Rb * pr.ldb + C) * 2u; }
    const size_t kstep = (size_t)(BK * 2);
    const size_t hstepB = (size_t)HALF * pr.ldb * 2;
    const unsigned ldsw = (unsigned)wid * 1024u;
    const int aoff = lds_byte(wr * 64 + fr, fq * 8), boff = lds_byte(wc * 32 + fr, fq * 8);
#define PG8_SA(b, h) (((b) * 2 + (h)) * HTB)
#define PG8_SB(b, h) ((4 + (b) * 2 + (h)) * HTB)
#define PG8_STAGE(bufoff, gbase, voff) do { _Pragma("unroll") for (int _i = 0; _i < 2; ++_i) \
        __builtin_amdgcn_global_load_lds((const unsigned*)((const char*)(gbase) + (voff)[_i]), (LAS unsigned*)(lds + (bufoff) + ldsw + _i * 8192), 16, 0, 0); } while (0)
#define PG8_LDA(dst, b, h) do { _Pragma("unroll") for (int m = 0; m < 4; ++m) _Pragma("unroll") for (int k = 0; k < 2; ++k) dst[m][k] = *(const LAS bf16x8*)(lds + PG8_SA(b, h) + aoff + m * 2048 + k * 1024); } while (0)
#define PG8_LDB(dst, b, h) do { _Pragma("unroll") for (int n = 0; n < 2; ++n) _Pragma("unroll") for (int k = 0; k < 2; ++k) dst[n][k] = *(const LAS bf16x8*)(lds + PG8_SB(b, h) + boff + n * 2048 + k * 1024); } while (0)
#define PG8_MMA(ai, bj, At, Bt) do { __builtin_amdgcn_s_setprio(1); _Pragma("unroll") for (int m = 0; m < 4; ++m) _Pragma("unroll") for (int n = 0; n < 2; ++n) _Pragma("unroll") for (int k = 0; k < 2; ++k) \
        acc[ai][bj][m][n] = __builtin_amdgcn_mfma_f32_16x16x32_bf16(Bt[n][k], At[m][k], acc[ai][bj][m][n], 0, 0, 0); __builtin_amdgcn_s_setprio(0); } while (0)
#define PG8_WAIT_V(n) asm volatile("s_waitcnt vmcnt(" #n ")" ::: "memory")
#define PG8_WAIT_L(n) asm volatile("s_waitcnt lgkmcnt(" #n ")" ::: "memory")
#define PG8_BAR __builtin_amdgcn_s_barrier()
#define PG8_SCHED __builtin_amdgcn_sched_barrier(0)
    Unit cur, nxt; int ui = 0;
    if (!S.next(0, cur)) return;
    f32x4 acc[2][2][4][2];
#pragma unroll
    for (int a = 0; a < 2; ++a)
#pragma unroll
        for (int b = 0; b < 2; ++b)
#pragma unroll
            for (int m = 0; m < 4; ++m)
#pragma unroll
                for (int n = 0; n < 2; ++n) acc[a][b][m][n] = (f32x4){0.f, 0.f, 0.f, 0.f};
    bf16x8 At[4][2], B0[2][2], B1[2][2];
    unsigned vA[2][2], vN[2][2];
    pr.avoff(cur, RA, CA, vA);
#pragma unroll
    for (int h = 0; h < 2; ++h)
#pragma unroll
        for (int i = 0; i < 2; ++i) vN[h][i] = vA[h][i];
    const char* cA = pr.abase(cur); const char* cB = pr.bbase(cur);
    PG8_STAGE(PG8_SB(0, 0), cB, voffB); PG8_STAGE(PG8_SA(0, 0), cA, vA[0]); PG8_STAGE(PG8_SB(0, 1), cB + hstepB, voffB); PG8_STAGE(PG8_SA(0, 1), cA, vA[1]);
    if (wr == 1) PG8_BAR;
    PG8_WAIT_V(4); PG8_BAR;
    PG8_STAGE(PG8_SB(1, 0), cB + kstep, voffB); PG8_STAGE(PG8_SA(1, 0), cA + kstep, vA[0]); PG8_STAGE(PG8_SB(1, 1), cB + hstepB + kstep, voffB);
    PG8_WAIT_V(6); PG8_BAR;
    for (;;) {
        const bool has_next = S.next(ui + 1, nxt);
        const char* nA = has_next ? pr.abase(nxt) : cA; const char* nB = has_next ? pr.bbase(nxt) : cB;
        if (P::GATHER) { if (has_next) pr.avoff(nxt, RA, CA, vN); }
        for (int t = 0; t < nt; t += 2) {
            const bool last = (t == nt - 2);
            const char* a1 = cA + (size_t)(t + 1) * kstep;
            const char* a2 = last ? nA : cA + (size_t)(t + 2) * kstep; const char* b2 = last ? nB : cB + (size_t)(t + 2) * kstep;
            const char* a3 = a2 + kstep; const char* b3 = b2 + kstep;
            unsigned v2[2][2];
#pragma unroll
            for (int h = 0; h < 2; ++h)
#pragma unroll
                for (int i = 0; i < 2; ++i) v2[h][i] = (P::GATHER && last) ? vN[h][i] : vA[h][i];
            PG8_LDB(B0, 0, 0); PG8_SCHED; PG8_LDA(At, 0, 0); PG8_STAGE(PG8_SA(1, 1), a1, vA[1]);
            PG8_WAIT_L(8); PG8_BAR; PG8_WAIT_L(0); PG8_MMA(0, 0, At, B0); PG8_BAR; PG8_SCHED;
            PG8_LDB(B1, 0, 1); PG8_STAGE(PG8_SB(0, 0), b2, voffB);
            PG8_BAR; PG8_WAIT_L(0); PG8_MMA(0, 1, At, B1); PG8_BAR;
            PG8_LDA(At, 0, 1); PG8_STAGE(PG8_SA(0, 0), a2, v2[0]);
            PG8_BAR; PG8_WAIT_L(0); PG8_MMA(1, 0, At, B0); PG8_BAR; PG8_SCHED;
            PG8_STAGE(PG8_SB(0, 1), b2 + hstepB, voffB);
            PG8_WAIT_V(6); PG8_BAR; PG8_MMA(1, 1, At, B1); PG8_BAR;
            PG8_LDB(B0, 1, 0); PG8_SCHED; PG8_LDA(At, 1, 0); PG8_STAGE(PG8_SA(0, 1), a2, v2[1]);
            PG8_WAIT_L(8); PG8_BAR; PG8_WAIT_L(0); PG8_MMA(0, 0, At, B0); PG8_BAR; PG8_SCHED;
            PG8_LDB(B1, 1, 1); PG8_STAGE(PG8_SB(1, 0), b3, voffB);
            PG8_BAR; PG8_WAIT_L(0); PG8_MMA(0, 1, At, B1); PG8_BAR;
            PG8_LDA(At, 1, 1); PG8_STAGE(PG8_SA(1, 0), a3, v2[0]);
            PG8_BAR; PG8_WAIT_L(0); PG8_MMA(1, 0, At, B0); PG8_BAR; PG8_SCHED;
            PG8_STAGE(PG8_SB(1, 1), b3 + hstepB, voffB);
            PG8_WAIT_V(6); PG8_BAR; PG8_MMA(1, 1, At, B1); PG8_BAR;
            if (P::GATHER && last) {
#pragma unroll
                for (int h = 0; h < 2; ++h)
#pragma unroll
                    for (int i = 0; i < 2; ++i) vA[h][i] = vN[h][i];
            }
        }
        E(acc, cur, wr, wc, fr, fq);
        if (!has_next) break;
#pragma unroll
        for (int a = 0; a < 2; ++a)
#pragma unroll
            for (int b = 0; b < 2; ++b)
#pragma unroll
                for (int m = 0; m < 4; ++m)
#pragma unroll
                    for (int n = 0; n < 2; ++n) acc[a][b][m][n] = (f32x4){0.f, 0.f, 0.f, 0.f};
        cur = nxt; cA = nA; cB = nB; ++ui;
    }
    PG8_WAIT_V(0);
    if (wr == 0) PG8_BAR;
    PG8_BAR;
#undef PG8_SA
#undef PG8_SB
#undef PG8_STAGE
#undef PG8_LDA
#undef PG8_LDB
#undef PG8_MMA
#undef PG8_WAIT_V
#undef PG8_WAIT_L
#undef PG8_BAR
#undef PG8_SCHED
}
template <class P, class Epi>
__device__ __forceinline__ void gemm_phase2(LAS unsigned char* lds, const P& pr, const Order& S, const Epi& E) {
    const int tid = threadIdx.x, wid = __builtin_amdgcn_readfirstlane(tid >> 6), lane = tid & 63, wr = wid >> 2, wc = wid & 3, fr = lane & 15, fq = lane >> 4;
    const int nt1 = pr.K1 / BK, nt = (pr.K1 + pr.K2) / BK;
    unsigned R2[2], Rb2[2], C2[2];
#pragma unroll
    for (int i = 0; i < 2; ++i) { int R, C; stage_rc(tid * 16 + i * 8192, R, C); const int Rb = Epi::PERM ? ((R & ~31) + perm32(R & 31)) : R; R2[i] = (unsigned)R * 2u; Rb2[i] = (unsigned)Rb * 2u; C2[i] = (unsigned)C * 2u; }
#define OFF_A(ld, h, i) ((R2[i] + (unsigned)((h) * 256)) * (unsigned)(ld) + C2[i])
#define OFF_B(ld, i) (Rb2[i] * (unsigned)(ld) + C2[i])
    const size_t kstep = (size_t)(BK * 2);
    const size_t hB1 = (size_t)HALF * pr.ldb1 * 2, hB2 = (size_t)HALF * pr.ldb2 * 2;
    const unsigned ldsw = (unsigned)wid * 1024u;
    const int aoff = lds_byte(wr * 64 + fr, fq * 8), boff = lds_byte(wc * 32 + fr, fq * 8);
#define PG8_SA(b, h) (((b) * 2 + (h)) * HTB)
#define PG8_SB(b, h) ((4 + (b) * 2 + (h)) * HTB)
#define PG8_STAGE(bufoff, gbase, voff) do { _Pragma("unroll") for (int _i = 0; _i < 2; ++_i) \
        __builtin_amdgcn_global_load_lds((const unsigned*)((const char*)(gbase) + (voff)[_i]), (LAS unsigned*)(lds + (bufoff) + ldsw + _i * 8192), 16, 0, 0); } while (0)
#define PG8_LDA(dst, b, h) do { _Pragma("unroll") for (int m = 0; m < 4; ++m) _Pragma("unroll") for (int k = 0; k < 2; ++k) dst[m][k] = *(const LAS bf16x8*)(lds + PG8_SA(b, h) + aoff + m * 2048 + k * 1024); } while (0)
#define PG8_LDB(dst, b, h) do { _Pragma("unroll") for (int n = 0; n < 2; ++n) _Pragma("unroll") for (int k = 0; k < 2; ++k) dst[n][k] = *(const LAS bf16x8*)(lds + PG8_SB(b, h) + boff + n * 2048 + k * 1024); } while (0)
#define PG8_MMA(ai, bj, At, Bt) do { __builtin_amdgcn_s_setprio(1); _Pragma("unroll") for (int m = 0; m < 4; ++m) _Pragma("unroll") for (int n = 0; n < 2; ++n) _Pragma("unroll") for (int k = 0; k < 2; ++k) \
        acc[ai][bj][m][n] = __builtin_amdgcn_mfma_f32_16x16x32_bf16(Bt[n][k], At[m][k], acc[ai][bj][m][n], 0, 0, 0); __builtin_amdgcn_s_setprio(0); } while (0)
#define PG8_WAIT_V(n) asm volatile("s_waitcnt vmcnt(" #n ")" ::: "memory")
#define PG8_WAIT_L(n) asm volatile("s_waitcnt lgkmcnt(" #n ")" ::: "memory")
#define PG8_BAR __builtin_amdgcn_s_barrier()
#define PG8_SCHED __builtin_amdgcn_sched_barrier(0)
    Unit cur, nxt; int ui = 0;
    if (!S.next(0, cur)) return;
    f32x4 acc[2][2][4][2];
#pragma unroll
    for (int a = 0; a < 2; ++a)
#pragma unroll
        for (int b = 0; b < 2; ++b)
#pragma unroll
            for (int m = 0; m < 4; ++m)
#pragma unroll
                for (int n = 0; n < 2; ++n) acc[a][b][m][n] = (f32x4){0.f, 0.f, 0.f, 0.f};
    bf16x8 At[4][2], B0[2][2], B1[2][2];
    const char* cA1 = pr.abase1(cur); const char* cB1 = pr.bbase1(cur); const char* cA2 = pr.abase2(cur); const char* cB2 = pr.bbase2(cur);
#define T_A(tt) ((tt) < nt1 ? cA1 + (size_t)(tt) * kstep : cA2 + (size_t)((tt) - nt1) * kstep)
#define T_B(tt) ((tt) < nt1 ? cB1 + (size_t)(tt) * kstep : cB2 + (size_t)((tt) - nt1) * kstep)
    { unsigned vb[2] = {OFF_B(pr.ldb1, 0), OFF_B(pr.ldb1, 1)}, va0[2] = {OFF_A(pr.lda1, 0, 0), OFF_A(pr.lda1, 0, 1)}, va1[2] = {OFF_A(pr.lda1, 1, 0), OFF_A(pr.lda1, 1, 1)};
    PG8_STAGE(PG8_SB(0, 0), cB1, vb); PG8_STAGE(PG8_SA(0, 0), cA1, va0); PG8_STAGE(PG8_SB(0, 1), cB1 + hB1, vb); PG8_STAGE(PG8_SA(0, 1), cA1, va1);
    if (wr == 1) PG8_BAR;
    PG8_WAIT_V(4); PG8_BAR;
    PG8_STAGE(PG8_SB(1, 0), cB1 + kstep, vb); PG8_STAGE(PG8_SA(1, 0), cA1 + kstep, va0); PG8_STAGE(PG8_SB(1, 1), cB1 + hB1 + kstep, vb); }
    PG8_WAIT_V(6); PG8_BAR;
    for (;;) {
        const bool has_next = S.next(ui + 1, nxt);
        const char* nA = has_next ? pr.abase1(nxt) : cA1; const char* nB = has_next ? pr.bbase1(nxt) : cB1;
        for (int t = 0; t < nt; t += 2) {
            const bool last = (t == nt - 2);
            const bool s1 = (t + 1 < nt1), s2 = last || (t + 2 < nt1);
            const char* a1 = T_A(t + 1);
            const char* a2 = last ? nA : T_A(t + 2); const char* b2 = last ? nB : T_B(t + 2);
            const char* a3 = a2 + kstep; const char* b3 = b2 + kstep;
            const size_t hstepB = s2 ? hB1 : hB2; const int ldaT1 = s1 ? pr.lda1 : pr.lda2, ldaT2 = s2 ? pr.lda1 : pr.lda2, ldbT2 = s2 ? pr.ldb1 : pr.ldb2;
            unsigned v2[2][2], voffB[2], vA1s[2];
#pragma unroll
            for (int i = 0; i < 2; ++i) { voffB[i] = OFF_B(ldbT2, i); vA1s[i] = OFF_A(ldaT1, 1, i);
#pragma unroll
                for (int h = 0; h < 2; ++h) v2[h][i] = OFF_A(ldaT2, h, i); }
            PG8_LDB(B0, 0, 0); PG8_SCHED; PG8_LDA(At, 0, 0); PG8_STAGE(PG8_SA(1, 1), a1, vA1s);
            PG8_WAIT_L(8); PG8_BAR; PG8_WAIT_L(0); PG8_MMA(0, 0, At, B0); PG8_BAR; PG8_SCHED;
            PG8_LDB(B1, 0, 1); PG8_STAGE(PG8_SB(0, 0), b2, voffB);
            PG8_BAR; PG8_WAIT_L(0); PG8_MMA(0, 1, At, B1); PG8_BAR;
            PG8_LDA(At, 0, 1); PG8_STAGE(PG8_SA(0, 0), a2, v2[0]);
            PG8_BAR; PG8_WAIT_L(0); PG8_MMA(1, 0, At, B0); PG8_BAR; PG8_SCHED;
            PG8_STAGE(PG8_SB(0, 1), b2 + hstepB, voffB);
            PG8_WAIT_V(6); PG8_BAR; PG8_MMA(1, 1, At, B1); PG8_BAR;
            PG8_LDB(B0, 1, 0); PG8_SCHED; PG8_LDA(At, 1, 0); PG8_STAGE(PG8_SA(0, 1), a2, v2[1]);
            PG8_WAIT_L(8); PG8_BAR; PG8_WAIT_L(0); PG8_MMA(0, 0, At, B0); PG8_BAR; PG8_SCHED;
            PG8_LDB(B1, 1, 1); PG8_STAGE(PG8_SB(1, 0), b3, voffB);
            PG8_BAR; PG8_WAIT_L(0); PG8_MMA(0, 1, At, B1); PG8_BAR;
            PG8_LDA(At, 1, 1); PG8_STAGE(PG8_SA(1, 0), a3, v2[0]);
            PG8_BAR; PG8_WAIT_L(0); PG8_MMA(1, 0, At, B0); PG8_BAR; PG8_SCHED;
            PG8_STAGE(PG8_SB(1, 1), b3 + hstepB, voffB);
            PG8_WAIT_V(6); PG8_BAR; PG8_MMA(1, 1, At, B1); PG8_BAR;
            if (t == nt1 - 2) E.mid(acc, cur, wr, wc, fr, fq);
        }
        E(acc, cur, wr, wc, fr, fq);
        if (!has_next) break;
#pragma unroll
        for (int a = 0; a < 2; ++a)
#pragma unroll
            for (int b = 0; b < 2; ++b)
#pragma unroll
                for (int m = 0; m < 4; ++m)
#pragma unroll
                    for (int n = 0; n < 2; ++n) acc[a][b][m][n] = (f32x4){0.f, 0.f, 0.f, 0.f};
        cur = nxt; cA1 = nA; cB1 = nB; cA2 = pr.abase2(cur); cB2 = pr.bbase2(cur); ++ui;
    }
    PG8_WAIT_V(0);
    if (wr == 0) PG8_BAR;
    PG8_BAR;
#undef T_A
#undef T_B
#undef OFF_A
#undef OFF_B
#undef PG8_SA
#undef PG8_SB
#undef PG8_STAGE
#undef PG8_LDA
#undef PG8_LDB
#undef PG8_MMA
#undef PG8_WAIT_V
#undef PG8_WAIT_L
#undef PG8_BAR
#undef PG8_SCHED
}
}
using pg8::Unit;

struct ProbPlain {
    static constexpr bool GATHER = false;
    const bf16_t* A; const bf16_t* B; int K, lda, ldb;
    __device__ __forceinline__ const char* abase(const Unit& u) const { return (const char*)(A + (size_t)u.pm * 256 * lda); }
    __device__ __forceinline__ const char* bbase(const Unit& u) const { return (const char*)(B + (size_t)u.pn * 256 * ldb); }
    __device__ __forceinline__ void avoff(const Unit&, const int (&RA)[2], const int (&CA)[2], unsigned (&v)[2][2]) const {
#pragma unroll
        for (int h = 0; h < 2; ++h)
#pragma unroll
            for (int i = 0; i < 2; ++i) v[h][i] = (unsigned)((h * 128 + RA[i]) * lda + CA[i]) * 2u;
    }
};
struct ProbMerge {
    const bf16_t* A1; const bf16_t* B1; const bf16_t* A2; const bf16_t* B2; int K1, K2, lda1, ldb1, lda2, ldb2;
    __device__ __forceinline__ const char* abase1(const Unit& u) const { return (const char*)(A1 + (size_t)u.pm * 256 * lda1); }
    __device__ __forceinline__ const char* bbase1(const Unit& u) const { return (const char*)(B1 + (size_t)u.pn * 256 * ldb1); }
    __device__ __forceinline__ const char* abase2(const Unit& u) const { return (const char*)(A2 + (size_t)u.pm * 256 * lda2); }
    __device__ __forceinline__ const char* bbase2(const Unit& u) const { return (const char*)(B2 + (size_t)u.pn * 256 * ldb2); }
};
struct ProbPQ {
    static constexpr bool GATHER = false;
    const bf16_t* A; const bf16_t* B; int K, lda, ldb;
    __device__ __forceinline__ const char* abase(const Unit& u) const { return (const char*)(A + (size_t)u.pm * 256 * lda); }
    __device__ __forceinline__ const char* bbase(const Unit& u) const { return (const char*)(B + ((size_t)(u.pn >> 4) * 4096 + (u.pn & 15)) * 1024); }
    __device__ __forceinline__ void avoff(const Unit&, const int (&RA)[2], const int (&CA)[2], unsigned (&v)[2][2]) const {
#pragma unroll
        for (int h = 0; h < 2; ++h)
#pragma unroll
            for (int i = 0; i < 2; ++i) v[h][i] = (unsigned)((h * 128 + RA[i]) * lda + CA[i]) * 2u;
    }
};
struct ProbMoeUp {
    static constexpr bool GATHER = true;
    const bf16_t* A; const bf16_t* B; const int* idx; int K, lda, ldb;
    __device__ __forceinline__ const char* abase(const Unit&) const { return (const char*)A; }
    __device__ __forceinline__ const char* bbase(const Unit& u) const { return (const char*)(B + ((size_t)(u.pm >> 4) * 3072 + (size_t)u.pn * 256) * ldb); }
    __device__ __forceinline__ void avoff(const Unit& u, const int (&RA)[2], const int (&CA)[2], unsigned (&v)[2][2]) const {
#pragma unroll
        for (int h = 0; h < 2; ++h)
#pragma unroll
            for (int i = 0; i < 2; ++i) { const int g = idx[u.pm * 256 + h * 128 + RA[i]]; v[h][i] = (unsigned)(g * lda + CA[i]) * 2u; }
    }
};
struct ProbMoeDown {
    static constexpr bool GATHER = false;
    const bf16_t* A; const bf16_t* B; int K, lda, ldb;
    __device__ __forceinline__ const char* abase(const Unit& u) const { return (const char*)(A + (size_t)u.pm * 256 * lda); }
    __device__ __forceinline__ const char* bbase(const Unit& u) const { return (const char*)(B + ((size_t)(u.pm >> 4) * 1024 + (size_t)u.pn * 256) * ldb); }
    __device__ __forceinline__ void avoff(const Unit&, const int (&RA)[2], const int (&CA)[2], unsigned (&v)[2][2]) const {
#pragma unroll
        for (int h = 0; h < 2; ++h)
#pragma unroll
            for (int i = 0; i < 2; ++i) v[h][i] = (unsigned)((h * 128 + RA[i]) * lda + CA[i]) * 2u;
    }
};

#define EPI_ROWS(...) _Pragma("unroll") for (int ai = 0; ai < 2; ++ai) _Pragma("unroll") for (int m = 0; m < 4; ++m) { const int row = u.pm * 256 + ai * 128 + wr * 64 + m * 16 + fr; __VA_ARGS__ }
__device__ __forceinline__ u32x4 pack8(const f32x4 v0, const f32x4 v1) { u32x4 w; w.x = cvt_pk_bf16(v0[0], v0[1]); w.y = cvt_pk_bf16(v0[2], v0[3]); w.z = cvt_pk_bf16(v1[0], v1[1]); w.w = cvt_pk_bf16(v1[2], v1[3]); return w; }

struct EpiPQ {
    static constexpr bool PERM = true; bf16_t* O;
    __device__ __forceinline__ void operator()(const f32x4 (&acc)[2][2][4][2], const Unit& u, int wr, int wc, int fr, int fq) const {
        const int t10 = wc * 32 + 8 * fq, b = u.pn >> 4, t2 = u.pn & 15;
        EPI_ROWS(
            bf16_t* rp = O + ((size_t)((b * 512 + (row >> 1)) * 16 + t2) * 512 + (row & 1) * 256 + t10);
            _Pragma("unroll") for (int bj = 0; bj < 2; ++bj) *(u32x4*)(rp + bj * 128) = pack8(acc[ai][bj][m][0], acc[ai][bj][m][1]);
        )
    }
};
struct EpiPlain {
    static constexpr bool PERM = true; bf16_t* O; size_t ldc;
    __device__ __forceinline__ void operator()(const f32x4 (&acc)[2][2][4][2], const Unit& u, int wr, int wc, int fr, int fq) const {
        const int col0 = u.pn * 256 + wc * 32 + 8 * fq;
        EPI_ROWS(
            bf16_t* rp = O + (size_t)row * ldc + col0;
            _Pragma("unroll") for (int bj = 0; bj < 2; ++bj) *(u32x4*)(rp + bj * 128) = pack8(acc[ai][bj][m][0], acc[ai][bj][m][1]);
        )
    }
};
struct EpiZ {
    static constexpr bool PERM = true; bf16_t* O; int ldc; int fixed_act;
    __device__ __forceinline__ void operator()(const f32x4 (&acc)[2][2][4][2], const Unit& u, int wr, int wc, int fr, int fq) const {
        const int col0 = u.pn * 256 + wc * 32 + 8 * fq; const int act = fixed_act >= 0 ? fixed_act : (u.pn >> 2);
        EPI_ROWS(
            bf16_t* rp = O + (size_t)row * ldc + col0;
            _Pragma("unroll") for (int bj = 0; bj < 2; ++bj) {
                f32x4 v0 = acc[ai][bj][m][0], v1 = acc[ai][bj][m][1];
                if (act == 1) { _Pragma("unroll") for (int j = 0; j < 4; ++j) { v0[j] = gelu_tanh(v0[j]); v1[j] = gelu_tanh(v1[j]); } }
                else if (act >= 2) { _Pragma("unroll") for (int j = 0; j < 4; ++j) { v0[j] = sigmoidf_(v0[j]); v1[j] = sigmoidf_(v1[j]); } }
                *(u32x4*)(rp + bj * 128) = pack8(v0, v1); }
        )
    }
};
struct EpiMerge {
    static constexpr bool PERM = true; bf16_t* O; const bf16_t* Z;
    __device__ __forceinline__ void mid(f32x4 (&acc)[2][2][4][2], const Unit& u, int wr, int wc, int fr, int fq) const {
        unsigned eo = (unsigned)((u.pm * 256 + wr * 64 + fr) * 4096 + 2048 + u.pn * 256 + wc * 32 + 8 * fq);
        asm volatile("" : "+v"(eo));
#pragma unroll
        for (int ai = 0; ai < 2; ++ai)
#pragma unroll
            for (int m = 0; m < 4; ++m) {
#pragma unroll
                for (int bj = 0; bj < 2; ++bj) { const unsigned o = eo + (unsigned)((ai * 128 + m * 16) * 4096 + bj * 128);
                    float ga[8], gb[8]; unpack8(*(const u32x4*)(Z + o), ga); unpack8(*(const u32x4*)(Z + o + 1024), gb);
#pragma unroll
                    for (int j = 0; j < 4; ++j) { acc[ai][bj][m][0][j] *= ga[j] * __builtin_amdgcn_rcpf(fmaxf(gb[j], 1e-30f)); acc[ai][bj][m][1][j] *= ga[4 + j] * __builtin_amdgcn_rcpf(fmaxf(gb[4 + j], 1e-30f)); } }
                if (m & 1) __builtin_amdgcn_sched_barrier(0); }
    }
    __device__ __forceinline__ void operator()(const f32x4 (&acc)[2][2][4][2], const Unit& u, int wr, int wc, int fr, int fq) const {
        const int col0 = u.pn * 256 + wc * 32 + 8 * fq;
        EPI_ROWS(
            _Pragma("unroll") for (int bj = 0; bj < 2; ++bj) {
                const int col = col0 + bj * 128; float g[8]; unpack8(*(const u32x4*)(Z + (size_t)row * 4096 + 3072 + col), g);
                f32x4 v0 = acc[ai][bj][m][0], v1 = acc[ai][bj][m][1];
                _Pragma("unroll") for (int j = 0; j < 4; ++j) { v0[j] *= g[j]; v1[j] *= g[4 + j]; }
                *(u32x4*)(O + (size_t)row * 1024 + col) = pack8(v0, v1); }
        )
    }
};
struct EpiOut {
    static constexpr bool PERM = false; float* O; const float* X; const float* pos; const float* ada;
    __device__ __forceinline__ void operator()(const f32x4 (&acc)[2][2][4][2], const Unit& u, int wr, int wc, int fr, int fq) const {
        const int col0 = u.pn * 256 + wc * 32 + 4 * fq; const int b = u.pm >> 4;
        EPI_ROWS(
            const int t = row & 4095;
            _Pragma("unroll") for (int bj = 0; bj < 2; ++bj) _Pragma("unroll") for (int n = 0; n < 2; ++n) {
                const int col = col0 + bj * 128 + n * 16;
                const f32x4 xv = *(const f32x4*)(X + (size_t)row * 1024 + col);
                const f32x4 pv = *(const f32x4*)(pos + (col < 512 ? (t >> 6) * 512 + col : (t & 63) * 512 + (col - 512)));
                const f32x4 gv = *(const f32x4*)(ada + b * 6144 + 2048 + col);
                *(f32x4*)(O + (size_t)row * 1024 + col) = xv + pv + gv * acc[ai][bj][m][n]; }
        )
    }
};
struct EpiGU {
    static constexpr bool PERM = true; bf16_t* O;
    __device__ __forceinline__ void operator()(const f32x4 (&acc)[2][2][4][2], const Unit& u, int wr, int wc, int fr, int fq) const {
        const int col0 = u.pn * 128 + wc * 32 + 8 * fq;
        EPI_ROWS(
            f32x4 v0, v1;
            _Pragma("unroll") for (int j = 0; j < 4; ++j) { const float g0 = acc[ai][0][m][0][j], g1 = acc[ai][0][m][1][j];
                v0[j] = g0 * sigmoidf_(g0) * acc[ai][1][m][0][j]; v1[j] = g1 * sigmoidf_(g1) * acc[ai][1][m][1][j]; }
            *(u32x4*)(O + (size_t)row * DE + col0) = pack8(v0, v1);
        )
    }
};
struct EpiDown {
    static constexpr bool PERM = true; bf16_t* O; const float* gate;
    __device__ __forceinline__ void operator()(const f32x4 (&acc)[2][2][4][2], const Unit& u, int wr, int wc, int fr, int fq) const {
        const int col0 = u.pn * 256 + wc * 32 + 8 * fq;
        EPI_ROWS(
            const float g = gate[row];
            _Pragma("unroll") for (int bj = 0; bj < 2; ++bj) *(u32x4*)(O + (size_t)row * 1024 + col0 + bj * 128) = pack8(acc[ai][bj][m][0] * g, acc[ai][bj][m][1] * g);
        )
    }
};

__device__ void p0_ada(const Params& p, LAS unsigned char* lds, int item) {
    const int tid = threadIdx.x;
    LAS float* s = (LAS float*)lds; LAS float* red = s + 9 * 1024;
    for (int i = tid; i < 9 * 1024; i += NTHR) { const int r = i >> 10, d = i & 1023; const float v = r < 8 ? p.c[r * 1024 + d] : p.c_ctx[d]; s[i] = v / (1.0f + expf(-v)); }
    __syncthreads();
    const int col = tid & 63, ds = tid >> 6; float a[9];
#pragma unroll
    for (int r = 0; r < 9; ++r) a[r] = 0.f;
    const float* w = p.w_ada + (size_t)(ds * 128) * 6144 + item * 64 + col;
    for (int d = 0; d < 128; ++d) { const float wv = w[(size_t)d * 6144];
#pragma unroll
        for (int r = 0; r < 9; ++r) a[r] += s[r * 1024 + ds * 128 + d] * wv; }
#pragma unroll
    for (int r = 0; r < 9; ++r) red[(ds * 9 + r) * 64 + col] = a[r];
    __syncthreads();
    float* ada = (float*)(p.ws + WS_ADA);
    for (int i = tid; i < 9 * 64; i += NTHR) { const int r = i >> 6, cc = i & 63; float v = 0.f;
#pragma unroll
        for (int k = 0; k < 8; ++k) v += red[(k * 9 + r) * 64 + cc];
        ada[r * 6144 + item * 64 + cc] = v + p.b_ada[item * 64 + cc]; }
    __syncthreads();
}
template <int NS>
__device__ __forceinline__ void xpose_item(const float* src, int ldsrc, bf16_t* dst, int lddst, int k0, int n0, int mode) {
    const int tid = threadIdx.x, nl = tid & 63, k8 = tid >> 6;
    float v[NS][8];
#pragma unroll
    for (int s = 0; s < NS; ++s)
#pragma unroll
        for (int j = 0; j < 8; ++j) v[s][j] = src[(size_t)(k0 + 8 * k8 + j) * ldsrc + n0 + 64 * s + nl];
#pragma unroll
    for (int s = 0; s < NS; ++s) { const int n = n0 + 64 * s + nl; int row = n;
        if (mode) row = (n >> 7) * 256 + (n & 127) + (mode == 2 ? 128 : 0);
        u32x4 w; w.x = cvt_pk_bf16(v[s][0], v[s][1]); w.y = cvt_pk_bf16(v[s][2], v[s][3]); w.z = cvt_pk_bf16(v[s][4], v[s][5]); w.w = cvt_pk_bf16(v[s][6], v[s][7]);
        *(u32x4*)(dst + (size_t)row * lddst + k0 + 8 * k8) = w; }
}
__device__ void p0_wpq(const Params& p, LAS unsigned char* lds, int item) {
    const int tid = threadIdx.x, g = item >> 4, db = item & 15;
    LAS float* wl = (LAS float*)lds; LAS float* ct = wl + 64 * 129;
    for (int i = tid; i < 64 * 128; i += NTHR) { const int d = i >> 7, cc = i & 127; wl[d * 129 + cc] = p.w_in[(size_t)(db * 64 + d) * 4608 + g * 128 + cc]; }
    if (tid < 128) { float sn, cs; sincospif((float)tid * (1.0f / 64.0f), &sn, &cs); ct[tid] = cs; ct[128 + tid] = sn; }
    __syncthreads();
    const int q = tid & 255, kc = q >> 1, pq = q & 1, dh = tid >> 8; const int n = (g * 128 + kc) * 2 + pq;
    bf16_t* dst = (bf16_t*)(p.ws + WS_WPQ) + (size_t)n * 1024 + db * 64 + dh * 32;
    const float scale = 0.001381067932f;
    for (int d8 = 0; d8 < 4; ++d8) { float a[8];
#pragma unroll
        for (int j = 0; j < 8; ++j) a[j] = 0.f;
        for (int cc = 0; cc < 128; ++cc) { const float tv = ct[pq * 128 + ((cc * kc) & 127)];
#pragma unroll
            for (int j = 0; j < 8; ++j) a[j] += wl[(dh * 32 + d8 * 8 + j) * 129 + cc] * tv; }
        u32x4 w; w.x = cvt_pk_bf16(a[0] * scale, a[1] * scale); w.y = cvt_pk_bf16(a[2] * scale, a[3] * scale); w.z = cvt_pk_bf16(a[4] * scale, a[5] * scale); w.w = cvt_pk_bf16(a[6] * scale, a[7] * scale);
        *(u32x4*)(dst + d8 * 8) = w; }
    __syncthreads();
}
__device__ void p0_d1t(const Params& p, int item) {
    bf16_t* dst = (bf16_t*)(p.ws + WS_D1T);
    const int row = item * 64 + (threadIdx.x >> 3), k1 = row >> 1, ri = row & 1, c0 = (threadIdx.x & 7) * 64;
    for (int c8 = 0; c8 < 64; c8 += 8) { float v[8];
#pragma unroll
        for (int j = 0; j < 8; ++j) { const int col = c0 + c8 + j, pq = col >> 8, t1 = col & 255; float sn, cs; sincospif((float)((k1 * t1) & 255) * (1.0f / 128.0f), &sn, &cs);
            v[j] = (ri == 0) ? (pq == 0 ? cs : -sn) : (pq == 0 ? -sn : -cs); }
        u32x4 w; w.x = cvt_pk_bf16(v[0], v[1]); w.y = cvt_pk_bf16(v[2], v[3]); w.z = cvt_pk_bf16(v[4], v[5]); w.w = cvt_pk_bf16(v[6], v[7]);
        *(u32x4*)(dst + (size_t)row * 512 + c0 + c8) = w; }
}
__device__ void p0_pos(const Params& p) {
    float* tab = (float*)(p.ws + WS_POS);
    for (int i = threadIdx.x; i < 64 * 512; i += NTHR) { const int ii = i >> 9, j = i & 511, jj = j & 255; const float f = expf(-9.210340371976184f * (float)jj / 256.0f); const float a = (float)ii * f; tab[i] = j < 256 ? sinf(a) : cosf(a); }
}
__device__ void phase0(const Params& p, LAS unsigned char* lds) {
    constexpr int N_ADA = 96, N_WIN = 16 * 16, N_WFOUR = 8 * 4, N_SQ = 16 * 4, N_LRU = 16 * 2, N_WPQ = 64, N_DFT = 8, N_POS = 1;
    constexpr int O1 = N_ADA, O2 = O1 + N_WIN, O3 = O2 + N_WFOUR, O4 = O3 + N_SQ, O5 = O4 + N_SQ, O6 = O5 + N_LRU, O7 = O6 + N_LRU, O8 = O7 + N_WPQ, O9 = O8 + N_DFT, O10 = O9 + N_POS;
    for (int it = blockIdx.x; it < O10; it += gridDim.x) {
        if (it < O1) p0_ada(p, lds, it);
        else if (it < O2) { const int j = it - O1; xpose_item<4>(p.w_in + 512, 4608, (bf16_t*)(p.ws + WS_WIN), 1024, (j >> 4) * 64, (j & 15) * 256, 0); }
        else if (it < O3) { const int j = it - O2; xpose_item<4>(p.w_four, 1024, (bf16_t*)(p.ws + WS_WFOUR), 512, (j >> 2) * 64, (j & 3) * 256, 0); }
        else if (it < O4) { const int j = it - O3; xpose_item<4>(p.w_lru, 1024, (bf16_t*)(p.ws + WS_WLRU), 1024, (j >> 2) * 64, (j & 3) * 256, 0); }
        else if (it < O5) { const int j = it - O4; xpose_item<4>(p.w_out, 1024, (bf16_t*)(p.ws + WS_WOUT), 1024, (j >> 2) * 64, (j & 3) * 256, 0); }
        else if (it < O6) { const int j = it - O5, mtx = j >> 1; xpose_item<2>(p.lru_wa + (size_t)mtx * 16384, 128, (bf16_t*)(p.ws + WS_WAT) + (size_t)mtx * 16384, 128, (j & 1) * 64, 0, 0); }
        else if (it < O7) { const int j = it - O6, mtx = j >> 1; xpose_item<2>(p.lru_wi + (size_t)mtx * 16384, 128, (bf16_t*)(p.ws + WS_WIT) + (size_t)mtx * 16384, 128, (j & 1) * 64, 0, 0); }
        else if (it < O8) p0_wpq(p, lds, it - O7);
        else if (it < O9) p0_d1t(p, it - O8);
        else p0_pos(p);
    }
}

__device__ void phase1(const Params& p) {
    const int lane = threadIdx.x & 63, wid = threadIdx.x >> 6;
    const float* ada = (const float*)(p.ws + WS_ADA); const float* tab = (const float*)(p.ws + WS_POS);
    bf16_t* h1 = (bf16_t*)(p.ws + WS_R1); bf16_t* hc = (bf16_t*)(p.ws + WS_HCTX);
    const int NR = MLAT + MCTX;
    for (int row0 = (blockIdx.x * 8 + wid) * 2; row0 < NR; row0 += gridDim.x * 16) {
        f32x4 v[2][4]; float ss[2];
#pragma unroll
        for (int r = 0; r < 2; ++r) { const int row = row0 + r; const bool lat = row < MLAT; const float* xr = lat ? p.x + (size_t)row * 1024 : p.ctx + (size_t)(row - MLAT) * 1024;
#pragma unroll
            for (int i = 0; i < 4; ++i) v[r][i] = *(const f32x4*)(xr + 256 * i + 4 * lane); }
#pragma unroll
        for (int r = 0; r < 2; ++r) { const int row = row0 + r; const bool lat = row < MLAT; const int t = row & 4095; float a = 0.f;
#pragma unroll
            for (int i = 0; i < 4; ++i) { const int d = 256 * i + 4 * lane;
                if (lat) v[r][i] += *(const f32x4*)(tab + (i < 2 ? (t >> 6) * 512 + d : (t & 63) * 512 + d - 512));
                a += v[r][i][0] * v[r][i][0] + v[r][i][1] * v[r][i][1] + v[r][i][2] * v[r][i][2] + v[r][i][3] * v[r][i][3]; }
            ss[r] = a; }
#pragma unroll
        for (int o = 32; o >= 1; o >>= 1) { ss[0] += __shfl_xor(ss[0], o); ss[1] += __shfl_xor(ss[1], o); }
#pragma unroll
        for (int r = 0; r < 2; ++r) { const int row = row0 + r; const bool lat = row < MLAT; const int mrow = lat ? (row >> 12) : 8;
            const float rs = rsqrtf(ss[r] * (1.0f / 1024.0f) + 1e-6f);
            bf16_t* dst = lat ? h1 + (size_t)row * 1024 : hc + (size_t)(row - MLAT) * 1024;
#pragma unroll
            for (int i = 0; i < 4; ++i) { const int d = 256 * i + 4 * lane;
                const f32x4 g = *(const f32x4*)(p.norm1_g + d), sh = *(const f32x4*)(ada + mrow * 6144 + d), sc = *(const f32x4*)(ada + mrow * 6144 + 1024 + d);
                const f32x4 h = v[r][i] * rs * g * (sc + 1.0f) + sh;
                u32x2 w; w.x = cvt_pk_bf16(h[0], h[1]); w.y = cvt_pk_bf16(h[2], h[3]); *(u32x2*)(dst + d) = w; } }
    }
}

#define LRU_CST(mb, r) (32 * (mb) + 8 * ((r) >> 2) + ((r) & 3))
template <bool FINAL, int DIR>
__device__ __forceinline__ void lru_wave(const Params& p, LAS unsigned char* ul, int b, int sc, int head, int cb, int lane, f32x16 (&accI)[4]) {
    constexpr int SG = DIR ? -1 : 1;
    const int lr = lane & 31, lh = lane >> 5;
    const int chl = cb * 32 + lr, ch = head * 128 + chl;
    const int tbase = DIR ? 127 - 4 * lh : 4 * lh;
    f32x16 accA[4];
#pragma unroll
    for (int mb = 0; mb < 4; ++mb)
#pragma unroll
        for (int r = 0; r < 16; ++r) { accA[mb][r] = 0.f; accI[mb][r] = 0.f; }
    {
        const bf16_t* wa = (const bf16_t*)(p.ws + WS_WAT) + ((size_t)(DIR * 8 + head) * 128 + chl) * 128 + 8 * lh;
        const bf16_t* wi = (const bf16_t*)(p.ws + WS_WIT) + ((size_t)(DIR * 8 + head) * 128 + chl) * 128 + 8 * lh;
        LAS unsigned char* arow0 = ul + (DIR ? 127 - lr : lr) * 272 + lh * 16;
#pragma unroll
        for (int kc = 0; kc < 2; ++kc) { bf16x8 bA[4], bI[4];
#pragma unroll
            for (int k4 = 0; k4 < 4; ++k4) { bA[k4] = *(const bf16x8*)(wa + 16 * (kc * 4 + k4)); bI[k4] = *(const bf16x8*)(wi + 16 * (kc * 4 + k4)); }
#pragma unroll
            for (int mb = 0; mb < 4; ++mb)
#pragma unroll
                for (int k4 = 0; k4 < 4; ++k4) { const bf16x8 af = *(const LAS bf16x8*)(arow0 + SG * 32 * mb * 272 + 32 * (kc * 4 + k4));
                    accA[mb] = __builtin_amdgcn_mfma_f32_32x32x16_bf16(af, bA[k4], accA[mb], 0, 0, 0);
                    accI[mb] = __builtin_amdgcn_mfma_f32_32x32x16_bf16(af, bI[k4], accI[mb], 0, 0, 0); }
            __builtin_amdgcn_sched_barrier(0); }
    }
    {
        const float lam = p.lru_lambda[DIR * 1024 + ch]; const float sp8 = 8.0f * log1pf(expf(-lam));
        const float ba = p.lru_ba[DIR * 1024 + ch], bi = p.lru_bi[DIR * 1024 + ch];
        LAS unsigned char* up = ul + tbase * 272 + chl * 2;
#pragma unroll
        for (int mb = 0; mb < 4; ++mb) {
#pragma unroll
            for (int r = 0; r < 16; ++r) {
                const float uv = bf2f(*(const LAS bf16_t*)(up + SG * LRU_CST(mb, r) * 272));
                const float rg = sigmoidf_(accA[mb][r] + ba), ig = sigmoidf_(accI[mb][r] + bi);
                const float a = __expf(-sp8 * rg); accA[mb][r] = a; accI[mb][r] = __builtin_amdgcn_sqrtf(fmaxf(1.0f - a * a, 0.f)) * ig * uv; }
            __builtin_amdgcn_sched_barrier(0); }
    }
    float rA[16], rH[16];
#pragma unroll
    for (int mb = 0; mb < 4; ++mb)
#pragma unroll
        for (int q = 0; q < 4; ++q) { float pa = 1.f, hh = 0.f;
#pragma unroll
            for (int j = 0; j < 4; ++j) { const int r = 4 * q + j; const float a = accA[mb][r], bb = accI[mb][r]; hh = a * hh + bb; pa *= a; accA[mb][r] = pa; accI[mb][r] = hh; }
            rA[mb * 4 + q] = pa; rH[mb * 4 + q] = hh; }
    const int agg_dir_off = ((b * NSEQ) * 2 + DIR) * 1024 + ch;
    const float* agg = (const float*)(p.ws + WS_AGG);
    float carry = 0.f;
    if (FINAL) {
        if (DIR == 0) { for (int q = 0; q < sc; ++q) { const float* a2 = agg + (size_t)(agg_dir_off + q * 2048) * 2; carry = a2[0] * carry + a2[1]; } }
        else { { const float* a2 = agg + (size_t)(agg_dir_off + 1 * 2048) * 2; carry = a2[0] * carry + a2[1]; } { const float* a2 = agg + (size_t)(agg_dir_off + 0 * 2048) * 2; carry = a2[0] * carry + a2[1]; }
            for (int q = NSEQ - 1; q > sc; --q) { const float* a2 = agg + (size_t)(agg_dir_off + q * 2048) * 2; carry = a2[0] * carry + a2[1]; } }
    }
    float cin[16];
#pragma unroll
    for (int i = 0; i < 16; ++i) cin[i] = 0.f;
    float s = carry, At = 1.f;
#pragma unroll
    for (int i = 0; i < 16; ++i) { const float oA = __shfl_xor(rA[i], 32), oH = __shfl_xor(rH[i], 32);
        { const bool mine = (lh == 0); const float a = mine ? rA[i] : oA, hh = mine ? rH[i] : oH; cin[i] = mine ? s : cin[i]; s = a * s + hh; At *= a; }
        { const bool mine = (lh == 1); const float a = mine ? rA[i] : oA, hh = mine ? rH[i] : oH; cin[i] = mine ? s : cin[i]; s = a * s + hh; At *= a; } }
    if (!FINAL) {
        if (lh == 0) { float* o = (float*)(p.ws + WS_AGG) + (size_t)(agg_dir_off + sc * 2048) * 2; o[0] = At; o[1] = s; }
        return;
    }
#pragma unroll
    for (int mb = 0; mb < 4; ++mb)
#pragma unroll
        for (int r = 0; r < 16; ++r) accI[mb][r] += accA[mb][r] * cin[mb * 4 + (r >> 2)];
}
template <bool FINAL>
__device__ void lru_tile(const Params& p, LAS unsigned char* lds, int item) {
    const int tid = threadIdx.x, lane = tid & 63, wid = __builtin_amdgcn_readfirstlane(tid >> 6);
    int b, sc, head;
    if (FINAL) { head = item & 7; sc = 2 + ((item >> 3) & 31); b = item >> 8; }
    else { head = item & 7; const int r = item >> 3; sc = r & 1; b = r >> 1; }
    const bf16_t* src; int Tseq, t0, ld;
    if (sc < 2) { src = (const bf16_t*)(p.ws + WS_ZXC) + (size_t)b * 256 * 1024; Tseq = 256; t0 = sc * 128; ld = 1024; }
    else { src = (const bf16_t*)(p.ws + WS_RZ) + (size_t)b * 4096 * 4096; Tseq = 4096; t0 = (sc - 2) * 128; ld = 4096; }
    LAS unsigned char* ul = lds;
    LAS float* ybuf = (LAS float*)(lds + 36 * 1024);
    {
        const int c8 = tid & 15, tb = tid >> 4; const int ch0 = head * 128 + 8 * c8;
        float w[4][8], bias[8];
#pragma unroll
        for (int k = 0; k < 4; ++k) { const f32x4 a = *(const f32x4*)(p.conv_w + k * 1024 + ch0), c2 = *(const f32x4*)(p.conv_w + k * 1024 + ch0 + 4);
#pragma unroll
            for (int j = 0; j < 4; ++j) { w[k][j] = a[j]; w[k][4 + j] = c2[j]; } }
        { const f32x4 a = *(const f32x4*)(p.conv_b + ch0), c2 = *(const f32x4*)(p.conv_b + ch0 + 4);
#pragma unroll
            for (int j = 0; j < 4; ++j) { bias[j] = a[j]; bias[4 + j] = c2[j]; } }
#pragma unroll
        for (int i = 0; i < 4; ++i) { const int t = tb + 32 * i; float a[8];
#pragma unroll
            for (int j = 0; j < 8; ++j) a[j] = bias[j];
#pragma unroll
            for (int k = 0; k < 4; ++k) { const int tt = t0 + t + k - 2;
                if (tt >= 0 && tt < Tseq) { float f[8]; unpack8(*(const u32x4*)(src + (size_t)tt * ld + ch0), f);
#pragma unroll
                    for (int j = 0; j < 8; ++j) a[j] += w[k][j] * f[j]; } }
            u32x4 wv; wv.x = cvt_pk_bf16(a[0], a[1]); wv.y = cvt_pk_bf16(a[2], a[3]); wv.z = cvt_pk_bf16(a[4], a[5]); wv.w = cvt_pk_bf16(a[6], a[7]);
            *(LAS u32x4*)(ul + t * 272 + c8 * 16) = wv; }
    }
    __syncthreads();
    f32x16 hacc[4];
    if (wid < 4) lru_wave<FINAL, 0>(p, ul, b, sc, head, wid & 3, lane, hacc);
    else lru_wave<FINAL, 1>(p, ul, b, sc, head, wid & 3, lane, hacc);
    if (FINAL) {
        const int lr = lane & 31, lh = lane >> 5, chl = (wid & 3) * 32 + lr;
        if (wid >= 4) { LAS float* yp = ybuf + (127 - 4 * lh) * 129 + chl;
#pragma unroll
            for (int mb = 0; mb < 4; ++mb)
#pragma unroll
                for (int r = 0; r < 16; ++r) yp[-LRU_CST(mb, r) * 129] = hacc[mb][r]; }
        __syncthreads();
        if (wid < 4) {
            const LAS float* yp = ybuf + (4 * lh) * 129 + chl;
            const bf16_t* Zu = (const bf16_t*)(p.ws + WS_RZ) + ((size_t)(b * 4096 + t0) * 4096 + 1024 + head * 128);
            bf16_t* Ou = (bf16_t*)(p.ws + WS_R1) + ((size_t)(b * 4096 + t0) * 1024 + head * 128);
            const unsigned zo = (unsigned)(4 * lh * 4096 + chl), oo = (unsigned)(4 * lh * 1024 + chl);
#pragma unroll
            for (int mb = 0; mb < 4; ++mb) {
#pragma unroll
                for (int r = 0; r < 16; ++r) {
                    const float y = hacc[mb][r] + yp[LRU_CST(mb, r) * 129];
                    const float gz = bf2f(Zu[zo + LRU_CST(mb, r) * 4096]);
                    Ou[oo + LRU_CST(mb, r) * 1024] = (bf16_t)(cvt_pk_bf16(gz * y, 0.f) & 0xffffu);
                    if ((r & 7) == 7) __builtin_amdgcn_sched_barrier(0); } }
        }
    }
    __syncthreads();
}

#ifndef LRU_PF_FRAG
#define LRU_PF_FRAG true
#endif
#ifndef LRU_PF_TILE
#define LRU_PF_TILE true
#endif
typedef unsigned long long u64_t;
template <int DIR, bool PREF>
__device__ __forceinline__ void lru2_dir(const Params& p, LAS unsigned char* ul, int head, int w, int lane, const bf16x8 (&bA)[4], const bf16x8 (&bI)[4], bf16x8 (&nA)[4], bf16x8 (&nI)[4],
                                         f32x4 (&hl)[8], f32x4 (&pp)[8], float& Atot, float& Htot) {
    constexpr int SG = DIR ? -1 : 1;
    const int fr = lane & 15, fq = lane >> 4, chl = 16 * w + fr, ch = head * 128 + chl;
    f32x4 accA[8], accI[8];
#pragma unroll
    for (int rb = 0; rb < 8; ++rb) { accA[rb] = (f32x4){0.f, 0.f, 0.f, 0.f}; accI[rb] = (f32x4){0.f, 0.f, 0.f, 0.f}; }
    {
        LAS unsigned char* arow0 = ul + (DIR ? 127 - fr : fr) * 272 + fq * 16;
#pragma unroll
        for (int rb = 0; rb < 8; ++rb)
#pragma unroll
            for (int ks = 0; ks < 4; ++ks) { const bf16x8 af = *(const LAS bf16x8*)(arow0 + SG * 16 * rb * 272 + 64 * ks);
                accA[rb] = __builtin_amdgcn_mfma_f32_16x16x32_bf16(af, bA[ks], accA[rb], 0, 0, 0);
                accI[rb] = __builtin_amdgcn_mfma_f32_16x16x32_bf16(af, bI[ks], accI[rb], 0, 0, 0); }
    }
    if (PREF) {
        const bf16_t* wa = (const bf16_t*)(p.ws + WS_WAT) + ((size_t)((1 - DIR) * 8 + head) * 128 + chl) * 128 + 8 * fq;
        const bf16_t* wi = (const bf16_t*)(p.ws + WS_WIT) + ((size_t)((1 - DIR) * 8 + head) * 128 + chl) * 128 + 8 * fq;
#pragma unroll
        for (int ks = 0; ks < 4; ++ks) { nA[ks] = *(const bf16x8*)(wa + 32 * ks); nI[ks] = *(const bf16x8*)(wi + 32 * ks); }
    }
    {
        const float lam = p.lru_lambda[DIR * 1024 + ch]; const float sp8 = 8.0f * log1pf(expf(-lam));
        const float ba = p.lru_ba[DIR * 1024 + ch], bi = p.lru_bi[DIR * 1024 + ch];
        LAS unsigned char* up = ul + (DIR ? 127 - 4 * fq : 4 * fq) * 272 + chl * 2;
#pragma unroll
        for (int rb = 0; rb < 8; ++rb)
#pragma unroll
            for (int r = 0; r < 4; ++r) {
                const float uv = bf2f(*(const LAS bf16_t*)(up + SG * (16 * rb + r) * 272));
                const float rg = sigmoidf_(accA[rb][r] + ba), ig = sigmoidf_(accI[rb][r] + bi);
                const float a = __expf(-sp8 * rg); accA[rb][r] = a; accI[rb][r] = __builtin_amdgcn_sqrtf(fmaxf(1.0f - a * a, 0.f)) * ig * uv;
                if (r == 3 && (rb & 1)) __builtin_amdgcn_sched_barrier(0); }
    }
    float rA[8], rH[8];
#pragma unroll
    for (int rb = 0; rb < 8; ++rb) { float pa = 1.f, hh = 0.f;
#pragma unroll
        for (int r = 0; r < 4; ++r) { const float a = accA[rb][r], bb = accI[rb][r]; hh = a * hh + bb; pa *= a; accA[rb][r] = pa; accI[rb][r] = hh; }
        rA[rb] = pa; rH[rb] = hh; }
    float Pc = 1.f, s = 0.f;
#pragma unroll
    for (int rb = 0; rb < 8; ++rb) { float Pin = 1.f, Hin = 0.f;
#pragma unroll
        for (int q = 0; q < 4; ++q) { const float a = __shfl(rA[rb], fr + 16 * q), hh = __shfl(rH[rb], fr + 16 * q);
            if (q == fq) { Pin = Pc; Hin = s; }
            s = a * s + hh; Pc *= a; }
#pragma unroll
        for (int r = 0; r < 4; ++r) { hl[rb][r] = accI[rb][r] + accA[rb][r] * Hin; pp[rb][r] = accA[rb][r] * Pin; }
        __builtin_amdgcn_sched_barrier(0); }
    Atot = Pc; Htot = s;
}
__device__ __forceinline__ u64_t agg_ld(const u64_t* a) { return __hip_atomic_load(a, __ATOMIC_RELAXED, __HIP_MEMORY_SCOPE_AGENT); }
template <int DIR>
__device__ __forceinline__ float lru2_carry(const u64_t* aggc, int n, int fr, int fq) {
    float Ap = 1.f, Hp = 0.f; u64_t v[9];
#pragma unroll
    for (int k = 0; k < 9; ++k) { const int j = fq * 9 + k; const int seq = DIR ? (j == 0 ? 1 : (j == 1 ? 0 : 35 - j)) : j;
        v[k] = (j < n) ? agg_ld(aggc + (size_t)seq * 2048) : 0x000000003f800000ull; }
#pragma unroll
    for (int k = 0; k < 9; ++k) { const float a = __uint_as_float((unsigned)v[k]), hh = __uint_as_float((unsigned)(v[k] >> 32)); Hp = a * Hp + hh; Ap *= a; }
    float s = 0.f;
#pragma unroll
    for (int q = 0; q < 4; ++q) { const float a = __shfl(Ap, fr + 16 * q), hh = __shfl(Hp, fr + 16 * q); s = a * s + hh; }
    return s;
}
__device__ void lru2_block(const Params& p, LAS unsigned char* lds, int slot, int c, int ngr) {
    const int tid = threadIdx.x, lane = tid & 63, wid = __builtin_amdgcn_readfirstlane(tid >> 6);
    const int sc = c + 2, t0 = c * 128;
    LAS unsigned char* raw = lds;
    LAS unsigned char* ul = lds + 33792;
    LAS unsigned char* gzl = lds + 68608;
    LAS unsigned char* outl = lds + 103424;
    const int fr = lane & 15, fq = lane >> 4, chl = 16 * wid + fr;
    u32x4 nr[5], ng[4];
#define LRU2_LOAD(gg) do { const bf16_t* Zb_ = (const bf16_t*)(p.ws + WS_RZ) + (size_t)((gg) >> 3) * 4096 * 4096 + ((gg) & 7) * 128; \
        _Pragma("unroll") for (int k = 0; k < 5; ++k) { const int pc = tid + NTHR * k; nr[k] = (u32x4){0u, 0u, 0u, 0u}; \
            if (pc < 131 * 16) { const int row = pc >> 4, c8 = pc & 15, tt = t0 - 2 + row; if (tt >= 0 && tt < TT) nr[k] = *(const u32x4*)(Zb_ + (size_t)tt * 4096 + c8 * 8); } } \
        _Pragma("unroll") for (int k = 0; k < 4; ++k) { const int pc = tid + NTHR * k, row = pc >> 4, c8 = pc & 15; ng[k] = *(const u32x4*)(Zb_ + (size_t)(t0 + row) * 4096 + 1024 + c8 * 8); } } while (0)
    LRU2_LOAD(slot);
    for (int g = slot; g < NB * 8; g += ngr) {
        const int b = g >> 3, head = g & 7, ch = head * 128 + chl;
        unsigned* gcnt = (unsigned*)(p.ws + WS_BAR + 16 * KiB) + g * 64;
        bf16x8 bA1[4], bI1[4], bA0[4], bI0[4];
        { const bf16_t* wa = (const bf16_t*)(p.ws + WS_WAT) + ((size_t)(8 + head) * 128 + chl) * 128 + 8 * fq; const bf16_t* wi = (const bf16_t*)(p.ws + WS_WIT) + ((size_t)(8 + head) * 128 + chl) * 128 + 8 * fq;
#pragma unroll
          for (int ks = 0; ks < 4; ++ks) { bA1[ks] = *(const bf16x8*)(wa + 32 * ks); bI1[ks] = *(const bf16x8*)(wi + 32 * ks); } }
#pragma unroll
        for (int k = 0; k < 5; ++k) { const int pc = tid + NTHR * k; if (pc < 131 * 16) *(LAS u32x4*)(raw + (pc >> 4) * 256 + (pc & 15) * 16) = nr[k]; }
#pragma unroll
        for (int k = 0; k < 4; ++k) { const int pc = tid + NTHR * k; *(LAS u32x4*)(gzl + (pc >> 4) * 272 + (pc & 15) * 16) = ng[k]; }
        __syncthreads();
        {
            const int c8 = tid & 15, tb = tid >> 4; const int ch0 = head * 128 + 8 * c8;
            float w[4][8], bias[8];
#pragma unroll
            for (int k = 0; k < 4; ++k) { const f32x4 a = *(const f32x4*)(p.conv_w + k * 1024 + ch0), c2 = *(const f32x4*)(p.conv_w + k * 1024 + ch0 + 4);
#pragma unroll
                for (int j = 0; j < 4; ++j) { w[k][j] = a[j]; w[k][4 + j] = c2[j]; } }
            { const f32x4 a = *(const f32x4*)(p.conv_b + ch0), c2 = *(const f32x4*)(p.conv_b + ch0 + 4);
#pragma unroll
                for (int j = 0; j < 4; ++j) { bias[j] = a[j]; bias[4 + j] = c2[j]; } }
#pragma unroll
            for (int i = 0; i < 4; ++i) { const int t = tb + 32 * i; float a[8];
#pragma unroll
                for (int j = 0; j < 8; ++j) a[j] = bias[j];
#pragma unroll
                for (int k = 0; k < 4; ++k) { float f[8]; unpack8(*(const LAS u32x4*)(raw + (t + k) * 256 + c8 * 16), f);
#pragma unroll
                    for (int j = 0; j < 8; ++j) a[j] += w[k][j] * f[j]; }
                u32x4 wv; wv.x = cvt_pk_bf16(a[0], a[1]); wv.y = cvt_pk_bf16(a[2], a[3]); wv.z = cvt_pk_bf16(a[4], a[5]); wv.w = cvt_pk_bf16(a[6], a[7]);
                *(LAS u32x4*)(ul + t * 272 + c8 * 16) = wv; }
        }
        __syncthreads();
        float A0, H0, A1, H1;
        {
            f32x4 hl1[8], pp1[8];
            lru2_dir<1, LRU_PF_FRAG>(p, ul, head, wid, lane, bA1, bI1, bA0, bI0, hl1, pp1, A1, H1);
            LAS unsigned char* hp = outl + (127 - 4 * fq) * 272 + chl * 2; LAS unsigned char* qp = raw + (127 - 4 * fq) * 256 + chl * 2;
#pragma unroll
            for (int rb = 0; rb < 8; ++rb)
#pragma unroll
                for (int r = 0; r < 4; ++r) { *(LAS bf16_t*)(hp - (16 * rb + r) * 272) = (bf16_t)(cvt_pk_bf16(hl1[rb][r], 0.f) & 0xffffu); *(LAS bf16_t*)(qp - (16 * rb + r) * 256) = (bf16_t)(cvt_pk_bf16(pp1[rb][r], 0.f) & 0xffffu); }
        }
        __builtin_amdgcn_sched_barrier(0);
        if (!LRU_PF_FRAG) { const bf16_t* wa = (const bf16_t*)(p.ws + WS_WAT) + ((size_t)(head) * 128 + chl) * 128 + 8 * fq; const bf16_t* wi = (const bf16_t*)(p.ws + WS_WIT) + ((size_t)(head) * 128 + chl) * 128 + 8 * fq;
#pragma unroll
          for (int ks = 0; ks < 4; ++ks) { bA0[ks] = *(const bf16x8*)(wa + 32 * ks); bI0[ks] = *(const bf16x8*)(wi + 32 * ks); } }
        f32x4 hl0[8], pp0[8];
        lru2_dir<0, false>(p, ul, head, wid, lane, bA0, bI0, bA1, bI1, hl0, pp0, A0, H0);
        u64_t* agg = (u64_t*)(p.ws + WS_AGG);
        const size_t ai0 = ((size_t)(b * NSEQ) * 2 + 0) * 1024 + ch, ai1 = ((size_t)(b * NSEQ) * 2 + 1) * 1024 + ch;
        if (fq == 0) {
            __hip_atomic_store(agg + ai0 + (size_t)sc * 2048, ((u64_t)__float_as_uint(H0) << 32) | __float_as_uint(A0), __ATOMIC_RELAXED, __HIP_MEMORY_SCOPE_AGENT);
            __hip_atomic_store(agg + ai1 + (size_t)sc * 2048, ((u64_t)__float_as_uint(H1) << 32) | __float_as_uint(A1), __ATOMIC_RELAXED, __HIP_MEMORY_SCOPE_AGENT); }
        asm volatile("s_waitcnt vmcnt(0)" ::: "memory");
        __syncthreads();
        if (tid == 0) (void)__hip_atomic_fetch_add(gcnt, 1u, __ATOMIC_RELAXED, __HIP_MEMORY_SCOPE_AGENT);
        if (wid == 0) { unsigned sp = 0;
            while ((unsigned)__builtin_amdgcn_readfirstlane(__hip_atomic_load(gcnt, __ATOMIC_RELAXED, __HIP_MEMORY_SCOPE_AGENT)) < 32u) { __builtin_amdgcn_s_sleep(1); if (++sp > (1u << 22)) break; }
            __builtin_amdgcn_fence(__ATOMIC_ACQUIRE, "agent");
            asm volatile("s_waitcnt vmcnt(0)" ::: "memory"); }
        __syncthreads();
        const float C0 = lru2_carry<0>(agg + ai0, sc, fr, fq);
        const float C1 = lru2_carry<1>(agg + ai1, 2 + (NSEQ - 1 - sc), fr, fq);
        __builtin_amdgcn_sched_barrier(0);
        if (LRU_PF_TILE) { const int gn = (g + ngr < NB * 8) ? g + ngr : g; LRU2_LOAD(gn); }
        __builtin_amdgcn_sched_barrier(0);
        LAS unsigned char* gp = gzl + (4 * fq) * 272 + chl * 2; LAS unsigned char* op = outl + (4 * fq) * 272 + chl * 2; LAS unsigned char* qp0 = raw + (4 * fq) * 256 + chl * 2;
#pragma unroll
        for (int rb = 0; rb < 8; ++rb)
#pragma unroll
            for (int r = 0; r < 4; ++r) { const float h1 = bf2f(*(const LAS bf16_t*)(op + (16 * rb + r) * 272)) + bf2f(*(const LAS bf16_t*)(qp0 + (16 * rb + r) * 256)) * C1;
                const float y = hl0[rb][r] + pp0[rb][r] * C0 + h1;
                const float gz = bf2f(*(const LAS bf16_t*)(gp + (16 * rb + r) * 272));
                *(LAS bf16_t*)(op + (16 * rb + r) * 272) = (bf16_t)(cvt_pk_bf16(gz * y, 0.f) & 0xffffu); }
        __syncthreads();
        bf16_t* Ob = (bf16_t*)(p.ws + WS_R1) + ((size_t)(b * 4096 + t0)) * 1024 + head * 128;
#pragma unroll
        for (int k = 0; k < 4; ++k) { const int pc = tid + NTHR * k, row = pc >> 4, c8 = pc & 15;
            *(u32x4*)(Ob + (size_t)row * 1024 + c8 * 8) = *(const LAS u32x4*)(outl + row * 272 + c8 * 16); }
        __syncthreads();
        if (!LRU_PF_TILE && g + ngr < NB * 8) LRU2_LOAD(g + ngr);
    }
#undef LRU2_LOAD
}

__device__ void fft_stage2(const Params& p, LAS unsigned char* lds, int item) {
    const int tid = threadIdx.x, b = item >> 8, k1 = item & 255;
    LAS unsigned char* yl = lds;
    LAS float* cf = (LAS float*)(lds + 32768);
    const bf16_t* Yt = (const bf16_t*)((const unsigned char*)p.out + OUT_YT);
#pragma unroll
    for (int k = 0; k < 4; ++k) { const int pc = tid + NTHR * k, ri = pc >> 10, o = (pc & 1023) * 8;
        *(LAS u32x4*)(yl + ri * 16384 + o * 2) = *(const u32x4*)(Yt + (size_t)(k1 * 2 + ri) * 65536 + (size_t)b * 8192 + o); }
    if (tid < 256) { const int k2 = tid >> 4, t2 = tid & 15; float sn, cs; sincospif((float)(((k1 + 256 * k2) * t2) & 4095) * (1.0f / 2048.0f), &sn, &cs); cf[tid * 2] = cs; cf[tid * 2 + 1] = sn; }
    __syncthreads();
    float yr[16], yi[16];
    { float f[8]; unpack8(*(const LAS u32x4*)(yl + tid * 32), f);
#pragma unroll
      for (int j = 0; j < 8; ++j) yr[j] = f[j];
      unpack8(*(const LAS u32x4*)(yl + tid * 32 + 16), f);
#pragma unroll
      for (int j = 0; j < 8; ++j) yr[8 + j] = f[j];
      unpack8(*(const LAS u32x4*)(yl + 16384 + tid * 32), f);
#pragma unroll
      for (int j = 0; j < 8; ++j) yi[j] = f[j];
      unpack8(*(const LAS u32x4*)(yl + 16384 + tid * 32 + 16), f);
#pragma unroll
      for (int j = 0; j < 8; ++j) yi[8 + j] = f[j]; }
    bf16_t* Fo = (bf16_t*)((unsigned char*)p.out + OUT_F) + ((size_t)b * 4096 + k1) * 512 + tid;
#pragma unroll
    for (int k2 = 0; k2 < 16; ++k2) { float a = 0.f;
#pragma unroll
        for (int t2 = 0; t2 < 16; ++t2) { const float cs = cf[(k2 * 16 + t2) * 2], sn = cf[(k2 * 16 + t2) * 2 + 1]; a += cs * yr[t2] + sn * yi[t2]; }
        Fo[(size_t)k2 * 256 * 512] = (bf16_t)(cvt_pk_bf16(a, 0.f) & 0xffffu); }
    __syncthreads();
}

__device__ void phase7_rows(const Params& p, LAS unsigned char* lds) {
    const int tid = threadIdx.x, lane = tid & 63, wid = tid >> 6;
    LAS float* wrt = (LAS float*)lds;
    for (int i = tid; i < 16 * 1024; i += NTHR) { const int d = i >> 4, e = i & 15; wrt[e * 1024 + d] = p.w_router[i]; }
    __syncthreads();
    const float* ada = (const float*)(p.ws + WS_ADA); bf16_t* h2 = (bf16_t*)(p.ws + WS_R1); float* scores = (float*)(p.ws + WS_SCORES);
    for (int row0 = (blockIdx.x * 8 + wid) * 2; row0 < MLAT; row0 += gridDim.x * 16) {
        const int b = row0 >> 12;
        f32x4 v[2][4]; float ss[2];
#pragma unroll
        for (int r = 0; r < 2; ++r)
#pragma unroll
            for (int i = 0; i < 4; ++i) v[r][i] = *(const f32x4*)(p.out + (size_t)(row0 + r) * 1024 + 256 * i + 4 * lane);
#pragma unroll
        for (int r = 0; r < 2; ++r) { float a = 0.f;
#pragma unroll
            for (int i = 0; i < 4; ++i) a += v[r][i][0] * v[r][i][0] + v[r][i][1] * v[r][i][1] + v[r][i][2] * v[r][i][2] + v[r][i][3] * v[r][i][3];
            ss[r] = a; }
#pragma unroll
        for (int o = 32; o >= 1; o >>= 1) { ss[0] += __shfl_xor(ss[0], o); ss[1] += __shfl_xor(ss[1], o); }
#pragma unroll
        for (int i = 0; i < 4; ++i) { const int d = 256 * i + 4 * lane;
            const f32x4 g = *(const f32x4*)(p.norm2_g + d), sh = *(const f32x4*)(ada + b * 6144 + 3072 + d), sc = *(const f32x4*)(ada + b * 6144 + 4096 + d);
#pragma unroll
            for (int r = 0; r < 2; ++r) { const float rs = rsqrtf(ss[r] * (1.0f / 1024.0f) + 1e-6f);
                v[r][i] = v[r][i] * rs * g * (sc + 1.0f) + sh;
                u32x2 w; w.x = cvt_pk_bf16(v[r][i][0], v[r][i][1]); w.y = cvt_pk_bf16(v[r][i][2], v[r][i][3]); *(u32x2*)(h2 + (size_t)(row0 + r) * 1024 + d) = w; } }
        float q[32];
#pragma unroll
        for (int e = 0; e < 16; ++e) { float a0 = 0.f, a1 = 0.f;
#pragma unroll
            for (int i = 0; i < 4; ++i) { const f32x4 w = *(const LAS f32x4*)(wrt + e * 1024 + 256 * i + 4 * lane);
                a0 += v[0][i][0] * w[0] + v[0][i][1] * w[1] + v[0][i][2] * w[2] + v[0][i][3] * w[3];
                a1 += v[1][i][0] * w[0] + v[1][i][1] * w[1] + v[1][i][2] * w[2] + v[1][i][3] * w[3]; }
            q[e] = a0; q[16 + e] = a1; }
#pragma unroll
        for (int j = 0; j < 16; ++j) { const bool up = (lane & 32) != 0; const float send = up ? q[j] : q[16 + j], keep = up ? q[16 + j] : q[j]; q[j] = keep + __shfl_xor(send, 32); }
#pragma unroll
        for (int j = 0; j < 8; ++j) { const bool up = (lane & 16) != 0; const float send = up ? q[j] : q[8 + j], keep = up ? q[8 + j] : q[j]; q[j] = keep + __shfl_xor(send, 16); }
#pragma unroll
        for (int j = 0; j < 4; ++j) { const bool up = (lane & 8) != 0; const float send = up ? q[j] : q[4 + j], keep = up ? q[4 + j] : q[j]; q[j] = keep + __shfl_xor(send, 8); }
#pragma unroll
        for (int j = 0; j < 2; ++j) { const bool up = (lane & 4) != 0; const float send = up ? q[j] : q[2 + j], keep = up ? q[2 + j] : q[j]; q[j] = keep + __shfl_xor(send, 4); }
        { const bool up = (lane & 2) != 0; const float send = up ? q[0] : q[1], keep = up ? q[1] : q[0]; q[0] = keep + __shfl_xor(send, 2); }
        float lg = q[0] + __shfl_xor(q[0], 1);
        float mx = lg;
#pragma unroll
        for (int o = 2; o <= 16; o <<= 1) mx = fmaxf(mx, __shfl_xor(mx, o));
        const float ex = expf(lg - mx); float sum = ex;
#pragma unroll
        for (int o = 2; o <= 16; o <<= 1) sum += __shfl_xor(sum, o);
        if ((lane & 1) == 0) scores[((size_t)b * 16 + ((lane >> 1) & 15)) * 4096 + ((row0 + (lane >> 5)) & 4095)] = ex / sum;
    }
    __syncthreads();
}
__device__ void phase7_weights(const Params& p) {
    constexpr int N_G = 16 * 16 * 6, N_D = 16 * 24 * 4;
    for (int it = blockIdx.x; it < 2 * N_G + N_D; it += gridDim.x) {
        if (it < 2 * N_G) { const int up = it >= N_G, j = up ? it - N_G : it, e = j / 96, r = j % 96, kb = r / 6, nb = r % 6;
            xpose_item<4>((up ? p.w_up_e : p.w_gate_e) + (size_t)e * 1024 * 1536, 1536, (bf16_t*)(p.ws + WS_WGU) + (size_t)e * 3072 * 1024, 1024, kb * 64, nb * 256, up ? 2 : 1); }
        else { const int j = it - 2 * N_G, e = j / 96, r = j % 96, kb = r >> 2, nb = r & 3;
            xpose_item<4>(p.w_down_e + (size_t)e * 1536 * 1024, 1024, (bf16_t*)(p.ws + WS_WD) + (size_t)e * 1024 * 1536, 1536, kb * 64, nb * 256, 0); }
    }
}

__device__ void phase8_topk(const Params& p, LAS unsigned char* lds) {
    const int tid = threadIdx.x, lane = tid & 63, wid = tid >> 6;
    LAS unsigned* cnt = (LAS unsigned*)lds;
    LAS unsigned* wsum = cnt + 16;
    const float* scores = (const float*)(p.ws + WS_SCORES);
    int* idx = (int*)(p.ws + WS_IDX); float* gate = (float*)(p.ws + WS_GATE); int* slot_of = (int*)(p.ws + WS_SLOT);
    for (int it = blockIdx.x; it < NB * NE; it += gridDim.x) {
        const int b = it >> 4, e = it & 15;
        unsigned key[8];
        { const u32x4* sp = (const u32x4*)(scores + (size_t)it * 4096 + tid * 8); const u32x4 a = sp[0], c2 = sp[1]; key[0] = a.x; key[1] = a.y; key[2] = a.z; key[3] = a.w; key[4] = c2.x; key[5] = c2.y; key[6] = c2.z; key[7] = c2.w; }
        unsigned thr = 0;
        for (int bit = 30; bit >= 0; --bit) {
            const unsigned cand = thr | (1u << bit); unsigned c = 0;
#pragma unroll
            for (int j = 0; j < 8; ++j) c += (unsigned)__popcll(__ballot(key[j] >= cand));
            LAS unsigned* cb = cnt + (bit & 1) * 8;
            if (lane == 0) cb[wid] = c;
            __syncthreads();
            unsigned tot = 0;
#pragma unroll
            for (int w = 0; w < 8; ++w) tot += cb[w];
            if (tot >= (unsigned)CAP) thr = cand;
        }
        unsigned cg_ = 0, ce = 0;
#pragma unroll
        for (int j = 0; j < 8; ++j) { cg_ += key[j] > thr; ce += key[j] == thr; }
        unsigned pk = cg_ | (ce << 16), incl = pk;
#pragma unroll
        for (int o = 1; o < 64; o <<= 1) { const unsigned n = __shfl_up(incl, o); if (lane >= o) incl += n; }
        if (lane == 63) wsum[wid] = incl;
        __syncthreads();
        unsigned base = 0, total = 0;
#pragma unroll
        for (int w = 0; w < 8; ++w) { const unsigned s = wsum[w]; if (w < wid) base += s; total += s; }
        const unsigned excl = base + incl - pk; unsigned og = excl & 0xffffu, oe = excl >> 16; const unsigned ngt = total & 0xffffu, krem = (unsigned)CAP - ngt;
#pragma unroll
        for (int j = 0; j < 8; ++j) { const int t = tid * 8 + j; int m = -1;
            if (key[j] > thr) { m = (e * 8 + b) * 512 + (int)og; ++og; }
            else if (key[j] == thr) { if (oe < krem) m = (e * 8 + b) * 512 + (int)(ngt + oe); ++oe; }
            slot_of[((size_t)b * 4096 + t) * 16 + e] = m;
            if (m >= 0) { idx[m] = b * 4096 + t; gate[m] = __uint_as_float(key[j]); } }
        __syncthreads();
    }
}

__device__ void phase11(const Params& p, float* dst) {
    const int tid = tid_opaque(), lane = tid & 63, wid = tid >> 6;
    const float* ada = (const float*)(p.ws + WS_ADA); const int* slot_of = (const int*)(p.ws + WS_SLOT); const bf16_t* oute = (const bf16_t*)(p.ws + WS_OUTE);
    const int stride = gridDim.x * 16;
    int row0 = (blockIdx.x * 8 + wid) * 2;
    int myslot = row0 < MLAT ? slot_of[(size_t)row0 * 16 + (lane & 31)] : -1;
    for (; row0 < MLAT; row0 += stride) {
        const int b = row0 >> 12;
        const int nrow = row0 + stride; const int nslot = nrow < MLAT ? slot_of[(size_t)nrow * 16 + (lane & 31)] : -1;
        f32x4 xv[2][4], acc[2][4];
#pragma unroll
        for (int r = 0; r < 2; ++r)
#pragma unroll
            for (int i = 0; i < 4; ++i) { xv[r][i] = *(const f32x4*)(p.out + (size_t)(row0 + r) * 1024 + 256 * i + 4 * lane); acc[r][i] = (f32x4){0.f, 0.f, 0.f, 0.f}; }
        const unsigned long long bal = __ballot(myslot >= 0);
        unsigned mask0 = (unsigned)(bal & 0xffffull), mask1 = (unsigned)((bal >> 16) & 0xffffull);
        while (mask0 | mask1) {
            int m[2][2];
#pragma unroll
            for (int j = 0; j < 2; ++j) { if (mask0) { const int e = __builtin_ctz(mask0); mask0 &= mask0 - 1; m[0][j] = __builtin_amdgcn_readlane(myslot, e); } else m[0][j] = MMOE;
                                          if (mask1) { const int e = __builtin_ctz(mask1); mask1 &= mask1 - 1; m[1][j] = __builtin_amdgcn_readlane(myslot, 16 + e); } else m[1][j] = MMOE; }
            u32x2 w[2][2][4];
#pragma unroll
            for (int r = 0; r < 2; ++r)
#pragma unroll
                for (int j = 0; j < 2; ++j)
#pragma unroll
                    for (int i = 0; i < 4; ++i) w[r][j][i] = *(const u32x2*)(oute + (size_t)m[r][j] * 1024 + 256 * i + 4 * lane);
#pragma unroll
            for (int r = 0; r < 2; ++r)
#pragma unroll
                for (int j = 0; j < 2; ++j)
#pragma unroll
                    for (int i = 0; i < 4; ++i) { acc[r][i][0] += bf_lo(w[r][j][i].x); acc[r][i][1] += bf_hi(w[r][j][i].x); acc[r][i][2] += bf_lo(w[r][j][i].y); acc[r][i][3] += bf_hi(w[r][j][i].y); }
        }
        float ss[2];
#pragma unroll
        for (int r = 0; r < 2; ++r) { float a = 0.f;
#pragma unroll
            for (int i = 0; i < 4; ++i) { const int d = 256 * i + 4 * lane; const f32x4 g2 = *(const f32x4*)(ada + b * 6144 + 5120 + d); xv[r][i] += g2 * acc[r][i];
                a += xv[r][i][0] * xv[r][i][0] + xv[r][i][1] * xv[r][i][1] + xv[r][i][2] * xv[r][i][2] + xv[r][i][3] * xv[r][i][3]; }
            ss[r] = a; }
#pragma unroll
        for (int o = 32; o >= 1; o >>= 1) { ss[0] += __shfl_xor(ss[0], o); ss[1] += __shfl_xor(ss[1], o); }
#pragma unroll
        for (int r = 0; r < 2; ++r) { const float rs = rsqrtf(ss[r] * (1.0f / 1024.0f) + 1e-6f);
#pragma unroll
            for (int i = 0; i < 4; ++i) { const int d = 256 * i + 4 * lane; *(f32x4*)(dst + (size_t)(row0 + r) * 1024 + d) = xv[r][i] * rs * *(const f32x4*)(p.final_g + d); } }
        myslot = nslot;
    }
}

#define XB_TMO      128
#define XB_XCNT(j)  (256  + 64 * (j))
#define XB_XSUB(j)  (1280 + 64 * (j))
#define XB_XGEN(j)  (2304 + 64 * (j))
#define XB_TOP      3328
#define XB_TOPGEN   3392
#define XCD_BAR_WORDS 3456
#define XB_SPIN_CAP (1u << 22)
__device__ __forceinline__ unsigned xb_ld(unsigned* p)              { return __hip_atomic_load(p, __ATOMIC_RELAXED, __HIP_MEMORY_SCOPE_AGENT); }
__device__ __forceinline__ unsigned xb_add(unsigned* p, unsigned v) { return __hip_atomic_fetch_add(p, v, __ATOMIC_RELAXED, __HIP_MEMORY_SCOPE_AGENT); }
__device__ __forceinline__ unsigned xb_xcc_id() { return (unsigned)__builtin_amdgcn_s_getreg((3 << 11) | 20) & 0xFu; }
#define XB_SPIN(cond, bar) do { unsigned _sp = 0; while (cond) { __builtin_amdgcn_s_sleep(1); \
    if ((++_sp & 255u) == 0u) { if (xb_ld(&(bar)[XB_TMO])) break; if (_sp > XB_SPIN_CAP) { atomicAdd(&(bar)[XB_TMO], 1u); break; } } } } while (0)
struct XcdBarrier { unsigned* bar; unsigned x; volatile LAS unsigned* st; };
__device__ __forceinline__ XcdBarrier xcd_barrier_post(unsigned* bar, volatile LAS unsigned* st) {
    XcdBarrier b; b.bar = bar; b.x = xb_xcc_id(); b.st = st;
    if (threadIdx.x == 0) (void)xb_add(&bar[XB_XCNT(b.x)], 1u);
    return b;
}
__device__ __forceinline__ void xcd_barrier_complete(unsigned* bar, unsigned x, unsigned& nloc, unsigned& nx) {
    const unsigned G = gridDim.x * gridDim.y * gridDim.z;
    unsigned sum, cnt, mine, sp = 0u;
    for (;;) {
        sum = 0u; cnt = 0u; mine = 0u;
#pragma unroll
        for (unsigned j = 0; j < 16; ++j) { const unsigned c = xb_ld(&bar[XB_XCNT(j)]); sum += c; cnt += (c > 0u) ? 1u : 0u; mine = (j == x) ? c : mine; }
        if (sum == G) break;
        __builtin_amdgcn_s_sleep(1);
        if ((++sp & 255u) == 0u) { if (xb_ld(&bar[XB_TMO])) break; if (sp > XB_SPIN_CAP) { atomicAdd(&bar[XB_TMO], 1u); break; } }
    }
    nloc = mine > 0u ? mine : 1u; nx = cnt > 0u ? cnt : 1u;
}
__device__ __forceinline__ void xcd_barrier(const XcdBarrier& b) {
    asm volatile("s_waitcnt vmcnt(0)" ::: "memory");
    __syncthreads();
    if (threadIdx.x == 0) {
        unsigned* bar = b.bar;
        __builtin_amdgcn_s_waitcnt(0);
        unsigned nloc = b.st[0], nx = b.st[1];
        if (nloc == 0u) { xcd_barrier_complete(bar, b.x, nloc, nx); b.st[0] = nloc; b.st[1] = nx; }
        const unsigned old = xb_add(&bar[XB_XSUB(b.x)], 1u);
        const unsigned gen = old / nloc;
        if (old + 1u == (gen + 1u) * nloc) {
            __builtin_amdgcn_fence(__ATOMIC_RELEASE, "agent");
            asm volatile("s_waitcnt vmcnt(0)" ::: "memory");
            const unsigned og = xb_add(&bar[XB_TOP], 1u);
            const unsigned tg = og / nx;
            if (og + 1u == (tg + 1u) * nx) xb_add(&bar[XB_TOPGEN], 1u);
            else XB_SPIN(xb_ld(&bar[XB_TOPGEN]) == tg, bar);
            __builtin_amdgcn_fence(__ATOMIC_ACQUIRE, "agent");
            xb_add(&bar[XB_XGEN(b.x)], 1u);
            asm volatile("s_waitcnt vmcnt(0)" ::: "memory");
        } else {
            XB_SPIN(xb_ld(&bar[XB_XGEN(b.x)]) == gen, bar);
            __builtin_amdgcn_fence(__ATOMIC_ACQUIRE, "agent");
            asm volatile("s_waitcnt vmcnt(0)" ::: "memory");
        }
    }
    __syncthreads();
}

__global__ void __launch_bounds__(NTHR, 2) fwd_megakernel(Params p) {
    extern __shared__ __attribute__((aligned(16))) unsigned char lds_raw[];
    LAS unsigned char* lds = (LAS unsigned char*)lds_raw;
    cg::grid_group grid = cg::this_grid();
    const int G = gridDim.x, bid = blockIdx.x;
    unsigned char* ws = p.ws;
    bf16_t* const R1 = (bf16_t*)(ws + WS_R1); bf16_t* const Zb = (bf16_t*)(ws + WS_RZ); bf16_t* const PQt = (bf16_t*)(ws + WS_RPQ); bf16_t* const MRG = (bf16_t*)(ws + WS_R2);
    bf16_t* const Fb = (bf16_t*)((unsigned char*)p.out + OUT_F); bf16_t* const Ytb = (bf16_t*)((unsigned char*)p.out + OUT_YT);
#ifdef ONLY_PH
#define PH(k) ((k) == ONLY_PH && p.ph_lo <= (k) && (k) < p.ph_hi)
#else
#define PH(k) (p.ph_lo <= (k) && (k) < p.ph_hi)
#endif
    volatile LAS unsigned* xst = (volatile LAS unsigned*)(lds + LDS_BYTES - 16);
    if (threadIdx.x < 4) xst[threadIdx.x] = 0u;
    __syncthreads();
    XcdBarrier xbar = xcd_barrier_post((unsigned*)(ws + WS_BAR), xst);
    if (p.ph_lo < 0) grid.sync();
#define SYNC(k) do { if (PH(k) && PH((k) + 1)) xcd_barrier(xbar); } while (0)
#ifndef REPMASK
#define REPMASK 0
#endif
#define REP(k) for (int rep_ = 0; rep_ <= ((REPMASK >> (k)) & 1); ++rep_)
    if (PH(0)) REP(0) phase0(p, lds);
    SYNC(0);
    if (PH(1)) REP(1) phase1(p);
    SYNC(1);
    if (PH(2)) REP(2) {
        { ProbPQ pr{(const bf16_t*)(ws + WS_WPQ), R1, 1024, 1024, 16384}; pg8::Order S; S.init(4, 128, G, bid); EpiPQ E{PQt}; pg8::gemm_phase(lds, pr, S, E); }
        { ProbPlain pr{R1, (const bf16_t*)(ws + WS_WIN), 1024, 1024, 1024}; pg8::Order S; S.init(128, 16, G, bid); EpiZ E{Zb, 4096, -1}; pg8::gemm_phase(lds, pr, S, E); }
        { ProbPlain pr{(const bf16_t*)(ws + WS_HCTX), (const bf16_t*)(ws + WS_WIN), 1024, 1024, 1024}; pg8::Order S; S.init(8, 4, G, bid); EpiZ E{(bf16_t*)(ws + WS_ZXC), 1024, 0}; pg8::gemm_phase(lds, pr, S, E); }
    }
    SYNC(2);
    if (PH(3)) REP(3) {
        { ProbPlain pr{(const bf16_t*)(ws + WS_D1T), PQt, 512, 512, 512}; pg8::Order S; S.init(2, 256, G, bid); EpiPlain E{Ytb, 65536}; pg8::gemm_phase(lds, pr, S, E); }
        for (int it = bid; it < NB * 2 * 8; it += G) lru_tile<false>(p, lds, it);
    }
    SYNC(3);
    if (PH(4)) {
        for (int it = bid; it < NB * 256; it += G) fft_stage2(p, lds, it);
        const int ngr = G >> 5;
        if (ngr > 0 && bid < ngr * 32) lru2_block(p, lds, bid % ngr, bid / ngr, ngr);
    }
    SYNC(4);
    if (PH(5)) REP(5) {
        { ProbMerge pr{Fb, (const bf16_t*)(ws + WS_WFOUR), R1, (const bf16_t*)(ws + WS_WLRU), 512, 1024, 512, 512, 1024, 1024}; pg8::Order S; S.init(128, 4, G, bid); EpiMerge E{MRG, Zb}; pg8::gemm_phase2(lds, pr, S, E); }
    }
    SYNC(5);
    if (PH(6)) REP(6) { ProbPlain pr{MRG, (const bf16_t*)(ws + WS_WOUT), 1024, 1024, 1024}; pg8::Order S; S.init(128, 4, G, bid);
        EpiOut E{p.out, p.x, (const float*)(ws + WS_POS), (const float*)(ws + WS_ADA)}; pg8::gemm_phase(lds, pr, S, E); }
    SYNC(6);
    if (PH(7)) REP(7) { phase7_rows(p, lds); phase7_weights(p); }
    SYNC(7);
    if (PH(8)) REP(8) phase8_topk(p, lds);
    SYNC(8);
    if (PH(9)) REP(9) { ProbMoeUp pr{R1, (const bf16_t*)(ws + WS_WGU), (const int*)(ws + WS_IDX), 1024, 1024, 1024}; pg8::Order S; S.init(256, 12, G, bid); EpiGU E{(bf16_t*)(ws + WS_HID)}; pg8::gemm_phase(lds, pr, S, E); }
    SYNC(9);
    if (PH(10)) { if (bid == 0 && threadIdx.x < 128) *(u32x4*)(ws + WS_OUTE + (size_t)MMOE * 2048 + threadIdx.x * 16) = (u32x4){0u, 0u, 0u, 0u}; }
    if (PH(10)) REP(10) { ProbMoeDown pr{(const bf16_t*)(ws + WS_HID), (const bf16_t*)(ws + WS_WD), 1536, 1536, 1536}; pg8::Order S; S.init(256, 4, G, bid); EpiDown E{(bf16_t*)(ws + WS_OUTE), (const float*)(ws + WS_GATE)}; pg8::gemm_phase(lds, pr, S, E); }
    SYNC(10);
    if (PH(12)) phase11(p, (float*)(ws + WS_HID));
    if (PH(11)) phase11(p, p.out);
}

#ifndef N_LAUNCHES
#define N_LAUNCHES 1
#endif
#ifndef PROBE_DUP
#define PROBE_DUP 0x0
#endif
extern "C" void kernel_launch(void* const* d_in, const int* in_sizes, int n_in, void* d_out, int out_size, void* d_ws, size_t ws_size, hipStream_t stream) {
    static int grid = 0;
    if (grid == 0) {
        if (n_in != 24 || out_size != MLAT * DM || ws_size < WS_END) { fprintf(stderr, "kernel_launch: unexpected shapes (n_in %d out %d ws %zu)\n", n_in, out_size, ws_size); grid = -1; return; }
        int dev = 0, cus = 0, per_cu = 0;
        hipGetDevice(&dev); hipDeviceGetAttribute(&cus, hipDeviceAttributeMultiprocessorCount, dev);
        hipFuncSetAttribute((const void*)fwd_megakernel, hipFuncAttributeMaxDynamicSharedMemorySize, LDS_BYTES);
        hipOccupancyMaxActiveBlocksPerMultiprocessor(&per_cu, (const void*)fwd_megakernel, NTHR, LDS_BYTES);
        if (per_cu < 1) { fprintf(stderr, "kernel_launch: occupancy query reports %d blocks per CU\n", per_cu); per_cu = 1; }
        grid = cus * 1;
        (void)hipGetLastError();
    }
    if (grid < 0) return;
    Params p{};
    const float** f = (const float**)&p;
    for (int i = 0; i < 24; ++i) f[i] = (const float*)d_in[i];
    p.out = (float*)d_out; p.ws = (unsigned char*)d_ws;
    (void)hipMemsetAsync((unsigned char*)d_ws + WS_BAR, 0, 32 * KiB, stream);
#if N_LAUNCHES == 1
    p.ph_lo = 0; p.ph_hi = 12;
    void* args[] = {&p};
    hipError_t e = hipLaunchCooperativeKernel((const void*)fwd_megakernel, dim3(grid), dim3(NTHR), args, LDS_BYTES, stream);
    if (e != hipSuccess) fprintf(stderr, "cooperative launch failed: %s (grid %d)\n", hipGetErrorString(e), grid);
#else
    for (int k = 0; k < 12; ++k) for (int r = 0; r <= ((PROBE_DUP >> k) & 1); ++r) { p.ph_lo = k; p.ph_hi = k + 1; if (k == 11 && r == 0 && ((PROBE_DUP >> 11) & 1)) { p.ph_lo = 12; p.ph_hi = 13; } hipLaunchKernelGGL(fwd_megakernel, dim3(grid), dim3(NTHR), LDS_BYTES, stream, p); }
#endif
}
```

```cpp
#include <hip/hip_runtime.h>
#include <hip/hip_cooperative_groups.h>
#include <cstdio>
namespace cg = cooperative_groups;

#define LAS __attribute__((address_space(3)))
typedef unsigned short bf16_t;
typedef short bf16x8 __attribute__((ext_vector_type(8)));
typedef float f32x4 __attribute__((ext_vector_type(4)));
typedef float f32x16 __attribute__((ext_vector_type(16)));
typedef unsigned u32x4 __attribute__((ext_vector_type(4)));
typedef unsigned u32x2 __attribute__((ext_vector_type(2)));

constexpr int NB = 8, TT = 4096, DM = 1024, CTXL = 256, MLAT = NB * TT, MCTX = NB * CTXL;
constexpr int NE = 16, CAP = 512, DE = 1536, MMOE = NE * NB * CAP;
constexpr int NSEQ = 34;
constexpr int NTHR = 512;
constexpr int LDS_BYTES = 144 * 1024;

constexpr size_t KiB = 1024, MiB = 1024 * 1024;
constexpr size_t WS_ADA = 0;
constexpr size_t WS_POS = 256 * KiB;
constexpr size_t WS_AGG = 512 * KiB;
constexpr size_t WS_WPQ = 5 * MiB;
constexpr size_t WS_WIN = 7 * MiB;
constexpr size_t WS_WFOUR = 15 * MiB;
constexpr size_t WS_WLRU = 16 * MiB;
constexpr size_t WS_WOUT = 18 * MiB;
constexpr size_t WS_WAT = 20 * MiB;
constexpr size_t WS_WIT = 20 * MiB + 512 * KiB;
constexpr size_t WS_SCORES = 21 * MiB;
constexpr size_t WS_IDX = 23 * MiB;
constexpr size_t WS_GATE = 23 * MiB + 256 * KiB;
constexpr size_t WS_SLOT = 23 * MiB + 512 * KiB;
constexpr size_t WS_BAR = 25 * MiB + 512 * KiB;
constexpr size_t WS_D1T = 34 * MiB;
constexpr size_t WS_D2T = 34 * MiB + 512 * KiB;
constexpr size_t WS_HCTX = 26 * MiB;
constexpr size_t WS_ZXC = 30 * MiB;
constexpr size_t WS_R1 = 40 * MiB;
constexpr size_t WS_RPQ = 104 * MiB;
constexpr size_t WS_R2 = 168 * MiB;
constexpr size_t WS_RZ = 232 * MiB;
constexpr size_t WS_END = 488 * MiB;
constexpr size_t WS_HID = WS_RZ, WS_WD = WS_RZ + 192 * MiB, WS_WGU = WS_RPQ, WS_OUTE = WS_R1;
constexpr size_t OUT_YT = 0, OUT_F = 64 * MiB;

struct Params {
    const float *x, *c, *ctx, *c_ctx, *w_ada, *b_ada, *norm1_g, *norm2_g, *w_in, *w_four, *conv_w, *conv_b, *lru_lambda,
        *lru_wa, *lru_ba, *lru_wi, *lru_bi, *w_lru, *w_out, *w_router, *w_gate_e, *w_up_e, *w_down_e, *final_g;
    float* out; unsigned char* ws; int ph_lo, ph_hi;
};

__device__ __forceinline__ int tid_opaque() { int t = threadIdx.x; asm volatile("" : "+v"(t)); return t; }
__device__ __forceinline__ unsigned cvt_pk_bf16(float lo, float hi) { unsigned r; asm volatile("v_cvt_pk_bf16_f32 %0, %1, %2" : "=v"(r) : "v"(lo), "v"(hi)); return r; }
__device__ __forceinline__ float bf_lo(unsigned w) { return __uint_as_float(w << 16); }
__device__ __forceinline__ float bf_hi(unsigned w) { return __uint_as_float(w & 0xffff0000u); }
__device__ __forceinline__ float bf2f(bf16_t h) { return __uint_as_float(((unsigned)h) << 16); }
__device__ __forceinline__ float sigmoidf_(float v) { return __builtin_amdgcn_rcpf(1.0f + __expf(-v)); }
__device__ __forceinline__ float gelu_tanh(float v) { const float y = 1.5957691216f * (v + 0.044715f * v * v * v); return v * sigmoidf_(y); }
__device__ __forceinline__ float wave_sum(float v) {
#pragma unroll
    for (int o = 32; o >= 1; o >>= 1) v += __shfl_xor(v, o);
    return v;
}
__device__ __forceinline__ void unpack8(const u32x4 w, float (&f)[8]) { f[0] = bf_lo(w.x); f[1] = bf_hi(w.x); f[2] = bf_lo(w.y); f[3] = bf_hi(w.y); f[4] = bf_lo(w.z); f[5] = bf_hi(w.z); f[6] = bf_lo(w.w); f[7] = bf_hi(w.w); }

namespace pg8 {
constexpr int BM = 256, BK = 64, HALF = 128, HTB = HALF * BK * 2, STAGE_BYTES = 8 * HTB, NXCD = 8, WGM = 8;
__device__ __forceinline__ int lds_byte(int r, int c) { const int st = (r >> 4) * 2 + (c >> 5), rr = r & 15, cc = c & 31, ob = rr * 64 + cc * 2; return st * 1024 + (ob ^ (((ob >> 9) & 1) << 5)); }
__device__ __forceinline__ void stage_rc(int b, int& R, int& C) { const int st = b / 1024, sb = b % 1024, swz = sb ^ (((sb >> 9) & 1) << 5); R = (st >> 1) * 16 + swz / 64; C = (st & 1) * 32 + (swz % 64) / 2; }
__device__ __forceinline__ int perm32(int rho) { const int n = rho >> 4, i = rho & 15; return 8 * (i >> 2) + 4 * n + (i & 3); }
struct Unit { int pm, pn; };
struct Order {
    int nM, nN, nwg, G, c, base, lim;
    __device__ void init(int nM_, int nN_, int G_, int c_) { nM = nM_; nN = nN_; nwg = nM * nN; G = G_; c = c_; base = 0; lim = 0x7fffffff; }
    __device__ bool next(int i, Unit& u) const {
        const long L = (long)base + (long)i * G + c; if (i >= lim || L >= nwg) return false;
        int wgid = (int)L; { const int q = nwg / NXCD, r = nwg % NXCD, xcd = wgid % NXCD, off = wgid / NXCD; wgid = (xcd < r ? xcd * (q + 1) : r * (q + 1) + (xcd - r) * q) + off; }
        const int nig = WGM * nN, gid = wgid / nig, fm = gid * WGM, gsz = (nM - fm) < WGM ? (nM - fm) : WGM;
        u.pm = fm + ((wgid % nig) % gsz); u.pn = (wgid % nig) / gsz; return true;
    }
};
template <class P, class Epi>
__device__ __forceinline__ void gemm_phase(LAS unsigned char* lds, const P& pr, const Order& S, const Epi& E) {
    const int tid = threadIdx.x, wid = __builtin_amdgcn_readfirstlane(tid >> 6), lane = tid & 63, wr = wid >> 2, wc = wid & 3, fr = lane & 15, fq = lane >> 4;
    const int nt = pr.K / BK;
    int RA[2], CA[2]; unsigned voffB[2];
#pragma unroll
    for (int i = 0; i < 2; ++i) { int R, C; stage_rc(tid * 16 + i * 8192, R, C); RA[i] = R; CA[i] = C; const int Rb = Epi::PERM ? ((R & ~31) + perm32(R & 31)) : R; voffB[i] = (unsigned)(Rb * pr.ldb + C) * 2u; }
    const size_t kstep = (size_t)(BK * 2);
    const size_t hstepB = (size_t)HALF * pr.ldb * 2;
    const unsigned ldsw = (unsigned)wid * 1024u;
    const int aoff = lds_byte(wr * 64 + fr, fq * 8), boff = lds_byte(wc * 32 + fr, fq * 8);
#define PG8_SA(b, h) (((b) * 2 + (h)) * HTB)
#define PG8_SB(b, h) ((4 + (b) * 2 + (h)) * HTB)
#define PG8_STAGE(bufoff, gbase, voff) do { _Pragma("unroll") for (int _i = 0; _i < 2; ++_i) \
        __builtin_amdgcn_global_load_lds((const unsigned*)((const char*)(gbase) + (voff)[_i]), (LAS unsigned*)(lds + (bufoff) + ldsw + _i * 8192), 16, 0, 0); } while (0)
#define PG8_LDA(dst, b, h) do { _Pragma("unroll") for (int m = 0; m < 4; ++m) _Pragma("unroll") for (int k = 0; k < 2; ++k) dst[m][k] = *(const LAS bf16x8*)(lds + PG8_SA(b, h) + aoff + m * 2048 + k * 1024); } while (0)
#define PG8_LDB(dst, b, h) do { _Pragma("unroll") for (int n = 0; n < 2; ++n) _Pragma("unroll") for (int k = 0; k < 2; ++k) dst[n][k] = *(const LAS bf16x8*)(lds + PG8_SB(b, h) + boff + n * 2048 + k * 1024); } while (0)
#define PG8_MMA(ai, bj, At, Bt) do { __builtin_amdgcn_s_setprio(1); _Pragma("unroll") for (int m = 0; m < 4; ++m) _Pragma("unroll") for (int n = 0; n < 2; ++n) _Pragma("unroll") for (int k = 0; k < 2; ++k) \
        acc[ai][bj][m][n] = __builtin_amdgcn_mfma_f32_16x16x32_bf16(Bt[n][k], At[m][k], acc[ai][bj][m][n], 0, 0, 0); __builtin_amdgcn_s_setprio(0); } while (0)
#define PG8_WAIT_V(n) asm volatile("s_waitcnt vmcnt(" #n ")" ::: "memory")
#define PG8_WAIT_L(n) asm volatile("s_waitcnt lgkmcnt(" #n ")" ::: "memory")
#define PG8_BAR __builtin_amdgcn_s_barrier()
#define PG8_SCHED __builtin_amdgcn_sched_barrier(0)
    Unit cur, nxt; int ui = 0;
    if (!S.next(0, cur)) return;
    f32x4 acc[2][2][4][2];
#pragma unroll
    for (int a = 0; a < 2; ++a)
#pragma unroll
        for (int b = 0; b < 2; ++b)
#pragma unroll
            for (int m = 0; m < 4; ++m)
#pragma unroll
                for (int n = 0; n < 2; ++n) acc[a][b][m][n] = (f32x4){0.f, 0.f, 0.f, 0.f};
    bf16x8 At[4][2], B0[2][2], B1[2][2];
    unsigned vA[2][2], vN[2][2];
    pr.avoff(cur, RA, CA, vA);
#pragma unroll
    for (int h = 0; h < 2; ++h)
#pragma unroll
        for (int i = 0; i < 2; ++i) vN[h][i] = vA[h][i];
    const char* cA = pr.abase(cur); const char* cB = pr.bbase(cur);
#define PG8_ROT(u) 0
#define PG8_KT(tt, rot) ((size_t)(((tt) + (rot)) >= nt ? ((tt) + (rot)) - nt : ((tt) + (rot))) * kstep)
    int rot = PG8_ROT(cur);
    { const char* pA = cA + PG8_KT(0, rot); const char* pB = cB + PG8_KT(0, rot);
    PG8_STAGE(PG8_SB(0, 0), pB, voffB); PG8_STAGE(PG8_SA(0, 0), pA, vA[0]); PG8_STAGE(PG8_SB(0, 1), pB + hstepB, voffB); PG8_STAGE(PG8_SA(0, 1), pA, vA[1]);
    if (wr == 1) PG8_BAR;
    PG8_WAIT_V(4); PG8_BAR;
    PG8_STAGE(PG8_SB(1, 0), pB + kstep, voffB); PG8_STAGE(PG8_SA(1, 0), pA + kstep, vA[0]); PG8_STAGE(PG8_SB(1, 1), pB + hstepB + kstep, voffB); }
    PG8_WAIT_V(6); PG8_BAR;
    for (;;) {
        const bool has_next = S.next(ui + 1, nxt);
        const char* nA = has_next ? pr.abase(nxt) : cA; const char* nB = has_next ? pr.bbase(nxt) : cB; const int nrot = has_next ? PG8_ROT(nxt) : rot;
        if (P::GATHER) { if (has_next) pr.avoff(nxt, RA, CA, vN); }
        for (int t = 0; t < nt; t += 2) {
            const bool last = (t == nt - 2);
            const char* a1 = cA + PG8_KT(t + 1, rot);
            const char* a2 = last ? nA + PG8_KT(0, nrot) : cA + PG8_KT(t + 2, rot); const char* b2 = last ? nB + PG8_KT(0, nrot) : cB + PG8_KT(t + 2, rot);
            const char* a3 = a2 + kstep; const char* b3 = b2 + kstep;
            unsigned v2[2][2];
#pragma unroll
            for (int h = 0; h < 2; ++h)
#pragma unroll
                for (int i = 0; i < 2; ++i) v2[h][i] = (P::GATHER && last) ? vN[h][i] : vA[h][i];
            PG8_LDB(B0, 0, 0); PG8_SCHED; PG8_LDA(At, 0, 0); PG8_STAGE(PG8_SA(1, 1), a1, vA[1]);
            PG8_WAIT_L(8); PG8_BAR; PG8_WAIT_L(0); PG8_MMA(0, 0, At, B0); PG8_BAR; PG8_SCHED;
            PG8_LDB(B1, 0, 1); PG8_STAGE(PG8_SB(0, 0), b2, voffB);
            PG8_BAR; PG8_WAIT_L(0); PG8_MMA(0, 1, At, B1); PG8_BAR;
            PG8_LDA(At, 0, 1); PG8_STAGE(PG8_SA(0, 0), a2, v2[0]);
            PG8_BAR; PG8_WAIT_L(0); PG8_MMA(1, 0, At, B0); PG8_BAR; PG8_SCHED;
            PG8_STAGE(PG8_SB(0, 1), b2 + hstepB, voffB);
            PG8_WAIT_V(6); PG8_BAR; PG8_MMA(1, 1, At, B1); PG8_BAR;
            PG8_LDB(B0, 1, 0); PG8_SCHED; PG8_LDA(At, 1, 0); PG8_STAGE(PG8_SA(0, 1), a2, v2[1]);
            PG8_WAIT_L(8); PG8_BAR; PG8_WAIT_L(0); PG8_MMA(0, 0, At, B0); PG8_BAR; PG8_SCHED;
            PG8_LDB(B1, 1, 1); PG8_STAGE(PG8_SB(1, 0), b3, voffB);
            PG8_BAR; PG8_WAIT_L(0); PG8_MMA(0, 1, At, B1); PG8_BAR;
            PG8_LDA(At, 1, 1); PG8_STAGE(PG8_SA(1, 0), a3, v2[0]);
            PG8_BAR; PG8_WAIT_L(0); PG8_MMA(1, 0, At, B0); PG8_BAR; PG8_SCHED;
            PG8_STAGE(PG8_SB(1, 1), b3 + hstepB, voffB);
            PG8_WAIT_V(6); PG8_BAR; PG8_MMA(1, 1, At, B1); PG8_BAR;
            if (P::GATHER && last) {
#pragma unroll
                for (int h = 0; h < 2; ++h)
#pragma unroll
                    for (int i = 0; i < 2; ++i) vA[h][i] = vN[h][i];
            }
        }
        E(acc, cur, wr, wc, fr, fq);
        if (!has_next) break;
#pragma unroll
        for (int a = 0; a < 2; ++a)
#pragma unroll
            for (int b = 0; b < 2; ++b)
#pragma unroll
                for (int m = 0; m < 4; ++m)
#pragma unroll
                    for (int n = 0; n < 2; ++n) acc[a][b][m][n] = (f32x4){0.f, 0.f, 0.f, 0.f};
        cur = nxt; cA = nA; cB = nB; rot = nrot; ++ui;
    }
    PG8_WAIT_V(0);
    if (wr == 0) PG8_BAR;
    PG8_BAR;
#undef PG8_ROT
#undef PG8_KT
#undef PG8_SA
#undef PG8_SB
#undef PG8_STAGE
#undef PG8_LDA
#undef PG8_LDB
#undef PG8_MMA
#undef PG8_WAIT_V
#undef PG8_WAIT_L
#undef PG8_BAR
#undef PG8_SCHED
}
template <class P, class Epi>
__device__ __forceinline__ void gemm_phase2(LAS unsigned char* lds, const P& pr, const Order& S, const Epi& E) {
    const int tid = threadIdx.x, wid = __builtin_amdgcn_readfirstlane(tid >> 6), lane = tid & 63, wr = wid >> 2, wc = wid & 3, fr = lane & 15, fq = lane >> 4;
    const int nt1 = pr.K1 / BK, nt = (pr.K1 + pr.K2) / BK;
    unsigned R2[2], Rb2[2], C2[2];
#pragma unroll
    for (int i = 0; i < 2; ++i) { int R, C; stage_rc(tid * 16 + i * 8192, R, C); const int Rb = Epi::PERM ? ((R & ~31) + perm32(R & 31)) : R; R2[i] = (unsigned)R * 2u; Rb2[i] = (unsigned)Rb * 2u; C2[i] = (unsigned)C * 2u; }
#define OFF_A(ld, h, i) ((R2[i] + (unsigned)((h) * 256)) * (unsigned)(ld) + C2[i])
#define OFF_B(ld, i) (Rb2[i] * (unsigned)(ld) + C2[i])
    const size_t kstep = (size_t)(BK * 2);
    const size_t hB1 = (size_t)HALF * pr.ldb1 * 2, hB2 = (size_t)HALF * pr.ldb2 * 2;
    const unsigned ldsw = (unsigned)wid * 1024u;
    const int aoff = lds_byte(wr * 64 + fr, fq * 8), boff = lds_byte(wc * 32 + fr, fq * 8);
#define PG8_SA(b, h) (((b) * 2 + (h)) * HTB)
#define PG8_SB(b, h) ((4 + (b) * 2 + (h)) * HTB)
#define PG8_STAGE(bufoff, gbase, voff) do { _Pragma("unroll") for (int _i = 0; _i < 2; ++_i) \
        __builtin_amdgcn_global_load_lds((const unsigned*)((const char*)(gbase) + (voff)[_i]), (LAS unsigned*)(lds + (bufoff) + ldsw + _i * 8192), 16, 0, 0); } while (0)
#define PG8_LDA(dst, b, h) do { _Pragma("unroll") for (int m = 0; m < 4; ++m) _Pragma("unroll") for (int k = 0; k < 2; ++k) dst[m][k] = *(const LAS bf16x8*)(lds + PG8_SA(b, h) + aoff + m * 2048 + k * 1024); } while (0)
#define PG8_LDB(dst, b, h) do { _Pragma("unroll") for (int n = 0; n < 2; ++n) _Pragma("unroll") for (int k = 0; k < 2; ++k) dst[n][k] = *(const LAS bf16x8*)(lds + PG8_SB(b, h) + boff + n * 2048 + k * 1024); } while (0)
#define PG8_MMA(ai, bj, At, Bt) do { __builtin_amdgcn_s_setprio(1); _Pragma("unroll") for (int m = 0; m < 4; ++m) _Pragma("unroll") for (int n = 0; n < 2; ++n) _Pragma("unroll") for (int k = 0; k < 2; ++k) \
        acc[ai][bj][m][n] = __builtin_amdgcn_mfma_f32_16x16x32_bf16(Bt[n][k], At[m][k], acc[ai][bj][m][n], 0, 0, 0); __builtin_amdgcn_s_setprio(0); } while (0)
#define PG8_WAIT_V(n) asm volatile("s_waitcnt vmcnt(" #n ")" ::: "memory")
#define PG8_WAIT_L(n) asm volatile("s_waitcnt lgkmcnt(" #n ")" ::: "memory")
#define PG8_BAR __builtin_amdgcn_s_barrier()
#define PG8_SCHED __builtin_amdgcn_sched_barrier(0)
    Unit cur, nxt; int ui = 0;
    if (!S.next(0, cur)) return;
    f32x4 acc[2][2][4][2];
#pragma unroll
    for (int a = 0; a < 2; ++a)
#pragma unroll
        for (int b = 0; b < 2; ++b)
#pragma unroll
            for (int m = 0; m < 4; ++m)
#pragma unroll
                for (int n = 0; n < 2; ++n) acc[a][b][m][n] = (f32x4){0.f, 0.f, 0.f, 0.f};
    bf16x8 At[4][2], B0[2][2], B1[2][2];
    const char* cA1 = pr.abase1(cur); const char* cB1 = pr.bbase1(cur); const char* cA2 = pr.abase2(cur); const char* cB2 = pr.bbase2(cur);
#define T_A(tt) ((tt) < nt1 ? cA1 + (size_t)(tt) * kstep : cA2 + (size_t)((tt) - nt1) * kstep)
#define T_B(tt) ((tt) < nt1 ? cB1 + (size_t)(tt) * kstep : cB2 + (size_t)((tt) - nt1) * kstep)
    { unsigned vb[2] = {OFF_B(pr.ldb1, 0), OFF_B(pr.ldb1, 1)}, va0[2] = {OFF_A(pr.lda1, 0, 0), OFF_A(pr.lda1, 0, 1)}, va1[2] = {OFF_A(pr.lda1, 1, 0), OFF_A(pr.lda1, 1, 1)};
    PG8_STAGE(PG8_SB(0, 0), cB1, vb); PG8_STAGE(PG8_SA(0, 0), cA1, va0); PG8_STAGE(PG8_SB(0, 1), cB1 + hB1, vb); PG8_STAGE(PG8_SA(0, 1), cA1, va1);
    if (wr == 1) PG8_BAR;
    PG8_WAIT_V(4); PG8_BAR;
    PG8_STAGE(PG8_SB(1, 0), cB1 + kstep, vb); PG8_STAGE(PG8_SA(1, 0), cA1 + kstep, va0); PG8_STAGE(PG8_SB(1, 1), cB1 + hB1 + kstep, vb); }
    PG8_WAIT_V(6); PG8_BAR;
    for (;;) {
        const bool has_next = S.next(ui + 1, nxt);
        const char* nA = has_next ? pr.abase1(nxt) : cA1; const char* nB = has_next ? pr.bbase1(nxt) : cB1;
        for (int t = 0; t < nt; t += 2) {
            const bool last = (t == nt - 2);
            const bool s1 = (t + 1 < nt1), s2 = last || (t + 2 < nt1);
            const char* a1 = T_A(t + 1);
            const char* a2 = last ? nA : T_A(t + 2); const char* b2 = last ? nB : T_B(t + 2);
            const char* a3 = a2 + kstep; const char* b3 = b2 + kstep;
            const size_t hstepB = s2 ? hB1 : hB2; const int ldaT1 = s1 ? pr.lda1 : pr.lda2, ldaT2 = s2 ? pr.lda1 : pr.lda2, ldbT2 = s2 ? pr.ldb1 : pr.ldb2;
            unsigned v2[2][2], voffB[2], vA1s[2];
#pragma unroll
            for (int i = 0; i < 2; ++i) { voffB[i] = OFF_B(ldbT2, i); vA1s[i] = OFF_A(ldaT1, 1, i);
#pragma unroll
                for (int h = 0; h < 2; ++h) v2[h][i] = OFF_A(ldaT2, h, i); }
            PG8_LDB(B0, 0, 0); PG8_SCHED; PG8_LDA(At, 0, 0); PG8_STAGE(PG8_SA(1, 1), a1, vA1s);
            PG8_WAIT_L(8); PG8_BAR; PG8_WAIT_L(0); PG8_MMA(0, 0, At, B0); PG8_BAR; PG8_SCHED;
            PG8_LDB(B1, 0, 1); PG8_STAGE(PG8_SB(0, 0), b2, voffB);
            PG8_BAR; PG8_WAIT_L(0); PG8_MMA(0, 1, At, B1); PG8_BAR;
            PG8_LDA(At, 0, 1); PG8_STAGE(PG8_SA(0, 0), a2, v2[0]);
            PG8_BAR; PG8_WAIT_L(0); PG8_MMA(1, 0, At, B0); PG8_BAR; PG8_SCHED;
            PG8_STAGE(PG8_SB(0, 1), b2 + hstepB, voffB);
            PG8_WAIT_V(6); PG8_BAR; PG8_MMA(1, 1, At, B1); PG8_BAR;
            PG8_LDB(B0, 1, 0); PG8_SCHED; PG8_LDA(At, 1, 0); PG8_STAGE(PG8_SA(0, 1), a2, v2[1]);
            PG8_WAIT_L(8); PG8_BAR; PG8_WAIT_L(0); PG8_MMA(0, 0, At, B0); PG8_BAR; PG8_SCHED;
            PG8_LDB(B1, 1, 1); PG8_STAGE(PG8_SB(1, 0), b3, voffB);
            PG8_BAR; PG8_WAIT_L(0); PG8_MMA(0, 1, At, B1); PG8_BAR;
            PG8_LDA(At, 1, 1); PG8_STAGE(PG8_SA(1, 0), a3, v2[0]);
            PG8_BAR; PG8_WAIT_L(0); PG8_MMA(1, 0, At, B0); PG8_BAR; PG8_SCHED;
            PG8_STAGE(PG8_SB(1, 1), b3 + hstepB, voffB);
            PG8_WAIT_V(6); PG8_BAR; PG8_MMA(1, 1, At, B1); PG8_BAR;
            if (t == nt1 - 2) E.mid(acc, cur, wr, wc, fr, fq);
        }
        E(acc, cur, wr, wc, fr, fq);
        if (!has_next) break;
#pragma unroll
        for (int a = 0; a < 2; ++a)
#pragma unroll
            for (int b = 0; b < 2; ++b)
#pragma unroll
                for (int m = 0; m < 4; ++m)
#pragma unroll
                    for (int n = 0; n < 2; ++n) acc[a][b][m][n] = (f32x4){0.f, 0.f, 0.f, 0.f};
        cur = nxt; cA1 = nA; cB1 = nB; cA2 = pr.abase2(cur); cB2 = pr.bbase2(cur); ++ui;
    }
    PG8_WAIT_V(0);
    if (wr == 0) PG8_BAR;
    PG8_BAR;
#undef T_A
#undef T_B
#undef OFF_A
#undef OFF_B
#undef PG8_SA
#undef PG8_SB
#undef PG8_STAGE
#undef PG8_LDA
#undef PG8_LDB
#undef PG8_MMA
#undef PG8_WAIT_V
#undef PG8_WAIT_L
#undef PG8_BAR
#undef PG8_SCHED
}
}
using pg8::Unit;

struct ProbPlain {
    static constexpr bool GATHER = false;
    const bf16_t* A; const bf16_t* B; int K, lda, ldb;
    __device__ __forceinline__ const char* abase(const Unit& u) const { return (const char*)(A + (size_t)u.pm * 256 * lda); }
    __device__ __forceinline__ const char* bbase(const Unit& u) const { return (const char*)(B + (size_t)u.pn * 256 * ldb); }
    __device__ __forceinline__ void avoff(const Unit&, const int (&RA)[2], const int (&CA)[2], unsigned (&v)[2][2]) const {
#pragma unroll
        for (int h = 0; h < 2; ++h)
#pragma unroll
            for (int i = 0; i < 2; ++i) v[h][i] = (unsigned)((h * 128 + RA[i]) * lda + CA[i]) * 2u;
    }
};
struct ProbMerge {
    const bf16_t* A1; const bf16_t* B1; const bf16_t* A2; const bf16_t* B2; int K1, K2, lda1, ldb1, lda2, ldb2;
    __device__ __forceinline__ const char* abase1(const Unit& u) const { return (const char*)(A1 + (size_t)u.pm * 256 * lda1); }
    __device__ __forceinline__ const char* bbase1(const Unit& u) const { return (const char*)(B1 + (size_t)u.pn * 256 * ldb1); }
    __device__ __forceinline__ const char* abase2(const Unit& u) const { return (const char*)(A2 + (size_t)u.pm * 256 * lda2); }
    __device__ __forceinline__ const char* bbase2(const Unit& u) const { return (const char*)(B2 + (size_t)u.pn * 256 * ldb2); }
};
struct ProbPQ {
    static constexpr bool GATHER = false;
    const bf16_t* A; const bf16_t* B; int K, lda, ldb;
    __device__ __forceinline__ const char* abase(const Unit& u) const { return (const char*)(A + (size_t)u.pm * 256 * lda); }
    __device__ __forceinline__ const char* bbase(const Unit& u) const { return (const char*)(B + ((size_t)(u.pn >> 4) * 4096 + (u.pn & 15)) * 1024); }
    __device__ __forceinline__ void avoff(const Unit&, const int (&RA)[2], const int (&CA)[2], unsigned (&v)[2][2]) const {
#pragma unroll
        for (int h = 0; h < 2; ++h)
#pragma unroll
            for (int i = 0; i < 2; ++i) v[h][i] = (unsigned)((h * 128 + RA[i]) * lda + CA[i]) * 2u;
    }
};
struct ProbMoeUp {
    static constexpr bool GATHER = true;
    const bf16_t* A; const bf16_t* B; const int* idx; int K, lda, ldb;
    __device__ __forceinline__ const char* abase(const Unit&) const { return (const char*)A; }
    __device__ __forceinline__ const char* bbase(const Unit& u) const { return (const char*)(B + ((size_t)(u.pm >> 4) * 3072 + (size_t)u.pn * 256) * ldb); }
    __device__ __forceinline__ void avoff(const Unit& u, const int (&RA)[2], const int (&CA)[2], unsigned (&v)[2][2]) const {
#pragma unroll
        for (int h = 0; h < 2; ++h)
#pragma unroll
            for (int i = 0; i < 2; ++i) { const int g = idx[u.pm * 256 + h * 128 + RA[i]]; v[h][i] = (unsigned)(g * lda + CA[i]) * 2u; }
    }
};
struct ProbMoeDown {
    static constexpr bool GATHER = false;
    const bf16_t* A; const bf16_t* B; int K, lda, ldb;
    __device__ __forceinline__ const char* abase(const Unit& u) const { return (const char*)(A + (size_t)u.pm * 256 * lda); }
    __device__ __forceinline__ const char* bbase(const Unit& u) const { return (const char*)(B + ((size_t)(u.pm >> 4) * 1024 + (size_t)u.pn * 256) * ldb); }
    __device__ __forceinline__ void avoff(const Unit&, const int (&RA)[2], const int (&CA)[2], unsigned (&v)[2][2]) const {
#pragma unroll
        for (int h = 0; h < 2; ++h)
#pragma unroll
            for (int i = 0; i < 2; ++i) v[h][i] = (unsigned)((h * 128 + RA[i]) * lda + CA[i]) * 2u;
    }
};

#define EPI_ROWS(...) _Pragma("unroll") for (int ai = 0; ai < 2; ++ai) _Pragma("unroll") for (int m = 0; m < 4; ++m) { const int row = u.pm * 256 + ai * 128 + wr * 64 + m * 16 + fr; __VA_ARGS__ }
__device__ __forceinline__ u32x4 pack8(const f32x4 v0, const f32x4 v1) { u32x4 w; w.x = cvt_pk_bf16(v0[0], v0[1]); w.y = cvt_pk_bf16(v0[2], v0[3]); w.z = cvt_pk_bf16(v1[0], v1[1]); w.w = cvt_pk_bf16(v1[2], v1[3]); return w; }

struct EpiPQ {
    static constexpr bool PERM = true; bf16_t* O;
    __device__ __forceinline__ void operator()(const f32x4 (&acc)[2][2][4][2], const Unit& u, int wr, int wc, int fr, int fq) const {
        const int t10 = wc * 32 + 8 * fq, b = u.pn >> 4, t2 = u.pn & 15;
        EPI_ROWS(
            bf16_t* rp = O + ((size_t)((b * 512 + (row >> 1)) * 16 + t2) * 512 + (row & 1) * 256 + t10);
            _Pragma("unroll") for (int bj = 0; bj < 2; ++bj) *(u32x4*)(rp + bj * 128) = pack8(acc[ai][bj][m][0], acc[ai][bj][m][1]);
        )
    }
};
struct EpiPlain {
    static constexpr bool PERM = true; bf16_t* O; size_t ldc;
    __device__ __forceinline__ void operator()(const f32x4 (&acc)[2][2][4][2], const Unit& u, int wr, int wc, int fr, int fq) const {
        const int col0 = u.pn * 256 + wc * 32 + 8 * fq;
        EPI_ROWS(
            bf16_t* rp = O + (size_t)row * ldc + col0;
            _Pragma("unroll") for (int bj = 0; bj < 2; ++bj) *(u32x4*)(rp + bj * 128) = pack8(acc[ai][bj][m][0], acc[ai][bj][m][1]);
        )
    }
};
struct EpiZ {
    static constexpr bool PERM = true; bf16_t* O; int ldc; int fixed_act;
    __device__ __forceinline__ void operator()(const f32x4 (&acc)[2][2][4][2], const Unit& u, int wr, int wc, int fr, int fq) const {
        const int col0 = u.pn * 256 + wc * 32 + 8 * fq; const int act = fixed_act >= 0 ? fixed_act : (u.pn >> 2);
        EPI_ROWS(
            bf16_t* rp = O + (size_t)row * ldc + col0;
            _Pragma("unroll") for (int bj = 0; bj < 2; ++bj) {
                f32x4 v0 = acc[ai][bj][m][0], v1 = acc[ai][bj][m][1];
                if (act == 1) { _Pragma("unroll") for (int j = 0; j < 4; ++j) { v0[j] = gelu_tanh(v0[j]); v1[j] = gelu_tanh(v1[j]); } }
                else if (act >= 2) { _Pragma("unroll") for (int j = 0; j < 4; ++j) { v0[j] = sigmoidf_(v0[j]); v1[j] = sigmoidf_(v1[j]); } }
                *(u32x4*)(rp + bj * 128) = pack8(v0, v1); }
        )
    }
};
struct EpiMerge {
    static constexpr bool PERM = true; bf16_t* O; const bf16_t* Z;
    __device__ __forceinline__ void mid(f32x4 (&acc)[2][2][4][2], const Unit& u, int wr, int wc, int fr, int fq) const {
        unsigned eo = (unsigned)((u.pm * 256 + wr * 64 + fr) * 4096 + 2048 + u.pn * 256 + wc * 32 + 8 * fq);
        asm volatile("" : "+v"(eo));
#pragma unroll
        for (int ai = 0; ai < 2; ++ai) {
            u32x4 wa[4][2], wb[4][2];
#pragma unroll
            for (int m = 0; m < 4; ++m)
#pragma unroll
                for (int bj = 0; bj < 2; ++bj) { const unsigned o = eo + (unsigned)((ai * 128 + m * 16) * 4096 + bj * 128); wa[m][bj] = *(const u32x4*)(Z + o); wb[m][bj] = *(const u32x4*)(Z + o + 1024); }
#pragma unroll
            for (int m = 0; m < 4; ++m)
#pragma unroll
                for (int bj = 0; bj < 2; ++bj) { float ga[8], gb[8]; unpack8(wa[m][bj], ga); unpack8(wb[m][bj], gb);
#pragma unroll
                    for (int j = 0; j < 4; ++j) { acc[ai][bj][m][0][j] *= ga[j] * __builtin_amdgcn_rcpf(fmaxf(gb[j], 1e-30f)); acc[ai][bj][m][1][j] *= ga[4 + j] * __builtin_amdgcn_rcpf(fmaxf(gb[4 + j], 1e-30f)); } }
            __builtin_amdgcn_sched_barrier(0); }
    }
    __device__ __forceinline__ void operator()(const f32x4 (&acc)[2][2][4][2], const Unit& u, int wr, int wc, int fr, int fq) const {
        unsigned eo = (unsigned)((u.pm * 256 + wr * 64 + fr) * 4096 + 3072 + u.pn * 256 + wc * 32 + 8 * fq); asm volatile("" : "+v"(eo));
        unsigned oo = (unsigned)((u.pm * 256 + wr * 64 + fr) * 1024 + u.pn * 256 + wc * 32 + 8 * fq); asm volatile("" : "+v"(oo));
        u32x4 wb[2][4][2];
#pragma unroll
        for (int ai = 0; ai < 2; ++ai)
#pragma unroll
            for (int m = 0; m < 4; ++m)
#pragma unroll
                for (int bj = 0; bj < 2; ++bj) wb[ai][m][bj] = *(const u32x4*)(Z + eo + (unsigned)((ai * 128 + m * 16) * 4096 + bj * 128));
#pragma unroll
        for (int ai = 0; ai < 2; ++ai)
#pragma unroll
            for (int m = 0; m < 4; ++m)
#pragma unroll
                for (int bj = 0; bj < 2; ++bj) { float g[8]; unpack8(wb[ai][m][bj], g);
                    f32x4 v0 = acc[ai][bj][m][0], v1 = acc[ai][bj][m][1];
#pragma unroll
                    for (int j = 0; j < 4; ++j) { v0[j] *= g[j]; v1[j] *= g[4 + j]; }
                    *(u32x4*)(O + oo + (unsigned)((ai * 128 + m * 16) * 1024 + bj * 128)) = pack8(v0, v1); }
    }
};
struct EpiOut {
    static constexpr bool PERM = false; float* O; const float* X; const float* pos; const float* ada;
    __device__ __forceinline__ void operator()(const f32x4 (&acc)[2][2][4][2], const Unit& u, int wr, int wc, int fr, int fq) const {
        const int col0 = u.pn * 256 + wc * 32 + 4 * fq; const int b = u.pm >> 4;
#ifdef TS_A
        unsigned long long* tsx = (unsigned long long*)(ada) + (WS_BAR + 40 * KiB - WS_ADA) / 8; unsigned ecall = 0;
        if (blockIdx.x == 0 && threadIdx.x == 0) { ecall = (unsigned)tsx[15]; tsx[15] = ecall + 1; tsx[40 + 2 * ecall] = __builtin_amdgcn_s_memrealtime(); }
#endif
        unsigned ro = (unsigned)((u.pm * 256 + wr * 64 + fr) * 1024 + col0); asm volatile("" : "+v"(ro));
#pragma unroll
        for (int ai = 0; ai < 2; ++ai) {
            f32x4 xv[4][2][2];
#pragma unroll
            for (int m = 0; m < 4; ++m)
#pragma unroll
                for (int bj = 0; bj < 2; ++bj)
#pragma unroll
                    for (int n = 0; n < 2; ++n) xv[m][bj][n] = *(const f32x4*)(X + ro + (unsigned)((ai * 128 + m * 16) * 1024 + bj * 128 + n * 16));
#pragma unroll
            for (int m = 0; m < 4; ++m) { const int row = u.pm * 256 + ai * 128 + wr * 64 + m * 16 + fr; const int t = row & 4095;
#pragma unroll
                for (int bj = 0; bj < 2; ++bj)
#pragma unroll
                    for (int n = 0; n < 2; ++n) { const int col = col0 + bj * 128 + n * 16;
                        const f32x4 pv = *(const f32x4*)(pos + (col < 512 ? (t >> 6) * 512 + col : (t & 63) * 512 + (col - 512)));
                        const f32x4 gv = *(const f32x4*)(ada + b * 6144 + 2048 + col);
                        *(f32x4*)(O + ro + (unsigned)((ai * 128 + m * 16) * 1024 + bj * 128 + n * 16)) = xv[m][bj][n] + pv + gv * acc[ai][bj][m][n]; } }
            __builtin_amdgcn_sched_barrier(0); }
#ifdef TS_A
        asm volatile("s_waitcnt vmcnt(0)" ::: "memory");
        if (blockIdx.x == 0 && threadIdx.x == 0) tsx[41 + 2 * ecall] = __builtin_amdgcn_s_memrealtime();
#endif
    }
};
struct EpiGU {
    static constexpr bool PERM = true; bf16_t* O;
    __device__ __forceinline__ void operator()(const f32x4 (&acc)[2][2][4][2], const Unit& u, int wr, int wc, int fr, int fq) const {
        const int col0 = u.pn * 128 + wc * 32 + 8 * fq;
        EPI_ROWS(
            f32x4 v0, v1;
            _Pragma("unroll") for (int j = 0; j < 4; ++j) { const float g0 = acc[ai][0][m][0][j], g1 = acc[ai][0][m][1][j];
                v0[j] = g0 * sigmoidf_(g0) * acc[ai][1][m][0][j]; v1[j] = g1 * sigmoidf_(g1) * acc[ai][1][m][1][j]; }
            *(u32x4*)(O + (size_t)row * DE + col0) = pack8(v0, v1);
        )
    }
};
struct EpiDown {
    static constexpr bool PERM = true; bf16_t* O; const float* gate;
    __device__ __forceinline__ void operator()(const f32x4 (&acc)[2][2][4][2], const Unit& u, int wr, int wc, int fr, int fq) const {
        const int col0 = u.pn * 256 + wc * 32 + 8 * fq;
        EPI_ROWS(
            const float g = gate[row];
            _Pragma("unroll") for (int bj = 0; bj < 2; ++bj) *(u32x4*)(O + (size_t)row * 1024 + col0 + bj * 128) = pack8(acc[ai][bj][m][0] * g, acc[ai][bj][m][1] * g);
        )
    }
};

__device__ void p0_ada(const Params& p, LAS unsigned char* lds, int item) {
    const int tid = threadIdx.x;
    LAS float* s = (LAS float*)lds; LAS float* red = s + 9 * 1024;
    for (int i = tid; i < 9 * 1024; i += NTHR) { const int r = i >> 10, d = i & 1023; const float v = r < 8 ? p.c[r * 1024 + d] : p.c_ctx[d]; s[i] = v / (1.0f + expf(-v)); }
    __syncthreads();
    const int col = tid & 63, ds = tid >> 6; float a[9];
#pragma unroll
    for (int r = 0; r < 9; ++r) a[r] = 0.f;
    const float* w = p.w_ada + (size_t)(ds * 128) * 6144 + item * 64 + col;
    for (int d0 = 0; d0 < 128; d0 += 32) { float wv[32];
#pragma unroll
        for (int j = 0; j < 32; ++j) wv[j] = w[(size_t)(d0 + j) * 6144];
#pragma unroll
        for (int j = 0; j < 32; ++j)
#pragma unroll
            for (int r = 0; r < 9; ++r) a[r] += s[r * 1024 + ds * 128 + d0 + j] * wv[j]; }
#pragma unroll
    for (int r = 0; r < 9; ++r) red[(ds * 9 + r) * 64 + col] = a[r];
    __syncthreads();
    float* ada = (float*)(p.ws + WS_ADA);
    for (int i = tid; i < 9 * 64; i += NTHR) { const int r = i >> 6, cc = i & 63; float v = 0.f;
#pragma unroll
        for (int k = 0; k < 8; ++k) v += red[(k * 9 + r) * 64 + cc];
        ada[r * 6144 + item * 64 + cc] = v + p.b_ada[item * 64 + cc]; }
    __syncthreads();
}
template <int NS>
__device__ __forceinline__ void xpose_item(const float* src, int ldsrc, bf16_t* dst, int lddst, int k0, int n0, int mode) {
    const int tid = threadIdx.x, nl = tid & 63, k8 = tid >> 6;
    float v[NS][8];
#pragma unroll
    for (int s = 0; s < NS; ++s)
#pragma unroll
        for (int j = 0; j < 8; ++j) v[s][j] = src[(size_t)(k0 + 8 * k8 + j) * ldsrc + n0 + 64 * s + nl];
#pragma unroll
    for (int s = 0; s < NS; ++s) { const int n = n0 + 64 * s + nl; int row = n;
        if (mode) row = (n >> 7) * 256 + (n & 127) + (mode == 2 ? 128 : 0);
        u32x4 w; w.x = cvt_pk_bf16(v[s][0], v[s][1]); w.y = cvt_pk_bf16(v[s][2], v[s][3]); w.z = cvt_pk_bf16(v[s][4], v[s][5]); w.w = cvt_pk_bf16(v[s][6], v[s][7]);
        *(u32x4*)(dst + (size_t)row * lddst + k0 + 8 * k8) = w; }
}
__device__ void p0_wpq(const Params& p, LAS unsigned char* lds, int item) {
    const int tid = threadIdx.x, g = item >> 6, db = item & 63;
    LAS float* wl = (LAS float*)lds; LAS float* ct = wl + 16 * 129;
    for (int i = tid; i < 16 * 128; i += NTHR) { const int d = i >> 7, cc = i & 127; wl[d * 129 + cc] = p.w_in[(size_t)(db * 16 + d) * 4608 + g * 128 + cc]; }
    if (tid < 128) { float sn, cs; sincospif((float)tid * (1.0f / 64.0f), &sn, &cs); ct[tid] = cs; ct[128 + tid] = sn; }
    __syncthreads();
    const int q = tid & 255, kc = q >> 1, pq = q & 1, dh = tid >> 8; const int n = (g * 128 + kc) * 2 + pq;
    bf16_t* dst = (bf16_t*)(p.ws + WS_WPQ) + (size_t)n * 1024 + db * 16 + dh * 8;
    const float scale = 0.001381067932f;
    float a[8];
#pragma unroll
    for (int j = 0; j < 8; ++j) a[j] = 0.f;
    for (int cc = 0; cc < 128; ++cc) { const float tv = ct[pq * 128 + ((cc * kc) & 127)];
#pragma unroll
        for (int j = 0; j < 8; ++j) a[j] += wl[(dh * 8 + j) * 129 + cc] * tv; }
    u32x4 w; w.x = cvt_pk_bf16(a[0] * scale, a[1] * scale); w.y = cvt_pk_bf16(a[2] * scale, a[3] * scale); w.z = cvt_pk_bf16(a[4] * scale, a[5] * scale); w.w = cvt_pk_bf16(a[6] * scale, a[7] * scale);
    *(u32x4*)dst = w;
    __syncthreads();
}
__device__ void p0_d1t(const Params& p, int item) {
    bf16_t* dst = (bf16_t*)(p.ws + WS_D1T);
    const int row = item * 64 + (threadIdx.x >> 3), k1 = row >> 1, ri = row & 1, c0 = (threadIdx.x & 7) * 64;
    for (int c8 = 0; c8 < 64; c8 += 8) { float v[8];
#pragma unroll
        for (int j = 0; j < 8; ++j) { const int col = c0 + c8 + j, pq = col >> 8, t1 = col & 255; float sn, cs; sincospif((float)((k1 * t1) & 255) * (1.0f / 128.0f), &sn, &cs);
            v[j] = (ri == 0) ? (pq == 0 ? cs : -sn) : (pq == 0 ? -sn : -cs); }
        u32x4 w; w.x = cvt_pk_bf16(v[0], v[1]); w.y = cvt_pk_bf16(v[2], v[3]); w.z = cvt_pk_bf16(v[4], v[5]); w.w = cvt_pk_bf16(v[6], v[7]);
        *(u32x4*)(dst + (size_t)row * 512 + c0 + c8) = w; }
}
__device__ void p0_d2t(const Params& p, int item) {
    bf16_t* dst = (bf16_t*)(p.ws + WS_D2T);
#pragma unroll
    for (int ps = 0; ps < 4; ++ps) { const int pc = (item * 4 + ps) * NTHR + threadIdx.x, tp = pc >> 2, kk0 = (pc & 3) * 8; float v[8];
#pragma unroll
        for (int j = 0; j < 8; ++j) { const int kk = kk0 + j, ri = kk >> 4, t2 = kk & 15; float sn, cs; sincospif((float)((tp * t2) & 4095) * (1.0f / 2048.0f), &sn, &cs); v[j] = ri ? sn : cs; }
        u32x4 w; w.x = cvt_pk_bf16(v[0], v[1]); w.y = cvt_pk_bf16(v[2], v[3]); w.z = cvt_pk_bf16(v[4], v[5]); w.w = cvt_pk_bf16(v[6], v[7]);
        *(u32x4*)(dst + (size_t)tp * 32 + kk0) = w; }
}
__device__ void p0_pos(const Params& p) {
    float* tab = (float*)(p.ws + WS_POS);
    for (int i = threadIdx.x; i < 64 * 512; i += NTHR) { const int ii = i >> 9, j = i & 511, jj = j & 255; const float f = expf(-9.210340371976184f * (float)jj / 256.0f); const float a = (float)ii * f; tab[i] = j < 256 ? sinf(a) : cosf(a); }
}
__device__ void phase0(const Params& p, LAS unsigned char* lds) {
    constexpr int N_ADA = 96, N_WIN = 16 * 16, N_WFOUR = 8 * 4, N_SQ = 16 * 4, N_LRU = 16 * 2, N_WPQ = 256, N_DFT = 8 + 8, N_POS = 1;
    constexpr int O1 = N_ADA, O2 = O1 + N_WIN, O3 = O2 + N_WFOUR, O4 = O3 + N_SQ, O5 = O4 + N_SQ, O6 = O5 + N_LRU, O7 = O6 + N_LRU, O8 = O7 + N_WPQ, O9 = O8 + N_DFT, O10 = O9 + N_POS;
    for (int it = blockIdx.x; it < O10; it += gridDim.x) {
        if (it < O1) p0_ada(p, lds, it);
        else if (it < O2) { const int j = it - O1; xpose_item<4>(p.w_in + 512, 4608, (bf16_t*)(p.ws + WS_WIN), 1024, (j >> 4) * 64, (j & 15) * 256, 0); }
        else if (it < O3) { const int j = it - O2; xpose_item<4>(p.w_four, 1024, (bf16_t*)(p.ws + WS_WFOUR), 512, (j >> 2) * 64, (j & 3) * 256, 0); }
        else if (it < O4) { const int j = it - O3; xpose_item<4>(p.w_lru, 1024, (bf16_t*)(p.ws + WS_WLRU), 1024, (j >> 2) * 64, (j & 3) * 256, 0); }
        else if (it < O5) { const int j = it - O4; xpose_item<4>(p.w_out, 1024, (bf16_t*)(p.ws + WS_WOUT), 1024, (j >> 2) * 64, (j & 3) * 256, 0); }
        else if (it < O6) { const int j = it - O5, mtx = j >> 1; xpose_item<2>(p.lru_wa + (size_t)mtx * 16384, 128, (bf16_t*)(p.ws + WS_WAT) + (size_t)mtx * 16384, 128, (j & 1) * 64, 0, 0); }
        else if (it < O7) { const int j = it - O6, mtx = j >> 1; xpose_item<2>(p.lru_wi + (size_t)mtx * 16384, 128, (bf16_t*)(p.ws + WS_WIT) + (size_t)mtx * 16384, 128, (j & 1) * 64, 0, 0); }
        else if (it < O8) p0_wpq(p, lds, it - O7);
        else if (it < O9) { if (it - O8 < 8) p0_d1t(p, it - O8); else p0_d2t(p, it - O8 - 8); }
        else p0_pos(p);
    }
}

__device__ void phase1(const Params& p) {
    const int lane = threadIdx.x & 63, wid = threadIdx.x >> 6;
    const float* ada = (const float*)(p.ws + WS_ADA); const float* tab = (const float*)(p.ws + WS_POS);
    bf16_t* h1 = (bf16_t*)(p.ws + WS_R1); bf16_t* hc = (bf16_t*)(p.ws + WS_HCTX);
    const int NR = MLAT + MCTX;
    for (int row0 = (blockIdx.x * 8 + wid) * 2; row0 < NR; row0 += gridDim.x * 16) {
        f32x4 v[2][4]; float ss[2];
#pragma unroll
        for (int r = 0; r < 2; ++r) { const int row = row0 + r; const bool lat = row < MLAT; const float* xr = lat ? p.x + (size_t)row * 1024 : p.ctx + (size_t)(row - MLAT) * 1024;
#pragma unroll
            for (int i = 0; i < 4; ++i) v[r][i] = *(const f32x4*)(xr + 256 * i + 4 * lane); }
#pragma unroll
        for (int r = 0; r < 2; ++r) { const int row = row0 + r; const bool lat = row < MLAT; const int t = row & 4095; float a = 0.f;
#pragma unroll
            for (int i = 0; i < 4; ++i) { const int d = 256 * i + 4 * lane;
                if (lat) v[r][i] += *(const f32x4*)(tab + (i < 2 ? (t >> 6) * 512 + d : (t & 63) * 512 + d - 512));
                a += v[r][i][0] * v[r][i][0] + v[r][i][1] * v[r][i][1] + v[r][i][2] * v[r][i][2] + v[r][i][3] * v[r][i][3]; }
            ss[r] = a; }
#pragma unroll
        for (int o = 32; o >= 1; o >>= 1) { ss[0] += __shfl_xor(ss[0], o); ss[1] += __shfl_xor(ss[1], o); }
#pragma unroll
        for (int r = 0; r < 2; ++r) { const int row = row0 + r; const bool lat = row < MLAT; const int mrow = lat ? (row >> 12) : 8;
            const float rs = rsqrtf(ss[r] * (1.0f / 1024.0f) + 1e-6f);
            bf16_t* dst = lat ? h1 + (size_t)row * 1024 : hc + (size_t)(row - MLAT) * 1024;
#pragma unroll
            for (int i = 0; i < 4; ++i) { const int d = 256 * i + 4 * lane;
                const f32x4 g = *(const f32x4*)(p.norm1_g + d), sh = *(const f32x4*)(ada + mrow * 6144 + d), sc = *(const f32x4*)(ada + mrow * 6144 + 1024 + d);
                const f32x4 h = v[r][i] * rs * g * (sc + 1.0f) + sh;
                u32x2 w; w.x = cvt_pk_bf16(h[0], h[1]); w.y = cvt_pk_bf16(h[2], h[3]); *(u32x2*)(dst + d) = w; } }
    }
}

#define LRU_CST(mb, r) (32 * (mb) + 8 * ((r) >> 2) + ((r) & 3))
template <bool FINAL, int DIR>
__device__ __forceinline__ void lru_wave(const Params& p, LAS unsigned char* ul, int b, int sc, int head, int cb, int lane, f32x16 (&accI)[4]) {
    constexpr int SG = DIR ? -1 : 1;
    const int lr = lane & 31, lh = lane >> 5;
    const int chl = cb * 32 + lr, ch = head * 128 + chl;
    const int tbase = DIR ? 127 - 4 * lh : 4 * lh;
    f32x16 accA[4];
#pragma unroll
    for (int mb = 0; mb < 4; ++mb)
#pragma unroll
        for (int r = 0; r < 16; ++r) { accA[mb][r] = 0.f; accI[mb][r] = 0.f; }
    {
        const bf16_t* wa = (const bf16_t*)(p.ws + WS_WAT) + ((size_t)(DIR * 8 + head) * 128 + chl) * 128 + 8 * lh;
        const bf16_t* wi = (const bf16_t*)(p.ws + WS_WIT) + ((size_t)(DIR * 8 + head) * 128 + chl) * 128 + 8 * lh;
        LAS unsigned char* arow0 = ul + (DIR ? 127 - lr : lr) * 272 + lh * 16;
#pragma unroll
        for (int kc = 0; kc < 2; ++kc) { bf16x8 bA[4], bI[4];
#pragma unroll
            for (int k4 = 0; k4 < 4; ++k4) { bA[k4] = *(const bf16x8*)(wa + 16 * (kc * 4 + k4)); bI[k4] = *(const bf16x8*)(wi + 16 * (kc * 4 + k4)); }
#pragma unroll
            for (int mb = 0; mb < 4; ++mb)
#pragma unroll
                for (int k4 = 0; k4 < 4; ++k4) { const bf16x8 af = *(const LAS bf16x8*)(arow0 + SG * 32 * mb * 272 + 32 * (kc * 4 + k4));
                    accA[mb] = __builtin_amdgcn_mfma_f32_32x32x16_bf16(af, bA[k4], accA[mb], 0, 0, 0);
                    accI[mb] = __builtin_amdgcn_mfma_f32_32x32x16_bf16(af, bI[k4], accI[mb], 0, 0, 0); }
            __builtin_amdgcn_sched_barrier(0); }
    }
    {
        const float lam = p.lru_lambda[DIR * 1024 + ch]; const float sp8 = 8.0f * log1pf(expf(-lam));
        const float ba = p.lru_ba[DIR * 1024 + ch], bi = p.lru_bi[DIR * 1024 + ch];
        LAS unsigned char* up = ul + tbase * 272 + chl * 2;
#pragma unroll
        for (int mb = 0; mb < 4; ++mb) {
#pragma unroll
            for (int r = 0; r < 16; ++r) {
                const float uv = bf2f(*(const LAS bf16_t*)(up + SG * LRU_CST(mb, r) * 272));
                const float rg = sigmoidf_(accA[mb][r] + ba), ig = sigmoidf_(accI[mb][r] + bi);
                const float a = __expf(-sp8 * rg); accA[mb][r] = a; accI[mb][r] = __builtin_amdgcn_sqrtf(fmaxf(1.0f - a * a, 0.f)) * ig * uv; }
            __builtin_amdgcn_sched_barrier(0); }
    }
    float rA[16], rH[16];
#pragma unroll
    for (int mb = 0; mb < 4; ++mb)
#pragma unroll
        for (int q = 0; q < 4; ++q) { float pa = 1.f, hh = 0.f;
#pragma unroll
            for (int j = 0; j < 4; ++j) { const int r = 4 * q + j; const float a = accA[mb][r], bb = accI[mb][r]; hh = a * hh + bb; pa *= a; accA[mb][r] = pa; accI[mb][r] = hh; }
            rA[mb * 4 + q] = pa; rH[mb * 4 + q] = hh; }
    const int agg_dir_off = ((b * NSEQ) * 2 + DIR) * 1024 + ch;
    const float* agg = (const float*)(p.ws + WS_AGG);
    float carry = 0.f;
    if (FINAL) {
        if (DIR == 0) { for (int q = 0; q < sc; ++q) { const float* a2 = agg + (size_t)(agg_dir_off + q * 2048) * 2; carry = a2[0] * carry + a2[1]; } }
        else { { const float* a2 = agg + (size_t)(agg_dir_off + 1 * 2048) * 2; carry = a2[0] * carry + a2[1]; } { const float* a2 = agg + (size_t)(agg_dir_off + 0 * 2048) * 2; carry = a2[0] * carry + a2[1]; }
            for (int q = NSEQ - 1; q > sc; --q) { const float* a2 = agg + (size_t)(agg_dir_off + q * 2048) * 2; carry = a2[0] * carry + a2[1]; } }
    }
    float cin[16];
#pragma unroll
    for (int i = 0; i < 16; ++i) cin[i] = 0.f;
    float s = carry, At = 1.f;
#pragma unroll
    for (int i = 0; i < 16; ++i) { const float oA = __shfl_xor(rA[i], 32), oH = __shfl_xor(rH[i], 32);
        { const bool mine = (lh == 0); const float a = mine ? rA[i] : oA, hh = mine ? rH[i] : oH; cin[i] = mine ? s : cin[i]; s = a * s + hh; At *= a; }
        { const bool mine = (lh == 1); const float a = mine ? rA[i] : oA, hh = mine ? rH[i] : oH; cin[i] = mine ? s : cin[i]; s = a * s + hh; At *= a; } }
    if (!FINAL) {
        if (lh == 0) { float* o = (float*)(p.ws + WS_AGG) + (size_t)(agg_dir_off + sc * 2048) * 2; o[0] = At; o[1] = s; }
        return;
    }
#pragma unroll
    for (int mb = 0; mb < 4; ++mb)
#pragma unroll
        for (int r = 0; r < 16; ++r) accI[mb][r] += accA[mb][r] * cin[mb * 4 + (r >> 2)];
}
template <bool FINAL>
__device__ void lru_tile(const Params& p, LAS unsigned char* lds, int item) {
    const int tid = threadIdx.x, lane = tid & 63, wid = __builtin_amdgcn_readfirstlane(tid >> 6);
    int b, sc, head;
    if (FINAL) { head = item & 7; sc = 2 + ((item >> 3) & 31); b = item >> 8; }
    else { head = item & 7; const int r = item >> 3; sc = r & 1; b = r >> 1; }
    const bf16_t* src; int Tseq, t0, ld;
    if (sc < 2) { src = (const bf16_t*)(p.ws + WS_ZXC) + (size_t)b * 256 * 1024; Tseq = 256; t0 = sc * 128; ld = 1024; }
    else { src = (const bf16_t*)(p.ws + WS_RZ) + (size_t)b * 4096 * 4096; Tseq = 4096; t0 = (sc - 2) * 128; ld = 4096; }
    LAS unsigned char* ul = lds;
    LAS float* ybuf = (LAS float*)(lds + 36 * 1024);
    {
        const int c8 = tid & 15, tb = tid >> 4; const int ch0 = head * 128 + 8 * c8;
        float w[4][8], bias[8];
#pragma unroll
        for (int k = 0; k < 4; ++k) { const f32x4 a = *(const f32x4*)(p.conv_w + k * 1024 + ch0), c2 = *(const f32x4*)(p.conv_w + k * 1024 + ch0 + 4);
#pragma unroll
            for (int j = 0; j < 4; ++j) { w[k][j] = a[j]; w[k][4 + j] = c2[j]; } }
        { const f32x4 a = *(const f32x4*)(p.conv_b + ch0), c2 = *(const f32x4*)(p.conv_b + ch0 + 4);
#pragma unroll
            for (int j = 0; j < 4; ++j) { bias[j] = a[j]; bias[4 + j] = c2[j]; } }
#pragma unroll
        for (int i = 0; i < 4; ++i) { const int t = tb + 32 * i; float a[8];
#pragma unroll
            for (int j = 0; j < 8; ++j) a[j] = bias[j];
#pragma unroll
            for (int k = 0; k < 4; ++k) { const int tt = t0 + t + k - 2;
                if (tt >= 0 && tt < Tseq) { float f[8]; unpack8(*(const u32x4*)(src + (size_t)tt * ld + ch0), f);
#pragma unroll
                    for (int j = 0; j < 8; ++j) a[j] += w[k][j] * f[j]; } }
            u32x4 wv; wv.x = cvt_pk_bf16(a[0], a[1]); wv.y = cvt_pk_bf16(a[2], a[3]); wv.z = cvt_pk_bf16(a[4], a[5]); wv.w = cvt_pk_bf16(a[6], a[7]);
            *(LAS u32x4*)(ul + t * 272 + c8 * 16) = wv; }
    }
    __syncthreads();
    f32x16 hacc[4];
    if (wid < 4) lru_wave<FINAL, 0>(p, ul, b, sc, head, wid & 3, lane, hacc);
    else lru_wave<FINAL, 1>(p, ul, b, sc, head, wid & 3, lane, hacc);
    if (FINAL) {
        const int lr = lane & 31, lh = lane >> 5, chl = (wid & 3) * 32 + lr;
        if (wid >= 4) { LAS float* yp = ybuf + (127 - 4 * lh) * 129 + chl;
#pragma unroll
            for (int mb = 0; mb < 4; ++mb)
#pragma unroll
                for (int r = 0; r < 16; ++r) yp[-LRU_CST(mb, r) * 129] = hacc[mb][r]; }
        __syncthreads();
        if (wid < 4) {
            const LAS float* yp = ybuf + (4 * lh) * 129 + chl;
            const bf16_t* Zu = (const bf16_t*)(p.ws + WS_RZ) + ((size_t)(b * 4096 + t0) * 4096 + 1024 + head * 128);
            bf16_t* Ou = (bf16_t*)(p.ws + WS_R1) + ((size_t)(b * 4096 + t0) * 1024 + head * 128);
            const unsigned zo = (unsigned)(4 * lh * 4096 + chl), oo = (unsigned)(4 * lh * 1024 + chl);
#pragma unroll
            for (int mb = 0; mb < 4; ++mb) {
#pragma unroll
                for (int r = 0; r < 16; ++r) {
                    const float y = hacc[mb][r] + yp[LRU_CST(mb, r) * 129];
                    const float gz = bf2f(Zu[zo + LRU_CST(mb, r) * 4096]);
                    Ou[oo + LRU_CST(mb, r) * 1024] = (bf16_t)(cvt_pk_bf16(gz * y, 0.f) & 0xffffu);
                    if ((r & 7) == 7) __builtin_amdgcn_sched_barrier(0); } }
        }
    }
    __syncthreads();
}

#ifndef LRU_PF_FRAG
#define LRU_PF_FRAG true
#endif
#ifndef LRU_PF_TILE
#define LRU_PF_TILE true
#endif
typedef unsigned long long u64_t;
template <int DIR, bool PREF>
__device__ __forceinline__ void lru2_dir(const Params& p, LAS unsigned char* ul, int head, int w, int lane, const bf16x8 (&bA)[4], const bf16x8 (&bI)[4], bf16x8 (&nA)[4], bf16x8 (&nI)[4],
                                         f32x4 (&hl)[8], f32x4 (&pp)[8], float& Atot, float& Htot) {
    constexpr int SG = DIR ? -1 : 1;
    const int fr = lane & 15, fq = lane >> 4, chl = 16 * w + fr, ch = head * 128 + chl;
    f32x4 accA[8], accI[8];
#pragma unroll
    for (int rb = 0; rb < 8; ++rb) { accA[rb] = (f32x4){0.f, 0.f, 0.f, 0.f}; accI[rb] = (f32x4){0.f, 0.f, 0.f, 0.f}; }
    {
        LAS unsigned char* arow0 = ul + (DIR ? 127 - fr : fr) * 272 + fq * 16;
#pragma unroll
        for (int rb = 0; rb < 8; ++rb)
#pragma unroll
            for (int ks = 0; ks < 4; ++ks) { const bf16x8 af = *(const LAS bf16x8*)(arow0 + SG * 16 * rb * 272 + 64 * ks);
                accA[rb] = __builtin_amdgcn_mfma_f32_16x16x32_bf16(af, bA[ks], accA[rb], 0, 0, 0);
                accI[rb] = __builtin_amdgcn_mfma_f32_16x16x32_bf16(af, bI[ks], accI[rb], 0, 0, 0); }
    }
    if (PREF) {
        const bf16_t* wa = (const bf16_t*)(p.ws + WS_WAT) + ((size_t)((1 - DIR) * 8 + head) * 128 + chl) * 128 + 8 * fq;
        const bf16_t* wi = (const bf16_t*)(p.ws + WS_WIT) + ((size_t)((1 - DIR) * 8 + head) * 128 + chl) * 128 + 8 * fq;
#pragma unroll
        for (int ks = 0; ks < 4; ++ks) { nA[ks] = *(const bf16x8*)(wa + 32 * ks); nI[ks] = *(const bf16x8*)(wi + 32 * ks); }
    }
    {
        const float lam = p.lru_lambda[DIR * 1024 + ch]; const float sp8 = 8.0f * log1pf(expf(-lam));
        const float ba = p.lru_ba[DIR * 1024 + ch], bi = p.lru_bi[DIR * 1024 + ch];
        LAS unsigned char* up = ul + (DIR ? 127 - 4 * fq : 4 * fq) * 272 + chl * 2;
#pragma unroll
        for (int rb = 0; rb < 8; ++rb)
#pragma unroll
            for (int r = 0; r < 4; ++r) {
                const float uv = bf2f(*(const LAS bf16_t*)(up + SG * (16 * rb + r) * 272));
                const float rg = sigmoidf_(accA[rb][r] + ba), ig = sigmoidf_(accI[rb][r] + bi);
                const float a = __expf(-sp8 * rg); accA[rb][r] = a; accI[rb][r] = __builtin_amdgcn_sqrtf(fmaxf(1.0f - a * a, 0.f)) * ig * uv;
                if (r == 3 && (rb & 1)) __builtin_amdgcn_sched_barrier(0); }
    }
    float rA[8], rH[8];
#pragma unroll
    for (int rb = 0; rb < 8; ++rb) { float pa = 1.f, hh = 0.f;
#pragma unroll
        for (int r = 0; r < 4; ++r) { const float a = accA[rb][r], bb = accI[rb][r]; hh = a * hh + bb; pa *= a; accA[rb][r] = pa; accI[rb][r] = hh; }
        rA[rb] = pa; rH[rb] = hh; }
    float Pc = 1.f, s = 0.f;
#pragma unroll
    for (int rb = 0; rb < 8; ++rb) { float Pin = 1.f, Hin = 0.f;
#pragma unroll
        for (int q = 0; q < 4; ++q) { const float a = __shfl(rA[rb], fr + 16 * q), hh = __shfl(rH[rb], fr + 16 * q);
            if (q == fq) { Pin = Pc; Hin = s; }
            s = a * s + hh; Pc *= a; }
#pragma unroll
        for (int r = 0; r < 4; ++r) { hl[rb][r] = accI[rb][r] + accA[rb][r] * Hin; pp[rb][r] = accA[rb][r] * Pin; }
        __builtin_amdgcn_sched_barrier(0); }
    Atot = Pc; Htot = s;
}
__device__ __forceinline__ u64_t agg_ld(const u64_t* a) { return __hip_atomic_load(a, __ATOMIC_RELAXED, __HIP_MEMORY_SCOPE_AGENT); }
template <int DIR>
__device__ __forceinline__ float lru2_carry(const u64_t* aggc, int n, int fr, int fq) {
    float Ap = 1.f, Hp = 0.f; u64_t v[9];
#pragma unroll
    for (int k = 0; k < 9; ++k) { const int j = fq * 9 + k; const int seq = DIR ? (j == 0 ? 1 : (j == 1 ? 0 : 35 - j)) : j;
        v[k] = (j < n) ? agg_ld(aggc + (size_t)seq * 2048) : 0x000000003f800000ull; }
#pragma unroll
    for (int k = 0; k < 9; ++k) { const float a = __uint_as_float((unsigned)v[k]), hh = __uint_as_float((unsigned)(v[k] >> 32)); Hp = a * Hp + hh; Ap *= a; }
    float s = 0.f;
#pragma unroll
    for (int q = 0; q < 4; ++q) { const float a = __shfl(Ap, fr + 16 * q), hh = __shfl(Hp, fr + 16 * q); s = a * s + hh; }
    return s;
}
__device__ void lru2_block(const Params& p, LAS unsigned char* lds, int slot, int c, int ngr) {
    const int tid = threadIdx.x, lane = tid & 63, wid = __builtin_amdgcn_readfirstlane(tid >> 6);
    const int sc = c + 2, t0 = c * 128;
    LAS unsigned char* raw = lds;
    LAS unsigned char* ul = lds + 33792;
    LAS unsigned char* gzl = lds + 68608;
    LAS unsigned char* outl = lds + 103424;
    const int fr = lane & 15, fq = lane >> 4, chl = 16 * wid + fr;
    u32x4 nr[5], ng[4];
#define LRU2_LOAD(gg) do { const bf16_t* Zb_ = (const bf16_t*)(p.ws + WS_RZ) + (size_t)((gg) >> 3) * 4096 * 4096 + ((gg) & 7) * 128; \
        _Pragma("unroll") for (int k = 0; k < 5; ++k) { const int pc = tid + NTHR * k; nr[k] = (u32x4){0u, 0u, 0u, 0u}; \
            if (pc < 131 * 16) { const int row = pc >> 4, c8 = pc & 15, tt = t0 - 2 + row; if (tt >= 0 && tt < TT) nr[k] = *(const u32x4*)(Zb_ + (size_t)tt * 4096 + c8 * 8); } } \
        _Pragma("unroll") for (int k = 0; k < 4; ++k) { const int pc = tid + NTHR * k, row = pc >> 4, c8 = pc & 15; ng[k] = *(const u32x4*)(Zb_ + (size_t)(t0 + row) * 4096 + 1024 + c8 * 8); } } while (0)
#ifdef LRU_TSA
#define LSTAMP(pos) do { if ((pos) == LRU_TSA || (pos) == LRU_TSB) { if (blockIdx.x == 0 && tid == 0 && g == slot + ngr) ((unsigned long long*)(p.ws + WS_BAR + 40 * KiB))[(pos) == LRU_TSA ? 24 : 25] = __builtin_amdgcn_s_memrealtime(); } } while (0)
#else
#define LSTAMP(pos) do { } while (0)
#endif
    LRU2_LOAD(slot);
    for (int g = slot; g < NB * 8; g += ngr) {
        LSTAMP(0);
        const int b = g >> 3, head = g & 7, ch = head * 128 + chl;
        unsigned* gcnt = (unsigned*)(p.ws + WS_BAR + 16 * KiB) + g * 64;
        bf16x8 bA1[4], bI1[4], bA0[4], bI0[4];
        { const bf16_t* wa = (const bf16_t*)(p.ws + WS_WAT) + ((size_t)(8 + head) * 128 + chl) * 128 + 8 * fq; const bf16_t* wi = (const bf16_t*)(p.ws + WS_WIT) + ((size_t)(8 + head) * 128 + chl) * 128 + 8 * fq;
#pragma unroll
          for (int ks = 0; ks < 4; ++ks) { bA1[ks] = *(const bf16x8*)(wa + 32 * ks); bI1[ks] = *(const bf16x8*)(wi + 32 * ks); } }
#pragma unroll
        for (int k = 0; k < 5; ++k) { const int pc = tid + NTHR * k; if (pc < 131 * 16) *(LAS u32x4*)(raw + (pc >> 4) * 256 + (pc & 15) * 16) = nr[k]; }
#pragma unroll
        for (int k = 0; k < 4; ++k) { const int pc = tid + NTHR * k; *(LAS u32x4*)(gzl + (pc >> 4) * 272 + (pc & 15) * 16) = ng[k]; }
        __syncthreads();
        {
            const int c8 = tid & 15, tb = tid >> 4; const int ch0 = head * 128 + 8 * c8;
            float w[4][8], bias[8];
#pragma unroll
            for (int k = 0; k < 4; ++k) { const f32x4 a = *(const f32x4*)(p.conv_w + k * 1024 + ch0), c2 = *(const f32x4*)(p.conv_w + k * 1024 + ch0 + 4);
#pragma unroll
                for (int j = 0; j < 4; ++j) { w[k][j] = a[j]; w[k][4 + j] = c2[j]; } }
            { const f32x4 a = *(const f32x4*)(p.conv_b + ch0), c2 = *(const f32x4*)(p.conv_b + ch0 + 4);
#pragma unroll
                for (int j = 0; j < 4; ++j) { bias[j] = a[j]; bias[4 + j] = c2[j]; } }
#pragma unroll
            for (int i = 0; i < 4; ++i) { const int t = tb + 32 * i; float a[8];
#pragma unroll
                for (int j = 0; j < 8; ++j) a[j] = bias[j];
#pragma unroll
                for (int k = 0; k < 4; ++k) { float f[8]; unpack8(*(const LAS u32x4*)(raw + (t + k) * 256 + c8 * 16), f);
#pragma unroll
                    for (int j = 0; j < 8; ++j) a[j] += w[k][j] * f[j]; }
                u32x4 wv; wv.x = cvt_pk_bf16(a[0], a[1]); wv.y = cvt_pk_bf16(a[2], a[3]); wv.z = cvt_pk_bf16(a[4], a[5]); wv.w = cvt_pk_bf16(a[6], a[7]);
                *(LAS u32x4*)(ul + t * 272 + c8 * 16) = wv; }
        }
        __syncthreads();
        LSTAMP(1);
        float A0, H0, A1, H1;
        {
            f32x4 hl1[8], pp1[8];
            lru2_dir<1, LRU_PF_FRAG>(p, ul, head, wid, lane, bA1, bI1, bA0, bI0, hl1, pp1, A1, H1);
            LAS unsigned char* hp = outl + (127 - 4 * fq) * 272 + chl * 2; LAS unsigned char* qp = raw + (127 - 4 * fq) * 256 + chl * 2;
#pragma unroll
            for (int rb = 0; rb < 8; ++rb)
#pragma unroll
                for (int r = 0; r < 4; ++r) { *(LAS bf16_t*)(hp - (16 * rb + r) * 272) = (bf16_t)(cvt_pk_bf16(hl1[rb][r], 0.f) & 0xffffu); *(LAS bf16_t*)(qp - (16 * rb + r) * 256) = (bf16_t)(cvt_pk_bf16(pp1[rb][r], 0.f) & 0xffffu); }
        }
        __builtin_amdgcn_sched_barrier(0);
        LSTAMP(2);
        if (!LRU_PF_FRAG) { const bf16_t* wa = (const bf16_t*)(p.ws + WS_WAT) + ((size_t)(head) * 128 + chl) * 128 + 8 * fq; const bf16_t* wi = (const bf16_t*)(p.ws + WS_WIT) + ((size_t)(head) * 128 + chl) * 128 + 8 * fq;
#pragma unroll
          for (int ks = 0; ks < 4; ++ks) { bA0[ks] = *(const bf16x8*)(wa + 32 * ks); bI0[ks] = *(const bf16x8*)(wi + 32 * ks); } }
        f32x4 hl0[8], pp0[8];
        lru2_dir<0, false>(p, ul, head, wid, lane, bA0, bI0, bA1, bI1, hl0, pp0, A0, H0);
        LSTAMP(3);
        u64_t* agg = (u64_t*)(p.ws + WS_AGG);
        const size_t ai0 = ((size_t)(b * NSEQ) * 2 + 0) * 1024 + ch, ai1 = ((size_t)(b * NSEQ) * 2 + 1) * 1024 + ch;
        if (fq == 0) {
            __hip_atomic_store(agg + ai0 + (size_t)sc * 2048, ((u64_t)__float_as_uint(H0) << 32) | __float_as_uint(A0), __ATOMIC_RELAXED, __HIP_MEMORY_SCOPE_AGENT);
            __hip_atomic_store(agg + ai1 + (size_t)sc * 2048, ((u64_t)__float_as_uint(H1) << 32) | __float_as_uint(A1), __ATOMIC_RELAXED, __HIP_MEMORY_SCOPE_AGENT); }
        asm volatile("s_waitcnt vmcnt(0)" ::: "memory");
        __syncthreads();
        if (tid == 0) (void)__hip_atomic_fetch_add(gcnt, 1u, __ATOMIC_RELAXED, __HIP_MEMORY_SCOPE_AGENT);
        if (wid == 0) { unsigned sp = 0;
            while ((unsigned)__builtin_amdgcn_readfirstlane(__hip_atomic_load(gcnt, __ATOMIC_RELAXED, __HIP_MEMORY_SCOPE_AGENT)) < 32u) { __builtin_amdgcn_s_sleep(1); if (++sp > (1u << 22)) break; }
            __builtin_amdgcn_fence(__ATOMIC_ACQUIRE, "agent");
            asm volatile("s_waitcnt vmcnt(0)" ::: "memory"); }
        __syncthreads();
        LSTAMP(4);
        const float C0 = lru2_carry<0>(agg + ai0, sc, fr, fq);
        const float C1 = lru2_carry<1>(agg + ai1, 2 + (NSEQ - 1 - sc), fr, fq);
        __builtin_amdgcn_sched_barrier(0);
        LSTAMP(5);
        if (LRU_PF_TILE) { const int gn = (g + ngr < NB * 8) ? g + ngr : g; LRU2_LOAD(gn); }
        __builtin_amdgcn_sched_barrier(0);
        LAS unsigned char* gp = gzl + (4 * fq) * 272 + chl * 2; LAS unsigned char* op = outl + (4 * fq) * 272 + chl * 2; LAS unsigned char* qp0 = raw + (4 * fq) * 256 + chl * 2;
#pragma unroll
        for (int rb = 0; rb < 8; ++rb)
#pragma unroll
            for (int r = 0; r < 4; ++r) { const float h1 = bf2f(*(const LAS bf16_t*)(op + (16 * rb + r) * 272)) + bf2f(*(const LAS bf16_t*)(qp0 + (16 * rb + r) * 256)) * C1;
                const float y = hl0[rb][r] + pp0[rb][r] * C0 + h1;
                const float gz = bf2f(*(const LAS bf16_t*)(gp + (16 * rb + r) * 272));
                *(LAS bf16_t*)(op + (16 * rb + r) * 272) = (bf16_t)(cvt_pk_bf16(gz * y, 0.f) & 0xffffu); }
        __syncthreads();
        bf16_t* Ob = (bf16_t*)(p.ws + WS_R1) + ((size_t)(b * 4096 + t0)) * 1024 + head * 128;
#pragma unroll
        for (int k = 0; k < 4; ++k) { const int pc = tid + NTHR * k, row = pc >> 4, c8 = pc & 15;
            *(u32x4*)(Ob + (size_t)row * 1024 + c8 * 8) = *(const LAS u32x4*)(outl + row * 272 + c8 * 16); }
        __syncthreads();
        LSTAMP(7);
        if (!LRU_PF_TILE && g + ngr < NB * 8) LRU2_LOAD(g + ngr);
    }
#undef LRU2_LOAD
}

__device__ void fft_stage2_all(const Params& p, LAS unsigned char* lds) {
    const int tid = tid_opaque(), lane = tid & 63, wid = tid >> 6, fr = lane & 15, fq = lane >> 4;
    const bf16_t* Yt = (const bf16_t*)((const unsigned char*)p.out + OUT_YT); const bf16_t* D2 = (const bf16_t*)(p.ws + WS_D2T);
    bf16_t* Fo = (bf16_t*)((unsigned char*)p.out + OUT_F);
    const int G = gridDim.x;
    int it = blockIdx.x; bf16x8 dfr, yfr[4];
#define S2_LOAD(item) do { const int b_ = (item) & 7, k1_ = (item) >> 3; dfr = *(const bf16x8*)(D2 + (size_t)(k1_ + 256 * fr) * 32 + 8 * fq); \
        _Pragma("unroll") for (int n = 0; n < 4; ++n) yfr[n] = *(const bf16x8*)(Yt + (size_t)(k1_ * 2 + (fq >> 1)) * 65536 + (size_t)b_ * 8192 + (size_t)(16 * (4 * wid + n) + fr) * 16 + 8 * (fq & 1)); } while (0)
    if (it < NB * 256) S2_LOAD(it);
    for (; it < NB * 256; it += G) {
        const int b = it & 7, k1 = it >> 3;
        f32x4 acc[4];
#pragma unroll
        for (int n = 0; n < 4; ++n) acc[n] = __builtin_amdgcn_mfma_f32_16x16x32_bf16(yfr[n], dfr, (f32x4){0.f, 0.f, 0.f, 0.f}, 0, 0, 0);
        const int nx = it + G; if (nx < NB * 256) S2_LOAD(nx);
#pragma unroll
        for (int n = 0; n < 4; ++n) { u32x2 w; w.x = cvt_pk_bf16(acc[n][0], acc[n][1]); w.y = cvt_pk_bf16(acc[n][2], acc[n][3]);
            *(LAS u32x2*)(lds + fr * 1040 + (16 * (4 * wid + n) + 4 * fq) * 2) = w; }
        __syncthreads();
#pragma unroll
        for (int k = 0; k < 2; ++k) { const int pc = tid + NTHR * k, k2 = pc >> 6, c8 = pc & 63;
            *(u32x4*)(Fo + ((size_t)b * 4096 + k1 + 256 * k2) * 512 + c8 * 8) = *(const LAS u32x4*)(lds + k2 * 1040 + c8 * 16); }
        __syncthreads();
    }
#undef S2_LOAD
}

__device__ void phase7_rows(const Params& p, LAS unsigned char* lds) {
    const int tid = threadIdx.x, lane = tid & 63, wid = tid >> 6;
    LAS float* wrt = (LAS float*)lds;
    for (int i = tid; i < 16 * 1024; i += NTHR) { const int d = i >> 4, e = i & 15; wrt[e * 1024 + d] = p.w_router[i]; }
    __syncthreads();
    const float* ada = (const float*)(p.ws + WS_ADA); bf16_t* h2 = (bf16_t*)(p.ws + WS_R1); float* scores = (float*)(p.ws + WS_SCORES);
    for (int row0 = (blockIdx.x * 8 + wid) * 2; row0 < MLAT; row0 += gridDim.x * 16) {
        const int b = row0 >> 12;
        f32x4 v[2][4]; float ss[2];
#pragma unroll
        for (int r = 0; r < 2; ++r)
#pragma unroll
            for (int i = 0; i < 4; ++i) v[r][i] = *(const f32x4*)(p.out + (size_t)(row0 + r) * 1024 + 256 * i + 4 * lane);
#pragma unroll
        for (int r = 0; r < 2; ++r) { float a = 0.f;
#pragma unroll
            for (int i = 0; i < 4; ++i) a += v[r][i][0] * v[r][i][0] + v[r][i][1] * v[r][i][1] + v[r][i][2] * v[r][i][2] + v[r][i][3] * v[r][i][3];
            ss[r] = a; }
#pragma unroll
        for (int o = 32; o >= 1; o >>= 1) { ss[0] += __shfl_xor(ss[0], o); ss[1] += __shfl_xor(ss[1], o); }
#pragma unroll
        for (int i = 0; i < 4; ++i) { const int d = 256 * i + 4 * lane;
            const f32x4 g = *(const f32x4*)(p.norm2_g + d), sh = *(const f32x4*)(ada + b * 6144 + 3072 + d), sc = *(const f32x4*)(ada + b * 6144 + 4096 + d);
#pragma unroll
            for (int r = 0; r < 2; ++r) { const float rs = rsqrtf(ss[r] * (1.0f / 1024.0f) + 1e-6f);
                v[r][i] = v[r][i] * rs * g * (sc + 1.0f) + sh;
                u32x2 w; w.x = cvt_pk_bf16(v[r][i][0], v[r][i][1]); w.y = cvt_pk_bf16(v[r][i][2], v[r][i][3]); *(u32x2*)(h2 + (size_t)(row0 + r) * 1024 + d) = w; } }
        float q[32];
#pragma unroll
        for (int e = 0; e < 16; ++e) { float a0 = 0.f, a1 = 0.f;
#pragma unroll
            for (int i = 0; i < 4; ++i) { const f32x4 w = *(const LAS f32x4*)(wrt + e * 1024 + 256 * i + 4 * lane);
                a0 += v[0][i][0] * w[0] + v[0][i][1] * w[1] + v[0][i][2] * w[2] + v[0][i][3] * w[3];
                a1 += v[1][i][0] * w[0] + v[1][i][1] * w[1] + v[1][i][2] * w[2] + v[1][i][3] * w[3]; }
            q[e] = a0; q[16 + e] = a1; }
#pragma unroll
        for (int j = 0; j < 16; ++j) { const bool up = (lane & 32) != 0; const float send = up ? q[j] : q[16 + j], keep = up ? q[16 + j] : q[j]; q[j] = keep + __shfl_xor(send, 32); }
#pragma unroll
        for (int j = 0; j < 8; ++j) { const bool up = (lane & 16) != 0; const float send = up ? q[j] : q[8 + j], keep = up ? q[8 + j] : q[j]; q[j] = keep + __shfl_xor(send, 16); }
#pragma unroll
        for (int j = 0; j < 4; ++j) { const bool up = (lane & 8) != 0; const float send = up ? q[j] : q[4 + j], keep = up ? q[4 + j] : q[j]; q[j] = keep + __shfl_xor(send, 8); }
#pragma unroll
        for (int j = 0; j < 2; ++j) { const bool up = (lane & 4) != 0; const float send = up ? q[j] : q[2 + j], keep = up ? q[2 + j] : q[j]; q[j] = keep + __shfl_xor(send, 4); }
        { const bool up = (lane & 2) != 0; const float send = up ? q[0] : q[1], keep = up ? q[1] : q[0]; q[0] = keep + __shfl_xor(send, 2); }
        float lg = q[0] + __shfl_xor(q[0], 1);
        float mx = lg;
#pragma unroll
        for (int o = 2; o <= 16; o <<= 1) mx = fmaxf(mx, __shfl_xor(mx, o));
        const float ex = expf(lg - mx); float sum = ex;
#pragma unroll
        for (int o = 2; o <= 16; o <<= 1) sum += __shfl_xor(sum, o);
        if ((lane & 1) == 0) scores[((size_t)b * 16 + ((lane >> 1) & 15)) * 4096 + ((row0 + (lane >> 5)) & 4095)] = ex / sum;
    }
    __syncthreads();
}
__device__ void phase7_weights(const Params& p) {
    constexpr int N_G = 16 * 16 * 6, N_D = 16 * 24 * 4;
    for (int it = blockIdx.x; it < 2 * N_G + N_D; it += gridDim.x) {
        if (it < 2 * N_G) { const int up = it >= N_G, j = up ? it - N_G : it, e = j / 96, r = j % 96, kb = r / 6, nb = r % 6;
            xpose_item<4>((up ? p.w_up_e : p.w_gate_e) + (size_t)e * 1024 * 1536, 1536, (bf16_t*)(p.ws + WS_WGU) + (size_t)e * 3072 * 1024, 1024, kb * 64, nb * 256, up ? 2 : 1); }
        else { const int j = it - 2 * N_G, e = j / 96, r = j % 96, kb = r >> 2, nb = r & 3;
            xpose_item<4>(p.w_down_e + (size_t)e * 1536 * 1024, 1024, (bf16_t*)(p.ws + WS_WD) + (size_t)e * 1024 * 1536, 1536, kb * 64, nb * 256, 0); }
    }
}

__device__ void phase8_topk(const Params& p, LAS unsigned char* lds) {
    const int tid = threadIdx.x, lane = tid & 63, wid = tid >> 6;
    LAS unsigned* cnt = (LAS unsigned*)lds;
    LAS unsigned* wsum = cnt + 16;
    const float* scores = (const float*)(p.ws + WS_SCORES);
    int* idx = (int*)(p.ws + WS_IDX); float* gate = (float*)(p.ws + WS_GATE); int* slot_of = (int*)(p.ws + WS_SLOT);
    for (int it = blockIdx.x; it < NB * NE; it += gridDim.x) {
        const int b = it >> 4, e = it & 15;
        unsigned key[8];
        { const u32x4* sp = (const u32x4*)(scores + (size_t)it * 4096 + tid * 8); const u32x4 a = sp[0], c2 = sp[1]; key[0] = a.x; key[1] = a.y; key[2] = a.z; key[3] = a.w; key[4] = c2.x; key[5] = c2.y; key[6] = c2.z; key[7] = c2.w; }
        unsigned thr = 0;
        for (int bit = 30; bit >= 0; --bit) {
            const unsigned cand = thr | (1u << bit); unsigned c = 0;
#pragma unroll
            for (int j = 0; j < 8; ++j) c += (unsigned)__popcll(__ballot(key[j] >= cand));
            LAS unsigned* cb = cnt + (bit & 1) * 8;
            if (lane == 0) cb[wid] = c;
            __syncthreads();
            unsigned tot = 0;
#pragma unroll
            for (int w = 0; w < 8; ++w) tot += cb[w];
            if (tot >= (unsigned)CAP) thr = cand;
        }
        unsigned cg_ = 0, ce = 0;
#pragma unroll
        for (int j = 0; j < 8; ++j) { cg_ += key[j] > thr; ce += key[j] == thr; }
        unsigned pk = cg_ | (ce << 16), incl = pk;
#pragma unroll
        for (int o = 1; o < 64; o <<= 1) { const unsigned n = __shfl_up(incl, o); if (lane >= o) incl += n; }
        if (lane == 63) wsum[wid] = incl;
        __syncthreads();
        unsigned base = 0, total = 0;
#pragma unroll
        for (int w = 0; w < 8; ++w) { const unsigned s = wsum[w]; if (w < wid) base += s; total += s; }
        const unsigned excl = base + incl - pk; unsigned og = excl & 0xffffu, oe = excl >> 16; const unsigned ngt = total & 0xffffu, krem = (unsigned)CAP - ngt;
#pragma unroll
        for (int j = 0; j < 8; ++j) { const int t = tid * 8 + j; int m = -1;
            if (key[j] > thr) { m = (e * 8 + b) * 512 + (int)og; ++og; }
            else if (key[j] == thr) { if (oe < krem) m = (e * 8 + b) * 512 + (int)(ngt + oe); ++oe; }
            slot_of[((size_t)b * 4096 + t) * 16 + e] = m;
            if (m >= 0) { idx[m] = b * 4096 + t; gate[m] = __uint_as_float(key[j]); } }
        __syncthreads();
    }
}

__device__ void phase11(const Params& p, float* dst) {
    const int tid = tid_opaque(), lane = tid & 63, wid = tid >> 6;
    const float* ada = (const float*)(p.ws + WS_ADA); const int* slot_of = (const int*)(p.ws + WS_SLOT); const bf16_t* oute = (const bf16_t*)(p.ws + WS_OUTE);
    const int stride = gridDim.x * 16;
    int row0 = (blockIdx.x * 8 + wid) * 2;
    int myslot = row0 < MLAT ? slot_of[(size_t)row0 * 16 + (lane & 31)] : -1;
    for (; row0 < MLAT; row0 += stride) {
        const int b = row0 >> 12;
        const int nrow = row0 + stride; const int nslot = nrow < MLAT ? slot_of[(size_t)nrow * 16 + (lane & 31)] : -1;
        f32x4 xv[2][4], acc[2][4];
#pragma unroll
        for (int r = 0; r < 2; ++r)
#pragma unroll
            for (int i = 0; i < 4; ++i) { xv[r][i] = *(const f32x4*)(p.out + (size_t)(row0 + r) * 1024 + 256 * i + 4 * lane); acc[r][i] = (f32x4){0.f, 0.f, 0.f, 0.f}; }
        const unsigned long long bal = __ballot(myslot >= 0);
        unsigned mask0 = (unsigned)(bal & 0xffffull), mask1 = (unsigned)((bal >> 16) & 0xffffull);
        while (mask0 | mask1) {
            int m[2][2];
#pragma unroll
            for (int j = 0; j < 2; ++j) { if (mask0) { const int e = __builtin_ctz(mask0); mask0 &= mask0 - 1; m[0][j] = __builtin_amdgcn_readlane(myslot, e); } else m[0][j] = MMOE;
                                          if (mask1) { const int e = __builtin_ctz(mask1); mask1 &= mask1 - 1; m[1][j] = __builtin_amdgcn_readlane(myslot, 16 + e); } else m[1][j] = MMOE; }
            u32x2 w[2][2][4];
#pragma unroll
            for (int r = 0; r < 2; ++r)
#pragma unroll
                for (int j = 0; j < 2; ++j)
#pragma unroll
                    for (int i = 0; i < 4; ++i) w[r][j][i] = *(const u32x2*)(oute + (size_t)m[r][j] * 1024 + 256 * i + 4 * lane);
#pragma unroll
            for (int r = 0; r < 2; ++r)
#pragma unroll
                for (int j = 0; j < 2; ++j)
#pragma unroll
                    for (int i = 0; i < 4; ++i) { acc[r][i][0] += bf_lo(w[r][j][i].x); acc[r][i][1] += bf_hi(w[r][j][i].x); acc[r][i][2] += bf_lo(w[r][j][i].y); acc[r][i][3] += bf_hi(w[r][j][i].y); }
        }
        float ss[2];
#pragma unroll
        for (int r = 0; r < 2; ++r) { float a = 0.f;
#pragma unroll
            for (int i = 0; i < 4; ++i) { const int d = 256 * i + 4 * lane; const f32x4 g2 = *(const f32x4*)(ada + b * 6144 + 5120 + d); xv[r][i] += g2 * acc[r][i];
                a += xv[r][i][0] * xv[r][i][0] + xv[r][i][1] * xv[r][i][1] + xv[r][i][2] * xv[r][i][2] + xv[r][i][3] * xv[r][i][3]; }
            ss[r] = a; }
#pragma unroll
        for (int o = 32; o >= 1; o >>= 1) { ss[0] += __shfl_xor(ss[0], o); ss[1] += __shfl_xor(ss[1], o); }
#pragma unroll
        for (int r = 0; r < 2; ++r) { const float rs = rsqrtf(ss[r] * (1.0f / 1024.0f) + 1e-6f);
#pragma unroll
            for (int i = 0; i < 4; ++i) { const int d = 256 * i + 4 * lane; *(f32x4*)(dst + (size_t)(row0 + r) * 1024 + d) = xv[r][i] * rs * *(const f32x4*)(p.final_g + d); } }
        myslot = nslot;
    }
}

#define XB_TMO      128
#define XB_XCNT(j)  (256  + 64 * (j))
#define XB_XSUB(j)  (1280 + 64 * (j))
#define XB_XGEN(j)  (2304 + 64 * (j))
#define XB_TOP      3328
#define XB_TOPGEN   3392
#define XCD_BAR_WORDS 3456
#define XB_SPIN_CAP (1u << 22)
__device__ __forceinline__ unsigned xb_ld(unsigned* p)              { return __hip_atomic_load(p, __ATOMIC_RELAXED, __HIP_MEMORY_SCOPE_AGENT); }
__device__ __forceinline__ unsigned xb_add(unsigned* p, unsigned v) { return __hip_atomic_fetch_add(p, v, __ATOMIC_RELAXED, __HIP_MEMORY_SCOPE_AGENT); }
__device__ __forceinline__ unsigned xb_xcc_id() { return (unsigned)__builtin_amdgcn_s_getreg((3 << 11) | 20) & 0xFu; }
#define XB_SPIN(cond, bar) do { unsigned _sp = 0; while (cond) { __builtin_amdgcn_s_sleep(1); \
    if ((++_sp & 255u) == 0u) { if (xb_ld(&(bar)[XB_TMO])) break; if (_sp > XB_SPIN_CAP) { atomicAdd(&(bar)[XB_TMO], 1u); break; } } } } while (0)
struct XcdBarrier { unsigned* bar; unsigned x; volatile LAS unsigned* st; };
__device__ __forceinline__ XcdBarrier xcd_barrier_post(unsigned* bar, volatile LAS unsigned* st) {
    XcdBarrier b; b.bar = bar; b.x = xb_xcc_id(); b.st = st;
    if (threadIdx.x == 0) (void)xb_add(&bar[XB_XCNT(b.x)], 1u);
    return b;
}
__device__ __forceinline__ void xcd_barrier_complete(unsigned* bar, unsigned x, unsigned& nloc, unsigned& nx) {
    const unsigned G = gridDim.x * gridDim.y * gridDim.z;
    unsigned sum, cnt, mine, sp = 0u;
    for (;;) {
        sum = 0u; cnt = 0u; mine = 0u;
#pragma unroll
        for (unsigned j = 0; j < 16; ++j) { const unsigned c = xb_ld(&bar[XB_XCNT(j)]); sum += c; cnt += (c > 0u) ? 1u : 0u; mine = (j == x) ? c : mine; }
        if (sum == G) break;
        __builtin_amdgcn_s_sleep(1);
        if ((++sp & 255u) == 0u) { if (xb_ld(&bar[XB_TMO])) break; if (sp > XB_SPIN_CAP) { atomicAdd(&bar[XB_TMO], 1u); break; } }
    }
    nloc = mine > 0u ? mine : 1u; nx = cnt > 0u ? cnt : 1u;
}
__device__ __forceinline__ void xcd_barrier(const XcdBarrier& b) {
    asm volatile("s_waitcnt vmcnt(0)" ::: "memory");
    __syncthreads();
    if (threadIdx.x == 0) {
        unsigned* bar = b.bar;
        __builtin_amdgcn_s_waitcnt(0);
        unsigned nloc = b.st[0], nx = b.st[1];
        if (nloc == 0u) { xcd_barrier_complete(bar, b.x, nloc, nx); b.st[0] = nloc; b.st[1] = nx; }
        const unsigned old = xb_add(&bar[XB_XSUB(b.x)], 1u);
        const unsigned gen = old / nloc;
        if (old + 1u == (gen + 1u) * nloc) {
            __builtin_amdgcn_fence(__ATOMIC_RELEASE, "agent");
            asm volatile("s_waitcnt vmcnt(0)" ::: "memory");
            const unsigned og = xb_add(&bar[XB_TOP], 1u);
            const unsigned tg = og / nx;
            if (og + 1u == (tg + 1u) * nx) xb_add(&bar[XB_TOPGEN], 1u);
            else XB_SPIN(xb_ld(&bar[XB_TOPGEN]) == tg, bar);
            __builtin_amdgcn_fence(__ATOMIC_ACQUIRE, "agent");
            xb_add(&bar[XB_XGEN(b.x)], 1u);
            asm volatile("s_waitcnt vmcnt(0)" ::: "memory");
        } else {
            XB_SPIN(xb_ld(&bar[XB_XGEN(b.x)]) == gen, bar);
            __builtin_amdgcn_fence(__ATOMIC_ACQUIRE, "agent");
            asm volatile("s_waitcnt vmcnt(0)" ::: "memory");
        }
    }
    __syncthreads();
}

__global__ void __launch_bounds__(NTHR, 2) fwd_megakernel(Params p) {
    extern __shared__ __attribute__((aligned(16))) unsigned char lds_raw[];
    LAS unsigned char* lds = (LAS unsigned char*)lds_raw;
    cg::grid_group grid = cg::this_grid();
    const int G = gridDim.x, bid = blockIdx.x;
    unsigned char* ws = p.ws;
    bf16_t* const R1 = (bf16_t*)(ws + WS_R1); bf16_t* const Zb = (bf16_t*)(ws + WS_RZ); bf16_t* const PQt = (bf16_t*)(ws + WS_RPQ); bf16_t* const MRG = (bf16_t*)(ws + WS_R2);
    bf16_t* const Fb = (bf16_t*)((unsigned char*)p.out + OUT_F); bf16_t* const Ytb = (bf16_t*)((unsigned char*)p.out + OUT_YT);
#ifdef ONLY_PH
#define PH(k) ((k) == ONLY_PH && p.ph_lo <= (k) && (k) < p.ph_hi)
#else
#define PH(k) (p.ph_lo <= (k) && (k) < p.ph_hi)
#endif
    volatile LAS unsigned* xst = (volatile LAS unsigned*)(lds + LDS_BYTES - 16);
    if (threadIdx.x < 4) xst[threadIdx.x] = 0u;
    __syncthreads();
    XcdBarrier xbar = xcd_barrier_post((unsigned*)(ws + WS_BAR), xst);
    if (p.ph_lo < 0) grid.sync();
#ifdef TS_A
    unsigned long long* tsb = (unsigned long long*)(ws + WS_BAR + 40 * KiB);
#define STAMP(i) do { if (bid == 0 && threadIdx.x == 0) tsb[i] = __builtin_amdgcn_s_memrealtime(); } while (0)
#else
#define STAMP(i) do { } while (0)
#endif
    STAMP(0);
#define SYNC(k) do { if (PH(k) && PH((k) + 1)) xcd_barrier(xbar); STAMP((k) + 1); } while (0)
#ifndef REPMASK
#define REPMASK 0
#endif
#define REP(k) for (int rep_ = 0; rep_ <= ((REPMASK >> (k)) & 1); ++rep_)
    if (PH(0)) REP(0) phase0(p, lds);
    SYNC(0);
    if (PH(1)) REP(1) phase1(p);
    SYNC(1);
    if (PH(2)) REP(2) {
        { ProbPQ pr{(const bf16_t*)(ws + WS_WPQ), R1, 1024, 1024, 16384}; pg8::Order S; S.init(4, 128, G, bid); EpiPQ E{PQt}; pg8::gemm_phase(lds, pr, S, E); }
        { ProbPlain pr{R1, (const bf16_t*)(ws + WS_WIN), 1024, 1024, 1024}; pg8::Order S; S.init(128, 16, G, bid); EpiZ E{Zb, 4096, -1}; pg8::gemm_phase(lds, pr, S, E); }
        { ProbPlain pr{(const bf16_t*)(ws + WS_HCTX), (const bf16_t*)(ws + WS_WIN), 1024, 1024, 1024}; pg8::Order S; S.init(8, 4, G, bid); EpiZ E{(bf16_t*)(ws + WS_ZXC), 1024, 0}; pg8::gemm_phase(lds, pr, S, E); }
    }
    SYNC(2);
    if (PH(3)) REP(3) {
        {
            ProbPlain pr{(const bf16_t*)(ws + WS_D1T), PQt, 512, 512, 512}; pg8::Order S; S.init(2, 256, G, bid);
            if (G == 256) { if (bid >= 128) { S.G = 128; S.c = bid - 128; S.base = 0; S.lim = 3; } else { S.G = 128; S.c = bid; S.base = 384; S.lim = 1; } }
            EpiPlain E{Ytb, 65536}; pg8::gemm_phase(lds, pr, S, E); }
        for (int it = bid; it < NB * 2 * 8; it += G) lru_tile<false>(p, lds, it);
    }
    SYNC(3);
    if (PH(4)) {
        STAMP(17);
        fft_stage2_all(p, lds);
        STAMP(16);
        const int ngr = G >> 5;
        if (ngr > 0 && bid < ngr * 32) lru2_block(p, lds, bid % ngr, bid / ngr, ngr);
    }
    SYNC(4);
    if (PH(5)) REP(5) {
        { ProbMerge pr{Fb, (const bf16_t*)(ws + WS_WFOUR), R1, (const bf16_t*)(ws + WS_WLRU), 512, 1024, 512, 512, 1024, 1024}; pg8::Order S; S.init(128, 4, G, bid); EpiMerge E{MRG, Zb}; pg8::gemm_phase2(lds, pr, S, E); }
    }
    SYNC(5);
    if (PH(6)) REP(6) { ProbPlain pr{MRG, (const bf16_t*)(ws + WS_WOUT), 1024, 1024, 1024}; pg8::Order S; S.init(128, 4, G, bid);
        EpiOut E{p.out, p.x, (const float*)(ws + WS_POS), (const float*)(ws + WS_ADA)}; pg8::gemm_phase(lds, pr, S, E); }
    SYNC(6);
    if (PH(7)) REP(7) { phase7_rows(p, lds); phase7_weights(p); }
    SYNC(7);
    if (PH(8)) REP(8) phase8_topk(p, lds);
    SYNC(8);
    if (PH(9)) REP(9) { ProbMoeUp pr{R1, (const bf16_t*)(ws + WS_WGU), (const int*)(ws + WS_IDX), 1024, 1024, 1024}; pg8::Order S; S.init(256, 12, G, bid); EpiGU E{(bf16_t*)(ws + WS_HID)}; pg8::gemm_phase(lds, pr, S, E); }
    SYNC(9);
    if (PH(10)) { if (bid == 0 && threadIdx.x < 128) *(u32x4*)(ws + WS_OUTE + (size_t)MMOE * 2048 + threadIdx.x * 16) = (u32x4){0u, 0u, 0u, 0u}; }
    if (PH(10)) REP(10) { ProbMoeDown pr{(const bf16_t*)(ws + WS_HID), (const bf16_t*)(ws + WS_WD), 1536, 1536, 1536}; pg8::Order S; S.init(256, 4, G, bid); EpiDown E{(bf16_t*)(ws + WS_OUTE), (const float*)(ws + WS_GATE)}; pg8::gemm_phase(lds, pr, S, E); }
    SYNC(10);
    if (PH(12)) phase11(p, (float*)(ws + WS_HID));
    if (PH(11)) phase11(p, p.out);
#ifdef TS_A
    xcd_barrier(xbar); STAMP(12);
    if (bid == 0 && threadIdx.x == 0) {

#ifndef TS_AE
#define TS_AE (TS_A + 1)
#endif
#ifndef TS_BE
#define TS_BE (TS_B + 1)
#endif
        const float ta = (float)(tsb[TS_AE] - tsb[TS_A]) * 0.01f * (float)(TS_SA), tb = (float)(tsb[TS_BE] - tsb[TS_B]) * 0.01f * (float)(TS_SB);
        p.out[7] = fminf(ta, 97.f); p.out[1024 * 5 + 9] = fminf(tb, 97.f); }
#endif
}

#ifndef N_LAUNCHES
#define N_LAUNCHES 1
#endif
#ifndef PROBE_DUP
#define PROBE_DUP 0x0
#endif
extern "C" void kernel_launch(void* const* d_in, const int* in_sizes, int n_in, void* d_out, int out_size, void* d_ws, size_t ws_size, hipStream_t stream) {
    static int grid = 0;
    if (grid == 0) {
        if (n_in != 24 || out_size != MLAT * DM || ws_size < WS_END) { fprintf(stderr, "kernel_launch: unexpected shapes (n_in %d out %d ws %zu)\n", n_in, out_size, ws_size); grid = -1; return; }
        int dev = 0, cus = 0, per_cu = 0;
        hipGetDevice(&dev); hipDeviceGetAttribute(&cus, hipDeviceAttributeMultiprocessorCount, dev);
        hipFuncSetAttribute((const void*)fwd_megakernel, hipFuncAttributeMaxDynamicSharedMemorySize, LDS_BYTES);
        hipOccupancyMaxActiveBlocksPerMultiprocessor(&per_cu, (const void*)fwd_megakernel, NTHR, LDS_BYTES);
        if (per_cu < 1) { fprintf(stderr, "kernel_launch: occupancy query reports %d blocks per CU\n", per_cu); per_cu = 1; }
        grid = cus * 1;
        (void)hipGetLastError();
    }
    if (grid < 0) return;
    Params p{};
    const float** f = (const float**)&p;
    for (int i = 0; i < 24; ++i) f[i] = (const float*)d_in[i];
    p.out = (float*)d_out; p.ws = (unsigned char*)d_ws;
    (void)hipMemsetAsync((unsigned char*)d_ws + WS_BAR, 0, 48 * KiB, stream);
#if N_LAUNCHES == 1
    p.ph_lo = 0; p.ph_hi = 12;
    void* args[] = {&p};
    hipError_t e = hipLaunchCooperativeKernel((const void*)fwd_megakernel, dim3(grid), dim3(NTHR), args, LDS_BYTES, stream);
    if (e != hipSuccess) fprintf(stderr, "cooperative launch failed: %s (grid %d)\n", hipGetErrorString(e), grid);
#else
    for (int k = 0; k < 12; ++k) for (int r = 0; r <= ((PROBE_DUP >> k) & 1); ++r) { p.ph_lo = k; p.ph_hi = k + 1; if (k == 11 && r == 0 && ((PROBE_DUP >> 11) & 1)) { p.ph_lo = 12; p.ph_hi = 13; } hipLaunchKernelGGL(fwd_megakernel, dim3(grid), dim3(NTHR), LDS_BYTES, stream, p); }
#endif
}
```

```cpp
#include <hip/hip_runtime.h>
#include <hip/hip_cooperative_groups.h>
#include <cstdio>
namespace cg = cooperative_groups;

#define LAS __attribute__((address_space(3)))
typedef unsigned short bf16_t;
typedef short bf16x8 __attribute__((ext_vector_type(8)));
typedef float f32x4 __attribute__((ext_vector_type(4)));
typedef float f32x16 __attribute__((ext_vector_type(16)));
typedef unsigned u32x4 __attribute__((ext_vector_type(4)));
typedef unsigned u32x2 __attribute__((ext_vector_type(2)));

constexpr int NB = 8, TT = 4096, DM = 1024, CTXL = 256, MLAT = NB * TT, MCTX = NB * CTXL;
constexpr int NE = 16, CAP = 512, DE = 1536, MMOE = NE * NB * CAP;
constexpr int NSEQ = 34;
constexpr int NTHR = 512;
constexpr int LDS_BYTES = 144 * 1024;

constexpr size_t KiB = 1024, MiB = 1024 * 1024;
constexpr size_t WS_ADA = 0;
constexpr size_t WS_POS = 256 * KiB;
constexpr size_t WS_AGG = 512 * KiB;
constexpr size_t WS_WPQ = 5 * MiB;
constexpr size_t WS_WIN = 7 * MiB;
constexpr size_t WS_WFOUR = 15 * MiB;
constexpr size_t WS_WLRU = 16 * MiB;
constexpr size_t WS_WOUT = 18 * MiB;
constexpr size_t WS_WAT = 20 * MiB;
constexpr size_t WS_WIT = 20 * MiB + 512 * KiB;
constexpr size_t WS_SCORES = 21 * MiB;
constexpr size_t WS_IDX = 23 * MiB;
constexpr size_t WS_GATE = 23 * MiB + 256 * KiB;
constexpr size_t WS_SLOT = 23 * MiB + 512 * KiB;
constexpr size_t WS_BAR = 25 * MiB + 512 * KiB;
constexpr size_t WS_D1T = 34 * MiB;
constexpr size_t WS_D2T = 34 * MiB + 512 * KiB;
constexpr size_t WS_HCTX = 26 * MiB;
constexpr size_t WS_ZXC = 30 * MiB;
constexpr size_t WS_R1 = 40 * MiB;
constexpr size_t WS_RPQ = 104 * MiB;
constexpr size_t WS_R2 = 168 * MiB;
constexpr size_t WS_RZ = 232 * MiB;
constexpr size_t WS_END = 488 * MiB;
constexpr size_t WS_HID = WS_RZ, WS_WD = WS_RZ + 192 * MiB, WS_WGU = WS_RPQ, WS_OUTE = WS_R1;
constexpr size_t OUT_YT = 0, OUT_F = 64 * MiB;

struct Params {
    const float *x, *c, *ctx, *c_ctx, *w_ada, *b_ada, *norm1_g, *norm2_g, *w_in, *w_four, *conv_w, *conv_b, *lru_lambda,
        *lru_wa, *lru_ba, *lru_wi, *lru_bi, *w_lru, *w_out, *w_router, *w_gate_e, *w_up_e, *w_down_e, *final_g;
    float* out; unsigned char* ws; int ph_lo, ph_hi;
};

__device__ __forceinline__ int tid_opaque() { int t = threadIdx.x; asm volatile("" : "+v"(t)); return t; }
__device__ __forceinline__ unsigned cvt_pk_bf16(float lo, float hi) { unsigned r; asm volatile("v_cvt_pk_bf16_f32 %0, %1, %2" : "=v"(r) : "v"(lo), "v"(hi)); return r; }
__device__ __forceinline__ float bf_lo(unsigned w) { return __uint_as_float(w << 16); }
__device__ __forceinline__ float bf_hi(unsigned w) { return __uint_as_float(w & 0xffff0000u); }
__device__ __forceinline__ float bf2f(bf16_t h) { return __uint_as_float(((unsigned)h) << 16); }
__device__ __forceinline__ float sigmoidf_(float v) { return __builtin_amdgcn_rcpf(1.0f + __expf(-v)); }
__device__ __forceinline__ float gelu_tanh(float v) { const float y = 1.5957691216f * (v + 0.044715f * v * v * v); return v * sigmoidf_(y); }
__device__ __forceinline__ float wave_sum(float v) {
#pragma unroll
    for (int o = 32; o >= 1; o >>= 1) v += __shfl_xor(v, o);
    return v;
}
__device__ __forceinline__ void unpack8(const u32x4 w, float (&f)[8]) { f[0] = bf_lo(w.x); f[1] = bf_hi(w.x); f[2] = bf_lo(w.y); f[3] = bf_hi(w.y); f[4] = bf_lo(w.z); f[5] = bf_hi(w.z); f[6] = bf_lo(w.w); f[7] = bf_hi(w.w); }

namespace pg8 {
constexpr int BM = 256, BK = 64, HALF = 128, HTB = HALF * BK * 2, STAGE_BYTES = 8 * HTB, NXCD = 8, WGM = 8;
__device__ __forceinline__ int lds_byte(int r, int c) { const int st = (r >> 4) * 2 + (c >> 5), rr = r & 15, cc = c & 31, ob = rr * 64 + cc * 2; return st * 1024 + (ob ^ (((ob >> 9) & 1) << 5)); }
__device__ __forceinline__ void stage_rc(int b, int& R, int& C) { const int st = b / 1024, sb = b % 1024, swz = sb ^ (((sb >> 9) & 1) << 5); R = (st >> 1) * 16 + swz / 64; C = (st & 1) * 32 + (swz % 64) / 2; }
__device__ __forceinline__ int perm32(int rho) { const int n = rho >> 4, i = rho & 15; return 8 * (i >> 2) + 4 * n + (i & 3); }
struct Unit { int pm, pn; };
struct Order {
    int nM, nN, nwg, G, c, base, lim;
    __device__ void init(int nM_, int nN_, int G_, int c_) { nM = nM_; nN = nN_; nwg = nM * nN; G = G_; c = c_; base = 0; lim = 0x7fffffff; }
    __device__ bool next(int i, Unit& u) const {
        const long L = (long)base + (long)i * G + c; if (i >= lim || L >= nwg) return false;
        int wgid = (int)L; { const int q = nwg / NXCD, r = nwg % NXCD, xcd = wgid % NXCD, off = wgid / NXCD; wgid = (xcd < r ? xcd * (q + 1) : r * (q + 1) + (xcd - r) * q) + off; }
        const int nig = WGM * nN, gid = wgid / nig, fm = gid * WGM, gsz = (nM - fm) < WGM ? (nM - fm) : WGM;
        u.pm = fm + ((wgid % nig) % gsz); u.pn = (wgid % nig) / gsz; return true;
    }
};
template <class P, class Epi>
__device__ __forceinline__ void gemm_phase(LAS unsigned char* lds, const P& pr, const Order& S, const Epi& E) {
    const int tid = threadIdx.x, wid = __builtin_amdgcn_readfirstlane(tid >> 6), lane = tid & 63, wr = wid >> 2, wc = wid & 3, fr = lane & 15, fq = lane >> 4;
    const int nt = pr.K / BK;
    int RA[2], CA[2]; unsigned voffB[2];
#pragma unroll
    for (int i = 0; i < 2; ++i) { int R, C; stage_rc(tid * 16 + i * 8192, R, C); RA[i] = R; CA[i] = C; const int Rb = Epi::PERM ? ((R & ~31) + perm32(R & 31)) : R; voffB[i] = (unsigned)(Rb * pr.ldb + C) * 2u; }
    const size_t kstep = (size_t)(BK * 2);
    const size_t hstepB = (size_t)HALF * pr.ldb * 2;
    const unsigned ldsw = (unsigned)wid * 1024u;
    const int aoff = lds_byte(wr * 64 + fr, fq * 8), boff = lds_byte(wc * 32 + fr, fq * 8);
#define PG8_SA(b, h) (((b) * 2 + (h)) * HTB)
#define PG8_SB(b, h) ((4 + (b) * 2 + (h)) * HTB)
#define PG8_STAGE(bufoff, gbase, voff) do { _Pragma("unroll") for (int _i = 0; _i < 2; ++_i) \
        __builtin_amdgcn_global_load_lds((const unsigned*)((const char*)(gbase) + (voff)[_i]), (LAS unsigned*)(lds + (bufoff) + ldsw + _i * 8192), 16, 0, 0); } while (0)
#define PG8_LDA(dst, b, h) do { _Pragma("unroll") for (int m = 0; m < 4; ++m) _Pragma("unroll") for (int k = 0; k < 2; ++k) dst[m][k] = *(const LAS bf16x8*)(lds + PG8_SA(b, h) + aoff + m * 2048 + k * 1024); } while (0)
#define PG8_LDB(dst, b, h) do { _Pragma("unroll") for (int n = 0; n < 2; ++n) _Pragma("unroll") for (int k = 0; k < 2; ++k) dst[n][k] = *(const LAS bf16x8*)(lds + PG8_SB(b, h) + boff + n * 2048 + k * 1024); } while (0)
#define PG8_MMA(ai, bj, At, Bt) do { __builtin_amdgcn_s_setprio(1); _Pragma("unroll") for (int m = 0; m < 4; ++m) _Pragma("unroll") for (int n = 0; n < 2; ++n) _Pragma("unroll") for (int k = 0; k < 2; ++k) \
        acc[ai][bj][m][n] = __builtin_amdgcn_mfma_f32_16x16x32_bf16(Bt[n][k], At[m][k], acc[ai][bj][m][n], 0, 0, 0); __builtin_amdgcn_s_setprio(0); } while (0)
#define PG8_WAIT_V(n) asm volatile("s_waitcnt vmcnt(" #n ")" ::: "memory")
#define PG8_WAIT_L(n) asm volatile("s_waitcnt lgkmcnt(" #n ")" ::: "memory")
#define PG8_BAR __builtin_amdgcn_s_barrier()
#define PG8_SCHED __builtin_amdgcn_sched_barrier(0)
    Unit cur, nxt; int ui = 0;
    if (!S.next(0, cur)) return;
    f32x4 acc[2][2][4][2];
#pragma unroll
    for (int a = 0; a < 2; ++a)
#pragma unroll
        for (int b = 0; b < 2; ++b)
#pragma unroll
            for (int m = 0; m < 4; ++m)
#pragma unroll
                for (int n = 0; n < 2; ++n) acc[a][b][m][n] = (f32x4){0.f, 0.f, 0.f, 0.f};
    bf16x8 At[4][2], B0[2][2], B1[2][2];
    unsigned vA[2][2], vN[2][2];
    pr.avoff(cur, RA, CA, vA);
#pragma unroll
    for (int h = 0; h < 2; ++h)
#pragma unroll
        for (int i = 0; i < 2; ++i) vN[h][i] = vA[h][i];
    const char* cA = pr.abase(cur); const char* cB = pr.bbase(cur);
#define PG8_ROT(u) 0
#define PG8_KT(tt, rot) ((size_t)(((tt) + (rot)) >= nt ? ((tt) + (rot)) - nt : ((tt) + (rot))) * kstep)
    int rot = PG8_ROT(cur);
    { const char* pA = cA + PG8_KT(0, rot); const char* pB = cB + PG8_KT(0, rot);
    PG8_STAGE(PG8_SB(0, 0), pB, voffB); PG8_STAGE(PG8_SA(0, 0), pA, vA[0]); PG8_STAGE(PG8_SB(0, 1), pB + hstepB, voffB); PG8_STAGE(PG8_SA(0, 1), pA, vA[1]);
    if (wr == 1) PG8_BAR;
    PG8_WAIT_V(4); PG8_BAR;
    PG8_STAGE(PG8_SB(1, 0), pB + kstep, voffB); PG8_STAGE(PG8_SA(1, 0), pA + kstep, vA[0]); PG8_STAGE(PG8_SB(1, 1), pB + hstepB + kstep, voffB); }
    PG8_WAIT_V(6); PG8_BAR;
    for (;;) {
        const bool has_next = S.next(ui + 1, nxt);
        const char* nA = has_next ? pr.abase(nxt) : cA; const char* nB = has_next ? pr.bbase(nxt) : cB; const int nrot = has_next ? PG8_ROT(nxt) : rot;
        if (P::GATHER) { if (has_next) pr.avoff(nxt, RA, CA, vN); }
        for (int t = 0; t < nt; t += 2) {
            const bool last = (t == nt - 2);
            const char* a1 = cA + PG8_KT(t + 1, rot);
            const char* a2 = last ? nA + PG8_KT(0, nrot) : cA + PG8_KT(t + 2, rot); const char* b2 = last ? nB + PG8_KT(0, nrot) : cB + PG8_KT(t + 2, rot);
            const char* a3 = a2 + kstep; const char* b3 = b2 + kstep;
            unsigned v2[2][2];
#pragma unroll
            for (int h = 0; h < 2; ++h)
#pragma unroll
                for (int i = 0; i < 2; ++i) v2[h][i] = (P::GATHER && last) ? vN[h][i] : vA[h][i];
            PG8_LDB(B0, 0, 0); PG8_SCHED; PG8_LDA(At, 0, 0); PG8_STAGE(PG8_SA(1, 1), a1, vA[1]);
            PG8_WAIT_L(8); PG8_BAR; PG8_WAIT_L(0); PG8_MMA(0, 0, At, B0); PG8_BAR; PG8_SCHED;
            PG8_LDB(B1, 0, 1); PG8_STAGE(PG8_SB(0, 0), b2, voffB);
            PG8_BAR; PG8_WAIT_L(0); PG8_MMA(0, 1, At, B1); PG8_BAR;
            PG8_LDA(At, 0, 1); PG8_STAGE(PG8_SA(0, 0), a2, v2[0]);
            PG8_BAR; PG8_WAIT_L(0); PG8_MMA(1, 0, At, B0); PG8_BAR; PG8_SCHED;
            PG8_STAGE(PG8_SB(0, 1), b2 + hstepB, voffB);
            PG8_WAIT_V(6); PG8_BAR; PG8_MMA(1, 1, At, B1); PG8_BAR;
            PG8_LDB(B0, 1, 0); PG8_SCHED; PG8_LDA(At, 1, 0); PG8_STAGE(PG8_SA(0, 1), a2, v2[1]);
            PG8_WAIT_L(8); PG8_BAR; PG8_WAIT_L(0); PG8_MMA(0, 0, At, B0); PG8_BAR; PG8_SCHED;
            PG8_LDB(B1, 1, 1); PG8_STAGE(PG8_SB(1, 0), b3, voffB);
            PG8_BAR; PG8_WAIT_L(0); PG8_MMA(0, 1, At, B1); PG8_BAR;
            PG8_LDA(At, 1, 1); PG8_STAGE(PG8_SA(1, 0), a3, v2[0]);
            PG8_BAR; PG8_WAIT_L(0); PG8_MMA(1, 0, At, B0); PG8_BAR; PG8_SCHED;
            PG8_STAGE(PG8_SB(1, 1), b3 + hstepB, voffB);
            PG8_WAIT_V(6); PG8_BAR; PG8_MMA(1, 1, At, B1); PG8_BAR;
            if (P::GATHER && last) {
#pragma unroll
                for (int h = 0; h < 2; ++h)
#pragma unroll
                    for (int i = 0; i < 2; ++i) vA[h][i] = vN[h][i];
            }
        }
        E(acc, cur, wr, wc, fr, fq);
        if (!has_next) break;
#pragma unroll
        for (int a = 0; a < 2; ++a)
#pragma unroll
            for (int b = 0; b < 2; ++b)
#pragma unroll
                for (int m = 0; m < 4; ++m)
#pragma unroll
                    for (int n = 0; n < 2; ++n) acc[a][b][m][n] = (f32x4){0.f, 0.f, 0.f, 0.f};
        cur = nxt; cA = nA; cB = nB; rot = nrot; ++ui;
    }
    PG8_WAIT_V(0);
    if (wr == 0) PG8_BAR;
    PG8_BAR;
#undef PG8_ROT
#undef PG8_KT
#undef PG8_SA
#undef PG8_SB
#undef PG8_STAGE
#undef PG8_LDA
#undef PG8_LDB
#undef PG8_MMA
#undef PG8_WAIT_V
#undef PG8_WAIT_L
#undef PG8_BAR
#undef PG8_SCHED
}
template <class P, class Epi>
__device__ __forceinline__ void gemm_phase2(LAS unsigned char* lds, const P& pr, const Order& S, const Epi& E) {
    const int tid = threadIdx.x, wid = __builtin_amdgcn_readfirstlane(tid >> 6), lane = tid & 63, wr = wid >> 2, wc = wid & 3, fr = lane & 15, fq = lane >> 4;
    const int nt1 = pr.K1 / BK, nt = (pr.K1 + pr.K2) / BK;
    unsigned R2[2], Rb2[2], C2[2];
#pragma unroll
    for (int i = 0; i < 2; ++i) { int R, C; stage_rc(tid * 16 + i * 8192, R, C); const int Rb = Epi::PERM ? ((R & ~31) + perm32(R & 31)) : R; R2[i] = (unsigned)R * 2u; Rb2[i] = (unsigned)Rb * 2u; C2[i] = (unsigned)C * 2u; }
#define OFF_A(ld, h, i) ((R2[i] + (unsigned)((h) * 256)) * (unsigned)(ld) + C2[i])
#define OFF_B(ld, i) (Rb2[i] * (unsigned)(ld) + C2[i])
    const size_t kstep = (size_t)(BK * 2);
    const size_t hB1 = (size_t)HALF * pr.ldb1 * 2, hB2 = (size_t)HALF * pr.ldb2 * 2;
    const unsigned ldsw = (unsigned)wid * 1024u;
    const int aoff = lds_byte(wr * 64 + fr, fq * 8), boff = lds_byte(wc * 32 + fr, fq * 8);
#define PG8_SA(b, h) (((b) * 2 + (h)) * HTB)
#define PG8_SB(b, h) ((4 + (b) * 2 + (h)) * HTB)
#define PG8_STAGE(bufoff, gbase, voff) do { _Pragma("unroll") for (int _i = 0; _i < 2; ++_i) \
        __builtin_amdgcn_global_load_lds((const unsigned*)((const char*)(gbase) + (voff)[_i]), (LAS unsigned*)(lds + (bufoff) + ldsw + _i * 8192), 16, 0, 0); } while (0)
#define PG8_LDA(dst, b, h) do { _Pragma("unroll") for (int m = 0; m < 4; ++m) _Pragma("unroll") for (int k = 0; k < 2; ++k) dst[m][k] = *(const LAS bf16x8*)(lds + PG8_SA(b, h) + aoff + m * 2048 + k * 1024); } while (0)
#define PG8_LDB(dst, b, h) do { _Pragma("unroll") for (int n = 0; n < 2; ++n) _Pragma("unroll") for (int k = 0; k < 2; ++k) dst[n][k] = *(const LAS bf16x8*)(lds + PG8_SB(b, h) + boff + n * 2048 + k * 1024); } while (0)
#define PG8_MMA(ai, bj, At, Bt) do { __builtin_amdgcn_s_setprio(1); _Pragma("unroll") for (int m = 0; m < 4; ++m) _Pragma("unroll") for (int n = 0; n < 2; ++n) _Pragma("unroll") for (int k = 0; k < 2; ++k) \
        acc[ai][bj][m][n] = __builtin_amdgcn_mfma_f32_16x16x32_bf16(Bt[n][k], At[m][k], acc[ai][bj][m][n], 0, 0, 0); __builtin_amdgcn_s_setprio(0); } while (0)
#define PG8_WAIT_V(n) asm volatile("s_waitcnt vmcnt(" #n ")" ::: "memory")
#define PG8_WAIT_L(n) asm volatile("s_waitcnt lgkmcnt(" #n ")" ::: "memory")
#define PG8_BAR __builtin_amdgcn_s_barrier()
#define PG8_SCHED __builtin_amdgcn_sched_barrier(0)
    Unit cur, nxt; int ui = 0;
    if (!S.next(0, cur)) return;
    f32x4 acc[2][2][4][2];
#pragma unroll
    for (int a = 0; a < 2; ++a)
#pragma unroll
        for (int b = 0; b < 2; ++b)
#pragma unroll
            for (int m = 0; m < 4; ++m)
#pragma unroll
                for (int n = 0; n < 2; ++n) acc[a][b][m][n] = (f32x4){0.f, 0.f, 0.f, 0.f};
    bf16x8 At[4][2], B0[2][2], B1[2][2];
    const char* cA1 = pr.abase1(cur); const char* cB1 = pr.bbase1(cur); const char* cA2 = pr.abase2(cur); const char* cB2 = pr.bbase2(cur);
#define T_A(tt) ((tt) < nt1 ? cA1 + (size_t)(tt) * kstep : cA2 + (size_t)((tt) - nt1) * kstep)
#define T_B(tt) ((tt) < nt1 ? cB1 + (size_t)(tt) * kstep : cB2 + (size_t)((tt) - nt1) * kstep)
    { unsigned vb[2] = {OFF_B(pr.ldb1, 0), OFF_B(pr.ldb1, 1)}, va0[2] = {OFF_A(pr.lda1, 0, 0), OFF_A(pr.lda1, 0, 1)}, va1[2] = {OFF_A(pr.lda1, 1, 0), OFF_A(pr.lda1, 1, 1)};
    PG8_STAGE(PG8_SB(0, 0), cB1, vb); PG8_STAGE(PG8_SA(0, 0), cA1, va0); PG8_STAGE(PG8_SB(0, 1), cB1 + hB1, vb); PG8_STAGE(PG8_SA(0, 1), cA1, va1);
    if (wr == 1) PG8_BAR;
    PG8_WAIT_V(4); PG8_BAR;
    PG8_STAGE(PG8_SB(1, 0), cB1 + kstep, vb); PG8_STAGE(PG8_SA(1, 0), cA1 + kstep, va0); PG8_STAGE(PG8_SB(1, 1), cB1 + hB1 + kstep, vb); }
    PG8_WAIT_V(6); PG8_BAR;
    for (;;) {
        const bool has_next = S.next(ui + 1, nxt);
        const char* nA = has_next ? pr.abase1(nxt) : cA1; const char* nB = has_next ? pr.bbase1(nxt) : cB1;
        for (int t = 0; t < nt; t += 2) {
            const bool last = (t == nt - 2);
            const bool s1 = (t + 1 < nt1), s2 = last || (t + 2 < nt1);
            const char* a1 = T_A(t + 1);
            const char* a2 = last ? nA : T_A(t + 2); const char* b2 = last ? nB : T_B(t + 2);
            const char* a3 = a2 + kstep; const char* b3 = b2 + kstep;
            const size_t hstepB = s2 ? hB1 : hB2; const int ldaT1 = s1 ? pr.lda1 : pr.lda2, ldaT2 = s2 ? pr.lda1 : pr.lda2, ldbT2 = s2 ? pr.ldb1 : pr.ldb2;
            unsigned v2[2][2], voffB[2], vA1s[2];
#pragma unroll
            for (int i = 0; i < 2; ++i) { voffB[i] = OFF_B(ldbT2, i); vA1s[i] = OFF_A(ldaT1, 1, i);
#pragma unroll
                for (int h = 0; h < 2; ++h) v2[h][i] = OFF_A(ldaT2, h, i); }
            PG8_LDB(B0, 0, 0); PG8_SCHED; PG8_LDA(At, 0, 0); PG8_STAGE(PG8_SA(1, 1), a1, vA1s);
            PG8_WAIT_L(8); PG8_BAR; PG8_WAIT_L(0); PG8_MMA(0, 0, At, B0); PG8_BAR; PG8_SCHED;
            PG8_LDB(B1, 0, 1); PG8_STAGE(PG8_SB(0, 0), b2, voffB);
            PG8_BAR; PG8_WAIT_L(0); PG8_MMA(0, 1, At, B1); PG8_BAR;
            PG8_LDA(At, 0, 1); PG8_STAGE(PG8_SA(0, 0), a2, v2[0]);
            PG8_BAR; PG8_WAIT_L(0); PG8_MMA(1, 0, At, B0); PG8_BAR; PG8_SCHED;
            PG8_STAGE(PG8_SB(0, 1), b2 + hstepB, voffB);
            PG8_WAIT_V(6); PG8_BAR; PG8_MMA(1, 1, At, B1); PG8_BAR;
            PG8_LDB(B0, 1, 0); PG8_SCHED; PG8_LDA(At, 1, 0); PG8_STAGE(PG8_SA(0, 1), a2, v2[1]);
            PG8_WAIT_L(8); PG8_BAR; PG8_WAIT_L(0); PG8_MMA(0, 0, At, B0); PG8_BAR; PG8_SCHED;
            PG8_LDB(B1, 1, 1); PG8_STAGE(PG8_SB(1, 0), b3, voffB);
            PG8_BAR; PG8_WAIT_L(0); PG8_MMA(0, 1, At, B1); PG8_BAR;
            PG8_LDA(At, 1, 1); PG8_STAGE(PG8_SA(1, 0), a3, v2[0]);
            PG8_BAR; PG8_WAIT_L(0); PG8_MMA(1, 0, At, B0); PG8_BAR; PG8_SCHED;
            PG8_STAGE(PG8_SB(1, 1), b3 + hstepB, voffB);
            PG8_WAIT_V(6); PG8_BAR; PG8_MMA(1, 1, At, B1); PG8_BAR;
            if (t == nt1 - 2) E.mid(acc, cur, wr, wc, fr, fq);
        }
        E(acc, cur, wr, wc, fr, fq);
        if (!has_next) break;
#pragma unroll
        for (int a = 0; a < 2; ++a)
#pragma unroll
            for (int b = 0; b < 2; ++b)
#pragma unroll
                for (int m = 0; m < 4; ++m)
#pragma unroll
                    for (int n = 0; n < 2; ++n) acc[a][b][m][n] = (f32x4){0.f, 0.f, 0.f, 0.f};
        cur = nxt; cA1 = nA; cB1 = nB; cA2 = pr.abase2(cur); cB2 = pr.bbase2(cur); ++ui;
    }
    PG8_WAIT_V(0);
    if (wr == 0) PG8_BAR;
    PG8_BAR;
#undef T_A
#undef T_B
#undef OFF_A
#undef OFF_B
#undef PG8_SA
#undef PG8_SB
#undef PG8_STAGE
#undef PG8_LDA
#undef PG8_LDB
#undef PG8_MMA
#undef PG8_WAIT_V
#undef PG8_WAIT_L
#undef PG8_BAR
#undef PG8_SCHED
}
}
using pg8::Unit;

struct ProbPlain {
    static constexpr bool GATHER = false;
    const bf16_t* A; const bf16_t* B; int K, lda, ldb;
    __device__ __forceinline__ const char* abase(const Unit& u) const { return (const char*)(A + (size_t)u.pm * 256 * lda); }
    __device__ __forceinline__ const char* bbase(const Unit& u) const { return (const char*)(B + (size_t)u.pn * 256 * ldb); }
    __device__ __forceinline__ void avoff(const Unit&, const int (&RA)[2], const int (&CA)[2], unsigned (&v)[2][2]) const {
#pragma unroll
        for (int h = 0; h < 2; ++h)
#pragma unroll
            for (int i = 0; i < 2; ++i) v[h][i] = (unsigned)((h * 128 + RA[i]) * lda + CA[i]) * 2u;
    }
};
struct ProbMerge {
    const bf16_t* A1; const bf16_t* B1; const bf16_t* A2; const bf16_t* B2; int K1, K2, lda1, ldb1, lda2, ldb2;
    __device__ __forceinline__ const char* abase1(const Unit& u) const { return (const char*)(A1 + (size_t)u.pm * 256 * lda1); }
    __device__ __forceinline__ const char* bbase1(const Unit& u) const { return (const char*)(B1 + (size_t)u.pn * 256 * ldb1); }
    __device__ __forceinline__ const char* abase2(const Unit& u) const { return (const char*)(A2 + (size_t)u.pm * 256 * lda2); }
    __device__ __forceinline__ const char* bbase2(const Unit& u) const { return (const char*)(B2 + (size_t)u.pn * 256 * ldb2); }
};
struct ProbPQ {
    static constexpr bool GATHER = false;
    const bf16_t* A; const bf16_t* B; int K, lda, ldb;
    __device__ __forceinline__ const char* abase(const Unit& u) const { return (const char*)(A + (size_t)u.pm * 256 * lda); }
    __device__ __forceinline__ const char* bbase(const Unit& u) const { return (const char*)(B + ((size_t)(u.pn >> 4) * 4096 + (u.pn & 15)) * 1024); }
    __device__ __forceinline__ void avoff(const Unit&, const int (&RA)[2], const int (&CA)[2], unsigned (&v)[2][2]) const {
#pragma unroll
        for (int h = 0; h < 2; ++h)
#pragma unroll
            for (int i = 0; i < 2; ++i) v[h][i] = (unsigned)((h * 128 + RA[i]) * lda + CA[i]) * 2u;
    }
};
struct ProbMoeUp {
    static constexpr bool GATHER = true;
    const bf16_t* A; const bf16_t* B; const int* idx; int K, lda, ldb;
    __device__ __forceinline__ const char* abase(const Unit&) const { return (const char*)A; }
    __device__ __forceinline__ const char* bbase(const Unit& u) const { return (const char*)(B + ((size_t)(u.pm >> 4) * 3072 + (size_t)u.pn * 256) * ldb); }
    __device__ __forceinline__ void avoff(const Unit& u, const int (&RA)[2], const int (&CA)[2], unsigned (&v)[2][2]) const {
#pragma unroll
        for (int h = 0; h < 2; ++h)
#pragma unroll
            for (int i = 0; i < 2; ++i) { const int g = idx[u.pm * 256 + h * 128 + RA[i]]; v[h][i] = (unsigned)(g * lda + CA[i]) * 2u; }
    }
};
struct ProbMoeDown {
    static constexpr bool GATHER = false;
    const bf16_t* A; const bf16_t* B; int K, lda, ldb;
    __device__ __forceinline__ const char* abase(const Unit& u) const { return (const char*)(A + (size_t)u.pm * 256 * lda); }
    __device__ __forceinline__ const char* bbase(const Unit& u) const { return (const char*)(B + ((size_t)(u.pm >> 4) * 1024 + (size_t)u.pn * 256) * ldb); }
    __device__ __forceinline__ void avoff(const Unit&, const int (&RA)[2], const int (&CA)[2], unsigned (&v)[2][2]) const {
#pragma unroll
        for (int h = 0; h < 2; ++h)
#pragma unroll
            for (int i = 0; i < 2; ++i) v[h][i] = (unsigned)((h * 128 + RA[i]) * lda + CA[i]) * 2u;
    }
};

#define EPI_ROWS(...) _Pragma("unroll") for (int ai = 0; ai < 2; ++ai) _Pragma("unroll") for (int m = 0; m < 4; ++m) { const int row = u.pm * 256 + ai * 128 + wr * 64 + m * 16 + fr; __VA_ARGS__ }
__device__ __forceinline__ u32x4 pack8(const f32x4 v0, const f32x4 v1) { u32x4 w; w.x = cvt_pk_bf16(v0[0], v0[1]); w.y = cvt_pk_bf16(v0[2], v0[3]); w.z = cvt_pk_bf16(v1[0], v1[1]); w.w = cvt_pk_bf16(v1[2], v1[3]); return w; }

struct EpiPQ {
    static constexpr bool PERM = true; bf16_t* O;
    __device__ __forceinline__ void operator()(const f32x4 (&acc)[2][2][4][2], const Unit& u, int wr, int wc, int fr, int fq) const {
        const int t10 = wc * 32 + 8 * fq, b = u.pn >> 4, t2 = u.pn & 15;
        EPI_ROWS(
            bf16_t* rp = O + ((size_t)((b * 512 + (row >> 1)) * 16 + t2) * 512 + (row & 1) * 256 + t10);
            _Pragma("unroll") for (int bj = 0; bj < 2; ++bj) *(u32x4*)(rp + bj * 128) = pack8(acc[ai][bj][m][0], acc[ai][bj][m][1]);
        )
    }
};
struct EpiPlain {
    static constexpr bool PERM = true; bf16_t* O; size_t ldc;
    __device__ __forceinline__ void operator()(const f32x4 (&acc)[2][2][4][2], const Unit& u, int wr, int wc, int fr, int fq) const {
        const int col0 = u.pn * 256 + wc * 32 + 8 * fq;
        EPI_ROWS(
            bf16_t* rp = O + (size_t)row * ldc + col0;
            _Pragma("unroll") for (int bj = 0; bj < 2; ++bj) *(u32x4*)(rp + bj * 128) = pack8(acc[ai][bj][m][0], acc[ai][bj][m][1]);
        )
    }
};
struct EpiZ {
    static constexpr bool PERM = true; bf16_t* O; int ldc; int fixed_act;
    __device__ __forceinline__ void operator()(const f32x4 (&acc)[2][2][4][2], const Unit& u, int wr, int wc, int fr, int fq) const {
        const int col0 = u.pn * 256 + wc * 32 + 8 * fq; const int act = fixed_act >= 0 ? fixed_act : (u.pn >> 2);
        EPI_ROWS(
            bf16_t* rp = O + (size_t)row * ldc + col0;
            _Pragma("unroll") for (int bj = 0; bj < 2; ++bj) {
                f32x4 v0 = acc[ai][bj][m][0], v1 = acc[ai][bj][m][1];
                if (act == 1) { _Pragma("unroll") for (int j = 0; j < 4; ++j) { v0[j] = gelu_tanh(v0[j]); v1[j] = gelu_tanh(v1[j]); } }
                else if (act >= 2) { _Pragma("unroll") for (int j = 0; j < 4; ++j) { v0[j] = sigmoidf_(v0[j]); v1[j] = sigmoidf_(v1[j]); } }
                *(u32x4*)(rp + bj * 128) = pack8(v0, v1); }
        )
    }
};
struct EpiMerge {
    static constexpr bool PERM = true; bf16_t* O; const bf16_t* Z;
    __device__ __forceinline__ void mid(f32x4 (&acc)[2][2][4][2], const Unit& u, int wr, int wc, int fr, int fq) const {
        unsigned eo = (unsigned)((u.pm * 256 + wr * 64 + fr) * 4096 + 2048 + u.pn * 256 + wc * 32 + 8 * fq);
        asm volatile("" : "+v"(eo));
#pragma unroll
        for (int ai = 0; ai < 2; ++ai) {
            u32x4 wa[4][2], wb[4][2];
#pragma unroll
            for (int m = 0; m < 4; ++m)
#pragma unroll
                for (int bj = 0; bj < 2; ++bj) { const unsigned o = eo + (unsigned)((ai * 128 + m * 16) * 4096 + bj * 128); wa[m][bj] = *(const u32x4*)(Z + o); wb[m][bj] = *(const u32x4*)(Z + o + 1024); }
#pragma unroll
            for (int m = 0; m < 4; ++m)
#pragma unroll
                for (int bj = 0; bj < 2; ++bj) { float ga[8], gb[8]; unpack8(wa[m][bj], ga); unpack8(wb[m][bj], gb);
#pragma unroll
                    for (int j = 0; j < 4; ++j) { acc[ai][bj][m][0][j] *= ga[j] * __builtin_amdgcn_rcpf(fmaxf(gb[j], 1e-30f)); acc[ai][bj][m][1][j] *= ga[4 + j] * __builtin_amdgcn_rcpf(fmaxf(gb[4 + j], 1e-30f)); } }
            __builtin_amdgcn_sched_barrier(0); }
    }
    __device__ __forceinline__ void operator()(const f32x4 (&acc)[2][2][4][2], const Unit& u, int wr, int wc, int fr, int fq) const {
        unsigned eo = (unsigned)((u.pm * 256 + wr * 64 + fr) * 4096 + 3072 + u.pn * 256 + wc * 32 + 8 * fq); asm volatile("" : "+v"(eo));
        unsigned oo = (unsigned)((u.pm * 256 + wr * 64 + fr) * 1024 + u.pn * 256 + wc * 32 + 8 * fq); asm volatile("" : "+v"(oo));
        u32x4 wb[2][4][2];
#pragma unroll
        for (int ai = 0; ai < 2; ++ai)
#pragma unroll
            for (int m = 0; m < 4; ++m)
#pragma unroll
                for (int bj = 0; bj < 2; ++bj) wb[ai][m][bj] = *(const u32x4*)(Z + eo + (unsigned)((ai * 128 + m * 16) * 4096 + bj * 128));
#pragma unroll
        for (int ai = 0; ai < 2; ++ai)
#pragma unroll
            for (int m = 0; m < 4; ++m)
#pragma unroll
                for (int bj = 0; bj < 2; ++bj) { float g[8]; unpack8(wb[ai][m][bj], g);
                    f32x4 v0 = acc[ai][bj][m][0], v1 = acc[ai][bj][m][1];
#pragma unroll
                    for (int j = 0; j < 4; ++j) { v0[j] *= g[j]; v1[j] *= g[4 + j]; }
                    *(u32x4*)(O + oo + (unsigned)((ai * 128 + m * 16) * 1024 + bj * 128)) = pack8(v0, v1); }
    }
};
struct EpiOut {
    static constexpr bool PERM = false; float* O; const float* X; const float* pos; const float* ada;
    __device__ __forceinline__ void operator()(const f32x4 (&acc)[2][2][4][2], const Unit& u, int wr, int wc, int fr, int fq) const {
        const int col0 = u.pn * 256 + wc * 32 + 4 * fq; const int b = u.pm >> 4;
        unsigned ro = (unsigned)((u.pm * 256 + wr * 64 + fr) * 1024 + col0); asm volatile("" : "+v"(ro));
#pragma unroll
        for (int ai = 0; ai < 2; ++ai) {
            f32x4 xv[4][2][2];
#pragma unroll
            for (int m = 0; m < 4; ++m)
#pragma unroll
                for (int bj = 0; bj < 2; ++bj)
#pragma unroll
                    for (int n = 0; n < 2; ++n) xv[m][bj][n] = *(const f32x4*)(X + ro + (unsigned)((ai * 128 + m * 16) * 1024 + bj * 128 + n * 16));
#pragma unroll
            for (int m = 0; m < 4; ++m) { const int row = u.pm * 256 + ai * 128 + wr * 64 + m * 16 + fr; const int t = row & 4095;
#pragma unroll
                for (int bj = 0; bj < 2; ++bj)
#pragma unroll
                    for (int n = 0; n < 2; ++n) { const int col = col0 + bj * 128 + n * 16;
                        const f32x4 pv = *(const f32x4*)(pos + (col < 512 ? (t >> 6) * 512 + col : (t & 63) * 512 + (col - 512)));
                        const f32x4 gv = *(const f32x4*)(ada + b * 6144 + 2048 + col);
                        *(f32x4*)(O + ro + (unsigned)((ai * 128 + m * 16) * 1024 + bj * 128 + n * 16)) = xv[m][bj][n] + pv + gv * acc[ai][bj][m][n]; } }
            __builtin_amdgcn_sched_barrier(0); }
    }
};
struct EpiGU {
    static constexpr bool PERM = true; bf16_t* O;
    __device__ __forceinline__ void operator()(const f32x4 (&acc)[2][2][4][2], const Unit& u, int wr, int wc, int fr, int fq) const {
        const int col0 = u.pn * 128 + wc * 32 + 8 * fq;
        EPI_ROWS(
            f32x4 v0, v1;
            _Pragma("unroll") for (int j = 0; j < 4; ++j) { const float g0 = acc[ai][0][m][0][j], g1 = acc[ai][0][m][1][j];
                v0[j] = g0 * sigmoidf_(g0) * acc[ai][1][m][0][j]; v1[j] = g1 * sigmoidf_(g1) * acc[ai][1][m][1][j]; }
            *(u32x4*)(O + (size_t)row * DE + col0) = pack8(v0, v1);
        )
    }
};
struct EpiDown {
    static constexpr bool PERM = true; bf16_t* O; const float* gate;
    __device__ __forceinline__ void operator()(const f32x4 (&acc)[2][2][4][2], const Unit& u, int wr, int wc, int fr, int fq) const {
        const int col0 = u.pn * 256 + wc * 32 + 8 * fq;
        EPI_ROWS(
            const float g = gate[row];
            _Pragma("unroll") for (int bj = 0; bj < 2; ++bj) *(u32x4*)(O + (size_t)row * 1024 + col0 + bj * 128) = pack8(acc[ai][bj][m][0] * g, acc[ai][bj][m][1] * g);
        )
    }
};

__device__ __forceinline__ void p0_ada(const Params& p, LAS unsigned char* lds, int item) {
    const int tid = threadIdx.x;
    LAS float* s = (LAS float*)lds; LAS float* red = s + 9 * 1024;
    for (int i = tid; i < 9 * 1024; i += NTHR) { const int r = i >> 10, d = i & 1023; const float v = r < 8 ? p.c[r * 1024 + d] : p.c_ctx[d]; s[i] = v / (1.0f + expf(-v)); }
    __syncthreads();
    const int col = tid & 63, ds = tid >> 6; float a[9];
#pragma unroll
    for (int r = 0; r < 9; ++r) a[r] = 0.f;
    const float* w = p.w_ada + (size_t)(ds * 128) * 6144 + item * 64 + col;
    for (int d0 = 0; d0 < 128; d0 += 32) { float wv[32];
#pragma unroll
        for (int j = 0; j < 32; ++j) wv[j] = w[(size_t)(d0 + j) * 6144];
#pragma unroll
        for (int j = 0; j < 32; ++j)
#pragma unroll
            for (int r = 0; r < 9; ++r) a[r] += s[r * 1024 + ds * 128 + d0 + j] * wv[j]; }
#pragma unroll
    for (int r = 0; r < 9; ++r) red[(ds * 9 + r) * 64 + col] = a[r];
    __syncthreads();
    float* ada = (float*)(p.ws + WS_ADA);
    for (int i = tid; i < 9 * 64; i += NTHR) { const int r = i >> 6, cc = i & 63; float v = 0.f;
#pragma unroll
        for (int k = 0; k < 8; ++k) v += red[(k * 9 + r) * 64 + cc];
        ada[r * 6144 + item * 64 + cc] = v + p.b_ada[item * 64 + cc]; }
    __syncthreads();
}
template <int NS>
__device__ __forceinline__ void xpose_item(const float* src, int ldsrc, bf16_t* dst, int lddst, int k0, int n0, int mode) {
    const int tid = threadIdx.x, nl = tid & 63, k8 = tid >> 6;
    float v[NS][8];
#pragma unroll
    for (int s = 0; s < NS; ++s)
#pragma unroll
        for (int j = 0; j < 8; ++j) v[s][j] = src[(size_t)(k0 + 8 * k8 + j) * ldsrc + n0 + 64 * s + nl];
#pragma unroll
    for (int s = 0; s < NS; ++s) { const int n = n0 + 64 * s + nl; int row = n;
        if (mode) row = (n >> 7) * 256 + (n & 127) + (mode == 2 ? 128 : 0);
        u32x4 w; w.x = cvt_pk_bf16(v[s][0], v[s][1]); w.y = cvt_pk_bf16(v[s][2], v[s][3]); w.z = cvt_pk_bf16(v[s][4], v[s][5]); w.w = cvt_pk_bf16(v[s][6], v[s][7]);
        *(u32x4*)(dst + (size_t)row * lddst + k0 + 8 * k8) = w; }
}
__device__ __forceinline__ void p0_wpq(const Params& p, LAS unsigned char* lds, int item) {
    const int tid = threadIdx.x, g = item >> 6, db = item & 63;
    LAS float* wl = (LAS float*)lds; LAS float* ct = wl + 16 * 129;
    for (int i = tid; i < 16 * 128; i += NTHR) { const int d = i >> 7, cc = i & 127; wl[d * 129 + cc] = p.w_in[(size_t)(db * 16 + d) * 4608 + g * 128 + cc]; }
    if (tid < 128) { float sn, cs; sincospif((float)tid * (1.0f / 64.0f), &sn, &cs); ct[tid] = cs; ct[128 + tid] = sn; }
    __syncthreads();
    const int q = tid & 255, kc = q >> 1, pq = q & 1, dh = tid >> 8; const int n = (g * 128 + kc) * 2 + pq;
    bf16_t* dst = (bf16_t*)(p.ws + WS_WPQ) + (size_t)n * 1024 + db * 16 + dh * 8;
    const float scale = 0.001381067932f;
    float a[8];
#pragma unroll
    for (int j = 0; j < 8; ++j) a[j] = 0.f;
    for (int cc = 0; cc < 128; ++cc) { const float tv = ct[pq * 128 + ((cc * kc) & 127)];
#pragma unroll
        for (int j = 0; j < 8; ++j) a[j] += wl[(dh * 8 + j) * 129 + cc] * tv; }
    u32x4 w; w.x = cvt_pk_bf16(a[0] * scale, a[1] * scale); w.y = cvt_pk_bf16(a[2] * scale, a[3] * scale); w.z = cvt_pk_bf16(a[4] * scale, a[5] * scale); w.w = cvt_pk_bf16(a[6] * scale, a[7] * scale);
    *(u32x4*)dst = w;
    __syncthreads();
}
__device__ __forceinline__ void p0_d1t(const Params& p, int item) {
    bf16_t* dst = (bf16_t*)(p.ws + WS_D1T);
    const int row = item * 64 + (threadIdx.x >> 3), k1 = row >> 1, ri = row & 1, c0 = (threadIdx.x & 7) * 64;
    for (int c8 = 0; c8 < 64; c8 += 8) { float v[8];
#pragma unroll
        for (int j = 0; j < 8; ++j) { const int col = c0 + c8 + j, pq = col >> 8, t1 = col & 255; float sn, cs; sincospif((float)((k1 * t1) & 255) * (1.0f / 128.0f), &sn, &cs);
            v[j] = (ri == 0) ? (pq == 0 ? cs : -sn) : (pq == 0 ? -sn : -cs); }
        u32x4 w; w.x = cvt_pk_bf16(v[0], v[1]); w.y = cvt_pk_bf16(v[2], v[3]); w.z = cvt_pk_bf16(v[4], v[5]); w.w = cvt_pk_bf16(v[6], v[7]);
        *(u32x4*)(dst + (size_t)row * 512 + c0 + c8) = w; }
}
__device__ __forceinline__ void p0_d2t(const Params& p, int item) {
    bf16_t* dst = (bf16_t*)(p.ws + WS_D2T);
#pragma unroll
    for (int ps = 0; ps < 4; ++ps) { const int pc = (item * 4 + ps) * NTHR + threadIdx.x, tp = pc >> 2, kk0 = (pc & 3) * 8; float v[8];
#pragma unroll
        for (int j = 0; j < 8; ++j) { const int kk = kk0 + j, ri = kk >> 4, t2 = kk & 15; float sn, cs; sincospif((float)((tp * t2) & 4095) * (1.0f / 2048.0f), &sn, &cs); v[j] = ri ? sn : cs; }
        u32x4 w; w.x = cvt_pk_bf16(v[0], v[1]); w.y = cvt_pk_bf16(v[2], v[3]); w.z = cvt_pk_bf16(v[4], v[5]); w.w = cvt_pk_bf16(v[6], v[7]);
        *(u32x4*)(dst + (size_t)tp * 32 + kk0) = w; }
}
__device__ __forceinline__ void p0_pos(const Params& p) {
    float* tab = (float*)(p.ws + WS_POS);
    for (int i = threadIdx.x; i < 64 * 512; i += NTHR) { const int ii = i >> 9, j = i & 511, jj = j & 255; const float f = expf(-9.210340371976184f * (float)jj / 256.0f); const float a = (float)ii * f; tab[i] = j < 256 ? sinf(a) : cosf(a); }
}
__device__ __forceinline__ void phase0(const Params& p, LAS unsigned char* lds) {
    constexpr int N_ADA = 96, N_WIN = 16 * 16, N_WFOUR = 8 * 4, N_SQ = 16 * 4, N_LRU = 16 * 2, N_WPQ = 256, N_DFT = 8 + 8, N_POS = 1;
    constexpr int O1 = N_ADA, O2 = O1 + N_WIN, O3 = O2 + N_WFOUR, O4 = O3 + N_SQ, O5 = O4 + N_SQ, O6 = O5 + N_LRU, O7 = O6 + N_LRU, O8 = O7 + N_WPQ, O9 = O8 + N_DFT, O10 = O9 + N_POS;
    for (int it = blockIdx.x; it < O10; it += gridDim.x) {
        if (it < O1) p0_ada(p, lds, it);
        else if (it < O2) { const int j = it - O1; xpose_item<4>(p.w_in + 512, 4608, (bf16_t*)(p.ws + WS_WIN), 1024, (j >> 4) * 64, (j & 15) * 256, 0); }
        else if (it < O3) { const int j = it - O2; xpose_item<4>(p.w_four, 1024, (bf16_t*)(p.ws + WS_WFOUR), 512, (j >> 2) * 64, (j & 3) * 256, 0); }
        else if (it < O4) { const int j = it - O3; xpose_item<4>(p.w_lru, 1024, (bf16_t*)(p.ws + WS_WLRU), 1024, (j >> 2) * 64, (j & 3) * 256, 0); }
        else if (it < O5) { const int j = it - O4; xpose_item<4>(p.w_out, 1024, (bf16_t*)(p.ws + WS_WOUT), 1024, (j >> 2) * 64, (j & 3) * 256, 0); }
        else if (it < O6) { const int j = it - O5, mtx = j >> 1; xpose_item<2>(p.lru_wa + (size_t)mtx * 16384, 128, (bf16_t*)(p.ws + WS_WAT) + (size_t)mtx * 16384, 128, (j & 1) * 64, 0, 0); }
        else if (it < O7) { const int j = it - O6, mtx = j >> 1; xpose_item<2>(p.lru_wi + (size_t)mtx * 16384, 128, (bf16_t*)(p.ws + WS_WIT) + (size_t)mtx * 16384, 128, (j & 1) * 64, 0, 0); }
        else if (it < O8) p0_wpq(p, lds, it - O7);
        else if (it < O9) { if (it - O8 < 8) p0_d1t(p, it - O8); else p0_d2t(p, it - O8 - 8); }
        else p0_pos(p);
    }
}

__device__ __forceinline__ void phase1(const Params& p) {
    const int tid = tid_opaque(), lane = tid & 63, wid = tid >> 6;
    const float* ada = (const float*)(p.ws + WS_ADA); const float* tab = (const float*)(p.ws + WS_POS);
    bf16_t* h1 = (bf16_t*)(p.ws + WS_R1); bf16_t* hc = (bf16_t*)(p.ws + WS_HCTX);
    constexpr int NR = MLAT + MCTX, RW = 4;
    for (int row0 = (blockIdx.x * 8 + wid) * RW; row0 < NR; row0 += gridDim.x * 8 * RW) {
        const bool lat = row0 < MLAT; const int mrow = lat ? (row0 >> 12) : 8;
        f32x4 v[RW][4]; float ss[RW];
#pragma unroll
        for (int r = 0; r < RW; ++r) { const int row = row0 + r; const float* xr = lat ? p.x + (size_t)row * 1024 : p.ctx + (size_t)(row - MLAT) * 1024;
#pragma unroll
            for (int i = 0; i < 4; ++i) v[r][i] = *(const f32x4*)(xr + 256 * i + 4 * lane); }
#pragma unroll
        for (int r = 0; r < RW; ++r) { const int t = (row0 + r) & 4095; float a = 0.f;
#pragma unroll
            for (int i = 0; i < 4; ++i) { const int d = 256 * i + 4 * lane;
                if (lat) v[r][i] += *(const f32x4*)(tab + (i < 2 ? (t >> 6) * 512 + d : (t & 63) * 512 + d - 512));
                a += v[r][i][0] * v[r][i][0] + v[r][i][1] * v[r][i][1] + v[r][i][2] * v[r][i][2] + v[r][i][3] * v[r][i][3]; }
            ss[r] = a; }
#pragma unroll
        for (int o = 32; o >= 1; o >>= 1) {
#pragma unroll
            for (int r = 0; r < RW; ++r) ss[r] += __shfl_xor(ss[r], o); }
#pragma unroll
        for (int i = 0; i < 4; ++i) { const int d = 256 * i + 4 * lane;
            const f32x4 g = *(const f32x4*)(p.norm1_g + d), sh = *(const f32x4*)(ada + mrow * 6144 + d), sc = *(const f32x4*)(ada + mrow * 6144 + 1024 + d);
#pragma unroll
            for (int r = 0; r < RW; ++r) { const int row = row0 + r; const float rs = rsqrtf(ss[r] * (1.0f / 1024.0f) + 1e-6f);
                bf16_t* dst = lat ? h1 + (size_t)row * 1024 : hc + (size_t)(row - MLAT) * 1024;
                const f32x4 h = v[r][i] * rs * g * (sc + 1.0f) + sh;
                u32x2 w; w.x = cvt_pk_bf16(h[0], h[1]); w.y = cvt_pk_bf16(h[2], h[3]); *(u32x2*)(dst + d) = w; } }
    }
}

#define LRU_CST(mb, r) (32 * (mb) + 8 * ((r) >> 2) + ((r) & 3))
template <bool FINAL, int DIR>
__device__ __forceinline__ void lru_wave(const Params& p, LAS unsigned char* ul, int b, int sc, int head, int cb, int lane, f32x16 (&accI)[4]) {
    constexpr int SG = DIR ? -1 : 1;
    const int lr = lane & 31, lh = lane >> 5;
    const int chl = cb * 32 + lr, ch = head * 128 + chl;
    const int tbase = DIR ? 127 - 4 * lh : 4 * lh;
    f32x16 accA[4];
#pragma unroll
    for (int mb = 0; mb < 4; ++mb)
#pragma unroll
        for (int r = 0; r < 16; ++r) { accA[mb][r] = 0.f; accI[mb][r] = 0.f; }
    {
        const bf16_t* wa = (const bf16_t*)(p.ws + WS_WAT) + ((size_t)(DIR * 8 + head) * 128 + chl) * 128 + 8 * lh;
        const bf16_t* wi = (const bf16_t*)(p.ws + WS_WIT) + ((size_t)(DIR * 8 + head) * 128 + chl) * 128 + 8 * lh;
        LAS unsigned char* arow0 = ul + (DIR ? 127 - lr : lr) * 272 + lh * 16;
#pragma unroll
        for (int kc = 0; kc < 2; ++kc) { bf16x8 bA[4], bI[4];
#pragma unroll
            for (int k4 = 0; k4 < 4; ++k4) { bA[k4] = *(const bf16x8*)(wa + 16 * (kc * 4 + k4)); bI[k4] = *(const bf16x8*)(wi + 16 * (kc * 4 + k4)); }
#pragma unroll
            for (int mb = 0; mb < 4; ++mb)
#pragma unroll
                for (int k4 = 0; k4 < 4; ++k4) { const bf16x8 af = *(const LAS bf16x8*)(arow0 + SG * 32 * mb * 272 + 32 * (kc * 4 + k4));
                    accA[mb] = __builtin_amdgcn_mfma_f32_32x32x16_bf16(af, bA[k4], accA[mb], 0, 0, 0);
                    accI[mb] = __builtin_amdgcn_mfma_f32_32x32x16_bf16(af, bI[k4], accI[mb], 0, 0, 0); }
            __builtin_amdgcn_sched_barrier(0); }
    }
    {
        const float lam = p.lru_lambda[DIR * 1024 + ch]; const float sp8 = 8.0f * log1pf(expf(-lam));
        const float ba = p.lru_ba[DIR * 1024 + ch], bi = p.lru_bi[DIR * 1024 + ch];
        LAS unsigned char* up = ul + tbase * 272 + chl * 2;
#pragma unroll
        for (int mb = 0; mb < 4; ++mb) {
#pragma unroll
            for (int r = 0; r < 16; ++r) {
                const float uv = bf2f(*(const LAS bf16_t*)(up + SG * LRU_CST(mb, r) * 272));
                const float rg = sigmoidf_(accA[mb][r] + ba), ig = sigmoidf_(accI[mb][r] + bi);
                const float a = __expf(-sp8 * rg); accA[mb][r] = a; accI[mb][r] = __builtin_amdgcn_sqrtf(fmaxf(1.0f - a * a, 0.f)) * ig * uv; }
            __builtin_amdgcn_sched_barrier(0); }
    }
    float rA[16], rH[16];
#pragma unroll
    for (int mb = 0; mb < 4; ++mb)
#pragma unroll
        for (int q = 0; q < 4; ++q) { float pa = 1.f, hh = 0.f;
#pragma unroll
            for (int j = 0; j < 4; ++j) { const int r = 4 * q + j; const float a = accA[mb][r], bb = accI[mb][r]; hh = a * hh + bb; pa *= a; accA[mb][r] = pa; accI[mb][r] = hh; }
            rA[mb * 4 + q] = pa; rH[mb * 4 + q] = hh; }
    const int agg_dir_off = ((b * NSEQ) * 2 + DIR) * 1024 + ch;
    const float* agg = (const float*)(p.ws + WS_AGG);
    float carry = 0.f;
    if (FINAL) {
        if (DIR == 0) { for (int q = 0; q < sc; ++q) { const float* a2 = agg + (size_t)(agg_dir_off + q * 2048) * 2; carry = a2[0] * carry + a2[1]; } }
        else { { const float* a2 = agg + (size_t)(agg_dir_off + 1 * 2048) * 2; carry = a2[0] * carry + a2[1]; } { const float* a2 = agg + (size_t)(agg_dir_off + 0 * 2048) * 2; carry = a2[0] * carry + a2[1]; }
            for (int q = NSEQ - 1; q > sc; --q) { const float* a2 = agg + (size_t)(agg_dir_off + q * 2048) * 2; carry = a2[0] * carry + a2[1]; } }
    }
    float cin[16];
#pragma unroll
    for (int i = 0; i < 16; ++i) cin[i] = 0.f;
    float s = carry, At = 1.f;
#pragma unroll
    for (int i = 0; i < 16; ++i) { const float oA = __shfl_xor(rA[i], 32), oH = __shfl_xor(rH[i], 32);
        { const bool mine = (lh == 0); const float a = mine ? rA[i] : oA, hh = mine ? rH[i] : oH; cin[i] = mine ? s : cin[i]; s = a * s + hh; At *= a; }
        { const bool mine = (lh == 1); const float a = mine ? rA[i] : oA, hh = mine ? rH[i] : oH; cin[i] = mine ? s : cin[i]; s = a * s + hh; At *= a; } }
    if (!FINAL) {
        if (lh == 0) { float* o = (float*)(p.ws + WS_AGG) + (size_t)(agg_dir_off + sc * 2048) * 2; o[0] = At; o[1] = s; }
        return;
    }
#pragma unroll
    for (int mb = 0; mb < 4; ++mb)
#pragma unroll
        for (int r = 0; r < 16; ++r) accI[mb][r] += accA[mb][r] * cin[mb * 4 + (r >> 2)];
}
template <bool FINAL>
__device__ __forceinline__ void lru_tile(const Params& p, LAS unsigned char* lds, int item) {
    const int tid = threadIdx.x, lane = tid & 63, wid = __builtin_amdgcn_readfirstlane(tid >> 6);
    int b, sc, head;
    if (FINAL) { head = item & 7; sc = 2 + ((item >> 3) & 31); b = item >> 8; }
    else { head = item & 7; const int r = item >> 3; sc = r & 1; b = r >> 1; }
    const bf16_t* src; int Tseq, t0, ld;
    if (sc < 2) { src = (const bf16_t*)(p.ws + WS_ZXC) + (size_t)b * 256 * 1024; Tseq = 256; t0 = sc * 128; ld = 1024; }
    else { src = (const bf16_t*)(p.ws + WS_RZ) + (size_t)b * 4096 * 4096; Tseq = 4096; t0 = (sc - 2) * 128; ld = 4096; }
    LAS unsigned char* ul = lds;
    LAS float* ybuf = (LAS float*)(lds + 36 * 1024);
    {
        const int c8 = tid & 15, tb = tid >> 4; const int ch0 = head * 128 + 8 * c8;
        float w[4][8], bias[8];
#pragma unroll
        for (int k = 0; k < 4; ++k) { const f32x4 a = *(const f32x4*)(p.conv_w + k * 1024 + ch0), c2 = *(const f32x4*)(p.conv_w + k * 1024 + ch0 + 4);
#pragma unroll
            for (int j = 0; j < 4; ++j) { w[k][j] = a[j]; w[k][4 + j] = c2[j]; } }
        { const f32x4 a = *(const f32x4*)(p.conv_b + ch0), c2 = *(const f32x4*)(p.conv_b + ch0 + 4);
#pragma unroll
            for (int j = 0; j < 4; ++j) { bias[j] = a[j]; bias[4 + j] = c2[j]; } }
#pragma unroll
        for (int i = 0; i < 4; ++i) { const int t = tb + 32 * i; float a[8];
#pragma unroll
            for (int j = 0; j < 8; ++j) a[j] = bias[j];
#pragma unroll
            for (int k = 0; k < 4; ++k) { const int tt = t0 + t + k - 2;
                if (tt >= 0 && tt < Tseq) { float f[8]; unpack8(*(const u32x4*)(src + (size_t)tt * ld + ch0), f);
#pragma unroll
                    for (int j = 0; j < 8; ++j) a[j] += w[k][j] * f[j]; } }
            u32x4 wv; wv.x = cvt_pk_bf16(a[0], a[1]); wv.y = cvt_pk_bf16(a[2], a[3]); wv.z = cvt_pk_bf16(a[4], a[5]); wv.w = cvt_pk_bf16(a[6], a[7]);
            *(LAS u32x4*)(ul + t * 272 + c8 * 16) = wv; }
    }
    __syncthreads();
    f32x16 hacc[4];
    if (wid < 4) lru_wave<FINAL, 0>(p, ul, b, sc, head, wid & 3, lane, hacc);
    else lru_wave<FINAL, 1>(p, ul, b, sc, head, wid & 3, lane, hacc);
    if (FINAL) {
        const int lr = lane & 31, lh = lane >> 5, chl = (wid & 3) * 32 + lr;
        if (wid >= 4) { LAS float* yp = ybuf + (127 - 4 * lh) * 129 + chl;
#pragma unroll
            for (int mb = 0; mb < 4; ++mb)
#pragma unroll
                for (int r = 0; r < 16; ++r) yp[-LRU_CST(mb, r) * 129] = hacc[mb][r]; }
        __syncthreads();
        if (wid < 4) {
            const LAS float* yp = ybuf + (4 * lh) * 129 + chl;
            const bf16_t* Zu = (const bf16_t*)(p.ws + WS_RZ) + ((size_t)(b * 4096 + t0) * 4096 + 1024 + head * 128);
            bf16_t* Ou = (bf16_t*)(p.ws + WS_R1) + ((size_t)(b * 4096 + t0) * 1024 + head * 128);
            const unsigned zo = (unsigned)(4 * lh * 4096 + chl), oo = (unsigned)(4 * lh * 1024 + chl);
#pragma unroll
            for (int mb = 0; mb < 4; ++mb) {
#pragma unroll
                for (int r = 0; r < 16; ++r) {
                    const float y = hacc[mb][r] + yp[LRU_CST(mb, r) * 129];
                    const float gz = bf2f(Zu[zo + LRU_CST(mb, r) * 4096]);
                    Ou[oo + LRU_CST(mb, r) * 1024] = (bf16_t)(cvt_pk_bf16(gz * y, 0.f) & 0xffffu);
                    if ((r & 7) == 7) __builtin_amdgcn_sched_barrier(0); } }
        }
    }
    __syncthreads();
}

#ifndef LRU_PF_FRAG
#define LRU_PF_FRAG true
#endif
#ifndef LRU_PF_TILE
#define LRU_PF_TILE true
#endif
typedef unsigned long long u64_t;
template <int DIR, bool PREF>
__device__ __forceinline__ void lru2_dir(const Params& p, LAS unsigned char* ul, int head, int w, int lane, const bf16x8 (&bA)[4], const bf16x8 (&bI)[4], bf16x8 (&nA)[4], bf16x8 (&nI)[4],
                                         f32x4 (&hl)[8], f32x4 (&pp)[8], float& Atot, float& Htot) {
    constexpr int SG = DIR ? -1 : 1;
    const int fr = lane & 15, fq = lane >> 4, chl = 16 * w + fr, ch = head * 128 + chl;
    f32x4 accA[8], accI[8];
#pragma unroll
    for (int rb = 0; rb < 8; ++rb) { accA[rb] = (f32x4){0.f, 0.f, 0.f, 0.f}; accI[rb] = (f32x4){0.f, 0.f, 0.f, 0.f}; }
    {
        LAS unsigned char* arow0 = ul + (DIR ? 127 - fr : fr) * 272 + fq * 16;
#pragma unroll
        for (int rb = 0; rb < 8; ++rb)
#pragma unroll
            for (int ks = 0; ks < 4; ++ks) { const bf16x8 af = *(const LAS bf16x8*)(arow0 + SG * 16 * rb * 272 + 64 * ks);
                accA[rb] = __builtin_amdgcn_mfma_f32_16x16x32_bf16(af, bA[ks], accA[rb], 0, 0, 0);
                accI[rb] = __builtin_amdgcn_mfma_f32_16x16x32_bf16(af, bI[ks], accI[rb], 0, 0, 0); }
    }
    if (PREF) {
        const bf16_t* wa = (const bf16_t*)(p.ws + WS_WAT) + ((size_t)((1 - DIR) * 8 + head) * 128 + chl) * 128 + 8 * fq;
        const bf16_t* wi = (const bf16_t*)(p.ws + WS_WIT) + ((size_t)((1 - DIR) * 8 + head) * 128 + chl) * 128 + 8 * fq;
#pragma unroll
        for (int ks = 0; ks < 4; ++ks) { nA[ks] = *(const bf16x8*)(wa + 32 * ks); nI[ks] = *(const bf16x8*)(wi + 32 * ks); }
    }
    {
        const float lam = p.lru_lambda[DIR * 1024 + ch]; const float sp8 = 8.0f * log1pf(expf(-lam));
        const float ba = p.lru_ba[DIR * 1024 + ch], bi = p.lru_bi[DIR * 1024 + ch];
        LAS unsigned char* up = ul + (DIR ? 127 - 4 * fq : 4 * fq) * 272 + chl * 2;
#pragma unroll
        for (int rb = 0; rb < 8; ++rb)
#pragma unroll
            for (int r = 0; r < 4; ++r) {
                const float uv = bf2f(*(const LAS bf16_t*)(up + SG * (16 * rb + r) * 272));
                const float rg = sigmoidf_(accA[rb][r] + ba), ig = sigmoidf_(accI[rb][r] + bi);
                const float a = __expf(-sp8 * rg); accA[rb][r] = a; accI[rb][r] = __builtin_amdgcn_sqrtf(fmaxf(1.0f - a * a, 0.f)) * ig * uv;
                if (r == 3 && (rb & 1)) __builtin_amdgcn_sched_barrier(0); }
    }
    float rA[8], rH[8];
#pragma unroll
    for (int rb = 0; rb < 8; ++rb) { float pa = 1.f, hh = 0.f;
#pragma unroll
        for (int r = 0; r < 4; ++r) { const float a = accA[rb][r], bb = accI[rb][r]; hh = a * hh + bb; pa *= a; accA[rb][r] = pa; accI[rb][r] = hh; }
        rA[rb] = pa; rH[rb] = hh; }
    float Pc = 1.f, s = 0.f;
#pragma unroll
    for (int rb = 0; rb < 8; ++rb) { float Pin = 1.f, Hin = 0.f;
#pragma unroll
        for (int q = 0; q < 4; ++q) { const float a = __shfl(rA[rb], fr + 16 * q), hh = __shfl(rH[rb], fr + 16 * q);
            if (q == fq) { Pin = Pc; Hin = s; }
            s = a * s + hh; Pc *= a; }
#pragma unroll
        for (int r = 0; r < 4; ++r) { hl[rb][r] = accI[rb][r] + accA[rb][r] * Hin; pp[rb][r] = accA[rb][r] * Pin; }
        __builtin_amdgcn_sched_barrier(0); }
    Atot = Pc; Htot = s;
}
__device__ __forceinline__ u64_t agg_ld(const u64_t* a) { return __hip_atomic_load(a, __ATOMIC_RELAXED, __HIP_MEMORY_SCOPE_AGENT); }
template <int DIR>
__device__ __forceinline__ float lru2_carry(const u64_t* aggc, int n, int fr, int fq) {
    float Ap = 1.f, Hp = 0.f; u64_t v[9];
#pragma unroll
    for (int k = 0; k < 9; ++k) { const int j = fq * 9 + k; const int seq = DIR ? (j == 0 ? 1 : (j == 1 ? 0 : 35 - j)) : j;
        v[k] = (j < n) ? agg_ld(aggc + (size_t)seq * 2048) : 0x000000003f800000ull; }
#pragma unroll
    for (int k = 0; k < 9; ++k) { const float a = __uint_as_float((unsigned)v[k]), hh = __uint_as_float((unsigned)(v[k] >> 32)); Hp = a * Hp + hh; Ap *= a; }
    float s = 0.f;
#pragma unroll
    for (int q = 0; q < 4; ++q) { const float a = __shfl(Ap, fr + 16 * q), hh = __shfl(Hp, fr + 16 * q); s = a * s + hh; }
    return s;
}
__device__ __forceinline__ void lru2_block(const Params& p, LAS unsigned char* lds, int slot, int c, int ngr) {
    const int tid = threadIdx.x, lane = tid & 63, wid = __builtin_amdgcn_readfirstlane(tid >> 6);
    const int sc = c + 2, t0 = c * 128;
    LAS unsigned char* raw = lds;
    LAS unsigned char* ul = lds + 33792;
    LAS unsigned char* gzl = lds + 68608;
    LAS unsigned char* outl = lds + 103424;
    const int fr = lane & 15, fq = lane >> 4, chl = 16 * wid + fr;
    u32x4 nr[5], ng[4];
#define LRU2_LOAD(gg) do { const bf16_t* Zb_ = (const bf16_t*)(p.ws + WS_RZ) + (size_t)((gg) >> 3) * 4096 * 4096 + ((gg) & 7) * 128; \
        _Pragma("unroll") for (int k = 0; k < 5; ++k) { const int pc = tid + NTHR * k; nr[k] = (u32x4){0u, 0u, 0u, 0u}; \
            if (pc < 131 * 16) { const int row = pc >> 4, c8 = pc & 15, tt = t0 - 2 + row; if (tt >= 0 && tt < TT) nr[k] = *(const u32x4*)(Zb_ + (size_t)tt * 4096 + c8 * 8); } } \
        _Pragma("unroll") for (int k = 0; k < 4; ++k) { const int pc = tid + NTHR * k, row = pc >> 4, c8 = pc & 15; ng[k] = *(const u32x4*)(Zb_ + (size_t)(t0 + row) * 4096 + 1024 + c8 * 8); } } while (0)
    LRU2_LOAD(slot);
    for (int g = slot; g < NB * 8; g += ngr) {
        const int b = g >> 3, head = g & 7, ch = head * 128 + chl;
        unsigned* gcnt = (unsigned*)(p.ws + WS_BAR + 16 * KiB) + g * 64;
        bf16x8 bA1[4], bI1[4], bA0[4], bI0[4];
        { const bf16_t* wa = (const bf16_t*)(p.ws + WS_WAT) + ((size_t)(8 + head) * 128 + chl) * 128 + 8 * fq; const bf16_t* wi = (const bf16_t*)(p.ws + WS_WIT) + ((size_t)(8 + head) * 128 + chl) * 128 + 8 * fq;
#pragma unroll
          for (int ks = 0; ks < 4; ++ks) { bA1[ks] = *(const bf16x8*)(wa + 32 * ks); bI1[ks] = *(const bf16x8*)(wi + 32 * ks); } }
#pragma unroll
        for (int k = 0; k < 5; ++k) { const int pc = tid + NTHR * k; if (pc < 131 * 16) *(LAS u32x4*)(raw + (pc >> 4) * 256 + (pc & 15) * 16) = nr[k]; }
#pragma unroll
        for (int k = 0; k < 4; ++k) { const int pc = tid + NTHR * k; *(LAS u32x4*)(gzl + (pc >> 4) * 272 + (pc & 15) * 16) = ng[k]; }
        __syncthreads();
        {
            const int c8 = tid & 15, tb = tid >> 4; const int ch0 = head * 128 + 8 * c8;
            float w[4][8], bias[8];
#pragma unroll
            for (int k = 0; k < 4; ++k) { const f32x4 a = *(const f32x4*)(p.conv_w + k * 1024 + ch0), c2 = *(const f32x4*)(p.conv_w + k * 1024 + ch0 + 4);
#pragma unroll
                for (int j = 0; j < 4; ++j) { w[k][j] = a[j]; w[k][4 + j] = c2[j]; } }
            { const f32x4 a = *(const f32x4*)(p.conv_b + ch0), c2 = *(const f32x4*)(p.conv_b + ch0 + 4);
#pragma unroll
                for (int j = 0; j < 4; ++j) { bias[j] = a[j]; bias[4 + j] = c2[j]; } }
#pragma unroll
            for (int i = 0; i < 4; ++i) { const int t = tb + 32 * i; float a[8];
#pragma unroll
                for (int j = 0; j < 8; ++j) a[j] = bias[j];
#pragma unroll
                for (int k = 0; k < 4; ++k) { float f[8]; unpack8(*(const LAS u32x4*)(raw + (t + k) * 256 + c8 * 16), f);
#pragma unroll
                    for (int j = 0; j < 8; ++j) a[j] += w[k][j] * f[j]; }
                u32x4 wv; wv.x = cvt_pk_bf16(a[0], a[1]); wv.y = cvt_pk_bf16(a[2], a[3]); wv.z = cvt_pk_bf16(a[4], a[5]); wv.w = cvt_pk_bf16(a[6], a[7]);
                *(LAS u32x4*)(ul + t * 272 + c8 * 16) = wv; }
        }
        __syncthreads();
        float A0, H0, A1, H1;
        {
            f32x4 hl1[8], pp1[8];
            lru2_dir<1, LRU_PF_FRAG>(p, ul, head, wid, lane, bA1, bI1, bA0, bI0, hl1, pp1, A1, H1);
            LAS unsigned char* hp = outl + (127 - 4 * fq) * 272 + chl * 2; LAS unsigned char* qp = raw + (127 - 4 * fq) * 256 + chl * 2;
#pragma unroll
            for (int rb = 0; rb < 8; ++rb)
#pragma unroll
                for (int r = 0; r < 4; ++r) { *(LAS bf16_t*)(hp - (16 * rb + r) * 272) = (bf16_t)(cvt_pk_bf16(hl1[rb][r], 0.f) & 0xffffu); *(LAS bf16_t*)(qp - (16 * rb + r) * 256) = (bf16_t)(cvt_pk_bf16(pp1[rb][r], 0.f) & 0xffffu); }
        }
        __builtin_amdgcn_sched_barrier(0);
        if (!LRU_PF_FRAG) { const bf16_t* wa = (const bf16_t*)(p.ws + WS_WAT) + ((size_t)(head) * 128 + chl) * 128 + 8 * fq; const bf16_t* wi = (const bf16_t*)(p.ws + WS_WIT) + ((size_t)(head) * 128 + chl) * 128 + 8 * fq;
#pragma unroll
          for (int ks = 0; ks < 4; ++ks) { bA0[ks] = *(const bf16x8*)(wa + 32 * ks); bI0[ks] = *(const bf16x8*)(wi + 32 * ks); } }
        f32x4 hl0[8], pp0[8];
        lru2_dir<0, false>(p, ul, head, wid, lane, bA0, bI0, bA1, bI1, hl0, pp0, A0, H0);
        u64_t* agg = (u64_t*)(p.ws + WS_AGG);
        const size_t ai0 = ((size_t)(b * NSEQ) * 2 + 0) * 1024 + ch, ai1 = ((size_t)(b * NSEQ) * 2 + 1) * 1024 + ch;
        if (fq == 0) {
            __hip_atomic_store(agg + ai0 + (size_t)sc * 2048, ((u64_t)__float_as_uint(H0) << 32) | __float_as_uint(A0), __ATOMIC_RELAXED, __HIP_MEMORY_SCOPE_AGENT);
            __hip_atomic_store(agg + ai1 + (size_t)sc * 2048, ((u64_t)__float_as_uint(H1) << 32) | __float_as_uint(A1), __ATOMIC_RELAXED, __HIP_MEMORY_SCOPE_AGENT); }
        asm volatile("s_waitcnt vmcnt(0)" ::: "memory");
        __syncthreads();
        if (tid == 0) (void)__hip_atomic_fetch_add(gcnt, 1u, __ATOMIC_RELAXED, __HIP_MEMORY_SCOPE_AGENT);
        if (wid == 0) { unsigned sp = 0;
            while ((unsigned)__builtin_amdgcn_readfirstlane(__hip_atomic_load(gcnt, __ATOMIC_RELAXED, __HIP_MEMORY_SCOPE_AGENT)) < 32u) { __builtin_amdgcn_s_sleep(1); if (++sp > (1u << 22)) break; }
            __builtin_amdgcn_fence(__ATOMIC_ACQUIRE, "agent");
            asm volatile("s_waitcnt vmcnt(0)" ::: "memory"); }
        __syncthreads();
        const float C0 = lru2_carry<0>(agg + ai0, sc, fr, fq);
        const float C1 = lru2_carry<1>(agg + ai1, 2 + (NSEQ - 1 - sc), fr, fq);
        __builtin_amdgcn_sched_barrier(0);
        if (LRU_PF_TILE) { const int gn = (g + ngr < NB * 8) ? g + ngr : g; LRU2_LOAD(gn); }
        __builtin_amdgcn_sched_barrier(0);
        LAS unsigned char* gp = gzl + (4 * fq) * 272 + chl * 2; LAS unsigned char* op = outl + (4 * fq) * 272 + chl * 2; LAS unsigned char* qp0 = raw + (4 * fq) * 256 + chl * 2;
#pragma unroll
        for (int rb = 0; rb < 8; ++rb)
#pragma unroll
            for (int r = 0; r < 4; ++r) { const float h1 = bf2f(*(const LAS bf16_t*)(op + (16 * rb + r) * 272)) + bf2f(*(const LAS bf16_t*)(qp0 + (16 * rb + r) * 256)) * C1;
                const float y = hl0[rb][r] + pp0[rb][r] * C0 + h1;
                const float gz = bf2f(*(const LAS bf16_t*)(gp + (16 * rb + r) * 272));
                *(LAS bf16_t*)(op + (16 * rb + r) * 272) = (bf16_t)(cvt_pk_bf16(gz * y, 0.f) & 0xffffu); }
        __syncthreads();
        bf16_t* Ob = (bf16_t*)(p.ws + WS_R1) + ((size_t)(b * 4096 + t0)) * 1024 + head * 128;
#pragma unroll
        for (int k = 0; k < 4; ++k) { const int pc = tid + NTHR * k, row = pc >> 4, c8 = pc & 15;
            *(u32x4*)(Ob + (size_t)row * 1024 + c8 * 8) = *(const LAS u32x4*)(outl + row * 272 + c8 * 16); }
        __syncthreads();
        if (!LRU_PF_TILE && g + ngr < NB * 8) LRU2_LOAD(g + ngr);
    }
#undef LRU2_LOAD
}

__device__ __forceinline__ void fft_stage2_all(const Params& p, LAS unsigned char* lds) {
    const int tid = tid_opaque(), lane = tid & 63, wid = tid >> 6, fr = lane & 15, fq = lane >> 4;
    const bf16_t* Yt = (const bf16_t*)((const unsigned char*)p.out + OUT_YT); const bf16_t* D2 = (const bf16_t*)(p.ws + WS_D2T);
    bf16_t* Fo = (bf16_t*)((unsigned char*)p.out + OUT_F);
    const int G = gridDim.x;
    int it = blockIdx.x; bf16x8 dfr, yfr[4];
#define S2_LOAD(item) do { const int b_ = (item) & 7, k1_ = (item) >> 3; dfr = *(const bf16x8*)(D2 + (size_t)(k1_ + 256 * fr) * 32 + 8 * fq); \
        _Pragma("unroll") for (int n = 0; n < 4; ++n) yfr[n] = *(const bf16x8*)(Yt + (size_t)(k1_ * 2 + (fq >> 1)) * 65536 + (size_t)b_ * 8192 + (size_t)(16 * (4 * wid + n) + fr) * 16 + 8 * (fq & 1)); } while (0)
    if (it < NB * 256) S2_LOAD(it);
    for (; it < NB * 256; it += G) {
        const int b = it & 7, k1 = it >> 3;
        f32x4 acc[4];
#pragma unroll
        for (int n = 0; n < 4; ++n) acc[n] = __builtin_amdgcn_mfma_f32_16x16x32_bf16(yfr[n], dfr, (f32x4){0.f, 0.f, 0.f, 0.f}, 0, 0, 0);
        const int nx = it + G; if (nx < NB * 256) S2_LOAD(nx);
#pragma unroll
        for (int n = 0; n < 4; ++n) { u32x2 w; w.x = cvt_pk_bf16(acc[n][0], acc[n][1]); w.y = cvt_pk_bf16(acc[n][2], acc[n][3]);
            *(LAS u32x2*)(lds + fr * 1040 + (16 * (4 * wid + n) + 4 * fq) * 2) = w; }
        __syncthreads();
#pragma unroll
        for (int k = 0; k < 2; ++k) { const int pc = tid + NTHR * k, k2 = pc >> 6, c8 = pc & 63;
            *(u32x4*)(Fo + ((size_t)b * 4096 + k1 + 256 * k2) * 512 + c8 * 8) = *(const LAS u32x4*)(lds + k2 * 1040 + c8 * 16); }
        __syncthreads();
    }
#undef S2_LOAD
}

__device__ __forceinline__ void topk_task(const Params& p, LAS unsigned char* lds, int it) {
    const int tid = tid_opaque(), lane = tid & 63, wid = tid >> 6;
    LAS unsigned* cnt = (LAS unsigned*)lds;
    LAS unsigned* wsum = cnt + 64;
    const float* scores = (const float*)(p.ws + WS_SCORES);
    int* idx = (int*)(p.ws + WS_IDX); float* gate = (float*)(p.ws + WS_GATE); int* slot_of = (int*)(p.ws + WS_SLOT);
    const int b = it >> 4, e = it & 15;
    unsigned key[8];
    { const u32x4* sp = (const u32x4*)(scores + (size_t)it * 4096 + tid * 8); const u32x4 a = sp[0], c2 = sp[1]; key[0] = a.x; key[1] = a.y; key[2] = a.z; key[3] = a.w; key[4] = c2.x; key[5] = c2.y; key[6] = c2.z; key[7] = c2.w; }
    unsigned thr = 0;
    for (int step = 0; step < 16; ++step) {
        const int sh = 29 - 2 * step;
        const unsigned c1 = sh >= 0 ? (thr | (1u << sh)) : (thr | 1u), c2 = sh >= 0 ? (thr | (2u << sh)) : 0xffffffffu, c3 = sh >= 0 ? (thr | (3u << sh)) : 0xffffffffu;
        unsigned n1 = 0, n2 = 0, n3 = 0;
#pragma unroll
        for (int j = 0; j < 8; ++j) { n1 += (unsigned)__popcll(__ballot(key[j] >= c1)); n2 += (unsigned)__popcll(__ballot(key[j] >= c2)); n3 += (unsigned)__popcll(__ballot(key[j] >= c3)); }
        LAS unsigned* cb = cnt + (step & 1) * 32;
        if (lane == 0) { cb[wid] = n1; cb[8 + wid] = n2; cb[16 + wid] = n3; }
        __syncthreads();
        unsigned t1 = 0, t2 = 0, t3 = 0;
#pragma unroll
        for (int w = 0; w < 8; ++w) { t1 += cb[w]; t2 += cb[8 + w]; t3 += cb[16 + w]; }
        if (sh >= 0) thr = t3 >= (unsigned)CAP ? c3 : (t2 >= (unsigned)CAP ? c2 : (t1 >= (unsigned)CAP ? c1 : thr));
        else thr = t1 >= (unsigned)CAP ? c1 : thr;
    }
    unsigned cg_ = 0, ce = 0;
#pragma unroll
    for (int j = 0; j < 8; ++j) { cg_ += key[j] > thr; ce += key[j] == thr; }
    unsigned pk = cg_ | (ce << 16), incl = pk;
#pragma unroll
    for (int o = 1; o < 64; o <<= 1) { const unsigned n = __shfl_up(incl, o); if (lane >= o) incl += n; }
    if (lane == 63) wsum[wid] = incl;
    __syncthreads();
    unsigned base = 0, total = 0;
#pragma unroll
    for (int w = 0; w < 8; ++w) { const unsigned s2 = wsum[w]; if (w < wid) base += s2; total += s2; }
    const unsigned excl = base + incl - pk; unsigned og = excl & 0xffffu, oe = excl >> 16; const unsigned ngt = total & 0xffffu, krem = (unsigned)CAP - ngt;
#pragma unroll
    for (int j = 0; j < 8; ++j) { const int t = tid * 8 + j; int m = -1;
        if (key[j] > thr) { m = (e * 8 + b) * 512 + (int)og; ++og; }
        else if (key[j] == thr) { if (oe < krem) m = (e * 8 + b) * 512 + (int)(ngt + oe); ++oe; }
        slot_of[((size_t)b * 4096 + t) * 16 + e] = m;
        if (m >= 0) { idx[m] = b * 4096 + t; gate[m] = __uint_as_float(key[j]); } }
    __syncthreads();
}

__device__ __forceinline__ void phase7_rows(const Params& p, LAS unsigned char* lds) {
    const int tid = threadIdx.x, lane = tid & 63, wid = tid >> 6;
    LAS float* wrt = (LAS float*)lds;
    for (int i = tid; i < 16 * 1024; i += NTHR) { const int d = i >> 4, e = i & 15; wrt[e * 1024 + d] = p.w_router[i]; }
    __syncthreads();
    const float* ada = (const float*)(p.ws + WS_ADA); bf16_t* h2 = (bf16_t*)(p.ws + WS_R1); float* scores = (float*)(p.ws + WS_SCORES);
    for (int row0 = (blockIdx.x * 8 + wid) * 2; row0 < MLAT; row0 += gridDim.x * 16) {
        const int b = row0 >> 12;
        f32x4 v[2][4]; float ss[2];
#pragma unroll
        for (int r = 0; r < 2; ++r)
#pragma unroll
            for (int i = 0; i < 4; ++i) v[r][i] = *(const f32x4*)(p.out + (size_t)(row0 + r) * 1024 + 256 * i + 4 * lane);
#pragma unroll
        for (int r = 0; r < 2; ++r) { float a = 0.f;
#pragma unroll
            for (int i = 0; i < 4; ++i) a += v[r][i][0] * v[r][i][0] + v[r][i][1] * v[r][i][1] + v[r][i][2] * v[r][i][2] + v[r][i][3] * v[r][i][3];
            ss[r] = a; }
#pragma unroll
        for (int o = 32; o >= 1; o >>= 1) { ss[0] += __shfl_xor(ss[0], o); ss[1] += __shfl_xor(ss[1], o); }
#pragma unroll
        for (int i = 0; i < 4; ++i) { const int d = 256 * i + 4 * lane;
            const f32x4 g = *(const f32x4*)(p.norm2_g + d), sh = *(const f32x4*)(ada + b * 6144 + 3072 + d), sc = *(const f32x4*)(ada + b * 6144 + 4096 + d);
#pragma unroll
            for (int r = 0; r < 2; ++r) { const float rs = rsqrtf(ss[r] * (1.0f / 1024.0f) + 1e-6f);
                v[r][i] = v[r][i] * rs * g * (sc + 1.0f) + sh;
                u32x2 w; w.x = cvt_pk_bf16(v[r][i][0], v[r][i][1]); w.y = cvt_pk_bf16(v[r][i][2], v[r][i][3]); *(u32x2*)(h2 + (size_t)(row0 + r) * 1024 + d) = w; } }
        float q[32];
#pragma unroll
        for (int e = 0; e < 16; ++e) { float a0 = 0.f, a1 = 0.f;
#pragma unroll
            for (int i = 0; i < 4; ++i) { const f32x4 w = *(const LAS f32x4*)(wrt + e * 1024 + 256 * i + 4 * lane);
                a0 += v[0][i][0] * w[0] + v[0][i][1] * w[1] + v[0][i][2] * w[2] + v[0][i][3] * w[3];
                a1 += v[1][i][0] * w[0] + v[1][i][1] * w[1] + v[1][i][2] * w[2] + v[1][i][3] * w[3]; }
            q[e] = a0; q[16 + e] = a1; }
#pragma unroll
        for (int j = 0; j < 16; ++j) { const bool up = (lane & 32) != 0; const float send = up ? q[j] : q[16 + j], keep = up ? q[16 + j] : q[j]; q[j] = keep + __shfl_xor(send, 32); }
#pragma unroll
        for (int j = 0; j < 8; ++j) { const bool up = (lane & 16) != 0; const float send = up ? q[j] : q[8 + j], keep = up ? q[8 + j] : q[j]; q[j] = keep + __shfl_xor(send, 16); }
#pragma unroll
        for (int j = 0; j < 4; ++j) { const bool up = (lane & 8) != 0; const float send = up ? q[j] : q[4 + j], keep = up ? q[4 + j] : q[j]; q[j] = keep + __shfl_xor(send, 8); }
#pragma unroll
        for (int j = 0; j < 2; ++j) { const bool up = (lane & 4) != 0; const float send = up ? q[j] : q[2 + j], keep = up ? q[2 + j] : q[j]; q[j] = keep + __shfl_xor(send, 4); }
        { const bool up = (lane & 2) != 0; const float send = up ? q[0] : q[1], keep = up ? q[1] : q[0]; q[0] = keep + __shfl_xor(send, 2); }
        float lg = q[0] + __shfl_xor(q[0], 1);
        float mx = lg;
#pragma unroll
        for (int o = 2; o <= 16; o <<= 1) mx = fmaxf(mx, __shfl_xor(mx, o));
        const float ex = expf(lg - mx); float sum = ex;
#pragma unroll
        for (int o = 2; o <= 16; o <<= 1) sum += __shfl_xor(sum, o);
        if ((lane & 1) == 0) __hip_atomic_store(scores + ((size_t)b * 16 + ((lane >> 1) & 15)) * 4096 + ((row0 + (lane >> 5)) & 4095), ex / sum, __ATOMIC_RELAXED, __HIP_MEMORY_SCOPE_AGENT);
        if (gridDim.x == 256) {
            asm volatile("s_waitcnt vmcnt(0)" ::: "memory");
            __syncthreads();
            if (tid == 0) (void)__hip_atomic_fetch_add((unsigned*)(p.ws + WS_BAR + 44 * KiB) + b * 64, 1u, __ATOMIC_RELAXED, __HIP_MEMORY_SCOPE_AGENT);
        }
    }
    __syncthreads();
}
__device__ __forceinline__ void phase7_topk(const Params& p, LAS unsigned char* lds) {
    const int bid = blockIdx.x; if (bid >= NB * NE) return;
    unsigned* c = (unsigned*)(p.ws + WS_BAR + 44 * KiB) + (bid >> 4) * 64;
    if (threadIdx.x < 64) { unsigned sp = 0;
        while ((unsigned)__builtin_amdgcn_readfirstlane(__hip_atomic_load(c, __ATOMIC_RELAXED, __HIP_MEMORY_SCOPE_AGENT)) < 256u) { __builtin_amdgcn_s_sleep(1); if (++sp > (1u << 22)) break; }
        __builtin_amdgcn_fence(__ATOMIC_ACQUIRE, "agent");
        asm volatile("s_waitcnt vmcnt(0)" ::: "memory"); }
    __syncthreads();
    topk_task(p, lds, bid);
}
__device__ __forceinline__ void phase7_weights(const Params& p) {
    constexpr int N_G = 16 * 16 * 6, N_D = 16 * 24 * 4;
    const bool fused = gridDim.x == 256;
    for (int j = 0; ; ++j) {
        int it;
        if (!fused) it = blockIdx.x + j * gridDim.x;
        else if (blockIdx.x >= 128) it = j < 4 ? (blockIdx.x - 128) + 128 * j : 512 + blockIdx.x + (j - 4) * 256;
        else it = 512 + blockIdx.x + j * 256;
        if (it >= 2 * N_G + N_D) break;
        if (it < 2 * N_G) { const int up = it >= N_G, j = up ? it - N_G : it, e = j / 96, r = j % 96, kb = r / 6, nb = r % 6;
            xpose_item<4>((up ? p.w_up_e : p.w_gate_e) + (size_t)e * 1024 * 1536, 1536, (bf16_t*)(p.ws + WS_WGU) + (size_t)e * 3072 * 1024, 1024, kb * 64, nb * 256, up ? 2 : 1); }
        else { const int j = it - 2 * N_G, e = j / 96, r = j % 96, kb = r >> 2, nb = r & 3;
            xpose_item<4>(p.w_down_e + (size_t)e * 1536 * 1024, 1024, (bf16_t*)(p.ws + WS_WD) + (size_t)e * 1024 * 1536, 1536, kb * 64, nb * 256, 0); }
    }
}

__device__ __forceinline__ void phase11(const Params& p, float* dst) {
    const int tid = tid_opaque(), lane = tid & 63, wid = tid >> 6;
    const float* ada = (const float*)(p.ws + WS_ADA); const int* slot_of = (const int*)(p.ws + WS_SLOT); const bf16_t* oute = (const bf16_t*)(p.ws + WS_OUTE);
    const int stride = gridDim.x * 16;
    int row0 = (blockIdx.x * 8 + wid) * 2;
    int myslot = row0 < MLAT ? slot_of[(size_t)row0 * 16 + (lane & 31)] : -1;
    for (; row0 < MLAT; row0 += stride) {
        const int b = row0 >> 12;
        const int nrow = row0 + stride; const int nslot = nrow < MLAT ? slot_of[(size_t)nrow * 16 + (lane & 31)] : -1;
        f32x4 xv[2][4], acc[2][4];
#pragma unroll
        for (int r = 0; r < 2; ++r)
#pragma unroll
            for (int i = 0; i < 4; ++i) { xv[r][i] = *(const f32x4*)(p.out + (size_t)(row0 + r) * 1024 + 256 * i + 4 * lane); acc[r][i] = (f32x4){0.f, 0.f, 0.f, 0.f}; }
        const unsigned long long bal = __ballot(myslot >= 0);
        unsigned mask0 = (unsigned)(bal & 0xffffull), mask1 = (unsigned)((bal >> 16) & 0xffffull);
        while (mask0 | mask1) {
            int m[2][2];
#pragma unroll
            for (int j = 0; j < 2; ++j) { if (mask0) { const int e = __builtin_ctz(mask0); mask0 &= mask0 - 1; m[0][j] = __builtin_amdgcn_readlane(myslot, e); } else m[0][j] = MMOE;
                                          if (mask1) { const int e = __builtin_ctz(mask1); mask1 &= mask1 - 1; m[1][j] = __builtin_amdgcn_readlane(myslot, 16 + e); } else m[1][j] = MMOE; }
            u32x2 w[2][2][4];
#pragma unroll
            for (int r = 0; r < 2; ++r)
#pragma unroll
                for (int j = 0; j < 2; ++j)
#pragma unroll
                    for (int i = 0; i < 4; ++i) w[r][j][i] = *(const u32x2*)(oute + (size_t)m[r][j] * 1024 + 256 * i + 4 * lane);
#pragma unroll
            for (int r = 0; r < 2; ++r)
#pragma unroll
                for (int j = 0; j < 2; ++j)
#pragma unroll
                    for (int i = 0; i < 4; ++i) { acc[r][i][0] += bf_lo(w[r][j][i].x); acc[r][i][1] += bf_hi(w[r][j][i].x); acc[r][i][2] += bf_lo(w[r][j][i].y); acc[r][i][3] += bf_hi(w[r][j][i].y); }
        }
        float ss[2];
#pragma unroll
        for (int r = 0; r < 2; ++r) { float a = 0.f;
#pragma unroll
            for (int i = 0; i < 4; ++i) { const int d = 256 * i + 4 * lane; const f32x4 g2 = *(const f32x4*)(ada + b * 6144 + 5120 + d); xv[r][i] += g2 * acc[r][i];
                a += xv[r][i][0] * xv[r][i][0] + xv[r][i][1] * xv[r][i][1] + xv[r][i][2] * xv[r][i][2] + xv[r][i][3] * xv[r][i][3]; }
            ss[r] = a; }
#pragma unroll
        for (int o = 32; o >= 1; o >>= 1) { ss[0] += __shfl_xor(ss[0], o); ss[1] += __shfl_xor(ss[1], o); }
#pragma unroll
        for (int r = 0; r < 2; ++r) { const float rs = rsqrtf(ss[r] * (1.0f / 1024.0f) + 1e-6f);
#pragma unroll
            for (int i = 0; i < 4; ++i) { const int d = 256 * i + 4 * lane; *(f32x4*)(dst + (size_t)(row0 + r) * 1024 + d) = xv[r][i] * rs * *(const f32x4*)(p.final_g + d); } }
        myslot = nslot;
    }
}

#define XB_TMO      128
#define XB_XCNT(j)  (256  + 64 * (j))
#define XB_XSUB(j)  (1280 + 64 * (j))
#define XB_XGEN(j)  (2304 + 64 * (j))
#define XB_TOP      3328
#define XB_TOPGEN   3392
#define XCD_BAR_WORDS 3456
#define XB_SPIN_CAP (1u << 22)
__device__ __forceinline__ unsigned xb_ld(unsigned* p)              { return __hip_atomic_load(p, __ATOMIC_RELAXED, __HIP_MEMORY_SCOPE_AGENT); }
__device__ __forceinline__ unsigned xb_add(unsigned* p, unsigned v) { return __hip_atomic_fetch_add(p, v, __ATOMIC_RELAXED, __HIP_MEMORY_SCOPE_AGENT); }
__device__ __forceinline__ unsigned xb_xcc_id() { return (unsigned)__builtin_amdgcn_s_getreg((3 << 11) | 20) & 0xFu; }
#define XB_SPIN(cond, bar) do { unsigned _sp = 0; while (cond) { __builtin_amdgcn_s_sleep(1); \
    if ((++_sp & 255u) == 0u) { if (xb_ld(&(bar)[XB_TMO])) break; if (_sp > XB_SPIN_CAP) { atomicAdd(&(bar)[XB_TMO], 1u); break; } } } } while (0)
struct XcdBarrier { unsigned* bar; unsigned x; volatile LAS unsigned* st; };
__device__ __forceinline__ XcdBarrier xcd_barrier_post(unsigned* bar, volatile LAS unsigned* st) {
    XcdBarrier b; b.bar = bar; b.x = xb_xcc_id(); b.st = st;
    if (threadIdx.x == 0) (void)xb_add(&bar[XB_XCNT(b.x)], 1u);
    return b;
}
__device__ __forceinline__ void xcd_barrier_complete(unsigned* bar, unsigned x, unsigned& nloc, unsigned& nx) {
    const unsigned G = gridDim.x * gridDim.y * gridDim.z;
    unsigned sum, cnt, mine, sp = 0u;
    for (;;) {
        sum = 0u; cnt = 0u; mine = 0u;
#pragma unroll
        for (unsigned j = 0; j < 16; ++j) { const unsigned c = xb_ld(&bar[XB_XCNT(j)]); sum += c; cnt += (c > 0u) ? 1u : 0u; mine = (j == x) ? c : mine; }
        if (sum == G) break;
        __builtin_amdgcn_s_sleep(1);
        if ((++sp & 255u) == 0u) { if (xb_ld(&bar[XB_TMO])) break; if (sp > XB_SPIN_CAP) { atomicAdd(&bar[XB_TMO], 1u); break; } }
    }
    nloc = mine > 0u ? mine : 1u; nx = cnt > 0u ? cnt : 1u;
}
__device__ __forceinline__ void xcd_barrier(const XcdBarrier& b) {
    asm volatile("s_waitcnt vmcnt(0)" ::: "memory");
    __syncthreads();
    if (threadIdx.x == 0) {
        unsigned* bar = b.bar;
        __builtin_amdgcn_s_waitcnt(0);
        unsigned nloc = b.st[0], nx = b.st[1];
        if (nloc == 0u) { xcd_barrier_complete(bar, b.x, nloc, nx); b.st[0] = nloc; b.st[1] = nx; }
        const unsigned old = xb_add(&bar[XB_XSUB(b.x)], 1u);
        const unsigned gen = old / nloc;
        if (old + 1u == (gen + 1u) * nloc) {
            __builtin_amdgcn_fence(__ATOMIC_RELEASE, "agent");
            asm volatile("s_waitcnt vmcnt(0)" ::: "memory");
            const unsigned og = xb_add(&bar[XB_TOP], 1u);
            const unsigned tg = og / nx;
            if (og + 1u == (tg + 1u) * nx) xb_add(&bar[XB_TOPGEN], 1u);
            else XB_SPIN(xb_ld(&bar[XB_TOPGEN]) == tg, bar);
            __builtin_amdgcn_fence(__ATOMIC_ACQUIRE, "agent");
            xb_add(&bar[XB_XGEN(b.x)], 1u);
            asm volatile("s_waitcnt vmcnt(0)" ::: "memory");
        } else {
            XB_SPIN(xb_ld(&bar[XB_XGEN(b.x)]) == gen, bar);
            __builtin_amdgcn_fence(__ATOMIC_ACQUIRE, "agent");
            asm volatile("s_waitcnt vmcnt(0)" ::: "memory");
        }
    }
    __syncthreads();
}

__global__ void __launch_bounds__(NTHR, 2) fwd_megakernel(Params p) {
    extern __shared__ __attribute__((aligned(16))) unsigned char lds_raw[];
    LAS unsigned char* lds = (LAS unsigned char*)lds_raw;
    cg::grid_group grid = cg::this_grid();
    const int G = gridDim.x, bid = blockIdx.x;
    unsigned char* ws = p.ws;
    bf16_t* const R1 = (bf16_t*)(ws + WS_R1); bf16_t* const Zb = (bf16_t*)(ws + WS_RZ); bf16_t* const PQt = (bf16_t*)(ws + WS_RPQ); bf16_t* const MRG = (bf16_t*)(ws + WS_R2);
    bf16_t* const Fb = (bf16_t*)((unsigned char*)p.out + OUT_F); bf16_t* const Ytb = (bf16_t*)((unsigned char*)p.out + OUT_YT);
#ifdef ONLY_PH
#define PH(k) ((k) == ONLY_PH && p.ph_lo <= (k) && (k) < p.ph_hi)
#else
#define PH(k) (p.ph_lo <= (k) && (k) < p.ph_hi)
#endif
    volatile LAS unsigned* xst = (volatile LAS unsigned*)(lds + LDS_BYTES - 16);
    if (threadIdx.x < 4) xst[threadIdx.x] = 0u;
    __syncthreads();
    XcdBarrier xbar = xcd_barrier_post((unsigned*)(ws + WS_BAR), xst);
    if (p.ph_lo < 0) grid.sync();
#ifdef TS_A
    unsigned long long* tsb = (unsigned long long*)(ws + WS_BAR + 40 * KiB);
#define STAMP(i) do { if (bid == 0 && threadIdx.x == 0) tsb[i] = __builtin_amdgcn_s_memrealtime(); } while (0)
#else
#define STAMP(i) do { } while (0)
#endif
    STAMP(0);
#define SYNC(k) do { if (PH(k) && PH((k) + 1)) xcd_barrier(xbar); STAMP((k) + 1); } while (0)
#ifndef REPMASK
#define REPMASK 0
#endif
#define REP(k) for (int rep_ = 0; rep_ <= ((REPMASK >> (k)) & 1); ++rep_)
    if (PH(0)) REP(0) phase0(p, lds);
    SYNC(0);
    if (PH(1)) REP(1) phase1(p);
    SYNC(1);
    if (PH(2)) REP(2) {
        { ProbPQ pr{(const bf16_t*)(ws + WS_WPQ), R1, 1024, 1024, 16384}; pg8::Order S; S.init(4, 128, G, bid); EpiPQ E{PQt}; pg8::gemm_phase(lds, pr, S, E); }
        { ProbPlain pr{R1, (const bf16_t*)(ws + WS_WIN), 1024, 1024, 1024}; pg8::Order S; S.init(128, 16, G, bid); EpiZ E{Zb, 4096, -1}; pg8::gemm_phase(lds, pr, S, E); }
        { ProbPlain pr{(const bf16_t*)(ws + WS_HCTX), (const bf16_t*)(ws + WS_WIN), 1024, 1024, 1024}; pg8::Order S; S.init(8, 4, G, bid); EpiZ E{(bf16_t*)(ws + WS_ZXC), 1024, 0}; pg8::gemm_phase(lds, pr, S, E); }
    }
    SYNC(2);
    if (PH(3)) REP(3) {
        {
            ProbPlain pr{(const bf16_t*)(ws + WS_D1T), PQt, 512, 512, 512}; pg8::Order S; S.init(2, 256, G, bid);
            if (G == 256) { if (bid >= 128) { S.G = 128; S.c = bid - 128; S.base = 0; S.lim = 3; } else { S.G = 128; S.c = bid; S.base = 384; S.lim = 1; } }
            EpiPlain E{Ytb, 65536}; pg8::gemm_phase(lds, pr, S, E); }
        for (int it = bid; it < NB * 2 * 8; it += G) lru_tile<false>(p, lds, it);
    }
    SYNC(3);
    if (PH(4)) {
        fft_stage2_all(p, lds);
        const int ngr = G >> 5;
        if (ngr > 0 && bid < ngr * 32) lru2_block(p, lds, bid % ngr, bid / ngr, ngr);
    }
    SYNC(4);
    if (PH(5)) REP(5) {
        { ProbMerge pr{Fb, (const bf16_t*)(ws + WS_WFOUR), R1, (const bf16_t*)(ws + WS_WLRU), 512, 1024, 512, 512, 1024, 1024}; pg8::Order S; S.init(128, 4, G, bid); EpiMerge E{MRG, Zb}; pg8::gemm_phase2(lds, pr, S, E); }
    }
    SYNC(5);
    if (PH(6)) REP(6) { ProbPlain pr{MRG, (const bf16_t*)(ws + WS_WOUT), 1024, 1024, 1024}; pg8::Order S; S.init(128, 4, G, bid);
        EpiOut E{p.out, p.x, (const float*)(ws + WS_POS), (const float*)(ws + WS_ADA)}; pg8::gemm_phase(lds, pr, S, E); }
    SYNC(6);
    if (PH(7)) { phase7_rows(p, lds); if (G == 256) phase7_topk(p, lds); phase7_weights(p); }
    SYNC(7);
    if (PH(8) && G != 256) { for (int it = bid; it < NB * NE; it += G) topk_task(p, lds, it); }
    if (G != 256) SYNC(8);
    if (PH(9)) REP(9) { ProbMoeUp pr{R1, (const bf16_t*)(ws + WS_WGU), (const int*)(ws + WS_IDX), 1024, 1024, 1024}; pg8::Order S; S.init(256, 12, G, bid); EpiGU E{(bf16_t*)(ws + WS_HID)}; pg8::gemm_phase(lds, pr, S, E); }
    SYNC(9);
    if (PH(10)) { if (bid == 0 && threadIdx.x < 128) *(u32x4*)(ws + WS_OUTE + (size_t)MMOE * 2048 + threadIdx.x * 16) = (u32x4){0u, 0u, 0u, 0u}; }
    if (PH(10)) REP(10) { ProbMoeDown pr{(const bf16_t*)(ws + WS_HID), (const bf16_t*)(ws + WS_WD), 1536, 1536, 1536}; pg8::Order S; S.init(256, 4, G, bid); EpiDown E{(bf16_t*)(ws + WS_OUTE), (const float*)(ws + WS_GATE)}; pg8::gemm_phase(lds, pr, S, E); }
    SYNC(10);
    if (PH(11)) phase11(p, p.out);
#ifdef TS_A
    xcd_barrier(xbar); STAMP(12);
    if (bid == 0 && threadIdx.x == 0) {

#ifndef TS_AE
#define TS_AE (TS_A + 1)
#endif
#ifndef TS_BE
#define TS_BE (TS_B + 1)
#endif
        const float ta = (float)(tsb[TS_AE] - tsb[TS_A]) * 0.01f * (float)(TS_SA), tb = (float)(tsb[TS_BE] - tsb[TS_B]) * 0.01f * (float)(TS_SB);
        p.out[7] = fminf(ta, 97.f); p.out[1024 * 5 + 9] = fminf(tb, 97.f); }
#endif
}

#ifndef N_LAUNCHES
#define N_LAUNCHES 1
#endif
#ifndef PROBE_DUP
#define PROBE_DUP 0x0
#endif
extern "C" void kernel_launch(void* const* d_in, const int* in_sizes, int n_in, void* d_out, int out_size, void* d_ws, size_t ws_size, hipStream_t stream) {
    static int grid = 0;
    if (grid == 0) {
        if (n_in != 24 || out_size != MLAT * DM || ws_size < WS_END) { fprintf(stderr, "kernel_launch: unexpected shapes (n_in %d out %d ws %zu)\n", n_in, out_size, ws_size); grid = -1; return; }
        int dev = 0, cus = 0, per_cu = 0;
        hipGetDevice(&dev); hipDeviceGetAttribute(&cus, hipDeviceAttributeMultiprocessorCount, dev);
        hipFuncSetAttribute((const void*)fwd_megakernel, hipFuncAttributeMaxDynamicSharedMemorySize, LDS_BYTES);
        hipOccupancyMaxActiveBlocksPerMultiprocessor(&per_cu, (const void*)fwd_megakernel, NTHR, LDS_BYTES);
        if (per_cu < 1) { fprintf(stderr, "kernel_launch: occupancy query reports %d blocks per CU\n", per_cu); per_cu = 1; }
        grid = cus * 1;
        (void)hipGetLastError();
    }
    if (grid < 0) return;
    Params p{};
    const float** f = (const float**)&p;
    for (int i = 0; i < 24; ++i) f[i] = (const float*)d_in[i];
    p.out = (float*)d_out; p.ws = (unsigned char*)d_ws;
    (void)hipMemsetAsync((unsigned char*)d_ws + WS_BAR, 0, 48 * KiB, stream);
#if N_LAUNCHES == 1
    p.ph_lo = 0; p.ph_hi = 12;
    void* args[] = {&p};
    hipError_t e = hipLaunchCooperativeKernel((const void*)fwd_megakernel, dim3(grid), dim3(NTHR), args, LDS_BYTES, stream);
    if (e != hipSuccess) fprintf(stderr, "cooperative launch failed: %s (grid %d)\n", hipGetErrorString(e), grid);
#else
    for (int k = 0; k < 12; ++k) for (int r = 0; r <= ((PROBE_DUP >> k) & 1); ++r) { p.ph_lo = k; p.ph_hi = k + 1; if (k == 11 && r == 0 && ((PROBE_DUP >> 11) & 1)) { p.ph_lo = 12; p.ph_hi = 13; } hipLaunchKernelGGL(fwd_megakernel, dim3(grid), dim3(NTHR), LDS_BYTES, stream, p); }
#endif
}
```

```cpp
#include <hip/hip_runtime.h>
#include <hip/hip_cooperative_groups.h>
#include <cstdio>
namespace cg = cooperative_groups;

#define LAS __attribute__((address_space(3)))
typedef unsigned short bf16_t;
typedef short bf16x8 __attribute__((ext_vector_type(8)));
typedef float f32x4 __attribute__((ext_vector_type(4)));
typedef float f32x16 __attribute__((ext_vector_type(16)));
typedef unsigned u32x4 __attribute__((ext_vector_type(4)));
typedef unsigned u32x2 __attribute__((ext_vector_type(2)));

constexpr int NB = 8, TT = 4096, DM = 1024, CTXL = 256, MLAT = NB * TT, MCTX = NB * CTXL;
constexpr int NE = 16, CAP = 512, DE = 1536, MMOE = NE * NB * CAP;
constexpr int NSEQ = 34;
constexpr int NTHR = 512;
constexpr float NLOG2E = -1.4426950408889634f;
constexpr int LDS_BYTES = 144 * 1024;

constexpr size_t KiB = 1024, MiB = 1024 * 1024;
constexpr size_t WS_ADA = 0;
constexpr size_t WS_POS = 256 * KiB;
constexpr size_t WS_AGG = 512 * KiB;
constexpr size_t WS_WPQ = 5 * MiB;
constexpr size_t WS_WIN = 7 * MiB;
constexpr size_t WS_WFOUR = 15 * MiB;
constexpr size_t WS_WLRU = 16 * MiB;
constexpr size_t WS_WOUT = 18 * MiB;
constexpr size_t WS_WAT = 20 * MiB;
constexpr size_t WS_WIT = 20 * MiB + 512 * KiB;
constexpr size_t WS_SCORES = 21 * MiB;
constexpr size_t WS_IDX = 23 * MiB;
constexpr size_t WS_GATE = 23 * MiB + 256 * KiB;
constexpr size_t WS_SLOT = 23 * MiB + 512 * KiB;
constexpr size_t WS_BAR = 25 * MiB + 512 * KiB;
constexpr size_t WS_D1T = 34 * MiB;
constexpr size_t WS_D2T = 34 * MiB + 512 * KiB;
constexpr size_t WS_HCTX = 26 * MiB;
constexpr size_t WS_ZXC = 30 * MiB;
constexpr size_t WS_R1 = 40 * MiB;
constexpr size_t WS_RPQ = 104 * MiB;
constexpr size_t WS_R2 = 168 * MiB;
constexpr size_t WS_RZ = 232 * MiB;
constexpr size_t WS_END = 488 * MiB;
constexpr size_t WS_HID = WS_RZ, WS_WD = WS_RZ + 192 * MiB, WS_WGU = WS_RPQ, WS_OUTE = WS_R1;
constexpr size_t OUT_YT = 0, OUT_F = 64 * MiB;

struct Params {
    const float *x, *c, *ctx, *c_ctx, *w_ada, *b_ada, *norm1_g, *norm2_g, *w_in, *w_four, *conv_w, *conv_b, *lru_lambda,
        *lru_wa, *lru_ba, *lru_wi, *lru_bi, *w_lru, *w_out, *w_router, *w_gate_e, *w_up_e, *w_down_e, *final_g;
    float* out; unsigned char* ws; int ph_lo, ph_hi;
};

__device__ __forceinline__ int tid_opaque() { int t = threadIdx.x; asm volatile("" : "+v"(t)); return t; }
__device__ __forceinline__ unsigned cvt_pk_bf16(float lo, float hi) { unsigned r; asm volatile("v_cvt_pk_bf16_f32 %0, %1, %2" : "=v"(r) : "v"(lo), "v"(hi)); return r; }
__device__ __forceinline__ float bf_lo(unsigned w) { return __uint_as_float(w << 16); }
__device__ __forceinline__ float bf_hi(unsigned w) { return __uint_as_float(w & 0xffff0000u); }
__device__ __forceinline__ float bf2f(bf16_t h) { return __uint_as_float(((unsigned)h) << 16); }
__device__ __forceinline__ float sigmoidf_(float v) { return __builtin_amdgcn_rcpf(1.0f + __expf(-v)); }
__device__ __forceinline__ float gelu_tanh(float v) { const float y = 1.5957691216f * (v + 0.044715f * v * v * v); return v * sigmoidf_(y); }
__device__ __forceinline__ float wave_sum(float v) {
#pragma unroll
    for (int o = 32; o >= 1; o >>= 1) v += __shfl_xor(v, o);
    return v;
}
__device__ __forceinline__ void unpack8(const u32x4 w, float (&f)[8]) { f[0] = bf_lo(w.x); f[1] = bf_hi(w.x); f[2] = bf_lo(w.y); f[3] = bf_hi(w.y); f[4] = bf_lo(w.z); f[5] = bf_hi(w.z); f[6] = bf_lo(w.w); f[7] = bf_hi(w.w); }

namespace pg8 {
constexpr int BM = 256, BK = 64, HALF = 128, HTB = HALF * BK * 2, STAGE_BYTES = 8 * HTB, NXCD = 8, WGM = 8;
__device__ __forceinline__ int lds_byte(int r, int c) { const int st = (r >> 4) * 2 + (c >> 5), rr = r & 15, cc = c & 31, ob = rr * 64 + cc * 2; return st * 1024 + (ob ^ (((ob >> 9) & 1) << 5)); }
__device__ __forceinline__ void stage_rc(int b, int& R, int& C) { const int st = b / 1024, sb = b % 1024, swz = sb ^ (((sb >> 9) & 1) << 5); R = (st >> 1) * 16 + swz / 64; C = (st & 1) * 32 + (swz % 64) / 2; }
__device__ __forceinline__ int perm32(int rho) { const int n = rho >> 4, i = rho & 15; return 8 * (i >> 2) + 4 * n + (i & 3); }
struct Unit { int pm, pn; };
struct Order {
    int nM, nN, nwg, G, c, base, lim;
    __device__ void init(int nM_, int nN_, int G_, int c_) { nM = nM_; nN = nN_; nwg = nM * nN; G = G_; c = c_; base = 0; lim = 0x7fffffff; }
    __device__ bool next(int i, Unit& u) const {
        const long L = (long)base + (long)i * G + c; if (i >= lim || L >= nwg) return false;
        int wgid = (int)L; { const int q = nwg / NXCD, r = nwg % NXCD, xcd = wgid % NXCD, off = wgid / NXCD; wgid = (xcd < r ? xcd * (q + 1) : r * (q + 1) + (xcd - r) * q) + off; }
        const int nig = WGM * nN, gid = wgid / nig, fm = gid * WGM, gsz = (nM - fm) < WGM ? (nM - fm) : WGM;
        u.pm = fm + ((wgid % nig) % gsz); u.pn = (wgid % nig) / gsz; return true;
    }
};
template <class P, class Epi>
__device__ __forceinline__ void gemm_phase(LAS unsigned char* lds, const P& pr, const Order& S, const Epi& E) {
    const int tid = threadIdx.x, wid = __builtin_amdgcn_readfirstlane(tid >> 6), lane = tid & 63, wr = wid >> 2, wc = wid & 3, fr = lane & 15, fq = lane >> 4;
    const int nt = pr.K / BK;
    int RA[2], CA[2]; unsigned voffB[2];
#pragma unroll
    for (int i = 0; i < 2; ++i) { int R, C; stage_rc(tid * 16 + i * 8192, R, C); RA[i] = R; CA[i] = C; const int Rb = Epi::PERM ? ((R & ~31) + perm32(R & 31)) : R; voffB[i] = (unsigned)(Rb * pr.ldb + C) * 2u; }
    const size_t kstep = (size_t)(BK * 2);
    const size_t hstepB = (size_t)HALF * pr.ldb * 2;
    const unsigned ldsw = (unsigned)wid * 1024u;
    const int aoff = lds_byte(wr * 64 + fr, fq * 8), boff = lds_byte(wc * 32 + fr, fq * 8);
#define PG8_SA(b, h) (((b) * 2 + (h)) * HTB)
#define PG8_SB(b, h) ((4 + (b) * 2 + (h)) * HTB)
#define PG8_STAGE(bufoff, gbase, voff) do { _Pragma("unroll") for (int _i = 0; _i < 2; ++_i) \
        __builtin_amdgcn_global_load_lds((const unsigned*)((const char*)(gbase) + (voff)[_i]), (LAS unsigned*)(lds + (bufoff) + ldsw + _i * 8192), 16, 0, 0); } while (0)
#define PG8_LDA(dst, b, h) do { _Pragma("unroll") for (int m = 0; m < 4; ++m) _Pragma("unroll") for (int k = 0; k < 2; ++k) dst[m][k] = *(const LAS bf16x8*)(lds + PG8_SA(b, h) + aoff + m * 2048 + k * 1024); } while (0)
#define PG8_LDB(dst, b, h) do { _Pragma("unroll") for (int n = 0; n < 2; ++n) _Pragma("unroll") for (int k = 0; k < 2; ++k) dst[n][k] = *(const LAS bf16x8*)(lds + PG8_SB(b, h) + boff + n * 2048 + k * 1024); } while (0)
#define PG8_MMA(ai, bj, At, Bt) do { __builtin_amdgcn_s_setprio(1); _Pragma("unroll") for (int m = 0; m < 4; ++m) _Pragma("unroll") for (int n = 0; n < 2; ++n) _Pragma("unroll") for (int k = 0; k < 2; ++k) \
        acc[ai][bj][m][n] = __builtin_amdgcn_mfma_f32_16x16x32_bf16(Bt[n][k], At[m][k], acc[ai][bj][m][n], 0, 0, 0); __builtin_amdgcn_s_setprio(0); } while (0)
#define PG8_WAIT_V(n) asm volatile("s_waitcnt vmcnt(" #n ")" ::: "memory")
#define PG8_WAIT_L(n) asm volatile("s_waitcnt lgkmcnt(" #n ")" ::: "memory")
#define PG8_BAR __builtin_amdgcn_s_barrier()
#define PG8_SCHED __builtin_amdgcn_sched_barrier(0)
    Unit cur, nxt; int ui = 0;
    if (!S.next(0, cur)) return;
    f32x4 acc[2][2][4][2];
#pragma unroll
    for (int a = 0; a < 2; ++a)
#pragma unroll
        for (int b = 0; b < 2; ++b)
#pragma unroll
            for (int m = 0; m < 4; ++m)
#pragma unroll
                for (int n = 0; n < 2; ++n) acc[a][b][m][n] = (f32x4){0.f, 0.f, 0.f, 0.f};
    bf16x8 At[4][2], B0[2][2], B1[2][2];
    unsigned vA[2][2], vN[2][2];
    pr.avoff(cur, RA, CA, vA);
#pragma unroll
    for (int h = 0; h < 2; ++h)
#pragma unroll
        for (int i = 0; i < 2; ++i) vN[h][i] = vA[h][i];
    const char* cA = pr.abase(cur); const char* cB = pr.bbase(cur);
#define PG8_ROT(u) 0
#define PG8_KT(tt, rot) ((size_t)(((tt) + (rot)) >= nt ? ((tt) + (rot)) - nt : ((tt) + (rot))) * kstep)
    int rot = PG8_ROT(cur);
    { const char* pA = cA + PG8_KT(0, rot); const char* pB = cB + PG8_KT(0, rot);
    PG8_STAGE(PG8_SB(0, 0), pB, voffB); PG8_STAGE(PG8_SA(0, 0), pA, vA[0]); PG8_STAGE(PG8_SB(0, 1), pB + hstepB, voffB); PG8_STAGE(PG8_SA(0, 1), pA, vA[1]);
    if (wr == 1) PG8_BAR;
    PG8_WAIT_V(4); PG8_BAR;
    PG8_STAGE(PG8_SB(1, 0), pB + kstep, voffB); PG8_STAGE(PG8_SA(1, 0), pA + kstep, vA[0]); PG8_STAGE(PG8_SB(1, 1), pB + hstepB + kstep, voffB); }
    PG8_WAIT_V(6); PG8_BAR;
    for (;;) {
        const bool has_next = S.next(ui + 1, nxt);
        const char* nA = has_next ? pr.abase(nxt) : cA; const char* nB = has_next ? pr.bbase(nxt) : cB; const int nrot = has_next ? PG8_ROT(nxt) : rot;
        if (P::GATHER) { if (has_next) pr.avoff(nxt, RA, CA, vN); }
        for (int t = 0; t < nt; t += 2) {
            const bool last = (t == nt - 2);
            const char* a1 = cA + PG8_KT(t + 1, rot);
            const char* a2 = last ? nA + PG8_KT(0, nrot) : cA + PG8_KT(t + 2, rot); const char* b2 = last ? nB + PG8_KT(0, nrot) : cB + PG8_KT(t + 2, rot);
            const char* a3 = a2 + kstep; const char* b3 = b2 + kstep;
            unsigned v2[2][2];
#pragma unroll
            for (int h = 0; h < 2; ++h)
#pragma unroll
                for (int i = 0; i < 2; ++i) v2[h][i] = (P::GATHER && last) ? vN[h][i] : vA[h][i];
            PG8_LDB(B0, 0, 0); PG8_SCHED; PG8_LDA(At, 0, 0); PG8_STAGE(PG8_SA(1, 1), a1, vA[1]);
            PG8_WAIT_L(8); PG8_BAR; PG8_WAIT_L(0); PG8_MMA(0, 0, At, B0); PG8_BAR; PG8_SCHED;
            PG8_LDB(B1, 0, 1); PG8_STAGE(PG8_SB(0, 0), b2, voffB);
            PG8_BAR; PG8_WAIT_L(0); PG8_MMA(0, 1, At, B1); PG8_BAR;
            PG8_LDA(At, 0, 1); PG8_STAGE(PG8_SA(0, 0), a2, v2[0]);
            PG8_BAR; PG8_WAIT_L(0); PG8_MMA(1, 0, At, B0); PG8_BAR; PG8_SCHED;
            PG8_STAGE(PG8_SB(0, 1), b2 + hstepB, voffB);
            PG8_WAIT_V(6); PG8_BAR; PG8_MMA(1, 1, At, B1); PG8_BAR;
            PG8_LDB(B0, 1, 0); PG8_SCHED; PG8_LDA(At, 1, 0); PG8_STAGE(PG8_SA(0, 1), a2, v2[1]);
            PG8_WAIT_L(8); PG8_BAR; PG8_WAIT_L(0); PG8_MMA(0, 0, At, B0); PG8_BAR; PG8_SCHED;
            PG8_LDB(B1, 1, 1); PG8_STAGE(PG8_SB(1, 0), b3, voffB);
            PG8_BAR; PG8_WAIT_L(0); PG8_MMA(0, 1, At, B1); PG8_BAR;
            PG8_LDA(At, 1, 1); PG8_STAGE(PG8_SA(1, 0), a3, v2[0]);
            PG8_BAR; PG8_WAIT_L(0); PG8_MMA(1, 0, At, B0); PG8_BAR; PG8_SCHED;
            PG8_STAGE(PG8_SB(1, 1), b3 + hstepB, voffB);
            PG8_WAIT_V(6); PG8_BAR; PG8_MMA(1, 1, At, B1); PG8_BAR;
            if (P::GATHER && last) {
#pragma unroll
                for (int h = 0; h < 2; ++h)
#pragma unroll
                    for (int i = 0; i < 2; ++i) vA[h][i] = vN[h][i];
            }
        }
        E(acc, cur, wr, wc, fr, fq);
        if (!has_next) break;
#pragma unroll
        for (int a = 0; a < 2; ++a)
#pragma unroll
            for (int b = 0; b < 2; ++b)
#pragma unroll
                for (int m = 0; m < 4; ++m)
#pragma unroll
                    for (int n = 0; n < 2; ++n) acc[a][b][m][n] = (f32x4){0.f, 0.f, 0.f, 0.f};
        cur = nxt; cA = nA; cB = nB; rot = nrot; ++ui;
    }
    PG8_WAIT_V(0);
    if (wr == 0) PG8_BAR;
    PG8_BAR;
#undef PG8_ROT
#undef PG8_KT
#undef PG8_SA
#undef PG8_SB
#undef PG8_STAGE
#undef PG8_LDA
#undef PG8_LDB
#undef PG8_MMA
#undef PG8_WAIT_V
#undef PG8_WAIT_L
#undef PG8_BAR
#undef PG8_SCHED
}
template <class P, class Epi>
__device__ __forceinline__ void gemm_phase2(LAS unsigned char* lds, const P& pr, const Order& S, const Epi& E) {
    const int tid = threadIdx.x, wid = __builtin_amdgcn_readfirstlane(tid >> 6), lane = tid & 63, wr = wid >> 2, wc = wid & 3, fr = lane & 15, fq = lane >> 4;
    const int nt1 = pr.K1 / BK, nt = (pr.K1 + pr.K2) / BK;
    unsigned R2[2], Rb2[2], C2[2];
#pragma unroll
    for (int i = 0; i < 2; ++i) { int R, C; stage_rc(tid * 16 + i * 8192, R, C); const int Rb = Epi::PERM ? ((R & ~31) + perm32(R & 31)) : R; R2[i] = (unsigned)R * 2u; Rb2[i] = (unsigned)Rb * 2u; C2[i] = (unsigned)C * 2u; }
#define OFF_A(ld, h, i) ((R2[i] + (unsigned)((h) * 256)) * (unsigned)(ld) + C2[i])
#define OFF_B(ld, i) (Rb2[i] * (unsigned)(ld) + C2[i])
    const size_t kstep = (size_t)(BK * 2);
    const size_t hB1 = (size_t)HALF * pr.ldb1 * 2, hB2 = (size_t)HALF * pr.ldb2 * 2;
    const unsigned ldsw = (unsigned)wid * 1024u;
    const int aoff = lds_byte(wr * 64 + fr, fq * 8), boff = lds_byte(wc * 32 + fr, fq * 8);
#define PG8_SA(b, h) (((b) * 2 + (h)) * HTB)
#define PG8_SB(b, h) ((4 + (b) * 2 + (h)) * HTB)
#define PG8_STAGE(bufoff, gbase, voff) do { _Pragma("unroll") for (int _i = 0; _i < 2; ++_i) \
        __builtin_amdgcn_global_load_lds((const unsigned*)((const char*)(gbase) + (voff)[_i]), (LAS unsigned*)(lds + (bufoff) + ldsw + _i * 8192), 16, 0, 0); } while (0)
#define PG8_LDA(dst, b, h) do { _Pragma("unroll") for (int m = 0; m < 4; ++m) _Pragma("unroll") for (int k = 0; k < 2; ++k) dst[m][k] = *(const LAS bf16x8*)(lds + PG8_SA(b, h) + aoff + m * 2048 + k * 1024); } while (0)
#define PG8_LDB(dst, b, h) do { _Pragma("unroll") for (int n = 0; n < 2; ++n) _Pragma("unroll") for (int k = 0; k < 2; ++k) dst[n][k] = *(const LAS bf16x8*)(lds + PG8_SB(b, h) + boff + n * 2048 + k * 1024); } while (0)
#define PG8_MMA(ai, bj, At, Bt) do { __builtin_amdgcn_s_setprio(1); _Pragma("unroll") for (int m = 0; m < 4; ++m) _Pragma("unroll") for (int n = 0; n < 2; ++n) _Pragma("unroll") for (int k = 0; k < 2; ++k) \
        acc[ai][bj][m][n] = __builtin_amdgcn_mfma_f32_16x16x32_bf16(Bt[n][k], At[m][k], acc[ai][bj][m][n], 0, 0, 0); __builtin_amdgcn_s_setprio(0); } while (0)
#define PG8_WAIT_V(n) asm volatile("s_waitcnt vmcnt(" #n ")" ::: "memory")
#define PG8_WAIT_L(n) asm volatile("s_waitcnt lgkmcnt(" #n ")" ::: "memory")
#define PG8_BAR __builtin_amdgcn_s_barrier()
#define PG8_SCHED __builtin_amdgcn_sched_barrier(0)
    Unit cur, nxt; int ui = 0;
    if (!S.next(0, cur)) return;
    f32x4 acc[2][2][4][2];
#pragma unroll
    for (int a = 0; a < 2; ++a)
#pragma unroll
        for (int b = 0; b < 2; ++b)
#pragma unroll
            for (int m = 0; m < 4; ++m)
#pragma unroll
                for (int n = 0; n < 2; ++n) acc[a][b][m][n] = (f32x4){0.f, 0.f, 0.f, 0.f};
    bf16x8 At[4][2], B0[2][2], B1[2][2];
    const char* cA1 = pr.abase1(cur); const char* cB1 = pr.bbase1(cur); const char* cA2 = pr.abase2(cur); const char* cB2 = pr.bbase2(cur);
#define T_A(tt) ((tt) < nt1 ? cA1 + (size_t)(tt) * kstep : cA2 + (size_t)((tt) - nt1) * kstep)
#define T_B(tt) ((tt) < nt1 ? cB1 + (size_t)(tt) * kstep : cB2 + (size_t)((tt) - nt1) * kstep)
    { unsigned vb[2] = {OFF_B(pr.ldb1, 0), OFF_B(pr.ldb1, 1)}, va0[2] = {OFF_A(pr.lda1, 0, 0), OFF_A(pr.lda1, 0, 1)}, va1[2] = {OFF_A(pr.lda1, 1, 0), OFF_A(pr.lda1, 1, 1)};
    PG8_STAGE(PG8_SB(0, 0), cB1, vb); PG8_STAGE(PG8_SA(0, 0), cA1, va0); PG8_STAGE(PG8_SB(0, 1), cB1 + hB1, vb); PG8_STAGE(PG8_SA(0, 1), cA1, va1);
    if (wr == 1) PG8_BAR;
    PG8_WAIT_V(4); PG8_BAR;
    PG8_STAGE(PG8_SB(1, 0), cB1 + kstep, vb); PG8_STAGE(PG8_SA(1, 0), cA1 + kstep, va0); PG8_STAGE(PG8_SB(1, 1), cB1 + hB1 + kstep, vb); }
    PG8_WAIT_V(6); PG8_BAR;
    for (;;) {
        const bool has_next = S.next(ui + 1, nxt);
        const char* nA = has_next ? pr.abase1(nxt) : cA1; const char* nB = has_next ? pr.bbase1(nxt) : cB1;
        for (int t = 0; t < nt; t += 2) {
            const bool last = (t == nt - 2);
            const bool s1 = (t + 1 < nt1), s2 = last || (t + 2 < nt1);
            const char* a1 = T_A(t + 1);
            const char* a2 = last ? nA : T_A(t + 2); const char* b2 = last ? nB : T_B(t + 2);
            const char* a3 = a2 + kstep; const char* b3 = b2 + kstep;
            const size_t hstepB = s2 ? hB1 : hB2; const int ldaT1 = s1 ? pr.lda1 : pr.lda2, ldaT2 = s2 ? pr.lda1 : pr.lda2, ldbT2 = s2 ? pr.ldb1 : pr.ldb2;
            unsigned v2[2][2], voffB[2], vA1s[2];
#pragma unroll
            for (int i = 0; i < 2; ++i) { voffB[i] = OFF_B(ldbT2, i); vA1s[i] = OFF_A(ldaT1, 1, i);
#pragma unroll
                for (int h = 0; h < 2; ++h) v2[h][i] = OFF_A(ldaT2, h, i); }
            PG8_LDB(B0, 0, 0); PG8_SCHED; PG8_LDA(At, 0, 0); PG8_STAGE(PG8_SA(1, 1), a1, vA1s);
            PG8_WAIT_L(8); PG8_BAR; PG8_WAIT_L(0); PG8_MMA(0, 0, At, B0); PG8_BAR; PG8_SCHED;
            PG8_LDB(B1, 0, 1); PG8_STAGE(PG8_SB(0, 0), b2, voffB);
            PG8_BAR; PG8_WAIT_L(0); PG8_MMA(0, 1, At, B1); PG8_BAR;
            PG8_LDA(At, 0, 1); PG8_STAGE(PG8_SA(0, 0), a2, v2[0]);
            PG8_BAR; PG8_WAIT_L(0); PG8_MMA(1, 0, At, B0); PG8_BAR; PG8_SCHED;
            PG8_STAGE(PG8_SB(0, 1), b2 + hstepB, voffB);
            PG8_WAIT_V(6); PG8_BAR; PG8_MMA(1, 1, At, B1); PG8_BAR;
            PG8_LDB(B0, 1, 0); PG8_SCHED; PG8_LDA(At, 1, 0); PG8_STAGE(PG8_SA(0, 1), a2, v2[1]);
            PG8_WAIT_L(8); PG8_BAR; PG8_WAIT_L(0); PG8_MMA(0, 0, At, B0); PG8_BAR; PG8_SCHED;
            PG8_LDB(B1, 1, 1); PG8_STAGE(PG8_SB(1, 0), b3, voffB);
            PG8_BAR; PG8_WAIT_L(0); PG8_MMA(0, 1, At, B1); PG8_BAR;
            PG8_LDA(At, 1, 1); PG8_STAGE(PG8_SA(1, 0), a3, v2[0]);
            PG8_BAR; PG8_WAIT_L(0); PG8_MMA(1, 0, At, B0); PG8_BAR; PG8_SCHED;
            PG8_STAGE(PG8_SB(1, 1), b3 + hstepB, voffB);
            PG8_WAIT_V(6); PG8_BAR; PG8_MMA(1, 1, At, B1); PG8_BAR;
            if (t == nt1 - 2) E.mid(acc, cur, wr, wc, fr, fq);
        }
        E(acc, cur, wr, wc, fr, fq);
        if (!has_next) break;
#pragma unroll
        for (int a = 0; a < 2; ++a)
#pragma unroll
            for (int b = 0; b < 2; ++b)
#pragma unroll
                for (int m = 0; m < 4; ++m)
#pragma unroll
                    for (int n = 0; n < 2; ++n) acc[a][b][m][n] = (f32x4){0.f, 0.f, 0.f, 0.f};
        cur = nxt; cA1 = nA; cB1 = nB; cA2 = pr.abase2(cur); cB2 = pr.bbase2(cur); ++ui;
    }
    PG8_WAIT_V(0);
    if (wr == 0) PG8_BAR;
    PG8_BAR;
#undef T_A
#undef T_B
#undef OFF_A
#undef OFF_B
#undef PG8_SA
#undef PG8_SB
#undef PG8_STAGE
#undef PG8_LDA
#undef PG8_LDB
#undef PG8_MMA
#undef PG8_WAIT_V
#undef PG8_WAIT_L
#undef PG8_BAR
#undef PG8_SCHED
}
}
using pg8::Unit;

struct ProbPlain {
    static constexpr bool GATHER = false;
    const bf16_t* A; const bf16_t* B; int K, lda, ldb;
    __device__ __forceinline__ const char* abase(const Unit& u) const { return (const char*)(A + (size_t)u.pm * 256 * lda); }
    __device__ __forceinline__ const char* bbase(const Unit& u) const { return (const char*)(B + (size_t)u.pn * 256 * ldb); }
    __device__ __forceinline__ void avoff(const Unit&, const int (&RA)[2], const int (&CA)[2], unsigned (&v)[2][2]) const {
#pragma unroll
        for (int h = 0; h < 2; ++h)
#pragma unroll
            for (int i = 0; i < 2; ++i) v[h][i] = (unsigned)((h * 128 + RA[i]) * lda + CA[i]) * 2u;
    }
};
struct ProbMerge {
    const bf16_t* A1; const bf16_t* B1; const bf16_t* A2; const bf16_t* B2; int K1, K2, lda1, ldb1, lda2, ldb2;
    __device__ __forceinline__ const char* abase1(const Unit& u) const { return (const char*)(A1 + (size_t)u.pm * 256 * lda1); }
    __device__ __forceinline__ const char* bbase1(const Unit& u) const { return (const char*)(B1 + (size_t)u.pn * 256 * ldb1); }
    __device__ __forceinline__ const char* abase2(const Unit& u) const { return (const char*)(A2 + (size_t)u.pm * 256 * lda2); }
    __device__ __forceinline__ const char* bbase2(const Unit& u) const { return (const char*)(B2 + (size_t)u.pn * 256 * ldb2); }
};
struct ProbPQ {
    static constexpr bool GATHER = false;
    const bf16_t* A; const bf16_t* B; int K, lda, ldb;
    __device__ __forceinline__ const char* abase(const Unit& u) const { return (const char*)(A + (size_t)u.pm * 256 * lda); }
    __device__ __forceinline__ const char* bbase(const Unit& u) const { return (const char*)(B + ((size_t)(u.pn >> 4) * 4096 + (u.pn & 15)) * 1024); }
    __device__ __forceinline__ void avoff(const Unit&, const int (&RA)[2], const int (&CA)[2], unsigned (&v)[2][2]) const {
#pragma unroll
        for (int h = 0; h < 2; ++h)
#pragma unroll
            for (int i = 0; i < 2; ++i) v[h][i] = (unsigned)((h * 128 + RA[i]) * lda + CA[i]) * 2u;
    }
};
struct ProbMoeUp {
    static constexpr bool GATHER = true;
    const bf16_t* A; const bf16_t* B; const int* idx; int K, lda, ldb;
    __device__ __forceinline__ const char* abase(const Unit&) const { return (const char*)A; }
    __device__ __forceinline__ const char* bbase(const Unit& u) const { return (const char*)(B + ((size_t)(u.pm >> 4) * 3072 + (size_t)u.pn * 256) * ldb); }
    __device__ __forceinline__ void avoff(const Unit& u, const int (&RA)[2], const int (&CA)[2], unsigned (&v)[2][2]) const {
#pragma unroll
        for (int h = 0; h < 2; ++h)
#pragma unroll
            for (int i = 0; i < 2; ++i) { const int g = idx[u.pm * 256 + h * 128 + RA[i]]; v[h][i] = (unsigned)(g * lda + CA[i]) * 2u; }
    }
};
struct ProbMoeDown {
    static constexpr bool GATHER = false;
    const bf16_t* A; const bf16_t* B; int K, lda, ldb;
    __device__ __forceinline__ const char* abase(const Unit& u) const { return (const char*)(A + (size_t)u.pm * 256 * lda); }
    __device__ __forceinline__ const char* bbase(const Unit& u) const { return (const char*)(B + ((size_t)(u.pm >> 4) * 1024 + (size_t)u.pn * 256) * ldb); }
    __device__ __forceinline__ void avoff(const Unit&, const int (&RA)[2], const int (&CA)[2], unsigned (&v)[2][2]) const {
#pragma unroll
        for (int h = 0; h < 2; ++h)
#pragma unroll
            for (int i = 0; i < 2; ++i) v[h][i] = (unsigned)((h * 128 + RA[i]) * lda + CA[i]) * 2u;
    }
};

#define EPI_ROWS(...) _Pragma("unroll") for (int ai = 0; ai < 2; ++ai) _Pragma("unroll") for (int m = 0; m < 4; ++m) { const int row = u.pm * 256 + ai * 128 + wr * 64 + m * 16 + fr; __VA_ARGS__ }
__device__ __forceinline__ u32x4 pack8(const f32x4 v0, const f32x4 v1) { u32x4 w; w.x = cvt_pk_bf16(v0[0], v0[1]); w.y = cvt_pk_bf16(v0[2], v0[3]); w.z = cvt_pk_bf16(v1[0], v1[1]); w.w = cvt_pk_bf16(v1[2], v1[3]); return w; }

struct EpiPQ {
    static constexpr bool PERM = true; bf16_t* O;
    __device__ __forceinline__ void operator()(const f32x4 (&acc)[2][2][4][2], const Unit& u, int wr, int wc, int fr, int fq) const {
        const int t10 = wc * 32 + 8 * fq, b = u.pn >> 4, t2 = u.pn & 15;
        EPI_ROWS(
            bf16_t* rp = O + ((size_t)((b * 512 + (row >> 1)) * 16 + t2) * 512 + (row & 1) * 256 + t10);
            _Pragma("unroll") for (int bj = 0; bj < 2; ++bj) *(u32x4*)(rp + bj * 128) = pack8(acc[ai][bj][m][0], acc[ai][bj][m][1]);
        )
    }
};
struct EpiPlain {
    static constexpr bool PERM = true; bf16_t* O; size_t ldc;
    __device__ __forceinline__ void operator()(const f32x4 (&acc)[2][2][4][2], const Unit& u, int wr, int wc, int fr, int fq) const {
        const int col0 = u.pn * 256 + wc * 32 + 8 * fq;
        EPI_ROWS(
            bf16_t* rp = O + (size_t)row * ldc + col0;
            _Pragma("unroll") for (int bj = 0; bj < 2; ++bj) *(u32x4*)(rp + bj * 128) = pack8(acc[ai][bj][m][0], acc[ai][bj][m][1]);
        )
    }
};
struct EpiZ {
    static constexpr bool PERM = true; bf16_t* O; int ldc; int fixed_act;
    __device__ __forceinline__ void operator()(const f32x4 (&acc)[2][2][4][2], const Unit& u, int wr, int wc, int fr, int fq) const {
        const int col0 = u.pn * 256 + wc * 32 + 8 * fq; const int act = fixed_act >= 0 ? fixed_act : (u.pn >> 2);
        EPI_ROWS(
            bf16_t* rp = O + (size_t)row * ldc + col0;
            _Pragma("unroll") for (int bj = 0; bj < 2; ++bj) {
                f32x4 v0 = acc[ai][bj][m][0], v1 = acc[ai][bj][m][1];
                if (act == 1) { _Pragma("unroll") for (int j = 0; j < 4; ++j) { v0[j] = gelu_tanh(v0[j]); v1[j] = gelu_tanh(v1[j]); } }
                else if (act >= 2) { _Pragma("unroll") for (int j = 0; j < 4; ++j) { v0[j] = sigmoidf_(v0[j]); v1[j] = sigmoidf_(v1[j]); } }
                *(u32x4*)(rp + bj * 128) = pack8(v0, v1); }
        )
    }
};
struct EpiMerge {
    static constexpr bool PERM = true; bf16_t* O; const bf16_t* Z;
    __device__ __forceinline__ void mid(f32x4 (&acc)[2][2][4][2], const Unit& u, int wr, int wc, int fr, int fq) const {
        unsigned eo = (unsigned)((u.pm * 256 + wr * 64 + fr) * 4096 + 2048 + u.pn * 256 + wc * 32 + 8 * fq);
        asm volatile("" : "+v"(eo));
#pragma unroll
        for (int ai = 0; ai < 2; ++ai) {
            u32x4 wa[4][2], wb[4][2];
#pragma unroll
            for (int m = 0; m < 4; ++m)
#pragma unroll
                for (int bj = 0; bj < 2; ++bj) { const unsigned o = eo + (unsigned)((ai * 128 + m * 16) * 4096 + bj * 128); wa[m][bj] = *(const u32x4*)(Z + o); wb[m][bj] = *(const u32x4*)(Z + o + 1024); }
#pragma unroll
            for (int m = 0; m < 4; ++m)
#pragma unroll
                for (int bj = 0; bj < 2; ++bj) { float ga[8], gb[8]; unpack8(wa[m][bj], ga); unpack8(wb[m][bj], gb);
#pragma unroll
                    for (int j = 0; j < 4; ++j) { acc[ai][bj][m][0][j] *= ga[j] * __builtin_amdgcn_rcpf(fmaxf(gb[j], 1e-30f)); acc[ai][bj][m][1][j] *= ga[4 + j] * __builtin_amdgcn_rcpf(fmaxf(gb[4 + j], 1e-30f)); } }
            __builtin_amdgcn_sched_barrier(0); }
    }
    __device__ __forceinline__ void operator()(const f32x4 (&acc)[2][2][4][2], const Unit& u, int wr, int wc, int fr, int fq) const {
        unsigned eo = (unsigned)((u.pm * 256 + wr * 64 + fr) * 4096 + 3072 + u.pn * 256 + wc * 32 + 8 * fq); asm volatile("" : "+v"(eo));
        unsigned oo = (unsigned)((u.pm * 256 + wr * 64 + fr) * 1024 + u.pn * 256 + wc * 32 + 8 * fq); asm volatile("" : "+v"(oo));
        u32x4 wb[2][4][2];
#pragma unroll
        for (int ai = 0; ai < 2; ++ai)
#pragma unroll
            for (int m = 0; m < 4; ++m)
#pragma unroll
                for (int bj = 0; bj < 2; ++bj) wb[ai][m][bj] = *(const u32x4*)(Z + eo + (unsigned)((ai * 128 + m * 16) * 4096 + bj * 128));
#pragma unroll
        for (int ai = 0; ai < 2; ++ai)
#pragma unroll
            for (int m = 0; m < 4; ++m)
#pragma unroll
                for (int bj = 0; bj < 2; ++bj) { float g[8]; unpack8(wb[ai][m][bj], g);
                    f32x4 v0 = acc[ai][bj][m][0], v1 = acc[ai][bj][m][1];
#pragma unroll
                    for (int j = 0; j < 4; ++j) { v0[j] *= g[j]; v1[j] *= g[4 + j]; }
                    *(u32x4*)(O + oo + (unsigned)((ai * 128 + m * 16) * 1024 + bj * 128)) = pack8(v0, v1); }
    }
};
struct EpiOut {
    static constexpr bool PERM = false; float* O; const float* X; const float* pos; const float* ada;
    __device__ __forceinline__ void operator()(const f32x4 (&acc)[2][2][4][2], const Unit& u, int wr, int wc, int fr, int fq) const {
        const int col0 = u.pn * 256 + wc * 32 + 4 * fq; const int b = u.pm >> 4;
        unsigned ro = (unsigned)((u.pm * 256 + wr * 64 + fr) * 1024 + col0); asm volatile("" : "+v"(ro));
#pragma unroll
        for (int ai = 0; ai < 2; ++ai) {
            f32x4 xv[4][2][2];
#pragma unroll
            for (int m = 0; m < 4; ++m)
#pragma unroll
                for (int bj = 0; bj < 2; ++bj)
#pragma unroll
                    for (int n = 0; n < 2; ++n) xv[m][bj][n] = *(const f32x4*)(X + ro + (unsigned)((ai * 128 + m * 16) * 1024 + bj * 128 + n * 16));
#pragma unroll
            for (int m = 0; m < 4; ++m) { const int row = u.pm * 256 + ai * 128 + wr * 64 + m * 16 + fr; const int t = row & 4095;
#pragma unroll
                for (int bj = 0; bj < 2; ++bj)
#pragma unroll
                    for (int n = 0; n < 2; ++n) { const int col = col0 + bj * 128 + n * 16;
                        const f32x4 pv = *(const f32x4*)(pos + (col < 512 ? (t >> 6) * 512 + col : (t & 63) * 512 + (col - 512)));
                        const f32x4 gv = *(const f32x4*)(ada + b * 6144 + 2048 + col);
                        *(f32x4*)(O + ro + (unsigned)((ai * 128 + m * 16) * 1024 + bj * 128 + n * 16)) = xv[m][bj][n] + pv + gv * acc[ai][bj][m][n]; } }
            __builtin_amdgcn_sched_barrier(0); }
    }
};
struct EpiGU {
    static constexpr bool PERM = true; bf16_t* O;
    __device__ __forceinline__ void operator()(const f32x4 (&acc)[2][2][4][2], const Unit& u, int wr, int wc, int fr, int fq) const {
        const int col0 = u.pn * 128 + wc * 32 + 8 * fq;
        EPI_ROWS(
            f32x4 v0, v1;
            _Pragma("unroll") for (int j = 0; j < 4; ++j) { const float g0 = acc[ai][0][m][0][j], g1 = acc[ai][0][m][1][j];
                v0[j] = g0 * sigmoidf_(g0) * acc[ai][1][m][0][j]; v1[j] = g1 * sigmoidf_(g1) * acc[ai][1][m][1][j]; }
            *(u32x4*)(O + (size_t)row * DE + col0) = pack8(v0, v1);
        )
    }
};
struct EpiDown {
    static constexpr bool PERM = true; bf16_t* O; const float* gate;
    __device__ __forceinline__ void operator()(const f32x4 (&acc)[2][2][4][2], const Unit& u, int wr, int wc, int fr, int fq) const {
        const int col0 = u.pn * 256 + wc * 32 + 8 * fq;
        EPI_ROWS(
            const float g = gate[row];
            _Pragma("unroll") for (int bj = 0; bj < 2; ++bj) *(u32x4*)(O + (size_t)row * 1024 + col0 + bj * 128) = pack8(acc[ai][bj][m][0] * g, acc[ai][bj][m][1] * g);
        )
    }
};

__device__ __forceinline__ void p0_ada(const Params& p, LAS unsigned char* lds, int item) {
    const int tid = threadIdx.x;
    LAS float* s = (LAS float*)lds; LAS float* red = s + 9 * 1024;
    for (int i = tid; i < 9 * 1024; i += NTHR) { const int r = i >> 10, d = i & 1023; const float v = r < 8 ? p.c[r * 1024 + d] : p.c_ctx[d]; s[i] = v / (1.0f + expf(-v)); }
    __syncthreads();
    const int col = tid & 63, ds = tid >> 6; float a[9];
#pragma unroll
    for (int r = 0; r < 9; ++r) a[r] = 0.f;
    const float* w = p.w_ada + (size_t)(ds * 128) * 6144 + item * 64 + col;
    for (int d0 = 0; d0 < 128; d0 += 32) { float wv[32];
#pragma unroll
        for (int j = 0; j < 32; ++j) wv[j] = w[(size_t)(d0 + j) * 6144];
#pragma unroll
        for (int j = 0; j < 32; ++j)
#pragma unroll
            for (int r = 0; r < 9; ++r) a[r] += s[r * 1024 + ds * 128 + d0 + j] * wv[j]; }
#pragma unroll
    for (int r = 0; r < 9; ++r) red[(ds * 9 + r) * 64 + col] = a[r];
    __syncthreads();
    float* ada = (float*)(p.ws + WS_ADA);
    for (int i = tid; i < 9 * 64; i += NTHR) { const int r = i >> 6, cc = i & 63; float v = 0.f;
#pragma unroll
        for (int k = 0; k < 8; ++k) v += red[(k * 9 + r) * 64 + cc];
        ada[r * 6144 + item * 64 + cc] = v + p.b_ada[item * 64 + cc]; }
    __syncthreads();
}
template <int NS>
__device__ __forceinline__ void xpose_item(const float* src, int ldsrc, bf16_t* dst, int lddst, int k0, int n0, int mode, float scale = 1.0f) {
    const int tid = threadIdx.x, k8 = tid & 7, nq = tid >> 3;
    if (nq >= 16 * NS) return;
    f32x4 v[8];
#pragma unroll
    for (int j = 0; j < 8; ++j) v[j] = *(const f32x4*)(src + (size_t)(k0 + 8 * k8 + j) * ldsrc + n0 + 4 * nq);
#pragma unroll
    for (int c = 0; c < 4; ++c) { const int n = n0 + 4 * nq + c; int row = n;
        if (mode) row = (n >> 7) * 256 + (n & 127) + (mode == 2 ? 128 : 0);
        u32x4 w; w.x = cvt_pk_bf16(v[0][c] * scale, v[1][c] * scale); w.y = cvt_pk_bf16(v[2][c] * scale, v[3][c] * scale); w.z = cvt_pk_bf16(v[4][c] * scale, v[5][c] * scale); w.w = cvt_pk_bf16(v[6][c] * scale, v[7][c] * scale);
        *(u32x4*)(dst + (size_t)row * lddst + k0 + 8 * k8) = w; }
}
__device__ __forceinline__ void p0_wpq(const Params& p, LAS unsigned char* lds, int item) {
    const int tid = threadIdx.x, g = item >> 6, db = item & 63;
    LAS float* wl = (LAS float*)lds; LAS float* ct = wl + 16 * 129;
    for (int i = tid; i < 16 * 128; i += NTHR) { const int d = i >> 7, cc = i & 127; wl[d * 129 + cc] = p.w_in[(size_t)(db * 16 + d) * 4608 + g * 128 + cc]; }
    if (tid < 128) { float sn, cs; sincospif((float)tid * (1.0f / 64.0f), &sn, &cs); ct[tid] = cs; ct[128 + tid] = sn; }
    __syncthreads();
    const int q = tid & 255, kc = q >> 1, pq = q & 1, dh = tid >> 8; const int n = (g * 128 + kc) * 2 + pq;
    bf16_t* dst = (bf16_t*)(p.ws + WS_WPQ) + (size_t)n * 1024 + db * 16 + dh * 8;
    const float scale = 0.001381067932f;
    float a[8];
#pragma unroll
    for (int j = 0; j < 8; ++j) a[j] = 0.f;
    for (int cc = 0; cc < 128; ++cc) { const float tv = ct[pq * 128 + ((cc * kc) & 127)];
#pragma unroll
        for (int j = 0; j < 8; ++j) a[j] += wl[(dh * 8 + j) * 129 + cc] * tv; }
    u32x4 w; w.x = cvt_pk_bf16(a[0] * scale, a[1] * scale); w.y = cvt_pk_bf16(a[2] * scale, a[3] * scale); w.z = cvt_pk_bf16(a[4] * scale, a[5] * scale); w.w = cvt_pk_bf16(a[6] * scale, a[7] * scale);
    *(u32x4*)dst = w;
    __syncthreads();
}
__device__ __forceinline__ void p0_d1t(const Params& p, int item) {
    bf16_t* dst = (bf16_t*)(p.ws + WS_D1T);
    const int row = item * 64 + (threadIdx.x >> 3), k1 = row >> 1, ri = row & 1, c0 = (threadIdx.x & 7) * 64;
    for (int c8 = 0; c8 < 64; c8 += 8) { float v[8];
#pragma unroll
        for (int j = 0; j < 8; ++j) { const int col = c0 + c8 + j, pq = col >> 8, t1 = col & 255; float sn, cs; sincospif((float)((k1 * t1) & 255) * (1.0f / 128.0f), &sn, &cs);
            v[j] = (ri == 0) ? (pq == 0 ? cs : -sn) : (pq == 0 ? -sn : -cs); }
        u32x4 w; w.x = cvt_pk_bf16(v[0], v[1]); w.y = cvt_pk_bf16(v[2], v[3]); w.z = cvt_pk_bf16(v[4], v[5]); w.w = cvt_pk_bf16(v[6], v[7]);
        *(u32x4*)(dst + (size_t)row * 512 + c0 + c8) = w; }
}
__device__ __forceinline__ void p0_d2t(const Params& p, int item) {
    bf16_t* dst = (bf16_t*)(p.ws + WS_D2T);
#pragma unroll
    for (int ps = 0; ps < 4; ++ps) { const int pc = (item * 4 + ps) * NTHR + threadIdx.x, tp = pc >> 2, kk0 = (pc & 3) * 8; float v[8];
#pragma unroll
        for (int j = 0; j < 8; ++j) { const int kk = kk0 + j, ri = kk >> 4, t2 = kk & 15; float sn, cs; sincospif((float)((tp * t2) & 4095) * (1.0f / 2048.0f), &sn, &cs); v[j] = ri ? sn : cs; }
        u32x4 w; w.x = cvt_pk_bf16(v[0], v[1]); w.y = cvt_pk_bf16(v[2], v[3]); w.z = cvt_pk_bf16(v[4], v[5]); w.w = cvt_pk_bf16(v[6], v[7]);
        *(u32x4*)(dst + (size_t)tp * 32 + kk0) = w; }
}
__device__ __forceinline__ void p0_pos(const Params& p) {
    float* tab = (float*)(p.ws + WS_POS);
    for (int i = threadIdx.x; i < 64 * 512; i += NTHR) { const int ii = i >> 9, j = i & 511, jj = j & 255; const float f = expf(-9.210340371976184f * (float)jj / 256.0f); const float a = (float)ii * f; tab[i] = j < 256 ? sinf(a) : cosf(a); }
}
__device__ __forceinline__ void phase0(const Params& p, LAS unsigned char* lds) {
    constexpr int N_ADA = 96, N_WIN = 16 * 16, N_WFOUR = 8 * 4, N_SQ = 16 * 4, N_LRU = 16 * 2, N_WPQ = 256, N_DFT = 8 + 8, N_POS = 1;
    constexpr int O1 = N_ADA, O2 = O1 + N_WIN, O3 = O2 + N_WFOUR, O4 = O3 + N_SQ, O5 = O4 + N_SQ, O6 = O5 + N_LRU, O7 = O6 + N_LRU, O8 = O7 + N_WPQ, O9 = O8 + N_DFT, O10 = O9 + N_POS;
    for (int it = blockIdx.x; it < O10; it += gridDim.x) {
        if (it < O1) p0_ada(p, lds, it);
        else if (it < O2) { const int j = it - O1; xpose_item<4>(p.w_in + 512, 4608, (bf16_t*)(p.ws + WS_WIN), 1024, (j >> 4) * 64, (j & 15) * 256, 0); }
        else if (it < O3) { const int j = it - O2; xpose_item<4>(p.w_four, 1024, (bf16_t*)(p.ws + WS_WFOUR), 512, (j >> 2) * 64, (j & 3) * 256, 0); }
        else if (it < O4) { const int j = it - O3; xpose_item<4>(p.w_lru, 1024, (bf16_t*)(p.ws + WS_WLRU), 1024, (j >> 2) * 64, (j & 3) * 256, 0); }
        else if (it < O5) { const int j = it - O4; xpose_item<4>(p.w_out, 1024, (bf16_t*)(p.ws + WS_WOUT), 1024, (j >> 2) * 64, (j & 3) * 256, 0); }
        else if (it < O6) { const int j = it - O5, mtx = j >> 1; xpose_item<2>(p.lru_wa + (size_t)mtx * 16384, 128, (bf16_t*)(p.ws + WS_WAT) + (size_t)mtx * 16384, 128, (j & 1) * 64, 0, 0, NLOG2E); }
        else if (it < O7) { const int j = it - O6, mtx = j >> 1; xpose_item<2>(p.lru_wi + (size_t)mtx * 16384, 128, (bf16_t*)(p.ws + WS_WIT) + (size_t)mtx * 16384, 128, (j & 1) * 64, 0, 0, NLOG2E); }
        else if (it < O8) p0_wpq(p, lds, it - O7);
        else if (it < O9) { if (it - O8 < 8) p0_d1t(p, it - O8); else p0_d2t(p, it - O8 - 8); }
        else p0_pos(p);
    }
}

__device__ __forceinline__ void phase1(const Params& p) {
    const int tid = tid_opaque(), lane = tid & 63, wid = tid >> 6;
    const float* ada = (const float*)(p.ws + WS_ADA); const float* tab = (const float*)(p.ws + WS_POS);
    bf16_t* h1 = (bf16_t*)(p.ws + WS_R1); bf16_t* hc = (bf16_t*)(p.ws + WS_HCTX);
    constexpr int NR = MLAT + MCTX, RW = 4;
    for (int row0 = (blockIdx.x * 8 + wid) * RW; row0 < NR; row0 += gridDim.x * 8 * RW) {
        const bool lat = row0 < MLAT; const int mrow = lat ? (row0 >> 12) : 8;
        f32x4 v[RW][4]; float ss[RW];
#pragma unroll
        for (int r = 0; r < RW; ++r) { const int row = row0 + r; const float* xr = lat ? p.x + (size_t)row * 1024 : p.ctx + (size_t)(row - MLAT) * 1024;
#pragma unroll
            for (int i = 0; i < 4; ++i) v[r][i] = *(const f32x4*)(xr + 256 * i + 4 * lane); }
#pragma unroll
        for (int r = 0; r < RW; ++r) { const int t = (row0 + r) & 4095; float a = 0.f;
#pragma unroll
            for (int i = 0; i < 4; ++i) { const int d = 256 * i + 4 * lane;
                if (lat) v[r][i] += *(const f32x4*)(tab + (i < 2 ? (t >> 6) * 512 + d : (t & 63) * 512 + d - 512));
                a += v[r][i][0] * v[r][i][0] + v[r][i][1] * v[r][i][1] + v[r][i][2] * v[r][i][2] + v[r][i][3] * v[r][i][3]; }
            ss[r] = a; }
#pragma unroll
        for (int o = 32; o >= 1; o >>= 1) {
#pragma unroll
            for (int r = 0; r < RW; ++r) ss[r] += __shfl_xor(ss[r], o); }
#pragma unroll
        for (int i = 0; i < 4; ++i) { const int d = 256 * i + 4 * lane;
            const f32x4 g = *(const f32x4*)(p.norm1_g + d), sh = *(const f32x4*)(ada + mrow * 6144 + d), sc = *(const f32x4*)(ada + mrow * 6144 + 1024 + d);
#pragma unroll
            for (int r = 0; r < RW; ++r) { const int row = row0 + r; const float rs = rsqrtf(ss[r] * (1.0f / 1024.0f) + 1e-6f);
                bf16_t* dst = lat ? h1 + (size_t)row * 1024 : hc + (size_t)(row - MLAT) * 1024;
                const f32x4 h = v[r][i] * rs * g * (sc + 1.0f) + sh;
                u32x2 w; w.x = cvt_pk_bf16(h[0], h[1]); w.y = cvt_pk_bf16(h[2], h[3]); *(u32x2*)(dst + d) = w; } }
    }
}

#define LRU_CST(mb, r) (32 * (mb) + 8 * ((r) >> 2) + ((r) & 3))
template <bool FINAL, int DIR>
__device__ __forceinline__ void lru_wave(const Params& p, LAS unsigned char* ul, int b, int sc, int head, int cb, int lane, f32x16 (&accI)[4]) {
    constexpr int SG = DIR ? -1 : 1;
    const int lr = lane & 31, lh = lane >> 5;
    const int chl = cb * 32 + lr, ch = head * 128 + chl;
    const int tbase = DIR ? 127 - 4 * lh : 4 * lh;
    f32x16 accA[4];
#pragma unroll
    for (int mb = 0; mb < 4; ++mb)
#pragma unroll
        for (int r = 0; r < 16; ++r) { accA[mb][r] = 0.f; accI[mb][r] = 0.f; }
    {
        const bf16_t* wa = (const bf16_t*)(p.ws + WS_WAT) + ((size_t)(DIR * 8 + head) * 128 + chl) * 128 + 8 * lh;
        const bf16_t* wi = (const bf16_t*)(p.ws + WS_WIT) + ((size_t)(DIR * 8 + head) * 128 + chl) * 128 + 8 * lh;
        LAS unsigned char* arow0 = ul + (DIR ? 127 - lr : lr) * 272 + lh * 16;
#pragma unroll
        for (int kc = 0; kc < 2; ++kc) { bf16x8 bA[4], bI[4];
#pragma unroll
            for (int k4 = 0; k4 < 4; ++k4) { bA[k4] = *(const bf16x8*)(wa + 16 * (kc * 4 + k4)); bI[k4] = *(const bf16x8*)(wi + 16 * (kc * 4 + k4)); }
#pragma unroll
            for (int mb = 0; mb < 4; ++mb)
#pragma unroll
                for (int k4 = 0; k4 < 4; ++k4) { const bf16x8 af = *(const LAS bf16x8*)(arow0 + SG * 32 * mb * 272 + 32 * (kc * 4 + k4));
                    accA[mb] = __builtin_amdgcn_mfma_f32_32x32x16_bf16(af, bA[k4], accA[mb], 0, 0, 0);
                    accI[mb] = __builtin_amdgcn_mfma_f32_32x32x16_bf16(af, bI[k4], accI[mb], 0, 0, 0); }
            __builtin_amdgcn_sched_barrier(0); }
    }
    {
        const float lam = p.lru_lambda[DIR * 1024 + ch]; const float sp8 = 8.0f * log1pf(expf(-lam));
        const float ba = p.lru_ba[DIR * 1024 + ch], bi = p.lru_bi[DIR * 1024 + ch];
        LAS unsigned char* up = ul + tbase * 272 + chl * 2;
#pragma unroll
        for (int mb = 0; mb < 4; ++mb) {
#pragma unroll
            for (int r = 0; r < 16; ++r) {
                const float uv = bf2f(*(const LAS bf16_t*)(up + SG * LRU_CST(mb, r) * 272));
                const float rg = __builtin_amdgcn_rcpf(1.0f + __builtin_amdgcn_exp2f(accA[mb][r] + NLOG2E * ba)), ig = __builtin_amdgcn_rcpf(1.0f + __builtin_amdgcn_exp2f(accI[mb][r] + NLOG2E * bi));
                const float a = __expf(-sp8 * rg); accA[mb][r] = a; accI[mb][r] = __builtin_amdgcn_sqrtf(fmaxf(1.0f - a * a, 0.f)) * ig * uv; }
            __builtin_amdgcn_sched_barrier(0); }
    }
    float rA[16], rH[16];
#pragma unroll
    for (int mb = 0; mb < 4; ++mb)
#pragma unroll
        for (int q = 0; q < 4; ++q) { float pa = 1.f, hh = 0.f;
#pragma unroll
            for (int j = 0; j < 4; ++j) { const int r = 4 * q + j; const float a = accA[mb][r], bb = accI[mb][r]; hh = a * hh + bb; pa *= a; accA[mb][r] = pa; accI[mb][r] = hh; }
            rA[mb * 4 + q] = pa; rH[mb * 4 + q] = hh; }
    const int agg_dir_off = ((b * NSEQ) * 2 + DIR) * 1024 + ch;
    const float* agg = (const float*)(p.ws + WS_AGG);
    float carry = 0.f;
    if (FINAL) {
        if (DIR == 0) { for (int q = 0; q < sc; ++q) { const float* a2 = agg + (size_t)(agg_dir_off + q * 2048) * 2; carry = a2[0] * carry + a2[1]; } }
        else { { const float* a2 = agg + (size_t)(agg_dir_off + 1 * 2048) * 2; carry = a2[0] * carry + a2[1]; } { const float* a2 = agg + (size_t)(agg_dir_off + 0 * 2048) * 2; carry = a2[0] * carry + a2[1]; }
            for (int q = NSEQ - 1; q > sc; --q) { const float* a2 = agg + (size_t)(agg_dir_off + q * 2048) * 2; carry = a2[0] * carry + a2[1]; } }
    }
    float cin[16];
#pragma unroll
    for (int i = 0; i < 16; ++i) cin[i] = 0.f;
    float s = carry, At = 1.f;
#pragma unroll
    for (int i = 0; i < 16; ++i) { const float oA = __shfl_xor(rA[i], 32), oH = __shfl_xor(rH[i], 32);
        { const bool mine = (lh == 0); const float a = mine ? rA[i] : oA, hh = mine ? rH[i] : oH; cin[i] = mine ? s : cin[i]; s = a * s + hh; At *= a; }
        { const bool mine = (lh == 1); const float a = mine ? rA[i] : oA, hh = mine ? rH[i] : oH; cin[i] = mine ? s : cin[i]; s = a * s + hh; At *= a; } }
    if (!FINAL) {
        if (lh == 0) { float* o = (float*)(p.ws + WS_AGG) + (size_t)(agg_dir_off + sc * 2048) * 2; o[0] = At; o[1] = s; }
        return;
    }
#pragma unroll
    for (int mb = 0; mb < 4; ++mb)
#pragma unroll
        for (int r = 0; r < 16; ++r) accI[mb][r] += accA[mb][r] * cin[mb * 4 + (r >> 2)];
}
template <bool FINAL>
__device__ __forceinline__ void lru_tile(const Params& p, LAS unsigned char* lds, int item) {
    const int tid = threadIdx.x, lane = tid & 63, wid = __builtin_amdgcn_readfirstlane(tid >> 6);
    int b, sc, head;
    if (FINAL) { head = item & 7; sc = 2 + ((item >> 3) & 31); b = item >> 8; }
    else { head = item & 7; const int r = item >> 3; sc = r & 1; b = r >> 1; }
    const bf16_t* src; int Tseq, t0, ld;
    if (sc < 2) { src = (const bf16_t*)(p.ws + WS_ZXC) + (size_t)b * 256 * 1024; Tseq = 256; t0 = sc * 128; ld = 1024; }
    else { src = (const bf16_t*)(p.ws + WS_RZ) + (size_t)b * 4096 * 4096; Tseq = 4096; t0 = (sc - 2) * 128; ld = 4096; }
    LAS unsigned char* ul = lds;
    LAS float* ybuf = (LAS float*)(lds + 36 * 1024);
    {
        const int c8 = tid & 15, tb = tid >> 4; const int ch0 = head * 128 + 8 * c8;
        float w[4][8], bias[8];
#pragma unroll
        for (int k = 0; k < 4; ++k) { const f32x4 a = *(const f32x4*)(p.conv_w + k * 1024 + ch0), c2 = *(const f32x4*)(p.conv_w + k * 1024 + ch0 + 4);
#pragma unroll
            for (int j = 0; j < 4; ++j) { w[k][j] = a[j]; w[k][4 + j] = c2[j]; } }
        { const f32x4 a = *(const f32x4*)(p.conv_b + ch0), c2 = *(const f32x4*)(p.conv_b + ch0 + 4);
#pragma unroll
            for (int j = 0; j < 4; ++j) { bias[j] = a[j]; bias[4 + j] = c2[j]; } }
#pragma unroll
        for (int i = 0; i < 4; ++i) { const int t = tb + 32 * i; float a[8];
#pragma unroll
            for (int j = 0; j < 8; ++j) a[j] = bias[j];
#pragma unroll
            for (int k = 0; k < 4; ++k) { const int tt = t0 + t + k - 2;
                if (tt >= 0 && tt < Tseq) { float f[8]; unpack8(*(const u32x4*)(src + (size_t)tt * ld + ch0), f);
#pragma unroll
                    for (int j = 0; j < 8; ++j) a[j] += w[k][j] * f[j]; } }
            u32x4 wv; wv.x = cvt_pk_bf16(a[0], a[1]); wv.y = cvt_pk_bf16(a[2], a[3]); wv.z = cvt_pk_bf16(a[4], a[5]); wv.w = cvt_pk_bf16(a[6], a[7]);
            *(LAS u32x4*)(ul + t * 272 + c8 * 16) = wv; }
    }
    __syncthreads();
    f32x16 hacc[4];
    if (wid < 4) lru_wave<FINAL, 0>(p, ul, b, sc, head, wid & 3, lane, hacc);
    else lru_wave<FINAL, 1>(p, ul, b, sc, head, wid & 3, lane, hacc);
    if (FINAL) {
        const int lr = lane & 31, lh = lane >> 5, chl = (wid & 3) * 32 + lr;
        if (wid >= 4) { LAS float* yp = ybuf + (127 - 4 * lh) * 129 + chl;
#pragma unroll
            for (int mb = 0; mb < 4; ++mb)
#pragma unroll
                for (int r = 0; r < 16; ++r) yp[-LRU_CST(mb, r) * 129] = hacc[mb][r]; }
        __syncthreads();
        if (wid < 4) {
            const LAS float* yp = ybuf + (4 * lh) * 129 + chl;
            const bf16_t* Zu = (const bf16_t*)(p.ws + WS_RZ) + ((size_t)(b * 4096 + t0) * 4096 + 1024 + head * 128);
            bf16_t* Ou = (bf16_t*)(p.ws + WS_R1) + ((size_t)(b * 4096 + t0) * 1024 + head * 128);
            const unsigned zo = (unsigned)(4 * lh * 4096 + chl), oo = (unsigned)(4 * lh * 1024 + chl);
#pragma unroll
            for (int mb = 0; mb < 4; ++mb) {
#pragma unroll
                for (int r = 0; r < 16; ++r) {
                    const float y = hacc[mb][r] + yp[LRU_CST(mb, r) * 129];
                    const float gz = bf2f(Zu[zo + LRU_CST(mb, r) * 4096]);
                    Ou[oo + LRU_CST(mb, r) * 1024] = (bf16_t)(cvt_pk_bf16(gz * y, 0.f) & 0xffffu);
                    if ((r & 7) == 7) __builtin_amdgcn_sched_barrier(0); } }
        }
    }
    __syncthreads();
}

#ifndef LRU_PF_FRAG
#define LRU_PF_FRAG true
#endif
#ifndef LRU_PF_TILE
#define LRU_PF_TILE true
#endif
typedef unsigned long long u64_t;
template <int DIR, bool PREF>
__device__ __forceinline__ void lru2_dir(const Params& p, LAS unsigned char* ul, int head, int w, int lane, const bf16x8 (&bA)[4], const bf16x8 (&bI)[4], bf16x8 (&nA)[4], bf16x8 (&nI)[4],
                                         f32x4 (&hl)[8], f32x4 (&pp)[8], float& Atot, float& Htot) {
    constexpr int SG = DIR ? -1 : 1;
    const int fr = lane & 15, fq = lane >> 4, chl = 16 * w + fr, ch = head * 128 + chl;
    f32x4 accA[8], accI[8];
    { const float ba2 = NLOG2E * p.lru_ba[DIR * 1024 + ch], bi2 = NLOG2E * p.lru_bi[DIR * 1024 + ch];
#pragma unroll
      for (int rb = 0; rb < 8; ++rb) { accA[rb] = (f32x4){ba2, ba2, ba2, ba2}; accI[rb] = (f32x4){bi2, bi2, bi2, bi2}; } }
    {
        LAS unsigned char* arow0 = ul + (DIR ? 127 - fr : fr) * 272 + fq * 16;
#pragma unroll
        for (int rb = 0; rb < 8; ++rb)
#pragma unroll
            for (int ks = 0; ks < 4; ++ks) { const bf16x8 af = *(const LAS bf16x8*)(arow0 + SG * 16 * rb * 272 + 64 * ks);
                accA[rb] = __builtin_amdgcn_mfma_f32_16x16x32_bf16(af, bA[ks], accA[rb], 0, 0, 0);
                accI[rb] = __builtin_amdgcn_mfma_f32_16x16x32_bf16(af, bI[ks], accI[rb], 0, 0, 0); }
    }
    if (PREF) {
        const bf16_t* wa = (const bf16_t*)(p.ws + WS_WAT) + ((size_t)((1 - DIR) * 8 + head) * 128 + chl) * 128 + 8 * fq;
        const bf16_t* wi = (const bf16_t*)(p.ws + WS_WIT) + ((size_t)((1 - DIR) * 8 + head) * 128 + chl) * 128 + 8 * fq;
#pragma unroll
        for (int ks = 0; ks < 4; ++ks) { nA[ks] = *(const bf16x8*)(wa + 32 * ks); nI[ks] = *(const bf16x8*)(wi + 32 * ks); }
    }
    {
        typedef float f32x2 __attribute__((ext_vector_type(2)));
        const float lam = p.lru_lambda[DIR * 1024 + ch]; const float k2 = NLOG2E * 8.0f * log1pf(expf(-lam));
        LAS unsigned char* up = ul + (DIR ? 127 - 4 * fq : 4 * fq) * 272 + chl * 2;
#pragma unroll
        for (int rb = 0; rb < 8; ++rb)
#pragma unroll
            for (int r = 0; r < 4; r += 2) {
                f32x2 uv; uv.x = bf2f(*(const LAS bf16_t*)(up + SG * (16 * rb + r) * 272)); uv.y = bf2f(*(const LAS bf16_t*)(up + SG * (16 * rb + r + 1) * 272));
                f32x2 ea, ei; ea.x = __builtin_amdgcn_exp2f(accA[rb][r]); ea.y = __builtin_amdgcn_exp2f(accA[rb][r + 1]); ei.x = __builtin_amdgcn_exp2f(accI[rb][r]); ei.y = __builtin_amdgcn_exp2f(accI[rb][r + 1]);
                const f32x2 da = ea + 1.0f, di = ei + 1.0f;
                f32x2 rg, ig; rg.x = __builtin_amdgcn_rcpf(da.x); rg.y = __builtin_amdgcn_rcpf(da.y); ig.x = __builtin_amdgcn_rcpf(di.x); ig.y = __builtin_amdgcn_rcpf(di.y);
                const f32x2 ka = rg * k2;
                f32x2 a; a.x = __builtin_amdgcn_exp2f(ka.x); a.y = __builtin_amdgcn_exp2f(ka.y);
                const f32x2 om = 1.0f - a * a;
                f32x2 sq; sq.x = __builtin_amdgcn_sqrtf(om.x); sq.y = __builtin_amdgcn_sqrtf(om.y);
                const f32x2 bb = sq * ig * uv;
                accA[rb][r] = a.x; accA[rb][r + 1] = a.y; accI[rb][r] = bb.x; accI[rb][r + 1] = bb.y; }
    }
    float rA[8], rH[8];
#pragma unroll
    for (int rb = 0; rb < 8; ++rb) { float pa = 1.f, hh = 0.f;
#pragma unroll
        for (int r = 0; r < 4; ++r) { const float a = accA[rb][r], bb = accI[rb][r]; hh = a * hh + bb; pa *= a; accA[rb][r] = pa; accI[rb][r] = hh; }
        rA[rb] = pa; rH[rb] = hh; }
    float Pc = 1.f, s = 0.f;
#pragma unroll
    for (int rb = 0; rb < 8; ++rb) { float Pin = 1.f, Hin = 0.f;
#pragma unroll
        for (int q = 0; q < 4; ++q) { const float a = __shfl(rA[rb], fr + 16 * q), hh = __shfl(rH[rb], fr + 16 * q);
            if (q == fq) { Pin = Pc; Hin = s; }
            s = a * s + hh; Pc *= a; }
#pragma unroll
        for (int r = 0; r < 4; ++r) { hl[rb][r] = accI[rb][r] + accA[rb][r] * Hin; pp[rb][r] = accA[rb][r] * Pin; }
        __builtin_amdgcn_sched_barrier(0); }
    Atot = Pc; Htot = s;
}
__device__ __forceinline__ u64_t agg_ld(const u64_t* a) { return __hip_atomic_load(a, __ATOMIC_RELAXED, __HIP_MEMORY_SCOPE_AGENT); }
template <int DIR>
__device__ __forceinline__ float lru2_carry(const u64_t* aggc, int n, int fr, int fq) {
    float Ap = 1.f, Hp = 0.f; u64_t v[9];
#pragma unroll
    for (int k = 0; k < 9; ++k) { const int j = fq * 9 + k; const int seq = DIR ? (j == 0 ? 1 : (j == 1 ? 0 : 35 - j)) : j;
        v[k] = (j < n) ? agg_ld(aggc + (size_t)seq * 2048) : 0x000000003f800000ull; }
#pragma unroll
    for (int k = 0; k < 9; ++k) { const float a = __uint_as_float((unsigned)v[k]), hh = __uint_as_float((unsigned)(v[k] >> 32)); Hp = a * Hp + hh; Ap *= a; }
    float s = 0.f;
#pragma unroll
    for (int q = 0; q < 4; ++q) { const float a = __shfl(Ap, fr + 16 * q), hh = __shfl(Hp, fr + 16 * q); s = a * s + hh; }
    return s;
}
__device__ __forceinline__ void lru2_block(const Params& p, LAS unsigned char* lds, int slot, int c, int ngr) {
    const int tid = threadIdx.x, lane = tid & 63, wid = __builtin_amdgcn_readfirstlane(tid >> 6);
    const int sc = c + 2, t0 = c * 128;
    LAS unsigned char* raw = lds;
    LAS unsigned char* ul = lds + 33792;
    LAS unsigned char* gzl = lds + 68608;
    LAS unsigned char* outl = lds + 103424;
    const int fr = lane & 15, fq = lane >> 4, chl = 16 * wid + fr;
    u32x4 nr[5], ng[4];
#define LRU2_LOAD(gg) do { const bf16_t* Zb_ = (const bf16_t*)(p.ws + WS_RZ) + (size_t)((gg) >> 3) * 4096 * 4096 + ((gg) & 7) * 128; \
        _Pragma("unroll") for (int k = 0; k < 5; ++k) { const int pc = tid + NTHR * k; nr[k] = (u32x4){0u, 0u, 0u, 0u}; \
            if (pc < 131 * 16) { const int row = pc >> 4, c8 = pc & 15, tt = t0 - 2 + row; if (tt >= 0 && tt < TT) nr[k] = *(const u32x4*)(Zb_ + (size_t)tt * 4096 + c8 * 8); } } \
        _Pragma("unroll") for (int k = 0; k < 4; ++k) { const int pc = tid + NTHR * k, row = pc >> 4, c8 = pc & 15; ng[k] = *(const u32x4*)(Zb_ + (size_t)(t0 + row) * 4096 + 1024 + c8 * 8); } } while (0)
    LRU2_LOAD(slot);
    for (int g = slot; g < NB * 8; g += ngr) {
        const int b = g >> 3, head = g & 7, ch = head * 128 + chl;
        unsigned* gcnt = (unsigned*)(p.ws + WS_BAR + 16 * KiB) + g * 64;
        bf16x8 bA1[4], bI1[4], bA0[4], bI0[4];
        { const bf16_t* wa = (const bf16_t*)(p.ws + WS_WAT) + ((size_t)(8 + head) * 128 + chl) * 128 + 8 * fq; const bf16_t* wi = (const bf16_t*)(p.ws + WS_WIT) + ((size_t)(8 + head) * 128 + chl) * 128 + 8 * fq;
#pragma unroll
          for (int ks = 0; ks < 4; ++ks) { bA1[ks] = *(const bf16x8*)(wa + 32 * ks); bI1[ks] = *(const bf16x8*)(wi + 32 * ks); } }
#pragma unroll
        for (int k = 0; k < 5; ++k) { const int pc = tid + NTHR * k; if (pc < 131 * 16) *(LAS u32x4*)(raw + (pc >> 4) * 256 + (pc & 15) * 16) = nr[k]; }
#pragma unroll
        for (int k = 0; k < 4; ++k) { const int pc = tid + NTHR * k; *(LAS u32x4*)(gzl + (pc >> 4) * 272 + (pc & 15) * 16) = ng[k]; }
        __syncthreads();
        {
            const int c8 = tid & 15, tb = tid >> 4; const int ch0 = head * 128 + 8 * c8;
            float w[4][8], bias[8];
#pragma unroll
            for (int k = 0; k < 4; ++k) { const f32x4 a = *(const f32x4*)(p.conv_w + k * 1024 + ch0), c2 = *(const f32x4*)(p.conv_w + k * 1024 + ch0 + 4);
#pragma unroll
                for (int j = 0; j < 4; ++j) { w[k][j] = a[j]; w[k][4 + j] = c2[j]; } }
            { const f32x4 a = *(const f32x4*)(p.conv_b + ch0), c2 = *(const f32x4*)(p.conv_b + ch0 + 4);
#pragma unroll
                for (int j = 0; j < 4; ++j) { bias[j] = a[j]; bias[4 + j] = c2[j]; } }
#pragma unroll
            for (int i = 0; i < 4; ++i) { const int t = tb + 32 * i; float a[8];
#pragma unroll
                for (int j = 0; j < 8; ++j) a[j] = bias[j];
#pragma unroll
                for (int k = 0; k < 4; ++k) { float f[8]; unpack8(*(const LAS u32x4*)(raw + (t + k) * 256 + c8 * 16), f);
#pragma unroll
                    for (int j = 0; j < 8; ++j) a[j] += w[k][j] * f[j]; }
                u32x4 wv; wv.x = cvt_pk_bf16(a[0], a[1]); wv.y = cvt_pk_bf16(a[2], a[3]); wv.z = cvt_pk_bf16(a[4], a[5]); wv.w = cvt_pk_bf16(a[6], a[7]);
                *(LAS u32x4*)(ul + t * 272 + c8 * 16) = wv; }
        }
        __syncthreads();
        float A0, H0, A1, H1;
        {
            f32x4 hl1[8], pp1[8];
            lru2_dir<1, LRU_PF_FRAG>(p, ul, head, wid, lane, bA1, bI1, bA0, bI0, hl1, pp1, A1, H1);
            LAS unsigned char* hp = outl + (127 - 4 * fq) * 272 + chl * 2; LAS unsigned char* qp = raw + (127 - 4 * fq) * 256 + chl * 2;
#pragma unroll
            for (int rb = 0; rb < 8; ++rb)
#pragma unroll
                for (int r = 0; r < 4; ++r) { *(LAS bf16_t*)(hp - (16 * rb + r) * 272) = (bf16_t)(cvt_pk_bf16(hl1[rb][r], 0.f) & 0xffffu); *(LAS bf16_t*)(qp - (16 * rb + r) * 256) = (bf16_t)(cvt_pk_bf16(pp1[rb][r], 0.f) & 0xffffu); }
        }
        __builtin_amdgcn_sched_barrier(0);
        if (!LRU_PF_FRAG) { const bf16_t* wa = (const bf16_t*)(p.ws + WS_WAT) + ((size_t)(head) * 128 + chl) * 128 + 8 * fq; const bf16_t* wi = (const bf16_t*)(p.ws + WS_WIT) + ((size_t)(head) * 128 + chl) * 128 + 8 * fq;
#pragma unroll
          for (int ks = 0; ks < 4; ++ks) { bA0[ks] = *(const bf16x8*)(wa + 32 * ks); bI0[ks] = *(const bf16x8*)(wi + 32 * ks); } }
        f32x4 hl0[8], pp0[8];
        lru2_dir<0, false>(p, ul, head, wid, lane, bA0, bI0, bA1, bI1, hl0, pp0, A0, H0);
        u64_t* agg = (u64_t*)(p.ws + WS_AGG);
        const size_t ai0 = ((size_t)(b * NSEQ) * 2 + 0) * 1024 + ch, ai1 = ((size_t)(b * NSEQ) * 2 + 1) * 1024 + ch;
        if (fq == 0) {
            __hip_atomic_store(agg + ai0 + (size_t)sc * 2048, ((u64_t)__float_as_uint(H0) << 32) | __float_as_uint(A0), __ATOMIC_RELAXED, __HIP_MEMORY_SCOPE_AGENT);
            __hip_atomic_store(agg + ai1 + (size_t)sc * 2048, ((u64_t)__float_as_uint(H1) << 32) | __float_as_uint(A1), __ATOMIC_RELAXED, __HIP_MEMORY_SCOPE_AGENT); }
        asm volatile("s_waitcnt vmcnt(0)" ::: "memory");
        __syncthreads();
        if (tid == 0) (void)__hip_atomic_fetch_add(gcnt, 1u, __ATOMIC_RELAXED, __HIP_MEMORY_SCOPE_AGENT);
        if (wid == 0) { unsigned sp = 0;
            while ((unsigned)__builtin_amdgcn_readfirstlane(__hip_atomic_load(gcnt, __ATOMIC_RELAXED, __HIP_MEMORY_SCOPE_AGENT)) < 32u) { __builtin_amdgcn_s_sleep(1); if (++sp > (1u << 22)) break; }
            __builtin_amdgcn_fence(__ATOMIC_ACQUIRE, "agent");
            asm volatile("s_waitcnt vmcnt(0)" ::: "memory"); }
        __syncthreads();
        const float C0 = lru2_carry<0>(agg + ai0, sc, fr, fq);
        const float C1 = lru2_carry<1>(agg + ai1, 2 + (NSEQ - 1 - sc), fr, fq);
        __builtin_amdgcn_sched_barrier(0);
        if (LRU_PF_TILE) { const int gn = (g + ngr < NB * 8) ? g + ngr : g; LRU2_LOAD(gn); }
        __builtin_amdgcn_sched_barrier(0);
        LAS unsigned char* gp = gzl + (4 * fq) * 272 + chl * 2; LAS unsigned char* op = outl + (4 * fq) * 272 + chl * 2; LAS unsigned char* qp0 = raw + (4 * fq) * 256 + chl * 2;
#pragma unroll
        for (int rb = 0; rb < 8; ++rb)
#pragma unroll
            for (int r = 0; r < 4; ++r) { const float h1 = bf2f(*(const LAS bf16_t*)(op + (16 * rb + r) * 272)) + bf2f(*(const LAS bf16_t*)(qp0 + (16 * rb + r) * 256)) * C1;
                const float y = hl0[rb][r] + pp0[rb][r] * C0 + h1;
                const float gz = bf2f(*(const LAS bf16_t*)(gp + (16 * rb + r) * 272));
                *(LAS bf16_t*)(op + (16 * rb + r) * 272) = (bf16_t)(cvt_pk_bf16(gz * y, 0.f) & 0xffffu); }
        __syncthreads();
        bf16_t* Ob = (bf16_t*)(p.ws + WS_R1) + ((size_t)(b * 4096 + t0)) * 1024 + head * 128;
#pragma unroll
        for (int k = 0; k < 4; ++k) { const int pc = tid + NTHR * k, row = pc >> 4, c8 = pc & 15;
            *(u32x4*)(Ob + (size_t)row * 1024 + c8 * 8) = *(const LAS u32x4*)(outl + row * 272 + c8 * 16); }
        __syncthreads();
        if (!LRU_PF_TILE && g + ngr < NB * 8) LRU2_LOAD(g + ngr);
    }
#undef LRU2_LOAD
}

__device__ __forceinline__ void fft_stage2_all(const Params& p, LAS unsigned char* lds) {
    const int tid = tid_opaque(), lane = tid & 63, wid = tid >> 6, fr = lane & 15, fq = lane >> 4;
    const bf16_t* Yt = (const bf16_t*)((const unsigned char*)p.out + OUT_YT); const bf16_t* D2 = (const bf16_t*)(p.ws + WS_D2T);
    bf16_t* Fo = (bf16_t*)((unsigned char*)p.out + OUT_F);
    const int G = gridDim.x;
    int it = blockIdx.x; bf16x8 dfr, yfr[4];
#define S2_LOAD(item) do { const int b_ = (item) & 7, k1_ = (item) >> 3; dfr = *(const bf16x8*)(D2 + (size_t)(k1_ + 256 * fr) * 32 + 8 * fq); \
        _Pragma("unroll") for (int n = 0; n < 4; ++n) yfr[n] = *(const bf16x8*)(Yt + (size_t)(k1_ * 2 + (fq >> 1)) * 65536 + (size_t)b_ * 8192 + (size_t)(16 * (4 * wid + n) + fr) * 16 + 8 * (fq & 1)); } while (0)
    if (it < NB * 256) S2_LOAD(it);
    for (; it < NB * 256; it += G) {
        const int b = it & 7, k1 = it >> 3;
        f32x4 acc[4];
#pragma unroll
        for (int n = 0; n < 4; ++n) acc[n] = __builtin_amdgcn_mfma_f32_16x16x32_bf16(yfr[n], dfr, (f32x4){0.f, 0.f, 0.f, 0.f}, 0, 0, 0);
        const int nx = it + G; if (nx < NB * 256) S2_LOAD(nx);
#pragma unroll
        for (int n = 0; n < 4; ++n) { u32x2 w; w.x = cvt_pk_bf16(acc[n][0], acc[n][1]); w.y = cvt_pk_bf16(acc[n][2], acc[n][3]);
            *(LAS u32x2*)(lds + fr * 1040 + (16 * (4 * wid + n) + 4 * fq) * 2) = w; }
        __syncthreads();
#pragma unroll
        for (int k = 0; k < 2; ++k) { const int pc = tid + NTHR * k, k2 = pc >> 6, c8 = pc & 63;
            *(u32x4*)(Fo + ((size_t)b * 4096 + k1 + 256 * k2) * 512 + c8 * 8) = *(const LAS u32x4*)(lds + k2 * 1040 + c8 * 16); }
        __syncthreads();
    }
#undef S2_LOAD
}

__device__ __forceinline__ void topk_task(const Params& p, LAS unsigned char* lds, int it) {
    const int tid = tid_opaque(), lane = tid & 63, wid = tid >> 6;
    LAS unsigned* cnt = (LAS unsigned*)lds;
    LAS unsigned* wsum = cnt + 64;
    const float* scores = (const float*)(p.ws + WS_SCORES);
    int* idx = (int*)(p.ws + WS_IDX); float* gate = (float*)(p.ws + WS_GATE); int* slot_of = (int*)(p.ws + WS_SLOT);
    const int b = it >> 4, e = it & 15;
    unsigned key[8];
    { const u32x4* sp = (const u32x4*)(scores + (size_t)it * 4096 + tid * 8); const u32x4 a = sp[0], c2 = sp[1]; key[0] = a.x; key[1] = a.y; key[2] = a.z; key[3] = a.w; key[4] = c2.x; key[5] = c2.y; key[6] = c2.z; key[7] = c2.w; }
    unsigned thr = 0;
    for (int step = 0; step < 16; ++step) {
        const int sh = 29 - 2 * step;
        const unsigned c1 = sh >= 0 ? (thr | (1u << sh)) : (thr | 1u), c2 = sh >= 0 ? (thr | (2u << sh)) : 0xffffffffu, c3 = sh >= 0 ? (thr | (3u << sh)) : 0xffffffffu;
        unsigned n1 = 0, n2 = 0, n3 = 0;
#pragma unroll
        for (int j = 0; j < 8; ++j) { n1 += (unsigned)__popcll(__ballot(key[j] >= c1)); n2 += (unsigned)__popcll(__ballot(key[j] >= c2)); n3 += (unsigned)__popcll(__ballot(key[j] >= c3)); }
        LAS unsigned* cb = cnt + (step & 1) * 32;
        if (lane == 0) { cb[wid] = n1; cb[8 + wid] = n2; cb[16 + wid] = n3; }
        __syncthreads();
        unsigned t1 = 0, t2 = 0, t3 = 0;
#pragma unroll
        for (int w = 0; w < 8; ++w) { t1 += cb[w]; t2 += cb[8 + w]; t3 += cb[16 + w]; }
        if (sh >= 0) thr = t3 >= (unsigned)CAP ? c3 : (t2 >= (unsigned)CAP ? c2 : (t1 >= (unsigned)CAP ? c1 : thr));
        else thr = t1 >= (unsigned)CAP ? c1 : thr;
    }
    unsigned cg_ = 0, ce = 0;
#pragma unroll
    for (int j = 0; j < 8; ++j) { cg_ += key[j] > thr; ce += key[j] == thr; }
    unsigned pk = cg_ | (ce << 16), incl = pk;
#pragma unroll
    for (int o = 1; o < 64; o <<= 1) { const unsigned n = __shfl_up(incl, o); if (lane >= o) incl += n; }
    if (lane == 63) wsum[wid] = incl;
    __syncthreads();
    unsigned base = 0, total = 0;
#pragma unroll
    for (int w = 0; w < 8; ++w) { const unsigned s2 = wsum[w]; if (w < wid) base += s2; total += s2; }
    const unsigned excl = base + incl - pk; unsigned og = excl & 0xffffu, oe = excl >> 16; const unsigned ngt = total & 0xffffu, krem = (unsigned)CAP - ngt;
#pragma unroll
    for (int j = 0; j < 8; ++j) { const int t = tid * 8 + j; int m = -1;
        if (key[j] > thr) { m = (e * 8 + b) * 512 + (int)og; ++og; }
        else if (key[j] == thr) { if (oe < krem) m = (e * 8 + b) * 512 + (int)(ngt + oe); ++oe; }
        slot_of[((size_t)b * 4096 + t) * 16 + e] = m;
        if (m >= 0) { idx[m] = b * 4096 + t; gate[m] = __uint_as_float(key[j]); } }
    __syncthreads();
}

__device__ __forceinline__ void phase7_rows(const Params& p, LAS unsigned char* lds) {
    const int tid = threadIdx.x, lane = tid & 63, wid = tid >> 6;
    LAS float* wrt = (LAS float*)lds;
    for (int i = tid; i < 16 * 1024; i += NTHR) { const int d = i >> 4, e = i & 15; wrt[e * 1024 + d] = p.w_router[i]; }
    __syncthreads();
    const float* ada = (const float*)(p.ws + WS_ADA); bf16_t* h2 = (bf16_t*)(p.ws + WS_R1); float* scores = (float*)(p.ws + WS_SCORES);
    for (int row0 = (blockIdx.x * 8 + wid) * 2; row0 < MLAT; row0 += gridDim.x * 16) {
        const int b = row0 >> 12;
        f32x4 v[2][4]; float ss[2];
#pragma unroll
        for (int r = 0; r < 2; ++r)
#pragma unroll
            for (int i = 0; i < 4; ++i) v[r][i] = *(const f32x4*)(p.out + (size_t)(row0 + r) * 1024 + 256 * i + 4 * lane);
#pragma unroll
        for (int r = 0; r < 2; ++r) { float a = 0.f;
#pragma unroll
            for (int i = 0; i < 4; ++i) a += v[r][i][0] * v[r][i][0] + v[r][i][1] * v[r][i][1] + v[r][i][2] * v[r][i][2] + v[r][i][3] * v[r][i][3];
            ss[r] = a; }
#pragma unroll
        for (int o = 32; o >= 1; o >>= 1) { ss[0] += __shfl_xor(ss[0], o); ss[1] += __shfl_xor(ss[1], o); }
#pragma unroll
        for (int i = 0; i < 4; ++i) { const int d = 256 * i + 4 * lane;
            const f32x4 g = *(const f32x4*)(p.norm2_g + d), sh = *(const f32x4*)(ada + b * 6144 + 3072 + d), sc = *(const f32x4*)(ada + b * 6144 + 4096 + d);
#pragma unroll
            for (int r = 0; r < 2; ++r) { const float rs = rsqrtf(ss[r] * (1.0f / 1024.0f) + 1e-6f);
                v[r][i] = v[r][i] * rs * g * (sc + 1.0f) + sh;
                u32x2 w; w.x = cvt_pk_bf16(v[r][i][0], v[r][i][1]); w.y = cvt_pk_bf16(v[r][i][2], v[r][i][3]); *(u32x2*)(h2 + (size_t)(row0 + r) * 1024 + d) = w; } }
        float q[32];
#pragma unroll
        for (int e = 0; e < 16; ++e) { float a0 = 0.f, a1 = 0.f;
#pragma unroll
            for (int i = 0; i < 4; ++i) { const f32x4 w = *(const LAS f32x4*)(wrt + e * 1024 + 256 * i + 4 * lane);
                a0 += v[0][i][0] * w[0] + v[0][i][1] * w[1] + v[0][i][2] * w[2] + v[0][i][3] * w[3];
                a1 += v[1][i][0] * w[0] + v[1][i][1] * w[1] + v[1][i][2] * w[2] + v[1][i][3] * w[3]; }
            q[e] = a0; q[16 + e] = a1; }
#pragma unroll
        for (int j = 0; j < 16; ++j) { const bool up = (lane & 32) != 0; const float send = up ? q[j] : q[16 + j], keep = up ? q[16 + j] : q[j]; q[j] = keep + __shfl_xor(send, 32); }
#pragma unroll
        for (int j = 0; j < 8; ++j) { const bool up = (lane & 16) != 0; const float send = up ? q[j] : q[8 + j], keep = up ? q[8 + j] : q[j]; q[j] = keep + __shfl_xor(send, 16); }
#pragma unroll
        for (int j = 0; j < 4; ++j) { const bool up = (lane & 8) != 0; const float send = up ? q[j] : q[4 + j], keep = up ? q[4 + j] : q[j]; q[j] = keep + __shfl_xor(send, 8); }
#pragma unroll
        for (int j = 0; j < 2; ++j) { const bool up = (lane & 4) != 0; const float send = up ? q[j] : q[2 + j], keep = up ? q[2 + j] : q[j]; q[j] = keep + __shfl_xor(send, 4); }
        { const bool up = (lane & 2) != 0; const float send = up ? q[0] : q[1], keep = up ? q[1] : q[0]; q[0] = keep + __shfl_xor(send, 2); }
        float lg = q[0] + __shfl_xor(q[0], 1);
        float mx = lg;
#pragma unroll
        for (int o = 2; o <= 16; o <<= 1) mx = fmaxf(mx, __shfl_xor(mx, o));
        const float ex = expf(lg - mx); float sum = ex;
#pragma unroll
        for (int o = 2; o <= 16; o <<= 1) sum += __shfl_xor(sum, o);
        if ((lane & 1) == 0) __hip_atomic_store(scores + ((size_t)b * 16 + ((lane >> 1) & 15)) * 4096 + ((row0 + (lane >> 5)) & 4095), ex / sum, __ATOMIC_RELAXED, __HIP_MEMORY_SCOPE_AGENT);
        if (gridDim.x == 256) {
            asm volatile("s_waitcnt vmcnt(0)" ::: "memory");
            __syncthreads();
            if (tid == 0) (void)__hip_atomic_fetch_add((unsigned*)(p.ws + WS_BAR + 44 * KiB) + b * 64, 1u, __ATOMIC_RELAXED, __HIP_MEMORY_SCOPE_AGENT);
        }
    }
    __syncthreads();
}
__device__ __forceinline__ void phase7_topk(const Params& p, LAS unsigned char* lds) {
    const int bid = blockIdx.x; if (bid >= NB * NE) return;
    unsigned* c = (unsigned*)(p.ws + WS_BAR + 44 * KiB) + (bid >> 4) * 64;
    if (threadIdx.x < 64) { unsigned sp = 0;
        while ((unsigned)__builtin_amdgcn_readfirstlane(__hip_atomic_load(c, __ATOMIC_RELAXED, __HIP_MEMORY_SCOPE_AGENT)) < 256u) { __builtin_amdgcn_s_sleep(1); if (++sp > (1u << 22)) break; }
        __builtin_amdgcn_fence(__ATOMIC_ACQUIRE, "agent");
        asm volatile("s_waitcnt vmcnt(0)" ::: "memory"); }
    __syncthreads();
    topk_task(p, lds, bid);
}
__device__ __forceinline__ void phase7_weights(const Params& p) {
    constexpr int N_G = 16 * 16 * 6, N_D = 16 * 24 * 4;
    const bool fused = gridDim.x == 256;
    for (int j = 0; ; ++j) {
        int it;
        if (!fused) it = blockIdx.x + j * gridDim.x;
        else if (blockIdx.x >= 128) it = j < 4 ? (blockIdx.x - 128) + 128 * j : 512 + blockIdx.x + (j - 4) * 256;
        else it = 512 + blockIdx.x + j * 256;
        if (it >= 2 * N_G + N_D) break;
        if (it < 2 * N_G) { const int up = it >= N_G, j = up ? it - N_G : it, e = j / 96, r = j % 96, kb = r / 6, nb = r % 6;
            xpose_item<4>((up ? p.w_up_e : p.w_gate_e) + (size_t)e * 1024 * 1536, 1536, (bf16_t*)(p.ws + WS_WGU) + (size_t)e * 3072 * 1024, 1024, kb * 64, nb * 256, up ? 2 : 1); }
        else { const int j = it - 2 * N_G, e = j / 96, r = j % 96, kb = r >> 2, nb = r & 3;
            xpose_item<4>(p.w_down_e + (size_t)e * 1536 * 1024, 1024, (bf16_t*)(p.ws + WS_WD) + (size_t)e * 1024 * 1536, 1536, kb * 64, nb * 256, 0); }
    }
}

__device__ __forceinline__ void phase11(const Params& p, float* dst) {
    const int tid = tid_opaque(), lane = tid & 63, wid = tid >> 6;
    const float* ada = (const float*)(p.ws + WS_ADA); const int* slot_of = (const int*)(p.ws + WS_SLOT); const bf16_t* oute = (const bf16_t*)(p.ws + WS_OUTE);
    const int stride = gridDim.x * 16;
    int row0 = (blockIdx.x * 8 + wid) * 2;
    int myslot = row0 < MLAT ? slot_of[(size_t)row0 * 16 + (lane & 31)] : -1;
    for (; row0 < MLAT; row0 += stride) {
        const int b = row0 >> 12;
        const int nrow = row0 + stride; const int nslot = nrow < MLAT ? slot_of[(size_t)nrow * 16 + (lane & 31)] : -1;
        f32x4 xv[2][4], acc[2][4];
#pragma unroll
        for (int r = 0; r < 2; ++r)
#pragma unroll
            for (int i = 0; i < 4; ++i) { xv[r][i] = *(const f32x4*)(p.out + (size_t)(row0 + r) * 1024 + 256 * i + 4 * lane); acc[r][i] = (f32x4){0.f, 0.f, 0.f, 0.f}; }
        const unsigned long long bal = __ballot(myslot >= 0);
        unsigned mask0 = (unsigned)(bal & 0xffffull), mask1 = (unsigned)((bal >> 16) & 0xffffull);
        while (mask0 | mask1) {
            int m[2][2];
#pragma unroll
            for (int j = 0; j < 2; ++j) { if (mask0) { const int e = __builtin_ctz(mask0); mask0 &= mask0 - 1; m[0][j] = __builtin_amdgcn_readlane(myslot, e); } else m[0][j] = MMOE;
                                          if (mask1) { const int e = __builtin_ctz(mask1); mask1 &= mask1 - 1; m[1][j] = __builtin_amdgcn_readlane(myslot, 16 + e); } else m[1][j] = MMOE; }
            u32x2 w[2][2][4];
#pragma unroll
            for (int r = 0; r < 2; ++r)
#pragma unroll
                for (int j = 0; j < 2; ++j)
#pragma unroll
                    for (int i = 0; i < 4; ++i) w[r][j][i] = *(const u32x2*)(oute + (size_t)m[r][j] * 1024 + 256 * i + 4 * lane);
#pragma unroll
            for (int r = 0; r < 2; ++r)
#pragma unroll
                for (int j = 0; j < 2; ++j)
#pragma unroll
                    for (int i = 0; i < 4; ++i) { acc[r][i][0] += bf_lo(w[r][j][i].x); acc[r][i][1] += bf_hi(w[r][j][i].x); acc[r][i][2] += bf_lo(w[r][j][i].y); acc[r][i][3] += bf_hi(w[r][j][i].y); }
        }
        float ss[2];
#pragma unroll
        for (int r = 0; r < 2; ++r) { float a = 0.f;
#pragma unroll
            for (int i = 0; i < 4; ++i) { const int d = 256 * i + 4 * lane; const f32x4 g2 = *(const f32x4*)(ada + b * 6144 + 5120 + d); xv[r][i] += g2 * acc[r][i];
                a += xv[r][i][0] * xv[r][i][0] + xv[r][i][1] * xv[r][i][1] + xv[r][i][2] * xv[r][i][2] + xv[r][i][3] * xv[r][i][3]; }
            ss[r] = a; }
#pragma unroll
        for (int o = 32; o >= 1; o >>= 1) { ss[0] += __shfl_xor(ss[0], o); ss[1] += __shfl_xor(ss[1], o); }
#pragma unroll
        for (int r = 0; r < 2; ++r) { const float rs = rsqrtf(ss[r] * (1.0f / 1024.0f) + 1e-6f);
#pragma unroll
            for (int i = 0; i < 4; ++i) { const int d = 256 * i + 4 * lane; *(f32x4*)(dst + (size_t)(row0 + r) * 1024 + d) = xv[r][i] * rs * *(const f32x4*)(p.final_g + d); } }
        myslot = nslot;
    }
}

#define XB_TMO      128
#define XB_XCNT(j)  (256  + 64 * (j))
#define XB_XSUB(j)  (1280 + 64 * (j))
#define XB_XGEN(j)  (2304 + 64 * (j))
#define XB_TOP      3328
#define XB_TOPGEN   3392
#define XCD_BAR_WORDS 3456
#define XB_SPIN_CAP (1u << 22)
__device__ __forceinline__ unsigned xb_ld(unsigned* p)              { return __hip_atomic_load(p, __ATOMIC_RELAXED, __HIP_MEMORY_SCOPE_AGENT); }
__device__ __forceinline__ unsigned xb_add(unsigned* p, unsigned v) { return __hip_atomic_fetch_add(p, v, __ATOMIC_RELAXED, __HIP_MEMORY_SCOPE_AGENT); }
__device__ __forceinline__ unsigned xb_xcc_id() { return (unsigned)__builtin_amdgcn_s_getreg((3 << 11) | 20) & 0xFu; }
#define XB_SPIN(cond, bar) do { unsigned _sp = 0; while (cond) { __builtin_amdgcn_s_sleep(1); \
    if ((++_sp & 255u) == 0u) { if (xb_ld(&(bar)[XB_TMO])) break; if (_sp > XB_SPIN_CAP) { atomicAdd(&(bar)[XB_TMO], 1u); break; } } } } while (0)
struct XcdBarrier { unsigned* bar; unsigned x; volatile LAS unsigned* st; };
__device__ __forceinline__ XcdBarrier xcd_barrier_post(unsigned* bar, volatile LAS unsigned* st) {
    XcdBarrier b; b.bar = bar; b.x = xb_xcc_id(); b.st = st;
    if (threadIdx.x == 0) (void)xb_add(&bar[XB_XCNT(b.x)], 1u);
    return b;
}
__device__ __forceinline__ void xcd_barrier_complete(unsigned* bar, unsigned x, unsigned& nloc, unsigned& nx) {
    const unsigned G = gridDim.x * gridDim.y * gridDim.z;
    unsigned sum, cnt, mine, sp = 0u;
    for (;;) {
        sum = 0u; cnt = 0u; mine = 0u;
#pragma unroll
        for (unsigned j = 0; j < 16; ++j) { const unsigned c = xb_ld(&bar[XB_XCNT(j)]); sum += c; cnt += (c > 0u) ? 1u : 0u; mine = (j == x) ? c : mine; }
        if (sum == G) break;
        __builtin_amdgcn_s_sleep(1);
        if ((++sp & 255u) == 0u) { if (xb_ld(&bar[XB_TMO])) break; if (sp > XB_SPIN_CAP) { atomicAdd(&bar[XB_TMO], 1u); break; } }
    }
    nloc = mine > 0u ? mine : 1u; nx = cnt > 0u ? cnt : 1u;
}
__device__ __forceinline__ void xcd_barrier(const XcdBarrier& b) {
    asm volatile("s_waitcnt vmcnt(0)" ::: "memory");
    __syncthreads();
    if (threadIdx.x == 0) {
        unsigned* bar = b.bar;
        __builtin_amdgcn_s_waitcnt(0);
        unsigned nloc = b.st[0], nx = b.st[1];
        if (nloc == 0u) { xcd_barrier_complete(bar, b.x, nloc, nx); b.st[0] = nloc; b.st[1] = nx; }
        const unsigned old = xb_add(&bar[XB_XSUB(b.x)], 1u);
        const unsigned gen = old / nloc;
        if (old + 1u == (gen + 1u) * nloc) {
            __builtin_amdgcn_fence(__ATOMIC_RELEASE, "agent");
            asm volatile("s_waitcnt vmcnt(0)" ::: "memory");
            const unsigned og = xb_add(&bar[XB_TOP], 1u);
            const unsigned tg = og / nx;
            if (og + 1u == (tg + 1u) * nx) xb_add(&bar[XB_TOPGEN], 1u);
            else XB_SPIN(xb_ld(&bar[XB_TOPGEN]) == tg, bar);
            __builtin_amdgcn_fence(__ATOMIC_ACQUIRE, "agent");
            xb_add(&bar[XB_XGEN(b.x)], 1u);
            asm volatile("s_waitcnt vmcnt(0)" ::: "memory");
        } else {
            XB_SPIN(xb_ld(&bar[XB_XGEN(b.x)]) == gen, bar);
            __builtin_amdgcn_fence(__ATOMIC_ACQUIRE, "agent");
            asm volatile("s_waitcnt vmcnt(0)" ::: "memory");
        }
    }
    __syncthreads();
}

__global__ void __launch_bounds__(NTHR, 2) fwd_megakernel(Params p) {
    extern __shared__ __attribute__((aligned(16))) unsigned char lds_raw[];
    LAS unsigned char* lds = (LAS unsigned char*)lds_raw;
    cg::grid_group grid = cg::this_grid();
    const int G = gridDim.x, bid = blockIdx.x;
    unsigned char* ws = p.ws;
    bf16_t* const R1 = (bf16_t*)(ws + WS_R1); bf16_t* const Zb = (bf16_t*)(ws + WS_RZ); bf16_t* const PQt = (bf16_t*)(ws + WS_RPQ); bf16_t* const MRG = (bf16_t*)(ws + WS_R2);
    bf16_t* const Fb = (bf16_t*)((unsigned char*)p.out + OUT_F); bf16_t* const Ytb = (bf16_t*)((unsigned char*)p.out + OUT_YT);
#ifdef ONLY_PH
#define PH(k) ((k) == ONLY_PH && p.ph_lo <= (k) && (k) < p.ph_hi)
#else
#define PH(k) (p.ph_lo <= (k) && (k) < p.ph_hi)
#endif
    volatile LAS unsigned* xst = (volatile LAS unsigned*)(lds + LDS_BYTES - 16);
    if (threadIdx.x < 4) xst[threadIdx.x] = 0u;
    __syncthreads();
    XcdBarrier xbar = xcd_barrier_post((unsigned*)(ws + WS_BAR), xst);
    if (p.ph_lo < 0) grid.sync();
#ifdef TS_A
    unsigned long long* tsb = (unsigned long long*)(ws + WS_BAR + 40 * KiB);
#define STAMP(i) do { if (bid == 0 && threadIdx.x == 0) tsb[i] = __builtin_amdgcn_s_memrealtime(); } while (0)
#else
#define STAMP(i) do { } while (0)
#endif
    STAMP(0);
#define SYNC(k) do { if (PH(k) && PH((k) + 1)) xcd_barrier(xbar); STAMP((k) + 1); } while (0)
#ifndef REPMASK
#define REPMASK 0
#endif
#define REP(k) for (int rep_ = 0; rep_ <= ((REPMASK >> (k)) & 1); ++rep_)
    if (PH(0)) REP(0) phase0(p, lds);
    SYNC(0);
    if (PH(1)) REP(1) phase1(p);
    SYNC(1);
    if (PH(2)) REP(2) {
        { ProbPQ pr{(const bf16_t*)(ws + WS_WPQ), R1, 1024, 1024, 16384}; pg8::Order S; S.init(4, 128, G, bid); EpiPQ E{PQt}; pg8::gemm_phase(lds, pr, S, E); }
        { ProbPlain pr{R1, (const bf16_t*)(ws + WS_WIN), 1024, 1024, 1024}; pg8::Order S; S.init(128, 16, G, bid); EpiZ E{Zb, 4096, -1}; pg8::gemm_phase(lds, pr, S, E); }
        { ProbPlain pr{(const bf16_t*)(ws + WS_HCTX), (const bf16_t*)(ws + WS_WIN), 1024, 1024, 1024}; pg8::Order S; S.init(8, 4, G, bid); EpiZ E{(bf16_t*)(ws + WS_ZXC), 1024, 0}; pg8::gemm_phase(lds, pr, S, E); }
    }
    SYNC(2);
    if (PH(3)) REP(3) {
        {
            ProbPlain pr{(const bf16_t*)(ws + WS_D1T), PQt, 512, 512, 512}; pg8::Order S; S.init(2, 256, G, bid);
            if (G == 256) { if (bid >= 128) { S.G = 128; S.c = bid - 128; S.base = 0; S.lim = 3; } else { S.G = 128; S.c = bid; S.base = 384; S.lim = 1; } }
            EpiPlain E{Ytb, 65536}; pg8::gemm_phase(lds, pr, S, E); }
        for (int it = bid; it < NB * 2 * 8; it += G) lru_tile<false>(p, lds, it);
    }
    SYNC(3);
    if (PH(4)) {
        fft_stage2_all(p, lds);
        const int ngr = G >> 5;
        if (ngr > 0 && bid < ngr * 32) lru2_block(p, lds, bid % ngr, bid / ngr, ngr);
    }
    SYNC(4);
    if (PH(5)) REP(5) {
        { ProbMerge pr{Fb, (const bf16_t*)(ws + WS_WFOUR), R1, (const bf16_t*)(ws + WS_WLRU), 512, 1024, 512, 512, 1024, 1024}; pg8::Order S; S.init(128, 4, G, bid); EpiMerge E{MRG, Zb}; pg8::gemm_phase2(lds, pr, S, E); }
    }
    SYNC(5);
    if (PH(6)) REP(6) { ProbPlain pr{MRG, (const bf16_t*)(ws + WS_WOUT), 1024, 1024, 1024}; pg8::Order S; S.init(128, 4, G, bid);
        EpiOut E{p.out, p.x, (const float*)(ws + WS_POS), (const float*)(ws + WS_ADA)}; pg8::gemm_phase(lds, pr, S, E); }
    SYNC(6);
    if (PH(7)) { phase7_rows(p, lds); if (G == 256) phase7_topk(p, lds); phase7_weights(p); }
    SYNC(7);
    if (PH(8) && G != 256) { for (int it = bid; it < NB * NE; it += G) topk_task(p, lds, it); }
    if (G != 256) SYNC(8);
    if (PH(9)) REP(9) { ProbMoeUp pr{R1, (const bf16_t*)(ws + WS_WGU), (const int*)(ws + WS_IDX), 1024, 1024, 1024}; pg8::Order S; S.init(256, 12, G, bid); EpiGU E{(bf16_t*)(ws + WS_HID)}; pg8::gemm_phase(lds, pr, S, E); }
    SYNC(9);
    if (PH(10)) { if (bid == 0 && threadIdx.x < 128) *(u32x4*)(ws + WS_OUTE + (size_t)MMOE * 2048 + threadIdx.x * 16) = (u32x4){0u, 0u, 0u, 0u}; }
    if (PH(10)) REP(10) { ProbMoeDown pr{(const bf16_t*)(ws + WS_HID), (const bf16_t*)(ws + WS_WD), 1536, 1536, 1536}; pg8::Order S; S.init(256, 4, G, bid); EpiDown E{(bf16_t*)(ws + WS_OUTE), (const float*)(ws + WS_GATE)}; pg8::gemm_phase(lds, pr, S, E); }
    SYNC(10);
    if (PH(11)) phase11(p, p.out);
#ifdef TS_A
    xcd_barrier(xbar); STAMP(12);
    if (bid == 0 && threadIdx.x == 0) {

#ifndef TS_AE
#define TS_AE (TS_A + 1)
#endif
#ifndef TS_BE
#define TS_BE (TS_B + 1)
#endif
        const float ta = (float)(tsb[TS_AE] - tsb[TS_A]) * 0.01f * (float)(TS_SA), tb = (float)(tsb[TS_BE] - tsb[TS_B]) * 0.01f * (float)(TS_SB);
        p.out[7] = fminf(ta, 97.f); p.out[1024 * 5 + 9] = fminf(tb, 97.f); }
#endif
}

#ifndef N_LAUNCHES
#define N_LAUNCHES 1
#endif
#ifndef PROBE_DUP
#define PROBE_DUP 0x0
#endif
extern "C" void kernel_launch(void* const* d_in, const int* in_sizes, int n_in, void* d_out, int out_size, void* d_ws, size_t ws_size, hipStream_t stream) {
    static int grid = 0;
    if (grid == 0) {
        if (n_in != 24 || out_size != MLAT * DM || ws_size < WS_END) { fprintf(stderr, "kernel_launch: unexpected shapes (n_in %d out %d ws %zu)\n", n_in, out_size, ws_size); grid = -1; return; }
        int dev = 0, cus = 0, per_cu = 0;
        hipGetDevice(&dev); hipDeviceGetAttribute(&cus, hipDeviceAttributeMultiprocessorCount, dev);
        hipFuncSetAttribute((const void*)fwd_megakernel, hipFuncAttributeMaxDynamicSharedMemorySize, LDS_BYTES);
        hipOccupancyMaxActiveBlocksPerMultiprocessor(&per_cu, (const void*)fwd_megakernel, NTHR, LDS_BYTES);
        if (per_cu < 1) { fprintf(stderr, "kernel_launch: occupancy query reports %d blocks per CU\n", per_cu); per_cu = 1; }
        grid = cus * 1;
        (void)hipGetLastError();
    }
    if (grid < 0) return;
    Params p{};
    const float** f = (const float**)&p;
    for (int i = 0; i < 24; ++i) f[i] = (const float*)d_in[i];
    p.out = (float*)d_out; p.ws = (unsigned char*)d_ws;
    (void)hipMemsetAsync((unsigned char*)d_ws + WS_BAR, 0, 48 * KiB, stream);
#if N_LAUNCHES == 1
    p.ph_lo = 0; p.ph_hi = 12;
    void* args[] = {&p};
    hipError_t e = hipLaunchCooperativeKernel((const void*)fwd_megakernel, dim3(grid), dim3(NTHR), args, LDS_BYTES, stream);
    if (e != hipSuccess) fprintf(stderr, "cooperative launch failed: %s (grid %d)\n", hipGetErrorString(e), grid);
#else
    for (int k = 0; k < 12; ++k) for (int r = 0; r <= ((PROBE_DUP >> k) & 1); ++r) { p.ph_lo = k; p.ph_hi = k + 1; if (k == 11 && r == 0 && ((PROBE_DUP >> 11) & 1)) { p.ph_lo = 12; p.ph_hi = 13; } hipLaunchKernelGGL(fwd_megakernel, dim3(grid), dim3(NTHR), LDS_BYTES, stream, p); }
#endif
}
```

```cpp
#include <hip/hip_runtime.h>
#include <hip/hip_cooperative_groups.h>
#include <cstdio>
namespace cg = cooperative_groups;

#define LAS __attribute__((address_space(3)))
typedef unsigned short bf16_t;
typedef short bf16x8 __attribute__((ext_vector_type(8)));
typedef float f32x4 __attribute__((ext_vector_type(4)));
typedef float f32x16 __attribute__((ext_vector_type(16)));
typedef unsigned u32x4 __attribute__((ext_vector_type(4)));
typedef unsigned u32x2 __attribute__((ext_vector_type(2)));

constexpr int NB = 8, TT = 4096, DM = 1024, CTXL = 256, MLAT = NB * TT, MCTX = NB * CTXL;
constexpr int NE = 16, CAP = 512, DE = 1536, MMOE = NE * NB * CAP;
constexpr int NSEQ = 34;
constexpr int NTHR = 512;
constexpr float NLOG2E = -1.4426950408889634f;
constexpr int LDS_BYTES = 144 * 1024;

constexpr size_t KiB = 1024, MiB = 1024 * 1024;
constexpr size_t WS_ADA = 0;
constexpr size_t WS_POS = 256 * KiB;
constexpr size_t WS_AGG = 512 * KiB;
constexpr size_t WS_WPQ = 5 * MiB;
constexpr size_t WS_WIN = 7 * MiB;
constexpr size_t WS_WFOUR = 15 * MiB;
constexpr size_t WS_WLRU = 16 * MiB;
constexpr size_t WS_WOUT = 18 * MiB;
constexpr size_t WS_WAT = 20 * MiB;
constexpr size_t WS_WIT = 20 * MiB + 512 * KiB;
constexpr size_t WS_SCORES = 21 * MiB;
constexpr size_t WS_IDX = 23 * MiB;
constexpr size_t WS_GATE = 23 * MiB + 256 * KiB;
constexpr size_t WS_SLOT = 23 * MiB + 512 * KiB;
constexpr size_t WS_BAR = 25 * MiB + 512 * KiB;
constexpr size_t WS_D1T = 34 * MiB;
constexpr size_t WS_D2T = 34 * MiB + 512 * KiB;
constexpr size_t WS_HCTX = 26 * MiB;
constexpr size_t WS_ZXC = 30 * MiB;
constexpr size_t WS_R1 = 40 * MiB;
constexpr size_t WS_RPQ = 104 * MiB;
constexpr size_t WS_R2 = 168 * MiB;
constexpr size_t WS_RZ = 232 * MiB;
constexpr size_t WS_END = 488 * MiB;
constexpr size_t WS_HID = WS_RZ, WS_WD = WS_RZ + 192 * MiB, WS_WGU = WS_RPQ, WS_OUTE = WS_R1;
constexpr size_t OUT_YT = 0, OUT_F = 64 * MiB;

struct Params {
    const float *x, *c, *ctx, *c_ctx, *w_ada, *b_ada, *norm1_g, *norm2_g, *w_in, *w_four, *conv_w, *conv_b, *lru_lambda,
        *lru_wa, *lru_ba, *lru_wi, *lru_bi, *w_lru, *w_out, *w_router, *w_gate_e, *w_up_e, *w_down_e, *final_g;
    float* out; unsigned char* ws; int ph_lo, ph_hi;
};

__device__ __forceinline__ int tid_opaque() { int t = threadIdx.x; asm volatile("" : "+v"(t)); return t; }
__device__ __forceinline__ unsigned cvt_pk_bf16(float lo, float hi) { unsigned r; asm volatile("v_cvt_pk_bf16_f32 %0, %1, %2" : "=v"(r) : "v"(lo), "v"(hi)); return r; }
__device__ __forceinline__ float bf_lo(unsigned w) { return __uint_as_float(w << 16); }
__device__ __forceinline__ float bf_hi(unsigned w) { return __uint_as_float(w & 0xffff0000u); }
__device__ __forceinline__ float bf2f(bf16_t h) { return __uint_as_float(((unsigned)h) << 16); }
__device__ __forceinline__ float sigmoidf_(float v) { return __builtin_amdgcn_rcpf(1.0f + __expf(-v)); }
__device__ __forceinline__ float gelu_tanh(float v) { const float y = 1.5957691216f * (v + 0.044715f * v * v * v); return v * sigmoidf_(y); }
__device__ __forceinline__ float wave_sum(float v) {
#pragma unroll
    for (int o = 32; o >= 1; o >>= 1) v += __shfl_xor(v, o);
    return v;
}
__device__ __forceinline__ void unpack8(const u32x4 w, float (&f)[8]) { f[0] = bf_lo(w.x); f[1] = bf_hi(w.x); f[2] = bf_lo(w.y); f[3] = bf_hi(w.y); f[4] = bf_lo(w.z); f[5] = bf_hi(w.z); f[6] = bf_lo(w.w); f[7] = bf_hi(w.w); }

namespace pg8 {
constexpr int BM = 256, BK = 64, HALF = 128, HTB = HALF * BK * 2, STAGE_BYTES = 8 * HTB, NXCD = 8, WGM = 8;
__device__ __forceinline__ int lds_byte(int r, int c) { const int st = (r >> 4) * 2 + (c >> 5), rr = r & 15, cc = c & 31, ob = rr * 64 + cc * 2; return st * 1024 + (ob ^ (((ob >> 9) & 1) << 5)); }
__device__ __forceinline__ void stage_rc(int b, int& R, int& C) { const int st = b / 1024, sb = b % 1024, swz = sb ^ (((sb >> 9) & 1) << 5); R = (st >> 1) * 16 + swz / 64; C = (st & 1) * 32 + (swz % 64) / 2; }
__device__ __forceinline__ int perm32(int rho) { const int n = rho >> 4, i = rho & 15; return 8 * (i >> 2) + 4 * n + (i & 3); }
struct Unit { int pm, pn; };
struct Order {
    int nM, nN, nwg, G, c, base, lim;
    __device__ void init(int nM_, int nN_, int G_, int c_) { nM = nM_; nN = nN_; nwg = nM * nN; G = G_; c = c_; base = 0; lim = 0x7fffffff; }
    __device__ bool next(int i, Unit& u) const {
        const long L = (long)base + (long)i * G + c; if (i >= lim || L >= nwg) return false;
        int wgid = (int)L; { const int q = nwg / NXCD, r = nwg % NXCD, xcd = wgid % NXCD, off = wgid / NXCD; wgid = (xcd < r ? xcd * (q + 1) : r * (q + 1) + (xcd - r) * q) + off; }
        const int nig = WGM * nN, gid = wgid / nig, fm = gid * WGM, gsz = (nM - fm) < WGM ? (nM - fm) : WGM;
        u.pm = fm + ((wgid % nig) % gsz); u.pn = (wgid % nig) / gsz; return true;
    }
};
template <class P, class Epi>
__device__ __forceinline__ void gemm_phase(LAS unsigned char* lds, const P& pr, const Order& S, const Epi& E) {
    const int tid = threadIdx.x, wid = __builtin_amdgcn_readfirstlane(tid >> 6), lane = tid & 63, wr = wid >> 2, wc = wid & 3, fr = lane & 15, fq = lane >> 4;
    const int nt = pr.K / BK;
    int RA[2], CA[2]; unsigned voffB[2];
#pragma unroll
    for (int i = 0; i < 2; ++i) { int R, C; stage_rc(tid * 16 + i * 8192, R, C); RA[i] = R; CA[i] = C; const int Rb = Epi::PERM ? ((R & ~31) + perm32(R & 31)) : R; voffB[i] = (unsigned)(Rb * pr.ldb + C) * 2u; }
    const size_t kstep = (size_t)(BK * 2);
    const size_t hstepB = (size_t)HALF * pr.ldb * 2;
    const unsigned ldsw = (unsigned)wid * 1024u;
    const int aoff = lds_byte(wr * 64 + fr, fq * 8), boff = lds_byte(wc * 32 + fr, fq * 8);
#define PG8_SA(b, h) (((b) * 2 + (h)) * HTB)
#define PG8_SB(b, h) ((4 + (b) * 2 + (h)) * HTB)
#define PG8_STAGE(bufoff, gbase, voff) do { _Pragma("unroll") for (int _i = 0; _i < 2; ++_i) \
        __builtin_amdgcn_global_load_lds((const unsigned*)((const char*)(gbase) + (voff)[_i]), (LAS unsigned*)(lds + (bufoff) + ldsw + _i * 8192), 16, 0, 0); } while (0)
#define PG8_LDA(dst, b, h) do { _Pragma("unroll") for (int m = 0; m < 4; ++m) _Pragma("unroll") for (int k = 0; k < 2; ++k) dst[m][k] = *(const LAS bf16x8*)(lds + PG8_SA(b, h) + aoff + m * 2048 + k * 1024); } while (0)
#define PG8_LDB(dst, b, h) do { _Pragma("unroll") for (int n = 0; n < 2; ++n) _Pragma("unroll") for (int k = 0; k < 2; ++k) dst[n][k] = *(const LAS bf16x8*)(lds + PG8_SB(b, h) + boff + n * 2048 + k * 1024); } while (0)
#define PG8_MMA(ai, bj, At, Bt) do { __builtin_amdgcn_s_setprio(1); _Pragma("unroll") for (int m = 0; m < 4; ++m) _Pragma("unroll") for (int n = 0; n < 2; ++n) _Pragma("unroll") for (int k = 0; k < 2; ++k) \
        acc[ai][bj][m][n] = __builtin_amdgcn_mfma_f32_16x16x32_bf16(Bt[n][k], At[m][k], acc[ai][bj][m][n], 0, 0, 0); __builtin_amdgcn_s_setprio(0); } while (0)
#define PG8_WAIT_V(n) asm volatile("s_waitcnt vmcnt(" #n ")" ::: "memory")
#define PG8_WAIT_L(n) asm volatile("s_waitcnt lgkmcnt(" #n ")" ::: "memory")
#define PG8_BAR __builtin_amdgcn_s_barrier()
#define PG8_SCHED __builtin_amdgcn_sched_barrier(0)
    Unit cur, nxt; int ui = 0;
    if (!S.next(0, cur)) return;
    f32x4 acc[2][2][4][2];
#pragma unroll
    for (int a = 0; a < 2; ++a)
#pragma unroll
        for (int b = 0; b < 2; ++b)
#pragma unroll
            for (int m = 0; m < 4; ++m)
#pragma unroll
                for (int n = 0; n < 2; ++n) acc[a][b][m][n] = (f32x4){0.f, 0.f, 0.f, 0.f};
    bf16x8 At[4][2], B0[2][2], B1[2][2];
    unsigned vA[2][2], vN[2][2];
    pr.avoff(cur, RA, CA, vA);
#pragma unroll
    for (int h = 0; h < 2; ++h)
#pragma unroll
        for (int i = 0; i < 2; ++i) vN[h][i] = vA[h][i];
    const char* cA = pr.abase(cur); const char* cB = pr.bbase(cur);
#define PG8_ROT(u) 0
#define PG8_KT(tt, rot) ((size_t)(((tt) + (rot)) >= nt ? ((tt) + (rot)) - nt : ((tt) + (rot))) * kstep)
    int rot = PG8_ROT(cur);
    { const char* pA = cA + PG8_KT(0, rot); const char* pB = cB + PG8_KT(0, rot);
    PG8_STAGE(PG8_SB(0, 0), pB, voffB); PG8_STAGE(PG8_SA(0, 0), pA, vA[0]); PG8_STAGE(PG8_SB(0, 1), pB + hstepB, voffB); PG8_STAGE(PG8_SA(0, 1), pA, vA[1]);
    if (wr == 1) PG8_BAR;
    PG8_WAIT_V(4); PG8_BAR;
    PG8_STAGE(PG8_SB(1, 0), pB + kstep, voffB); PG8_STAGE(PG8_SA(1, 0), pA + kstep, vA[0]); PG8_STAGE(PG8_SB(1, 1), pB + hstepB + kstep, voffB); }
    PG8_WAIT_V(6); PG8_BAR;
    for (;;) {
        const bool has_next = S.next(ui + 1, nxt);
        const char* nA = has_next ? pr.abase(nxt) : cA; const char* nB = has_next ? pr.bbase(nxt) : cB; const int nrot = has_next ? PG8_ROT(nxt) : rot;
        if (P::GATHER) { if (has_next) pr.avoff(nxt, RA, CA, vN); }
        for (int t = 0; t < nt; t += 2) {
            const bool last = (t == nt - 2);
            const char* a1 = cA + PG8_KT(t + 1, rot);
            const char* a2 = last ? nA + PG8_KT(0, nrot) : cA + PG8_KT(t + 2, rot); const char* b2 = last ? nB + PG8_KT(0, nrot) : cB + PG8_KT(t + 2, rot);
            const char* a3 = a2 + kstep; const char* b3 = b2 + kstep;
            unsigned v2[2][2];
#pragma unroll
            for (int h = 0; h < 2; ++h)
#pragma unroll
                for (int i = 0; i < 2; ++i) v2[h][i] = (P::GATHER && last) ? vN[h][i] : vA[h][i];
            PG8_LDB(B0, 0, 0); PG8_SCHED; PG8_LDA(At, 0, 0); PG8_STAGE(PG8_SA(1, 1), a1, vA[1]);
            PG8_WAIT_L(8); PG8_BAR; PG8_WAIT_L(0); PG8_MMA(0, 0, At, B0); PG8_BAR; PG8_SCHED;
            PG8_LDB(B1, 0, 1); PG8_STAGE(PG8_SB(0, 0), b2, voffB);
            PG8_BAR; PG8_WAIT_L(0); PG8_MMA(0, 1, At, B1); PG8_BAR;
            PG8_LDA(At, 0, 1); PG8_STAGE(PG8_SA(0, 0), a2, v2[0]);
            PG8_BAR; PG8_WAIT_L(0); PG8_MMA(1, 0, At, B0); PG8_BAR; PG8_SCHED;
            PG8_STAGE(PG8_SB(0, 1), b2 + hstepB, voffB);
            PG8_WAIT_V(6); PG8_BAR; PG8_MMA(1, 1, At, B1); PG8_BAR;
            PG8_LDB(B0, 1, 0); PG8_SCHED; PG8_LDA(At, 1, 0); PG8_STAGE(PG8_SA(0, 1), a2, v2[1]);
            PG8_WAIT_L(8); PG8_BAR; PG8_WAIT_L(0); PG8_MMA(0, 0, At, B0); PG8_BAR; PG8_SCHED;
            PG8_LDB(B1, 1, 1); PG8_STAGE(PG8_SB(1, 0), b3, voffB);
            PG8_BAR; PG8_WAIT_L(0); PG8_MMA(0, 1, At, B1); PG8_BAR;
            PG8_LDA(At, 1, 1); PG8_STAGE(PG8_SA(1, 0), a3, v2[0]);
            PG8_BAR; PG8_WAIT_L(0); PG8_MMA(1, 0, At, B0); PG8_BAR; PG8_SCHED;
            PG8_STAGE(PG8_SB(1, 1), b3 + hstepB, voffB);
            PG8_WAIT_V(6); PG8_BAR; PG8_MMA(1, 1, At, B1); PG8_BAR;
            if (P::GATHER && last) {
#pragma unroll
                for (int h = 0; h < 2; ++h)
#pragma unroll
                    for (int i = 0; i < 2; ++i) vA[h][i] = vN[h][i];
            }
        }
        E(acc, cur, wr, wc, fr, fq);
        if (!has_next) break;
#pragma unroll
        for (int a = 0; a < 2; ++a)
#pragma unroll
            for (int b = 0; b < 2; ++b)
#pragma unroll
                for (int m = 0; m < 4; ++m)
#pragma unroll
                    for (int n = 0; n < 2; ++n) acc[a][b][m][n] = (f32x4){0.f, 0.f, 0.f, 0.f};
        cur = nxt; cA = nA; cB = nB; rot = nrot; ++ui;
    }
    PG8_WAIT_V(0);
    if (wr == 0) PG8_BAR;
    PG8_BAR;
#undef PG8_ROT
#undef PG8_KT
#undef PG8_SA
#undef PG8_SB
#undef PG8_STAGE
#undef PG8_LDA
#undef PG8_LDB
#undef PG8_MMA
#undef PG8_WAIT_V
#undef PG8_WAIT_L
#undef PG8_BAR
#undef PG8_SCHED
}
template <class P, class Epi>
__device__ __forceinline__ void gemm_phase2(LAS unsigned char* lds, const P& pr, const Order& S, const Epi& E) {
    const int tid = threadIdx.x, wid = __builtin_amdgcn_readfirstlane(tid >> 6), lane = tid & 63, wr = wid >> 2, wc = wid & 3, fr = lane & 15, fq = lane >> 4;
    const int nt1 = pr.K1 / BK, nt = (pr.K1 + pr.K2) / BK;
    unsigned R2[2], Rb2[2], C2[2];
#pragma unroll
    for (int i = 0; i < 2; ++i) { int R, C; stage_rc(tid * 16 + i * 8192, R, C); const int Rb = Epi::PERM ? ((R & ~31) + perm32(R & 31)) : R; R2[i] = (unsigned)R * 2u; Rb2[i] = (unsigned)Rb * 2u; C2[i] = (unsigned)C * 2u; }
#define OFF_A(ld, h, i) ((R2[i] + (unsigned)((h) * 256)) * (unsigned)(ld) + C2[i])
#define OFF_B(ld, i) (Rb2[i] * (unsigned)(ld) + C2[i])
    const size_t kstep = (size_t)(BK * 2);
    const size_t hB1 = (size_t)HALF * pr.ldb1 * 2, hB2 = (size_t)HALF * pr.ldb2 * 2;
    const unsigned ldsw = (unsigned)wid * 1024u;
    const int aoff = lds_byte(wr * 64 + fr, fq * 8), boff = lds_byte(wc * 32 + fr, fq * 8);
#define PG8_SA(b, h) (((b) * 2 + (h)) * HTB)
#define PG8_SB(b, h) ((4 + (b) * 2 + (h)) * HTB)
#define PG8_STAGE(bufoff, gbase, voff) do { _Pragma("unroll") for (int _i = 0; _i < 2; ++_i) \
        __builtin_amdgcn_global_load_lds((const unsigned*)((const char*)(gbase) + (voff)[_i]), (LAS unsigned*)(lds + (bufoff) + ldsw + _i * 8192), 16, 0, 0); } while (0)
#define PG8_LDA(dst, b, h) do { _Pragma("unroll") for (int m = 0; m < 4; ++m) _Pragma("unroll") for (int k = 0; k < 2; ++k) dst[m][k] = *(const LAS bf16x8*)(lds + PG8_SA(b, h) + aoff + m * 2048 + k * 1024); } while (0)
#define PG8_LDB(dst, b, h) do { _Pragma("unroll") for (int n = 0; n < 2; ++n) _Pragma("unroll") for (int k = 0; k < 2; ++k) dst[n][k] = *(const LAS bf16x8*)(lds + PG8_SB(b, h) + boff + n * 2048 + k * 1024); } while (0)
#define PG8_MMA(ai, bj, At, Bt) do { __builtin_amdgcn_s_setprio(1); _Pragma("unroll") for (int m = 0; m < 4; ++m) _Pragma("unroll") for (int n = 0; n < 2; ++n) _Pragma("unroll") for (int k = 0; k < 2; ++k) \
        acc[ai][bj][m][n] = __builtin_amdgcn_mfma_f32_16x16x32_bf16(Bt[n][k], At[m][k], acc[ai][bj][m][n], 0, 0, 0); __builtin_amdgcn_s_setprio(0); } while (0)
#define PG8_WAIT_V(n) asm volatile("s_waitcnt vmcnt(" #n ")" ::: "memory")
#define PG8_WAIT_L(n) asm volatile("s_waitcnt lgkmcnt(" #n ")" ::: "memory")
#define PG8_BAR __builtin_amdgcn_s_barrier()
#define PG8_SCHED __builtin_amdgcn_sched_barrier(0)
    Unit cur, nxt; int ui = 0;
    if (!S.next(0, cur)) return;
    f32x4 acc[2][2][4][2];
#pragma unroll
    for (int a = 0; a < 2; ++a)
#pragma unroll
        for (int b = 0; b < 2; ++b)
#pragma unroll
            for (int m = 0; m < 4; ++m)
#pragma unroll
                for (int n = 0; n < 2; ++n) acc[a][b][m][n] = (f32x4){0.f, 0.f, 0.f, 0.f};
    bf16x8 At[4][2], B0[2][2], B1[2][2];
    const char* cA1 = pr.abase1(cur); const char* cB1 = pr.bbase1(cur); const char* cA2 = pr.abase2(cur); const char* cB2 = pr.bbase2(cur);
#define T_A(tt) ((tt) < nt1 ? cA1 + (size_t)(tt) * kstep : cA2 + (size_t)((tt) - nt1) * kstep)
#define T_B(tt) ((tt) < nt1 ? cB1 + (size_t)(tt) * kstep : cB2 + (size_t)((tt) - nt1) * kstep)
    { unsigned vb[2] = {OFF_B(pr.ldb1, 0), OFF_B(pr.ldb1, 1)}, va0[2] = {OFF_A(pr.lda1, 0, 0), OFF_A(pr.lda1, 0, 1)}, va1[2] = {OFF_A(pr.lda1, 1, 0), OFF_A(pr.lda1, 1, 1)};
    PG8_STAGE(PG8_SB(0, 0), cB1, vb); PG8_STAGE(PG8_SA(0, 0), cA1, va0); PG8_STAGE(PG8_SB(0, 1), cB1 + hB1, vb); PG8_STAGE(PG8_SA(0, 1), cA1, va1);
    if (wr == 1) PG8_BAR;
    PG8_WAIT_V(4); PG8_BAR;
    PG8_STAGE(PG8_SB(1, 0), cB1 + kstep, vb); PG8_STAGE(PG8_SA(1, 0), cA1 + kstep, va0); PG8_STAGE(PG8_SB(1, 1), cB1 + hB1 + kstep, vb); }
    PG8_WAIT_V(6); PG8_BAR;
    for (;;) {
        const bool has_next = S.next(ui + 1, nxt);
        const char* nA = has_next ? pr.abase1(nxt) : cA1; const char* nB = has_next ? pr.bbase1(nxt) : cB1;
        for (int t = 0; t < nt; t += 2) {
            const bool last = (t == nt - 2);
            const bool s1 = (t + 1 < nt1), s2 = last || (t + 2 < nt1);
            const char* a1 = T_A(t + 1);
            const char* a2 = last ? nA : T_A(t + 2); const char* b2 = last ? nB : T_B(t + 2);
            const char* a3 = a2 + kstep; const char* b3 = b2 + kstep;
            const size_t hstepB = s2 ? hB1 : hB2; const int ldaT1 = s1 ? pr.lda1 : pr.lda2, ldaT2 = s2 ? pr.lda1 : pr.lda2, ldbT2 = s2 ? pr.ldb1 : pr.ldb2;
            unsigned v2[2][2], voffB[2], vA1s[2];
#pragma unroll
            for (int i = 0; i < 2; ++i) { voffB[i] = OFF_B(ldbT2, i); vA1s[i] = OFF_A(ldaT1, 1, i);
#pragma unroll
                for (int h = 0; h < 2; ++h) v2[h][i] = OFF_A(ldaT2, h, i); }
            PG8_LDB(B0, 0, 0); PG8_SCHED; PG8_LDA(At, 0, 0); PG8_STAGE(PG8_SA(1, 1), a1, vA1s);
            PG8_WAIT_L(8); PG8_BAR; PG8_WAIT_L(0); PG8_MMA(0, 0, At, B0); PG8_BAR; PG8_SCHED;
            PG8_LDB(B1, 0, 1); PG8_STAGE(PG8_SB(0, 0), b2, voffB);
            PG8_BAR; PG8_WAIT_L(0); PG8_MMA(0, 1, At, B1); PG8_BAR;
            PG8_LDA(At, 0, 1); PG8_STAGE(PG8_SA(0, 0), a2, v2[0]);
            PG8_BAR; PG8_WAIT_L(0); PG8_MMA(1, 0, At, B0); PG8_BAR; PG8_SCHED;
            PG8_STAGE(PG8_SB(0, 1), b2 + hstepB, voffB);
            PG8_WAIT_V(6); PG8_BAR; PG8_MMA(1, 1, At, B1); PG8_BAR;
            PG8_LDB(B0, 1, 0); PG8_SCHED; PG8_LDA(At, 1, 0); PG8_STAGE(PG8_SA(0, 1), a2, v2[1]);
            PG8_WAIT_L(8); PG8_BAR; PG8_WAIT_L(0); PG8_MMA(0, 0, At, B0); PG8_BAR; PG8_SCHED;
            PG8_LDB(B1, 1, 1); PG8_STAGE(PG8_SB(1, 0), b3, voffB);
            PG8_BAR; PG8_WAIT_L(0); PG8_MMA(0, 1, At, B1); PG8_BAR;
            PG8_LDA(At, 1, 1); PG8_STAGE(PG8_SA(1, 0), a3, v2[0]);
            PG8_BAR; PG8_WAIT_L(0); PG8_MMA(1, 0, At, B0); PG8_BAR; PG8_SCHED;
            PG8_STAGE(PG8_SB(1, 1), b3 + hstepB, voffB);
            PG8_WAIT_V(6); PG8_BAR; PG8_MMA(1, 1, At, B1); PG8_BAR;
            if (t == nt1 - 2) E.mid(acc, cur, wr, wc, fr, fq);
        }
        E(acc, cur, wr, wc, fr, fq);
        if (!has_next) break;
#pragma unroll
        for (int a = 0; a < 2; ++a)
#pragma unroll
            for (int b = 0; b < 2; ++b)
#pragma unroll
                for (int m = 0; m < 4; ++m)
#pragma unroll
                    for (int n = 0; n < 2; ++n) acc[a][b][m][n] = (f32x4){0.f, 0.f, 0.f, 0.f};
        cur = nxt; cA1 = nA; cB1 = nB; cA2 = pr.abase2(cur); cB2 = pr.bbase2(cur); ++ui;
    }
    PG8_WAIT_V(0);
    if (wr == 0) PG8_BAR;
    PG8_BAR;
#undef T_A
#undef T_B
#undef OFF_A
#undef OFF_B
#undef PG8_SA
#undef PG8_SB
#undef PG8_STAGE
#undef PG8_LDA
#undef PG8_LDB
#undef PG8_MMA
#undef PG8_WAIT_V
#undef PG8_WAIT_L
#undef PG8_BAR
#undef PG8_SCHED
}
}
using pg8::Unit;

struct ProbPlain {
    static constexpr bool GATHER = false;
    const bf16_t* A; const bf16_t* B; int K, lda, ldb;
    __device__ __forceinline__ const char* abase(const Unit& u) const { return (const char*)(A + (size_t)u.pm * 256 * lda); }
    __device__ __forceinline__ const char* bbase(const Unit& u) const { return (const char*)(B + (size_t)u.pn * 256 * ldb); }
    __device__ __forceinline__ void avoff(const Unit&, const int (&RA)[2], const int (&CA)[2], unsigned (&v)[2][2]) const {
#pragma unroll
        for (int h = 0; h < 2; ++h)
#pragma unroll
            for (int i = 0; i < 2; ++i) v[h][i] = (unsigned)((h * 128 + RA[i]) * lda + CA[i]) * 2u;
    }
};
struct ProbMerge {
    const bf16_t* A1; const bf16_t* B1; const bf16_t* A2; const bf16_t* B2; int K1, K2, lda1, ldb1, lda2, ldb2;
    __device__ __forceinline__ const char* abase1(const Unit& u) const { return (const char*)(A1 + (size_t)u.pm * 256 * lda1); }
    __device__ __forceinline__ const char* bbase1(const Unit& u) const { return (const char*)(B1 + (size_t)u.pn * 256 * ldb1); }
    __device__ __forceinline__ const char* abase2(const Unit& u) const { return (const char*)(A2 + (size_t)u.pm * 256 * lda2); }
    __device__ __forceinline__ const char* bbase2(const Unit& u) const { return (const char*)(B2 + (size_t)u.pn * 256 * ldb2); }
};
struct ProbPQ {
    static constexpr bool GATHER = false;
    const bf16_t* A; const bf16_t* B; int K, lda, ldb;
    __device__ __forceinline__ const char* abase(const Unit& u) const { return (const char*)(A + (size_t)u.pm * 256 * lda); }
    __device__ __forceinline__ const char* bbase(const Unit& u) const { return (const char*)(B + ((size_t)(u.pn >> 4) * 4096 + (u.pn & 15)) * 1024); }
    __device__ __forceinline__ void avoff(const Unit&, const int (&RA)[2], const int (&CA)[2], unsigned (&v)[2][2]) const {
#pragma unroll
        for (int h = 0; h < 2; ++h)
#pragma unroll
            for (int i = 0; i < 2; ++i) v[h][i] = (unsigned)((h * 128 + RA[i]) * lda + CA[i]) * 2u;
    }
};
struct ProbMoeUp {
    static constexpr bool GATHER = true;
    const bf16_t* A; const bf16_t* B; const int* idx; int K, lda, ldb;
    __device__ __forceinline__ const char* abase(const Unit&) const { return (const char*)A; }
    __device__ __forceinline__ const char* bbase(const Unit& u) const { return (const char*)(B + ((size_t)(u.pm >> 4) * 3072 + (size_t)u.pn * 256) * ldb); }
    __device__ __forceinline__ void avoff(const Unit& u, const int (&RA)[2], const int (&CA)[2], unsigned (&v)[2][2]) const {
#pragma unroll
        for (int h = 0; h < 2; ++h)
#pragma unroll
            for (int i = 0; i < 2; ++i) { const int g = idx[u.pm * 256 + h * 128 + RA[i]]; v[h][i] = (unsigned)(g * lda + CA[i]) * 2u; }
    }
};
struct ProbMoeDown {
    static constexpr bool GATHER = false;
    const bf16_t* A; const bf16_t* B; int K, lda, ldb;
    __device__ __forceinline__ const char* abase(const Unit& u) const { return (const char*)(A + (size_t)u.pm * 256 * lda); }
    __device__ __forceinline__ const char* bbase(const Unit& u) const { return (const char*)(B + ((size_t)(u.pm >> 4) * 1024 + (size_t)u.pn * 256) * ldb); }
    __device__ __forceinline__ void avoff(const Unit&, const int (&RA)[2], const int (&CA)[2], unsigned (&v)[2][2]) const {
#pragma unroll
        for (int h = 0; h < 2; ++h)
#pragma unroll
            for (int i = 0; i < 2; ++i) v[h][i] = (unsigned)((h * 128 + RA[i]) * lda + CA[i]) * 2u;
    }
};

#define EPI_ROWS(...) _Pragma("unroll") for (int ai = 0; ai < 2; ++ai) _Pragma("unroll") for (int m = 0; m < 4; ++m) { const int row = u.pm * 256 + ai * 128 + wr * 64 + m * 16 + fr; __VA_ARGS__ }
__device__ __forceinline__ u32x4 pack8(const f32x4 v0, const f32x4 v1) { u32x4 w; w.x = cvt_pk_bf16(v0[0], v0[1]); w.y = cvt_pk_bf16(v0[2], v0[3]); w.z = cvt_pk_bf16(v1[0], v1[1]); w.w = cvt_pk_bf16(v1[2], v1[3]); return w; }

struct EpiPQ {
    static constexpr bool PERM = true; bf16_t* O;
    __device__ __forceinline__ void operator()(const f32x4 (&acc)[2][2][4][2], const Unit& u, int wr, int wc, int fr, int fq) const {
        const int t10 = wc * 32 + 8 * fq, b = u.pn >> 4, t2 = u.pn & 15;
        EPI_ROWS(
            bf16_t* rp = O + ((size_t)((b * 512 + (row >> 1)) * 16 + t2) * 512 + (row & 1) * 256 + t10);
            _Pragma("unroll") for (int bj = 0; bj < 2; ++bj) *(u32x4*)(rp + bj * 128) = pack8(acc[ai][bj][m][0], acc[ai][bj][m][1]);
        )
    }
};
struct EpiPlain {
    static constexpr bool PERM = true; bf16_t* O; size_t ldc;
    __device__ __forceinline__ void operator()(const f32x4 (&acc)[2][2][4][2], const Unit& u, int wr, int wc, int fr, int fq) const {
        const int col0 = u.pn * 256 + wc * 32 + 8 * fq;
        EPI_ROWS(
            bf16_t* rp = O + (size_t)row * ldc + col0;
            _Pragma("unroll") for (int bj = 0; bj < 2; ++bj) *(u32x4*)(rp + bj * 128) = pack8(acc[ai][bj][m][0], acc[ai][bj][m][1]);
        )
    }
};
struct EpiZ {
    static constexpr bool PERM = true; bf16_t* O; int ldc; int fixed_act;
    __device__ __forceinline__ void operator()(const f32x4 (&acc)[2][2][4][2], const Unit& u, int wr, int wc, int fr, int fq) const {
        const int col0 = u.pn * 256 + wc * 32 + 8 * fq; const int act = fixed_act >= 0 ? fixed_act : (u.pn >> 2);
        EPI_ROWS(
            bf16_t* rp = O + (size_t)row * ldc + col0;
            _Pragma("unroll") for (int bj = 0; bj < 2; ++bj) {
                f32x4 v0 = acc[ai][bj][m][0], v1 = acc[ai][bj][m][1];
                if (act == 1) { _Pragma("unroll") for (int j = 0; j < 4; ++j) { v0[j] = gelu_tanh(v0[j]); v1[j] = gelu_tanh(v1[j]); } }
                else if (act >= 2) { _Pragma("unroll") for (int j = 0; j < 4; ++j) { v0[j] = sigmoidf_(v0[j]); v1[j] = sigmoidf_(v1[j]); } }
                *(u32x4*)(rp + bj * 128) = pack8(v0, v1); }
        )
    }
};
struct EpiMerge {
    static constexpr bool PERM = true; bf16_t* O; const bf16_t* Z;
    __device__ __forceinline__ void mid(f32x4 (&acc)[2][2][4][2], const Unit& u, int wr, int wc, int fr, int fq) const {
        unsigned eo = (unsigned)((u.pm * 256 + wr * 64 + fr) * 4096 + 2048 + u.pn * 256 + wc * 32 + 8 * fq);
        asm volatile("" : "+v"(eo));
#pragma unroll
        for (int ai = 0; ai < 2; ++ai) {
            u32x4 wa[4][2], wb[4][2];
#pragma unroll
            for (int m = 0; m < 4; ++m)
#pragma unroll
                for (int bj = 0; bj < 2; ++bj) { const unsigned o = eo + (unsigned)((ai * 128 + m * 16) * 4096 + bj * 128); wa[m][bj] = *(const u32x4*)(Z + o); wb[m][bj] = *(const u32x4*)(Z + o + 1024); }
#pragma unroll
            for (int m = 0; m < 4; ++m)
#pragma unroll
                for (int bj = 0; bj < 2; ++bj) { float ga[8], gb[8]; unpack8(wa[m][bj], ga); unpack8(wb[m][bj], gb);
#pragma unroll
                    for (int j = 0; j < 4; ++j) { acc[ai][bj][m][0][j] *= ga[j] * __builtin_amdgcn_rcpf(fmaxf(gb[j], 1e-30f)); acc[ai][bj][m][1][j] *= ga[4 + j] * __builtin_amdgcn_rcpf(fmaxf(gb[4 + j], 1e-30f)); } }
            __builtin_amdgcn_sched_barrier(0); }
    }
    __device__ __forceinline__ void operator()(const f32x4 (&acc)[2][2][4][2], const Unit& u, int wr, int wc, int fr, int fq) const {
        unsigned eo = (unsigned)((u.pm * 256 + wr * 64 + fr) * 4096 + 3072 + u.pn * 256 + wc * 32 + 8 * fq); asm volatile("" : "+v"(eo));
        unsigned oo = (unsigned)((u.pm * 256 + wr * 64 + fr) * 1024 + u.pn * 256 + wc * 32 + 8 * fq); asm volatile("" : "+v"(oo));
        u32x4 wb[2][4][2];
#pragma unroll
        for (int ai = 0; ai < 2; ++ai)
#pragma unroll
            for (int m = 0; m < 4; ++m)
#pragma unroll
                for (int bj = 0; bj < 2; ++bj) wb[ai][m][bj] = *(const u32x4*)(Z + eo + (unsigned)((ai * 128 + m * 16) * 4096 + bj * 128));
#pragma unroll
        for (int ai = 0; ai < 2; ++ai)
#pragma unroll
            for (int m = 0; m < 4; ++m)
#pragma unroll
                for (int bj = 0; bj < 2; ++bj) { float g[8]; unpack8(wb[ai][m][bj], g);
                    f32x4 v0 = acc[ai][bj][m][0], v1 = acc[ai][bj][m][1];
#pragma unroll
                    for (int j = 0; j < 4; ++j) { v0[j] *= g[j]; v1[j] *= g[4 + j]; }
                    *(u32x4*)(O + oo + (unsigned)((ai * 128 + m * 16) * 1024 + bj * 128)) = pack8(v0, v1); }
    }
};
struct EpiOut {
    static constexpr bool PERM = false; float* O; const float* X; const float* pos; const float* ada;
    __device__ __forceinline__ void operator()(const f32x4 (&acc)[2][2][4][2], const Unit& u, int wr, int wc, int fr, int fq) const {
        const int col0 = u.pn * 256 + wc * 32 + 4 * fq; const int b = u.pm >> 4;
        unsigned ro = (unsigned)((u.pm * 256 + wr * 64 + fr) * 1024 + col0); asm volatile("" : "+v"(ro));
#pragma unroll
        for (int ai = 0; ai < 2; ++ai) {
            f32x4 xv[4][2][2];
#pragma unroll
            for (int m = 0; m < 4; ++m)
#pragma unroll
                for (int bj = 0; bj < 2; ++bj)
#pragma unroll
                    for (int n = 0; n < 2; ++n) xv[m][bj][n] = *(const f32x4*)(X + ro + (unsigned)((ai * 128 + m * 16) * 1024 + bj * 128 + n * 16));
#pragma unroll
            for (int m = 0; m < 4; ++m) { const int row = u.pm * 256 + ai * 128 + wr * 64 + m * 16 + fr; const int t = row & 4095;
#pragma unroll
                for (int bj = 0; bj < 2; ++bj)
#pragma unroll
                    for (int n = 0; n < 2; ++n) { const int col = col0 + bj * 128 + n * 16;
                        const f32x4 pv = *(const f32x4*)(pos + (col < 512 ? (t >> 6) * 512 + col : (t & 63) * 512 + (col - 512)));
                        const f32x4 gv = *(const f32x4*)(ada + b * 6144 + 2048 + col);
                        *(f32x4*)(O + ro + (unsigned)((ai * 128 + m * 16) * 1024 + bj * 128 + n * 16)) = xv[m][bj][n] + pv + gv * acc[ai][bj][m][n]; } }
            __builtin_amdgcn_sched_barrier(0); }
    }
};
struct EpiGU {
    static constexpr bool PERM = true; bf16_t* O;
    __device__ __forceinline__ void operator()(const f32x4 (&acc)[2][2][4][2], const Unit& u, int wr, int wc, int fr, int fq) const {
        const int col0 = u.pn * 128 + wc * 32 + 8 * fq;
        EPI_ROWS(
            f32x4 v0, v1;
            _Pragma("unroll") for (int j = 0; j < 4; ++j) { const float g0 = acc[ai][0][m][0][j], g1 = acc[ai][0][m][1][j];
                v0[j] = g0 * sigmoidf_(g0) * acc[ai][1][m][0][j]; v1[j] = g1 * sigmoidf_(g1) * acc[ai][1][m][1][j]; }
            *(u32x4*)(O + (size_t)row * DE + col0) = pack8(v0, v1);
        )
    }
};
struct EpiDown {
    static constexpr bool PERM = true; bf16_t* O; const float* gate;
    __device__ __forceinline__ void operator()(const f32x4 (&acc)[2][2][4][2], const Unit& u, int wr, int wc, int fr, int fq) const {
        const int col0 = u.pn * 256 + wc * 32 + 8 * fq;
        EPI_ROWS(
            const float g = gate[row];
            _Pragma("unroll") for (int bj = 0; bj < 2; ++bj) *(u32x4*)(O + (size_t)row * 1024 + col0 + bj * 128) = pack8(acc[ai][bj][m][0] * g, acc[ai][bj][m][1] * g);
        )
    }
};

__device__ __forceinline__ void p0_ada(const Params& p, LAS unsigned char* lds, int item) {
    const int tid = threadIdx.x;
    LAS float* s = (LAS float*)lds; LAS float* red = s + 9 * 1024;
    for (int i = tid; i < 9 * 1024; i += NTHR) { const int r = i >> 10, d = i & 1023; const float v = r < 8 ? p.c[r * 1024 + d] : p.c_ctx[d]; s[i] = v / (1.0f + expf(-v)); }
    __syncthreads();
    const int col = tid & 63, ds = tid >> 6; float a[9];
#pragma unroll
    for (int r = 0; r < 9; ++r) a[r] = 0.f;
    const float* w = p.w_ada + (size_t)(ds * 128) * 6144 + item * 64 + col;
    for (int d0 = 0; d0 < 128; d0 += 32) { float wv[32];
#pragma unroll
        for (int j = 0; j < 32; ++j) wv[j] = w[(size_t)(d0 + j) * 6144];
#pragma unroll
        for (int j = 0; j < 32; ++j)
#pragma unroll
            for (int r = 0; r < 9; ++r) a[r] += s[r * 1024 + ds * 128 + d0 + j] * wv[j]; }
#pragma unroll
    for (int r = 0; r < 9; ++r) red[(ds * 9 + r) * 64 + col] = a[r];
    __syncthreads();
    float* ada = (float*)(p.ws + WS_ADA);
    for (int i = tid; i < 9 * 64; i += NTHR) { const int r = i >> 6, cc = i & 63; float v = 0.f;
#pragma unroll
        for (int k = 0; k < 8; ++k) v += red[(k * 9 + r) * 64 + cc];
        ada[r * 6144 + item * 64 + cc] = v + p.b_ada[item * 64 + cc]; }
    __syncthreads();
}
template <int NS>
__device__ __forceinline__ void xpose_item(const float* src, int ldsrc, bf16_t* dst, int lddst, int k0, int n0, int mode, float scale = 1.0f) {
    const int tid = threadIdx.x, k8 = tid & 7, nq = tid >> 3;
    if (nq >= 16 * NS) return;
    f32x4 v[8];
#pragma unroll
    for (int j = 0; j < 8; ++j) v[j] = *(const f32x4*)(src + (size_t)(k0 + 8 * k8 + j) * ldsrc + n0 + 4 * nq);
#pragma unroll
    for (int c = 0; c < 4; ++c) { const int n = n0 + 4 * nq + c; int row = n;
        if (mode) row = (n >> 7) * 256 + (n & 127) + (mode == 2 ? 128 : 0);
        u32x4 w; w.x = cvt_pk_bf16(v[0][c] * scale, v[1][c] * scale); w.y = cvt_pk_bf16(v[2][c] * scale, v[3][c] * scale); w.z = cvt_pk_bf16(v[4][c] * scale, v[5][c] * scale); w.w = cvt_pk_bf16(v[6][c] * scale, v[7][c] * scale);
        *(u32x4*)(dst + (size_t)row * lddst + k0 + 8 * k8) = w; }
}
__device__ __forceinline__ void p0_wpq(const Params& p, LAS unsigned char* lds, int item) {
    const int tid = threadIdx.x, g = item >> 6, db = item & 63;
    LAS float* wl = (LAS float*)lds; LAS float* ct = wl + 16 * 129;
    for (int i = tid; i < 16 * 128; i += NTHR) { const int d = i >> 7, cc = i & 127; wl[d * 129 + cc] = p.w_in[(size_t)(db * 16 + d) * 4608 + g * 128 + cc]; }
    if (tid < 128) { float sn, cs; sincospif((float)tid * (1.0f / 64.0f), &sn, &cs); ct[tid] = cs; ct[128 + tid] = sn; }
    __syncthreads();
    const int q = tid & 255, kc = q >> 1, pq = q & 1, dh = tid >> 8; const int n = (g * 128 + kc) * 2 + pq;
    bf16_t* dst = (bf16_t*)(p.ws + WS_WPQ) + (size_t)n * 1024 + db * 16 + dh * 8;
    const float scale = 0.001381067932f;
    float a[8];
#pragma unroll
    for (int j = 0; j < 8; ++j) a[j] = 0.f;
    for (int cc = 0; cc < 128; ++cc) { const float tv = ct[pq * 128 + ((cc * kc) & 127)];
#pragma unroll
        for (int j = 0; j < 8; ++j) a[j] += wl[(dh * 8 + j) * 129 + cc] * tv; }
    u32x4 w; w.x = cvt_pk_bf16(a[0] * scale, a[1] * scale); w.y = cvt_pk_bf16(a[2] * scale, a[3] * scale); w.z = cvt_pk_bf16(a[4] * scale, a[5] * scale); w.w = cvt_pk_bf16(a[6] * scale, a[7] * scale);
    *(u32x4*)dst = w;
    __syncthreads();
}
__device__ __forceinline__ void p0_d1t(const Params& p, int item) {
    bf16_t* dst = (bf16_t*)(p.ws + WS_D1T);
    const int row = item * 64 + (threadIdx.x >> 3), k1 = row >> 1, ri = row & 1, c0 = (threadIdx.x & 7) * 64;
    for (int c8 = 0; c8 < 64; c8 += 8) { float v[8];
#pragma unroll
        for (int j = 0; j < 8; ++j) { const int col = c0 + c8 + j, pq = col >> 8, t1 = col & 255; float sn, cs; sincospif((float)((k1 * t1) & 255) * (1.0f / 128.0f), &sn, &cs);
            v[j] = (ri == 0) ? (pq == 0 ? cs : -sn) : (pq == 0 ? -sn : -cs); }
        u32x4 w; w.x = cvt_pk_bf16(v[0], v[1]); w.y = cvt_pk_bf16(v[2], v[3]); w.z = cvt_pk_bf16(v[4], v[5]); w.w = cvt_pk_bf16(v[6], v[7]);
        *(u32x4*)(dst + (size_t)row * 512 + c0 + c8) = w; }
}
__device__ __forceinline__ void p0_d2t(const Params& p, int item) {
    bf16_t* dst = (bf16_t*)(p.ws + WS_D2T);
#pragma unroll
    for (int ps = 0; ps < 4; ++ps) { const int pc = (item * 4 + ps) * NTHR + threadIdx.x, tp = pc >> 2, kk0 = (pc & 3) * 8; float v[8];
#pragma unroll
        for (int j = 0; j < 8; ++j) { const int kk = kk0 + j, ri = kk >> 4, t2 = kk & 15; float sn, cs; sincospif((float)((tp * t2) & 4095) * (1.0f / 2048.0f), &sn, &cs); v[j] = ri ? sn : cs; }
        u32x4 w; w.x = cvt_pk_bf16(v[0], v[1]); w.y = cvt_pk_bf16(v[2], v[3]); w.z = cvt_pk_bf16(v[4], v[5]); w.w = cvt_pk_bf16(v[6], v[7]);
        *(u32x4*)(dst + (size_t)tp * 32 + kk0) = w; }
}
__device__ __forceinline__ void p0_pos(const Params& p) {
    float* tab = (float*)(p.ws + WS_POS);
    for (int i = threadIdx.x; i < 64 * 512; i += NTHR) { const int ii = i >> 9, j = i & 511, jj = j & 255; const float f = expf(-9.210340371976184f * (float)jj / 256.0f); const float a = (float)ii * f; tab[i] = j < 256 ? sinf(a) : cosf(a); }
}
__device__ __forceinline__ void phase0(const Params& p, LAS unsigned char* lds) {
    constexpr int N_ADA = 96, N_WIN = 16 * 16, N_WFOUR = 8 * 4, N_SQ = 16 * 4, N_LRU = 16 * 2, N_WPQ = 256, N_DFT = 8 + 8, N_POS = 1;
    constexpr int O1 = N_ADA, O2 = O1 + N_WIN, O3 = O2 + N_WFOUR, O4 = O3 + N_SQ, O5 = O4 + N_SQ, O6 = O5 + N_LRU, O7 = O6 + N_LRU, O8 = O7 + N_WPQ, O9 = O8 + N_DFT, O10 = O9 + N_POS;
    for (int it = blockIdx.x; it < O10; it += gridDim.x) {
        if (it < O1) p0_ada(p, lds, it);
        else if (it < O2) { const int j = it - O1; xpose_item<4>(p.w_in + 512, 4608, (bf16_t*)(p.ws + WS_WIN), 1024, (j >> 4) * 64, (j & 15) * 256, 0); }
        else if (it < O3) { const int j = it - O2; xpose_item<4>(p.w_four, 1024, (bf16_t*)(p.ws + WS_WFOUR), 512, (j >> 2) * 64, (j & 3) * 256, 0); }
        else if (it < O4) { const int j = it - O3; xpose_item<4>(p.w_lru, 1024, (bf16_t*)(p.ws + WS_WLRU), 1024, (j >> 2) * 64, (j & 3) * 256, 0); }
        else if (it < O5) { const int j = it - O4; xpose_item<4>(p.w_out, 1024, (bf16_t*)(p.ws + WS_WOUT), 1024, (j >> 2) * 64, (j & 3) * 256, 0); }
        else if (it < O6) { const int j = it - O5, mtx = j >> 1; xpose_item<2>(p.lru_wa + (size_t)mtx * 16384, 128, (bf16_t*)(p.ws + WS_WAT) + (size_t)mtx * 16384, 128, (j & 1) * 64, 0, 0, NLOG2E); }
        else if (it < O7) { const int j = it - O6, mtx = j >> 1; xpose_item<2>(p.lru_wi + (size_t)mtx * 16384, 128, (bf16_t*)(p.ws + WS_WIT) + (size_t)mtx * 16384, 128, (j & 1) * 64, 0, 0, NLOG2E); }
        else if (it < O8) p0_wpq(p, lds, it - O7);
        else if (it < O9) { if (it - O8 < 8) p0_d1t(p, it - O8); else p0_d2t(p, it - O8 - 8); }
        else p0_pos(p);
    }
}

__device__ __forceinline__ void phase1(const Params& p) {
    const int tid = tid_opaque(), lane = tid & 63, wid = tid >> 6;
    const float* ada = (const float*)(p.ws + WS_ADA); const float* tab = (const float*)(p.ws + WS_POS);
    bf16_t* h1 = (bf16_t*)(p.ws + WS_R1); bf16_t* hc = (bf16_t*)(p.ws + WS_HCTX);
    constexpr int NR = MLAT + MCTX, RW = 4;
    for (int row0 = (blockIdx.x * 8 + wid) * RW; row0 < NR; row0 += gridDim.x * 8 * RW) {
        const bool lat = row0 < MLAT; const int mrow = lat ? (row0 >> 12) : 8;
        f32x4 v[RW][4]; float ss[RW];
#pragma unroll
        for (int r = 0; r < RW; ++r) { const int row = row0 + r; const float* xr = lat ? p.x + (size_t)row * 1024 : p.ctx + (size_t)(row - MLAT) * 1024;
#pragma unroll
            for (int i = 0; i < 4; ++i) v[r][i] = *(const f32x4*)(xr + 256 * i + 4 * lane); }
#pragma unroll
        for (int r = 0; r < RW; ++r) { const int t = (row0 + r) & 4095; float a = 0.f;
#pragma unroll
            for (int i = 0; i < 4; ++i) { const int d = 256 * i + 4 * lane;
                if (lat) v[r][i] += *(const f32x4*)(tab + (i < 2 ? (t >> 6) * 512 + d : (t & 63) * 512 + d - 512));
                a += v[r][i][0] * v[r][i][0] + v[r][i][1] * v[r][i][1] + v[r][i][2] * v[r][i][2] + v[r][i][3] * v[r][i][3]; }
            ss[r] = a; }
#pragma unroll
        for (int o = 32; o >= 1; o >>= 1) {
#pragma unroll
            for (int r = 0; r < RW; ++r) ss[r] += __shfl_xor(ss[r], o); }
#pragma unroll
        for (int i = 0; i < 4; ++i) { const int d = 256 * i + 4 * lane;
            const f32x4 g = *(const f32x4*)(p.norm1_g + d), sh = *(const f32x4*)(ada + mrow * 6144 + d), sc = *(const f32x4*)(ada + mrow * 6144 + 1024 + d);
#pragma unroll
            for (int r = 0; r < RW; ++r) { const int row = row0 + r; const float rs = rsqrtf(ss[r] * (1.0f / 1024.0f) + 1e-6f);
                bf16_t* dst = lat ? h1 + (size_t)row * 1024 : hc + (size_t)(row - MLAT) * 1024;
                const f32x4 h = v[r][i] * rs * g * (sc + 1.0f) + sh;
                u32x2 w; w.x = cvt_pk_bf16(h[0], h[1]); w.y = cvt_pk_bf16(h[2], h[3]); *(u32x2*)(dst + d) = w; } }
    }
}

#define LRU_CST(mb, r) (32 * (mb) + 8 * ((r) >> 2) + ((r) & 3))
template <bool FINAL, int DIR>
__device__ __forceinline__ void lru_wave(const Params& p, LAS unsigned char* ul, int b, int sc, int head, int cb, int lane, f32x16 (&accI)[4]) {
    constexpr int SG = DIR ? -1 : 1;
    const int lr = lane & 31, lh = lane >> 5;
    const int chl = cb * 32 + lr, ch = head * 128 + chl;
    const int tbase = DIR ? 127 - 4 * lh : 4 * lh;
    f32x16 accA[4];
#pragma unroll
    for (int mb = 0; mb < 4; ++mb)
#pragma unroll
        for (int r = 0; r < 16; ++r) { accA[mb][r] = 0.f; accI[mb][r] = 0.f; }
    {
        const bf16_t* wa = (const bf16_t*)(p.ws + WS_WAT) + ((size_t)(DIR * 8 + head) * 128 + chl) * 128 + 8 * lh;
        const bf16_t* wi = (const bf16_t*)(p.ws + WS_WIT) + ((size_t)(DIR * 8 + head) * 128 + chl) * 128 + 8 * lh;
        LAS unsigned char* arow0 = ul + (DIR ? 127 - lr : lr) * 272 + lh * 16;
#pragma unroll
        for (int kc = 0; kc < 2; ++kc) { bf16x8 bA[4], bI[4];
#pragma unroll
            for (int k4 = 0; k4 < 4; ++k4) { bA[k4] = *(const bf16x8*)(wa + 16 * (kc * 4 + k4)); bI[k4] = *(const bf16x8*)(wi + 16 * (kc * 4 + k4)); }
#pragma unroll
            for (int mb = 0; mb < 4; ++mb)
#pragma unroll
                for (int k4 = 0; k4 < 4; ++k4) { const bf16x8 af = *(const LAS bf16x8*)(arow0 + SG * 32 * mb * 272 + 32 * (kc * 4 + k4));
                    accA[mb] = __builtin_amdgcn_mfma_f32_32x32x16_bf16(af, bA[k4], accA[mb], 0, 0, 0);
                    accI[mb] = __builtin_amdgcn_mfma_f32_32x32x16_bf16(af, bI[k4], accI[mb], 0, 0, 0); }
            __builtin_amdgcn_sched_barrier(0); }
    }
    {
        const float lam = p.lru_lambda[DIR * 1024 + ch]; const float sp8 = 8.0f * log1pf(expf(-lam));
        const float ba = p.lru_ba[DIR * 1024 + ch], bi = p.lru_bi[DIR * 1024 + ch];
        LAS unsigned char* up = ul + tbase * 272 + chl * 2;
#pragma unroll
        for (int mb = 0; mb < 4; ++mb) {
#pragma unroll
            for (int r = 0; r < 16; ++r) {
                const float uv = bf2f(*(const LAS bf16_t*)(up + SG * LRU_CST(mb, r) * 272));
                const float rg = __builtin_amdgcn_rcpf(1.0f + __builtin_amdgcn_exp2f(accA[mb][r] + NLOG2E * ba)), ig = __builtin_amdgcn_rcpf(1.0f + __builtin_amdgcn_exp2f(accI[mb][r] + NLOG2E * bi));
                const float a = __expf(-sp8 * rg); accA[mb][r] = a; accI[mb][r] = __builtin_amdgcn_sqrtf(fmaxf(1.0f - a * a, 0.f)) * ig * uv; }
            __builtin_amdgcn_sched_barrier(0); }
    }
    float rA[16], rH[16];
#pragma unroll
    for (int mb = 0; mb < 4; ++mb)
#pragma unroll
        for (int q = 0; q < 4; ++q) { float pa = 1.f, hh = 0.f;
#pragma unroll
            for (int j = 0; j < 4; ++j) { const int r = 4 * q + j; const float a = accA[mb][r], bb = accI[mb][r]; hh = a * hh + bb; pa *= a; accA[mb][r] = pa; accI[mb][r] = hh; }
            rA[mb * 4 + q] = pa; rH[mb * 4 + q] = hh; }
    const int agg_dir_off = ((b * NSEQ) * 2 + DIR) * 1024 + ch;
    const float* agg = (const float*)(p.ws + WS_AGG);
    float carry = 0.f;
    if (FINAL) {
        if (DIR == 0) { for (int q = 0; q < sc; ++q) { const float* a2 = agg + (size_t)(agg_dir_off + q * 2048) * 2; carry = a2[0] * carry + a2[1]; } }
        else { { const float* a2 = agg + (size_t)(agg_dir_off + 1 * 2048) * 2; carry = a2[0] * carry + a2[1]; } { const float* a2 = agg + (size_t)(agg_dir_off + 0 * 2048) * 2; carry = a2[0] * carry + a2[1]; }
            for (int q = NSEQ - 1; q > sc; --q) { const float* a2 = agg + (size_t)(agg_dir_off + q * 2048) * 2; carry = a2[0] * carry + a2[1]; } }
    }
    float cin[16];
#pragma unroll
    for (int i = 0; i < 16; ++i) cin[i] = 0.f;
    float s = carry, At = 1.f;
#pragma unroll
    for (int i = 0; i < 16; ++i) { const float oA = __shfl_xor(rA[i], 32), oH = __shfl_xor(rH[i], 32);
        { const bool mine = (lh == 0); const float a = mine ? rA[i] : oA, hh = mine ? rH[i] : oH; cin[i] = mine ? s : cin[i]; s = a * s + hh; At *= a; }
        { const bool mine = (lh == 1); const float a = mine ? rA[i] : oA, hh = mine ? rH[i] : oH; cin[i] = mine ? s : cin[i]; s = a * s + hh; At *= a; } }
    if (!FINAL) {
        if (lh == 0) { float* o = (float*)(p.ws + WS_AGG) + (size_t)(agg_dir_off + sc * 2048) * 2; o[0] = At; o[1] = s; }
        return;
    }
#pragma unroll
    for (int mb = 0; mb < 4; ++mb)
#pragma unroll
        for (int r = 0; r < 16; ++r) accI[mb][r] += accA[mb][r] * cin[mb * 4 + (r >> 2)];
}
template <bool FINAL>
__device__ __forceinline__ void lru_tile(const Params& p, LAS unsigned char* lds, int item) {
    const int tid = threadIdx.x, lane = tid & 63, wid = __builtin_amdgcn_readfirstlane(tid >> 6);
    int b, sc, head;
    if (FINAL) { head = item & 7; sc = 2 + ((item >> 3) & 31); b = item >> 8; }
    else { head = item & 7; const int r = item >> 3; sc = r & 1; b = r >> 1; }
    const bf16_t* src; int Tseq, t0, ld;
    if (sc < 2) { src = (const bf16_t*)(p.ws + WS_ZXC) + (size_t)b * 256 * 1024; Tseq = 256; t0 = sc * 128; ld = 1024; }
    else { src = (const bf16_t*)(p.ws + WS_RZ) + (size_t)b * 4096 * 4096; Tseq = 4096; t0 = (sc - 2) * 128; ld = 4096; }
    LAS unsigned char* ul = lds;
    LAS float* ybuf = (LAS float*)(lds + 36 * 1024);
    {
        const int c8 = tid & 15, tb = tid >> 4; const int ch0 = head * 128 + 8 * c8;
        float w[4][8], bias[8];
#pragma unroll
        for (int k = 0; k < 4; ++k) { const f32x4 a = *(const f32x4*)(p.conv_w + k * 1024 + ch0), c2 = *(const f32x4*)(p.conv_w + k * 1024 + ch0 + 4);
#pragma unroll
            for (int j = 0; j < 4; ++j) { w[k][j] = a[j]; w[k][4 + j] = c2[j]; } }
        { const f32x4 a = *(const f32x4*)(p.conv_b + ch0), c2 = *(const f32x4*)(p.conv_b + ch0 + 4);
#pragma unroll
            for (int j = 0; j < 4; ++j) { bias[j] = a[j]; bias[4 + j] = c2[j]; } }
#pragma unroll
        for (int i = 0; i < 4; ++i) { const int t = tb + 32 * i; float a[8];
#pragma unroll
            for (int j = 0; j < 8; ++j) a[j] = bias[j];
#pragma unroll
            for (int k = 0; k < 4; ++k) { const int tt = t0 + t + k - 2;
                if (tt >= 0 && tt < Tseq) { float f[8]; unpack8(*(const u32x4*)(src + (size_t)tt * ld + ch0), f);
#pragma unroll
                    for (int j = 0; j < 8; ++j) a[j] += w[k][j] * f[j]; } }
            u32x4 wv; wv.x = cvt_pk_bf16(a[0], a[1]); wv.y = cvt_pk_bf16(a[2], a[3]); wv.z = cvt_pk_bf16(a[4], a[5]); wv.w = cvt_pk_bf16(a[6], a[7]);
            *(LAS u32x4*)(ul + t * 272 + c8 * 16) = wv; }
    }
    __syncthreads();
    f32x16 hacc[4];
    if (wid < 4) lru_wave<FINAL, 0>(p, ul, b, sc, head, wid & 3, lane, hacc);
    else lru_wave<FINAL, 1>(p, ul, b, sc, head, wid & 3, lane, hacc);
    if (FINAL) {
        const int lr = lane & 31, lh = lane >> 5, chl = (wid & 3) * 32 + lr;
        if (wid >= 4) { LAS float* yp = ybuf + (127 - 4 * lh) * 129 + chl;
#pragma unroll
            for (int mb = 0; mb < 4; ++mb)
#pragma unroll
                for (int r = 0; r < 16; ++r) yp[-LRU_CST(mb, r) * 129] = hacc[mb][r]; }
        __syncthreads();
        if (wid < 4) {
            const LAS float* yp = ybuf + (4 * lh) * 129 + chl;
            const bf16_t* Zu = (const bf16_t*)(p.ws + WS_RZ) + ((size_t)(b * 4096 + t0) * 4096 + 1024 + head * 128);
            bf16_t* Ou = (bf16_t*)(p.ws + WS_R1) + ((size_t)(b * 4096 + t0) * 1024 + head * 128);
            const unsigned zo = (unsigned)(4 * lh * 4096 + chl), oo = (unsigned)(4 * lh * 1024 + chl);
#pragma unroll
            for (int mb = 0; mb < 4; ++mb) {
#pragma unroll
                for (int r = 0; r < 16; ++r) {
                    const float y = hacc[mb][r] + yp[LRU_CST(mb, r) * 129];
                    const float gz = bf2f(Zu[zo + LRU_CST(mb, r) * 4096]);
                    Ou[oo + LRU_CST(mb, r) * 1024] = (bf16_t)(cvt_pk_bf16(gz * y, 0.f) & 0xffffu);
                    if ((r & 7) == 7) __builtin_amdgcn_sched_barrier(0); } }
        }
    }
    __syncthreads();
}

#ifndef LRU_PF_FRAG
#define LRU_PF_FRAG true
#endif
#ifndef LRU_PF_TILE
#define LRU_PF_TILE true
#endif
typedef unsigned long long u64_t;
template <int DIR, bool PREF>
__device__ __forceinline__ void lru2_dir(const Params& p, LAS unsigned char* ul, int head, int w, int lane, const bf16x8 (&bA)[4], const bf16x8 (&bI)[4], bf16x8 (&nA)[4], bf16x8 (&nI)[4],
                                         f32x4 (&hl)[8], f32x4 (&pp)[8], float& Atot, float& Htot) {
    constexpr int SG = DIR ? -1 : 1;
    const int fr = lane & 15, fq = lane >> 4, chl = 16 * w + fr, ch = head * 128 + chl;
    f32x4 accA[8], accI[8];
    { const float ba2 = NLOG2E * p.lru_ba[DIR * 1024 + ch], bi2 = NLOG2E * p.lru_bi[DIR * 1024 + ch];
#pragma unroll
      for (int rb = 0; rb < 8; ++rb) { accA[rb] = (f32x4){ba2, ba2, ba2, ba2}; accI[rb] = (f32x4){bi2, bi2, bi2, bi2}; } }
    {
        LAS unsigned char* arow0 = ul + (DIR ? 127 - fr : fr) * 272 + fq * 16;
#pragma unroll
        for (int rb = 0; rb < 8; ++rb)
#pragma unroll
            for (int ks = 0; ks < 4; ++ks) { const bf16x8 af = *(const LAS bf16x8*)(arow0 + SG * 16 * rb * 272 + 64 * ks);
                accA[rb] = __builtin_amdgcn_mfma_f32_16x16x32_bf16(af, bA[ks], accA[rb], 0, 0, 0);
                accI[rb] = __builtin_amdgcn_mfma_f32_16x16x32_bf16(af, bI[ks], accI[rb], 0, 0, 0); }
    }
    if (PREF) {
        const bf16_t* wa = (const bf16_t*)(p.ws + WS_WAT) + ((size_t)((1 - DIR) * 8 + head) * 128 + chl) * 128 + 8 * fq;
        const bf16_t* wi = (const bf16_t*)(p.ws + WS_WIT) + ((size_t)((1 - DIR) * 8 + head) * 128 + chl) * 128 + 8 * fq;
#pragma unroll
        for (int ks = 0; ks < 4; ++ks) { nA[ks] = *(const bf16x8*)(wa + 32 * ks); nI[ks] = *(const bf16x8*)(wi + 32 * ks); }
    }
    {
        typedef float f32x2 __attribute__((ext_vector_type(2)));
        const float lam = p.lru_lambda[DIR * 1024 + ch]; const float k2 = NLOG2E * 8.0f * log1pf(expf(-lam));
        LAS unsigned char* up = ul + (DIR ? 127 - 4 * fq : 4 * fq) * 272 + chl * 2;
#pragma unroll
        for (int rb = 0; rb < 8; ++rb)
#pragma unroll
            for (int r = 0; r < 4; r += 2) {
                f32x2 uv; uv.x = bf2f(*(const LAS bf16_t*)(up + SG * (16 * rb + r) * 272)); uv.y = bf2f(*(const LAS bf16_t*)(up + SG * (16 * rb + r + 1) * 272));
                f32x2 ea, ei; ea.x = __builtin_amdgcn_exp2f(accA[rb][r]); ea.y = __builtin_amdgcn_exp2f(accA[rb][r + 1]); ei.x = __builtin_amdgcn_exp2f(accI[rb][r]); ei.y = __builtin_amdgcn_exp2f(accI[rb][r + 1]);
                const f32x2 da = ea + 1.0f, di = ei + 1.0f;
                f32x2 rg, ig; rg.x = __builtin_amdgcn_rcpf(da.x); rg.y = __builtin_amdgcn_rcpf(da.y); ig.x = __builtin_amdgcn_rcpf(di.x); ig.y = __builtin_amdgcn_rcpf(di.y);
                const f32x2 ka = rg * k2;
                f32x2 a; a.x = __builtin_amdgcn_exp2f(ka.x); a.y = __builtin_amdgcn_exp2f(ka.y);
                const f32x2 om = 1.0f - a * a;
                f32x2 sq; sq.x = __builtin_amdgcn_sqrtf(om.x); sq.y = __builtin_amdgcn_sqrtf(om.y);
                const f32x2 bb = sq * ig * uv;
                accA[rb][r] = a.x; accA[rb][r + 1] = a.y; accI[rb][r] = bb.x; accI[rb][r + 1] = bb.y; }
    }
    float rA[8], rH[8];
#pragma unroll
    for (int rb = 0; rb < 8; ++rb) { float pa = 1.f, hh = 0.f;
#pragma unroll
        for (int r = 0; r < 4; ++r) { const float a = accA[rb][r], bb = accI[rb][r]; hh = a * hh + bb; pa *= a; accA[rb][r] = pa; accI[rb][r] = hh; }
        rA[rb] = pa; rH[rb] = hh; }
    float Pc = 1.f, s = 0.f;
#pragma unroll
    for (int rb = 0; rb < 8; ++rb) { float Pin = 1.f, Hin = 0.f;
#pragma unroll
        for (int q = 0; q < 4; ++q) { const float a = __shfl(rA[rb], fr + 16 * q), hh = __shfl(rH[rb], fr + 16 * q);
            if (q == fq) { Pin = Pc; Hin = s; }
            s = a * s + hh; Pc *= a; }
#pragma unroll
        for (int r = 0; r < 4; ++r) { hl[rb][r] = accI[rb][r] + accA[rb][r] * Hin; pp[rb][r] = accA[rb][r] * Pin; }
        __builtin_amdgcn_sched_barrier(0); }
    Atot = Pc; Htot = s;
}
__device__ __forceinline__ u64_t agg_ld(const u64_t* a) { return __hip_atomic_load(a, __ATOMIC_RELAXED, __HIP_MEMORY_SCOPE_AGENT); }
template <int DIR>
__device__ __forceinline__ float lru2_carry(const u64_t* aggc, int n, int fr, int fq) {
    float Ap = 1.f, Hp = 0.f; u64_t v[9];
#pragma unroll
    for (int k = 0; k < 9; ++k) { const int j = fq * 9 + k; const int seq = DIR ? (j == 0 ? 1 : (j == 1 ? 0 : 35 - j)) : j;
        v[k] = (j < n) ? agg_ld(aggc + (size_t)seq * 2048) : 0x000000003f800000ull; }
#pragma unroll
    for (int k = 0; k < 9; ++k) { const float a = __uint_as_float((unsigned)v[k]), hh = __uint_as_float((unsigned)(v[k] >> 32)); Hp = a * Hp + hh; Ap *= a; }
    float s = 0.f;
#pragma unroll
    for (int q = 0; q < 4; ++q) { const float a = __shfl(Ap, fr + 16 * q), hh = __shfl(Hp, fr + 16 * q); s = a * s + hh; }
    return s;
}
__device__ __forceinline__ void lru2_block(const Params& p, LAS unsigned char* lds, int slot, int c, int ngr) {
    const int tid = threadIdx.x, lane = tid & 63, wid = __builtin_amdgcn_readfirstlane(tid >> 6);
    const int sc = c + 2, t0 = c * 128;
    LAS unsigned char* raw = lds;
    LAS unsigned char* ul = lds + 33792;
    LAS unsigned char* gzl = lds + 68608;
    LAS unsigned char* outl = lds + 103424;
    const int fr = lane & 15, fq = lane >> 4, chl = 16 * wid + fr;
    u32x4 nr[5], ng[4];
#define LRU2_LOAD(gg) do { const bf16_t* Zb_ = (const bf16_t*)(p.ws + WS_RZ) + (size_t)((gg) >> 3) * 4096 * 4096 + ((gg) & 7) * 128; \
        _Pragma("unroll") for (int k = 0; k < 5; ++k) { const int pc = tid + NTHR * k; nr[k] = (u32x4){0u, 0u, 0u, 0u}; \
            if (pc < 131 * 16) { const int row = pc >> 4, c8 = pc & 15, tt = t0 - 2 + row; if (tt >= 0 && tt < TT) nr[k] = *(const u32x4*)(Zb_ + (size_t)tt * 4096 + c8 * 8); } } \
        _Pragma("unroll") for (int k = 0; k < 4; ++k) { const int pc = tid + NTHR * k, row = pc >> 4, c8 = pc & 15; ng[k] = *(const u32x4*)(Zb_ + (size_t)(t0 + row) * 4096 + 1024 + c8 * 8); } } while (0)
    LRU2_LOAD(slot);
    for (int g = slot; g < NB * 8; g += ngr) {
        const int b = g >> 3, head = g & 7, ch = head * 128 + chl;
        unsigned* gcnt = (unsigned*)(p.ws + WS_BAR + 16 * KiB) + g * 64;
        bf16x8 bA1[4], bI1[4], bA0[4], bI0[4];
        { const bf16_t* wa = (const bf16_t*)(p.ws + WS_WAT) + ((size_t)(8 + head) * 128 + chl) * 128 + 8 * fq; const bf16_t* wi = (const bf16_t*)(p.ws + WS_WIT) + ((size_t)(8 + head) * 128 + chl) * 128 + 8 * fq;
#pragma unroll
          for (int ks = 0; ks < 4; ++ks) { bA1[ks] = *(const bf16x8*)(wa + 32 * ks); bI1[ks] = *(const bf16x8*)(wi + 32 * ks); } }
#pragma unroll
        for (int k = 0; k < 5; ++k) { const int pc = tid + NTHR * k; if (pc < 131 * 16) *(LAS u32x4*)(raw + (pc >> 4) * 256 + (pc & 15) * 16) = nr[k]; }
#pragma unroll
        for (int k = 0; k < 4; ++k) { const int pc = tid + NTHR * k; *(LAS u32x4*)(gzl + (pc >> 4) * 272 + (pc & 15) * 16) = ng[k]; }
        __syncthreads();
        {
            const int c8 = tid & 15, tb = tid >> 4; const int ch0 = head * 128 + 8 * c8;
            float w[4][8], bias[8];
#pragma unroll
            for (int k = 0; k < 4; ++k) { const f32x4 a = *(const f32x4*)(p.conv_w + k * 1024 + ch0), c2 = *(const f32x4*)(p.conv_w + k * 1024 + ch0 + 4);
#pragma unroll
                for (int j = 0; j < 4; ++j) { w[k][j] = a[j]; w[k][4 + j] = c2[j]; } }
            { const f32x4 a = *(const f32x4*)(p.conv_b + ch0), c2 = *(const f32x4*)(p.conv_b + ch0 + 4);
#pragma unroll
                for (int j = 0; j < 4; ++j) { bias[j] = a[j]; bias[4 + j] = c2[j]; } }
#pragma unroll
            for (int i = 0; i < 4; ++i) { const int t = tb + 32 * i; float a[8];
#pragma unroll
                for (int j = 0; j < 8; ++j) a[j] = bias[j];
#pragma unroll
                for (int k = 0; k < 4; ++k) { float f[8]; unpack8(*(const LAS u32x4*)(raw + (t + k) * 256 + c8 * 16), f);
#pragma unroll
                    for (int j = 0; j < 8; ++j) a[j] += w[k][j] * f[j]; }
                u32x4 wv; wv.x = cvt_pk_bf16(a[0], a[1]); wv.y = cvt_pk_bf16(a[2], a[3]); wv.z = cvt_pk_bf16(a[4], a[5]); wv.w = cvt_pk_bf16(a[6], a[7]);
                *(LAS u32x4*)(ul + t * 272 + c8 * 16) = wv; }
        }
        __syncthreads();
        float A0, H0, A1, H1;
        {
            f32x4 hl1[8], pp1[8];
            lru2_dir<1, LRU_PF_FRAG>(p, ul, head, wid, lane, bA1, bI1, bA0, bI0, hl1, pp1, A1, H1);
            LAS unsigned char* hp = outl + (127 - 4 * fq) * 272 + chl * 2; LAS unsigned char* qp = raw + (127 - 4 * fq) * 256 + chl * 2;
#pragma unroll
            for (int rb = 0; rb < 8; ++rb)
#pragma unroll
                for (int r = 0; r < 4; ++r) { *(LAS bf16_t*)(hp - (16 * rb + r) * 272) = (bf16_t)(cvt_pk_bf16(hl1[rb][r], 0.f) & 0xffffu); *(LAS bf16_t*)(qp - (16 * rb + r) * 256) = (bf16_t)(cvt_pk_bf16(pp1[rb][r], 0.f) & 0xffffu); }
        }
        __builtin_amdgcn_sched_barrier(0);
        if (!LRU_PF_FRAG) { const bf16_t* wa = (const bf16_t*)(p.ws + WS_WAT) + ((size_t)(head) * 128 + chl) * 128 + 8 * fq; const bf16_t* wi = (const bf16_t*)(p.ws + WS_WIT) + ((size_t)(head) * 128 + chl) * 128 + 8 * fq;
#pragma unroll
          for (int ks = 0; ks < 4; ++ks) { bA0[ks] = *(const bf16x8*)(wa + 32 * ks); bI0[ks] = *(const bf16x8*)(wi + 32 * ks); } }
        f32x4 hl0[8], pp0[8];
        lru2_dir<0, false>(p, ul, head, wid, lane, bA0, bI0, bA1, bI1, hl0, pp0, A0, H0);
        u64_t* agg = (u64_t*)(p.ws + WS_AGG);
        const size_t ai0 = ((size_t)(b * NSEQ) * 2 + 0) * 1024 + ch, ai1 = ((size_t)(b * NSEQ) * 2 + 1) * 1024 + ch;
        if (fq == 0) {
            __hip_atomic_store(agg + ai0 + (size_t)sc * 2048, ((u64_t)__float_as_uint(H0) << 32) | __float_as_uint(A0), __ATOMIC_RELAXED, __HIP_MEMORY_SCOPE_AGENT);
            __hip_atomic_store(agg + ai1 + (size_t)sc * 2048, ((u64_t)__float_as_uint(H1) << 32) | __float_as_uint(A1), __ATOMIC_RELAXED, __HIP_MEMORY_SCOPE_AGENT); }
        asm volatile("s_waitcnt vmcnt(0)" ::: "memory");
        __syncthreads();
        if (tid == 0) (void)__hip_atomic_fetch_add(gcnt, 1u, __ATOMIC_RELAXED, __HIP_MEMORY_SCOPE_AGENT);
        if (wid == 0) { unsigned sp = 0;
            while ((unsigned)__builtin_amdgcn_readfirstlane(__hip_atomic_load(gcnt, __ATOMIC_RELAXED, __HIP_MEMORY_SCOPE_AGENT)) < 32u) { __builtin_amdgcn_s_sleep(1); if (++sp > (1u << 22)) break; }
            __builtin_amdgcn_fence(__ATOMIC_ACQUIRE, "agent");
            asm volatile("s_waitcnt vmcnt(0)" ::: "memory"); }
        __syncthreads();
        const float C0 = lru2_carry<0>(agg + ai0, sc, fr, fq);
        const float C1 = lru2_carry<1>(agg + ai1, 2 + (NSEQ - 1 - sc), fr, fq);
        __builtin_amdgcn_sched_barrier(0);
        if (LRU_PF_TILE) { const int gn = (g + ngr < NB * 8) ? g + ngr : g; LRU2_LOAD(gn); }
        __builtin_amdgcn_sched_barrier(0);
        LAS unsigned char* gp = gzl + (4 * fq) * 272 + chl * 2; LAS unsigned char* op = outl + (4 * fq) * 272 + chl * 2; LAS unsigned char* qp0 = raw + (4 * fq) * 256 + chl * 2;
#pragma unroll
        for (int rb = 0; rb < 8; ++rb)
#pragma unroll
            for (int r = 0; r < 4; ++r) { const float h1 = bf2f(*(const LAS bf16_t*)(op + (16 * rb + r) * 272)) + bf2f(*(const LAS bf16_t*)(qp0 + (16 * rb + r) * 256)) * C1;
                const float y = hl0[rb][r] + pp0[rb][r] * C0 + h1;
                const float gz = bf2f(*(const LAS bf16_t*)(gp + (16 * rb + r) * 272));
                *(LAS bf16_t*)(op + (16 * rb + r) * 272) = (bf16_t)(cvt_pk_bf16(gz * y, 0.f) & 0xffffu); }
        __syncthreads();
        bf16_t* Ob = (bf16_t*)(p.ws + WS_R1) + ((size_t)(b * 4096 + t0)) * 1024 + head * 128;
#pragma unroll
        for (int k = 0; k < 4; ++k) { const int pc = tid + NTHR * k, row = pc >> 4, c8 = pc & 15;
            *(u32x4*)(Ob + (size_t)row * 1024 + c8 * 8) = *(const LAS u32x4*)(outl + row * 272 + c8 * 16); }
        __syncthreads();
        if (!LRU_PF_TILE && g + ngr < NB * 8) LRU2_LOAD(g + ngr);
    }
#undef LRU2_LOAD
}

__device__ __forceinline__ void fft_stage2_all(const Params& p, LAS unsigned char* lds) {
    const int tid = tid_opaque(), lane = tid & 63, wid = tid >> 6, fr = lane & 15, fq = lane >> 4;
    const bf16_t* Yt = (const bf16_t*)((const unsigned char*)p.out + OUT_YT); const bf16_t* D2 = (const bf16_t*)(p.ws + WS_D2T);
    bf16_t* Fo = (bf16_t*)((unsigned char*)p.out + OUT_F);
    const int G = gridDim.x;
    int it = blockIdx.x; bf16x8 dfr, yfr[4];
#define S2_LOAD(item) do { const int b_ = (item) & 7, k1_ = (item) >> 3; dfr = *(const bf16x8*)(D2 + (size_t)(k1_ + 256 * fr) * 32 + 8 * fq); \
        _Pragma("unroll") for (int n = 0; n < 4; ++n) yfr[n] = *(const bf16x8*)(Yt + (size_t)(k1_ * 2 + (fq >> 1)) * 65536 + (size_t)b_ * 8192 + (size_t)(16 * (4 * wid + n) + fr) * 16 + 8 * (fq & 1)); } while (0)
    if (it < NB * 256) S2_LOAD(it);
    for (; it < NB * 256; it += G) {
        const int b = it & 7, k1 = it >> 3;
        f32x4 acc[4];
#pragma unroll
        for (int n = 0; n < 4; ++n) acc[n] = __builtin_amdgcn_mfma_f32_16x16x32_bf16(yfr[n], dfr, (f32x4){0.f, 0.f, 0.f, 0.f}, 0, 0, 0);
        const int nx = it + G; if (nx < NB * 256) S2_LOAD(nx);
#pragma unroll
        for (int n = 0; n < 4; ++n) { u32x2 w; w.x = cvt_pk_bf16(acc[n][0], acc[n][1]); w.y = cvt_pk_bf16(acc[n][2], acc[n][3]);
            *(LAS u32x2*)(lds + fr * 1040 + (16 * (4 * wid + n) + 4 * fq) * 2) = w; }
        __syncthreads();
#pragma unroll
        for (int k = 0; k < 2; ++k) { const int pc = tid + NTHR * k, k2 = pc >> 6, c8 = pc & 63;
            *(u32x4*)(Fo + ((size_t)b * 4096 + k1 + 256 * k2) * 512 + c8 * 8) = *(const LAS u32x4*)(lds + k2 * 1040 + c8 * 16); }
        __syncthreads();
    }
#undef S2_LOAD
}

__device__ __forceinline__ void topk_task(const Params& p, LAS unsigned char* lds, int it) {
    const int tid = tid_opaque(), lane = tid & 63, wid = tid >> 6;
    LAS unsigned* cnt = (LAS unsigned*)lds;
    LAS unsigned* wsum = cnt + 64;
    const float* scores = (const float*)(p.ws + WS_SCORES);
    int* idx = (int*)(p.ws + WS_IDX); float* gate = (float*)(p.ws + WS_GATE); int* slot_of = (int*)(p.ws + WS_SLOT);
    const int b = it >> 4, e = it & 15;
    unsigned key[8];
    { const u32x4* sp = (const u32x4*)(scores + (size_t)it * 4096 + tid * 8); const u32x4 a = sp[0], c2 = sp[1]; key[0] = a.x; key[1] = a.y; key[2] = a.z; key[3] = a.w; key[4] = c2.x; key[5] = c2.y; key[6] = c2.z; key[7] = c2.w; }
    unsigned thr = 0;
    for (int step = 0; step < 16; ++step) {
        const int sh = 29 - 2 * step;
        const unsigned c1 = sh >= 0 ? (thr | (1u << sh)) : (thr | 1u), c2 = sh >= 0 ? (thr | (2u << sh)) : 0xffffffffu, c3 = sh >= 0 ? (thr | (3u << sh)) : 0xffffffffu;
        unsigned n1 = 0, n2 = 0, n3 = 0;
#pragma unroll
        for (int j = 0; j < 8; ++j) { n1 += (unsigned)__popcll(__ballot(key[j] >= c1)); n2 += (unsigned)__popcll(__ballot(key[j] >= c2)); n3 += (unsigned)__popcll(__ballot(key[j] >= c3)); }
        LAS unsigned* cb = cnt + (step & 1) * 32;
        if (lane == 0) { cb[wid] = n1; cb[8 + wid] = n2; cb[16 + wid] = n3; }
        __syncthreads();
        unsigned t1 = 0, t2 = 0, t3 = 0;
#pragma unroll
        for (int w = 0; w < 8; ++w) { t1 += cb[w]; t2 += cb[8 + w]; t3 += cb[16 + w]; }
        if (sh >= 0) thr = t3 >= (unsigned)CAP ? c3 : (t2 >= (unsigned)CAP ? c2 : (t1 >= (unsigned)CAP ? c1 : thr));
        else thr = t1 >= (unsigned)CAP ? c1 : thr;
    }
    unsigned cg_ = 0, ce = 0;
#pragma unroll
    for (int j = 0; j < 8; ++j) { cg_ += key[j] > thr; ce += key[j] == thr; }
    unsigned pk = cg_ | (ce << 16), incl = pk;
#pragma unroll
    for (int o = 1; o < 64; o <<= 1) { const unsigned n = __shfl_up(incl, o); if (lane >= o) incl += n; }
    if (lane == 63) wsum[wid] = incl;
    __syncthreads();
    unsigned base = 0, total = 0;
#pragma unroll
    for (int w = 0; w < 8; ++w) { const unsigned s2 = wsum[w]; if (w < wid) base += s2; total += s2; }
    const unsigned excl = base + incl - pk; unsigned og = excl & 0xffffu, oe = excl >> 16; const unsigned ngt = total & 0xffffu, krem = (unsigned)CAP - ngt;
    int mm[8];
#pragma unroll
    for (int j = 0; j < 8; ++j) { const int t = tid * 8 + j; int m = -1;
        if (key[j] > thr) { m = (e * 8 + b) * 512 + (int)og; ++og; }
        else if (key[j] == thr) { if (oe < krem) m = (e * 8 + b) * 512 + (int)(ngt + oe); ++oe; }
        mm[j] = m;
        if (m >= 0) { idx[m] = b * 4096 + t; gate[m] = __uint_as_float(key[j]); } }
    { u32x4* so = (u32x4*)(slot_of + (size_t)it * 4096 + tid * 8);
      so[0] = (u32x4){(unsigned)mm[0], (unsigned)mm[1], (unsigned)mm[2], (unsigned)mm[3]}; so[1] = (u32x4){(unsigned)mm[4], (unsigned)mm[5], (unsigned)mm[6], (unsigned)mm[7]}; }
    __syncthreads();
}

__device__ __forceinline__ void phase7_rows(const Params& p, LAS unsigned char* lds) {
    const int tid = threadIdx.x, lane = tid & 63, wid = tid >> 6;
    LAS float* wrt = (LAS float*)lds;
    for (int i = tid; i < 16 * 1024; i += NTHR) { const int d = i >> 4, e = i & 15; wrt[e * 1024 + d] = p.w_router[i]; }
    __syncthreads();
    const float* ada = (const float*)(p.ws + WS_ADA); bf16_t* h2 = (bf16_t*)(p.ws + WS_R1); float* scores = (float*)(p.ws + WS_SCORES);
    for (int row0 = (blockIdx.x * 8 + wid) * 2; row0 < MLAT; row0 += gridDim.x * 16) {
        const int b = row0 >> 12;
        f32x4 v[2][4]; float ss[2];
#pragma unroll
        for (int r = 0; r < 2; ++r)
#pragma unroll
            for (int i = 0; i < 4; ++i) v[r][i] = *(const f32x4*)(p.out + (size_t)(row0 + r) * 1024 + 256 * i + 4 * lane);
#pragma unroll
        for (int r = 0; r < 2; ++r) { float a = 0.f;
#pragma unroll
            for (int i = 0; i < 4; ++i) a += v[r][i][0] * v[r][i][0] + v[r][i][1] * v[r][i][1] + v[r][i][2] * v[r][i][2] + v[r][i][3] * v[r][i][3];
            ss[r] = a; }
#pragma unroll
        for (int o = 32; o >= 1; o >>= 1) { ss[0] += __shfl_xor(ss[0], o); ss[1] += __shfl_xor(ss[1], o); }
#pragma unroll
        for (int i = 0; i < 4; ++i) { const int d = 256 * i + 4 * lane;
            const f32x4 g = *(const f32x4*)(p.norm2_g + d), sh = *(const f32x4*)(ada + b * 6144 + 3072 + d), sc = *(const f32x4*)(ada + b * 6144 + 4096 + d);
#pragma unroll
            for (int r = 0; r < 2; ++r) { const float rs = rsqrtf(ss[r] * (1.0f / 1024.0f) + 1e-6f);
                v[r][i] = v[r][i] * rs * g * (sc + 1.0f) + sh;
                u32x2 w; w.x = cvt_pk_bf16(v[r][i][0], v[r][i][1]); w.y = cvt_pk_bf16(v[r][i][2], v[r][i][3]); *(u32x2*)(h2 + (size_t)(row0 + r) * 1024 + d) = w; } }
        float q[32];
#pragma unroll
        for (int e = 0; e < 16; ++e) { float a0 = 0.f, a1 = 0.f;
#pragma unroll
            for (int i = 0; i < 4; ++i) { const f32x4 w = *(const LAS f32x4*)(wrt + e * 1024 + 256 * i + 4 * lane);
                a0 += v[0][i][0] * w[0] + v[0][i][1] * w[1] + v[0][i][2] * w[2] + v[0][i][3] * w[3];
                a1 += v[1][i][0] * w[0] + v[1][i][1] * w[1] + v[1][i][2] * w[2] + v[1][i][3] * w[3]; }
            q[e] = a0; q[16 + e] = a1; }
#pragma unroll
        for (int j = 0; j < 16; ++j) { const bool up = (lane & 32) != 0; const float send = up ? q[j] : q[16 + j], keep = up ? q[16 + j] : q[j]; q[j] = keep + __shfl_xor(send, 32); }
#pragma unroll
        for (int j = 0; j < 8; ++j) { const bool up = (lane & 16) != 0; const float send = up ? q[j] : q[8 + j], keep = up ? q[8 + j] : q[j]; q[j] = keep + __shfl_xor(send, 16); }
#pragma unroll
        for (int j = 0; j < 4; ++j) { const bool up = (lane & 8) != 0; const float send = up ? q[j] : q[4 + j], keep = up ? q[4 + j] : q[j]; q[j] = keep + __shfl_xor(send, 8); }
#pragma unroll
        for (int j = 0; j < 2; ++j) { const bool up = (lane & 4) != 0; const float send = up ? q[j] : q[2 + j], keep = up ? q[2 + j] : q[j]; q[j] = keep + __shfl_xor(send, 4); }
        { const bool up = (lane & 2) != 0; const float send = up ? q[0] : q[1], keep = up ? q[1] : q[0]; q[0] = keep + __shfl_xor(send, 2); }
        float lg = q[0] + __shfl_xor(q[0], 1);
        float mx = lg;
#pragma unroll
        for (int o = 2; o <= 16; o <<= 1) mx = fmaxf(mx, __shfl_xor(mx, o));
        const float ex = expf(lg - mx); float sum = ex;
#pragma unroll
        for (int o = 2; o <= 16; o <<= 1) sum += __shfl_xor(sum, o);
        if (gridDim.x == 256) {
            LAS float* scl = (LAS float*)(lds + 64 * 1024);
            if ((lane & 1) == 0) scl[((lane >> 1) & 15) * 16 + wid * 2 + (lane >> 5)] = ex / sum;
            __syncthreads();
            if (tid < 128) { const int e = tid >> 3, q = tid & 7; const u64_t v2 = *(const LAS u64_t*)(scl + e * 16 + 2 * q);
                __hip_atomic_store((u64_t*)(scores + ((size_t)b * 16 + e) * 4096 + ((row0 - 2 * wid) & 4095) + 2 * q), v2, __ATOMIC_RELAXED, __HIP_MEMORY_SCOPE_AGENT); }
            asm volatile("s_waitcnt vmcnt(0)" ::: "memory");
            __syncthreads();
            if (tid == 0) (void)__hip_atomic_fetch_add((unsigned*)(p.ws + WS_BAR + 44 * KiB) + b * 64, 1u, __ATOMIC_RELAXED, __HIP_MEMORY_SCOPE_AGENT);
        } else if ((lane & 1) == 0) scores[((size_t)b * 16 + ((lane >> 1) & 15)) * 4096 + ((row0 + (lane >> 5)) & 4095)] = ex / sum;
    }
    __syncthreads();
}
__device__ __forceinline__ void phase7_topk(const Params& p, LAS unsigned char* lds) {
    const int bid = blockIdx.x; if (bid >= NB * NE) return;
    unsigned* c = (unsigned*)(p.ws + WS_BAR + 44 * KiB) + (bid >> 4) * 64;
    if (threadIdx.x < 64) { unsigned sp = 0;
        while ((unsigned)__builtin_amdgcn_readfirstlane(__hip_atomic_load(c, __ATOMIC_RELAXED, __HIP_MEMORY_SCOPE_AGENT)) < 256u) { __builtin_amdgcn_s_sleep(1); if (++sp > (1u << 22)) break; }
        __builtin_amdgcn_fence(__ATOMIC_ACQUIRE, "agent");
        asm volatile("s_waitcnt vmcnt(0)" ::: "memory"); }
    __syncthreads();
    topk_task(p, lds, bid);
}
__device__ __forceinline__ void phase7_weights(const Params& p) {
    constexpr int N_G = 16 * 16 * 6, N_D = 16 * 24 * 4;
    const bool fused = gridDim.x == 256;
    for (int j = 0; ; ++j) {
        int it;
        if (!fused) it = blockIdx.x + j * gridDim.x;
        else if (blockIdx.x >= 128) it = j < 4 ? (blockIdx.x - 128) + 128 * j : 512 + blockIdx.x + (j - 4) * 256;
        else it = 512 + blockIdx.x + j * 256;
        if (it >= 2 * N_G + N_D) break;
        if (it < 2 * N_G) { const int up = it >= N_G, j = up ? it - N_G : it, e = j / 96, r = j % 96, kb = r / 6, nb = r % 6;
            xpose_item<4>((up ? p.w_up_e : p.w_gate_e) + (size_t)e * 1024 * 1536, 1536, (bf16_t*)(p.ws + WS_WGU) + (size_t)e * 3072 * 1024, 1024, kb * 64, nb * 256, up ? 2 : 1); }
        else { const int j = it - 2 * N_G, e = j / 96, r = j % 96, kb = r >> 2, nb = r & 3;
            xpose_item<4>(p.w_down_e + (size_t)e * 1536 * 1024, 1024, (bf16_t*)(p.ws + WS_WD) + (size_t)e * 1024 * 1536, 1536, kb * 64, nb * 256, 0); }
    }
}

__device__ __forceinline__ void phase11(const Params& p, float* dst) {
    const int tid = tid_opaque(), lane = tid & 63, wid = tid >> 6;
    const float* ada = (const float*)(p.ws + WS_ADA); const int* slot_of = (const int*)(p.ws + WS_SLOT); const bf16_t* oute = (const bf16_t*)(p.ws + WS_OUTE);
    const int stride = gridDim.x * 16;
    int row0 = (blockIdx.x * 8 + wid) * 2;
    int myslot = row0 < MLAT ? slot_of[((size_t)(row0 >> 12) * 16 + (lane & 15)) * 4096 + ((row0 & 4095) + ((lane >> 4) & 1))] : -1;
    for (; row0 < MLAT; row0 += stride) {
        const int b = row0 >> 12;
        const int nrow = row0 + stride; const int nslot = nrow < MLAT ? slot_of[((size_t)(nrow >> 12) * 16 + (lane & 15)) * 4096 + ((nrow & 4095) + ((lane >> 4) & 1))] : -1;
        f32x4 xv[2][4], acc[2][4];
#pragma unroll
        for (int r = 0; r < 2; ++r)
#pragma unroll
            for (int i = 0; i < 4; ++i) { xv[r][i] = *(const f32x4*)(p.out + (size_t)(row0 + r) * 1024 + 256 * i + 4 * lane); acc[r][i] = (f32x4){0.f, 0.f, 0.f, 0.f}; }
        const unsigned long long bal = __ballot(myslot >= 0);
        unsigned mask0 = (unsigned)(bal & 0xffffull), mask1 = (unsigned)((bal >> 16) & 0xffffull);
        while (mask0 | mask1) {
            int m[2][2];
#pragma unroll
            for (int j = 0; j < 2; ++j) { if (mask0) { const int e = __builtin_ctz(mask0); mask0 &= mask0 - 1; m[0][j] = __builtin_amdgcn_readlane(myslot, e); } else m[0][j] = MMOE;
                                          if (mask1) { const int e = __builtin_ctz(mask1); mask1 &= mask1 - 1; m[1][j] = __builtin_amdgcn_readlane(myslot, 16 + e); } else m[1][j] = MMOE; }
            u32x2 w[2][2][4];
#pragma unroll
            for (int r = 0; r < 2; ++r)
#pragma unroll
                for (int j = 0; j < 2; ++j)
#pragma unroll
                    for (int i = 0; i < 4; ++i) w[r][j][i] = *(const u32x2*)(oute + (size_t)m[r][j] * 1024 + 256 * i + 4 * lane);
#pragma unroll
            for (int r = 0; r < 2; ++r)
#pragma unroll
                for (int j = 0; j < 2; ++j)
#pragma unroll
                    for (int i = 0; i < 4; ++i) { acc[r][i][0] += bf_lo(w[r][j][i].x); acc[r][i][1] += bf_hi(w[r][j][i].x); acc[r][i][2] += bf_lo(w[r][j][i].y); acc[r][i][3] += bf_hi(w[r][j][i].y); }
        }
        float ss[2];
#pragma unroll
        for (int r = 0; r < 2; ++r) { float a = 0.f;
#pragma unroll
            for (int i = 0; i < 4; ++i) { const int d = 256 * i + 4 * lane; const f32x4 g2 = *(const f32x4*)(ada + b * 6144 + 5120 + d); xv[r][i] += g2 * acc[r][i];
                a += xv[r][i][0] * xv[r][i][0] + xv[r][i][1] * xv[r][i][1] + xv[r][i][2] * xv[r][i][2] + xv[r][i][3] * xv[r][i][3]; }
            ss[r] = a; }
#pragma unroll
        for (int o = 32; o >= 1; o >>= 1) { ss[0] += __shfl_xor(ss[0], o); ss[1] += __shfl_xor(ss[1], o); }
#pragma unroll
        for (int r = 0; r < 2; ++r) { const float rs = rsqrtf(ss[r] * (1.0f / 1024.0f) + 1e-6f);
#pragma unroll
            for (int i = 0; i < 4; ++i) { const int d = 256 * i + 4 * lane; *(f32x4*)(dst + (size_t)(row0 + r) * 1024 + d) = xv[r][i] * rs * *(const f32x4*)(p.final_g + d); } }
        myslot = nslot;
    }
}

#define XB_TMO      128
#define XB_XCNT(j)  (256  + 64 * (j))
#define XB_XSUB(j)  (1280 + 64 * (j))
#define XB_XGEN(j)  (2304 + 64 * (j))
#define XB_TOP      3328
#define XB_TOPGEN   3392
#define XCD_BAR_WORDS 3456
#define XB_SPIN_CAP (1u << 22)
__device__ __forceinline__ unsigned xb_ld(unsigned* p)              { return __hip_atomic_load(p, __ATOMIC_RELAXED, __HIP_MEMORY_SCOPE_AGENT); }
__device__ __forceinline__ unsigned xb_add(unsigned* p, unsigned v) { return __hip_atomic_fetch_add(p, v, __ATOMIC_RELAXED, __HIP_MEMORY_SCOPE_AGENT); }
__device__ __forceinline__ unsigned xb_xcc_id() { return (unsigned)__builtin_amdgcn_s_getreg((3 << 11) | 20) & 0xFu; }
#define XB_SPIN(cond, bar) do { unsigned _sp = 0; while (cond) { __builtin_amdgcn_s_sleep(1); \
    if ((++_sp & 255u) == 0u) { if (xb_ld(&(bar)[XB_TMO])) break; if (_sp > XB_SPIN_CAP) { atomicAdd(&(bar)[XB_TMO], 1u); break; } } } } while (0)
struct XcdBarrier { unsigned* bar; unsigned x; volatile LAS unsigned* st; };
__device__ __forceinline__ XcdBarrier xcd_barrier_post(unsigned* bar, volatile LAS unsigned* st) {
    XcdBarrier b; b.bar = bar; b.x = xb_xcc_id(); b.st = st;
    if (threadIdx.x == 0) (void)xb_add(&bar[XB_XCNT(b.x)], 1u);
    return b;
}
__device__ __forceinline__ void xcd_barrier_complete(unsigned* bar, unsigned x, unsigned& nloc, unsigned& nx) {
    const unsigned G = gridDim.x * gridDim.y * gridDim.z;
    unsigned sum, cnt, mine, sp = 0u;
    for (;;) {
        sum = 0u; cnt = 0u; mine = 0u;
#pragma unroll
        for (unsigned j = 0; j < 16; ++j) { const unsigned c = xb_ld(&bar[XB_XCNT(j)]); sum += c; cnt += (c > 0u) ? 1u : 0u; mine = (j == x) ? c : mine; }
        if (sum == G) break;
        __builtin_amdgcn_s_sleep(1);
        if ((++sp & 255u) == 0u) { if (xb_ld(&bar[XB_TMO])) break; if (sp > XB_SPIN_CAP) { atomicAdd(&bar[XB_TMO], 1u); break; } }
    }
    nloc = mine > 0u ? mine : 1u; nx = cnt > 0u ? cnt : 1u;
}
__device__ __forceinline__ void xcd_barrier(const XcdBarrier& b) {
    asm volatile("s_waitcnt vmcnt(0)" ::: "memory");
    __syncthreads();
    if (threadIdx.x == 0) {
        unsigned* bar = b.bar;
        __builtin_amdgcn_s_waitcnt(0);
        unsigned nloc = b.st[0], nx = b.st[1];
        if (nloc == 0u) { xcd_barrier_complete(bar, b.x, nloc, nx); b.st[0] = nloc; b.st[1] = nx; }
        const unsigned old = xb_add(&bar[XB_XSUB(b.x)], 1u);
        const unsigned gen = old / nloc;
        if (old + 1u == (gen + 1u) * nloc) {
            __builtin_amdgcn_fence(__ATOMIC_RELEASE, "agent");
            asm volatile("s_waitcnt vmcnt(0)" ::: "memory");
            const unsigned og = xb_add(&bar[XB_TOP], 1u);
            const unsigned tg = og / nx;
            if (og + 1u == (tg + 1u) * nx) xb_add(&bar[XB_TOPGEN], 1u);
            else XB_SPIN(xb_ld(&bar[XB_TOPGEN]) == tg, bar);
            __builtin_amdgcn_fence(__ATOMIC_ACQUIRE, "agent");
            xb_add(&bar[XB_XGEN(b.x)], 1u);
            asm volatile("s_waitcnt vmcnt(0)" ::: "memory");
        } else {
            XB_SPIN(xb_ld(&bar[XB_XGEN(b.x)]) == gen, bar);
            __builtin_amdgcn_fence(__ATOMIC_ACQUIRE, "agent");
            asm volatile("s_waitcnt vmcnt(0)" ::: "memory");
        }
    }
    __syncthreads();
}

__global__ void __launch_bounds__(NTHR, 2) fwd_megakernel(Params p) {
    extern __shared__ __attribute__((aligned(16))) unsigned char lds_raw[];
    LAS unsigned char* lds = (LAS unsigned char*)lds_raw;
    cg::grid_group grid = cg::this_grid();
    const int G = gridDim.x, bid = blockIdx.x;
    unsigned char* ws = p.ws;
    bf16_t* const R1 = (bf16_t*)(ws + WS_R1); bf16_t* const Zb = (bf16_t*)(ws + WS_RZ); bf16_t* const PQt = (bf16_t*)(ws + WS_RPQ); bf16_t* const MRG = (bf16_t*)(ws + WS_R2);
    bf16_t* const Fb = (bf16_t*)((unsigned char*)p.out + OUT_F); bf16_t* const Ytb = (bf16_t*)((unsigned char*)p.out + OUT_YT);
#ifdef ONLY_PH
#define PH(k) ((k) == ONLY_PH && p.ph_lo <= (k) && (k) < p.ph_hi)
#else
#define PH(k) (p.ph_lo <= (k) && (k) < p.ph_hi)
#endif
    volatile LAS unsigned* xst = (volatile LAS unsigned*)(lds + LDS_BYTES - 16);
    if (threadIdx.x < 4) xst[threadIdx.x] = 0u;
    __syncthreads();
    XcdBarrier xbar = xcd_barrier_post((unsigned*)(ws + WS_BAR), xst);
    if (p.ph_lo < 0) grid.sync();
#ifdef TS_A
    unsigned long long* tsb = (unsigned long long*)(ws + WS_BAR + 40 * KiB);
#define STAMP(i) do { if (bid == 0 && threadIdx.x == 0) tsb[i] = __builtin_amdgcn_s_memrealtime(); } while (0)
#else
#define STAMP(i) do { } while (0)
#endif
    STAMP(0);
#define SYNC(k) do { if (PH(k) && PH((k) + 1)) xcd_barrier(xbar); STAMP((k) + 1); } while (0)
#ifndef REPMASK
#define REPMASK 0
#endif
#define REP(k) for (int rep_ = 0; rep_ <= ((REPMASK >> (k)) & 1); ++rep_)
    if (PH(0)) REP(0) phase0(p, lds);
    SYNC(0);
    if (PH(1)) REP(1) phase1(p);
    SYNC(1);
    if (PH(2)) REP(2) {
        { ProbPQ pr{(const bf16_t*)(ws + WS_WPQ), R1, 1024, 1024, 16384}; pg8::Order S; S.init(4, 128, G, bid); EpiPQ E{PQt}; pg8::gemm_phase(lds, pr, S, E); }
        { ProbPlain pr{R1, (const bf16_t*)(ws + WS_WIN), 1024, 1024, 1024}; pg8::Order S; S.init(128, 16, G, bid); EpiZ E{Zb, 4096, -1}; pg8::gemm_phase(lds, pr, S, E); }
        { ProbPlain pr{(const bf16_t*)(ws + WS_HCTX), (const bf16_t*)(ws + WS_WIN), 1024, 1024, 1024}; pg8::Order S; S.init(8, 4, G, bid); EpiZ E{(bf16_t*)(ws + WS_ZXC), 1024, 0}; pg8::gemm_phase(lds, pr, S, E); }
    }
    SYNC(2);
    if (PH(3)) REP(3) {
        {
            ProbPlain pr{(const bf16_t*)(ws + WS_D1T), PQt, 512, 512, 512}; pg8::Order S; S.init(2, 256, G, bid);
            if (G == 256) { if (bid >= 128) { S.G = 128; S.c = bid - 128; S.base = 0; S.lim = 3; } else { S.G = 128; S.c = bid; S.base = 384; S.lim = 1; } }
            EpiPlain E{Ytb, 65536}; pg8::gemm_phase(lds, pr, S, E); }
        for (int it = bid; it < NB * 2 * 8; it += G) lru_tile<false>(p, lds, it);
    }
    SYNC(3);
    if (PH(4)) {
        fft_stage2_all(p, lds);
        const int ngr = G >> 5;
        if (ngr > 0 && bid < ngr * 32) lru2_block(p, lds, bid % ngr, bid / ngr, ngr);
    }
    SYNC(4);
    if (PH(5)) REP(5) {
        { ProbMerge pr{Fb, (const bf16_t*)(ws + WS_WFOUR), R1, (const bf16_t*)(ws + WS_WLRU), 512, 1024, 512, 512, 1024, 1024}; pg8::Order S; S.init(128, 4, G, bid); EpiMerge E{MRG, Zb}; pg8::gemm_phase2(lds, pr, S, E); }
    }
    SYNC(5);
    if (PH(6)) REP(6) { ProbPlain pr{MRG, (const bf16_t*)(ws + WS_WOUT), 1024, 1024, 1024}; pg8::Order S; S.init(128, 4, G, bid);
        EpiOut E{p.out, p.x, (const float*)(ws + WS_POS), (const float*)(ws + WS_ADA)}; pg8::gemm_phase(lds, pr, S, E); }
    SYNC(6);
    if (PH(7)) { phase7_rows(p, lds); if (G == 256) phase7_topk(p, lds); phase7_weights(p); }
    SYNC(7);
    if (PH(8) && G != 256) { for (int it = bid; it < NB * NE; it += G) topk_task(p, lds, it); }
    if (G != 256) SYNC(8);
    if (PH(9)) REP(9) { ProbMoeUp pr{R1, (const bf16_t*)(ws + WS_WGU), (const int*)(ws + WS_IDX), 1024, 1024, 1024}; pg8::Order S; S.init(256, 12, G, bid); EpiGU E{(bf16_t*)(ws + WS_HID)}; pg8::gemm_phase(lds, pr, S, E); }
    SYNC(9);
    if (PH(10)) { if (bid == 0 && threadIdx.x < 128) *(u32x4*)(ws + WS_OUTE + (size_t)MMOE * 2048 + threadIdx.x * 16) = (u32x4){0u, 0u, 0u, 0u}; }
    if (PH(10)) REP(10) { ProbMoeDown pr{(const bf16_t*)(ws + WS_HID), (const bf16_t*)(ws + WS_WD), 1536, 1536, 1536}; pg8::Order S; S.init(256, 4, G, bid); EpiDown E{(bf16_t*)(ws + WS_OUTE), (const float*)(ws + WS_GATE)}; pg8::gemm_phase(lds, pr, S, E); }
    SYNC(10);
    if (PH(11)) phase11(p, p.out);
#ifdef TS_A
    xcd_barrier(xbar); STAMP(12);
    if (bid == 0 && threadIdx.x == 0) {

#ifndef TS_AE
#define TS_AE (TS_A + 1)
#endif
#ifndef TS_BE
#define TS_BE (TS_B + 1)
#endif
        const float ta = (float)(tsb[TS_AE] - tsb[TS_A]) * 0.01f * (float)(TS_SA), tb = (float)(tsb[TS_BE] - tsb[TS_B]) * 0.01f * (float)(TS_SB);
        p.out[7] = fminf(ta, 97.f); p.out[1024 * 5 + 9] = fminf(tb, 97.f); }
#endif
}

#ifndef N_LAUNCHES
#define N_LAUNCHES 1
#endif
#ifndef PROBE_DUP
#define PROBE_DUP 0x0
#endif
extern "C" void kernel_launch(void* const* d_in, const int* in_sizes, int n_in, void* d_out, int out_size, void* d_ws, size_t ws_size, hipStream_t stream) {
    static int grid = 0;
    if (grid == 0) {
        if (n_in != 24 || out_size != MLAT * DM || ws_size < WS_END) { fprintf(stderr, "kernel_launch: unexpected shapes (n_in %d out %d ws %zu)\n", n_in, out_size, ws_size); grid = -1; return; }
        int dev = 0, cus = 0, per_cu = 0;
        hipGetDevice(&dev); hipDeviceGetAttribute(&cus, hipDeviceAttributeMultiprocessorCount, dev);
        hipFuncSetAttribute((const void*)fwd_megakernel, hipFuncAttributeMaxDynamicSharedMemorySize, LDS_BYTES);
        hipOccupancyMaxActiveBlocksPerMultiprocessor(&per_cu, (const void*)fwd_megakernel, NTHR, LDS_BYTES);
        if (per_cu < 1) { fprintf(stderr, "kernel_launch: occupancy query reports %d blocks per CU\n", per_cu); per_cu = 1; }
        grid = cus * 1;
        (void)hipGetLastError();
    }
    if (grid < 0) return;
    Params p{};
    const float** f = (const float**)&p;
    for (int i = 0; i < 24; ++i) f[i] = (const float*)d_in[i];
    p.out = (float*)d_out; p.ws = (unsigned char*)d_ws;
    (void)hipMemsetAsync((unsigned char*)d_ws + WS_BAR, 0, 48 * KiB, stream);
#if N_LAUNCHES == 1
    p.ph_lo = 0; p.ph_hi = 12;
    void* args[] = {&p};
    hipError_t e = hipLaunchCooperativeKernel((const void*)fwd_megakernel, dim3(grid), dim3(NTHR), args, LDS_BYTES, stream);
    if (e != hipSuccess) fprintf(stderr, "cooperative launch failed: %s (grid %d)\n", hipGetErrorString(e), grid);
#else
    for (int k = 0; k < 12; ++k) for (int r = 0; r <= ((PROBE_DUP >> k) & 1); ++r) { p.ph_lo = k; p.ph_hi = k + 1; if (k == 11 && r == 0 && ((PROBE_DUP >> 11) & 1)) { p.ph_lo = 12; p.ph_hi = 13; } hipLaunchKernelGGL(fwd_megakernel, dim3(grid), dim3(NTHR), LDS_BYTES, stream, p); }
#endif
}
```

```cpp
#include <hip/hip_runtime.h>
#include <hip/hip_cooperative_groups.h>
#include <cstdio>
namespace cg = cooperative_groups;

#define LAS __attribute__((address_space(3)))
typedef unsigned short bf16_t;
typedef short bf16x8 __attribute__((ext_vector_type(8)));
typedef float f32x4 __attribute__((ext_vector_type(4)));
typedef float f32x16 __attribute__((ext_vector_type(16)));
typedef unsigned u32x4 __attribute__((ext_vector_type(4)));
typedef unsigned u32x2 __attribute__((ext_vector_type(2)));

constexpr int NB = 8, TT = 4096, DM = 1024, CTXL = 256, MLAT = NB * TT, MCTX = NB * CTXL;
constexpr int NE = 16, CAP = 512, DE = 1536, MMOE = NE * NB * CAP;
constexpr int NSEQ = 34;
constexpr int NTHR = 512;
constexpr float NLOG2E = -1.4426950408889634f;
constexpr int LDS_BYTES = 144 * 1024;

constexpr size_t KiB = 1024, MiB = 1024 * 1024;
constexpr size_t WS_ADA = 0;
constexpr size_t WS_POS = 256 * KiB;
constexpr size_t WS_AGG = 512 * KiB;
constexpr size_t WS_WPQ = 5 * MiB;
constexpr size_t WS_WIN = 7 * MiB;
constexpr size_t WS_WFOUR = 15 * MiB;
constexpr size_t WS_WLRU = 16 * MiB;
constexpr size_t WS_WOUT = 18 * MiB;
constexpr size_t WS_WAT = 20 * MiB;
constexpr size_t WS_WIT = 20 * MiB + 512 * KiB;
constexpr size_t WS_SCORES = 21 * MiB;
constexpr size_t WS_IDX = 23 * MiB;
constexpr size_t WS_GATE = 23 * MiB + 256 * KiB;
constexpr size_t WS_SLOT = 23 * MiB + 512 * KiB;
constexpr size_t WS_BAR = 25 * MiB + 512 * KiB;
constexpr size_t WS_D1T = 34 * MiB;
constexpr size_t WS_D2T = 34 * MiB + 512 * KiB;
constexpr size_t WS_HCTX = 26 * MiB;
constexpr size_t WS_ZXC = 30 * MiB;
constexpr size_t WS_R1 = 40 * MiB;
constexpr size_t WS_RPQ = 104 * MiB;
constexpr size_t WS_R2 = 168 * MiB;
constexpr size_t WS_RZ = 232 * MiB;
constexpr size_t WS_END = 504 * MiB;
constexpr size_t WS_X2B = WS_R1, WS_H2 = WS_RPQ, WS_WGU = 168 * MiB, WS_WD = 264 * MiB, WS_HID = 312 * MiB, WS_OUTE = WS_RPQ;
constexpr size_t OUT_YT = 0, OUT_F = 64 * MiB;

struct Params {
    const float *x, *c, *ctx, *c_ctx, *w_ada, *b_ada, *norm1_g, *norm2_g, *w_in, *w_four, *conv_w, *conv_b, *lru_lambda,
        *lru_wa, *lru_ba, *lru_wi, *lru_bi, *w_lru, *w_out, *w_router, *w_gate_e, *w_up_e, *w_down_e, *final_g;
    float* out; unsigned char* ws; int ph_lo, ph_hi;
};

__device__ __forceinline__ int tid_opaque() { int t = threadIdx.x; asm volatile("" : "+v"(t)); return t; }
__device__ __forceinline__ unsigned cvt_pk_bf16(float lo, float hi) { unsigned r; asm volatile("v_cvt_pk_bf16_f32 %0, %1, %2" : "=v"(r) : "v"(lo), "v"(hi)); return r; }
__device__ __forceinline__ float bf_lo(unsigned w) { return __uint_as_float(w << 16); }
__device__ __forceinline__ float bf_hi(unsigned w) { return __uint_as_float(w & 0xffff0000u); }
__device__ __forceinline__ float bf2f(bf16_t h) { return __uint_as_float(((unsigned)h) << 16); }
__device__ __forceinline__ float sigmoidf_(float v) { return __builtin_amdgcn_rcpf(1.0f + __expf(-v)); }
__device__ __forceinline__ float gelu_tanh(float v) { const float y = 1.5957691216f * (v + 0.044715f * v * v * v); return v * sigmoidf_(y); }
__device__ __forceinline__ float wave_sum(float v) {
#pragma unroll
    for (int o = 32; o >= 1; o >>= 1) v += __shfl_xor(v, o);
    return v;
}
__device__ __forceinline__ void unpack8(const u32x4 w, float (&f)[8]) { f[0] = bf_lo(w.x); f[1] = bf_hi(w.x); f[2] = bf_lo(w.y); f[3] = bf_hi(w.y); f[4] = bf_lo(w.z); f[5] = bf_hi(w.z); f[6] = bf_lo(w.w); f[7] = bf_hi(w.w); }

namespace pg8 {
constexpr int BM = 256, BK = 64, HALF = 128, HTB = HALF * BK * 2, STAGE_BYTES = 8 * HTB, NXCD = 8, WGM = 8;
__device__ __forceinline__ int lds_byte(int r, int c) { const int st = (r >> 4) * 2 + (c >> 5), rr = r & 15, cc = c & 31, ob = rr * 64 + cc * 2; return st * 1024 + (ob ^ (((ob >> 9) & 1) << 5)); }
__device__ __forceinline__ void stage_rc(int b, int& R, int& C) { const int st = b / 1024, sb = b % 1024, swz = sb ^ (((sb >> 9) & 1) << 5); R = (st >> 1) * 16 + swz / 64; C = (st & 1) * 32 + (swz % 64) / 2; }
__device__ __forceinline__ int perm32(int rho) { const int n = rho >> 4, i = rho & 15; return 8 * (i >> 2) + 4 * n + (i & 3); }
struct Unit { int pm, pn; };
struct Order {
    int nM, nN, nwg, G, c, base, lim;
    __device__ void init(int nM_, int nN_, int G_, int c_) { nM = nM_; nN = nN_; nwg = nM * nN; G = G_; c = c_; base = 0; lim = 0x7fffffff; }
    __device__ bool next(int i, Unit& u) const {
        const long L = (long)base + (long)i * G + c; if (i >= lim || L >= nwg) return false;
        int wgid = (int)L; { const int q = nwg / NXCD, r = nwg % NXCD, xcd = wgid % NXCD, off = wgid / NXCD; wgid = (xcd < r ? xcd * (q + 1) : r * (q + 1) + (xcd - r) * q) + off; }
        const int nig = WGM * nN, gid = wgid / nig, fm = gid * WGM, gsz = (nM - fm) < WGM ? (nM - fm) : WGM;
        u.pm = fm + ((wgid % nig) % gsz); u.pn = (wgid % nig) / gsz; return true;
    }
};
template <class P, class Epi>
__device__ __forceinline__ void gemm_phase(LAS unsigned char* lds, const P& pr, const Order& S, const Epi& E) {
    const int tid = tid_opaque(), wid = __builtin_amdgcn_readfirstlane(tid >> 6), lane = tid & 63, wr = wid >> 2, wc = wid & 3, fr = lane & 15, fq = lane >> 4;
    const int nt = pr.K / BK;
    int RA[2], CA[2]; unsigned voffB[2];
#pragma unroll
    for (int i = 0; i < 2; ++i) { int R, C; stage_rc(tid * 16 + i * 8192, R, C); RA[i] = R; CA[i] = C; const int Rb = Epi::PERM ? ((R & ~31) + perm32(R & 31)) : R; voffB[i] = (unsigned)(Rb * pr.ldb + C) * 2u; }
    const size_t kstep = (size_t)(BK * 2);
    const size_t hstepB = (size_t)HALF * pr.ldb * 2;
    const unsigned ldsw = (unsigned)wid * 1024u;
    const int aoff = lds_byte(wr * 64 + fr, fq * 8), boff = lds_byte(wc * 32 + fr, fq * 8);
#define PG8_SA(b, h) (((b) * 2 + (h)) * HTB)
#define PG8_SB(b, h) ((4 + (b) * 2 + (h)) * HTB)
#define PG8_STAGE(bufoff, gbase, voff) do { _Pragma("unroll") for (int _i = 0; _i < 2; ++_i) \
        __builtin_amdgcn_global_load_lds((const unsigned*)((const char*)(gbase) + (voff)[_i]), (LAS unsigned*)(lds + (bufoff) + ldsw + _i * 8192), 16, 0, 0); } while (0)
#define PG8_LDA(dst, b, h) do { _Pragma("unroll") for (int m = 0; m < 4; ++m) _Pragma("unroll") for (int k = 0; k < 2; ++k) dst[m][k] = *(const LAS bf16x8*)(lds + PG8_SA(b, h) + aoff + m * 2048 + k * 1024); } while (0)
#define PG8_LDB(dst, b, h) do { _Pragma("unroll") for (int n = 0; n < 2; ++n) _Pragma("unroll") for (int k = 0; k < 2; ++k) dst[n][k] = *(const LAS bf16x8*)(lds + PG8_SB(b, h) + boff + n * 2048 + k * 1024); } while (0)
#define PG8_MMA(ai, bj, At, Bt) do { __builtin_amdgcn_s_setprio(1); _Pragma("unroll") for (int m = 0; m < 4; ++m) _Pragma("unroll") for (int n = 0; n < 2; ++n) _Pragma("unroll") for (int k = 0; k < 2; ++k) \
        acc[ai][bj][m][n] = __builtin_amdgcn_mfma_f32_16x16x32_bf16(Bt[n][k], At[m][k], acc[ai][bj][m][n], 0, 0, 0); __builtin_amdgcn_s_setprio(0); } while (0)
#define PG8_WAIT_V(n) asm volatile("s_waitcnt vmcnt(" #n ")" ::: "memory")
#define PG8_WAIT_L(n) asm volatile("s_waitcnt lgkmcnt(" #n ")" ::: "memory")
#define PG8_BAR __builtin_amdgcn_s_barrier()
#define PG8_SCHED __builtin_amdgcn_sched_barrier(0)
    Unit cur, nxt; int ui = 0;
    if (!S.next(0, cur)) return;
    f32x4 acc[2][2][4][2];
#pragma unroll
    for (int a = 0; a < 2; ++a)
#pragma unroll
        for (int b = 0; b < 2; ++b)
#pragma unroll
            for (int m = 0; m < 4; ++m)
#pragma unroll
                for (int n = 0; n < 2; ++n) acc[a][b][m][n] = (f32x4){0.f, 0.f, 0.f, 0.f};
    bf16x8 At[4][2], B0[2][2], B1[2][2];
    unsigned vA[2][2], vN[2][2];
    pr.avoff(cur, RA, CA, vA);
#pragma unroll
    for (int h = 0; h < 2; ++h)
#pragma unroll
        for (int i = 0; i < 2; ++i) vN[h][i] = vA[h][i];
    const char* cA = pr.abase(cur); const char* cB = pr.bbase(cur);
#define PG8_ROT(u) 0
#define PG8_KT(tt, rot) ((size_t)(((tt) + (rot)) >= nt ? ((tt) + (rot)) - nt : ((tt) + (rot))) * kstep)
    int rot = PG8_ROT(cur);
    { const char* pA = cA + PG8_KT(0, rot); const char* pB = cB + PG8_KT(0, rot);
    PG8_STAGE(PG8_SB(0, 0), pB, voffB); PG8_STAGE(PG8_SA(0, 0), pA, vA[0]); PG8_STAGE(PG8_SB(0, 1), pB + hstepB, voffB); PG8_STAGE(PG8_SA(0, 1), pA, vA[1]);
    if (wr == 1) PG8_BAR;
    PG8_WAIT_V(4); PG8_BAR;
    PG8_STAGE(PG8_SB(1, 0), pB + kstep, voffB); PG8_STAGE(PG8_SA(1, 0), pA + kstep, vA[0]); PG8_STAGE(PG8_SB(1, 1), pB + hstepB + kstep, voffB); }
    PG8_WAIT_V(6); PG8_BAR;
    for (;;) {
        const bool has_next = S.next(ui + 1, nxt);
        const char* nA = has_next ? pr.abase(nxt) : cA; const char* nB = has_next ? pr.bbase(nxt) : cB; const int nrot = has_next ? PG8_ROT(nxt) : rot;
        if (P::GATHER) { if (has_next) pr.avoff(nxt, RA, CA, vN); }
        for (int t = 0; t < nt; t += 2) {
            const bool last = (t == nt - 2);
            const char* a1 = cA + PG8_KT(t + 1, rot);
            const char* a2 = last ? nA + PG8_KT(0, nrot) : cA + PG8_KT(t + 2, rot); const char* b2 = last ? nB + PG8_KT(0, nrot) : cB + PG8_KT(t + 2, rot);
            const char* a3 = a2 + kstep; const char* b3 = b2 + kstep;
            unsigned v2[2][2];
#pragma unroll
            for (int h = 0; h < 2; ++h)
#pragma unroll
                for (int i = 0; i < 2; ++i) v2[h][i] = (P::GATHER && last) ? vN[h][i] : vA[h][i];
            PG8_LDB(B0, 0, 0); PG8_SCHED; PG8_LDA(At, 0, 0); PG8_STAGE(PG8_SA(1, 1), a1, vA[1]);
            PG8_WAIT_L(8); PG8_BAR; PG8_WAIT_L(0); PG8_MMA(0, 0, At, B0); PG8_BAR; PG8_SCHED;
            PG8_LDB(B1, 0, 1); PG8_STAGE(PG8_SB(0, 0), b2, voffB);
            PG8_BAR; PG8_WAIT_L(0); PG8_MMA(0, 1, At, B1); PG8_BAR;
            PG8_LDA(At, 0, 1); PG8_STAGE(PG8_SA(0, 0), a2, v2[0]);
            PG8_BAR; PG8_WAIT_L(0); PG8_MMA(1, 0, At, B0); PG8_BAR; PG8_SCHED;
            PG8_STAGE(PG8_SB(0, 1), b2 + hstepB, voffB);
            PG8_WAIT_V(6); PG8_BAR; PG8_MMA(1, 1, At, B1); PG8_BAR;
            PG8_LDB(B0, 1, 0); PG8_SCHED; PG8_LDA(At, 1, 0); PG8_STAGE(PG8_SA(0, 1), a2, v2[1]);
            PG8_WAIT_L(8); PG8_BAR; PG8_WAIT_L(0); PG8_MMA(0, 0, At, B0); PG8_BAR; PG8_SCHED;
            PG8_LDB(B1, 1, 1); PG8_STAGE(PG8_SB(1, 0), b3, voffB);
            PG8_BAR; PG8_WAIT_L(0); PG8_MMA(0, 1, At, B1); PG8_BAR;
            PG8_LDA(At, 1, 1); PG8_STAGE(PG8_SA(1, 0), a3, v2[0]);
            PG8_BAR; PG8_WAIT_L(0); PG8_MMA(1, 0, At, B0); PG8_BAR; PG8_SCHED;
            PG8_STAGE(PG8_SB(1, 1), b3 + hstepB, voffB);
            PG8_WAIT_V(6); PG8_BAR; PG8_MMA(1, 1, At, B1); PG8_BAR;
            if (P::GATHER && last) {
#pragma unroll
                for (int h = 0; h < 2; ++h)
#pragma unroll
                    for (int i = 0; i < 2; ++i) vA[h][i] = vN[h][i];
            }
        }
        E(acc, cur, wr, wc, fr, fq);
        if (!has_next) break;
#pragma unroll
        for (int a = 0; a < 2; ++a)
#pragma unroll
            for (int b = 0; b < 2; ++b)
#pragma unroll
                for (int m = 0; m < 4; ++m)
#pragma unroll
                    for (int n = 0; n < 2; ++n) acc[a][b][m][n] = (f32x4){0.f, 0.f, 0.f, 0.f};
        cur = nxt; cA = nA; cB = nB; rot = nrot; ++ui;
    }
    PG8_WAIT_V(0);
    if (wr == 0) PG8_BAR;
    PG8_BAR;
#undef PG8_ROT
#undef PG8_KT
#undef PG8_SA
#undef PG8_SB
#undef PG8_STAGE
#undef PG8_LDA
#undef PG8_LDB
#undef PG8_MMA
#undef PG8_WAIT_V
#undef PG8_WAIT_L
#undef PG8_BAR
#undef PG8_SCHED
}
template <class P, class Epi>
__device__ __forceinline__ void gemm_phase2(LAS unsigned char* lds, const P& pr, const Order& S, const Epi& E) {
    const int tid = tid_opaque(), wid = __builtin_amdgcn_readfirstlane(tid >> 6), lane = tid & 63, wr = wid >> 2, wc = wid & 3, fr = lane & 15, fq = lane >> 4;
    const int nt1 = pr.K1 / BK, nt = (pr.K1 + pr.K2) / BK;
    unsigned R2[2], Rb2[2], C2[2];
#pragma unroll
    for (int i = 0; i < 2; ++i) { int R, C; stage_rc(tid * 16 + i * 8192, R, C); const int Rb = Epi::PERM ? ((R & ~31) + perm32(R & 31)) : R; R2[i] = (unsigned)R * 2u; Rb2[i] = (unsigned)Rb * 2u; C2[i] = (unsigned)C * 2u; }
#define OFF_A(ld, h, i) ((R2[i] + (unsigned)((h) * 256)) * (unsigned)(ld) + C2[i])
#define OFF_B(ld, i) (Rb2[i] * (unsigned)(ld) + C2[i])
    const size_t kstep = (size_t)(BK * 2);
    const size_t hB1 = (size_t)HALF * pr.ldb1 * 2, hB2 = (size_t)HALF * pr.ldb2 * 2;
    const unsigned ldsw = (unsigned)wid * 1024u;
    const int aoff = lds_byte(wr * 64 + fr, fq * 8), boff = lds_byte(wc * 32 + fr, fq * 8);
#define PG8_SA(b, h) (((b) * 2 + (h)) * HTB)
#define PG8_SB(b, h) ((4 + (b) * 2 + (h)) * HTB)
#define PG8_STAGE(bufoff, gbase, voff) do { _Pragma("unroll") for (int _i = 0; _i < 2; ++_i) \
        __builtin_amdgcn_global_load_lds((const unsigned*)((const char*)(gbase) + (voff)[_i]), (LAS unsigned*)(lds + (bufoff) + ldsw + _i * 8192), 16, 0, 0); } while (0)
#define PG8_LDA(dst, b, h) do { _Pragma("unroll") for (int m = 0; m < 4; ++m) _Pragma("unroll") for (int k = 0; k < 2; ++k) dst[m][k] = *(const LAS bf16x8*)(lds + PG8_SA(b, h) + aoff + m * 2048 + k * 1024); } while (0)
#define PG8_LDB(dst, b, h) do { _Pragma("unroll") for (int n = 0; n < 2; ++n) _Pragma("unroll") for (int k = 0; k < 2; ++k) dst[n][k] = *(const LAS bf16x8*)(lds + PG8_SB(b, h) + boff + n * 2048 + k * 1024); } while (0)
#define PG8_MMA(ai, bj, At, Bt) do { __builtin_amdgcn_s_setprio(1); _Pragma("unroll") for (int m = 0; m < 4; ++m) _Pragma("unroll") for (int n = 0; n < 2; ++n) _Pragma("unroll") for (int k = 0; k < 2; ++k) \
        acc[ai][bj][m][n] = __builtin_amdgcn_mfma_f32_16x16x32_bf16(Bt[n][k], At[m][k], acc[ai][bj][m][n], 0, 0, 0); __builtin_amdgcn_s_setprio(0); } while (0)
#define PG8_WAIT_V(n) asm volatile("s_waitcnt vmcnt(" #n ")" ::: "memory")
#define PG8_WAIT_L(n) asm volatile("s_waitcnt lgkmcnt(" #n ")" ::: "memory")
#define PG8_BAR __builtin_amdgcn_s_barrier()
#define PG8_SCHED __builtin_amdgcn_sched_barrier(0)
    Unit cur, nxt; int ui = 0;
    if (!S.next(0, cur)) return;
    f32x4 acc[2][2][4][2];
#pragma unroll
    for (int a = 0; a < 2; ++a)
#pragma unroll
        for (int b = 0; b < 2; ++b)
#pragma unroll
            for (int m = 0; m < 4; ++m)
#pragma unroll
                for (int n = 0; n < 2; ++n) acc[a][b][m][n] = (f32x4){0.f, 0.f, 0.f, 0.f};
    bf16x8 At[4][2], B0[2][2], B1[2][2];
    const char* cA1 = pr.abase1(cur); const char* cB1 = pr.bbase1(cur); const char* cA2 = pr.abase2(cur); const char* cB2 = pr.bbase2(cur);
#define T_A(tt) ((tt) < nt1 ? cA1 + (size_t)(tt) * kstep : cA2 + (size_t)((tt) - nt1) * kstep)
#define T_B(tt) ((tt) < nt1 ? cB1 + (size_t)(tt) * kstep : cB2 + (size_t)((tt) - nt1) * kstep)
    { unsigned vb[2] = {OFF_B(pr.ldb1, 0), OFF_B(pr.ldb1, 1)}, va0[2] = {OFF_A(pr.lda1, 0, 0), OFF_A(pr.lda1, 0, 1)}, va1[2] = {OFF_A(pr.lda1, 1, 0), OFF_A(pr.lda1, 1, 1)};
    PG8_STAGE(PG8_SB(0, 0), cB1, vb); PG8_STAGE(PG8_SA(0, 0), cA1, va0); PG8_STAGE(PG8_SB(0, 1), cB1 + hB1, vb); PG8_STAGE(PG8_SA(0, 1), cA1, va1);
    if (wr == 1) PG8_BAR;
    PG8_WAIT_V(4); PG8_BAR;
    PG8_STAGE(PG8_SB(1, 0), cB1 + kstep, vb); PG8_STAGE(PG8_SA(1, 0), cA1 + kstep, va0); PG8_STAGE(PG8_SB(1, 1), cB1 + hB1 + kstep, vb); }
    PG8_WAIT_V(6); PG8_BAR;
    for (;;) {
        const bool has_next = S.next(ui + 1, nxt);
        const char* nA = has_next ? pr.abase1(nxt) : cA1; const char* nB = has_next ? pr.bbase1(nxt) : cB1;
        for (int t = 0; t < nt; t += 2) {
            const bool last = (t == nt - 2);
            const bool s1 = (t + 1 < nt1), s2 = last || (t + 2 < nt1);
            const char* a1 = T_A(t + 1);
            const char* a2 = last ? nA : T_A(t + 2); const char* b2 = last ? nB : T_B(t + 2);
            const char* a3 = a2 + kstep; const char* b3 = b2 + kstep;
            const size_t hstepB = s2 ? hB1 : hB2; const int ldaT1 = s1 ? pr.lda1 : pr.lda2, ldaT2 = s2 ? pr.lda1 : pr.lda2, ldbT2 = s2 ? pr.ldb1 : pr.ldb2;
            unsigned v2[2][2], voffB[2], vA1s[2];
#pragma unroll
            for (int i = 0; i < 2; ++i) { voffB[i] = OFF_B(ldbT2, i); vA1s[i] = OFF_A(ldaT1, 1, i);
#pragma unroll
                for (int h = 0; h < 2; ++h) v2[h][i] = OFF_A(ldaT2, h, i); }
            PG8_LDB(B0, 0, 0); PG8_SCHED; PG8_LDA(At, 0, 0); PG8_STAGE(PG8_SA(1, 1), a1, vA1s);
            PG8_WAIT_L(8); PG8_BAR; PG8_WAIT_L(0); PG8_MMA(0, 0, At, B0); PG8_BAR; PG8_SCHED;
            PG8_LDB(B1, 0, 1); PG8_STAGE(PG8_SB(0, 0), b2, voffB);
            PG8_BAR; PG8_WAIT_L(0); PG8_MMA(0, 1, At, B1); PG8_BAR;
            PG8_LDA(At, 0, 1); PG8_STAGE(PG8_SA(0, 0), a2, v2[0]);
            PG8_BAR; PG8_WAIT_L(0); PG8_MMA(1, 0, At, B0); PG8_BAR; PG8_SCHED;
            PG8_STAGE(PG8_SB(0, 1), b2 + hstepB, voffB);
            PG8_WAIT_V(6); PG8_BAR; PG8_MMA(1, 1, At, B1); PG8_BAR;
            PG8_LDB(B0, 1, 0); PG8_SCHED; PG8_LDA(At, 1, 0); PG8_STAGE(PG8_SA(0, 1), a2, v2[1]);
            PG8_WAIT_L(8); PG8_BAR; PG8_WAIT_L(0); PG8_MMA(0, 0, At, B0); PG8_BAR; PG8_SCHED;
            PG8_LDB(B1, 1, 1); PG8_STAGE(PG8_SB(1, 0), b3, voffB);
            PG8_BAR; PG8_WAIT_L(0); PG8_MMA(0, 1, At, B1); PG8_BAR;
            PG8_LDA(At, 1, 1); PG8_STAGE(PG8_SA(1, 0), a3, v2[0]);
            PG8_BAR; PG8_WAIT_L(0); PG8_MMA(1, 0, At, B0); PG8_BAR; PG8_SCHED;
            PG8_STAGE(PG8_SB(1, 1), b3 + hstepB, voffB);
            PG8_WAIT_V(6); PG8_BAR; PG8_MMA(1, 1, At, B1); PG8_BAR;
            if (t == nt1 - 2) E.mid(acc, cur, wr, wc, fr, fq);
        }
        E(acc, cur, wr, wc, fr, fq);
        if (!has_next) break;
#pragma unroll
        for (int a = 0; a < 2; ++a)
#pragma unroll
            for (int b = 0; b < 2; ++b)
#pragma unroll
                for (int m = 0; m < 4; ++m)
#pragma unroll
                    for (int n = 0; n < 2; ++n) acc[a][b][m][n] = (f32x4){0.f, 0.f, 0.f, 0.f};
        cur = nxt; cA1 = nA; cB1 = nB; cA2 = pr.abase2(cur); cB2 = pr.bbase2(cur); ++ui;
    }
    PG8_WAIT_V(0);
    if (wr == 0) PG8_BAR;
    PG8_BAR;
#undef T_A
#undef T_B
#undef OFF_A
#undef OFF_B
#undef PG8_SA
#undef PG8_SB
#undef PG8_STAGE
#undef PG8_LDA
#undef PG8_LDB
#undef PG8_MMA
#undef PG8_WAIT_V
#undef PG8_WAIT_L
#undef PG8_BAR
#undef PG8_SCHED
}
}
using pg8::Unit;

struct ProbPlain {
    static constexpr bool GATHER = false;
    const bf16_t* A; const bf16_t* B; int K, lda, ldb;
    __device__ __forceinline__ const char* abase(const Unit& u) const { return (const char*)(A + (size_t)u.pm * 256 * lda); }
    __device__ __forceinline__ const char* bbase(const Unit& u) const { return (const char*)(B + (size_t)u.pn * 256 * ldb); }
    __device__ __forceinline__ void avoff(const Unit&, const int (&RA)[2], const int (&CA)[2], unsigned (&v)[2][2]) const {
#pragma unroll
        for (int h = 0; h < 2; ++h)
#pragma unroll
            for (int i = 0; i < 2; ++i) v[h][i] = (unsigned)((h * 128 + RA[i]) * lda + CA[i]) * 2u;
    }
};
struct ProbMerge {
    const bf16_t* A1; const bf16_t* B1; const bf16_t* A2; const bf16_t* B2; int K1, K2, lda1, ldb1, lda2, ldb2;
    __device__ __forceinline__ const char* abase1(const Unit& u) const { return (const char*)(A1 + (size_t)u.pm * 256 * lda1); }
    __device__ __forceinline__ const char* bbase1(const Unit& u) const { return (const char*)(B1 + (size_t)u.pn * 256 * ldb1); }
    __device__ __forceinline__ const char* abase2(const Unit& u) const { return (const char*)(A2 + (size_t)u.pm * 256 * lda2); }
    __device__ __forceinline__ const char* bbase2(const Unit& u) const { return (const char*)(B2 + (size_t)u.pn * 256 * ldb2); }
};
struct ProbPQ {
    static constexpr bool GATHER = false;
    const bf16_t* A; const bf16_t* B; int K, lda, ldb;
    __device__ __forceinline__ const char* abase(const Unit& u) const { return (const char*)(A + (size_t)u.pm * 256 * lda); }
    __device__ __forceinline__ const char* bbase(const Unit& u) const { return (const char*)(B + ((size_t)(u.pn >> 4) * 4096 + (u.pn & 15)) * 1024); }
    __device__ __forceinline__ void avoff(const Unit&, const int (&RA)[2], const int (&CA)[2], unsigned (&v)[2][2]) const {
#pragma unroll
        for (int h = 0; h < 2; ++h)
#pragma unroll
            for (int i = 0; i < 2; ++i) v[h][i] = (unsigned)((h * 128 + RA[i]) * lda + CA[i]) * 2u;
    }
};
struct ProbMoeUp {
    static constexpr bool GATHER = true;
    const bf16_t* A; const bf16_t* B; const int* idx; int K, lda, ldb;
    __device__ __forceinline__ const char* abase(const Unit&) const { return (const char*)A; }
    __device__ __forceinline__ const char* bbase(const Unit& u) const { return (const char*)(B + ((size_t)(u.pm >> 4) * 3072 + (size_t)u.pn * 256) * ldb); }
    __device__ __forceinline__ void avoff(const Unit& u, const int (&RA)[2], const int (&CA)[2], unsigned (&v)[2][2]) const {
#pragma unroll
        for (int h = 0; h < 2; ++h)
#pragma unroll
            for (int i = 0; i < 2; ++i) { const int g = idx[u.pm * 256 + h * 128 + RA[i]]; v[h][i] = (unsigned)(g * lda + CA[i]) * 2u; }
    }
};
struct ProbMoeDown {
    static constexpr bool GATHER = false;
    const bf16_t* A; const bf16_t* B; int K, lda, ldb;
    __device__ __forceinline__ const char* abase(const Unit& u) const { return (const char*)(A + (size_t)u.pm * 256 * lda); }
    __device__ __forceinline__ const char* bbase(const Unit& u) const { return (const char*)(B + ((size_t)(u.pm >> 4) * 1024 + (size_t)u.pn * 256) * ldb); }
    __device__ __forceinline__ void avoff(const Unit&, const int (&RA)[2], const int (&CA)[2], unsigned (&v)[2][2]) const {
#pragma unroll
        for (int h = 0; h < 2; ++h)
#pragma unroll
            for (int i = 0; i < 2; ++i) v[h][i] = (unsigned)((h * 128 + RA[i]) * lda + CA[i]) * 2u;
    }
};

#define EPI_ROWS(...) _Pragma("unroll") for (int ai = 0; ai < 2; ++ai) _Pragma("unroll") for (int m = 0; m < 4; ++m) { const int row = u.pm * 256 + ai * 128 + wr * 64 + m * 16 + fr; __VA_ARGS__ }
__device__ __forceinline__ u32x4 pack8(const f32x4 v0, const f32x4 v1) { u32x4 w; w.x = cvt_pk_bf16(v0[0], v0[1]); w.y = cvt_pk_bf16(v0[2], v0[3]); w.z = cvt_pk_bf16(v1[0], v1[1]); w.w = cvt_pk_bf16(v1[2], v1[3]); return w; }

struct EpiPQ {
    static constexpr bool PERM = true; bf16_t* O;
    __device__ __forceinline__ void operator()(const f32x4 (&acc)[2][2][4][2], const Unit& u, int wr, int wc, int fr, int fq) const {
        const int t10 = wc * 32 + 8 * fq, b = u.pn >> 4, t2 = u.pn & 15;
        EPI_ROWS(
            bf16_t* rp = O + ((size_t)((b * 512 + (row >> 1)) * 16 + t2) * 512 + (row & 1) * 256 + t10);
            _Pragma("unroll") for (int bj = 0; bj < 2; ++bj) *(u32x4*)(rp + bj * 128) = pack8(acc[ai][bj][m][0], acc[ai][bj][m][1]);
        )
    }
};
struct EpiPlain {
    static constexpr bool PERM = true; bf16_t* O; size_t ldc;
    __device__ __forceinline__ void operator()(const f32x4 (&acc)[2][2][4][2], const Unit& u, int wr, int wc, int fr, int fq) const {
        const int col0 = u.pn * 256 + wc * 32 + 8 * fq;
        EPI_ROWS(
            bf16_t* rp = O + (size_t)row * ldc + col0;
            _Pragma("unroll") for (int bj = 0; bj < 2; ++bj) *(u32x4*)(rp + bj * 128) = pack8(acc[ai][bj][m][0], acc[ai][bj][m][1]);
        )
    }
};
struct EpiZ {
    static constexpr bool PERM = true; bf16_t* O; int ldc; int fixed_act;
    __device__ __forceinline__ void operator()(const f32x4 (&acc)[2][2][4][2], const Unit& u, int wr, int wc, int fr, int fq) const {
        const int col0 = u.pn * 256 + wc * 32 + 8 * fq; const int act = fixed_act >= 0 ? fixed_act : (u.pn >> 2);
        EPI_ROWS(
            bf16_t* rp = O + (size_t)row * ldc + col0;
            _Pragma("unroll") for (int bj = 0; bj < 2; ++bj) {
                f32x4 v0 = acc[ai][bj][m][0], v1 = acc[ai][bj][m][1];
                if (act == 1) { _Pragma("unroll") for (int j = 0; j < 4; ++j) { v0[j] = gelu_tanh(v0[j]); v1[j] = gelu_tanh(v1[j]); } }
                else if (act >= 2) { _Pragma("unroll") for (int j = 0; j < 4; ++j) { v0[j] = sigmoidf_(v0[j]); v1[j] = sigmoidf_(v1[j]); } }
                *(u32x4*)(rp + bj * 128) = pack8(v0, v1); }
        )
    }
};
struct EpiMerge {
    static constexpr bool PERM = true; bf16_t* O; const bf16_t* Z;
    __device__ __forceinline__ void mid(f32x4 (&acc)[2][2][4][2], const Unit& u, int wr, int wc, int fr, int fq) const {
        unsigned eo = (unsigned)((u.pm * 256 + wr * 64 + fr) * 4096 + 2048 + u.pn * 256 + wc * 32 + 8 * fq);
        asm volatile("" : "+v"(eo));
#pragma unroll
        for (int ai = 0; ai < 2; ++ai) {
            u32x4 wa[4][2], wb[4][2];
#pragma unroll
            for (int m = 0; m < 4; ++m)
#pragma unroll
                for (int bj = 0; bj < 2; ++bj) { const unsigned o = eo + (unsigned)((ai * 128 + m * 16) * 4096 + bj * 128); wa[m][bj] = *(const u32x4*)(Z + o); wb[m][bj] = *(const u32x4*)(Z + o + 1024); }
#pragma unroll
            for (int m = 0; m < 4; ++m)
#pragma unroll
                for (int bj = 0; bj < 2; ++bj) { float ga[8], gb[8]; unpack8(wa[m][bj], ga); unpack8(wb[m][bj], gb);
#pragma unroll
                    for (int j = 0; j < 4; ++j) { acc[ai][bj][m][0][j] *= ga[j] * __builtin_amdgcn_rcpf(fmaxf(gb[j], 1e-30f)); acc[ai][bj][m][1][j] *= ga[4 + j] * __builtin_amdgcn_rcpf(fmaxf(gb[4 + j], 1e-30f)); } }
            __builtin_amdgcn_sched_barrier(0); }
    }
    __device__ __forceinline__ void operator()(const f32x4 (&acc)[2][2][4][2], const Unit& u, int wr, int wc, int fr, int fq) const {
        unsigned eo = (unsigned)((u.pm * 256 + wr * 64 + fr) * 4096 + 3072 + u.pn * 256 + wc * 32 + 8 * fq); asm volatile("" : "+v"(eo));
        unsigned oo = (unsigned)((u.pm * 256 + wr * 64 + fr) * 1024 + u.pn * 256 + wc * 32 + 8 * fq); asm volatile("" : "+v"(oo));
        u32x4 wb[2][4][2];
#pragma unroll
        for (int ai = 0; ai < 2; ++ai)
#pragma unroll
            for (int m = 0; m < 4; ++m)
#pragma unroll
                for (int bj = 0; bj < 2; ++bj) wb[ai][m][bj] = *(const u32x4*)(Z + eo + (unsigned)((ai * 128 + m * 16) * 4096 + bj * 128));
#pragma unroll
        for (int ai = 0; ai < 2; ++ai)
#pragma unroll
            for (int m = 0; m < 4; ++m)
#pragma unroll
                for (int bj = 0; bj < 2; ++bj) { float g[8]; unpack8(wb[ai][m][bj], g);
                    f32x4 v0 = acc[ai][bj][m][0], v1 = acc[ai][bj][m][1];
#pragma unroll
                    for (int j = 0; j < 4; ++j) { v0[j] *= g[j]; v1[j] *= g[4 + j]; }
                    *(u32x4*)(O + oo + (unsigned)((ai * 128 + m * 16) * 1024 + bj * 128)) = pack8(v0, v1); }
    }
};
struct EpiOut {
    static constexpr bool PERM = true; bf16_t* O; const float* X; const float* pos; const float* ada;
    __device__ __forceinline__ void operator()(const f32x4 (&acc)[2][2][4][2], const Unit& u, int wr, int wc, int fr, int fq) const {
        const int col0 = u.pn * 256 + wc * 32 + 8 * fq; const int b = u.pm >> 4;
        unsigned ro = (unsigned)((u.pm * 256 + wr * 64 + fr) * 1024 + col0); asm volatile("" : "+v"(ro));
#pragma unroll
        for (int ai = 0; ai < 2; ++ai)
#pragma unroll
            for (int mh = 0; mh < 2; ++mh) {
                f32x4 xv[2][2][2];
#pragma unroll
                for (int m2 = 0; m2 < 2; ++m2)
#pragma unroll
                    for (int bj = 0; bj < 2; ++bj)
#pragma unroll
                        for (int n = 0; n < 2; ++n) xv[m2][bj][n] = *(const f32x4*)(X + ro + (unsigned)((ai * 128 + (mh * 2 + m2) * 16) * 1024 + bj * 128 + n * 4));
#pragma unroll
                for (int m2 = 0; m2 < 2; ++m2) { const int m = mh * 2 + m2; const int row = u.pm * 256 + ai * 128 + wr * 64 + m * 16 + fr; const int t = row & 4095;
#pragma unroll
                    for (int bj = 0; bj < 2; ++bj) { f32x4 o[2];
#pragma unroll
                        for (int n = 0; n < 2; ++n) { const int col = col0 + bj * 128 + n * 4;
                            const f32x4 pv = *(const f32x4*)(pos + (col < 512 ? (t >> 6) * 512 + col : (t & 63) * 512 + (col - 512)));
                            const f32x4 gv = *(const f32x4*)(ada + b * 6144 + 2048 + col);
                            o[n] = xv[m2][bj][n] + pv + gv * acc[ai][bj][m][n]; }
                        *(u32x4*)(O + ro + (unsigned)((ai * 128 + m * 16) * 1024 + bj * 128)) = pack8(o[0], o[1]); } }
                __builtin_amdgcn_sched_barrier(0); }
    }
};
struct EpiGU {
    static constexpr bool PERM = true; bf16_t* O;
    __device__ __forceinline__ void operator()(const f32x4 (&acc)[2][2][4][2], const Unit& u, int wr, int wc, int fr, int fq) const {
        const int col0 = u.pn * 128 + wc * 32 + 8 * fq;
        EPI_ROWS(
            f32x4 v0, v1;
            _Pragma("unroll") for (int j = 0; j < 4; ++j) { const float g0 = acc[ai][0][m][0][j], g1 = acc[ai][0][m][1][j];
                v0[j] = g0 * sigmoidf_(g0) * acc[ai][1][m][0][j]; v1[j] = g1 * sigmoidf_(g1) * acc[ai][1][m][1][j]; }
            *(u32x4*)(O + (size_t)row * DE + col0) = pack8(v0, v1);
        )
    }
};
struct EpiDown {
    static constexpr bool PERM = true; bf16_t* O; const float* gate;
    __device__ __forceinline__ void operator()(const f32x4 (&acc)[2][2][4][2], const Unit& u, int wr, int wc, int fr, int fq) const {
        const int col0 = u.pn * 256 + wc * 32 + 8 * fq;
        EPI_ROWS(
            const float g = gate[row];
            _Pragma("unroll") for (int bj = 0; bj < 2; ++bj) *(u32x4*)(O + (size_t)row * 1024 + col0 + bj * 128) = pack8(acc[ai][bj][m][0] * g, acc[ai][bj][m][1] * g);
        )
    }
};

__device__ __forceinline__ void p0_ada(const Params& p, LAS unsigned char* lds, int item) {
    const int tid = threadIdx.x;
    LAS float* s = (LAS float*)lds; LAS float* red = s + 9 * 1024;
    for (int i = tid; i < 9 * 1024; i += NTHR) { const int r = i >> 10, d = i & 1023; const float v = r < 8 ? p.c[r * 1024 + d] : p.c_ctx[d]; s[i] = v / (1.0f + expf(-v)); }
    __syncthreads();
    const int col = tid & 63, ds = tid >> 6; float a[9];
#pragma unroll
    for (int r = 0; r < 9; ++r) a[r] = 0.f;
    const float* w = p.w_ada + (size_t)(ds * 128) * 6144 + item * 64 + col;
    for (int d0 = 0; d0 < 128; d0 += 32) { float wv[32];
#pragma unroll
        for (int j = 0; j < 32; ++j) wv[j] = w[(size_t)(d0 + j) * 6144];
#pragma unroll
        for (int j = 0; j < 32; ++j)
#pragma unroll
            for (int r = 0; r < 9; ++r) a[r] += s[r * 1024 + ds * 128 + d0 + j] * wv[j]; }
#pragma unroll
    for (int r = 0; r < 9; ++r) red[(ds * 9 + r) * 64 + col] = a[r];
    __syncthreads();
    float* ada = (float*)(p.ws + WS_ADA);
    for (int i = tid; i < 9 * 64; i += NTHR) { const int r = i >> 6, cc = i & 63; float v = 0.f;
#pragma unroll
        for (int k = 0; k < 8; ++k) v += red[(k * 9 + r) * 64 + cc];
        ada[r * 6144 + item * 64 + cc] = v + p.b_ada[item * 64 + cc]; }
    __syncthreads();
}
template <int NS>
__device__ __forceinline__ void xpose_item(const float* src, int ldsrc, bf16_t* dst, int lddst, int k0, int n0, int mode, float scale = 1.0f) {
    const int tid = threadIdx.x, k8 = tid & 7, nq = tid >> 3;
    if (nq >= 16 * NS) return;
    f32x4 v[8];
#pragma unroll
    for (int j = 0; j < 8; ++j) v[j] = *(const f32x4*)(src + (size_t)(k0 + 8 * k8 + j) * ldsrc + n0 + 4 * nq);
#pragma unroll
    for (int c = 0; c < 4; ++c) { const int n = n0 + 4 * nq + c; int row = n;
        if (mode) row = (n >> 7) * 256 + (n & 127) + (mode == 2 ? 128 : 0);
        u32x4 w; w.x = cvt_pk_bf16(v[0][c] * scale, v[1][c] * scale); w.y = cvt_pk_bf16(v[2][c] * scale, v[3][c] * scale); w.z = cvt_pk_bf16(v[4][c] * scale, v[5][c] * scale); w.w = cvt_pk_bf16(v[6][c] * scale, v[7][c] * scale);
        *(u32x4*)(dst + (size_t)row * lddst + k0 + 8 * k8) = w; }
}
__device__ __forceinline__ void p0_wpq(const Params& p, LAS unsigned char* lds, int item) {
    const int tid = threadIdx.x, g = item >> 6, db = item & 63;
    LAS float* wl = (LAS float*)lds; LAS float* ct = wl + 16 * 129;
    for (int i = tid; i < 16 * 128; i += NTHR) { const int d = i >> 7, cc = i & 127; wl[d * 129 + cc] = p.w_in[(size_t)(db * 16 + d) * 4608 + g * 128 + cc]; }
    if (tid < 128) { float sn, cs; sincospif((float)tid * (1.0f / 64.0f), &sn, &cs); ct[tid] = cs; ct[128 + tid] = sn; }
    __syncthreads();
    const int q = tid & 255, kc = q >> 1, pq = q & 1, dh = tid >> 8; const int n = (g * 128 + kc) * 2 + pq;
    bf16_t* dst = (bf16_t*)(p.ws + WS_WPQ) + (size_t)n * 1024 + db * 16 + dh * 8;
    const float scale = 0.001381067932f;
    float a[8];
#pragma unroll
    for (int j = 0; j < 8; ++j) a[j] = 0.f;
    for (int cc = 0; cc < 128; ++cc) { const float tv = ct[pq * 128 + ((cc * kc) & 127)];
#pragma unroll
        for (int j = 0; j < 8; ++j) a[j] += wl[(dh * 8 + j) * 129 + cc] * tv; }
    u32x4 w; w.x = cvt_pk_bf16(a[0] * scale, a[1] * scale); w.y = cvt_pk_bf16(a[2] * scale, a[3] * scale); w.z = cvt_pk_bf16(a[4] * scale, a[5] * scale); w.w = cvt_pk_bf16(a[6] * scale, a[7] * scale);
    *(u32x4*)dst = w;
    __syncthreads();
}
__device__ __forceinline__ void p0_d1t(const Params& p, int item) {
    bf16_t* dst = (bf16_t*)(p.ws + WS_D1T);
    const int row = item * 64 + (threadIdx.x >> 3), k1 = row >> 1, ri = row & 1, c0 = (threadIdx.x & 7) * 64;
    for (int c8 = 0; c8 < 64; c8 += 8) { float v[8];
#pragma unroll
        for (int j = 0; j < 8; ++j) { const int col = c0 + c8 + j, pq = col >> 8, t1 = col & 255; float sn, cs; sincospif((float)((k1 * t1) & 255) * (1.0f / 128.0f), &sn, &cs);
            v[j] = (ri == 0) ? (pq == 0 ? cs : -sn) : (pq == 0 ? -sn : -cs); }
        u32x4 w; w.x = cvt_pk_bf16(v[0], v[1]); w.y = cvt_pk_bf16(v[2], v[3]); w.z = cvt_pk_bf16(v[4], v[5]); w.w = cvt_pk_bf16(v[6], v[7]);
        *(u32x4*)(dst + (size_t)row * 512 + c0 + c8) = w; }
}
__device__ __forceinline__ void p0_d2t(const Params& p, int item) {
    bf16_t* dst = (bf16_t*)(p.ws + WS_D2T);
#pragma unroll
    for (int ps = 0; ps < 4; ++ps) { const int pc = (item * 4 + ps) * NTHR + threadIdx.x, tp = pc >> 2, kk0 = (pc & 3) * 8; float v[8];
#pragma unroll
        for (int j = 0; j < 8; ++j) { const int kk = kk0 + j, ri = kk >> 4, t2 = kk & 15; float sn, cs; sincospif((float)((tp * t2) & 4095) * (1.0f / 2048.0f), &sn, &cs); v[j] = ri ? sn : cs; }
        u32x4 w; w.x = cvt_pk_bf16(v[0], v[1]); w.y = cvt_pk_bf16(v[2], v[3]); w.z = cvt_pk_bf16(v[4], v[5]); w.w = cvt_pk_bf16(v[6], v[7]);
        *(u32x4*)(dst + (size_t)tp * 32 + kk0) = w; }
}
__device__ __forceinline__ void p0_pos(const Params& p) {
    float* tab = (float*)(p.ws + WS_POS);
    for (int i = threadIdx.x; i < 64 * 512; i += NTHR) { const int ii = i >> 9, j = i & 511, jj = j & 255; const float f = expf(-9.210340371976184f * (float)jj / 256.0f); const float a = (float)ii * f; tab[i] = j < 256 ? sinf(a) : cosf(a); }
}
__device__ __forceinline__ void phase0(const Params& p, LAS unsigned char* lds) {
    constexpr int N_ADA = 96, N_WIN = 16 * 16, N_WFOUR = 8 * 4, N_SQ = 16 * 4, N_LRU = 16 * 2, N_WPQ = 256, N_DFT = 8 + 8, N_POS = 1;
    constexpr int O1 = N_ADA, O2 = O1 + N_WIN, O3 = O2 + N_WFOUR, O4 = O3 + N_SQ, O5 = O4 + N_SQ, O6 = O5 + N_LRU, O7 = O6 + N_LRU, O8 = O7 + N_WPQ, O9 = O8 + N_DFT, O10 = O9 + N_POS;
    for (int it = blockIdx.x; it < O10; it += gridDim.x) {
        if (it < O1) p0_ada(p, lds, it);
        else if (it < O2) { const int j = it - O1; xpose_item<4>(p.w_in + 512, 4608, (bf16_t*)(p.ws + WS_WIN), 1024, (j >> 4) * 64, (j & 15) * 256, 0); }
        else if (it < O3) { const int j = it - O2; xpose_item<4>(p.w_four, 1024, (bf16_t*)(p.ws + WS_WFOUR), 512, (j >> 2) * 64, (j & 3) * 256, 0); }
        else if (it < O4) { const int j = it - O3; xpose_item<4>(p.w_lru, 1024, (bf16_t*)(p.ws + WS_WLRU), 1024, (j >> 2) * 64, (j & 3) * 256, 0); }
        else if (it < O5) { const int j = it - O4; xpose_item<4>(p.w_out, 1024, (bf16_t*)(p.ws + WS_WOUT), 1024, (j >> 2) * 64, (j & 3) * 256, 0); }
        else if (it < O6) { const int j = it - O5, mtx = j >> 1; xpose_item<2>(p.lru_wa + (size_t)mtx * 16384, 128, (bf16_t*)(p.ws + WS_WAT) + (size_t)mtx * 16384, 128, (j & 1) * 64, 0, 0, NLOG2E); }
        else if (it < O7) { const int j = it - O6, mtx = j >> 1; xpose_item<2>(p.lru_wi + (size_t)mtx * 16384, 128, (bf16_t*)(p.ws + WS_WIT) + (size_t)mtx * 16384, 128, (j & 1) * 64, 0, 0, NLOG2E); }
        else if (it < O8) p0_wpq(p, lds, it - O7);
        else if (it < O9) { if (it - O8 < 8) p0_d1t(p, it - O8); else p0_d2t(p, it - O8 - 8); }
        else p0_pos(p);
    }
}

__device__ __forceinline__ void phase1(const Params& p) {
    const int tid = tid_opaque(), lane = tid & 63, wid = tid >> 6;
    const float* ada = (const float*)(p.ws + WS_ADA); const float* tab = (const float*)(p.ws + WS_POS);
    bf16_t* h1 = (bf16_t*)(p.ws + WS_R1); bf16_t* hc = (bf16_t*)(p.ws + WS_HCTX);
    constexpr int NR = MLAT + MCTX, RW = 4;
    for (int row0 = (blockIdx.x * 8 + wid) * RW; row0 < NR; row0 += gridDim.x * 8 * RW) {
        const bool lat = row0 < MLAT; const int mrow = lat ? (row0 >> 12) : 8;
        f32x4 v[RW][4]; float ss[RW];
#pragma unroll
        for (int r = 0; r < RW; ++r) { const int row = row0 + r; const float* xr = lat ? p.x + (size_t)row * 1024 : p.ctx + (size_t)(row - MLAT) * 1024;
#pragma unroll
            for (int i = 0; i < 4; ++i) v[r][i] = *(const f32x4*)(xr + 256 * i + 4 * lane); }
#pragma unroll
        for (int r = 0; r < RW; ++r) { const int t = (row0 + r) & 4095; float a = 0.f;
#pragma unroll
            for (int i = 0; i < 4; ++i) { const int d = 256 * i + 4 * lane;
                if (lat) v[r][i] += *(const f32x4*)(tab + (i < 2 ? (t >> 6) * 512 + d : (t & 63) * 512 + d - 512));
                a += v[r][i][0] * v[r][i][0] + v[r][i][1] * v[r][i][1] + v[r][i][2] * v[r][i][2] + v[r][i][3] * v[r][i][3]; }
            ss[r] = a; }
#pragma unroll
        for (int o = 32; o >= 1; o >>= 1) {
#pragma unroll
            for (int r = 0; r < RW; ++r) ss[r] += __shfl_xor(ss[r], o); }
#pragma unroll
        for (int i = 0; i < 4; ++i) { const int d = 256 * i + 4 * lane;
            const f32x4 g = *(const f32x4*)(p.norm1_g + d), sh = *(const f32x4*)(ada + mrow * 6144 + d), sc = *(const f32x4*)(ada + mrow * 6144 + 1024 + d);
#pragma unroll
            for (int r = 0; r < RW; ++r) { const int row = row0 + r; const float rs = rsqrtf(ss[r] * (1.0f / 1024.0f) + 1e-6f);
                bf16_t* dst = lat ? h1 + (size_t)row * 1024 : hc + (size_t)(row - MLAT) * 1024;
                const f32x4 h = v[r][i] * rs * g * (sc + 1.0f) + sh;
                u32x2 w; w.x = cvt_pk_bf16(h[0], h[1]); w.y = cvt_pk_bf16(h[2], h[3]); *(u32x2*)(dst + d) = w; } }
    }
}

#define LRU_CST(mb, r) (32 * (mb) + 8 * ((r) >> 2) + ((r) & 3))
template <bool FINAL, int DIR>
__device__ __forceinline__ void lru_wave(const Params& p, LAS unsigned char* ul, int b, int sc, int head, int cb, int lane, f32x16 (&accI)[4]) {
    constexpr int SG = DIR ? -1 : 1;
    const int lr = lane & 31, lh = lane >> 5;
    const int chl = cb * 32 + lr, ch = head * 128 + chl;
    const int tbase = DIR ? 127 - 4 * lh : 4 * lh;
    f32x16 accA[4];
#pragma unroll
    for (int mb = 0; mb < 4; ++mb)
#pragma unroll
        for (int r = 0; r < 16; ++r) { accA[mb][r] = 0.f; accI[mb][r] = 0.f; }
    {
        const bf16_t* wa = (const bf16_t*)(p.ws + WS_WAT) + ((size_t)(DIR * 8 + head) * 128 + chl) * 128 + 8 * lh;
        const bf16_t* wi = (const bf16_t*)(p.ws + WS_WIT) + ((size_t)(DIR * 8 + head) * 128 + chl) * 128 + 8 * lh;
        LAS unsigned char* arow0 = ul + (DIR ? 127 - lr : lr) * 272 + lh * 16;
#pragma unroll
        for (int kc = 0; kc < 2; ++kc) { bf16x8 bA[4], bI[4];
#pragma unroll
            for (int k4 = 0; k4 < 4; ++k4) { bA[k4] = *(const bf16x8*)(wa + 16 * (kc * 4 + k4)); bI[k4] = *(const bf16x8*)(wi + 16 * (kc * 4 + k4)); }
#pragma unroll
            for (int mb = 0; mb < 4; ++mb)
#pragma unroll
                for (int k4 = 0; k4 < 4; ++k4) { const bf16x8 af = *(const LAS bf16x8*)(arow0 + SG * 32 * mb * 272 + 32 * (kc * 4 + k4));
                    accA[mb] = __builtin_amdgcn_mfma_f32_32x32x16_bf16(af, bA[k4], accA[mb], 0, 0, 0);
                    accI[mb] = __builtin_amdgcn_mfma_f32_32x32x16_bf16(af, bI[k4], accI[mb], 0, 0, 0); }
            __builtin_amdgcn_sched_barrier(0); }
    }
    {
        const float lam = p.lru_lambda[DIR * 1024 + ch]; const float sp8 = 8.0f * log1pf(expf(-lam));
        const float ba = p.lru_ba[DIR * 1024 + ch], bi = p.lru_bi[DIR * 1024 + ch];
        LAS unsigned char* up = ul + tbase * 272 + chl * 2;
#pragma unroll
        for (int mb = 0; mb < 4; ++mb) {
#pragma unroll
            for (int r = 0; r < 16; ++r) {
                const float uv = bf2f(*(const LAS bf16_t*)(up + SG * LRU_CST(mb, r) * 272));
                const float rg = __builtin_amdgcn_rcpf(1.0f + __builtin_amdgcn_exp2f(accA[mb][r] + NLOG2E * ba)), ig = __builtin_amdgcn_rcpf(1.0f + __builtin_amdgcn_exp2f(accI[mb][r] + NLOG2E * bi));
                const float a = __expf(-sp8 * rg); accA[mb][r] = a; accI[mb][r] = __builtin_amdgcn_sqrtf(fmaxf(1.0f - a * a, 0.f)) * ig * uv; }
            __builtin_amdgcn_sched_barrier(0); }
    }
    float rA[16], rH[16];
#pragma unroll
    for (int mb = 0; mb < 4; ++mb)
#pragma unroll
        for (int q = 0; q < 4; ++q) { float pa = 1.f, hh = 0.f;
#pragma unroll
            for (int j = 0; j < 4; ++j) { const int r = 4 * q + j; const float a = accA[mb][r], bb = accI[mb][r]; hh = a * hh + bb; pa *= a; accA[mb][r] = pa; accI[mb][r] = hh; }
            rA[mb * 4 + q] = pa; rH[mb * 4 + q] = hh; }
    const int agg_dir_off = ((b * NSEQ) * 2 + DIR) * 1024 + ch;
    const float* agg = (const float*)(p.ws + WS_AGG);
    float carry = 0.f;
    if (FINAL) {
        if (DIR == 0) { for (int q = 0; q < sc; ++q) { const float* a2 = agg + (size_t)(agg_dir_off + q * 2048) * 2; carry = a2[0] * carry + a2[1]; } }
        else { { const float* a2 = agg + (size_t)(agg_dir_off + 1 * 2048) * 2; carry = a2[0] * carry + a2[1]; } { const float* a2 = agg + (size_t)(agg_dir_off + 0 * 2048) * 2; carry = a2[0] * carry + a2[1]; }
            for (int q = NSEQ - 1; q > sc; --q) { const float* a2 = agg + (size_t)(agg_dir_off + q * 2048) * 2; carry = a2[0] * carry + a2[1]; } }
    }
    float cin[16];
#pragma unroll
    for (int i = 0; i < 16; ++i) cin[i] = 0.f;
    float s = carry, At = 1.f;
#pragma unroll
    for (int i = 0; i < 16; ++i) { const float oA = __shfl_xor(rA[i], 32), oH = __shfl_xor(rH[i], 32);
        { const bool mine = (lh == 0); const float a = mine ? rA[i] : oA, hh = mine ? rH[i] : oH; cin[i] = mine ? s : cin[i]; s = a * s + hh; At *= a; }
        { const bool mine = (lh == 1); const float a = mine ? rA[i] : oA, hh = mine ? rH[i] : oH; cin[i] = mine ? s : cin[i]; s = a * s + hh; At *= a; } }
    if (!FINAL) {
        if (lh == 0) { float* o = (float*)(p.ws + WS_AGG) + (size_t)(agg_dir_off + sc * 2048) * 2; o[0] = At; o[1] = s; }
        return;
    }
#pragma unroll
    for (int mb = 0; mb < 4; ++mb)
#pragma unroll
        for (int r = 0; r < 16; ++r) accI[mb][r] += accA[mb][r] * cin[mb * 4 + (r >> 2)];
}
template <bool FINAL>
__device__ __forceinline__ void lru_tile(const Params& p, LAS unsigned char* lds, int item) {
    const int tid = threadIdx.x, lane = tid & 63, wid = __builtin_amdgcn_readfirstlane(tid >> 6);
    int b, sc, head;
    if (FINAL) { head = item & 7; sc = 2 + ((item >> 3) & 31); b = item >> 8; }
    else { head = item & 7; const int r = item >> 3; sc = r & 1; b = r >> 1; }
    const bf16_t* src; int Tseq, t0, ld;
    if (sc < 2) { src = (const bf16_t*)(p.ws + WS_ZXC) + (size_t)b * 256 * 1024; Tseq = 256; t0 = sc * 128; ld = 1024; }
    else { src = (const bf16_t*)(p.ws + WS_RZ) + (size_t)b * 4096 * 4096; Tseq = 4096; t0 = (sc - 2) * 128; ld = 4096; }
    LAS unsigned char* ul = lds;
    LAS float* ybuf = (LAS float*)(lds + 36 * 1024);
    {
        const int c8 = tid & 15, tb = tid >> 4; const int ch0 = head * 128 + 8 * c8;
        float w[4][8], bias[8];
#pragma unroll
        for (int k = 0; k < 4; ++k) { const f32x4 a = *(const f32x4*)(p.conv_w + k * 1024 + ch0), c2 = *(const f32x4*)(p.conv_w + k * 1024 + ch0 + 4);
#pragma unroll
            for (int j = 0; j < 4; ++j) { w[k][j] = a[j]; w[k][4 + j] = c2[j]; } }
        { const f32x4 a = *(const f32x4*)(p.conv_b + ch0), c2 = *(const f32x4*)(p.conv_b + ch0 + 4);
#pragma unroll
            for (int j = 0; j < 4; ++j) { bias[j] = a[j]; bias[4 + j] = c2[j]; } }
#pragma unroll
        for (int i = 0; i < 4; ++i) { const int t = tb + 32 * i; float a[8];
#pragma unroll
            for (int j = 0; j < 8; ++j) a[j] = bias[j];
#pragma unroll
            for (int k = 0; k < 4; ++k) { const int tt = t0 + t + k - 2;
                if (tt >= 0 && tt < Tseq) { float f[8]; unpack8(*(const u32x4*)(src + (size_t)tt * ld + ch0), f);
#pragma unroll
                    for (int j = 0; j < 8; ++j) a[j] += w[k][j] * f[j]; } }
            u32x4 wv; wv.x = cvt_pk_bf16(a[0], a[1]); wv.y = cvt_pk_bf16(a[2], a[3]); wv.z = cvt_pk_bf16(a[4], a[5]); wv.w = cvt_pk_bf16(a[6], a[7]);
            *(LAS u32x4*)(ul + t * 272 + c8 * 16) = wv; }
    }
    __syncthreads();
    f32x16 hacc[4];
    if (wid < 4) lru_wave<FINAL, 0>(p, ul, b, sc, head, wid & 3, lane, hacc);
    else lru_wave<FINAL, 1>(p, ul, b, sc, head, wid & 3, lane, hacc);
    if (FINAL) {
        const int lr = lane & 31, lh = lane >> 5, chl = (wid & 3) * 32 + lr;
        if (wid >= 4) { LAS float* yp = ybuf + (127 - 4 * lh) * 129 + chl;
#pragma unroll
            for (int mb = 0; mb < 4; ++mb)
#pragma unroll
                for (int r = 0; r < 16; ++r) yp[-LRU_CST(mb, r) * 129] = hacc[mb][r]; }
        __syncthreads();
        if (wid < 4) {
            const LAS float* yp = ybuf + (4 * lh) * 129 + chl;
            const bf16_t* Zu = (const bf16_t*)(p.ws + WS_RZ) + ((size_t)(b * 4096 + t0) * 4096 + 1024 + head * 128);
            bf16_t* Ou = (bf16_t*)(p.ws + WS_R1) + ((size_t)(b * 4096 + t0) * 1024 + head * 128);
            const unsigned zo = (unsigned)(4 * lh * 4096 + chl), oo = (unsigned)(4 * lh * 1024 + chl);
#pragma unroll
            for (int mb = 0; mb < 4; ++mb) {
#pragma unroll
                for (int r = 0; r < 16; ++r) {
                    const float y = hacc[mb][r] + yp[LRU_CST(mb, r) * 129];
                    const float gz = bf2f(Zu[zo + LRU_CST(mb, r) * 4096]);
                    Ou[oo + LRU_CST(mb, r) * 1024] = (bf16_t)(cvt_pk_bf16(gz * y, 0.f) & 0xffffu);
                    if ((r & 7) == 7) __builtin_amdgcn_sched_barrier(0); } }
        }
    }
    __syncthreads();
}

#ifndef LRU_PF_FRAG
#define LRU_PF_FRAG true
#endif
#ifndef LRU_PF_TILE
#define LRU_PF_TILE true
#endif
typedef unsigned long long u64_t;
template <int DIR, bool PREF>
__device__ __forceinline__ void lru2_dir(const Params& p, LAS unsigned char* ul, int head, int w, int lane, const bf16x8 (&bA)[4], const bf16x8 (&bI)[4], bf16x8 (&nA)[4], bf16x8 (&nI)[4],
                                         f32x4 (&hl)[8], f32x4 (&pp)[8], float& Atot, float& Htot) {
    constexpr int SG = DIR ? -1 : 1;
    const int fr = lane & 15, fq = lane >> 4, chl = 16 * w + fr, ch = head * 128 + chl;
    f32x4 accA[8], accI[8];
    { const float ba2 = NLOG2E * p.lru_ba[DIR * 1024 + ch], bi2 = NLOG2E * p.lru_bi[DIR * 1024 + ch];
#pragma unroll
      for (int rb = 0; rb < 8; ++rb) { accA[rb] = (f32x4){ba2, ba2, ba2, ba2}; accI[rb] = (f32x4){bi2, bi2, bi2, bi2}; } }
    {
        LAS unsigned char* arow0 = ul + (DIR ? 127 - fr : fr) * 272 + fq * 16;
#pragma unroll
        for (int rb = 0; rb < 8; ++rb)
#pragma unroll
            for (int ks = 0; ks < 4; ++ks) { const bf16x8 af = *(const LAS bf16x8*)(arow0 + SG * 16 * rb * 272 + 64 * ks);
                accA[rb] = __builtin_amdgcn_mfma_f32_16x16x32_bf16(af, bA[ks], accA[rb], 0, 0, 0);
                accI[rb] = __builtin_amdgcn_mfma_f32_16x16x32_bf16(af, bI[ks], accI[rb], 0, 0, 0); }
    }
    if (PREF) {
        const bf16_t* wa = (const bf16_t*)(p.ws + WS_WAT) + ((size_t)((1 - DIR) * 8 + head) * 128 + chl) * 128 + 8 * fq;
        const bf16_t* wi = (const bf16_t*)(p.ws + WS_WIT) + ((size_t)((1 - DIR) * 8 + head) * 128 + chl) * 128 + 8 * fq;
#pragma unroll
        for (int ks = 0; ks < 4; ++ks) { nA[ks] = *(const bf16x8*)(wa + 32 * ks); nI[ks] = *(const bf16x8*)(wi + 32 * ks); }
    }
    {
        typedef float f32x2 __attribute__((ext_vector_type(2)));
        const float lam = p.lru_lambda[DIR * 1024 + ch]; const float k2 = NLOG2E * 8.0f * log1pf(expf(-lam));
        LAS unsigned char* up = ul + (DIR ? 127 - 4 * fq : 4 * fq) * 272 + chl * 2;
#pragma unroll
        for (int rb = 0; rb < 8; ++rb)
#pragma unroll
            for (int r = 0; r < 4; r += 2) {
                f32x2 uv; uv.x = bf2f(*(const LAS bf16_t*)(up + SG * (16 * rb + r) * 272)); uv.y = bf2f(*(const LAS bf16_t*)(up + SG * (16 * rb + r + 1) * 272));
                f32x2 ea, ei; ea.x = __builtin_amdgcn_exp2f(accA[rb][r]); ea.y = __builtin_amdgcn_exp2f(accA[rb][r + 1]); ei.x = __builtin_amdgcn_exp2f(accI[rb][r]); ei.y = __builtin_amdgcn_exp2f(accI[rb][r + 1]);
                const f32x2 da = ea + 1.0f, di = ei + 1.0f;
                f32x2 rg, ig; rg.x = __builtin_amdgcn_rcpf(da.x); rg.y = __builtin_amdgcn_rcpf(da.y); ig.x = __builtin_amdgcn_rcpf(di.x); ig.y = __builtin_amdgcn_rcpf(di.y);
                const f32x2 ka = rg * k2;
                f32x2 a; a.x = __builtin_amdgcn_exp2f(ka.x); a.y = __builtin_amdgcn_exp2f(ka.y);
                const f32x2 om = 1.0f - a * a;
                f32x2 sq; sq.x = __builtin_amdgcn_sqrtf(om.x); sq.y = __builtin_amdgcn_sqrtf(om.y);
                const f32x2 bb = sq * ig * uv;
                accA[rb][r] = a.x; accA[rb][r + 1] = a.y; accI[rb][r] = bb.x; accI[rb][r + 1] = bb.y; }
    }
    float rA[8], rH[8];
#pragma unroll
    for (int rb = 0; rb < 8; ++rb) { float pa = 1.f, hh = 0.f;
#pragma unroll
        for (int r = 0; r < 4; ++r) { const float a = accA[rb][r], bb = accI[rb][r]; hh = a * hh + bb; pa *= a; accA[rb][r] = pa; accI[rb][r] = hh; }
        rA[rb] = pa; rH[rb] = hh; }
    float Pc = 1.f, s = 0.f;
#pragma unroll
    for (int rb = 0; rb < 8; ++rb) { float Pin = 1.f, Hin = 0.f;
#pragma unroll
        for (int q = 0; q < 4; ++q) { const float a = __shfl(rA[rb], fr + 16 * q), hh = __shfl(rH[rb], fr + 16 * q);
            if (q == fq) { Pin = Pc; Hin = s; }
            s = a * s + hh; Pc *= a; }
#pragma unroll
        for (int r = 0; r < 4; ++r) { hl[rb][r] = accI[rb][r] + accA[rb][r] * Hin; pp[rb][r] = accA[rb][r] * Pin; }
        __builtin_amdgcn_sched_barrier(0); }
    Atot = Pc; Htot = s;
}
__device__ __forceinline__ u64_t agg_ld(const u64_t* a) { return __hip_atomic_load(a, __ATOMIC_RELAXED, __HIP_MEMORY_SCOPE_AGENT); }
template <int DIR>
__device__ __forceinline__ float lru2_carry(const u64_t* aggc, int n, int fr, int fq) {
    float Ap = 1.f, Hp = 0.f; u64_t v[9];
#pragma unroll
    for (int k = 0; k < 9; ++k) { const int j = fq * 9 + k; const int seq = DIR ? (j == 0 ? 1 : (j == 1 ? 0 : 35 - j)) : j;
        v[k] = (j < n) ? agg_ld(aggc + (size_t)seq * 2048) : 0x000000003f800000ull; }
#pragma unroll
    for (int k = 0; k < 9; ++k) { const float a = __uint_as_float((unsigned)v[k]), hh = __uint_as_float((unsigned)(v[k] >> 32)); Hp = a * Hp + hh; Ap *= a; }
    float s = 0.f;
#pragma unroll
    for (int q = 0; q < 4; ++q) { const float a = __shfl(Ap, fr + 16 * q), hh = __shfl(Hp, fr + 16 * q); s = a * s + hh; }
    return s;
}
__device__ __forceinline__ void lru2_block(const Params& p, LAS unsigned char* lds, int slot, int c, int ngr) {
    const int tid = threadIdx.x, lane = tid & 63, wid = __builtin_amdgcn_readfirstlane(tid >> 6);
    const int sc = c + 2, t0 = c * 128;
    LAS unsigned char* raw = lds;
    LAS unsigned char* ul = lds + 33792;
    LAS unsigned char* gzl = lds + 68608;
    LAS unsigned char* outl = lds + 103424;
    const int fr = lane & 15, fq = lane >> 4, chl = 16 * wid + fr;
    u32x4 nr[5], ng[4];
#define LRU2_LOAD_R(gg) do { const bf16_t* Zb_ = (const bf16_t*)(p.ws + WS_RZ) + (size_t)((gg) >> 3) * 4096 * 4096 + ((gg) & 7) * 128; \
        _Pragma("unroll") for (int k = 0; k < 5; ++k) { const int pc = tid + NTHR * k; nr[k] = (u32x4){0u, 0u, 0u, 0u}; \
            if (pc < 131 * 16) { const int row = pc >> 4, c8 = pc & 15, tt = t0 - 2 + row; if (tt >= 0 && tt < TT) nr[k] = *(const u32x4*)(Zb_ + (size_t)tt * 4096 + c8 * 8); } } } while (0)
#define LRU2_LOAD_G(gg) do { const bf16_t* Zb_ = (const bf16_t*)(p.ws + WS_RZ) + (size_t)((gg) >> 3) * 4096 * 4096 + ((gg) & 7) * 128; \
        _Pragma("unroll") for (int k = 0; k < 4; ++k) { const int pc = tid + NTHR * k, row = pc >> 4, c8 = pc & 15; ng[k] = *(const u32x4*)(Zb_ + (size_t)(t0 + row) * 4096 + 1024 + c8 * 8); } } while (0)
    LRU2_LOAD_R(slot); LRU2_LOAD_G(slot);
    for (int g = slot; g < NB * 8; g += ngr) {
        const int b = g >> 3, head = g & 7, ch = head * 128 + chl;
        unsigned* gcnt = (unsigned*)(p.ws + WS_BAR + 16 * KiB) + g * 64;
        bf16x8 bA1[4], bI1[4], bA0[4], bI0[4];
        { const bf16_t* wa = (const bf16_t*)(p.ws + WS_WAT) + ((size_t)(8 + head) * 128 + chl) * 128 + 8 * fq; const bf16_t* wi = (const bf16_t*)(p.ws + WS_WIT) + ((size_t)(8 + head) * 128 + chl) * 128 + 8 * fq;
#pragma unroll
          for (int ks = 0; ks < 4; ++ks) { bA1[ks] = *(const bf16x8*)(wa + 32 * ks); bI1[ks] = *(const bf16x8*)(wi + 32 * ks); } }
#pragma unroll
        for (int k = 0; k < 5; ++k) { const int pc = tid + NTHR * k; if (pc < 131 * 16) *(LAS u32x4*)(raw + (pc >> 4) * 256 + (pc & 15) * 16) = nr[k]; }
#pragma unroll
        for (int k = 0; k < 4; ++k) { const int pc = tid + NTHR * k; *(LAS u32x4*)(gzl + (pc >> 4) * 272 + (pc & 15) * 16) = ng[k]; }
        __syncthreads();
        {
            const int c8 = tid & 15, tb = tid >> 4; const int ch0 = head * 128 + 8 * c8;
            float w[4][8], bias[8];
#pragma unroll
            for (int k = 0; k < 4; ++k) { const f32x4 a = *(const f32x4*)(p.conv_w + k * 1024 + ch0), c2 = *(const f32x4*)(p.conv_w + k * 1024 + ch0 + 4);
#pragma unroll
                for (int j = 0; j < 4; ++j) { w[k][j] = a[j]; w[k][4 + j] = c2[j]; } }
            { const f32x4 a = *(const f32x4*)(p.conv_b + ch0), c2 = *(const f32x4*)(p.conv_b + ch0 + 4);
#pragma unroll
                for (int j = 0; j < 4; ++j) { bias[j] = a[j]; bias[4 + j] = c2[j]; } }
#pragma unroll
            for (int i = 0; i < 4; ++i) { const int t = tb + 32 * i; float a[8];
#pragma unroll
                for (int j = 0; j < 8; ++j) a[j] = bias[j];
#pragma unroll
                for (int k = 0; k < 4; ++k) { float f[8]; unpack8(*(const LAS u32x4*)(raw + (t + k) * 256 + c8 * 16), f);
#pragma unroll
                    for (int j = 0; j < 8; ++j) a[j] += w[k][j] * f[j]; }
                u32x4 wv; wv.x = cvt_pk_bf16(a[0], a[1]); wv.y = cvt_pk_bf16(a[2], a[3]); wv.z = cvt_pk_bf16(a[4], a[5]); wv.w = cvt_pk_bf16(a[6], a[7]);
                *(LAS u32x4*)(ul + t * 272 + c8 * 16) = wv; }
        }
        __syncthreads();
        float A0, H0, A1, H1;
        {
            f32x4 hl1[8], pp1[8];
            lru2_dir<1, LRU_PF_FRAG>(p, ul, head, wid, lane, bA1, bI1, bA0, bI0, hl1, pp1, A1, H1);
            LAS unsigned char* hp = outl + (127 - 4 * fq) * 272 + chl * 2; LAS unsigned char* qp = raw + (127 - 4 * fq) * 256 + chl * 2;
#pragma unroll
            for (int rb = 0; rb < 8; ++rb)
#pragma unroll
                for (int r = 0; r < 4; ++r) { *(LAS bf16_t*)(hp - (16 * rb + r) * 272) = (bf16_t)(cvt_pk_bf16(hl1[rb][r], 0.f) & 0xffffu); *(LAS bf16_t*)(qp - (16 * rb + r) * 256) = (bf16_t)(cvt_pk_bf16(pp1[rb][r], 0.f) & 0xffffu); }
        }
        __builtin_amdgcn_sched_barrier(0);
        if (!LRU_PF_FRAG) { const bf16_t* wa = (const bf16_t*)(p.ws + WS_WAT) + ((size_t)(head) * 128 + chl) * 128 + 8 * fq; const bf16_t* wi = (const bf16_t*)(p.ws + WS_WIT) + ((size_t)(head) * 128 + chl) * 128 + 8 * fq;
#pragma unroll
          for (int ks = 0; ks < 4; ++ks) { bA0[ks] = *(const bf16x8*)(wa + 32 * ks); bI0[ks] = *(const bf16x8*)(wi + 32 * ks); } }
        f32x4 hl0[8], pp0[8];
        lru2_dir<0, false>(p, ul, head, wid, lane, bA0, bI0, bA1, bI1, hl0, pp0, A0, H0);
        u64_t* agg = (u64_t*)(p.ws + WS_AGG);
        const size_t ai0 = ((size_t)(b * NSEQ) * 2 + 0) * 1024 + ch, ai1 = ((size_t)(b * NSEQ) * 2 + 1) * 1024 + ch;
        if (fq == 0) {
            __hip_atomic_store(agg + ai0 + (size_t)sc * 2048, ((u64_t)__float_as_uint(H0) << 32) | __float_as_uint(A0), __ATOMIC_RELAXED, __HIP_MEMORY_SCOPE_AGENT);
            __hip_atomic_store(agg + ai1 + (size_t)sc * 2048, ((u64_t)__float_as_uint(H1) << 32) | __float_as_uint(A1), __ATOMIC_RELAXED, __HIP_MEMORY_SCOPE_AGENT); }
        asm volatile("s_waitcnt vmcnt(0)" ::: "memory");
        __syncthreads();
        if (tid == 0) (void)__hip_atomic_fetch_add(gcnt, 1u, __ATOMIC_RELAXED, __HIP_MEMORY_SCOPE_AGENT);
        if (wid == 0) { unsigned sp = 0;
            while ((unsigned)__builtin_amdgcn_readfirstlane(__hip_atomic_load(gcnt, __ATOMIC_RELAXED, __HIP_MEMORY_SCOPE_AGENT)) < 32u) { __builtin_amdgcn_s_sleep(1); if (++sp > (1u << 22)) break; }
            __builtin_amdgcn_fence(__ATOMIC_ACQUIRE, "agent");
            asm volatile("s_waitcnt vmcnt(0)" ::: "memory"); }
        __syncthreads();
        const float C0 = lru2_carry<0>(agg + ai0, sc, fr, fq);
        const float C1 = lru2_carry<1>(agg + ai1, 2 + (NSEQ - 1 - sc), fr, fq);
        __builtin_amdgcn_sched_barrier(0);
        if (LRU_PF_TILE) { const int gn = (g + ngr < NB * 8) ? g + ngr : g; LRU2_LOAD_R(gn); LRU2_LOAD_G(gn); }
        __builtin_amdgcn_sched_barrier(0);
        LAS unsigned char* gp = gzl + (4 * fq) * 272 + chl * 2; LAS unsigned char* op = outl + (4 * fq) * 272 + chl * 2; LAS unsigned char* qp0 = raw + (4 * fq) * 256 + chl * 2;
#pragma unroll
        for (int rb = 0; rb < 8; ++rb)
#pragma unroll
            for (int r = 0; r < 4; ++r) { const float h1 = bf2f(*(const LAS bf16_t*)(op + (16 * rb + r) * 272)) + bf2f(*(const LAS bf16_t*)(qp0 + (16 * rb + r) * 256)) * C1;
                const float y = hl0[rb][r] + pp0[rb][r] * C0 + h1;
                const float gz = bf2f(*(const LAS bf16_t*)(gp + (16 * rb + r) * 272));
                *(LAS bf16_t*)(op + (16 * rb + r) * 272) = (bf16_t)(cvt_pk_bf16(gz * y, 0.f) & 0xffffu); }
        __syncthreads();
        bf16_t* Ob = (bf16_t*)(p.ws + WS_R1) + ((size_t)(b * 4096 + t0)) * 1024 + head * 128;
#pragma unroll
        for (int k = 0; k < 4; ++k) { const int pc = tid + NTHR * k, row = pc >> 4, c8 = pc & 15;
            *(u32x4*)(Ob + (size_t)row * 1024 + c8 * 8) = *(const LAS u32x4*)(outl + row * 272 + c8 * 16); }
        __syncthreads();
        if (!LRU_PF_TILE && g + ngr < NB * 8) LRU2_LOAD_R(g + ngr);
    }
#undef LRU2_LOAD_R
#undef LRU2_LOAD_G
}

__device__ __forceinline__ void fft_stage2_all(const Params& p, LAS unsigned char* lds) {
    const int tid = tid_opaque(), lane = tid & 63, wid = tid >> 6, fr = lane & 15, fq = lane >> 4;
    const bf16_t* Yt = (const bf16_t*)((const unsigned char*)p.out + OUT_YT); const bf16_t* D2 = (const bf16_t*)(p.ws + WS_D2T);
    bf16_t* Fo = (bf16_t*)((unsigned char*)p.out + OUT_F);
    const int G = gridDim.x;
    int it = blockIdx.x; bf16x8 dfr, yfr[4];
#define S2_LOAD(item) do { const int b_ = (item) & 7, k1_ = (item) >> 3; dfr = *(const bf16x8*)(D2 + (size_t)(k1_ + 256 * fr) * 32 + 8 * fq); \
        _Pragma("unroll") for (int n = 0; n < 4; ++n) yfr[n] = *(const bf16x8*)(Yt + (size_t)(k1_ * 2 + (fq >> 1)) * 65536 + (size_t)b_ * 8192 + (size_t)(16 * (4 * wid + n) + fr) * 16 + 8 * (fq & 1)); } while (0)
    if (it < NB * 256) S2_LOAD(it);
    for (; it < NB * 256; it += G) {
        const int b = it & 7, k1 = it >> 3;
        f32x4 acc[4];
#pragma unroll
        for (int n = 0; n < 4; ++n) acc[n] = __builtin_amdgcn_mfma_f32_16x16x32_bf16(yfr[n], dfr, (f32x4){0.f, 0.f, 0.f, 0.f}, 0, 0, 0);
        const int nx = it + G; if (nx < NB * 256) S2_LOAD(nx);
#pragma unroll
        for (int n = 0; n < 4; ++n) { u32x2 w; w.x = cvt_pk_bf16(acc[n][0], acc[n][1]); w.y = cvt_pk_bf16(acc[n][2], acc[n][3]);
            *(LAS u32x2*)(lds + fr * 1040 + (16 * (4 * wid + n) + 4 * fq) * 2) = w; }
        __syncthreads();
#pragma unroll
        for (int k = 0; k < 2; ++k) { const int pc = tid + NTHR * k, k2 = pc >> 6, c8 = pc & 63;
            *(u32x4*)(Fo + ((size_t)b * 4096 + k1 + 256 * k2) * 512 + c8 * 8) = *(const LAS u32x4*)(lds + k2 * 1040 + c8 * 16); }
        __syncthreads();
    }
#undef S2_LOAD
}

__device__ __forceinline__ void topk_task(const Params& p, LAS unsigned char* lds, int it) {
    const int tid = tid_opaque(), lane = tid & 63, wid = tid >> 6;
    LAS unsigned* cnt = (LAS unsigned*)lds;
    LAS unsigned* wsum = cnt + 64;
    const float* scores = (const float*)(p.ws + WS_SCORES);
    int* idx = (int*)(p.ws + WS_IDX); float* gate = (float*)(p.ws + WS_GATE); int* slot_of = (int*)(p.ws + WS_SLOT);
    const int b = it >> 4, e = it & 15;
    unsigned key[8];
    { const u32x4* sp = (const u32x4*)(scores + (size_t)it * 4096 + tid * 8); const u32x4 a = sp[0], c2 = sp[1]; key[0] = a.x; key[1] = a.y; key[2] = a.z; key[3] = a.w; key[4] = c2.x; key[5] = c2.y; key[6] = c2.z; key[7] = c2.w; }
    unsigned thr = 0;
    for (int step = 0; step < 16; ++step) {
        const int sh = 29 - 2 * step;
        const unsigned c1 = sh >= 0 ? (thr | (1u << sh)) : (thr | 1u), c2 = sh >= 0 ? (thr | (2u << sh)) : 0xffffffffu, c3 = sh >= 0 ? (thr | (3u << sh)) : 0xffffffffu;
        unsigned n1 = 0, n2 = 0, n3 = 0;
#pragma unroll
        for (int j = 0; j < 8; ++j) { n1 += (unsigned)__popcll(__ballot(key[j] >= c1)); n2 += (unsigned)__popcll(__ballot(key[j] >= c2)); n3 += (unsigned)__popcll(__ballot(key[j] >= c3)); }
        LAS unsigned* cb = cnt + (step & 1) * 32;
        if (lane == 0) { cb[wid] = n1; cb[8 + wid] = n2; cb[16 + wid] = n3; }
        __syncthreads();
        unsigned t1 = 0, t2 = 0, t3 = 0;
#pragma unroll
        for (int w = 0; w < 8; ++w) { t1 += cb[w]; t2 += cb[8 + w]; t3 += cb[16 + w]; }
        if (sh >= 0) thr = t3 >= (unsigned)CAP ? c3 : (t2 >= (unsigned)CAP ? c2 : (t1 >= (unsigned)CAP ? c1 : thr));
        else thr = t1 >= (unsigned)CAP ? c1 : thr;
    }
    unsigned cg_ = 0, ce = 0;
#pragma unroll
    for (int j = 0; j < 8; ++j) { cg_ += key[j] > thr; ce += key[j] == thr; }
    unsigned pk = cg_ | (ce << 16), incl = pk;
#pragma unroll
    for (int o = 1; o < 64; o <<= 1) { const unsigned n = __shfl_up(incl, o); if (lane >= o) incl += n; }
    if (lane == 63) wsum[wid] = incl;
    __syncthreads();
    unsigned base = 0, total = 0;
#pragma unroll
    for (int w = 0; w < 8; ++w) { const unsigned s2 = wsum[w]; if (w < wid) base += s2; total += s2; }
    const unsigned excl = base + incl - pk; unsigned og = excl & 0xffffu, oe = excl >> 16; const unsigned ngt = total & 0xffffu, krem = (unsigned)CAP - ngt;
    int mm[8];
#pragma unroll
    for (int j = 0; j < 8; ++j) { const int t = tid * 8 + j; int m = -1;
        if (key[j] > thr) { m = (e * 8 + b) * 512 + (int)og; ++og; }
        else if (key[j] == thr) { if (oe < krem) m = (e * 8 + b) * 512 + (int)(ngt + oe); ++oe; }
        mm[j] = m;
        if (m >= 0) { idx[m] = b * 4096 + t; gate[m] = __uint_as_float(key[j]); } }
    { u32x4* so = (u32x4*)(slot_of + (size_t)it * 4096 + tid * 8);
      so[0] = (u32x4){(unsigned)mm[0], (unsigned)mm[1], (unsigned)mm[2], (unsigned)mm[3]}; so[1] = (u32x4){(unsigned)mm[4], (unsigned)mm[5], (unsigned)mm[6], (unsigned)mm[7]}; }
    __syncthreads();
}

__device__ __forceinline__ void phase7_rows(const Params& p, LAS unsigned char* lds) {
    const int tid = threadIdx.x, lane = tid & 63, wid = tid >> 6;
    LAS float* wrt = (LAS float*)lds;
    for (int i = tid; i < 16 * 1024; i += NTHR) { const int d = i >> 4, e = i & 15; wrt[e * 1024 + d] = p.w_router[i]; }
    __syncthreads();
    const float* ada = (const float*)(p.ws + WS_ADA); bf16_t* h2 = (bf16_t*)(p.ws + WS_H2); const bf16_t* x2b = (const bf16_t*)(p.ws + WS_X2B); float* scores = (float*)(p.ws + WS_SCORES);
    for (int row0 = (blockIdx.x * 8 + wid) * 2; row0 < MLAT; row0 += gridDim.x * 16) {
        const int b = row0 >> 12;
        f32x4 v[2][4]; float ss[2];
#pragma unroll
        for (int r = 0; r < 2; ++r)
#pragma unroll
            for (int i = 0; i < 4; ++i) { const u32x2 w = *(const u32x2*)(x2b + (size_t)(row0 + r) * 1024 + 256 * i + 4 * lane); v[r][i] = (f32x4){bf_lo(w.x), bf_hi(w.x), bf_lo(w.y), bf_hi(w.y)}; }
#pragma unroll
        for (int r = 0; r < 2; ++r) { float a = 0.f;
#pragma unroll
            for (int i = 0; i < 4; ++i) a += v[r][i][0] * v[r][i][0] + v[r][i][1] * v[r][i][1] + v[r][i][2] * v[r][i][2] + v[r][i][3] * v[r][i][3];
            ss[r] = a; }
#pragma unroll
        for (int o = 32; o >= 1; o >>= 1) { ss[0] += __shfl_xor(ss[0], o); ss[1] += __shfl_xor(ss[1], o); }
#pragma unroll
        for (int i = 0; i < 4; ++i) { const int d = 256 * i + 4 * lane;
            const f32x4 g = *(const f32x4*)(p.norm2_g + d), sh = *(const f32x4*)(ada + b * 6144 + 3072 + d), sc = *(const f32x4*)(ada + b * 6144 + 4096 + d);
#pragma unroll
            for (int r = 0; r < 2; ++r) { const float rs = rsqrtf(ss[r] * (1.0f / 1024.0f) + 1e-6f);
                v[r][i] = v[r][i] * rs * g * (sc + 1.0f) + sh;
                u32x2 w; w.x = cvt_pk_bf16(v[r][i][0], v[r][i][1]); w.y = cvt_pk_bf16(v[r][i][2], v[r][i][3]); *(u32x2*)(h2 + (size_t)(row0 + r) * 1024 + d) = w; } }
        float q[32];
#pragma unroll
        for (int e = 0; e < 16; ++e) { float a0 = 0.f, a1 = 0.f;
#pragma unroll
            for (int i = 0; i < 4; ++i) { const f32x4 w = *(const LAS f32x4*)(wrt + e * 1024 + 256 * i + 4 * lane);
                a0 += v[0][i][0] * w[0] + v[0][i][1] * w[1] + v[0][i][2] * w[2] + v[0][i][3] * w[3];
                a1 += v[1][i][0] * w[0] + v[1][i][1] * w[1] + v[1][i][2] * w[2] + v[1][i][3] * w[3]; }
            q[e] = a0; q[16 + e] = a1; }
#pragma unroll
        for (int j = 0; j < 16; ++j) { const bool up = (lane & 32) != 0; const float send = up ? q[j] : q[16 + j], keep = up ? q[16 + j] : q[j]; q[j] = keep + __shfl_xor(send, 32); }
#pragma unroll
        for (int j = 0; j < 8; ++j) { const bool up = (lane & 16) != 0; const float send = up ? q[j] : q[8 + j], keep = up ? q[8 + j] : q[j]; q[j] = keep + __shfl_xor(send, 16); }
#pragma unroll
        for (int j = 0; j < 4; ++j) { const bool up = (lane & 8) != 0; const float send = up ? q[j] : q[4 + j], keep = up ? q[4 + j] : q[j]; q[j] = keep + __shfl_xor(send, 8); }
#pragma unroll
        for (int j = 0; j < 2; ++j) { const bool up = (lane & 4) != 0; const float send = up ? q[j] : q[2 + j], keep = up ? q[2 + j] : q[j]; q[j] = keep + __shfl_xor(send, 4); }
        { const bool up = (lane & 2) != 0; const float send = up ? q[0] : q[1], keep = up ? q[1] : q[0]; q[0] = keep + __shfl_xor(send, 2); }
        float lg = q[0] + __shfl_xor(q[0], 1);
        float mx = lg;
#pragma unroll
        for (int o = 2; o <= 16; o <<= 1) mx = fmaxf(mx, __shfl_xor(mx, o));
        const float ex = expf(lg - mx); float sum = ex;
#pragma unroll
        for (int o = 2; o <= 16; o <<= 1) sum += __shfl_xor(sum, o);
        if (gridDim.x == 256) {
            LAS float* scl = (LAS float*)(lds + 64 * 1024);
            if ((lane & 1) == 0) scl[((lane >> 1) & 15) * 16 + wid * 2 + (lane >> 5)] = ex / sum;
            __syncthreads();
            if (tid < 128) { const int e = tid >> 3, q = tid & 7; const u64_t v2 = *(const LAS u64_t*)(scl + e * 16 + 2 * q);
                __hip_atomic_store((u64_t*)(scores + ((size_t)b * 16 + e) * 4096 + ((row0 - 2 * wid) & 4095) + 2 * q), v2, __ATOMIC_RELAXED, __HIP_MEMORY_SCOPE_AGENT); }
            asm volatile("s_waitcnt vmcnt(0)" ::: "memory");
            __syncthreads();
            if (tid == 0) (void)__hip_atomic_fetch_add((unsigned*)(p.ws + WS_BAR + 44 * KiB) + b * 64, 1u, __ATOMIC_RELAXED, __HIP_MEMORY_SCOPE_AGENT);
        } else if ((lane & 1) == 0) scores[((size_t)b * 16 + ((lane >> 1) & 15)) * 4096 + ((row0 + (lane >> 5)) & 4095)] = ex / sum;
    }
    __syncthreads();
}
__device__ __forceinline__ void phase7_topk(const Params& p, LAS unsigned char* lds) {
    const int bid = blockIdx.x; if (bid >= NB * NE) return;
    unsigned* c = (unsigned*)(p.ws + WS_BAR + 44 * KiB) + (bid >> 4) * 64;
    if (threadIdx.x < 64) { unsigned sp = 0;
        while ((unsigned)__builtin_amdgcn_readfirstlane(__hip_atomic_load(c, __ATOMIC_RELAXED, __HIP_MEMORY_SCOPE_AGENT)) < 256u) { __builtin_amdgcn_s_sleep(1); if (++sp > (1u << 22)) break; }
        __builtin_amdgcn_fence(__ATOMIC_ACQUIRE, "agent");
        asm volatile("s_waitcnt vmcnt(0)" ::: "memory"); }
    __syncthreads();
    topk_task(p, lds, bid);
}
__device__ __forceinline__ void phase7_weights(const Params& p) {
    constexpr int N_G = 16 * 16 * 6, N_D = 16 * 24 * 4;
    const bool fused = gridDim.x == 256;
    for (int j = 0; ; ++j) {
        int it;
        if (!fused) it = blockIdx.x + j * gridDim.x;
        else if (blockIdx.x >= 128) it = j < 4 ? (blockIdx.x - 128) + 128 * j : 512 + blockIdx.x + (j - 4) * 256;
        else it = 512 + blockIdx.x + j * 256;
        if (it >= 2 * N_G + N_D) break;
        if (it < 2 * N_G) { const int up = it >= N_G, j = up ? it - N_G : it, e = j / 96, r = j % 96, kb = r / 6, nb = r % 6;
            xpose_item<4>((up ? p.w_up_e : p.w_gate_e) + (size_t)e * 1024 * 1536, 1536, (bf16_t*)(p.ws + WS_WGU) + (size_t)e * 3072 * 1024, 1024, kb * 64, nb * 256, up ? 2 : 1); }
        else { const int j = it - 2 * N_G, e = j / 96, r = j % 96, kb = r >> 2, nb = r & 3;
            xpose_item<4>(p.w_down_e + (size_t)e * 1536 * 1024, 1024, (bf16_t*)(p.ws + WS_WD) + (size_t)e * 1024 * 1536, 1536, kb * 64, nb * 256, 0); }
    }
}

__device__ __forceinline__ void phase11(const Params& p, float* dst) {
    const int tid = tid_opaque(), lane = tid & 63, wid = tid >> 6;
    const float* ada = (const float*)(p.ws + WS_ADA); const int* slot_of = (const int*)(p.ws + WS_SLOT); const bf16_t* oute = (const bf16_t*)(p.ws + WS_OUTE); const bf16_t* x2b = (const bf16_t*)(p.ws + WS_X2B);
    const int stride = gridDim.x * 16;
    int row0 = (blockIdx.x * 8 + wid) * 2;
    int myslot = row0 < MLAT ? slot_of[((size_t)(row0 >> 12) * 16 + (lane & 15)) * 4096 + ((row0 & 4095) + ((lane >> 4) & 1))] : -1;
    for (; row0 < MLAT; row0 += stride) {
        const int b = row0 >> 12;
        const int nrow = row0 + stride; const int nslot = nrow < MLAT ? slot_of[((size_t)(nrow >> 12) * 16 + (lane & 15)) * 4096 + ((nrow & 4095) + ((lane >> 4) & 1))] : -1;
        f32x4 xv[2][4], acc[2][4];
#pragma unroll
        for (int r = 0; r < 2; ++r)
#pragma unroll
            for (int i = 0; i < 4; ++i) { const u32x2 w = *(const u32x2*)(x2b + (size_t)(row0 + r) * 1024 + 256 * i + 4 * lane); xv[r][i] = (f32x4){bf_lo(w.x), bf_hi(w.x), bf_lo(w.y), bf_hi(w.y)}; acc[r][i] = (f32x4){0.f, 0.f, 0.f, 0.f}; }
        const unsigned long long bal = __ballot(myslot >= 0);
        unsigned mask0 = (unsigned)(bal & 0xffffull), mask1 = (unsigned)((bal >> 16) & 0xffffull);
        while (mask0 | mask1) {
            int m[2][2];
#pragma unroll
            for (int j = 0; j < 2; ++j) { if (mask0) { const int e = __builtin_ctz(mask0); mask0 &= mask0 - 1; m[0][j] = __builtin_amdgcn_readlane(myslot, e); } else m[0][j] = MMOE;
                                          if (mask1) { const int e = __builtin_ctz(mask1); mask1 &= mask1 - 1; m[1][j] = __builtin_amdgcn_readlane(myslot, 16 + e); } else m[1][j] = MMOE; }
            u32x2 w[2][2][4];
#pragma unroll
            for (int r = 0; r < 2; ++r)
#pragma unroll
                for (int j = 0; j < 2; ++j)
#pragma unroll
                    for (int i = 0; i < 4; ++i) w[r][j][i] = *(const u32x2*)(oute + (size_t)m[r][j] * 1024 + 256 * i + 4 * lane);
#pragma unroll
            for (int r = 0; r < 2; ++r)
#pragma unroll
                for (int j = 0; j < 2; ++j)
#pragma unroll
                    for (int i = 0; i < 4; ++i) { acc[r][i][0] += bf_lo(w[r][j][i].x); acc[r][i][1] += bf_hi(w[r][j][i].x); acc[r][i][2] += bf_lo(w[r][j][i].y); acc[r][i][3] += bf_hi(w[r][j][i].y); }
        }
        float ss[2];
#pragma unroll
        for (int r = 0; r < 2; ++r) { float a = 0.f;
#pragma unroll
            for (int i = 0; i < 4; ++i) { const int d = 256 * i + 4 * lane; const f32x4 g2 = *(const f32x4*)(ada + b * 6144 + 5120 + d); xv[r][i] += g2 * acc[r][i];
                a += xv[r][i][0] * xv[r][i][0] + xv[r][i][1] * xv[r][i][1] + xv[r][i][2] * xv[r][i][2] + xv[r][i][3] * xv[r][i][3]; }
            ss[r] = a; }
#pragma unroll
        for (int o = 32; o >= 1; o >>= 1) { ss[0] += __shfl_xor(ss[0], o); ss[1] += __shfl_xor(ss[1], o); }
#pragma unroll
        for (int r = 0; r < 2; ++r) { const float rs = rsqrtf(ss[r] * (1.0f / 1024.0f) + 1e-6f);
#pragma unroll
            for (int i = 0; i < 4; ++i) { const int d = 256 * i + 4 * lane; *(f32x4*)(dst + (size_t)(row0 + r) * 1024 + d) = xv[r][i] * rs * *(const f32x4*)(p.final_g + d); } }
        myslot = nslot;
    }
}

#define XB_TMO      128
#define XB_XCNT(j)  (256  + 64 * (j))
#define XB_XSUB(j)  (1280 + 64 * (j))
#define XB_XGEN(j)  (2304 + 64 * (j))
#define XB_TOP      3328
#define XB_TOPGEN   3392
#define XCD_BAR_WORDS 3456
#define XB_SPIN_CAP (1u << 22)
__device__ __forceinline__ unsigned xb_ld(unsigned* p)              { return __hip_atomic_load(p, __ATOMIC_RELAXED, __HIP_MEMORY_SCOPE_AGENT); }
__device__ __forceinline__ unsigned xb_add(unsigned* p, unsigned v) { return __hip_atomic_fetch_add(p, v, __ATOMIC_RELAXED, __HIP_MEMORY_SCOPE_AGENT); }
__device__ __forceinline__ unsigned xb_xcc_id() { return (unsigned)__builtin_amdgcn_s_getreg((3 << 11) | 20) & 0xFu; }
#define XB_SPIN(cond, bar) do { unsigned _sp = 0; while (cond) { __builtin_amdgcn_s_sleep(1); \
    if ((++_sp & 255u) == 0u) { if (xb_ld(&(bar)[XB_TMO])) break; if (_sp > XB_SPIN_CAP) { atomicAdd(&(bar)[XB_TMO], 1u); break; } } } } while (0)
struct XcdBarrier { unsigned* bar; unsigned x; volatile LAS unsigned* st; };
__device__ __forceinline__ XcdBarrier xcd_barrier_post(unsigned* bar, volatile LAS unsigned* st) {
    XcdBarrier b; b.bar = bar; b.x = xb_xcc_id(); b.st = st;
    if (threadIdx.x == 0) (void)xb_add(&bar[XB_XCNT(b.x)], 1u);
    return b;
}
__device__ __forceinline__ void xcd_barrier_complete(unsigned* bar, unsigned x, unsigned& nloc, unsigned& nx) {
    const unsigned G = gridDim.x * gridDim.y * gridDim.z;
    unsigned sum, cnt, mine, sp = 0u;
    for (;;) {
        sum = 0u; cnt = 0u; mine = 0u;
#pragma unroll
        for (unsigned j = 0; j < 16; ++j) { const unsigned c = xb_ld(&bar[XB_XCNT(j)]); sum += c; cnt += (c > 0u) ? 1u : 0u; mine = (j == x) ? c : mine; }
        if (sum == G) break;
        __builtin_amdgcn_s_sleep(1);
        if ((++sp & 255u) == 0u) { if (xb_ld(&bar[XB_TMO])) break; if (sp > XB_SPIN_CAP) { atomicAdd(&bar[XB_TMO], 1u); break; } }
    }
    nloc = mine > 0u ? mine : 1u; nx = cnt > 0u ? cnt : 1u;
}
__device__ __forceinline__ void xcd_barrier(const XcdBarrier& b) {
    asm volatile("s_waitcnt vmcnt(0)" ::: "memory");
    __syncthreads();
    if (threadIdx.x == 0) {
        unsigned* bar = b.bar;
        __builtin_amdgcn_s_waitcnt(0);
        unsigned nloc = b.st[0], nx = b.st[1];
        if (nloc == 0u) { xcd_barrier_complete(bar, b.x, nloc, nx); b.st[0] = nloc; b.st[1] = nx; }
        const unsigned old = xb_add(&bar[XB_XSUB(b.x)], 1u);
        const unsigned gen = old / nloc;
        if (old + 1u == (gen + 1u) * nloc) {
            __builtin_amdgcn_fence(__ATOMIC_RELEASE, "agent");
            asm volatile("s_waitcnt vmcnt(0)" ::: "memory");
            const unsigned og = xb_add(&bar[XB_TOP], 1u);
            const unsigned tg = og / nx;
            if (og + 1u == (tg + 1u) * nx) xb_add(&bar[XB_TOPGEN], 1u);
            else XB_SPIN(xb_ld(&bar[XB_TOPGEN]) == tg, bar);
            __builtin_amdgcn_fence(__ATOMIC_ACQUIRE, "agent");
            xb_add(&bar[XB_XGEN(b.x)], 1u);
            asm volatile("s_waitcnt vmcnt(0)" ::: "memory");
        } else {
            XB_SPIN(xb_ld(&bar[XB_XGEN(b.x)]) == gen, bar);
            __builtin_amdgcn_fence(__ATOMIC_ACQUIRE, "agent");
            asm volatile("s_waitcnt vmcnt(0)" ::: "memory");
        }
    }
    __syncthreads();
}

__global__ void __launch_bounds__(NTHR, 2) fwd_megakernel(Params p_in) {
    Params p = p_in;
    extern __shared__ __attribute__((aligned(16))) unsigned char lds_raw[];
    LAS unsigned char* lds = (LAS unsigned char*)lds_raw;
    cg::grid_group grid = cg::this_grid();
    const int G = gridDim.x, bid = blockIdx.x;
    unsigned char* ws = p.ws;
    bf16_t* const R1 = (bf16_t*)(ws + WS_R1); bf16_t* const Zb = (bf16_t*)(ws + WS_RZ); bf16_t* const PQt = (bf16_t*)(ws + WS_RPQ); bf16_t* const MRG = (bf16_t*)(ws + WS_R2);
    bf16_t* const Fb = (bf16_t*)((unsigned char*)p.out + OUT_F); bf16_t* const Ytb = (bf16_t*)((unsigned char*)p.out + OUT_YT);
#ifdef ONLY_PH
#define PH(k) ((k) == ONLY_PH && p.ph_lo <= (k) && (k) < p.ph_hi)
#else
#define PH(k) (p.ph_lo <= (k) && (k) < p.ph_hi)
#endif
    volatile LAS unsigned* xst = (volatile LAS unsigned*)(lds + LDS_BYTES - 16);
    if (threadIdx.x < 4) xst[threadIdx.x] = 0u;
    __syncthreads();
    XcdBarrier xbar = xcd_barrier_post((unsigned*)(ws + WS_BAR), xst);
    if (p.ph_lo < 0) grid.sync();
#ifdef TS_A
    unsigned long long* tsb = (unsigned long long*)(ws + WS_BAR + 40 * KiB);
#define STAMP(i) do { if (bid == 0 && threadIdx.x == 0) tsb[i] = __builtin_amdgcn_s_memrealtime(); } while (0)
#else
#define STAMP(i) do { } while (0)
#endif
    STAMP(0);
#define LAUNDER() do { asm volatile("" : "+s"(p.ws), "+s"(p.out), "+s"(p.x)); ws = p.ws; } while (0)
#define SYNC(k) do { if (PH(k) && PH((k) + 1)) xcd_barrier(xbar); STAMP((k) + 1); LAUNDER(); } while (0)
#ifndef REPMASK
#define REPMASK 0
#endif
#define REP(k) for (int rep_ = 0; rep_ <= ((REPMASK >> (k)) & 1); ++rep_)
    if (PH(0)) REP(0) phase0(p, lds);
    SYNC(0);
    if (PH(1)) REP(1) phase1(p);
    SYNC(1);
    if (PH(2)) REP(2) {
        { ProbPQ pr{(const bf16_t*)(ws + WS_WPQ), R1, 1024, 1024, 16384}; pg8::Order S; S.init(4, 128, G, bid); EpiPQ E{PQt}; pg8::gemm_phase(lds, pr, S, E); }
        { ProbPlain pr{R1, (const bf16_t*)(ws + WS_WIN), 1024, 1024, 1024}; pg8::Order S; S.init(128, 16, G, bid); EpiZ E{Zb, 4096, -1}; pg8::gemm_phase(lds, pr, S, E); }
        { ProbPlain pr{(const bf16_t*)(ws + WS_HCTX), (const bf16_t*)(ws + WS_WIN), 1024, 1024, 1024}; pg8::Order S; S.init(8, 4, G, bid); EpiZ E{(bf16_t*)(ws + WS_ZXC), 1024, 0}; pg8::gemm_phase(lds, pr, S, E); }
    }
    SYNC(2);
    if (PH(3)) REP(3) {
        {
            ProbPlain pr{(const bf16_t*)(ws + WS_D1T), PQt, 512, 512, 512}; pg8::Order S; S.init(2, 256, G, bid);
            if (G == 256) { if (bid >= 128) { S.G = 128; S.c = bid - 128; S.base = 0; S.lim = 3; } else { S.G = 128; S.c = bid; S.base = 384; S.lim = 1; } }
            EpiPlain E{Ytb, 65536}; pg8::gemm_phase(lds, pr, S, E); }
        for (int it = bid; it < NB * 2 * 8; it += G) lru_tile<false>(p, lds, it);
    }
    SYNC(3);
    if (PH(4)) {
        fft_stage2_all(p, lds);
        const int ngr = G >> 5;
        if (ngr > 0 && bid < ngr * 32) lru2_block(p, lds, bid % ngr, bid / ngr, ngr);
    }
    SYNC(4);
    if (PH(5)) REP(5) {
        { ProbMerge pr{Fb, (const bf16_t*)(ws + WS_WFOUR), R1, (const bf16_t*)(ws + WS_WLRU), 512, 1024, 512, 512, 1024, 1024}; pg8::Order S; S.init(128, 4, G, bid); EpiMerge E{MRG, Zb}; pg8::gemm_phase2(lds, pr, S, E); }
    }
    SYNC(5);
    if (PH(6)) REP(6) { ProbPlain pr{MRG, (const bf16_t*)(ws + WS_WOUT), 1024, 1024, 1024}; pg8::Order S; S.init(128, 4, G, bid);
        EpiOut E{(bf16_t*)(ws + WS_X2B), p.x, (const float*)(ws + WS_POS), (const float*)(ws + WS_ADA)}; pg8::gemm_phase(lds, pr, S, E); }
    SYNC(6);
    if (PH(7)) { phase7_rows(p, lds); if (G == 256) phase7_topk(p, lds); phase7_weights(p); }
    SYNC(7);
    if (PH(8) && G != 256) { for (int it = bid; it < NB * NE; it += G) topk_task(p, lds, it); }
    if (G != 256) SYNC(8);
    if (PH(9)) REP(9) { ProbMoeUp pr{(const bf16_t*)(ws + WS_H2), (const bf16_t*)(ws + WS_WGU), (const int*)(ws + WS_IDX), 1024, 1024, 1024}; pg8::Order S; S.init(256, 12, G, bid); EpiGU E{(bf16_t*)(ws + WS_HID)}; pg8::gemm_phase(lds, pr, S, E); }
    SYNC(9);
    if (PH(10)) { if (bid == 0 && threadIdx.x < 128) *(u32x4*)(ws + WS_OUTE + (size_t)MMOE * 2048 + threadIdx.x * 16) = (u32x4){0u, 0u, 0u, 0u}; }
    if (PH(10)) REP(10) { ProbMoeDown pr{(const bf16_t*)(ws + WS_HID), (const bf16_t*)(ws + WS_WD), 1536, 1536, 1536}; pg8::Order S; S.init(256, 4, G, bid); EpiDown E{(bf16_t*)(ws + WS_OUTE), (const float*)(ws + WS_GATE)}; pg8::gemm_phase(lds, pr, S, E); }
    SYNC(10);
    if (PH(11)) phase11(p, p.out);
#ifdef TS_A
    xcd_barrier(xbar); STAMP(12);
    if (bid == 0 && threadIdx.x == 0) {

#ifndef TS_AE
#define TS_AE (TS_A + 1)
#endif
#ifndef TS_BE
#define TS_BE (TS_B + 1)
#endif
        const float ta = (float)(tsb[TS_AE] - tsb[TS_A]) * 0.01f * (float)(TS_SA), tb = (float)(tsb[TS_BE] - tsb[TS_B]) * 0.01f * (float)(TS_SB);
        p.out[7] = fminf(ta, 97.f); p.out[1024 * 5 + 9] = fminf(tb, 97.f); }
#endif
}

#ifndef N_LAUNCHES
#define N_LAUNCHES 1
#endif
#ifndef PROBE_DUP
#define PROBE_DUP 0x0
#endif
extern "C" void kernel_launch(void* const* d_in, const int* in_sizes, int n_in, void* d_out, int out_size, void* d_ws, size_t ws_size, hipStream_t stream) {
    static int grid = 0;
    if (grid == 0) {
        if (n_in != 24 || out_size != MLAT * DM || ws_size < WS_END) { fprintf(stderr, "kernel_launch: unexpected shapes (n_in %d out %d ws %zu)\n", n_in, out_size, ws_size); grid = -1; return; }
        int dev = 0, cus = 0, per_cu = 0;
        hipGetDevice(&dev); hipDeviceGetAttribute(&cus, hipDeviceAttributeMultiprocessorCount, dev);
        hipFuncSetAttribute((const void*)fwd_megakernel, hipFuncAttributeMaxDynamicSharedMemorySize, LDS_BYTES);
        hipOccupancyMaxActiveBlocksPerMultiprocessor(&per_cu, (const void*)fwd_megakernel, NTHR, LDS_BYTES);
        if (per_cu < 1) { fprintf(stderr, "kernel_launch: occupancy query reports %d blocks per CU\n", per_cu); per_cu = 1; }
        grid = cus * 1;
        (void)hipGetLastError();
    }
    if (grid < 0) return;
    Params p{};
    const float** f = (const float**)&p;
    for (int i = 0; i < 24; ++i) f[i] = (const float*)d_in[i];
    p.out = (float*)d_out; p.ws = (unsigned char*)d_ws;
    (void)hipMemsetAsync((unsigned char*)d_ws + WS_BAR, 0, 48 * KiB, stream);
#if N_LAUNCHES == 1
    p.ph_lo = 0; p.ph_hi = 12;
    void* args[] = {&p};
    hipError_t e = hipLaunchCooperativeKernel((const void*)fwd_megakernel, dim3(grid), dim3(NTHR), args, LDS_BYTES, stream);
    if (e != hipSuccess) fprintf(stderr, "cooperative launch failed: %s (grid %d)\n", hipGetErrorString(e), grid);
#else
    for (int k = 0; k < 12; ++k) for (int r = 0; r <= ((PROBE_DUP >> k) & 1); ++r) { p.ph_lo = k; p.ph_hi = k + 1; if (k == 11 && r == 0 && ((PROBE_DUP >> 11) & 1)) { p.ph_lo = 12; p.ph_hi = 13; } hipLaunchKernelGGL(fwd_megakernel, dim3(grid), dim3(NTHR), LDS_BYTES, stream, p); }
#endif
}
```

```cpp
#include <hip/hip_runtime.h>
#include <hip/hip_cooperative_groups.h>
#include <cstdio>
namespace cg = cooperative_groups;

#define LAS __attribute__((address_space(3)))
typedef unsigned short bf16_t;
typedef short bf16x8 __attribute__((ext_vector_type(8)));
typedef float f32x4 __attribute__((ext_vector_type(4)));
typedef float f32x16 __attribute__((ext_vector_type(16)));
typedef unsigned u32x4 __attribute__((ext_vector_type(4)));
typedef unsigned u32x2 __attribute__((ext_vector_type(2)));

constexpr int NB = 8, TT = 4096, DM = 1024, CTXL = 256, MLAT = NB * TT, MCTX = NB * CTXL;
constexpr int NE = 16, CAP = 512, DE = 1536, MMOE = NE * NB * CAP;
constexpr int NSEQ = 34;
constexpr int NTHR = 512;
constexpr float NLOG2E = -1.4426950408889634f;
constexpr int LDS_BYTES = 144 * 1024;

constexpr size_t KiB = 1024, MiB = 1024 * 1024;
constexpr size_t WS_ADA = 0;
constexpr size_t WS_POS = 256 * KiB;
constexpr size_t WS_AGG = 512 * KiB;
constexpr size_t WS_WPQ = 5 * MiB;
constexpr size_t WS_WIN = 7 * MiB;
constexpr size_t WS_WFOUR = 15 * MiB;
constexpr size_t WS_WLRU = 16 * MiB;
constexpr size_t WS_WOUT = 18 * MiB;
constexpr size_t WS_WAT = 20 * MiB;
constexpr size_t WS_WIT = 20 * MiB + 512 * KiB;
constexpr size_t WS_SCORES = 21 * MiB;
constexpr size_t WS_IDX = 23 * MiB;
constexpr size_t WS_GATE = 23 * MiB + 256 * KiB;
constexpr size_t WS_SLOT = 23 * MiB + 512 * KiB;
constexpr size_t WS_BAR = 25 * MiB + 512 * KiB;
constexpr size_t WS_D1T = 34 * MiB;
constexpr size_t WS_D2T = 34 * MiB + 512 * KiB;
constexpr size_t WS_HCTX = 26 * MiB;
constexpr size_t WS_ZXC = 30 * MiB;
constexpr size_t WS_R1 = 40 * MiB;
constexpr size_t WS_RPQ = 104 * MiB;
constexpr size_t WS_R2 = 168 * MiB;
constexpr size_t WS_RZ = 232 * MiB;
constexpr size_t WS_END = 504 * MiB;
constexpr size_t WS_X2B = WS_R1, WS_H2 = WS_RPQ, WS_WGU = 168 * MiB, WS_WD = 264 * MiB, WS_HID = 312 * MiB, WS_OUTE = WS_RPQ;
constexpr size_t OUT_YT = 0, OUT_F = 64 * MiB;

struct Params {
    const float *x, *c, *ctx, *c_ctx, *w_ada, *b_ada, *norm1_g, *norm2_g, *w_in, *w_four, *conv_w, *conv_b, *lru_lambda,
        *lru_wa, *lru_ba, *lru_wi, *lru_bi, *w_lru, *w_out, *w_router, *w_gate_e, *w_up_e, *w_down_e, *final_g;
    float* out; unsigned char* ws; int ph_lo, ph_hi;
};

__device__ __forceinline__ int tid_opaque() { int t = threadIdx.x; asm volatile("" : "+v"(t)); return t; }
__device__ __forceinline__ unsigned cvt_pk_bf16(float lo, float hi) { unsigned r; asm volatile("v_cvt_pk_bf16_f32 %0, %1, %2" : "=v"(r) : "v"(lo), "v"(hi)); return r; }
__device__ __forceinline__ float bf_lo(unsigned w) { return __uint_as_float(w << 16); }
__device__ __forceinline__ float bf_hi(unsigned w) { return __uint_as_float(w & 0xffff0000u); }
__device__ __forceinline__ float bf2f(bf16_t h) { return __uint_as_float(((unsigned)h) << 16); }
__device__ __forceinline__ float sigmoidf_(float v) { return __builtin_amdgcn_rcpf(1.0f + __expf(-v)); }
__device__ __forceinline__ float gelu_tanh(float v) { const float y = 1.5957691216f * (v + 0.044715f * v * v * v); return v * sigmoidf_(y); }
__device__ __forceinline__ float wave_sum(float v) {
#pragma unroll
    for (int o = 32; o >= 1; o >>= 1) v += __shfl_xor(v, o);
    return v;
}
__device__ __forceinline__ void unpack8(const u32x4 w, float (&f)[8]) { f[0] = bf_lo(w.x); f[1] = bf_hi(w.x); f[2] = bf_lo(w.y); f[3] = bf_hi(w.y); f[4] = bf_lo(w.z); f[5] = bf_hi(w.z); f[6] = bf_lo(w.w); f[7] = bf_hi(w.w); }

namespace pg8 {
constexpr int BM = 256, BK = 64, HALF = 128, HTB = HALF * BK * 2, STAGE_BYTES = 8 * HTB, NXCD = 8, WGM = 8;
__device__ __forceinline__ int lds_byte(int r, int c) { const int st = (r >> 4) * 2 + (c >> 5), rr = r & 15, cc = c & 31, ob = rr * 64 + cc * 2; return st * 1024 + (ob ^ (((ob >> 9) & 1) << 5)); }
__device__ __forceinline__ void stage_rc(int b, int& R, int& C) { const int st = b / 1024, sb = b % 1024, swz = sb ^ (((sb >> 9) & 1) << 5); R = (st >> 1) * 16 + swz / 64; C = (st & 1) * 32 + (swz % 64) / 2; }
__device__ __forceinline__ int perm32(int rho) { const int n = rho >> 4, i = rho & 15; return 8 * (i >> 2) + 4 * n + (i & 3); }
struct Unit { int pm, pn; };
struct Order {
    int nM, nN, nwg, G, c, base, lim, rev;
    __device__ void init(int nM_, int nN_, int G_, int c_) { nM = nM_; nN = nN_; nwg = nM * nN; G = G_; c = c_; base = 0; lim = 0x7fffffff; rev = 0; }
    __device__ bool next(int i, Unit& u) const {
        if (rev > 0 && i >= rev) return false;
        const long L = (long)base + (long)(rev > 0 ? rev - 1 - i : i) * G + c; if (i >= lim || L >= nwg) return false;
        int wgid = (int)L; { const int q = nwg / NXCD, r = nwg % NXCD, xcd = wgid % NXCD, off = wgid / NXCD; wgid = (xcd < r ? xcd * (q + 1) : r * (q + 1) + (xcd - r) * q) + off; }
        const int nig = WGM * nN, gid = wgid / nig, fm = gid * WGM, gsz = (nM - fm) < WGM ? (nM - fm) : WGM;
        u.pm = fm + ((wgid % nig) % gsz); u.pn = (wgid % nig) / gsz; return true;
    }
};
template <class P, class Epi>
__device__ __forceinline__ void gemm_phase(LAS unsigned char* lds, const P& pr, const Order& S, const Epi& E) {
    const int tid = tid_opaque(), wid = __builtin_amdgcn_readfirstlane(tid >> 6), lane = tid & 63, wr = wid >> 2, wc = wid & 3, fr = lane & 15, fq = lane >> 4;
    const int nt = pr.K / BK;
    int RA[2], CA[2]; unsigned voffB[2];
#pragma unroll
    for (int i = 0; i < 2; ++i) { int R, C; stage_rc(tid * 16 + i * 8192, R, C); RA[i] = R; CA[i] = C; const int Rb = Epi::PERM ? ((R & ~31) + perm32(R & 31)) : R; voffB[i] = (unsigned)(Rb * pr.ldb + C) * 2u; }
    const size_t kstep = (size_t)(BK * 2);
    const size_t hstepB = (size_t)HALF * pr.ldb * 2;
    const unsigned ldsw = (unsigned)wid * 1024u;
    const int aoff = lds_byte(wr * 64 + fr, fq * 8), boff = lds_byte(wc * 32 + fr, fq * 8);
#define PG8_SA(b, h) (((b) * 2 + (h)) * HTB)
#define PG8_SB(b, h) ((4 + (b) * 2 + (h)) * HTB)
#define PG8_STAGE(bufoff, gbase, voff) do { _Pragma("unroll") for (int _i = 0; _i < 2; ++_i) \
        __builtin_amdgcn_global_load_lds((const unsigned*)((const char*)(gbase) + (voff)[_i]), (LAS unsigned*)(lds + (bufoff) + ldsw + _i * 8192), 16, 0, 0); } while (0)
#define PG8_LDA(dst, b, h) do { _Pragma("unroll") for (int m = 0; m < 4; ++m) _Pragma("unroll") for (int k = 0; k < 2; ++k) dst[m][k] = *(const LAS bf16x8*)(lds + PG8_SA(b, h) + aoff + m * 2048 + k * 1024); } while (0)
#define PG8_LDB(dst, b, h) do { _Pragma("unroll") for (int n = 0; n < 2; ++n) _Pragma("unroll") for (int k = 0; k < 2; ++k) dst[n][k] = *(const LAS bf16x8*)(lds + PG8_SB(b, h) + boff + n * 2048 + k * 1024); } while (0)
#define PG8_MMA(ai, bj, At, Bt) do { __builtin_amdgcn_s_setprio(1); _Pragma("unroll") for (int m = 0; m < 4; ++m) _Pragma("unroll") for (int n = 0; n < 2; ++n) _Pragma("unroll") for (int k = 0; k < 2; ++k) \
        acc[ai][bj][m][n] = __builtin_amdgcn_mfma_f32_16x16x32_bf16(Bt[n][k], At[m][k], acc[ai][bj][m][n], 0, 0, 0); __builtin_amdgcn_s_setprio(0); } while (0)
#define PG8_WAIT_V(n) asm volatile("s_waitcnt vmcnt(" #n ")" ::: "memory")
#define PG8_WAIT_L(n) asm volatile("s_waitcnt lgkmcnt(" #n ")" ::: "memory")
#define PG8_BAR __builtin_amdgcn_s_barrier()
#define PG8_SCHED __builtin_amdgcn_sched_barrier(0)
    Unit cur, nxt; int ui = 0;
    if (!S.next(0, cur)) return;
    f32x4 acc[2][2][4][2];
#pragma unroll
    for (int a = 0; a < 2; ++a)
#pragma unroll
        for (int b = 0; b < 2; ++b)
#pragma unroll
            for (int m = 0; m < 4; ++m)
#pragma unroll
                for (int n = 0; n < 2; ++n) acc[a][b][m][n] = (f32x4){0.f, 0.f, 0.f, 0.f};
    bf16x8 At[4][2], B0[2][2], B1[2][2];
    unsigned vA[2][2], vN[2][2];
    pr.avoff(cur, RA, CA, vA);
#pragma unroll
    for (int h = 0; h < 2; ++h)
#pragma unroll
        for (int i = 0; i < 2; ++i) vN[h][i] = vA[h][i];
    const char* cA = pr.abase(cur); const char* cB = pr.bbase(cur);
#define PG8_ROT(u) 0
#define PG8_KT(tt, rot) ((size_t)(((tt) + (rot)) >= nt ? ((tt) + (rot)) - nt : ((tt) + (rot))) * kstep)
    int rot = PG8_ROT(cur);
    { const char* pA = cA + PG8_KT(0, rot); const char* pB = cB + PG8_KT(0, rot);
    PG8_STAGE(PG8_SB(0, 0), pB, voffB); PG8_STAGE(PG8_SA(0, 0), pA, vA[0]); PG8_STAGE(PG8_SB(0, 1), pB + hstepB, voffB); PG8_STAGE(PG8_SA(0, 1), pA, vA[1]);
    if (wr == 1) PG8_BAR;
    PG8_WAIT_V(4); PG8_BAR;
    PG8_STAGE(PG8_SB(1, 0), pB + kstep, voffB); PG8_STAGE(PG8_SA(1, 0), pA + kstep, vA[0]); PG8_STAGE(PG8_SB(1, 1), pB + hstepB + kstep, voffB); }
    PG8_WAIT_V(6); PG8_BAR;
    for (;;) {
        const bool has_next = S.next(ui + 1, nxt);
        const char* nA = has_next ? pr.abase(nxt) : cA; const char* nB = has_next ? pr.bbase(nxt) : cB; const int nrot = has_next ? PG8_ROT(nxt) : rot;
        if (P::GATHER) { if (has_next) pr.avoff(nxt, RA, CA, vN); }
        for (int t = 0; t < nt; t += 2) {
            const bool last = (t == nt - 2);
            const char* a1 = cA + PG8_KT(t + 1, rot);
            const char* a2 = last ? nA + PG8_KT(0, nrot) : cA + PG8_KT(t + 2, rot); const char* b2 = last ? nB + PG8_KT(0, nrot) : cB + PG8_KT(t + 2, rot);
            const char* a3 = a2 + kstep; const char* b3 = b2 + kstep;
            unsigned v2[2][2];
#pragma unroll
            for (int h = 0; h < 2; ++h)
#pragma unroll
                for (int i = 0; i < 2; ++i) v2[h][i] = (P::GATHER && last) ? vN[h][i] : vA[h][i];
            PG8_LDB(B0, 0, 0); PG8_SCHED; PG8_LDA(At, 0, 0); PG8_STAGE(PG8_SA(1, 1), a1, vA[1]);
            PG8_WAIT_L(8); PG8_BAR; PG8_WAIT_L(0); PG8_MMA(0, 0, At, B0); PG8_BAR; PG8_SCHED;
            PG8_LDB(B1, 0, 1); PG8_STAGE(PG8_SB(0, 0), b2, voffB);
            PG8_BAR; PG8_WAIT_L(0); PG8_MMA(0, 1, At, B1); PG8_BAR;
            PG8_LDA(At, 0, 1); PG8_STAGE(PG8_SA(0, 0), a2, v2[0]);
            PG8_BAR; PG8_WAIT_L(0); PG8_MMA(1, 0, At, B0); PG8_BAR; PG8_SCHED;
            PG8_STAGE(PG8_SB(0, 1), b2 + hstepB, voffB);
            PG8_WAIT_V(6); PG8_BAR; PG8_MMA(1, 1, At, B1); PG8_BAR;
            PG8_LDB(B0, 1, 0); PG8_SCHED; PG8_LDA(At, 1, 0); PG8_STAGE(PG8_SA(0, 1), a2, v2[1]);
            PG8_WAIT_L(8); PG8_BAR; PG8_WAIT_L(0); PG8_MMA(0, 0, At, B0); PG8_BAR; PG8_SCHED;
            PG8_LDB(B1, 1, 1); PG8_STAGE(PG8_SB(1, 0), b3, voffB);
            PG8_BAR; PG8_WAIT_L(0); PG8_MMA(0, 1, At, B1); PG8_BAR;
            PG8_LDA(At, 1, 1); PG8_STAGE(PG8_SA(1, 0), a3, v2[0]);
            PG8_BAR; PG8_WAIT_L(0); PG8_MMA(1, 0, At, B0); PG8_BAR; PG8_SCHED;
            PG8_STAGE(PG8_SB(1, 1), b3 + hstepB, voffB);
            PG8_WAIT_V(6); PG8_BAR; PG8_MMA(1, 1, At, B1); PG8_BAR;
            if (P::GATHER && last) {
#pragma unroll
                for (int h = 0; h < 2; ++h)
#pragma unroll
                    for (int i = 0; i < 2; ++i) vA[h][i] = vN[h][i];
            }
        }
        E(acc, cur, wr, wc, fr, fq);
        if (!has_next) break;
#pragma unroll
        for (int a = 0; a < 2; ++a)
#pragma unroll
            for (int b = 0; b < 2; ++b)
#pragma unroll
                for (int m = 0; m < 4; ++m)
#pragma unroll
                    for (int n = 0; n < 2; ++n) acc[a][b][m][n] = (f32x4){0.f, 0.f, 0.f, 0.f};
        cur = nxt; cA = nA; cB = nB; rot = nrot; ++ui;
    }
    PG8_WAIT_V(0);
    if (wr == 0) PG8_BAR;
    PG8_BAR;
#undef PG8_ROT
#undef PG8_KT
#undef PG8_SA
#undef PG8_SB
#undef PG8_STAGE
#undef PG8_LDA
#undef PG8_LDB
#undef PG8_MMA
#undef PG8_WAIT_V
#undef PG8_WAIT_L
#undef PG8_BAR
#undef PG8_SCHED
}
template <class P, class Epi>
__device__ __forceinline__ void gemm_phase2(LAS unsigned char* lds, const P& pr, const Order& S, const Epi& E) {
    const int tid = tid_opaque(), wid = __builtin_amdgcn_readfirstlane(tid >> 6), lane = tid & 63, wr = wid >> 2, wc = wid & 3, fr = lane & 15, fq = lane >> 4;
    const int nt1 = pr.K1 / BK, nt = (pr.K1 + pr.K2) / BK;
    unsigned R2[2], Rb2[2], C2[2];
#pragma unroll
    for (int i = 0; i < 2; ++i) { int R, C; stage_rc(tid * 16 + i * 8192, R, C); const int Rb = Epi::PERM ? ((R & ~31) + perm32(R & 31)) : R; R2[i] = (unsigned)R * 2u; Rb2[i] = (unsigned)Rb * 2u; C2[i] = (unsigned)C * 2u; }
#define OFF_A(ld, h, i) ((R2[i] + (unsigned)((h) * 256)) * (unsigned)(ld) + C2[i])
#define OFF_B(ld, i) (Rb2[i] * (unsigned)(ld) + C2[i])
    const size_t kstep = (size_t)(BK * 2);
    const size_t hB1 = (size_t)HALF * pr.ldb1 * 2, hB2 = (size_t)HALF * pr.ldb2 * 2;
    const unsigned ldsw = (unsigned)wid * 1024u;
    const int aoff = lds_byte(wr * 64 + fr, fq * 8), boff = lds_byte(wc * 32 + fr, fq * 8);
#define PG8_SA(b, h) (((b) * 2 + (h)) * HTB)
#define PG8_SB(b, h) ((4 + (b) * 2 + (h)) * HTB)
#define PG8_STAGE(bufoff, gbase, voff) do { _Pragma("unroll") for (int _i = 0; _i < 2; ++_i) \
        __builtin_amdgcn_global_load_lds((const unsigned*)((const char*)(gbase) + (voff)[_i]), (LAS unsigned*)(lds + (bufoff) + ldsw + _i * 8192), 16, 0, 0); } while (0)
#define PG8_LDA(dst, b, h) do { _Pragma("unroll") for (int m = 0; m < 4; ++m) _Pragma("unroll") for (int k = 0; k < 2; ++k) dst[m][k] = *(const LAS bf16x8*)(lds + PG8_SA(b, h) + aoff + m * 2048 + k * 1024); } while (0)
#define PG8_LDB(dst, b, h) do { _Pragma("unroll") for (int n = 0; n < 2; ++n) _Pragma("unroll") for (int k = 0; k < 2; ++k) dst[n][k] = *(const LAS bf16x8*)(lds + PG8_SB(b, h) + boff + n * 2048 + k * 1024); } while (0)
#define PG8_MMA(ai, bj, At, Bt) do { __builtin_amdgcn_s_setprio(1); _Pragma("unroll") for (int m = 0; m < 4; ++m) _Pragma("unroll") for (int n = 0; n < 2; ++n) _Pragma("unroll") for (int k = 0; k < 2; ++k) \
        acc[ai][bj][m][n] = __builtin_amdgcn_mfma_f32_16x16x32_bf16(Bt[n][k], At[m][k], acc[ai][bj][m][n], 0, 0, 0); __builtin_amdgcn_s_setprio(0); } while (0)
#define PG8_WAIT_V(n) asm volatile("s_waitcnt vmcnt(" #n ")" ::: "memory")
#define PG8_WAIT_L(n) asm volatile("s_waitcnt lgkmcnt(" #n ")" ::: "memory")
#define PG8_BAR __builtin_amdgcn_s_barrier()
#define PG8_SCHED __builtin_amdgcn_sched_barrier(0)
    Unit cur, nxt; int ui = 0;
    if (!S.next(0, cur)) return;
    f32x4 acc[2][2][4][2];
#pragma unroll
    for (int a = 0; a < 2; ++a)
#pragma unroll
        for (int b = 0; b < 2; ++b)
#pragma unroll
            for (int m = 0; m < 4; ++m)
#pragma unroll
                for (int n = 0; n < 2; ++n) acc[a][b][m][n] = (f32x4){0.f, 0.f, 0.f, 0.f};
    bf16x8 At[4][2], B0[2][2], B1[2][2];
    const char* cA1 = pr.abase1(cur); const char* cB1 = pr.bbase1(cur); const char* cA2 = pr.abase2(cur); const char* cB2 = pr.bbase2(cur);
#define T_A(tt) ((tt) < nt1 ? cA1 + (size_t)(tt) * kstep : cA2 + (size_t)((tt) - nt1) * kstep)
#define T_B(tt) ((tt) < nt1 ? cB1 + (size_t)(tt) * kstep : cB2 + (size_t)((tt) - nt1) * kstep)
    { unsigned vb[2] = {OFF_B(pr.ldb1, 0), OFF_B(pr.ldb1, 1)}, va0[2] = {OFF_A(pr.lda1, 0, 0), OFF_A(pr.lda1, 0, 1)}, va1[2] = {OFF_A(pr.lda1, 1, 0), OFF_A(pr.lda1, 1, 1)};
    PG8_STAGE(PG8_SB(0, 0), cB1, vb); PG8_STAGE(PG8_SA(0, 0), cA1, va0); PG8_STAGE(PG8_SB(0, 1), cB1 + hB1, vb); PG8_STAGE(PG8_SA(0, 1), cA1, va1);
    if (wr == 1) PG8_BAR;
    PG8_WAIT_V(4); PG8_BAR;
    PG8_STAGE(PG8_SB(1, 0), cB1 + kstep, vb); PG8_STAGE(PG8_SA(1, 0), cA1 + kstep, va0); PG8_STAGE(PG8_SB(1, 1), cB1 + hB1 + kstep, vb); }
    PG8_WAIT_V(6); PG8_BAR;
    for (;;) {
        const bool has_next = S.next(ui + 1, nxt);
        const char* nA = has_next ? pr.abase1(nxt) : cA1; const char* nB = has_next ? pr.bbase1(nxt) : cB1;
        for (int t = 0; t < nt; t += 2) {
            const bool last = (t == nt - 2);
            const bool s1 = (t + 1 < nt1), s2 = last || (t + 2 < nt1);
            const char* a1 = T_A(t + 1);
            const char* a2 = last ? nA : T_A(t + 2); const char* b2 = last ? nB : T_B(t + 2);
            const char* a3 = a2 + kstep; const char* b3 = b2 + kstep;
            const size_t hstepB = s2 ? hB1 : hB2; const int ldaT1 = s1 ? pr.lda1 : pr.lda2, ldaT2 = s2 ? pr.lda1 : pr.lda2, ldbT2 = s2 ? pr.ldb1 : pr.ldb2;
            unsigned v2[2][2], voffB[2], vA1s[2];
#pragma unroll
            for (int i = 0; i < 2; ++i) { voffB[i] = OFF_B(ldbT2, i); vA1s[i] = OFF_A(ldaT1, 1, i);
#pragma unroll
                for (int h = 0; h < 2; ++h) v2[h][i] = OFF_A(ldaT2, h, i); }
            PG8_LDB(B0, 0, 0); PG8_SCHED; PG8_LDA(At, 0, 0); PG8_STAGE(PG8_SA(1, 1), a1, vA1s);
            PG8_WAIT_L(8); PG8_BAR; PG8_WAIT_L(0); PG8_MMA(0, 0, At, B0); PG8_BAR; PG8_SCHED;
            PG8_LDB(B1, 0, 1); PG8_STAGE(PG8_SB(0, 0), b2, voffB);
            PG8_BAR; PG8_WAIT_L(0); PG8_MMA(0, 1, At, B1); PG8_BAR;
            PG8_LDA(At, 0, 1); PG8_STAGE(PG8_SA(0, 0), a2, v2[0]);
            PG8_BAR; PG8_WAIT_L(0); PG8_MMA(1, 0, At, B0); PG8_BAR; PG8_SCHED;
            PG8_STAGE(PG8_SB(0, 1), b2 + hstepB, voffB);
            PG8_WAIT_V(6); PG8_BAR; PG8_MMA(1, 1, At, B1); PG8_BAR;
            PG8_LDB(B0, 1, 0); PG8_SCHED; PG8_LDA(At, 1, 0); PG8_STAGE(PG8_SA(0, 1), a2, v2[1]);
            PG8_WAIT_L(8); PG8_BAR; PG8_WAIT_L(0); PG8_MMA(0, 0, At, B0); PG8_BAR; PG8_SCHED;
            PG8_LDB(B1, 1, 1); PG8_STAGE(PG8_SB(1, 0), b3, voffB);
            PG8_BAR; PG8_WAIT_L(0); PG8_MMA(0, 1, At, B1); PG8_BAR;
            PG8_LDA(At, 1, 1); PG8_STAGE(PG8_SA(1, 0), a3, v2[0]);
            PG8_BAR; PG8_WAIT_L(0); PG8_MMA(1, 0, At, B0); PG8_BAR; PG8_SCHED;
            PG8_STAGE(PG8_SB(1, 1), b3 + hstepB, voffB);
            PG8_WAIT_V(6); PG8_BAR; PG8_MMA(1, 1, At, B1); PG8_BAR;
            if (t == nt1 - 2) E.mid(acc, cur, wr, wc, fr, fq);
        }
        E(acc, cur, wr, wc, fr, fq);
        if (!has_next) break;
#pragma unroll
        for (int a = 0; a < 2; ++a)
#pragma unroll
            for (int b = 0; b < 2; ++b)
#pragma unroll
                for (int m = 0; m < 4; ++m)
#pragma unroll
                    for (int n = 0; n < 2; ++n) acc[a][b][m][n] = (f32x4){0.f, 0.f, 0.f, 0.f};
        cur = nxt; cA1 = nA; cB1 = nB; cA2 = pr.abase2(cur); cB2 = pr.bbase2(cur); ++ui;
    }
    PG8_WAIT_V(0);
    if (wr == 0) PG8_BAR;
    PG8_BAR;
#undef T_A
#undef T_B
#undef OFF_A
#undef OFF_B
#undef PG8_SA
#undef PG8_SB
#undef PG8_STAGE
#undef PG8_LDA
#undef PG8_LDB
#undef PG8_MMA
#undef PG8_WAIT_V
#undef PG8_WAIT_L
#undef PG8_BAR
#undef PG8_SCHED
}
}
using pg8::Unit;

struct ProbPlain {
    static constexpr bool GATHER = false;
    const bf16_t* A; const bf16_t* B; int K, lda, ldb;
    __device__ __forceinline__ const char* abase(const Unit& u) const { return (const char*)(A + (size_t)u.pm * 256 * lda); }
    __device__ __forceinline__ const char* bbase(const Unit& u) const { return (const char*)(B + (size_t)u.pn * 256 * ldb); }
    __device__ __forceinline__ void avoff(const Unit&, const int (&RA)[2], const int (&CA)[2], unsigned (&v)[2][2]) const {
#pragma unroll
        for (int h = 0; h < 2; ++h)
#pragma unroll
            for (int i = 0; i < 2; ++i) v[h][i] = (unsigned)((h * 128 + RA[i]) * lda + CA[i]) * 2u;
    }
};
struct ProbMerge {
    const bf16_t* A1; const bf16_t* B1; const bf16_t* A2; const bf16_t* B2; int K1, K2, lda1, ldb1, lda2, ldb2;
    __device__ __forceinline__ const char* abase1(const Unit& u) const { return (const char*)(A1 + (size_t)u.pm * 256 * lda1); }
    __device__ __forceinline__ const char* bbase1(const Unit& u) const { return (const char*)(B1 + (size_t)u.pn * 256 * ldb1); }
    __device__ __forceinline__ const char* abase2(const Unit& u) const { return (const char*)(A2 + (size_t)u.pm * 256 * lda2); }
    __device__ __forceinline__ const char* bbase2(const Unit& u) const { return (const char*)(B2 + (size_t)u.pn * 256 * ldb2); }
};
struct ProbPQ {
    static constexpr bool GATHER = false;
    const bf16_t* A; const bf16_t* B; int K, lda, ldb;
    __device__ __forceinline__ const char* abase(const Unit& u) const { return (const char*)(A + (size_t)u.pm * 256 * lda); }
    __device__ __forceinline__ const char* bbase(const Unit& u) const { return (const char*)(B + ((size_t)(u.pn >> 4) * 4096 + (u.pn & 15)) * 1024); }
    __device__ __forceinline__ void avoff(const Unit&, const int (&RA)[2], const int (&CA)[2], unsigned (&v)[2][2]) const {
#pragma unroll
        for (int h = 0; h < 2; ++h)
#pragma unroll
            for (int i = 0; i < 2; ++i) v[h][i] = (unsigned)((h * 128 + RA[i]) * lda + CA[i]) * 2u;
    }
};
struct ProbMoeUp {
    static constexpr bool GATHER = true;
    const bf16_t* A; const bf16_t* B; const int* idx; int K, lda, ldb;
    __device__ __forceinline__ const char* abase(const Unit&) const { return (const char*)A; }
    __device__ __forceinline__ const char* bbase(const Unit& u) const { return (const char*)(B + ((size_t)(u.pm >> 4) * 3072 + (size_t)u.pn * 256) * ldb); }
    __device__ __forceinline__ void avoff(const Unit& u, const int (&RA)[2], const int (&CA)[2], unsigned (&v)[2][2]) const {
#pragma unroll
        for (int h = 0; h < 2; ++h)
#pragma unroll
            for (int i = 0; i < 2; ++i) { const int g = idx[u.pm * 256 + h * 128 + RA[i]]; v[h][i] = (unsigned)(g * lda + CA[i]) * 2u; }
    }
};
struct ProbMoeDown {
    static constexpr bool GATHER = false;
    const bf16_t* A; const bf16_t* B; int K, lda, ldb;
    __device__ __forceinline__ const char* abase(const Unit& u) const { return (const char*)(A + (size_t)u.pm * 256 * lda); }
    __device__ __forceinline__ const char* bbase(const Unit& u) const { return (const char*)(B + ((size_t)(u.pm >> 4) * 1024 + (size_t)u.pn * 256) * ldb); }
    __device__ __forceinline__ void avoff(const Unit&, const int (&RA)[2], const int (&CA)[2], unsigned (&v)[2][2]) const {
#pragma unroll
        for (int h = 0; h < 2; ++h)
#pragma unroll
            for (int i = 0; i < 2; ++i) v[h][i] = (unsigned)((h * 128 + RA[i]) * lda + CA[i]) * 2u;
    }
};

#define EPI_ROWS(...) _Pragma("unroll") for (int ai = 0; ai < 2; ++ai) _Pragma("unroll") for (int m = 0; m < 4; ++m) { const int row = u.pm * 256 + ai * 128 + wr * 64 + m * 16 + fr; __VA_ARGS__ }
__device__ __forceinline__ u32x4 pack8(const f32x4 v0, const f32x4 v1) { u32x4 w; w.x = cvt_pk_bf16(v0[0], v0[1]); w.y = cvt_pk_bf16(v0[2], v0[3]); w.z = cvt_pk_bf16(v1[0], v1[1]); w.w = cvt_pk_bf16(v1[2], v1[3]); return w; }

struct EpiPQ {
    static constexpr bool PERM = true; bf16_t* O;
    __device__ __forceinline__ void operator()(const f32x4 (&acc)[2][2][4][2], const Unit& u, int wr, int wc, int fr, int fq) const {
        const int t10 = wc * 32 + 8 * fq, b = u.pn >> 4, t2 = u.pn & 15;
        EPI_ROWS(
            bf16_t* rp = O + ((size_t)((b * 512 + (row >> 1)) * 16 + t2) * 512 + (row & 1) * 256 + t10);
            _Pragma("unroll") for (int bj = 0; bj < 2; ++bj) *(u32x4*)(rp + bj * 128) = pack8(acc[ai][bj][m][0], acc[ai][bj][m][1]);
        )
    }
};
struct EpiPlain {
    static constexpr bool PERM = true; bf16_t* O; size_t ldc;
    __device__ __forceinline__ void operator()(const f32x4 (&acc)[2][2][4][2], const Unit& u, int wr, int wc, int fr, int fq) const {
        const int col0 = u.pn * 256 + wc * 32 + 8 * fq;
        EPI_ROWS(
            bf16_t* rp = O + (size_t)row * ldc + col0;
            _Pragma("unroll") for (int bj = 0; bj < 2; ++bj) *(u32x4*)(rp + bj * 128) = pack8(acc[ai][bj][m][0], acc[ai][bj][m][1]);
        )
    }
};
struct EpiZ {
    static constexpr bool PERM = true; bf16_t* O; int ldc; int fixed_act;
    __device__ __forceinline__ void operator()(const f32x4 (&acc)[2][2][4][2], const Unit& u, int wr, int wc, int fr, int fq) const {
        const int col0 = u.pn * 256 + wc * 32 + 8 * fq; const int act = fixed_act >= 0 ? fixed_act : (u.pn >> 2);
        EPI_ROWS(
            bf16_t* rp = O + (size_t)row * ldc + col0;
            _Pragma("unroll") for (int bj = 0; bj < 2; ++bj) {
                f32x4 v0 = acc[ai][bj][m][0], v1 = acc[ai][bj][m][1];
                if (act == 1) { _Pragma("unroll") for (int j = 0; j < 4; ++j) { v0[j] = gelu_tanh(v0[j]); v1[j] = gelu_tanh(v1[j]); } }
                else if (act >= 2) { _Pragma("unroll") for (int j = 0; j < 4; ++j) { v0[j] = sigmoidf_(v0[j]); v1[j] = sigmoidf_(v1[j]); } }
                *(u32x4*)(rp + bj * 128) = pack8(v0, v1); }
        )
    }
};
struct EpiMerge {
    static constexpr bool PERM = true; bf16_t* O; const bf16_t* Z;
    __device__ __forceinline__ void mid(f32x4 (&acc)[2][2][4][2], const Unit& u, int wr, int wc, int fr, int fq) const {
        unsigned eo = (unsigned)((u.pm * 256 + wr * 64 + fr) * 4096 + 2048 + u.pn * 256 + wc * 32 + 8 * fq);
        asm volatile("" : "+v"(eo));
#pragma unroll
        for (int ai = 0; ai < 2; ++ai) {
            u32x4 wa[4][2], wb[4][2];
#pragma unroll
            for (int m = 0; m < 4; ++m)
#pragma unroll
                for (int bj = 0; bj < 2; ++bj) { const unsigned o = eo + (unsigned)((ai * 128 + m * 16) * 4096 + bj * 128); wa[m][bj] = *(const u32x4*)(Z + o); wb[m][bj] = *(const u32x4*)(Z + o + 1024); }
#pragma unroll
            for (int m = 0; m < 4; ++m)
#pragma unroll
                for (int bj = 0; bj < 2; ++bj) { float ga[8], gb[8]; unpack8(wa[m][bj], ga); unpack8(wb[m][bj], gb);
#pragma unroll
                    for (int j = 0; j < 4; ++j) { acc[ai][bj][m][0][j] *= ga[j] * __builtin_amdgcn_rcpf(fmaxf(gb[j], 1e-30f)); acc[ai][bj][m][1][j] *= ga[4 + j] * __builtin_amdgcn_rcpf(fmaxf(gb[4 + j], 1e-30f)); } }
            __builtin_amdgcn_sched_barrier(0); }
    }
    __device__ __forceinline__ void operator()(const f32x4 (&acc)[2][2][4][2], const Unit& u, int wr, int wc, int fr, int fq) const {
        unsigned eo = (unsigned)((u.pm * 256 + wr * 64 + fr) * 4096 + 3072 + u.pn * 256 + wc * 32 + 8 * fq); asm volatile("" : "+v"(eo));
        unsigned oo = (unsigned)((u.pm * 256 + wr * 64 + fr) * 1024 + u.pn * 256 + wc * 32 + 8 * fq); asm volatile("" : "+v"(oo));
        u32x4 wb[2][4][2];
#pragma unroll
        for (int ai = 0; ai < 2; ++ai)
#pragma unroll
            for (int m = 0; m < 4; ++m)
#pragma unroll
                for (int bj = 0; bj < 2; ++bj) wb[ai][m][bj] = *(const u32x4*)(Z + eo + (unsigned)((ai * 128 + m * 16) * 4096 + bj * 128));
#pragma unroll
        for (int ai = 0; ai < 2; ++ai)
#pragma unroll
            for (int m = 0; m < 4; ++m)
#pragma unroll
                for (int bj = 0; bj < 2; ++bj) { float g[8]; unpack8(wb[ai][m][bj], g);
                    f32x4 v0 = acc[ai][bj][m][0], v1 = acc[ai][bj][m][1];
#pragma unroll
                    for (int j = 0; j < 4; ++j) { v0[j] *= g[j]; v1[j] *= g[4 + j]; }
                    *(u32x4*)(O + oo + (unsigned)((ai * 128 + m * 16) * 1024 + bj * 128)) = pack8(v0, v1); }
    }
};
struct EpiOut {
    static constexpr bool PERM = true; bf16_t* O; const float* X; const float* pos; const float* ada;
    __device__ __forceinline__ void operator()(const f32x4 (&acc)[2][2][4][2], const Unit& u, int wr, int wc, int fr, int fq) const {
        const int col0 = u.pn * 256 + wc * 32 + 8 * fq; const int b = u.pm >> 4;
        unsigned ro = (unsigned)((u.pm * 256 + wr * 64 + fr) * 1024 + col0); asm volatile("" : "+v"(ro));
#pragma unroll
        for (int ai = 0; ai < 2; ++ai)
#pragma unroll
            for (int mh = 0; mh < 2; ++mh) {
                f32x4 xv[2][2][2];
#pragma unroll
                for (int m2 = 0; m2 < 2; ++m2)
#pragma unroll
                    for (int bj = 0; bj < 2; ++bj)
#pragma unroll
                        for (int n = 0; n < 2; ++n) xv[m2][bj][n] = *(const f32x4*)(X + ro + (unsigned)((ai * 128 + (mh * 2 + m2) * 16) * 1024 + bj * 128 + n * 4));
#pragma unroll
                for (int m2 = 0; m2 < 2; ++m2) { const int m = mh * 2 + m2; const int row = u.pm * 256 + ai * 128 + wr * 64 + m * 16 + fr; const int t = row & 4095;
#pragma unroll
                    for (int bj = 0; bj < 2; ++bj) { f32x4 o[2];
#pragma unroll
                        for (int n = 0; n < 2; ++n) { const int col = col0 + bj * 128 + n * 4;
                            const f32x4 pv = *(const f32x4*)(pos + (col < 512 ? (t >> 6) * 512 + col : (t & 63) * 512 + (col - 512)));
                            const f32x4 gv = *(const f32x4*)(ada + b * 6144 + 2048 + col);
                            o[n] = xv[m2][bj][n] + pv + gv * acc[ai][bj][m][n]; }
                        *(u32x4*)(O + ro + (unsigned)((ai * 128 + m * 16) * 1024 + bj * 128)) = pack8(o[0], o[1]); } }
                __builtin_amdgcn_sched_barrier(0); }
    }
};
struct EpiGU {
    static constexpr bool PERM = true; bf16_t* O;
    __device__ __forceinline__ void operator()(const f32x4 (&acc)[2][2][4][2], const Unit& u, int wr, int wc, int fr, int fq) const {
        const int col0 = u.pn * 128 + wc * 32 + 8 * fq;
        EPI_ROWS(
            f32x4 v0, v1;
            _Pragma("unroll") for (int j = 0; j < 4; ++j) { const float g0 = acc[ai][0][m][0][j], g1 = acc[ai][0][m][1][j];
                v0[j] = g0 * sigmoidf_(g0) * acc[ai][1][m][0][j]; v1[j] = g1 * sigmoidf_(g1) * acc[ai][1][m][1][j]; }
            *(u32x4*)(O + (size_t)row * DE + col0) = pack8(v0, v1);
        )
    }
};
struct EpiDown {
    static constexpr bool PERM = true; bf16_t* O; const float* gate;
    __device__ __forceinline__ void operator()(const f32x4 (&acc)[2][2][4][2], const Unit& u, int wr, int wc, int fr, int fq) const {
        const int col0 = u.pn * 256 + wc * 32 + 8 * fq;
        EPI_ROWS(
            const float g = gate[row];
            _Pragma("unroll") for (int bj = 0; bj < 2; ++bj) *(u32x4*)(O + (size_t)row * 1024 + col0 + bj * 128) = pack8(acc[ai][bj][m][0] * g, acc[ai][bj][m][1] * g);
        )
    }
};

__device__ __forceinline__ void p0_ada(const Params& p, LAS unsigned char* lds, int item) {
    const int tid = threadIdx.x, lane = tid & 63, wv = tid >> 6;
    LAS float* s = (LAS float*)lds; LAS float* red = s + 9 * 1024;
    { float cv[18];
#pragma unroll
      for (int k = 0; k < 18; ++k) { const int i = tid + NTHR * k, r = i >> 10, d = i & 1023; cv[k] = r < 8 ? p.c[r * 1024 + d] : p.c_ctx[d]; }
#pragma unroll
      for (int k = 0; k < 18; ++k) s[tid + NTHR * k] = cv[k] * __builtin_amdgcn_rcpf(1.0f + __expf(-cv[k])); }
    __syncthreads();
    const int col = lane % 24, dh = lane / 24;
    const int dsl = wv * 128 + dh * 64;
    float a[9];
#pragma unroll
    for (int r = 0; r < 9; ++r) a[r] = 0.f;
    if (dh < 2) {
        const float* w = p.w_ada + (size_t)dsl * 6144 + item * 24 + col;
        for (int d0 = 0; d0 < 64; d0 += 32) { float wv2[32];
#pragma unroll
            for (int j = 0; j < 32; ++j) wv2[j] = w[(size_t)(d0 + j) * 6144];
#pragma unroll
            for (int j = 0; j < 32; ++j)
#pragma unroll
                for (int r = 0; r < 9; ++r) a[r] += s[r * 1024 + dsl + d0 + j] * wv2[j]; }
#pragma unroll
        for (int r = 0; r < 9; ++r) red[((wv * 2 + dh) * 9 + r) * 24 + col] = a[r];
    }
    __syncthreads();
    float* ada = (float*)(p.ws + WS_ADA);
    if (tid < 9 * 24) { const int r = tid / 24, cc = tid % 24; float v = 0.f;
#pragma unroll
        for (int k = 0; k < 16; ++k) v += red[(k * 9 + r) * 24 + cc];
        ada[r * 6144 + item * 24 + cc] = v + p.b_ada[item * 24 + cc]; }
    __syncthreads();
}
template <int NS>
__device__ __forceinline__ void xpose_item(const float* src, int ldsrc, bf16_t* dst, int lddst, int k0, int n0, int mode, float scale = 1.0f) {
    const int tid = threadIdx.x, k8 = tid & 7, nq = tid >> 3;
    if (nq >= 16 * NS) return;
    f32x4 v[8];
#pragma unroll
    for (int j = 0; j < 8; ++j) v[j] = *(const f32x4*)(src + (size_t)(k0 + 8 * k8 + j) * ldsrc + n0 + 4 * nq);
#pragma unroll
    for (int c = 0; c < 4; ++c) { const int n = n0 + 4 * nq + c; int row = n;
        if (mode) row = (n >> 7) * 256 + (n & 127) + (mode == 2 ? 128 : 0);
        u32x4 w; w.x = cvt_pk_bf16(v[0][c] * scale, v[1][c] * scale); w.y = cvt_pk_bf16(v[2][c] * scale, v[3][c] * scale); w.z = cvt_pk_bf16(v[4][c] * scale, v[5][c] * scale); w.w = cvt_pk_bf16(v[6][c] * scale, v[7][c] * scale);
        *(u32x4*)(dst + (size_t)row * lddst + k0 + 8 * k8) = w; }
}
__device__ __forceinline__ void p0_wpq(const Params& p, LAS unsigned char* lds, int item) {
    const int tid = threadIdx.x, g = item >> 6, db = item & 63;
    LAS float* wl = (LAS float*)lds; LAS float* ct = wl + 16 * 129;
    for (int i = tid; i < 16 * 128; i += NTHR) { const int d = i >> 7, cc = i & 127; wl[d * 129 + cc] = p.w_in[(size_t)(db * 16 + d) * 4608 + g * 128 + cc]; }
    if (tid < 128) { float sn, cs; sincospif((float)tid * (1.0f / 64.0f), &sn, &cs); ct[tid] = cs; ct[128 + tid] = sn; }
    __syncthreads();
    const int q = tid & 255, kc = q >> 1, pq = q & 1, dh = tid >> 8; const int n = (g * 128 + kc) * 2 + pq;
    bf16_t* dst = (bf16_t*)(p.ws + WS_WPQ) + (size_t)n * 1024 + db * 16 + dh * 8;
    const float scale = 0.001381067932f;
    float a[8];
#pragma unroll
    for (int j = 0; j < 8; ++j) a[j] = 0.f;
    for (int cc = 0; cc < 128; ++cc) { const float tv = ct[pq * 128 + ((cc * kc) & 127)];
#pragma unroll
        for (int j = 0; j < 8; ++j) a[j] += wl[(dh * 8 + j) * 129 + cc] * tv; }
    u32x4 w; w.x = cvt_pk_bf16(a[0] * scale, a[1] * scale); w.y = cvt_pk_bf16(a[2] * scale, a[3] * scale); w.z = cvt_pk_bf16(a[4] * scale, a[5] * scale); w.w = cvt_pk_bf16(a[6] * scale, a[7] * scale);
    *(u32x4*)dst = w;
    __syncthreads();
}
__device__ __forceinline__ void p0_d1t(const Params& p, int item) {
    bf16_t* dst = (bf16_t*)(p.ws + WS_D1T);
    const int row = item * 64 + (threadIdx.x >> 3), k1 = row >> 1, ri = row & 1, c0 = (threadIdx.x & 7) * 64;
    for (int c8 = 0; c8 < 64; c8 += 8) { float v[8];
#pragma unroll
        for (int j = 0; j < 8; ++j) { const int col = c0 + c8 + j, pq = col >> 8, t1 = col & 255; float sn, cs; sincospif((float)((k1 * t1) & 255) * (1.0f / 128.0f), &sn, &cs);
            v[j] = (ri == 0) ? (pq == 0 ? cs : -sn) : (pq == 0 ? -sn : -cs); }
        u32x4 w; w.x = cvt_pk_bf16(v[0], v[1]); w.y = cvt_pk_bf16(v[2], v[3]); w.z = cvt_pk_bf16(v[4], v[5]); w.w = cvt_pk_bf16(v[6], v[7]);
        *(u32x4*)(dst + (size_t)row * 512 + c0 + c8) = w; }
}
__device__ __forceinline__ void p0_d2t(const Params& p, int item) {
    bf16_t* dst = (bf16_t*)(p.ws + WS_D2T);
#pragma unroll
    for (int ps = 0; ps < 4; ++ps) { const int pc = (item * 4 + ps) * NTHR + threadIdx.x, tp = pc >> 2, kk0 = (pc & 3) * 8; float v[8];
#pragma unroll
        for (int j = 0; j < 8; ++j) { const int kk = kk0 + j, ri = kk >> 4, t2 = kk & 15; float sn, cs; sincospif((float)((tp * t2) & 4095) * (1.0f / 2048.0f), &sn, &cs); v[j] = ri ? sn : cs; }
        u32x4 w; w.x = cvt_pk_bf16(v[0], v[1]); w.y = cvt_pk_bf16(v[2], v[3]); w.z = cvt_pk_bf16(v[4], v[5]); w.w = cvt_pk_bf16(v[6], v[7]);
        *(u32x4*)(dst + (size_t)tp * 32 + kk0) = w; }
}
__device__ __forceinline__ void p0_pos(const Params& p, int item) {
    float* tab = (float*)(p.ws + WS_POS);
    for (int i = item * 2048 + threadIdx.x; i < (item + 1) * 2048; i += NTHR) { const int ii = i >> 9, j = i & 511, jj = j & 255; const float f = expf(-9.210340371976184f * (float)jj / 256.0f); const float a = (float)ii * f; tab[i] = j < 256 ? sinf(a) : cosf(a); }
}
__device__ __forceinline__ void phase0(const Params& p, LAS unsigned char* lds) {
    constexpr int N_ADA = 256, N_WIN = 16 * 16, N_WFOUR = 8 * 4, N_SQ = 16 * 4, N_LRU = 16 * 2, N_WPQ = 256, N_DFT = 8 + 8, N_POS = 16;
    constexpr int O1 = N_ADA, O2 = O1 + N_WIN, O3 = O2 + N_WFOUR, O4 = O3 + N_SQ, O5 = O4 + N_SQ, O6 = O5 + N_LRU, O7 = O6 + N_LRU, O8 = O7 + N_WPQ, O9 = O8 + N_DFT, O10 = O9 + N_POS;
    for (int it = blockIdx.x; it < O10; it += gridDim.x) {
        if (it < O1) { p0_ada(p, lds, it);
#ifdef TS_A
            if (blockIdx.x == 0 && threadIdx.x == 0) ((unsigned long long*)(p.ws + WS_BAR + 40 * KiB))[27] = __builtin_amdgcn_s_memrealtime();
#endif
        }
        else if (it < O2) { const int j = it - O1; xpose_item<4>(p.w_in + 512, 4608, (bf16_t*)(p.ws + WS_WIN), 1024, (j >> 4) * 64, (j & 15) * 256, 0); }
        else if (it < O3) { const int j = it - O2; xpose_item<4>(p.w_four, 1024, (bf16_t*)(p.ws + WS_WFOUR), 512, (j >> 2) * 64, (j & 3) * 256, 0); }
        else if (it < O4) { const int j = it - O3; xpose_item<4>(p.w_lru, 1024, (bf16_t*)(p.ws + WS_WLRU), 1024, (j >> 2) * 64, (j & 3) * 256, 0); }
        else if (it < O5) { const int j = it - O4; xpose_item<4>(p.w_out, 1024, (bf16_t*)(p.ws + WS_WOUT), 1024, (j >> 2) * 64, (j & 3) * 256, 0); }
        else if (it < O6) { const int j = it - O5, mtx = j >> 1; xpose_item<2>(p.lru_wa + (size_t)mtx * 16384, 128, (bf16_t*)(p.ws + WS_WAT) + (size_t)mtx * 16384, 128, (j & 1) * 64, 0, 0, NLOG2E); }
        else if (it < O7) { const int j = it - O6, mtx = j >> 1; xpose_item<2>(p.lru_wi + (size_t)mtx * 16384, 128, (bf16_t*)(p.ws + WS_WIT) + (size_t)mtx * 16384, 128, (j & 1) * 64, 0, 0, NLOG2E); }
        else if (it < O8) p0_wpq(p, lds, it - O7);
        else if (it < O9) { if (it - O8 < 8) p0_d1t(p, it - O8); else p0_d2t(p, it - O8 - 8); }
        else p0_pos(p, it - O9);
    }
}

__device__ __forceinline__ void phase1(const Params& p) {
    const int tid = tid_opaque(), lane = tid & 63, wid = tid >> 6;
    const float* ada = (const float*)(p.ws + WS_ADA); const float* tab = (const float*)(p.ws + WS_POS);
    bf16_t* h1 = (bf16_t*)(p.ws + WS_R1); bf16_t* hc = (bf16_t*)(p.ws + WS_HCTX);
    constexpr int NR = MLAT + MCTX, RW = 4;
    for (int row0 = (blockIdx.x * 8 + wid) * RW; row0 < NR; row0 += gridDim.x * 8 * RW) {
        const bool lat = row0 < MLAT; const int mrow = lat ? (row0 >> 12) : 8;
        f32x4 v[RW][4]; float ss[RW];
#pragma unroll
        for (int r = 0; r < RW; ++r) { const int row = row0 + r; const float* xr = lat ? p.x + (size_t)row * 1024 : p.ctx + (size_t)(row - MLAT) * 1024;
#pragma unroll
            for (int i = 0; i < 4; ++i) v[r][i] = *(const f32x4*)(xr + 256 * i + 4 * lane); }
#pragma unroll
        for (int r = 0; r < RW; ++r) { const int t = (row0 + r) & 4095; float a = 0.f;
#pragma unroll
            for (int i = 0; i < 4; ++i) { const int d = 256 * i + 4 * lane;
                if (lat) v[r][i] += *(const f32x4*)(tab + (i < 2 ? (t >> 6) * 512 + d : (t & 63) * 512 + d - 512));
                a += v[r][i][0] * v[r][i][0] + v[r][i][1] * v[r][i][1] + v[r][i][2] * v[r][i][2] + v[r][i][3] * v[r][i][3]; }
            ss[r] = a; }
#pragma unroll
        for (int o = 32; o >= 1; o >>= 1) {
#pragma unroll
            for (int r = 0; r < RW; ++r) ss[r] += __shfl_xor(ss[r], o); }
#pragma unroll
        for (int i = 0; i < 4; ++i) { const int d = 256 * i + 4 * lane;
            const f32x4 g = *(const f32x4*)(p.norm1_g + d), sh = *(const f32x4*)(ada + mrow * 6144 + d), sc = *(const f32x4*)(ada + mrow * 6144 + 1024 + d);
#pragma unroll
            for (int r = 0; r < RW; ++r) { const int row = row0 + r; const float rs = rsqrtf(ss[r] * (1.0f / 1024.0f) + 1e-6f);
                bf16_t* dst = lat ? h1 + (size_t)row * 1024 : hc + (size_t)(row - MLAT) * 1024;
                const f32x4 h = v[r][i] * rs * g * (sc + 1.0f) + sh;
                u32x2 w; w.x = cvt_pk_bf16(h[0], h[1]); w.y = cvt_pk_bf16(h[2], h[3]); *(u32x2*)(dst + d) = w; } }
    }
}

#define LRU_CST(mb, r) (32 * (mb) + 8 * ((r) >> 2) + ((r) & 3))
template <bool FINAL, int DIR>
__device__ __forceinline__ void lru_wave(const Params& p, LAS unsigned char* ul, int b, int sc, int head, int cb, int lane, f32x16 (&accI)[4]) {
    constexpr int SG = DIR ? -1 : 1;
    const int lr = lane & 31, lh = lane >> 5;
    const int chl = cb * 32 + lr, ch = head * 128 + chl;
    const int tbase = DIR ? 127 - 4 * lh : 4 * lh;
    f32x16 accA[4];
#pragma unroll
    for (int mb = 0; mb < 4; ++mb)
#pragma unroll
        for (int r = 0; r < 16; ++r) { accA[mb][r] = 0.f; accI[mb][r] = 0.f; }
    {
        const bf16_t* wa = (const bf16_t*)(p.ws + WS_WAT) + ((size_t)(DIR * 8 + head) * 128 + chl) * 128 + 8 * lh;
        const bf16_t* wi = (const bf16_t*)(p.ws + WS_WIT) + ((size_t)(DIR * 8 + head) * 128 + chl) * 128 + 8 * lh;
        LAS unsigned char* arow0 = ul + (DIR ? 127 - lr : lr) * 272 + lh * 16;
#pragma unroll
        for (int kc = 0; kc < 2; ++kc) { bf16x8 bA[4], bI[4];
#pragma unroll
            for (int k4 = 0; k4 < 4; ++k4) { bA[k4] = *(const bf16x8*)(wa + 16 * (kc * 4 + k4)); bI[k4] = *(const bf16x8*)(wi + 16 * (kc * 4 + k4)); }
#pragma unroll
            for (int mb = 0; mb < 4; ++mb)
#pragma unroll
                for (int k4 = 0; k4 < 4; ++k4) { const bf16x8 af = *(const LAS bf16x8*)(arow0 + SG * 32 * mb * 272 + 32 * (kc * 4 + k4));
                    accA[mb] = __builtin_amdgcn_mfma_f32_32x32x16_bf16(af, bA[k4], accA[mb], 0, 0, 0);
                    accI[mb] = __builtin_amdgcn_mfma_f32_32x32x16_bf16(af, bI[k4], accI[mb], 0, 0, 0); }
            __builtin_amdgcn_sched_barrier(0); }
    }
    {
        const float lam = p.lru_lambda[DIR * 1024 + ch]; const float sp8 = 8.0f * log1pf(expf(-lam));
        const float ba = p.lru_ba[DIR * 1024 + ch], bi = p.lru_bi[DIR * 1024 + ch];
        LAS unsigned char* up = ul + tbase * 272 + chl * 2;
#pragma unroll
        for (int mb = 0; mb < 4; ++mb) {
#pragma unroll
            for (int r = 0; r < 16; ++r) {
                const float uv = bf2f(*(const LAS bf16_t*)(up + SG * LRU_CST(mb, r) * 272));
                const float rg = __builtin_amdgcn_rcpf(1.0f + __builtin_amdgcn_exp2f(accA[mb][r] + NLOG2E * ba)), ig = __builtin_amdgcn_rcpf(1.0f + __builtin_amdgcn_exp2f(accI[mb][r] + NLOG2E * bi));
                const float a = __expf(-sp8 * rg); accA[mb][r] = a; accI[mb][r] = __builtin_amdgcn_sqrtf(fmaxf(1.0f - a * a, 0.f)) * ig * uv; }
            __builtin_amdgcn_sched_barrier(0); }
    }
    float rA[16], rH[16];
#pragma unroll
    for (int mb = 0; mb < 4; ++mb)
#pragma unroll
        for (int q = 0; q < 4; ++q) { float pa = 1.f, hh = 0.f;
#pragma unroll
            for (int j = 0; j < 4; ++j) { const int r = 4 * q + j; const float a = accA[mb][r], bb = accI[mb][r]; hh = a * hh + bb; pa *= a; accA[mb][r] = pa; accI[mb][r] = hh; }
            rA[mb * 4 + q] = pa; rH[mb * 4 + q] = hh; }
    const int agg_dir_off = ((b * NSEQ) * 2 + DIR) * 1024 + ch;
    const float* agg = (const float*)(p.ws + WS_AGG);
    float carry = 0.f;
    if (FINAL) {
        if (DIR == 0) { for (int q = 0; q < sc; ++q) { const float* a2 = agg + (size_t)(agg_dir_off + q * 2048) * 2; carry = a2[0] * carry + a2[1]; } }
        else { { const float* a2 = agg + (size_t)(agg_dir_off + 1 * 2048) * 2; carry = a2[0] * carry + a2[1]; } { const float* a2 = agg + (size_t)(agg_dir_off + 0 * 2048) * 2; carry = a2[0] * carry + a2[1]; }
            for (int q = NSEQ - 1; q > sc; --q) { const float* a2 = agg + (size_t)(agg_dir_off + q * 2048) * 2; carry = a2[0] * carry + a2[1]; } }
    }
    float cin[16];
#pragma unroll
    for (int i = 0; i < 16; ++i) cin[i] = 0.f;
    float s = carry, At = 1.f;
#pragma unroll
    for (int i = 0; i < 16; ++i) { const float oA = __shfl_xor(rA[i], 32), oH = __shfl_xor(rH[i], 32);
        { const bool mine = (lh == 0); const float a = mine ? rA[i] : oA, hh = mine ? rH[i] : oH; cin[i] = mine ? s : cin[i]; s = a * s + hh; At *= a; }
        { const bool mine = (lh == 1); const float a = mine ? rA[i] : oA, hh = mine ? rH[i] : oH; cin[i] = mine ? s : cin[i]; s = a * s + hh; At *= a; } }
    if (!FINAL) {
        if (lh == 0) { float* o = (float*)(p.ws + WS_AGG) + (size_t)(agg_dir_off + sc * 2048) * 2; o[0] = At; o[1] = s; }
        return;
    }
#pragma unroll
    for (int mb = 0; mb < 4; ++mb)
#pragma unroll
        for (int r = 0; r < 16; ++r) accI[mb][r] += accA[mb][r] * cin[mb * 4 + (r >> 2)];
}
template <bool FINAL>
__device__ __forceinline__ void lru_tile(const Params& p, LAS unsigned char* lds, int item) {
    const int tid = threadIdx.x, lane = tid & 63, wid = __builtin_amdgcn_readfirstlane(tid >> 6);
    int b, sc, head;
    if (FINAL) { head = item & 7; sc = 2 + ((item >> 3) & 31); b = item >> 8; }
    else { head = item & 7; const int r = item >> 3; sc = r & 1; b = r >> 1; }
    const bf16_t* src; int Tseq, t0, ld;
    if (sc < 2) { src = (const bf16_t*)(p.ws + WS_ZXC) + (size_t)b * 256 * 1024; Tseq = 256; t0 = sc * 128; ld = 1024; }
    else { src = (const bf16_t*)(p.ws + WS_RZ) + (size_t)b * 4096 * 4096; Tseq = 4096; t0 = (sc - 2) * 128; ld = 4096; }
    LAS unsigned char* ul = lds;
    LAS float* ybuf = (LAS float*)(lds + 36 * 1024);
    {
        const int c8 = tid & 15, tb = tid >> 4; const int ch0 = head * 128 + 8 * c8;
        float w[4][8], bias[8];
#pragma unroll
        for (int k = 0; k < 4; ++k) { const f32x4 a = *(const f32x4*)(p.conv_w + k * 1024 + ch0), c2 = *(const f32x4*)(p.conv_w + k * 1024 + ch0 + 4);
#pragma unroll
            for (int j = 0; j < 4; ++j) { w[k][j] = a[j]; w[k][4 + j] = c2[j]; } }
        { const f32x4 a = *(const f32x4*)(p.conv_b + ch0), c2 = *(const f32x4*)(p.conv_b + ch0 + 4);
#pragma unroll
            for (int j = 0; j < 4; ++j) { bias[j] = a[j]; bias[4 + j] = c2[j]; } }
#pragma unroll
        for (int i = 0; i < 4; ++i) { const int t = tb + 32 * i; float a[8];
#pragma unroll
            for (int j = 0; j < 8; ++j) a[j] = bias[j];
#pragma unroll
            for (int k = 0; k < 4; ++k) { const int tt = t0 + t + k - 2;
                if (tt >= 0 && tt < Tseq) { float f[8]; unpack8(*(const u32x4*)(src + (size_t)tt * ld + ch0), f);
#pragma unroll
                    for (int j = 0; j < 8; ++j) a[j] += w[k][j] * f[j]; } }
            u32x4 wv; wv.x = cvt_pk_bf16(a[0], a[1]); wv.y = cvt_pk_bf16(a[2], a[3]); wv.z = cvt_pk_bf16(a[4], a[5]); wv.w = cvt_pk_bf16(a[6], a[7]);
            *(LAS u32x4*)(ul + t * 272 + c8 * 16) = wv; }
    }
    __syncthreads();
    f32x16 hacc[4];
    if (wid < 4) lru_wave<FINAL, 0>(p, ul, b, sc, head, wid & 3, lane, hacc);
    else lru_wave<FINAL, 1>(p, ul, b, sc, head, wid & 3, lane, hacc);
    if (FINAL) {
        const int lr = lane & 31, lh = lane >> 5, chl = (wid & 3) * 32 + lr;
        if (wid >= 4) { LAS float* yp = ybuf + (127 - 4 * lh) * 129 + chl;
#pragma unroll
            for (int mb = 0; mb < 4; ++mb)
#pragma unroll
                for (int r = 0; r < 16; ++r) yp[-LRU_CST(mb, r) * 129] = hacc[mb][r]; }
        __syncthreads();
        if (wid < 4) {
            const LAS float* yp = ybuf + (4 * lh) * 129 + chl;
            const bf16_t* Zu = (const bf16_t*)(p.ws + WS_RZ) + ((size_t)(b * 4096 + t0) * 4096 + 1024 + head * 128);
            bf16_t* Ou = (bf16_t*)(p.ws + WS_R1) + ((size_t)(b * 4096 + t0) * 1024 + head * 128);
            const unsigned zo = (unsigned)(4 * lh * 4096 + chl), oo = (unsigned)(4 * lh * 1024 + chl);
#pragma unroll
            for (int mb = 0; mb < 4; ++mb) {
#pragma unroll
                for (int r = 0; r < 16; ++r) {
                    const float y = hacc[mb][r] + yp[LRU_CST(mb, r) * 129];
                    const float gz = bf2f(Zu[zo + LRU_CST(mb, r) * 4096]);
                    Ou[oo + LRU_CST(mb, r) * 1024] = (bf16_t)(cvt_pk_bf16(gz * y, 0.f) & 0xffffu);
                    if ((r & 7) == 7) __builtin_amdgcn_sched_barrier(0); } }
        }
    }
    __syncthreads();
}

#ifndef LRU_PF_FRAG
#define LRU_PF_FRAG true
#endif
#ifndef LRU_PF_TILE
#define LRU_PF_TILE true
#endif
typedef unsigned long long u64_t;
template <int DIR, bool PREF>
__device__ __forceinline__ void lru2_dir(const Params& p, LAS unsigned char* ul, int head, int w, int lane, const bf16x8 (&bA)[4], const bf16x8 (&bI)[4], bf16x8 (&nA)[4], bf16x8 (&nI)[4],
                                         f32x4 (&hl)[8], f32x4 (&pp)[8], float& Atot, float& Htot) {
    constexpr int SG = DIR ? -1 : 1;
    const int fr = lane & 15, fq = lane >> 4, chl = 16 * w + fr, ch = head * 128 + chl;
    f32x4 accA[8], accI[8];
    { const float ba2 = NLOG2E * p.lru_ba[DIR * 1024 + ch], bi2 = NLOG2E * p.lru_bi[DIR * 1024 + ch];
#pragma unroll
      for (int rb = 0; rb < 8; ++rb) { accA[rb] = (f32x4){ba2, ba2, ba2, ba2}; accI[rb] = (f32x4){bi2, bi2, bi2, bi2}; } }
    {
        LAS unsigned char* arow0 = ul + (DIR ? 127 - fr : fr) * 272 + fq * 16;
#pragma unroll
        for (int rb = 0; rb < 8; ++rb)
#pragma unroll
            for (int ks = 0; ks < 4; ++ks) { const bf16x8 af = *(const LAS bf16x8*)(arow0 + SG * 16 * rb * 272 + 64 * ks);
                accA[rb] = __builtin_amdgcn_mfma_f32_16x16x32_bf16(af, bA[ks], accA[rb], 0, 0, 0);
                accI[rb] = __builtin_amdgcn_mfma_f32_16x16x32_bf16(af, bI[ks], accI[rb], 0, 0, 0); }
    }
    if (PREF) {
        const bf16_t* wa = (const bf16_t*)(p.ws + WS_WAT) + ((size_t)((1 - DIR) * 8 + head) * 128 + chl) * 128 + 8 * fq;
        const bf16_t* wi = (const bf16_t*)(p.ws + WS_WIT) + ((size_t)((1 - DIR) * 8 + head) * 128 + chl) * 128 + 8 * fq;
#pragma unroll
        for (int ks = 0; ks < 4; ++ks) { nA[ks] = *(const bf16x8*)(wa + 32 * ks); nI[ks] = *(const bf16x8*)(wi + 32 * ks); }
    }
    {
        typedef float f32x2 __attribute__((ext_vector_type(2)));
        const float lam = p.lru_lambda[DIR * 1024 + ch]; const float k2 = NLOG2E * 8.0f * log1pf(expf(-lam));
        LAS unsigned char* up = ul + (DIR ? 127 - 4 * fq : 4 * fq) * 272 + chl * 2;
#pragma unroll
        for (int rb = 0; rb < 8; ++rb)
#pragma unroll
            for (int r = 0; r < 4; r += 2) {
                f32x2 uv; uv.x = bf2f(*(const LAS bf16_t*)(up + SG * (16 * rb + r) * 272)); uv.y = bf2f(*(const LAS bf16_t*)(up + SG * (16 * rb + r + 1) * 272));
                f32x2 ea, ei; ea.x = __builtin_amdgcn_exp2f(accA[rb][r]); ea.y = __builtin_amdgcn_exp2f(accA[rb][r + 1]); ei.x = __builtin_amdgcn_exp2f(accI[rb][r]); ei.y = __builtin_amdgcn_exp2f(accI[rb][r + 1]);
                const f32x2 da = ea + 1.0f, di = ei + 1.0f;
                f32x2 rg, ig; rg.x = __builtin_amdgcn_rcpf(da.x); rg.y = __builtin_amdgcn_rcpf(da.y); ig.x = __builtin_amdgcn_rcpf(di.x); ig.y = __builtin_amdgcn_rcpf(di.y);
                const f32x2 ka = rg * k2;
                f32x2 a; a.x = __builtin_amdgcn_exp2f(ka.x); a.y = __builtin_amdgcn_exp2f(ka.y);
                const f32x2 om = 1.0f - a * a;
                f32x2 sq; sq.x = __builtin_amdgcn_sqrtf(om.x); sq.y = __builtin_amdgcn_sqrtf(om.y);
                const f32x2 bb = sq * ig * uv;
                accA[rb][r] = a.x; accA[rb][r + 1] = a.y; accI[rb][r] = bb.x; accI[rb][r + 1] = bb.y; }
    }
    float rA[8], rH[8];
#pragma unroll
    for (int rb = 0; rb < 8; ++rb) { float pa = 1.f, hh = 0.f;
#pragma unroll
        for (int r = 0; r < 4; ++r) { const float a = accA[rb][r], bb = accI[rb][r]; hh = a * hh + bb; pa *= a; accA[rb][r] = pa; accI[rb][r] = hh; }
        rA[rb] = pa; rH[rb] = hh; }
    float Pc = 1.f, s = 0.f;
#pragma unroll
    for (int rb = 0; rb < 8; ++rb) { float Pin = 1.f, Hin = 0.f;
#pragma unroll
        for (int q = 0; q < 4; ++q) { const float a = __shfl(rA[rb], fr + 16 * q), hh = __shfl(rH[rb], fr + 16 * q);
            if (q == fq) { Pin = Pc; Hin = s; }
            s = a * s + hh; Pc *= a; }
#pragma unroll
        for (int r = 0; r < 4; ++r) { hl[rb][r] = accI[rb][r] + accA[rb][r] * Hin; pp[rb][r] = accA[rb][r] * Pin; }
        __builtin_amdgcn_sched_barrier(0); }
    Atot = Pc; Htot = s;
}
__device__ __forceinline__ u64_t agg_ld(const u64_t* a) { return __hip_atomic_load(a, __ATOMIC_RELAXED, __HIP_MEMORY_SCOPE_AGENT); }
template <int DIR>
__device__ __forceinline__ float lru2_carry(const u64_t* aggc, int n, int fr, int fq) {
    float Ap = 1.f, Hp = 0.f; u64_t v[9];
#pragma unroll
    for (int k = 0; k < 9; ++k) { const int j = fq * 9 + k; const int seq = DIR ? (j == 0 ? 1 : (j == 1 ? 0 : 35 - j)) : j;
        v[k] = (j < n) ? agg_ld(aggc + (size_t)seq * 2048) : 0x000000003f800000ull; }
#pragma unroll
    for (int k = 0; k < 9; ++k) { const float a = __uint_as_float((unsigned)v[k]), hh = __uint_as_float((unsigned)(v[k] >> 32)); Hp = a * Hp + hh; Ap *= a; }
    float s = 0.f;
#pragma unroll
    for (int q = 0; q < 4; ++q) { const float a = __shfl(Ap, fr + 16 * q), hh = __shfl(Hp, fr + 16 * q); s = a * s + hh; }
    return s;
}
__device__ __forceinline__ void lru2_ctx_tile(const Params& p, LAS unsigned char* lds, int item) {
    const int tid = tid_opaque(), lane = tid & 63, wid = __builtin_amdgcn_readfirstlane(tid >> 6);
    const int head = item & 7, sc = (item >> 3) & 1, b = item >> 4, t0 = sc * 128;
    LAS unsigned char* raw = lds; LAS unsigned char* ul = lds + 33792;
    const int fr = lane & 15, fq = lane >> 4, chl = 16 * wid + fr, ch = head * 128 + chl;
    const bf16_t* Zc = (const bf16_t*)(p.ws + WS_ZXC) + (size_t)b * 256 * 1024 + head * 128;
    bf16x8 bA1[4], bI1[4], bA0[4], bI0[4];
    { const bf16_t* wa = (const bf16_t*)(p.ws + WS_WAT) + ((size_t)(8 + head) * 128 + chl) * 128 + 8 * fq; const bf16_t* wi = (const bf16_t*)(p.ws + WS_WIT) + ((size_t)(8 + head) * 128 + chl) * 128 + 8 * fq;
#pragma unroll
      for (int ks = 0; ks < 4; ++ks) { bA1[ks] = *(const bf16x8*)(wa + 32 * ks); bI1[ks] = *(const bf16x8*)(wi + 32 * ks); } }
#pragma unroll
    for (int k = 0; k < 5; ++k) { const int pc = tid + NTHR * k;
        if (pc < 131 * 16) { const int row = pc >> 4, c8 = pc & 15, tt = t0 - 2 + row; u32x4 v = (u32x4){0u, 0u, 0u, 0u};
            if (tt >= 0 && tt < CTXL) v = *(const u32x4*)(Zc + (size_t)tt * 1024 + c8 * 8);
            *(LAS u32x4*)(raw + row * 256 + c8 * 16) = v; } }
    __syncthreads();
    {
        const int c8 = tid & 15, tb = tid >> 4; const int ch0 = head * 128 + 8 * c8;
        float w[4][8], bias[8];
#pragma unroll
        for (int k = 0; k < 4; ++k) { const f32x4 a = *(const f32x4*)(p.conv_w + k * 1024 + ch0), c2 = *(const f32x4*)(p.conv_w + k * 1024 + ch0 + 4);
#pragma unroll
            for (int j = 0; j < 4; ++j) { w[k][j] = a[j]; w[k][4 + j] = c2[j]; } }
        { const f32x4 a = *(const f32x4*)(p.conv_b + ch0), c2 = *(const f32x4*)(p.conv_b + ch0 + 4);
#pragma unroll
            for (int j = 0; j < 4; ++j) { bias[j] = a[j]; bias[4 + j] = c2[j]; } }
#pragma unroll
        for (int i = 0; i < 4; ++i) { const int t = tb + 32 * i; float a[8];
#pragma unroll
            for (int j = 0; j < 8; ++j) a[j] = bias[j];
#pragma unroll
            for (int k = 0; k < 4; ++k) { float f[8]; unpack8(*(const LAS u32x4*)(raw + (t + k) * 256 + c8 * 16), f);
#pragma unroll
                for (int j = 0; j < 8; ++j) a[j] += w[k][j] * f[j]; }
            u32x4 wv; wv.x = cvt_pk_bf16(a[0], a[1]); wv.y = cvt_pk_bf16(a[2], a[3]); wv.z = cvt_pk_bf16(a[4], a[5]); wv.w = cvt_pk_bf16(a[6], a[7]);
            *(LAS u32x4*)(ul + t * 272 + c8 * 16) = wv; }
    }
    __syncthreads();
    float A0, H0, A1, H1;
    { f32x4 hl[8], pp[8]; lru2_dir<1, false>(p, ul, head, wid, lane, bA1, bI1, bA0, bI0, hl, pp, A1, H1); }
    __builtin_amdgcn_sched_barrier(0);
    { const bf16_t* wa = (const bf16_t*)(p.ws + WS_WAT) + ((size_t)(head) * 128 + chl) * 128 + 8 * fq; const bf16_t* wi = (const bf16_t*)(p.ws + WS_WIT) + ((size_t)(head) * 128 + chl) * 128 + 8 * fq;
#pragma unroll
      for (int ks = 0; ks < 4; ++ks) { bA0[ks] = *(const bf16x8*)(wa + 32 * ks); bI0[ks] = *(const bf16x8*)(wi + 32 * ks); } }
    { f32x4 hl[8], pp[8]; lru2_dir<0, false>(p, ul, head, wid, lane, bA0, bI0, bA1, bI1, hl, pp, A0, H0); }
    if (fq == 0) { float* agg = (float*)(p.ws + WS_AGG);
        float* o0 = agg + ((size_t)((b * NSEQ + sc) * 2 + 0) * 1024 + ch) * 2; o0[0] = A0; o0[1] = H0;
        float* o1 = agg + ((size_t)((b * NSEQ + sc) * 2 + 1) * 1024 + ch) * 2; o1[0] = A1; o1[1] = H1; }
    __syncthreads();
}

__device__ __forceinline__ void lru2_block(const Params& p, LAS unsigned char* lds, int slot, int c, int ngr) {
    const int tid = threadIdx.x, lane = tid & 63, wid = __builtin_amdgcn_readfirstlane(tid >> 6);
    const int sc = c + 2, t0 = c * 128;
    LAS unsigned char* raw = lds;
    LAS unsigned char* ul = lds + 33792;
    LAS unsigned char* gzl = lds + 68608;
    LAS unsigned char* outl = lds + 103424;
    const int fr = lane & 15, fq = lane >> 4, chl = 16 * wid + fr;
    u32x4 nr[5], ng[4];
#define LRU2_LOAD_R(gg) do { const bf16_t* Zb_ = (const bf16_t*)(p.ws + WS_RZ) + (size_t)((gg) >> 3) * 4096 * 4096 + ((gg) & 7) * 128; \
        _Pragma("unroll") for (int k = 0; k < 5; ++k) { const int pc = tid + NTHR * k; nr[k] = (u32x4){0u, 0u, 0u, 0u}; \
            if (pc < 131 * 16) { const int row = pc >> 4, c8 = pc & 15, tt = t0 - 2 + row; if (tt >= 0 && tt < TT) nr[k] = *(const u32x4*)(Zb_ + (size_t)tt * 4096 + c8 * 8); } } } while (0)
#define LRU2_LOAD_G(gg) do { const bf16_t* Zb_ = (const bf16_t*)(p.ws + WS_RZ) + (size_t)((gg) >> 3) * 4096 * 4096 + ((gg) & 7) * 128; \
        _Pragma("unroll") for (int k = 0; k < 4; ++k) { const int pc = tid + NTHR * k, row = pc >> 4, c8 = pc & 15; ng[k] = *(const u32x4*)(Zb_ + (size_t)(t0 + row) * 4096 + 1024 + c8 * 8); } } while (0)
    LRU2_LOAD_R(slot); LRU2_LOAD_G(slot);
    for (int g = slot; g < NB * 8; g += ngr) {
        const int b = g >> 3, head = g & 7, ch = head * 128 + chl;
        unsigned* gcnt = (unsigned*)(p.ws + WS_BAR + 16 * KiB) + g * 64;
        bf16x8 bA1[4], bI1[4], bA0[4], bI0[4];
        { const bf16_t* wa = (const bf16_t*)(p.ws + WS_WAT) + ((size_t)(8 + head) * 128 + chl) * 128 + 8 * fq; const bf16_t* wi = (const bf16_t*)(p.ws + WS_WIT) + ((size_t)(8 + head) * 128 + chl) * 128 + 8 * fq;
#pragma unroll
          for (int ks = 0; ks < 4; ++ks) { bA1[ks] = *(const bf16x8*)(wa + 32 * ks); bI1[ks] = *(const bf16x8*)(wi + 32 * ks); } }
#pragma unroll
        for (int k = 0; k < 5; ++k) { const int pc = tid + NTHR * k; if (pc < 131 * 16) *(LAS u32x4*)(raw + (pc >> 4) * 256 + (pc & 15) * 16) = nr[k]; }
#pragma unroll
        for (int k = 0; k < 4; ++k) { const int pc = tid + NTHR * k; *(LAS u32x4*)(gzl + (pc >> 4) * 272 + (pc & 15) * 16) = ng[k]; }
        __syncthreads();
        {
            const int c8 = tid & 15, tb = tid >> 4; const int ch0 = head * 128 + 8 * c8;
            float w[4][8], bias[8];
#pragma unroll
            for (int k = 0; k < 4; ++k) { const f32x4 a = *(const f32x4*)(p.conv_w + k * 1024 + ch0), c2 = *(const f32x4*)(p.conv_w + k * 1024 + ch0 + 4);
#pragma unroll
                for (int j = 0; j < 4; ++j) { w[k][j] = a[j]; w[k][4 + j] = c2[j]; } }
            { const f32x4 a = *(const f32x4*)(p.conv_b + ch0), c2 = *(const f32x4*)(p.conv_b + ch0 + 4);
#pragma unroll
                for (int j = 0; j < 4; ++j) { bias[j] = a[j]; bias[4 + j] = c2[j]; } }
#pragma unroll
            for (int i = 0; i < 4; ++i) { const int t = tb + 32 * i; float a[8];
#pragma unroll
                for (int j = 0; j < 8; ++j) a[j] = bias[j];
#pragma unroll
                for (int k = 0; k < 4; ++k) { float f[8]; unpack8(*(const LAS u32x4*)(raw + (t + k) * 256 + c8 * 16), f);
#pragma unroll
                    for (int j = 0; j < 8; ++j) a[j] += w[k][j] * f[j]; }
                u32x4 wv; wv.x = cvt_pk_bf16(a[0], a[1]); wv.y = cvt_pk_bf16(a[2], a[3]); wv.z = cvt_pk_bf16(a[4], a[5]); wv.w = cvt_pk_bf16(a[6], a[7]);
                *(LAS u32x4*)(ul + t * 272 + c8 * 16) = wv; }
        }
        __syncthreads();
        float A0, H0, A1, H1;
        {
            f32x4 hl1[8], pp1[8];
            lru2_dir<1, LRU_PF_FRAG>(p, ul, head, wid, lane, bA1, bI1, bA0, bI0, hl1, pp1, A1, H1);
            LAS unsigned char* hp = outl + (127 - 4 * fq) * 272 + chl * 2; LAS unsigned char* qp = raw + (127 - 4 * fq) * 256 + chl * 2;
#pragma unroll
            for (int rb = 0; rb < 8; ++rb)
#pragma unroll
                for (int r = 0; r < 4; ++r) { *(LAS bf16_t*)(hp - (16 * rb + r) * 272) = (bf16_t)(cvt_pk_bf16(hl1[rb][r], 0.f) & 0xffffu); *(LAS bf16_t*)(qp - (16 * rb + r) * 256) = (bf16_t)(cvt_pk_bf16(pp1[rb][r], 0.f) & 0xffffu); }
        }
        __builtin_amdgcn_sched_barrier(0);
        if (!LRU_PF_FRAG) { const bf16_t* wa = (const bf16_t*)(p.ws + WS_WAT) + ((size_t)(head) * 128 + chl) * 128 + 8 * fq; const bf16_t* wi = (const bf16_t*)(p.ws + WS_WIT) + ((size_t)(head) * 128 + chl) * 128 + 8 * fq;
#pragma unroll
          for (int ks = 0; ks < 4; ++ks) { bA0[ks] = *(const bf16x8*)(wa + 32 * ks); bI0[ks] = *(const bf16x8*)(wi + 32 * ks); } }
        f32x4 hl0[8], pp0[8];
        lru2_dir<0, false>(p, ul, head, wid, lane, bA0, bI0, bA1, bI1, hl0, pp0, A0, H0);
        u64_t* agg = (u64_t*)(p.ws + WS_AGG);
        const size_t ai0 = ((size_t)(b * NSEQ) * 2 + 0) * 1024 + ch, ai1 = ((size_t)(b * NSEQ) * 2 + 1) * 1024 + ch;
        if (fq == 0) {
            __hip_atomic_store(agg + ai0 + (size_t)sc * 2048, ((u64_t)__float_as_uint(H0) << 32) | __float_as_uint(A0), __ATOMIC_RELAXED, __HIP_MEMORY_SCOPE_AGENT);
            __hip_atomic_store(agg + ai1 + (size_t)sc * 2048, ((u64_t)__float_as_uint(H1) << 32) | __float_as_uint(A1), __ATOMIC_RELAXED, __HIP_MEMORY_SCOPE_AGENT); }
        asm volatile("s_waitcnt vmcnt(0)" ::: "memory");
        __syncthreads();
        if (tid == 0) (void)__hip_atomic_fetch_add(gcnt, 1u, __ATOMIC_RELAXED, __HIP_MEMORY_SCOPE_AGENT);
        if (wid == 0) { unsigned sp = 0;
            while ((unsigned)__builtin_amdgcn_readfirstlane(__hip_atomic_load(gcnt, __ATOMIC_RELAXED, __HIP_MEMORY_SCOPE_AGENT)) < 32u) { __builtin_amdgcn_s_sleep(1); if (++sp > (1u << 22)) break; }
            __builtin_amdgcn_fence(__ATOMIC_ACQUIRE, "agent");
            asm volatile("s_waitcnt vmcnt(0)" ::: "memory"); }
        __syncthreads();
        const float C0 = lru2_carry<0>(agg + ai0, sc, fr, fq);
        const float C1 = lru2_carry<1>(agg + ai1, 2 + (NSEQ - 1 - sc), fr, fq);
        __builtin_amdgcn_sched_barrier(0);
        if (LRU_PF_TILE) { const int gn = (g + ngr < NB * 8) ? g + ngr : g; LRU2_LOAD_R(gn); LRU2_LOAD_G(gn); }
        __builtin_amdgcn_sched_barrier(0);
        LAS unsigned char* gp = gzl + (4 * fq) * 272 + chl * 2; LAS unsigned char* op = outl + (4 * fq) * 272 + chl * 2; LAS unsigned char* qp0 = raw + (4 * fq) * 256 + chl * 2;
#pragma unroll
        for (int rb = 0; rb < 8; ++rb)
#pragma unroll
            for (int r = 0; r < 4; ++r) { const float h1 = bf2f(*(const LAS bf16_t*)(op + (16 * rb + r) * 272)) + bf2f(*(const LAS bf16_t*)(qp0 + (16 * rb + r) * 256)) * C1;
                const float y = hl0[rb][r] + pp0[rb][r] * C0 + h1;
                const float gz = bf2f(*(const LAS bf16_t*)(gp + (16 * rb + r) * 272));
                *(LAS bf16_t*)(op + (16 * rb + r) * 272) = (bf16_t)(cvt_pk_bf16(gz * y, 0.f) & 0xffffu); }
        __syncthreads();
        bf16_t* Ob = (bf16_t*)(p.ws + WS_R1) + ((size_t)(b * 4096 + t0)) * 1024 + head * 128;
#pragma unroll
        for (int k = 0; k < 4; ++k) { const int pc = tid + NTHR * k, row = pc >> 4, c8 = pc & 15;
            *(u32x4*)(Ob + (size_t)row * 1024 + c8 * 8) = *(const LAS u32x4*)(outl + row * 272 + c8 * 16); }
        __syncthreads();
        if (!LRU_PF_TILE && g + ngr < NB * 8) LRU2_LOAD_R(g + ngr);
    }
#undef LRU2_LOAD_R
#undef LRU2_LOAD_G
}

__device__ __forceinline__ void fft_stage2_all(const Params& p, LAS unsigned char* lds) {
    const int tid = tid_opaque(), lane = tid & 63, wid = tid >> 6, fr = lane & 15, fq = lane >> 4;
    const bf16_t* Yt = (const bf16_t*)((const unsigned char*)p.out + OUT_YT); const bf16_t* D2 = (const bf16_t*)(p.ws + WS_D2T);
    bf16_t* Fo = (bf16_t*)((unsigned char*)p.out + OUT_F);
    const int G = gridDim.x;
    int it = blockIdx.x; bf16x8 dfr, yfr[4];
#define S2_LOAD(item) do { const int b_ = (item) & 7, k1_ = (item) >> 3; dfr = *(const bf16x8*)(D2 + (size_t)(k1_ + 256 * fr) * 32 + 8 * fq); \
        _Pragma("unroll") for (int n = 0; n < 4; ++n) yfr[n] = *(const bf16x8*)(Yt + (size_t)(k1_ * 2 + (fq >> 1)) * 65536 + (size_t)b_ * 8192 + (size_t)(16 * (4 * wid + n) + fr) * 16 + 8 * (fq & 1)); } while (0)
    if (it < NB * 256) S2_LOAD(it);
    for (; it < NB * 256; it += G) {
        const int b = it & 7, k1 = it >> 3;
        f32x4 acc[4];
#pragma unroll
        for (int n = 0; n < 4; ++n) acc[n] = __builtin_amdgcn_mfma_f32_16x16x32_bf16(yfr[n], dfr, (f32x4){0.f, 0.f, 0.f, 0.f}, 0, 0, 0);
        const int nx = it + G; if (nx < NB * 256) S2_LOAD(nx);
#pragma unroll
        for (int n = 0; n < 4; ++n) { u32x2 w; w.x = cvt_pk_bf16(acc[n][0], acc[n][1]); w.y = cvt_pk_bf16(acc[n][2], acc[n][3]);
            *(LAS u32x2*)(lds + fr * 1040 + (16 * (4 * wid + n) + 4 * fq) * 2) = w; }
        __syncthreads();
#pragma unroll
        for (int k = 0; k < 2; ++k) { const int pc = tid + NTHR * k, k2 = pc >> 6, c8 = pc & 63;
            *(u32x4*)(Fo + ((size_t)b * 4096 + k1 + 256 * k2) * 512 + c8 * 8) = *(const LAS u32x4*)(lds + k2 * 1040 + c8 * 16); }
        __syncthreads();
    }
#undef S2_LOAD
}

__device__ __forceinline__ void topk_task(const Params& p, LAS unsigned char* lds, int it) {
    const int tid = tid_opaque(), lane = tid & 63, wid = tid >> 6;
    LAS unsigned* cnt = (LAS unsigned*)lds;
    LAS unsigned* wsum = cnt + 64;
    const float* scores = (const float*)(p.ws + WS_SCORES);
    int* idx = (int*)(p.ws + WS_IDX); float* gate = (float*)(p.ws + WS_GATE); int* slot_of = (int*)(p.ws + WS_SLOT);
    const int b = it >> 4, e = it & 15;
    unsigned key[8];
    { const u32x4* sp = (const u32x4*)(scores + (size_t)it * 4096 + tid * 8); const u32x4 a = sp[0], c2 = sp[1]; key[0] = a.x; key[1] = a.y; key[2] = a.z; key[3] = a.w; key[4] = c2.x; key[5] = c2.y; key[6] = c2.z; key[7] = c2.w; }
    unsigned thr = 0;
    for (int step = 0; step < 16; ++step) {
        const int sh = 29 - 2 * step;
        const unsigned c1 = sh >= 0 ? (thr | (1u << sh)) : (thr | 1u), c2 = sh >= 0 ? (thr | (2u << sh)) : 0xffffffffu, c3 = sh >= 0 ? (thr | (3u << sh)) : 0xffffffffu;
        unsigned n1 = 0, n2 = 0, n3 = 0;
#pragma unroll
        for (int j = 0; j < 8; ++j) { n1 += (unsigned)__popcll(__ballot(key[j] >= c1)); n2 += (unsigned)__popcll(__ballot(key[j] >= c2)); n3 += (unsigned)__popcll(__ballot(key[j] >= c3)); }
        LAS unsigned* cb = cnt + (step & 1) * 32;
        if (lane == 0) { cb[wid] = n1; cb[8 + wid] = n2; cb[16 + wid] = n3; }
        __syncthreads();
        unsigned t1 = 0, t2 = 0, t3 = 0;
#pragma unroll
        for (int w = 0; w < 8; ++w) { t1 += cb[w]; t2 += cb[8 + w]; t3 += cb[16 + w]; }
        if (sh >= 0) thr = t3 >= (unsigned)CAP ? c3 : (t2 >= (unsigned)CAP ? c2 : (t1 >= (unsigned)CAP ? c1 : thr));
        else thr = t1 >= (unsigned)CAP ? c1 : thr;
    }
    unsigned cg_ = 0, ce = 0;
#pragma unroll
    for (int j = 0; j < 8; ++j) { cg_ += key[j] > thr; ce += key[j] == thr; }
    unsigned pk = cg_ | (ce << 16), incl = pk;
#pragma unroll
    for (int o = 1; o < 64; o <<= 1) { const unsigned n = __shfl_up(incl, o); if (lane >= o) incl += n; }
    if (lane == 63) wsum[wid] = incl;
    __syncthreads();
    unsigned base = 0, total = 0;
#pragma unroll
    for (int w = 0; w < 8; ++w) { const unsigned s2 = wsum[w]; if (w < wid) base += s2; total += s2; }
    const unsigned excl = base + incl - pk; unsigned og = excl & 0xffffu, oe = excl >> 16; const unsigned ngt = total & 0xffffu, krem = (unsigned)CAP - ngt;
    int mm[8];
#pragma unroll
    for (int j = 0; j < 8; ++j) { const int t = tid * 8 + j; int m = -1;
        if (key[j] > thr) { m = (e * 8 + b) * 512 + (int)og; ++og; }
        else if (key[j] == thr) { if (oe < krem) m = (e * 8 + b) * 512 + (int)(ngt + oe); ++oe; }
        mm[j] = m;
        if (m >= 0) { idx[m] = b * 4096 + t; gate[m] = __uint_as_float(key[j]); } }
    { u32x4* so = (u32x4*)(slot_of + (size_t)it * 4096 + tid * 8);
      so[0] = (u32x4){(unsigned)mm[0], (unsigned)mm[1], (unsigned)mm[2], (unsigned)mm[3]}; so[1] = (u32x4){(unsigned)mm[4], (unsigned)mm[5], (unsigned)mm[6], (unsigned)mm[7]}; }
    __syncthreads();
}

__device__ __forceinline__ void phase7_rows(const Params& p, LAS unsigned char* lds) {
    const int tid = threadIdx.x, lane = tid & 63, wid = tid >> 6;
    LAS float* wrt = (LAS float*)lds;
    for (int i = tid; i < 16 * 1024; i += NTHR) { const int d = i >> 4, e = i & 15; wrt[e * 1024 + d] = p.w_router[i]; }
    __syncthreads();
    const float* ada = (const float*)(p.ws + WS_ADA); bf16_t* h2 = (bf16_t*)(p.ws + WS_H2); const bf16_t* x2b = (const bf16_t*)(p.ws + WS_X2B); float* scores = (float*)(p.ws + WS_SCORES);
    for (int row0 = (blockIdx.x * 8 + wid) * 2; row0 < MLAT; row0 += gridDim.x * 16) {
        const int b = row0 >> 12;
        f32x4 v[2][4]; float ss[2];
#pragma unroll
        for (int r = 0; r < 2; ++r)
#pragma unroll
            for (int i = 0; i < 4; ++i) { const u32x2 w = *(const u32x2*)(x2b + (size_t)(row0 + r) * 1024 + 256 * i + 4 * lane); v[r][i] = (f32x4){bf_lo(w.x), bf_hi(w.x), bf_lo(w.y), bf_hi(w.y)}; }
#pragma unroll
        for (int r = 0; r < 2; ++r) { float a = 0.f;
#pragma unroll
            for (int i = 0; i < 4; ++i) a += v[r][i][0] * v[r][i][0] + v[r][i][1] * v[r][i][1] + v[r][i][2] * v[r][i][2] + v[r][i][3] * v[r][i][3];
            ss[r] = a; }
#pragma unroll
        for (int o = 32; o >= 1; o >>= 1) { ss[0] += __shfl_xor(ss[0], o); ss[1] += __shfl_xor(ss[1], o); }
#pragma unroll
        for (int i = 0; i < 4; ++i) { const int d = 256 * i + 4 * lane;
            const f32x4 g = *(const f32x4*)(p.norm2_g + d), sh = *(const f32x4*)(ada + b * 6144 + 3072 + d), sc = *(const f32x4*)(ada + b * 6144 + 4096 + d);
#pragma unroll
            for (int r = 0; r < 2; ++r) { const float rs = rsqrtf(ss[r] * (1.0f / 1024.0f) + 1e-6f);
                v[r][i] = v[r][i] * rs * g * (sc + 1.0f) + sh;
                u32x2 w; w.x = cvt_pk_bf16(v[r][i][0], v[r][i][1]); w.y = cvt_pk_bf16(v[r][i][2], v[r][i][3]); *(u32x2*)(h2 + (size_t)(row0 + r) * 1024 + d) = w; } }
        float q[32];
#pragma unroll
        for (int e = 0; e < 16; ++e) { float a0 = 0.f, a1 = 0.f;
#pragma unroll
            for (int i = 0; i < 4; ++i) { const f32x4 w = *(const LAS f32x4*)(wrt + e * 1024 + 256 * i + 4 * lane);
                a0 += v[0][i][0] * w[0] + v[0][i][1] * w[1] + v[0][i][2] * w[2] + v[0][i][3] * w[3];
                a1 += v[1][i][0] * w[0] + v[1][i][1] * w[1] + v[1][i][2] * w[2] + v[1][i][3] * w[3]; }
            q[e] = a0; q[16 + e] = a1; }
#pragma unroll
        for (int j = 0; j < 16; ++j) { const bool up = (lane & 32) != 0; const float send = up ? q[j] : q[16 + j], keep = up ? q[16 + j] : q[j]; q[j] = keep + __shfl_xor(send, 32); }
#pragma unroll
        for (int j = 0; j < 8; ++j) { const bool up = (lane & 16) != 0; const float send = up ? q[j] : q[8 + j], keep = up ? q[8 + j] : q[j]; q[j] = keep + __shfl_xor(send, 16); }
#pragma unroll
        for (int j = 0; j < 4; ++j) { const bool up = (lane & 8) != 0; const float send = up ? q[j] : q[4 + j], keep = up ? q[4 + j] : q[j]; q[j] = keep + __shfl_xor(send, 8); }
#pragma unroll
        for (int j = 0; j < 2; ++j) { const bool up = (lane & 4) != 0; const float send = up ? q[j] : q[2 + j], keep = up ? q[2 + j] : q[j]; q[j] = keep + __shfl_xor(send, 4); }
        { const bool up = (lane & 2) != 0; const float send = up ? q[0] : q[1], keep = up ? q[1] : q[0]; q[0] = keep + __shfl_xor(send, 2); }
        float lg = q[0] + __shfl_xor(q[0], 1);
        float mx = lg;
#pragma unroll
        for (int o = 2; o <= 16; o <<= 1) mx = fmaxf(mx, __shfl_xor(mx, o));
        const float ex = expf(lg - mx); float sum = ex;
#pragma unroll
        for (int o = 2; o <= 16; o <<= 1) sum += __shfl_xor(sum, o);
        if (gridDim.x == 256) {
            LAS float* scl = (LAS float*)(lds + 64 * 1024);
            if ((lane & 1) == 0) scl[((lane >> 1) & 15) * 16 + wid * 2 + (lane >> 5)] = ex / sum;
            __syncthreads();
            if (tid < 128) { const int e = tid >> 3, q = tid & 7; const u64_t v2 = *(const LAS u64_t*)(scl + e * 16 + 2 * q);
                __hip_atomic_store((u64_t*)(scores + ((size_t)b * 16 + e) * 4096 + ((row0 - 2 * wid) & 4095) + 2 * q), v2, __ATOMIC_RELAXED, __HIP_MEMORY_SCOPE_AGENT); }
            asm volatile("s_waitcnt vmcnt(0)" ::: "memory");
            __syncthreads();
            if (tid == 0) (void)__hip_atomic_fetch_add((unsigned*)(p.ws + WS_BAR + 44 * KiB) + b * 64, 1u, __ATOMIC_RELAXED, __HIP_MEMORY_SCOPE_AGENT);
        } else if ((lane & 1) == 0) scores[((size_t)b * 16 + ((lane >> 1) & 15)) * 4096 + ((row0 + (lane >> 5)) & 4095)] = ex / sum;
    }
    __syncthreads();
}
__device__ __forceinline__ void phase7_topk(const Params& p, LAS unsigned char* lds) {
    const int bid = blockIdx.x; if (bid >= NB * NE) return;
    unsigned* c = (unsigned*)(p.ws + WS_BAR + 44 * KiB) + (bid >> 4) * 64;
    if (threadIdx.x < 64) { unsigned sp = 0;
        while ((unsigned)__builtin_amdgcn_readfirstlane(__hip_atomic_load(c, __ATOMIC_RELAXED, __HIP_MEMORY_SCOPE_AGENT)) < 256u) { __builtin_amdgcn_s_sleep(1); if (++sp > (1u << 22)) break; }
        __builtin_amdgcn_fence(__ATOMIC_ACQUIRE, "agent");
        asm volatile("s_waitcnt vmcnt(0)" ::: "memory"); }
    __syncthreads();
    topk_task(p, lds, bid);
}
__device__ __forceinline__ void phase7_weights(const Params& p) {
    constexpr int N_G = 16 * 16 * 6, N_D = 16 * 24 * 4;
    const bool fused = gridDim.x == 256;
    for (int j = 0; ; ++j) {
        int it;
        if (!fused) it = blockIdx.x + j * gridDim.x;
        else if (blockIdx.x >= 128) it = j < 4 ? (blockIdx.x - 128) + 128 * j : 512 + blockIdx.x + (j - 4) * 256;
        else it = 512 + blockIdx.x + j * 256;
        if (it >= 2 * N_G + N_D) break;
        if (it < 2 * N_G) { const int up = it >= N_G, j = up ? it - N_G : it, e = j / 96, r = j % 96, kb = r / 6, nb = r % 6;
            xpose_item<4>((up ? p.w_up_e : p.w_gate_e) + (size_t)e * 1024 * 1536, 1536, (bf16_t*)(p.ws + WS_WGU) + (size_t)e * 3072 * 1024, 1024, kb * 64, nb * 256, up ? 2 : 1); }
        else { const int j = it - 2 * N_G, e = j / 96, r = j % 96, kb = r >> 2, nb = r & 3;
            xpose_item<4>(p.w_down_e + (size_t)e * 1536 * 1024, 1024, (bf16_t*)(p.ws + WS_WD) + (size_t)e * 1024 * 1536, 1536, kb * 64, nb * 256, 0); }
    }
}

__device__ __forceinline__ void phase11(const Params& p, float* dst) {
    const int tid = tid_opaque(), lane = tid & 63, wid = tid >> 6;
    const float* ada = (const float*)(p.ws + WS_ADA); const int* slot_of = (const int*)(p.ws + WS_SLOT); const bf16_t* oute = (const bf16_t*)(p.ws + WS_OUTE); const bf16_t* x2b = (const bf16_t*)(p.ws + WS_X2B);
    const int stride = gridDim.x * 16;
    int row0 = (blockIdx.x * 8 + wid) * 2;
    int myslot = row0 < MLAT ? slot_of[((size_t)(row0 >> 12) * 16 + (lane & 15)) * 4096 + ((row0 & 4095) + ((lane >> 4) & 1))] : -1;
    for (; row0 < MLAT; row0 += stride) {
        const int b = row0 >> 12;
        const int nrow = row0 + stride; const int nslot = nrow < MLAT ? slot_of[((size_t)(nrow >> 12) * 16 + (lane & 15)) * 4096 + ((nrow & 4095) + ((lane >> 4) & 1))] : -1;
        f32x4 xv[2][4], acc[2][4];
#pragma unroll
        for (int r = 0; r < 2; ++r)
#pragma unroll
            for (int i = 0; i < 4; ++i) { const u32x2 w = *(const u32x2*)(x2b + (size_t)(row0 + r) * 1024 + 256 * i + 4 * lane); xv[r][i] = (f32x4){bf_lo(w.x), bf_hi(w.x), bf_lo(w.y), bf_hi(w.y)}; acc[r][i] = (f32x4){0.f, 0.f, 0.f, 0.f}; }
        const unsigned long long bal = __ballot(myslot >= 0);
        unsigned mask0 = (unsigned)(bal & 0xffffull), mask1 = (unsigned)((bal >> 16) & 0xffffull);
        while (mask0 | mask1) {
            int m[2][2];
#pragma unroll
            for (int j = 0; j < 2; ++j) { if (mask0) { const int e = __builtin_ctz(mask0); mask0 &= mask0 - 1; m[0][j] = __builtin_amdgcn_readlane(myslot, e); } else m[0][j] = MMOE;
                                          if (mask1) { const int e = __builtin_ctz(mask1); mask1 &= mask1 - 1; m[1][j] = __builtin_amdgcn_readlane(myslot, 16 + e); } else m[1][j] = MMOE; }
            u32x2 w[2][2][4];
#pragma unroll
            for (int r = 0; r < 2; ++r)
#pragma unroll
                for (int j = 0; j < 2; ++j)
#pragma unroll
                    for (int i = 0; i < 4; ++i) w[r][j][i] = *(const u32x2*)(oute + (size_t)m[r][j] * 1024 + 256 * i + 4 * lane);
#pragma unroll
            for (int r = 0; r < 2; ++r)
#pragma unroll
                for (int j = 0; j < 2; ++j)
#pragma unroll
                    for (int i = 0; i < 4; ++i) { acc[r][i][0] += bf_lo(w[r][j][i].x); acc[r][i][1] += bf_hi(w[r][j][i].x); acc[r][i][2] += bf_lo(w[r][j][i].y); acc[r][i][3] += bf_hi(w[r][j][i].y); }
        }
        float ss[2];
#pragma unroll
        for (int r = 0; r < 2; ++r) { float a = 0.f;
#pragma unroll
            for (int i = 0; i < 4; ++i) { const int d = 256 * i + 4 * lane; const f32x4 g2 = *(const f32x4*)(ada + b * 6144 + 5120 + d); xv[r][i] += g2 * acc[r][i];
                a += xv[r][i][0] * xv[r][i][0] + xv[r][i][1] * xv[r][i][1] + xv[r][i][2] * xv[r][i][2] + xv[r][i][3] * xv[r][i][3]; }
            ss[r] = a; }
#pragma unroll
        for (int o = 32; o >= 1; o >>= 1) { ss[0] += __shfl_xor(ss[0], o); ss[1] += __shfl_xor(ss[1], o); }
#pragma unroll
        for (int r = 0; r < 2; ++r) { const float rs = rsqrtf(ss[r] * (1.0f / 1024.0f) + 1e-6f);
#pragma unroll
            for (int i = 0; i < 4; ++i) { const int d = 256 * i + 4 * lane; *(f32x4*)(dst + (size_t)(row0 + r) * 1024 + d) = xv[r][i] * rs * *(const f32x4*)(p.final_g + d); } }
        myslot = nslot;
    }
}

#define XB_TMO      128
#define XB_XCNT(j)  (256  + 64 * (j))
#define XB_XSUB(j)  (1280 + 64 * (j))
#define XB_XGEN(j)  (2304 + 64 * (j))
#define XB_TOP      3328
#define XB_TOPGEN   3392
#define XCD_BAR_WORDS 3456
#define XB_SPIN_CAP (1u << 22)
__device__ __forceinline__ unsigned xb_ld(unsigned* p)              { return __hip_atomic_load(p, __ATOMIC_RELAXED, __HIP_MEMORY_SCOPE_AGENT); }
__device__ __forceinline__ unsigned xb_add(unsigned* p, unsigned v) { return __hip_atomic_fetch_add(p, v, __ATOMIC_RELAXED, __HIP_MEMORY_SCOPE_AGENT); }
__device__ __forceinline__ unsigned xb_xcc_id() { return (unsigned)__builtin_amdgcn_s_getreg((3 << 11) | 20) & 0xFu; }
#define XB_SPIN(cond, bar) do { unsigned _sp = 0; while (cond) { __builtin_amdgcn_s_sleep(1); \
    if ((++_sp & 255u) == 0u) { if (xb_ld(&(bar)[XB_TMO])) break; if (_sp > XB_SPIN_CAP) { atomicAdd(&(bar)[XB_TMO], 1u); break; } } } } while (0)
struct XcdBarrier { unsigned* bar; unsigned x; volatile LAS unsigned* st; };
__device__ __forceinline__ XcdBarrier xcd_barrier_post(unsigned* bar, volatile LAS unsigned* st) {
    XcdBarrier b; b.bar = bar; b.x = xb_xcc_id(); b.st = st;
    if (threadIdx.x == 0) (void)xb_add(&bar[XB_XCNT(b.x)], 1u);
    return b;
}
__device__ __forceinline__ void xcd_barrier_complete(unsigned* bar, unsigned x, unsigned& nloc, unsigned& nx) {
    const unsigned G = gridDim.x * gridDim.y * gridDim.z;
    unsigned sum, cnt, mine, sp = 0u;
    for (;;) {
        sum = 0u; cnt = 0u; mine = 0u;
#pragma unroll
        for (unsigned j = 0; j < 16; ++j) { const unsigned c = xb_ld(&bar[XB_XCNT(j)]); sum += c; cnt += (c > 0u) ? 1u : 0u; mine = (j == x) ? c : mine; }
        if (sum == G) break;
        __builtin_amdgcn_s_sleep(1);
        if ((++sp & 255u) == 0u) { if (xb_ld(&bar[XB_TMO])) break; if (sp > XB_SPIN_CAP) { atomicAdd(&bar[XB_TMO], 1u); break; } }
    }
    nloc = mine > 0u ? mine : 1u; nx = cnt > 0u ? cnt : 1u;
}
__device__ __forceinline__ void xcd_barrier(const XcdBarrier& b) {
    asm volatile("s_waitcnt vmcnt(0)" ::: "memory");
    __syncthreads();
    if (threadIdx.x == 0) {
        unsigned* bar = b.bar;
        __builtin_amdgcn_s_waitcnt(0);
        unsigned nloc = b.st[0], nx = b.st[1];
        if (nloc == 0u) { xcd_barrier_complete(bar, b.x, nloc, nx); b.st[0] = nloc; b.st[1] = nx; }
        const unsigned old = xb_add(&bar[XB_XSUB(b.x)], 1u);
        const unsigned gen = old / nloc;
        if (old + 1u == (gen + 1u) * nloc) {
            __builtin_amdgcn_fence(__ATOMIC_RELEASE, "agent");
            asm volatile("s_waitcnt vmcnt(0)" ::: "memory");
            const unsigned og = xb_add(&bar[XB_TOP], 1u);
            const unsigned tg = og / nx;
            if (og + 1u == (tg + 1u) * nx) xb_add(&bar[XB_TOPGEN], 1u);
            else XB_SPIN(xb_ld(&bar[XB_TOPGEN]) == tg, bar);
            __builtin_amdgcn_fence(__ATOMIC_ACQUIRE, "agent");
            xb_add(&bar[XB_XGEN(b.x)], 1u);
            asm volatile("s_waitcnt vmcnt(0)" ::: "memory");
        } else {
            XB_SPIN(xb_ld(&bar[XB_XGEN(b.x)]) == gen, bar);
            __builtin_amdgcn_fence(__ATOMIC_ACQUIRE, "agent");
            asm volatile("s_waitcnt vmcnt(0)" ::: "memory");
        }
    }
    __syncthreads();
}

__global__ void __launch_bounds__(NTHR, 2) fwd_megakernel(Params p_in) {
    Params p = p_in;
    extern __shared__ __attribute__((aligned(16))) unsigned char lds_raw[];
    LAS unsigned char* lds = (LAS unsigned char*)lds_raw;
    cg::grid_group grid = cg::this_grid();
    const int G = gridDim.x, bid = blockIdx.x;
    unsigned char* ws = p.ws;
    bf16_t* const R1 = (bf16_t*)(ws + WS_R1); bf16_t* const Zb = (bf16_t*)(ws + WS_RZ); bf16_t* const PQt = (bf16_t*)(ws + WS_RPQ); bf16_t* const MRG = (bf16_t*)(ws + WS_R2);
    bf16_t* const Fb = (bf16_t*)((unsigned char*)p.out + OUT_F); bf16_t* const Ytb = (bf16_t*)((unsigned char*)p.out + OUT_YT);
#ifdef ONLY_PH
#define PH(k) ((k) == ONLY_PH && p.ph_lo <= (k) && (k) < p.ph_hi)
#else
#define PH(k) (p.ph_lo <= (k) && (k) < p.ph_hi)
#endif
    volatile LAS unsigned* xst = (volatile LAS unsigned*)(lds + LDS_BYTES - 16);
    if (threadIdx.x < 4) xst[threadIdx.x] = 0u;
    __syncthreads();
    XcdBarrier xbar = xcd_barrier_post((unsigned*)(ws + WS_BAR), xst);
    if (p.ph_lo < 0) grid.sync();
#ifdef TS_A
    unsigned long long* tsb = (unsigned long long*)(ws + WS_BAR + 40 * KiB);
#define STAMP(i) do { if (bid == 0 && threadIdx.x == 0) tsb[i] = __builtin_amdgcn_s_memrealtime(); } while (0)
#else
#define STAMP(i) do { } while (0)
#endif
    STAMP(0);
#define LAUNDER() do { asm volatile("" : "+s"(p.ws), "+s"(p.out), "+s"(p.x)); ws = p.ws; } while (0)
#define SYNC(k) do { if (PH(k) && PH((k) + 1)) xcd_barrier(xbar); STAMP((k) + 1); LAUNDER(); } while (0)
#ifndef REPMASK
#define REPMASK 0
#endif
#define REP(k) for (int rep_ = 0; rep_ <= ((REPMASK >> (k)) & 1); ++rep_)
    if (PH(0)) REP(0) phase0(p, lds);
    SYNC(0);
    if (PH(1)) REP(1) phase1(p);
    SYNC(1);
    if (PH(2)) REP(2) {
        { ProbPQ pr{(const bf16_t*)(ws + WS_WPQ), R1, 1024, 1024, 16384}; pg8::Order S; S.init(4, 128, G, bid); EpiPQ E{PQt}; pg8::gemm_phase(lds, pr, S, E); }
        { ProbPlain pr{R1, (const bf16_t*)(ws + WS_WIN), 1024, 1024, 1024}; pg8::Order S; S.init(128, 16, G, bid); EpiZ E{Zb, 4096, -1}; pg8::gemm_phase(lds, pr, S, E); }
        { ProbPlain pr{(const bf16_t*)(ws + WS_HCTX), (const bf16_t*)(ws + WS_WIN), 1024, 1024, 1024}; pg8::Order S; S.init(8, 4, G, bid); EpiZ E{(bf16_t*)(ws + WS_ZXC), 1024, 0}; pg8::gemm_phase(lds, pr, S, E); }
    }
    SYNC(2);
    if (PH(3)) REP(3) {
        {
            ProbPlain pr{(const bf16_t*)(ws + WS_D1T), PQt, 512, 512, 512}; pg8::Order S; S.init(2, 256, G, bid);
            if (G == 256) { if (bid >= 128) { S.G = 128; S.c = bid - 128; S.base = 0; S.lim = 3; } else { S.G = 128; S.c = bid; S.base = 384; S.lim = 1; } }
            EpiPlain E{Ytb, 65536}; pg8::gemm_phase(lds, pr, S, E); }
        for (int it = bid; it < NB * 2 * 8; it += G) lru_tile<false>(p, lds, it);
    }
    SYNC(3);
    if (PH(4)) {
        fft_stage2_all(p, lds);
        const int ngr = G >> 5;
        if (ngr > 0 && bid < ngr * 32) lru2_block(p, lds, bid % ngr, bid / ngr, ngr);
    }
    SYNC(4);
    if (PH(5)) REP(5) {
        { ProbMerge pr{Fb, (const bf16_t*)(ws + WS_WFOUR), R1, (const bf16_t*)(ws + WS_WLRU), 512, 1024, 512, 512, 1024, 1024}; pg8::Order S; S.init(128, 4, G, bid); EpiMerge E{MRG, Zb}; pg8::gemm_phase2(lds, pr, S, E); }
    }
    SYNC(5);
    if (PH(6)) REP(6) { ProbPlain pr{MRG, (const bf16_t*)(ws + WS_WOUT), 1024, 1024, 1024}; pg8::Order S; S.init(128, 4, G, bid); if (512 % G == 0) S.rev = 512 / G;
        EpiOut E{(bf16_t*)(ws + WS_X2B), p.x, (const float*)(ws + WS_POS), (const float*)(ws + WS_ADA)}; pg8::gemm_phase(lds, pr, S, E); }
    SYNC(6);
    if (PH(7)) { phase7_rows(p, lds); if (G == 256) phase7_topk(p, lds); phase7_weights(p); }
    SYNC(7);
    if (PH(8) && G != 256) { for (int it = bid; it < NB * NE; it += G) topk_task(p, lds, it); }
    if (G != 256) SYNC(8);
    if (PH(9)) REP(9) { ProbMoeUp pr{(const bf16_t*)(ws + WS_H2), (const bf16_t*)(ws + WS_WGU), (const int*)(ws + WS_IDX), 1024, 1024, 1024}; pg8::Order S; S.init(256, 12, G, bid); EpiGU E{(bf16_t*)(ws + WS_HID)}; pg8::gemm_phase(lds, pr, S, E); }
    SYNC(9);
    if (PH(10)) { if (bid == 0 && threadIdx.x < 128) *(u32x4*)(ws + WS_OUTE + (size_t)MMOE * 2048 + threadIdx.x * 16) = (u32x4){0u, 0u, 0u, 0u}; }
    if (PH(10)) REP(10) { ProbMoeDown pr{(const bf16_t*)(ws + WS_HID), (const bf16_t*)(ws + WS_WD), 1536, 1536, 1536}; pg8::Order S; S.init(256, 4, G, bid); if (1024 % G == 0) S.rev = 1024 / G; EpiDown E{(bf16_t*)(ws + WS_OUTE), (const float*)(ws + WS_GATE)}; pg8::gemm_phase(lds, pr, S, E); }
    SYNC(10);
    if (PH(11)) phase11(p, p.out);
#ifdef TS_A
    xcd_barrier(xbar); STAMP(12);
    if (bid == 0 && threadIdx.x == 0) {

#ifndef TS_AE
#define TS_AE (TS_A + 1)
#endif
#ifndef TS_BE
#define TS_BE (TS_B + 1)
#endif
        const float ta = (float)(tsb[TS_AE] - tsb[TS_A]) * 0.01f * (float)(TS_SA), tb = (float)(tsb[TS_BE] - tsb[TS_B]) * 0.01f * (float)(TS_SB);
        p.out[7] = fminf(ta, 97.f); p.out[1024 * 5 + 9] = fminf(tb, 97.f); }
#endif
}

#ifndef N_LAUNCHES
#define N_LAUNCHES 1
#endif
#ifndef PROBE_DUP
#define PROBE_DUP 0x0
#endif
extern "C" void kernel_launch(void* const* d_in, const int* in_sizes, int n_in, void* d_out, int out_size, void* d_ws, size_t ws_size, hipStream_t stream) {
    static int grid = 0;
    if (grid == 0) {
        if (n_in != 24 || out_size != MLAT * DM || ws_size < WS_END) { fprintf(stderr, "kernel_launch: unexpected shapes (n_in %d out %d ws %zu)\n", n_in, out_size, ws_size); grid = -1; return; }
        int dev = 0, cus = 0, per_cu = 0;
        hipGetDevice(&dev); hipDeviceGetAttribute(&cus, hipDeviceAttributeMultiprocessorCount, dev);
        hipFuncSetAttribute((const void*)fwd_megakernel, hipFuncAttributeMaxDynamicSharedMemorySize, LDS_BYTES);
        hipOccupancyMaxActiveBlocksPerMultiprocessor(&per_cu, (const void*)fwd_megakernel, NTHR, LDS_BYTES);
        if (per_cu < 1) { fprintf(stderr, "kernel_launch: occupancy query reports %d blocks per CU\n", per_cu); per_cu = 1; }
        grid = cus * 1;
        (void)hipGetLastError();
    }
    if (grid < 0) return;
    Params p{};
    const float** f = (const float**)&p;
    for (int i = 0; i < 24; ++i) f[i] = (const float*)d_in[i];
    p.out = (float*)d_out; p.ws = (unsigned char*)d_ws;
    (void)hipMemsetAsync((unsigned char*)d_ws + WS_BAR, 0, 48 * KiB, stream);
#if N_LAUNCHES == 1
    p.ph_lo = 0; p.ph_hi = 12;
    void* args[] = {&p};
    hipError_t e = hipLaunchCooperativeKernel((const void*)fwd_megakernel, dim3(grid), dim3(NTHR), args, LDS_BYTES, stream);
    if (e != hipSuccess) fprintf(stderr, "cooperative launch failed: %s (grid %d)\n", hipGetErrorString(e), grid);
#else
    for (int k = 0; k < 12; ++k) for (int r = 0; r <= ((PROBE_DUP >> k) & 1); ++r) { p.ph_lo = k; p.ph_hi = k + 1; if (k == 11 && r == 0 && ((PROBE_DUP >> 11) & 1)) { p.ph_lo = 12; p.ph_hi = 13; } hipLaunchKernelGGL(fwd_megakernel, dim3(grid), dim3(NTHR), LDS_BYTES, stream, p); }
#endif
}
```

```cpp
#include <hip/hip_runtime.h>
#include <hip/hip_cooperative_groups.h>
#include <cstdio>
namespace cg = cooperative_groups;

#ifndef P9_WGM
#define P9_WGM 2
#endif
#define LAS __attribute__((address_space(3)))
typedef unsigned short bf16_t;
typedef short bf16x8 __attribute__((ext_vector_type(8)));
typedef float f32x4 __attribute__((ext_vector_type(4)));
typedef float f32x16 __attribute__((ext_vector_type(16)));
typedef unsigned u32x4 __attribute__((ext_vector_type(4)));
typedef unsigned u32x2 __attribute__((ext_vector_type(2)));
typedef unsigned long long u64_t;

constexpr int NB = 8, TT = 4096, DM = 1024, CTXL = 256, MLAT = NB * TT, MCTX = NB * CTXL;
constexpr int NE = 16, CAP = 512, DE = 1536, MMOE = NE * NB * CAP;
constexpr int NSEQ = 34;
constexpr int NTHR = 512;
constexpr float NLOG2E = -1.4426950408889634f;
constexpr int LDS_BYTES = 144 * 1024;

constexpr size_t KiB = 1024, MiB = 1024 * 1024;
constexpr size_t WS_ADA = 0;
constexpr size_t WS_POS = 256 * KiB;
constexpr size_t WS_AGG = 512 * KiB;
constexpr size_t WS_WPQ = 5 * MiB;
constexpr size_t WS_WIN = 7 * MiB;
constexpr size_t WS_WFOUR = 15 * MiB;
constexpr size_t WS_WLRU = 16 * MiB;
constexpr size_t WS_WOUT = 18 * MiB;
constexpr size_t WS_WAT = 20 * MiB;
constexpr size_t WS_WIT = 20 * MiB + 512 * KiB;
constexpr size_t WS_SCORES = 21 * MiB;
constexpr size_t WS_IDX = 23 * MiB;
constexpr size_t WS_GATE = 23 * MiB + 256 * KiB;
constexpr size_t WS_SLOT = 23 * MiB + 512 * KiB;
constexpr size_t WS_BAR = 25 * MiB + 512 * KiB;
constexpr size_t WS_D1T = 34 * MiB;
constexpr size_t WS_D2T = 34 * MiB + 512 * KiB;
constexpr size_t WS_HCTX = 26 * MiB;
constexpr size_t WS_ZXC = 30 * MiB;
constexpr size_t WS_R1 = 40 * MiB;
constexpr size_t WS_RPQ = 104 * MiB;
constexpr size_t WS_R2 = 168 * MiB;
constexpr size_t WS_RZ = 232 * MiB;
constexpr size_t WS_END = 504 * MiB;
constexpr size_t WS_X2B = WS_R1, WS_H2 = WS_RPQ, WS_WGU = 168 * MiB, WS_WD = 264 * MiB, WS_HID = 312 * MiB, WS_OUTE = WS_RPQ;
constexpr size_t OUT_YT = 0, OUT_F = 64 * MiB;

struct Params {
    const float *x, *c, *ctx, *c_ctx, *w_ada, *b_ada, *norm1_g, *norm2_g, *w_in, *w_four, *conv_w, *conv_b, *lru_lambda,
        *lru_wa, *lru_ba, *lru_wi, *lru_bi, *w_lru, *w_out, *w_router, *w_gate_e, *w_up_e, *w_down_e, *final_g;
    float* out; unsigned char* ws; int ph_lo, ph_hi;
};

__device__ __forceinline__ int tid_opaque() { int t = threadIdx.x; asm volatile("" : "+v"(t)); return t; }
__device__ __forceinline__ unsigned cvt_pk_bf16(float lo, float hi) { unsigned r; asm volatile("v_cvt_pk_bf16_f32 %0, %1, %2" : "=v"(r) : "v"(lo), "v"(hi)); return r; }
__device__ __forceinline__ void mfma_settle(f32x4& a) { asm volatile("s_nop 15\n\ts_nop 7" : "+v"(a)); }
__device__ __forceinline__ void block_wait_ge(unsigned* cnt, unsigned need) {
    if (threadIdx.x < 64) { unsigned sp = 0;
        while ((unsigned)__builtin_amdgcn_readfirstlane(__hip_atomic_load(cnt, __ATOMIC_RELAXED, __HIP_MEMORY_SCOPE_AGENT)) < need) { __builtin_amdgcn_s_sleep(2); if (++sp > (1u << 22)) break; }
        __builtin_amdgcn_fence(__ATOMIC_ACQUIRE, "agent"); asm volatile("s_waitcnt vmcnt(0)" ::: "memory"); }
    __syncthreads();
}
__device__ __forceinline__ float bf_lo(unsigned w) { return __uint_as_float(w << 16); }
__device__ __forceinline__ float bf_hi(unsigned w) { return __uint_as_float(w & 0xffff0000u); }
__device__ __forceinline__ float bf2f(bf16_t h) { return __uint_as_float(((unsigned)h) << 16); }
__device__ __forceinline__ float sigmoidf_(float v) { return __builtin_amdgcn_rcpf(1.0f + __expf(-v)); }
__device__ __forceinline__ float gelu_tanh(float v) { const float y = 1.5957691216f * (v + 0.044715f * v * v * v); return v * sigmoidf_(y); }
__device__ __forceinline__ float wave_sum(float v) {
#pragma unroll
    for (int o = 32; o >= 1; o >>= 1) v += __shfl_xor(v, o);
    return v;
}
__device__ __forceinline__ void unpack8(const u32x4 w, float (&f)[8]) { f[0] = bf_lo(w.x); f[1] = bf_hi(w.x); f[2] = bf_lo(w.y); f[3] = bf_hi(w.y); f[4] = bf_lo(w.z); f[5] = bf_hi(w.z); f[6] = bf_lo(w.w); f[7] = bf_hi(w.w); }

namespace pg8 {
constexpr int BM = 256, BK = 64, HALF = 128, HTB = HALF * BK * 2, STAGE_BYTES = 8 * HTB, NXCD = 8, WGM = 2;
__device__ __forceinline__ int lds_byte(int r, int c) { const int st = (r >> 4) * 2 + (c >> 5), rr = r & 15, cc = c & 31, ob = rr * 64 + cc * 2; return st * 1024 + (ob ^ (((ob >> 9) & 1) << 5)); }
__device__ __forceinline__ void stage_rc(int b, int& R, int& C) { const int st = b / 1024, sb = b % 1024, swz = sb ^ (((sb >> 9) & 1) << 5); R = (st >> 1) * 16 + swz / 64; C = (st & 1) * 32 + (swz % 64) / 2; }
__device__ __forceinline__ int perm32(int rho) { const int n = rho >> 4, i = rho & 15; return 8 * (i >> 2) + 4 * n + (i & 3); }
struct Unit { int pm, pn; };
struct Order {
    int nM, nN, nwg, G, c, base, lim, rev, wgm;
    __device__ void init(int nM_, int nN_, int G_, int c_) { nM = nM_; nN = nN_; nwg = nM * nN; G = G_; c = c_; base = 0; lim = 0x7fffffff; rev = 0; wgm = WGM; }
    __device__ bool next(int i, Unit& u) const {
        if (rev > 0 && i >= rev) return false;
        const long L = (long)base + (long)(rev > 0 ? rev - 1 - i : i) * G + c; if (i >= lim || L >= nwg) return false;
        int wgid = (int)L; { const int q = nwg / NXCD, r = nwg % NXCD, xcd = wgid % NXCD, off = wgid / NXCD; wgid = (xcd < r ? xcd * (q + 1) : r * (q + 1) + (xcd - r) * q) + off; }
        const int nig = wgm * nN, gid = wgid / nig, fm = gid * wgm, gsz = (nM - fm) < wgm ? (nM - fm) : wgm;
        u.pm = fm + ((wgid % nig) % gsz); u.pn = (wgid % nig) / gsz; return true;
    }
};
template <class P, class Epi>
__device__ __forceinline__ void gemm_phase(LAS unsigned char* lds, const P& pr, const Order& S, const Epi& E) {
    const int tid = tid_opaque(), wid = __builtin_amdgcn_readfirstlane(tid >> 6), lane = tid & 63, wr = wid >> 2, wc = wid & 3, fr = lane & 15, fq = lane >> 4;
    const int nt = pr.K / BK;
    int RA[2], CA[2]; unsigned voffB[2];
#pragma unroll
    for (int i = 0; i < 2; ++i) { int R, C; stage_rc(tid * 16 + i * 8192, R, C); RA[i] = R; CA[i] = C; const int Rb = Epi::PERM ? ((R & ~31) + perm32(R & 31)) : R; voffB[i] = (unsigned)(Rb * pr.ldb + C) * 2u; }
    const size_t kstep = (size_t)(BK * 2);
    const size_t hstepB = (size_t)HALF * pr.ldb * 2;
    const unsigned ldsw = (unsigned)wid * 1024u;
    const int aoff = lds_byte(wr * 64 + fr, fq * 8), boff = lds_byte(wc * 32 + fr, fq * 8);
#define PG8_SA(b, h) (((b) * 2 + (h)) * HTB)
#define PG8_SB(b, h) ((4 + (b) * 2 + (h)) * HTB)
#define PG8_STAGE(bufoff, gbase, voff) do { _Pragma("unroll") for (int _i = 0; _i < 2; ++_i) \
        __builtin_amdgcn_global_load_lds((const unsigned*)((const char*)(gbase) + (voff)[_i]), (LAS unsigned*)(lds + (bufoff) + ldsw + _i * 8192), 16, 0, 0); } while (0)
#define PG8_LDA(dst, b, h) do { _Pragma("unroll") for (int m = 0; m < 4; ++m) _Pragma("unroll") for (int k = 0; k < 2; ++k) dst[m][k] = *(const LAS bf16x8*)(lds + PG8_SA(b, h) + aoff + m * 2048 + k * 1024); } while (0)
#define PG8_LDB(dst, b, h) do { _Pragma("unroll") for (int n = 0; n < 2; ++n) _Pragma("unroll") for (int k = 0; k < 2; ++k) dst[n][k] = *(const LAS bf16x8*)(lds + PG8_SB(b, h) + boff + n * 2048 + k * 1024); } while (0)
#define PG8_MMA(ai, bj, At, Bt) do { __builtin_amdgcn_s_setprio(1); _Pragma("unroll") for (int m = 0; m < 4; ++m) _Pragma("unroll") for (int n = 0; n < 2; ++n) _Pragma("unroll") for (int k = 0; k < 2; ++k) \
        acc[ai][bj][m][n] = __builtin_amdgcn_mfma_f32_16x16x32_bf16(Bt[n][k], At[m][k], acc[ai][bj][m][n], 0, 0, 0); __builtin_amdgcn_s_setprio(0); } while (0)
#define PG8_WAIT_V(n) asm volatile("s_waitcnt vmcnt(" #n ")" ::: "memory")
#define PG8_WAIT_L(n) asm volatile("s_waitcnt lgkmcnt(" #n ")" ::: "memory")
#define PG8_BAR __builtin_amdgcn_s_barrier()
#define PG8_SCHED __builtin_amdgcn_sched_barrier(0)
    Unit cur, nxt; int ui = 0;
    if (!S.next(0, cur)) return;
    f32x4 acc[2][2][4][2];
#pragma unroll
    for (int a = 0; a < 2; ++a)
#pragma unroll
        for (int b = 0; b < 2; ++b)
#pragma unroll
            for (int m = 0; m < 4; ++m)
#pragma unroll
                for (int n = 0; n < 2; ++n) acc[a][b][m][n] = (f32x4){0.f, 0.f, 0.f, 0.f};
    bf16x8 At[4][2], B0[2][2], B1[2][2];
    unsigned vA[2][2], vN[2][2];
    pr.avoff(cur, RA, CA, vA);
#pragma unroll
    for (int h = 0; h < 2; ++h)
#pragma unroll
        for (int i = 0; i < 2; ++i) vN[h][i] = vA[h][i];
    const char* cA = pr.abase(cur); const char* cB = pr.bbase(cur);
#define PG8_ROT(u) 0
#define PG8_KT(tt, rot) ((size_t)(((tt) + (rot)) >= nt ? ((tt) + (rot)) - nt : ((tt) + (rot))) * kstep)
    int rot = PG8_ROT(cur);
    { const char* pA = cA + PG8_KT(0, rot); const char* pB = cB + PG8_KT(0, rot);
    PG8_STAGE(PG8_SB(0, 0), pB, voffB); PG8_STAGE(PG8_SA(0, 0), pA, vA[0]); PG8_STAGE(PG8_SB(0, 1), pB + hstepB, voffB); PG8_STAGE(PG8_SA(0, 1), pA, vA[1]);
    if (wr == 1) PG8_BAR;
    PG8_WAIT_V(4); PG8_BAR;
    PG8_STAGE(PG8_SB(1, 0), pB + kstep, voffB); PG8_STAGE(PG8_SA(1, 0), pA + kstep, vA[0]); PG8_STAGE(PG8_SB(1, 1), pB + hstepB + kstep, voffB); }
    PG8_WAIT_V(6); PG8_BAR;
    for (;;) {
        const bool has_next = S.next(ui + 1, nxt);
        const char* nA = has_next ? pr.abase(nxt) : cA; const char* nB = has_next ? pr.bbase(nxt) : cB; const int nrot = has_next ? PG8_ROT(nxt) : rot;
        if (P::GATHER) { if (has_next) pr.avoff(nxt, RA, CA, vN); }
        for (int t = 0; t < nt; t += 2) {
            const bool last = (t == nt - 2);
            const char* a1 = cA + PG8_KT(t + 1, rot);
            const char* a2 = last ? nA + PG8_KT(0, nrot) : cA + PG8_KT(t + 2, rot); const char* b2 = last ? nB + PG8_KT(0, nrot) : cB + PG8_KT(t + 2, rot);
            const char* a3 = a2 + kstep; const char* b3 = b2 + kstep;
            unsigned v2[2][2];
#pragma unroll
            for (int h = 0; h < 2; ++h)
#pragma unroll
                for (int i = 0; i < 2; ++i) v2[h][i] = (P::GATHER && last) ? vN[h][i] : vA[h][i];
            PG8_LDB(B0, 0, 0); PG8_SCHED; PG8_LDA(At, 0, 0); PG8_STAGE(PG8_SA(1, 1), a1, vA[1]);
            PG8_WAIT_L(8); PG8_BAR; PG8_WAIT_L(0); PG8_MMA(0, 0, At, B0); PG8_BAR; PG8_SCHED;
            PG8_LDB(B1, 0, 1); PG8_STAGE(PG8_SB(0, 0), b2, voffB);
            PG8_BAR; PG8_WAIT_L(0); PG8_MMA(0, 1, At, B1); PG8_BAR;
            PG8_LDA(At, 0, 1); PG8_STAGE(PG8_SA(0, 0), a2, v2[0]);
            PG8_BAR; PG8_WAIT_L(0); PG8_MMA(1, 0, At, B0); PG8_BAR; PG8_SCHED;
            PG8_STAGE(PG8_SB(0, 1), b2 + hstepB, voffB);
            PG8_WAIT_V(6); PG8_BAR; PG8_MMA(1, 1, At, B1); PG8_BAR;
            PG8_LDB(B0, 1, 0); PG8_SCHED; PG8_LDA(At, 1, 0); PG8_STAGE(PG8_SA(0, 1), a2, v2[1]);
            PG8_WAIT_L(8); PG8_BAR; PG8_WAIT_L(0); PG8_MMA(0, 0, At, B0); PG8_BAR; PG8_SCHED;
            PG8_LDB(B1, 1, 1); PG8_STAGE(PG8_SB(1, 0), b3, voffB);
            PG8_BAR; PG8_WAIT_L(0); PG8_MMA(0, 1, At, B1); PG8_BAR;
            PG8_LDA(At, 1, 1); PG8_STAGE(PG8_SA(1, 0), a3, v2[0]);
            PG8_BAR; PG8_WAIT_L(0); PG8_MMA(1, 0, At, B0); PG8_BAR; PG8_SCHED;
            PG8_STAGE(PG8_SB(1, 1), b3 + hstepB, voffB);
            PG8_WAIT_V(6); PG8_BAR; PG8_MMA(1, 1, At, B1); PG8_BAR;
            if (P::GATHER && last) {
#pragma unroll
                for (int h = 0; h < 2; ++h)
#pragma unroll
                    for (int i = 0; i < 2; ++i) vA[h][i] = vN[h][i];
            }
        }
        E(acc, cur, wr, wc, fr, fq);
        if (!has_next) break;
#pragma unroll
        for (int a = 0; a < 2; ++a)
#pragma unroll
            for (int b = 0; b < 2; ++b)
#pragma unroll
                for (int m = 0; m < 4; ++m)
#pragma unroll
                    for (int n = 0; n < 2; ++n) acc[a][b][m][n] = (f32x4){0.f, 0.f, 0.f, 0.f};
        cur = nxt; cA = nA; cB = nB; rot = nrot; ++ui;
    }
    PG8_WAIT_V(0);
    if (wr == 0) PG8_BAR;
    PG8_BAR;
#undef PG8_ROT
#undef PG8_KT
#undef PG8_SA
#undef PG8_SB
#undef PG8_STAGE
#undef PG8_LDA
#undef PG8_LDB
#undef PG8_MMA
#undef PG8_WAIT_V
#undef PG8_WAIT_L
#undef PG8_BAR
#undef PG8_SCHED
}
template <class P, class Epi>
__device__ __forceinline__ void gemm_phase2(LAS unsigned char* lds, const P& pr, const Order& S, const Epi& E) {
    const int tid = tid_opaque(), wid = __builtin_amdgcn_readfirstlane(tid >> 6), lane = tid & 63, wr = wid >> 2, wc = wid & 3, fr = lane & 15, fq = lane >> 4;
    const int nt1 = pr.K1 / BK, nt = (pr.K1 + pr.K2) / BK;
    unsigned R2[2], Rb2[2], C2[2];
#pragma unroll
    for (int i = 0; i < 2; ++i) { int R, C; stage_rc(tid * 16 + i * 8192, R, C); const int Rb = Epi::PERM ? ((R & ~31) + perm32(R & 31)) : R; R2[i] = (unsigned)R * 2u; Rb2[i] = (unsigned)Rb * 2u; C2[i] = (unsigned)C * 2u; }
#define OFF_A(ld, h, i) ((R2[i] + (unsigned)((h) * 256)) * (unsigned)(ld) + C2[i])
#define OFF_B(ld, i) (Rb2[i] * (unsigned)(ld) + C2[i])
    const size_t kstep = (size_t)(BK * 2);
    const size_t hB1 = (size_t)HALF * pr.ldb1 * 2, hB2 = (size_t)HALF * pr.ldb2 * 2;
    const unsigned ldsw = (unsigned)wid * 1024u;
    const int aoff = lds_byte(wr * 64 + fr, fq * 8), boff = lds_byte(wc * 32 + fr, fq * 8);
#define PG8_SA(b, h) (((b) * 2 + (h)) * HTB)
#define PG8_SB(b, h) ((4 + (b) * 2 + (h)) * HTB)
#define PG8_STAGE(bufoff, gbase, voff) do { _Pragma("unroll") for (int _i = 0; _i < 2; ++_i) \
        __builtin_amdgcn_global_load_lds((const unsigned*)((const char*)(gbase) + (voff)[_i]), (LAS unsigned*)(lds + (bufoff) + ldsw + _i * 8192), 16, 0, 0); } while (0)
#define PG8_LDA(dst, b, h) do { _Pragma("unroll") for (int m = 0; m < 4; ++m) _Pragma("unroll") for (int k = 0; k < 2; ++k) dst[m][k] = *(const LAS bf16x8*)(lds + PG8_SA(b, h) + aoff + m * 2048 + k * 1024); } while (0)
#define PG8_LDB(dst, b, h) do { _Pragma("unroll") for (int n = 0; n < 2; ++n) _Pragma("unroll") for (int k = 0; k < 2; ++k) dst[n][k] = *(const LAS bf16x8*)(lds + PG8_SB(b, h) + boff + n * 2048 + k * 1024); } while (0)
#define PG8_MMA(ai, bj, At, Bt) do { __builtin_amdgcn_s_setprio(1); _Pragma("unroll") for (int m = 0; m < 4; ++m) _Pragma("unroll") for (int n = 0; n < 2; ++n) _Pragma("unroll") for (int k = 0; k < 2; ++k) \
        acc[ai][bj][m][n] = __builtin_amdgcn_mfma_f32_16x16x32_bf16(Bt[n][k], At[m][k], acc[ai][bj][m][n], 0, 0, 0); __builtin_amdgcn_s_setprio(0); } while (0)
#define PG8_WAIT_V(n) asm volatile("s_waitcnt vmcnt(" #n ")" ::: "memory")
#define PG8_WAIT_L(n) asm volatile("s_waitcnt lgkmcnt(" #n ")" ::: "memory")
#define PG8_BAR __builtin_amdgcn_s_barrier()
#define PG8_SCHED __builtin_amdgcn_sched_barrier(0)
    Unit cur, nxt; int ui = 0;
    if (!S.next(0, cur)) return;
    f32x4 acc[2][2][4][2];
#pragma unroll
    for (int a = 0; a < 2; ++a)
#pragma unroll
        for (int b = 0; b < 2; ++b)
#pragma unroll
            for (int m = 0; m < 4; ++m)
#pragma unroll
                for (int n = 0; n < 2; ++n) acc[a][b][m][n] = (f32x4){0.f, 0.f, 0.f, 0.f};
    bf16x8 At[4][2], B0[2][2], B1[2][2];
    const char* cA1 = pr.abase1(cur); const char* cB1 = pr.bbase1(cur); const char* cA2 = pr.abase2(cur); const char* cB2 = pr.bbase2(cur);
#define T_A(tt) ((tt) < nt1 ? cA1 + (size_t)(tt) * kstep : cA2 + (size_t)((tt) - nt1) * kstep)
#define T_B(tt) ((tt) < nt1 ? cB1 + (size_t)(tt) * kstep : cB2 + (size_t)((tt) - nt1) * kstep)
    { unsigned vb[2] = {OFF_B(pr.ldb1, 0), OFF_B(pr.ldb1, 1)}, va0[2] = {OFF_A(pr.lda1, 0, 0), OFF_A(pr.lda1, 0, 1)}, va1[2] = {OFF_A(pr.lda1, 1, 0), OFF_A(pr.lda1, 1, 1)};
    PG8_STAGE(PG8_SB(0, 0), cB1, vb); PG8_STAGE(PG8_SA(0, 0), cA1, va0); PG8_STAGE(PG8_SB(0, 1), cB1 + hB1, vb); PG8_STAGE(PG8_SA(0, 1), cA1, va1);
    if (wr == 1) PG8_BAR;
    PG8_WAIT_V(4); PG8_BAR;
    PG8_STAGE(PG8_SB(1, 0), cB1 + kstep, vb); PG8_STAGE(PG8_SA(1, 0), cA1 + kstep, va0); PG8_STAGE(PG8_SB(1, 1), cB1 + hB1 + kstep, vb); }
    PG8_WAIT_V(6); PG8_BAR;
    for (;;) {
        const bool has_next = S.next(ui + 1, nxt);
        const char* nA = has_next ? pr.abase1(nxt) : cA1; const char* nB = has_next ? pr.bbase1(nxt) : cB1;
        for (int t = 0; t < nt; t += 2) {
            const bool last = (t == nt - 2);
            const bool s1 = (t + 1 < nt1), s2 = last || (t + 2 < nt1);
            const char* a1 = T_A(t + 1);
            const char* a2 = last ? nA : T_A(t + 2); const char* b2 = last ? nB : T_B(t + 2);
            const char* a3 = a2 + kstep; const char* b3 = b2 + kstep;
            const size_t hstepB = s2 ? hB1 : hB2; const int ldaT1 = s1 ? pr.lda1 : pr.lda2, ldaT2 = s2 ? pr.lda1 : pr.lda2, ldbT2 = s2 ? pr.ldb1 : pr.ldb2;
            unsigned v2[2][2], voffB[2], vA1s[2];
#pragma unroll
            for (int i = 0; i < 2; ++i) { voffB[i] = OFF_B(ldbT2, i); vA1s[i] = OFF_A(ldaT1, 1, i);
#pragma unroll
                for (int h = 0; h < 2; ++h) v2[h][i] = OFF_A(ldaT2, h, i); }
            PG8_LDB(B0, 0, 0); PG8_SCHED; PG8_LDA(At, 0, 0); PG8_STAGE(PG8_SA(1, 1), a1, vA1s);
            PG8_WAIT_L(8); PG8_BAR; PG8_WAIT_L(0); PG8_MMA(0, 0, At, B0); PG8_BAR; PG8_SCHED;
            PG8_LDB(B1, 0, 1); PG8_STAGE(PG8_SB(0, 0), b2, voffB);
            PG8_BAR; PG8_WAIT_L(0); PG8_MMA(0, 1, At, B1); PG8_BAR;
            PG8_LDA(At, 0, 1); PG8_STAGE(PG8_SA(0, 0), a2, v2[0]);
            PG8_BAR; PG8_WAIT_L(0); PG8_MMA(1, 0, At, B0); PG8_BAR; PG8_SCHED;
            PG8_STAGE(PG8_SB(0, 1), b2 + hstepB, voffB);
            PG8_WAIT_V(6); PG8_BAR; PG8_MMA(1, 1, At, B1); PG8_BAR;
            PG8_LDB(B0, 1, 0); PG8_SCHED; PG8_LDA(At, 1, 0); PG8_STAGE(PG8_SA(0, 1), a2, v2[1]);
            PG8_WAIT_L(8); PG8_BAR; PG8_WAIT_L(0); PG8_MMA(0, 0, At, B0); PG8_BAR; PG8_SCHED;
            PG8_LDB(B1, 1, 1); PG8_STAGE(PG8_SB(1, 0), b3, voffB);
            PG8_BAR; PG8_WAIT_L(0); PG8_MMA(0, 1, At, B1); PG8_BAR;
            PG8_LDA(At, 1, 1); PG8_STAGE(PG8_SA(1, 0), a3, v2[0]);
            PG8_BAR; PG8_WAIT_L(0); PG8_MMA(1, 0, At, B0); PG8_BAR; PG8_SCHED;
            PG8_STAGE(PG8_SB(1, 1), b3 + hstepB, voffB);
            PG8_WAIT_V(6); PG8_BAR; PG8_MMA(1, 1, At, B1); PG8_BAR;
            if (t == nt1 - 2) E.mid(acc, cur, wr, wc, fr, fq);
        }
        E(acc, cur, wr, wc, fr, fq);
        if (!has_next) break;
#pragma unroll
        for (int a = 0; a < 2; ++a)
#pragma unroll
            for (int b = 0; b < 2; ++b)
#pragma unroll
                for (int m = 0; m < 4; ++m)
#pragma unroll
                    for (int n = 0; n < 2; ++n) acc[a][b][m][n] = (f32x4){0.f, 0.f, 0.f, 0.f};
        cur = nxt; cA1 = nA; cB1 = nB; cA2 = pr.abase2(cur); cB2 = pr.bbase2(cur); ++ui;
    }
    PG8_WAIT_V(0);
    if (wr == 0) PG8_BAR;
    PG8_BAR;
#undef T_A
#undef T_B
#undef OFF_A
#undef OFF_B
#undef PG8_SA
#undef PG8_SB
#undef PG8_STAGE
#undef PG8_LDA
#undef PG8_LDB
#undef PG8_MMA
#undef PG8_WAIT_V
#undef PG8_WAIT_L
#undef PG8_BAR
#undef PG8_SCHED
}
}
using pg8::Unit;

struct ProbPlain {
    static constexpr bool GATHER = false;
    const bf16_t* A; const bf16_t* B; int K, lda, ldb;
    __device__ __forceinline__ const char* abase(const Unit& u) const { return (const char*)(A + (size_t)u.pm * 256 * lda); }
    __device__ __forceinline__ const char* bbase(const Unit& u) const { return (const char*)(B + (size_t)u.pn * 256 * ldb); }
    __device__ __forceinline__ void avoff(const Unit&, const int (&RA)[2], const int (&CA)[2], unsigned (&v)[2][2]) const {
#pragma unroll
        for (int h = 0; h < 2; ++h)
#pragma unroll
            for (int i = 0; i < 2; ++i) v[h][i] = (unsigned)((h * 128 + RA[i]) * lda + CA[i]) * 2u;
    }
};
struct ProbMerge {
    const bf16_t* A1; const bf16_t* B1; const bf16_t* A2; const bf16_t* B2; int K1, K2, lda1, ldb1, lda2, ldb2;
    __device__ __forceinline__ const char* abase1(const Unit& u) const { return (const char*)(A1 + (size_t)u.pm * 256 * lda1); }
    __device__ __forceinline__ const char* bbase1(const Unit& u) const { return (const char*)(B1 + (size_t)u.pn * 256 * ldb1); }
    __device__ __forceinline__ const char* abase2(const Unit& u) const { return (const char*)(A2 + (size_t)u.pm * 256 * lda2); }
    __device__ __forceinline__ const char* bbase2(const Unit& u) const { return (const char*)(B2 + (size_t)u.pn * 256 * ldb2); }
};
struct ProbPQ {
    static constexpr bool GATHER = false;
    const bf16_t* A; const bf16_t* B; int K, lda, ldb;
    __device__ __forceinline__ const char* abase(const Unit& u) const { return (const char*)(A + (size_t)u.pm * 256 * lda); }
    __device__ __forceinline__ const char* bbase(const Unit& u) const { return (const char*)(B + ((size_t)(u.pn >> 4) * 4096 + (u.pn & 15)) * 1024); }
    __device__ __forceinline__ void avoff(const Unit&, const int (&RA)[2], const int (&CA)[2], unsigned (&v)[2][2]) const {
#pragma unroll
        for (int h = 0; h < 2; ++h)
#pragma unroll
            for (int i = 0; i < 2; ++i) v[h][i] = (unsigned)((h * 128 + RA[i]) * lda + CA[i]) * 2u;
    }
};
struct ProbMoeUp {
    static constexpr bool GATHER = true;
    const bf16_t* A; const bf16_t* B; const int* idx; int K, lda, ldb;
    __device__ __forceinline__ const char* abase(const Unit&) const { return (const char*)A; }
    __device__ __forceinline__ const char* bbase(const Unit& u) const { return (const char*)(B + ((size_t)(u.pm >> 4) * 3072 + (size_t)u.pn * 256) * ldb); }
    __device__ __forceinline__ void avoff(const Unit& u, const int (&RA)[2], const int (&CA)[2], unsigned (&v)[2][2]) const {
#pragma unroll
        for (int h = 0; h < 2; ++h)
#pragma unroll
            for (int i = 0; i < 2; ++i) { const int g = idx[u.pm * 256 + h * 128 + RA[i]]; v[h][i] = (unsigned)(g * lda + CA[i]) * 2u; }
    }
};
struct ProbMoeDown {
    static constexpr bool GATHER = false;
    const bf16_t* A; const bf16_t* B; int K, lda, ldb;
    __device__ __forceinline__ const char* abase(const Unit& u) const { return (const char*)(A + (size_t)u.pm * 256 * lda); }
    __device__ __forceinline__ const char* bbase(const Unit& u) const { return (const char*)(B + ((size_t)(u.pm >> 4) * 1024 + (size_t)u.pn * 256) * ldb); }
    __device__ __forceinline__ void avoff(const Unit&, const int (&RA)[2], const int (&CA)[2], unsigned (&v)[2][2]) const {
#pragma unroll
        for (int h = 0; h < 2; ++h)
#pragma unroll
            for (int i = 0; i < 2; ++i) v[h][i] = (unsigned)((h * 128 + RA[i]) * lda + CA[i]) * 2u;
    }
};

#define EPI_ROWS(...) _Pragma("unroll") for (int ai = 0; ai < 2; ++ai) _Pragma("unroll") for (int m = 0; m < 4; ++m) { const int row = u.pm * 256 + ai * 128 + wr * 64 + m * 16 + fr; __VA_ARGS__ }
__device__ __forceinline__ u32x4 pack8(const f32x4 v0, const f32x4 v1) { u32x4 w; w.x = cvt_pk_bf16(v0[0], v0[1]); w.y = cvt_pk_bf16(v0[2], v0[3]); w.z = cvt_pk_bf16(v1[0], v1[1]); w.w = cvt_pk_bf16(v1[2], v1[3]); return w; }

struct EpiPQ {
    static constexpr bool PERM = true; bf16_t* O;
    __device__ __forceinline__ void operator()(const f32x4 (&acc)[2][2][4][2], const Unit& u, int wr, int wc, int fr, int fq) const {
        const int t10 = wc * 32 + 8 * fq, b = u.pn >> 4, t2 = u.pn & 15;
        EPI_ROWS(
            bf16_t* rp = O + ((size_t)((b * 512 + (row >> 1)) * 16 + t2) * 512 + (row & 1) * 256 + t10);
            _Pragma("unroll") for (int bj = 0; bj < 2; ++bj) *(u32x4*)(rp + bj * 128) = pack8(acc[ai][bj][m][0], acc[ai][bj][m][1]);
        )
    }
};
struct EpiPlain {
    static constexpr bool PERM = true; bf16_t* O; size_t ldc;
    __device__ __forceinline__ void operator()(const f32x4 (&acc)[2][2][4][2], const Unit& u, int wr, int wc, int fr, int fq) const {
        const int col0 = u.pn * 256 + wc * 32 + 8 * fq;
        EPI_ROWS(
            bf16_t* rp = O + (size_t)row * ldc + col0;
            _Pragma("unroll") for (int bj = 0; bj < 2; ++bj) *(u32x4*)(rp + bj * 128) = pack8(acc[ai][bj][m][0], acc[ai][bj][m][1]);
        )
    }
};
struct EpiZ {
    static constexpr bool PERM = true; bf16_t* O; int ldc; int fixed_act;
    __device__ __forceinline__ void operator()(const f32x4 (&acc)[2][2][4][2], const Unit& u, int wr, int wc, int fr, int fq) const {
        const int col0 = u.pn * 256 + wc * 32 + 8 * fq; const int act = fixed_act >= 0 ? fixed_act : (u.pn >> 2);
        EPI_ROWS(
            bf16_t* rp = O + (size_t)row * ldc + col0;
            _Pragma("unroll") for (int bj = 0; bj < 2; ++bj) {
                f32x4 v0 = acc[ai][bj][m][0], v1 = acc[ai][bj][m][1];
                if (act == 1) { _Pragma("unroll") for (int j = 0; j < 4; ++j) { v0[j] = gelu_tanh(v0[j]); v1[j] = gelu_tanh(v1[j]); } }
                else if (act >= 2) { _Pragma("unroll") for (int j = 0; j < 4; ++j) { v0[j] = sigmoidf_(v0[j]); v1[j] = sigmoidf_(v1[j]); } }
                *(u32x4*)(rp + bj * 128) = pack8(v0, v1); }
        )
    }
};
struct EpiMerge {
    static constexpr bool PERM = true; bf16_t* O; const bf16_t* Z;
    __device__ __forceinline__ void mid(f32x4 (&acc)[2][2][4][2], const Unit& u, int wr, int wc, int fr, int fq) const {
        unsigned eo = (unsigned)((u.pm * 256 + wr * 64 + fr) * 4096 + 2048 + u.pn * 256 + wc * 32 + 8 * fq);
        asm volatile("" : "+v"(eo));
#pragma unroll
        for (int ai = 0; ai < 2; ++ai) {
            u32x4 wa[4][2], wb[4][2];
#pragma unroll
            for (int m = 0; m < 4; ++m)
#pragma unroll
                for (int bj = 0; bj < 2; ++bj) { const unsigned o = eo + (unsigned)((ai * 128 + m * 16) * 4096 + bj * 128); wa[m][bj] = __builtin_nontemporal_load((const u32x4*)(Z + o)); wb[m][bj] = *(const u32x4*)(Z + o + 1024); }
#pragma unroll
            for (int m = 0; m < 4; ++m)
#pragma unroll
                for (int bj = 0; bj < 2; ++bj) { float ga[8], gb[8]; unpack8(wa[m][bj], ga); unpack8(wb[m][bj], gb);
#pragma unroll
                    for (int j = 0; j < 4; ++j) { acc[ai][bj][m][0][j] *= ga[j] * __builtin_amdgcn_rcpf(fmaxf(gb[j], 1e-30f)); acc[ai][bj][m][1][j] *= ga[4 + j] * __builtin_amdgcn_rcpf(fmaxf(gb[4 + j], 1e-30f)); } }
            __builtin_amdgcn_sched_barrier(0); }
    }
    __device__ __forceinline__ void operator()(const f32x4 (&acc)[2][2][4][2], const Unit& u, int wr, int wc, int fr, int fq) const {
        unsigned eo = (unsigned)((u.pm * 256 + wr * 64 + fr) * 4096 + 3072 + u.pn * 256 + wc * 32 + 8 * fq); asm volatile("" : "+v"(eo));
        unsigned oo = (unsigned)((u.pm * 256 + wr * 64 + fr) * 1024 + u.pn * 256 + wc * 32 + 8 * fq); asm volatile("" : "+v"(oo));
        u32x4 wb[2][4][2];
#pragma unroll
        for (int ai = 0; ai < 2; ++ai)
#pragma unroll
            for (int m = 0; m < 4; ++m)
#pragma unroll
                for (int bj = 0; bj < 2; ++bj) wb[ai][m][bj] = __builtin_nontemporal_load((const u32x4*)(Z + eo + (unsigned)((ai * 128 + m * 16) * 4096 + bj * 128)));
#pragma unroll
        for (int ai = 0; ai < 2; ++ai)
#pragma unroll
            for (int m = 0; m < 4; ++m)
#pragma unroll
                for (int bj = 0; bj < 2; ++bj) { float g[8]; unpack8(wb[ai][m][bj], g);
                    f32x4 v0 = acc[ai][bj][m][0], v1 = acc[ai][bj][m][1];
#pragma unroll
                    for (int j = 0; j < 4; ++j) { v0[j] *= g[j]; v1[j] *= g[4 + j]; }
                    *(u32x4*)(O + oo + (unsigned)((ai * 128 + m * 16) * 1024 + bj * 128)) = pack8(v0, v1); }
    }
};
struct EpiOut {
    static constexpr bool PERM = true; bf16_t* O; const float* X; const float* pos; const float* ada;
    __device__ __forceinline__ void operator()(const f32x4 (&acc)[2][2][4][2], const Unit& u, int wr, int wc, int fr, int fq) const {
        const int col0 = u.pn * 256 + wc * 32 + 8 * fq; const int b = u.pm >> 4;
        unsigned ro = (unsigned)((u.pm * 256 + wr * 64 + fr) * 1024 + col0); asm volatile("" : "+v"(ro));
#pragma unroll
        for (int ai = 0; ai < 2; ++ai)
#pragma unroll
            for (int mh = 0; mh < 2; ++mh) {
                f32x4 xv[2][2][2];
#pragma unroll
                for (int m2 = 0; m2 < 2; ++m2)
#pragma unroll
                    for (int bj = 0; bj < 2; ++bj)
#pragma unroll
                        for (int n = 0; n < 2; ++n) xv[m2][bj][n] = __builtin_nontemporal_load((const f32x4*)(X + ro + (unsigned)((ai * 128 + (mh * 2 + m2) * 16) * 1024 + bj * 128 + n * 4)));
#pragma unroll
                for (int m2 = 0; m2 < 2; ++m2) { const int m = mh * 2 + m2; const int row = u.pm * 256 + ai * 128 + wr * 64 + m * 16 + fr; const int t = row & 4095;
#pragma unroll
                    for (int bj = 0; bj < 2; ++bj) { f32x4 o[2];
#pragma unroll
                        for (int n = 0; n < 2; ++n) { const int col = col0 + bj * 128 + n * 4;
                            const f32x4 pv = *(const f32x4*)(pos + (col < 512 ? (t >> 6) * 512 + col : (t & 63) * 512 + (col - 512)));
                            const f32x4 gv = *(const f32x4*)(ada + b * 6144 + 2048 + col);
                            o[n] = xv[m2][bj][n] + pv + gv * acc[ai][bj][m][n]; }
                        *(u32x4*)(O + ro + (unsigned)((ai * 128 + m * 16) * 1024 + bj * 128)) = pack8(o[0], o[1]); } }
                __builtin_amdgcn_sched_barrier(0); }
    }
};
struct EpiGU {
    static constexpr bool PERM = true; bf16_t* O;
    __device__ __forceinline__ void operator()(const f32x4 (&acc)[2][2][4][2], const Unit& u, int wr, int wc, int fr, int fq) const {
        const int col0 = u.pn * 128 + wc * 32 + 8 * fq;
        EPI_ROWS(
            f32x4 v0, v1;
            _Pragma("unroll") for (int j = 0; j < 4; ++j) { const float g0 = acc[ai][0][m][0][j], g1 = acc[ai][0][m][1][j];
                v0[j] = g0 * sigmoidf_(g0) * acc[ai][1][m][0][j]; v1[j] = g1 * sigmoidf_(g1) * acc[ai][1][m][1][j]; }
            *(u32x4*)(O + (size_t)row * DE + col0) = pack8(v0, v1);
        )
    }
};
struct EpiDown {
    static constexpr bool PERM = true; bf16_t* O; const float* gate;
    __device__ __forceinline__ void operator()(const f32x4 (&acc)[2][2][4][2], const Unit& u, int wr, int wc, int fr, int fq) const {
        const int col0 = u.pn * 256 + wc * 32 + 8 * fq;
        EPI_ROWS(
            const float g = gate[row];
            _Pragma("unroll") for (int bj = 0; bj < 2; ++bj) *(u32x4*)(O + (size_t)row * 1024 + col0 + bj * 128) = pack8(acc[ai][bj][m][0] * g, acc[ai][bj][m][1] * g);
        )
    }
};

__device__ __forceinline__ void p0_ada(const Params& p, LAS unsigned char* lds, int item) {
    const int tid = threadIdx.x, lane = tid & 63, wv = tid >> 6;
    LAS float* s = (LAS float*)lds; LAS float* red = s + 9 * 1024;
    { float cv[18];
#pragma unroll
      for (int k = 0; k < 18; ++k) { const int i = tid + NTHR * k, r = i >> 10, d = i & 1023; cv[k] = r < 8 ? p.c[r * 1024 + d] : p.c_ctx[d]; }
#pragma unroll
      for (int k = 0; k < 18; ++k) s[tid + NTHR * k] = cv[k] * __builtin_amdgcn_rcpf(1.0f + __expf(-cv[k])); }
    __syncthreads();
    const int col = lane % 24, dh = lane / 24;
    const int dsl = wv * 128 + dh * 64;
    float a[9];
#pragma unroll
    for (int r = 0; r < 9; ++r) a[r] = 0.f;
    if (dh < 2) {
        const float* w = p.w_ada + (size_t)dsl * 6144 + item * 24 + col;
        for (int d0 = 0; d0 < 64; d0 += 32) { float wv2[32];
#pragma unroll
            for (int j = 0; j < 32; ++j) wv2[j] = __builtin_nontemporal_load(w + (size_t)(d0 + j) * 6144);
#pragma unroll
            for (int j = 0; j < 32; ++j)
#pragma unroll
                for (int r = 0; r < 9; ++r) a[r] += s[r * 1024 + dsl + d0 + j] * wv2[j]; }
#pragma unroll
        for (int r = 0; r < 9; ++r) red[((wv * 2 + dh) * 9 + r) * 24 + col] = a[r];
    }
    __syncthreads();
    float* ada = (float*)(p.ws + WS_ADA);
    if (tid < 9 * 24) { const int r = tid / 24, cc = tid % 24; float v = 0.f;
#pragma unroll
        for (int k = 0; k < 16; ++k) v += red[(k * 9 + r) * 24 + cc];
        __hip_atomic_store(ada + r * 6144 + item * 24 + cc, v + p.b_ada[item * 24 + cc], __ATOMIC_RELAXED, __HIP_MEMORY_SCOPE_AGENT); }
    asm volatile("s_waitcnt vmcnt(0)" ::: "memory");
    __syncthreads();
    if (tid == 0) (void)__hip_atomic_fetch_add((unsigned*)(p.ws + WS_BAR + 46 * KiB), 1u, __ATOMIC_RELAXED, __HIP_MEMORY_SCOPE_AGENT);
}
template <int NS>
__device__ __forceinline__ void xpose_item(const float* src, int ldsrc, bf16_t* dst, int lddst, int k0, int n0, int mode, float scale = 1.0f) {
    const int tid = threadIdx.x, k8 = tid & 7, nq = tid >> 3;
    if (nq >= 16 * NS) return;
    f32x4 v[8];
#pragma unroll
    for (int j = 0; j < 8; ++j) v[j] = __builtin_nontemporal_load((const f32x4*)(src + (size_t)(k0 + 8 * k8 + j) * ldsrc + n0 + 4 * nq));
#pragma unroll
    for (int c = 0; c < 4; ++c) { const int n = n0 + 4 * nq + c; int row = n;
        if (mode) row = (n >> 7) * 256 + (n & 127) + (mode == 2 ? 128 : 0);
        u32x4 w; w.x = cvt_pk_bf16(v[0][c] * scale, v[1][c] * scale); w.y = cvt_pk_bf16(v[2][c] * scale, v[3][c] * scale); w.z = cvt_pk_bf16(v[4][c] * scale, v[5][c] * scale); w.w = cvt_pk_bf16(v[6][c] * scale, v[7][c] * scale);
        *(u32x4*)(dst + (size_t)row * lddst + k0 + 8 * k8) = w; }
}
__device__ __forceinline__ void p0_wpq(const Params& p, LAS unsigned char* lds, int item) {
    const int tid = threadIdx.x, g = item >> 6, db = item & 63;
    LAS float* wl = (LAS float*)lds; LAS float* ct = wl + 16 * 129;
    for (int i = tid; i < 16 * 128; i += NTHR) { const int d = i >> 7, cc = i & 127; wl[d * 129 + cc] = p.w_in[(size_t)(db * 16 + d) * 4608 + g * 128 + cc]; }
    if (tid < 128) { float sn, cs; sincospif((float)tid * (1.0f / 64.0f), &sn, &cs); ct[tid] = cs; ct[128 + tid] = sn; }
    __syncthreads();
    const int q = tid & 255, kc = q >> 1, pq = q & 1, dh = tid >> 8; const int n = (g * 128 + kc) * 2 + pq;
    bf16_t* dst = (bf16_t*)(p.ws + WS_WPQ) + (size_t)n * 1024 + db * 16 + dh * 8;
    const float scale = 0.001381067932f;
    float a[8];
#pragma unroll
    for (int j = 0; j < 8; ++j) a[j] = 0.f;
    for (int cc = 0; cc < 128; ++cc) { const float tv = ct[pq * 128 + ((cc * kc) & 127)];
#pragma unroll
        for (int j = 0; j < 8; ++j) a[j] += wl[(dh * 8 + j) * 129 + cc] * tv; }
    u32x4 w; w.x = cvt_pk_bf16(a[0] * scale, a[1] * scale); w.y = cvt_pk_bf16(a[2] * scale, a[3] * scale); w.z = cvt_pk_bf16(a[4] * scale, a[5] * scale); w.w = cvt_pk_bf16(a[6] * scale, a[7] * scale);
    *(u32x4*)dst = w;
    __syncthreads();
}
__device__ __forceinline__ void p0_d1t(const Params& p, int item) {
    bf16_t* dst = (bf16_t*)(p.ws + WS_D1T);
    const int row = item * 64 + (threadIdx.x >> 3), k1 = row >> 1, ri = row & 1, c0 = (threadIdx.x & 7) * 64;
    for (int c8 = 0; c8 < 64; c8 += 8) { float v[8];
#pragma unroll
        for (int j = 0; j < 8; ++j) { const int col = c0 + c8 + j, pq = col >> 8, t1 = col & 255; float sn, cs; sincospif((float)((k1 * t1) & 255) * (1.0f / 128.0f), &sn, &cs);
            v[j] = (ri == 0) ? (pq == 0 ? cs : -sn) : (pq == 0 ? -sn : -cs); }
        u32x4 w; w.x = cvt_pk_bf16(v[0], v[1]); w.y = cvt_pk_bf16(v[2], v[3]); w.z = cvt_pk_bf16(v[4], v[5]); w.w = cvt_pk_bf16(v[6], v[7]);
        *(u32x4*)(dst + (size_t)row * 512 + c0 + c8) = w; }
}
__device__ __forceinline__ void p0_d2t(const Params& p, int item) {
    bf16_t* dst = (bf16_t*)(p.ws + WS_D2T);
#pragma unroll
    for (int ps = 0; ps < 4; ++ps) { const int pc = (item * 4 + ps) * NTHR + threadIdx.x, tp = pc >> 2, kk0 = (pc & 3) * 8; float v[8];
#pragma unroll
        for (int j = 0; j < 8; ++j) { const int kk = kk0 + j, ri = kk >> 4, t2 = kk & 15; float sn, cs; sincospif((float)((tp * t2) & 4095) * (1.0f / 2048.0f), &sn, &cs); v[j] = ri ? sn : cs; }
        u32x4 w; w.x = cvt_pk_bf16(v[0], v[1]); w.y = cvt_pk_bf16(v[2], v[3]); w.z = cvt_pk_bf16(v[4], v[5]); w.w = cvt_pk_bf16(v[6], v[7]);
        *(u32x4*)(dst + (size_t)tp * 32 + kk0) = w; }
}
__device__ __forceinline__ void p0_pos(const Params& p, int item) {
    float* tab = (float*)(p.ws + WS_POS);
    for (int i = item * 2048 + threadIdx.x; i < (item + 1) * 2048; i += NTHR) { const int ii = i >> 9, j = i & 511, jj = j & 255; const float f = expf(-9.210340371976184f * (float)jj / 256.0f); const float a = (float)ii * f;
        __hip_atomic_store(tab + i, j < 256 ? sinf(a) : cosf(a), __ATOMIC_RELAXED, __HIP_MEMORY_SCOPE_AGENT); }
    asm volatile("s_waitcnt vmcnt(0)" ::: "memory");
    __syncthreads();
    if (threadIdx.x == 0) (void)__hip_atomic_fetch_add((unsigned*)(p.ws + WS_BAR + 46 * KiB), 1u, __ATOMIC_RELAXED, __HIP_MEMORY_SCOPE_AGENT);
}
__device__ __forceinline__ void phase0(const Params& p, LAS unsigned char* lds) {
    constexpr int N_ADA = 256, N_WIN = 16 * 16, N_WFOUR = 8 * 4, N_SQ = 16 * 4, N_LRU = 16 * 2, N_WPQ = 256, N_DFT = 8 + 8, N_POS = 16;
    constexpr int O1 = N_ADA, O2 = O1 + N_WIN, O3 = O2 + N_WFOUR, O4 = O3 + N_SQ, O5 = O4 + N_SQ, O6 = O5 + N_LRU, O7 = O6 + N_LRU, O8 = O7 + N_WPQ, O9 = O8 + N_DFT, O10 = O9 + N_POS;
    for (int it0 = blockIdx.x; it0 < O10; it0 += gridDim.x) {
        if (it0 < O1) { p0_ada(p, lds, it0); continue; }
        if (it0 < O1 + N_POS) { p0_pos(p, it0 - O1); continue; }
        const int it = it0 - N_POS;
        if (it < O2) { const int j = it - O1; xpose_item<4>(p.w_in + 512, 4608, (bf16_t*)(p.ws + WS_WIN), 1024, (j >> 4) * 64, (j & 15) * 256, 0); }
        else if (it < O3) { const int j = it - O2; xpose_item<4>(p.w_four, 1024, (bf16_t*)(p.ws + WS_WFOUR), 512, (j >> 2) * 64, (j & 3) * 256, 0); }
        else if (it < O4) { const int j = it - O3; xpose_item<4>(p.w_lru, 1024, (bf16_t*)(p.ws + WS_WLRU), 1024, (j >> 2) * 64, (j & 3) * 256, 0); }
        else if (it < O5) { const int j = it - O4; xpose_item<4>(p.w_out, 1024, (bf16_t*)(p.ws + WS_WOUT), 1024, (j >> 2) * 64, (j & 3) * 256, 0); }
        else if (it < O6) { const int j = it - O5, mtx = j >> 1; xpose_item<2>(p.lru_wa + (size_t)mtx * 16384, 128, (bf16_t*)(p.ws + WS_WAT) + (size_t)mtx * 16384, 128, (j & 1) * 64, 0, 0, NLOG2E); }
        else if (it < O7) { const int j = it - O6, mtx = j >> 1; xpose_item<2>(p.lru_wi + (size_t)mtx * 16384, 128, (bf16_t*)(p.ws + WS_WIT) + (size_t)mtx * 16384, 128, (j & 1) * 64, 0, 0, NLOG2E); }
        else if (it < O8) p0_wpq(p, lds, it - O7);
        else { if (it - O8 < 8) p0_d1t(p, it - O8); else p0_d2t(p, it - O8 - 8); }
    }
}

__device__ __forceinline__ void phase1(const Params& p) {
    const int tid = tid_opaque(), lane = tid & 63, wid = tid >> 6;
    const float* ada = (const float*)(p.ws + WS_ADA); const float* tab = (const float*)(p.ws + WS_POS);
    bf16_t* h1 = (bf16_t*)(p.ws + WS_R1); bf16_t* hc = (bf16_t*)(p.ws + WS_HCTX);
    constexpr int NR = MLAT + MCTX, RW = 4;
    for (int row0 = (blockIdx.x * 8 + wid) * RW; row0 < NR; row0 += gridDim.x * 8 * RW) {
        const bool lat = row0 < MLAT; const int mrow = lat ? (row0 >> 12) : 8;
        f32x4 v[RW][4]; float ss[RW];
#pragma unroll
        for (int r = 0; r < RW; ++r) { const int row = row0 + r; const float* xr = lat ? p.x + (size_t)row * 1024 : p.ctx + (size_t)(row - MLAT) * 1024;
#pragma unroll
            for (int i = 0; i < 4; ++i) v[r][i] = __builtin_nontemporal_load((const f32x4*)(xr + 256 * i + 4 * lane)); }
#pragma unroll
        for (int r = 0; r < RW; ++r) { const int t = (row0 + r) & 4095; float a = 0.f;
#pragma unroll
            for (int i = 0; i < 4; ++i) { const int d = 256 * i + 4 * lane;
                if (lat) v[r][i] += *(const f32x4*)(tab + (i < 2 ? (t >> 6) * 512 + d : (t & 63) * 512 + d - 512));
                a += v[r][i][0] * v[r][i][0] + v[r][i][1] * v[r][i][1] + v[r][i][2] * v[r][i][2] + v[r][i][3] * v[r][i][3]; }
            ss[r] = a; }
#pragma unroll
        for (int o = 32; o >= 1; o >>= 1) {
#pragma unroll
            for (int r = 0; r < RW; ++r) ss[r] += __shfl_xor(ss[r], o); }
#pragma unroll
        for (int i = 0; i < 4; ++i) { const int d = 256 * i + 4 * lane;
            const f32x4 g = *(const f32x4*)(p.norm1_g + d), sh = *(const f32x4*)(ada + mrow * 6144 + d), sc = *(const f32x4*)(ada + mrow * 6144 + 1024 + d);
#pragma unroll
            for (int r = 0; r < RW; ++r) { const int row = row0 + r; const float rs = rsqrtf(ss[r] * (1.0f / 1024.0f) + 1e-6f);
                bf16_t* dst = lat ? h1 + (size_t)row * 1024 : hc + (size_t)(row - MLAT) * 1024;
                const f32x4 h = v[r][i] * rs * g * (sc + 1.0f) + sh;
                u32x2 w; w.x = cvt_pk_bf16(h[0], h[1]); w.y = cvt_pk_bf16(h[2], h[3]); *(u32x2*)(dst + d) = w; } }
    }
}

#define LRU_CST(mb, r) (32 * (mb) + 8 * ((r) >> 2) + ((r) & 3))
template <bool FINAL, int DIR>
__device__ __forceinline__ void lru_wave(const Params& p, LAS unsigned char* ul, int b, int sc, int head, int cb, int lane, f32x16 (&accI)[4]) {
    constexpr int SG = DIR ? -1 : 1;
    const int lr = lane & 31, lh = lane >> 5;
    const int chl = cb * 32 + lr, ch = head * 128 + chl;
    const int tbase = DIR ? 127 - 4 * lh : 4 * lh;
    f32x16 accA[4];
#pragma unroll
    for (int mb = 0; mb < 4; ++mb)
#pragma unroll
        for (int r = 0; r < 16; ++r) { accA[mb][r] = 0.f; accI[mb][r] = 0.f; }
    {
        const bf16_t* wa = (const bf16_t*)(p.ws + WS_WAT) + ((size_t)(DIR * 8 + head) * 128 + chl) * 128 + 8 * lh;
        const bf16_t* wi = (const bf16_t*)(p.ws + WS_WIT) + ((size_t)(DIR * 8 + head) * 128 + chl) * 128 + 8 * lh;
        LAS unsigned char* arow0 = ul + (DIR ? 127 - lr : lr) * 272 + lh * 16;
#pragma unroll
        for (int kc = 0; kc < 2; ++kc) { bf16x8 bA[4], bI[4];
#pragma unroll
            for (int k4 = 0; k4 < 4; ++k4) { bA[k4] = *(const bf16x8*)(wa + 16 * (kc * 4 + k4)); bI[k4] = *(const bf16x8*)(wi + 16 * (kc * 4 + k4)); }
#pragma unroll
            for (int mb = 0; mb < 4; ++mb)
#pragma unroll
                for (int k4 = 0; k4 < 4; ++k4) { const bf16x8 af = *(const LAS bf16x8*)(arow0 + SG * 32 * mb * 272 + 32 * (kc * 4 + k4));
                    accA[mb] = __builtin_amdgcn_mfma_f32_32x32x16_bf16(af, bA[k4], accA[mb], 0, 0, 0);
                    accI[mb] = __builtin_amdgcn_mfma_f32_32x32x16_bf16(af, bI[k4], accI[mb], 0, 0, 0); }
            __builtin_amdgcn_sched_barrier(0); }
    }
    {
        const float lam = p.lru_lambda[DIR * 1024 + ch]; const float sp8 = 8.0f * log1pf(expf(-lam));
        const float ba = p.lru_ba[DIR * 1024 + ch], bi = p.lru_bi[DIR * 1024 + ch];
        LAS unsigned char* up = ul + tbase * 272 + chl * 2;
#pragma unroll
        for (int mb = 0; mb < 4; ++mb) {
#pragma unroll
            for (int r = 0; r < 16; ++r) {
                const float uv = bf2f(*(const LAS bf16_t*)(up + SG * LRU_CST(mb, r) * 272));
                const float rg = __builtin_amdgcn_rcpf(1.0f + __builtin_amdgcn_exp2f(accA[mb][r] + NLOG2E * ba)), ig = __builtin_amdgcn_rcpf(1.0f + __builtin_amdgcn_exp2f(accI[mb][r] + NLOG2E * bi));
                const float a = __expf(-sp8 * rg); accA[mb][r] = a; accI[mb][r] = __builtin_amdgcn_sqrtf(fmaxf(1.0f - a * a, 0.f)) * ig * uv; }
            __builtin_amdgcn_sched_barrier(0); }
    }
    float rA[16], rH[16];
#pragma unroll
    for (int mb = 0; mb < 4; ++mb)
#pragma unroll
        for (int q = 0; q < 4; ++q) { float pa = 1.f, hh = 0.f;
#pragma unroll
            for (int j = 0; j < 4; ++j) { const int r = 4 * q + j; const float a = accA[mb][r], bb = accI[mb][r]; hh = a * hh + bb; pa *= a; accA[mb][r] = pa; accI[mb][r] = hh; }
            rA[mb * 4 + q] = pa; rH[mb * 4 + q] = hh; }
    const int agg_dir_off = ((b * NSEQ) * 2 + DIR) * 1024 + ch;
    const float* agg = (const float*)(p.ws + WS_AGG);
    float carry = 0.f;
    if (FINAL) {
        if (DIR == 0) { for (int q = 0; q < sc; ++q) { const float* a2 = agg + (size_t)(agg_dir_off + q * 2048) * 2; carry = a2[0] * carry + a2[1]; } }
        else { { const float* a2 = agg + (size_t)(agg_dir_off + 1 * 2048) * 2; carry = a2[0] * carry + a2[1]; } { const float* a2 = agg + (size_t)(agg_dir_off + 0 * 2048) * 2; carry = a2[0] * carry + a2[1]; }
            for (int q = NSEQ - 1; q > sc; --q) { const float* a2 = agg + (size_t)(agg_dir_off + q * 2048) * 2; carry = a2[0] * carry + a2[1]; } }
    }
    float cin[16];
#pragma unroll
    for (int i = 0; i < 16; ++i) cin[i] = 0.f;
    float s = carry, At = 1.f;
#pragma unroll
    for (int i = 0; i < 16; ++i) { const float oA = __shfl_xor(rA[i], 32), oH = __shfl_xor(rH[i], 32);
        { const bool mine = (lh == 0); const float a = mine ? rA[i] : oA, hh = mine ? rH[i] : oH; cin[i] = mine ? s : cin[i]; s = a * s + hh; At *= a; }
        { const bool mine = (lh == 1); const float a = mine ? rA[i] : oA, hh = mine ? rH[i] : oH; cin[i] = mine ? s : cin[i]; s = a * s + hh; At *= a; } }
    if (!FINAL) {
        if (lh == 0) { float* o = (float*)(p.ws + WS_AGG) + (size_t)(agg_dir_off + sc * 2048) * 2; o[0] = At; o[1] = s; }
        return;
    }
#pragma unroll
    for (int mb = 0; mb < 4; ++mb)
#pragma unroll
        for (int r = 0; r < 16; ++r) accI[mb][r] += accA[mb][r] * cin[mb * 4 + (r >> 2)];
}
template <bool FINAL>
__device__ __forceinline__ void lru_tile(const Params& p, LAS unsigned char* lds, int item) {
    const int tid = threadIdx.x, lane = tid & 63, wid = __builtin_amdgcn_readfirstlane(tid >> 6);
    int b, sc, head;
    if (FINAL) { head = item & 7; sc = 2 + ((item >> 3) & 31); b = item >> 8; }
    else { head = item & 7; const int r = item >> 3; sc = r & 1; b = r >> 1; }
    const bf16_t* src; int Tseq, t0, ld;
    if (sc < 2) { src = (const bf16_t*)(p.ws + WS_ZXC) + (size_t)b * 256 * 1024; Tseq = 256; t0 = sc * 128; ld = 1024; }
    else { src = (const bf16_t*)(p.ws + WS_RZ) + (size_t)b * 4096 * 4096; Tseq = 4096; t0 = (sc - 2) * 128; ld = 4096; }
    LAS unsigned char* ul = lds;
    LAS float* ybuf = (LAS float*)(lds + 36 * 1024);
    {
        const int c8 = tid & 15, tb = tid >> 4; const int ch0 = head * 128 + 8 * c8;
        float w[4][8], bias[8];
#pragma unroll
        for (int k = 0; k < 4; ++k) { const f32x4 a = *(const f32x4*)(p.conv_w + k * 1024 + ch0), c2 = *(const f32x4*)(p.conv_w + k * 1024 + ch0 + 4);
#pragma unroll
            for (int j = 0; j < 4; ++j) { w[k][j] = a[j]; w[k][4 + j] = c2[j]; } }
        { const f32x4 a = *(const f32x4*)(p.conv_b + ch0), c2 = *(const f32x4*)(p.conv_b + ch0 + 4);
#pragma unroll
            for (int j = 0; j < 4; ++j) { bias[j] = a[j]; bias[4 + j] = c2[j]; } }
#pragma unroll
        for (int i = 0; i < 4; ++i) { const int t = tb + 32 * i; float a[8];
#pragma unroll
            for (int j = 0; j < 8; ++j) a[j] = bias[j];
#pragma unroll
            for (int k = 0; k < 4; ++k) { const int tt = t0 + t + k - 2;
                if (tt >= 0 && tt < Tseq) { float f[8]; unpack8(*(const u32x4*)(src + (size_t)tt * ld + ch0), f);
#pragma unroll
                    for (int j = 0; j < 8; ++j) a[j] += w[k][j] * f[j]; } }
            u32x4 wv; wv.x = cvt_pk_bf16(a[0], a[1]); wv.y = cvt_pk_bf16(a[2], a[3]); wv.z = cvt_pk_bf16(a[4], a[5]); wv.w = cvt_pk_bf16(a[6], a[7]);
            *(LAS u32x4*)(ul + t * 272 + c8 * 16) = wv; }
    }
    __syncthreads();
    f32x16 hacc[4];
    if (wid < 4) lru_wave<FINAL, 0>(p, ul, b, sc, head, wid & 3, lane, hacc);
    else lru_wave<FINAL, 1>(p, ul, b, sc, head, wid & 3, lane, hacc);
    if (FINAL) {
        const int lr = lane & 31, lh = lane >> 5, chl = (wid & 3) * 32 + lr;
        if (wid >= 4) { LAS float* yp = ybuf + (127 - 4 * lh) * 129 + chl;
#pragma unroll
            for (int mb = 0; mb < 4; ++mb)
#pragma unroll
                for (int r = 0; r < 16; ++r) yp[-LRU_CST(mb, r) * 129] = hacc[mb][r]; }
        __syncthreads();
        if (wid < 4) {
            const LAS float* yp = ybuf + (4 * lh) * 129 + chl;
            const bf16_t* Zu = (const bf16_t*)(p.ws + WS_RZ) + ((size_t)(b * 4096 + t0) * 4096 + 1024 + head * 128);
            bf16_t* Ou = (bf16_t*)(p.ws + WS_R1) + ((size_t)(b * 4096 + t0) * 1024 + head * 128);
            const unsigned zo = (unsigned)(4 * lh * 4096 + chl), oo = (unsigned)(4 * lh * 1024 + chl);
#pragma unroll
            for (int mb = 0; mb < 4; ++mb) {
#pragma unroll
                for (int r = 0; r < 16; ++r) {
                    const float y = hacc[mb][r] + yp[LRU_CST(mb, r) * 129];
                    const float gz = bf2f(Zu[zo + LRU_CST(mb, r) * 4096]);
                    Ou[oo + LRU_CST(mb, r) * 1024] = (bf16_t)(cvt_pk_bf16(gz * y, 0.f) & 0xffffu);
                    if ((r & 7) == 7) __builtin_amdgcn_sched_barrier(0); } }
        }
    }
    __syncthreads();
}

#ifndef LRU_PF_FRAG
#define LRU_PF_FRAG true
#endif
#ifndef LRU_PF_TILE
#define LRU_PF_TILE true
#endif
template <int DIR, bool PREF>
__device__ __forceinline__ void lru2_dir(const Params& p, LAS unsigned char* ul, int head, int w, int lane, const bf16x8 (&bA)[4], const bf16x8 (&bI)[4], bf16x8 (&nA)[4], bf16x8 (&nI)[4],
                                         f32x4 (&hl)[8], f32x4 (&pp)[8], float& Atot, float& Htot) {
    constexpr int SG = DIR ? -1 : 1;
    const int fr = lane & 15, fq = lane >> 4, chl = 16 * w + fr, ch = head * 128 + chl;
    f32x4 accA[8], accI[8];
    { const float ba2 = NLOG2E * p.lru_ba[DIR * 1024 + ch], bi2 = NLOG2E * p.lru_bi[DIR * 1024 + ch];
#pragma unroll
      for (int rb = 0; rb < 8; ++rb) { accA[rb] = (f32x4){ba2, ba2, ba2, ba2}; accI[rb] = (f32x4){bi2, bi2, bi2, bi2}; } }
    {
        LAS unsigned char* arow0 = ul + (DIR ? 127 - fr : fr) * 272 + fq * 16;
#pragma unroll
        for (int rb = 0; rb < 8; ++rb)
#pragma unroll
            for (int ks = 0; ks < 4; ++ks) { const bf16x8 af = *(const LAS bf16x8*)(arow0 + SG * 16 * rb * 272 + 64 * ks);
                accA[rb] = __builtin_amdgcn_mfma_f32_16x16x32_bf16(af, bA[ks], accA[rb], 0, 0, 0);
                accI[rb] = __builtin_amdgcn_mfma_f32_16x16x32_bf16(af, bI[ks], accI[rb], 0, 0, 0); }
    }
    if (PREF) {
        const bf16_t* wa = (const bf16_t*)(p.ws + WS_WAT) + ((size_t)((1 - DIR) * 8 + head) * 128 + chl) * 128 + 8 * fq;
        const bf16_t* wi = (const bf16_t*)(p.ws + WS_WIT) + ((size_t)((1 - DIR) * 8 + head) * 128 + chl) * 128 + 8 * fq;
#pragma unroll
        for (int ks = 0; ks < 4; ++ks) { nA[ks] = *(const bf16x8*)(wa + 32 * ks); nI[ks] = *(const bf16x8*)(wi + 32 * ks); }
    }
    {
        typedef float f32x2 __attribute__((ext_vector_type(2)));
        const float lam = p.lru_lambda[DIR * 1024 + ch]; const float k2 = NLOG2E * 8.0f * log1pf(expf(-lam));
        LAS unsigned char* up = ul + (DIR ? 127 - 4 * fq : 4 * fq) * 272 + chl * 2;
#pragma unroll
        for (int rb = 0; rb < 8; ++rb)
#pragma unroll
            for (int r = 0; r < 4; r += 2) {
                f32x2 uv; uv.x = bf2f(*(const LAS bf16_t*)(up + SG * (16 * rb + r) * 272)); uv.y = bf2f(*(const LAS bf16_t*)(up + SG * (16 * rb + r + 1) * 272));
                f32x2 ea, ei; ea.x = __builtin_amdgcn_exp2f(accA[rb][r]); ea.y = __builtin_amdgcn_exp2f(accA[rb][r + 1]); ei.x = __builtin_amdgcn_exp2f(accI[rb][r]); ei.y = __builtin_amdgcn_exp2f(accI[rb][r + 1]);
                const f32x2 da = ea + 1.0f, di = ei + 1.0f;
                f32x2 rg, ig; rg.x = __builtin_amdgcn_rcpf(da.x); rg.y = __builtin_amdgcn_rcpf(da.y); ig.x = __builtin_amdgcn_rcpf(di.x); ig.y = __builtin_amdgcn_rcpf(di.y);
                const f32x2 ka = rg * k2;
                f32x2 a; a.x = __builtin_amdgcn_exp2f(ka.x); a.y = __builtin_amdgcn_exp2f(ka.y);
                const f32x2 om = 1.0f - a * a;
                f32x2 sq; sq.x = __builtin_amdgcn_sqrtf(om.x); sq.y = __builtin_amdgcn_sqrtf(om.y);
                const f32x2 bb = sq * ig * uv;
                accA[rb][r] = a.x; accA[rb][r + 1] = a.y; accI[rb][r] = bb.x; accI[rb][r + 1] = bb.y; }
    }
    float rA[8], rH[8];
#pragma unroll
    for (int rb = 0; rb < 8; ++rb) { float pa = 1.f, hh = 0.f;
#pragma unroll
        for (int r = 0; r < 4; ++r) { const float a = accA[rb][r], bb = accI[rb][r]; hh = a * hh + bb; pa *= a; accA[rb][r] = pa; accI[rb][r] = hh; }
        rA[rb] = pa; rH[rb] = hh; }
    float Pc = 1.f, s = 0.f;
#pragma unroll
    for (int rb = 0; rb < 8; ++rb) { float Pin = 1.f, Hin = 0.f;
#pragma unroll
        for (int q = 0; q < 4; ++q) { const float a = __shfl(rA[rb], fr + 16 * q), hh = __shfl(rH[rb], fr + 16 * q);
            if (q == fq) { Pin = Pc; Hin = s; }
            s = a * s + hh; Pc *= a; }
#pragma unroll
        for (int r = 0; r < 4; ++r) { hl[rb][r] = accI[rb][r] + accA[rb][r] * Hin; pp[rb][r] = accA[rb][r] * Pin; }
        __builtin_amdgcn_sched_barrier(0); }
    Atot = Pc; Htot = s;
}
__device__ __forceinline__ u64_t agg_ld(const u64_t* a) { return __hip_atomic_load(a, __ATOMIC_RELAXED, __HIP_MEMORY_SCOPE_AGENT); }
template <int DIR>
__device__ __forceinline__ float lru2_carry(const u64_t* aggc, int n, int fr, int fq) {
    float Ap = 1.f, Hp = 0.f; u64_t v[9];
#pragma unroll
    for (int k = 0; k < 9; ++k) { const int j = fq * 9 + k; const int seq = DIR ? (j == 0 ? 1 : (j == 1 ? 0 : 35 - j)) : j;
        v[k] = (j < n) ? agg_ld(aggc + (size_t)seq * 2048) : 0x000000003f800000ull; }
#pragma unroll
    for (int k = 0; k < 9; ++k) { const float a = __uint_as_float((unsigned)v[k]), hh = __uint_as_float((unsigned)(v[k] >> 32)); Hp = a * Hp + hh; Ap *= a; }
    float s = 0.f;
#pragma unroll
    for (int q = 0; q < 4; ++q) { const float a = __shfl(Ap, fr + 16 * q), hh = __shfl(Hp, fr + 16 * q); s = a * s + hh; }
    return s;
}
__device__ __forceinline__ void lru2_block(const Params& p, LAS unsigned char* lds, int slot, int c, int ngr) {
    const int tid = threadIdx.x, lane = tid & 63, wid = __builtin_amdgcn_readfirstlane(tid >> 6);
    const int sc = c + 2, t0 = c * 128;
    LAS unsigned char* raw = lds;
    LAS unsigned char* ul = lds + 33792;
    LAS unsigned char* gzl = lds + 68608;
    LAS unsigned char* outl = lds + 103424;
    const int fr = lane & 15, fq = lane >> 4, chl = 16 * wid + fr;
    u32x4 nr[5], ng[4];
#define LRU2_LOAD_R(gg) do { const bf16_t* Zb_ = (const bf16_t*)(p.ws + WS_RZ) + (size_t)((gg) >> 3) * 4096 * 4096 + ((gg) & 7) * 128; \
        _Pragma("unroll") for (int k = 0; k < 5; ++k) { const int pc = tid + NTHR * k; nr[k] = (u32x4){0u, 0u, 0u, 0u}; \
            if (pc < 131 * 16) { const int row = pc >> 4, c8 = pc & 15, tt = t0 - 2 + row; if (tt >= 0 && tt < TT) nr[k] = __builtin_nontemporal_load((const u32x4*)(Zb_ + (size_t)tt * 4096 + c8 * 8)); } } } while (0)
#define LRU2_LOAD_G(gg) do { const bf16_t* Zb_ = (const bf16_t*)(p.ws + WS_RZ) + (size_t)((gg) >> 3) * 4096 * 4096 + ((gg) & 7) * 128; \
        _Pragma("unroll") for (int k = 0; k < 4; ++k) { const int pc = tid + NTHR * k, row = pc >> 4, c8 = pc & 15; ng[k] = __builtin_nontemporal_load((const u32x4*)(Zb_ + (size_t)(t0 + row) * 4096 + 1024 + c8 * 8)); } } while (0)
    LRU2_LOAD_R(slot); LRU2_LOAD_G(slot);
    for (int g = slot; g < NB * 8; g += ngr) {
        const int b = g >> 3, head = g & 7, ch = head * 128 + chl;
        unsigned* gcnt = (unsigned*)(p.ws + WS_BAR + 16 * KiB) + g * 64;
        bf16x8 bA1[4], bI1[4], bA0[4], bI0[4];
        { const bf16_t* wa = (const bf16_t*)(p.ws + WS_WAT) + ((size_t)(8 + head) * 128 + chl) * 128 + 8 * fq; const bf16_t* wi = (const bf16_t*)(p.ws + WS_WIT) + ((size_t)(8 + head) * 128 + chl) * 128 + 8 * fq;
#pragma unroll
          for (int ks = 0; ks < 4; ++ks) { bA1[ks] = *(const bf16x8*)(wa + 32 * ks); bI1[ks] = *(const bf16x8*)(wi + 32 * ks); } }
#pragma unroll
        for (int k = 0; k < 5; ++k) { const int pc = tid + NTHR * k; if (pc < 131 * 16) *(LAS u32x4*)(raw + (pc >> 4) * 256 + (pc & 15) * 16) = nr[k]; }
#pragma unroll
        for (int k = 0; k < 4; ++k) { const int pc = tid + NTHR * k; *(LAS u32x4*)(gzl + (pc >> 4) * 272 + (pc & 15) * 16) = ng[k]; }
        __syncthreads();
        {
            const int c8 = tid & 15, tb = tid >> 4; const int ch0 = head * 128 + 8 * c8;
            float w[4][8], bias[8];
#pragma unroll
            for (int k = 0; k < 4; ++k) { const f32x4 a = *(const f32x4*)(p.conv_w + k * 1024 + ch0), c2 = *(const f32x4*)(p.conv_w + k * 1024 + ch0 + 4);
#pragma unroll
                for (int j = 0; j < 4; ++j) { w[k][j] = a[j]; w[k][4 + j] = c2[j]; } }
            { const f32x4 a = *(const f32x4*)(p.conv_b + ch0), c2 = *(const f32x4*)(p.conv_b + ch0 + 4);
#pragma unroll
                for (int j = 0; j < 4; ++j) { bias[j] = a[j]; bias[4 + j] = c2[j]; } }
#pragma unroll
            for (int i = 0; i < 4; ++i) { const int t = tb + 32 * i; float a[8];
#pragma unroll
                for (int j = 0; j < 8; ++j) a[j] = bias[j];
#pragma unroll
                for (int k = 0; k < 4; ++k) { float f[8]; unpack8(*(const LAS u32x4*)(raw + (t + k) * 256 + c8 * 16), f);
#pragma unroll
                    for (int j = 0; j < 8; ++j) a[j] += w[k][j] * f[j]; }
                u32x4 wv; wv.x = cvt_pk_bf16(a[0], a[1]); wv.y = cvt_pk_bf16(a[2], a[3]); wv.z = cvt_pk_bf16(a[4], a[5]); wv.w = cvt_pk_bf16(a[6], a[7]);
                *(LAS u32x4*)(ul + t * 272 + c8 * 16) = wv; }
        }
        __syncthreads();
        float A0, H0, A1, H1;
        {
            f32x4 hl1[8], pp1[8];
            lru2_dir<1, LRU_PF_FRAG>(p, ul, head, wid, lane, bA1, bI1, bA0, bI0, hl1, pp1, A1, H1);
            LAS unsigned char* hp = outl + chl * 264 + (124 - 4 * fq) * 2; LAS unsigned char* qp = raw + chl * 264 + (124 - 4 * fq) * 2;
#pragma unroll
            for (int rb = 0; rb < 8; ++rb) { u32x2 wh, wq; wh.x = cvt_pk_bf16(hl1[rb][3], hl1[rb][2]); wh.y = cvt_pk_bf16(hl1[rb][1], hl1[rb][0]); wq.x = cvt_pk_bf16(pp1[rb][3], pp1[rb][2]); wq.y = cvt_pk_bf16(pp1[rb][1], pp1[rb][0]);
                *(LAS u32x2*)(hp - 32 * rb) = wh; *(LAS u32x2*)(qp - 32 * rb) = wq; }
        }
        __builtin_amdgcn_sched_barrier(0);
        if (!LRU_PF_FRAG) { const bf16_t* wa = (const bf16_t*)(p.ws + WS_WAT) + ((size_t)(head) * 128 + chl) * 128 + 8 * fq; const bf16_t* wi = (const bf16_t*)(p.ws + WS_WIT) + ((size_t)(head) * 128 + chl) * 128 + 8 * fq;
#pragma unroll
          for (int ks = 0; ks < 4; ++ks) { bA0[ks] = *(const bf16x8*)(wa + 32 * ks); bI0[ks] = *(const bf16x8*)(wi + 32 * ks); } }
        f32x4 hl0[8], pp0[8];
        lru2_dir<0, false>(p, ul, head, wid, lane, bA0, bI0, bA1, bI1, hl0, pp0, A0, H0);
        u64_t* agg = (u64_t*)(p.ws + WS_AGG);
        const size_t ai0 = ((size_t)(b * NSEQ) * 2 + 0) * 1024 + ch, ai1 = ((size_t)(b * NSEQ) * 2 + 1) * 1024 + ch;
        if (fq == 0) {
            __hip_atomic_store(agg + ai0 + (size_t)sc * 2048, ((u64_t)__float_as_uint(H0) << 32) | __float_as_uint(A0), __ATOMIC_RELAXED, __HIP_MEMORY_SCOPE_AGENT);
            __hip_atomic_store(agg + ai1 + (size_t)sc * 2048, ((u64_t)__float_as_uint(H1) << 32) | __float_as_uint(A1), __ATOMIC_RELAXED, __HIP_MEMORY_SCOPE_AGENT); }
        asm volatile("s_waitcnt vmcnt(0)" ::: "memory");
        __syncthreads();
        if (tid == 0) (void)__hip_atomic_fetch_add(gcnt, 1u, __ATOMIC_RELAXED, __HIP_MEMORY_SCOPE_AGENT);
        if (wid == 0) { unsigned sp = 0;
            while ((unsigned)__builtin_amdgcn_readfirstlane(__hip_atomic_load(gcnt, __ATOMIC_RELAXED, __HIP_MEMORY_SCOPE_AGENT)) < 32u) { __builtin_amdgcn_s_sleep(1); if (++sp > (1u << 22)) break; }
            __builtin_amdgcn_fence(__ATOMIC_ACQUIRE, "agent");
            asm volatile("s_waitcnt vmcnt(0)" ::: "memory"); }
        __syncthreads();
        const float C0 = lru2_carry<0>(agg + ai0, sc, fr, fq);
        const float C1 = lru2_carry<1>(agg + ai1, 2 + (NSEQ - 1 - sc), fr, fq);
        __builtin_amdgcn_sched_barrier(0);
        if (LRU_PF_TILE) { const int gn = (g + ngr < NB * 8) ? g + ngr : g; LRU2_LOAD_R(gn); LRU2_LOAD_G(gn); }
        __builtin_amdgcn_sched_barrier(0);
        LAS unsigned char* gp = gzl + (4 * fq) * 272 + chl * 2; LAS unsigned char* op = outl + (4 * fq) * 272 + chl * 2;
        const LAS unsigned char* hp1 = outl + chl * 264 + (4 * fq) * 2; const LAS unsigned char* qp1 = raw + chl * 264 + (4 * fq) * 2;
        unsigned ov[16];
#pragma unroll
        for (int rb = 0; rb < 8; ++rb) { const u32x2 wh = *(const LAS u32x2*)(hp1 + 32 * rb), wq = *(const LAS u32x2*)(qp1 + 32 * rb);
            const float h1v[4] = {bf_lo(wh.x), bf_hi(wh.x), bf_lo(wh.y), bf_hi(wh.y)}, q1v[4] = {bf_lo(wq.x), bf_hi(wq.x), bf_lo(wq.y), bf_hi(wq.y)};
            float o[4];
#pragma unroll
            for (int r = 0; r < 4; ++r) { const float y = hl0[rb][r] + pp0[rb][r] * C0 + h1v[r] + q1v[r] * C1;
                o[r] = bf2f(*(const LAS bf16_t*)(gp + (16 * rb + r) * 272)) * y; }
            ov[2 * rb] = cvt_pk_bf16(o[0], o[1]); ov[2 * rb + 1] = cvt_pk_bf16(o[2], o[3]); }
        __syncthreads();
#pragma unroll
        for (int rb = 0; rb < 8; ++rb) { *(LAS bf16_t*)(op + (16 * rb + 0) * 272) = (bf16_t)(ov[2 * rb] & 0xffffu); *(LAS bf16_t*)(op + (16 * rb + 1) * 272) = (bf16_t)(ov[2 * rb] >> 16);
            *(LAS bf16_t*)(op + (16 * rb + 2) * 272) = (bf16_t)(ov[2 * rb + 1] & 0xffffu); *(LAS bf16_t*)(op + (16 * rb + 3) * 272) = (bf16_t)(ov[2 * rb + 1] >> 16); }
        __syncthreads();
        bf16_t* Ob = (bf16_t*)(p.ws + WS_R1) + ((size_t)(b * 4096 + t0)) * 1024 + head * 128;
#pragma unroll
        for (int k = 0; k < 4; ++k) { const int pc = tid + NTHR * k, row = pc >> 4, c8 = pc & 15;
            *(u32x4*)(Ob + (size_t)row * 1024 + c8 * 8) = *(const LAS u32x4*)(outl + row * 272 + c8 * 16); }
        if (!LRU_PF_TILE && g + ngr < NB * 8) LRU2_LOAD_R(g + ngr);
    }
#undef LRU2_LOAD_R
#undef LRU2_LOAD_G
}

__device__ __forceinline__ void fft_stage2_all(const Params& p, LAS unsigned char* lds) {
    const int tid = tid_opaque(), lane = tid & 63, wid = tid >> 6, fr = lane & 15, fq = lane >> 4;
    const bf16_t* Yt = (const bf16_t*)((const unsigned char*)p.out + OUT_YT); const bf16_t* D2 = (const bf16_t*)(p.ws + WS_D2T);
    bf16_t* Fo = (bf16_t*)((unsigned char*)p.out + OUT_F);
    const int G = gridDim.x;
    int it = blockIdx.x; bf16x8 dfr, yfr[4];
#define S2_LOAD(item) do { const int b_ = (item) & 7, k1_ = (item) >> 3; dfr = *(const bf16x8*)(D2 + (size_t)(k1_ + 256 * fr) * 32 + 8 * fq); \
        _Pragma("unroll") for (int n = 0; n < 4; ++n) yfr[n] = __builtin_nontemporal_load((const bf16x8*)(Yt + (size_t)(k1_ * 2 + (fq >> 1)) * 65536 + (size_t)b_ * 8192 + (size_t)(16 * (4 * wid + n) + fr) * 16 + 8 * (fq & 1))); } while (0)
    if (it < NB * 256) S2_LOAD(it);
    for (; it < NB * 256; it += G) {
        const int b = it & 7, k1 = it >> 3;
        f32x4 acc[4];
#pragma unroll
        for (int n = 0; n < 4; ++n) acc[n] = __builtin_amdgcn_mfma_f32_16x16x32_bf16(yfr[n], dfr, (f32x4){0.f, 0.f, 0.f, 0.f}, 0, 0, 0);
        const int nx = it + G; if (nx < NB * 256) S2_LOAD(nx);
#pragma unroll
        for (int n = 0; n < 4; ++n) mfma_settle(acc[n]);
#pragma unroll
        for (int n = 0; n < 4; ++n) { u32x2 w; w.x = cvt_pk_bf16(acc[n][0], acc[n][1]); w.y = cvt_pk_bf16(acc[n][2], acc[n][3]);
            *(LAS u32x2*)(lds + fr * 1040 + (16 * (4 * wid + n) + 4 * fq) * 2) = w; }
        __syncthreads();
#pragma unroll
        for (int k = 0; k < 2; ++k) { const int pc = tid + NTHR * k, k2 = pc >> 6, c8 = pc & 63;
            *(u32x4*)(Fo + ((size_t)b * 4096 + k1 + 256 * k2) * 512 + c8 * 8) = *(const LAS u32x4*)(lds + k2 * 1040 + c8 * 16); }
        __syncthreads();
    }
#undef S2_LOAD
}

__device__ __forceinline__ void topk_task(const Params& p, LAS unsigned char* lds, int it) {
    const int tid = tid_opaque(), lane = tid & 63, wid = tid >> 6;
    LAS unsigned* cnt = (LAS unsigned*)lds;
    LAS unsigned* wsum = cnt + 64;
    const float* scores = (const float*)(p.ws + WS_SCORES);
    int* idx = (int*)(p.ws + WS_IDX); float* gate = (float*)(p.ws + WS_GATE); int* slot_of = (int*)(p.ws + WS_SLOT);
    const int b = it >> 4, e = it & 15;
    unsigned key[8];
    { const u64_t* sp = (const u64_t*)(scores + (size_t)it * 4096 + tid * 8);
#pragma unroll
      for (int j = 0; j < 4; ++j) { const u64_t v = __hip_atomic_load(sp + j, __ATOMIC_RELAXED, __HIP_MEMORY_SCOPE_AGENT); key[2 * j] = (unsigned)v; key[2 * j + 1] = (unsigned)(v >> 32); } }
    unsigned thr = 0;
    for (int step = 0; step < 16; ++step) {
        const int sh = 29 - 2 * step;
        const unsigned c1 = sh >= 0 ? (thr | (1u << sh)) : (thr | 1u), c2 = sh >= 0 ? (thr | (2u << sh)) : 0xffffffffu, c3 = sh >= 0 ? (thr | (3u << sh)) : 0xffffffffu;
        unsigned n1 = 0, n2 = 0, n3 = 0;
#pragma unroll
        for (int j = 0; j < 8; ++j) { n1 += (unsigned)__popcll(__ballot(key[j] >= c1)); n2 += (unsigned)__popcll(__ballot(key[j] >= c2)); n3 += (unsigned)__popcll(__ballot(key[j] >= c3)); }
        LAS unsigned* cb = cnt + (step & 1) * 32;
        if (lane == 0) { cb[wid] = n1; cb[8 + wid] = n2; cb[16 + wid] = n3; }
        __syncthreads();
        unsigned t1 = 0, t2 = 0, t3 = 0;
#pragma unroll
        for (int w = 0; w < 8; ++w) { t1 += cb[w]; t2 += cb[8 + w]; t3 += cb[16 + w]; }
        if (sh >= 0) thr = t3 >= (unsigned)CAP ? c3 : (t2 >= (unsigned)CAP ? c2 : (t1 >= (unsigned)CAP ? c1 : thr));
        else thr = t1 >= (unsigned)CAP ? c1 : thr;
    }
    unsigned cg_ = 0, ce = 0;
#pragma unroll
    for (int j = 0; j < 8; ++j) { cg_ += key[j] > thr; ce += key[j] == thr; }
    unsigned pk = cg_ | (ce << 16), incl = pk;
#pragma unroll
    for (int o = 1; o < 64; o <<= 1) { const unsigned n = __shfl_up(incl, o); if (lane >= o) incl += n; }
    if (lane == 63) wsum[wid] = incl;
    __syncthreads();
    unsigned base = 0, total = 0;
#pragma unroll
    for (int w = 0; w < 8; ++w) { const unsigned s2 = wsum[w]; if (w < wid) base += s2; total += s2; }
    const unsigned excl = base + incl - pk; unsigned og = excl & 0xffffu, oe = excl >> 16; const unsigned ngt = total & 0xffffu, krem = (unsigned)CAP - ngt;
    int mm[8];
#pragma unroll
    for (int j = 0; j < 8; ++j) { const int t = tid * 8 + j; int m = -1;
        if (key[j] > thr) { m = (e * 8 + b) * 512 + (int)og; ++og; }
        else if (key[j] == thr) { if (oe < krem) m = (e * 8 + b) * 512 + (int)(ngt + oe); ++oe; }
        mm[j] = m;
        if (m >= 0) { idx[m] = b * 4096 + t; gate[m] = __uint_as_float(key[j]); } }
    { u32x4* so = (u32x4*)(slot_of + (size_t)it * 4096 + tid * 8);
      so[0] = (u32x4){(unsigned)mm[0], (unsigned)mm[1], (unsigned)mm[2], (unsigned)mm[3]}; so[1] = (u32x4){(unsigned)mm[4], (unsigned)mm[5], (unsigned)mm[6], (unsigned)mm[7]}; }
    __syncthreads();
}

__device__ __forceinline__ void phase7_rows(const Params& p, LAS unsigned char* lds) {
    const int tid = threadIdx.x, lane = tid & 63, wid = tid >> 6;
    LAS float* wrt = (LAS float*)lds;
    for (int i = tid; i < 16 * 1024; i += NTHR) { const int d = i >> 4, e = i & 15; wrt[e * 1024 + d] = p.w_router[i]; }
    __syncthreads();
    const float* ada = (const float*)(p.ws + WS_ADA); bf16_t* h2 = (bf16_t*)(p.ws + WS_H2); const bf16_t* x2b = (const bf16_t*)(p.ws + WS_X2B); float* scores = (float*)(p.ws + WS_SCORES);
    for (int row0 = (blockIdx.x * 8 + wid) * 2; row0 < MLAT; row0 += gridDim.x * 16) {
        const int b = row0 >> 12;
        f32x4 v[2][4]; float ss[2];
#pragma unroll
        for (int r = 0; r < 2; ++r)
#pragma unroll
            for (int i = 0; i < 4; ++i) { const u32x2 w = *(const u32x2*)(x2b + (size_t)(row0 + r) * 1024 + 256 * i + 4 * lane); v[r][i] = (f32x4){bf_lo(w.x), bf_hi(w.x), bf_lo(w.y), bf_hi(w.y)}; }
#pragma unroll
        for (int r = 0; r < 2; ++r) { float a = 0.f;
#pragma unroll
            for (int i = 0; i < 4; ++i) a += v[r][i][0] * v[r][i][0] + v[r][i][1] * v[r][i][1] + v[r][i][2] * v[r][i][2] + v[r][i][3] * v[r][i][3];
            ss[r] = a; }
#pragma unroll
        for (int o = 32; o >= 1; o >>= 1) { ss[0] += __shfl_xor(ss[0], o); ss[1] += __shfl_xor(ss[1], o); }
#pragma unroll
        for (int i = 0; i < 4; ++i) { const int d = 256 * i + 4 * lane;
            const f32x4 g = *(const f32x4*)(p.norm2_g + d), sh = *(const f32x4*)(ada + b * 6144 + 3072 + d), sc = *(const f32x4*)(ada + b * 6144 + 4096 + d);
#pragma unroll
            for (int r = 0; r < 2; ++r) { const float rs = rsqrtf(ss[r] * (1.0f / 1024.0f) + 1e-6f);
                v[r][i] = v[r][i] * rs * g * (sc + 1.0f) + sh;
                u32x2 w; w.x = cvt_pk_bf16(v[r][i][0], v[r][i][1]); w.y = cvt_pk_bf16(v[r][i][2], v[r][i][3]); *(u32x2*)(h2 + (size_t)(row0 + r) * 1024 + d) = w; } }
        float q[32];
#pragma unroll
        for (int e = 0; e < 16; ++e) { float a0 = 0.f, a1 = 0.f;
#pragma unroll
            for (int i = 0; i < 4; ++i) { const f32x4 w = *(const LAS f32x4*)(wrt + e * 1024 + 256 * i + 4 * lane);
                a0 += v[0][i][0] * w[0] + v[0][i][1] * w[1] + v[0][i][2] * w[2] + v[0][i][3] * w[3];
                a1 += v[1][i][0] * w[0] + v[1][i][1] * w[1] + v[1][i][2] * w[2] + v[1][i][3] * w[3]; }
            q[e] = a0; q[16 + e] = a1; }
#pragma unroll
        for (int j = 0; j < 16; ++j) { const bool up = (lane & 32) != 0; const float send = up ? q[j] : q[16 + j], keep = up ? q[16 + j] : q[j]; q[j] = keep + __shfl_xor(send, 32); }
#pragma unroll
        for (int j = 0; j < 8; ++j) { const bool up = (lane & 16) != 0; const float send = up ? q[j] : q[8 + j], keep = up ? q[8 + j] : q[j]; q[j] = keep + __shfl_xor(send, 16); }
#pragma unroll
        for (int j = 0; j < 4; ++j) { const bool up = (lane & 8) != 0; const float send = up ? q[j] : q[4 + j], keep = up ? q[4 + j] : q[j]; q[j] = keep + __shfl_xor(send, 8); }
#pragma unroll
        for (int j = 0; j < 2; ++j) { const bool up = (lane & 4) != 0; const float send = up ? q[j] : q[2 + j], keep = up ? q[2 + j] : q[j]; q[j] = keep + __shfl_xor(send, 4); }
        { const bool up = (lane & 2) != 0; const float send = up ? q[0] : q[1], keep = up ? q[1] : q[0]; q[0] = keep + __shfl_xor(send, 2); }
        float lg = q[0] + __shfl_xor(q[0], 1);
        float mx = lg;
#pragma unroll
        for (int o = 2; o <= 16; o <<= 1) mx = fmaxf(mx, __shfl_xor(mx, o));
        const float ex = expf(lg - mx); float sum = ex;
#pragma unroll
        for (int o = 2; o <= 16; o <<= 1) sum += __shfl_xor(sum, o);
        if (gridDim.x == 256) {
            LAS float* scl = (LAS float*)(lds + 64 * 1024);
            if ((lane & 1) == 0) scl[((lane >> 1) & 15) * 16 + wid * 2 + (lane >> 5)] = ex / sum;
            __syncthreads();
            if (tid < 128) { const int e = tid >> 3, q = tid & 7; const u64_t v2 = *(const LAS u64_t*)(scl + e * 16 + 2 * q);
                __hip_atomic_store((u64_t*)(scores + ((size_t)b * 16 + e) * 4096 + ((row0 - 2 * wid) & 4095) + 2 * q), v2, __ATOMIC_RELAXED, __HIP_MEMORY_SCOPE_AGENT); }
            asm volatile("s_waitcnt vmcnt(0)" ::: "memory");
            __syncthreads();
            if (tid == 0) (void)__hip_atomic_fetch_add((unsigned*)(p.ws + WS_BAR + 44 * KiB) + b * 64, 1u, __ATOMIC_RELAXED, __HIP_MEMORY_SCOPE_AGENT);
        } else if ((lane & 1) == 0) scores[((size_t)b * 16 + ((lane >> 1) & 15)) * 4096 + ((row0 + (lane >> 5)) & 4095)] = ex / sum;
    }
    __syncthreads();
}
__device__ __forceinline__ void phase7_topk(const Params& p, LAS unsigned char* lds) {
    const int bid = blockIdx.x; if (bid >= NB * NE) return;
    unsigned* c = (unsigned*)(p.ws + WS_BAR + 44 * KiB) + (bid >> 4) * 64;
    if (threadIdx.x < 64) { unsigned sp = 0;
        while ((unsigned)__builtin_amdgcn_readfirstlane(__hip_atomic_load(c, __ATOMIC_RELAXED, __HIP_MEMORY_SCOPE_AGENT)) < 256u) { __builtin_amdgcn_s_sleep(1); if (++sp > (1u << 22)) break; }
        __builtin_amdgcn_fence(__ATOMIC_ACQUIRE, "agent");
        asm volatile("s_waitcnt vmcnt(0)" ::: "memory"); }
    __syncthreads();
    topk_task(p, lds, bid);
}
__device__ __forceinline__ void phase7_weights(const Params& p) {
    constexpr int N_G = 16 * 16 * 6, N_D = 16 * 24 * 4;
    const bool fused = gridDim.x == 256;
    for (int j = 0; ; ++j) {
        int it;
        if (!fused) it = blockIdx.x + j * gridDim.x;
        else if (blockIdx.x >= 128) it = j < 4 ? (blockIdx.x - 128) + 128 * j : 512 + blockIdx.x + (j - 4) * 256;
        else it = 512 + blockIdx.x + j * 256;
        if (it >= 2 * N_G + N_D) break;
        if (it < 2 * N_G) { const int up = it >= N_G, j = up ? it - N_G : it, e = j / 96, r = j % 96, kb = r / 6, nb = r % 6;
            xpose_item<4>((up ? p.w_up_e : p.w_gate_e) + (size_t)e * 1024 * 1536, 1536, (bf16_t*)(p.ws + WS_WGU) + (size_t)e * 3072 * 1024, 1024, kb * 64, nb * 256, up ? 2 : 1); }
        else { const int j = it - 2 * N_G, e = j / 96, r = j % 96, kb = r >> 2, nb = r & 3;
            xpose_item<4>(p.w_down_e + (size_t)e * 1536 * 1024, 1024, (bf16_t*)(p.ws + WS_WD) + (size_t)e * 1024 * 1536, 1536, kb * 64, nb * 256, 0); }
    }
}

__device__ __forceinline__ void phase11(const Params& p, float* dst) {
    const int tid = tid_opaque(), lane = tid & 63, wid = tid >> 6;
    const float* ada = (const float*)(p.ws + WS_ADA); const int* slot_of = (const int*)(p.ws + WS_SLOT); const bf16_t* oute = (const bf16_t*)(p.ws + WS_OUTE); const bf16_t* x2b = (const bf16_t*)(p.ws + WS_X2B);
    const int stride = gridDim.x * 16;
    int row0 = (blockIdx.x * 8 + wid) * 2;
    int myslot = row0 < MLAT ? slot_of[((size_t)(row0 >> 12) * 16 + (lane & 15)) * 4096 + ((row0 & 4095) + ((lane >> 4) & 1))] : -1;
    for (; row0 < MLAT; row0 += stride) {
        const int b = row0 >> 12;
        const int nrow = row0 + stride; const int nslot = nrow < MLAT ? slot_of[((size_t)(nrow >> 12) * 16 + (lane & 15)) * 4096 + ((nrow & 4095) + ((lane >> 4) & 1))] : -1;
        f32x4 xv[2][4], acc[2][4];
#pragma unroll
        for (int r = 0; r < 2; ++r)
#pragma unroll
            for (int i = 0; i < 4; ++i) { const u32x2 w = __builtin_nontemporal_load((const u32x2*)(x2b + (size_t)(row0 + r) * 1024 + 256 * i + 4 * lane)); xv[r][i] = (f32x4){bf_lo(w.x), bf_hi(w.x), bf_lo(w.y), bf_hi(w.y)}; acc[r][i] = (f32x4){0.f, 0.f, 0.f, 0.f}; }
        const unsigned long long bal = __ballot(myslot >= 0);
        unsigned mask0 = (unsigned)(bal & 0xffffull), mask1 = (unsigned)((bal >> 16) & 0xffffull);
        while (mask0 | mask1) {
            int m[2][2];
#pragma unroll
            for (int j = 0; j < 2; ++j) { if (mask0) { const int e = __builtin_ctz(mask0); mask0 &= mask0 - 1; m[0][j] = __builtin_amdgcn_readlane(myslot, e); } else m[0][j] = MMOE;
                                          if (mask1) { const int e = __builtin_ctz(mask1); mask1 &= mask1 - 1; m[1][j] = __builtin_amdgcn_readlane(myslot, 16 + e); } else m[1][j] = MMOE; }
            u32x2 w[2][2][4];
#pragma unroll
            for (int r = 0; r < 2; ++r)
#pragma unroll
                for (int j = 0; j < 2; ++j)
#pragma unroll
                    for (int i = 0; i < 4; ++i) w[r][j][i] = __builtin_nontemporal_load((const u32x2*)(oute + (size_t)m[r][j] * 1024 + 256 * i + 4 * lane));
#pragma unroll
            for (int r = 0; r < 2; ++r)
#pragma unroll
                for (int j = 0; j < 2; ++j)
#pragma unroll
                    for (int i = 0; i < 4; ++i) { acc[r][i][0] += bf_lo(w[r][j][i].x); acc[r][i][1] += bf_hi(w[r][j][i].x); acc[r][i][2] += bf_lo(w[r][j][i].y); acc[r][i][3] += bf_hi(w[r][j][i].y); }
        }
        float ss[2];
#pragma unroll
        for (int r = 0; r < 2; ++r) { float a = 0.f;
#pragma unroll
            for (int i = 0; i < 4; ++i) { const int d = 256 * i + 4 * lane; const f32x4 g2 = *(const f32x4*)(ada + b * 6144 + 5120 + d); xv[r][i] += g2 * acc[r][i];
                a += xv[r][i][0] * xv[r][i][0] + xv[r][i][1] * xv[r][i][1] + xv[r][i][2] * xv[r][i][2] + xv[r][i][3] * xv[r][i][3]; }
            ss[r] = a; }
#pragma unroll
        for (int o = 32; o >= 1; o >>= 1) { ss[0] += __shfl_xor(ss[0], o); ss[1] += __shfl_xor(ss[1], o); }
#pragma unroll
        for (int r = 0; r < 2; ++r) { const float rs = rsqrtf(ss[r] * (1.0f / 1024.0f) + 1e-6f);
#pragma unroll
            for (int i = 0; i < 4; ++i) { const int d = 256 * i + 4 * lane; __builtin_nontemporal_store(xv[r][i] * rs * *(const f32x4*)(p.final_g + d), (f32x4*)(dst + (size_t)(row0 + r) * 1024 + d)); } }
        myslot = nslot;
    }
}

#define XB_TMO      128
#define XB_XCNT(j)  (256  + 64 * (j))
#define XB_XSUB(j)  (1280 + 64 * (j))
#define XB_XGEN(j)  (2304 + 64 * (j))
#define XB_TOP      3328
#define XB_TOPGEN   3392
#define XCD_BAR_WORDS 3456
#define XB_SPIN_CAP (1u << 22)
__device__ __forceinline__ unsigned xb_ld(unsigned* p)              { return __hip_atomic_load(p, __ATOMIC_RELAXED, __HIP_MEMORY_SCOPE_AGENT); }
__device__ __forceinline__ unsigned xb_add(unsigned* p, unsigned v) { return __hip_atomic_fetch_add(p, v, __ATOMIC_RELAXED, __HIP_MEMORY_SCOPE_AGENT); }
__device__ __forceinline__ unsigned xb_xcc_id() { return (unsigned)__builtin_amdgcn_s_getreg((3 << 11) | 20) & 0xFu; }
#define XB_SPIN(cond, bar) do { unsigned _sp = 0; while (cond) { __builtin_amdgcn_s_sleep(1); \
    if ((++_sp & 255u) == 0u) { if (xb_ld(&(bar)[XB_TMO])) break; if (_sp > XB_SPIN_CAP) { atomicAdd(&(bar)[XB_TMO], 1u); break; } } } } while (0)
struct XcdBarrier { unsigned* bar; unsigned x; volatile LAS unsigned* st; };
__device__ __forceinline__ XcdBarrier xcd_barrier_post(unsigned* bar, volatile LAS unsigned* st) {
    XcdBarrier b; b.bar = bar; b.x = xb_xcc_id(); b.st = st;
    if (threadIdx.x == 0) (void)xb_add(&bar[XB_XCNT(b.x)], 1u);
    return b;
}
__device__ __forceinline__ void xcd_barrier_complete(unsigned* bar, unsigned x, unsigned& nloc, unsigned& nx) {
    const unsigned G = gridDim.x * gridDim.y * gridDim.z;
    unsigned sum, cnt, mine, sp = 0u;
    for (;;) {
        sum = 0u; cnt = 0u; mine = 0u;
#pragma unroll
        for (unsigned j = 0; j < 16; ++j) { const unsigned c = xb_ld(&bar[XB_XCNT(j)]); sum += c; cnt += (c > 0u) ? 1u : 0u; mine = (j == x) ? c : mine; }
        if (sum == G) break;
        __builtin_amdgcn_s_sleep(1);
        if ((++sp & 255u) == 0u) { if (xb_ld(&bar[XB_TMO])) break; if (sp > XB_SPIN_CAP) { atomicAdd(&bar[XB_TMO], 1u); break; } }
    }
    nloc = mine > 0u ? mine : 1u; nx = cnt > 0u ? cnt : 1u;
}
__device__ __forceinline__ void xcd_barrier(const XcdBarrier& b) {
    asm volatile("s_waitcnt vmcnt(0)" ::: "memory");
    __syncthreads();
    if (threadIdx.x == 0) {
        unsigned* bar = b.bar;
        __builtin_amdgcn_s_waitcnt(0);
        unsigned nloc = b.st[0], nx = b.st[1];
        if (nloc == 0u) { xcd_barrier_complete(bar, b.x, nloc, nx); b.st[0] = nloc; b.st[1] = nx; }
        const unsigned old = xb_add(&bar[XB_XSUB(b.x)], 1u);
        const unsigned gen = old / nloc;
        if (old + 1u == (gen + 1u) * nloc) {
            __builtin_amdgcn_fence(__ATOMIC_RELEASE, "agent");
            asm volatile("s_waitcnt vmcnt(0)" ::: "memory");
            const unsigned og = xb_add(&bar[XB_TOP], 1u);
            const unsigned tg = og / nx;
            if (og + 1u == (tg + 1u) * nx) xb_add(&bar[XB_TOPGEN], 1u);
            else XB_SPIN(xb_ld(&bar[XB_TOPGEN]) == tg, bar);
            __builtin_amdgcn_fence(__ATOMIC_ACQUIRE, "agent");
            xb_add(&bar[XB_XGEN(b.x)], 1u);
            asm volatile("s_waitcnt vmcnt(0)" ::: "memory");
        } else {
            XB_SPIN(xb_ld(&bar[XB_XGEN(b.x)]) == gen, bar);
            __builtin_amdgcn_fence(__ATOMIC_ACQUIRE, "agent");
            asm volatile("s_waitcnt vmcnt(0)" ::: "memory");
        }
    }
    __syncthreads();
}

__global__ void __launch_bounds__(NTHR, 2) fwd_megakernel(Params p_in) {
    Params p = p_in;
    extern __shared__ __attribute__((aligned(16))) unsigned char lds_raw[];
    LAS unsigned char* lds = (LAS unsigned char*)lds_raw;
    cg::grid_group grid = cg::this_grid();
    const int G = gridDim.x, bid = blockIdx.x;
    unsigned char* ws = p.ws;
    bf16_t* const R1 = (bf16_t*)(ws + WS_R1); bf16_t* const Zb = (bf16_t*)(ws + WS_RZ); bf16_t* const PQt = (bf16_t*)(ws + WS_RPQ); bf16_t* const MRG = (bf16_t*)(ws + WS_R2);
    bf16_t* const Fb = (bf16_t*)((unsigned char*)p.out + OUT_F); bf16_t* const Ytb = (bf16_t*)((unsigned char*)p.out + OUT_YT);
#ifdef ONLY_PH
#define PH(k) ((k) == ONLY_PH && p.ph_lo <= (k) && (k) < p.ph_hi)
#else
#define PH(k) (p.ph_lo <= (k) && (k) < p.ph_hi)
#endif
    volatile LAS unsigned* xst = (volatile LAS unsigned*)(lds + LDS_BYTES - 16);
    if (threadIdx.x < 4) xst[threadIdx.x] = 0u;
    __syncthreads();
    XcdBarrier xbar = xcd_barrier_post((unsigned*)(ws + WS_BAR), xst);
    if (p.ph_lo < 0) grid.sync();
#ifdef TS_A
    unsigned long long* tsb = (unsigned long long*)(ws + WS_BAR + 40 * KiB);
#define STAMP(i) do { if (bid == 0 && threadIdx.x == 0) tsb[i] = __builtin_amdgcn_s_memrealtime(); } while (0)
#else
#define STAMP(i) do { } while (0)
#endif
    STAMP(0);
#define LAUNDER() do { asm volatile("" : "+s"(p.ws), "+s"(p.out), "+s"(p.x)); ws = p.ws; } while (0)
#define SYNC(k) do { if (PH(k) && PH((k) + 1)) xcd_barrier(xbar); STAMP((k) + 1); LAUNDER(); } while (0)
#ifndef REPMASK
#define REPMASK 0
#endif
#define REP(k) for (int rep_ = 0; rep_ <= ((REPMASK >> (k)) & 1); ++rep_)
    const bool fuse01 = PH(0) && PH(1);
    if (PH(0)) phase0(p, lds);
    if (fuse01) block_wait_ge((unsigned*)(ws + WS_BAR + 46 * KiB), 256u + 16u);
    else SYNC(0);
    if (PH(1)) REP(1) phase1(p);
    SYNC(1);
    if (PH(2)) REP(2) {
        { ProbPQ pr{(const bf16_t*)(ws + WS_WPQ), R1, 1024, 1024, 16384}; pg8::Order S; S.init(4, 128, G, bid); EpiPQ E{PQt}; pg8::gemm_phase(lds, pr, S, E); }
        STAMP(28);
        { ProbPlain pr{R1, (const bf16_t*)(ws + WS_WIN), 1024, 1024, 1024}; pg8::Order S; S.init(128, 16, G, bid); EpiZ E{Zb, 4096, -1}; pg8::gemm_phase(lds, pr, S, E); }
        STAMP(29);
        { ProbPlain pr{(const bf16_t*)(ws + WS_HCTX), (const bf16_t*)(ws + WS_WIN), 1024, 1024, 1024}; pg8::Order S; S.init(8, 4, G, bid); EpiZ E{(bf16_t*)(ws + WS_ZXC), 1024, 0}; pg8::gemm_phase(lds, pr, S, E); }
    }
    SYNC(2);
    if (PH(3)) REP(3) {
        {
            ProbPlain pr{(const bf16_t*)(ws + WS_D1T), PQt, 512, 512, 512}; pg8::Order S; S.init(2, 256, G, bid);
            if (G == 256) { if (bid >= 128) { S.G = 128; S.c = bid - 128; S.base = 0; S.lim = 3; } else { S.G = 128; S.c = bid; S.base = 384; S.lim = 1; } }
            EpiPlain E{Ytb, 65536}; pg8::gemm_phase(lds, pr, S, E); }
        for (int it = bid; it < NB * 2 * 8; it += G) lru_tile<false>(p, lds, it);
    }
    SYNC(3);
    if (PH(4)) {
        fft_stage2_all(p, lds);
        const int ngr = G >> 5;
        if (ngr > 0 && bid < ngr * 32) lru2_block(p, lds, bid % ngr, bid / ngr, ngr);
    }
    SYNC(4);
    if (PH(5)) REP(5) {
        { ProbMerge pr{Fb, (const bf16_t*)(ws + WS_WFOUR), R1, (const bf16_t*)(ws + WS_WLRU), 512, 1024, 512, 512, 1024, 1024}; pg8::Order S; S.init(128, 4, G, bid); EpiMerge E{MRG, Zb}; pg8::gemm_phase2(lds, pr, S, E); }
    }
    SYNC(5);
    if (PH(6)) REP(6) { ProbPlain pr{MRG, (const bf16_t*)(ws + WS_WOUT), 1024, 1024, 1024}; pg8::Order S; S.init(128, 4, G, bid); if (512 % G == 0) S.rev = 512 / G;
        EpiOut E{(bf16_t*)(ws + WS_X2B), p.x, (const float*)(ws + WS_POS), (const float*)(ws + WS_ADA)}; pg8::gemm_phase(lds, pr, S, E); }
    SYNC(6);
    if (PH(7)) { phase7_rows(p, lds); if (G == 256) phase7_topk(p, lds); phase7_weights(p); }
    SYNC(7);
    if (PH(8) && G != 256) { for (int it = bid; it < NB * NE; it += G) topk_task(p, lds, it); }
    if (G != 256) SYNC(8);
    if (PH(9)) REP(9) { ProbMoeUp pr{(const bf16_t*)(ws + WS_H2), (const bf16_t*)(ws + WS_WGU), (const int*)(ws + WS_IDX), 1024, 1024, 1024}; pg8::Order S; S.init(256, 12, G, bid); S.wgm = P9_WGM; EpiGU E{(bf16_t*)(ws + WS_HID)}; pg8::gemm_phase(lds, pr, S, E); }
    SYNC(9);
    if (PH(10)) { if (bid == 0 && threadIdx.x < 128) *(u32x4*)(ws + WS_OUTE + (size_t)MMOE * 2048 + threadIdx.x * 16) = (u32x4){0u, 0u, 0u, 0u}; }
    if (PH(10)) REP(10) { ProbMoeDown pr{(const bf16_t*)(ws + WS_HID), (const bf16_t*)(ws + WS_WD), 1536, 1536, 1536}; pg8::Order S; S.init(256, 4, G, bid); if (1024 % G == 0) S.rev = 1024 / G; EpiDown E{(bf16_t*)(ws + WS_OUTE), (const float*)(ws + WS_GATE)}; pg8::gemm_phase(lds, pr, S, E); }
    SYNC(10);
    if (PH(11)) phase11(p, p.out);
#ifdef TS_A
    xcd_barrier(xbar); STAMP(12);
    if (bid == 0 && threadIdx.x == 0) {

#ifndef TS_AE
#define TS_AE (TS_A + 1)
#endif
#ifndef TS_BE
#define TS_BE (TS_B + 1)
#endif
        const float ta = (float)(tsb[TS_AE] - tsb[TS_A]) * 0.01f * (float)(TS_SA), tb = (float)(tsb[TS_BE] - tsb[TS_B]) * 0.01f * (float)(TS_SB);
        p.out[7] = fminf(ta, 97.f); p.out[1024 * 5 + 9] = fminf(tb, 97.f); }
#endif
}

#ifndef N_LAUNCHES
#define N_LAUNCHES 1
#endif
#ifndef PROBE_DUP
#define PROBE_DUP 0x0
#endif
extern "C" void kernel_launch(void* const* d_in, const int* in_sizes, int n_in, void* d_out, int out_size, void* d_ws, size_t ws_size, hipStream_t stream) {
    static int grid = 0;
    if (grid == 0) {
        if (n_in != 24 || out_size != MLAT * DM || ws_size < WS_END) { fprintf(stderr, "kernel_launch: unexpected shapes (n_in %d out %d ws %zu)\n", n_in, out_size, ws_size); grid = -1; return; }
        int dev = 0, cus = 0, per_cu = 0;
        hipGetDevice(&dev); hipDeviceGetAttribute(&cus, hipDeviceAttributeMultiprocessorCount, dev);
        hipFuncSetAttribute((const void*)fwd_megakernel, hipFuncAttributeMaxDynamicSharedMemorySize, LDS_BYTES);
        hipOccupancyMaxActiveBlocksPerMultiprocessor(&per_cu, (const void*)fwd_megakernel, NTHR, LDS_BYTES);
        if (per_cu < 1) { fprintf(stderr, "kernel_launch: occupancy query reports %d blocks per CU\n", per_cu); per_cu = 1; }
        grid = cus * 1;
        (void)hipGetLastError();
    }
    if (grid < 0) return;
    Params p{};
    const float** f = (const float**)&p;
    for (int i = 0; i < 24; ++i) f[i] = (const float*)d_in[i];
    p.out = (float*)d_out; p.ws = (unsigned char*)d_ws;
    (void)hipMemsetAsync((unsigned char*)d_ws + WS_BAR, 0, 48 * KiB, stream);
#if N_LAUNCHES == 1
    p.ph_lo = 0; p.ph_hi = 12;
    void* args[] = {&p};
    hipError_t e = hipLaunchCooperativeKernel((const void*)fwd_megakernel, dim3(grid), dim3(NTHR), args, LDS_BYTES, stream);
    if (e != hipSuccess) fprintf(stderr, "cooperative launch failed: %s (grid %d)\n", hipGetErrorString(e), grid);
#else
    for (int k = 0; k < 12; ++k) for (int r = 0; r <= ((PROBE_DUP >> k) & 1); ++r) { p.ph_lo = k; p.ph_hi = k + 1; if (k == 11 && r == 0 && ((PROBE_DUP >> 11) & 1)) { p.ph_lo = 12; p.ph_hi = 13; } hipLaunchKernelGGL(fwd_megakernel, dim3(grid), dim3(NTHR), LDS_BYTES, stream, p); }
#endif
}
```

```cpp
#include <hip/hip_runtime.h>
#include <hip/hip_cooperative_groups.h>
#include <cstdio>
namespace cg = cooperative_groups;

#ifndef P9_WGM
#define P9_WGM 2
#endif
#define LAS __attribute__((address_space(3)))
typedef unsigned short bf16_t;
typedef short bf16x8 __attribute__((ext_vector_type(8)));
typedef float f32x4 __attribute__((ext_vector_type(4)));
typedef float f32x16 __attribute__((ext_vector_type(16)));
typedef unsigned u32x4 __attribute__((ext_vector_type(4)));
typedef unsigned u32x2 __attribute__((ext_vector_type(2)));
typedef unsigned long long u64_t;

constexpr int NB = 8, TT = 4096, DM = 1024, CTXL = 256, MLAT = NB * TT, MCTX = NB * CTXL;
constexpr int NE = 16, CAP = 512, DE = 1536, MMOE = NE * NB * CAP;
constexpr int NSEQ = 34;
constexpr int NTHR = 512;
constexpr float NLOG2E = -1.4426950408889634f;
constexpr int LDS_BYTES = 144 * 1024;

constexpr size_t KiB = 1024, MiB = 1024 * 1024;
constexpr size_t WS_ADA = 0;
constexpr size_t WS_POS = 256 * KiB;
constexpr size_t WS_AGG = 512 * KiB;
constexpr size_t WS_WPQ = 5 * MiB;
constexpr size_t WS_WIN = 7 * MiB;
constexpr size_t WS_WFOUR = 15 * MiB;
constexpr size_t WS_WLRU = 16 * MiB;
constexpr size_t WS_WOUT = 18 * MiB;
constexpr size_t WS_WAT = 20 * MiB;
constexpr size_t WS_WIT = 20 * MiB + 512 * KiB;
constexpr size_t WS_SCORES = 21 * MiB;
constexpr size_t WS_IDX = 23 * MiB;
constexpr size_t WS_GATE = 23 * MiB + 256 * KiB;
constexpr size_t WS_SLOT = 23 * MiB + 512 * KiB;
constexpr size_t WS_BAR = 25 * MiB + 512 * KiB;
constexpr size_t WS_D1T = 34 * MiB;
constexpr size_t WS_D2T = 34 * MiB + 512 * KiB;
constexpr size_t WS_HCTX = 26 * MiB;
constexpr size_t WS_ZXC = 30 * MiB;
constexpr size_t WS_R1 = 40 * MiB;
constexpr size_t WS_RPQ = 104 * MiB;
constexpr size_t WS_R2 = 168 * MiB;
constexpr size_t WS_RZ = 232 * MiB;
constexpr size_t WS_END = 504 * MiB;
constexpr size_t WS_X2B = WS_R1, WS_H2 = WS_RPQ, WS_WGU = 168 * MiB, WS_WD = 264 * MiB, WS_HID = 312 * MiB, WS_OUTE = WS_RPQ;
constexpr size_t OUT_YT = 0, OUT_F = 64 * MiB;

struct Params {
    const float *x, *c, *ctx, *c_ctx, *w_ada, *b_ada, *norm1_g, *norm2_g, *w_in, *w_four, *conv_w, *conv_b, *lru_lambda,
        *lru_wa, *lru_ba, *lru_wi, *lru_bi, *w_lru, *w_out, *w_router, *w_gate_e, *w_up_e, *w_down_e, *final_g;
    float* out; unsigned char* ws; int ph_lo, ph_hi;
};

__device__ __forceinline__ int tid_opaque() { int t = threadIdx.x; asm volatile("" : "+v"(t)); return t; }
__device__ __forceinline__ unsigned cvt_pk_bf16(float lo, float hi) { unsigned r; asm volatile("v_cvt_pk_bf16_f32 %0, %1, %2" : "=v"(r) : "v"(lo), "v"(hi)); return r; }
__device__ __forceinline__ void mfma_settle(f32x4& a) { asm volatile("s_nop 15\n\ts_nop 7" : "+v"(a)); }
__device__ __forceinline__ void block_wait_ge(unsigned* cnt, unsigned need) {
    if (threadIdx.x < 64) { unsigned sp = 0;
        while ((unsigned)__builtin_amdgcn_readfirstlane(__hip_atomic_load(cnt, __ATOMIC_RELAXED, __HIP_MEMORY_SCOPE_AGENT)) < need) { __builtin_amdgcn_s_sleep(2); if (++sp > (1u << 22)) break; }
        __builtin_amdgcn_fence(__ATOMIC_ACQUIRE, "agent"); asm volatile("s_waitcnt vmcnt(0)" ::: "memory"); }
    __syncthreads();
}
__device__ __forceinline__ float bf_lo(unsigned w) { return __uint_as_float(w << 16); }
__device__ __forceinline__ float bf_hi(unsigned w) { return __uint_as_float(w & 0xffff0000u); }
__device__ __forceinline__ float bf2f(bf16_t h) { return __uint_as_float(((unsigned)h) << 16); }
__device__ __forceinline__ float sigmoidf_(float v) { return __builtin_amdgcn_rcpf(1.0f + __expf(-v)); }
__device__ __forceinline__ float gelu_tanh(float v) { const float y = 1.5957691216f * (v + 0.044715f * v * v * v); return v * sigmoidf_(y); }
__device__ __forceinline__ float wave_sum(float v) {
#pragma unroll
    for (int o = 32; o >= 1; o >>= 1) v += __shfl_xor(v, o);
    return v;
}
__device__ __forceinline__ void unpack8(const u32x4 w, float (&f)[8]) { f[0] = bf_lo(w.x); f[1] = bf_hi(w.x); f[2] = bf_lo(w.y); f[3] = bf_hi(w.y); f[4] = bf_lo(w.z); f[5] = bf_hi(w.z); f[6] = bf_lo(w.w); f[7] = bf_hi(w.w); }

namespace pg8 {
constexpr int BM = 256, BK = 64, HALF = 128, HTB = HALF * BK * 2, STAGE_BYTES = 8 * HTB, NXCD = 8, WGM = 2;
__device__ __forceinline__ int lds_byte(int r, int c) { const int st = (r >> 4) * 2 + (c >> 5), rr = r & 15, cc = c & 31, ob = rr * 64 + cc * 2; return st * 1024 + (ob ^ (((ob >> 9) & 1) << 5)); }
__device__ __forceinline__ void stage_rc(int b, int& R, int& C) { const int st = b / 1024, sb = b % 1024, swz = sb ^ (((sb >> 9) & 1) << 5); R = (st >> 1) * 16 + swz / 64; C = (st & 1) * 32 + (swz % 64) / 2; }
__device__ __forceinline__ int perm32(int rho) { const int n = rho >> 4, i = rho & 15; return 8 * (i >> 2) + 4 * n + (i & 3); }
struct Unit { int pm, pn; };
struct Order {
    int nM, nN, nwg, G, c, base, lim, rev, wgm;
    __device__ void init(int nM_, int nN_, int G_, int c_) { nM = nM_; nN = nN_; nwg = nM * nN; G = G_; c = c_; base = 0; lim = 0x7fffffff; rev = 0; wgm = WGM; }
    __device__ bool next(int i, Unit& u) const {
        if (rev > 0 && i >= rev) return false;
        const long L = (long)base + (long)(rev > 0 ? rev - 1 - i : i) * G + c; if (i >= lim || L >= nwg) return false;
        int wgid = (int)L; { const int q = nwg / NXCD, r = nwg % NXCD, xcd = wgid % NXCD, off = wgid / NXCD; wgid = (xcd < r ? xcd * (q + 1) : r * (q + 1) + (xcd - r) * q) + off; }
        const int nig = wgm * nN, gid = wgid / nig, fm = gid * wgm, gsz = (nM - fm) < wgm ? (nM - fm) : wgm;
        u.pm = fm + ((wgid % nig) % gsz); u.pn = (wgid % nig) / gsz; return true;
    }
};
template <class P, class Epi>
__device__ __forceinline__ void gemm_phase(LAS unsigned char* lds, const P& pr, const Order& S, const Epi& E) {
    const int tid = tid_opaque(), wid = __builtin_amdgcn_readfirstlane(tid >> 6), lane = tid & 63, wr = wid >> 2, wc = wid & 3, fr = lane & 15, fq = lane >> 4;
    const int nt = pr.K / BK;
    int RA[2], CA[2]; unsigned voffB[2];
#pragma unroll
    for (int i = 0; i < 2; ++i) { int R, C; stage_rc(tid * 16 + i * 8192, R, C); RA[i] = R; CA[i] = C; const int Rb = Epi::PERM ? ((R & ~31) + perm32(R & 31)) : R; voffB[i] = (unsigned)(Rb * pr.ldb + C) * 2u; }
    const size_t kstep = (size_t)(BK * 2);
    const size_t hstepB = (size_t)HALF * pr.ldb * 2;
    const unsigned ldsw = (unsigned)wid * 1024u;
    const int aoff = lds_byte(wr * 64 + fr, fq * 8), boff = lds_byte(wc * 32 + fr, fq * 8);
#define PG8_SA(b, h) (((b) * 2 + (h)) * HTB)
#define PG8_SB(b, h) ((4 + (b) * 2 + (h)) * HTB)
#define PG8_STAGE(bufoff, gbase, voff) do { _Pragma("unroll") for (int _i = 0; _i < 2; ++_i) \
        __builtin_amdgcn_global_load_lds((const unsigned*)((const char*)(gbase) + (voff)[_i]), (LAS unsigned*)(lds + (bufoff) + ldsw + _i * 8192), 16, 0, 0); } while (0)
#define PG8_LDA(dst, b, h) do { _Pragma("unroll") for (int m = 0; m < 4; ++m) _Pragma("unroll") for (int k = 0; k < 2; ++k) dst[m][k] = *(const LAS bf16x8*)(lds + PG8_SA(b, h) + aoff + m * 2048 + k * 1024); } while (0)
#define PG8_LDB(dst, b, h) do { _Pragma("unroll") for (int n = 0; n < 2; ++n) _Pragma("unroll") for (int k = 0; k < 2; ++k) dst[n][k] = *(const LAS bf16x8*)(lds + PG8_SB(b, h) + boff + n * 2048 + k * 1024); } while (0)
#define PG8_MMA(ai, bj, At, Bt) do { __builtin_amdgcn_s_setprio(1); _Pragma("unroll") for (int m = 0; m < 4; ++m) _Pragma("unroll") for (int n = 0; n < 2; ++n) _Pragma("unroll") for (int k = 0; k < 2; ++k) \
        acc[ai][bj][m][n] = __builtin_amdgcn_mfma_f32_16x16x32_bf16(Bt[n][k], At[m][k], acc[ai][bj][m][n], 0, 0, 0); __builtin_amdgcn_s_setprio(0); } while (0)
#define PG8_WAIT_V(n) asm volatile("s_waitcnt vmcnt(" #n ")" ::: "memory")
#define PG8_WAIT_L(n) asm volatile("s_waitcnt lgkmcnt(" #n ")" ::: "memory")
#define PG8_BAR __builtin_amdgcn_s_barrier()
#define PG8_SCHED __builtin_amdgcn_sched_barrier(0)
    Unit cur, nxt; int ui = 0;
    if (!S.next(0, cur)) return;
    f32x4 acc[2][2][4][2];
#pragma unroll
    for (int a = 0; a < 2; ++a)
#pragma unroll
        for (int b = 0; b < 2; ++b)
#pragma unroll
            for (int m = 0; m < 4; ++m)
#pragma unroll
                for (int n = 0; n < 2; ++n) acc[a][b][m][n] = (f32x4){0.f, 0.f, 0.f, 0.f};
    bf16x8 At[4][2], B0[2][2], B1[2][2];
    unsigned vA[2][2], vN[2][2];
    pr.avoff(cur, RA, CA, vA);
#pragma unroll
    for (int h = 0; h < 2; ++h)
#pragma unroll
        for (int i = 0; i < 2; ++i) vN[h][i] = vA[h][i];
    const char* cA = pr.abase(cur); const char* cB = pr.bbase(cur);
#define PG8_ROT(u) 0
#define PG8_KT(tt, rot) ((size_t)(((tt) + (rot)) >= nt ? ((tt) + (rot)) - nt : ((tt) + (rot))) * kstep)
    int rot = PG8_ROT(cur);
    { const char* pA = cA + PG8_KT(0, rot); const char* pB = cB + PG8_KT(0, rot);
    PG8_STAGE(PG8_SB(0, 0), pB, voffB); PG8_STAGE(PG8_SA(0, 0), pA, vA[0]); PG8_STAGE(PG8_SB(0, 1), pB + hstepB, voffB); PG8_STAGE(PG8_SA(0, 1), pA, vA[1]);
    if (wr == 1) PG8_BAR;
    PG8_WAIT_V(4); PG8_BAR;
    PG8_STAGE(PG8_SB(1, 0), pB + kstep, voffB); PG8_STAGE(PG8_SA(1, 0), pA + kstep, vA[0]); PG8_STAGE(PG8_SB(1, 1), pB + hstepB + kstep, voffB); }
    PG8_WAIT_V(6); PG8_BAR;
    for (;;) {
        const bool has_next = S.next(ui + 1, nxt);
        const char* nA = has_next ? pr.abase(nxt) : cA; const char* nB = has_next ? pr.bbase(nxt) : cB; const int nrot = has_next ? PG8_ROT(nxt) : rot;
        if (P::GATHER) { if (has_next) pr.avoff(nxt, RA, CA, vN); }
        for (int t = 0; t < nt; t += 2) {
            const bool last = (t == nt - 2);
            const char* a1 = cA + PG8_KT(t + 1, rot);
            const char* a2 = last ? nA + PG8_KT(0, nrot) : cA + PG8_KT(t + 2, rot); const char* b2 = last ? nB + PG8_KT(0, nrot) : cB + PG8_KT(t + 2, rot);
            const char* a3 = a2 + kstep; const char* b3 = b2 + kstep;
            unsigned v2[2][2];
#pragma unroll
            for (int h = 0; h < 2; ++h)
#pragma unroll
                for (int i = 0; i < 2; ++i) v2[h][i] = (P::GATHER && last) ? vN[h][i] : vA[h][i];
            PG8_LDB(B0, 0, 0); PG8_SCHED; PG8_LDA(At, 0, 0); PG8_STAGE(PG8_SA(1, 1), a1, vA[1]);
            PG8_WAIT_L(8); PG8_BAR; PG8_WAIT_L(0); PG8_MMA(0, 0, At, B0); PG8_BAR; PG8_SCHED;
            PG8_LDB(B1, 0, 1); PG8_STAGE(PG8_SB(0, 0), b2, voffB);
            PG8_BAR; PG8_WAIT_L(0); PG8_MMA(0, 1, At, B1); PG8_BAR;
            PG8_LDA(At, 0, 1); PG8_STAGE(PG8_SA(0, 0), a2, v2[0]);
            PG8_BAR; PG8_WAIT_L(0); PG8_MMA(1, 0, At, B0); PG8_BAR; PG8_SCHED;
            PG8_STAGE(PG8_SB(0, 1), b2 + hstepB, voffB);
            PG8_WAIT_V(6); PG8_BAR; PG8_MMA(1, 1, At, B1); PG8_BAR;
            PG8_LDB(B0, 1, 0); PG8_SCHED; PG8_LDA(At, 1, 0); PG8_STAGE(PG8_SA(0, 1), a2, v2[1]);
            PG8_WAIT_L(8); PG8_BAR; PG8_WAIT_L(0); PG8_MMA(0, 0, At, B0); PG8_BAR; PG8_SCHED;
            PG8_LDB(B1, 1, 1); PG8_STAGE(PG8_SB(1, 0), b3, voffB);
            PG8_BAR; PG8_WAIT_L(0); PG8_MMA(0, 1, At, B1); PG8_BAR;
            PG8_LDA(At, 1, 1); PG8_STAGE(PG8_SA(1, 0), a3, v2[0]);
            PG8_BAR; PG8_WAIT_L(0); PG8_MMA(1, 0, At, B0); PG8_BAR; PG8_SCHED;
            PG8_STAGE(PG8_SB(1, 1), b3 + hstepB, voffB);
            PG8_WAIT_V(6); PG8_BAR; PG8_MMA(1, 1, At, B1); PG8_BAR;
            if (P::GATHER && last) {
#pragma unroll
                for (int h = 0; h < 2; ++h)
#pragma unroll
                    for (int i = 0; i < 2; ++i) vA[h][i] = vN[h][i];
            }
        }
        E(acc, cur, wr, wc, fr, fq);
        if (!has_next) break;
#pragma unroll
        for (int a = 0; a < 2; ++a)
#pragma unroll
            for (int b = 0; b < 2; ++b)
#pragma unroll
                for (int m = 0; m < 4; ++m)
#pragma unroll
                    for (int n = 0; n < 2; ++n) acc[a][b][m][n] = (f32x4){0.f, 0.f, 0.f, 0.f};
        cur = nxt; cA = nA; cB = nB; rot = nrot; ++ui;
    }
    PG8_WAIT_V(0);
    if (wr == 0) PG8_BAR;
    PG8_BAR;
#undef PG8_ROT
#undef PG8_KT
#undef PG8_SA
#undef PG8_SB
#undef PG8_STAGE
#undef PG8_LDA
#undef PG8_LDB
#undef PG8_MMA
#undef PG8_WAIT_V
#undef PG8_WAIT_L
#undef PG8_BAR
#undef PG8_SCHED
}
template <class P, class Epi>
__device__ __forceinline__ void gemm_phase2(LAS unsigned char* lds, const P& pr, const Order& S, const Epi& E) {
    const int tid = tid_opaque(), wid = __builtin_amdgcn_readfirstlane(tid >> 6), lane = tid & 63, wr = wid >> 2, wc = wid & 3, fr = lane & 15, fq = lane >> 4;
    const int nt1 = pr.K1 / BK, nt = (pr.K1 + pr.K2) / BK;
    unsigned R2[2], Rb2[2], C2[2];
#pragma unroll
    for (int i = 0; i < 2; ++i) { int R, C; stage_rc(tid * 16 + i * 8192, R, C); const int Rb = Epi::PERM ? ((R & ~31) + perm32(R & 31)) : R; R2[i] = (unsigned)R * 2u; Rb2[i] = (unsigned)Rb * 2u; C2[i] = (unsigned)C * 2u; }
#define OFF_A(ld, h, i) ((R2[i] + (unsigned)((h) * 256)) * (unsigned)(ld) + C2[i])
#define OFF_B(ld, i) (Rb2[i] * (unsigned)(ld) + C2[i])
    const size_t kstep = (size_t)(BK * 2);
    const size_t hB1 = (size_t)HALF * pr.ldb1 * 2, hB2 = (size_t)HALF * pr.ldb2 * 2;
    const unsigned ldsw = (unsigned)wid * 1024u;
    const int aoff = lds_byte(wr * 64 + fr, fq * 8), boff = lds_byte(wc * 32 + fr, fq * 8);
#define PG8_SA(b, h) (((b) * 2 + (h)) * HTB)
#define PG8_SB(b, h) ((4 + (b) * 2 + (h)) * HTB)
#define PG8_STAGE(bufoff, gbase, voff) do { _Pragma("unroll") for (int _i = 0; _i < 2; ++_i) \
        __builtin_amdgcn_global_load_lds((const unsigned*)((const char*)(gbase) + (voff)[_i]), (LAS unsigned*)(lds + (bufoff) + ldsw + _i * 8192), 16, 0, 0); } while (0)
#define PG8_LDA(dst, b, h) do { _Pragma("unroll") for (int m = 0; m < 4; ++m) _Pragma("unroll") for (int k = 0; k < 2; ++k) dst[m][k] = *(const LAS bf16x8*)(lds + PG8_SA(b, h) + aoff + m * 2048 + k * 1024); } while (0)
#define PG8_LDB(dst, b, h) do { _Pragma("unroll") for (int n = 0; n < 2; ++n) _Pragma("unroll") for (int k = 0; k < 2; ++k) dst[n][k] = *(const LAS bf16x8*)(lds + PG8_SB(b, h) + boff + n * 2048 + k * 1024); } while (0)
#define PG8_MMA(ai, bj, At, Bt) do { __builtin_amdgcn_s_setprio(1); _Pragma("unroll") for (int m = 0; m < 4; ++m) _Pragma("unroll") for (int n = 0; n < 2; ++n) _Pragma("unroll") for (int k = 0; k < 2; ++k) \
        acc[ai][bj][m][n] = __builtin_amdgcn_mfma_f32_16x16x32_bf16(Bt[n][k], At[m][k], acc[ai][bj][m][n], 0, 0, 0); __builtin_amdgcn_s_setprio(0); } while (0)
#define PG8_WAIT_V(n) asm volatile("s_waitcnt vmcnt(" #n ")" ::: "memory")
#define PG8_WAIT_L(n) asm volatile("s_waitcnt lgkmcnt(" #n ")" ::: "memory")
#define PG8_BAR __builtin_amdgcn_s_barrier()
#define PG8_SCHED __builtin_amdgcn_sched_barrier(0)
    Unit cur, nxt; int ui = 0;
    if (!S.next(0, cur)) return;
    f32x4 acc[2][2][4][2];
#pragma unroll
    for (int a = 0; a < 2; ++a)
#pragma unroll
        for (int b = 0; b < 2; ++b)
#pragma unroll
            for (int m = 0; m < 4; ++m)
#pragma unroll
                for (int n = 0; n < 2; ++n) acc[a][b][m][n] = (f32x4){0.f, 0.f, 0.f, 0.f};
    bf16x8 At[4][2], B0[2][2], B1[2][2];
    const char* cA1 = pr.abase1(cur); const char* cB1 = pr.bbase1(cur); const char* cA2 = pr.abase2(cur); const char* cB2 = pr.bbase2(cur);
#define T_A(tt) ((tt) < nt1 ? cA1 + (size_t)(tt) * kstep : cA2 + (size_t)((tt) - nt1) * kstep)
#define T_B(tt) ((tt) < nt1 ? cB1 + (size_t)(tt) * kstep : cB2 + (size_t)((tt) - nt1) * kstep)
    { unsigned vb[2] = {OFF_B(pr.ldb1, 0), OFF_B(pr.ldb1, 1)}, va0[2] = {OFF_A(pr.lda1, 0, 0), OFF_A(pr.lda1, 0, 1)}, va1[2] = {OFF_A(pr.lda1, 1, 0), OFF_A(pr.lda1, 1, 1)};
    PG8_STAGE(PG8_SB(0, 0), cB1, vb); PG8_STAGE(PG8_SA(0, 0), cA1, va0); PG8_STAGE(PG8_SB(0, 1), cB1 + hB1, vb); PG8_STAGE(PG8_SA(0, 1), cA1, va1);
    if (wr == 1) PG8_BAR;
    PG8_WAIT_V(4); PG8_BAR;
    PG8_STAGE(PG8_SB(1, 0), cB1 + kstep, vb); PG8_STAGE(PG8_SA(1, 0), cA1 + kstep, va0); PG8_STAGE(PG8_SB(1, 1), cB1 + hB1 + kstep, vb); }
    PG8_WAIT_V(6); PG8_BAR;
    for (;;) {
        const bool has_next = S.next(ui + 1, nxt);
        const char* nA = has_next ? pr.abase1(nxt) : cA1; const char* nB = has_next ? pr.bbase1(nxt) : cB1;
        for (int t = 0; t < nt; t += 2) {
            const bool last = (t == nt - 2);
            const bool s1 = (t + 1 < nt1), s2 = last || (t + 2 < nt1);
            const char* a1 = T_A(t + 1);
            const char* a2 = last ? nA : T_A(t + 2); const char* b2 = last ? nB : T_B(t + 2);
            const char* a3 = a2 + kstep; const char* b3 = b2 + kstep;
            const size_t hstepB = s2 ? hB1 : hB2; const int ldaT1 = s1 ? pr.lda1 : pr.lda2, ldaT2 = s2 ? pr.lda1 : pr.lda2, ldbT2 = s2 ? pr.ldb1 : pr.ldb2;
            unsigned v2[2][2], voffB[2], vA1s[2];
#pragma unroll
            for (int i = 0; i < 2; ++i) { voffB[i] = OFF_B(ldbT2, i); vA1s[i] = OFF_A(ldaT1, 1, i);
#pragma unroll
                for (int h = 0; h < 2; ++h) v2[h][i] = OFF_A(ldaT2, h, i); }
            PG8_LDB(B0, 0, 0); PG8_SCHED; PG8_LDA(At, 0, 0); PG8_STAGE(PG8_SA(1, 1), a1, vA1s);
            PG8_WAIT_L(8); PG8_BAR; PG8_WAIT_L(0); PG8_MMA(0, 0, At, B0); PG8_BAR; PG8_SCHED;
            PG8_LDB(B1, 0, 1); PG8_STAGE(PG8_SB(0, 0), b2, voffB);
            PG8_BAR; PG8_WAIT_L(0); PG8_MMA(0, 1, At, B1); PG8_BAR;
            PG8_LDA(At, 0, 1); PG8_STAGE(PG8_SA(0, 0), a2, v2[0]);
            PG8_BAR; PG8_WAIT_L(0); PG8_MMA(1, 0, At, B0); PG8_BAR; PG8_SCHED;
            PG8_STAGE(PG8_SB(0, 1), b2 + hstepB, voffB);
            PG8_WAIT_V(6); PG8_BAR; PG8_MMA(1, 1, At, B1); PG8_BAR;
            PG8_LDB(B0, 1, 0); PG8_SCHED; PG8_LDA(At, 1, 0); PG8_STAGE(PG8_SA(0, 1), a2, v2[1]);
            PG8_WAIT_L(8); PG8_BAR; PG8_WAIT_L(0); PG8_MMA(0, 0, At, B0); PG8_BAR; PG8_SCHED;
            PG8_LDB(B1, 1, 1); PG8_STAGE(PG8_SB(1, 0), b3, voffB);
            PG8_BAR; PG8_WAIT_L(0); PG8_MMA(0, 1, At, B1); PG8_BAR;
            PG8_LDA(At, 1, 1); PG8_STAGE(PG8_SA(1, 0), a3, v2[0]);
            PG8_BAR; PG8_WAIT_L(0); PG8_MMA(1, 0, At, B0); PG8_BAR; PG8_SCHED;
            PG8_STAGE(PG8_SB(1, 1), b3 + hstepB, voffB);
            PG8_WAIT_V(6); PG8_BAR; PG8_MMA(1, 1, At, B1); PG8_BAR;
            if (t == nt1 - 2) E.mid(acc, cur, wr, wc, fr, fq);
        }
        E(acc, cur, wr, wc, fr, fq);
        if (!has_next) break;
#pragma unroll
        for (int a = 0; a < 2; ++a)
#pragma unroll
            for (int b = 0; b < 2; ++b)
#pragma unroll
                for (int m = 0; m < 4; ++m)
#pragma unroll
                    for (int n = 0; n < 2; ++n) acc[a][b][m][n] = (f32x4){0.f, 0.f, 0.f, 0.f};
        cur = nxt; cA1 = nA; cB1 = nB; cA2 = pr.abase2(cur); cB2 = pr.bbase2(cur); ++ui;
    }
    PG8_WAIT_V(0);
    if (wr == 0) PG8_BAR;
    PG8_BAR;
#undef T_A
#undef T_B
#undef OFF_A
#undef OFF_B
#undef PG8_SA
#undef PG8_SB
#undef PG8_STAGE
#undef PG8_LDA
#undef PG8_LDB
#undef PG8_MMA
#undef PG8_WAIT_V
#undef PG8_WAIT_L
#undef PG8_BAR
#undef PG8_SCHED
}
}
using pg8::Unit;

struct ProbPlain {
    static constexpr bool GATHER = false;
    const bf16_t* A; const bf16_t* B; int K, lda, ldb;
    __device__ __forceinline__ const char* abase(const Unit& u) const { return (const char*)(A + (size_t)u.pm * 256 * lda); }
    __device__ __forceinline__ const char* bbase(const Unit& u) const { return (const char*)(B + (size_t)u.pn * 256 * ldb); }
    __device__ __forceinline__ void avoff(const Unit&, const int (&RA)[2], const int (&CA)[2], unsigned (&v)[2][2]) const {
#pragma unroll
        for (int h = 0; h < 2; ++h)
#pragma unroll
            for (int i = 0; i < 2; ++i) v[h][i] = (unsigned)((h * 128 + RA[i]) * lda + CA[i]) * 2u;
    }
};
struct ProbMerge {
    const bf16_t* A1; const bf16_t* B1; const bf16_t* A2; const bf16_t* B2; int K1, K2, lda1, ldb1, lda2, ldb2;
    __device__ __forceinline__ const char* abase1(const Unit& u) const { return (const char*)(A1 + (size_t)u.pm * 256 * lda1); }
    __device__ __forceinline__ const char* bbase1(const Unit& u) const { return (const char*)(B1 + (size_t)u.pn * 256 * ldb1); }
    __device__ __forceinline__ const char* abase2(const Unit& u) const { return (const char*)(A2 + (size_t)u.pm * 256 * lda2); }
    __device__ __forceinline__ const char* bbase2(const Unit& u) const { return (const char*)(B2 + (size_t)u.pn * 256 * ldb2); }
};
struct ProbPQ {
    static constexpr bool GATHER = false;
    const bf16_t* A; const bf16_t* B; int K, lda, ldb;
    __device__ __forceinline__ const char* abase(const Unit& u) const { return (const char*)(A + (size_t)u.pm * 256 * lda); }
    __device__ __forceinline__ const char* bbase(const Unit& u) const { return (const char*)(B + ((size_t)(u.pn >> 4) * 4096 + (u.pn & 15)) * 1024); }
    __device__ __forceinline__ void avoff(const Unit&, const int (&RA)[2], const int (&CA)[2], unsigned (&v)[2][2]) const {
#pragma unroll
        for (int h = 0; h < 2; ++h)
#pragma unroll
            for (int i = 0; i < 2; ++i) v[h][i] = (unsigned)((h * 128 + RA[i]) * lda + CA[i]) * 2u;
    }
};
struct ProbMoeUp {
    static constexpr bool GATHER = true;
    const bf16_t* A; const bf16_t* B; const int* idx; int K, lda, ldb;
    __device__ __forceinline__ const char* abase(const Unit&) const { return (const char*)A; }
    __device__ __forceinline__ const char* bbase(const Unit& u) const { return (const char*)(B + ((size_t)(u.pm >> 4) * 3072 + (size_t)u.pn * 256) * ldb); }
    __device__ __forceinline__ void avoff(const Unit& u, const int (&RA)[2], const int (&CA)[2], unsigned (&v)[2][2]) const {
#pragma unroll
        for (int h = 0; h < 2; ++h)
#pragma unroll
            for (int i = 0; i < 2; ++i) { const int g = idx[u.pm * 256 + h * 128 + RA[i]]; v[h][i] = (unsigned)(g * lda + CA[i]) * 2u; }
    }
};
struct ProbMoeDown {
    static constexpr bool GATHER = false;
    const bf16_t* A; const bf16_t* B; int K, lda, ldb;
    __device__ __forceinline__ const char* abase(const Unit& u) const { return (const char*)(A + (size_t)u.pm * 256 * lda); }
    __device__ __forceinline__ const char* bbase(const Unit& u) const { return (const char*)(B + ((size_t)(u.pm >> 4) * 1024 + (size_t)u.pn * 256) * ldb); }
    __device__ __forceinline__ void avoff(const Unit&, const int (&RA)[2], const int (&CA)[2], unsigned (&v)[2][2]) const {
#pragma unroll
        for (int h = 0; h < 2; ++h)
#pragma unroll
            for (int i = 0; i < 2; ++i) v[h][i] = (unsigned)((h * 128 + RA[i]) * lda + CA[i]) * 2u;
    }
};

#define EPI_ROWS(...) _Pragma("unroll") for (int ai = 0; ai < 2; ++ai) _Pragma("unroll") for (int m = 0; m < 4; ++m) { const int row = u.pm * 256 + ai * 128 + wr * 64 + m * 16 + fr; __VA_ARGS__ }
__device__ __forceinline__ u32x4 pack8(const f32x4 v0, const f32x4 v1) { u32x4 w; w.x = cvt_pk_bf16(v0[0], v0[1]); w.y = cvt_pk_bf16(v0[2], v0[3]); w.z = cvt_pk_bf16(v1[0], v1[1]); w.w = cvt_pk_bf16(v1[2], v1[3]); return w; }

struct EpiPQ {
    static constexpr bool PERM = true; bf16_t* O;
    __device__ __forceinline__ void operator()(const f32x4 (&acc)[2][2][4][2], const Unit& u, int wr, int wc, int fr, int fq) const {
        const int t10 = wc * 32 + 8 * fq, b = u.pn >> 4, t2 = u.pn & 15;
        EPI_ROWS(
            bf16_t* rp = O + ((size_t)((b * 512 + (row >> 1)) * 16 + t2) * 512 + (row & 1) * 256 + t10);
            _Pragma("unroll") for (int bj = 0; bj < 2; ++bj) *(u32x4*)(rp + bj * 128) = pack8(acc[ai][bj][m][0], acc[ai][bj][m][1]);
        )
    }
};
struct EpiPlain {
    static constexpr bool PERM = true; bf16_t* O; size_t ldc;
    __device__ __forceinline__ void operator()(const f32x4 (&acc)[2][2][4][2], const Unit& u, int wr, int wc, int fr, int fq) const {
        const int col0 = u.pn * 256 + wc * 32 + 8 * fq;
        EPI_ROWS(
            bf16_t* rp = O + (size_t)row * ldc + col0;
            _Pragma("unroll") for (int bj = 0; bj < 2; ++bj) *(u32x4*)(rp + bj * 128) = pack8(acc[ai][bj][m][0], acc[ai][bj][m][1]);
        )
    }
};
struct EpiZ {
    static constexpr bool PERM = true; bf16_t* O; int ldc; int fixed_act;
    __device__ __forceinline__ void operator()(const f32x4 (&acc)[2][2][4][2], const Unit& u, int wr, int wc, int fr, int fq) const {
        const int col0 = u.pn * 256 + wc * 32 + 8 * fq; const int act = fixed_act >= 0 ? fixed_act : (u.pn >> 2);
        EPI_ROWS(
            bf16_t* rp = O + (size_t)row * ldc + col0;
            _Pragma("unroll") for (int bj = 0; bj < 2; ++bj) {
                f32x4 v0 = acc[ai][bj][m][0], v1 = acc[ai][bj][m][1];
                if (act == 1) { _Pragma("unroll") for (int j = 0; j < 4; ++j) { v0[j] = gelu_tanh(v0[j]); v1[j] = gelu_tanh(v1[j]); } }
                else if (act >= 2) { _Pragma("unroll") for (int j = 0; j < 4; ++j) { v0[j] = sigmoidf_(v0[j]); v1[j] = sigmoidf_(v1[j]); } }
                *(u32x4*)(rp + bj * 128) = pack8(v0, v1); }
        )
    }
};
struct EpiMerge {
    static constexpr bool PERM = true; bf16_t* O; const bf16_t* Z;
    __device__ __forceinline__ void mid(f32x4 (&acc)[2][2][4][2], const Unit& u, int wr, int wc, int fr, int fq) const {
        unsigned eo = (unsigned)((u.pm * 256 + wr * 64 + fr) * 4096 + 2048 + u.pn * 256 + wc * 32 + 8 * fq);
        asm volatile("" : "+v"(eo));
#pragma unroll
        for (int ai = 0; ai < 2; ++ai) {
            u32x4 wa[4][2], wb[4][2];
#pragma unroll
            for (int m = 0; m < 4; ++m)
#pragma unroll
                for (int bj = 0; bj < 2; ++bj) { const unsigned o = eo + (unsigned)((ai * 128 + m * 16) * 4096 + bj * 128); wa[m][bj] = __builtin_nontemporal_load((const u32x4*)(Z + o)); wb[m][bj] = *(const u32x4*)(Z + o + 1024); }
#pragma unroll
            for (int m = 0; m < 4; ++m)
#pragma unroll
                for (int bj = 0; bj < 2; ++bj) { float ga[8], gb[8]; unpack8(wa[m][bj], ga); unpack8(wb[m][bj], gb);
#pragma unroll
                    for (int j = 0; j < 4; ++j) { acc[ai][bj][m][0][j] *= ga[j] * __builtin_amdgcn_rcpf(fmaxf(gb[j], 1e-30f)); acc[ai][bj][m][1][j] *= ga[4 + j] * __builtin_amdgcn_rcpf(fmaxf(gb[4 + j], 1e-30f)); } }
            __builtin_amdgcn_sched_barrier(0); }
    }
    __device__ __forceinline__ void operator()(const f32x4 (&acc)[2][2][4][2], const Unit& u, int wr, int wc, int fr, int fq) const {
        unsigned eo = (unsigned)((u.pm * 256 + wr * 64 + fr) * 4096 + 3072 + u.pn * 256 + wc * 32 + 8 * fq); asm volatile("" : "+v"(eo));
        unsigned oo = (unsigned)((u.pm * 256 + wr * 64 + fr) * 1024 + u.pn * 256 + wc * 32 + 8 * fq); asm volatile("" : "+v"(oo));
        u32x4 wb[2][4][2];
#pragma unroll
        for (int ai = 0; ai < 2; ++ai)
#pragma unroll
            for (int m = 0; m < 4; ++m)
#pragma unroll
                for (int bj = 0; bj < 2; ++bj) wb[ai][m][bj] = __builtin_nontemporal_load((const u32x4*)(Z + eo + (unsigned)((ai * 128 + m * 16) * 4096 + bj * 128)));
#pragma unroll
        for (int ai = 0; ai < 2; ++ai)
#pragma unroll
            for (int m = 0; m < 4; ++m)
#pragma unroll
                for (int bj = 0; bj < 2; ++bj) { float g[8]; unpack8(wb[ai][m][bj], g);
                    f32x4 v0 = acc[ai][bj][m][0], v1 = acc[ai][bj][m][1];
#pragma unroll
                    for (int j = 0; j < 4; ++j) { v0[j] *= g[j]; v1[j] *= g[4 + j]; }
                    *(u32x4*)(O + oo + (unsigned)((ai * 128 + m * 16) * 1024 + bj * 128)) = pack8(v0, v1); }
    }
};
struct EpiOut {
    static constexpr bool PERM = true; bf16_t* O; const float* X; const float* pos; const float* ada;
    __device__ __forceinline__ void operator()(const f32x4 (&acc)[2][2][4][2], const Unit& u, int wr, int wc, int fr, int fq) const {
        const int col0 = u.pn * 256 + wc * 32 + 8 * fq; const int b = u.pm >> 4;
        unsigned ro = (unsigned)((u.pm * 256 + wr * 64 + fr) * 1024 + col0); asm volatile("" : "+v"(ro));
#pragma unroll
        for (int ai = 0; ai < 2; ++ai)
#pragma unroll
            for (int mh = 0; mh < 2; ++mh) {
                f32x4 xv[2][2][2];
#pragma unroll
                for (int m2 = 0; m2 < 2; ++m2)
#pragma unroll
                    for (int bj = 0; bj < 2; ++bj)
#pragma unroll
                        for (int n = 0; n < 2; ++n) xv[m2][bj][n] = __builtin_nontemporal_load((const f32x4*)(X + ro + (unsigned)((ai * 128 + (mh * 2 + m2) * 16) * 1024 + bj * 128 + n * 4)));
#pragma unroll
                for (int m2 = 0; m2 < 2; ++m2) { const int m = mh * 2 + m2; const int row = u.pm * 256 + ai * 128 + wr * 64 + m * 16 + fr; const int t = row & 4095;
#pragma unroll
                    for (int bj = 0; bj < 2; ++bj) { f32x4 o[2];
#pragma unroll
                        for (int n = 0; n < 2; ++n) { const int col = col0 + bj * 128 + n * 4;
                            const f32x4 pv = *(const f32x4*)(pos + (col < 512 ? (t >> 6) * 512 + col : (t & 63) * 512 + (col - 512)));
                            const f32x4 gv = *(const f32x4*)(ada + b * 6144 + 2048 + col);
                            o[n] = xv[m2][bj][n] + pv + gv * acc[ai][bj][m][n]; }
                        *(u32x4*)(O + ro + (unsigned)((ai * 128 + m * 16) * 1024 + bj * 128)) = pack8(o[0], o[1]); } }
                __builtin_amdgcn_sched_barrier(0); }
    }
};
struct EpiGU {
    static constexpr bool PERM = true; bf16_t* O;
    __device__ __forceinline__ void operator()(const f32x4 (&acc)[2][2][4][2], const Unit& u, int wr, int wc, int fr, int fq) const {
        const int col0 = u.pn * 128 + wc * 32 + 8 * fq;
        EPI_ROWS(
            f32x4 v0, v1;
            _Pragma("unroll") for (int j = 0; j < 4; ++j) { const float g0 = acc[ai][0][m][0][j], g1 = acc[ai][0][m][1][j];
                v0[j] = g0 * sigmoidf_(g0) * acc[ai][1][m][0][j]; v1[j] = g1 * sigmoidf_(g1) * acc[ai][1][m][1][j]; }
            *(u32x4*)(O + (size_t)row * DE + col0) = pack8(v0, v1);
        )
    }
};
struct EpiDown {
    static constexpr bool PERM = true; bf16_t* O; const float* gate;
    __device__ __forceinline__ void operator()(const f32x4 (&acc)[2][2][4][2], const Unit& u, int wr, int wc, int fr, int fq) const {
        const int col0 = u.pn * 256 + wc * 32 + 8 * fq;
        EPI_ROWS(
            const float g = gate[row];
            _Pragma("unroll") for (int bj = 0; bj < 2; ++bj) *(u32x4*)(O + (size_t)row * 1024 + col0 + bj * 128) = pack8(acc[ai][bj][m][0] * g, acc[ai][bj][m][1] * g);
        )
    }
};

__device__ __forceinline__ void p0_ada(const Params& p, LAS unsigned char* lds, int item) {
    const int tid = threadIdx.x, lane = tid & 63, wv = tid >> 6;
    LAS float* s = (LAS float*)lds; LAS float* red = s + 9 * 1024;
    { float cv[18];
#pragma unroll
      for (int k = 0; k < 18; ++k) { const int i = tid + NTHR * k, r = i >> 10, d = i & 1023; cv[k] = r < 8 ? p.c[r * 1024 + d] : p.c_ctx[d]; }
#pragma unroll
      for (int k = 0; k < 18; ++k) s[tid + NTHR * k] = cv[k] * __builtin_amdgcn_rcpf(1.0f + __expf(-cv[k])); }
    __syncthreads();
    const int col = lane % 24, dh = lane / 24;
    const int dsl = wv * 128 + dh * 64;
    float a[9];
#pragma unroll
    for (int r = 0; r < 9; ++r) a[r] = 0.f;
    if (dh < 2) {
        const float* w = p.w_ada + (size_t)dsl * 6144 + item * 24 + col;
        for (int d0 = 0; d0 < 64; d0 += 32) { float wv2[32];
#pragma unroll
            for (int j = 0; j < 32; ++j) wv2[j] = __builtin_nontemporal_load(w + (size_t)(d0 + j) * 6144);
#pragma unroll
            for (int j = 0; j < 32; ++j)
#pragma unroll
                for (int r = 0; r < 9; ++r) a[r] += s[r * 1024 + dsl + d0 + j] * wv2[j]; }
#pragma unroll
        for (int r = 0; r < 9; ++r) red[((wv * 2 + dh) * 9 + r) * 24 + col] = a[r];
    }
    __syncthreads();
    float* ada = (float*)(p.ws + WS_ADA);
    if (tid < 9 * 24) { const int r = tid / 24, cc = tid % 24; float v = 0.f;
#pragma unroll
        for (int k = 0; k < 16; ++k) v += red[(k * 9 + r) * 24 + cc];
        __hip_atomic_store(ada + r * 6144 + item * 24 + cc, v + p.b_ada[item * 24 + cc], __ATOMIC_RELAXED, __HIP_MEMORY_SCOPE_AGENT); }
    asm volatile("s_waitcnt vmcnt(0)" ::: "memory");
    __syncthreads();
    if (tid == 0) (void)__hip_atomic_fetch_add((unsigned*)(p.ws + WS_BAR + 46 * KiB), 1u, __ATOMIC_RELAXED, __HIP_MEMORY_SCOPE_AGENT);
}
template <int NS>
__device__ __forceinline__ void xpose_item(const float* src, int ldsrc, bf16_t* dst, int lddst, int k0, int n0, int mode, float scale = 1.0f) {
    const int tid = threadIdx.x, k8 = tid & 7, nq = tid >> 3;
    if (nq >= 16 * NS) return;
    f32x4 v[8];
#pragma unroll
    for (int j = 0; j < 8; ++j) v[j] = __builtin_nontemporal_load((const f32x4*)(src + (size_t)(k0 + 8 * k8 + j) * ldsrc + n0 + 4 * nq));
#pragma unroll
    for (int c = 0; c < 4; ++c) { const int n = n0 + 4 * nq + c; int row = n;
        if (mode) row = (n >> 7) * 256 + (n & 127) + (mode == 2 ? 128 : 0);
        u32x4 w; w.x = cvt_pk_bf16(v[0][c] * scale, v[1][c] * scale); w.y = cvt_pk_bf16(v[2][c] * scale, v[3][c] * scale); w.z = cvt_pk_bf16(v[4][c] * scale, v[5][c] * scale); w.w = cvt_pk_bf16(v[6][c] * scale, v[7][c] * scale);
        *(u32x4*)(dst + (size_t)row * lddst + k0 + 8 * k8) = w; }
}
__device__ __forceinline__ void p0_wpq(const Params& p, LAS unsigned char* lds, int item) {
    const int tid = threadIdx.x, g = item >> 6, db = item & 63;
    LAS float* wl = (LAS float*)lds; LAS float* ct = wl + 16 * 129;
    for (int i = tid; i < 16 * 128; i += NTHR) { const int d = i >> 7, cc = i & 127; wl[d * 129 + cc] = p.w_in[(size_t)(db * 16 + d) * 4608 + g * 128 + cc]; }
    if (tid < 128) { float sn, cs; sincospif((float)tid * (1.0f / 64.0f), &sn, &cs); ct[tid] = cs; ct[128 + tid] = sn; }
    __syncthreads();
    const int q = tid & 255, kc = q >> 1, pq = q & 1, dh = tid >> 8; const int n = (g * 128 + kc) * 2 + pq;
    bf16_t* dst = (bf16_t*)(p.ws + WS_WPQ) + (size_t)n * 1024 + db * 16 + dh * 8;
    const float scale = 0.001381067932f;
    float a[8];
#pragma unroll
    for (int j = 0; j < 8; ++j) a[j] = 0.f;
    for (int cc = 0; cc < 128; ++cc) { const float tv = ct[pq * 128 + ((cc * kc) & 127)];
#pragma unroll
        for (int j = 0; j < 8; ++j) a[j] += wl[(dh * 8 + j) * 129 + cc] * tv; }
    u32x4 w; w.x = cvt_pk_bf16(a[0] * scale, a[1] * scale); w.y = cvt_pk_bf16(a[2] * scale, a[3] * scale); w.z = cvt_pk_bf16(a[4] * scale, a[5] * scale); w.w = cvt_pk_bf16(a[6] * scale, a[7] * scale);
    *(u32x4*)dst = w;
    __syncthreads();
}
__device__ __forceinline__ void p0_d1t(const Params& p, int item) {
    bf16_t* dst = (bf16_t*)(p.ws + WS_D1T);
    const int row = item * 64 + (threadIdx.x >> 3), k1 = row >> 1, ri = row & 1, c0 = (threadIdx.x & 7) * 64;
    for (int c8 = 0; c8 < 64; c8 += 8) { float v[8];
#pragma unroll
        for (int j = 0; j < 8; ++j) { const int col = c0 + c8 + j, pq = col >> 8, t1 = col & 255; float sn, cs; sincospif((float)((k1 * t1) & 255) * (1.0f / 128.0f), &sn, &cs);
            v[j] = (ri == 0) ? (pq == 0 ? cs : -sn) : (pq == 0 ? -sn : -cs); }
        u32x4 w; w.x = cvt_pk_bf16(v[0], v[1]); w.y = cvt_pk_bf16(v[2], v[3]); w.z = cvt_pk_bf16(v[4], v[5]); w.w = cvt_pk_bf16(v[6], v[7]);
        *(u32x4*)(dst + (size_t)row * 512 + c0 + c8) = w; }
}
__device__ __forceinline__ void p0_d2t(const Params& p, int item) {
    bf16_t* dst = (bf16_t*)(p.ws + WS_D2T);
#pragma unroll
    for (int ps = 0; ps < 4; ++ps) { const int pc = (item * 4 + ps) * NTHR + threadIdx.x, tp = pc >> 2, kk0 = (pc & 3) * 8; float v[8];
#pragma unroll
        for (int j = 0; j < 8; ++j) { const int kk = kk0 + j, ri = kk >> 4, t2 = kk & 15; float sn, cs; sincospif((float)((tp * t2) & 4095) * (1.0f / 2048.0f), &sn, &cs); v[j] = ri ? sn : cs; }
        u32x4 w; w.x = cvt_pk_bf16(v[0], v[1]); w.y = cvt_pk_bf16(v[2], v[3]); w.z = cvt_pk_bf16(v[4], v[5]); w.w = cvt_pk_bf16(v[6], v[7]);
        *(u32x4*)(dst + (size_t)tp * 32 + kk0) = w; }
}
__device__ __forceinline__ void p0_pos(const Params& p, int item) {
    float* tab = (float*)(p.ws + WS_POS);
    for (int i = item * 2048 + threadIdx.x; i < (item + 1) * 2048; i += NTHR) { const int ii = i >> 9, j = i & 511, jj = j & 255; const float f = expf(-9.210340371976184f * (float)jj / 256.0f); const float a = (float)ii * f;
        __hip_atomic_store(tab + i, j < 256 ? sinf(a) : cosf(a), __ATOMIC_RELAXED, __HIP_MEMORY_SCOPE_AGENT); }
    asm volatile("s_waitcnt vmcnt(0)" ::: "memory");
    __syncthreads();
    if (threadIdx.x == 0) (void)__hip_atomic_fetch_add((unsigned*)(p.ws + WS_BAR + 46 * KiB), 1u, __ATOMIC_RELAXED, __HIP_MEMORY_SCOPE_AGENT);
}
__device__ __forceinline__ void phase0(const Params& p, LAS unsigned char* lds) {
    constexpr int N_ADA = 256, N_WIN = 16 * 16, N_WFOUR = 8 * 4, N_SQ = 16 * 4, N_LRU = 16 * 2, N_WPQ = 256, N_DFT = 8 + 8, N_POS = 16;
    constexpr int O1 = N_ADA, O2 = O1 + N_WIN, O3 = O2 + N_WFOUR, O4 = O3 + N_SQ, O5 = O4 + N_SQ, O6 = O5 + N_LRU, O7 = O6 + N_LRU, O8 = O7 + N_WPQ, O9 = O8 + N_DFT, O10 = O9 + N_POS;
    for (int it0 = blockIdx.x; it0 < O10; it0 += gridDim.x) {
        if (it0 < O1) { p0_ada(p, lds, it0); continue; }
        if (it0 < O1 + N_POS) { p0_pos(p, it0 - O1); continue; }
        const int it = it0 - N_POS;
        if (it < O2) { const int j = it - O1; xpose_item<4>(p.w_in + 512, 4608, (bf16_t*)(p.ws + WS_WIN), 1024, (j >> 4) * 64, (j & 15) * 256, 0); }
        else if (it < O3) { const int j = it - O2; xpose_item<4>(p.w_four, 1024, (bf16_t*)(p.ws + WS_WFOUR), 512, (j >> 2) * 64, (j & 3) * 256, 0); }
        else if (it < O4) { const int j = it - O3; xpose_item<4>(p.w_lru, 1024, (bf16_t*)(p.ws + WS_WLRU), 1024, (j >> 2) * 64, (j & 3) * 256, 0); }
        else if (it < O5) { const int j = it - O4; xpose_item<4>(p.w_out, 1024, (bf16_t*)(p.ws + WS_WOUT), 1024, (j >> 2) * 64, (j & 3) * 256, 0); }
        else if (it < O6) { const int j = it - O5, mtx = j >> 1; xpose_item<2>(p.lru_wa + (size_t)mtx * 16384, 128, (bf16_t*)(p.ws + WS_WAT) + (size_t)mtx * 16384, 128, (j & 1) * 64, 0, 0, NLOG2E); }
        else if (it < O7) { const int j = it - O6, mtx = j >> 1; xpose_item<2>(p.lru_wi + (size_t)mtx * 16384, 128, (bf16_t*)(p.ws + WS_WIT) + (size_t)mtx * 16384, 128, (j & 1) * 64, 0, 0, NLOG2E); }
        else if (it < O8) p0_wpq(p, lds, it - O7);
        else { if (it - O8 < 8) p0_d1t(p, it - O8); else p0_d2t(p, it - O8 - 8); }
    }
}

__device__ __forceinline__ void phase1(const Params& p) {
    const int tid = tid_opaque(), lane = tid & 63, wid = tid >> 6;
    const float* ada = (const float*)(p.ws + WS_ADA); const float* tab = (const float*)(p.ws + WS_POS);
    bf16_t* h1 = (bf16_t*)(p.ws + WS_R1); bf16_t* hc = (bf16_t*)(p.ws + WS_HCTX);
    constexpr int NR = MLAT + MCTX, RW = 4;
    for (int row0 = (blockIdx.x * 8 + wid) * RW; row0 < NR; row0 += gridDim.x * 8 * RW) {
        const bool lat = row0 < MLAT; const int mrow = lat ? (row0 >> 12) : 8;
        f32x4 v[RW][4]; float ss[RW];
#pragma unroll
        for (int r = 0; r < RW; ++r) { const int row = row0 + r; const float* xr = lat ? p.x + (size_t)row * 1024 : p.ctx + (size_t)(row - MLAT) * 1024;
#pragma unroll
            for (int i = 0; i < 4; ++i) v[r][i] = __builtin_nontemporal_load((const f32x4*)(xr + 256 * i + 4 * lane)); }
#pragma unroll
        for (int r = 0; r < RW; ++r) { const int t = (row0 + r) & 4095; float a = 0.f;
#pragma unroll
            for (int i = 0; i < 4; ++i) { const int d = 256 * i + 4 * lane;
                if (lat) v[r][i] += *(const f32x4*)(tab + (i < 2 ? (t >> 6) * 512 + d : (t & 63) * 512 + d - 512));
                a += v[r][i][0] * v[r][i][0] + v[r][i][1] * v[r][i][1] + v[r][i][2] * v[r][i][2] + v[r][i][3] * v[r][i][3]; }
            ss[r] = a; }
#pragma unroll
        for (int o = 32; o >= 1; o >>= 1) {
#pragma unroll
            for (int r = 0; r < RW; ++r) ss[r] += __shfl_xor(ss[r], o); }
#pragma unroll
        for (int i = 0; i < 4; ++i) { const int d = 256 * i + 4 * lane;
            const f32x4 g = *(const f32x4*)(p.norm1_g + d), sh = *(const f32x4*)(ada + mrow * 6144 + d), sc = *(const f32x4*)(ada + mrow * 6144 + 1024 + d);
#pragma unroll
            for (int r = 0; r < RW; ++r) { const int row = row0 + r; const float rs = rsqrtf(ss[r] * (1.0f / 1024.0f) + 1e-6f);
                bf16_t* dst = lat ? h1 + (size_t)row * 1024 : hc + (size_t)(row - MLAT) * 1024;
                const f32x4 h = v[r][i] * rs * g * (sc + 1.0f) + sh;
                u32x2 w; w.x = cvt_pk_bf16(h[0], h[1]); w.y = cvt_pk_bf16(h[2], h[3]); *(u32x2*)(dst + d) = w; } }
    }
}

#define LRU_CST(mb, r) (32 * (mb) + 8 * ((r) >> 2) + ((r) & 3))
template <bool FINAL, int DIR>
__device__ __forceinline__ void lru_wave(const Params& p, LAS unsigned char* ul, int b, int sc, int head, int cb, int lane, f32x16 (&accI)[4]) {
    constexpr int SG = DIR ? -1 : 1;
    const int lr = lane & 31, lh = lane >> 5;
    const int chl = cb * 32 + lr, ch = head * 128 + chl;
    const int tbase = DIR ? 127 - 4 * lh : 4 * lh;
    f32x16 accA[4];
#pragma unroll
    for (int mb = 0; mb < 4; ++mb)
#pragma unroll
        for (int r = 0; r < 16; ++r) { accA[mb][r] = 0.f; accI[mb][r] = 0.f; }
    {
        const bf16_t* wa = (const bf16_t*)(p.ws + WS_WAT) + ((size_t)(DIR * 8 + head) * 128 + chl) * 128 + 8 * lh;
        const bf16_t* wi = (const bf16_t*)(p.ws + WS_WIT) + ((size_t)(DIR * 8 + head) * 128 + chl) * 128 + 8 * lh;
        LAS unsigned char* arow0 = ul + (DIR ? 127 - lr : lr) * 272 + lh * 16;
#pragma unroll
        for (int kc = 0; kc < 2; ++kc) { bf16x8 bA[4], bI[4];
#pragma unroll
            for (int k4 = 0; k4 < 4; ++k4) { bA[k4] = *(const bf16x8*)(wa + 16 * (kc * 4 + k4)); bI[k4] = *(const bf16x8*)(wi + 16 * (kc * 4 + k4)); }
#pragma unroll
            for (int mb = 0; mb < 4; ++mb)
#pragma unroll
                for (int k4 = 0; k4 < 4; ++k4) { const bf16x8 af = *(const LAS bf16x8*)(arow0 + SG * 32 * mb * 272 + 32 * (kc * 4 + k4));
                    accA[mb] = __builtin_amdgcn_mfma_f32_32x32x16_bf16(af, bA[k4], accA[mb], 0, 0, 0);
                    accI[mb] = __builtin_amdgcn_mfma_f32_32x32x16_bf16(af, bI[k4], accI[mb], 0, 0, 0); }
            __builtin_amdgcn_sched_barrier(0); }
    }
    {
        const float lam = p.lru_lambda[DIR * 1024 + ch]; const float sp8 = 8.0f * log1pf(expf(-lam));
        const float ba = p.lru_ba[DIR * 1024 + ch], bi = p.lru_bi[DIR * 1024 + ch];
        LAS unsigned char* up = ul + tbase * 272 + chl * 2;
#pragma unroll
        for (int mb = 0; mb < 4; ++mb) {
#pragma unroll
            for (int r = 0; r < 16; ++r) {
                const float uv = bf2f(*(const LAS bf16_t*)(up + SG * LRU_CST(mb, r) * 272));
                const float rg = __builtin_amdgcn_rcpf(1.0f + __builtin_amdgcn_exp2f(accA[mb][r] + NLOG2E * ba)), ig = __builtin_amdgcn_rcpf(1.0f + __builtin_amdgcn_exp2f(accI[mb][r] + NLOG2E * bi));
                const float a = __expf(-sp8 * rg); accA[mb][r] = a; accI[mb][r] = __builtin_amdgcn_sqrtf(fmaxf(1.0f - a * a, 0.f)) * ig * uv; }
            __builtin_amdgcn_sched_barrier(0); }
    }
    float rA[16], rH[16];
#pragma unroll
    for (int mb = 0; mb < 4; ++mb)
#pragma unroll
        for (int q = 0; q < 4; ++q) { float pa = 1.f, hh = 0.f;
#pragma unroll
            for (int j = 0; j < 4; ++j) { const int r = 4 * q + j; const float a = accA[mb][r], bb = accI[mb][r]; hh = a * hh + bb; pa *= a; accA[mb][r] = pa; accI[mb][r] = hh; }
            rA[mb * 4 + q] = pa; rH[mb * 4 + q] = hh; }
    const int agg_dir_off = ((b * NSEQ) * 2 + DIR) * 1024 + ch;
    const float* agg = (const float*)(p.ws + WS_AGG);
    float carry = 0.f;
    if (FINAL) {
        if (DIR == 0) { for (int q = 0; q < sc; ++q) { const float* a2 = agg + (size_t)(agg_dir_off + q * 2048) * 2; carry = a2[0] * carry + a2[1]; } }
        else { { const float* a2 = agg + (size_t)(agg_dir_off + 1 * 2048) * 2; carry = a2[0] * carry + a2[1]; } { const float* a2 = agg + (size_t)(agg_dir_off + 0 * 2048) * 2; carry = a2[0] * carry + a2[1]; }
            for (int q = NSEQ - 1; q > sc; --q) { const float* a2 = agg + (size_t)(agg_dir_off + q * 2048) * 2; carry = a2[0] * carry + a2[1]; } }
    }
    float cin[16];
#pragma unroll
    for (int i = 0; i < 16; ++i) cin[i] = 0.f;
    float s = carry, At = 1.f;
#pragma unroll
    for (int i = 0; i < 16; ++i) { const float oA = __shfl_xor(rA[i], 32), oH = __shfl_xor(rH[i], 32);
        { const bool mine = (lh == 0); const float a = mine ? rA[i] : oA, hh = mine ? rH[i] : oH; cin[i] = mine ? s : cin[i]; s = a * s + hh; At *= a; }
        { const bool mine = (lh == 1); const float a = mine ? rA[i] : oA, hh = mine ? rH[i] : oH; cin[i] = mine ? s : cin[i]; s = a * s + hh; At *= a; } }
    if (!FINAL) {
        if (lh == 0) { float* o = (float*)(p.ws + WS_AGG) + (size_t)(agg_dir_off + sc * 2048) * 2; o[0] = At; o[1] = s; }
        return;
    }
#pragma unroll
    for (int mb = 0; mb < 4; ++mb)
#pragma unroll
        for (int r = 0; r < 16; ++r) accI[mb][r] += accA[mb][r] * cin[mb * 4 + (r >> 2)];
}
template <bool FINAL>
__device__ __forceinline__ void lru_tile(const Params& p, LAS unsigned char* lds, int item) {
    const int tid = threadIdx.x, lane = tid & 63, wid = __builtin_amdgcn_readfirstlane(tid >> 6);
    int b, sc, head;
    if (FINAL) { head = item & 7; sc = 2 + ((item >> 3) & 31); b = item >> 8; }
    else { head = item & 7; const int r = item >> 3; sc = r & 1; b = r >> 1; }
    const bf16_t* src; int Tseq, t0, ld;
    if (sc < 2) { src = (const bf16_t*)(p.ws + WS_ZXC) + (size_t)b * 256 * 1024; Tseq = 256; t0 = sc * 128; ld = 1024; }
    else { src = (const bf16_t*)(p.ws + WS_RZ) + (size_t)b * 4096 * 4096; Tseq = 4096; t0 = (sc - 2) * 128; ld = 4096; }
    LAS unsigned char* ul = lds;
    LAS float* ybuf = (LAS float*)(lds + 36 * 1024);
    {
        const int c8 = tid & 15, tb = tid >> 4; const int ch0 = head * 128 + 8 * c8;
        float w[4][8], bias[8];
#pragma unroll
        for (int k = 0; k < 4; ++k) { const f32x4 a = *(const f32x4*)(p.conv_w + k * 1024 + ch0), c2 = *(const f32x4*)(p.conv_w + k * 1024 + ch0 + 4);
#pragma unroll
            for (int j = 0; j < 4; ++j) { w[k][j] = a[j]; w[k][4 + j] = c2[j]; } }
        { const f32x4 a = *(const f32x4*)(p.conv_b + ch0), c2 = *(const f32x4*)(p.conv_b + ch0 + 4);
#pragma unroll
            for (int j = 0; j < 4; ++j) { bias[j] = a[j]; bias[4 + j] = c2[j]; } }
#pragma unroll
        for (int i = 0; i < 4; ++i) { const int t = tb + 32 * i; float a[8];
#pragma unroll
            for (int j = 0; j < 8; ++j) a[j] = bias[j];
#pragma unroll
            for (int k = 0; k < 4; ++k) { const int tt = t0 + t + k - 2;
                if (tt >= 0 && tt < Tseq) { float f[8]; unpack8(*(const u32x4*)(src + (size_t)tt * ld + ch0), f);
#pragma unroll
                    for (int j = 0; j < 8; ++j) a[j] += w[k][j] * f[j]; } }
            u32x4 wv; wv.x = cvt_pk_bf16(a[0], a[1]); wv.y = cvt_pk_bf16(a[2], a[3]); wv.z = cvt_pk_bf16(a[4], a[5]); wv.w = cvt_pk_bf16(a[6], a[7]);
            *(LAS u32x4*)(ul + t * 272 + c8 * 16) = wv; }
    }
    __syncthreads();
    f32x16 hacc[4];
    if (wid < 4) lru_wave<FINAL, 0>(p, ul, b, sc, head, wid & 3, lane, hacc);
    else lru_wave<FINAL, 1>(p, ul, b, sc, head, wid & 3, lane, hacc);
    if (FINAL) {
        const int lr = lane & 31, lh = lane >> 5, chl = (wid & 3) * 32 + lr;
        if (wid >= 4) { LAS float* yp = ybuf + (127 - 4 * lh) * 129 + chl;
#pragma unroll
            for (int mb = 0; mb < 4; ++mb)
#pragma unroll
                for (int r = 0; r < 16; ++r) yp[-LRU_CST(mb, r) * 129] = hacc[mb][r]; }
        __syncthreads();
        if (wid < 4) {
            const LAS float* yp = ybuf + (4 * lh) * 129 + chl;
            const bf16_t* Zu = (const bf16_t*)(p.ws + WS_RZ) + ((size_t)(b * 4096 + t0) * 4096 + 1024 + head * 128);
            bf16_t* Ou = (bf16_t*)(p.ws + WS_R1) + ((size_t)(b * 4096 + t0) * 1024 + head * 128);
            const unsigned zo = (unsigned)(4 * lh * 4096 + chl), oo = (unsigned)(4 * lh * 1024 + chl);
#pragma unroll
            for (int mb = 0; mb < 4; ++mb) {
#pragma unroll
                for (int r = 0; r < 16; ++r) {
                    const float y = hacc[mb][r] + yp[LRU_CST(mb, r) * 129];
                    const float gz = bf2f(Zu[zo + LRU_CST(mb, r) * 4096]);
                    Ou[oo + LRU_CST(mb, r) * 1024] = (bf16_t)(cvt_pk_bf16(gz * y, 0.f) & 0xffffu);
                    if ((r & 7) == 7) __builtin_amdgcn_sched_barrier(0); } }
        }
    }
    __syncthreads();
}

#ifndef LRU_PF_FRAG
#define LRU_PF_FRAG true
#endif
#ifndef LRU_PF_TILE
#define LRU_PF_TILE true
#endif
template <int DIR, bool PREF>
__device__ __forceinline__ void lru2_dir(const Params& p, LAS unsigned char* ul, int head, int w, int lane, const bf16x8 (&bA)[4], const bf16x8 (&bI)[4], bf16x8 (&nA)[4], bf16x8 (&nI)[4],
                                         f32x4 (&hl)[8], f32x4 (&pp)[8], float& Atot, float& Htot) {
    constexpr int SG = DIR ? -1 : 1;
    const int fr = lane & 15, fq = lane >> 4, chl = 16 * w + fr, ch = head * 128 + chl;
    f32x4 accA[8], accI[8];
    { const float ba2 = NLOG2E * p.lru_ba[DIR * 1024 + ch], bi2 = NLOG2E * p.lru_bi[DIR * 1024 + ch];
#pragma unroll
      for (int rb = 0; rb < 8; ++rb) { accA[rb] = (f32x4){ba2, ba2, ba2, ba2}; accI[rb] = (f32x4){bi2, bi2, bi2, bi2}; } }
    {
        LAS unsigned char* arow0 = ul + (DIR ? 127 - fr : fr) * 272 + fq * 16;
#pragma unroll
        for (int rb = 0; rb < 8; ++rb)
#pragma unroll
            for (int ks = 0; ks < 4; ++ks) { const bf16x8 af = *(const LAS bf16x8*)(arow0 + SG * 16 * rb * 272 + 64 * ks);
                accA[rb] = __builtin_amdgcn_mfma_f32_16x16x32_bf16(af, bA[ks], accA[rb], 0, 0, 0);
                accI[rb] = __builtin_amdgcn_mfma_f32_16x16x32_bf16(af, bI[ks], accI[rb], 0, 0, 0); }
    }
    if (PREF) {
        const bf16_t* wa = (const bf16_t*)(p.ws + WS_WAT) + ((size_t)((1 - DIR) * 8 + head) * 128 + chl) * 128 + 8 * fq;
        const bf16_t* wi = (const bf16_t*)(p.ws + WS_WIT) + ((size_t)((1 - DIR) * 8 + head) * 128 + chl) * 128 + 8 * fq;
#pragma unroll
        for (int ks = 0; ks < 4; ++ks) { nA[ks] = *(const bf16x8*)(wa + 32 * ks); nI[ks] = *(const bf16x8*)(wi + 32 * ks); }
    }
    {
        typedef float f32x2 __attribute__((ext_vector_type(2)));
        const float lam = p.lru_lambda[DIR * 1024 + ch]; const float k2 = NLOG2E * 8.0f * log1pf(expf(-lam));
        LAS unsigned char* up = ul + (DIR ? 127 - 4 * fq : 4 * fq) * 272 + chl * 2;
#pragma unroll
        for (int rb = 0; rb < 8; ++rb)
#pragma unroll
            for (int r = 0; r < 4; r += 2) {
                f32x2 uv; uv.x = bf2f(*(const LAS bf16_t*)(up + SG * (16 * rb + r) * 272)); uv.y = bf2f(*(const LAS bf16_t*)(up + SG * (16 * rb + r + 1) * 272));
                f32x2 ea, ei; ea.x = __builtin_amdgcn_exp2f(accA[rb][r]); ea.y = __builtin_amdgcn_exp2f(accA[rb][r + 1]); ei.x = __builtin_amdgcn_exp2f(accI[rb][r]); ei.y = __builtin_amdgcn_exp2f(accI[rb][r + 1]);
                const f32x2 da = ea + 1.0f, di = ei + 1.0f;
                f32x2 rg, ig; rg.x = __builtin_amdgcn_rcpf(da.x); rg.y = __builtin_amdgcn_rcpf(da.y); ig.x = __builtin_amdgcn_rcpf(di.x); ig.y = __builtin_amdgcn_rcpf(di.y);
                const f32x2 ka = rg * k2;
                f32x2 a; a.x = __builtin_amdgcn_exp2f(ka.x); a.y = __builtin_amdgcn_exp2f(ka.y);
                const f32x2 om = 1.0f - a * a;
                f32x2 sq; sq.x = __builtin_amdgcn_sqrtf(om.x); sq.y = __builtin_amdgcn_sqrtf(om.y);
                const f32x2 bb = sq * ig * uv;
                accA[rb][r] = a.x; accA[rb][r + 1] = a.y; accI[rb][r] = bb.x; accI[rb][r + 1] = bb.y; }
    }
    float rA[8], rH[8];
#pragma unroll
    for (int rb = 0; rb < 8; ++rb) { float pa = 1.f, hh = 0.f;
#pragma unroll
        for (int r = 0; r < 4; ++r) { const float a = accA[rb][r], bb = accI[rb][r]; hh = a * hh + bb; pa *= a; accA[rb][r] = pa; accI[rb][r] = hh; }
        rA[rb] = pa; rH[rb] = hh; }
    float Pc = 1.f, s = 0.f;
#pragma unroll
    for (int rb = 0; rb < 8; ++rb) { float Pin = 1.f, Hin = 0.f;
#pragma unroll
        for (int q = 0; q < 4; ++q) { const float a = __shfl(rA[rb], fr + 16 * q), hh = __shfl(rH[rb], fr + 16 * q);
            if (q == fq) { Pin = Pc; Hin = s; }
            s = a * s + hh; Pc *= a; }
#pragma unroll
        for (int r = 0; r < 4; ++r) { hl[rb][r] = accI[rb][r] + accA[rb][r] * Hin; pp[rb][r] = accA[rb][r] * Pin; }
        __builtin_amdgcn_sched_barrier(0); }
    Atot = Pc; Htot = s;
}
__device__ __forceinline__ u64_t agg_ld(const u64_t* a) { return __hip_atomic_load(a, __ATOMIC_RELAXED, __HIP_MEMORY_SCOPE_AGENT); }
template <int DIR>
__device__ __forceinline__ float lru2_carry(const u64_t* aggc, int n, int fr, int fq) {
    float Ap = 1.f, Hp = 0.f; u64_t v[9];
#pragma unroll
    for (int k = 0; k < 9; ++k) { const int j = fq * 9 + k; const int seq = DIR ? (j == 0 ? 1 : (j == 1 ? 0 : 35 - j)) : j;
        v[k] = (j < n) ? agg_ld(aggc + (size_t)seq * 2048) : 0x000000003f800000ull; }
#pragma unroll
    for (int k = 0; k < 9; ++k) { const float a = __uint_as_float((unsigned)v[k]), hh = __uint_as_float((unsigned)(v[k] >> 32)); Hp = a * Hp + hh; Ap *= a; }
    float s = 0.f;
#pragma unroll
    for (int q = 0; q < 4; ++q) { const float a = __shfl(Ap, fr + 16 * q), hh = __shfl(Hp, fr + 16 * q); s = a * s + hh; }
    return s;
}
__device__ __forceinline__ void lru2_block(const Params& p, LAS unsigned char* lds, int slot, int c, int ngr) {
    const int tid = threadIdx.x, lane = tid & 63, wid = __builtin_amdgcn_readfirstlane(tid >> 6);
    const int sc = c + 2, t0 = c * 128;
    LAS unsigned char* raw = lds;
    LAS unsigned char* ul = lds + 33792;
    LAS unsigned char* gzl = lds + 68608;
    LAS unsigned char* outl = lds + 103424;
    const int fr = lane & 15, fq = lane >> 4, chl = 16 * wid + fr;
    u32x4 nr[5], ng[4];
#define LRU2_LOAD_R(gg) do { const bf16_t* Zb_ = (const bf16_t*)(p.ws + WS_RZ) + (size_t)((gg) >> 3) * 4096 * 4096 + ((gg) & 7) * 128; \
        _Pragma("unroll") for (int k = 0; k < 5; ++k) { const int pc = tid + NTHR * k; nr[k] = (u32x4){0u, 0u, 0u, 0u}; \
            if (pc < 131 * 16) { const int row = pc >> 4, c8 = pc & 15, tt = t0 - 2 + row; if (tt >= 0 && tt < TT) nr[k] = __builtin_nontemporal_load((const u32x4*)(Zb_ + (size_t)tt * 4096 + c8 * 8)); } } } while (0)
#define LRU2_LOAD_G(gg) do { const bf16_t* Zb_ = (const bf16_t*)(p.ws + WS_RZ) + (size_t)((gg) >> 3) * 4096 * 4096 + ((gg) & 7) * 128; \
        _Pragma("unroll") for (int k = 0; k < 4; ++k) { const int pc = tid + NTHR * k, row = pc >> 4, c8 = pc & 15; ng[k] = __builtin_nontemporal_load((const u32x4*)(Zb_ + (size_t)(t0 + row) * 4096 + 1024 + c8 * 8)); } } while (0)
    LRU2_LOAD_R(slot); LRU2_LOAD_G(slot);
    for (int g = slot; g < NB * 8; g += ngr) {
        const int b = g >> 3, head = g & 7, ch = head * 128 + chl;
        unsigned* gcnt = (unsigned*)(p.ws + WS_BAR + 16 * KiB) + g * 64;
        bf16x8 bA1[4], bI1[4], bA0[4], bI0[4];
        { const bf16_t* wa = (const bf16_t*)(p.ws + WS_WAT) + ((size_t)(8 + head) * 128 + chl) * 128 + 8 * fq; const bf16_t* wi = (const bf16_t*)(p.ws + WS_WIT) + ((size_t)(8 + head) * 128 + chl) * 128 + 8 * fq;
#pragma unroll
          for (int ks = 0; ks < 4; ++ks) { bA1[ks] = *(const bf16x8*)(wa + 32 * ks); bI1[ks] = *(const bf16x8*)(wi + 32 * ks); } }
#pragma unroll
        for (int k = 0; k < 5; ++k) { const int pc = tid + NTHR * k; if (pc < 131 * 16) *(LAS u32x4*)(raw + (pc >> 4) * 256 + (pc & 15) * 16) = nr[k]; }
#pragma unroll
        for (int k = 0; k < 4; ++k) { const int pc = tid + NTHR * k; *(LAS u32x4*)(gzl + (pc >> 4) * 272 + (pc & 15) * 16) = ng[k]; }
        __syncthreads();
        {
            const int c8 = tid & 15, tb = tid >> 4; const int ch0 = head * 128 + 8 * c8;
            float w[4][8], bias[8];
#pragma unroll
            for (int k = 0; k < 4; ++k) { const f32x4 a = *(const f32x4*)(p.conv_w + k * 1024 + ch0), c2 = *(const f32x4*)(p.conv_w + k * 1024 + ch0 + 4);
#pragma unroll
                for (int j = 0; j < 4; ++j) { w[k][j] = a[j]; w[k][4 + j] = c2[j]; } }
            { const f32x4 a = *(const f32x4*)(p.conv_b + ch0), c2 = *(const f32x4*)(p.conv_b + ch0 + 4);
#pragma unroll
                for (int j = 0; j < 4; ++j) { bias[j] = a[j]; bias[4 + j] = c2[j]; } }
#pragma unroll
            for (int i = 0; i < 4; ++i) { const int t = tb + 32 * i; float a[8];
#pragma unroll
                for (int j = 0; j < 8; ++j) a[j] = bias[j];
#pragma unroll
                for (int k = 0; k < 4; ++k) { float f[8]; unpack8(*(const LAS u32x4*)(raw + (t + k) * 256 + c8 * 16), f);
#pragma unroll
                    for (int j = 0; j < 8; ++j) a[j] += w[k][j] * f[j]; }
                u32x4 wv; wv.x = cvt_pk_bf16(a[0], a[1]); wv.y = cvt_pk_bf16(a[2], a[3]); wv.z = cvt_pk_bf16(a[4], a[5]); wv.w = cvt_pk_bf16(a[6], a[7]);
                *(LAS u32x4*)(ul + t * 272 + c8 * 16) = wv; }
        }
        __syncthreads();
        float A0, H0, A1, H1;
        {
            f32x4 hl1[8], pp1[8];
            lru2_dir<1, LRU_PF_FRAG>(p, ul, head, wid, lane, bA1, bI1, bA0, bI0, hl1, pp1, A1, H1);
            LAS unsigned char* hp = outl + chl * 264 + (124 - 4 * fq) * 2; LAS unsigned char* qp = raw + chl * 264 + (124 - 4 * fq) * 2;
#pragma unroll
            for (int rb = 0; rb < 8; ++rb) { u32x2 wh, wq; wh.x = cvt_pk_bf16(hl1[rb][3], hl1[rb][2]); wh.y = cvt_pk_bf16(hl1[rb][1], hl1[rb][0]); wq.x = cvt_pk_bf16(pp1[rb][3], pp1[rb][2]); wq.y = cvt_pk_bf16(pp1[rb][1], pp1[rb][0]);
                *(LAS u32x2*)(hp - 32 * rb) = wh; *(LAS u32x2*)(qp - 32 * rb) = wq; }
        }
        __builtin_amdgcn_sched_barrier(0);
        if (!LRU_PF_FRAG) { const bf16_t* wa = (const bf16_t*)(p.ws + WS_WAT) + ((size_t)(head) * 128 + chl) * 128 + 8 * fq; const bf16_t* wi = (const bf16_t*)(p.ws + WS_WIT) + ((size_t)(head) * 128 + chl) * 128 + 8 * fq;
#pragma unroll
          for (int ks = 0; ks < 4; ++ks) { bA0[ks] = *(const bf16x8*)(wa + 32 * ks); bI0[ks] = *(const bf16x8*)(wi + 32 * ks); } }
        f32x4 hl0[8], pp0[8];
        lru2_dir<0, false>(p, ul, head, wid, lane, bA0, bI0, bA1, bI1, hl0, pp0, A0, H0);
        u64_t* agg = (u64_t*)(p.ws + WS_AGG);
        const size_t ai0 = ((size_t)(b * NSEQ) * 2 + 0) * 1024 + ch, ai1 = ((size_t)(b * NSEQ) * 2 + 1) * 1024 + ch;
        if (fq == 0) {
            __hip_atomic_store(agg + ai0 + (size_t)sc * 2048, ((u64_t)__float_as_uint(H0) << 32) | __float_as_uint(A0), __ATOMIC_RELAXED, __HIP_MEMORY_SCOPE_AGENT);
            __hip_atomic_store(agg + ai1 + (size_t)sc * 2048, ((u64_t)__float_as_uint(H1) << 32) | __float_as_uint(A1), __ATOMIC_RELAXED, __HIP_MEMORY_SCOPE_AGENT); }
        asm volatile("s_waitcnt vmcnt(0)" ::: "memory");
        __syncthreads();
        if (tid == 0) (void)__hip_atomic_fetch_add(gcnt, 1u, __ATOMIC_RELAXED, __HIP_MEMORY_SCOPE_AGENT);
        if (wid == 0) { unsigned sp = 0;
            while ((unsigned)__builtin_amdgcn_readfirstlane(__hip_atomic_load(gcnt, __ATOMIC_RELAXED, __HIP_MEMORY_SCOPE_AGENT)) < 32u) { __builtin_amdgcn_s_sleep(1); if (++sp > (1u << 22)) break; }
            __builtin_amdgcn_fence(__ATOMIC_ACQUIRE, "agent");
            asm volatile("s_waitcnt vmcnt(0)" ::: "memory"); }
        __syncthreads();
        const float C0 = lru2_carry<0>(agg + ai0, sc, fr, fq);
        const float C1 = lru2_carry<1>(agg + ai1, 2 + (NSEQ - 1 - sc), fr, fq);
        __builtin_amdgcn_sched_barrier(0);
        if (LRU_PF_TILE) { const int gn = (g + ngr < NB * 8) ? g + ngr : g; LRU2_LOAD_R(gn); LRU2_LOAD_G(gn); }
        __builtin_amdgcn_sched_barrier(0);
        LAS unsigned char* gp = gzl + (4 * fq) * 272 + chl * 2; LAS unsigned char* op = outl + (4 * fq) * 272 + chl * 2;
        const LAS unsigned char* hp1 = outl + chl * 264 + (4 * fq) * 2; const LAS unsigned char* qp1 = raw + chl * 264 + (4 * fq) * 2;
        unsigned ov[16];
#pragma unroll
        for (int rb = 0; rb < 8; ++rb) { const u32x2 wh = *(const LAS u32x2*)(hp1 + 32 * rb), wq = *(const LAS u32x2*)(qp1 + 32 * rb);
            const float h1v[4] = {bf_lo(wh.x), bf_hi(wh.x), bf_lo(wh.y), bf_hi(wh.y)}, q1v[4] = {bf_lo(wq.x), bf_hi(wq.x), bf_lo(wq.y), bf_hi(wq.y)};
            float o[4];
#pragma unroll
            for (int r = 0; r < 4; ++r) { const float y = hl0[rb][r] + pp0[rb][r] * C0 + h1v[r] + q1v[r] * C1;
                o[r] = bf2f(*(const LAS bf16_t*)(gp + (16 * rb + r) * 272)) * y; }
            ov[2 * rb] = cvt_pk_bf16(o[0], o[1]); ov[2 * rb + 1] = cvt_pk_bf16(o[2], o[3]); }
        __syncthreads();
#pragma unroll
        for (int rb = 0; rb < 8; ++rb) { *(LAS bf16_t*)(op + (16 * rb + 0) * 272) = (bf16_t)(ov[2 * rb] & 0xffffu); *(LAS bf16_t*)(op + (16 * rb + 1) * 272) = (bf16_t)(ov[2 * rb] >> 16);
            *(LAS bf16_t*)(op + (16 * rb + 2) * 272) = (bf16_t)(ov[2 * rb + 1] & 0xffffu); *(LAS bf16_t*)(op + (16 * rb + 3) * 272) = (bf16_t)(ov[2 * rb + 1] >> 16); }
        __syncthreads();
        bf16_t* Ob = (bf16_t*)(p.ws + WS_R1) + ((size_t)(b * 4096 + t0)) * 1024 + head * 128;
#pragma unroll
        for (int k = 0; k < 4; ++k) { const int pc = tid + NTHR * k, row = pc >> 4, c8 = pc & 15;
            *(u32x4*)(Ob + (size_t)row * 1024 + c8 * 8) = *(const LAS u32x4*)(outl + row * 272 + c8 * 16); }
        __syncthreads();
        if (!LRU_PF_TILE && g + ngr < NB * 8) LRU2_LOAD_R(g + ngr);
    }
#undef LRU2_LOAD_R
#undef LRU2_LOAD_G
}

__device__ __forceinline__ void fft_stage2_all(const Params& p, LAS unsigned char* lds) {
    const int tid = tid_opaque(), lane = tid & 63, wid = tid >> 6, fr = lane & 15, fq = lane >> 4;
    const bf16_t* Yt = (const bf16_t*)((const unsigned char*)p.out + OUT_YT); const bf16_t* D2 = (const bf16_t*)(p.ws + WS_D2T);
    bf16_t* Fo = (bf16_t*)((unsigned char*)p.out + OUT_F);
    const int G = gridDim.x;
    int it = blockIdx.x; bf16x8 dfr, yfr[4];
#define S2_LOAD(item) do { const int b_ = (item) & 7, k1_ = (item) >> 3; dfr = *(const bf16x8*)(D2 + (size_t)(k1_ + 256 * fr) * 32 + 8 * fq); \
        _Pragma("unroll") for (int n = 0; n < 4; ++n) yfr[n] = __builtin_nontemporal_load((const bf16x8*)(Yt + (size_t)(k1_ * 2 + (fq >> 1)) * 65536 + (size_t)b_ * 8192 + (size_t)(16 * (4 * wid + n) + fr) * 16 + 8 * (fq & 1))); } while (0)
    if (it < NB * 256) S2_LOAD(it);
    for (; it < NB * 256; it += G) {
        const int b = it & 7, k1 = it >> 3;
        f32x4 acc[4];
#pragma unroll
        for (int n = 0; n < 4; ++n) acc[n] = __builtin_amdgcn_mfma_f32_16x16x32_bf16(yfr[n], dfr, (f32x4){0.f, 0.f, 0.f, 0.f}, 0, 0, 0);
        const int nx = it + G; if (nx < NB * 256) S2_LOAD(nx);
#pragma unroll
        for (int n = 0; n < 4; ++n) mfma_settle(acc[n]);
#pragma unroll
        for (int n = 0; n < 4; ++n) { u32x2 w; w.x = cvt_pk_bf16(acc[n][0], acc[n][1]); w.y = cvt_pk_bf16(acc[n][2], acc[n][3]);
            *(LAS u32x2*)(lds + fr * 1040 + (16 * (4 * wid + n) + 4 * fq) * 2) = w; }
        __syncthreads();
#pragma unroll
        for (int k = 0; k < 2; ++k) { const int pc = tid + NTHR * k, k2 = pc >> 6, c8 = pc & 63;
            *(u32x4*)(Fo + ((size_t)b * 4096 + k1 + 256 * k2) * 512 + c8 * 8) = *(const LAS u32x4*)(lds + k2 * 1040 + c8 * 16); }
        __syncthreads();
    }
#undef S2_LOAD
}

__device__ __forceinline__ void topk_task(const Params& p, LAS unsigned char* lds, int it) {
    const int tid = tid_opaque(), lane = tid & 63, wid = tid >> 6;
    LAS unsigned* cnt = (LAS unsigned*)lds;
    LAS unsigned* wsum = cnt + 64;
    const float* scores = (const float*)(p.ws + WS_SCORES);
    int* idx = (int*)(p.ws + WS_IDX); float* gate = (float*)(p.ws + WS_GATE); int* slot_of = (int*)(p.ws + WS_SLOT);
    const int b = it >> 4, e = it & 15;
    unsigned key[8];
    { const u64_t* sp = (const u64_t*)(scores + (size_t)it * 4096 + tid * 8);
#pragma unroll
      for (int j = 0; j < 4; ++j) { const u64_t v = __hip_atomic_load(sp + j, __ATOMIC_RELAXED, __HIP_MEMORY_SCOPE_AGENT); key[2 * j] = (unsigned)v; key[2 * j + 1] = (unsigned)(v >> 32); } }
    unsigned thr = 0;
    for (int step = 0; step < 16; ++step) {
        const int sh = 29 - 2 * step;
        const unsigned c1 = sh >= 0 ? (thr | (1u << sh)) : (thr | 1u), c2 = sh >= 0 ? (thr | (2u << sh)) : 0xffffffffu, c3 = sh >= 0 ? (thr | (3u << sh)) : 0xffffffffu;
        unsigned n1 = 0, n2 = 0, n3 = 0;
#pragma unroll
        for (int j = 0; j < 8; ++j) { n1 += (unsigned)__popcll(__ballot(key[j] >= c1)); n2 += (unsigned)__popcll(__ballot(key[j] >= c2)); n3 += (unsigned)__popcll(__ballot(key[j] >= c3)); }
        LAS unsigned* cb = cnt + (step & 1) * 32;
        if (lane == 0) { cb[wid] = n1; cb[8 + wid] = n2; cb[16 + wid] = n3; }
        __syncthreads();
        unsigned t1 = 0, t2 = 0, t3 = 0;
#pragma unroll
        for (int w = 0; w < 8; ++w) { t1 += cb[w]; t2 += cb[8 + w]; t3 += cb[16 + w]; }
        if (sh >= 0) thr = t3 >= (unsigned)CAP ? c3 : (t2 >= (unsigned)CAP ? c2 : (t1 >= (unsigned)CAP ? c1 : thr));
        else thr = t1 >= (unsigned)CAP ? c1 : thr;
    }
    unsigned cg_ = 0, ce = 0;
#pragma unroll
    for (int j = 0; j < 8; ++j) { cg_ += key[j] > thr; ce += key[j] == thr; }
    unsigned pk = cg_ | (ce << 16), incl = pk;
#pragma unroll
    for (int o = 1; o < 64; o <<= 1) { const unsigned n = __shfl_up(incl, o); if (lane >= o) incl += n; }
    if (lane == 63) wsum[wid] = incl;
    __syncthreads();
    unsigned base = 0, total = 0;
#pragma unroll
    for (int w = 0; w < 8; ++w) { const unsigned s2 = wsum[w]; if (w < wid) base += s2; total += s2; }
    const unsigned excl = base + incl - pk; unsigned og = excl & 0xffffu, oe = excl >> 16; const unsigned ngt = total & 0xffffu, krem = (unsigned)CAP - ngt;
    int mm[8];
#pragma unroll
    for (int j = 0; j < 8; ++j) { const int t = tid * 8 + j; int m = -1;
        if (key[j] > thr) { m = (e * 8 + b) * 512 + (int)og; ++og; }
        else if (key[j] == thr) { if (oe < krem) m = (e * 8 + b) * 512 + (int)(ngt + oe); ++oe; }
        mm[j] = m;
        if (m >= 0) { idx[m] = b * 4096 + t; gate[m] = __uint_as_float(key[j]); } }
    { u32x4* so = (u32x4*)(slot_of + (size_t)it * 4096 + tid * 8);
      so[0] = (u32x4){(unsigned)mm[0], (unsigned)mm[1], (unsigned)mm[2], (unsigned)mm[3]}; so[1] = (u32x4){(unsigned)mm[4], (unsigned)mm[5], (unsigned)mm[6], (unsigned)mm[7]}; }
    __syncthreads();
}

__device__ __forceinline__ void phase7_rows(const Params& p, LAS unsigned char* lds) {
    const int tid = threadIdx.x, lane = tid & 63, wid = tid >> 6;
    LAS float* wrt = (LAS float*)lds;
    for (int i = tid; i < 16 * 1024; i += NTHR) { const int d = i >> 4, e = i & 15; wrt[e * 1024 + d] = p.w_router[i]; }
    __syncthreads();
    const float* ada = (const float*)(p.ws + WS_ADA); bf16_t* h2 = (bf16_t*)(p.ws + WS_H2); const bf16_t* x2b = (const bf16_t*)(p.ws + WS_X2B); float* scores = (float*)(p.ws + WS_SCORES);
    for (int row0 = (blockIdx.x * 8 + wid) * 2; row0 < MLAT; row0 += gridDim.x * 16) {
        const int b = row0 >> 12;
        f32x4 v[2][4]; float ss[2];
#pragma unroll
        for (int r = 0; r < 2; ++r)
#pragma unroll
            for (int i = 0; i < 4; ++i) { const u32x2 w = __builtin_nontemporal_load((const u32x2*)(x2b + (size_t)(row0 + r) * 1024 + 256 * i + 4 * lane)); v[r][i] = (f32x4){bf_lo(w.x), bf_hi(w.x), bf_lo(w.y), bf_hi(w.y)}; }
#pragma unroll
        for (int r = 0; r < 2; ++r) { float a = 0.f;
#pragma unroll
            for (int i = 0; i < 4; ++i) a += v[r][i][0] * v[r][i][0] + v[r][i][1] * v[r][i][1] + v[r][i][2] * v[r][i][2] + v[r][i][3] * v[r][i][3];
            ss[r] = a; }
#pragma unroll
        for (int o = 32; o >= 1; o >>= 1) { ss[0] += __shfl_xor(ss[0], o); ss[1] += __shfl_xor(ss[1], o); }
#pragma unroll
        for (int i = 0; i < 4; ++i) { const int d = 256 * i + 4 * lane;
            const f32x4 g = *(const f32x4*)(p.norm2_g + d), sh = *(const f32x4*)(ada + b * 6144 + 3072 + d), sc = *(const f32x4*)(ada + b * 6144 + 4096 + d);
#pragma unroll
            for (int r = 0; r < 2; ++r) { const float rs = rsqrtf(ss[r] * (1.0f / 1024.0f) + 1e-6f);
                v[r][i] = v[r][i] * rs * g * (sc + 1.0f) + sh;
                u32x2 w; w.x = cvt_pk_bf16(v[r][i][0], v[r][i][1]); w.y = cvt_pk_bf16(v[r][i][2], v[r][i][3]); *(u32x2*)(h2 + (size_t)(row0 + r) * 1024 + d) = w; } }
        float q[32];
#pragma unroll
        for (int e = 0; e < 16; ++e) { float a0 = 0.f, a1 = 0.f;
#pragma unroll
            for (int i = 0; i < 4; ++i) { const f32x4 w = *(const LAS f32x4*)(wrt + e * 1024 + 256 * i + 4 * lane);
                a0 += v[0][i][0] * w[0] + v[0][i][1] * w[1] + v[0][i][2] * w[2] + v[0][i][3] * w[3];
                a1 += v[1][i][0] * w[0] + v[1][i][1] * w[1] + v[1][i][2] * w[2] + v[1][i][3] * w[3]; }
            q[e] = a0; q[16 + e] = a1; }
#pragma unroll
        for (int j = 0; j < 16; ++j) { const bool up = (lane & 32) != 0; const float send = up ? q[j] : q[16 + j], keep = up ? q[16 + j] : q[j]; q[j] = keep + __shfl_xor(send, 32); }
#pragma unroll
        for (int j = 0; j < 8; ++j) { const bool up = (lane & 16) != 0; const float send = up ? q[j] : q[8 + j], keep = up ? q[8 + j] : q[j]; q[j] = keep + __shfl_xor(send, 16); }
#pragma unroll
        for (int j = 0; j < 4; ++j) { const bool up = (lane & 8) != 0; const float send = up ? q[j] : q[4 + j], keep = up ? q[4 + j] : q[j]; q[j] = keep + __shfl_xor(send, 8); }
#pragma unroll
        for (int j = 0; j < 2; ++j) { const bool up = (lane & 4) != 0; const float send = up ? q[j] : q[2 + j], keep = up ? q[2 + j] : q[j]; q[j] = keep + __shfl_xor(send, 4); }
        { const bool up = (lane & 2) != 0; const float send = up ? q[0] : q[1], keep = up ? q[1] : q[0]; q[0] = keep + __shfl_xor(send, 2); }
        float lg = q[0] + __shfl_xor(q[0], 1);
        float mx = lg;
#pragma unroll
        for (int o = 2; o <= 16; o <<= 1) mx = fmaxf(mx, __shfl_xor(mx, o));
        const float ex = expf(lg - mx); float sum = ex;
#pragma unroll
        for (int o = 2; o <= 16; o <<= 1) sum += __shfl_xor(sum, o);
        if (gridDim.x == 256) {
            LAS float* scl = (LAS float*)(lds + 64 * 1024);
            if ((lane & 1) == 0) scl[((lane >> 1) & 15) * 16 + wid * 2 + (lane >> 5)] = ex / sum;
            __syncthreads();
            if (tid < 128) { const int e = tid >> 3, q = tid & 7; const u64_t v2 = *(const LAS u64_t*)(scl + e * 16 + 2 * q);
                __hip_atomic_store((u64_t*)(scores + ((size_t)b * 16 + e) * 4096 + ((row0 - 2 * wid) & 4095) + 2 * q), v2, __ATOMIC_RELAXED, __HIP_MEMORY_SCOPE_AGENT); }
            asm volatile("s_waitcnt vmcnt(0)" ::: "memory");
            __syncthreads();
            if (tid == 0) (void)__hip_atomic_fetch_add((unsigned*)(p.ws + WS_BAR + 44 * KiB) + b * 64, 1u, __ATOMIC_RELAXED, __HIP_MEMORY_SCOPE_AGENT);
        } else if ((lane & 1) == 0) scores[((size_t)b * 16 + ((lane >> 1) & 15)) * 4096 + ((row0 + (lane >> 5)) & 4095)] = ex / sum;
    }
    __syncthreads();
}
__device__ __forceinline__ void phase7_topk(const Params& p, LAS unsigned char* lds) {
    const int bid = blockIdx.x; if (bid >= NB * NE) return;
    unsigned* c = (unsigned*)(p.ws + WS_BAR + 44 * KiB) + (bid >> 4) * 64;
    if (threadIdx.x < 64) { unsigned sp = 0;
        while ((unsigned)__builtin_amdgcn_readfirstlane(__hip_atomic_load(c, __ATOMIC_RELAXED, __HIP_MEMORY_SCOPE_AGENT)) < 256u) { __builtin_amdgcn_s_sleep(1); if (++sp > (1u << 22)) break; }
        __builtin_amdgcn_fence(__ATOMIC_ACQUIRE, "agent");
        asm volatile("s_waitcnt vmcnt(0)" ::: "memory"); }
    __syncthreads();
    topk_task(p, lds, bid);
}
__device__ __forceinline__ void phase7_weights(const Params& p) {
    constexpr int N_G = 16 * 16 * 6, N_D = 16 * 24 * 4;
    const bool fused = gridDim.x == 256;
    for (int j = 0; ; ++j) {
        int it;
        if (!fused) it = blockIdx.x + j * gridDim.x;
        else if (blockIdx.x >= 128) it = j < 4 ? (blockIdx.x - 128) + 128 * j : 512 + blockIdx.x + (j - 4) * 256;
        else it = 512 + blockIdx.x + j * 256;
        if (it >= 2 * N_G + N_D) break;
        if (it < 2 * N_G) { const int up = it >= N_G, j = up ? it - N_G : it, e = j / 96, r = j % 96, kb = r / 6, nb = r % 6;
            xpose_item<4>((up ? p.w_up_e : p.w_gate_e) + (size_t)e * 1024 * 1536, 1536, (bf16_t*)(p.ws + WS_WGU) + (size_t)e * 3072 * 1024, 1024, kb * 64, nb * 256, up ? 2 : 1); }
        else { const int j = it - 2 * N_G, e = j / 96, r = j % 96, kb = r >> 2, nb = r & 3;
            xpose_item<4>(p.w_down_e + (size_t)e * 1536 * 1024, 1024, (bf16_t*)(p.ws + WS_WD) + (size_t)e * 1024 * 1536, 1536, kb * 64, nb * 256, 0); }
    }
}

__device__ __forceinline__ void phase11(const Params& p, float* dst) {
    const int tid = tid_opaque(), lane = tid & 63, wid = tid >> 6;
    const float* ada = (const float*)(p.ws + WS_ADA); const int* slot_of = (const int*)(p.ws + WS_SLOT); const bf16_t* oute = (const bf16_t*)(p.ws + WS_OUTE); const bf16_t* x2b = (const bf16_t*)(p.ws + WS_X2B);
    const int stride = gridDim.x * 16;
    int row0 = (blockIdx.x * 8 + wid) * 2;
    int myslot = row0 < MLAT ? slot_of[((size_t)(row0 >> 12) * 16 + (lane & 15)) * 4096 + ((row0 & 4095) + ((lane >> 4) & 1))] : -1;
    for (; row0 < MLAT; row0 += stride) {
        const int b = row0 >> 12;
        const int nrow = row0 + stride; const int nslot = nrow < MLAT ? slot_of[((size_t)(nrow >> 12) * 16 + (lane & 15)) * 4096 + ((nrow & 4095) + ((lane >> 4) & 1))] : -1;
        f32x4 xv[2][4], acc[2][4];
#pragma unroll
        for (int r = 0; r < 2; ++r)
#pragma unroll
            for (int i = 0; i < 4; ++i) { const u32x2 w = __builtin_nontemporal_load((const u32x2*)(x2b + (size_t)(row0 + r) * 1024 + 256 * i + 4 * lane)); xv[r][i] = (f32x4){bf_lo(w.x), bf_hi(w.x), bf_lo(w.y), bf_hi(w.y)}; acc[r][i] = (f32x4){0.f, 0.f, 0.f, 0.f}; }
        const unsigned long long bal = __ballot(myslot >= 0);
        unsigned mask0 = (unsigned)(bal & 0xffffull), mask1 = (unsigned)((bal >> 16) & 0xffffull);
        while (mask0 | mask1) {
            int m[2][2];
#pragma unroll
            for (int j = 0; j < 2; ++j) { if (mask0) { const int e = __builtin_ctz(mask0); mask0 &= mask0 - 1; m[0][j] = __builtin_amdgcn_readlane(myslot, e); } else m[0][j] = MMOE;
                                          if (mask1) { const int e = __builtin_ctz(mask1); mask1 &= mask1 - 1; m[1][j] = __builtin_amdgcn_readlane(myslot, 16 + e); } else m[1][j] = MMOE; }
            u32x2 w[2][2][4];
#pragma unroll
            for (int r = 0; r < 2; ++r)
#pragma unroll
                for (int j = 0; j < 2; ++j)
#pragma unroll
                    for (int i = 0; i < 4; ++i) w[r][j][i] = __builtin_nontemporal_load((const u32x2*)(oute + (size_t)m[r][j] * 1024 + 256 * i + 4 * lane));
#pragma unroll
            for (int r = 0; r < 2; ++r)
#pragma unroll
                for (int j = 0; j < 2; ++j)
#pragma unroll
                    for (int i = 0; i < 4; ++i) { acc[r][i][0] += bf_lo(w[r][j][i].x); acc[r][i][1] += bf_hi(w[r][j][i].x); acc[r][i][2] += bf_lo(w[r][j][i].y); acc[r][i][3] += bf_hi(w[r][j][i].y); }
        }
        float ss[2];
#pragma unroll
        for (int r = 0; r < 2; ++r) { float a = 0.f;
#pragma unroll
            for (int i = 0; i < 4; ++i) { const int d = 256 * i + 4 * lane; const f32x4 g2 = *(const f32x4*)(ada + b * 6144 + 5120 + d); xv[r][i] += g2 * acc[r][i];
                a += xv[r][i][0] * xv[r][i][0] + xv[r][i][1] * xv[r][i][1] + xv[r][i][2] * xv[r][i][2] + xv[r][i][3] * xv[r][i][3]; }
            ss[r] = a; }
#pragma unroll
        for (int o = 32; o >= 1; o >>= 1) { ss[0] += __shfl_xor(ss[0], o); ss[1] += __shfl_xor(ss[1], o); }
#pragma unroll
        for (int r = 0; r < 2; ++r) { const float rs = rsqrtf(ss[r] * (1.0f / 1024.0f) + 1e-6f);
#pragma unroll
            for (int i = 0; i < 4; ++i) { const int d = 256 * i + 4 * lane; __builtin_nontemporal_store(xv[r][i] * rs * *(const f32x4*)(p.final_g + d), (f32x4*)(dst + (size_t)(row0 + r) * 1024 + d)); } }
        myslot = nslot;
    }
}

#define XB_TMO      128
#define XB_XCNT(j)  (256  + 64 * (j))
#define XB_XSUB(j)  (1280 + 64 * (j))
#define XB_XGEN(j)  (2304 + 64 * (j))
#define XB_TOP      3328
#define XB_TOPGEN   3392
#define XCD_BAR_WORDS 3456
#define XB_SPIN_CAP (1u << 22)
__device__ __forceinline__ unsigned xb_ld(unsigned* p)              { return __hip_atomic_load(p, __ATOMIC_RELAXED, __HIP_MEMORY_SCOPE_AGENT); }
__device__ __forceinline__ unsigned xb_add(unsigned* p, unsigned v) { return __hip_atomic_fetch_add(p, v, __ATOMIC_RELAXED, __HIP_MEMORY_SCOPE_AGENT); }
__device__ __forceinline__ unsigned xb_xcc_id() { return (unsigned)__builtin_amdgcn_s_getreg((3 << 11) | 20) & 0xFu; }
#define XB_SPIN(cond, bar) do { unsigned _sp = 0; while (cond) { __builtin_amdgcn_s_sleep(1); \
    if ((++_sp & 255u) == 0u) { if (xb_ld(&(bar)[XB_TMO])) break; if (_sp > XB_SPIN_CAP) { atomicAdd(&(bar)[XB_TMO], 1u); break; } } } } while (0)
struct XcdBarrier { unsigned* bar; unsigned x; volatile LAS unsigned* st; };
__device__ __forceinline__ XcdBarrier xcd_barrier_post(unsigned* bar, volatile LAS unsigned* st) {
    XcdBarrier b; b.bar = bar; b.x = xb_xcc_id(); b.st = st;
    if (threadIdx.x == 0) (void)xb_add(&bar[XB_XCNT(b.x)], 1u);
    return b;
}
__device__ __forceinline__ void xcd_barrier_complete(unsigned* bar, unsigned x, unsigned& nloc, unsigned& nx) {
    const unsigned G = gridDim.x * gridDim.y * gridDim.z;
    unsigned sum, cnt, mine, sp = 0u;
    for (;;) {
        sum = 0u; cnt = 0u; mine = 0u;
#pragma unroll
        for (unsigned j = 0; j < 16; ++j) { const unsigned c = xb_ld(&bar[XB_XCNT(j)]); sum += c; cnt += (c > 0u) ? 1u : 0u; mine = (j == x) ? c : mine; }
        if (sum == G) break;
        __builtin_amdgcn_s_sleep(1);
        if ((++sp & 255u) == 0u) { if (xb_ld(&bar[XB_TMO])) break; if (sp > XB_SPIN_CAP) { atomicAdd(&bar[XB_TMO], 1u); break; } }
    }
    nloc = mine > 0u ? mine : 1u; nx = cnt > 0u ? cnt : 1u;
}
__device__ __forceinline__ void xcd_barrier(const XcdBarrier& b) {
    asm volatile("s_waitcnt vmcnt(0)" ::: "memory");
    __syncthreads();
    if (threadIdx.x == 0) {
        unsigned* bar = b.bar;
        __builtin_amdgcn_s_waitcnt(0);
        unsigned nloc = b.st[0], nx = b.st[1];
        if (nloc == 0u) { xcd_barrier_complete(bar, b.x, nloc, nx); b.st[0] = nloc; b.st[1] = nx; }
        const unsigned old = xb_add(&bar[XB_XSUB(b.x)], 1u);
        const unsigned gen = old / nloc;
        if (old + 1u == (gen + 1u) * nloc) {
            __builtin_amdgcn_fence(__ATOMIC_RELEASE, "agent");
            asm volatile("s_waitcnt vmcnt(0)" ::: "memory");
            const unsigned og = xb_add(&bar[XB_TOP], 1u);
            const unsigned tg = og / nx;
            if (og + 1u == (tg + 1u) * nx) xb_add(&bar[XB_TOPGEN], 1u);
            else XB_SPIN(xb_ld(&bar[XB_TOPGEN]) == tg, bar);
            __builtin_amdgcn_fence(__ATOMIC_ACQUIRE, "agent");
            xb_add(&bar[XB_XGEN(b.x)], 1u);
            asm volatile("s_waitcnt vmcnt(0)" ::: "memory");
        } else {
            XB_SPIN(xb_ld(&bar[XB_XGEN(b.x)]) == gen, bar);
            __builtin_amdgcn_fence(__ATOMIC_ACQUIRE, "agent");
            asm volatile("s_waitcnt vmcnt(0)" ::: "memory");
        }
    }
    __syncthreads();
}

__global__ void __launch_bounds__(NTHR, 2) fwd_megakernel(Params p_in) {
    Params p = p_in;
    extern __shared__ __attribute__((aligned(16))) unsigned char lds_raw[];
    LAS unsigned char* lds = (LAS unsigned char*)lds_raw;
    cg::grid_group grid = cg::this_grid();
    const int G = gridDim.x, bid = blockIdx.x;
    unsigned char* ws = p.ws;
    bf16_t* const R1 = (bf16_t*)(ws + WS_R1); bf16_t* const Zb = (bf16_t*)(ws + WS_RZ); bf16_t* const PQt = (bf16_t*)(ws + WS_RPQ); bf16_t* const MRG = (bf16_t*)(ws + WS_R2);
    bf16_t* const Fb = (bf16_t*)((unsigned char*)p.out + OUT_F); bf16_t* const Ytb = (bf16_t*)((unsigned char*)p.out + OUT_YT);
#ifdef ONLY_PH
#define PH(k) ((k) == ONLY_PH && p.ph_lo <= (k) && (k) < p.ph_hi)
#else
#define PH(k) (p.ph_lo <= (k) && (k) < p.ph_hi)
#endif
    volatile LAS unsigned* xst = (volatile LAS unsigned*)(lds + LDS_BYTES - 16);
    if (threadIdx.x < 4) xst[threadIdx.x] = 0u;
    __syncthreads();
    XcdBarrier xbar = xcd_barrier_post((unsigned*)(ws + WS_BAR), xst);
    if (p.ph_lo < 0) grid.sync();
#ifdef TS_A
    unsigned long long* tsb = (unsigned long long*)(ws + WS_BAR + 40 * KiB);
#define STAMP(i) do { if (bid == 0 && threadIdx.x == 0) tsb[i] = __builtin_amdgcn_s_memrealtime(); } while (0)
#else
#define STAMP(i) do { } while (0)
#endif
    STAMP(0);
#define LAUNDER() do { asm volatile("" : "+s"(p.ws), "+s"(p.out), "+s"(p.x)); ws = p.ws; } while (0)
#define SYNC(k) do { if (PH(k) && PH((k) + 1)) xcd_barrier(xbar); STAMP((k) + 1); LAUNDER(); } while (0)
#ifndef REPMASK
#define REPMASK 0
#endif
#define REP(k) for (int rep_ = 0; rep_ <= ((REPMASK >> (k)) & 1); ++rep_)
    const bool fuse01 = PH(0) && PH(1);
    if (PH(0)) phase0(p, lds);
    if (fuse01) block_wait_ge((unsigned*)(ws + WS_BAR + 46 * KiB), 256u + 16u);
    else SYNC(0);
    if (PH(1)) REP(1) phase1(p);
    SYNC(1);
    if (PH(2)) REP(2) {
        { ProbPQ pr{(const bf16_t*)(ws + WS_WPQ), R1, 1024, 1024, 16384}; pg8::Order S; S.init(4, 128, G, bid); EpiPQ E{PQt}; pg8::gemm_phase(lds, pr, S, E); }
        STAMP(28);
        { ProbPlain pr{R1, (const bf16_t*)(ws + WS_WIN), 1024, 1024, 1024}; pg8::Order S; S.init(128, 16, G, bid); EpiZ E{Zb, 4096, -1}; pg8::gemm_phase(lds, pr, S, E); }
        STAMP(29);
        { ProbPlain pr{(const bf16_t*)(ws + WS_HCTX), (const bf16_t*)(ws + WS_WIN), 1024, 1024, 1024}; pg8::Order S; S.init(8, 4, G, bid); EpiZ E{(bf16_t*)(ws + WS_ZXC), 1024, 0}; pg8::gemm_phase(lds, pr, S, E); }
    }
    SYNC(2);
    if (PH(3)) REP(3) {
        {
            ProbPlain pr{(const bf16_t*)(ws + WS_D1T), PQt, 512, 512, 512}; pg8::Order S; S.init(2, 256, G, bid);
            if (G == 256) { if (bid >= 128) { S.G = 128; S.c = bid - 128; S.base = 0; S.lim = 3; } else { S.G = 128; S.c = bid; S.base = 384; S.lim = 1; } }
            EpiPlain E{Ytb, 65536}; pg8::gemm_phase(lds, pr, S, E); }
        for (int it = bid; it < NB * 2 * 8; it += G) lru_tile<false>(p, lds, it);
    }
    SYNC(3);
    if (PH(4)) {
        fft_stage2_all(p, lds);
        const int ngr = G >> 5;
        if (ngr > 0 && bid < ngr * 32) lru2_block(p, lds, bid % ngr, bid / ngr, ngr);
    }
    SYNC(4);
    if (PH(5)) REP(5) {
        { ProbMerge pr{Fb, (const bf16_t*)(ws + WS_WFOUR), R1, (const bf16_t*)(ws + WS_WLRU), 512, 1024, 512, 512, 1024, 1024}; pg8::Order S; S.init(128, 4, G, bid); EpiMerge E{MRG, Zb}; pg8::gemm_phase2(lds, pr, S, E); }
    }
    SYNC(5);
    if (PH(6)) REP(6) { ProbPlain pr{MRG, (const bf16_t*)(ws + WS_WOUT), 1024, 1024, 1024}; pg8::Order S; S.init(128, 4, G, bid); if (512 % G == 0) S.rev = 512 / G;
        EpiOut E{(bf16_t*)(ws + WS_X2B), p.x, (const float*)(ws + WS_POS), (const float*)(ws + WS_ADA)}; pg8::gemm_phase(lds, pr, S, E); }
    SYNC(6);
    if (PH(7)) { phase7_rows(p, lds); if (G == 256) phase7_topk(p, lds); phase7_weights(p); }
    SYNC(7);
    if (PH(8) && G != 256) { for (int it = bid; it < NB * NE; it += G) topk_task(p, lds, it); }
    if (G != 256) SYNC(8);
    if (PH(9)) REP(9) { ProbMoeUp pr{(const bf16_t*)(ws + WS_H2), (const bf16_t*)(ws + WS_WGU), (const int*)(ws + WS_IDX), 1024, 1024, 1024}; pg8::Order S; S.init(256, 12, G, bid); S.wgm = P9_WGM; EpiGU E{(bf16_t*)(ws + WS_HID)}; pg8::gemm_phase(lds, pr, S, E); }
    SYNC(9);
    if (PH(10)) { if (bid == 0 && threadIdx.x < 128) *(u32x4*)(ws + WS_OUTE + (size_t)MMOE * 2048 + threadIdx.x * 16) = (u32x4){0u, 0u, 0u, 0u}; }
    if (PH(10)) REP(10) { ProbMoeDown pr{(const bf16_t*)(ws + WS_HID), (const bf16_t*)(ws + WS_WD), 1536, 1536, 1536}; pg8::Order S; S.init(256, 4, G, bid); if (1024 % G == 0) S.rev = 1024 / G; EpiDown E{(bf16_t*)(ws + WS_OUTE), (const float*)(ws + WS_GATE)}; pg8::gemm_phase(lds, pr, S, E); }
    SYNC(10);
    if (PH(11)) phase11(p, p.out);
#ifdef TS_A
    xcd_barrier(xbar); STAMP(12);
    if (bid == 0 && threadIdx.x == 0) {

#ifndef TS_AE
#define TS_AE (TS_A + 1)
#endif
#ifndef TS_BE
#define TS_BE (TS_B + 1)
#endif
        const float ta = (float)(tsb[TS_AE] - tsb[TS_A]) * 0.01f * (float)(TS_SA), tb = (float)(tsb[TS_BE] - tsb[TS_B]) * 0.01f * (float)(TS_SB);
        p.out[7] = fminf(ta, 97.f); p.out[1024 * 5 + 9] = fminf(tb, 97.f); }
#endif
}

#ifndef N_LAUNCHES
#define N_LAUNCHES 1
#endif
#ifndef PROBE_DUP
#define PROBE_DUP 0x0
#endif
extern "C" void kernel_launch(void* const* d_in, const int* in_sizes, int n_in, void* d_out, int out_size, void* d_ws, size_t ws_size, hipStream_t stream) {
    static int grid = 0;
    if (grid == 0) {
        if (n_in != 24 || out_size != MLAT * DM || ws_size < WS_END) { fprintf(stderr, "kernel_launch: unexpected shapes (n_in %d out %d ws %zu)\n", n_in, out_size, ws_size); grid = -1; return; }
        int dev = 0, cus = 0, per_cu = 0;
        hipGetDevice(&dev); hipDeviceGetAttribute(&cus, hipDeviceAttributeMultiprocessorCount, dev);
        hipFuncSetAttribute((const void*)fwd_megakernel, hipFuncAttributeMaxDynamicSharedMemorySize, LDS_BYTES);
        hipOccupancyMaxActiveBlocksPerMultiprocessor(&per_cu, (const void*)fwd_megakernel, NTHR, LDS_BYTES);
        if (per_cu < 1) { fprintf(stderr, "kernel_launch: occupancy query reports %d blocks per CU\n", per_cu); per_cu = 1; }
        grid = cus * 1;
        (void)hipGetLastError();
    }
    if (grid < 0) return;
    Params p{};
    const float** f = (const float**)&p;
    for (int i = 0; i < 24; ++i) f[i] = (const float*)d_in[i];
    p.out = (float*)d_out; p.ws = (unsigned char*)d_ws;
    (void)hipMemsetAsync((unsigned char*)d_ws + WS_BAR, 0, 48 * KiB, stream);
#if N_LAUNCHES == 1
    p.ph_lo = 0; p.ph_hi = 12;
    void* args[] = {&p};
    hipError_t e = hipLaunchCooperativeKernel((const void*)fwd_megakernel, dim3(grid), dim3(NTHR), args, LDS_BYTES, stream);
    if (e != hipSuccess) fprintf(stderr, "cooperative launch failed: %s (grid %d)\n", hipGetErrorString(e), grid);
#else
    for (int k = 0; k < 12; ++k) for (int r = 0; r <= ((PROBE_DUP >> k) & 1); ++r) { p.ph_lo = k; p.ph_hi = k + 1; if (k == 11 && r == 0 && ((PROBE_DUP >> 11) & 1)) { p.ph_lo = 12; p.ph_hi = 13; } hipLaunchKernelGGL(fwd_megakernel, dim3(grid), dim3(NTHR), LDS_BYTES, stream, p); }
#endif
}
```

```cpp
#include <hip/hip_runtime.h>
#include <hip/hip_cooperative_groups.h>
#include <cstdio>
namespace cg = cooperative_groups;

#ifndef P9_WGM
#define P9_WGM 2
#endif
#define LAS __attribute__((address_space(3)))
typedef unsigned short bf16_t;
typedef short bf16x8 __attribute__((ext_vector_type(8)));
typedef float f32x4 __attribute__((ext_vector_type(4)));
typedef float f32x16 __attribute__((ext_vector_type(16)));
typedef unsigned u32x4 __attribute__((ext_vector_type(4)));
typedef unsigned u32x2 __attribute__((ext_vector_type(2)));
typedef unsigned long long u64_t;

constexpr int NB = 8, TT = 4096, DM = 1024, CTXL = 256, MLAT = NB * TT, MCTX = NB * CTXL;
constexpr int NE = 16, CAP = 512, DE = 1536, MMOE = NE * NB * CAP;
constexpr int NSEQ = 34;
constexpr int NTHR = 512;
constexpr float NLOG2E = -1.4426950408889634f;
constexpr int LDS_BYTES = 144 * 1024;

constexpr size_t KiB = 1024, MiB = 1024 * 1024;
constexpr size_t WS_ADA = 0;
constexpr size_t WS_POS = 256 * KiB;
constexpr size_t WS_AGG = 512 * KiB;
constexpr int FCOLS = 32768 + 512;
constexpr size_t WS_WPQ = 5 * MiB;
constexpr size_t WS_WIN = 7 * MiB;
constexpr size_t WS_WFOUR = 15 * MiB;
constexpr size_t WS_WLRU = 16 * MiB;
constexpr size_t WS_WOUT = 18 * MiB;
constexpr size_t WS_WAT = 20 * MiB;
constexpr size_t WS_WIT = 20 * MiB + 512 * KiB;
constexpr size_t WS_SCORES = 21 * MiB;
constexpr size_t WS_IDX = 23 * MiB;
constexpr size_t WS_GATE = 23 * MiB + 256 * KiB;
constexpr size_t WS_SLOT = 23 * MiB + 512 * KiB;
constexpr size_t WS_BAR = 25 * MiB + 512 * KiB;
constexpr size_t WS_D1T = 34 * MiB;
constexpr size_t WS_D2T = 34 * MiB + 512 * KiB;
constexpr size_t WS_HCTX = 26 * MiB;
constexpr size_t WS_ZXC = 30 * MiB;
constexpr size_t WS_R1 = 40 * MiB;
constexpr size_t WS_RPQ = 104 * MiB;
constexpr size_t WS_R2 = 168 * MiB;
constexpr size_t WS_RZ = 232 * MiB;
constexpr size_t WS_END = 504 * MiB;
constexpr size_t WS_X2B = WS_R1, WS_H2 = WS_RPQ, WS_WGU = 168 * MiB, WS_WD = 264 * MiB, WS_HID = 312 * MiB, WS_OUTE = WS_RPQ;
constexpr size_t OUT_YT = 0, OUT_F = 64 * MiB;

struct Params {
    const float *x, *c, *ctx, *c_ctx, *w_ada, *b_ada, *norm1_g, *norm2_g, *w_in, *w_four, *conv_w, *conv_b, *lru_lambda,
        *lru_wa, *lru_ba, *lru_wi, *lru_bi, *w_lru, *w_out, *w_router, *w_gate_e, *w_up_e, *w_down_e, *final_g;
    float* out; unsigned char* ws; int ph_lo, ph_hi;
};

__device__ __forceinline__ int tid_opaque() { int t = threadIdx.x; asm volatile("" : "+v"(t)); return t; }
__device__ __forceinline__ unsigned cvt_pk_bf16(float lo, float hi) { unsigned r; asm volatile("v_cvt_pk_bf16_f32 %0, %1, %2" : "=v"(r) : "v"(lo), "v"(hi)); return r; }
__device__ __forceinline__ void mfma_settle(f32x4& a) { asm volatile("s_nop 15\n\ts_nop 7" : "+v"(a)); }
__device__ __forceinline__ void block_wait_ge(unsigned* cnt, unsigned need) {
    if (threadIdx.x < 64) { unsigned sp = 0;
        while ((unsigned)__builtin_amdgcn_readfirstlane(__hip_atomic_load(cnt, __ATOMIC_RELAXED, __HIP_MEMORY_SCOPE_AGENT)) < need) { __builtin_amdgcn_s_sleep(2); if (++sp > (1u << 22)) break; }
        __builtin_amdgcn_fence(__ATOMIC_ACQUIRE, "agent"); asm volatile("s_waitcnt vmcnt(0)" ::: "memory"); }
    __syncthreads();
}
__device__ __forceinline__ float bf_lo(unsigned w) { return __uint_as_float(w << 16); }
__device__ __forceinline__ float bf_hi(unsigned w) { return __uint_as_float(w & 0xffff0000u); }
__device__ __forceinline__ float bf2f(bf16_t h) { return __uint_as_float(((unsigned)h) << 16); }
__device__ __forceinline__ float sigmoidf_(float v) { return __builtin_amdgcn_rcpf(1.0f + __expf(-v)); }
__device__ __forceinline__ float gelu_tanh(float v) { const float y = 1.5957691216f * (v + 0.044715f * v * v * v); return v * sigmoidf_(y); }
__device__ __forceinline__ float wave_sum(float v) {
#pragma unroll
    for (int o = 32; o >= 1; o >>= 1) v += __shfl_xor(v, o);
    return v;
}
__device__ __forceinline__ void unpack8(const u32x4 w, float (&f)[8]) { f[0] = bf_lo(w.x); f[1] = bf_hi(w.x); f[2] = bf_lo(w.y); f[3] = bf_hi(w.y); f[4] = bf_lo(w.z); f[5] = bf_hi(w.z); f[6] = bf_lo(w.w); f[7] = bf_hi(w.w); }

namespace pg8 {
constexpr int BM = 256, BK = 64, HALF = 128, HTB = HALF * BK * 2, STAGE_BYTES = 8 * HTB, NXCD = 8, WGM = 2;
__device__ __forceinline__ int lds_byte(int r, int c) { const int st = (r >> 4) * 2 + (c >> 5), rr = r & 15, cc = c & 31, ob = rr * 64 + cc * 2; return st * 1024 + (ob ^ (((ob >> 9) & 1) << 5)); }
__device__ __forceinline__ void stage_rc(int b, int& R, int& C) { const int st = b / 1024, sb = b % 1024, swz = sb ^ (((sb >> 9) & 1) << 5); R = (st >> 1) * 16 + swz / 64; C = (st & 1) * 32 + (swz % 64) / 2; }
__device__ __forceinline__ int perm32(int rho) { const int n = rho >> 4, i = rho & 15; return 8 * (i >> 2) + 4 * n + (i & 3); }
struct Unit { int pm, pn; };
struct Order {
    int nM, nN, nwg, G, c, base, lim, rev, wgm;
    __device__ void init(int nM_, int nN_, int G_, int c_) { nM = nM_; nN = nN_; nwg = nM * nN; G = G_; c = c_; base = 0; lim = 0x7fffffff; rev = 0; wgm = WGM; }
    __device__ bool next(int i, Unit& u) const {
        if (rev > 0 && i >= rev) return false;
        const long L = (long)base + (long)(rev > 0 ? rev - 1 - i : i) * G + c; if (i >= lim || L >= nwg) return false;
        int wgid = (int)L; { const int q = nwg / NXCD, r = nwg % NXCD, xcd = wgid % NXCD, off = wgid / NXCD; wgid = (xcd < r ? xcd * (q + 1) : r * (q + 1) + (xcd - r) * q) + off; }
        const int nig = wgm * nN, gid = wgid / nig, fm = gid * wgm, gsz = (nM - fm) < wgm ? (nM - fm) : wgm;
        u.pm = fm + ((wgid % nig) % gsz); u.pn = (wgid % nig) / gsz; return true;
    }
};
template <class P, class Epi>
__device__ __forceinline__ void gemm_phase(LAS unsigned char* lds, const P& pr, const Order& S, const Epi& E) {
    const int tid = tid_opaque(), wid = __builtin_amdgcn_readfirstlane(tid >> 6), lane = tid & 63, wr = wid >> 2, wc = wid & 3, fr = lane & 15, fq = lane >> 4;
    const int nt = pr.K / BK;
    int RA[2], CA[2]; unsigned voffB[2];
#pragma unroll
    for (int i = 0; i < 2; ++i) { int R, C; stage_rc(tid * 16 + i * 8192, R, C); RA[i] = R; CA[i] = C; const int Rb = Epi::PERM ? ((R & ~31) + perm32(R & 31)) : R; voffB[i] = (unsigned)(Rb * pr.ldb + C) * 2u; }
    const size_t kstep = (size_t)(BK * 2);
    const size_t hstepB = (size_t)HALF * pr.ldb * 2;
    const unsigned ldsw = (unsigned)wid * 1024u;
    const int aoff = lds_byte(wr * 64 + fr, fq * 8), boff = lds_byte(wc * 32 + fr, fq * 8);
#define PG8_SA(b, h) (((b) * 2 + (h)) * HTB)
#define PG8_SB(b, h) ((4 + (b) * 2 + (h)) * HTB)
#define PG8_STAGE(bufoff, gbase, voff) do { _Pragma("unroll") for (int _i = 0; _i < 2; ++_i) \
        __builtin_amdgcn_global_load_lds((const unsigned*)((const char*)(gbase) + (voff)[_i]), (LAS unsigned*)(lds + (bufoff) + ldsw + _i * 8192), 16, 0, 0); } while (0)
#define PG8_LDA(dst, b, h) do { _Pragma("unroll") for (int m = 0; m < 4; ++m) _Pragma("unroll") for (int k = 0; k < 2; ++k) dst[m][k] = *(const LAS bf16x8*)(lds + PG8_SA(b, h) + aoff + m * 2048 + k * 1024); } while (0)
#define PG8_LDB(dst, b, h) do { _Pragma("unroll") for (int n = 0; n < 2; ++n) _Pragma("unroll") for (int k = 0; k < 2; ++k) dst[n][k] = *(const LAS bf16x8*)(lds + PG8_SB(b, h) + boff + n * 2048 + k * 1024); } while (0)
#define PG8_MMA(ai, bj, At, Bt) do { __builtin_amdgcn_s_setprio(1); _Pragma("unroll") for (int m = 0; m < 4; ++m) _Pragma("unroll") for (int n = 0; n < 2; ++n) _Pragma("unroll") for (int k = 0; k < 2; ++k) \
        acc[ai][bj][m][n] = __builtin_amdgcn_mfma_f32_16x16x32_bf16(Bt[n][k], At[m][k], acc[ai][bj][m][n], 0, 0, 0); __builtin_amdgcn_s_setprio(0); } while (0)
#define PG8_WAIT_V(n) asm volatile("s_waitcnt vmcnt(" #n ")" ::: "memory")
#define PG8_WAIT_L(n) asm volatile("s_waitcnt lgkmcnt(" #n ")" ::: "memory")
#define PG8_BAR __builtin_amdgcn_s_barrier()
#define PG8_SCHED __builtin_amdgcn_sched_barrier(0)
    Unit cur, nxt; int ui = 0;
    if (!S.next(0, cur)) return;
    f32x4 acc[2][2][4][2];
#pragma unroll
    for (int a = 0; a < 2; ++a)
#pragma unroll
        for (int b = 0; b < 2; ++b)
#pragma unroll
            for (int m = 0; m < 4; ++m)
#pragma unroll
                for (int n = 0; n < 2; ++n) acc[a][b][m][n] = (f32x4){0.f, 0.f, 0.f, 0.f};
    bf16x8 At[4][2], B0[2][2], B1[2][2];
    unsigned vA[2][2], vN[2][2];
    pr.avoff(cur, RA, CA, vA);
#pragma unroll
    for (int h = 0; h < 2; ++h)
#pragma unroll
        for (int i = 0; i < 2; ++i) vN[h][i] = vA[h][i];
    const char* cA = pr.abase(cur); const char* cB = pr.bbase(cur);
#define PG8_ROT(u) 0
#define PG8_KT(tt, rot) ((size_t)(((tt) + (rot)) >= nt ? ((tt) + (rot)) - nt : ((tt) + (rot))) * kstep)
    int rot = PG8_ROT(cur);
    { const char* pA = cA + PG8_KT(0, rot); const char* pB = cB + PG8_KT(0, rot);
    PG8_STAGE(PG8_SB(0, 0), pB, voffB); PG8_STAGE(PG8_SA(0, 0), pA, vA[0]); PG8_STAGE(PG8_SB(0, 1), pB + hstepB, voffB); PG8_STAGE(PG8_SA(0, 1), pA, vA[1]);
    if (wr == 1) PG8_BAR;
    PG8_WAIT_V(4); PG8_BAR;
    PG8_STAGE(PG8_SB(1, 0), pB + kstep, voffB); PG8_STAGE(PG8_SA(1, 0), pA + kstep, vA[0]); PG8_STAGE(PG8_SB(1, 1), pB + hstepB + kstep, voffB); }
    PG8_WAIT_V(6); PG8_BAR;
    for (;;) {
        const bool has_next = S.next(ui + 1, nxt);
        const char* nA = has_next ? pr.abase(nxt) : cA; const char* nB = has_next ? pr.bbase(nxt) : cB; const int nrot = has_next ? PG8_ROT(nxt) : rot;
        if (P::GATHER) { if (has_next) pr.avoff(nxt, RA, CA, vN); }
        for (int t = 0; t < nt; t += 2) {
            const bool last = (t == nt - 2);
            const char* a1 = cA + PG8_KT(t + 1, rot);
            const char* a2 = last ? nA + PG8_KT(0, nrot) : cA + PG8_KT(t + 2, rot); const char* b2 = last ? nB + PG8_KT(0, nrot) : cB + PG8_KT(t + 2, rot);
            const char* a3 = a2 + kstep; const char* b3 = b2 + kstep;
            unsigned v2[2][2];
#pragma unroll
            for (int h = 0; h < 2; ++h)
#pragma unroll
                for (int i = 0; i < 2; ++i) v2[h][i] = (P::GATHER && last) ? vN[h][i] : vA[h][i];
            PG8_LDB(B0, 0, 0); PG8_SCHED; PG8_LDA(At, 0, 0); PG8_STAGE(PG8_SA(1, 1), a1, vA[1]);
            PG8_WAIT_L(8); PG8_BAR; PG8_WAIT_L(0); PG8_MMA(0, 0, At, B0); PG8_BAR; PG8_SCHED;
            PG8_LDB(B1, 0, 1); PG8_STAGE(PG8_SB(0, 0), b2, voffB);
            PG8_BAR; PG8_WAIT_L(0); PG8_MMA(0, 1, At, B1); PG8_BAR;
            PG8_LDA(At, 0, 1); PG8_STAGE(PG8_SA(0, 0), a2, v2[0]);
            PG8_BAR; PG8_WAIT_L(0); PG8_MMA(1, 0, At, B0); PG8_BAR; PG8_SCHED;
            PG8_STAGE(PG8_SB(0, 1), b2 + hstepB, voffB);
            PG8_WAIT_V(6); PG8_BAR; PG8_MMA(1, 1, At, B1); PG8_BAR;
            PG8_LDB(B0, 1, 0); PG8_SCHED; PG8_LDA(At, 1, 0); PG8_STAGE(PG8_SA(0, 1), a2, v2[1]);
            PG8_WAIT_L(8); PG8_BAR; PG8_WAIT_L(0); PG8_MMA(0, 0, At, B0); PG8_BAR; PG8_SCHED;
            PG8_LDB(B1, 1, 1); PG8_STAGE(PG8_SB(1, 0), b3, voffB);
            PG8_BAR; PG8_WAIT_L(0); PG8_MMA(0, 1, At, B1); PG8_BAR;
            PG8_LDA(At, 1, 1); PG8_STAGE(PG8_SA(1, 0), a3, v2[0]);
            PG8_BAR; PG8_WAIT_L(0); PG8_MMA(1, 0, At, B0); PG8_BAR; PG8_SCHED;
            PG8_STAGE(PG8_SB(1, 1), b3 + hstepB, voffB);
            PG8_WAIT_V(6); PG8_BAR; PG8_MMA(1, 1, At, B1); PG8_BAR;
            if (P::GATHER && last) {
#pragma unroll
                for (int h = 0; h < 2; ++h)
#pragma unroll
                    for (int i = 0; i < 2; ++i) vA[h][i] = vN[h][i];
            }
        }
        E(acc, cur, wr, wc, fr, fq);
        if (!has_next) break;
#pragma unroll
        for (int a = 0; a < 2; ++a)
#pragma unroll
            for (int b = 0; b < 2; ++b)
#pragma unroll
                for (int m = 0; m < 4; ++m)
#pragma unroll
                    for (int n = 0; n < 2; ++n) acc[a][b][m][n] = (f32x4){0.f, 0.f, 0.f, 0.f};
        cur = nxt; cA = nA; cB = nB; rot = nrot; ++ui;
    }
    PG8_WAIT_V(0);
    if (wr == 0) PG8_BAR;
    PG8_BAR;
#undef PG8_ROT
#undef PG8_KT
#undef PG8_SA
#undef PG8_SB
#undef PG8_STAGE
#undef PG8_LDA
#undef PG8_LDB
#undef PG8_MMA
#undef PG8_WAIT_V
#undef PG8_WAIT_L
#undef PG8_BAR
#undef PG8_SCHED
}
template <class P, class Epi>
__device__ __forceinline__ void gemm_phase2(LAS unsigned char* lds, const P& pr, const Order& S, const Epi& E) {
    const int tid = tid_opaque(), wid = __builtin_amdgcn_readfirstlane(tid >> 6), lane = tid & 63, wr = wid >> 2, wc = wid & 3, fr = lane & 15, fq = lane >> 4;
    const int nt1 = pr.K1 / BK, nt = (pr.K1 + pr.K2) / BK;
    unsigned R2[2], Rb2[2], C2[2];
#pragma unroll
    for (int i = 0; i < 2; ++i) { int R, C; stage_rc(tid * 16 + i * 8192, R, C); const int Rb = Epi::PERM ? ((R & ~31) + perm32(R & 31)) : R; R2[i] = (unsigned)R * 2u; Rb2[i] = (unsigned)Rb * 2u; C2[i] = (unsigned)C * 2u; }
#define OFF_A(ld, h, i) ((R2[i] + (unsigned)((h) * 256)) * (unsigned)(ld) + C2[i])
#define OFF_B(ld, i) (Rb2[i] * (unsigned)(ld) + C2[i])
    const size_t kstep = (size_t)(BK * 2);
    const size_t hB1 = (size_t)HALF * pr.ldb1 * 2, hB2 = (size_t)HALF * pr.ldb2 * 2;
    const unsigned ldsw = (unsigned)wid * 1024u;
    const int aoff = lds_byte(wr * 64 + fr, fq * 8), boff = lds_byte(wc * 32 + fr, fq * 8);
#define PG8_SA(b, h) (((b) * 2 + (h)) * HTB)
#define PG8_SB(b, h) ((4 + (b) * 2 + (h)) * HTB)
#define PG8_STAGE(bufoff, gbase, voff) do { _Pragma("unroll") for (int _i = 0; _i < 2; ++_i) \
        __builtin_amdgcn_global_load_lds((const unsigned*)((const char*)(gbase) + (voff)[_i]), (LAS unsigned*)(lds + (bufoff) + ldsw + _i * 8192), 16, 0, 0); } while (0)
#define PG8_LDA(dst, b, h) do { _Pragma("unroll") for (int m = 0; m < 4; ++m) _Pragma("unroll") for (int k = 0; k < 2; ++k) dst[m][k] = *(const LAS bf16x8*)(lds + PG8_SA(b, h) + aoff + m * 2048 + k * 1024); } while (0)
#define PG8_LDB(dst, b, h) do { _Pragma("unroll") for (int n = 0; n < 2; ++n) _Pragma("unroll") for (int k = 0; k < 2; ++k) dst[n][k] = *(const LAS bf16x8*)(lds + PG8_SB(b, h) + boff + n * 2048 + k * 1024); } while (0)
#define PG8_MMA(ai, bj, At, Bt) do { __builtin_amdgcn_s_setprio(1); _Pragma("unroll") for (int m = 0; m < 4; ++m) _Pragma("unroll") for (int n = 0; n < 2; ++n) _Pragma("unroll") for (int k = 0; k < 2; ++k) \
        acc[ai][bj][m][n] = __builtin_amdgcn_mfma_f32_16x16x32_bf16(Bt[n][k], At[m][k], acc[ai][bj][m][n], 0, 0, 0); __builtin_amdgcn_s_setprio(0); } while (0)
#define PG8_WAIT_V(n) asm volatile("s_waitcnt vmcnt(" #n ")" ::: "memory")
#define PG8_WAIT_L(n) asm volatile("s_waitcnt lgkmcnt(" #n ")" ::: "memory")
#define PG8_BAR __builtin_amdgcn_s_barrier()
#define PG8_SCHED __builtin_amdgcn_sched_barrier(0)
    Unit cur, nxt; int ui = 0;
    if (!S.next(0, cur)) return;
    f32x4 acc[2][2][4][2];
#pragma unroll
    for (int a = 0; a < 2; ++a)
#pragma unroll
        for (int b = 0; b < 2; ++b)
#pragma unroll
            for (int m = 0; m < 4; ++m)
#pragma unroll
                for (int n = 0; n < 2; ++n) acc[a][b][m][n] = (f32x4){0.f, 0.f, 0.f, 0.f};
    bf16x8 At[4][2], B0[2][2], B1[2][2];
    const char* cA1 = pr.abase1(cur); const char* cB1 = pr.bbase1(cur); const char* cA2 = pr.abase2(cur); const char* cB2 = pr.bbase2(cur);
#define T_A(tt) ((tt) < nt1 ? cA1 + (size_t)(tt) * kstep : cA2 + (size_t)((tt) - nt1) * kstep)
#define T_B(tt) ((tt) < nt1 ? cB1 + (size_t)(tt) * kstep : cB2 + (size_t)((tt) - nt1) * kstep)
    { unsigned vb[2] = {OFF_B(pr.ldb1, 0), OFF_B(pr.ldb1, 1)}, va0[2] = {OFF_A(pr.lda1, 0, 0), OFF_A(pr.lda1, 0, 1)}, va1[2] = {OFF_A(pr.lda1, 1, 0), OFF_A(pr.lda1, 1, 1)};
    PG8_STAGE(PG8_SB(0, 0), cB1, vb); PG8_STAGE(PG8_SA(0, 0), cA1, va0); PG8_STAGE(PG8_SB(0, 1), cB1 + hB1, vb); PG8_STAGE(PG8_SA(0, 1), cA1, va1);
    if (wr == 1) PG8_BAR;
    PG8_WAIT_V(4); PG8_BAR;
    PG8_STAGE(PG8_SB(1, 0), cB1 + kstep, vb); PG8_STAGE(PG8_SA(1, 0), cA1 + kstep, va0); PG8_STAGE(PG8_SB(1, 1), cB1 + hB1 + kstep, vb); }
    PG8_WAIT_V(6); PG8_BAR;
    for (;;) {
        const bool has_next = S.next(ui + 1, nxt);
        const char* nA = has_next ? pr.abase1(nxt) : cA1; const char* nB = has_next ? pr.bbase1(nxt) : cB1;
        for (int t = 0; t < nt; t += 2) {
            const bool last = (t == nt - 2);
            const bool s1 = (t + 1 < nt1), s2 = last || (t + 2 < nt1);
            const char* a1 = T_A(t + 1);
            const char* a2 = last ? nA : T_A(t + 2); const char* b2 = last ? nB : T_B(t + 2);
            const char* a3 = a2 + kstep; const char* b3 = b2 + kstep;
            const size_t hstepB = s2 ? hB1 : hB2; const int ldaT1 = s1 ? pr.lda1 : pr.lda2, ldaT2 = s2 ? pr.lda1 : pr.lda2, ldbT2 = s2 ? pr.ldb1 : pr.ldb2;
            unsigned v2[2][2], voffB[2], vA1s[2];
#pragma unroll
            for (int i = 0; i < 2; ++i) { voffB[i] = OFF_B(ldbT2, i); vA1s[i] = OFF_A(ldaT1, 1, i);
#pragma unroll
                for (int h = 0; h < 2; ++h) v2[h][i] = OFF_A(ldaT2, h, i); }
            PG8_LDB(B0, 0, 0); PG8_SCHED; PG8_LDA(At, 0, 0); PG8_STAGE(PG8_SA(1, 1), a1, vA1s);
            PG8_WAIT_L(8); PG8_BAR; PG8_WAIT_L(0); PG8_MMA(0, 0, At, B0); PG8_BAR; PG8_SCHED;
            PG8_LDB(B1, 0, 1); PG8_STAGE(PG8_SB(0, 0), b2, voffB);
            PG8_BAR; PG8_WAIT_L(0); PG8_MMA(0, 1, At, B1); PG8_BAR;
            PG8_LDA(At, 0, 1); PG8_STAGE(PG8_SA(0, 0), a2, v2[0]);
            PG8_BAR; PG8_WAIT_L(0); PG8_MMA(1, 0, At, B0); PG8_BAR; PG8_SCHED;
            PG8_STAGE(PG8_SB(0, 1), b2 + hstepB, voffB);
            PG8_WAIT_V(6); PG8_BAR; PG8_MMA(1, 1, At, B1); PG8_BAR;
            PG8_LDB(B0, 1, 0); PG8_SCHED; PG8_LDA(At, 1, 0); PG8_STAGE(PG8_SA(0, 1), a2, v2[1]);
            PG8_WAIT_L(8); PG8_BAR; PG8_WAIT_L(0); PG8_MMA(0, 0, At, B0); PG8_BAR; PG8_SCHED;
            PG8_LDB(B1, 1, 1); PG8_STAGE(PG8_SB(1, 0), b3, voffB);
            PG8_BAR; PG8_WAIT_L(0); PG8_MMA(0, 1, At, B1); PG8_BAR;
            PG8_LDA(At, 1, 1); PG8_STAGE(PG8_SA(1, 0), a3, v2[0]);
            PG8_BAR; PG8_WAIT_L(0); PG8_MMA(1, 0, At, B0); PG8_BAR; PG8_SCHED;
            PG8_STAGE(PG8_SB(1, 1), b3 + hstepB, voffB);
            PG8_WAIT_V(6); PG8_BAR; PG8_MMA(1, 1, At, B1); PG8_BAR;
            if (t == nt1 - 2) E.mid(acc, cur, wr, wc, fr, fq);
        }
        E(acc, cur, wr, wc, fr, fq);
        if (!has_next) break;
#pragma unroll
        for (int a = 0; a < 2; ++a)
#pragma unroll
            for (int b = 0; b < 2; ++b)
#pragma unroll
                for (int m = 0; m < 4; ++m)
#pragma unroll
                    for (int n = 0; n < 2; ++n) acc[a][b][m][n] = (f32x4){0.f, 0.f, 0.f, 0.f};
        cur = nxt; cA1 = nA; cB1 = nB; cA2 = pr.abase2(cur); cB2 = pr.bbase2(cur); ++ui;
    }
    PG8_WAIT_V(0);
    if (wr == 0) PG8_BAR;
    PG8_BAR;
#undef T_A
#undef T_B
#undef OFF_A
#undef OFF_B
#undef PG8_SA
#undef PG8_SB
#undef PG8_STAGE
#undef PG8_LDA
#undef PG8_LDB
#undef PG8_MMA
#undef PG8_WAIT_V
#undef PG8_WAIT_L
#undef PG8_BAR
#undef PG8_SCHED
}
}
using pg8::Unit;

struct ProbPlain {
    static constexpr bool GATHER = false;
    const bf16_t* A; const bf16_t* B; int K, lda, ldb;
    __device__ __forceinline__ const char* abase(const Unit& u) const { return (const char*)(A + (size_t)u.pm * 256 * lda); }
    __device__ __forceinline__ const char* bbase(const Unit& u) const { return (const char*)(B + (size_t)u.pn * 256 * ldb); }
    __device__ __forceinline__ void avoff(const Unit&, const int (&RA)[2], const int (&CA)[2], unsigned (&v)[2][2]) const {
#pragma unroll
        for (int h = 0; h < 2; ++h)
#pragma unroll
            for (int i = 0; i < 2; ++i) v[h][i] = (unsigned)((h * 128 + RA[i]) * lda + CA[i]) * 2u;
    }
};
struct ProbMerge {
    const bf16_t* A1; const bf16_t* B1; const bf16_t* A2; const bf16_t* B2; int K1, K2, lda1, ldb1, lda2, ldb2;
    __device__ __forceinline__ const char* abase1(const Unit& u) const { return (const char*)(A1 + (size_t)u.pm * 256 * lda1); }
    __device__ __forceinline__ const char* bbase1(const Unit& u) const { return (const char*)(B1 + (size_t)u.pn * 256 * ldb1); }
    __device__ __forceinline__ const char* abase2(const Unit& u) const { return (const char*)(A2 + (size_t)u.pm * 256 * lda2); }
    __device__ __forceinline__ const char* bbase2(const Unit& u) const { return (const char*)(B2 + (size_t)u.pn * 256 * ldb2); }
};
struct ProbPQ {
    static constexpr bool GATHER = false;
    const bf16_t* A; const bf16_t* B; int K, lda, ldb;
    __device__ __forceinline__ const char* abase(const Unit& u) const { return (const char*)(A + (size_t)u.pm * 256 * lda); }
    __device__ __forceinline__ const char* bbase(const Unit& u) const { return (const char*)(B + ((size_t)(u.pn >> 4) * 4096 + (u.pn & 15)) * 1024); }
    __device__ __forceinline__ void avoff(const Unit&, const int (&RA)[2], const int (&CA)[2], unsigned (&v)[2][2]) const {
#pragma unroll
        for (int h = 0; h < 2; ++h)
#pragma unroll
            for (int i = 0; i < 2; ++i) v[h][i] = (unsigned)((h * 128 + RA[i]) * lda + CA[i]) * 2u;
    }
};
struct ProbMoeUp {
    static constexpr bool GATHER = true;
    const bf16_t* A; const bf16_t* B; const int* idx; int K, lda, ldb;
    __device__ __forceinline__ const char* abase(const Unit&) const { return (const char*)A; }
    __device__ __forceinline__ const char* bbase(const Unit& u) const { return (const char*)(B + ((size_t)(u.pm >> 4) * 3072 + (size_t)u.pn * 256) * ldb); }
    __device__ __forceinline__ void avoff(const Unit& u, const int (&RA)[2], const int (&CA)[2], unsigned (&v)[2][2]) const {
#pragma unroll
        for (int h = 0; h < 2; ++h)
#pragma unroll
            for (int i = 0; i < 2; ++i) { const int g = idx[u.pm * 256 + h * 128 + RA[i]]; v[h][i] = (unsigned)(g * lda + CA[i]) * 2u; }
    }
};
struct ProbMoeDown {
    static constexpr bool GATHER = false;
    const bf16_t* A; const bf16_t* B; int K, lda, ldb;
    __device__ __forceinline__ const char* abase(const Unit& u) const { return (const char*)(A + (size_t)u.pm * 256 * lda); }
    __device__ __forceinline__ const char* bbase(const Unit& u) const { return (const char*)(B + ((size_t)(u.pm >> 4) * 1024 + (size_t)u.pn * 256) * ldb); }
    __device__ __forceinline__ void avoff(const Unit&, const int (&RA)[2], const int (&CA)[2], unsigned (&v)[2][2]) const {
#pragma unroll
        for (int h = 0; h < 2; ++h)
#pragma unroll
            for (int i = 0; i < 2; ++i) v[h][i] = (unsigned)((h * 128 + RA[i]) * lda + CA[i]) * 2u;
    }
};

#define EPI_ROWS(...) _Pragma("unroll") for (int ai = 0; ai < 2; ++ai) _Pragma("unroll") for (int m = 0; m < 4; ++m) { const int row = u.pm * 256 + ai * 128 + wr * 64 + m * 16 + fr; __VA_ARGS__ }
__device__ __forceinline__ u32x4 pack8(const f32x4 v0, const f32x4 v1) { u32x4 w; w.x = cvt_pk_bf16(v0[0], v0[1]); w.y = cvt_pk_bf16(v0[2], v0[3]); w.z = cvt_pk_bf16(v1[0], v1[1]); w.w = cvt_pk_bf16(v1[2], v1[3]); return w; }

struct EpiPQ {
    static constexpr bool PERM = true; bf16_t* O;
    __device__ __forceinline__ void operator()(const f32x4 (&acc)[2][2][4][2], const Unit& u, int wr, int wc, int fr, int fq) const {
        const int t10 = wc * 32 + 8 * fq, b = u.pn >> 4, t2 = u.pn & 15;
        EPI_ROWS(
            bf16_t* rp = O + ((size_t)((b * 256 + (row >> 1)) * 16 + t2) * 512 + (row & 1) * 256 + t10);
            if (m == 0 && wr == 0 && fr == 1) {
                bf16_t* sp = O + ((size_t)(32768 + (b * 4 + (row >> 7)) * 16 + t2) * 512 + t10);
                _Pragma("unroll") for (int bj = 0; bj < 2; ++bj) { *(u32x4*)(sp + bj * 128) = pack8(acc[ai][bj][m][0], acc[ai][bj][m][1]); *(u32x4*)(sp + 256 + bj * 128) = (u32x4){0u, 0u, 0u, 0u}; *(u32x4*)(rp + bj * 128) = (u32x4){0u, 0u, 0u, 0u}; }
            } else {
                _Pragma("unroll") for (int bj = 0; bj < 2; ++bj) *(u32x4*)(rp + bj * 128) = pack8(acc[ai][bj][m][0], acc[ai][bj][m][1]);
            }
        )
    }
};
struct EpiPlain {
    static constexpr bool PERM = true; bf16_t* O; size_t ldc;
    __device__ __forceinline__ void operator()(const f32x4 (&acc)[2][2][4][2], const Unit& u, int wr, int wc, int fr, int fq) const {
        const int col0 = u.pn * 256 + wc * 32 + 8 * fq;
        EPI_ROWS(
            bf16_t* rp = O + (size_t)row * ldc + col0;
            _Pragma("unroll") for (int bj = 0; bj < 2; ++bj) *(u32x4*)(rp + bj * 128) = pack8(acc[ai][bj][m][0], acc[ai][bj][m][1]);
        )
    }
};
struct EpiZ {
    static constexpr bool PERM = true; bf16_t* O; int ldc; int fixed_act;
    __device__ __forceinline__ void operator()(const f32x4 (&acc)[2][2][4][2], const Unit& u, int wr, int wc, int fr, int fq) const {
        const int col0 = u.pn * 256 + wc * 32 + 8 * fq; const int act = fixed_act >= 0 ? fixed_act : (u.pn >> 2);
        EPI_ROWS(
            bf16_t* rp = O + (size_t)row * ldc + col0;
            _Pragma("unroll") for (int bj = 0; bj < 2; ++bj) {
                f32x4 v0 = acc[ai][bj][m][0], v1 = acc[ai][bj][m][1];
                if (act == 1) { _Pragma("unroll") for (int j = 0; j < 4; ++j) { v0[j] = gelu_tanh(v0[j]); v1[j] = gelu_tanh(v1[j]); } }
                else if (act >= 2) { _Pragma("unroll") for (int j = 0; j < 4; ++j) { v0[j] = sigmoidf_(v0[j]); v1[j] = sigmoidf_(v1[j]); } }
                *(u32x4*)(rp + bj * 128) = pack8(v0, v1); }
        )
    }
};
struct EpiMerge {
    static constexpr bool PERM = true; bf16_t* O; const bf16_t* Z;
    __device__ __forceinline__ void mid(f32x4 (&acc)[2][2][4][2], const Unit& u, int wr, int wc, int fr, int fq) const {
        unsigned eo = (unsigned)((u.pm * 256 + wr * 64 + fr) * 4096 + 2048 + u.pn * 256 + wc * 32 + 8 * fq);
        asm volatile("" : "+v"(eo));
#pragma unroll
        for (int ai = 0; ai < 2; ++ai) {
            u32x4 wa[4][2], wb[4][2];
#pragma unroll
            for (int m = 0; m < 4; ++m)
#pragma unroll
                for (int bj = 0; bj < 2; ++bj) { const unsigned o = eo + (unsigned)((ai * 128 + m * 16) * 4096 + bj * 128); wa[m][bj] = __builtin_nontemporal_load((const u32x4*)(Z + o)); wb[m][bj] = *(const u32x4*)(Z + o + 1024); }
#pragma unroll
            for (int m = 0; m < 4; ++m)
#pragma unroll
                for (int bj = 0; bj < 2; ++bj) { float ga[8], gb[8]; unpack8(wa[m][bj], ga); unpack8(wb[m][bj], gb);
#pragma unroll
                    for (int j = 0; j < 4; ++j) { acc[ai][bj][m][0][j] *= ga[j] * __builtin_amdgcn_rcpf(fmaxf(gb[j], 1e-30f)); acc[ai][bj][m][1][j] *= ga[4 + j] * __builtin_amdgcn_rcpf(fmaxf(gb[4 + j], 1e-30f)); } }
            __builtin_amdgcn_sched_barrier(0); }
    }
    __device__ __forceinline__ void operator()(const f32x4 (&acc)[2][2][4][2], const Unit& u, int wr, int wc, int fr, int fq) const {
        unsigned eo = (unsigned)((u.pm * 256 + wr * 64 + fr) * 4096 + 3072 + u.pn * 256 + wc * 32 + 8 * fq); asm volatile("" : "+v"(eo));
        unsigned oo = (unsigned)((u.pm * 256 + wr * 64 + fr) * 1024 + u.pn * 256 + wc * 32 + 8 * fq); asm volatile("" : "+v"(oo));
        u32x4 wb[2][4][2];
#pragma unroll
        for (int ai = 0; ai < 2; ++ai)
#pragma unroll
            for (int m = 0; m < 4; ++m)
#pragma unroll
                for (int bj = 0; bj < 2; ++bj) wb[ai][m][bj] = __builtin_nontemporal_load((const u32x4*)(Z + eo + (unsigned)((ai * 128 + m * 16) * 4096 + bj * 128)));
#pragma unroll
        for (int ai = 0; ai < 2; ++ai)
#pragma unroll
            for (int m = 0; m < 4; ++m)
#pragma unroll
                for (int bj = 0; bj < 2; ++bj) { float g[8]; unpack8(wb[ai][m][bj], g);
                    f32x4 v0 = acc[ai][bj][m][0], v1 = acc[ai][bj][m][1];
#pragma unroll
                    for (int j = 0; j < 4; ++j) { v0[j] *= g[j]; v1[j] *= g[4 + j]; }
                    *(u32x4*)(O + oo + (unsigned)((ai * 128 + m * 16) * 1024 + bj * 128)) = pack8(v0, v1); }
    }
};
struct EpiOut {
    static constexpr bool PERM = true; bf16_t* O; const float* X; const float* pos; const float* ada;
    __device__ __forceinline__ void operator()(const f32x4 (&acc)[2][2][4][2], const Unit& u, int wr, int wc, int fr, int fq) const {
        const int col0 = u.pn * 256 + wc * 32 + 8 * fq; const int b = u.pm >> 4;
        unsigned ro = (unsigned)((u.pm * 256 + wr * 64 + fr) * 1024 + col0); asm volatile("" : "+v"(ro));
#pragma unroll
        for (int ai = 0; ai < 2; ++ai)
#pragma unroll
            for (int mh = 0; mh < 2; ++mh) {
                f32x4 xv[2][2][2];
#pragma unroll
                for (int m2 = 0; m2 < 2; ++m2)
#pragma unroll
                    for (int bj = 0; bj < 2; ++bj)
#pragma unroll
                        for (int n = 0; n < 2; ++n) xv[m2][bj][n] = __builtin_nontemporal_load((const f32x4*)(X + ro + (unsigned)((ai * 128 + (mh * 2 + m2) * 16) * 1024 + bj * 128 + n * 4)));
#pragma unroll
                for (int m2 = 0; m2 < 2; ++m2) { const int m = mh * 2 + m2; const int row = u.pm * 256 + ai * 128 + wr * 64 + m * 16 + fr; const int t = row & 4095;
#pragma unroll
                    for (int bj = 0; bj < 2; ++bj) { f32x4 o[2];
#pragma unroll
                        for (int n = 0; n < 2; ++n) { const int col = col0 + bj * 128 + n * 4;
                            const f32x4 pv = *(const f32x4*)(pos + (col < 512 ? (t >> 6) * 512 + col : (t & 63) * 512 + (col - 512)));
                            const f32x4 gv = *(const f32x4*)(ada + b * 6144 + 2048 + col);
                            o[n] = xv[m2][bj][n] + pv + gv * acc[ai][bj][m][n]; }
                        *(u32x4*)(O + ro + (unsigned)((ai * 128 + m * 16) * 1024 + bj * 128)) = pack8(o[0], o[1]); } }
                __builtin_amdgcn_sched_barrier(0); }
    }
};
struct EpiGU {
    static constexpr bool PERM = true; bf16_t* O;
    __device__ __forceinline__ void operator()(const f32x4 (&acc)[2][2][4][2], const Unit& u, int wr, int wc, int fr, int fq) const {
        const int col0 = u.pn * 128 + wc * 32 + 8 * fq;
        EPI_ROWS(
            f32x4 v0, v1;
            _Pragma("unroll") for (int j = 0; j < 4; ++j) { const float g0 = acc[ai][0][m][0][j], g1 = acc[ai][0][m][1][j];
                v0[j] = g0 * sigmoidf_(g0) * acc[ai][1][m][0][j]; v1[j] = g1 * sigmoidf_(g1) * acc[ai][1][m][1][j]; }
            *(u32x4*)(O + (size_t)row * DE + col0) = pack8(v0, v1);
        )
    }
};
struct EpiDown {
    static constexpr bool PERM = true; bf16_t* O; const float* gate;
    __device__ __forceinline__ void operator()(const f32x4 (&acc)[2][2][4][2], const Unit& u, int wr, int wc, int fr, int fq) const {
        const int col0 = u.pn * 256 + wc * 32 + 8 * fq;
        EPI_ROWS(
            const float g = gate[row];
            _Pragma("unroll") for (int bj = 0; bj < 2; ++bj) *(u32x4*)(O + (size_t)row * 1024 + col0 + bj * 128) = pack8(acc[ai][bj][m][0] * g, acc[ai][bj][m][1] * g);
        )
    }
};

__device__ __forceinline__ void p0_ada(const Params& p, LAS unsigned char* lds, int item) {
    const int tid = threadIdx.x, lane = tid & 63, wv = tid >> 6;
    LAS float* s = (LAS float*)lds; LAS float* red = s + 9 * 1024;
    { float cv[18];
#pragma unroll
      for (int k = 0; k < 18; ++k) { const int i = tid + NTHR * k, r = i >> 10, d = i & 1023; cv[k] = r < 8 ? p.c[r * 1024 + d] : p.c_ctx[d]; }
#pragma unroll
      for (int k = 0; k < 18; ++k) s[tid + NTHR * k] = cv[k] * __builtin_amdgcn_rcpf(1.0f + __expf(-cv[k])); }
    __syncthreads();
    const int col = lane % 24, dh = lane / 24;
    const int dsl = wv * 128 + dh * 64;
    float a[9];
#pragma unroll
    for (int r = 0; r < 9; ++r) a[r] = 0.f;
    if (dh < 2) {
        const float* w = p.w_ada + (size_t)dsl * 6144 + item * 24 + col;
        for (int d0 = 0; d0 < 64; d0 += 32) { float wv2[32];
#pragma unroll
            for (int j = 0; j < 32; ++j) wv2[j] = __builtin_nontemporal_load(w + (size_t)(d0 + j) * 6144);
#pragma unroll
            for (int j = 0; j < 32; ++j)
#pragma unroll
                for (int r = 0; r < 9; ++r) a[r] += s[r * 1024 + dsl + d0 + j] * wv2[j]; }
#pragma unroll
        for (int r = 0; r < 9; ++r) red[((wv * 2 + dh) * 9 + r) * 24 + col] = a[r];
    }
    __syncthreads();
    float* ada = (float*)(p.ws + WS_ADA);
    if (tid < 9 * 24) { const int r = tid / 24, cc = tid % 24; float v = 0.f;
#pragma unroll
        for (int k = 0; k < 16; ++k) v += red[(k * 9 + r) * 24 + cc];
        __hip_atomic_store(ada + r * 6144 + item * 24 + cc, v + p.b_ada[item * 24 + cc], __ATOMIC_RELAXED, __HIP_MEMORY_SCOPE_AGENT); }
    asm volatile("s_waitcnt vmcnt(0)" ::: "memory");
    __syncthreads();
    if (tid == 0) (void)__hip_atomic_fetch_add((unsigned*)(p.ws + WS_BAR + 46 * KiB), 1u, __ATOMIC_RELAXED, __HIP_MEMORY_SCOPE_AGENT);
}
template <int NS>
__device__ __forceinline__ void xpose_item(const float* src, int ldsrc, bf16_t* dst, int lddst, int k0, int n0, int mode, float scale = 1.0f) {
    const int tid = threadIdx.x, k8 = tid & 7, nq = tid >> 3;
    if (nq >= 16 * NS) return;
    f32x4 v[8];
#pragma unroll
    for (int j = 0; j < 8; ++j) v[j] = __builtin_nontemporal_load((const f32x4*)(src + (size_t)(k0 + 8 * k8 + j) * ldsrc + n0 + 4 * nq));
#pragma unroll
    for (int c = 0; c < 4; ++c) { const int n = n0 + 4 * nq + c; int row = n;
        if (mode) row = (n >> 7) * 256 + (n & 127) + (mode == 2 ? 128 : 0);
        u32x4 w; w.x = cvt_pk_bf16(v[0][c] * scale, v[1][c] * scale); w.y = cvt_pk_bf16(v[2][c] * scale, v[3][c] * scale); w.z = cvt_pk_bf16(v[4][c] * scale, v[5][c] * scale); w.w = cvt_pk_bf16(v[6][c] * scale, v[7][c] * scale);
        *(u32x4*)(dst + (size_t)row * lddst + k0 + 8 * k8) = w; }
}
__device__ __forceinline__ void p0_wpq(const Params& p, LAS unsigned char* lds, int item) {
    const int tid = threadIdx.x, g = item >> 5, db = item & 31;
    LAS float* wl = (LAS float*)lds; LAS float* ct = wl + 32 * 129;
    for (int i = tid; i < 32 * 128; i += NTHR) { const int d = i >> 7, cc = i & 127; wl[d * 129 + cc] = p.w_in[(size_t)(db * 32 + d) * 4608 + g * 128 + cc]; }
    if (tid < 128) { float sn, cs; sincospif((float)tid * (1.0f / 64.0f), &sn, &cs); ct[tid] = cs; ct[128 + tid] = sn; }
    __syncthreads();
    const int q = tid & 127, kc = q >> 1, pq = q & 1, dh = tid >> 7; const int n = (g * 64 + kc) * 2 + pq;
    const bool spec = (kc == 0 && pq == 1); const int kce = spec ? 64 : kc, tsel = spec ? 0 : pq * 128;
    bf16_t* dst = (bf16_t*)(p.ws + WS_WPQ) + (size_t)n * 1024 + db * 32 + dh * 8;
    const float scale = 0.001381067932f;
    float a[8];
#pragma unroll
    for (int j = 0; j < 8; ++j) a[j] = 0.f;
    for (int cc = 0; cc < 128; ++cc) { const float tv = ct[tsel + ((cc * kce) & 127)];
#pragma unroll
        for (int j = 0; j < 8; ++j) a[j] += wl[(dh * 8 + j) * 129 + cc] * tv; }
    u32x4 w; w.x = cvt_pk_bf16(a[0] * scale, a[1] * scale); w.y = cvt_pk_bf16(a[2] * scale, a[3] * scale); w.z = cvt_pk_bf16(a[4] * scale, a[5] * scale); w.w = cvt_pk_bf16(a[6] * scale, a[7] * scale);
    *(u32x4*)dst = w;
    __syncthreads();
}
__device__ __forceinline__ void p0_d1t(const Params& p, int item) {
    bf16_t* dst = (bf16_t*)(p.ws + WS_D1T);
    const int row = item * 64 + (threadIdx.x >> 3), k1 = row >> 1, ri = row & 1, c0 = (threadIdx.x & 7) * 64;
    for (int c8 = 0; c8 < 64; c8 += 8) { float v[8];
#pragma unroll
        for (int j = 0; j < 8; ++j) { const int col = c0 + c8 + j, pq = col >> 8, t1 = col & 255; float sn, cs; sincospif((float)((k1 * t1) & 255) * (1.0f / 128.0f), &sn, &cs);
            v[j] = (ri == 0) ? (pq == 0 ? cs : -sn) : (pq == 0 ? -sn : -cs); }
        u32x4 w; w.x = cvt_pk_bf16(v[0], v[1]); w.y = cvt_pk_bf16(v[2], v[3]); w.z = cvt_pk_bf16(v[4], v[5]); w.w = cvt_pk_bf16(v[6], v[7]);
        *(u32x4*)(dst + (size_t)row * 512 + c0 + c8) = w; }
}
__device__ __forceinline__ void p0_d2t(const Params& p, int item) {
    bf16_t* dst = (bf16_t*)(p.ws + WS_D2T);
#pragma unroll
    for (int ps = 0; ps < 4; ++ps) { const int pc = (item * 4 + ps) * NTHR + threadIdx.x, tp = pc >> 2, kk0 = (pc & 3) * 8; float v[8];
#pragma unroll
        for (int j = 0; j < 8; ++j) { const int kk = kk0 + j, ri = kk >> 4, t2 = kk & 15; float sn, cs; sincospif((float)((tp * t2) & 4095) * (1.0f / 2048.0f), &sn, &cs); v[j] = ri ? sn : cs; }
        u32x4 w; w.x = cvt_pk_bf16(v[0], v[1]); w.y = cvt_pk_bf16(v[2], v[3]); w.z = cvt_pk_bf16(v[4], v[5]); w.w = cvt_pk_bf16(v[6], v[7]);
        *(u32x4*)(dst + (size_t)tp * 32 + kk0) = w; }
}
__device__ __forceinline__ void p0_pos(const Params& p, int item) {
    float* tab = (float*)(p.ws + WS_POS);
    for (int i = item * 2048 + threadIdx.x; i < (item + 1) * 2048; i += NTHR) { const int ii = i >> 9, j = i & 511, jj = j & 255; const float f = expf(-9.210340371976184f * (float)jj / 256.0f); const float a = (float)ii * f;
        __hip_atomic_store(tab + i, j < 256 ? sinf(a) : cosf(a), __ATOMIC_RELAXED, __HIP_MEMORY_SCOPE_AGENT); }
    asm volatile("s_waitcnt vmcnt(0)" ::: "memory");
    __syncthreads();
    if (threadIdx.x == 0) (void)__hip_atomic_fetch_add((unsigned*)(p.ws + WS_BAR + 46 * KiB), 1u, __ATOMIC_RELAXED, __HIP_MEMORY_SCOPE_AGENT);
}
__device__ __forceinline__ void phase0(const Params& p, LAS unsigned char* lds) {
    constexpr int N_ADA = 256, N_WIN = 16 * 16, N_WFOUR = 8 * 4, N_SQ = 16 * 4, N_LRU = 16 * 2, N_WPQ = 128, N_DFT = 8 + 8, N_POS = 16;
    constexpr int O1 = N_ADA, O2 = O1 + N_WIN, O3 = O2 + N_WFOUR, O4 = O3 + N_SQ, O5 = O4 + N_SQ, O6 = O5 + N_LRU, O7 = O6 + N_LRU, O8 = O7 + N_WPQ, O9 = O8 + N_DFT, O10 = O9 + N_POS;
    for (int it0 = blockIdx.x; it0 < O10; it0 += gridDim.x) {
        if (it0 < O1) { p0_ada(p, lds, it0); continue; }
        if (it0 < O1 + N_POS) { p0_pos(p, it0 - O1); continue; }
        const int it = it0 - N_POS;
        if (it < O2) { const int j = it - O1; xpose_item<4>(p.w_in + 512, 4608, (bf16_t*)(p.ws + WS_WIN), 1024, (j >> 4) * 64, (j & 15) * 256, 0); }
        else if (it < O3) { const int j = it - O2; xpose_item<4>(p.w_four, 1024, (bf16_t*)(p.ws + WS_WFOUR), 512, (j >> 2) * 64, (j & 3) * 256, 0); }
        else if (it < O4) { const int j = it - O3; xpose_item<4>(p.w_lru, 1024, (bf16_t*)(p.ws + WS_WLRU), 1024, (j >> 2) * 64, (j & 3) * 256, 0); }
        else if (it < O5) { const int j = it - O4; xpose_item<4>(p.w_out, 1024, (bf16_t*)(p.ws + WS_WOUT), 1024, (j >> 2) * 64, (j & 3) * 256, 0); }
        else if (it < O6) { const int j = it - O5, mtx = j >> 1; xpose_item<2>(p.lru_wa + (size_t)mtx * 16384, 128, (bf16_t*)(p.ws + WS_WAT) + (size_t)mtx * 16384, 128, (j & 1) * 64, 0, 0, NLOG2E); }
        else if (it < O7) { const int j = it - O6, mtx = j >> 1; xpose_item<2>(p.lru_wi + (size_t)mtx * 16384, 128, (bf16_t*)(p.ws + WS_WIT) + (size_t)mtx * 16384, 128, (j & 1) * 64, 0, 0, NLOG2E); }
        else if (it < O8) p0_wpq(p, lds, it - O7);
        else { if (it - O8 < 8) p0_d1t(p, it - O8); else p0_d2t(p, it - O8 - 8); }
    }
}

__device__ __forceinline__ void phase1(const Params& p) {
    const int tid = tid_opaque(), lane = tid & 63, wid = tid >> 6;
    const float* ada = (const float*)(p.ws + WS_ADA); const float* tab = (const float*)(p.ws + WS_POS);
    bf16_t* h1 = (bf16_t*)(p.ws + WS_R1); bf16_t* hc = (bf16_t*)(p.ws + WS_HCTX);
    constexpr int NR = MLAT + MCTX, RW = 4;
    for (int row0 = (blockIdx.x * 8 + wid) * RW; row0 < NR; row0 += gridDim.x * 8 * RW) {
        const bool lat = row0 < MLAT; const int mrow = lat ? (row0 >> 12) : 8;
        f32x4 v[RW][4]; float ss[RW];
#pragma unroll
        for (int r = 0; r < RW; ++r) { const int row = row0 + r; const float* xr = lat ? p.x + (size_t)row * 1024 : p.ctx + (size_t)(row - MLAT) * 1024;
#pragma unroll
            for (int i = 0; i < 4; ++i) v[r][i] = __builtin_nontemporal_load((const f32x4*)(xr + 256 * i + 4 * lane)); }
#pragma unroll
        for (int r = 0; r < RW; ++r) { const int t = (row0 + r) & 4095; float a = 0.f;
#pragma unroll
            for (int i = 0; i < 4; ++i) { const int d = 256 * i + 4 * lane;
                if (lat) v[r][i] += *(const f32x4*)(tab + (i < 2 ? (t >> 6) * 512 + d : (t & 63) * 512 + d - 512));
                a += v[r][i][0] * v[r][i][0] + v[r][i][1] * v[r][i][1] + v[r][i][2] * v[r][i][2] + v[r][i][3] * v[r][i][3]; }
            ss[r] = a; }
#pragma unroll
        for (int o = 32; o >= 1; o >>= 1) {
#pragma unroll
            for (int r = 0; r < RW; ++r) ss[r] += __shfl_xor(ss[r], o); }
#pragma unroll
        for (int i = 0; i < 4; ++i) { const int d = 256 * i + 4 * lane;
            const f32x4 g = *(const f32x4*)(p.norm1_g + d), sh = *(const f32x4*)(ada + mrow * 6144 + d), sc = *(const f32x4*)(ada + mrow * 6144 + 1024 + d);
#pragma unroll
            for (int r = 0; r < RW; ++r) { const int row = row0 + r; const float rs = rsqrtf(ss[r] * (1.0f / 1024.0f) + 1e-6f);
                bf16_t* dst = lat ? h1 + (size_t)row * 1024 : hc + (size_t)(row - MLAT) * 1024;
                const f32x4 h = v[r][i] * rs * g * (sc + 1.0f) + sh;
                u32x2 w; w.x = cvt_pk_bf16(h[0], h[1]); w.y = cvt_pk_bf16(h[2], h[3]); *(u32x2*)(dst + d) = w; } }
    }
}

#define LRU_CST(mb, r) (32 * (mb) + 8 * ((r) >> 2) + ((r) & 3))
template <bool FINAL, int DIR>
__device__ __forceinline__ void lru_wave(const Params& p, LAS unsigned char* ul, int b, int sc, int head, int cb, int lane, f32x16 (&accI)[4]) {
    constexpr int SG = DIR ? -1 : 1;
    const int lr = lane & 31, lh = lane >> 5;
    const int chl = cb * 32 + lr, ch = head * 128 + chl;
    const int tbase = DIR ? 127 - 4 * lh : 4 * lh;
    f32x16 accA[4];
#pragma unroll
    for (int mb = 0; mb < 4; ++mb)
#pragma unroll
        for (int r = 0; r < 16; ++r) { accA[mb][r] = 0.f; accI[mb][r] = 0.f; }
    {
        const bf16_t* wa = (const bf16_t*)(p.ws + WS_WAT) + ((size_t)(DIR * 8 + head) * 128 + chl) * 128 + 8 * lh;
        const bf16_t* wi = (const bf16_t*)(p.ws + WS_WIT) + ((size_t)(DIR * 8 + head) * 128 + chl) * 128 + 8 * lh;
        LAS unsigned char* arow0 = ul + (DIR ? 127 - lr : lr) * 272 + lh * 16;
#pragma unroll
        for (int kc = 0; kc < 2; ++kc) { bf16x8 bA[4], bI[4];
#pragma unroll
            for (int k4 = 0; k4 < 4; ++k4) { bA[k4] = *(const bf16x8*)(wa + 16 * (kc * 4 + k4)); bI[k4] = *(const bf16x8*)(wi + 16 * (kc * 4 + k4)); }
#pragma unroll
            for (int mb = 0; mb < 4; ++mb)
#pragma unroll
                for (int k4 = 0; k4 < 4; ++k4) { const bf16x8 af = *(const LAS bf16x8*)(arow0 + SG * 32 * mb * 272 + 32 * (kc * 4 + k4));
                    accA[mb] = __builtin_amdgcn_mfma_f32_32x32x16_bf16(af, bA[k4], accA[mb], 0, 0, 0);
                    accI[mb] = __builtin_amdgcn_mfma_f32_32x32x16_bf16(af, bI[k4], accI[mb], 0, 0, 0); }
            __builtin_amdgcn_sched_barrier(0); }
    }
    {
        const float lam = p.lru_lambda[DIR * 1024 + ch]; const float sp8 = 8.0f * log1pf(expf(-lam));
        const float ba = p.lru_ba[DIR * 1024 + ch], bi = p.lru_bi[DIR * 1024 + ch];
        LAS unsigned char* up = ul + tbase * 272 + chl * 2;
#pragma unroll
        for (int mb = 0; mb < 4; ++mb) {
#pragma unroll
            for (int r = 0; r < 16; ++r) {
                const float uv = bf2f(*(const LAS bf16_t*)(up + SG * LRU_CST(mb, r) * 272));
                const float rg = __builtin_amdgcn_rcpf(1.0f + __builtin_amdgcn_exp2f(accA[mb][r] + NLOG2E * ba)), ig = __builtin_amdgcn_rcpf(1.0f + __builtin_amdgcn_exp2f(accI[mb][r] + NLOG2E * bi));
                const float a = __expf(-sp8 * rg); accA[mb][r] = a; accI[mb][r] = __builtin_amdgcn_sqrtf(fmaxf(1.0f - a * a, 0.f)) * ig * uv; }
            __builtin_amdgcn_sched_barrier(0); }
    }
    float rA[16], rH[16];
#pragma unroll
    for (int mb = 0; mb < 4; ++mb)
#pragma unroll
        for (int q = 0; q < 4; ++q) { float pa = 1.f, hh = 0.f;
#pragma unroll
            for (int j = 0; j < 4; ++j) { const int r = 4 * q + j; const float a = accA[mb][r], bb = accI[mb][r]; hh = a * hh + bb; pa *= a; accA[mb][r] = pa; accI[mb][r] = hh; }
            rA[mb * 4 + q] = pa; rH[mb * 4 + q] = hh; }
    const int agg_dir_off = ((b * NSEQ) * 2 + DIR) * 1024 + ch;
    const float* agg = (const float*)(p.ws + WS_AGG);
    float carry = 0.f;
    if (FINAL) {
        if (DIR == 0) { for (int q = 0; q < sc; ++q) { const float* a2 = agg + (size_t)(agg_dir_off + q * 2048) * 2; carry = a2[0] * carry + a2[1]; } }
        else { { const float* a2 = agg + (size_t)(agg_dir_off + 1 * 2048) * 2; carry = a2[0] * carry + a2[1]; } { const float* a2 = agg + (size_t)(agg_dir_off + 0 * 2048) * 2; carry = a2[0] * carry + a2[1]; }
            for (int q = NSEQ - 1; q > sc; --q) { const float* a2 = agg + (size_t)(agg_dir_off + q * 2048) * 2; carry = a2[0] * carry + a2[1]; } }
    }
    float cin[16];
#pragma unroll
    for (int i = 0; i < 16; ++i) cin[i] = 0.f;
    float s = carry, At = 1.f;
#pragma unroll
    for (int i = 0; i < 16; ++i) { const float oA = __shfl_xor(rA[i], 32), oH = __shfl_xor(rH[i], 32);
        { const bool mine = (lh == 0); const float a = mine ? rA[i] : oA, hh = mine ? rH[i] : oH; cin[i] = mine ? s : cin[i]; s = a * s + hh; At *= a; }
        { const bool mine = (lh == 1); const float a = mine ? rA[i] : oA, hh = mine ? rH[i] : oH; cin[i] = mine ? s : cin[i]; s = a * s + hh; At *= a; } }
    if (!FINAL) {
        if (lh == 0) { float* o = (float*)(p.ws + WS_AGG) + (size_t)(agg_dir_off + sc * 2048) * 2; o[0] = At; o[1] = s; }
        return;
    }
#pragma unroll
    for (int mb = 0; mb < 4; ++mb)
#pragma unroll
        for (int r = 0; r < 16; ++r) accI[mb][r] += accA[mb][r] * cin[mb * 4 + (r >> 2)];
}
template <bool FINAL>
__device__ __forceinline__ void lru_tile(const Params& p, LAS unsigned char* lds, int item) {
    const int tid = threadIdx.x, lane = tid & 63, wid = __builtin_amdgcn_readfirstlane(tid >> 6);
    int b, sc, head;
    if (FINAL) { head = item & 7; sc = 2 + ((item >> 3) & 31); b = item >> 8; }
    else { head = item & 7; const int r = item >> 3; sc = r & 1; b = r >> 1; }
    const bf16_t* src; int Tseq, t0, ld;
    if (sc < 2) { src = (const bf16_t*)(p.ws + WS_ZXC) + (size_t)b * 256 * 1024; Tseq = 256; t0 = sc * 128; ld = 1024; }
    else { src = (const bf16_t*)(p.ws + WS_RZ) + (size_t)b * 4096 * 4096; Tseq = 4096; t0 = (sc - 2) * 128; ld = 4096; }
    LAS unsigned char* ul = lds;
    LAS float* ybuf = (LAS float*)(lds + 36 * 1024);
    {
        const int c8 = tid & 15, tb = tid >> 4; const int ch0 = head * 128 + 8 * c8;
        float w[4][8], bias[8];
#pragma unroll
        for (int k = 0; k < 4; ++k) { const f32x4 a = *(const f32x4*)(p.conv_w + k * 1024 + ch0), c2 = *(const f32x4*)(p.conv_w + k * 1024 + ch0 + 4);
#pragma unroll
            for (int j = 0; j < 4; ++j) { w[k][j] = a[j]; w[k][4 + j] = c2[j]; } }
        { const f32x4 a = *(const f32x4*)(p.conv_b + ch0), c2 = *(const f32x4*)(p.conv_b + ch0 + 4);
#pragma unroll
            for (int j = 0; j < 4; ++j) { bias[j] = a[j]; bias[4 + j] = c2[j]; } }
#pragma unroll
        for (int i = 0; i < 4; ++i) { const int t = tb + 32 * i; float a[8];
#pragma unroll
            for (int j = 0; j < 8; ++j) a[j] = bias[j];
#pragma unroll
            for (int k = 0; k < 4; ++k) { const int tt = t0 + t + k - 2;
                if (tt >= 0 && tt < Tseq) { float f[8]; unpack8(*(const u32x4*)(src + (size_t)tt * ld + ch0), f);
#pragma unroll
                    for (int j = 0; j < 8; ++j) a[j] += w[k][j] * f[j]; } }
            u32x4 wv; wv.x = cvt_pk_bf16(a[0], a[1]); wv.y = cvt_pk_bf16(a[2], a[3]); wv.z = cvt_pk_bf16(a[4], a[5]); wv.w = cvt_pk_bf16(a[6], a[7]);
            *(LAS u32x4*)(ul + t * 272 + c8 * 16) = wv; }
    }
    __syncthreads();
    f32x16 hacc[4];
    if (wid < 4) lru_wave<FINAL, 0>(p, ul, b, sc, head, wid & 3, lane, hacc);
    else lru_wave<FINAL, 1>(p, ul, b, sc, head, wid & 3, lane, hacc);
    if (FINAL) {
        const int lr = lane & 31, lh = lane >> 5, chl = (wid & 3) * 32 + lr;
        if (wid >= 4) { LAS float* yp = ybuf + (127 - 4 * lh) * 129 + chl;
#pragma unroll
            for (int mb = 0; mb < 4; ++mb)
#pragma unroll
                for (int r = 0; r < 16; ++r) yp[-LRU_CST(mb, r) * 129] = hacc[mb][r]; }
        __syncthreads();
        if (wid < 4) {
            const LAS float* yp = ybuf + (4 * lh) * 129 + chl;
            const bf16_t* Zu = (const bf16_t*)(p.ws + WS_RZ) + ((size_t)(b * 4096 + t0) * 4096 + 1024 + head * 128);
            bf16_t* Ou = (bf16_t*)(p.ws + WS_R1) + ((size_t)(b * 4096 + t0) * 1024 + head * 128);
            const unsigned zo = (unsigned)(4 * lh * 4096 + chl), oo = (unsigned)(4 * lh * 1024 + chl);
#pragma unroll
            for (int mb = 0; mb < 4; ++mb) {
#pragma unroll
                for (int r = 0; r < 16; ++r) {
                    const float y = hacc[mb][r] + yp[LRU_CST(mb, r) * 129];
                    const float gz = bf2f(Zu[zo + LRU_CST(mb, r) * 4096]);
                    Ou[oo + LRU_CST(mb, r) * 1024] = (bf16_t)(cvt_pk_bf16(gz * y, 0.f) & 0xffffu);
                    if ((r & 7) == 7) __builtin_amdgcn_sched_barrier(0); } }
        }
    }
    __syncthreads();
}

#ifndef LRU_PF_FRAG
#define LRU_PF_FRAG true
#endif
#ifndef LRU_PF_TILE
#define LRU_PF_TILE true
#endif
template <int DIR, bool PREF>
__device__ __forceinline__ void lru2_dir(const Params& p, LAS unsigned char* ul, int head, int w, int lane, const bf16x8 (&bA)[4], const bf16x8 (&bI)[4], bf16x8 (&nA)[4], bf16x8 (&nI)[4],
                                         f32x4 (&hl)[8], f32x4 (&pp)[8], float& Atot, float& Htot) {
    constexpr int SG = DIR ? -1 : 1;
    const int fr = lane & 15, fq = lane >> 4, chl = 16 * w + fr, ch = head * 128 + chl;
    f32x4 accA[8], accI[8];
    { const float ba2 = NLOG2E * p.lru_ba[DIR * 1024 + ch], bi2 = NLOG2E * p.lru_bi[DIR * 1024 + ch];
#pragma unroll
      for (int rb = 0; rb < 8; ++rb) { accA[rb] = (f32x4){ba2, ba2, ba2, ba2}; accI[rb] = (f32x4){bi2, bi2, bi2, bi2}; } }
    {
        LAS unsigned char* arow0 = ul + (DIR ? 127 - fr : fr) * 272 + fq * 16;
#pragma unroll
        for (int rb = 0; rb < 8; ++rb)
#pragma unroll
            for (int ks = 0; ks < 4; ++ks) { const bf16x8 af = *(const LAS bf16x8*)(arow0 + SG * 16 * rb * 272 + 64 * ks);
                accA[rb] = __builtin_amdgcn_mfma_f32_16x16x32_bf16(af, bA[ks], accA[rb], 0, 0, 0);
                accI[rb] = __builtin_amdgcn_mfma_f32_16x16x32_bf16(af, bI[ks], accI[rb], 0, 0, 0); }
    }
    if (PREF) {
        const bf16_t* wa = (const bf16_t*)(p.ws + WS_WAT) + ((size_t)((1 - DIR) * 8 + head) * 128 + chl) * 128 + 8 * fq;
        const bf16_t* wi = (const bf16_t*)(p.ws + WS_WIT) + ((size_t)((1 - DIR) * 8 + head) * 128 + chl) * 128 + 8 * fq;
#pragma unroll
        for (int ks = 0; ks < 4; ++ks) { nA[ks] = *(const bf16x8*)(wa + 32 * ks); nI[ks] = *(const bf16x8*)(wi + 32 * ks); }
    }
    {
        typedef float f32x2 __attribute__((ext_vector_type(2)));
        const float lam = p.lru_lambda[DIR * 1024 + ch]; const float k2 = NLOG2E * 8.0f * log1pf(expf(-lam));
        LAS unsigned char* up = ul + (DIR ? 127 - 4 * fq : 4 * fq) * 272 + chl * 2;
#pragma unroll
        for (int rb = 0; rb < 8; ++rb)
#pragma unroll
            for (int r = 0; r < 4; r += 2) {
                f32x2 uv; uv.x = bf2f(*(const LAS bf16_t*)(up + SG * (16 * rb + r) * 272)); uv.y = bf2f(*(const LAS bf16_t*)(up + SG * (16 * rb + r + 1) * 272));
                f32x2 ea, ei; ea.x = __builtin_amdgcn_exp2f(accA[rb][r]); ea.y = __builtin_amdgcn_exp2f(accA[rb][r + 1]); ei.x = __builtin_amdgcn_exp2f(accI[rb][r]); ei.y = __builtin_amdgcn_exp2f(accI[rb][r + 1]);
                const f32x2 da = ea + 1.0f, di = ei + 1.0f;
                f32x2 rg, ig; rg.x = __builtin_amdgcn_rcpf(da.x); rg.y = __builtin_amdgcn_rcpf(da.y); ig.x = __builtin_amdgcn_rcpf(di.x); ig.y = __builtin_amdgcn_rcpf(di.y);
                const f32x2 ka = rg * k2;
                f32x2 a; a.x = __builtin_amdgcn_exp2f(ka.x); a.y = __builtin_amdgcn_exp2f(ka.y);
                const f32x2 om = 1.0f - a * a;
                f32x2 sq; sq.x = __builtin_amdgcn_sqrtf(om.x); sq.y = __builtin_amdgcn_sqrtf(om.y);
                const f32x2 bb = sq * ig * uv;
                accA[rb][r] = a.x; accA[rb][r + 1] = a.y; accI[rb][r] = bb.x; accI[rb][r + 1] = bb.y; }
    }
    float rA[8], rH[8];
#pragma unroll
    for (int rb = 0; rb < 8; ++rb) { float pa = 1.f, hh = 0.f;
#pragma unroll
        for (int r = 0; r < 4; ++r) { const float a = accA[rb][r], bb = accI[rb][r]; hh = a * hh + bb; pa *= a; accA[rb][r] = pa; accI[rb][r] = hh; }
        rA[rb] = pa; rH[rb] = hh; }
    float Pc = 1.f, s = 0.f;
#pragma unroll
    for (int rb = 0; rb < 8; ++rb) { float Pin = 1.f, Hin = 0.f;
#pragma unroll
        for (int q = 0; q < 4; ++q) { const float a = __shfl(rA[rb], fr + 16 * q), hh = __shfl(rH[rb], fr + 16 * q);
            if (q == fq) { Pin = Pc; Hin = s; }
            s = a * s + hh; Pc *= a; }
#pragma unroll
        for (int r = 0; r < 4; ++r) { hl[rb][r] = accI[rb][r] + accA[rb][r] * Hin; pp[rb][r] = accA[rb][r] * Pin; }
        __builtin_amdgcn_sched_barrier(0); }
    Atot = Pc; Htot = s;
}
__device__ __forceinline__ u64_t agg_ld(const u64_t* a) { return __hip_atomic_load(a, __ATOMIC_RELAXED, __HIP_MEMORY_SCOPE_AGENT); }
template <int DIR>
__device__ __forceinline__ float lru2_carry(const u64_t* aggc, int n, int fr, int fq) {
    float Ap = 1.f, Hp = 0.f; u64_t v[9];
#pragma unroll
    for (int k = 0; k < 9; ++k) { const int j = fq * 9 + k; const int seq = DIR ? (j == 0 ? 1 : (j == 1 ? 0 : 35 - j)) : j;
        v[k] = (j < n) ? agg_ld(aggc + (size_t)seq * 2048) : 0x000000003f800000ull; }
#pragma unroll
    for (int k = 0; k < 9; ++k) { const float a = __uint_as_float((unsigned)v[k]), hh = __uint_as_float((unsigned)(v[k] >> 32)); Hp = a * Hp + hh; Ap *= a; }
    float s = 0.f;
#pragma unroll
    for (int q = 0; q < 4; ++q) { const float a = __shfl(Ap, fr + 16 * q), hh = __shfl(Hp, fr + 16 * q); s = a * s + hh; }
    return s;
}
__device__ __forceinline__ void lru2_block(const Params& p, LAS unsigned char* lds, int slot, int c, int ngr) {
    const int tid = threadIdx.x, lane = tid & 63, wid = __builtin_amdgcn_readfirstlane(tid >> 6);
    const int sc = c + 2, t0 = c * 128;
    LAS unsigned char* raw = lds;
    LAS unsigned char* ul = lds + 33792;
    LAS unsigned char* gzl = lds + 68608;
    LAS unsigned char* outl = lds + 103424;
    const int fr = lane & 15, fq = lane >> 4, chl = 16 * wid + fr;
    u32x4 nr[5], ng[4];
#define LRU2_LOAD_R(gg) do { const bf16_t* Zb_ = (const bf16_t*)(p.ws + WS_RZ) + (size_t)((gg) >> 3) * 4096 * 4096 + ((gg) & 7) * 128; \
        _Pragma("unroll") for (int k = 0; k < 5; ++k) { const int pc = tid + NTHR * k; nr[k] = (u32x4){0u, 0u, 0u, 0u}; \
            if (pc < 131 * 16) { const int row = pc >> 4, c8 = pc & 15, tt = t0 - 2 + row; if (tt >= 0 && tt < TT) nr[k] = __builtin_nontemporal_load((const u32x4*)(Zb_ + (size_t)tt * 4096 + c8 * 8)); } } } while (0)
#define LRU2_LOAD_G(gg) do { const bf16_t* Zb_ = (const bf16_t*)(p.ws + WS_RZ) + (size_t)((gg) >> 3) * 4096 * 4096 + ((gg) & 7) * 128; \
        _Pragma("unroll") for (int k = 0; k < 4; ++k) { const int pc = tid + NTHR * k, row = pc >> 4, c8 = pc & 15; ng[k] = __builtin_nontemporal_load((const u32x4*)(Zb_ + (size_t)(t0 + row) * 4096 + 1024 + c8 * 8)); } } while (0)
    LRU2_LOAD_R(slot); LRU2_LOAD_G(slot);
    for (int g = slot; g < NB * 8; g += ngr) {
        const int b = g >> 3, head = g & 7, ch = head * 128 + chl;
        unsigned* gcnt = (unsigned*)(p.ws + WS_BAR + 16 * KiB) + g * 64;
        bf16x8 bA1[4], bI1[4], bA0[4], bI0[4];
        { const bf16_t* wa = (const bf16_t*)(p.ws + WS_WAT) + ((size_t)(8 + head) * 128 + chl) * 128 + 8 * fq; const bf16_t* wi = (const bf16_t*)(p.ws + WS_WIT) + ((size_t)(8 + head) * 128 + chl) * 128 + 8 * fq;
#pragma unroll
          for (int ks = 0; ks < 4; ++ks) { bA1[ks] = *(const bf16x8*)(wa + 32 * ks); bI1[ks] = *(const bf16x8*)(wi + 32 * ks); } }
#pragma unroll
        for (int k = 0; k < 5; ++k) { const int pc = tid + NTHR * k; if (pc < 131 * 16) *(LAS u32x4*)(raw + (pc >> 4) * 256 + (pc & 15) * 16) = nr[k]; }
#pragma unroll
        for (int k = 0; k < 4; ++k) { const int pc = tid + NTHR * k; *(LAS u32x4*)(gzl + (pc >> 4) * 272 + (pc & 15) * 16) = ng[k]; }
        __syncthreads();
        {
            const int c8 = tid & 15, tb = tid >> 4; const int ch0 = head * 128 + 8 * c8;
            float w[4][8], bias[8];
#pragma unroll
            for (int k = 0; k < 4; ++k) { const f32x4 a = *(const f32x4*)(p.conv_w + k * 1024 + ch0), c2 = *(const f32x4*)(p.conv_w + k * 1024 + ch0 + 4);
#pragma unroll
                for (int j = 0; j < 4; ++j) { w[k][j] = a[j]; w[k][4 + j] = c2[j]; } }
            { const f32x4 a = *(const f32x4*)(p.conv_b + ch0), c2 = *(const f32x4*)(p.conv_b + ch0 + 4);
#pragma unroll
                for (int j = 0; j < 4; ++j) { bias[j] = a[j]; bias[4 + j] = c2[j]; } }
#pragma unroll
            for (int i = 0; i < 4; ++i) { const int t = tb + 32 * i; float a[8];
#pragma unroll
                for (int j = 0; j < 8; ++j) a[j] = bias[j];
#pragma unroll
                for (int k = 0; k < 4; ++k) { float f[8]; unpack8(*(const LAS u32x4*)(raw + (t + k) * 256 + c8 * 16), f);
#pragma unroll
                    for (int j = 0; j < 8; ++j) a[j] += w[k][j] * f[j]; }
                u32x4 wv; wv.x = cvt_pk_bf16(a[0], a[1]); wv.y = cvt_pk_bf16(a[2], a[3]); wv.z = cvt_pk_bf16(a[4], a[5]); wv.w = cvt_pk_bf16(a[6], a[7]);
                *(LAS u32x4*)(ul + t * 272 + c8 * 16) = wv; }
        }
        __syncthreads();
        float A0, H0, A1, H1;
        {
            f32x4 hl1[8], pp1[8];
            lru2_dir<1, LRU_PF_FRAG>(p, ul, head, wid, lane, bA1, bI1, bA0, bI0, hl1, pp1, A1, H1);
            LAS unsigned char* hp = outl + chl * 264 + (124 - 4 * fq) * 2; LAS unsigned char* qp = raw + chl * 264 + (124 - 4 * fq) * 2;
#pragma unroll
            for (int rb = 0; rb < 8; ++rb) { u32x2 wh, wq; wh.x = cvt_pk_bf16(hl1[rb][3], hl1[rb][2]); wh.y = cvt_pk_bf16(hl1[rb][1], hl1[rb][0]); wq.x = cvt_pk_bf16(pp1[rb][3], pp1[rb][2]); wq.y = cvt_pk_bf16(pp1[rb][1], pp1[rb][0]);
                *(LAS u32x2*)(hp - 32 * rb) = wh; *(LAS u32x2*)(qp - 32 * rb) = wq; }
        }
        __builtin_amdgcn_sched_barrier(0);
        if (!LRU_PF_FRAG) { const bf16_t* wa = (const bf16_t*)(p.ws + WS_WAT) + ((size_t)(head) * 128 + chl) * 128 + 8 * fq; const bf16_t* wi = (const bf16_t*)(p.ws + WS_WIT) + ((size_t)(head) * 128 + chl) * 128 + 8 * fq;
#pragma unroll
          for (int ks = 0; ks < 4; ++ks) { bA0[ks] = *(const bf16x8*)(wa + 32 * ks); bI0[ks] = *(const bf16x8*)(wi + 32 * ks); } }
        f32x4 hl0[8], pp0[8];
        lru2_dir<0, false>(p, ul, head, wid, lane, bA0, bI0, bA1, bI1, hl0, pp0, A0, H0);
        u64_t* agg = (u64_t*)(p.ws + WS_AGG);
        const size_t ai0 = ((size_t)(b * NSEQ) * 2 + 0) * 1024 + ch, ai1 = ((size_t)(b * NSEQ) * 2 + 1) * 1024 + ch;
        if (fq == 0) {
            __hip_atomic_store(agg + ai0 + (size_t)sc * 2048, ((u64_t)__float_as_uint(H0) << 32) | __float_as_uint(A0), __ATOMIC_RELAXED, __HIP_MEMORY_SCOPE_AGENT);
            __hip_atomic_store(agg + ai1 + (size_t)sc * 2048, ((u64_t)__float_as_uint(H1) << 32) | __float_as_uint(A1), __ATOMIC_RELAXED, __HIP_MEMORY_SCOPE_AGENT); }
        asm volatile("s_waitcnt vmcnt(0)" ::: "memory");
        __syncthreads();
        if (tid == 0) (void)__hip_atomic_fetch_add(gcnt, 1u, __ATOMIC_RELAXED, __HIP_MEMORY_SCOPE_AGENT);
        if (wid == 0) { unsigned sp = 0;
            while ((unsigned)__builtin_amdgcn_readfirstlane(__hip_atomic_load(gcnt, __ATOMIC_RELAXED, __HIP_MEMORY_SCOPE_AGENT)) < 32u) { __builtin_amdgcn_s_sleep(1); if (++sp > (1u << 22)) break; }
            __builtin_amdgcn_fence(__ATOMIC_ACQUIRE, "agent");
            asm volatile("s_waitcnt vmcnt(0)" ::: "memory"); }
        __syncthreads();
        const float C0 = lru2_carry<0>(agg + ai0, sc, fr, fq);
        const float C1 = lru2_carry<1>(agg + ai1, 2 + (NSEQ - 1 - sc), fr, fq);
        __builtin_amdgcn_sched_barrier(0);
        if (LRU_PF_TILE) { const int gn = (g + ngr < NB * 8) ? g + ngr : g; LRU2_LOAD_R(gn); LRU2_LOAD_G(gn); }
        __builtin_amdgcn_sched_barrier(0);
        LAS unsigned char* gp = gzl + (4 * fq) * 272 + chl * 2; LAS unsigned char* op = outl + (4 * fq) * 272 + chl * 2;
        const LAS unsigned char* hp1 = outl + chl * 264 + (4 * fq) * 2; const LAS unsigned char* qp1 = raw + chl * 264 + (4 * fq) * 2;
        unsigned ov[16];
#pragma unroll
        for (int rb = 0; rb < 8; ++rb) { const u32x2 wh = *(const LAS u32x2*)(hp1 + 32 * rb), wq = *(const LAS u32x2*)(qp1 + 32 * rb);
            const float h1v[4] = {bf_lo(wh.x), bf_hi(wh.x), bf_lo(wh.y), bf_hi(wh.y)}, q1v[4] = {bf_lo(wq.x), bf_hi(wq.x), bf_lo(wq.y), bf_hi(wq.y)};
            float o[4];
#pragma unroll
            for (int r = 0; r < 4; ++r) { const float y = hl0[rb][r] + pp0[rb][r] * C0 + h1v[r] + q1v[r] * C1;
                o[r] = bf2f(*(const LAS bf16_t*)(gp + (16 * rb + r) * 272)) * y; }
            ov[2 * rb] = cvt_pk_bf16(o[0], o[1]); ov[2 * rb + 1] = cvt_pk_bf16(o[2], o[3]); }
        __syncthreads();
#pragma unroll
        for (int rb = 0; rb < 8; ++rb) { *(LAS bf16_t*)(op + (16 * rb + 0) * 272) = (bf16_t)(ov[2 * rb] & 0xffffu); *(LAS bf16_t*)(op + (16 * rb + 1) * 272) = (bf16_t)(ov[2 * rb] >> 16);
            *(LAS bf16_t*)(op + (16 * rb + 2) * 272) = (bf16_t)(ov[2 * rb + 1] & 0xffffu); *(LAS bf16_t*)(op + (16 * rb + 3) * 272) = (bf16_t)(ov[2 * rb + 1] >> 16); }
        __syncthreads();
        bf16_t* Ob = (bf16_t*)(p.ws + WS_R1) + ((size_t)(b * 4096 + t0)) * 1024 + head * 128;
#pragma unroll
        for (int k = 0; k < 4; ++k) { const int pc = tid + NTHR * k, row = pc >> 4, c8 = pc & 15;
            *(u32x4*)(Ob + (size_t)row * 1024 + c8 * 8) = *(const LAS u32x4*)(outl + row * 272 + c8 * 16); }
        __syncthreads();
        if (!LRU_PF_TILE && g + ngr < NB * 8) LRU2_LOAD_R(g + ngr);
    }
#undef LRU2_LOAD_R
#undef LRU2_LOAD_G
}

__device__ __forceinline__ void fft_stage2_all(const Params& p, LAS unsigned char* lds) {
    const int tid = tid_opaque(), lane = tid & 63, wid = tid >> 6, fr = lane & 15, fq = lane >> 4;
    const bf16_t* Yt = (const bf16_t*)((const unsigned char*)p.out + OUT_YT); const bf16_t* D2 = (const bf16_t*)(p.ws + WS_D2T);
    bf16_t* Fo = (bf16_t*)((unsigned char*)p.out + OUT_F);
    const int G = gridDim.x;
    int it = blockIdx.x; bf16x8 dfr, yfr[3];
    LAS unsigned char* own = lds; LAS unsigned char* mir = lds + 16 * 528;
#define S2_LOAD(item) do { const int b_ = (item) & 7, k1_ = (item) >> 3; dfr = *(const bf16x8*)(D2 + (size_t)(k1_ + 256 * fr) * 32 + 8 * fq); \
        const bf16_t* yrow_ = Yt + (size_t)(k1_ * 2 + (fq >> 1)) * FCOLS + 8 * (fq & 1); \
        _Pragma("unroll") for (int n = 0; n < 2; ++n) yfr[n] = __builtin_nontemporal_load((const bf16x8*)(yrow_ + (size_t)(b_ * 256 + 16 * (2 * wid + n) + fr) * 16)); \
        yfr[2] = __builtin_nontemporal_load((const bf16x8*)(yrow_ + (size_t)(32768 + (b_ * 4 + (fr & 3)) * 16))); } while (0)
    if (it < NB * 256) S2_LOAD(it);
    for (; it < NB * 256; it += G) {
        const int b = it & 7, k1 = it >> 3;
        f32x4 acc[3];
#pragma unroll
        for (int n = 0; n < 3; ++n) acc[n] = __builtin_amdgcn_mfma_f32_16x16x32_bf16(yfr[n], dfr, (f32x4){0.f, 0.f, 0.f, 0.f}, 0, 0, 0);
        const int nx = it + G; if (nx < NB * 256) S2_LOAD(nx);
#pragma unroll
        for (int n = 0; n < 3; ++n) mfma_settle(acc[n]);
#pragma unroll
        for (int n = 0; n < 2; ++n) { const int c0 = 16 * (2 * wid + n) + 4 * fq, g = c0 >> 6, kb = c0 & 63;
            u32x2 w; w.x = cvt_pk_bf16(acc[n][0], acc[n][1]); w.y = cvt_pk_bf16(acc[n][2], acc[n][3]);
            *(LAS u32x2*)(own + fr * 528 + c0 * 2) = w;
            LAS bf16_t* mp = (LAS bf16_t*)(mir + fr * 528) + g * 64 + 64 - kb;
            if (kb != 0) mp[0] = (bf16_t)(w.x & 0xffffu);
            mp[-1] = (bf16_t)(w.x >> 16); mp[-2] = (bf16_t)(w.y & 0xffffu); mp[-3] = (bf16_t)(w.y >> 16); }
        if (wid == 0 && fq == 0) {
            u32x2 w; w.x = cvt_pk_bf16(acc[2][0], acc[2][1]); w.y = cvt_pk_bf16(acc[2][2], acc[2][3]);
            LAS bf16_t* mp = (LAS bf16_t*)(mir + fr * 528);
            mp[0] = (bf16_t)(w.x & 0xffffu); mp[64] = (bf16_t)(w.x >> 16); mp[128] = (bf16_t)(w.y & 0xffffu); mp[192] = (bf16_t)(w.y >> 16); }
        __syncthreads();
        { const int k2 = tid >> 5, c8 = tid & 31, tp = k1 + 256 * k2, tm = (4096 - tp) & 4095, col = (c8 >> 3) * 128 + (c8 & 7) * 8;
          *(u32x4*)(Fo + ((size_t)b * 4096 + tp) * 512 + col) = *(const LAS u32x4*)(own + k2 * 528 + c8 * 16);
          *(u32x4*)(Fo + ((size_t)b * 4096 + tm) * 512 + col + 64) = *(const LAS u32x4*)(mir + k2 * 528 + c8 * 16); }
        __syncthreads();
    }
#undef S2_LOAD
}

__device__ __forceinline__ void topk_task(const Params& p, LAS unsigned char* lds, int it) {
    const int tid = tid_opaque(), lane = tid & 63, wid = tid >> 6;
    LAS unsigned* cnt = (LAS unsigned*)lds;
    LAS unsigned* wsum = cnt + 64;
    const float* scores = (const float*)(p.ws + WS_SCORES);
    int* idx = (int*)(p.ws + WS_IDX); float* gate = (float*)(p.ws + WS_GATE); int* slot_of = (int*)(p.ws + WS_SLOT);
    const int b = it >> 4, e = it & 15;
    unsigned key[8];
    { const u64_t* sp = (const u64_t*)(scores + (size_t)it * 4096 + tid * 8);
#pragma unroll
      for (int j = 0; j < 4; ++j) { const u64_t v = __hip_atomic_load(sp + j, __ATOMIC_RELAXED, __HIP_MEMORY_SCOPE_AGENT); key[2 * j] = (unsigned)v; key[2 * j + 1] = (unsigned)(v >> 32); } }
    unsigned thr = 0;
    for (int step = 0; step < 16; ++step) {
        const int sh = 29 - 2 * step;
        const unsigned c1 = sh >= 0 ? (thr | (1u << sh)) : (thr | 1u), c2 = sh >= 0 ? (thr | (2u << sh)) : 0xffffffffu, c3 = sh >= 0 ? (thr | (3u << sh)) : 0xffffffffu;
        unsigned n1 = 0, n2 = 0, n3 = 0;
#pragma unroll
        for (int j = 0; j < 8; ++j) { n1 += (unsigned)__popcll(__ballot(key[j] >= c1)); n2 += (unsigned)__popcll(__ballot(key[j] >= c2)); n3 += (unsigned)__popcll(__ballot(key[j] >= c3)); }
        LAS unsigned* cb = cnt + (step & 1) * 32;
        if (lane == 0) { cb[wid] = n1; cb[8 + wid] = n2; cb[16 + wid] = n3; }
        __syncthreads();
        unsigned t1 = 0, t2 = 0, t3 = 0;
#pragma unroll
        for (int w = 0; w < 8; ++w) { t1 += cb[w]; t2 += cb[8 + w]; t3 += cb[16 + w]; }
        if (sh >= 0) thr = t3 >= (unsigned)CAP ? c3 : (t2 >= (unsigned)CAP ? c2 : (t1 >= (unsigned)CAP ? c1 : thr));
        else thr = t1 >= (unsigned)CAP ? c1 : thr;
    }
    unsigned cg_ = 0, ce = 0;
#pragma unroll
    for (int j = 0; j < 8; ++j) { cg_ += key[j] > thr; ce += key[j] == thr; }
    unsigned pk = cg_ | (ce << 16), incl = pk;
#pragma unroll
    for (int o = 1; o < 64; o <<= 1) { const unsigned n = __shfl_up(incl, o); if (lane >= o) incl += n; }
    if (lane == 63) wsum[wid] = incl;
    __syncthreads();
    unsigned base = 0, total = 0;
#pragma unroll
    for (int w = 0; w < 8; ++w) { const unsigned s2 = wsum[w]; if (w < wid) base += s2; total += s2; }
    const unsigned excl = base + incl - pk; unsigned og = excl & 0xffffu, oe = excl >> 16; const unsigned ngt = total & 0xffffu, krem = (unsigned)CAP - ngt;
    int mm[8];
#pragma unroll
    for (int j = 0; j < 8; ++j) { const int t = tid * 8 + j; int m = -1;
        if (key[j] > thr) { m = (e * 8 + b) * 512 + (int)og; ++og; }
        else if (key[j] == thr) { if (oe < krem) m = (e * 8 + b) * 512 + (int)(ngt + oe); ++oe; }
        mm[j] = m;
        if (m >= 0) { idx[m] = b * 4096 + t; gate[m] = __uint_as_float(key[j]); } }
    { u32x4* so = (u32x4*)(slot_of + (size_t)it * 4096 + tid * 8);
      so[0] = (u32x4){(unsigned)mm[0], (unsigned)mm[1], (unsigned)mm[2], (unsigned)mm[3]}; so[1] = (u32x4){(unsigned)mm[4], (unsigned)mm[5], (unsigned)mm[6], (unsigned)mm[7]}; }
    __syncthreads();
}

__device__ __forceinline__ void phase7_rows(const Params& p, LAS unsigned char* lds) {
    const int tid = threadIdx.x, lane = tid & 63, wid = tid >> 6;
    LAS float* wrt = (LAS float*)lds;
    for (int i = tid; i < 16 * 1024; i += NTHR) { const int d = i >> 4, e = i & 15; wrt[e * 1024 + d] = p.w_router[i]; }
    __syncthreads();
    const float* ada = (const float*)(p.ws + WS_ADA); bf16_t* h2 = (bf16_t*)(p.ws + WS_H2); const bf16_t* x2b = (const bf16_t*)(p.ws + WS_X2B); float* scores = (float*)(p.ws + WS_SCORES);
    for (int row0 = (blockIdx.x * 8 + wid) * 2; row0 < MLAT; row0 += gridDim.x * 16) {
        const int b = row0 >> 12;
        f32x4 v[2][4]; float ss[2];
#pragma unroll
        for (int r = 0; r < 2; ++r)
#pragma unroll
            for (int i = 0; i < 4; ++i) { const u32x2 w = *(const u32x2*)(x2b + (size_t)(row0 + r) * 1024 + 256 * i + 4 * lane); v[r][i] = (f32x4){bf_lo(w.x), bf_hi(w.x), bf_lo(w.y), bf_hi(w.y)}; }
#pragma unroll
        for (int r = 0; r < 2; ++r) { float a = 0.f;
#pragma unroll
            for (int i = 0; i < 4; ++i) a += v[r][i][0] * v[r][i][0] + v[r][i][1] * v[r][i][1] + v[r][i][2] * v[r][i][2] + v[r][i][3] * v[r][i][3];
            ss[r] = a; }
#pragma unroll
        for (int o = 32; o >= 1; o >>= 1) { ss[0] += __shfl_xor(ss[0], o); ss[1] += __shfl_xor(ss[1], o); }
#pragma unroll
        for (int i = 0; i < 4; ++i) { const int d = 256 * i + 4 * lane;
            const f32x4 g = *(const f32x4*)(p.norm2_g + d), sh = *(const f32x4*)(ada + b * 6144 + 3072 + d), sc = *(const f32x4*)(ada + b * 6144 + 4096 + d);
#pragma unroll
            for (int r = 0; r < 2; ++r) { const float rs = rsqrtf(ss[r] * (1.0f / 1024.0f) + 1e-6f);
                v[r][i] = v[r][i] * rs * g * (sc + 1.0f) + sh;
                u32x2 w; w.x = cvt_pk_bf16(v[r][i][0], v[r][i][1]); w.y = cvt_pk_bf16(v[r][i][2], v[r][i][3]); *(u32x2*)(h2 + (size_t)(row0 + r) * 1024 + d) = w; } }
        float q[32];
#pragma unroll
        for (int e = 0; e < 16; ++e) { float a0 = 0.f, a1 = 0.f;
#pragma unroll
            for (int i = 0; i < 4; ++i) { const f32x4 w = *(const LAS f32x4*)(wrt + e * 1024 + 256 * i + 4 * lane);
                a0 += v[0][i][0] * w[0] + v[0][i][1] * w[1] + v[0][i][2] * w[2] + v[0][i][3] * w[3];
                a1 += v[1][i][0] * w[0] + v[1][i][1] * w[1] + v[1][i][2] * w[2] + v[1][i][3] * w[3]; }
            q[e] = a0; q[16 + e] = a1; }
#pragma unroll
        for (int j = 0; j < 16; ++j) { const bool up = (lane & 32) != 0; const float send = up ? q[j] : q[16 + j], keep = up ? q[16 + j] : q[j]; q[j] = keep + __shfl_xor(send, 32); }
#pragma unroll
        for (int j = 0; j < 8; ++j) { const bool up = (lane & 16) != 0; const float send = up ? q[j] : q[8 + j], keep = up ? q[8 + j] : q[j]; q[j] = keep + __shfl_xor(send, 16); }
#pragma unroll
        for (int j = 0; j < 4; ++j) { const bool up = (lane & 8) != 0; const float send = up ? q[j] : q[4 + j], keep = up ? q[4 + j] : q[j]; q[j] = keep + __shfl_xor(send, 8); }
#pragma unroll
        for (int j = 0; j < 2; ++j) { const bool up = (lane & 4) != 0; const float send = up ? q[j] : q[2 + j], keep = up ? q[2 + j] : q[j]; q[j] = keep + __shfl_xor(send, 4); }
        { const bool up = (lane & 2) != 0; const float send = up ? q[0] : q[1], keep = up ? q[1] : q[0]; q[0] = keep + __shfl_xor(send, 2); }
        float lg = q[0] + __shfl_xor(q[0], 1);
        float mx = lg;
#pragma unroll
        for (int o = 2; o <= 16; o <<= 1) mx = fmaxf(mx, __shfl_xor(mx, o));
        const float ex = expf(lg - mx); float sum = ex;
#pragma unroll
        for (int o = 2; o <= 16; o <<= 1) sum += __shfl_xor(sum, o);
        if (gridDim.x == 256) {
            LAS float* scl = (LAS float*)(lds + 64 * 1024);
            if ((lane & 1) == 0) scl[((lane >> 1) & 15) * 16 + wid * 2 + (lane >> 5)] = ex / sum;
            __syncthreads();
            if (tid < 128) { const int e = tid >> 3, q = tid & 7; const u64_t v2 = *(const LAS u64_t*)(scl + e * 16 + 2 * q);
                __hip_atomic_store((u64_t*)(scores + ((size_t)b * 16 + e) * 4096 + ((row0 - 2 * wid) & 4095) + 2 * q), v2, __ATOMIC_RELAXED, __HIP_MEMORY_SCOPE_AGENT); }
            asm volatile("s_waitcnt vmcnt(0)" ::: "memory");
            __syncthreads();
            if (tid == 0) (void)__hip_atomic_fetch_add((unsigned*)(p.ws + WS_BAR + 44 * KiB) + b * 64, 1u, __ATOMIC_RELAXED, __HIP_MEMORY_SCOPE_AGENT);
        } else if ((lane & 1) == 0) scores[((size_t)b * 16 + ((lane >> 1) & 15)) * 4096 + ((row0 + (lane >> 5)) & 4095)] = ex / sum;
    }
    __syncthreads();
}
__device__ __forceinline__ void phase7_topk(const Params& p, LAS unsigned char* lds) {
    const int bid = blockIdx.x; if (bid >= NB * NE) return;
    unsigned* c = (unsigned*)(p.ws + WS_BAR + 44 * KiB) + (bid >> 4) * 64;
    if (threadIdx.x < 64) { unsigned sp = 0;
        while ((unsigned)__builtin_amdgcn_readfirstlane(__hip_atomic_load(c, __ATOMIC_RELAXED, __HIP_MEMORY_SCOPE_AGENT)) < 256u) { __builtin_amdgcn_s_sleep(1); if (++sp > (1u << 22)) break; }
        __builtin_amdgcn_fence(__ATOMIC_ACQUIRE, "agent");
        asm volatile("s_waitcnt vmcnt(0)" ::: "memory"); }
    __syncthreads();
    topk_task(p, lds, bid);
}
__device__ __forceinline__ void phase7_weights(const Params& p) {
    constexpr int N_G = 16 * 16 * 6, N_D = 16 * 24 * 4;
    const bool fused = gridDim.x == 256;
    for (int j = 0; ; ++j) {
        int it;
        if (!fused) it = blockIdx.x + j * gridDim.x;
        else if (blockIdx.x >= 128) it = j < 4 ? (blockIdx.x - 128) + 128 * j : 512 + blockIdx.x + (j - 4) * 256;
        else it = 512 + blockIdx.x + j * 256;
        if (it >= 2 * N_G + N_D) break;
        if (it < 2 * N_G) { const int up = it >= N_G, j = up ? it - N_G : it, e = j / 96, r = j % 96, kb = r / 6, nb = r % 6;
            xpose_item<4>((up ? p.w_up_e : p.w_gate_e) + (size_t)e * 1024 * 1536, 1536, (bf16_t*)(p.ws + WS_WGU) + (size_t)e * 3072 * 1024, 1024, kb * 64, nb * 256, up ? 2 : 1); }
        else { const int j = it - 2 * N_G, e = j / 96, r = j % 96, kb = r >> 2, nb = r & 3;
            xpose_item<4>(p.w_down_e + (size_t)e * 1536 * 1024, 1024, (bf16_t*)(p.ws + WS_WD) + (size_t)e * 1024 * 1536, 1536, kb * 64, nb * 256, 0); }
    }
}

__device__ __forceinline__ void phase11(const Params& p, float* dst) {
    const int tid = tid_opaque(), lane = tid & 63, wid = tid >> 6;
    const float* ada = (const float*)(p.ws + WS_ADA); const int* slot_of = (const int*)(p.ws + WS_SLOT); const bf16_t* oute = (const bf16_t*)(p.ws + WS_OUTE); const bf16_t* x2b = (const bf16_t*)(p.ws + WS_X2B);
    const int stride = gridDim.x * 16;
    int row0 = (blockIdx.x * 8 + wid) * 2;
    int myslot = row0 < MLAT ? slot_of[((size_t)(row0 >> 12) * 16 + (lane & 15)) * 4096 + ((row0 & 4095) + ((lane >> 4) & 1))] : -1;
    for (; row0 < MLAT; row0 += stride) {
        const int b = row0 >> 12;
        const int nrow = row0 + stride; const int nslot = nrow < MLAT ? slot_of[((size_t)(nrow >> 12) * 16 + (lane & 15)) * 4096 + ((nrow & 4095) + ((lane >> 4) & 1))] : -1;
        f32x4 xv[2][4], acc[2][4];
#pragma unroll
        for (int r = 0; r < 2; ++r)
#pragma unroll
            for (int i = 0; i < 4; ++i) { const u32x2 w = __builtin_nontemporal_load((const u32x2*)(x2b + (size_t)(row0 + r) * 1024 + 256 * i + 4 * lane)); xv[r][i] = (f32x4){bf_lo(w.x), bf_hi(w.x), bf_lo(w.y), bf_hi(w.y)}; acc[r][i] = (f32x4){0.f, 0.f, 0.f, 0.f}; }
        const unsigned long long bal = __ballot(myslot >= 0);
        unsigned mask0 = (unsigned)(bal & 0xffffull), mask1 = (unsigned)((bal >> 16) & 0xffffull);
        while (mask0 | mask1) {
            int m[2][2];
#pragma unroll
            for (int j = 0; j < 2; ++j) { if (mask0) { const int e = __builtin_ctz(mask0); mask0 &= mask0 - 1; m[0][j] = __builtin_amdgcn_readlane(myslot, e); } else m[0][j] = MMOE;
                                          if (mask1) { const int e = __builtin_ctz(mask1); mask1 &= mask1 - 1; m[1][j] = __builtin_amdgcn_readlane(myslot, 16 + e); } else m[1][j] = MMOE; }
            u32x2 w[2][2][4];
#pragma unroll
            for (int r = 0; r < 2; ++r)
#pragma unroll
                for (int j = 0; j < 2; ++j)
#pragma unroll
                    for (int i = 0; i < 4; ++i) w[r][j][i] = __builtin_nontemporal_load((const u32x2*)(oute + (size_t)m[r][j] * 1024 + 256 * i + 4 * lane));
#pragma unroll
            for (int r = 0; r < 2; ++r)
#pragma unroll
                for (int j = 0; j < 2; ++j)
#pragma unroll
                    for (int i = 0; i < 4; ++i) { acc[r][i][0] += bf_lo(w[r][j][i].x); acc[r][i][1] += bf_hi(w[r][j][i].x); acc[r][i][2] += bf_lo(w[r][j][i].y); acc[r][i][3] += bf_hi(w[r][j][i].y); }
        }
        float ss[2];
#pragma unroll
        for (int r = 0; r < 2; ++r) { float a = 0.f;
#pragma unroll
            for (int i = 0; i < 4; ++i) { const int d = 256 * i + 4 * lane; const f32x4 g2 = *(const f32x4*)(ada + b * 6144 + 5120 + d); xv[r][i] += g2 * acc[r][i];
                a += xv[r][i][0] * xv[r][i][0] + xv[r][i][1] * xv[r][i][1] + xv[r][i][2] * xv[r][i][2] + xv[r][i][3] * xv[r][i][3]; }
            ss[r] = a; }
#pragma unroll
        for (int o = 32; o >= 1; o >>= 1) { ss[0] += __shfl_xor(ss[0], o); ss[1] += __shfl_xor(ss[1], o); }
#pragma unroll
        for (int r = 0; r < 2; ++r) { const float rs = rsqrtf(ss[r] * (1.0f / 1024.0f) + 1e-6f);
#pragma unroll
            for (int i = 0; i < 4; ++i) { const int d = 256 * i + 4 * lane; __builtin_nontemporal_store(xv[r][i] * rs * *(const f32x4*)(p.final_g + d), (f32x4*)(dst + (size_t)(row0 + r) * 1024 + d)); } }
        myslot = nslot;
    }
}

#define XB_TMO      128
#define XB_XCNT(j)  (256  + 64 * (j))
#define XB_XSUB(j)  (1280 + 64 * (j))
#define XB_XGEN(j)  (2304 + 64 * (j))
#define XB_TOP      3328
#define XB_TOPGEN   3392
#define XCD_BAR_WORDS 3456
#define XB_SPIN_CAP (1u << 22)
__device__ __forceinline__ unsigned xb_ld(unsigned* p)              { return __hip_atomic_load(p, __ATOMIC_RELAXED, __HIP_MEMORY_SCOPE_AGENT); }
__device__ __forceinline__ unsigned xb_add(unsigned* p, unsigned v) { return __hip_atomic_fetch_add(p, v, __ATOMIC_RELAXED, __HIP_MEMORY_SCOPE_AGENT); }
__device__ __forceinline__ unsigned xb_xcc_id() { return (unsigned)__builtin_amdgcn_s_getreg((3 << 11) | 20) & 0xFu; }
#define XB_SPIN(cond, bar) do { unsigned _sp = 0; while (cond) { __builtin_amdgcn_s_sleep(1); \
    if ((++_sp & 255u) == 0u) { if (xb_ld(&(bar)[XB_TMO])) break; if (_sp > XB_SPIN_CAP) { atomicAdd(&(bar)[XB_TMO], 1u); break; } } } } while (0)
struct XcdBarrier { unsigned* bar; unsigned x; volatile LAS unsigned* st; };
__device__ __forceinline__ XcdBarrier xcd_barrier_post(unsigned* bar, volatile LAS unsigned* st) {
    XcdBarrier b; b.bar = bar; b.x = xb_xcc_id(); b.st = st;
    if (threadIdx.x == 0) (void)xb_add(&bar[XB_XCNT(b.x)], 1u);
    return b;
}
__device__ __forceinline__ void xcd_barrier_complete(unsigned* bar, unsigned x, unsigned& nloc, unsigned& nx) {
    const unsigned G = gridDim.x * gridDim.y * gridDim.z;
    unsigned sum, cnt, mine, sp = 0u;
    for (;;) {
        sum = 0u; cnt = 0u; mine = 0u;
#pragma unroll
        for (unsigned j = 0; j < 16; ++j) { const unsigned c = xb_ld(&bar[XB_XCNT(j)]); sum += c; cnt += (c > 0u) ? 1u : 0u; mine = (j == x) ? c : mine; }
        if (sum == G) break;
        __builtin_amdgcn_s_sleep(1);
        if ((++sp & 255u) == 0u) { if (xb_ld(&bar[XB_TMO])) break; if (sp > XB_SPIN_CAP) { atomicAdd(&bar[XB_TMO], 1u); break; } }
    }
    nloc = mine > 0u ? mine : 1u; nx = cnt > 0u ? cnt : 1u;
}
__device__ __forceinline__ void xcd_barrier(const XcdBarrier& b) {
    asm volatile("s_waitcnt vmcnt(0)" ::: "memory");
    __syncthreads();
    if (threadIdx.x == 0) {
        unsigned* bar = b.bar;
        __builtin_amdgcn_s_waitcnt(0);
        unsigned nloc = b.st[0], nx = b.st[1];
        if (nloc == 0u) { xcd_barrier_complete(bar, b.x, nloc, nx); b.st[0] = nloc; b.st[1] = nx; }
        const unsigned old = xb_add(&bar[XB_XSUB(b.x)], 1u);
        const unsigned gen = old / nloc;
        if (old + 1u == (gen + 1u) * nloc) {
            __builtin_amdgcn_fence(__ATOMIC_RELEASE, "agent");
            asm volatile("s_waitcnt vmcnt(0)" ::: "memory");
            const unsigned og = xb_add(&bar[XB_TOP], 1u);
            const unsigned tg = og / nx;
            if (og + 1u == (tg + 1u) * nx) xb_add(&bar[XB_TOPGEN], 1u);
            else XB_SPIN(xb_ld(&bar[XB_TOPGEN]) == tg, bar);
            __builtin_amdgcn_fence(__ATOMIC_ACQUIRE, "agent");
            xb_add(&bar[XB_XGEN(b.x)], 1u);
            asm volatile("s_waitcnt vmcnt(0)" ::: "memory");
        } else {
            XB_SPIN(xb_ld(&bar[XB_XGEN(b.x)]) == gen, bar);
            __builtin_amdgcn_fence(__ATOMIC_ACQUIRE, "agent");
            asm volatile("s_waitcnt vmcnt(0)" ::: "memory");
        }
    }
    __syncthreads();
}

__global__ void __launch_bounds__(NTHR, 2) fwd_megakernel(Params p_in) {
    Params p = p_in;
    extern __shared__ __attribute__((aligned(16))) unsigned char lds_raw[];
    LAS unsigned char* lds = (LAS unsigned char*)lds_raw;
    cg::grid_group grid = cg::this_grid();
    const int G = gridDim.x, bid = blockIdx.x;
    unsigned char* ws = p.ws;
    bf16_t* const R1 = (bf16_t*)(ws + WS_R1); bf16_t* const Zb = (bf16_t*)(ws + WS_RZ); bf16_t* const PQt = (bf16_t*)(ws + WS_RPQ); bf16_t* const MRG = (bf16_t*)(ws + WS_R2);
    bf16_t* const Fb = (bf16_t*)((unsigned char*)p.out + OUT_F); bf16_t* const Ytb = (bf16_t*)((unsigned char*)p.out + OUT_YT);
#ifdef ONLY_PH
#define PH(k) ((k) == ONLY_PH && p.ph_lo <= (k) && (k) < p.ph_hi)
#else
#define PH(k) (p.ph_lo <= (k) && (k) < p.ph_hi)
#endif
    volatile LAS unsigned* xst = (volatile LAS unsigned*)(lds + LDS_BYTES - 16);
    if (threadIdx.x < 4) xst[threadIdx.x] = 0u;
    __syncthreads();
    XcdBarrier xbar = xcd_barrier_post((unsigned*)(ws + WS_BAR), xst);
    if (p.ph_lo < 0) grid.sync();
#ifdef TS_A
    unsigned long long* tsb = (unsigned long long*)(ws + WS_BAR + 40 * KiB);
#define STAMP(i) do { if (bid == 0 && threadIdx.x == 0) tsb[i] = __builtin_amdgcn_s_memrealtime(); } while (0)
#else
#define STAMP(i) do { } while (0)
#endif
    STAMP(0);
#define LAUNDER() do { asm volatile("" : "+s"(p.ws), "+s"(p.out), "+s"(p.x)); ws = p.ws; } while (0)
#define SYNC(k) do { if (PH(k) && PH((k) + 1)) xcd_barrier(xbar); STAMP((k) + 1); LAUNDER(); } while (0)
#ifndef REPMASK
#define REPMASK 0
#endif
#define REP(k) for (int rep_ = 0; rep_ <= ((REPMASK >> (k)) & 1); ++rep_)
    const bool fuse01 = PH(0) && PH(1);
    if (PH(0)) phase0(p, lds);
    if (fuse01) block_wait_ge((unsigned*)(ws + WS_BAR + 46 * KiB), 256u + 16u);
    else SYNC(0);
    if (PH(1)) REP(1) phase1(p);
    SYNC(1);
    if (PH(2)) REP(2) {
        { ProbPQ pr{(const bf16_t*)(ws + WS_WPQ), R1, 1024, 1024, 16384}; pg8::Order S; S.init(2, 128, G, bid); EpiPQ E{PQt}; pg8::gemm_phase(lds, pr, S, E); }
        STAMP(28);
        { ProbPlain pr{R1, (const bf16_t*)(ws + WS_WIN), 1024, 1024, 1024}; pg8::Order S; S.init(128, 16, G, bid); EpiZ E{Zb, 4096, -1}; pg8::gemm_phase(lds, pr, S, E); }
        STAMP(29);
        { ProbPlain pr{(const bf16_t*)(ws + WS_HCTX), (const bf16_t*)(ws + WS_WIN), 1024, 1024, 1024}; pg8::Order S; S.init(8, 4, G, bid); EpiZ E{(bf16_t*)(ws + WS_ZXC), 1024, 0}; pg8::gemm_phase(lds, pr, S, E); }
    }
    SYNC(2);
    if (PH(3)) REP(3) {
        {
            ProbPlain pr{(const bf16_t*)(ws + WS_D1T), PQt, 512, 512, 512}; pg8::Order S; S.init(2, FCOLS / 256, G, bid);
            if (G == 256) { if (bid >= 128) { S.G = 128; S.c = bid - 128; S.base = 0; S.lim = 2; } else { S.G = 128; S.c = bid; S.base = 256; S.lim = bid < 4 ? 1 : 0; } }
            EpiPlain E{Ytb, FCOLS}; pg8::gemm_phase(lds, pr, S, E); }
        for (int it = bid; it < NB * 2 * 8; it += G) lru_tile<false>(p, lds, it);
    }
    SYNC(3);
    if (PH(4)) {
        fft_stage2_all(p, lds);
        const int ngr = G >> 5;
        if (ngr > 0 && bid < ngr * 32) lru2_block(p, lds, bid % ngr, bid / ngr, ngr);
    }
    SYNC(4);
    if (PH(5)) REP(5) {
        { ProbMerge pr{Fb, (const bf16_t*)(ws + WS_WFOUR), R1, (const bf16_t*)(ws + WS_WLRU), 512, 1024, 512, 512, 1024, 1024}; pg8::Order S; S.init(128, 4, G, bid); EpiMerge E{MRG, Zb}; pg8::gemm_phase2(lds, pr, S, E); }
    }
    SYNC(5);
    if (PH(6)) REP(6) { ProbPlain pr{MRG, (const bf16_t*)(ws + WS_WOUT), 1024, 1024, 1024}; pg8::Order S; S.init(128, 4, G, bid); if (512 % G == 0) S.rev = 512 / G;
        EpiOut E{(bf16_t*)(ws + WS_X2B), p.x, (const float*)(ws + WS_POS), (const float*)(ws + WS_ADA)}; pg8::gemm_phase(lds, pr, S, E); }
    SYNC(6);
    if (PH(7)) { phase7_rows(p, lds); if (G == 256) phase7_topk(p, lds); phase7_weights(p); }
    SYNC(7);
    if (PH(8) && G != 256) { for (int it = bid; it < NB * NE; it += G) topk_task(p, lds, it); }
    if (G != 256) SYNC(8);
    if (PH(9)) REP(9) { ProbMoeUp pr{(const bf16_t*)(ws + WS_H2), (const bf16_t*)(ws + WS_WGU), (const int*)(ws + WS_IDX), 1024, 1024, 1024}; pg8::Order S; S.init(256, 12, G, bid); S.wgm = P9_WGM; EpiGU E{(bf16_t*)(ws + WS_HID)}; pg8::gemm_phase(lds, pr, S, E); }
    SYNC(9);
    if (PH(10)) { if (bid == 0 && threadIdx.x < 128) *(u32x4*)(ws + WS_OUTE + (size_t)MMOE * 2048 + threadIdx.x * 16) = (u32x4){0u, 0u, 0u, 0u}; }
    if (PH(10)) REP(10) { ProbMoeDown pr{(const bf16_t*)(ws + WS_HID), (const bf16_t*)(ws + WS_WD), 1536, 1536, 1536}; pg8::Order S; S.init(256, 4, G, bid); if (1024 % G == 0) S.rev = 1024 / G; EpiDown E{(bf16_t*)(ws + WS_OUTE), (const float*)(ws + WS_GATE)}; pg8::gemm_phase(lds, pr, S, E); }
    SYNC(10);
    if (PH(11)) phase11(p, p.out);
#ifdef TS_A
    xcd_barrier(xbar); STAMP(12);
    if (bid == 0 && threadIdx.x == 0) {

#ifndef TS_AE
#define TS_AE (TS_A + 1)
#endif
#ifndef TS_BE
#define TS_BE (TS_B + 1)
#endif
        const float ta = (float)(tsb[TS_AE] - tsb[TS_A]) * 0.01f * (float)(TS_SA), tb = (float)(tsb[TS_BE] - tsb[TS_B]) * 0.01f * (float)(TS_SB);
        p.out[7] = fminf(ta, 97.f); p.out[1024 * 5 + 9] = fminf(tb, 97.f); }
#endif
}

#ifndef N_LAUNCHES
#define N_LAUNCHES 1
#endif
#ifndef PROBE_DUP
#define PROBE_DUP 0x0
#endif
extern "C" void kernel_launch(void* const* d_in, const int* in_sizes, int n_in, void* d_out, int out_size, void* d_ws, size_t ws_size, hipStream_t stream) {
    static int grid = 0;
    if (grid == 0) {
        if (n_in != 24 || out_size != MLAT * DM || ws_size < WS_END) { fprintf(stderr, "kernel_launch: unexpected shapes (n_in %d out %d ws %zu)\n", n_in, out_size, ws_size); grid = -1; return; }
        int dev = 0, cus = 0, per_cu = 0;
        hipGetDevice(&dev); hipDeviceGetAttribute(&cus, hipDeviceAttributeMultiprocessorCount, dev);
        hipFuncSetAttribute((const void*)fwd_megakernel, hipFuncAttributeMaxDynamicSharedMemorySize, LDS_BYTES);
        hipOccupancyMaxActiveBlocksPerMultiprocessor(&per_cu, (const void*)fwd_megakernel, NTHR, LDS_BYTES);
        if (per_cu < 1) { fprintf(stderr, "kernel_launch: occupancy query reports %d blocks per CU\n", per_cu); per_cu = 1; }
        grid = cus * 1;
        (void)hipGetLastError();
    }
    if (grid < 0) return;
    Params p{};
    const float** f = (const float**)&p;
    for (int i = 0; i < 24; ++i) f[i] = (const float*)d_in[i];
    p.out = (float*)d_out; p.ws = (unsigned char*)d_ws;
    (void)hipMemsetAsync((unsigned char*)d_ws + WS_BAR, 0, 48 * KiB, stream);
#if N_LAUNCHES == 1
    p.ph_lo = 0; p.ph_hi = 12;
    void* args[] = {&p};
    hipError_t e = hipLaunchCooperativeKernel((const void*)fwd_megakernel, dim3(grid), dim3(NTHR), args, LDS_BYTES, stream);
    if (e != hipSuccess) fprintf(stderr, "cooperative launch failed: %s (grid %d)\n", hipGetErrorString(e), grid);
#else
    for (int k = 0; k < 12; ++k) for (int r = 0; r <= ((PROBE_DUP >> k) & 1); ++r) { p.ph_lo = k; p.ph_hi = k + 1; if (k == 11 && r == 0 && ((PROBE_DUP >> 11) & 1)) { p.ph_lo = 12; p.ph_hi = 13; } hipLaunchKernelGGL(fwd_megakernel, dim3(grid), dim3(NTHR), LDS_BYTES, stream, p); }
#endif
}
```

```cpp
#include <hip/hip_runtime.h>
#include <hip/hip_cooperative_groups.h>
#include <cstdio>
namespace cg = cooperative_groups;

#ifndef P9_WGM
#define P9_WGM 2
#endif
#define LAS __attribute__((address_space(3)))
typedef unsigned short bf16_t;
typedef short bf16x8 __attribute__((ext_vector_type(8)));
typedef float f32x4 __attribute__((ext_vector_type(4)));
typedef float f32x16 __attribute__((ext_vector_type(16)));
typedef unsigned u32x4 __attribute__((ext_vector_type(4)));
typedef unsigned u32x2 __attribute__((ext_vector_type(2)));
typedef unsigned long long u64_t;

constexpr int NB = 8, TT = 4096, DM = 1024, CTXL = 256, MLAT = NB * TT, MCTX = NB * CTXL;
constexpr int NE = 16, CAP = 512, DE = 1536, MMOE = NE * NB * CAP;
constexpr int NSEQ = 34;
constexpr int NTHR = 512;
constexpr float NLOG2E = -1.4426950408889634f;
constexpr int LDS_BYTES = 144 * 1024;

constexpr size_t KiB = 1024, MiB = 1024 * 1024;
constexpr size_t WS_ADA = 0;
constexpr size_t WS_POS = 256 * KiB;
constexpr size_t WS_AGG = 512 * KiB;
constexpr int FCOLS = 32768 + 512;
constexpr size_t WS_WPQ = 5 * MiB;
constexpr size_t WS_WIN = 7 * MiB;
constexpr size_t WS_WFOUR = 15 * MiB;
constexpr size_t WS_WLRU = 16 * MiB;
constexpr size_t WS_WOUT = 18 * MiB;
constexpr size_t WS_WAT = 20 * MiB;
constexpr size_t WS_WIT = 20 * MiB + 512 * KiB;
constexpr size_t WS_SCORES = 21 * MiB;
constexpr size_t WS_IDX = 23 * MiB;
constexpr size_t WS_GATE = 23 * MiB + 256 * KiB;
constexpr size_t WS_SLOT = 23 * MiB + 512 * KiB;
constexpr size_t WS_BAR = 25 * MiB + 512 * KiB;
constexpr size_t WS_D1T = 34 * MiB;
constexpr size_t WS_D2T = 34 * MiB + 512 * KiB;
constexpr size_t WS_HCTX = 26 * MiB;
constexpr size_t WS_ZXC = 30 * MiB;
constexpr size_t WS_R1 = 40 * MiB;
constexpr size_t WS_RPQ = 104 * MiB;
constexpr size_t WS_R2 = 168 * MiB;
constexpr size_t WS_RZ = 232 * MiB;
constexpr size_t WS_END = 504 * MiB;
constexpr size_t WS_X2B = WS_R1, WS_H2 = WS_RPQ, WS_WGU = 168 * MiB, WS_WD = 264 * MiB, WS_HID = 312 * MiB, WS_OUTE = WS_RPQ;
constexpr size_t OUT_YT = 0, OUT_F = 64 * MiB;

struct Params {
    const float *x, *c, *ctx, *c_ctx, *w_ada, *b_ada, *norm1_g, *norm2_g, *w_in, *w_four, *conv_w, *conv_b, *lru_lambda,
        *lru_wa, *lru_ba, *lru_wi, *lru_bi, *w_lru, *w_out, *w_router, *w_gate_e, *w_up_e, *w_down_e, *final_g;
    float* out; unsigned char* ws; int ph_lo, ph_hi;
};

__device__ __forceinline__ int tid_opaque() { int t = threadIdx.x; asm volatile("" : "+v"(t)); return t; }
__device__ __forceinline__ unsigned cvt_pk_bf16(float lo, float hi) { unsigned r; asm volatile("v_cvt_pk_bf16_f32 %0, %1, %2" : "=v"(r) : "v"(lo), "v"(hi)); return r; }
__device__ __forceinline__ void mfma_settle(f32x4& a) { asm volatile("s_nop 15\n\ts_nop 7" : "+v"(a)); }
__device__ __forceinline__ void block_wait_ge(unsigned* cnt, unsigned need) {
    if (threadIdx.x < 64) { unsigned sp = 0;
        while ((unsigned)__builtin_amdgcn_readfirstlane(__hip_atomic_load(cnt, __ATOMIC_RELAXED, __HIP_MEMORY_SCOPE_AGENT)) < need) { __builtin_amdgcn_s_sleep(2); if (++sp > (1u << 22)) break; }
        __builtin_amdgcn_fence(__ATOMIC_ACQUIRE, "agent"); asm volatile("s_waitcnt vmcnt(0)" ::: "memory"); }
    __syncthreads();
}
__device__ __forceinline__ float bf_lo(unsigned w) { return __uint_as_float(w << 16); }
__device__ __forceinline__ float bf_hi(unsigned w) { return __uint_as_float(w & 0xffff0000u); }
__device__ __forceinline__ float bf2f(bf16_t h) { return __uint_as_float(((unsigned)h) << 16); }
__device__ __forceinline__ float sigmoidf_(float v) { return __builtin_amdgcn_rcpf(1.0f + __expf(-v)); }
__device__ __forceinline__ float gelu_tanh(float v) { const float y = 1.5957691216f * (v + 0.044715f * v * v * v); return v * sigmoidf_(y); }
__device__ __forceinline__ float wave_sum(float v) {
#pragma unroll
    for (int o = 32; o >= 1; o >>= 1) v += __shfl_xor(v, o);
    return v;
}
__device__ __forceinline__ void unpack8(const u32x4 w, float (&f)[8]) { f[0] = bf_lo(w.x); f[1] = bf_hi(w.x); f[2] = bf_lo(w.y); f[3] = bf_hi(w.y); f[4] = bf_lo(w.z); f[5] = bf_hi(w.z); f[6] = bf_lo(w.w); f[7] = bf_hi(w.w); }

namespace pg8 {
constexpr int BM = 256, BK = 64, HALF = 128, HTB = HALF * BK * 2, STAGE_BYTES = 8 * HTB, NXCD = 8, WGM = 2;
__device__ __forceinline__ int lds_byte(int r, int c) { const int st = (r >> 4) * 2 + (c >> 5), rr = r & 15, cc = c & 31, ob = rr * 64 + cc * 2; return st * 1024 + (ob ^ (((ob >> 9) & 1) << 5)); }
__device__ __forceinline__ void stage_rc(int b, int& R, int& C) { const int st = b / 1024, sb = b % 1024, swz = sb ^ (((sb >> 9) & 1) << 5); R = (st >> 1) * 16 + swz / 64; C = (st & 1) * 32 + (swz % 64) / 2; }
__device__ __forceinline__ int perm32(int rho) { const int n = rho >> 4, i = rho & 15; return 8 * (i >> 2) + 4 * n + (i & 3); }
struct Unit { int pm, pn; };
struct Order {
    int nM, nN, nwg, G, c, base, lim, rev, wgm;
    __device__ void init(int nM_, int nN_, int G_, int c_) { nM = nM_; nN = nN_; nwg = nM * nN; G = G_; c = c_; base = 0; lim = 0x7fffffff; rev = 0; wgm = WGM; }
    __device__ bool next(int i, Unit& u) const {
        if (rev > 0 && i >= rev) return false;
        const long L = (long)base + (long)(rev > 0 ? rev - 1 - i : i) * G + c; if (i >= lim || L >= nwg) return false;
        int wgid = (int)L; { const int q = nwg / NXCD, r = nwg % NXCD, xcd = wgid % NXCD, off = wgid / NXCD; wgid = (xcd < r ? xcd * (q + 1) : r * (q + 1) + (xcd - r) * q) + off; }
        const int nig = wgm * nN, gid = wgid / nig, fm = gid * wgm, gsz = (nM - fm) < wgm ? (nM - fm) : wgm;
        u.pm = fm + ((wgid % nig) % gsz); u.pn = (wgid % nig) / gsz; return true;
    }
};
template <class P, class Epi>
__device__ __forceinline__ void gemm_phase(LAS unsigned char* lds, const P& pr, const Order& S, const Epi& E) {
    const int tid = tid_opaque(), wid = __builtin_amdgcn_readfirstlane(tid >> 6), lane = tid & 63, wr = wid >> 2, wc = wid & 3, fr = lane & 15, fq = lane >> 4;
    const int nt = pr.K / BK;
    int RA[2], CA[2]; unsigned voffB[2];
#pragma unroll
    for (int i = 0; i < 2; ++i) { int R, C; stage_rc(tid * 16 + i * 8192, R, C); RA[i] = R; CA[i] = C; const int Rb = Epi::PERM ? ((R & ~31) + perm32(R & 31)) : R; voffB[i] = (unsigned)(Rb * pr.ldb + C) * 2u; }
    const size_t kstep = (size_t)(BK * 2);
    const size_t hstepB = (size_t)HALF * pr.ldb * 2;
    const unsigned ldsw = (unsigned)wid * 1024u;
    const int aoff = lds_byte(wr * 64 + fr, fq * 8), boff = lds_byte(wc * 32 + fr, fq * 8);
#define PG8_SA(b, h) (((b) * 2 + (h)) * HTB)
#define PG8_SB(b, h) ((4 + (b) * 2 + (h)) * HTB)
#define PG8_STAGE(bufoff, gbase, voff) do { _Pragma("unroll") for (int _i = 0; _i < 2; ++_i) \
        __builtin_amdgcn_global_load_lds((const unsigned*)((const char*)(gbase) + (voff)[_i]), (LAS unsigned*)(lds + (bufoff) + ldsw + _i * 8192), 16, 0, 0); } while (0)
#define PG8_LDA(dst, b, h) do { _Pragma("unroll") for (int m = 0; m < 4; ++m) _Pragma("unroll") for (int k = 0; k < 2; ++k) dst[m][k] = *(const LAS bf16x8*)(lds + PG8_SA(b, h) + aoff + m * 2048 + k * 1024); } while (0)
#define PG8_LDB(dst, b, h) do { _Pragma("unroll") for (int n = 0; n < 2; ++n) _Pragma("unroll") for (int k = 0; k < 2; ++k) dst[n][k] = *(const LAS bf16x8*)(lds + PG8_SB(b, h) + boff + n * 2048 + k * 1024); } while (0)
#define PG8_MMA(ai, bj, At, Bt) do { __builtin_amdgcn_s_setprio(1); _Pragma("unroll") for (int m = 0; m < 4; ++m) _Pragma("unroll") for (int n = 0; n < 2; ++n) _Pragma("unroll") for (int k = 0; k < 2; ++k) \
        acc[ai][bj][m][n] = __builtin_amdgcn_mfma_f32_16x16x32_bf16(Bt[n][k], At[m][k], acc[ai][bj][m][n], 0, 0, 0); __builtin_amdgcn_s_setprio(0); } while (0)
#define PG8_WAIT_V(n) asm volatile("s_waitcnt vmcnt(" #n ")" ::: "memory")
#define PG8_WAIT_L(n) asm volatile("s_waitcnt lgkmcnt(" #n ")" ::: "memory")
#define PG8_BAR __builtin_amdgcn_s_barrier()
#define PG8_SCHED __builtin_amdgcn_sched_barrier(0)
    Unit cur, nxt; int ui = 0;
    if (!S.next(0, cur)) return;
    f32x4 acc[2][2][4][2];
#pragma unroll
    for (int a = 0; a < 2; ++a)
#pragma unroll
        for (int b = 0; b < 2; ++b)
#pragma unroll
            for (int m = 0; m < 4; ++m)
#pragma unroll
                for (int n = 0; n < 2; ++n) acc[a][b][m][n] = (f32x4){0.f, 0.f, 0.f, 0.f};
    bf16x8 At[4][2], B0[2][2], B1[2][2];
    unsigned vA[2][2], vN[2][2];
    pr.avoff(cur, RA, CA, vA);
#pragma unroll
    for (int h = 0; h < 2; ++h)
#pragma unroll
        for (int i = 0; i < 2; ++i) vN[h][i] = vA[h][i];
    const char* cA = pr.abase(cur); const char* cB = pr.bbase(cur);
#define PG8_ROT(u) 0
#define PG8_KT(tt, rot) ((size_t)(((tt) + (rot)) >= nt ? ((tt) + (rot)) - nt : ((tt) + (rot))) * kstep)
    int rot = PG8_ROT(cur);
    { const char* pA = cA + PG8_KT(0, rot); const char* pB = cB + PG8_KT(0, rot);
    PG8_STAGE(PG8_SB(0, 0), pB, voffB); PG8_STAGE(PG8_SA(0, 0), pA, vA[0]); PG8_STAGE(PG8_SB(0, 1), pB + hstepB, voffB); PG8_STAGE(PG8_SA(0, 1), pA, vA[1]);
    if (wr == 1) PG8_BAR;
    PG8_WAIT_V(4); PG8_BAR;
    PG8_STAGE(PG8_SB(1, 0), pB + kstep, voffB); PG8_STAGE(PG8_SA(1, 0), pA + kstep, vA[0]); PG8_STAGE(PG8_SB(1, 1), pB + hstepB + kstep, voffB); }
    PG8_WAIT_V(6); PG8_BAR;
    for (;;) {
        const bool has_next = S.next(ui + 1, nxt);
        const char* nA = has_next ? pr.abase(nxt) : cA; const char* nB = has_next ? pr.bbase(nxt) : cB; const int nrot = has_next ? PG8_ROT(nxt) : rot;
        if (P::GATHER) { if (has_next) pr.avoff(nxt, RA, CA, vN); }
        for (int t = 0; t < nt; t += 2) {
            const bool last = (t == nt - 2);
            const char* a1 = cA + PG8_KT(t + 1, rot);
            const char* a2 = last ? nA + PG8_KT(0, nrot) : cA + PG8_KT(t + 2, rot); const char* b2 = last ? nB + PG8_KT(0, nrot) : cB + PG8_KT(t + 2, rot);
            const char* a3 = a2 + kstep; const char* b3 = b2 + kstep;
            unsigned v2[2][2];
#pragma unroll
            for (int h = 0; h < 2; ++h)
#pragma unroll
                for (int i = 0; i < 2; ++i) v2[h][i] = (P::GATHER && last) ? vN[h][i] : vA[h][i];
            PG8_LDB(B0, 0, 0); PG8_SCHED; PG8_LDA(At, 0, 0); PG8_STAGE(PG8_SA(1, 1), a1, vA[1]);
            PG8_WAIT_L(8); PG8_BAR; PG8_WAIT_L(0); PG8_MMA(0, 0, At, B0); PG8_BAR; PG8_SCHED;
            PG8_LDB(B1, 0, 1); PG8_STAGE(PG8_SB(0, 0), b2, voffB);
            PG8_BAR; PG8_WAIT_L(0); PG8_MMA(0, 1, At, B1); PG8_BAR;
            PG8_LDA(At, 0, 1); PG8_STAGE(PG8_SA(0, 0), a2, v2[0]);
            PG8_BAR; PG8_WAIT_L(0); PG8_MMA(1, 0, At, B0); PG8_BAR; PG8_SCHED;
            PG8_STAGE(PG8_SB(0, 1), b2 + hstepB, voffB);
            PG8_WAIT_V(6); PG8_BAR; PG8_MMA(1, 1, At, B1); PG8_BAR;
            PG8_LDB(B0, 1, 0); PG8_SCHED; PG8_LDA(At, 1, 0); PG8_STAGE(PG8_SA(0, 1), a2, v2[1]);
            PG8_WAIT_L(8); PG8_BAR; PG8_WAIT_L(0); PG8_MMA(0, 0, At, B0); PG8_BAR; PG8_SCHED;
            PG8_LDB(B1, 1, 1); PG8_STAGE(PG8_SB(1, 0), b3, voffB);
            PG8_BAR; PG8_WAIT_L(0); PG8_MMA(0, 1, At, B1); PG8_BAR;
            PG8_LDA(At, 1, 1); PG8_STAGE(PG8_SA(1, 0), a3, v2[0]);
            PG8_BAR; PG8_WAIT_L(0); PG8_MMA(1, 0, At, B0); PG8_BAR; PG8_SCHED;
            PG8_STAGE(PG8_SB(1, 1), b3 + hstepB, voffB);
            PG8_WAIT_V(6); PG8_BAR; PG8_MMA(1, 1, At, B1); PG8_BAR;
            if (P::GATHER && last) {
#pragma unroll
                for (int h = 0; h < 2; ++h)
#pragma unroll
                    for (int i = 0; i < 2; ++i) vA[h][i] = vN[h][i];
            }
        }
        E(acc, cur, wr, wc, fr, fq);
        if (!has_next) break;
#pragma unroll
        for (int a = 0; a < 2; ++a)
#pragma unroll
            for (int b = 0; b < 2; ++b)
#pragma unroll
                for (int m = 0; m < 4; ++m)
#pragma unroll
                    for (int n = 0; n < 2; ++n) acc[a][b][m][n] = (f32x4){0.f, 0.f, 0.f, 0.f};
        cur = nxt; cA = nA; cB = nB; rot = nrot; ++ui;
    }
    PG8_WAIT_V(0);
    if (wr == 0) PG8_BAR;
    PG8_BAR;
#undef PG8_ROT
#undef PG8_KT
#undef PG8_SA
#undef PG8_SB
#undef PG8_STAGE
#undef PG8_LDA
#undef PG8_LDB
#undef PG8_MMA
#undef PG8_WAIT_V
#undef PG8_WAIT_L
#undef PG8_BAR
#undef PG8_SCHED
}
template <class P, class Epi>
__device__ __forceinline__ void gemm_phase2(LAS unsigned char* lds, const P& pr, const Order& S, const Epi& E) {
    const int tid = tid_opaque(), wid = __builtin_amdgcn_readfirstlane(tid >> 6), lane = tid & 63, wr = wid >> 2, wc = wid & 3, fr = lane & 15, fq = lane >> 4;
    const int nt1 = pr.K1 / BK, nt = (pr.K1 + pr.K2) / BK;
    unsigned R2[2], Rb2[2], C2[2];
#pragma unroll
    for (int i = 0; i < 2; ++i) { int R, C; stage_rc(tid * 16 + i * 8192, R, C); const int Rb = Epi::PERM ? ((R & ~31) + perm32(R & 31)) : R; R2[i] = (unsigned)R * 2u; Rb2[i] = (unsigned)Rb * 2u; C2[i] = (unsigned)C * 2u; }
#define OFF_A(ld, h, i) ((R2[i] + (unsigned)((h) * 256)) * (unsigned)(ld) + C2[i])
#define OFF_B(ld, i) (Rb2[i] * (unsigned)(ld) + C2[i])
    const size_t kstep = (size_t)(BK * 2);
    const size_t hB1 = (size_t)HALF * pr.ldb1 * 2, hB2 = (size_t)HALF * pr.ldb2 * 2;
    const unsigned ldsw = (unsigned)wid * 1024u;
    const int aoff = lds_byte(wr * 64 + fr, fq * 8), boff = lds_byte(wc * 32 + fr, fq * 8);
#define PG8_SA(b, h) (((b) * 2 + (h)) * HTB)
#define PG8_SB(b, h) ((4 + (b) * 2 + (h)) * HTB)
#define PG8_STAGE(bufoff, gbase, voff) do { _Pragma("unroll") for (int _i = 0; _i < 2; ++_i) \
        __builtin_amdgcn_global_load_lds((const unsigned*)((const char*)(gbase) + (voff)[_i]), (LAS unsigned*)(lds + (bufoff) + ldsw + _i * 8192), 16, 0, 0); } while (0)
#define PG8_LDA(dst, b, h) do { _Pragma("unroll") for (int m = 0; m < 4; ++m) _Pragma("unroll") for (int k = 0; k < 2; ++k) dst[m][k] = *(const LAS bf16x8*)(lds + PG8_SA(b, h) + aoff + m * 2048 + k * 1024); } while (0)
#define PG8_LDB(dst, b, h) do { _Pragma("unroll") for (int n = 0; n < 2; ++n) _Pragma("unroll") for (int k = 0; k < 2; ++k) dst[n][k] = *(const LAS bf16x8*)(lds + PG8_SB(b, h) + boff + n * 2048 + k * 1024); } while (0)
#define PG8_MMA(ai, bj, At, Bt) do { __builtin_amdgcn_s_setprio(1); _Pragma("unroll") for (int m = 0; m < 4; ++m) _Pragma("unroll") for (int n = 0; n < 2; ++n) _Pragma("unroll") for (int k = 0; k < 2; ++k) \
        acc[ai][bj][m][n] = __builtin_amdgcn_mfma_f32_16x16x32_bf16(Bt[n][k], At[m][k], acc[ai][bj][m][n], 0, 0, 0); __builtin_amdgcn_s_setprio(0); } while (0)
#define PG8_WAIT_V(n) asm volatile("s_waitcnt vmcnt(" #n ")" ::: "memory")
#define PG8_WAIT_L(n) asm volatile("s_waitcnt lgkmcnt(" #n ")" ::: "memory")
#define PG8_BAR __builtin_amdgcn_s_barrier()
#define PG8_SCHED __builtin_amdgcn_sched_barrier(0)
    Unit cur, nxt; int ui = 0;
    if (!S.next(0, cur)) return;
    f32x4 acc[2][2][4][2];
#pragma unroll
    for (int a = 0; a < 2; ++a)
#pragma unroll
        for (int b = 0; b < 2; ++b)
#pragma unroll
            for (int m = 0; m < 4; ++m)
#pragma unroll
                for (int n = 0; n < 2; ++n) acc[a][b][m][n] = (f32x4){0.f, 0.f, 0.f, 0.f};
    bf16x8 At[4][2], B0[2][2], B1[2][2];
    const char* cA1 = pr.abase1(cur); const char* cB1 = pr.bbase1(cur); const char* cA2 = pr.abase2(cur); const char* cB2 = pr.bbase2(cur);
#define T_A(tt) ((tt) < nt1 ? cA1 + (size_t)(tt) * kstep : cA2 + (size_t)((tt) - nt1) * kstep)
#define T_B(tt) ((tt) < nt1 ? cB1 + (size_t)(tt) * kstep : cB2 + (size_t)((tt) - nt1) * kstep)
    { unsigned vb[2] = {OFF_B(pr.ldb1, 0), OFF_B(pr.ldb1, 1)}, va0[2] = {OFF_A(pr.lda1, 0, 0), OFF_A(pr.lda1, 0, 1)}, va1[2] = {OFF_A(pr.lda1, 1, 0), OFF_A(pr.lda1, 1, 1)};
    PG8_STAGE(PG8_SB(0, 0), cB1, vb); PG8_STAGE(PG8_SA(0, 0), cA1, va0); PG8_STAGE(PG8_SB(0, 1), cB1 + hB1, vb); PG8_STAGE(PG8_SA(0, 1), cA1, va1);
    if (wr == 1) PG8_BAR;
    PG8_WAIT_V(4); PG8_BAR;
    PG8_STAGE(PG8_SB(1, 0), cB1 + kstep, vb); PG8_STAGE(PG8_SA(1, 0), cA1 + kstep, va0); PG8_STAGE(PG8_SB(1, 1), cB1 + hB1 + kstep, vb); }
    PG8_WAIT_V(6); PG8_BAR;
    for (;;) {
        const bool has_next = S.next(ui + 1, nxt);
        const char* nA = has_next ? pr.abase1(nxt) : cA1; const char* nB = has_next ? pr.bbase1(nxt) : cB1;
        for (int t = 0; t < nt; t += 2) {
            const bool last = (t == nt - 2);
            const bool s1 = (t + 1 < nt1), s2 = last || (t + 2 < nt1);
            const char* a1 = T_A(t + 1);
            const char* a2 = last ? nA : T_A(t + 2); const char* b2 = last ? nB : T_B(t + 2);
            const char* a3 = a2 + kstep; const char* b3 = b2 + kstep;
            const size_t hstepB = s2 ? hB1 : hB2; const int ldaT1 = s1 ? pr.lda1 : pr.lda2, ldaT2 = s2 ? pr.lda1 : pr.lda2, ldbT2 = s2 ? pr.ldb1 : pr.ldb2;
            unsigned v2[2][2], voffB[2], vA1s[2];
#pragma unroll
            for (int i = 0; i < 2; ++i) { voffB[i] = OFF_B(ldbT2, i); vA1s[i] = OFF_A(ldaT1, 1, i);
#pragma unroll
                for (int h = 0; h < 2; ++h) v2[h][i] = OFF_A(ldaT2, h, i); }
            PG8_LDB(B0, 0, 0); PG8_SCHED; PG8_LDA(At, 0, 0); PG8_STAGE(PG8_SA(1, 1), a1, vA1s);
            PG8_WAIT_L(8); PG8_BAR; PG8_WAIT_L(0); PG8_MMA(0, 0, At, B0); PG8_BAR; PG8_SCHED;
            PG8_LDB(B1, 0, 1); PG8_STAGE(PG8_SB(0, 0), b2, voffB);
            PG8_BAR; PG8_WAIT_L(0); PG8_MMA(0, 1, At, B1); PG8_BAR;
            PG8_LDA(At, 0, 1); PG8_STAGE(PG8_SA(0, 0), a2, v2[0]);
            PG8_BAR; PG8_WAIT_L(0); PG8_MMA(1, 0, At, B0); PG8_BAR; PG8_SCHED;
            PG8_STAGE(PG8_SB(0, 1), b2 + hstepB, voffB);
            PG8_WAIT_V(6); PG8_BAR; PG8_MMA(1, 1, At, B1); PG8_BAR;
            PG8_LDB(B0, 1, 0); PG8_SCHED; PG8_LDA(At, 1, 0); PG8_STAGE(PG8_SA(0, 1), a2, v2[1]);
            PG8_WAIT_L(8); PG8_BAR; PG8_WAIT_L(0); PG8_MMA(0, 0, At, B0); PG8_BAR; PG8_SCHED;
            PG8_LDB(B1, 1, 1); PG8_STAGE(PG8_SB(1, 0), b3, voffB);
            PG8_BAR; PG8_WAIT_L(0); PG8_MMA(0, 1, At, B1); PG8_BAR;
            PG8_LDA(At, 1, 1); PG8_STAGE(PG8_SA(1, 0), a3, v2[0]);
            PG8_BAR; PG8_WAIT_L(0); PG8_MMA(1, 0, At, B0); PG8_BAR; PG8_SCHED;
            PG8_STAGE(PG8_SB(1, 1), b3 + hstepB, voffB);
            PG8_WAIT_V(6); PG8_BAR; PG8_MMA(1, 1, At, B1); PG8_BAR;
            if (t == nt1 - 2) E.mid(acc, cur, wr, wc, fr, fq);
        }
        E(acc, cur, wr, wc, fr, fq);
        if (!has_next) break;
#pragma unroll
        for (int a = 0; a < 2; ++a)
#pragma unroll
            for (int b = 0; b < 2; ++b)
#pragma unroll
                for (int m = 0; m < 4; ++m)
#pragma unroll
                    for (int n = 0; n < 2; ++n) acc[a][b][m][n] = (f32x4){0.f, 0.f, 0.f, 0.f};
        cur = nxt; cA1 = nA; cB1 = nB; cA2 = pr.abase2(cur); cB2 = pr.bbase2(cur); ++ui;
    }
    PG8_WAIT_V(0);
    if (wr == 0) PG8_BAR;
    PG8_BAR;
#undef T_A
#undef T_B
#undef OFF_A
#undef OFF_B
#undef PG8_SA
#undef PG8_SB
#undef PG8_STAGE
#undef PG8_LDA
#undef PG8_LDB
#undef PG8_MMA
#undef PG8_WAIT_V
#undef PG8_WAIT_L
#undef PG8_BAR
#undef PG8_SCHED
}
}
using pg8::Unit;

struct ProbPlain {
    static constexpr bool GATHER = false;
    const bf16_t* A; const bf16_t* B; int K, lda, ldb;
    __device__ __forceinline__ const char* abase(const Unit& u) const { return (const char*)(A + (size_t)u.pm * 256 * lda); }
    __device__ __forceinline__ const char* bbase(const Unit& u) const { return (const char*)(B + (size_t)u.pn * 256 * ldb); }
    __device__ __forceinline__ void avoff(const Unit&, const int (&RA)[2], const int (&CA)[2], unsigned (&v)[2][2]) const {
#pragma unroll
        for (int h = 0; h < 2; ++h)
#pragma unroll
            for (int i = 0; i < 2; ++i) v[h][i] = (unsigned)((h * 128 + RA[i]) * lda + CA[i]) * 2u;
    }
};
struct ProbMerge {
    const bf16_t* A1; const bf16_t* B1; const bf16_t* A2; const bf16_t* B2; int K1, K2, lda1, ldb1, lda2, ldb2;
    __device__ __forceinline__ const char* abase1(const Unit& u) const { return (const char*)(A1 + (size_t)u.pm * 256 * lda1); }
    __device__ __forceinline__ const char* bbase1(const Unit& u) const { return (const char*)(B1 + (size_t)u.pn * 256 * ldb1); }
    __device__ __forceinline__ const char* abase2(const Unit& u) const { return (const char*)(A2 + (size_t)u.pm * 256 * lda2); }
    __device__ __forceinline__ const char* bbase2(const Unit& u) const { return (const char*)(B2 + (size_t)u.pn * 256 * ldb2); }
};
struct ProbPQ {
    static constexpr bool GATHER = false;
    const bf16_t* A; const bf16_t* B; int K, lda, ldb;
    __device__ __forceinline__ const char* abase(const Unit& u) const { return (const char*)(A + (size_t)u.pm * 256 * lda); }
    __device__ __forceinline__ const char* bbase(const Unit& u) const { return (const char*)(B + ((size_t)(u.pn >> 4) * 4096 + (u.pn & 15)) * 1024); }
    __device__ __forceinline__ void avoff(const Unit&, const int (&RA)[2], const int (&CA)[2], unsigned (&v)[2][2]) const {
#pragma unroll
        for (int h = 0; h < 2; ++h)
#pragma unroll
            for (int i = 0; i < 2; ++i) v[h][i] = (unsigned)((h * 128 + RA[i]) * lda + CA[i]) * 2u;
    }
};
struct ProbMoeUp {
    static constexpr bool GATHER = true;
    const bf16_t* A; const bf16_t* B; const int* idx; int K, lda, ldb;
    __device__ __forceinline__ const char* abase(const Unit&) const { return (const char*)A; }
    __device__ __forceinline__ const char* bbase(const Unit& u) const { return (const char*)(B + ((size_t)(u.pm >> 4) * 3072 + (size_t)u.pn * 256) * ldb); }
    __device__ __forceinline__ void avoff(const Unit& u, const int (&RA)[2], const int (&CA)[2], unsigned (&v)[2][2]) const {
#pragma unroll
        for (int h = 0; h < 2; ++h)
#pragma unroll
            for (int i = 0; i < 2; ++i) { const int g = idx[u.pm * 256 + h * 128 + RA[i]]; v[h][i] = (unsigned)(g * lda + CA[i]) * 2u; }
    }
};
struct ProbMoeDown {
    static constexpr bool GATHER = false;
    const bf16_t* A; const bf16_t* B; int K, lda, ldb;
    __device__ __forceinline__ const char* abase(const Unit& u) const { return (const char*)(A + (size_t)u.pm * 256 * lda); }
    __device__ __forceinline__ const char* bbase(const Unit& u) const { return (const char*)(B + ((size_t)(u.pm >> 4) * 1024 + (size_t)u.pn * 256) * ldb); }
    __device__ __forceinline__ void avoff(const Unit&, const int (&RA)[2], const int (&CA)[2], unsigned (&v)[2][2]) const {
#pragma unroll
        for (int h = 0; h < 2; ++h)
#pragma unroll
            for (int i = 0; i < 2; ++i) v[h][i] = (unsigned)((h * 128 + RA[i]) * lda + CA[i]) * 2u;
    }
};

#define EPI_ROWS(...) _Pragma("unroll") for (int ai = 0; ai < 2; ++ai) _Pragma("unroll") for (int m = 0; m < 4; ++m) { const int row = u.pm * 256 + ai * 128 + wr * 64 + m * 16 + fr; __VA_ARGS__ }
__device__ __forceinline__ u32x4 pack8(const f32x4 v0, const f32x4 v1) { u32x4 w; w.x = cvt_pk_bf16(v0[0], v0[1]); w.y = cvt_pk_bf16(v0[2], v0[3]); w.z = cvt_pk_bf16(v1[0], v1[1]); w.w = cvt_pk_bf16(v1[2], v1[3]); return w; }

struct EpiPQ {
    static constexpr bool PERM = true; bf16_t* O;
    __device__ __forceinline__ void operator()(const f32x4 (&acc)[2][2][4][2], const Unit& u, int wr, int wc, int fr, int fq) const {
        const int t10 = wc * 32 + 8 * fq, b = u.pn >> 4, t2 = u.pn & 15;
        EPI_ROWS(
            bf16_t* rp = O + ((size_t)((b * 256 + (row >> 1)) * 16 + t2) * 512 + (row & 1) * 256 + t10);
            if (m == 0 && wr == 0 && fr == 1) {
                bf16_t* sp = O + ((size_t)(32768 + (b * 4 + (row >> 7)) * 16 + t2) * 512 + t10);
                _Pragma("unroll") for (int bj = 0; bj < 2; ++bj) { *(u32x4*)(sp + bj * 128) = pack8(acc[ai][bj][m][0], acc[ai][bj][m][1]); *(u32x4*)(sp + 256 + bj * 128) = (u32x4){0u, 0u, 0u, 0u}; *(u32x4*)(rp + bj * 128) = (u32x4){0u, 0u, 0u, 0u}; }
            } else {
                _Pragma("unroll") for (int bj = 0; bj < 2; ++bj) *(u32x4*)(rp + bj * 128) = pack8(acc[ai][bj][m][0], acc[ai][bj][m][1]);
            }
        )
    }
};
struct EpiPlain {
    static constexpr bool PERM = true; bf16_t* O; size_t ldc;
    __device__ __forceinline__ void operator()(const f32x4 (&acc)[2][2][4][2], const Unit& u, int wr, int wc, int fr, int fq) const {
        const int col0 = u.pn * 256 + wc * 32 + 8 * fq;
        EPI_ROWS(
            bf16_t* rp = O + (size_t)row * ldc + col0;
            _Pragma("unroll") for (int bj = 0; bj < 2; ++bj) *(u32x4*)(rp + bj * 128) = pack8(acc[ai][bj][m][0], acc[ai][bj][m][1]);
        )
    }
};
struct EpiZ {
    static constexpr bool PERM = true; bf16_t* O; int ldc; int fixed_act;
    __device__ __forceinline__ void operator()(const f32x4 (&acc)[2][2][4][2], const Unit& u, int wr, int wc, int fr, int fq) const {
        const int col0 = u.pn * 256 + wc * 32 + 8 * fq; const int act = fixed_act >= 0 ? fixed_act : (u.pn >> 2);
        if (act >= 2) {
            const int cg = (u.pn - 8) * 128 + wc * 32 + 8 * fq;
            EPI_ROWS(
                bf16_t* rp = O + (size_t)row * ldc + cg;
                f32x4 r0, r1, s0, s1;
                _Pragma("unroll") for (int j = 0; j < 4; ++j) {
                    const float ea0 = __builtin_amdgcn_exp2f(-1.4426950408889634f * acc[ai][0][m][0][j]), ea1 = __builtin_amdgcn_exp2f(-1.4426950408889634f * acc[ai][0][m][1][j]);
                    const float eb0 = fminf(__builtin_amdgcn_exp2f(-1.4426950408889634f * acc[ai][1][m][0][j]), 1e30f), eb1 = fminf(__builtin_amdgcn_exp2f(-1.4426950408889634f * acc[ai][1][m][1][j]), 1e30f);
                    s0[j] = __builtin_amdgcn_rcpf(1.0f + eb0); s1[j] = __builtin_amdgcn_rcpf(1.0f + eb1);
                    r0[j] = (1.0f + eb0) * __builtin_amdgcn_rcpf(1.0f + ea0); r1[j] = (1.0f + eb1) * __builtin_amdgcn_rcpf(1.0f + ea1); }
                *(u32x4*)(rp + 2048) = pack8(r0, r1); *(u32x4*)(rp + 3072) = pack8(s0, s1);
            )
            return;
        }
        EPI_ROWS(
            bf16_t* rp = O + (size_t)row * ldc + col0;
            _Pragma("unroll") for (int bj = 0; bj < 2; ++bj) {
                f32x4 v0 = acc[ai][bj][m][0], v1 = acc[ai][bj][m][1];
                if (act == 1) { _Pragma("unroll") for (int j = 0; j < 4; ++j) { v0[j] = gelu_tanh(v0[j]); v1[j] = gelu_tanh(v1[j]); } }
                *(u32x4*)(rp + bj * 128) = pack8(v0, v1); }
        )
    }
};
struct EpiMerge {
    static constexpr bool PERM = true; bf16_t* O; const bf16_t* Z;
    __device__ __forceinline__ void mid(f32x4 (&acc)[2][2][4][2], const Unit& u, int wr, int wc, int fr, int fq) const {
        unsigned eo = (unsigned)((u.pm * 256 + wr * 64 + fr) * 4096 + 2048 + u.pn * 256 + wc * 32 + 8 * fq);
        asm volatile("" : "+v"(eo));
#pragma unroll
        for (int ai = 0; ai < 2; ++ai) {
            u32x4 wa[4][2];
#pragma unroll
            for (int m = 0; m < 4; ++m)
#pragma unroll
                for (int bj = 0; bj < 2; ++bj) { const unsigned o = eo + (unsigned)((ai * 128 + m * 16) * 4096 + bj * 128); wa[m][bj] = __builtin_nontemporal_load((const u32x4*)(Z + o)); }
#pragma unroll
            for (int m = 0; m < 4; ++m)
#pragma unroll
                for (int bj = 0; bj < 2; ++bj) { float ga[8]; unpack8(wa[m][bj], ga);
#pragma unroll
                    for (int j = 0; j < 4; ++j) { acc[ai][bj][m][0][j] *= ga[j]; acc[ai][bj][m][1][j] *= ga[4 + j]; } }
            __builtin_amdgcn_sched_barrier(0); }
    }
    __device__ __forceinline__ void operator()(const f32x4 (&acc)[2][2][4][2], const Unit& u, int wr, int wc, int fr, int fq) const {
        unsigned eo = (unsigned)((u.pm * 256 + wr * 64 + fr) * 4096 + 3072 + u.pn * 256 + wc * 32 + 8 * fq); asm volatile("" : "+v"(eo));
        unsigned oo = (unsigned)((u.pm * 256 + wr * 64 + fr) * 1024 + u.pn * 256 + wc * 32 + 8 * fq); asm volatile("" : "+v"(oo));
        u32x4 wb[2][4][2];
#pragma unroll
        for (int ai = 0; ai < 2; ++ai)
#pragma unroll
            for (int m = 0; m < 4; ++m)
#pragma unroll
                for (int bj = 0; bj < 2; ++bj) wb[ai][m][bj] = __builtin_nontemporal_load((const u32x4*)(Z + eo + (unsigned)((ai * 128 + m * 16) * 4096 + bj * 128)));
#pragma unroll
        for (int ai = 0; ai < 2; ++ai)
#pragma unroll
            for (int m = 0; m < 4; ++m)
#pragma unroll
                for (int bj = 0; bj < 2; ++bj) { float g[8]; unpack8(wb[ai][m][bj], g);
                    f32x4 v0 = acc[ai][bj][m][0], v1 = acc[ai][bj][m][1];
#pragma unroll
                    for (int j = 0; j < 4; ++j) { v0[j] *= g[j]; v1[j] *= g[4 + j]; }
                    *(u32x4*)(O + oo + (unsigned)((ai * 128 + m * 16) * 1024 + bj * 128)) = pack8(v0, v1); }
    }
};
struct EpiOut {
    static constexpr bool PERM = true; bf16_t* O; const float* X; const float* pos; const float* ada;
    __device__ __forceinline__ void operator()(const f32x4 (&acc)[2][2][4][2], const Unit& u, int wr, int wc, int fr, int fq) const {
        const int col0 = u.pn * 256 + wc * 32 + 8 * fq; const int b = u.pm >> 4;
        unsigned ro = (unsigned)((u.pm * 256 + wr * 64 + fr) * 1024 + col0); asm volatile("" : "+v"(ro));
#pragma unroll
        for (int ai = 0; ai < 2; ++ai)
#pragma unroll
            for (int mh = 0; mh < 2; ++mh) {
                f32x4 xv[2][2][2];
#pragma unroll
                for (int m2 = 0; m2 < 2; ++m2)
#pragma unroll
                    for (int bj = 0; bj < 2; ++bj)
#pragma unroll
                        for (int n = 0; n < 2; ++n) xv[m2][bj][n] = __builtin_nontemporal_load((const f32x4*)(X + ro + (unsigned)((ai * 128 + (mh * 2 + m2) * 16) * 1024 + bj * 128 + n * 4)));
#pragma unroll
                for (int m2 = 0; m2 < 2; ++m2) { const int m = mh * 2 + m2; const int row = u.pm * 256 + ai * 128 + wr * 64 + m * 16 + fr; const int t = row & 4095;
#pragma unroll
                    for (int bj = 0; bj < 2; ++bj) { f32x4 o[2];
#pragma unroll
                        for (int n = 0; n < 2; ++n) { const int col = col0 + bj * 128 + n * 4;
                            const f32x4 pv = *(const f32x4*)(pos + (col < 512 ? (t >> 6) * 512 + col : (t & 63) * 512 + (col - 512)));
                            const f32x4 gv = *(const f32x4*)(ada + b * 6144 + 2048 + col);
                            o[n] = xv[m2][bj][n] + pv + gv * acc[ai][bj][m][n]; }
                        *(u32x4*)(O + ro + (unsigned)((ai * 128 + m * 16) * 1024 + bj * 128)) = pack8(o[0], o[1]); } }
                __builtin_amdgcn_sched_barrier(0); }
    }
};
struct EpiGU {
    static constexpr bool PERM = true; bf16_t* O;
    __device__ __forceinline__ void operator()(const f32x4 (&acc)[2][2][4][2], const Unit& u, int wr, int wc, int fr, int fq) const {
        const int col0 = u.pn * 128 + wc * 32 + 8 * fq;
        EPI_ROWS(
            f32x4 v0, v1;
            _Pragma("unroll") for (int j = 0; j < 4; ++j) { const float g0 = acc[ai][0][m][0][j], g1 = acc[ai][0][m][1][j];
                v0[j] = g0 * sigmoidf_(g0) * acc[ai][1][m][0][j]; v1[j] = g1 * sigmoidf_(g1) * acc[ai][1][m][1][j]; }
            *(u32x4*)(O + (size_t)row * DE + col0) = pack8(v0, v1);
        )
    }
};
struct EpiDown {
    static constexpr bool PERM = true; bf16_t* O; const float* gate;
    __device__ __forceinline__ void operator()(const f32x4 (&acc)[2][2][4][2], const Unit& u, int wr, int wc, int fr, int fq) const {
        const int col0 = u.pn * 256 + wc * 32 + 8 * fq;
        EPI_ROWS(
            const float g = gate[row];
            _Pragma("unroll") for (int bj = 0; bj < 2; ++bj) *(u32x4*)(O + (size_t)row * 1024 + col0 + bj * 128) = pack8(acc[ai][bj][m][0] * g, acc[ai][bj][m][1] * g);
        )
    }
};

__device__ __forceinline__ void p0_ada(const Params& p, LAS unsigned char* lds, int item) {
    const int tid = threadIdx.x, lane = tid & 63, wv = tid >> 6;
    LAS float* s = (LAS float*)lds; LAS float* red = s + 9 * 1024;
    { float cv[18];
#pragma unroll
      for (int k = 0; k < 18; ++k) { const int i = tid + NTHR * k, r = i >> 10, d = i & 1023; cv[k] = r < 8 ? p.c[r * 1024 + d] : p.c_ctx[d]; }
#pragma unroll
      for (int k = 0; k < 18; ++k) s[tid + NTHR * k] = cv[k] * __builtin_amdgcn_rcpf(1.0f + __expf(-cv[k])); }
    __syncthreads();
    const int col = lane % 24, dh = lane / 24;
    const int dsl = wv * 128 + dh * 64;
    float a[9];
#pragma unroll
    for (int r = 0; r < 9; ++r) a[r] = 0.f;
    if (dh < 2) {
        const float* w = p.w_ada + (size_t)dsl * 6144 + item * 24 + col;
        for (int d0 = 0; d0 < 64; d0 += 32) { float wv2[32];
#pragma unroll
            for (int j = 0; j < 32; ++j) wv2[j] = __builtin_nontemporal_load(w + (size_t)(d0 + j) * 6144);
#pragma unroll
            for (int j = 0; j < 32; ++j)
#pragma unroll
                for (int r = 0; r < 9; ++r) a[r] += s[r * 1024 + dsl + d0 + j] * wv2[j]; }
#pragma unroll
        for (int r = 0; r < 9; ++r) red[((wv * 2 + dh) * 9 + r) * 24 + col] = a[r];
    }
    __syncthreads();
    float* ada = (float*)(p.ws + WS_ADA);
    if (tid < 9 * 24) { const int r = tid / 24, cc = tid % 24; float v = 0.f;
#pragma unroll
        for (int k = 0; k < 16; ++k) v += red[(k * 9 + r) * 24 + cc];
        __hip_atomic_store(ada + r * 6144 + item * 24 + cc, v + p.b_ada[item * 24 + cc], __ATOMIC_RELAXED, __HIP_MEMORY_SCOPE_AGENT); }
    asm volatile("s_waitcnt vmcnt(0)" ::: "memory");
    __syncthreads();
    if (tid == 0) (void)__hip_atomic_fetch_add((unsigned*)(p.ws + WS_BAR + 46 * KiB), 1u, __ATOMIC_RELAXED, __HIP_MEMORY_SCOPE_AGENT);
}
template <int NS>
__device__ __forceinline__ void xpose_item(const float* src, int ldsrc, bf16_t* dst, int lddst, int k0, int n0, int mode, float scale = 1.0f) {
    const int tid = threadIdx.x, k8 = tid & 7, nq = tid >> 3;
    if (nq >= 16 * NS) return;
    f32x4 v[8];
#pragma unroll
    for (int j = 0; j < 8; ++j) v[j] = __builtin_nontemporal_load((const f32x4*)(src + (size_t)(k0 + 8 * k8 + j) * ldsrc + n0 + 4 * nq));
#pragma unroll
    for (int c = 0; c < 4; ++c) { const int n = n0 + 4 * nq + c; int row = n;
        if (mode) row = (n >> 7) * 256 + (n & 127) + (mode == 2 ? 128 : 0);
        u32x4 w; w.x = cvt_pk_bf16(v[0][c] * scale, v[1][c] * scale); w.y = cvt_pk_bf16(v[2][c] * scale, v[3][c] * scale); w.z = cvt_pk_bf16(v[4][c] * scale, v[5][c] * scale); w.w = cvt_pk_bf16(v[6][c] * scale, v[7][c] * scale);
        *(u32x4*)(dst + (size_t)row * lddst + k0 + 8 * k8) = w; }
}
__device__ __forceinline__ void p0_wpq(const Params& p, LAS unsigned char* lds, int item) {
    const int tid = threadIdx.x, g = item >> 5, db = item & 31;
    LAS float* wl = (LAS float*)lds; LAS float* ct = wl + 32 * 129;
    for (int i = tid; i < 32 * 128; i += NTHR) { const int d = i >> 7, cc = i & 127; wl[d * 129 + cc] = p.w_in[(size_t)(db * 32 + d) * 4608 + g * 128 + cc]; }
    if (tid < 128) { float sn, cs; sincospif((float)tid * (1.0f / 64.0f), &sn, &cs); ct[tid] = cs; ct[128 + tid] = sn; }
    __syncthreads();
    const int q = tid & 127, kc = q >> 1, pq = q & 1, dh = tid >> 7; const int n = (g * 64 + kc) * 2 + pq;
    const bool spec = (kc == 0 && pq == 1); const int kce = spec ? 64 : kc, tsel = spec ? 0 : pq * 128;
    bf16_t* dst = (bf16_t*)(p.ws + WS_WPQ) + (size_t)n * 1024 + db * 32 + dh * 8;
    const float scale = 0.001381067932f;
    float a[8];
#pragma unroll
    for (int j = 0; j < 8; ++j) a[j] = 0.f;
    for (int cc = 0; cc < 128; ++cc) { const float tv = ct[tsel + ((cc * kce) & 127)];
#pragma unroll
        for (int j = 0; j < 8; ++j) a[j] += wl[(dh * 8 + j) * 129 + cc] * tv; }
    u32x4 w; w.x = cvt_pk_bf16(a[0] * scale, a[1] * scale); w.y = cvt_pk_bf16(a[2] * scale, a[3] * scale); w.z = cvt_pk_bf16(a[4] * scale, a[5] * scale); w.w = cvt_pk_bf16(a[6] * scale, a[7] * scale);
    *(u32x4*)dst = w;
    __syncthreads();
}
__device__ __forceinline__ void p0_d1t(const Params& p, int item) {
    bf16_t* dst = (bf16_t*)(p.ws + WS_D1T);
    const int row = item * 64 + (threadIdx.x >> 3), k1 = row >> 1, ri = row & 1, c0 = (threadIdx.x & 7) * 64;
    for (int c8 = 0; c8 < 64; c8 += 8) { float v[8];
#pragma unroll
        for (int j = 0; j < 8; ++j) { const int col = c0 + c8 + j, pq = col >> 8, t1 = col & 255; float sn, cs; sincospif((float)((k1 * t1) & 255) * (1.0f / 128.0f), &sn, &cs);
            v[j] = (ri == 0) ? (pq == 0 ? cs : -sn) : (pq == 0 ? -sn : -cs); }
        u32x4 w; w.x = cvt_pk_bf16(v[0], v[1]); w.y = cvt_pk_bf16(v[2], v[3]); w.z = cvt_pk_bf16(v[4], v[5]); w.w = cvt_pk_bf16(v[6], v[7]);
        *(u32x4*)(dst + (size_t)row * 512 + c0 + c8) = w; }
}
__device__ __forceinline__ void p0_d2t(const Params& p, int item) {
    bf16_t* dst = (bf16_t*)(p.ws + WS_D2T);
#pragma unroll
    for (int ps = 0; ps < 4; ++ps) { const int pc = (item * 4 + ps) * NTHR + threadIdx.x, tp = pc >> 2, kk0 = (pc & 3) * 8; float v[8];
#pragma unroll
        for (int j = 0; j < 8; ++j) { const int kk = kk0 + j, ri = kk >> 4, t2 = kk & 15; float sn, cs; sincospif((float)((tp * t2) & 4095) * (1.0f / 2048.0f), &sn, &cs); v[j] = ri ? sn : cs; }
        u32x4 w; w.x = cvt_pk_bf16(v[0], v[1]); w.y = cvt_pk_bf16(v[2], v[3]); w.z = cvt_pk_bf16(v[4], v[5]); w.w = cvt_pk_bf16(v[6], v[7]);
        *(u32x4*)(dst + (size_t)tp * 32 + kk0) = w; }
}
__device__ __forceinline__ void p0_pos(const Params& p, int item) {
    float* tab = (float*)(p.ws + WS_POS);
    for (int i = item * 2048 + threadIdx.x; i < (item + 1) * 2048; i += NTHR) { const int ii = i >> 9, j = i & 511, jj = j & 255; const float f = expf(-9.210340371976184f * (float)jj / 256.0f); const float a = (float)ii * f;
        __hip_atomic_store(tab + i, j < 256 ? sinf(a) : cosf(a), __ATOMIC_RELAXED, __HIP_MEMORY_SCOPE_AGENT); }
    asm volatile("s_waitcnt vmcnt(0)" ::: "memory");
    __syncthreads();
    if (threadIdx.x == 0) (void)__hip_atomic_fetch_add((unsigned*)(p.ws + WS_BAR + 46 * KiB), 1u, __ATOMIC_RELAXED, __HIP_MEMORY_SCOPE_AGENT);
}
__device__ __forceinline__ void phase0(const Params& p, LAS unsigned char* lds) {
    constexpr int N_ADA = 256, N_WIN = 16 * 16, N_WFOUR = 8 * 4, N_SQ = 16 * 4, N_LRU = 16 * 2, N_WPQ = 128, N_DFT = 8 + 8, N_POS = 16;
    constexpr int O1 = N_ADA, O2 = O1 + N_WIN, O3 = O2 + N_WFOUR, O4 = O3 + N_SQ, O5 = O4 + N_SQ, O6 = O5 + N_LRU, O7 = O6 + N_LRU, O8 = O7 + N_WPQ, O9 = O8 + N_DFT, O10 = O9 + N_POS;
    for (int it0 = blockIdx.x; it0 < O10; it0 += gridDim.x) {
        if (it0 < O1) { p0_ada(p, lds, it0); continue; }
        if (it0 < O1 + N_POS) { p0_pos(p, it0 - O1); continue; }
        const int it = it0 - N_POS;
        if (it < O2) { const int j = it - O1, ct = j & 15;
            if (ct < 8) xpose_item<4>(p.w_in + 512, 4608, (bf16_t*)(p.ws + WS_WIN), 1024, (j >> 4) * 64, ct * 256, 0);
            else if (ct < 12) xpose_item<4>(p.w_in + 512 + 2048, 4608, (bf16_t*)(p.ws + WS_WIN) + (size_t)2048 * 1024, 1024, (j >> 4) * 64, (ct - 8) * 256, 1);
            else xpose_item<4>(p.w_in + 512 + 3072, 4608, (bf16_t*)(p.ws + WS_WIN) + (size_t)2048 * 1024, 1024, (j >> 4) * 64, (ct - 12) * 256, 2); }
        else if (it < O3) { const int j = it - O2; xpose_item<4>(p.w_four, 1024, (bf16_t*)(p.ws + WS_WFOUR), 512, (j >> 2) * 64, (j & 3) * 256, 0); }
        else if (it < O4) { const int j = it - O3; xpose_item<4>(p.w_lru, 1024, (bf16_t*)(p.ws + WS_WLRU), 1024, (j >> 2) * 64, (j & 3) * 256, 0); }
        else if (it < O5) { const int j = it - O4; xpose_item<4>(p.w_out, 1024, (bf16_t*)(p.ws + WS_WOUT), 1024, (j >> 2) * 64, (j & 3) * 256, 0); }
        else if (it < O6) { const int j = it - O5, mtx = j >> 1; xpose_item<2>(p.lru_wa + (size_t)mtx * 16384, 128, (bf16_t*)(p.ws + WS_WAT) + (size_t)mtx * 16384, 128, (j & 1) * 64, 0, 0, NLOG2E); }
        else if (it < O7) { const int j = it - O6, mtx = j >> 1; xpose_item<2>(p.lru_wi + (size_t)mtx * 16384, 128, (bf16_t*)(p.ws + WS_WIT) + (size_t)mtx * 16384, 128, (j & 1) * 64, 0, 0, NLOG2E); }
        else if (it < O8) p0_wpq(p, lds, it - O7);
        else { if (it - O8 < 8) p0_d1t(p, it - O8); else p0_d2t(p, it - O8 - 8); }
    }
}

__device__ __forceinline__ void phase1(const Params& p) {
    const int tid = tid_opaque(), lane = tid & 63, wid = tid >> 6;
    const float* ada = (const float*)(p.ws + WS_ADA); const float* tab = (const float*)(p.ws + WS_POS);
    bf16_t* h1 = (bf16_t*)(p.ws + WS_R1); bf16_t* hc = (bf16_t*)(p.ws + WS_HCTX);
    constexpr int NR = MLAT + MCTX, RW = 4;
    for (int row0 = (blockIdx.x * 8 + wid) * RW; row0 < NR; row0 += gridDim.x * 8 * RW) {
        const bool lat = row0 < MLAT; const int mrow = lat ? (row0 >> 12) : 8;
        f32x4 v[RW][4]; float ss[RW];
#pragma unroll
        for (int r = 0; r < RW; ++r) { const int row = row0 + r; const float* xr = lat ? p.x + (size_t)row * 1024 : p.ctx + (size_t)(row - MLAT) * 1024;
#pragma unroll
            for (int i = 0; i < 4; ++i) v[r][i] = __builtin_nontemporal_load((const f32x4*)(xr + 256 * i + 4 * lane)); }
#pragma unroll
        for (int r = 0; r < RW; ++r) { const int t = (row0 + r) & 4095; float a = 0.f;
#pragma unroll
            for (int i = 0; i < 4; ++i) { const int d = 256 * i + 4 * lane;
                if (lat) v[r][i] += *(const f32x4*)(tab + (i < 2 ? (t >> 6) * 512 + d : (t & 63) * 512 + d - 512));
                a += v[r][i][0] * v[r][i][0] + v[r][i][1] * v[r][i][1] + v[r][i][2] * v[r][i][2] + v[r][i][3] * v[r][i][3]; }
            ss[r] = a; }
#pragma unroll
        for (int o = 32; o >= 1; o >>= 1) {
#pragma unroll
            for (int r = 0; r < RW; ++r) ss[r] += __shfl_xor(ss[r], o); }
#pragma unroll
        for (int i = 0; i < 4; ++i) { const int d = 256 * i + 4 * lane;
            const f32x4 g = *(const f32x4*)(p.norm1_g + d), sh = *(const f32x4*)(ada + mrow * 6144 + d), sc = *(const f32x4*)(ada + mrow * 6144 + 1024 + d);
#pragma unroll
            for (int r = 0; r < RW; ++r) { const int row = row0 + r; const float rs = rsqrtf(ss[r] * (1.0f / 1024.0f) + 1e-6f);
                bf16_t* dst = lat ? h1 + (size_t)row * 1024 : hc + (size_t)(row - MLAT) * 1024;
                const f32x4 h = v[r][i] * rs * g * (sc + 1.0f) + sh;
                u32x2 w; w.x = cvt_pk_bf16(h[0], h[1]); w.y = cvt_pk_bf16(h[2], h[3]); *(u32x2*)(dst + d) = w; } }
    }
}

#define LRU_CST(mb, r) (32 * (mb) + 8 * ((r) >> 2) + ((r) & 3))
template <bool FINAL, int DIR>
__device__ __forceinline__ void lru_wave(const Params& p, LAS unsigned char* ul, int b, int sc, int head, int cb, int lane, f32x16 (&accI)[4]) {
    constexpr int SG = DIR ? -1 : 1;
    const int lr = lane & 31, lh = lane >> 5;
    const int chl = cb * 32 + lr, ch = head * 128 + chl;
    const int tbase = DIR ? 127 - 4 * lh : 4 * lh;
    f32x16 accA[4];
#pragma unroll
    for (int mb = 0; mb < 4; ++mb)
#pragma unroll
        for (int r = 0; r < 16; ++r) { accA[mb][r] = 0.f; accI[mb][r] = 0.f; }
    {
        const bf16_t* wa = (const bf16_t*)(p.ws + WS_WAT) + ((size_t)(DIR * 8 + head) * 128 + chl) * 128 + 8 * lh;
        const bf16_t* wi = (const bf16_t*)(p.ws + WS_WIT) + ((size_t)(DIR * 8 + head) * 128 + chl) * 128 + 8 * lh;
        LAS unsigned char* arow0 = ul + (DIR ? 127 - lr : lr) * 272 + lh * 16;
#pragma unroll
        for (int kc = 0; kc < 2; ++kc) { bf16x8 bA[4], bI[4];
#pragma unroll
            for (int k4 = 0; k4 < 4; ++k4) { bA[k4] = *(const bf16x8*)(wa + 16 * (kc * 4 + k4)); bI[k4] = *(const bf16x8*)(wi + 16 * (kc * 4 + k4)); }
#pragma unroll
            for (int mb = 0; mb < 4; ++mb)
#pragma unroll
                for (int k4 = 0; k4 < 4; ++k4) { const bf16x8 af = *(const LAS bf16x8*)(arow0 + SG * 32 * mb * 272 + 32 * (kc * 4 + k4));
                    accA[mb] = __builtin_amdgcn_mfma_f32_32x32x16_bf16(af, bA[k4], accA[mb], 0, 0, 0);
                    accI[mb] = __builtin_amdgcn_mfma_f32_32x32x16_bf16(af, bI[k4], accI[mb], 0, 0, 0); }
            __builtin_amdgcn_sched_barrier(0); }
    }
    {
        const float lam = p.lru_lambda[DIR * 1024 + ch]; const float sp8 = 8.0f * log1pf(expf(-lam));
        const float ba = p.lru_ba[DIR * 1024 + ch], bi = p.lru_bi[DIR * 1024 + ch];
        LAS unsigned char* up = ul + tbase * 272 + chl * 2;
#pragma unroll
        for (int mb = 0; mb < 4; ++mb) {
#pragma unroll
            for (int r = 0; r < 16; ++r) {
                const float uv = bf2f(*(const LAS bf16_t*)(up + SG * LRU_CST(mb, r) * 272));
                const float rg = __builtin_amdgcn_rcpf(1.0f + __builtin_amdgcn_exp2f(accA[mb][r] + NLOG2E * ba)), ig = __builtin_amdgcn_rcpf(1.0f + __builtin_amdgcn_exp2f(accI[mb][r] + NLOG2E * bi));
                const float a = __expf(-sp8 * rg); accA[mb][r] = a; accI[mb][r] = __builtin_amdgcn_sqrtf(fmaxf(1.0f - a * a, 0.f)) * ig * uv; }
            __builtin_amdgcn_sched_barrier(0); }
    }
    float rA[16], rH[16];
#pragma unroll
    for (int mb = 0; mb < 4; ++mb)
#pragma unroll
        for (int q = 0; q < 4; ++q) { float pa = 1.f, hh = 0.f;
#pragma unroll
            for (int j = 0; j < 4; ++j) { const int r = 4 * q + j; const float a = accA[mb][r], bb = accI[mb][r]; hh = a * hh + bb; pa *= a; accA[mb][r] = pa; accI[mb][r] = hh; }
            rA[mb * 4 + q] = pa; rH[mb * 4 + q] = hh; }
    const int agg_dir_off = ((b * NSEQ) * 2 + DIR) * 1024 + ch;
    const float* agg = (const float*)(p.ws + WS_AGG);
    float carry = 0.f;
    if (FINAL) {
        if (DIR == 0) { for (int q = 0; q < sc; ++q) { const float* a2 = agg + (size_t)(agg_dir_off + q * 2048) * 2; carry = a2[0] * carry + a2[1]; } }
        else { { const float* a2 = agg + (size_t)(agg_dir_off + 1 * 2048) * 2; carry = a2[0] * carry + a2[1]; } { const float* a2 = agg + (size_t)(agg_dir_off + 0 * 2048) * 2; carry = a2[0] * carry + a2[1]; }
            for (int q = NSEQ - 1; q > sc; --q) { const float* a2 = agg + (size_t)(agg_dir_off + q * 2048) * 2; carry = a2[0] * carry + a2[1]; } }
    }
    float cin[16];
#pragma unroll
    for (int i = 0; i < 16; ++i) cin[i] = 0.f;
    float s = carry, At = 1.f;
#pragma unroll
    for (int i = 0; i < 16; ++i) { const float oA = __shfl_xor(rA[i], 32), oH = __shfl_xor(rH[i], 32);
        { const bool mine = (lh == 0); const float a = mine ? rA[i] : oA, hh = mine ? rH[i] : oH; cin[i] = mine ? s : cin[i]; s = a * s + hh; At *= a; }
        { const bool mine = (lh == 1); const float a = mine ? rA[i] : oA, hh = mine ? rH[i] : oH; cin[i] = mine ? s : cin[i]; s = a * s + hh; At *= a; } }
    if (!FINAL) {
        if (lh == 0) { float* o = (float*)(p.ws + WS_AGG) + (size_t)(agg_dir_off + sc * 2048) * 2; o[0] = At; o[1] = s; }
        return;
    }
#pragma unroll
    for (int mb = 0; mb < 4; ++mb)
#pragma unroll
        for (int r = 0; r < 16; ++r) accI[mb][r] += accA[mb][r] * cin[mb * 4 + (r >> 2)];
}
template <bool FINAL>
__device__ __forceinline__ void lru_tile(const Params& p, LAS unsigned char* lds, int item) {
    const int tid = threadIdx.x, lane = tid & 63, wid = __builtin_amdgcn_readfirstlane(tid >> 6);
    int b, sc, head;
    if (FINAL) { head = item & 7; sc = 2 + ((item >> 3) & 31); b = item >> 8; }
    else { head = item & 7; const int r = item >> 3; sc = r & 1; b = r >> 1; }
    const bf16_t* src; int Tseq, t0, ld;
    if (sc < 2) { src = (const bf16_t*)(p.ws + WS_ZXC) + (size_t)b * 256 * 1024; Tseq = 256; t0 = sc * 128; ld = 1024; }
    else { src = (const bf16_t*)(p.ws + WS_RZ) + (size_t)b * 4096 * 4096; Tseq = 4096; t0 = (sc - 2) * 128; ld = 4096; }
    LAS unsigned char* ul = lds;
    LAS float* ybuf = (LAS float*)(lds + 36 * 1024);
    {
        const int c8 = tid & 15, tb = tid >> 4; const int ch0 = head * 128 + 8 * c8;
        float w[4][8], bias[8];
#pragma unroll
        for (int k = 0; k < 4; ++k) { const f32x4 a = *(const f32x4*)(p.conv_w + k * 1024 + ch0), c2 = *(const f32x4*)(p.conv_w + k * 1024 + ch0 + 4);
#pragma unroll
            for (int j = 0; j < 4; ++j) { w[k][j] = a[j]; w[k][4 + j] = c2[j]; } }
        { const f32x4 a = *(const f32x4*)(p.conv_b + ch0), c2 = *(const f32x4*)(p.conv_b + ch0 + 4);
#pragma unroll
            for (int j = 0; j < 4; ++j) { bias[j] = a[j]; bias[4 + j] = c2[j]; } }
#pragma unroll
        for (int i = 0; i < 4; ++i) { const int t = tb + 32 * i; float a[8];
#pragma unroll
            for (int j = 0; j < 8; ++j) a[j] = bias[j];
#pragma unroll
            for (int k = 0; k < 4; ++k) { const int tt = t0 + t + k - 2;
                if (tt >= 0 && tt < Tseq) { float f[8]; unpack8(*(const u32x4*)(src + (size_t)tt * ld + ch0), f);
#pragma unroll
                    for (int j = 0; j < 8; ++j) a[j] += w[k][j] * f[j]; } }
            u32x4 wv; wv.x = cvt_pk_bf16(a[0], a[1]); wv.y = cvt_pk_bf16(a[2], a[3]); wv.z = cvt_pk_bf16(a[4], a[5]); wv.w = cvt_pk_bf16(a[6], a[7]);
            *(LAS u32x4*)(ul + t * 272 + c8 * 16) = wv; }
    }
    __syncthreads();
    f32x16 hacc[4];
    if (wid < 4) lru_wave<FINAL, 0>(p, ul, b, sc, head, wid & 3, lane, hacc);
    else lru_wave<FINAL, 1>(p, ul, b, sc, head, wid & 3, lane, hacc);
    if (FINAL) {
        const int lr = lane & 31, lh = lane >> 5, chl = (wid & 3) * 32 + lr;
        if (wid >= 4) { LAS float* yp = ybuf + (127 - 4 * lh) * 129 + chl;
#pragma unroll
            for (int mb = 0; mb < 4; ++mb)
#pragma unroll
                for (int r = 0; r < 16; ++r) yp[-LRU_CST(mb, r) * 129] = hacc[mb][r]; }
        __syncthreads();
        if (wid < 4) {
            const LAS float* yp = ybuf + (4 * lh) * 129 + chl;
            const bf16_t* Zu = (const bf16_t*)(p.ws + WS_RZ) + ((size_t)(b * 4096 + t0) * 4096 + 1024 + head * 128);
            bf16_t* Ou = (bf16_t*)(p.ws + WS_R1) + ((size_t)(b * 4096 + t0) * 1024 + head * 128);
            const unsigned zo = (unsigned)(4 * lh * 4096 + chl), oo = (unsigned)(4 * lh * 1024 + chl);
#pragma unroll
            for (int mb = 0; mb < 4; ++mb) {
#pragma unroll
                for (int r = 0; r < 16; ++r) {
                    const float y = hacc[mb][r] + yp[LRU_CST(mb, r) * 129];
                    const float gz = bf2f(Zu[zo + LRU_CST(mb, r) * 4096]);
                    Ou[oo + LRU_CST(mb, r) * 1024] = (bf16_t)(cvt_pk_bf16(gz * y, 0.f) & 0xffffu);
                    if ((r & 7) == 7) __builtin_amdgcn_sched_barrier(0); } }
        }
    }
    __syncthreads();
}

#ifndef LRU_PF_FRAG
#define LRU_PF_FRAG true
#endif
#ifndef LRU_PF_TILE
#define LRU_PF_TILE true
#endif
template <int DIR, bool PREF>
__device__ __forceinline__ void lru2_dir(const Params& p, LAS unsigned char* ul, int head, int w, int lane, const bf16x8 (&bA)[4], const bf16x8 (&bI)[4], bf16x8 (&nA)[4], bf16x8 (&nI)[4],
                                         f32x4 (&hl)[8], f32x4 (&pp)[8], float& Atot, float& Htot) {
    constexpr int SG = DIR ? -1 : 1;
    const int fr = lane & 15, fq = lane >> 4, chl = 16 * w + fr, ch = head * 128 + chl;
    f32x4 accA[8], accI[8];
    { const float ba2 = NLOG2E * p.lru_ba[DIR * 1024 + ch], bi2 = NLOG2E * p.lru_bi[DIR * 1024 + ch];
#pragma unroll
      for (int rb = 0; rb < 8; ++rb) { accA[rb] = (f32x4){ba2, ba2, ba2, ba2}; accI[rb] = (f32x4){bi2, bi2, bi2, bi2}; } }
    {
        LAS unsigned char* arow0 = ul + (DIR ? 127 - fr : fr) * 272 + fq * 16;
#pragma unroll
        for (int rb = 0; rb < 8; ++rb)
#pragma unroll
            for (int ks = 0; ks < 4; ++ks) { const bf16x8 af = *(const LAS bf16x8*)(arow0 + SG * 16 * rb * 272 + 64 * ks);
                accA[rb] = __builtin_amdgcn_mfma_f32_16x16x32_bf16(af, bA[ks], accA[rb], 0, 0, 0);
                accI[rb] = __builtin_amdgcn_mfma_f32_16x16x32_bf16(af, bI[ks], accI[rb], 0, 0, 0); }
    }
    if (PREF) {
        const bf16_t* wa = (const bf16_t*)(p.ws + WS_WAT) + ((size_t)((1 - DIR) * 8 + head) * 128 + chl) * 128 + 8 * fq;
        const bf16_t* wi = (const bf16_t*)(p.ws + WS_WIT) + ((size_t)((1 - DIR) * 8 + head) * 128 + chl) * 128 + 8 * fq;
#pragma unroll
        for (int ks = 0; ks < 4; ++ks) { nA[ks] = *(const bf16x8*)(wa + 32 * ks); nI[ks] = *(const bf16x8*)(wi + 32 * ks); }
    }
    {
        typedef float f32x2 __attribute__((ext_vector_type(2)));
        const float lam = p.lru_lambda[DIR * 1024 + ch]; const float k2 = NLOG2E * 8.0f * log1pf(expf(-lam));
        LAS unsigned char* up = ul + (DIR ? 127 - 4 * fq : 4 * fq) * 272 + chl * 2;
#pragma unroll
        for (int rb = 0; rb < 8; ++rb)
#pragma unroll
            for (int r = 0; r < 4; r += 2) {
                f32x2 uv; uv.x = bf2f(*(const LAS bf16_t*)(up + SG * (16 * rb + r) * 272)); uv.y = bf2f(*(const LAS bf16_t*)(up + SG * (16 * rb + r + 1) * 272));
                f32x2 ea, ei; ea.x = __builtin_amdgcn_exp2f(accA[rb][r]); ea.y = __builtin_amdgcn_exp2f(accA[rb][r + 1]); ei.x = __builtin_amdgcn_exp2f(accI[rb][r]); ei.y = __builtin_amdgcn_exp2f(accI[rb][r + 1]);
                const f32x2 da = ea + 1.0f, di = ei + 1.0f;
                f32x2 rg, ig; rg.x = __builtin_amdgcn_rcpf(da.x); rg.y = __builtin_amdgcn_rcpf(da.y); ig.x = __builtin_amdgcn_rcpf(di.x); ig.y = __builtin_amdgcn_rcpf(di.y);
                const f32x2 ka = rg * k2;
                f32x2 a; a.x = __builtin_amdgcn_exp2f(ka.x); a.y = __builtin_amdgcn_exp2f(ka.y);
                const f32x2 om = 1.0f - a * a;
                f32x2 sq; sq.x = __builtin_amdgcn_sqrtf(om.x); sq.y = __builtin_amdgcn_sqrtf(om.y);
                const f32x2 bb = sq * ig * uv;
                accA[rb][r] = a.x; accA[rb][r + 1] = a.y; accI[rb][r] = bb.x; accI[rb][r + 1] = bb.y; }
    }
    float rA[8], rH[8];
#pragma unroll
    for (int rb = 0; rb < 8; ++rb) { float pa = 1.f, hh = 0.f;
#pragma unroll
        for (int r = 0; r < 4; ++r) { const float a = accA[rb][r], bb = accI[rb][r]; hh = a * hh + bb; pa *= a; accA[rb][r] = pa; accI[rb][r] = hh; }
        rA[rb] = pa; rH[rb] = hh; }
    float Pc = 1.f, s = 0.f;
#pragma unroll
    for (int rb = 0; rb < 8; ++rb) { float Pin = 1.f, Hin = 0.f;
#pragma unroll
        for (int q = 0; q < 4; ++q) { const float a = __shfl(rA[rb], fr + 16 * q), hh = __shfl(rH[rb], fr + 16 * q);
            if (q == fq) { Pin = Pc; Hin = s; }
            s = a * s + hh; Pc *= a; }
#pragma unroll
        for (int r = 0; r < 4; ++r) { hl[rb][r] = accI[rb][r] + accA[rb][r] * Hin; pp[rb][r] = accA[rb][r] * Pin; }
        __builtin_amdgcn_sched_barrier(0); }
    Atot = Pc; Htot = s;
}
__device__ __forceinline__ u64_t agg_ld(const u64_t* a) { return __hip_atomic_load(a, __ATOMIC_RELAXED, __HIP_MEMORY_SCOPE_AGENT); }
template <int DIR>
__device__ __forceinline__ float lru2_carry(const u64_t* aggc, int n, int fr, int fq) {
    float Ap = 1.f, Hp = 0.f; u64_t v[9];
#pragma unroll
    for (int k = 0; k < 9; ++k) { const int j = fq * 9 + k; const int seq = DIR ? (j == 0 ? 1 : (j == 1 ? 0 : 35 - j)) : j;
        v[k] = (j < n) ? agg_ld(aggc + (size_t)seq * 2048) : 0x000000003f800000ull; }
#pragma unroll
    for (int k = 0; k < 9; ++k) { const float a = __uint_as_float((unsigned)v[k]), hh = __uint_as_float((unsigned)(v[k] >> 32)); Hp = a * Hp + hh; Ap *= a; }
    float s = 0.f;
#pragma unroll
    for (int q = 0; q < 4; ++q) { const float a = __shfl(Ap, fr + 16 * q), hh = __shfl(Hp, fr + 16 * q); s = a * s + hh; }
    return s;
}
__device__ __forceinline__ void lru2_block(const Params& p, LAS unsigned char* lds, int slot, int c, int ngr) {
    const int tid = threadIdx.x, lane = tid & 63, wid = __builtin_amdgcn_readfirstlane(tid >> 6);
    const int sc = c + 2, t0 = c * 128;
    LAS unsigned char* raw = lds;
    LAS unsigned char* ul = lds + 33792;
    LAS unsigned char* gzl = lds + 68608;
    LAS unsigned char* outl = lds + 103424;
    const int fr = lane & 15, fq = lane >> 4, chl = 16 * wid + fr;
    u32x4 nr[5], ng[4];
#define LRU2_LOAD_R(gg) do { const bf16_t* Zb_ = (const bf16_t*)(p.ws + WS_RZ) + (size_t)((gg) >> 3) * 4096 * 4096 + ((gg) & 7) * 128; \
        _Pragma("unroll") for (int k = 0; k < 5; ++k) { const int pc = tid + NTHR * k; nr[k] = (u32x4){0u, 0u, 0u, 0u}; \
            if (pc < 131 * 16) { const int row = pc >> 4, c8 = pc & 15, tt = t0 - 2 + row; if (tt >= 0 && tt < TT) nr[k] = __builtin_nontemporal_load((const u32x4*)(Zb_ + (size_t)tt * 4096 + c8 * 8)); } } } while (0)
#define LRU2_LOAD_G(gg) do { const bf16_t* Zb_ = (const bf16_t*)(p.ws + WS_RZ) + (size_t)((gg) >> 3) * 4096 * 4096 + ((gg) & 7) * 128; \
        _Pragma("unroll") for (int k = 0; k < 4; ++k) { const int pc = tid + NTHR * k, row = pc >> 4, c8 = pc & 15; ng[k] = __builtin_nontemporal_load((const u32x4*)(Zb_ + (size_t)(t0 + row) * 4096 + 1024 + c8 * 8)); } } while (0)
    LRU2_LOAD_R(slot); LRU2_LOAD_G(slot);
    for (int g = slot; g < NB * 8; g += ngr) {
        const int b = g >> 3, head = g & 7, ch = head * 128 + chl;
        unsigned* gcnt = (unsigned*)(p.ws + WS_BAR + 16 * KiB) + g * 64;
        bf16x8 bA1[4], bI1[4], bA0[4], bI0[4];
        { const bf16_t* wa = (const bf16_t*)(p.ws + WS_WAT) + ((size_t)(8 + head) * 128 + chl) * 128 + 8 * fq; const bf16_t* wi = (const bf16_t*)(p.ws + WS_WIT) + ((size_t)(8 + head) * 128 + chl) * 128 + 8 * fq;
#pragma unroll
          for (int ks = 0; ks < 4; ++ks) { bA1[ks] = *(const bf16x8*)(wa + 32 * ks); bI1[ks] = *(const bf16x8*)(wi + 32 * ks); } }
#pragma unroll
        for (int k = 0; k < 5; ++k) { const int pc = tid + NTHR * k; if (pc < 131 * 16) *(LAS u32x4*)(raw + (pc >> 4) * 256 + (pc & 15) * 16) = nr[k]; }
#pragma unroll
        for (int k = 0; k < 4; ++k) { const int pc = tid + NTHR * k; *(LAS u32x4*)(gzl + (pc >> 4) * 272 + (pc & 15) * 16) = ng[k]; }
        __syncthreads();
        {
            const int c8 = tid & 15, tb = tid >> 4; const int ch0 = head * 128 + 8 * c8;
            float w[4][8], bias[8];
#pragma unroll
            for (int k = 0; k < 4; ++k) { const f32x4 a = *(const f32x4*)(p.conv_w + k * 1024 + ch0), c2 = *(const f32x4*)(p.conv_w + k * 1024 + ch0 + 4);
#pragma unroll
                for (int j = 0; j < 4; ++j) { w[k][j] = a[j]; w[k][4 + j] = c2[j]; } }
            { const f32x4 a = *(const f32x4*)(p.conv_b + ch0), c2 = *(const f32x4*)(p.conv_b + ch0 + 4);
#pragma unroll
                for (int j = 0; j < 4; ++j) { bias[j] = a[j]; bias[4 + j] = c2[j]; } }
#pragma unroll
            for (int i = 0; i < 4; ++i) { const int t = tb + 32 * i; float a[8];
#pragma unroll
                for (int j = 0; j < 8; ++j) a[j] = bias[j];
#pragma unroll
                for (int k = 0; k < 4; ++k) { float f[8]; unpack8(*(const LAS u32x4*)(raw + (t + k) * 256 + c8 * 16), f);
#pragma unroll
                    for (int j = 0; j < 8; ++j) a[j] += w[k][j] * f[j]; }
                u32x4 wv; wv.x = cvt_pk_bf16(a[0], a[1]); wv.y = cvt_pk_bf16(a[2], a[3]); wv.z = cvt_pk_bf16(a[4], a[5]); wv.w = cvt_pk_bf16(a[6], a[7]);
                *(LAS u32x4*)(ul + t * 272 + c8 * 16) = wv; }
        }
        __syncthreads();
        float A0, H0, A1, H1;
        {
            f32x4 hl1[8], pp1[8];
            lru2_dir<1, LRU_PF_FRAG>(p, ul, head, wid, lane, bA1, bI1, bA0, bI0, hl1, pp1, A1, H1);
            LAS unsigned char* hp = outl + chl * 264 + (124 - 4 * fq) * 2; LAS unsigned char* qp = raw + chl * 264 + (124 - 4 * fq) * 2;
#pragma unroll
            for (int rb = 0; rb < 8; ++rb) { u32x2 wh, wq; wh.x = cvt_pk_bf16(hl1[rb][3], hl1[rb][2]); wh.y = cvt_pk_bf16(hl1[rb][1], hl1[rb][0]); wq.x = cvt_pk_bf16(pp1[rb][3], pp1[rb][2]); wq.y = cvt_pk_bf16(pp1[rb][1], pp1[rb][0]);
                *(LAS u32x2*)(hp - 32 * rb) = wh; *(LAS u32x2*)(qp - 32 * rb) = wq; }
        }
        __builtin_amdgcn_sched_barrier(0);
        if (!LRU_PF_FRAG) { const bf16_t* wa = (const bf16_t*)(p.ws + WS_WAT) + ((size_t)(head) * 128 + chl) * 128 + 8 * fq; const bf16_t* wi = (const bf16_t*)(p.ws + WS_WIT) + ((size_t)(head) * 128 + chl) * 128 + 8 * fq;
#pragma unroll
          for (int ks = 0; ks < 4; ++ks) { bA0[ks] = *(const bf16x8*)(wa + 32 * ks); bI0[ks] = *(const bf16x8*)(wi + 32 * ks); } }
        f32x4 hl0[8], pp0[8];
        lru2_dir<0, false>(p, ul, head, wid, lane, bA0, bI0, bA1, bI1, hl0, pp0, A0, H0);
        u64_t* agg = (u64_t*)(p.ws + WS_AGG);
        const size_t ai0 = ((size_t)(b * NSEQ) * 2 + 0) * 1024 + ch, ai1 = ((size_t)(b * NSEQ) * 2 + 1) * 1024 + ch;
        if (fq == 0) {
            __hip_atomic_store(agg + ai0 + (size_t)sc * 2048, ((u64_t)__float_as_uint(H0) << 32) | __float_as_uint(A0), __ATOMIC_RELAXED, __HIP_MEMORY_SCOPE_AGENT);
            __hip_atomic_store(agg + ai1 + (size_t)sc * 2048, ((u64_t)__float_as_uint(H1) << 32) | __float_as_uint(A1), __ATOMIC_RELAXED, __HIP_MEMORY_SCOPE_AGENT); }
        asm volatile("s_waitcnt vmcnt(0)" ::: "memory");
        __syncthreads();
        if (tid == 0) (void)__hip_atomic_fetch_add(gcnt, 1u, __ATOMIC_RELAXED, __HIP_MEMORY_SCOPE_AGENT);
        if (wid == 0) { unsigned sp = 0;
            while ((unsigned)__builtin_amdgcn_readfirstlane(__hip_atomic_load(gcnt, __ATOMIC_RELAXED, __HIP_MEMORY_SCOPE_AGENT)) < 32u) { __builtin_amdgcn_s_sleep(1); if (++sp > (1u << 22)) break; }
            __builtin_amdgcn_fence(__ATOMIC_ACQUIRE, "agent");
            asm volatile("s_waitcnt vmcnt(0)" ::: "memory"); }
        __syncthreads();
        const float C0 = lru2_carry<0>(agg + ai0, sc, fr, fq);
        const float C1 = lru2_carry<1>(agg + ai1, 2 + (NSEQ - 1 - sc), fr, fq);
        __builtin_amdgcn_sched_barrier(0);
        if (LRU_PF_TILE) { const int gn = (g + ngr < NB * 8) ? g + ngr : g; LRU2_LOAD_R(gn); LRU2_LOAD_G(gn); }
        __builtin_amdgcn_sched_barrier(0);
        LAS unsigned char* gp = gzl + (4 * fq) * 272 + chl * 2; LAS unsigned char* op = outl + (4 * fq) * 272 + chl * 2;
        const LAS unsigned char* hp1 = outl + chl * 264 + (4 * fq) * 2; const LAS unsigned char* qp1 = raw + chl * 264 + (4 * fq) * 2;
        unsigned ov[16];
#pragma unroll
        for (int rb = 0; rb < 8; ++rb) { const u32x2 wh = *(const LAS u32x2*)(hp1 + 32 * rb), wq = *(const LAS u32x2*)(qp1 + 32 * rb);
            const float h1v[4] = {bf_lo(wh.x), bf_hi(wh.x), bf_lo(wh.y), bf_hi(wh.y)}, q1v[4] = {bf_lo(wq.x), bf_hi(wq.x), bf_lo(wq.y), bf_hi(wq.y)};
            float o[4];
#pragma unroll
            for (int r = 0; r < 4; ++r) { const float y = hl0[rb][r] + pp0[rb][r] * C0 + h1v[r] + q1v[r] * C1;
                o[r] = bf2f(*(const LAS bf16_t*)(gp + (16 * rb + r) * 272)) * y; }
            ov[2 * rb] = cvt_pk_bf16(o[0], o[1]); ov[2 * rb + 1] = cvt_pk_bf16(o[2], o[3]); }
        __syncthreads();
#pragma unroll
        for (int rb = 0; rb < 8; ++rb) { *(LAS bf16_t*)(op + (16 * rb + 0) * 272) = (bf16_t)(ov[2 * rb] & 0xffffu); *(LAS bf16_t*)(op + (16 * rb + 1) * 272) = (bf16_t)(ov[2 * rb] >> 16);
            *(LAS bf16_t*)(op + (16 * rb + 2) * 272) = (bf16_t)(ov[2 * rb + 1] & 0xffffu); *(LAS bf16_t*)(op + (16 * rb + 3) * 272) = (bf16_t)(ov[2 * rb + 1] >> 16); }
        __syncthreads();
        bf16_t* Ob = (bf16_t*)(p.ws + WS_R1) + ((size_t)(b * 4096 + t0)) * 1024 + head * 128;
#pragma unroll
        for (int k = 0; k < 4; ++k) { const int pc = tid + NTHR * k, row = pc >> 4, c8 = pc & 15;
            *(u32x4*)(Ob + (size_t)row * 1024 + c8 * 8) = *(const LAS u32x4*)(outl + row * 272 + c8 * 16); }
        __syncthreads();
        if (!LRU_PF_TILE && g + ngr < NB * 8) LRU2_LOAD_R(g + ngr);
    }
#undef LRU2_LOAD_R
#undef LRU2_LOAD_G
}

__device__ __forceinline__ void fft_stage2_all(const Params& p, LAS unsigned char* lds) {
    const int tid = tid_opaque(), lane = tid & 63, wid = tid >> 6, fr = lane & 15, fq = lane >> 4;
    const bf16_t* Yt = (const bf16_t*)((const unsigned char*)p.out + OUT_YT); const bf16_t* D2 = (const bf16_t*)(p.ws + WS_D2T);
    bf16_t* Fo = (bf16_t*)((unsigned char*)p.out + OUT_F);
    const int G = gridDim.x;
    int it = blockIdx.x; bf16x8 dfr, yfr[3];
    LAS unsigned char* own = lds; LAS unsigned char* mir = lds + 16 * 528;
#define S2_LOAD(item) do { const int b_ = (item) & 7, k1_ = (item) >> 3; dfr = *(const bf16x8*)(D2 + (size_t)(k1_ + 256 * fr) * 32 + 8 * fq); \
        const bf16_t* yrow_ = Yt + (size_t)(k1_ * 2 + (fq >> 1)) * FCOLS + 8 * (fq & 1); \
        _Pragma("unroll") for (int n = 0; n < 2; ++n) yfr[n] = __builtin_nontemporal_load((const bf16x8*)(yrow_ + (size_t)(b_ * 256 + 16 * (2 * wid + n) + fr) * 16)); \
        yfr[2] = __builtin_nontemporal_load((const bf16x8*)(yrow_ + (size_t)(32768 + (b_ * 4 + (fr & 3)) * 16))); } while (0)
    if (it < NB * 256) S2_LOAD(it);
    for (; it < NB * 256; it += G) {
        const int b = it & 7, k1 = it >> 3;
        f32x4 acc[3];
#pragma unroll
        for (int n = 0; n < 3; ++n) acc[n] = __builtin_amdgcn_mfma_f32_16x16x32_bf16(yfr[n], dfr, (f32x4){0.f, 0.f, 0.f, 0.f}, 0, 0, 0);
        const int nx = it + G; if (nx < NB * 256) S2_LOAD(nx);
#pragma unroll
        for (int n = 0; n < 3; ++n) mfma_settle(acc[n]);
#pragma unroll
        for (int n = 0; n < 2; ++n) { const int c0 = 16 * (2 * wid + n) + 4 * fq, g = c0 >> 6, kb = c0 & 63;
            u32x2 w; w.x = cvt_pk_bf16(acc[n][0], acc[n][1]); w.y = cvt_pk_bf16(acc[n][2], acc[n][3]);
            *(LAS u32x2*)(own + fr * 528 + c0 * 2) = w;
            LAS bf16_t* mp = (LAS bf16_t*)(mir + fr * 528) + g * 64 + 64 - kb;
            if (kb != 0) mp[0] = (bf16_t)(w.x & 0xffffu);
            mp[-1] = (bf16_t)(w.x >> 16); mp[-2] = (bf16_t)(w.y & 0xffffu); mp[-3] = (bf16_t)(w.y >> 16); }
        if (wid == 0 && fq == 0) {
            u32x2 w; w.x = cvt_pk_bf16(acc[2][0], acc[2][1]); w.y = cvt_pk_bf16(acc[2][2], acc[2][3]);
            LAS bf16_t* mp = (LAS bf16_t*)(mir + fr * 528);
            mp[0] = (bf16_t)(w.x & 0xffffu); mp[64] = (bf16_t)(w.x >> 16); mp[128] = (bf16_t)(w.y & 0xffffu); mp[192] = (bf16_t)(w.y >> 16); }
        __syncthreads();
        { const int k2 = tid >> 5, c8 = tid & 31, tp = k1 + 256 * k2, tm = (4096 - tp) & 4095, col = (c8 >> 3) * 128 + (c8 & 7) * 8;
          *(u32x4*)(Fo + ((size_t)b * 4096 + tp) * 512 + col) = *(const LAS u32x4*)(own + k2 * 528 + c8 * 16);
          *(u32x4*)(Fo + ((size_t)b * 4096 + tm) * 512 + col + 64) = *(const LAS u32x4*)(mir + k2 * 528 + c8 * 16); }
        __syncthreads();
    }
#undef S2_LOAD
}

__device__ __forceinline__ void topk_task(const Params& p, LAS unsigned char* lds, int it) {
    const int tid = tid_opaque(), lane = tid & 63, wid = tid >> 6;
    LAS unsigned* cnt = (LAS unsigned*)lds;
    LAS unsigned* wsum = cnt + 64;
    const float* scores = (const float*)(p.ws + WS_SCORES);
    int* idx = (int*)(p.ws + WS_IDX); float* gate = (float*)(p.ws + WS_GATE); int* slot_of = (int*)(p.ws + WS_SLOT);
    const int b = it >> 4, e = it & 15;
    unsigned key[8];
    { const u64_t* sp = (const u64_t*)(scores + (size_t)it * 4096 + tid * 8);
#pragma unroll
      for (int j = 0; j < 4; ++j) { const u64_t v = __hip_atomic_load(sp + j, __ATOMIC_RELAXED, __HIP_MEMORY_SCOPE_AGENT); key[2 * j] = (unsigned)v; key[2 * j + 1] = (unsigned)(v >> 32); } }
    unsigned thr = 0;
    for (int step = 0; step < 16; ++step) {
        const int sh = 29 - 2 * step;
        const unsigned c1 = sh >= 0 ? (thr | (1u << sh)) : (thr | 1u), c2 = sh >= 0 ? (thr | (2u << sh)) : 0xffffffffu, c3 = sh >= 0 ? (thr | (3u << sh)) : 0xffffffffu;
        unsigned n1 = 0, n2 = 0, n3 = 0;
#pragma unroll
        for (int j = 0; j < 8; ++j) { n1 += (unsigned)__popcll(__ballot(key[j] >= c1)); n2 += (unsigned)__popcll(__ballot(key[j] >= c2)); n3 += (unsigned)__popcll(__ballot(key[j] >= c3)); }
        LAS unsigned* cb = cnt + (step & 1) * 32;
        if (lane == 0) { cb[wid] = n1; cb[8 + wid] = n2; cb[16 + wid] = n3; }
        __syncthreads();
        unsigned t1 = 0, t2 = 0, t3 = 0;
#pragma unroll
        for (int w = 0; w < 8; ++w) { t1 += cb[w]; t2 += cb[8 + w]; t3 += cb[16 + w]; }
        if (sh >= 0) thr = t3 >= (unsigned)CAP ? c3 : (t2 >= (unsigned)CAP ? c2 : (t1 >= (unsigned)CAP ? c1 : thr));
        else thr = t1 >= (unsigned)CAP ? c1 : thr;
    }
    unsigned cg_ = 0, ce = 0;
#pragma unroll
    for (int j = 0; j < 8; ++j) { cg_ += key[j] > thr; ce += key[j] == thr; }
    unsigned pk = cg_ | (ce << 16), incl = pk;
#pragma unroll
    for (int o = 1; o < 64; o <<= 1) { const unsigned n = __shfl_up(incl, o); if (lane >= o) incl += n; }
    if (lane == 63) wsum[wid] = incl;
    __syncthreads();
    unsigned base = 0, total = 0;
#pragma unroll
    for (int w = 0; w < 8; ++w) { const unsigned s2 = wsum[w]; if (w < wid) base += s2; total += s2; }
    const unsigned excl = base + incl - pk; unsigned og = excl & 0xffffu, oe = excl >> 16; const unsigned ngt = total & 0xffffu, krem = (unsigned)CAP - ngt;
    int mm[8];
#pragma unroll
    for (int j = 0; j < 8; ++j) { const int t = tid * 8 + j; int m = -1;
        if (key[j] > thr) { m = (e * 8 + b) * 512 + (int)og; ++og; }
        else if (key[j] == thr) { if (oe < krem) m = (e * 8 + b) * 512 + (int)(ngt + oe); ++oe; }
        mm[j] = m;
        if (m >= 0) { idx[m] = b * 4096 + t; gate[m] = __uint_as_float(key[j]); } }
    { u32x4* so = (u32x4*)(slot_of + (size_t)it * 4096 + tid * 8);
      so[0] = (u32x4){(unsigned)mm[0], (unsigned)mm[1], (unsigned)mm[2], (unsigned)mm[3]}; so[1] = (u32x4){(unsigned)mm[4], (unsigned)mm[5], (unsigned)mm[6], (unsigned)mm[7]}; }
    __syncthreads();
}

__device__ __forceinline__ void phase7_rows(const Params& p, LAS unsigned char* lds) {
    const int tid = threadIdx.x, lane = tid & 63, wid = tid >> 6;
    LAS float* wrt = (LAS float*)lds;
    for (int i = tid; i < 16 * 1024; i += NTHR) { const int d = i >> 4, e = i & 15; wrt[e * 1024 + d] = p.w_router[i]; }
    __syncthreads();
    const float* ada = (const float*)(p.ws + WS_ADA); bf16_t* h2 = (bf16_t*)(p.ws + WS_H2); const bf16_t* x2b = (const bf16_t*)(p.ws + WS_X2B); float* scores = (float*)(p.ws + WS_SCORES);
    for (int row0 = (blockIdx.x * 8 + wid) * 2; row0 < MLAT; row0 += gridDim.x * 16) {
        const int b = row0 >> 12;
        f32x4 v[2][4]; float ss[2];
#pragma unroll
        for (int r = 0; r < 2; ++r)
#pragma unroll
            for (int i = 0; i < 4; ++i) { const u32x2 w = *(const u32x2*)(x2b + (size_t)(row0 + r) * 1024 + 256 * i + 4 * lane); v[r][i] = (f32x4){bf_lo(w.x), bf_hi(w.x), bf_lo(w.y), bf_hi(w.y)}; }
#pragma unroll
        for (int r = 0; r < 2; ++r) { float a = 0.f;
#pragma unroll
            for (int i = 0; i < 4; ++i) a += v[r][i][0] * v[r][i][0] + v[r][i][1] * v[r][i][1] + v[r][i][2] * v[r][i][2] + v[r][i][3] * v[r][i][3];
            ss[r] = a; }
#pragma unroll
        for (int o = 32; o >= 1; o >>= 1) { ss[0] += __shfl_xor(ss[0], o); ss[1] += __shfl_xor(ss[1], o); }
#pragma unroll
        for (int i = 0; i < 4; ++i) { const int d = 256 * i + 4 * lane;
            const f32x4 g = *(const f32x4*)(p.norm2_g + d), sh = *(const f32x4*)(ada + b * 6144 + 3072 + d), sc = *(const f32x4*)(ada + b * 6144 + 4096 + d);
#pragma unroll
            for (int r = 0; r < 2; ++r) { const float rs = rsqrtf(ss[r] * (1.0f / 1024.0f) + 1e-6f);
                v[r][i] = v[r][i] * rs * g * (sc + 1.0f) + sh;
                u32x2 w; w.x = cvt_pk_bf16(v[r][i][0], v[r][i][1]); w.y = cvt_pk_bf16(v[r][i][2], v[r][i][3]); *(u32x2*)(h2 + (size_t)(row0 + r) * 1024 + d) = w; } }
        float q[32];
#pragma unroll
        for (int e = 0; e < 16; ++e) { float a0 = 0.f, a1 = 0.f;
#pragma unroll
            for (int i = 0; i < 4; ++i) { const f32x4 w = *(const LAS f32x4*)(wrt + e * 1024 + 256 * i + 4 * lane);
                a0 += v[0][i][0] * w[0] + v[0][i][1] * w[1] + v[0][i][2] * w[2] + v[0][i][3] * w[3];
                a1 += v[1][i][0] * w[0] + v[1][i][1] * w[1] + v[1][i][2] * w[2] + v[1][i][3] * w[3]; }
            q[e] = a0; q[16 + e] = a1; }
#pragma unroll
        for (int j = 0; j < 16; ++j) { const bool up = (lane & 32) != 0; const float send = up ? q[j] : q[16 + j], keep = up ? q[16 + j] : q[j]; q[j] = keep + __shfl_xor(send, 32); }
#pragma unroll
        for (int j = 0; j < 8; ++j) { const bool up = (lane & 16) != 0; const float send = up ? q[j] : q[8 + j], keep = up ? q[8 + j] : q[j]; q[j] = keep + __shfl_xor(send, 16); }
#pragma unroll
        for (int j = 0; j < 4; ++j) { const bool up = (lane & 8) != 0; const float send = up ? q[j] : q[4 + j], keep = up ? q[4 + j] : q[j]; q[j] = keep + __shfl_xor(send, 8); }
#pragma unroll
        for (int j = 0; j < 2; ++j) { const bool up = (lane & 4) != 0; const float send = up ? q[j] : q[2 + j], keep = up ? q[2 + j] : q[j]; q[j] = keep + __shfl_xor(send, 4); }
        { const bool up = (lane & 2) != 0; const float send = up ? q[0] : q[1], keep = up ? q[1] : q[0]; q[0] = keep + __shfl_xor(send, 2); }
        float lg = q[0] + __shfl_xor(q[0], 1);
        float mx = lg;
#pragma unroll
        for (int o = 2; o <= 16; o <<= 1) mx = fmaxf(mx, __shfl_xor(mx, o));
        const float ex = expf(lg - mx); float sum = ex;
#pragma unroll
        for (int o = 2; o <= 16; o <<= 1) sum += __shfl_xor(sum, o);
        if (gridDim.x == 256) {
            LAS float* scl = (LAS float*)(lds + 64 * 1024);
            if ((lane & 1) == 0) scl[((lane >> 1) & 15) * 16 + wid * 2 + (lane >> 5)] = ex / sum;
            __syncthreads();
            if (tid < 128) { const int e = tid >> 3, q = tid & 7; const u64_t v2 = *(const LAS u64_t*)(scl + e * 16 + 2 * q);
                __hip_atomic_store((u64_t*)(scores + ((size_t)b * 16 + e) * 4096 + ((row0 - 2 * wid) & 4095) + 2 * q), v2, __ATOMIC_RELAXED, __HIP_MEMORY_SCOPE_AGENT); }
            asm volatile("s_waitcnt vmcnt(0)" ::: "memory");
            __syncthreads();
            if (tid == 0) (void)__hip_atomic_fetch_add((unsigned*)(p.ws + WS_BAR + 44 * KiB) + b * 64, 1u, __ATOMIC_RELAXED, __HIP_MEMORY_SCOPE_AGENT);
        } else if ((lane & 1) == 0) scores[((size_t)b * 16 + ((lane >> 1) & 15)) * 4096 + ((row0 + (lane >> 5)) & 4095)] = ex / sum;
    }
    __syncthreads();
}
__device__ __forceinline__ void phase7_topk(const Params& p, LAS unsigned char* lds) {
    const int bid = blockIdx.x; if (bid >= NB * NE) return;
    unsigned* c = (unsigned*)(p.ws + WS_BAR + 44 * KiB) + (bid >> 4) * 64;
    if (threadIdx.x < 64) { unsigned sp = 0;
        while ((unsigned)__builtin_amdgcn_readfirstlane(__hip_atomic_load(c, __ATOMIC_RELAXED, __HIP_MEMORY_SCOPE_AGENT)) < 256u) { __builtin_amdgcn_s_sleep(1); if (++sp > (1u << 22)) break; }
        __builtin_amdgcn_fence(__ATOMIC_ACQUIRE, "agent");
        asm volatile("s_waitcnt vmcnt(0)" ::: "memory"); }
    __syncthreads();
    topk_task(p, lds, bid);
}
__device__ __forceinline__ void phase7_weights(const Params& p) {
    constexpr int N_G = 16 * 16 * 6, N_D = 16 * 24 * 4;
    const bool fused = gridDim.x == 256;
    for (int j = 0; ; ++j) {
        int it;
        if (!fused) it = blockIdx.x + j * gridDim.x;
        else if (blockIdx.x >= 128) it = j < 4 ? (blockIdx.x - 128) + 128 * j : 512 + blockIdx.x + (j - 4) * 256;
        else it = 512 + blockIdx.x + j * 256;
        if (it >= 2 * N_G + N_D) break;
        if (it < 2 * N_G) { const int up = it >= N_G, j = up ? it - N_G : it, e = j / 96, r = j % 96, kb = r / 6, nb = r % 6;
            xpose_item<4>((up ? p.w_up_e : p.w_gate_e) + (size_t)e * 1024 * 1536, 1536, (bf16_t*)(p.ws + WS_WGU) + (size_t)e * 3072 * 1024, 1024, kb * 64, nb * 256, up ? 2 : 1); }
        else { const int j = it - 2 * N_G, e = j / 96, r = j % 96, kb = r >> 2, nb = r & 3;
            xpose_item<4>(p.w_down_e + (size_t)e * 1536 * 1024, 1024, (bf16_t*)(p.ws + WS_WD) + (size_t)e * 1024 * 1536, 1536, kb * 64, nb * 256, 0); }
    }
}

__device__ __forceinline__ void phase11(const Params& p, float* dst) {
    const int tid = tid_opaque(), lane = tid & 63, wid = tid >> 6;
    const float* ada = (const float*)(p.ws + WS_ADA); const int* slot_of = (const int*)(p.ws + WS_SLOT); const bf16_t* oute = (const bf16_t*)(p.ws + WS_OUTE); const bf16_t* x2b = (const bf16_t*)(p.ws + WS_X2B);
    const int stride = gridDim.x * 16;
    int row0 = (blockIdx.x * 8 + wid) * 2;
    int myslot = row0 < MLAT ? slot_of[((size_t)(row0 >> 12) * 16 + (lane & 15)) * 4096 + ((row0 & 4095) + ((lane >> 4) & 1))] : -1;
    for (; row0 < MLAT; row0 += stride) {
        const int b = row0 >> 12;
        const int nrow = row0 + stride; const int nslot = nrow < MLAT ? slot_of[((size_t)(nrow >> 12) * 16 + (lane & 15)) * 4096 + ((nrow & 4095) + ((lane >> 4) & 1))] : -1;
        f32x4 xv[2][4], acc[2][4];
#pragma unroll
        for (int r = 0; r < 2; ++r)
#pragma unroll
            for (int i = 0; i < 4; ++i) { const u32x2 w = __builtin_nontemporal_load((const u32x2*)(x2b + (size_t)(row0 + r) * 1024 + 256 * i + 4 * lane)); xv[r][i] = (f32x4){bf_lo(w.x), bf_hi(w.x), bf_lo(w.y), bf_hi(w.y)}; acc[r][i] = (f32x4){0.f, 0.f, 0.f, 0.f}; }
        const unsigned long long bal = __ballot(myslot >= 0);
        unsigned mask0 = (unsigned)(bal & 0xffffull), mask1 = (unsigned)((bal >> 16) & 0xffffull);
        while (mask0 | mask1) {
            int m[2][2];
#pragma unroll
            for (int j = 0; j < 2; ++j) { if (mask0) { const int e = __builtin_ctz(mask0); mask0 &= mask0 - 1; m[0][j] = __builtin_amdgcn_readlane(myslot, e); } else m[0][j] = MMOE;
                                          if (mask1) { const int e = __builtin_ctz(mask1); mask1 &= mask1 - 1; m[1][j] = __builtin_amdgcn_readlane(myslot, 16 + e); } else m[1][j] = MMOE; }
            u32x2 w[2][2][4];
#pragma unroll
            for (int r = 0; r < 2; ++r)
#pragma unroll
                for (int j = 0; j < 2; ++j)
#pragma unroll
                    for (int i = 0; i < 4; ++i) w[r][j][i] = __builtin_nontemporal_load((const u32x2*)(oute + (size_t)m[r][j] * 1024 + 256 * i + 4 * lane));
#pragma unroll
            for (int r = 0; r < 2; ++r)
#pragma unroll
                for (int j = 0; j < 2; ++j)
#pragma unroll
                    for (int i = 0; i < 4; ++i) { acc[r][i][0] += bf_lo(w[r][j][i].x); acc[r][i][1] += bf_hi(w[r][j][i].x); acc[r][i][2] += bf_lo(w[r][j][i].y); acc[r][i][3] += bf_hi(w[r][j][i].y); }
        }
        float ss[2];
#pragma unroll
        for (int r = 0; r < 2; ++r) { float a = 0.f;
#pragma unroll
            for (int i = 0; i < 4; ++i) { const int d = 256 * i + 4 * lane; const f32x4 g2 = *(const f32x4*)(ada + b * 6144 + 5120 + d); xv[r][i] += g2 * acc[r][i];
                a += xv[r][i][0] * xv[r][i][0] + xv[r][i][1] * xv[r][i][1] + xv[r][i][2] * xv[r][i][2] + xv[r][i][3] * xv[r][i][3]; }
            ss[r] = a; }
#pragma unroll
        for (int o = 32; o >= 1; o >>= 1) { ss[0] += __shfl_xor(ss[0], o); ss[1] += __shfl_xor(ss[1], o); }
#pragma unroll
        for (int r = 0; r < 2; ++r) { const float rs = rsqrtf(ss[r] * (1.0f / 1024.0f) + 1e-6f);
#pragma unroll
            for (int i = 0; i < 4; ++i) { const int d = 256 * i + 4 * lane; __builtin_nontemporal_store(xv[r][i] * rs * *(const f32x4*)(p.final_g + d), (f32x4*)(dst + (size_t)(row0 + r) * 1024 + d)); } }
        myslot = nslot;
    }
}

#define XB_TMO      128
#define XB_XCNT(j)  (256  + 64 * (j))
#define XB_XSUB(j)  (1280 + 64 * (j))
#define XB_XGEN(j)  (2304 + 64 * (j))
#define XB_TOP      3328
#define XB_TOPGEN   3392
#define XCD_BAR_WORDS 3456
#define XB_SPIN_CAP (1u << 22)
__device__ __forceinline__ unsigned xb_ld(unsigned* p)              { return __hip_atomic_load(p, __ATOMIC_RELAXED, __HIP_MEMORY_SCOPE_AGENT); }
__device__ __forceinline__ unsigned xb_add(unsigned* p, unsigned v) { return __hip_atomic_fetch_add(p, v, __ATOMIC_RELAXED, __HIP_MEMORY_SCOPE_AGENT); }
__device__ __forceinline__ unsigned xb_xcc_id() { return (unsigned)__builtin_amdgcn_s_getreg((3 << 11) | 20) & 0xFu; }
#define XB_SPIN(cond, bar) do { unsigned _sp = 0; while (cond) { __builtin_amdgcn_s_sleep(1); \
    if ((++_sp & 255u) == 0u) { if (xb_ld(&(bar)[XB_TMO])) break; if (_sp > XB_SPIN_CAP) { atomicAdd(&(bar)[XB_TMO], 1u); break; } } } } while (0)
struct XcdBarrier { unsigned* bar; unsigned x; volatile LAS unsigned* st; };
__device__ __forceinline__ XcdBarrier xcd_barrier_post(unsigned* bar, volatile LAS unsigned* st) {
    XcdBarrier b; b.bar = bar; b.x = xb_xcc_id(); b.st = st;
    if (threadIdx.x == 0) (void)xb_add(&bar[XB_XCNT(b.x)], 1u);
    return b;
}
__device__ __forceinline__ void xcd_barrier_complete(unsigned* bar, unsigned x, unsigned& nloc, unsigned& nx) {
    const unsigned G = gridDim.x * gridDim.y * gridDim.z;
    unsigned sum, cnt, mine, sp = 0u;
    for (;;) {
        sum = 0u; cnt = 0u; mine = 0u;
#pragma unroll
        for (unsigned j = 0; j < 16; ++j) { const unsigned c = xb_ld(&bar[XB_XCNT(j)]); sum += c; cnt += (c > 0u) ? 1u : 0u; mine = (j == x) ? c : mine; }
        if (sum == G) break;
        __builtin_amdgcn_s_sleep(1);
        if ((++sp & 255u) == 0u) { if (xb_ld(&bar[XB_TMO])) break; if (sp > XB_SPIN_CAP) { atomicAdd(&bar[XB_TMO], 1u); break; } }
    }
    nloc = mine > 0u ? mine : 1u; nx = cnt > 0u ? cnt : 1u;
}
__device__ __forceinline__ void xcd_barrier(const XcdBarrier& b) {
    asm volatile("s_waitcnt vmcnt(0)" ::: "memory");
    __syncthreads();
    if (threadIdx.x == 0) {
        unsigned* bar = b.bar;
        __builtin_amdgcn_s_waitcnt(0);
        unsigned nloc = b.st[0], nx = b.st[1];
        if (nloc == 0u) { xcd_barrier_complete(bar, b.x, nloc, nx); b.st[0] = nloc; b.st[1] = nx; }
        const unsigned old = xb_add(&bar[XB_XSUB(b.x)], 1u);
        const unsigned gen = old / nloc;
        if (old + 1u == (gen + 1u) * nloc) {
            __builtin_amdgcn_fence(__ATOMIC_RELEASE, "agent");
            asm volatile("s_waitcnt vmcnt(0)" ::: "memory");
            const unsigned og = xb_add(&bar[XB_TOP], 1u);
            const unsigned tg = og / nx;
            if (og + 1u == (tg + 1u) * nx) xb_add(&bar[XB_TOPGEN], 1u);
            else XB_SPIN(xb_ld(&bar[XB_TOPGEN]) == tg, bar);
            __builtin_amdgcn_fence(__ATOMIC_ACQUIRE, "agent");
            xb_add(&bar[XB_XGEN(b.x)], 1u);
            asm volatile("s_waitcnt vmcnt(0)" ::: "memory");
        } else {
            XB_SPIN(xb_ld(&bar[XB_XGEN(b.x)]) == gen, bar);
            __builtin_amdgcn_fence(__ATOMIC_ACQUIRE, "agent");
            asm volatile("s_waitcnt vmcnt(0)" ::: "memory");
        }
    }
    __syncthreads();
}

__global__ void __launch_bounds__(NTHR, 2) fwd_megakernel(Params p_in) {
    Params p = p_in;
    extern __shared__ __attribute__((aligned(16))) unsigned char lds_raw[];
    LAS unsigned char* lds = (LAS unsigned char*)lds_raw;
    cg::grid_group grid = cg::this_grid();
    const int G = gridDim.x, bid = blockIdx.x;
    unsigned char* ws = p.ws;
    bf16_t* const R1 = (bf16_t*)(ws + WS_R1); bf16_t* const Zb = (bf16_t*)(ws + WS_RZ); bf16_t* const PQt = (bf16_t*)(ws + WS_RPQ); bf16_t* const MRG = (bf16_t*)(ws + WS_R2);
    bf16_t* const Fb = (bf16_t*)((unsigned char*)p.out + OUT_F); bf16_t* const Ytb = (bf16_t*)((unsigned char*)p.out + OUT_YT);
#ifdef ONLY_PH
#define PH(k) ((k) == ONLY_PH && p.ph_lo <= (k) && (k) < p.ph_hi)
#else
#define PH(k) (p.ph_lo <= (k) && (k) < p.ph_hi)
#endif
    volatile LAS unsigned* xst = (volatile LAS unsigned*)(lds + LDS_BYTES - 16);
    if (threadIdx.x < 4) xst[threadIdx.x] = 0u;
    __syncthreads();
    XcdBarrier xbar = xcd_barrier_post((unsigned*)(ws + WS_BAR), xst);
    if (p.ph_lo < 0) grid.sync();
#ifdef TS_A
    unsigned long long* tsb = (unsigned long long*)(ws + WS_BAR + 40 * KiB);
#define STAMP(i) do { if (bid == 0 && threadIdx.x == 0) tsb[i] = __builtin_amdgcn_s_memrealtime(); } while (0)
#else
#define STAMP(i) do { } while (0)
#endif
    STAMP(0);
#define LAUNDER() do { asm volatile("" : "+s"(p.ws), "+s"(p.out), "+s"(p.x)); ws = p.ws; } while (0)
#define SYNC(k) do { if (PH(k) && PH((k) + 1)) xcd_barrier(xbar); STAMP((k) + 1); LAUNDER(); } while (0)
#ifndef REPMASK
#define REPMASK 0
#endif
#define REP(k) for (int rep_ = 0; rep_ <= ((REPMASK >> (k)) & 1); ++rep_)
    const bool fuse01 = PH(0) && PH(1);
    if (PH(0)) phase0(p, lds);
    if (fuse01) block_wait_ge((unsigned*)(ws + WS_BAR + 46 * KiB), 256u + 16u);
    else SYNC(0);
    if (PH(1)) REP(1) phase1(p);
    SYNC(1);
    if (PH(2)) REP(2) {
        { ProbPQ pr{(const bf16_t*)(ws + WS_WPQ), R1, 1024, 1024, 16384}; pg8::Order S; S.init(2, 128, G, bid); EpiPQ E{PQt}; pg8::gemm_phase(lds, pr, S, E); }
        STAMP(28);
        { ProbPlain pr{R1, (const bf16_t*)(ws + WS_WIN), 1024, 1024, 1024}; pg8::Order S; S.init(128, 16, G, bid); EpiZ E{Zb, 4096, -1}; pg8::gemm_phase(lds, pr, S, E); }
        STAMP(29);
        { ProbPlain pr{(const bf16_t*)(ws + WS_HCTX), (const bf16_t*)(ws + WS_WIN), 1024, 1024, 1024}; pg8::Order S; S.init(8, 4, G, bid); EpiZ E{(bf16_t*)(ws + WS_ZXC), 1024, 0}; pg8::gemm_phase(lds, pr, S, E); }
    }
    SYNC(2);
    if (PH(3)) REP(3) {
        {
            ProbPlain pr{(const bf16_t*)(ws + WS_D1T), PQt, 512, 512, 512}; pg8::Order S; S.init(2, FCOLS / 256, G, bid);
            if (G == 256) { if (bid >= 128) { S.G = 128; S.c = bid - 128; S.base = 0; S.lim = 2; } else { S.G = 128; S.c = bid; S.base = 256; S.lim = bid < 4 ? 1 : 0; } }
            EpiPlain E{Ytb, FCOLS}; pg8::gemm_phase(lds, pr, S, E); }
        for (int it = bid; it < NB * 2 * 8; it += G) lru_tile<false>(p, lds, it);
    }
    SYNC(3);
    if (PH(4)) {
        fft_stage2_all(p, lds);
        const int ngr = G >> 5;
        if (ngr > 0 && bid < ngr * 32) lru2_block(p, lds, bid % ngr, bid / ngr, ngr);
    }
    SYNC(4);
    if (PH(5)) REP(5) {
        { ProbMerge pr{Fb, (const bf16_t*)(ws + WS_WFOUR), R1, (const bf16_t*)(ws + WS_WLRU), 512, 1024, 512, 512, 1024, 1024}; pg8::Order S; S.init(128, 4, G, bid); EpiMerge E{MRG, Zb}; pg8::gemm_phase2(lds, pr, S, E); }
    }
    SYNC(5);
    if (PH(6)) REP(6) { ProbPlain pr{MRG, (const bf16_t*)(ws + WS_WOUT), 1024, 1024, 1024}; pg8::Order S; S.init(128, 4, G, bid); if (512 % G == 0) S.rev = 512 / G;
        EpiOut E{(bf16_t*)(ws + WS_X2B), p.x, (const float*)(ws + WS_POS), (const float*)(ws + WS_ADA)}; pg8::gemm_phase(lds, pr, S, E); }
    SYNC(6);
    if (PH(7)) { phase7_rows(p, lds); if (G == 256) phase7_topk(p, lds); phase7_weights(p); }
    SYNC(7);
    if (PH(8) && G != 256) { for (int it = bid; it < NB * NE; it += G) topk_task(p, lds, it); }
    if (G != 256) SYNC(8);
    if (PH(9)) REP(9) { ProbMoeUp pr{(const bf16_t*)(ws + WS_H2), (const bf16_t*)(ws + WS_WGU), (const int*)(ws + WS_IDX), 1024, 1024, 1024}; pg8::Order S; S.init(256, 12, G, bid); S.wgm = P9_WGM; EpiGU E{(bf16_t*)(ws + WS_HID)}; pg8::gemm_phase(lds, pr, S, E); }
    SYNC(9);
    if (PH(10)) { if (bid == 0 && threadIdx.x < 128) *(u32x4*)(ws + WS_OUTE + (size_t)MMOE * 2048 + threadIdx.x * 16) = (u32x4){0u, 0u, 0u, 0u}; }
    if (PH(10)) REP(10) { ProbMoeDown pr{(const bf16_t*)(ws + WS_HID), (const bf16_t*)(ws + WS_WD), 1536, 1536, 1536}; pg8::Order S; S.init(256, 4, G, bid); if (1024 % G == 0) S.rev = 1024 / G; EpiDown E{(bf16_t*)(ws + WS_OUTE), (const float*)(ws + WS_GATE)}; pg8::gemm_phase(lds, pr, S, E); }
    SYNC(10);
    if (PH(11)) phase11(p, p.out);
#ifdef TS_A
    xcd_barrier(xbar); STAMP(12);
    if (bid == 0 && threadIdx.x == 0) {

#ifndef TS_AE
#define TS_AE (TS_A + 1)
#endif
#ifndef TS_BE
#define TS_BE (TS_B + 1)
#endif
        const float ta = (float)(tsb[TS_AE] - tsb[TS_A]) * 0.01f * (float)(TS_SA), tb = (float)(tsb[TS_BE] - tsb[TS_B]) * 0.01f * (float)(TS_SB);
        p.out[7] = fminf(ta, 97.f); p.out[1024 * 5 + 9] = fminf(tb, 97.f); }
#endif
}

#ifndef N_LAUNCHES
#define N_LAUNCHES 1
#endif
#ifndef PROBE_DUP
#define PROBE_DUP 0x0
#endif
extern "C" void kernel_launch(void* const* d_in, const int* in_sizes, int n_in, void* d_out, int out_size, void* d_ws, size_t ws_size, hipStream_t stream) {
    static int grid = 0;
    if (grid == 0) {
        if (n_in != 24 || out_size != MLAT * DM || ws_size < WS_END) { fprintf(stderr, "kernel_launch: unexpected shapes (n_in %d out %d ws %zu)\n", n_in, out_size, ws_size); grid = -1; return; }
        int dev = 0, cus = 0, per_cu = 0;
        hipGetDevice(&dev); hipDeviceGetAttribute(&cus, hipDeviceAttributeMultiprocessorCount, dev);
        hipFuncSetAttribute((const void*)fwd_megakernel, hipFuncAttributeMaxDynamicSharedMemorySize, LDS_BYTES);
        hipOccupancyMaxActiveBlocksPerMultiprocessor(&per_cu, (const void*)fwd_megakernel, NTHR, LDS_BYTES);
        if (per_cu < 1) { fprintf(stderr, "kernel_launch: occupancy query reports %d blocks per CU\n", per_cu); per_cu = 1; }
        grid = cus * 1;
        (void)hipGetLastError();
    }
    if (grid < 0) return;
    Params p{};
    const float** f = (const float**)&p;
    for (int i = 0; i < 24; ++i) f[i] = (const float*)d_in[i];
    p.out = (float*)d_out; p.ws = (unsigned char*)d_ws;
    (void)hipMemsetAsync((unsigned char*)d_ws + WS_BAR, 0, 48 * KiB, stream);
#if N_LAUNCHES == 1
    p.ph_lo = 0; p.ph_hi = 12;
    void* args[] = {&p};
    hipError_t e = hipLaunchCooperativeKernel((const void*)fwd_megakernel, dim3(grid), dim3(NTHR), args, LDS_BYTES, stream);
    if (e != hipSuccess) fprintf(stderr, "cooperative launch failed: %s (grid %d)\n", hipGetErrorString(e), grid);
#else
    for (int k = 0; k < 12; ++k) for (int r = 0; r <= ((PROBE_DUP >> k) & 1); ++r) { p.ph_lo = k; p.ph_hi = k + 1; if (k == 11 && r == 0 && ((PROBE_DUP >> 11) & 1)) { p.ph_lo = 12; p.ph_hi = 13; } hipLaunchKernelGGL(fwd_megakernel, dim3(grid), dim3(NTHR), LDS_BYTES, stream, p); }
#endif
}
```

```cpp
#include <hip/hip_runtime.h>
#include <hip/hip_cooperative_groups.h>
#include <cstdio>
namespace cg = cooperative_groups;

#ifndef P9_WGM
#define P9_WGM 2
#endif
#define LAS __attribute__((address_space(3)))
typedef unsigned short bf16_t;
typedef short bf16x8 __attribute__((ext_vector_type(8)));
typedef float f32x4 __attribute__((ext_vector_type(4)));
typedef float f32x16 __attribute__((ext_vector_type(16)));
typedef unsigned u32x4 __attribute__((ext_vector_type(4)));
typedef unsigned u32x2 __attribute__((ext_vector_type(2)));
typedef unsigned long long u64_t;

constexpr int NB = 8, TT = 4096, DM = 1024, CTXL = 256, MLAT = NB * TT, MCTX = NB * CTXL;
constexpr int NE = 16, CAP = 512, DE = 1536, MMOE = NE * NB * CAP;
constexpr int NSEQ = 34;
constexpr int NTHR = 512;
constexpr float NLOG2E = -1.4426950408889634f;
constexpr int LDS_BYTES = 144 * 1024;

constexpr size_t KiB = 1024, MiB = 1024 * 1024;
constexpr size_t WS_ADA = 0;
constexpr size_t WS_POS = 256 * KiB;
constexpr size_t WS_AGG = 512 * KiB;
constexpr int FCOLS = 32768 + 512;
constexpr size_t WS_WPQ = 5 * MiB;
constexpr size_t WS_WIN = 7 * MiB;
constexpr size_t WS_WFOUR = 15 * MiB;
constexpr size_t WS_WLRU = 16 * MiB;
constexpr size_t WS_WOUT = 18 * MiB;
constexpr size_t WS_WAT = 20 * MiB;
constexpr size_t WS_WIT = 20 * MiB + 512 * KiB;
constexpr size_t WS_SCORES = 21 * MiB;
constexpr size_t WS_IDX = 23 * MiB;
constexpr size_t WS_GATE = 23 * MiB + 256 * KiB;
constexpr size_t WS_SLOT = 23 * MiB + 512 * KiB;
constexpr size_t WS_BAR = 25 * MiB + 512 * KiB;
constexpr size_t WS_D1T = 34 * MiB;
constexpr size_t WS_D2T = 34 * MiB + 512 * KiB;
constexpr size_t WS_HCTX = 26 * MiB;
constexpr size_t WS_ZXC = 30 * MiB;
constexpr size_t WS_R1 = 40 * MiB;
constexpr size_t WS_RPQ = 104 * MiB;
constexpr size_t WS_R2 = 168 * MiB;
constexpr size_t WS_RZ = 232 * MiB;
constexpr size_t WS_END = 504 * MiB;
constexpr size_t WS_X2B = WS_R1, WS_H2 = WS_RPQ, WS_WGU = 168 * MiB, WS_WD = 264 * MiB, WS_HID = 312 * MiB, WS_OUTE = WS_RPQ;
constexpr size_t OUT_YT = 0, OUT_F = 64 * MiB;

struct Params {
    const float *x, *c, *ctx, *c_ctx, *w_ada, *b_ada, *norm1_g, *norm2_g, *w_in, *w_four, *conv_w, *conv_b, *lru_lambda,
        *lru_wa, *lru_ba, *lru_wi, *lru_bi, *w_lru, *w_out, *w_router, *w_gate_e, *w_up_e, *w_down_e, *final_g;
    float* out; unsigned char* ws; int ph_lo, ph_hi;
};

__device__ __forceinline__ int tid_opaque() { int t = threadIdx.x; asm volatile("" : "+v"(t)); return t; }
__device__ __forceinline__ unsigned cvt_pk_bf16(float lo, float hi) { unsigned r; asm volatile("v_cvt_pk_bf16_f32 %0, %1, %2" : "=v"(r) : "v"(lo), "v"(hi)); return r; }
__device__ __forceinline__ void mfma_settle(f32x4& a) { asm volatile("s_nop 15\n\ts_nop 7" : "+v"(a)); }
__device__ __forceinline__ void block_wait_ge(unsigned* cnt, unsigned need) {
    if (threadIdx.x < 64) { unsigned sp = 0;
        while ((unsigned)__builtin_amdgcn_readfirstlane(__hip_atomic_load(cnt, __ATOMIC_RELAXED, __HIP_MEMORY_SCOPE_AGENT)) < need) { __builtin_amdgcn_s_sleep(2); if (++sp > (1u << 22)) break; }
        __builtin_amdgcn_fence(__ATOMIC_ACQUIRE, "agent"); asm volatile("s_waitcnt vmcnt(0)" ::: "memory"); }
    __syncthreads();
}
__device__ __forceinline__ float bf_lo(unsigned w) { return __uint_as_float(w << 16); }
__device__ __forceinline__ float bf_hi(unsigned w) { return __uint_as_float(w & 0xffff0000u); }
__device__ __forceinline__ float bf2f(bf16_t h) { return __uint_as_float(((unsigned)h) << 16); }
__device__ __forceinline__ float sigmoidf_(float v) { return __builtin_amdgcn_rcpf(1.0f + __expf(-v)); }
__device__ __forceinline__ float gelu_tanh(float v) { const float y = 1.5957691216f * (v + 0.044715f * v * v * v); return v * sigmoidf_(y); }
__device__ __forceinline__ float wave_sum(float v) {
#pragma unroll
    for (int o = 32; o >= 1; o >>= 1) v += __shfl_xor(v, o);
    return v;
}
__device__ __forceinline__ void unpack8(const u32x4 w, float (&f)[8]) { f[0] = bf_lo(w.x); f[1] = bf_hi(w.x); f[2] = bf_lo(w.y); f[3] = bf_hi(w.y); f[4] = bf_lo(w.z); f[5] = bf_hi(w.z); f[6] = bf_lo(w.w); f[7] = bf_hi(w.w); }

namespace pg8 {
constexpr int BM = 256, BK = 64, HALF = 128, HTB = HALF * BK * 2, STAGE_BYTES = 8 * HTB, NXCD = 8, WGM = 2;
__device__ __forceinline__ int lds_byte(int r, int c) { const int st = (r >> 4) * 2 + (c >> 5), rr = r & 15, cc = c & 31, ob = rr * 64 + cc * 2; return st * 1024 + (ob ^ (((ob >> 9) & 1) << 5)); }
__device__ __forceinline__ void stage_rc(int b, int& R, int& C) { const int st = b / 1024, sb = b % 1024, swz = sb ^ (((sb >> 9) & 1) << 5); R = (st >> 1) * 16 + swz / 64; C = (st & 1) * 32 + (swz % 64) / 2; }
__device__ __forceinline__ int perm32(int rho) { const int n = rho >> 4, i = rho & 15; return 8 * (i >> 2) + 4 * n + (i & 3); }
struct Unit { int pm, pn; };
struct Order {
    int nM, nN, nwg, G, c, base, lim, rev, wgm;
    __device__ void init(int nM_, int nN_, int G_, int c_) { nM = nM_; nN = nN_; nwg = nM * nN; G = G_; c = c_; base = 0; lim = 0x7fffffff; rev = 0; wgm = WGM; }
    __device__ bool next(int i, Unit& u) const {
        if (rev > 0 && i >= rev) return false;
        const long L = (long)base + (long)(rev > 0 ? rev - 1 - i : i) * G + c; if (i >= lim || L >= nwg) return false;
        int wgid = (int)L; { const int q = nwg / NXCD, r = nwg % NXCD, xcd = wgid % NXCD, off = wgid / NXCD; wgid = (xcd < r ? xcd * (q + 1) : r * (q + 1) + (xcd - r) * q) + off; }
        const int nig = wgm * nN, gid = wgid / nig, fm = gid * wgm, gsz = (nM - fm) < wgm ? (nM - fm) : wgm;
        u.pm = fm + ((wgid % nig) % gsz); u.pn = (wgid % nig) / gsz; return true;
    }
};
template <class P, class Epi>
__device__ __forceinline__ void gemm_phase(LAS unsigned char* lds, const P& pr, const Order& S, const Epi& E) {
    const int tid = tid_opaque(), wid = __builtin_amdgcn_readfirstlane(tid >> 6), lane = tid & 63, wr = wid >> 2, wc = wid & 3, fr = lane & 15, fq = lane >> 4;
    const int nt = pr.K / BK;
    int RA[2], CA[2]; unsigned voffB[2];
#pragma unroll
    for (int i = 0; i < 2; ++i) { int R, C; stage_rc(tid * 16 + i * 8192, R, C); RA[i] = R; CA[i] = C; const int Rb = Epi::PERM ? ((R & ~31) + perm32(R & 31)) : R; voffB[i] = (unsigned)(Rb * pr.ldb + C) * 2u; }
    const size_t kstep = (size_t)(BK * 2);
    const size_t hstepB = (size_t)HALF * pr.ldb * 2;
    const unsigned ldsw = (unsigned)wid * 1024u;
    const int aoff = lds_byte(wr * 64 + fr, fq * 8), boff = lds_byte(wc * 32 + fr, fq * 8);
#define PG8_SA(b, h) (((b) * 2 + (h)) * HTB)
#define PG8_SB(b, h) ((4 + (b) * 2 + (h)) * HTB)
#define PG8_STAGE(bufoff, gbase, voff) do { _Pragma("unroll") for (int _i = 0; _i < 2; ++_i) \
        __builtin_amdgcn_global_load_lds((const unsigned*)((const char*)(gbase) + (voff)[_i]), (LAS unsigned*)(lds + (bufoff) + ldsw + _i * 8192), 16, 0, 0); } while (0)
#define PG8_LDA(dst, b, h) do { _Pragma("unroll") for (int m = 0; m < 4; ++m) _Pragma("unroll") for (int k = 0; k < 2; ++k) dst[m][k] = *(const LAS bf16x8*)(lds + PG8_SA(b, h) + aoff + m * 2048 + k * 1024); } while (0)
#define PG8_LDB(dst, b, h) do { _Pragma("unroll") for (int n = 0; n < 2; ++n) _Pragma("unroll") for (int k = 0; k < 2; ++k) dst[n][k] = *(const LAS bf16x8*)(lds + PG8_SB(b, h) + boff + n * 2048 + k * 1024); } while (0)
#define PG8_MMA(ai, bj, At, Bt) do { __builtin_amdgcn_s_setprio(1); _Pragma("unroll") for (int m = 0; m < 4; ++m) _Pragma("unroll") for (int n = 0; n < 2; ++n) _Pragma("unroll") for (int k = 0; k < 2; ++k) \
        acc[ai][bj][m][n] = __builtin_amdgcn_mfma_f32_16x16x32_bf16(Bt[n][k], At[m][k], acc[ai][bj][m][n], 0, 0, 0); __builtin_amdgcn_s_setprio(0); } while (0)
#define PG8_WAIT_V(n) asm volatile("s_waitcnt vmcnt(" #n ")" ::: "memory")
#define PG8_WAIT_L(n) asm volatile("s_waitcnt lgkmcnt(" #n ")" ::: "memory")
#define PG8_BAR __builtin_amdgcn_s_barrier()
#define PG8_SCHED __builtin_amdgcn_sched_barrier(0)
    Unit cur, nxt; int ui = 0;
    if (!S.next(0, cur)) return;
    f32x4 acc[2][2][4][2];
#pragma unroll
    for (int a = 0; a < 2; ++a)
#pragma unroll
        for (int b = 0; b < 2; ++b)
#pragma unroll
            for (int m = 0; m < 4; ++m)
#pragma unroll
                for (int n = 0; n < 2; ++n) acc[a][b][m][n] = (f32x4){0.f, 0.f, 0.f, 0.f};
    bf16x8 At[4][2], B0[2][2], B1[2][2];
    unsigned vA[2][2], vN[2][2];
    pr.avoff(cur, RA, CA, vA);
#pragma unroll
    for (int h = 0; h < 2; ++h)
#pragma unroll
        for (int i = 0; i < 2; ++i) vN[h][i] = vA[h][i];
    const char* cA = pr.abase(cur); const char* cB = pr.bbase(cur);
#define PG8_ROT(u) 0
#define PG8_KT(tt, rot) ((size_t)(((tt) + (rot)) >= nt ? ((tt) + (rot)) - nt : ((tt) + (rot))) * kstep)
    int rot = PG8_ROT(cur);
    { const char* pA = cA + PG8_KT(0, rot); const char* pB = cB + PG8_KT(0, rot);
    PG8_STAGE(PG8_SB(0, 0), pB, voffB); PG8_STAGE(PG8_SA(0, 0), pA, vA[0]); PG8_STAGE(PG8_SB(0, 1), pB + hstepB, voffB); PG8_STAGE(PG8_SA(0, 1), pA, vA[1]);
    if (wr == 1) PG8_BAR;
    PG8_WAIT_V(4); PG8_BAR;
    PG8_STAGE(PG8_SB(1, 0), pB + kstep, voffB); PG8_STAGE(PG8_SA(1, 0), pA + kstep, vA[0]); PG8_STAGE(PG8_SB(1, 1), pB + hstepB + kstep, voffB); }
    PG8_WAIT_V(6); PG8_BAR;
    for (;;) {
        const bool has_next = S.next(ui + 1, nxt);
        const char* nA = has_next ? pr.abase(nxt) : cA; const char* nB = has_next ? pr.bbase(nxt) : cB; const int nrot = has_next ? PG8_ROT(nxt) : rot;
        if (P::GATHER) { if (has_next) pr.avoff(nxt, RA, CA, vN); }
        for (int t = 0; t < nt; t += 2) {
            const bool last = (t == nt - 2);
            const char* a1 = cA + PG8_KT(t + 1, rot);
            const char* a2 = last ? nA + PG8_KT(0, nrot) : cA + PG8_KT(t + 2, rot); const char* b2 = last ? nB + PG8_KT(0, nrot) : cB + PG8_KT(t + 2, rot);
            const char* a3 = a2 + kstep; const char* b3 = b2 + kstep;
            unsigned v2[2][2];
#pragma unroll
            for (int h = 0; h < 2; ++h)
#pragma unroll
                for (int i = 0; i < 2; ++i) v2[h][i] = (P::GATHER && last) ? vN[h][i] : vA[h][i];
            PG8_LDB(B0, 0, 0); PG8_SCHED; PG8_LDA(At, 0, 0); PG8_STAGE(PG8_SA(1, 1), a1, vA[1]);
            PG8_WAIT_L(8); PG8_BAR; PG8_WAIT_L(0); PG8_MMA(0, 0, At, B0); PG8_BAR; PG8_SCHED;
            PG8_LDB(B1, 0, 1); PG8_STAGE(PG8_SB(0, 0), b2, voffB);
            PG8_BAR; PG8_WAIT_L(0); PG8_MMA(0, 1, At, B1); PG8_BAR;
            PG8_LDA(At, 0, 1); PG8_STAGE(PG8_SA(0, 0), a2, v2[0]);
            PG8_BAR; PG8_WAIT_L(0); PG8_MMA(1, 0, At, B0); PG8_BAR; PG8_SCHED;
            PG8_STAGE(PG8_SB(0, 1), b2 + hstepB, voffB);
            PG8_WAIT_V(6); PG8_BAR; PG8_MMA(1, 1, At, B1); PG8_BAR;
            PG8_LDB(B0, 1, 0); PG8_SCHED; PG8_LDA(At, 1, 0); PG8_STAGE(PG8_SA(0, 1), a2, v2[1]);
            PG8_WAIT_L(8); PG8_BAR; PG8_WAIT_L(0); PG8_MMA(0, 0, At, B0); PG8_BAR; PG8_SCHED;
            PG8_LDB(B1, 1, 1); PG8_STAGE(PG8_SB(1, 0), b3, voffB);
            PG8_BAR; PG8_WAIT_L(0); PG8_MMA(0, 1, At, B1); PG8_BAR;
            PG8_LDA(At, 1, 1); PG8_STAGE(PG8_SA(1, 0), a3, v2[0]);
            PG8_BAR; PG8_WAIT_L(0); PG8_MMA(1, 0, At, B0); PG8_BAR; PG8_SCHED;
            PG8_STAGE(PG8_SB(1, 1), b3 + hstepB, voffB);
            PG8_WAIT_V(6); PG8_BAR; PG8_MMA(1, 1, At, B1); PG8_BAR;
            if (P::GATHER && last) {
#pragma unroll
                for (int h = 0; h < 2; ++h)
#pragma unroll
                    for (int i = 0; i < 2; ++i) vA[h][i] = vN[h][i];
            }
        }
        E(acc, cur, wr, wc, fr, fq);
        if (!has_next) break;
#pragma unroll
        for (int a = 0; a < 2; ++a)
#pragma unroll
            for (int b = 0; b < 2; ++b)
#pragma unroll
                for (int m = 0; m < 4; ++m)
#pragma unroll
                    for (int n = 0; n < 2; ++n) acc[a][b][m][n] = (f32x4){0.f, 0.f, 0.f, 0.f};
        cur = nxt; cA = nA; cB = nB; rot = nrot; ++ui;
    }
    PG8_WAIT_V(0);
    if (wr == 0) PG8_BAR;
    PG8_BAR;
#undef PG8_ROT
#undef PG8_KT
#undef PG8_SA
#undef PG8_SB
#undef PG8_STAGE
#undef PG8_LDA
#undef PG8_LDB
#undef PG8_MMA
#undef PG8_WAIT_V
#undef PG8_WAIT_L
#undef PG8_BAR
#undef PG8_SCHED
}
template <class P, class Epi>
__device__ __forceinline__ void gemm_phase2(LAS unsigned char* lds, const P& pr, const Order& S, const Epi& E) {
    const int tid = tid_opaque(), wid = __builtin_amdgcn_readfirstlane(tid >> 6), lane = tid & 63, wr = wid >> 2, wc = wid & 3, fr = lane & 15, fq = lane >> 4;
    const int nt1 = pr.K1 / BK, nt = (pr.K1 + pr.K2) / BK;
    unsigned R2[2], Rb2[2], C2[2];
#pragma unroll
    for (int i = 0; i < 2; ++i) { int R, C; stage_rc(tid * 16 + i * 8192, R, C); const int Rb = Epi::PERM ? ((R & ~31) + perm32(R & 31)) : R; R2[i] = (unsigned)R * 2u; Rb2[i] = (unsigned)Rb * 2u; C2[i] = (unsigned)C * 2u; }
#define OFF_A(ld, h, i) ((R2[i] + (unsigned)((h) * 256)) * (unsigned)(ld) + C2[i])
#define OFF_B(ld, i) (Rb2[i] * (unsigned)(ld) + C2[i])
    const size_t kstep = (size_t)(BK * 2);
    const size_t hB1 = (size_t)HALF * pr.ldb1 * 2, hB2 = (size_t)HALF * pr.ldb2 * 2;
    const unsigned ldsw = (unsigned)wid * 1024u;
    const int aoff = lds_byte(wr * 64 + fr, fq * 8), boff = lds_byte(wc * 32 + fr, fq * 8);
#define PG8_SA(b, h) (((b) * 2 + (h)) * HTB)
#define PG8_SB(b, h) ((4 + (b) * 2 + (h)) * HTB)
#define PG8_STAGE(bufoff, gbase, voff) do { _Pragma("unroll") for (int _i = 0; _i < 2; ++_i) \
        __builtin_amdgcn_global_load_lds((const unsigned*)((const char*)(gbase) + (voff)[_i]), (LAS unsigned*)(lds + (bufoff) + ldsw + _i * 8192), 16, 0, 0); } while (0)
#define PG8_LDA(dst, b, h) do { _Pragma("unroll") for (int m = 0; m < 4; ++m) _Pragma("unroll") for (int k = 0; k < 2; ++k) dst[m][k] = *(const LAS bf16x8*)(lds + PG8_SA(b, h) + aoff + m * 2048 + k * 1024); } while (0)
#define PG8_LDB(dst, b, h) do { _Pragma("unroll") for (int n = 0; n < 2; ++n) _Pragma("unroll") for (int k = 0; k < 2; ++k) dst[n][k] = *(const LAS bf16x8*)(lds + PG8_SB(b, h) + boff + n * 2048 + k * 1024); } while (0)
#define PG8_MMA(ai, bj, At, Bt) do { __builtin_amdgcn_s_setprio(1); _Pragma("unroll") for (int m = 0; m < 4; ++m) _Pragma("unroll") for (int n = 0; n < 2; ++n) _Pragma("unroll") for (int k = 0; k < 2; ++k) \
        acc[ai][bj][m][n] = __builtin_amdgcn_mfma_f32_16x16x32_bf16(Bt[n][k], At[m][k], acc[ai][bj][m][n], 0, 0, 0); __builtin_amdgcn_s_setprio(0); } while (0)
#define PG8_WAIT_V(n) asm volatile("s_waitcnt vmcnt(" #n ")" ::: "memory")
#define PG8_WAIT_L(n) asm volatile("s_waitcnt lgkmcnt(" #n ")" ::: "memory")
#define PG8_BAR __builtin_amdgcn_s_barrier()
#define PG8_SCHED __builtin_amdgcn_sched_barrier(0)
    Unit cur, nxt; int ui = 0;
    if (!S.next(0, cur)) return;
    f32x4 acc[2][2][4][2];
#pragma unroll
    for (int a = 0; a < 2; ++a)
#pragma unroll
        for (int b = 0; b < 2; ++b)
#pragma unroll
            for (int m = 0; m < 4; ++m)
#pragma unroll
                for (int n = 0; n < 2; ++n) acc[a][b][m][n] = (f32x4){0.f, 0.f, 0.f, 0.f};
    bf16x8 At[4][2], B0[2][2], B1[2][2];
    const char* cA1 = pr.abase1(cur); const char* cB1 = pr.bbase1(cur); const char* cA2 = pr.abase2(cur); const char* cB2 = pr.bbase2(cur);
#define T_A(tt) ((tt) < nt1 ? cA1 + (size_t)(tt) * kstep : cA2 + (size_t)((tt) - nt1) * kstep)
#define T_B(tt) ((tt) < nt1 ? cB1 + (size_t)(tt) * kstep : cB2 + (size_t)((tt) - nt1) * kstep)
    { unsigned vb[2] = {OFF_B(pr.ldb1, 0), OFF_B(pr.ldb1, 1)}, va0[2] = {OFF_A(pr.lda1, 0, 0), OFF_A(pr.lda1, 0, 1)}, va1[2] = {OFF_A(pr.lda1, 1, 0), OFF_A(pr.lda1, 1, 1)};
    PG8_STAGE(PG8_SB(0, 0), cB1, vb); PG8_STAGE(PG8_SA(0, 0), cA1, va0); PG8_STAGE(PG8_SB(0, 1), cB1 + hB1, vb); PG8_STAGE(PG8_SA(0, 1), cA1, va1);
    if (wr == 1) PG8_BAR;
    PG8_WAIT_V(4); PG8_BAR;
    PG8_STAGE(PG8_SB(1, 0), cB1 + kstep, vb); PG8_STAGE(PG8_SA(1, 0), cA1 + kstep, va0); PG8_STAGE(PG8_SB(1, 1), cB1 + hB1 + kstep, vb); }
    PG8_WAIT_V(6); PG8_BAR;
    for (;;) {
        const bool has_next = S.next(ui + 1, nxt);
        const char* nA = has_next ? pr.abase1(nxt) : cA1; const char* nB = has_next ? pr.bbase1(nxt) : cB1;
        for (int t = 0; t < nt; t += 2) {
            const bool last = (t == nt - 2);
            const bool s1 = (t + 1 < nt1), s2 = last || (t + 2 < nt1);
            const char* a1 = T_A(t + 1);
            const char* a2 = last ? nA : T_A(t + 2); const char* b2 = last ? nB : T_B(t + 2);
            const char* a3 = a2 + kstep; const char* b3 = b2 + kstep;
            const size_t hstepB = s2 ? hB1 : hB2; const int ldaT1 = s1 ? pr.lda1 : pr.lda2, ldaT2 = s2 ? pr.lda1 : pr.lda2, ldbT2 = s2 ? pr.ldb1 : pr.ldb2;
            unsigned v2[2][2], voffB[2], vA1s[2];
#pragma unroll
            for (int i = 0; i < 2; ++i) { voffB[i] = OFF_B(ldbT2, i); vA1s[i] = OFF_A(ldaT1, 1, i);
#pragma unroll
                for (int h = 0; h < 2; ++h) v2[h][i] = OFF_A(ldaT2, h, i); }
            PG8_LDB(B0, 0, 0); PG8_SCHED; PG8_LDA(At, 0, 0); PG8_STAGE(PG8_SA(1, 1), a1, vA1s);
            PG8_WAIT_L(8); PG8_BAR; PG8_WAIT_L(0); PG8_MMA(0, 0, At, B0); PG8_BAR; PG8_SCHED;
            PG8_LDB(B1, 0, 1); PG8_STAGE(PG8_SB(0, 0), b2, voffB);
            PG8_BAR; PG8_WAIT_L(0); PG8_MMA(0, 1, At, B1); PG8_BAR;
            PG8_LDA(At, 0, 1); PG8_STAGE(PG8_SA(0, 0), a2, v2[0]);
            PG8_BAR; PG8_WAIT_L(0); PG8_MMA(1, 0, At, B0); PG8_BAR; PG8_SCHED;
            PG8_STAGE(PG8_SB(0, 1), b2 + hstepB, voffB);
            PG8_WAIT_V(6); PG8_BAR; PG8_MMA(1, 1, At, B1); PG8_BAR;
            PG8_LDB(B0, 1, 0); PG8_SCHED; PG8_LDA(At, 1, 0); PG8_STAGE(PG8_SA(0, 1), a2, v2[1]);
            PG8_WAIT_L(8); PG8_BAR; PG8_WAIT_L(0); PG8_MMA(0, 0, At, B0); PG8_BAR; PG8_SCHED;
            PG8_LDB(B1, 1, 1); PG8_STAGE(PG8_SB(1, 0), b3, voffB);
            PG8_BAR; PG8_WAIT_L(0); PG8_MMA(0, 1, At, B1); PG8_BAR;
            PG8_LDA(At, 1, 1); PG8_STAGE(PG8_SA(1, 0), a3, v2[0]);
            PG8_BAR; PG8_WAIT_L(0); PG8_MMA(1, 0, At, B0); PG8_BAR; PG8_SCHED;
            PG8_STAGE(PG8_SB(1, 1), b3 + hstepB, voffB);
            PG8_WAIT_V(6); PG8_BAR; PG8_MMA(1, 1, At, B1); PG8_BAR;
            if (t == nt1 - 2) E.mid(acc, cur, wr, wc, fr, fq);
        }
        E(acc, cur, wr, wc, fr, fq);
        if (!has_next) break;
#pragma unroll
        for (int a = 0; a < 2; ++a)
#pragma unroll
            for (int b = 0; b < 2; ++b)
#pragma unroll
                for (int m = 0; m < 4; ++m)
#pragma unroll
                    for (int n = 0; n < 2; ++n) acc[a][b][m][n] = (f32x4){0.f, 0.f, 0.f, 0.f};
        cur = nxt; cA1 = nA; cB1 = nB; cA2 = pr.abase2(cur); cB2 = pr.bbase2(cur); ++ui;
    }
    PG8_WAIT_V(0);
    if (wr == 0) PG8_BAR;
    PG8_BAR;
#undef T_A
#undef T_B
#undef OFF_A
#undef OFF_B
#undef PG8_SA
#undef PG8_SB
#undef PG8_STAGE
#undef PG8_LDA
#undef PG8_LDB
#undef PG8_MMA
#undef PG8_WAIT_V
#undef PG8_WAIT_L
#undef PG8_BAR
#undef PG8_SCHED
}
}
using pg8::Unit;

struct ProbPlain {
    static constexpr bool GATHER = false;
    const bf16_t* A; const bf16_t* B; int K, lda, ldb;
    __device__ __forceinline__ const char* abase(const Unit& u) const { return (const char*)(A + (size_t)u.pm * 256 * lda); }
    __device__ __forceinline__ const char* bbase(const Unit& u) const { return (const char*)(B + (size_t)u.pn * 256 * ldb); }
    __device__ __forceinline__ void avoff(const Unit&, const int (&RA)[2], const int (&CA)[2], unsigned (&v)[2][2]) const {
#pragma unroll
        for (int h = 0; h < 2; ++h)
#pragma unroll
            for (int i = 0; i < 2; ++i) v[h][i] = (unsigned)((h * 128 + RA[i]) * lda + CA[i]) * 2u;
    }
};
struct ProbMerge {
    const bf16_t* A1; const bf16_t* B1; const bf16_t* A2; const bf16_t* B2; int K1, K2, lda1, ldb1, lda2, ldb2;
    __device__ __forceinline__ const char* abase1(const Unit& u) const { return (const char*)(A1 + (size_t)u.pm * 256 * lda1); }
    __device__ __forceinline__ const char* bbase1(const Unit& u) const { return (const char*)(B1 + (size_t)u.pn * 256 * ldb1); }
    __device__ __forceinline__ const char* abase2(const Unit& u) const { return (const char*)(A2 + (size_t)u.pm * 256 * lda2); }
    __device__ __forceinline__ const char* bbase2(const Unit& u) const { return (const char*)(B2 + (size_t)u.pn * 256 * ldb2); }
};
struct ProbPQ {
    static constexpr bool GATHER = false;
    const bf16_t* A; const bf16_t* B; int K, lda, ldb;
    __device__ __forceinline__ const char* abase(const Unit& u) const { return (const char*)(A + (size_t)u.pm * 256 * lda); }
    __device__ __forceinline__ const char* bbase(const Unit& u) const { return (const char*)(B + ((size_t)(u.pn >> 4) * 4096 + (u.pn & 15)) * 1024); }
    __device__ __forceinline__ void avoff(const Unit&, const int (&RA)[2], const int (&CA)[2], unsigned (&v)[2][2]) const {
#pragma unroll
        for (int h = 0; h < 2; ++h)
#pragma unroll
            for (int i = 0; i < 2; ++i) v[h][i] = (unsigned)((h * 128 + RA[i]) * lda + CA[i]) * 2u;
    }
};
struct ProbMoeUp {
    static constexpr bool GATHER = true;
    const bf16_t* A; const bf16_t* B; const int* idx; int K, lda, ldb;
    __device__ __forceinline__ const char* abase(const Unit&) const { return (const char*)A; }
    __device__ __forceinline__ const char* bbase(const Unit& u) const { return (const char*)(B + ((size_t)(u.pm >> 4) * 3072 + (size_t)u.pn * 256) * ldb); }
    __device__ __forceinline__ void avoff(const Unit& u, const int (&RA)[2], const int (&CA)[2], unsigned (&v)[2][2]) const {
#pragma unroll
        for (int h = 0; h < 2; ++h)
#pragma unroll
            for (int i = 0; i < 2; ++i) { const int g = idx[u.pm * 256 + h * 128 + RA[i]]; v[h][i] = (unsigned)(g * lda + CA[i]) * 2u; }
    }
};
struct ProbMoeDown {
    static constexpr bool GATHER = false;
    const bf16_t* A; const bf16_t* B; int K, lda, ldb;
    __device__ __forceinline__ const char* abase(const Unit& u) const { return (const char*)(A + (size_t)u.pm * 256 * lda); }
    __device__ __forceinline__ const char* bbase(const Unit& u) const { return (const char*)(B + ((size_t)(u.pm >> 4) * 1024 + (size_t)u.pn * 256) * ldb); }
    __device__ __forceinline__ void avoff(const Unit&, const int (&RA)[2], const int (&CA)[2], unsigned (&v)[2][2]) const {
#pragma unroll
        for (int h = 0; h < 2; ++h)
#pragma unroll
            for (int i = 0; i < 2; ++i) v[h][i] = (unsigned)((h * 128 + RA[i]) * lda + CA[i]) * 2u;
    }
};

#define EPI_ROWS(...) _Pragma("unroll") for (int ai = 0; ai < 2; ++ai) _Pragma("unroll") for (int m = 0; m < 4; ++m) { const int row = u.pm * 256 + ai * 128 + wr * 64 + m * 16 + fr; __VA_ARGS__ }
__device__ __forceinline__ u32x4 pack8(const f32x4 v0, const f32x4 v1) { u32x4 w; w.x = cvt_pk_bf16(v0[0], v0[1]); w.y = cvt_pk_bf16(v0[2], v0[3]); w.z = cvt_pk_bf16(v1[0], v1[1]); w.w = cvt_pk_bf16(v1[2], v1[3]); return w; }

struct EpiPQ {
    static constexpr bool PERM = true; bf16_t* O;
    __device__ __forceinline__ void operator()(const f32x4 (&acc)[2][2][4][2], const Unit& u, int wr, int wc, int fr, int fq) const {
        const int t10 = wc * 32 + 8 * fq, b = u.pn >> 4, t2 = u.pn & 15;
        EPI_ROWS(
            bf16_t* rp = O + ((size_t)((b * 256 + (row >> 1)) * 16 + t2) * 512 + (row & 1) * 256 + t10);
            if (m == 0 && wr == 0 && fr == 1) {
                bf16_t* sp = O + ((size_t)(32768 + (b * 4 + (row >> 7)) * 16 + t2) * 512 + t10);
                _Pragma("unroll") for (int bj = 0; bj < 2; ++bj) { *(u32x4*)(sp + bj * 128) = pack8(acc[ai][bj][m][0], acc[ai][bj][m][1]); *(u32x4*)(sp + 256 + bj * 128) = (u32x4){0u, 0u, 0u, 0u}; *(u32x4*)(rp + bj * 128) = (u32x4){0u, 0u, 0u, 0u}; }
            } else {
                _Pragma("unroll") for (int bj = 0; bj < 2; ++bj) *(u32x4*)(rp + bj * 128) = pack8(acc[ai][bj][m][0], acc[ai][bj][m][1]);
            }
        )
    }
};
struct EpiPlain {
    static constexpr bool PERM = true; bf16_t* O; size_t ldc;
    __device__ __forceinline__ void operator()(const f32x4 (&acc)[2][2][4][2], const Unit& u, int wr, int wc, int fr, int fq) const {
        const int col0 = u.pn * 256 + wc * 32 + 8 * fq;
        EPI_ROWS(
            bf16_t* rp = O + (size_t)row * ldc + col0;
            _Pragma("unroll") for (int bj = 0; bj < 2; ++bj) *(u32x4*)(rp + bj * 128) = pack8(acc[ai][bj][m][0], acc[ai][bj][m][1]);
        )
    }
};
struct EpiZ {
    static constexpr bool PERM = true; bf16_t* O; int ldc; int fixed_act;
    __device__ __forceinline__ void operator()(const f32x4 (&acc)[2][2][4][2], const Unit& u, int wr, int wc, int fr, int fq) const {
        const int col0 = u.pn * 256 + wc * 32 + 8 * fq; const int act = fixed_act >= 0 ? fixed_act : (u.pn >> 2);
        if (act >= 2) {
            const int cg = (u.pn - 8) * 128 + wc * 32 + 8 * fq;
            EPI_ROWS(
                bf16_t* rp = O + (size_t)row * ldc + cg;
                f32x4 r0, r1, s0, s1;
                _Pragma("unroll") for (int j = 0; j < 4; ++j) {
                    const float ea0 = __builtin_amdgcn_exp2f(-1.4426950408889634f * acc[ai][0][m][0][j]), ea1 = __builtin_amdgcn_exp2f(-1.4426950408889634f * acc[ai][0][m][1][j]);
                    const float eb0 = fminf(__builtin_amdgcn_exp2f(-1.4426950408889634f * acc[ai][1][m][0][j]), 1e30f), eb1 = fminf(__builtin_amdgcn_exp2f(-1.4426950408889634f * acc[ai][1][m][1][j]), 1e30f);
                    s0[j] = __builtin_amdgcn_rcpf(1.0f + eb0); s1[j] = __builtin_amdgcn_rcpf(1.0f + eb1);
                    r0[j] = (1.0f + eb0) * __builtin_amdgcn_rcpf(1.0f + ea0); r1[j] = (1.0f + eb1) * __builtin_amdgcn_rcpf(1.0f + ea1); }
                *(u32x4*)(rp + 2048) = pack8(r0, r1); *(u32x4*)(rp + 3072) = pack8(s0, s1);
            )
            return;
        }
        EPI_ROWS(
            bf16_t* rp = O + (size_t)row * ldc + col0;
            _Pragma("unroll") for (int bj = 0; bj < 2; ++bj) {
                f32x4 v0 = acc[ai][bj][m][0], v1 = acc[ai][bj][m][1];
                if (act == 1) { _Pragma("unroll") for (int j = 0; j < 4; ++j) { v0[j] = gelu_tanh(v0[j]); v1[j] = gelu_tanh(v1[j]); } }
                *(u32x4*)(rp + bj * 128) = pack8(v0, v1); }
        )
    }
};
struct EpiMerge {
    static constexpr bool PERM = true; bf16_t* O; const bf16_t* Z;
    __device__ __forceinline__ void mid(f32x4 (&acc)[2][2][4][2], const Unit& u, int wr, int wc, int fr, int fq) const {
        unsigned eo = (unsigned)((u.pm * 256 + wr * 64 + fr) * 4096 + 2048 + u.pn * 256 + wc * 32 + 8 * fq);
        asm volatile("" : "+v"(eo));
#pragma unroll
        for (int ai = 0; ai < 2; ++ai) {
            u32x4 wa[4][2];
#pragma unroll
            for (int m = 0; m < 4; ++m)
#pragma unroll
                for (int bj = 0; bj < 2; ++bj) { const unsigned o = eo + (unsigned)((ai * 128 + m * 16) * 4096 + bj * 128); wa[m][bj] = __builtin_nontemporal_load((const u32x4*)(Z + o)); }
#pragma unroll
            for (int m = 0; m < 4; ++m)
#pragma unroll
                for (int bj = 0; bj < 2; ++bj) { float ga[8]; unpack8(wa[m][bj], ga);
#pragma unroll
                    for (int j = 0; j < 4; ++j) { acc[ai][bj][m][0][j] *= ga[j]; acc[ai][bj][m][1][j] *= ga[4 + j]; } }
            __builtin_amdgcn_sched_barrier(0); }
    }
    __device__ __forceinline__ void operator()(const f32x4 (&acc)[2][2][4][2], const Unit& u, int wr, int wc, int fr, int fq) const {
        unsigned eo = (unsigned)((u.pm * 256 + wr * 64 + fr) * 4096 + 3072 + u.pn * 256 + wc * 32 + 8 * fq); asm volatile("" : "+v"(eo));
        unsigned oo = (unsigned)((u.pm * 256 + wr * 64 + fr) * 1024 + u.pn * 256 + wc * 32 + 8 * fq); asm volatile("" : "+v"(oo));
        u32x4 wb[2][4][2];
#pragma unroll
        for (int ai = 0; ai < 2; ++ai)
#pragma unroll
            for (int m = 0; m < 4; ++m)
#pragma unroll
                for (int bj = 0; bj < 2; ++bj) wb[ai][m][bj] = __builtin_nontemporal_load((const u32x4*)(Z + eo + (unsigned)((ai * 128 + m * 16) * 4096 + bj * 128)));
#pragma unroll
        for (int ai = 0; ai < 2; ++ai)
#pragma unroll
            for (int m = 0; m < 4; ++m)
#pragma unroll
                for (int bj = 0; bj < 2; ++bj) { float g[8]; unpack8(wb[ai][m][bj], g);
                    f32x4 v0 = acc[ai][bj][m][0], v1 = acc[ai][bj][m][1];
#pragma unroll
                    for (int j = 0; j < 4; ++j) { v0[j] *= g[j]; v1[j] *= g[4 + j]; }
                    *(u32x4*)(O + oo + (unsigned)((ai * 128 + m * 16) * 1024 + bj * 128)) = pack8(v0, v1); }
    }
};
struct EpiOut {
    static constexpr bool PERM = true; bf16_t* O; const float* X; const float* pos; const float* ada;
    __device__ __forceinline__ void operator()(const f32x4 (&acc)[2][2][4][2], const Unit& u, int wr, int wc, int fr, int fq) const {
        const int col0 = u.pn * 256 + wc * 32 + 8 * fq; const int b = u.pm >> 4;
        unsigned ro = (unsigned)((u.pm * 256 + wr * 64 + fr) * 1024 + col0); asm volatile("" : "+v"(ro));
#pragma unroll
        for (int ai = 0; ai < 2; ++ai)
#pragma unroll
            for (int mh = 0; mh < 2; ++mh) {
                f32x4 xv[2][2][2];
#pragma unroll
                for (int m2 = 0; m2 < 2; ++m2)
#pragma unroll
                    for (int bj = 0; bj < 2; ++bj)
#pragma unroll
                        for (int n = 0; n < 2; ++n) xv[m2][bj][n] = __builtin_nontemporal_load((const f32x4*)(X + ro + (unsigned)((ai * 128 + (mh * 2 + m2) * 16) * 1024 + bj * 128 + n * 4)));
#pragma unroll
                for (int m2 = 0; m2 < 2; ++m2) { const int m = mh * 2 + m2; const int row = u.pm * 256 + ai * 128 + wr * 64 + m * 16 + fr; const int t = row & 4095;
#pragma unroll
                    for (int bj = 0; bj < 2; ++bj) { f32x4 o[2];
#pragma unroll
                        for (int n = 0; n < 2; ++n) { const int col = col0 + bj * 128 + n * 4;
                            const f32x4 pv = *(const f32x4*)(pos + (col < 512 ? (t >> 6) * 512 + col : (t & 63) * 512 + (col - 512)));
                            const f32x4 gv = *(const f32x4*)(ada + b * 6144 + 2048 + col);
                            o[n] = xv[m2][bj][n] + pv + gv * acc[ai][bj][m][n]; }
                        *(u32x4*)(O + ro + (unsigned)((ai * 128 + m * 16) * 1024 + bj * 128)) = pack8(o[0], o[1]); } }
                __builtin_amdgcn_sched_barrier(0); }
    }
};
struct EpiGU {
    static constexpr bool PERM = true; bf16_t* O;
    __device__ __forceinline__ void operator()(const f32x4 (&acc)[2][2][4][2], const Unit& u, int wr, int wc, int fr, int fq) const {
        const int col0 = u.pn * 128 + wc * 32 + 8 * fq;
        EPI_ROWS(
            f32x4 v0, v1;
            _Pragma("unroll") for (int j = 0; j < 4; ++j) { const float g0 = acc[ai][0][m][0][j], g1 = acc[ai][0][m][1][j];
                v0[j] = g0 * sigmoidf_(g0) * acc[ai][1][m][0][j]; v1[j] = g1 * sigmoidf_(g1) * acc[ai][1][m][1][j]; }
            *(u32x4*)(O + (size_t)row * DE + col0) = pack8(v0, v1);
        )
    }
};
struct EpiDown {
    static constexpr bool PERM = true; bf16_t* O; const float* gate;
    __device__ __forceinline__ void operator()(const f32x4 (&acc)[2][2][4][2], const Unit& u, int wr, int wc, int fr, int fq) const {
        const int col0 = u.pn * 256 + wc * 32 + 8 * fq;
        EPI_ROWS(
            const float g = gate[row];
            _Pragma("unroll") for (int bj = 0; bj < 2; ++bj) *(u32x4*)(O + (size_t)row * 1024 + col0 + bj * 128) = pack8(acc[ai][bj][m][0] * g, acc[ai][bj][m][1] * g);
        )
    }
};

__device__ __forceinline__ void p0_ada(const Params& p, LAS unsigned char* lds, int item) {
    const int tid = threadIdx.x, lane = tid & 63, wv = tid >> 6;
    LAS float* s = (LAS float*)lds; LAS float* red = s + 9 * 1024;
    { float cv[18];
#pragma unroll
      for (int k = 0; k < 18; ++k) { const int i = tid + NTHR * k, r = i >> 10, d = i & 1023; cv[k] = r < 8 ? p.c[r * 1024 + d] : p.c_ctx[d]; }
#pragma unroll
      for (int k = 0; k < 18; ++k) s[tid + NTHR * k] = cv[k] * __builtin_amdgcn_rcpf(1.0f + __expf(-cv[k])); }
    __syncthreads();
    const int col = lane % 24, dh = lane / 24;
    const int dsl = wv * 128 + dh * 64;
    float a[9];
#pragma unroll
    for (int r = 0; r < 9; ++r) a[r] = 0.f;
    if (dh < 2) {
        const float* w = p.w_ada + (size_t)dsl * 6144 + item * 24 + col;
        for (int d0 = 0; d0 < 64; d0 += 32) { float wv2[32];
#pragma unroll
            for (int j = 0; j < 32; ++j) wv2[j] = __builtin_nontemporal_load(w + (size_t)(d0 + j) * 6144);
#pragma unroll
            for (int j = 0; j < 32; ++j)
#pragma unroll
                for (int r = 0; r < 9; ++r) a[r] += s[r * 1024 + dsl + d0 + j] * wv2[j]; }
#pragma unroll
        for (int r = 0; r < 9; ++r) red[((wv * 2 + dh) * 9 + r) * 24 + col] = a[r];
    }
    __syncthreads();
    float* ada = (float*)(p.ws + WS_ADA);
    if (tid < 9 * 24) { const int r = tid / 24, cc = tid % 24; float v = 0.f;
#pragma unroll
        for (int k = 0; k < 16; ++k) v += red[(k * 9 + r) * 24 + cc];
        __hip_atomic_store(ada + r * 6144 + item * 24 + cc, v + p.b_ada[item * 24 + cc], __ATOMIC_RELAXED, __HIP_MEMORY_SCOPE_AGENT); }
    asm volatile("s_waitcnt vmcnt(0)" ::: "memory");
    __syncthreads();
    if (tid == 0) (void)__hip_atomic_fetch_add((unsigned*)(p.ws + WS_BAR + 46 * KiB), 1u, __ATOMIC_RELAXED, __HIP_MEMORY_SCOPE_AGENT);
}
template <int NS>
__device__ __forceinline__ void xpose_item(const float* src, int ldsrc, bf16_t* dst, int lddst, int k0, int n0, int mode, float scale = 1.0f) {
    const int tid = threadIdx.x, k8 = tid & 7, nq = tid >> 3;
    if (nq >= 16 * NS) return;
    f32x4 v[8];
#pragma unroll
    for (int j = 0; j < 8; ++j) v[j] = __builtin_nontemporal_load((const f32x4*)(src + (size_t)(k0 + 8 * k8 + j) * ldsrc + n0 + 4 * nq));
#pragma unroll
    for (int c = 0; c < 4; ++c) { const int n = n0 + 4 * nq + c; int row = n;
        if (mode) row = (n >> 7) * 256 + (n & 127) + (mode == 2 ? 128 : 0);
        u32x4 w; w.x = cvt_pk_bf16(v[0][c] * scale, v[1][c] * scale); w.y = cvt_pk_bf16(v[2][c] * scale, v[3][c] * scale); w.z = cvt_pk_bf16(v[4][c] * scale, v[5][c] * scale); w.w = cvt_pk_bf16(v[6][c] * scale, v[7][c] * scale);
        *(u32x4*)(dst + (size_t)row * lddst + k0 + 8 * k8) = w; }
}
__device__ __forceinline__ void p0_wpq(const Params& p, LAS unsigned char* lds, int item) {
    const int tid = threadIdx.x, g = item >> 5, db = item & 31;
    LAS float* wl = (LAS float*)lds; LAS float* ct = wl + 32 * 129;
    for (int i = tid; i < 32 * 128; i += NTHR) { const int d = i >> 7, cc = i & 127; wl[d * 129 + cc] = p.w_in[(size_t)(db * 32 + d) * 4608 + g * 128 + cc]; }
    if (tid < 128) { float sn, cs; sincospif((float)tid * (1.0f / 64.0f), &sn, &cs); ct[tid] = cs; ct[128 + tid] = sn; }
    __syncthreads();
    const int q = tid & 127, kc = q >> 1, pq = q & 1, dh = tid >> 7; const int n = (g * 64 + kc) * 2 + pq;
    const bool spec = (kc == 0 && pq == 1); const int kce = spec ? 64 : kc, tsel = spec ? 0 : pq * 128;
    bf16_t* dst = (bf16_t*)(p.ws + WS_WPQ) + (size_t)n * 1024 + db * 32 + dh * 8;
    const float scale = 0.001381067932f;
    float a[8];
#pragma unroll
    for (int j = 0; j < 8; ++j) a[j] = 0.f;
    for (int cc = 0; cc < 128; ++cc) { const float tv = ct[tsel + ((cc * kce) & 127)];
#pragma unroll
        for (int j = 0; j < 8; ++j) a[j] += wl[(dh * 8 + j) * 129 + cc] * tv; }
    u32x4 w; w.x = cvt_pk_bf16(a[0] * scale, a[1] * scale); w.y = cvt_pk_bf16(a[2] * scale, a[3] * scale); w.z = cvt_pk_bf16(a[4] * scale, a[5] * scale); w.w = cvt_pk_bf16(a[6] * scale, a[7] * scale);
    *(u32x4*)dst = w;
    __syncthreads();
}
__device__ __forceinline__ void p0_d1t(const Params& p, int item) {
    bf16_t* dst = (bf16_t*)(p.ws + WS_D1T);
    const int row = item * 64 + (threadIdx.x >> 3), k1 = row >> 1, ri = row & 1, c0 = (threadIdx.x & 7) * 64;
    for (int c8 = 0; c8 < 64; c8 += 8) { float v[8];
#pragma unroll
        for (int j = 0; j < 8; ++j) { const int col = c0 + c8 + j, pq = col >> 8, t1 = col & 255; float sn, cs; sincospif((float)((k1 * t1) & 255) * (1.0f / 128.0f), &sn, &cs);
            v[j] = (ri == 0) ? (pq == 0 ? cs : -sn) : (pq == 0 ? -sn : -cs); }
        u32x4 w; w.x = cvt_pk_bf16(v[0], v[1]); w.y = cvt_pk_bf16(v[2], v[3]); w.z = cvt_pk_bf16(v[4], v[5]); w.w = cvt_pk_bf16(v[6], v[7]);
        *(u32x4*)(dst + (size_t)row * 512 + c0 + c8) = w; }
}
__device__ __forceinline__ void p0_d2t(const Params& p, int item) {
    bf16_t* dst = (bf16_t*)(p.ws + WS_D2T);
#pragma unroll
    for (int ps = 0; ps < 4; ++ps) { const int pc = (item * 4 + ps) * NTHR + threadIdx.x, tp = pc >> 2, kk0 = (pc & 3) * 8; float v[8];
#pragma unroll
        for (int j = 0; j < 8; ++j) { const int kk = kk0 + j, ri = kk >> 4, t2 = kk & 15; float sn, cs; sincospif((float)((tp * t2) & 4095) * (1.0f / 2048.0f), &sn, &cs); v[j] = ri ? sn : cs; }
        u32x4 w; w.x = cvt_pk_bf16(v[0], v[1]); w.y = cvt_pk_bf16(v[2], v[3]); w.z = cvt_pk_bf16(v[4], v[5]); w.w = cvt_pk_bf16(v[6], v[7]);
        *(u32x4*)(dst + (size_t)tp * 32 + kk0) = w; }
}
__device__ __forceinline__ void p0_pos(const Params& p, int item) {
    float* tab = (float*)(p.ws + WS_POS);
    for (int i = item * 2048 + threadIdx.x; i < (item + 1) * 2048; i += NTHR) { const int ii = i >> 9, j = i & 511, jj = j & 255; const float f = expf(-9.210340371976184f * (float)jj / 256.0f); const float a = (float)ii * f;
        __hip_atomic_store(tab + i, j < 256 ? sinf(a) : cosf(a), __ATOMIC_RELAXED, __HIP_MEMORY_SCOPE_AGENT); }
    asm volatile("s_waitcnt vmcnt(0)" ::: "memory");
    __syncthreads();
    if (threadIdx.x == 0) (void)__hip_atomic_fetch_add((unsigned*)(p.ws + WS_BAR + 46 * KiB), 1u, __ATOMIC_RELAXED, __HIP_MEMORY_SCOPE_AGENT);
}
__device__ __forceinline__ void phase0(const Params& p, LAS unsigned char* lds) {
    constexpr int N_ADA = 256, N_WIN = 16 * 16, N_WFOUR = 8 * 4, N_SQ = 16 * 4, N_LRU = 16 * 2, N_WPQ = 128, N_DFT = 8 + 8, N_POS = 16;
    constexpr int O1 = N_ADA, O2 = O1 + N_WIN, O3 = O2 + N_WFOUR, O4 = O3 + N_SQ, O5 = O4 + N_SQ, O6 = O5 + N_LRU, O7 = O6 + N_LRU, O8 = O7 + N_WPQ, O9 = O8 + N_DFT, O10 = O9 + N_POS;
    for (int it0 = blockIdx.x; it0 < O10; it0 += gridDim.x) {
        if (it0 < O1) { p0_ada(p, lds, it0); continue; }
        if (it0 < O1 + N_POS) { p0_pos(p, it0 - O1); continue; }
        const int it = it0 - N_POS;
        if (it < O2) { const int j = it - O1, ct = j & 15;
            if (ct < 8) xpose_item<4>(p.w_in + 512, 4608, (bf16_t*)(p.ws + WS_WIN), 1024, (j >> 4) * 64, ct * 256, 0);
            else if (ct < 12) xpose_item<4>(p.w_in + 512 + 2048, 4608, (bf16_t*)(p.ws + WS_WIN) + (size_t)2048 * 1024, 1024, (j >> 4) * 64, (ct - 8) * 256, 1);
            else xpose_item<4>(p.w_in + 512 + 3072, 4608, (bf16_t*)(p.ws + WS_WIN) + (size_t)2048 * 1024, 1024, (j >> 4) * 64, (ct - 12) * 256, 2); }
        else if (it < O3) { const int j = it - O2; xpose_item<4>(p.w_four, 1024, (bf16_t*)(p.ws + WS_WFOUR), 512, (j >> 2) * 64, (j & 3) * 256, 0); }
        else if (it < O4) { const int j = it - O3; xpose_item<4>(p.w_lru, 1024, (bf16_t*)(p.ws + WS_WLRU), 1024, (j >> 2) * 64, (j & 3) * 256, 0); }
        else if (it < O5) { const int j = it - O4; xpose_item<4>(p.w_out, 1024, (bf16_t*)(p.ws + WS_WOUT), 1024, (j >> 2) * 64, (j & 3) * 256, 0); }
        else if (it < O6) { const int j = it - O5, mtx = j >> 1; xpose_item<2>(p.lru_wa + (size_t)mtx * 16384, 128, (bf16_t*)(p.ws + WS_WAT) + (size_t)mtx * 16384, 128, (j & 1) * 64, 0, 0, NLOG2E); }
        else if (it < O7) { const int j = it - O6, mtx = j >> 1; xpose_item<2>(p.lru_wi + (size_t)mtx * 16384, 128, (bf16_t*)(p.ws + WS_WIT) + (size_t)mtx * 16384, 128, (j & 1) * 64, 0, 0, NLOG2E); }
        else if (it < O8) p0_wpq(p, lds, it - O7);
        else { if (it - O8 < 8) p0_d1t(p, it - O8); else p0_d2t(p, it - O8 - 8); }
    }
}

__device__ __forceinline__ void phase1(const Params& p) {
    const int tid = tid_opaque(), lane = tid & 63, wid = tid >> 6;
    const float* ada = (const float*)(p.ws + WS_ADA); const float* tab = (const float*)(p.ws + WS_POS);
    bf16_t* h1 = (bf16_t*)(p.ws + WS_R1); bf16_t* hc = (bf16_t*)(p.ws + WS_HCTX);
    constexpr int NR = MLAT + MCTX, RW = 4;
    for (int row0 = (blockIdx.x * 8 + wid) * RW; row0 < NR; row0 += gridDim.x * 8 * RW) {
        const bool lat = row0 < MLAT; const int mrow = lat ? (row0 >> 12) : 8;
        f32x4 v[RW][4]; float ss[RW];
#pragma unroll
        for (int r = 0; r < RW; ++r) { const int row = row0 + r; const float* xr = lat ? p.x + (size_t)row * 1024 : p.ctx + (size_t)(row - MLAT) * 1024;
#pragma unroll
            for (int i = 0; i < 4; ++i) v[r][i] = __builtin_nontemporal_load((const f32x4*)(xr + 256 * i + 4 * lane)); }
#pragma unroll
        for (int r = 0; r < RW; ++r) { const int t = (row0 + r) & 4095; float a = 0.f;
#pragma unroll
            for (int i = 0; i < 4; ++i) { const int d = 256 * i + 4 * lane;
                if (lat) v[r][i] += *(const f32x4*)(tab + (i < 2 ? (t >> 6) * 512 + d : (t & 63) * 512 + d - 512));
                a += v[r][i][0] * v[r][i][0] + v[r][i][1] * v[r][i][1] + v[r][i][2] * v[r][i][2] + v[r][i][3] * v[r][i][3]; }
            ss[r] = a; }
#pragma unroll
        for (int o = 32; o >= 1; o >>= 1) {
#pragma unroll
            for (int r = 0; r < RW; ++r) ss[r] += __shfl_xor(ss[r], o); }
#pragma unroll
        for (int i = 0; i < 4; ++i) { const int d = 256 * i + 4 * lane;
            const f32x4 g = *(const f32x4*)(p.norm1_g + d), sh = *(const f32x4*)(ada + mrow * 6144 + d), sc = *(const f32x4*)(ada + mrow * 6144 + 1024 + d);
#pragma unroll
            for (int r = 0; r < RW; ++r) { const int row = row0 + r; const float rs = rsqrtf(ss[r] * (1.0f / 1024.0f) + 1e-6f);
                bf16_t* dst = lat ? h1 + (size_t)row * 1024 : hc + (size_t)(row - MLAT) * 1024;
                const f32x4 h = v[r][i] * rs * g * (sc + 1.0f) + sh;
                u32x2 w; w.x = cvt_pk_bf16(h[0], h[1]); w.y = cvt_pk_bf16(h[2], h[3]); *(u32x2*)(dst + d) = w; } }
    }
}

#define LRU_CST(mb, r) (32 * (mb) + 8 * ((r) >> 2) + ((r) & 3))
template <bool FINAL, int DIR>
__device__ __forceinline__ void lru_wave(const Params& p, LAS unsigned char* ul, int b, int sc, int head, int cb, int lane, f32x16 (&accI)[4]) {
    constexpr int SG = DIR ? -1 : 1;
    const int lr = lane & 31, lh = lane >> 5;
    const int chl = cb * 32 + lr, ch = head * 128 + chl;
    const int tbase = DIR ? 127 - 4 * lh : 4 * lh;
    f32x16 accA[4];
#pragma unroll
    for (int mb = 0; mb < 4; ++mb)
#pragma unroll
        for (int r = 0; r < 16; ++r) { accA[mb][r] = 0.f; accI[mb][r] = 0.f; }
    {
        const bf16_t* wa = (const bf16_t*)(p.ws + WS_WAT) + ((size_t)(DIR * 8 + head) * 128 + chl) * 128 + 8 * lh;
        const bf16_t* wi = (const bf16_t*)(p.ws + WS_WIT) + ((size_t)(DIR * 8 + head) * 128 + chl) * 128 + 8 * lh;
        LAS unsigned char* arow0 = ul + (DIR ? 127 - lr : lr) * 272 + lh * 16;
#pragma unroll
        for (int kc = 0; kc < 2; ++kc) { bf16x8 bA[4], bI[4];
#pragma unroll
            for (int k4 = 0; k4 < 4; ++k4) { bA[k4] = *(const bf16x8*)(wa + 16 * (kc * 4 + k4)); bI[k4] = *(const bf16x8*)(wi + 16 * (kc * 4 + k4)); }
#pragma unroll
            for (int mb = 0; mb < 4; ++mb)
#pragma unroll
                for (int k4 = 0; k4 < 4; ++k4) { const bf16x8 af = *(const LAS bf16x8*)(arow0 + SG * 32 * mb * 272 + 32 * (kc * 4 + k4));
                    accA[mb] = __builtin_amdgcn_mfma_f32_32x32x16_bf16(af, bA[k4], accA[mb], 0, 0, 0);
                    accI[mb] = __builtin_amdgcn_mfma_f32_32x32x16_bf16(af, bI[k4], accI[mb], 0, 0, 0); }
            __builtin_amdgcn_sched_barrier(0); }
    }
    {
        const float lam = p.lru_lambda[DIR * 1024 + ch]; const float sp8 = 8.0f * log1pf(expf(-lam));
        const float ba = p.lru_ba[DIR * 1024 + ch], bi = p.lru_bi[DIR * 1024 + ch];
        LAS unsigned char* up = ul + tbase * 272 + chl * 2;
#pragma unroll
        for (int mb = 0; mb < 4; ++mb) {
#pragma unroll
            for (int r = 0; r < 16; ++r) {
                const float uv = bf2f(*(const LAS bf16_t*)(up + SG * LRU_CST(mb, r) * 272));
                const float rg = __builtin_amdgcn_rcpf(1.0f + __builtin_amdgcn_exp2f(accA[mb][r] + NLOG2E * ba)), ig = __builtin_amdgcn_rcpf(1.0f + __builtin_amdgcn_exp2f(accI[mb][r] + NLOG2E * bi));
                const float a = __expf(-sp8 * rg); accA[mb][r] = a; accI[mb][r] = __builtin_amdgcn_sqrtf(fmaxf(1.0f - a * a, 0.f)) * ig * uv; }
            __builtin_amdgcn_sched_barrier(0); }
    }
    float rA[16], rH[16];
#pragma unroll
    for (int mb = 0; mb < 4; ++mb)
#pragma unroll
        for (int q = 0; q < 4; ++q) { float pa = 1.f, hh = 0.f;
#pragma unroll
            for (int j = 0; j < 4; ++j) { const int r = 4 * q + j; const float a = accA[mb][r], bb = accI[mb][r]; hh = a * hh + bb; pa *= a; accA[mb][r] = pa; accI[mb][r] = hh; }
            rA[mb * 4 + q] = pa; rH[mb * 4 + q] = hh; }
    const int agg_dir_off = ((b * NSEQ) * 2 + DIR) * 1024 + ch;
    const float* agg = (const float*)(p.ws + WS_AGG);
    float carry = 0.f;
    if (FINAL) {
        if (DIR == 0) { for (int q = 0; q < sc; ++q) { const float* a2 = agg + (size_t)(agg_dir_off + q * 2048) * 2; carry = a2[0] * carry + a2[1]; } }
        else { { const float* a2 = agg + (size_t)(agg_dir_off + 1 * 2048) * 2; carry = a2[0] * carry + a2[1]; } { const float* a2 = agg + (size_t)(agg_dir_off + 0 * 2048) * 2; carry = a2[0] * carry + a2[1]; }
            for (int q = NSEQ - 1; q > sc; --q) { const float* a2 = agg + (size_t)(agg_dir_off + q * 2048) * 2; carry = a2[0] * carry + a2[1]; } }
    }
    float cin[16];
#pragma unroll
    for (int i = 0; i < 16; ++i) cin[i] = 0.f;
    float s = carry, At = 1.f;
#pragma unroll
    for (int i = 0; i < 16; ++i) { const float oA = __shfl_xor(rA[i], 32), oH = __shfl_xor(rH[i], 32);
        { const bool mine = (lh == 0); const float a = mine ? rA[i] : oA, hh = mine ? rH[i] : oH; cin[i] = mine ? s : cin[i]; s = a * s + hh; At *= a; }
        { const bool mine = (lh == 1); const float a = mine ? rA[i] : oA, hh = mine ? rH[i] : oH; cin[i] = mine ? s : cin[i]; s = a * s + hh; At *= a; } }
    if (!FINAL) {
        if (lh == 0) { float* o = (float*)(p.ws + WS_AGG) + (size_t)(agg_dir_off + sc * 2048) * 2; o[0] = At; o[1] = s; }
        return;
    }
#pragma unroll
    for (int mb = 0; mb < 4; ++mb)
#pragma unroll
        for (int r = 0; r < 16; ++r) accI[mb][r] += accA[mb][r] * cin[mb * 4 + (r >> 2)];
}
template <bool FINAL>
__device__ __forceinline__ void lru_tile(const Params& p, LAS unsigned char* lds, int item) {
    const int tid = threadIdx.x, lane = tid & 63, wid = __builtin_amdgcn_readfirstlane(tid >> 6);
    int b, sc, head;
    if (FINAL) { head = item & 7; sc = 2 + ((item >> 3) & 31); b = item >> 8; }
    else { head = item & 7; const int r = item >> 3; sc = r & 1; b = r >> 1; }
    const bf16_t* src; int Tseq, t0, ld;
    if (sc < 2) { src = (const bf16_t*)(p.ws + WS_ZXC) + (size_t)b * 256 * 1024; Tseq = 256; t0 = sc * 128; ld = 1024; }
    else { src = (const bf16_t*)(p.ws + WS_RZ) + (size_t)b * 4096 * 4096; Tseq = 4096; t0 = (sc - 2) * 128; ld = 4096; }
    LAS unsigned char* ul = lds;
    LAS float* ybuf = (LAS float*)(lds + 36 * 1024);
    {
        const int c8 = tid & 15, tb = tid >> 4; const int ch0 = head * 128 + 8 * c8;
        float w[4][8], bias[8];
#pragma unroll
        for (int k = 0; k < 4; ++k) { const f32x4 a = *(const f32x4*)(p.conv_w + k * 1024 + ch0), c2 = *(const f32x4*)(p.conv_w + k * 1024 + ch0 + 4);
#pragma unroll
            for (int j = 0; j < 4; ++j) { w[k][j] = a[j]; w[k][4 + j] = c2[j]; } }
        { const f32x4 a = *(const f32x4*)(p.conv_b + ch0), c2 = *(const f32x4*)(p.conv_b + ch0 + 4);
#pragma unroll
            for (int j = 0; j < 4; ++j) { bias[j] = a[j]; bias[4 + j] = c2[j]; } }
#pragma unroll
        for (int i = 0; i < 4; ++i) { const int t = tb + 32 * i; float a[8];
#pragma unroll
            for (int j = 0; j < 8; ++j) a[j] = bias[j];
#pragma unroll
            for (int k = 0; k < 4; ++k) { const int tt = t0 + t + k - 2;
                if (tt >= 0 && tt < Tseq) { float f[8]; unpack8(*(const u32x4*)(src + (size_t)tt * ld + ch0), f);
#pragma unroll
                    for (int j = 0; j < 8; ++j) a[j] += w[k][j] * f[j]; } }
            u32x4 wv; wv.x = cvt_pk_bf16(a[0], a[1]); wv.y = cvt_pk_bf16(a[2], a[3]); wv.z = cvt_pk_bf16(a[4], a[5]); wv.w = cvt_pk_bf16(a[6], a[7]);
            *(LAS u32x4*)(ul + t * 272 + c8 * 16) = wv; }
    }
    __syncthreads();
    f32x16 hacc[4];
    if (wid < 4) lru_wave<FINAL, 0>(p, ul, b, sc, head, wid & 3, lane, hacc);
    else lru_wave<FINAL, 1>(p, ul, b, sc, head, wid & 3, lane, hacc);
    if (FINAL) {
        const int lr = lane & 31, lh = lane >> 5, chl = (wid & 3) * 32 + lr;
        if (wid >= 4) { LAS float* yp = ybuf + (127 - 4 * lh) * 129 + chl;
#pragma unroll
            for (int mb = 0; mb < 4; ++mb)
#pragma unroll
                for (int r = 0; r < 16; ++r) yp[-LRU_CST(mb, r) * 129] = hacc[mb][r]; }
        __syncthreads();
        if (wid < 4) {
            const LAS float* yp = ybuf + (4 * lh) * 129 + chl;
            const bf16_t* Zu = (const bf16_t*)(p.ws + WS_RZ) + ((size_t)(b * 4096 + t0) * 4096 + 1024 + head * 128);
            bf16_t* Ou = (bf16_t*)(p.ws + WS_R1) + ((size_t)(b * 4096 + t0) * 1024 + head * 128);
            const unsigned zo = (unsigned)(4 * lh * 4096 + chl), oo = (unsigned)(4 * lh * 1024 + chl);
#pragma unroll
            for (int mb = 0; mb < 4; ++mb) {
#pragma unroll
                for (int r = 0; r < 16; ++r) {
                    const float y = hacc[mb][r] + yp[LRU_CST(mb, r) * 129];
                    const float gz = bf2f(Zu[zo + LRU_CST(mb, r) * 4096]);
                    Ou[oo + LRU_CST(mb, r) * 1024] = (bf16_t)(cvt_pk_bf16(gz * y, 0.f) & 0xffffu);
                    if ((r & 7) == 7) __builtin_amdgcn_sched_barrier(0); } }
        }
    }
    __syncthreads();
}

#ifndef LRU_PF_FRAG
#define LRU_PF_FRAG true
#endif
#ifndef LRU_PF_TILE
#define LRU_PF_TILE true
#endif
template <int DIR, bool PREF>
__device__ __forceinline__ void lru2_dir(const Params& p, LAS unsigned char* ul, int head, int w, int lane, const bf16x8 (&bA)[4], const bf16x8 (&bI)[4], bf16x8 (&nA)[4], bf16x8 (&nI)[4],
                                         f32x4 (&hl)[8], f32x4 (&pp)[8], float& Atot, float& Htot) {
    constexpr int SG = DIR ? -1 : 1;
    const int fr = lane & 15, fq = lane >> 4, chl = 16 * w + fr, ch = head * 128 + chl;
    f32x4 accA[8], accI[8];
    { const float ba2 = NLOG2E * p.lru_ba[DIR * 1024 + ch], bi2 = NLOG2E * p.lru_bi[DIR * 1024 + ch];
#pragma unroll
      for (int rb = 0; rb < 8; ++rb) { accA[rb] = (f32x4){ba2, ba2, ba2, ba2}; accI[rb] = (f32x4){bi2, bi2, bi2, bi2}; } }
    {
        LAS unsigned char* arow0 = ul + (DIR ? 127 - fr : fr) * 272 + fq * 16;
#pragma unroll
        for (int rb = 0; rb < 8; ++rb)
#pragma unroll
            for (int ks = 0; ks < 4; ++ks) { const bf16x8 af = *(const LAS bf16x8*)(arow0 + SG * 16 * rb * 272 + 64 * ks);
                accA[rb] = __builtin_amdgcn_mfma_f32_16x16x32_bf16(af, bA[ks], accA[rb], 0, 0, 0);
                accI[rb] = __builtin_amdgcn_mfma_f32_16x16x32_bf16(af, bI[ks], accI[rb], 0, 0, 0); }
    }
    if (PREF) {
        const bf16_t* wa = (const bf16_t*)(p.ws + WS_WAT) + ((size_t)((1 - DIR) * 8 + head) * 128 + chl) * 128 + 8 * fq;
        const bf16_t* wi = (const bf16_t*)(p.ws + WS_WIT) + ((size_t)((1 - DIR) * 8 + head) * 128 + chl) * 128 + 8 * fq;
#pragma unroll
        for (int ks = 0; ks < 4; ++ks) { nA[ks] = *(const bf16x8*)(wa + 32 * ks); nI[ks] = *(const bf16x8*)(wi + 32 * ks); }
    }
    {
        typedef float f32x2 __attribute__((ext_vector_type(2)));
        const float lam = p.lru_lambda[DIR * 1024 + ch]; const float k2 = NLOG2E * 8.0f * log1pf(expf(-lam));
        LAS unsigned char* up = ul + (DIR ? 127 - 4 * fq : 4 * fq) * 272 + chl * 2;
#pragma unroll
        for (int rb = 0; rb < 8; ++rb)
#pragma unroll
            for (int r = 0; r < 4; r += 2) {
                f32x2 uv; uv.x = bf2f(*(const LAS bf16_t*)(up + SG * (16 * rb + r) * 272)); uv.y = bf2f(*(const LAS bf16_t*)(up + SG * (16 * rb + r + 1) * 272));
                f32x2 ea, ei; ea.x = __builtin_amdgcn_exp2f(accA[rb][r]); ea.y = __builtin_amdgcn_exp2f(accA[rb][r + 1]); ei.x = __builtin_amdgcn_exp2f(accI[rb][r]); ei.y = __builtin_amdgcn_exp2f(accI[rb][r + 1]);
                const f32x2 da = ea + 1.0f, di = ei + 1.0f;
                f32x2 rg, ig; rg.x = __builtin_amdgcn_rcpf(da.x); rg.y = __builtin_amdgcn_rcpf(da.y); ig.x = __builtin_amdgcn_rcpf(di.x); ig.y = __builtin_amdgcn_rcpf(di.y);
                const f32x2 ka = rg * k2;
                f32x2 a; a.x = __builtin_amdgcn_exp2f(ka.x); a.y = __builtin_amdgcn_exp2f(ka.y);
                const f32x2 om = 1.0f - a * a;
                f32x2 sq; sq.x = __builtin_amdgcn_sqrtf(om.x); sq.y = __builtin_amdgcn_sqrtf(om.y);
                const f32x2 bb = sq * ig * uv;
                accA[rb][r] = a.x; accA[rb][r + 1] = a.y; accI[rb][r] = bb.x; accI[rb][r + 1] = bb.y; }
    }
    float rA[8], rH[8];
#pragma unroll
    for (int rb = 0; rb < 8; ++rb) { float pa = 1.f, hh = 0.f;
#pragma unroll
        for (int r = 0; r < 4; ++r) { const float a = accA[rb][r], bb = accI[rb][r]; hh = a * hh + bb; pa *= a; accA[rb][r] = pa; accI[rb][r] = hh; }
        rA[rb] = pa; rH[rb] = hh; }
    float Pc = 1.f, s = 0.f;
#pragma unroll
    for (int rb = 0; rb < 8; ++rb) { float Pin = 1.f, Hin = 0.f;
#pragma unroll
        for (int q = 0; q < 4; ++q) { const float a = __shfl(rA[rb], fr + 16 * q), hh = __shfl(rH[rb], fr + 16 * q);
            if (q == fq) { Pin = Pc; Hin = s; }
            s = a * s + hh; Pc *= a; }
#pragma unroll
        for (int r = 0; r < 4; ++r) { hl[rb][r] = accI[rb][r] + accA[rb][r] * Hin; pp[rb][r] = accA[rb][r] * Pin; }
        __builtin_amdgcn_sched_barrier(0); }
    Atot = Pc; Htot = s;
}
__device__ __forceinline__ u64_t agg_ld(const u64_t* a) { return __hip_atomic_load(a, __ATOMIC_RELAXED, __HIP_MEMORY_SCOPE_AGENT); }
template <int DIR>
__device__ __forceinline__ float lru2_carry(const u64_t* aggc, int n, int fr, int fq) {
    float Ap = 1.f, Hp = 0.f; u64_t v[9];
#pragma unroll
    for (int k = 0; k < 9; ++k) { const int j = fq * 9 + k; const int seq = DIR ? (j == 0 ? 1 : (j == 1 ? 0 : 35 - j)) : j;
        v[k] = (j < n) ? agg_ld(aggc + (size_t)seq * 2048) : 0x000000003f800000ull; }
#pragma unroll
    for (int k = 0; k < 9; ++k) { const float a = __uint_as_float((unsigned)v[k]), hh = __uint_as_float((unsigned)(v[k] >> 32)); Hp = a * Hp + hh; Ap *= a; }
    float s = 0.f;
#pragma unroll
    for (int q = 0; q < 4; ++q) { const float a = __shfl(Ap, fr + 16 * q), hh = __shfl(Hp, fr + 16 * q); s = a * s + hh; }
    return s;
}
__device__ __forceinline__ void lru2_block(const Params& p, LAS unsigned char* lds, int slot, int c, int ngr) {
    const int tid = threadIdx.x, lane = tid & 63, wid = __builtin_amdgcn_readfirstlane(tid >> 6);
    const int sc = c + 2, t0 = c * 128;
    LAS unsigned char* raw = lds;
    LAS unsigned char* ul = lds + 33792;
    LAS unsigned char* gzl = lds + 68608;
    LAS unsigned char* outl = lds + 103424;
    const int fr = lane & 15, fq = lane >> 4, chl = 16 * wid + fr;
    u32x4 nr[5], ng[4];
#define LRU2_LOAD_R(gg) do { const bf16_t* Zb_ = (const bf16_t*)(p.ws + WS_RZ) + (size_t)((gg) >> 3) * 4096 * 4096 + ((gg) & 7) * 128; \
        _Pragma("unroll") for (int k = 0; k < 5; ++k) { const int pc = tid + NTHR * k; nr[k] = (u32x4){0u, 0u, 0u, 0u}; \
            if (pc < 131 * 16) { const int row = pc >> 4, c8 = pc & 15, tt = t0 - 2 + row; if (tt >= 0 && tt < TT) nr[k] = __builtin_nontemporal_load((const u32x4*)(Zb_ + (size_t)tt * 4096 + c8 * 8)); } } } while (0)
#define LRU2_LOAD_G(gg) do { const bf16_t* Zb_ = (const bf16_t*)(p.ws + WS_RZ) + (size_t)((gg) >> 3) * 4096 * 4096 + ((gg) & 7) * 128; \
        _Pragma("unroll") for (int k = 0; k < 4; ++k) { const int pc = tid + NTHR * k, row = pc >> 4, c8 = pc & 15; ng[k] = __builtin_nontemporal_load((const u32x4*)(Zb_ + (size_t)(t0 + row) * 4096 + 1024 + c8 * 8)); } } while (0)
    LRU2_LOAD_R(slot); LRU2_LOAD_G(slot);
    for (int g = slot; g < NB * 8; g += ngr) {
        const int b = g >> 3, head = g & 7, ch = head * 128 + chl;
        unsigned* gcnt = (unsigned*)(p.ws + WS_BAR + 16 * KiB) + g * 64;
        bf16x8 bA1[4], bI1[4], bA0[4], bI0[4];
        { const bf16_t* wa = (const bf16_t*)(p.ws + WS_WAT) + ((size_t)(8 + head) * 128 + chl) * 128 + 8 * fq; const bf16_t* wi = (const bf16_t*)(p.ws + WS_WIT) + ((size_t)(8 + head) * 128 + chl) * 128 + 8 * fq;
#pragma unroll
          for (int ks = 0; ks < 4; ++ks) { bA1[ks] = *(const bf16x8*)(wa + 32 * ks); bI1[ks] = *(const bf16x8*)(wi + 32 * ks); } }
#pragma unroll
        for (int k = 0; k < 5; ++k) { const int pc = tid + NTHR * k; if (pc < 131 * 16) *(LAS u32x4*)(raw + (pc >> 4) * 256 + (pc & 15) * 16) = nr[k]; }
#pragma unroll
        for (int k = 0; k < 4; ++k) { const int pc = tid + NTHR * k; *(LAS u32x4*)(gzl + (pc >> 4) * 272 + (pc & 15) * 16) = ng[k]; }
        __syncthreads();
        {
            const int c8 = tid & 15, tb = tid >> 4; const int ch0 = head * 128 + 8 * c8;
            float w[4][8], bias[8];
#pragma unroll
            for (int k = 0; k < 4; ++k) { const f32x4 a = *(const f32x4*)(p.conv_w + k * 1024 + ch0), c2 = *(const f32x4*)(p.conv_w + k * 1024 + ch0 + 4);
#pragma unroll
                for (int j = 0; j < 4; ++j) { w[k][j] = a[j]; w[k][4 + j] = c2[j]; } }
            { const f32x4 a = *(const f32x4*)(p.conv_b + ch0), c2 = *(const f32x4*)(p.conv_b + ch0 + 4);
#pragma unroll
                for (int j = 0; j < 4; ++j) { bias[j] = a[j]; bias[4 + j] = c2[j]; } }
#pragma unroll
            for (int i = 0; i < 4; ++i) { const int t = tb + 32 * i; float a[8];
#pragma unroll
                for (int j = 0; j < 8; ++j) a[j] = bias[j];
#pragma unroll
                for (int k = 0; k < 4; ++k) { float f[8]; unpack8(*(const LAS u32x4*)(raw + (t + k) * 256 + c8 * 16), f);
#pragma unroll
                    for (int j = 0; j < 8; ++j) a[j] += w[k][j] * f[j]; }
                u32x4 wv; wv.x = cvt_pk_bf16(a[0], a[1]); wv.y = cvt_pk_bf16(a[2], a[3]); wv.z = cvt_pk_bf16(a[4], a[5]); wv.w = cvt_pk_bf16(a[6], a[7]);
                *(LAS u32x4*)(ul + t * 272 + c8 * 16) = wv; }
        }
        __syncthreads();
        float A0, H0, A1, H1;
        {
            f32x4 hl1[8], pp1[8];
            lru2_dir<1, LRU_PF_FRAG>(p, ul, head, wid, lane, bA1, bI1, bA0, bI0, hl1, pp1, A1, H1);
            LAS unsigned char* hp = outl + chl * 264 + (124 - 4 * fq) * 2; LAS unsigned char* qp = raw + chl * 264 + (124 - 4 * fq) * 2;
#pragma unroll
            for (int rb = 0; rb < 8; ++rb) { u32x2 wh, wq; wh.x = cvt_pk_bf16(hl1[rb][3], hl1[rb][2]); wh.y = cvt_pk_bf16(hl1[rb][1], hl1[rb][0]); wq.x = cvt_pk_bf16(pp1[rb][3], pp1[rb][2]); wq.y = cvt_pk_bf16(pp1[rb][1], pp1[rb][0]);
                *(LAS u32x2*)(hp - 32 * rb) = wh; *(LAS u32x2*)(qp - 32 * rb) = wq; }
        }
        __builtin_amdgcn_sched_barrier(0);
        if (!LRU_PF_FRAG) { const bf16_t* wa = (const bf16_t*)(p.ws + WS_WAT) + ((size_t)(head) * 128 + chl) * 128 + 8 * fq; const bf16_t* wi = (const bf16_t*)(p.ws + WS_WIT) + ((size_t)(head) * 128 + chl) * 128 + 8 * fq;
#pragma unroll
          for (int ks = 0; ks < 4; ++ks) { bA0[ks] = *(const bf16x8*)(wa + 32 * ks); bI0[ks] = *(const bf16x8*)(wi + 32 * ks); } }
        f32x4 hl0[8], pp0[8];
        lru2_dir<0, false>(p, ul, head, wid, lane, bA0, bI0, bA1, bI1, hl0, pp0, A0, H0);
        u64_t* agg = (u64_t*)(p.ws + WS_AGG);
        const size_t ai0 = ((size_t)(b * NSEQ) * 2 + 0) * 1024 + ch, ai1 = ((size_t)(b * NSEQ) * 2 + 1) * 1024 + ch;
        if (fq == 0) {
            __hip_atomic_store(agg + ai0 + (size_t)sc * 2048, ((u64_t)__float_as_uint(H0) << 32) | __float_as_uint(A0), __ATOMIC_RELAXED, __HIP_MEMORY_SCOPE_AGENT);
            __hip_atomic_store(agg + ai1 + (size_t)sc * 2048, ((u64_t)__float_as_uint(H1) << 32) | __float_as_uint(A1), __ATOMIC_RELAXED, __HIP_MEMORY_SCOPE_AGENT); }
        asm volatile("s_waitcnt vmcnt(0)" ::: "memory");
        __syncthreads();
        if (tid == 0) (void)__hip_atomic_fetch_add(gcnt, 1u, __ATOMIC_RELAXED, __HIP_MEMORY_SCOPE_AGENT);
        if (wid == 0) { unsigned sp = 0;
            while ((unsigned)__builtin_amdgcn_readfirstlane(__hip_atomic_load(gcnt, __ATOMIC_RELAXED, __HIP_MEMORY_SCOPE_AGENT)) < 32u) { __builtin_amdgcn_s_sleep(1); if (++sp > (1u << 22)) break; }
            __builtin_amdgcn_fence(__ATOMIC_ACQUIRE, "agent");
            asm volatile("s_waitcnt vmcnt(0)" ::: "memory"); }
        __syncthreads();
        const float C0 = lru2_carry<0>(agg + ai0, sc, fr, fq);
        const float C1 = lru2_carry<1>(agg + ai1, 2 + (NSEQ - 1 - sc), fr, fq);
        __builtin_amdgcn_sched_barrier(0);
        if (LRU_PF_TILE) { const int gn = (g + ngr < NB * 8) ? g + ngr : g; LRU2_LOAD_R(gn); LRU2_LOAD_G(gn); }
        __builtin_amdgcn_sched_barrier(0);
        LAS unsigned char* gp = gzl + (4 * fq) * 272 + chl * 2; LAS unsigned char* op = outl + (4 * fq) * 272 + chl * 2;
        const LAS unsigned char* hp1 = outl + chl * 264 + (4 * fq) * 2; const LAS unsigned char* qp1 = raw + chl * 264 + (4 * fq) * 2;
        unsigned ov[16];
#pragma unroll
        for (int rb = 0; rb < 8; ++rb) { const u32x2 wh = *(const LAS u32x2*)(hp1 + 32 * rb), wq = *(const LAS u32x2*)(qp1 + 32 * rb);
            const float h1v[4] = {bf_lo(wh.x), bf_hi(wh.x), bf_lo(wh.y), bf_hi(wh.y)}, q1v[4] = {bf_lo(wq.x), bf_hi(wq.x), bf_lo(wq.y), bf_hi(wq.y)};
            float o[4];
#pragma unroll
            for (int r = 0; r < 4; ++r) { const float y = hl0[rb][r] + pp0[rb][r] * C0 + h1v[r] + q1v[r] * C1;
                o[r] = bf2f(*(const LAS bf16_t*)(gp + (16 * rb + r) * 272)) * y; }
            ov[2 * rb] = cvt_pk_bf16(o[0], o[1]); ov[2 * rb + 1] = cvt_pk_bf16(o[2], o[3]); }
        __syncthreads();
#pragma unroll
        for (int rb = 0; rb < 8; ++rb) { *(LAS bf16_t*)(op + (16 * rb + 0) * 272) = (bf16_t)(ov[2 * rb] & 0xffffu); *(LAS bf16_t*)(op + (16 * rb + 1) * 272) = (bf16_t)(ov[2 * rb] >> 16);
            *(LAS bf16_t*)(op + (16 * rb + 2) * 272) = (bf16_t)(ov[2 * rb + 1] & 0xffffu); *(LAS bf16_t*)(op + (16 * rb + 3) * 272) = (bf16_t)(ov[2 * rb + 1] >> 16); }
        __syncthreads();
        bf16_t* Ob = (bf16_t*)(p.ws + WS_R1) + ((size_t)(b * 4096 + t0)) * 1024 + head * 128;
#pragma unroll
        for (int k = 0; k < 4; ++k) { const int pc = tid + NTHR * k, row = pc >> 4, c8 = pc & 15;
            *(u32x4*)(Ob + (size_t)row * 1024 + c8 * 8) = *(const LAS u32x4*)(outl + row * 272 + c8 * 16); }
        __syncthreads();
        if (!LRU_PF_TILE && g + ngr < NB * 8) LRU2_LOAD_R(g + ngr);
    }
#undef LRU2_LOAD_R
#undef LRU2_LOAD_G
}

__device__ __forceinline__ void fft_stage2_all(const Params& p, LAS unsigned char* lds) {
    const int tid = tid_opaque(), lane = tid & 63, wid = tid >> 6, fr = lane & 15, fq = lane >> 4;
    const bf16_t* Yt = (const bf16_t*)((const unsigned char*)p.out + OUT_YT); const bf16_t* D2 = (const bf16_t*)(p.ws + WS_D2T);
    bf16_t* Fo = (bf16_t*)((unsigned char*)p.out + OUT_F);
    const int G = gridDim.x;
    int it = blockIdx.x; bf16x8 dfr, yfr[3];
    LAS unsigned char* own = lds; LAS unsigned char* mir = lds + 16 * 528;
#define S2_LOAD(item) do { const int b_ = (item) & 7, k1_ = (item) >> 3; dfr = *(const bf16x8*)(D2 + (size_t)(k1_ + 256 * fr) * 32 + 8 * fq); \
        const bf16_t* yrow_ = Yt + (size_t)(k1_ * 2 + (fq >> 1)) * FCOLS + 8 * (fq & 1); \
        _Pragma("unroll") for (int n = 0; n < 2; ++n) yfr[n] = __builtin_nontemporal_load((const bf16x8*)(yrow_ + (size_t)(b_ * 256 + 16 * (2 * wid + n) + fr) * 16)); \
        yfr[2] = __builtin_nontemporal_load((const bf16x8*)(yrow_ + (size_t)(32768 + (b_ * 4 + (fr & 3)) * 16))); } while (0)
    if (it < NB * 256) S2_LOAD(it);
    for (; it < NB * 256; it += G) {
        const int b = it & 7, k1 = it >> 3;
        f32x4 acc[3];
#pragma unroll
        for (int n = 0; n < 3; ++n) acc[n] = __builtin_amdgcn_mfma_f32_16x16x32_bf16(yfr[n], dfr, (f32x4){0.f, 0.f, 0.f, 0.f}, 0, 0, 0);
        const int nx = it + G; if (nx < NB * 256) S2_LOAD(nx);
#pragma unroll
        for (int n = 0; n < 3; ++n) mfma_settle(acc[n]);
#pragma unroll
        for (int n = 0; n < 2; ++n) { const int c0 = 16 * (2 * wid + n) + 4 * fq, g = c0 >> 6, kb = c0 & 63;
            u32x2 w; w.x = cvt_pk_bf16(acc[n][0], acc[n][1]); w.y = cvt_pk_bf16(acc[n][2], acc[n][3]);
            *(LAS u32x2*)(own + fr * 528 + c0 * 2) = w;
            LAS bf16_t* mp = (LAS bf16_t*)(mir + fr * 528) + g * 64 + 64 - kb;
            if (kb != 0) mp[0] = (bf16_t)(w.x & 0xffffu);
            mp[-1] = (bf16_t)(w.x >> 16); mp[-2] = (bf16_t)(w.y & 0xffffu); mp[-3] = (bf16_t)(w.y >> 16); }
        if (wid == 0 && fq == 0) {
            u32x2 w; w.x = cvt_pk_bf16(acc[2][0], acc[2][1]); w.y = cvt_pk_bf16(acc[2][2], acc[2][3]);
            LAS bf16_t* mp = (LAS bf16_t*)(mir + fr * 528);
            mp[0] = (bf16_t)(w.x & 0xffffu); mp[64] = (bf16_t)(w.x >> 16); mp[128] = (bf16_t)(w.y & 0xffffu); mp[192] = (bf16_t)(w.y >> 16); }
        __syncthreads();
        { const int k2 = tid >> 5, c8 = tid & 31, tp = k1 + 256 * k2, tm = (4096 - tp) & 4095, col = (c8 >> 3) * 128 + (c8 & 7) * 8;
          *(u32x4*)(Fo + ((size_t)b * 4096 + tp) * 512 + col) = *(const LAS u32x4*)(own + k2 * 528 + c8 * 16);
          *(u32x4*)(Fo + ((size_t)b * 4096 + tm) * 512 + col + 64) = *(const LAS u32x4*)(mir + k2 * 528 + c8 * 16); }
        __syncthreads();
    }
#undef S2_LOAD
}

__device__ __forceinline__ void topk_task(const Params& p, LAS unsigned char* lds, int it) {
    const int tid = tid_opaque(), lane = tid & 63, wid = tid >> 6;
    LAS unsigned* cnt = (LAS unsigned*)lds;
    LAS unsigned* wsum = cnt + 64;
    const float* scores = (const float*)(p.ws + WS_SCORES);
    int* idx = (int*)(p.ws + WS_IDX); float* gate = (float*)(p.ws + WS_GATE); int* slot_of = (int*)(p.ws + WS_SLOT);
    const int b = it >> 4, e = it & 15;
    unsigned key[8];
    { const u64_t* sp = (const u64_t*)(scores + (size_t)it * 4096 + tid * 8);
#pragma unroll
      for (int j = 0; j < 4; ++j) { const u64_t v = __hip_atomic_load(sp + j, __ATOMIC_RELAXED, __HIP_MEMORY_SCOPE_AGENT); key[2 * j] = (unsigned)v; key[2 * j + 1] = (unsigned)(v >> 32); } }
    unsigned thr = 0;
    for (int step = 0; step < 16; ++step) {
        const int sh = 29 - 2 * step;
        const unsigned c1 = sh >= 0 ? (thr | (1u << sh)) : (thr | 1u), c2 = sh >= 0 ? (thr | (2u << sh)) : 0xffffffffu, c3 = sh >= 0 ? (thr | (3u << sh)) : 0xffffffffu;
        unsigned n1 = 0, n2 = 0, n3 = 0;
#pragma unroll
        for (int j = 0; j < 8; ++j) { n1 += (unsigned)__popcll(__ballot(key[j] >= c1)); n2 += (unsigned)__popcll(__ballot(key[j] >= c2)); n3 += (unsigned)__popcll(__ballot(key[j] >= c3)); }
        LAS unsigned* cb = cnt + (step & 1) * 32;
        if (lane == 0) { cb[wid] = n1; cb[8 + wid] = n2; cb[16 + wid] = n3; }
        __syncthreads();
        unsigned t1 = 0, t2 = 0, t3 = 0;
#pragma unroll
        for (int w = 0; w < 8; ++w) { t1 += cb[w]; t2 += cb[8 + w]; t3 += cb[16 + w]; }
        if (sh >= 0) thr = t3 >= (unsigned)CAP ? c3 : (t2 >= (unsigned)CAP ? c2 : (t1 >= (unsigned)CAP ? c1 : thr));
        else thr = t1 >= (unsigned)CAP ? c1 : thr;
    }
    unsigned cg_ = 0, ce = 0;
#pragma unroll
    for (int j = 0; j < 8; ++j) { cg_ += key[j] > thr; ce += key[j] == thr; }
    unsigned pk = cg_ | (ce << 16), incl = pk;
#pragma unroll
    for (int o = 1; o < 64; o <<= 1) { const unsigned n = __shfl_up(incl, o); if (lane >= o) incl += n; }
    if (lane == 63) wsum[wid] = incl;
    __syncthreads();
    unsigned base = 0, total = 0;
#pragma unroll
    for (int w = 0; w < 8; ++w) { const unsigned s2 = wsum[w]; if (w < wid) base += s2; total += s2; }
    const unsigned excl = base + incl - pk; unsigned og = excl & 0xffffu, oe = excl >> 16; const unsigned ngt = total & 0xffffu, krem = (unsigned)CAP - ngt;
    int mm[8];
#pragma unroll
    for (int j = 0; j < 8; ++j) { const int t = tid * 8 + j; int m = -1;
        if (key[j] > thr) { m = (e * 8 + b) * 512 + (int)og; ++og; }
        else if (key[j] == thr) { if (oe < krem) m = (e * 8 + b) * 512 + (int)(ngt + oe); ++oe; }
        mm[j] = m;
        if (m >= 0) { idx[m] = b * 4096 + t; gate[m] = __uint_as_float(key[j]); } }
    { u32x4* so = (u32x4*)(slot_of + (size_t)it * 4096 + tid * 8);
      so[0] = (u32x4){(unsigned)mm[0], (unsigned)mm[1], (unsigned)mm[2], (unsigned)mm[3]}; so[1] = (u32x4){(unsigned)mm[4], (unsigned)mm[5], (unsigned)mm[6], (unsigned)mm[7]}; }
    __syncthreads();
}

__device__ __forceinline__ void phase7_rows(const Params& p, LAS unsigned char* lds) {
    const int tid = threadIdx.x, lane = tid & 63, wid = tid >> 6;
    LAS float* wrt = (LAS float*)lds;
    for (int i = tid; i < 16 * 1024; i += NTHR) { const int d = i >> 4, e = i & 15; wrt[e * 1024 + d] = p.w_router[i]; }
    LAS float* modl = (LAS float*)(lds + 65 * 1024);
    { const float* ada0 = (const float*)(p.ws + WS_ADA);
      for (int i = tid; i < 8 * 1024; i += NTHR) { const int bb = i >> 10, d = i & 1023; modl[(bb * 2) * 1024 + d] = p.norm2_g[d] * (ada0[bb * 6144 + 4096 + d] + 1.0f); modl[(bb * 2 + 1) * 1024 + d] = ada0[bb * 6144 + 3072 + d]; } }
    __syncthreads();
    typedef __attribute__((address_space(1))) bf16_t gbf16_t; typedef __attribute__((address_space(1))) float gfloat_t; typedef __attribute__((address_space(1))) unsigned guint_t;
    gbf16_t* h2 = (gbf16_t*)(p.ws + WS_H2); const gbf16_t* x2b = (const gbf16_t*)(p.ws + WS_X2B); gfloat_t* scores = (gfloat_t*)(p.ws + WS_SCORES); guint_t* cnt7 = (guint_t*)(p.ws + WS_BAR + 44 * KiB);
    u32x2 nw[2][4]; int pend_b = -1;
#define P7_LOAD(rw) do { _Pragma("unroll") for (int r = 0; r < 2; ++r) _Pragma("unroll") for (int i = 0; i < 4; ++i) nw[r][i] = *(const __attribute__((address_space(1))) u32x2*)(x2b + (size_t)((rw) + r) * 1024 + 256 * i + 4 * lane); } while (0)
    { const int r0 = (blockIdx.x * 8 + wid) * 2; if (r0 < MLAT) P7_LOAD(r0); }
    auto trip = [&](const int row0) __attribute__((always_inline)) {
        const int b = row0 >> 12;
        f32x4 v[2][4]; float ss[2];
#pragma unroll
        for (int r = 0; r < 2; ++r)
#pragma unroll
            for (int i = 0; i < 4; ++i) { const u32x2 w = nw[r][i]; v[r][i] = (f32x4){bf_lo(w.x), bf_hi(w.x), bf_lo(w.y), bf_hi(w.y)}; }
        { const int nrow = row0 + (int)gridDim.x * 16 < MLAT ? row0 + (int)gridDim.x * 16 : row0; P7_LOAD(nrow); }
        __builtin_amdgcn_sched_barrier(0);
#pragma unroll
        for (int r = 0; r < 2; ++r) { float a = 0.f;
#pragma unroll
            for (int i = 0; i < 4; ++i) a += v[r][i][0] * v[r][i][0] + v[r][i][1] * v[r][i][1] + v[r][i][2] * v[r][i][2] + v[r][i][3] * v[r][i][3];
            ss[r] = a; }
#pragma unroll
        for (int o = 32; o >= 1; o >>= 1) { ss[0] += __shfl_xor(ss[0], o); ss[1] += __shfl_xor(ss[1], o); }
#pragma unroll
        for (int i = 0; i < 4; ++i) { const int d = 256 * i + 4 * lane;
            const f32x4 gg = *(const LAS f32x4*)(modl + (b * 2) * 1024 + d), sh = *(const LAS f32x4*)(modl + (b * 2 + 1) * 1024 + d);
#pragma unroll
            for (int r = 0; r < 2; ++r) { const float rs = rsqrtf(ss[r] * (1.0f / 1024.0f) + 1e-6f);
                v[r][i] = v[r][i] * rs * gg + sh;
                u32x2 w; w.x = cvt_pk_bf16(v[r][i][0], v[r][i][1]); w.y = cvt_pk_bf16(v[r][i][2], v[r][i][3]); *(__attribute__((address_space(1))) u32x2*)(h2 + (size_t)(row0 + r) * 1024 + d) = w; } }
        float q[32];
#pragma unroll
        for (int e = 0; e < 16; ++e) { float a0 = 0.f, a1 = 0.f;
#pragma unroll
            for (int i = 0; i < 4; ++i) { const f32x4 w = *(const LAS f32x4*)(wrt + e * 1024 + 256 * i + 4 * lane);
                a0 += v[0][i][0] * w[0] + v[0][i][1] * w[1] + v[0][i][2] * w[2] + v[0][i][3] * w[3];
                a1 += v[1][i][0] * w[0] + v[1][i][1] * w[1] + v[1][i][2] * w[2] + v[1][i][3] * w[3]; }
            q[e] = a0; q[16 + e] = a1; }
#pragma unroll
        for (int j = 0; j < 16; ++j) { const bool up = (lane & 32) != 0; const float send = up ? q[j] : q[16 + j], keep = up ? q[16 + j] : q[j]; q[j] = keep + __shfl_xor(send, 32); }
#pragma unroll
        for (int j = 0; j < 8; ++j) { const bool up = (lane & 16) != 0; const float send = up ? q[j] : q[8 + j], keep = up ? q[8 + j] : q[j]; q[j] = keep + __shfl_xor(send, 16); }
#pragma unroll
        for (int j = 0; j < 4; ++j) { const bool up = (lane & 8) != 0; const float send = up ? q[j] : q[4 + j], keep = up ? q[4 + j] : q[j]; q[j] = keep + __shfl_xor(send, 8); }
#pragma unroll
        for (int j = 0; j < 2; ++j) { const bool up = (lane & 4) != 0; const float send = up ? q[j] : q[2 + j], keep = up ? q[2 + j] : q[j]; q[j] = keep + __shfl_xor(send, 4); }
        { const bool up = (lane & 2) != 0; const float send = up ? q[0] : q[1], keep = up ? q[1] : q[0]; q[0] = keep + __shfl_xor(send, 2); }
        float lg = q[0] + __shfl_xor(q[0], 1);
        float mx = lg;
#pragma unroll
        for (int o = 2; o <= 16; o <<= 1) mx = fmaxf(mx, __shfl_xor(mx, o));
        const float ex = expf(lg - mx); float sum = ex;
#pragma unroll
        for (int o = 2; o <= 16; o <<= 1) sum += __shfl_xor(sum, o);
        if (gridDim.x == 256) {
            LAS float* scl = (LAS float*)(lds + 64 * 1024);
            if ((lane & 1) == 0) scl[((lane >> 1) & 15) * 16 + wid * 2 + (lane >> 5)] = ex / sum;
            __syncthreads();
            if (tid < 128) { const int e = tid >> 3, q = tid & 7; const u64_t v2 = *(const LAS u64_t*)(scl + e * 16 + 2 * q);
                __hip_atomic_store((__attribute__((address_space(1))) u64_t*)(scores + ((size_t)b * 16 + e) * 4096 + ((row0 - 2 * wid) & 4095) + 2 * q), v2, __ATOMIC_RELAXED, __HIP_MEMORY_SCOPE_AGENT); }
            if (wid < 2) asm volatile("s_waitcnt vmcnt(17)" ::: "memory"); else asm volatile("s_waitcnt vmcnt(16)" ::: "memory");
            __syncthreads();
            if (tid == 0 && pend_b >= 0) (void)__hip_atomic_fetch_add(cnt7 + pend_b * 64, 1u, __ATOMIC_RELAXED, __HIP_MEMORY_SCOPE_AGENT);
            pend_b = b;
        } else if ((lane & 1) == 0) scores[((size_t)b * 16 + ((lane >> 1) & 15)) * 4096 + ((row0 + (lane >> 5)) & 4095)] = ex / sum;
    };
    { int row0 = (blockIdx.x * 8 + wid) * 2;
      if (row0 < MLAT) { trip(row0); for (row0 += gridDim.x * 16; row0 < MLAT; row0 += gridDim.x * 16) trip(row0); } }
#undef P7_LOAD
    asm volatile("s_waitcnt vmcnt(0)" ::: "memory");
    __syncthreads();
    if (tid == 0 && pend_b >= 0) (void)__hip_atomic_fetch_add(cnt7 + pend_b * 64, 1u, __ATOMIC_RELAXED, __HIP_MEMORY_SCOPE_AGENT);
    __syncthreads();
}
__device__ __forceinline__ void phase7_topk(const Params& p, LAS unsigned char* lds) {
    const int bid = blockIdx.x; if (bid >= NB * NE) return;
    unsigned* c = (unsigned*)(p.ws + WS_BAR + 44 * KiB) + (bid >> 4) * 64;
    if (threadIdx.x < 64) { unsigned sp = 0;
        while ((unsigned)__builtin_amdgcn_readfirstlane(__hip_atomic_load(c, __ATOMIC_RELAXED, __HIP_MEMORY_SCOPE_AGENT)) < 256u) { __builtin_amdgcn_s_sleep(1); if (++sp > (1u << 22)) break; }
        __builtin_amdgcn_fence(__ATOMIC_ACQUIRE, "agent");
        asm volatile("s_waitcnt vmcnt(0)" ::: "memory"); }
    __syncthreads();
    topk_task(p, lds, bid);
}
__device__ __forceinline__ void phase7_weights(const Params& p) {
    constexpr int N_G = 16 * 16 * 6, N_D = 16 * 24 * 4;
    const bool fused = gridDim.x == 256;
    for (int j = 0; ; ++j) {
        int it;
        if (!fused) it = blockIdx.x + j * gridDim.x;
        else if (blockIdx.x >= 128) it = j < 4 ? (blockIdx.x - 128) + 128 * j : 512 + blockIdx.x + (j - 4) * 256;
        else it = 512 + blockIdx.x + j * 256;
        if (it >= 2 * N_G + N_D) break;
        if (it < 2 * N_G) { const int up = it >= N_G, j = up ? it - N_G : it, e = j / 96, r = j % 96, kb = r / 6, nb = r % 6;
            xpose_item<4>((up ? p.w_up_e : p.w_gate_e) + (size_t)e * 1024 * 1536, 1536, (bf16_t*)(p.ws + WS_WGU) + (size_t)e * 3072 * 1024, 1024, kb * 64, nb * 256, up ? 2 : 1); }
        else { const int j = it - 2 * N_G, e = j / 96, r = j % 96, kb = r >> 2, nb = r & 3;
            xpose_item<4>(p.w_down_e + (size_t)e * 1536 * 1024, 1024, (bf16_t*)(p.ws + WS_WD) + (size_t)e * 1024 * 1536, 1536, kb * 64, nb * 256, 0); }
    }
}

__device__ __forceinline__ void phase11(const Params& p, float* dst) {
    const int tid = tid_opaque(), lane = tid & 63, wid = tid >> 6;
    const float* ada = (const float*)(p.ws + WS_ADA); const int* slot_of = (const int*)(p.ws + WS_SLOT); const bf16_t* oute = (const bf16_t*)(p.ws + WS_OUTE); const bf16_t* x2b = (const bf16_t*)(p.ws + WS_X2B);
    const int stride = gridDim.x * 16;
    int row0 = (blockIdx.x * 8 + wid) * 2;
    int myslot = row0 < MLAT ? slot_of[((size_t)(row0 >> 12) * 16 + (lane & 15)) * 4096 + ((row0 & 4095) + ((lane >> 4) & 1))] : -1;
    for (; row0 < MLAT; row0 += stride) {
        const int b = row0 >> 12;
        const int nrow = row0 + stride; const int nslot = nrow < MLAT ? slot_of[((size_t)(nrow >> 12) * 16 + (lane & 15)) * 4096 + ((nrow & 4095) + ((lane >> 4) & 1))] : -1;
        f32x4 xv[2][4], acc[2][4];
#pragma unroll
        for (int r = 0; r < 2; ++r)
#pragma unroll
            for (int i = 0; i < 4; ++i) { const u32x2 w = __builtin_nontemporal_load((const u32x2*)(x2b + (size_t)(row0 + r) * 1024 + 256 * i + 4 * lane)); xv[r][i] = (f32x4){bf_lo(w.x), bf_hi(w.x), bf_lo(w.y), bf_hi(w.y)}; acc[r][i] = (f32x4){0.f, 0.f, 0.f, 0.f}; }
        const unsigned long long bal = __ballot(myslot >= 0);
        unsigned mask0 = (unsigned)(bal & 0xffffull), mask1 = (unsigned)((bal >> 16) & 0xffffull);
        while (mask0 | mask1) {
            int m[2][2];
#pragma unroll
            for (int j = 0; j < 2; ++j) { if (mask0) { const int e = __builtin_ctz(mask0); mask0 &= mask0 - 1; m[0][j] = __builtin_amdgcn_readlane(myslot, e); } else m[0][j] = MMOE;
                                          if (mask1) { const int e = __builtin_ctz(mask1); mask1 &= mask1 - 1; m[1][j] = __builtin_amdgcn_readlane(myslot, 16 + e); } else m[1][j] = MMOE; }
            u32x2 w[2][2][4];
#pragma unroll
            for (int r = 0; r < 2; ++r)
#pragma unroll
                for (int j = 0; j < 2; ++j)
#pragma unroll
                    for (int i = 0; i < 4; ++i) w[r][j][i] = __builtin_nontemporal_load((const u32x2*)(oute + (size_t)m[r][j] * 1024 + 256 * i + 4 * lane));
#pragma unroll
            for (int r = 0; r < 2; ++r)
#pragma unroll
                for (int j = 0; j < 2; ++j)
#pragma unroll
                    for (int i = 0; i < 4; ++i) { acc[r][i][0] += bf_lo(w[r][j][i].x); acc[r][i][1] += bf_hi(w[r][j][i].x); acc[r][i][2] += bf_lo(w[r][j][i].y); acc[r][i][3] += bf_hi(w[r][j][i].y); }
        }
        float ss[2];
#pragma unroll
        for (int r = 0; r < 2; ++r) { float a = 0.f;
#pragma unroll
            for (int i = 0; i < 4; ++i) { const int d = 256 * i + 4 * lane; const f32x4 g2 = *(const f32x4*)(ada + b * 6144 + 5120 + d); xv[r][i] += g2 * acc[r][i];
                a += xv[r][i][0] * xv[r][i][0] + xv[r][i][1] * xv[r][i][1] + xv[r][i][2] * xv[r][i][2] + xv[r][i][3] * xv[r][i][3]; }
            ss[r] = a; }
#pragma unroll
        for (int o = 32; o >= 1; o >>= 1) { ss[0] += __shfl_xor(ss[0], o); ss[1] += __shfl_xor(ss[1], o); }
#pragma unroll
        for (int r = 0; r < 2; ++r) { const float rs = rsqrtf(ss[r] * (1.0f / 1024.0f) + 1e-6f);
#pragma unroll
            for (int i = 0; i < 4; ++i) { const int d = 256 * i + 4 * lane; __builtin_nontemporal_store(xv[r][i] * rs * *(const f32x4*)(p.final_g + d), (f32x4*)(dst + (size_t)(row0 + r) * 1024 + d)); } }
        myslot = nslot;
    }
}

#define XB_TMO      128
#define XB_XCNT(j)  (256  + 64 * (j))
#define XB_XSUB(j)  (1280 + 64 * (j))
#define XB_XGEN(j)  (2304 + 64 * (j))
#define XB_TOP      3328
#define XB_TOPGEN   3392
#define XCD_BAR_WORDS 3456
#define XB_SPIN_CAP (1u << 22)
__device__ __forceinline__ unsigned xb_ld(unsigned* p)              { return __hip_atomic_load(p, __ATOMIC_RELAXED, __HIP_MEMORY_SCOPE_AGENT); }
__device__ __forceinline__ unsigned xb_add(unsigned* p, unsigned v) { return __hip_atomic_fetch_add(p, v, __ATOMIC_RELAXED, __HIP_MEMORY_SCOPE_AGENT); }
__device__ __forceinline__ unsigned xb_xcc_id() { return (unsigned)__builtin_amdgcn_s_getreg((3 << 11) | 20) & 0xFu; }
#define XB_SPIN(cond, bar) do { unsigned _sp = 0; while (cond) { __builtin_amdgcn_s_sleep(1); \
    if ((++_sp & 255u) == 0u) { if (xb_ld(&(bar)[XB_TMO])) break; if (_sp > XB_SPIN_CAP) { atomicAdd(&(bar)[XB_TMO], 1u); break; } } } } while (0)
struct XcdBarrier { unsigned* bar; unsigned x; volatile LAS unsigned* st; };
__device__ __forceinline__ XcdBarrier xcd_barrier_post(unsigned* bar, volatile LAS unsigned* st) {
    XcdBarrier b; b.bar = bar; b.x = xb_xcc_id(); b.st = st;
    if (threadIdx.x == 0) (void)xb_add(&bar[XB_XCNT(b.x)], 1u);
    return b;
}
__device__ __forceinline__ void xcd_barrier_complete(unsigned* bar, unsigned x, unsigned& nloc, unsigned& nx) {
    const unsigned G = gridDim.x * gridDim.y * gridDim.z;
    unsigned sum, cnt, mine, sp = 0u;
    for (;;) {
        sum = 0u; cnt = 0u; mine = 0u;
#pragma unroll
        for (unsigned j = 0; j < 16; ++j) { const unsigned c = xb_ld(&bar[XB_XCNT(j)]); sum += c; cnt += (c > 0u) ? 1u : 0u; mine = (j == x) ? c : mine; }
        if (sum == G) break;
        __builtin_amdgcn_s_sleep(1);
        if ((++sp & 255u) == 0u) { if (xb_ld(&bar[XB_TMO])) break; if (sp > XB_SPIN_CAP) { atomicAdd(&bar[XB_TMO], 1u); break; } }
    }
    nloc = mine > 0u ? mine : 1u; nx = cnt > 0u ? cnt : 1u;
}
__device__ __forceinline__ void xcd_barrier(const XcdBarrier& b) {
    asm volatile("s_waitcnt vmcnt(0)" ::: "memory");
    __syncthreads();
    if (threadIdx.x == 0) {
        unsigned* bar = b.bar;
        __builtin_amdgcn_s_waitcnt(0);
        unsigned nloc = b.st[0], nx = b.st[1];
        if (nloc == 0u) { xcd_barrier_complete(bar, b.x, nloc, nx); b.st[0] = nloc; b.st[1] = nx; }
        const unsigned old = xb_add(&bar[XB_XSUB(b.x)], 1u);
        const unsigned gen = old / nloc;
        if (old + 1u == (gen + 1u) * nloc) {
            __builtin_amdgcn_fence(__ATOMIC_RELEASE, "agent");
            asm volatile("s_waitcnt vmcnt(0)" ::: "memory");
            const unsigned og = xb_add(&bar[XB_TOP], 1u);
            const unsigned tg = og / nx;
            if (og + 1u == (tg + 1u) * nx) xb_add(&bar[XB_TOPGEN], 1u);
            else XB_SPIN(xb_ld(&bar[XB_TOPGEN]) == tg, bar);
            __builtin_amdgcn_fence(__ATOMIC_ACQUIRE, "agent");
            xb_add(&bar[XB_XGEN(b.x)], 1u);
            asm volatile("s_waitcnt vmcnt(0)" ::: "memory");
        } else {
            XB_SPIN(xb_ld(&bar[XB_XGEN(b.x)]) == gen, bar);
            __builtin_amdgcn_fence(__ATOMIC_ACQUIRE, "agent");
            asm volatile("s_waitcnt vmcnt(0)" ::: "memory");
        }
    }
    __syncthreads();
}

__global__ void __launch_bounds__(NTHR, 2) fwd_megakernel(Params p_in) {
    Params p = p_in;
    extern __shared__ __attribute__((aligned(16))) unsigned char lds_raw[];
    LAS unsigned char* lds = (LAS unsigned char*)lds_raw;
    cg::grid_group grid = cg::this_grid();
    const int G = gridDim.x, bid = blockIdx.x;
    unsigned char* ws = p.ws;
    bf16_t* const R1 = (bf16_t*)(ws + WS_R1); bf16_t* const Zb = (bf16_t*)(ws + WS_RZ); bf16_t* const PQt = (bf16_t*)(ws + WS_RPQ); bf16_t* const MRG = (bf16_t*)(ws + WS_R2);
    bf16_t* const Fb = (bf16_t*)((unsigned char*)p.out + OUT_F); bf16_t* const Ytb = (bf16_t*)((unsigned char*)p.out + OUT_YT);
#ifdef ONLY_PH
#define PH(k) ((k) == ONLY_PH && p.ph_lo <= (k) && (k) < p.ph_hi)
#else
#define PH(k) (p.ph_lo <= (k) && (k) < p.ph_hi)
#endif
    volatile LAS unsigned* xst = (volatile LAS unsigned*)(lds + LDS_BYTES - 16);
    if (threadIdx.x < 4) xst[threadIdx.x] = 0u;
    __syncthreads();
    XcdBarrier xbar = xcd_barrier_post((unsigned*)(ws + WS_BAR), xst);
    if (p.ph_lo < 0) grid.sync();
#ifdef TS_A
    unsigned long long* tsb = (unsigned long long*)(ws + WS_BAR + 40 * KiB);
#define STAMP(i) do { if (bid == 0 && threadIdx.x == 0) tsb[i] = __builtin_amdgcn_s_memrealtime(); } while (0)
#else
#define STAMP(i) do { } while (0)
#endif
    STAMP(0);
#define LAUNDER() do { asm volatile("" : "+s"(p.ws), "+s"(p.out), "+s"(p.x)); ws = p.ws; } while (0)
#define SYNC(k) do { if (PH(k) && PH((k) + 1)) xcd_barrier(xbar); STAMP((k) + 1); LAUNDER(); } while (0)
#ifndef REPMASK
#define REPMASK 0
#endif
#define REP(k) for (int rep_ = 0; rep_ <= ((REPMASK >> (k)) & 1); ++rep_)
    const bool fuse01 = PH(0) && PH(1);
    if (PH(0)) phase0(p, lds);
    if (fuse01) block_wait_ge((unsigned*)(ws + WS_BAR + 46 * KiB), 256u + 16u);
    else SYNC(0);
    if (PH(1)) REP(1) phase1(p);
    SYNC(1);
    if (PH(2)) REP(2) {
        { ProbPQ pr{(const bf16_t*)(ws + WS_WPQ), R1, 1024, 1024, 16384}; pg8::Order S; S.init(2, 128, G, bid); EpiPQ E{PQt}; pg8::gemm_phase(lds, pr, S, E); }
        STAMP(28);
        { ProbPlain pr{R1, (const bf16_t*)(ws + WS_WIN), 1024, 1024, 1024}; pg8::Order S; S.init(128, 16, G, bid); EpiZ E{Zb, 4096, -1}; pg8::gemm_phase(lds, pr, S, E); }
        STAMP(29);
        { ProbPlain pr{(const bf16_t*)(ws + WS_HCTX), (const bf16_t*)(ws + WS_WIN), 1024, 1024, 1024}; pg8::Order S; S.init(8, 4, G, bid); EpiZ E{(bf16_t*)(ws + WS_ZXC), 1024, 0}; pg8::gemm_phase(lds, pr, S, E); }
    }
    SYNC(2);
    if (PH(3)) REP(3) {
        {
            ProbPlain pr{(const bf16_t*)(ws + WS_D1T), PQt, 512, 512, 512}; pg8::Order S; S.init(2, FCOLS / 256, G, bid);
            if (G == 256) { if (bid >= 128) { S.G = 128; S.c = bid - 128; S.base = 0; S.lim = 2; } else { S.G = 128; S.c = bid; S.base = 256; S.lim = bid < 4 ? 1 : 0; } }
            EpiPlain E{Ytb, FCOLS}; pg8::gemm_phase(lds, pr, S, E); }
        for (int it = bid; it < NB * 2 * 8; it += G) lru_tile<false>(p, lds, it);
    }
    SYNC(3);
    if (PH(4)) {
        fft_stage2_all(p, lds);
        const int ngr = G >> 5;
        if (ngr > 0 && bid < ngr * 32) lru2_block(p, lds, bid % ngr, bid / ngr, ngr);
    }
    SYNC(4);
    if (PH(5)) REP(5) {
        { ProbMerge pr{Fb, (const bf16_t*)(ws + WS_WFOUR), R1, (const bf16_t*)(ws + WS_WLRU), 512, 1024, 512, 512, 1024, 1024}; pg8::Order S; S.init(128, 4, G, bid); EpiMerge E{MRG, Zb}; pg8::gemm_phase2(lds, pr, S, E); }
    }
    SYNC(5);
    if (PH(6)) REP(6) { ProbPlain pr{MRG, (const bf16_t*)(ws + WS_WOUT), 1024, 1024, 1024}; pg8::Order S; S.init(128, 4, G, bid); if (512 % G == 0) S.rev = 512 / G;
        EpiOut E{(bf16_t*)(ws + WS_X2B), p.x, (const float*)(ws + WS_POS), (const float*)(ws + WS_ADA)}; pg8::gemm_phase(lds, pr, S, E); }
    SYNC(6);
    if (PH(7)) { phase7_rows(p, lds); if (G == 256) phase7_topk(p, lds); phase7_weights(p); }
    SYNC(7);
    if (PH(8) && G != 256) { for (int it = bid; it < NB * NE; it += G) topk_task(p, lds, it); }
    if (G != 256) SYNC(8);
    if (PH(9)) REP(9) { ProbMoeUp pr{(const bf16_t*)(ws + WS_H2), (const bf16_t*)(ws + WS_WGU), (const int*)(ws + WS_IDX), 1024, 1024, 1024}; pg8::Order S; S.init(256, 12, G, bid); S.wgm = P9_WGM; EpiGU E{(bf16_t*)(ws + WS_HID)}; pg8::gemm_phase(lds, pr, S, E); }
    SYNC(9);
    if (PH(10)) { if (bid == 0 && threadIdx.x < 128) *(u32x4*)(ws + WS_OUTE + (size_t)MMOE * 2048 + threadIdx.x * 16) = (u32x4){0u, 0u, 0u, 0u}; }
    if (PH(10)) REP(10) { ProbMoeDown pr{(const bf16_t*)(ws + WS_HID), (const bf16_t*)(ws + WS_WD), 1536, 1536, 1536}; pg8::Order S; S.init(256, 4, G, bid); if (1024 % G == 0) S.rev = 1024 / G; EpiDown E{(bf16_t*)(ws + WS_OUTE), (const float*)(ws + WS_GATE)}; pg8::gemm_phase(lds, pr, S, E); }
    SYNC(10);
    if (PH(11)) phase11(p, p.out);
#ifdef TS_A
    xcd_barrier(xbar); STAMP(12);
    if (bid == 0 && threadIdx.x == 0) {

#ifndef TS_AE
#define TS_AE (TS_A + 1)
#endif
#ifndef TS_BE
#define TS_BE (TS_B + 1)
#endif
        const float ta = (float)(tsb[TS_AE] - tsb[TS_A]) * 0.01f * (float)(TS_SA), tb = (float)(tsb[TS_BE] - tsb[TS_B]) * 0.01f * (float)(TS_SB);
        p.out[7] = fminf(ta, 97.f); p.out[1024 * 5 + 9] = fminf(tb, 97.f); }
#endif
}

#ifndef N_LAUNCHES
#define N_LAUNCHES 1
#endif
#ifndef PROBE_DUP
#define PROBE_DUP 0x0
#endif
extern "C" void kernel_launch(void* const* d_in, const int* in_sizes, int n_in, void* d_out, int out_size, void* d_ws, size_t ws_size, hipStream_t stream) {
    static int grid = 0;
    if (grid == 0) {
        if (n_in != 24 || out_size != MLAT * DM || ws_size < WS_END) { fprintf(stderr, "kernel_launch: unexpected shapes (n_in %d out %d ws %zu)\n", n_in, out_size, ws_size); grid = -1; return; }
        int dev = 0, cus = 0, per_cu = 0;
        hipGetDevice(&dev); hipDeviceGetAttribute(&cus, hipDeviceAttributeMultiprocessorCount, dev);
        hipFuncSetAttribute((const void*)fwd_megakernel, hipFuncAttributeMaxDynamicSharedMemorySize, LDS_BYTES);
        hipOccupancyMaxActiveBlocksPerMultiprocessor(&per_cu, (const void*)fwd_megakernel, NTHR, LDS_BYTES);
        if (per_cu < 1) { fprintf(stderr, "kernel_launch: occupancy query reports %d blocks per CU\n", per_cu); per_cu = 1; }
        grid = cus * 1;
        (void)hipGetLastError();
    }
    if (grid < 0) return;
    Params p{};
    const float** f = (const float**)&p;
    for (int i = 0; i < 24; ++i) f[i] = (const float*)d_in[i];
    p.out = (float*)d_out; p.ws = (unsigned char*)d_ws;
    (void)hipMemsetAsync((unsigned char*)d_ws + WS_BAR, 0, 48 * KiB, stream);
#if N_LAUNCHES == 1
    p.ph_lo = 0; p.ph_hi = 12;
    void* args[] = {&p};
    hipError_t e = hipLaunchCooperativeKernel((const void*)fwd_megakernel, dim3(grid), dim3(NTHR), args, LDS_BYTES, stream);
    if (e != hipSuccess) fprintf(stderr, "cooperative launch failed: %s (grid %d)\n", hipGetErrorString(e), grid);
#else
    for (int k = 0; k < 12; ++k) for (int r = 0; r <= ((PROBE_DUP >> k) & 1); ++r) { p.ph_lo = k; p.ph_hi = k + 1; if (k == 11 && r == 0 && ((PROBE_DUP >> 11) & 1)) { p.ph_lo = 12; p.ph_hi = 13; } hipLaunchKernelGGL(fwd_megakernel, dim3(grid), dim3(NTHR), LDS_BYTES, stream, p); }
#endif
}
```

```cpp
#include <hip/hip_runtime.h>
#include <hip/hip_cooperative_groups.h>
#include <cstdio>
namespace cg = cooperative_groups;

#ifndef P9_WGM
#define P9_WGM 2
#endif
#define LAS __attribute__((address_space(3)))
typedef unsigned short bf16_t;
typedef short bf16x8 __attribute__((ext_vector_type(8)));
typedef float f32x4 __attribute__((ext_vector_type(4)));
typedef float f32x16 __attribute__((ext_vector_type(16)));
typedef unsigned u32x4 __attribute__((ext_vector_type(4)));
typedef unsigned u32x2 __attribute__((ext_vector_type(2)));
typedef unsigned long long u64_t;

constexpr int NB = 8, TT = 4096, DM = 1024, CTXL = 256, MLAT = NB * TT, MCTX = NB * CTXL;
constexpr int NE = 16, CAP = 512, DE = 1536, MMOE = NE * NB * CAP;
constexpr int NSEQ = 34;
constexpr int NTHR = 512;
constexpr float NLOG2E = -1.4426950408889634f;
constexpr int LDS_BYTES = 144 * 1024;

constexpr size_t KiB = 1024, MiB = 1024 * 1024;
constexpr size_t WS_ADA = 0;
constexpr size_t WS_POS = 256 * KiB;
constexpr size_t WS_AGG = 512 * KiB;
constexpr int FCOLS = 32768 + 512;
constexpr size_t WS_WPQ = 5 * MiB;
constexpr size_t WS_WIN = 7 * MiB;
constexpr size_t WS_WFOUR = 15 * MiB;
constexpr size_t WS_WLRU = 16 * MiB;
constexpr size_t WS_WOUT = 18 * MiB;
constexpr size_t WS_WAT = 20 * MiB;
constexpr size_t WS_WIT = 20 * MiB + 512 * KiB;
constexpr size_t WS_SCORES = 21 * MiB;
constexpr size_t WS_IDX = 23 * MiB;
constexpr size_t WS_GATE = 23 * MiB + 256 * KiB;
constexpr size_t WS_SLOT = 23 * MiB + 512 * KiB;
constexpr size_t WS_BAR = 25 * MiB + 512 * KiB;
constexpr size_t WS_D1T = 34 * MiB;
constexpr size_t WS_D2T = 34 * MiB + 512 * KiB;
constexpr size_t WS_HCTX = 26 * MiB;
constexpr size_t WS_ZXC = 30 * MiB;
constexpr size_t WS_R1 = 40 * MiB;
constexpr size_t WS_RPQ = 104 * MiB;
constexpr size_t WS_R2 = 168 * MiB;
constexpr size_t WS_RZ = 232 * MiB;
constexpr size_t WS_END = 504 * MiB;
constexpr size_t WS_X2B = WS_R1, WS_H2 = WS_RPQ, WS_WGU = 168 * MiB, WS_WD = 264 * MiB, WS_HID = 312 * MiB, WS_OUTE = WS_RPQ;
constexpr size_t OUT_YT = 0, OUT_F = 64 * MiB;

struct Params {
    const float *x, *c, *ctx, *c_ctx, *w_ada, *b_ada, *norm1_g, *norm2_g, *w_in, *w_four, *conv_w, *conv_b, *lru_lambda,
        *lru_wa, *lru_ba, *lru_wi, *lru_bi, *w_lru, *w_out, *w_router, *w_gate_e, *w_up_e, *w_down_e, *final_g;
    float* out; unsigned char* ws; int ph_lo, ph_hi;
};

__device__ __forceinline__ int tid_opaque() { int t = threadIdx.x; asm volatile("" : "+v"(t)); return t; }
__device__ __forceinline__ unsigned cvt_pk_bf16(float lo, float hi) { unsigned r; asm volatile("v_cvt_pk_bf16_f32 %0, %1, %2" : "=v"(r) : "v"(lo), "v"(hi)); return r; }
__device__ __forceinline__ void mfma_settle(f32x4& a) { asm volatile("s_nop 15\n\ts_nop 7" : "+v"(a)); }
__device__ __forceinline__ void block_wait_ge(unsigned* cnt, unsigned need) {
    if (threadIdx.x < 64) { unsigned sp = 0;
        while ((unsigned)__builtin_amdgcn_readfirstlane(__hip_atomic_load(cnt, __ATOMIC_RELAXED, __HIP_MEMORY_SCOPE_AGENT)) < need) { __builtin_amdgcn_s_sleep(2); if (++sp > (1u << 22)) break; }
        __builtin_amdgcn_fence(__ATOMIC_ACQUIRE, "agent"); asm volatile("s_waitcnt vmcnt(0)" ::: "memory"); }
    __syncthreads();
}
__device__ __forceinline__ float bf_lo(unsigned w) { return __uint_as_float(w << 16); }
__device__ __forceinline__ float bf_hi(unsigned w) { return __uint_as_float(w & 0xffff0000u); }
__device__ __forceinline__ float bf2f(bf16_t h) { return __uint_as_float(((unsigned)h) << 16); }
__device__ __forceinline__ float sigmoidf_(float v) { return __builtin_amdgcn_rcpf(1.0f + __expf(-v)); }
__device__ __forceinline__ float gelu_tanh(float v) { const float y = 1.5957691216f * (v + 0.044715f * v * v * v); return v * sigmoidf_(y); }
__device__ __forceinline__ float wave_sum(float v) {
#pragma unroll
    for (int o = 32; o >= 1; o >>= 1) v += __shfl_xor(v, o);
    return v;
}
__device__ __forceinline__ void unpack8(const u32x4 w, float (&f)[8]) { f[0] = bf_lo(w.x); f[1] = bf_hi(w.x); f[2] = bf_lo(w.y); f[3] = bf_hi(w.y); f[4] = bf_lo(w.z); f[5] = bf_hi(w.z); f[6] = bf_lo(w.w); f[7] = bf_hi(w.w); }

namespace pg8 {
constexpr int BM = 256, BK = 64, HALF = 128, HTB = HALF * BK * 2, STAGE_BYTES = 8 * HTB, NXCD = 8, WGM = 2;
__device__ __forceinline__ int lds_byte(int r, int c) { const int st = (r >> 4) * 2 + (c >> 5), rr = r & 15, cc = c & 31, ob = rr * 64 + cc * 2; return st * 1024 + (ob ^ (((ob >> 9) & 1) << 5)); }
__device__ __forceinline__ void stage_rc(int b, int& R, int& C) { const int st = b / 1024, sb = b % 1024, swz = sb ^ (((sb >> 9) & 1) << 5); R = (st >> 1) * 16 + swz / 64; C = (st & 1) * 32 + (swz % 64) / 2; }
__device__ __forceinline__ int perm32(int rho) { const int n = rho >> 4, i = rho & 15; return 8 * (i >> 2) + 4 * n + (i & 3); }
struct Unit { int pm, pn; };
struct Order {
    int nM, nN, nwg, G, c, base, lim, rev, wgm;
    __device__ void init(int nM_, int nN_, int G_, int c_) { nM = nM_; nN = nN_; nwg = nM * nN; G = G_; c = c_; base = 0; lim = 0x7fffffff; rev = 0; wgm = WGM; }
    __device__ bool next(int i, Unit& u) const {
        if (rev > 0 && i >= rev) return false;
        const long L = (long)base + (long)(rev > 0 ? rev - 1 - i : i) * G + c; if (i >= lim || L >= nwg) return false;
        int wgid = (int)L; { const int q = nwg / NXCD, r = nwg % NXCD, xcd = wgid % NXCD, off = wgid / NXCD; wgid = (xcd < r ? xcd * (q + 1) : r * (q + 1) + (xcd - r) * q) + off; }
        const int nig = wgm * nN, gid = wgid / nig, fm = gid * wgm, gsz = (nM - fm) < wgm ? (nM - fm) : wgm;
        u.pm = fm + ((wgid % nig) % gsz); u.pn = (wgid % nig) / gsz; return true;
    }
};
template <class P, class Epi>
__device__ __forceinline__ void gemm_phase(LAS unsigned char* lds, const P& pr, const Order& S, const Epi& E) {
    const int tid = tid_opaque(), wid = __builtin_amdgcn_readfirstlane(tid >> 6), lane = tid & 63, wr = wid >> 2, wc = wid & 3, fr = lane & 15, fq = lane >> 4;
    const int nt = pr.K / BK;
    int RA[2], CA[2]; unsigned voffB[2];
#pragma unroll
    for (int i = 0; i < 2; ++i) { int R, C; stage_rc(tid * 16 + i * 8192, R, C); RA[i] = R; CA[i] = C; const int Rb = Epi::PERM ? ((R & ~31) + perm32(R & 31)) : R; voffB[i] = (unsigned)(Rb * pr.ldb + C) * 2u; }
    const size_t kstep = (size_t)(BK * 2);
    const size_t hstepB = (size_t)HALF * pr.ldb * 2;
    const unsigned ldsw = (unsigned)wid * 1024u;
    const int aoff = lds_byte(wr * 64 + fr, fq * 8), boff = lds_byte(wc * 32 + fr, fq * 8);
#define PG8_SA(b, h) (((b) * 2 + (h)) * HTB)
#define PG8_SB(b, h) ((4 + (b) * 2 + (h)) * HTB)
#define PG8_STAGE(bufoff, gbase, voff) do { _Pragma("unroll") for (int _i = 0; _i < 2; ++_i) \
        __builtin_amdgcn_global_load_lds((const unsigned*)((const char*)(gbase) + (voff)[_i]), (LAS unsigned*)(lds + (bufoff) + ldsw + _i * 8192), 16, 0, 0); } while (0)
#define PG8_LDA(dst, b, h) do { _Pragma("unroll") for (int m = 0; m < 4; ++m) _Pragma("unroll") for (int k = 0; k < 2; ++k) dst[m][k] = *(const LAS bf16x8*)(lds + PG8_SA(b, h) + aoff + m * 2048 + k * 1024); } while (0)
#define PG8_LDB(dst, b, h) do { _Pragma("unroll") for (int n = 0; n < 2; ++n) _Pragma("unroll") for (int k = 0; k < 2; ++k) dst[n][k] = *(const LAS bf16x8*)(lds + PG8_SB(b, h) + boff + n * 2048 + k * 1024); } while (0)
#define PG8_MMA(ai, bj, At, Bt) do { __builtin_amdgcn_s_setprio(1); _Pragma("unroll") for (int m = 0; m < 4; ++m) _Pragma("unroll") for (int n = 0; n < 2; ++n) _Pragma("unroll") for (int k = 0; k < 2; ++k) \
        acc[ai][bj][m][n] = __builtin_amdgcn_mfma_f32_16x16x32_bf16(Bt[n][k], At[m][k], acc[ai][bj][m][n], 0, 0, 0); __builtin_amdgcn_s_setprio(0); } while (0)
#define PG8_WAIT_V(n) asm volatile("s_waitcnt vmcnt(" #n ")" ::: "memory")
#define PG8_WAIT_L(n) asm volatile("s_waitcnt lgkmcnt(" #n ")" ::: "memory")
#define PG8_BAR __builtin_amdgcn_s_barrier()
#define PG8_SCHED __builtin_amdgcn_sched_barrier(0)
    Unit cur, nxt; int ui = 0;
    if (!S.next(0, cur)) return;
    f32x4 acc[2][2][4][2];
#pragma unroll
    for (int a = 0; a < 2; ++a)
#pragma unroll
        for (int b = 0; b < 2; ++b)
#pragma unroll
            for (int m = 0; m < 4; ++m)
#pragma unroll
                for (int n = 0; n < 2; ++n) acc[a][b][m][n] = (f32x4){0.f, 0.f, 0.f, 0.f};
    bf16x8 At[4][2], B0[2][2], B1[2][2];
    unsigned vA[2][2], vN[2][2];
    pr.avoff(cur, RA, CA, vA);
#pragma unroll
    for (int h = 0; h < 2; ++h)
#pragma unroll
        for (int i = 0; i < 2; ++i) vN[h][i] = vA[h][i];
    const char* cA = pr.abase(cur); const char* cB = pr.bbase(cur);
#define PG8_ROT(u) 0
#define PG8_KT(tt, rot) ((size_t)(((tt) + (rot)) >= nt ? ((tt) + (rot)) - nt : ((tt) + (rot))) * kstep)
    int rot = PG8_ROT(cur);
    { const char* pA = cA + PG8_KT(0, rot); const char* pB = cB + PG8_KT(0, rot);
    PG8_STAGE(PG8_SB(0, 0), pB, voffB); PG8_STAGE(PG8_SA(0, 0), pA, vA[0]); PG8_STAGE(PG8_SB(0, 1), pB + hstepB, voffB); PG8_STAGE(PG8_SA(0, 1), pA, vA[1]);
    if (wr == 1) PG8_BAR;
    PG8_WAIT_V(4); PG8_BAR;
    PG8_STAGE(PG8_SB(1, 0), pB + kstep, voffB); PG8_STAGE(PG8_SA(1, 0), pA + kstep, vA[0]); PG8_STAGE(PG8_SB(1, 1), pB + hstepB + kstep, voffB); }
    PG8_WAIT_V(6); PG8_BAR;
    for (;;) {
        const bool has_next = S.next(ui + 1, nxt);
        const char* nA = has_next ? pr.abase(nxt) : cA; const char* nB = has_next ? pr.bbase(nxt) : cB; const int nrot = has_next ? PG8_ROT(nxt) : rot;
        if (P::GATHER) { if (has_next) pr.avoff(nxt, RA, CA, vN); }
        for (int t = 0; t < nt; t += 2) {
            const bool last = (t == nt - 2);
            const char* a1 = cA + PG8_KT(t + 1, rot);
            const char* a2 = last ? nA + PG8_KT(0, nrot) : cA + PG8_KT(t + 2, rot); const char* b2 = last ? nB + PG8_KT(0, nrot) : cB + PG8_KT(t + 2, rot);
            const char* a3 = a2 + kstep; const char* b3 = b2 + kstep;
            unsigned v2[2][2];
#pragma unroll
            for (int h = 0; h < 2; ++h)
#pragma unroll
                for (int i = 0; i < 2; ++i) v2[h][i] = (P::GATHER && last) ? vN[h][i] : vA[h][i];
            PG8_LDB(B0, 0, 0); PG8_SCHED; PG8_LDA(At, 0, 0); PG8_STAGE(PG8_SA(1, 1), a1, vA[1]);
            PG8_WAIT_L(8); PG8_BAR; PG8_WAIT_L(0); PG8_MMA(0, 0, At, B0); PG8_BAR; PG8_SCHED;
            PG8_LDB(B1, 0, 1); PG8_STAGE(PG8_SB(0, 0), b2, voffB);
            PG8_BAR; PG8_WAIT_L(0); PG8_MMA(0, 1, At, B1); PG8_BAR;
            PG8_LDA(At, 0, 1); PG8_STAGE(PG8_SA(0, 0), a2, v2[0]);
            PG8_BAR; PG8_WAIT_L(0); PG8_MMA(1, 0, At, B0); PG8_BAR; PG8_SCHED;
            PG8_STAGE(PG8_SB(0, 1), b2 + hstepB, voffB);
            PG8_WAIT_V(6); PG8_BAR; PG8_MMA(1, 1, At, B1); PG8_BAR;
            PG8_LDB(B0, 1, 0); PG8_SCHED; PG8_LDA(At, 1, 0); PG8_STAGE(PG8_SA(0, 1), a2, v2[1]);
            PG8_WAIT_L(8); PG8_BAR; PG8_WAIT_L(0); PG8_MMA(0, 0, At, B0); PG8_BAR; PG8_SCHED;
            PG8_LDB(B1, 1, 1); PG8_STAGE(PG8_SB(1, 0), b3, voffB);
            PG8_BAR; PG8_WAIT_L(0); PG8_MMA(0, 1, At, B1); PG8_BAR;
            PG8_LDA(At, 1, 1); PG8_STAGE(PG8_SA(1, 0), a3, v2[0]);
            PG8_BAR; PG8_WAIT_L(0); PG8_MMA(1, 0, At, B0); PG8_BAR; PG8_SCHED;
            PG8_STAGE(PG8_SB(1, 1), b3 + hstepB, voffB);
            PG8_WAIT_V(6); PG8_BAR; PG8_MMA(1, 1, At, B1); PG8_BAR;
            if (P::GATHER && last) {
#pragma unroll
                for (int h = 0; h < 2; ++h)
#pragma unroll
                    for (int i = 0; i < 2; ++i) vA[h][i] = vN[h][i];
            }
        }
        E(acc, cur, wr, wc, fr, fq);
        if (!has_next) break;
#pragma unroll
        for (int a = 0; a < 2; ++a)
#pragma unroll
            for (int b = 0; b < 2; ++b)
#pragma unroll
                for (int m = 0; m < 4; ++m)
#pragma unroll
                    for (int n = 0; n < 2; ++n) acc[a][b][m][n] = (f32x4){0.f, 0.f, 0.f, 0.f};
        cur = nxt; cA = nA; cB = nB; rot = nrot; ++ui;
    }
    PG8_WAIT_V(0);
    if (wr == 0) PG8_BAR;
    PG8_BAR;
#undef PG8_ROT
#undef PG8_KT
#undef PG8_SA
#undef PG8_SB
#undef PG8_STAGE
#undef PG8_LDA
#undef PG8_LDB
#undef PG8_MMA
#undef PG8_WAIT_V
#undef PG8_WAIT_L
#undef PG8_BAR
#undef PG8_SCHED
}
template <class P, class Epi>
__device__ __forceinline__ void gemm_phase2(LAS unsigned char* lds, const P& pr, const Order& S, const Epi& E) {
    const int tid = tid_opaque(), wid = __builtin_amdgcn_readfirstlane(tid >> 6), lane = tid & 63, wr = wid >> 2, wc = wid & 3, fr = lane & 15, fq = lane >> 4;
    const int nt1 = pr.K1 / BK, nt = (pr.K1 + pr.K2) / BK;
    unsigned R2[2], Rb2[2], C2[2];
#pragma unroll
    for (int i = 0; i < 2; ++i) { int R, C; stage_rc(tid * 16 + i * 8192, R, C); const int Rb = Epi::PERM ? ((R & ~31) + perm32(R & 31)) : R; R2[i] = (unsigned)R * 2u; Rb2[i] = (unsigned)Rb * 2u; C2[i] = (unsigned)C * 2u; }
#define OFF_A(ld, h, i) ((R2[i] + (unsigned)((h) * 256)) * (unsigned)(ld) + C2[i])
#define OFF_B(ld, i) (Rb2[i] * (unsigned)(ld) + C2[i])
    const size_t kstep = (size_t)(BK * 2);
    const size_t hB1 = (size_t)HALF * pr.ldb1 * 2, hB2 = (size_t)HALF * pr.ldb2 * 2;
    const unsigned ldsw = (unsigned)wid * 1024u;
    const int aoff = lds_byte(wr * 64 + fr, fq * 8), boff = lds_byte(wc * 32 + fr, fq * 8);
#define PG8_SA(b, h) (((b) * 2 + (h)) * HTB)
#define PG8_SB(b, h) ((4 + (b) * 2 + (h)) * HTB)
#define PG8_STAGE(bufoff, gbase, voff) do { _Pragma("unroll") for (int _i = 0; _i < 2; ++_i) \
        __builtin_amdgcn_global_load_lds((const unsigned*)((const char*)(gbase) + (voff)[_i]), (LAS unsigned*)(lds + (bufoff) + ldsw + _i * 8192), 16, 0, 0); } while (0)
#define PG8_LDA(dst, b, h) do { _Pragma("unroll") for (int m = 0; m < 4; ++m) _Pragma("unroll") for (int k = 0; k < 2; ++k) dst[m][k] = *(const LAS bf16x8*)(lds + PG8_SA(b, h) + aoff + m * 2048 + k * 1024); } while (0)
#define PG8_LDB(dst, b, h) do { _Pragma("unroll") for (int n = 0; n < 2; ++n) _Pragma("unroll") for (int k = 0; k < 2; ++k) dst[n][k] = *(const LAS bf16x8*)(lds + PG8_SB(b, h) + boff + n * 2048 + k * 1024); } while (0)
#define PG8_MMA(ai, bj, At, Bt) do { __builtin_amdgcn_s_setprio(1); _Pragma("unroll") for (int m = 0; m < 4; ++m) _Pragma("unroll") for (int n = 0; n < 2; ++n) _Pragma("unroll") for (int k = 0; k < 2; ++k) \
        acc[ai][bj][m][n] = __builtin_amdgcn_mfma_f32_16x16x32_bf16(Bt[n][k], At[m][k], acc[ai][bj][m][n], 0, 0, 0); __builtin_amdgcn_s_setprio(0); } while (0)
#define PG8_WAIT_V(n) asm volatile("s_waitcnt vmcnt(" #n ")" ::: "memory")
#define PG8_WAIT_L(n) asm volatile("s_waitcnt lgkmcnt(" #n ")" ::: "memory")
#define PG8_BAR __builtin_amdgcn_s_barrier()
#define PG8_SCHED __builtin_amdgcn_sched_barrier(0)
    Unit cur, nxt; int ui = 0;
    if (!S.next(0, cur)) return;
    f32x4 acc[2][2][4][2];
#pragma unroll
    for (int a = 0; a < 2; ++a)
#pragma unroll
        for (int b = 0; b < 2; ++b)
#pragma unroll
            for (int m = 0; m < 4; ++m)
#pragma unroll
                for (int n = 0; n < 2; ++n) acc[a][b][m][n] = (f32x4){0.f, 0.f, 0.f, 0.f};
    bf16x8 At[4][2], B0[2][2], B1[2][2];
    const char* cA1 = pr.abase1(cur); const char* cB1 = pr.bbase1(cur); const char* cA2 = pr.abase2(cur); const char* cB2 = pr.bbase2(cur);
#define T_A(tt) ((tt) < nt1 ? cA1 + (size_t)(tt) * kstep : cA2 + (size_t)((tt) - nt1) * kstep)
#define T_B(tt) ((tt) < nt1 ? cB1 + (size_t)(tt) * kstep : cB2 + (size_t)((tt) - nt1) * kstep)
    { unsigned vb[2] = {OFF_B(pr.ldb1, 0), OFF_B(pr.ldb1, 1)}, va0[2] = {OFF_A(pr.lda1, 0, 0), OFF_A(pr.lda1, 0, 1)}, va1[2] = {OFF_A(pr.lda1, 1, 0), OFF_A(pr.lda1, 1, 1)};
    PG8_STAGE(PG8_SB(0, 0), cB1, vb); PG8_STAGE(PG8_SA(0, 0), cA1, va0); PG8_STAGE(PG8_SB(0, 1), cB1 + hB1, vb); PG8_STAGE(PG8_SA(0, 1), cA1, va1);
    if (wr == 1) PG8_BAR;
    PG8_WAIT_V(4); PG8_BAR;
    PG8_STAGE(PG8_SB(1, 0), cB1 + kstep, vb); PG8_STAGE(PG8_SA(1, 0), cA1 + kstep, va0); PG8_STAGE(PG8_SB(1, 1), cB1 + hB1 + kstep, vb); }
    PG8_WAIT_V(6); PG8_BAR;
    for (;;) {
        const bool has_next = S.next(ui + 1, nxt);
        const char* nA = has_next ? pr.abase1(nxt) : cA1; const char* nB = has_next ? pr.bbase1(nxt) : cB1;
        for (int t = 0; t < nt; t += 2) {
            const bool last = (t == nt - 2);
            const bool s1 = (t + 1 < nt1), s2 = last || (t + 2 < nt1);
            const char* a1 = T_A(t + 1);
            const char* a2 = last ? nA : T_A(t + 2); const char* b2 = last ? nB : T_B(t + 2);
            const char* a3 = a2 + kstep; const char* b3 = b2 + kstep;
            const size_t hstepB = s2 ? hB1 : hB2; const int ldaT1 = s1 ? pr.lda1 : pr.lda2, ldaT2 = s2 ? pr.lda1 : pr.lda2, ldbT2 = s2 ? pr.ldb1 : pr.ldb2;
            unsigned v2[2][2], voffB[2], vA1s[2];
#pragma unroll
            for (int i = 0; i < 2; ++i) { voffB[i] = OFF_B(ldbT2, i); vA1s[i] = OFF_A(ldaT1, 1, i);
#pragma unroll
                for (int h = 0; h < 2; ++h) v2[h][i] = OFF_A(ldaT2, h, i); }
            PG8_LDB(B0, 0, 0); PG8_SCHED; PG8_LDA(At, 0, 0); PG8_STAGE(PG8_SA(1, 1), a1, vA1s);
            PG8_WAIT_L(8); PG8_BAR; PG8_WAIT_L(0); PG8_MMA(0, 0, At, B0); PG8_BAR; PG8_SCHED;
            PG8_LDB(B1, 0, 1); PG8_STAGE(PG8_SB(0, 0), b2, voffB);
            PG8_BAR; PG8_WAIT_L(0); PG8_MMA(0, 1, At, B1); PG8_BAR;
            PG8_LDA(At, 0, 1); PG8_STAGE(PG8_SA(0, 0), a2, v2[0]);
            PG8_BAR; PG8_WAIT_L(0); PG8_MMA(1, 0, At, B0); PG8_BAR; PG8_SCHED;
            PG8_STAGE(PG8_SB(0, 1), b2 + hstepB, voffB);
            PG8_WAIT_V(6); PG8_BAR; PG8_MMA(1, 1, At, B1); PG8_BAR;
            PG8_LDB(B0, 1, 0); PG8_SCHED; PG8_LDA(At, 1, 0); PG8_STAGE(PG8_SA(0, 1), a2, v2[1]);
            PG8_WAIT_L(8); PG8_BAR; PG8_WAIT_L(0); PG8_MMA(0, 0, At, B0); PG8_BAR; PG8_SCHED;
            PG8_LDB(B1, 1, 1); PG8_STAGE(PG8_SB(1, 0), b3, voffB);
            PG8_BAR; PG8_WAIT_L(0); PG8_MMA(0, 1, At, B1); PG8_BAR;
            PG8_LDA(At, 1, 1); PG8_STAGE(PG8_SA(1, 0), a3, v2[0]);
            PG8_BAR; PG8_WAIT_L(0); PG8_MMA(1, 0, At, B0); PG8_BAR; PG8_SCHED;
            PG8_STAGE(PG8_SB(1, 1), b3 + hstepB, voffB);
            PG8_WAIT_V(6); PG8_BAR; PG8_MMA(1, 1, At, B1); PG8_BAR;
            if (t == nt1 - 2) E.mid(acc, cur, wr, wc, fr, fq);
        }
        E(acc, cur, wr, wc, fr, fq);
        if (!has_next) break;
#pragma unroll
        for (int a = 0; a < 2; ++a)
#pragma unroll
            for (int b = 0; b < 2; ++b)
#pragma unroll
                for (int m = 0; m < 4; ++m)
#pragma unroll
                    for (int n = 0; n < 2; ++n) acc[a][b][m][n] = (f32x4){0.f, 0.f, 0.f, 0.f};
        cur = nxt; cA1 = nA; cB1 = nB; cA2 = pr.abase2(cur); cB2 = pr.bbase2(cur); ++ui;
    }
    PG8_WAIT_V(0);
    if (wr == 0) PG8_BAR;
    PG8_BAR;
#undef T_A
#undef T_B
#undef OFF_A
#undef OFF_B
#undef PG8_SA
#undef PG8_SB
#undef PG8_STAGE
#undef PG8_LDA
#undef PG8_LDB
#undef PG8_MMA
#undef PG8_WAIT_V
#undef PG8_WAIT_L
#undef PG8_BAR
#undef PG8_SCHED
}
}
using pg8::Unit;

struct ProbPlain {
    static constexpr bool GATHER = false;
    const bf16_t* A; const bf16_t* B; int K, lda, ldb;
    __device__ __forceinline__ const char* abase(const Unit& u) const { return (const char*)(A + (size_t)u.pm * 256 * lda); }
    __device__ __forceinline__ const char* bbase(const Unit& u) const { return (const char*)(B + (size_t)u.pn * 256 * ldb); }
    __device__ __forceinline__ void avoff(const Unit&, const int (&RA)[2], const int (&CA)[2], unsigned (&v)[2][2]) const {
#pragma unroll
        for (int h = 0; h < 2; ++h)
#pragma unroll
            for (int i = 0; i < 2; ++i) v[h][i] = (unsigned)((h * 128 + RA[i]) * lda + CA[i]) * 2u;
    }
};
struct ProbMerge {
    const bf16_t* A1; const bf16_t* B1; const bf16_t* A2; const bf16_t* B2; int K1, K2, lda1, ldb1, lda2, ldb2;
    __device__ __forceinline__ const char* abase1(const Unit& u) const { return (const char*)(A1 + (size_t)u.pm * 256 * lda1); }
    __device__ __forceinline__ const char* bbase1(const Unit& u) const { return (const char*)(B1 + (size_t)u.pn * 256 * ldb1); }
    __device__ __forceinline__ const char* abase2(const Unit& u) const { return (const char*)(A2 + (size_t)u.pm * 256 * lda2); }
    __device__ __forceinline__ const char* bbase2(const Unit& u) const { return (const char*)(B2 + (size_t)u.pn * 256 * ldb2); }
};
struct ProbPQ {
    static constexpr bool GATHER = false;
    const bf16_t* A; const bf16_t* B; int K, lda, ldb;
    __device__ __forceinline__ const char* abase(const Unit& u) const { return (const char*)(A + (size_t)u.pm * 256 * lda); }
    __device__ __forceinline__ const char* bbase(const Unit& u) const { return (const char*)(B + ((size_t)(u.pn >> 4) * 4096 + (u.pn & 15)) * 1024); }
    __device__ __forceinline__ void avoff(const Unit&, const int (&RA)[2], const int (&CA)[2], unsigned (&v)[2][2]) const {
#pragma unroll
        for (int h = 0; h < 2; ++h)
#pragma unroll
            for (int i = 0; i < 2; ++i) v[h][i] = (unsigned)((h * 128 + RA[i]) * lda + CA[i]) * 2u;
    }
};
struct ProbMoeUp {
    static constexpr bool GATHER = true;
    const bf16_t* A; const bf16_t* B; const int* idx; int K, lda, ldb;
    __device__ __forceinline__ const char* abase(const Unit&) const { return (const char*)A; }
    __device__ __forceinline__ const char* bbase(const Unit& u) const { return (const char*)(B + ((size_t)(u.pm >> 4) * 3072 + (size_t)u.pn * 256) * ldb); }
    __device__ __forceinline__ void avoff(const Unit& u, const int (&RA)[2], const int (&CA)[2], unsigned (&v)[2][2]) const {
#pragma unroll
        for (int h = 0; h < 2; ++h)
#pragma unroll
            for (int i = 0; i < 2; ++i) { const int g = idx[u.pm * 256 + h * 128 + RA[i]]; v[h][i] = (unsigned)(g * lda + CA[i]) * 2u; }
    }
};
struct ProbMoeDown {
    static constexpr bool GATHER = false;
    const bf16_t* A; const bf16_t* B; int K, lda, ldb;
    __device__ __forceinline__ const char* abase(const Unit& u) const { return (const char*)(A + (size_t)u.pm * 256 * lda); }
    __device__ __forceinline__ const char* bbase(const Unit& u) const { return (const char*)(B + ((size_t)(u.pm >> 4) * 1024 + (size_t)u.pn * 256) * ldb); }
    __device__ __forceinline__ void avoff(const Unit&, const int (&RA)[2], const int (&CA)[2], unsigned (&v)[2][2]) const {
#pragma unroll
        for (int h = 0; h < 2; ++h)
#pragma unroll
            for (int i = 0; i < 2; ++i) v[h][i] = (unsigned)((h * 128 + RA[i]) * lda + CA[i]) * 2u;
    }
};

#define EPI_ROWS(...) _Pragma("unroll") for (int ai = 0; ai < 2; ++ai) _Pragma("unroll") for (int m = 0; m < 4; ++m) { const int row = u.pm * 256 + ai * 128 + wr * 64 + m * 16 + fr; __VA_ARGS__ }
__device__ __forceinline__ u32x4 pack8(const f32x4 v0, const f32x4 v1) { u32x4 w; w.x = cvt_pk_bf16(v0[0], v0[1]); w.y = cvt_pk_bf16(v0[2], v0[3]); w.z = cvt_pk_bf16(v1[0], v1[1]); w.w = cvt_pk_bf16(v1[2], v1[3]); return w; }

struct EpiPQ {
    static constexpr bool PERM = true; bf16_t* O;
    __device__ __forceinline__ void operator()(const f32x4 (&acc)[2][2][4][2], const Unit& u, int wr, int wc, int fr, int fq) const {
        const int t10 = wc * 32 + 8 * fq, b = u.pn >> 4, t2 = u.pn & 15;
        EPI_ROWS(
            bf16_t* rp = O + ((size_t)((b * 256 + (row >> 1)) * 16 + t2) * 512 + (row & 1) * 256 + t10);
            if (m == 0 && wr == 0 && fr == 1) {
                bf16_t* sp = O + ((size_t)(32768 + (b * 4 + (row >> 7)) * 16 + t2) * 512 + t10);
                _Pragma("unroll") for (int bj = 0; bj < 2; ++bj) { *(u32x4*)(sp + bj * 128) = pack8(acc[ai][bj][m][0], acc[ai][bj][m][1]); *(u32x4*)(sp + 256 + bj * 128) = (u32x4){0u, 0u, 0u, 0u}; *(u32x4*)(rp + bj * 128) = (u32x4){0u, 0u, 0u, 0u}; }
            } else {
                _Pragma("unroll") for (int bj = 0; bj < 2; ++bj) *(u32x4*)(rp + bj * 128) = pack8(acc[ai][bj][m][0], acc[ai][bj][m][1]);
            }
        )
    }
};
struct EpiPlain {
    static constexpr bool PERM = true; bf16_t* O; size_t ldc;
    __device__ __forceinline__ void operator()(const f32x4 (&acc)[2][2][4][2], const Unit& u, int wr, int wc, int fr, int fq) const {
        const int col0 = u.pn * 256 + wc * 32 + 8 * fq;
        EPI_ROWS(
            bf16_t* rp = O + (size_t)row * ldc + col0;
            _Pragma("unroll") for (int bj = 0; bj < 2; ++bj) *(u32x4*)(rp + bj * 128) = pack8(acc[ai][bj][m][0], acc[ai][bj][m][1]);
        )
    }
};
struct EpiZ {
    static constexpr bool PERM = true; bf16_t* O; int ldc; int fixed_act;
    __device__ __forceinline__ void operator()(const f32x4 (&acc)[2][2][4][2], const Unit& u, int wr, int wc, int fr, int fq) const {
        const int col0 = u.pn * 256 + wc * 32 + 8 * fq; const int act = fixed_act >= 0 ? fixed_act : (u.pn >> 2);
        if (act >= 2) {
            const int cg = (u.pn - 8) * 128 + wc * 32 + 8 * fq;
            EPI_ROWS(
                bf16_t* rp = O + (size_t)row * ldc + cg;
                f32x4 r0, r1, s0, s1;
                _Pragma("unroll") for (int j = 0; j < 4; ++j) {
                    const float ea0 = __builtin_amdgcn_exp2f(-1.4426950408889634f * acc[ai][0][m][0][j]), ea1 = __builtin_amdgcn_exp2f(-1.4426950408889634f * acc[ai][0][m][1][j]);
                    const float eb0 = fminf(__builtin_amdgcn_exp2f(-1.4426950408889634f * acc[ai][1][m][0][j]), 1e30f), eb1 = fminf(__builtin_amdgcn_exp2f(-1.4426950408889634f * acc[ai][1][m][1][j]), 1e30f);
                    s0[j] = __builtin_amdgcn_rcpf(1.0f + eb0); s1[j] = __builtin_amdgcn_rcpf(1.0f + eb1);
                    r0[j] = (1.0f + eb0) * __builtin_amdgcn_rcpf(1.0f + ea0); r1[j] = (1.0f + eb1) * __builtin_amdgcn_rcpf(1.0f + ea1); }
                *(u32x4*)(rp + 2048) = pack8(r0, r1); *(u32x4*)(rp + 3072) = pack8(s0, s1);
            )
            return;
        }
        EPI_ROWS(
            bf16_t* rp = O + (size_t)row * ldc + col0;
            _Pragma("unroll") for (int bj = 0; bj < 2; ++bj) {
                f32x4 v0 = acc[ai][bj][m][0], v1 = acc[ai][bj][m][1];
                if (act == 1) { _Pragma("unroll") for (int j = 0; j < 4; ++j) { v0[j] = gelu_tanh(v0[j]); v1[j] = gelu_tanh(v1[j]); } }
                *(u32x4*)(rp + bj * 128) = pack8(v0, v1); }
        )
    }
};
struct EpiMerge {
    static constexpr bool PERM = true; bf16_t* O; const bf16_t* Z;
    __device__ __forceinline__ void mid(f32x4 (&acc)[2][2][4][2], const Unit& u, int wr, int wc, int fr, int fq) const {
        unsigned eo = (unsigned)((u.pm * 256 + wr * 64 + fr) * 4096 + 2048 + u.pn * 256 + wc * 32 + 8 * fq);
        asm volatile("" : "+v"(eo));
#pragma unroll
        for (int ai = 0; ai < 2; ++ai) {
            u32x4 wa[4][2];
#pragma unroll
            for (int m = 0; m < 4; ++m)
#pragma unroll
                for (int bj = 0; bj < 2; ++bj) { const unsigned o = eo + (unsigned)((ai * 128 + m * 16) * 4096 + bj * 128); wa[m][bj] = __builtin_nontemporal_load((const u32x4*)(Z + o)); }
#pragma unroll
            for (int m = 0; m < 4; ++m)
#pragma unroll
                for (int bj = 0; bj < 2; ++bj) { float ga[8]; unpack8(wa[m][bj], ga);
#pragma unroll
                    for (int j = 0; j < 4; ++j) { acc[ai][bj][m][0][j] *= ga[j]; acc[ai][bj][m][1][j] *= ga[4 + j]; } }
            __builtin_amdgcn_sched_barrier(0); }
    }
    __device__ __forceinline__ void operator()(const f32x4 (&acc)[2][2][4][2], const Unit& u, int wr, int wc, int fr, int fq) const {
        unsigned eo = (unsigned)((u.pm * 256 + wr * 64 + fr) * 4096 + 3072 + u.pn * 256 + wc * 32 + 8 * fq); asm volatile("" : "+v"(eo));
        unsigned oo = (unsigned)((u.pm * 256 + wr * 64 + fr) * 1024 + u.pn * 256 + wc * 32 + 8 * fq); asm volatile("" : "+v"(oo));
        u32x4 wb[2][4][2];
#pragma unroll
        for (int ai = 0; ai < 2; ++ai)
#pragma unroll
            for (int m = 0; m < 4; ++m)
#pragma unroll
                for (int bj = 0; bj < 2; ++bj) wb[ai][m][bj] = __builtin_nontemporal_load((const u32x4*)(Z + eo + (unsigned)((ai * 128 + m * 16) * 4096 + bj * 128)));
#pragma unroll
        for (int ai = 0; ai < 2; ++ai)
#pragma unroll
            for (int m = 0; m < 4; ++m)
#pragma unroll
                for (int bj = 0; bj < 2; ++bj) { float g[8]; unpack8(wb[ai][m][bj], g);
                    f32x4 v0 = acc[ai][bj][m][0], v1 = acc[ai][bj][m][1];
#pragma unroll
                    for (int j = 0; j < 4; ++j) { v0[j] *= g[j]; v1[j] *= g[4 + j]; }
                    *(u32x4*)(O + oo + (unsigned)((ai * 128 + m * 16) * 1024 + bj * 128)) = pack8(v0, v1); }
    }
};
struct EpiOut {
    static constexpr bool PERM = true; bf16_t* O; const float* X; const float* pos; const float* ada;
    __device__ __forceinline__ void operator()(const f32x4 (&acc)[2][2][4][2], const Unit& u, int wr, int wc, int fr, int fq) const {
        const int col0 = u.pn * 256 + wc * 32 + 8 * fq; const int b = u.pm >> 4;
        unsigned ro = (unsigned)((u.pm * 256 + wr * 64 + fr) * 1024 + col0); asm volatile("" : "+v"(ro));
#pragma unroll
        for (int ai = 0; ai < 2; ++ai)
#pragma unroll
            for (int mh = 0; mh < 2; ++mh) {
                f32x4 xv[2][2][2];
#pragma unroll
                for (int m2 = 0; m2 < 2; ++m2)
#pragma unroll
                    for (int bj = 0; bj < 2; ++bj)
#pragma unroll
                        for (int n = 0; n < 2; ++n) xv[m2][bj][n] = __builtin_nontemporal_load((const f32x4*)(X + ro + (unsigned)((ai * 128 + (mh * 2 + m2) * 16) * 1024 + bj * 128 + n * 4)));
#pragma unroll
                for (int m2 = 0; m2 < 2; ++m2) { const int m = mh * 2 + m2; const int row = u.pm * 256 + ai * 128 + wr * 64 + m * 16 + fr; const int t = row & 4095;
#pragma unroll
                    for (int bj = 0; bj < 2; ++bj) { f32x4 o[2];
#pragma unroll
                        for (int n = 0; n < 2; ++n) { const int col = col0 + bj * 128 + n * 4;
                            const f32x4 pv = *(const f32x4*)(pos + (col < 512 ? (t >> 6) * 512 + col : (t & 63) * 512 + (col - 512)));
                            const f32x4 gv = *(const f32x4*)(ada + b * 6144 + 2048 + col);
                            o[n] = xv[m2][bj][n] + pv + gv * acc[ai][bj][m][n]; }
                        *(u32x4*)(O + ro + (unsigned)((ai * 128 + m * 16) * 1024 + bj * 128)) = pack8(o[0], o[1]); } }
                __builtin_amdgcn_sched_barrier(0); }
    }
};
struct EpiGU {
    static constexpr bool PERM = true; bf16_t* O;
    __device__ __forceinline__ void operator()(const f32x4 (&acc)[2][2][4][2], const Unit& u, int wr, int wc, int fr, int fq) const {
        const int col0 = u.pn * 128 + wc * 32 + 8 * fq;
        EPI_ROWS(
            f32x4 v0, v1;
            _Pragma("unroll") for (int j = 0; j < 4; ++j) { const float g0 = acc[ai][0][m][0][j], g1 = acc[ai][0][m][1][j];
                v0[j] = g0 * sigmoidf_(g0) * acc[ai][1][m][0][j]; v1[j] = g1 * sigmoidf_(g1) * acc[ai][1][m][1][j]; }
            *(u32x4*)(O + (size_t)row * DE + col0) = pack8(v0, v1);
        )
    }
};
struct EpiDown {
    static constexpr bool PERM = true; bf16_t* O; const float* gate;
    __device__ __forceinline__ void operator()(const f32x4 (&acc)[2][2][4][2], const Unit& u, int wr, int wc, int fr, int fq) const {
        const int col0 = u.pn * 256 + wc * 32 + 8 * fq;
        EPI_ROWS(
            const float g = gate[row];
            _Pragma("unroll") for (int bj = 0; bj < 2; ++bj) *(u32x4*)(O + (size_t)row * 1024 + col0 + bj * 128) = pack8(acc[ai][bj][m][0] * g, acc[ai][bj][m][1] * g);
        )
    }
};

__device__ __forceinline__ void p0_ada(const Params& p, LAS unsigned char* lds, int item) {
    const int tid = threadIdx.x, lane = tid & 63, wv = tid >> 6;
    LAS float* s = (LAS float*)lds; LAS float* red = s + 9 * 1024;
    { float cv[18];
#pragma unroll
      for (int k = 0; k < 18; ++k) { const int i = tid + NTHR * k, r = i >> 10, d = i & 1023; cv[k] = r < 8 ? p.c[r * 1024 + d] : p.c_ctx[d]; }
#pragma unroll
      for (int k = 0; k < 18; ++k) s[tid + NTHR * k] = cv[k] * __builtin_amdgcn_rcpf(1.0f + __expf(-cv[k])); }
    __syncthreads();
    const int col = lane % 24, dh = lane / 24;
    const int dsl = wv * 128 + dh * 64;
    float a[9];
#pragma unroll
    for (int r = 0; r < 9; ++r) a[r] = 0.f;
    if (dh < 2) {
        const float* w = p.w_ada + (size_t)dsl * 6144 + item * 24 + col;
        for (int d0 = 0; d0 < 64; d0 += 32) { float wv2[32];
#pragma unroll
            for (int j = 0; j < 32; ++j) wv2[j] = __builtin_nontemporal_load(w + (size_t)(d0 + j) * 6144);
#pragma unroll
            for (int j = 0; j < 32; ++j)
#pragma unroll
                for (int r = 0; r < 9; ++r) a[r] += s[r * 1024 + dsl + d0 + j] * wv2[j]; }
#pragma unroll
        for (int r = 0; r < 9; ++r) red[((wv * 2 + dh) * 9 + r) * 24 + col] = a[r];
    }
    __syncthreads();
    float* ada = (float*)(p.ws + WS_ADA);
    if (tid < 9 * 24) { const int r = tid / 24, cc = tid % 24; float v = 0.f;
#pragma unroll
        for (int k = 0; k < 16; ++k) v += red[(k * 9 + r) * 24 + cc];
        __hip_atomic_store(ada + r * 6144 + item * 24 + cc, v + p.b_ada[item * 24 + cc], __ATOMIC_RELAXED, __HIP_MEMORY_SCOPE_AGENT); }
    asm volatile("s_waitcnt vmcnt(0)" ::: "memory");
    __syncthreads();
    if (tid == 0) (void)__hip_atomic_fetch_add((unsigned*)(p.ws + WS_BAR + 46 * KiB), 1u, __ATOMIC_RELAXED, __HIP_MEMORY_SCOPE_AGENT);
}
template <int NS>
__device__ __forceinline__ void xpose_item(const float* src, int ldsrc, bf16_t* dst, int lddst, int k0, int n0, int mode, float scale = 1.0f) {
    const int tid = threadIdx.x, k8 = tid & 7, nq = tid >> 3;
    if (nq >= 16 * NS) return;
    f32x4 v[8];
#pragma unroll
    for (int j = 0; j < 8; ++j) v[j] = __builtin_nontemporal_load((const f32x4*)(src + (size_t)(k0 + 8 * k8 + j) * ldsrc + n0 + 4 * nq));
#pragma unroll
    for (int c = 0; c < 4; ++c) { const int n = n0 + 4 * nq + c; int row = n;
        if (mode) row = (n >> 7) * 256 + (n & 127) + (mode == 2 ? 128 : 0);
        u32x4 w; w.x = cvt_pk_bf16(v[0][c] * scale, v[1][c] * scale); w.y = cvt_pk_bf16(v[2][c] * scale, v[3][c] * scale); w.z = cvt_pk_bf16(v[4][c] * scale, v[5][c] * scale); w.w = cvt_pk_bf16(v[6][c] * scale, v[7][c] * scale);
        *(u32x4*)(dst + (size_t)row * lddst + k0 + 8 * k8) = w; }
}
__device__ __forceinline__ void p0_wpq(const Params& p, LAS unsigned char* lds, int item) {
    const int tid = threadIdx.x, g = item >> 5, db = item & 31;
    LAS float* wl = (LAS float*)lds; LAS float* ct = wl + 32 * 129;
    for (int i = tid; i < 32 * 128; i += NTHR) { const int d = i >> 7, cc = i & 127; wl[d * 129 + cc] = p.w_in[(size_t)(db * 32 + d) * 4608 + g * 128 + cc]; }
    if (tid < 128) { float sn, cs; sincospif((float)tid * (1.0f / 64.0f), &sn, &cs); ct[tid] = cs; ct[128 + tid] = sn; }
    __syncthreads();
    const int q = tid & 127, kc = q >> 1, pq = q & 1, dh = tid >> 7; const int n = (g * 64 + kc) * 2 + pq;
    const bool spec = (kc == 0 && pq == 1); const int kce = spec ? 64 : kc, tsel = spec ? 0 : pq * 128;
    bf16_t* dst = (bf16_t*)(p.ws + WS_WPQ) + (size_t)n * 1024 + db * 32 + dh * 8;
    const float scale = 0.001381067932f;
    float a[8];
#pragma unroll
    for (int j = 0; j < 8; ++j) a[j] = 0.f;
    for (int cc = 0; cc < 128; ++cc) { const float tv = ct[tsel + ((cc * kce) & 127)];
#pragma unroll
        for (int j = 0; j < 8; ++j) a[j] += wl[(dh * 8 + j) * 129 + cc] * tv; }
    u32x4 w; w.x = cvt_pk_bf16(a[0] * scale, a[1] * scale); w.y = cvt_pk_bf16(a[2] * scale, a[3] * scale); w.z = cvt_pk_bf16(a[4] * scale, a[5] * scale); w.w = cvt_pk_bf16(a[6] * scale, a[7] * scale);
    *(u32x4*)dst = w;
    __syncthreads();
}
__device__ __forceinline__ void p0_d1t(const Params& p, int item) {
    bf16_t* dst = (bf16_t*)(p.ws + WS_D1T);
    const int row = item * 64 + (threadIdx.x >> 3), k1 = row >> 1, ri = row & 1, c0 = (threadIdx.x & 7) * 64;
    for (int c8 = 0; c8 < 64; c8 += 8) { float v[8];
#pragma unroll
        for (int j = 0; j < 8; ++j) { const int col = c0 + c8 + j, pq = col >> 8, t1 = col & 255; float sn, cs; sincospif((float)((k1 * t1) & 255) * (1.0f / 128.0f), &sn, &cs);
            v[j] = (ri == 0) ? (pq == 0 ? cs : -sn) : (pq == 0 ? -sn : -cs); }
        u32x4 w; w.x = cvt_pk_bf16(v[0], v[1]); w.y = cvt_pk_bf16(v[2], v[3]); w.z = cvt_pk_bf16(v[4], v[5]); w.w = cvt_pk_bf16(v[6], v[7]);
        *(u32x4*)(dst + (size_t)row * 512 + c0 + c8) = w; }
}
__device__ __forceinline__ void p0_d2t(const Params& p, int item) {
    bf16_t* dst = (bf16_t*)(p.ws + WS_D2T);
#pragma unroll
    for (int ps = 0; ps < 4; ++ps) { const int pc = (item * 4 + ps) * NTHR + threadIdx.x, tp = pc >> 2, kk0 = (pc & 3) * 8; float v[8];
#pragma unroll
        for (int j = 0; j < 8; ++j) { const int kk = kk0 + j, ri = kk >> 4, t2 = kk & 15; float sn, cs; sincospif((float)((tp * t2) & 4095) * (1.0f / 2048.0f), &sn, &cs); v[j] = ri ? sn : cs; }
        u32x4 w; w.x = cvt_pk_bf16(v[0], v[1]); w.y = cvt_pk_bf16(v[2], v[3]); w.z = cvt_pk_bf16(v[4], v[5]); w.w = cvt_pk_bf16(v[6], v[7]);
        *(u32x4*)(dst + (size_t)tp * 32 + kk0) = w; }
}
__device__ __forceinline__ void p0_pos(const Params& p, int item) {
    float* tab = (float*)(p.ws + WS_POS);
    for (int i = item * 2048 + threadIdx.x; i < (item + 1) * 2048; i += NTHR) { const int ii = i >> 9, j = i & 511, jj = j & 255; const float f = expf(-9.210340371976184f * (float)jj / 256.0f); const float a = (float)ii * f;
        __hip_atomic_store(tab + i, j < 256 ? sinf(a) : cosf(a), __ATOMIC_RELAXED, __HIP_MEMORY_SCOPE_AGENT); }
    asm volatile("s_waitcnt vmcnt(0)" ::: "memory");
    __syncthreads();
    if (threadIdx.x == 0) (void)__hip_atomic_fetch_add((unsigned*)(p.ws + WS_BAR + 46 * KiB), 1u, __ATOMIC_RELAXED, __HIP_MEMORY_SCOPE_AGENT);
}
__device__ __forceinline__ void phase0(const Params& p, LAS unsigned char* lds) {
    constexpr int N_ADA = 256, N_WIN = 16 * 16, N_WFOUR = 8 * 4, N_SQ = 16 * 4, N_LRU = 16 * 2, N_WPQ = 128, N_DFT = 8 + 8, N_POS = 16;
    constexpr int O1 = N_ADA, O2 = O1 + N_WIN, O3 = O2 + N_WFOUR, O4 = O3 + N_SQ, O5 = O4 + N_SQ, O6 = O5 + N_LRU, O7 = O6 + N_LRU, O8 = O7 + N_WPQ, O9 = O8 + N_DFT, O10 = O9 + N_POS;
    for (int it0 = blockIdx.x; it0 < O10; it0 += gridDim.x) {
        if (it0 < O1) { p0_ada(p, lds, it0); continue; }
        if (it0 < O1 + N_POS) { p0_pos(p, it0 - O1); continue; }
        const int it = it0 - N_POS;
        if (it < O2) { const int j = it - O1, ct = j & 15;
            if (ct < 8) xpose_item<4>(p.w_in + 512, 4608, (bf16_t*)(p.ws + WS_WIN), 1024, (j >> 4) * 64, ct * 256, 0);
            else if (ct < 12) xpose_item<4>(p.w_in + 512 + 2048, 4608, (bf16_t*)(p.ws + WS_WIN) + (size_t)2048 * 1024, 1024, (j >> 4) * 64, (ct - 8) * 256, 1);
            else xpose_item<4>(p.w_in + 512 + 3072, 4608, (bf16_t*)(p.ws + WS_WIN) + (size_t)2048 * 1024, 1024, (j >> 4) * 64, (ct - 12) * 256, 2); }
        else if (it < O3) { const int j = it - O2; xpose_item<4>(p.w_four, 1024, (bf16_t*)(p.ws + WS_WFOUR), 512, (j >> 2) * 64, (j & 3) * 256, 0); }
        else if (it < O4) { const int j = it - O3; xpose_item<4>(p.w_lru, 1024, (bf16_t*)(p.ws + WS_WLRU), 1024, (j >> 2) * 64, (j & 3) * 256, 0); }
        else if (it < O5) { const int j = it - O4; xpose_item<4>(p.w_out, 1024, (bf16_t*)(p.ws + WS_WOUT), 1024, (j >> 2) * 64, (j & 3) * 256, 0); }
        else if (it < O6) { const int j = it - O5, mtx = j >> 1; xpose_item<2>(p.lru_wa + (size_t)mtx * 16384, 128, (bf16_t*)(p.ws + WS_WAT) + (size_t)mtx * 16384, 128, (j & 1) * 64, 0, 0, NLOG2E); }
        else if (it < O7) { const int j = it - O6, mtx = j >> 1; xpose_item<2>(p.lru_wi + (size_t)mtx * 16384, 128, (bf16_t*)(p.ws + WS_WIT) + (size_t)mtx * 16384, 128, (j & 1) * 64, 0, 0, NLOG2E); }
        else if (it < O8) p0_wpq(p, lds, it - O7);
        else { if (it - O8 < 8) p0_d1t(p, it - O8); else p0_d2t(p, it - O8 - 8); }
    }
}

__device__ __forceinline__ void phase1(const Params& p) {
    const int tid = tid_opaque(), lane = tid & 63, wid = tid >> 6;
    const float* ada = (const float*)(p.ws + WS_ADA); const float* tab = (const float*)(p.ws + WS_POS);
    bf16_t* h1 = (bf16_t*)(p.ws + WS_R1); bf16_t* hc = (bf16_t*)(p.ws + WS_HCTX);
    constexpr int NR = MLAT + MCTX, RW = 4;
    for (int row0 = (blockIdx.x * 8 + wid) * RW; row0 < NR; row0 += gridDim.x * 8 * RW) {
        const bool lat = row0 < MLAT; const int mrow = lat ? (row0 >> 12) : 8;
        f32x4 v[RW][4]; float ss[RW];
#pragma unroll
        for (int r = 0; r < RW; ++r) { const int row = row0 + r; const float* xr = lat ? p.x + (size_t)row * 1024 : p.ctx + (size_t)(row - MLAT) * 1024;
#pragma unroll
            for (int i = 0; i < 4; ++i) v[r][i] = __builtin_nontemporal_load((const f32x4*)(xr + 256 * i + 4 * lane)); }
#pragma unroll
        for (int r = 0; r < RW; ++r) { const int t = (row0 + r) & 4095; float a = 0.f;
#pragma unroll
            for (int i = 0; i < 4; ++i) { const int d = 256 * i + 4 * lane;
                if (lat) v[r][i] += *(const f32x4*)(tab + (i < 2 ? (t >> 6) * 512 + d : (t & 63) * 512 + d - 512));
                a += v[r][i][0] * v[r][i][0] + v[r][i][1] * v[r][i][1] + v[r][i][2] * v[r][i][2] + v[r][i][3] * v[r][i][3]; }
            ss[r] = a; }
#pragma unroll
        for (int o = 32; o >= 1; o >>= 1) {
#pragma unroll
            for (int r = 0; r < RW; ++r) ss[r] += __shfl_xor(ss[r], o); }
#pragma unroll
        for (int i = 0; i < 4; ++i) { const int d = 256 * i + 4 * lane;
            const f32x4 g = *(const f32x4*)(p.norm1_g + d), sh = *(const f32x4*)(ada + mrow * 6144 + d), sc = *(const f32x4*)(ada + mrow * 6144 + 1024 + d);
#pragma unroll
            for (int r = 0; r < RW; ++r) { const int row = row0 + r; const float rs = rsqrtf(ss[r] * (1.0f / 1024.0f) + 1e-6f);
                bf16_t* dst = lat ? h1 + (size_t)row * 1024 : hc + (size_t)(row - MLAT) * 1024;
                const f32x4 h = v[r][i] * rs * g * (sc + 1.0f) + sh;
                u32x2 w; w.x = cvt_pk_bf16(h[0], h[1]); w.y = cvt_pk_bf16(h[2], h[3]); *(u32x2*)(dst + d) = w; } }
    }
}

#define LRU_CST(mb, r) (32 * (mb) + 8 * ((r) >> 2) + ((r) & 3))
template <bool FINAL, int DIR>
__device__ __forceinline__ void lru_wave(const Params& p, LAS unsigned char* ul, int b, int sc, int head, int cb, int lane, f32x16 (&accI)[4]) {
    constexpr int SG = DIR ? -1 : 1;
    const int lr = lane & 31, lh = lane >> 5;
    const int chl = cb * 32 + lr, ch = head * 128 + chl;
    const int tbase = DIR ? 127 - 4 * lh : 4 * lh;
    f32x16 accA[4];
#pragma unroll
    for (int mb = 0; mb < 4; ++mb)
#pragma unroll
        for (int r = 0; r < 16; ++r) { accA[mb][r] = 0.f; accI[mb][r] = 0.f; }
    {
        const bf16_t* wa = (const bf16_t*)(p.ws + WS_WAT) + ((size_t)(DIR * 8 + head) * 128 + chl) * 128 + 8 * lh;
        const bf16_t* wi = (const bf16_t*)(p.ws + WS_WIT) + ((size_t)(DIR * 8 + head) * 128 + chl) * 128 + 8 * lh;
        LAS unsigned char* arow0 = ul + (DIR ? 127 - lr : lr) * 272 + lh * 16;
#pragma unroll
        for (int kc = 0; kc < 2; ++kc) { bf16x8 bA[4], bI[4];
#pragma unroll
            for (int k4 = 0; k4 < 4; ++k4) { bA[k4] = *(const bf16x8*)(wa + 16 * (kc * 4 + k4)); bI[k4] = *(const bf16x8*)(wi + 16 * (kc * 4 + k4)); }
#pragma unroll
            for (int mb = 0; mb < 4; ++mb)
#pragma unroll
                for (int k4 = 0; k4 < 4; ++k4) { const bf16x8 af = *(const LAS bf16x8*)(arow0 + SG * 32 * mb * 272 + 32 * (kc * 4 + k4));
                    accA[mb] = __builtin_amdgcn_mfma_f32_32x32x16_bf16(af, bA[k4], accA[mb], 0, 0, 0);
                    accI[mb] = __builtin_amdgcn_mfma_f32_32x32x16_bf16(af, bI[k4], accI[mb], 0, 0, 0); }
            __builtin_amdgcn_sched_barrier(0); }
    }
    {
        const float lam = p.lru_lambda[DIR * 1024 + ch]; const float sp8 = 8.0f * log1pf(expf(-lam));
        const float ba = p.lru_ba[DIR * 1024 + ch], bi = p.lru_bi[DIR * 1024 + ch];
        LAS unsigned char* up = ul + tbase * 272 + chl * 2;
#pragma unroll
        for (int mb = 0; mb < 4; ++mb) {
#pragma unroll
            for (int r = 0; r < 16; ++r) {
                const float uv = bf2f(*(const LAS bf16_t*)(up + SG * LRU_CST(mb, r) * 272));
                const float rg = __builtin_amdgcn_rcpf(1.0f + __builtin_amdgcn_exp2f(accA[mb][r] + NLOG2E * ba)), ig = __builtin_amdgcn_rcpf(1.0f + __builtin_amdgcn_exp2f(accI[mb][r] + NLOG2E * bi));
                const float a = __expf(-sp8 * rg); accA[mb][r] = a; accI[mb][r] = __builtin_amdgcn_sqrtf(fmaxf(1.0f - a * a, 0.f)) * ig * uv; }
            __builtin_amdgcn_sched_barrier(0); }
    }
    float rA[16], rH[16];
#pragma unroll
    for (int mb = 0; mb < 4; ++mb)
#pragma unroll
        for (int q = 0; q < 4; ++q) { float pa = 1.f, hh = 0.f;
#pragma unroll
            for (int j = 0; j < 4; ++j) { const int r = 4 * q + j; const float a = accA[mb][r], bb = accI[mb][r]; hh = a * hh + bb; pa *= a; accA[mb][r] = pa; accI[mb][r] = hh; }
            rA[mb * 4 + q] = pa; rH[mb * 4 + q] = hh; }
    const int agg_dir_off = ((b * NSEQ) * 2 + DIR) * 1024 + ch;
    const float* agg = (const float*)(p.ws + WS_AGG);
    float carry = 0.f;
    if (FINAL) {
        if (DIR == 0) { for (int q = 0; q < sc; ++q) { const float* a2 = agg + (size_t)(agg_dir_off + q * 2048) * 2; carry = a2[0] * carry + a2[1]; } }
        else { { const float* a2 = agg + (size_t)(agg_dir_off + 1 * 2048) * 2; carry = a2[0] * carry + a2[1]; } { const float* a2 = agg + (size_t)(agg_dir_off + 0 * 2048) * 2; carry = a2[0] * carry + a2[1]; }
            for (int q = NSEQ - 1; q > sc; --q) { const float* a2 = agg + (size_t)(agg_dir_off + q * 2048) * 2; carry = a2[0] * carry + a2[1]; } }
    }
    float cin[16];
#pragma unroll
    for (int i = 0; i < 16; ++i) cin[i] = 0.f;
    float s = carry, At = 1.f;
#pragma unroll
    for (int i = 0; i < 16; ++i) { const float oA = __shfl_xor(rA[i], 32), oH = __shfl_xor(rH[i], 32);
        { const bool mine = (lh == 0); const float a = mine ? rA[i] : oA, hh = mine ? rH[i] : oH; cin[i] = mine ? s : cin[i]; s = a * s + hh; At *= a; }
        { const bool mine = (lh == 1); const float a = mine ? rA[i] : oA, hh = mine ? rH[i] : oH; cin[i] = mine ? s : cin[i]; s = a * s + hh; At *= a; } }
    if (!FINAL) {
        if (lh == 0) { float* o = (float*)(p.ws + WS_AGG) + (size_t)(agg_dir_off + sc * 2048) * 2; o[0] = At; o[1] = s; }
        return;
    }
#pragma unroll
    for (int mb = 0; mb < 4; ++mb)
#pragma unroll
        for (int r = 0; r < 16; ++r) accI[mb][r] += accA[mb][r] * cin[mb * 4 + (r >> 2)];
}
template <bool FINAL>
__device__ __forceinline__ void lru_tile(const Params& p, LAS unsigned char* lds, int item) {
    const int tid = threadIdx.x, lane = tid & 63, wid = __builtin_amdgcn_readfirstlane(tid >> 6);
    int b, sc, head;
    if (FINAL) { head = item & 7; sc = 2 + ((item >> 3) & 31); b = item >> 8; }
    else { head = item & 7; const int r = item >> 3; sc = r & 1; b = r >> 1; }
    const bf16_t* src; int Tseq, t0, ld;
    if (sc < 2) { src = (const bf16_t*)(p.ws + WS_ZXC) + (size_t)b * 256 * 1024; Tseq = 256; t0 = sc * 128; ld = 1024; }
    else { src = (const bf16_t*)(p.ws + WS_RZ) + (size_t)b * 4096 * 4096; Tseq = 4096; t0 = (sc - 2) * 128; ld = 4096; }
    LAS unsigned char* ul = lds;
    LAS float* ybuf = (LAS float*)(lds + 36 * 1024);
    {
        const int c8 = tid & 15, tb = tid >> 4; const int ch0 = head * 128 + 8 * c8;
        float w[4][8], bias[8];
#pragma unroll
        for (int k = 0; k < 4; ++k) { const f32x4 a = *(const f32x4*)(p.conv_w + k * 1024 + ch0), c2 = *(const f32x4*)(p.conv_w + k * 1024 + ch0 + 4);
#pragma unroll
            for (int j = 0; j < 4; ++j) { w[k][j] = a[j]; w[k][4 + j] = c2[j]; } }
        { const f32x4 a = *(const f32x4*)(p.conv_b + ch0), c2 = *(const f32x4*)(p.conv_b + ch0 + 4);
#pragma unroll
            for (int j = 0; j < 4; ++j) { bias[j] = a[j]; bias[4 + j] = c2[j]; } }
#pragma unroll
        for (int i = 0; i < 4; ++i) { const int t = tb + 32 * i; float a[8];
#pragma unroll
            for (int j = 0; j < 8; ++j) a[j] = bias[j];
#pragma unroll
            for (int k = 0; k < 4; ++k) { const int tt = t0 + t + k - 2;
                if (tt >= 0 && tt < Tseq) { float f[8]; unpack8(*(const u32x4*)(src + (size_t)tt * ld + ch0), f);
#pragma unroll
                    for (int j = 0; j < 8; ++j) a[j] += w[k][j] * f[j]; } }
            u32x4 wv; wv.x = cvt_pk_bf16(a[0], a[1]); wv.y = cvt_pk_bf16(a[2], a[3]); wv.z = cvt_pk_bf16(a[4], a[5]); wv.w = cvt_pk_bf16(a[6], a[7]);
            *(LAS u32x4*)(ul + t * 272 + c8 * 16) = wv; }
    }
    __syncthreads();
    f32x16 hacc[4];
    if (wid < 4) lru_wave<FINAL, 0>(p, ul, b, sc, head, wid & 3, lane, hacc);
    else lru_wave<FINAL, 1>(p, ul, b, sc, head, wid & 3, lane, hacc);
    if (FINAL) {
        const int lr = lane & 31, lh = lane >> 5, chl = (wid & 3) * 32 + lr;
        if (wid >= 4) { LAS float* yp = ybuf + (127 - 4 * lh) * 129 + chl;
#pragma unroll
            for (int mb = 0; mb < 4; ++mb)
#pragma unroll
                for (int r = 0; r < 16; ++r) yp[-LRU_CST(mb, r) * 129] = hacc[mb][r]; }
        __syncthreads();
        if (wid < 4) {
            const LAS float* yp = ybuf + (4 * lh) * 129 + chl;
            const bf16_t* Zu = (const bf16_t*)(p.ws + WS_RZ) + ((size_t)(b * 4096 + t0) * 4096 + 1024 + head * 128);
            bf16_t* Ou = (bf16_t*)(p.ws + WS_R1) + ((size_t)(b * 4096 + t0) * 1024 + head * 128);
            const unsigned zo = (unsigned)(4 * lh * 4096 + chl), oo = (unsigned)(4 * lh * 1024 + chl);
#pragma unroll
            for (int mb = 0; mb < 4; ++mb) {
#pragma unroll
                for (int r = 0; r < 16; ++r) {
                    const float y = hacc[mb][r] + yp[LRU_CST(mb, r) * 129];
                    const float gz = bf2f(Zu[zo + LRU_CST(mb, r) * 4096]);
                    Ou[oo + LRU_CST(mb, r) * 1024] = (bf16_t)(cvt_pk_bf16(gz * y, 0.f) & 0xffffu);
                    if ((r & 7) == 7) __builtin_amdgcn_sched_barrier(0); } }
        }
    }
    __syncthreads();
}

#ifndef LRU_PF_FRAG
#define LRU_PF_FRAG true
#endif
#ifndef LRU_PF_TILE
#define LRU_PF_TILE true
#endif
template <int DIR, bool PREF>
__device__ __forceinline__ void lru2_dir(const Params& p, LAS unsigned char* ul, int head, int w, int lane, const bf16x8 (&bA)[4], const bf16x8 (&bI)[4], bf16x8 (&nA)[4], bf16x8 (&nI)[4],
                                         f32x4 (&hl)[8], f32x4 (&pp)[8], float& Atot, float& Htot) {
    constexpr int SG = DIR ? -1 : 1;
    const int fr = lane & 15, fq = lane >> 4, chl = 16 * w + fr, ch = head * 128 + chl;
    f32x4 accA[8], accI[8];
    { const float ba2 = NLOG2E * p.lru_ba[DIR * 1024 + ch], bi2 = NLOG2E * p.lru_bi[DIR * 1024 + ch];
#pragma unroll
      for (int rb = 0; rb < 8; ++rb) { accA[rb] = (f32x4){ba2, ba2, ba2, ba2}; accI[rb] = (f32x4){bi2, bi2, bi2, bi2}; } }
    {
        LAS unsigned char* arow0 = ul + (DIR ? 127 - fr : fr) * 272 + fq * 16;
#pragma unroll
        for (int rb = 0; rb < 8; ++rb)
#pragma unroll
            for (int ks = 0; ks < 4; ++ks) { const bf16x8 af = *(const LAS bf16x8*)(arow0 + SG * 16 * rb * 272 + 64 * ks);
                accA[rb] = __builtin_amdgcn_mfma_f32_16x16x32_bf16(af, bA[ks], accA[rb], 0, 0, 0);
                accI[rb] = __builtin_amdgcn_mfma_f32_16x16x32_bf16(af, bI[ks], accI[rb], 0, 0, 0); }
    }
    if (PREF) {
        const bf16_t* wa = (const bf16_t*)(p.ws + WS_WAT) + ((size_t)((1 - DIR) * 8 + head) * 128 + chl) * 128 + 8 * fq;
        const bf16_t* wi = (const bf16_t*)(p.ws + WS_WIT) + ((size_t)((1 - DIR) * 8 + head) * 128 + chl) * 128 + 8 * fq;
#pragma unroll
        for (int ks = 0; ks < 4; ++ks) { nA[ks] = *(const bf16x8*)(wa + 32 * ks); nI[ks] = *(const bf16x8*)(wi + 32 * ks); }
    }
    {
        typedef float f32x2 __attribute__((ext_vector_type(2)));
        const float lam = p.lru_lambda[DIR * 1024 + ch]; const float k2 = NLOG2E * 8.0f * log1pf(expf(-lam));
        LAS unsigned char* up = ul + (DIR ? 127 - 4 * fq : 4 * fq) * 272 + chl * 2;
#pragma unroll
        for (int rb = 0; rb < 8; ++rb)
#pragma unroll
            for (int r = 0; r < 4; r += 2) {
                f32x2 uv; uv.x = bf2f(*(const LAS bf16_t*)(up + SG * (16 * rb + r) * 272)); uv.y = bf2f(*(const LAS bf16_t*)(up + SG * (16 * rb + r + 1) * 272));
                f32x2 ea, ei; ea.x = __builtin_amdgcn_exp2f(accA[rb][r]); ea.y = __builtin_amdgcn_exp2f(accA[rb][r + 1]); ei.x = __builtin_amdgcn_exp2f(accI[rb][r]); ei.y = __builtin_amdgcn_exp2f(accI[rb][r + 1]);
                const f32x2 da = ea + 1.0f, di = ei + 1.0f;
                f32x2 rg, ig; rg.x = __builtin_amdgcn_rcpf(da.x); rg.y = __builtin_amdgcn_rcpf(da.y); ig.x = __builtin_amdgcn_rcpf(di.x); ig.y = __builtin_amdgcn_rcpf(di.y);
                const f32x2 ka = rg * k2;
                f32x2 a; a.x = __builtin_amdgcn_exp2f(ka.x); a.y = __builtin_amdgcn_exp2f(ka.y);
                const f32x2 om = 1.0f - a * a;
                f32x2 sq; sq.x = __builtin_amdgcn_sqrtf(om.x); sq.y = __builtin_amdgcn_sqrtf(om.y);
                const f32x2 bb = sq * ig * uv;
                accA[rb][r] = a.x; accA[rb][r + 1] = a.y; accI[rb][r] = bb.x; accI[rb][r + 1] = bb.y; }
    }
    float rA[8], rH[8];
#pragma unroll
    for (int rb = 0; rb < 8; ++rb) { float pa = 1.f, hh = 0.f;
#pragma unroll
        for (int r = 0; r < 4; ++r) { const float a = accA[rb][r], bb = accI[rb][r]; hh = a * hh + bb; pa *= a; accA[rb][r] = pa; accI[rb][r] = hh; }
        rA[rb] = pa; rH[rb] = hh; }
    float Pc = 1.f, s = 0.f;
#pragma unroll
    for (int rb = 0; rb < 8; ++rb) { float Pin = 1.f, Hin = 0.f;
#pragma unroll
        for (int q = 0; q < 4; ++q) { const float a = __shfl(rA[rb], fr + 16 * q), hh = __shfl(rH[rb], fr + 16 * q);
            if (q == fq) { Pin = Pc; Hin = s; }
            s = a * s + hh; Pc *= a; }
#pragma unroll
        for (int r = 0; r < 4; ++r) { hl[rb][r] = accI[rb][r] + accA[rb][r] * Hin; pp[rb][r] = accA[rb][r] * Pin; }
        __builtin_amdgcn_sched_barrier(0); }
    Atot = Pc; Htot = s;
}
__device__ __forceinline__ u64_t agg_ld(const u64_t* a) { return __hip_atomic_load(a, __ATOMIC_RELAXED, __HIP_MEMORY_SCOPE_AGENT); }
template <int DIR>
__device__ __forceinline__ float lru2_carry(const u64_t* aggc, int n, int fr, int fq) {
    float Ap = 1.f, Hp = 0.f; u64_t v[9];
#pragma unroll
    for (int k = 0; k < 9; ++k) { const int j = fq * 9 + k; const int seq = DIR ? (j == 0 ? 1 : (j == 1 ? 0 : 35 - j)) : j;
        v[k] = (j < n) ? agg_ld(aggc + (size_t)seq * 2048) : 0x000000003f800000ull; }
#pragma unroll
    for (int k = 0; k < 9; ++k) { const float a = __uint_as_float((unsigned)v[k]), hh = __uint_as_float((unsigned)(v[k] >> 32)); Hp = a * Hp + hh; Ap *= a; }
    float s = 0.f;
#pragma unroll
    for (int q = 0; q < 4; ++q) { const float a = __shfl(Ap, fr + 16 * q), hh = __shfl(Hp, fr + 16 * q); s = a * s + hh; }
    return s;
}
__device__ __forceinline__ void lru2_block(const Params& p, LAS unsigned char* lds, int slot, int c, int ngr) {
    const int tid = threadIdx.x, lane = tid & 63, wid = __builtin_amdgcn_readfirstlane(tid >> 6);
    const int sc = c + 2, t0 = c * 128;
    LAS unsigned char* raw = lds;
    LAS unsigned char* ul = lds + 33792;
    LAS unsigned char* gzl = lds + 68608;
    LAS unsigned char* outl = lds + 103424;
    const int fr = lane & 15, fq = lane >> 4, chl = 16 * wid + fr;
    u32x4 nr[5], ng[4];
#define LRU2_LOAD_R(gg) do { const bf16_t* Zb_ = (const bf16_t*)(p.ws + WS_RZ) + (size_t)((gg) >> 3) * 4096 * 4096 + ((gg) & 7) * 128; \
        _Pragma("unroll") for (int k = 0; k < 5; ++k) { const int pc = tid + NTHR * k; nr[k] = (u32x4){0u, 0u, 0u, 0u}; \
            if (pc < 131 * 16) { const int row = pc >> 4, c8 = pc & 15, tt = t0 - 2 + row; if (tt >= 0 && tt < TT) nr[k] = __builtin_nontemporal_load((const u32x4*)(Zb_ + (size_t)tt * 4096 + c8 * 8)); } } } while (0)
#define LRU2_LOAD_G(gg) do { const bf16_t* Zb_ = (const bf16_t*)(p.ws + WS_RZ) + (size_t)((gg) >> 3) * 4096 * 4096 + ((gg) & 7) * 128; \
        _Pragma("unroll") for (int k = 0; k < 4; ++k) { const int pc = tid + NTHR * k, row = pc >> 4, c8 = pc & 15; ng[k] = __builtin_nontemporal_load((const u32x4*)(Zb_ + (size_t)(t0 + row) * 4096 + 1024 + c8 * 8)); } } while (0)
    LRU2_LOAD_R(slot); LRU2_LOAD_G(slot);
    for (int g = slot; g < NB * 8; g += ngr) {
        const int b = g >> 3, head = g & 7, ch = head * 128 + chl;
        unsigned* gcnt = (unsigned*)(p.ws + WS_BAR + 16 * KiB) + g * 64;
        bf16x8 bA1[4], bI1[4], bA0[4], bI0[4];
        { const bf16_t* wa = (const bf16_t*)(p.ws + WS_WAT) + ((size_t)(8 + head) * 128 + chl) * 128 + 8 * fq; const bf16_t* wi = (const bf16_t*)(p.ws + WS_WIT) + ((size_t)(8 + head) * 128 + chl) * 128 + 8 * fq;
#pragma unroll
          for (int ks = 0; ks < 4; ++ks) { bA1[ks] = *(const bf16x8*)(wa + 32 * ks); bI1[ks] = *(const bf16x8*)(wi + 32 * ks); } }
#pragma unroll
        for (int k = 0; k < 5; ++k) { const int pc = tid + NTHR * k; if (pc < 131 * 16) *(LAS u32x4*)(raw + (pc >> 4) * 256 + (pc & 15) * 16) = nr[k]; }
#pragma unroll
        for (int k = 0; k < 4; ++k) { const int pc = tid + NTHR * k; *(LAS u32x4*)(gzl + (pc >> 4) * 272 + (pc & 15) * 16) = ng[k]; }
        __syncthreads();
        {
            const int c8 = tid & 15, tb = tid >> 4; const int ch0 = head * 128 + 8 * c8;
            float w[4][8], bias[8];
#pragma unroll
            for (int k = 0; k < 4; ++k) { const f32x4 a = *(const f32x4*)(p.conv_w + k * 1024 + ch0), c2 = *(const f32x4*)(p.conv_w + k * 1024 + ch0 + 4);
#pragma unroll
                for (int j = 0; j < 4; ++j) { w[k][j] = a[j]; w[k][4 + j] = c2[j]; } }
            { const f32x4 a = *(const f32x4*)(p.conv_b + ch0), c2 = *(const f32x4*)(p.conv_b + ch0 + 4);
#pragma unroll
                for (int j = 0; j < 4; ++j) { bias[j] = a[j]; bias[4 + j] = c2[j]; } }
#pragma unroll
            for (int i = 0; i < 4; ++i) { const int t = tb + 32 * i; float a[8];
#pragma unroll
                for (int j = 0; j < 8; ++j) a[j] = bias[j];
#pragma unroll
                for (int k = 0; k < 4; ++k) { float f[8]; unpack8(*(const LAS u32x4*)(raw + (t + k) * 256 + c8 * 16), f);
#pragma unroll
                    for (int j = 0; j < 8; ++j) a[j] += w[k][j] * f[j]; }
                u32x4 wv; wv.x = cvt_pk_bf16(a[0], a[1]); wv.y = cvt_pk_bf16(a[2], a[3]); wv.z = cvt_pk_bf16(a[4], a[5]); wv.w = cvt_pk_bf16(a[6], a[7]);
                *(LAS u32x4*)(ul + t * 272 + c8 * 16) = wv; }
        }
        __syncthreads();
        float A0, H0, A1, H1;
        {
            f32x4 hl1[8], pp1[8];
            lru2_dir<1, LRU_PF_FRAG>(p, ul, head, wid, lane, bA1, bI1, bA0, bI0, hl1, pp1, A1, H1);
            LAS unsigned char* hp = outl + chl * 264 + (124 - 4 * fq) * 2; LAS unsigned char* qp = raw + chl * 264 + (124 - 4 * fq) * 2;
#pragma unroll
            for (int rb = 0; rb < 8; ++rb) { u32x2 wh, wq; wh.x = cvt_pk_bf16(hl1[rb][3], hl1[rb][2]); wh.y = cvt_pk_bf16(hl1[rb][1], hl1[rb][0]); wq.x = cvt_pk_bf16(pp1[rb][3], pp1[rb][2]); wq.y = cvt_pk_bf16(pp1[rb][1], pp1[rb][0]);
                *(LAS u32x2*)(hp - 32 * rb) = wh; *(LAS u32x2*)(qp - 32 * rb) = wq; }
        }
        __builtin_amdgcn_sched_barrier(0);
        if (!LRU_PF_FRAG) { const bf16_t* wa = (const bf16_t*)(p.ws + WS_WAT) + ((size_t)(head) * 128 + chl) * 128 + 8 * fq; const bf16_t* wi = (const bf16_t*)(p.ws + WS_WIT) + ((size_t)(head) * 128 + chl) * 128 + 8 * fq;
#pragma unroll
          for (int ks = 0; ks < 4; ++ks) { bA0[ks] = *(const bf16x8*)(wa + 32 * ks); bI0[ks] = *(const bf16x8*)(wi + 32 * ks); } }
        f32x4 hl0[8], pp0[8];
        lru2_dir<0, false>(p, ul, head, wid, lane, bA0, bI0, bA1, bI1, hl0, pp0, A0, H0);
        u64_t* agg = (u64_t*)(p.ws + WS_AGG);
        const size_t ai0 = ((size_t)(b * NSEQ) * 2 + 0) * 1024 + ch, ai1 = ((size_t)(b * NSEQ) * 2 + 1) * 1024 + ch;
        if (fq == 0) {
            __hip_atomic_store(agg + ai0 + (size_t)sc * 2048, ((u64_t)__float_as_uint(H0) << 32) | __float_as_uint(A0), __ATOMIC_RELAXED, __HIP_MEMORY_SCOPE_AGENT);
            __hip_atomic_store(agg + ai1 + (size_t)sc * 2048, ((u64_t)__float_as_uint(H1) << 32) | __float_as_uint(A1), __ATOMIC_RELAXED, __HIP_MEMORY_SCOPE_AGENT); }
        asm volatile("s_waitcnt vmcnt(0)" ::: "memory");
        __syncthreads();
        if (tid == 0) (void)__hip_atomic_fetch_add(gcnt, 1u, __ATOMIC_RELAXED, __HIP_MEMORY_SCOPE_AGENT);
        if (wid == 0) { unsigned sp = 0;
            while ((unsigned)__builtin_amdgcn_readfirstlane(__hip_atomic_load(gcnt, __ATOMIC_RELAXED, __HIP_MEMORY_SCOPE_AGENT)) < 32u) { __builtin_amdgcn_s_sleep(1); if (++sp > (1u << 22)) break; }
            __builtin_amdgcn_fence(__ATOMIC_ACQUIRE, "agent");
            asm volatile("s_waitcnt vmcnt(0)" ::: "memory"); }
        __syncthreads();
        const float C0 = lru2_carry<0>(agg + ai0, sc, fr, fq);
        const float C1 = lru2_carry<1>(agg + ai1, 2 + (NSEQ - 1 - sc), fr, fq);
        __builtin_amdgcn_sched_barrier(0);
        if (LRU_PF_TILE) { const int gn = (g + ngr < NB * 8) ? g + ngr : g; LRU2_LOAD_R(gn); LRU2_LOAD_G(gn); }
        __builtin_amdgcn_sched_barrier(0);
        LAS unsigned char* gp = gzl + (4 * fq) * 272 + chl * 2; LAS unsigned char* op = outl + (4 * fq) * 272 + chl * 2;
        const LAS unsigned char* hp1 = outl + chl * 264 + (4 * fq) * 2; const LAS unsigned char* qp1 = raw + chl * 264 + (4 * fq) * 2;
        unsigned ov[16];
#pragma unroll
        for (int rb = 0; rb < 8; ++rb) { const u32x2 wh = *(const LAS u32x2*)(hp1 + 32 * rb), wq = *(const LAS u32x2*)(qp1 + 32 * rb);
            const float h1v[4] = {bf_lo(wh.x), bf_hi(wh.x), bf_lo(wh.y), bf_hi(wh.y)}, q1v[4] = {bf_lo(wq.x), bf_hi(wq.x), bf_lo(wq.y), bf_hi(wq.y)};
            float o[4];
#pragma unroll
            for (int r = 0; r < 4; ++r) { const float y = hl0[rb][r] + pp0[rb][r] * C0 + h1v[r] + q1v[r] * C1;
                o[r] = bf2f(*(const LAS bf16_t*)(gp + (16 * rb + r) * 272)) * y; }
            ov[2 * rb] = cvt_pk_bf16(o[0], o[1]); ov[2 * rb + 1] = cvt_pk_bf16(o[2], o[3]); }
        __syncthreads();
#pragma unroll
        for (int rb = 0; rb < 8; ++rb) { *(LAS bf16_t*)(op + (16 * rb + 0) * 272) = (bf16_t)(ov[2 * rb] & 0xffffu); *(LAS bf16_t*)(op + (16 * rb + 1) * 272) = (bf16_t)(ov[2 * rb] >> 16);
            *(LAS bf16_t*)(op + (16 * rb + 2) * 272) = (bf16_t)(ov[2 * rb + 1] & 0xffffu); *(LAS bf16_t*)(op + (16 * rb + 3) * 272) = (bf16_t)(ov[2 * rb + 1] >> 16); }
        __syncthreads();
        bf16_t* Ob = (bf16_t*)(p.ws + WS_R1) + ((size_t)(b * 4096 + t0)) * 1024 + head * 128;
#pragma unroll
        for (int k = 0; k < 4; ++k) { const int pc = tid + NTHR * k, row = pc >> 4, c8 = pc & 15;
            *(u32x4*)(Ob + (size_t)row * 1024 + c8 * 8) = *(const LAS u32x4*)(outl + row * 272 + c8 * 16); }
        __syncthreads();
        if (!LRU_PF_TILE && g + ngr < NB * 8) LRU2_LOAD_R(g + ngr);
    }
#undef LRU2_LOAD_R
#undef LRU2_LOAD_G
}

__device__ __forceinline__ void fft_stage2_all(const Params& p, LAS unsigned char* lds) {
    const int tid = tid_opaque(), lane = tid & 63, wid = tid >> 6, fr = lane & 15, fq = lane >> 4;
    const bf16_t* Yt = (const bf16_t*)((const unsigned char*)p.out + OUT_YT); const bf16_t* D2 = (const bf16_t*)(p.ws + WS_D2T);
    bf16_t* Fo = (bf16_t*)((unsigned char*)p.out + OUT_F);
    const int G = gridDim.x;
    int it = blockIdx.x; bf16x8 dfr, yfr[3];
    LAS unsigned char* own = lds; LAS unsigned char* mir = lds + 16 * 528;
#define S2_LOAD(item) do { const int b_ = (item) & 7, k1_ = (item) >> 3; dfr = *(const bf16x8*)(D2 + (size_t)(k1_ + 256 * fr) * 32 + 8 * fq); \
        const bf16_t* yrow_ = Yt + (size_t)(k1_ * 2 + (fq >> 1)) * FCOLS + 8 * (fq & 1); \
        _Pragma("unroll") for (int n = 0; n < 2; ++n) yfr[n] = __builtin_nontemporal_load((const bf16x8*)(yrow_ + (size_t)(b_ * 256 + 16 * (2 * wid + n) + fr) * 16)); \
        yfr[2] = __builtin_nontemporal_load((const bf16x8*)(yrow_ + (size_t)(32768 + (b_ * 4 + (fr & 3)) * 16))); } while (0)
    if (it < NB * 256) S2_LOAD(it);
    for (; it < NB * 256; it += G) {
        const int b = it & 7, k1 = it >> 3;
        f32x4 acc[3];
#pragma unroll
        for (int n = 0; n < 3; ++n) acc[n] = __builtin_amdgcn_mfma_f32_16x16x32_bf16(yfr[n], dfr, (f32x4){0.f, 0.f, 0.f, 0.f}, 0, 0, 0);
        const int nx = it + G; if (nx < NB * 256) S2_LOAD(nx);
#pragma unroll
        for (int n = 0; n < 3; ++n) mfma_settle(acc[n]);
#pragma unroll
        for (int n = 0; n < 2; ++n) { const int c0 = 16 * (2 * wid + n) + 4 * fq, g = c0 >> 6, kb = c0 & 63;
            u32x2 w; w.x = cvt_pk_bf16(acc[n][0], acc[n][1]); w.y = cvt_pk_bf16(acc[n][2], acc[n][3]);
            *(LAS u32x2*)(own + fr * 528 + c0 * 2) = w;
            LAS bf16_t* mp = (LAS bf16_t*)(mir + fr * 528) + g * 64 + 64 - kb;
            if (kb != 0) mp[0] = (bf16_t)(w.x & 0xffffu);
            mp[-1] = (bf16_t)(w.x >> 16); mp[-2] = (bf16_t)(w.y & 0xffffu); mp[-3] = (bf16_t)(w.y >> 16); }
        if (wid == 0 && fq == 0) {
            u32x2 w; w.x = cvt_pk_bf16(acc[2][0], acc[2][1]); w.y = cvt_pk_bf16(acc[2][2], acc[2][3]);
            LAS bf16_t* mp = (LAS bf16_t*)(mir + fr * 528);
            mp[0] = (bf16_t)(w.x & 0xffffu); mp[64] = (bf16_t)(w.x >> 16); mp[128] = (bf16_t)(w.y & 0xffffu); mp[192] = (bf16_t)(w.y >> 16); }
        __syncthreads();
        { const int k2 = tid >> 5, c8 = tid & 31, tp = k1 + 256 * k2, tm = (4096 - tp) & 4095, col = (c8 >> 3) * 128 + (c8 & 7) * 8;
          *(u32x4*)(Fo + ((size_t)b * 4096 + tp) * 512 + col) = *(const LAS u32x4*)(own + k2 * 528 + c8 * 16);
          *(u32x4*)(Fo + ((size_t)b * 4096 + tm) * 512 + col + 64) = *(const LAS u32x4*)(mir + k2 * 528 + c8 * 16); }
        __syncthreads();
    }
#undef S2_LOAD
}

__device__ __forceinline__ void topk_task(const Params& p, LAS unsigned char* lds, int it) {
    const int tid = tid_opaque(), lane = tid & 63, wid = tid >> 6;
    LAS unsigned* cnt = (LAS unsigned*)lds;
    LAS unsigned* wsum = cnt + 64;
    const float* scores = (const float*)(p.ws + WS_SCORES);
    int* idx = (int*)(p.ws + WS_IDX); float* gate = (float*)(p.ws + WS_GATE); int* slot_of = (int*)(p.ws + WS_SLOT);
    const int b = it >> 4, e = it & 15;
    unsigned key[8];
    { const u64_t* sp = (const u64_t*)(scores + (size_t)it * 4096 + tid * 8);
#pragma unroll
      for (int j = 0; j < 4; ++j) { const u64_t v = __hip_atomic_load(sp + j, __ATOMIC_RELAXED, __HIP_MEMORY_SCOPE_AGENT); key[2 * j] = (unsigned)v; key[2 * j + 1] = (unsigned)(v >> 32); } }
    unsigned thr = 0;
    for (int step = 0; step < 16; ++step) {
        const int sh = 29 - 2 * step;
        const unsigned c1 = sh >= 0 ? (thr | (1u << sh)) : (thr | 1u), c2 = sh >= 0 ? (thr | (2u << sh)) : 0xffffffffu, c3 = sh >= 0 ? (thr | (3u << sh)) : 0xffffffffu;
        unsigned n1 = 0, n2 = 0, n3 = 0;
#pragma unroll
        for (int j = 0; j < 8; ++j) { n1 += (unsigned)__popcll(__ballot(key[j] >= c1)); n2 += (unsigned)__popcll(__ballot(key[j] >= c2)); n3 += (unsigned)__popcll(__ballot(key[j] >= c3)); }
        LAS unsigned* cb = cnt + (step & 1) * 32;
        if (lane == 0) { cb[wid] = n1; cb[8 + wid] = n2; cb[16 + wid] = n3; }
        __syncthreads();
        unsigned t1 = 0, t2 = 0, t3 = 0;
#pragma unroll
        for (int w = 0; w < 8; ++w) { t1 += cb[w]; t2 += cb[8 + w]; t3 += cb[16 + w]; }
        if (sh >= 0) thr = t3 >= (unsigned)CAP ? c3 : (t2 >= (unsigned)CAP ? c2 : (t1 >= (unsigned)CAP ? c1 : thr));
        else thr = t1 >= (unsigned)CAP ? c1 : thr;
    }
    unsigned cg_ = 0, ce = 0;
#pragma unroll
    for (int j = 0; j < 8; ++j) { cg_ += key[j] > thr; ce += key[j] == thr; }
    unsigned pk = cg_ | (ce << 16), incl = pk;
#pragma unroll
    for (int o = 1; o < 64; o <<= 1) { const unsigned n = __shfl_up(incl, o); if (lane >= o) incl += n; }
    if (lane == 63) wsum[wid] = incl;
    __syncthreads();
    unsigned base = 0, total = 0;
#pragma unroll
    for (int w = 0; w < 8; ++w) { const unsigned s2 = wsum[w]; if (w < wid) base += s2; total += s2; }
    const unsigned excl = base + incl - pk; unsigned og = excl & 0xffffu, oe = excl >> 16; const unsigned ngt = total & 0xffffu, krem = (unsigned)CAP - ngt;
    int mm[8];
#pragma unroll
    for (int j = 0; j < 8; ++j) { const int t = tid * 8 + j; int m = -1;
        if (key[j] > thr) { m = (e * 8 + b) * 512 + (int)og; ++og; }
        else if (key[j] == thr) { if (oe < krem) m = (e * 8 + b) * 512 + (int)(ngt + oe); ++oe; }
        mm[j] = m;
        if (m >= 0) { idx[m] = b * 4096 + t; gate[m] = __uint_as_float(key[j]); } }
    { u32x4* so = (u32x4*)(slot_of + (size_t)it * 4096 + tid * 8);
      so[0] = (u32x4){(unsigned)mm[0], (unsigned)mm[1], (unsigned)mm[2], (unsigned)mm[3]}; so[1] = (u32x4){(unsigned)mm[4], (unsigned)mm[5], (unsigned)mm[6], (unsigned)mm[7]}; }
    __syncthreads();
}

__device__ __forceinline__ void phase7_rows(const Params& p, LAS unsigned char* lds) {
    const int tid = threadIdx.x, lane = tid & 63, wid = tid >> 6, fr = lane & 15, fq = lane >> 4;
    LAS unsigned char* ahi = lds; LAS unsigned char* alo = lds + 16 * 2064;
    LAS float* modl = (LAS float*)(lds + 65 * 1024);
    LAS float* scl = (LAS float*)(lds + 129 * 1024);
    LAS float* red = (LAS float*)(lds + 130 * 1024);
    { const float* ada0 = (const float*)(p.ws + WS_ADA);
      for (int i = tid; i < 8 * 1024; i += NTHR) { const int bb = i >> 10, d = i & 1023; modl[(bb * 2) * 1024 + d] = p.norm2_g[d] * (ada0[bb * 6144 + 4096 + d] + 1.0f); modl[(bb * 2 + 1) * 1024 + d] = ada0[bb * 6144 + 3072 + d]; } }
    bf16x8 bhi[4], blo[4];
#pragma unroll
    for (int s4 = 0; s4 < 4; ++s4) { float wv[8];
#pragma unroll
        for (int j = 0; j < 8; ++j) wv[j] = p.w_router[(size_t)(128 * wid + 32 * s4 + 8 * fq + j) * 16 + fr];
        u32x4 h, l;
#pragma unroll
        for (int jj = 0; jj < 4; ++jj) { const unsigned hp = cvt_pk_bf16(wv[2 * jj], wv[2 * jj + 1]); h[jj] = hp; l[jj] = cvt_pk_bf16(wv[2 * jj] - bf_lo(hp), wv[2 * jj + 1] - bf_hi(hp)); }
        bhi[s4] = __builtin_bit_cast(bf16x8, h); blo[s4] = __builtin_bit_cast(bf16x8, l); }
    __syncthreads();
    typedef __attribute__((address_space(1))) bf16_t gbf16_t; typedef __attribute__((address_space(1))) float gfloat_t; typedef __attribute__((address_space(1))) unsigned guint_t;
    gbf16_t* h2 = (gbf16_t*)(p.ws + WS_H2); const gbf16_t* x2b = (const gbf16_t*)(p.ws + WS_X2B); gfloat_t* scores = (gfloat_t*)(p.ws + WS_SCORES); guint_t* cnt7 = (guint_t*)(p.ws + WS_BAR + 44 * KiB);
    u32x2 nw[2][4]; int pend_b = -1;
#define P7_LOAD(rw) do { _Pragma("unroll") for (int r = 0; r < 2; ++r) _Pragma("unroll") for (int i = 0; i < 4; ++i) nw[r][i] = *(const __attribute__((address_space(1))) u32x2*)(x2b + (size_t)((rw) + r) * 1024 + 256 * i + 4 * lane); } while (0)
    { const int r0 = (blockIdx.x * 8 + wid) * 2; if (r0 < MLAT) P7_LOAD(r0); }
    auto trip = [&](const int row0) __attribute__((always_inline)) {
        const int b = row0 >> 12;
        f32x4 v[2][4]; float ss[2];
#pragma unroll
        for (int r = 0; r < 2; ++r)
#pragma unroll
            for (int i = 0; i < 4; ++i) { const u32x2 w = nw[r][i]; v[r][i] = (f32x4){bf_lo(w.x), bf_hi(w.x), bf_lo(w.y), bf_hi(w.y)}; }
        { const int nrow = row0 + (int)gridDim.x * 16 < MLAT ? row0 + (int)gridDim.x * 16 : row0; P7_LOAD(nrow); }
        __builtin_amdgcn_sched_barrier(0);
#pragma unroll
        for (int r = 0; r < 2; ++r) { float a = 0.f;
#pragma unroll
            for (int i = 0; i < 4; ++i) a += v[r][i][0] * v[r][i][0] + v[r][i][1] * v[r][i][1] + v[r][i][2] * v[r][i][2] + v[r][i][3] * v[r][i][3];
            ss[r] = a; }
#pragma unroll
        for (int o = 32; o >= 1; o >>= 1) { ss[0] += __shfl_xor(ss[0], o); ss[1] += __shfl_xor(ss[1], o); }
#pragma unroll
        for (int i = 0; i < 4; ++i) { const int d = 256 * i + 4 * lane;
            const f32x4 gg = *(const LAS f32x4*)(modl + (b * 2) * 1024 + d), sh = *(const LAS f32x4*)(modl + (b * 2 + 1) * 1024 + d);
#pragma unroll
            for (int r = 0; r < 2; ++r) { const float rs = rsqrtf(ss[r] * (1.0f / 1024.0f) + 1e-6f);
                const f32x4 hv = v[r][i] * rs * gg + sh;
                u32x2 w; w.x = cvt_pk_bf16(hv[0], hv[1]); w.y = cvt_pk_bf16(hv[2], hv[3]); *(__attribute__((address_space(1))) u32x2*)(h2 + (size_t)(row0 + r) * 1024 + d) = w;
                u32x2 l; l.x = cvt_pk_bf16(hv[0] - bf_lo(w.x), hv[1] - bf_hi(w.x)); l.y = cvt_pk_bf16(hv[2] - bf_lo(w.y), hv[3] - bf_hi(w.y));
                *(LAS u32x2*)(ahi + (2 * wid + r) * 2064 + d * 2) = w; *(LAS u32x2*)(alo + (2 * wid + r) * 2064 + d * 2) = l; } }
        __syncthreads();
        f32x4 acc = (f32x4){0.f, 0.f, 0.f, 0.f};
#pragma unroll
        for (int s4 = 0; s4 < 4; ++s4) { const int ko = (128 * wid + 32 * s4 + 8 * fq) * 2;
            const bf16x8 ah = *(const LAS bf16x8*)(ahi + fr * 2064 + ko), al = *(const LAS bf16x8*)(alo + fr * 2064 + ko);
            acc = __builtin_amdgcn_mfma_f32_16x16x32_bf16(ah, bhi[s4], acc, 0, 0, 0); acc = __builtin_amdgcn_mfma_f32_16x16x32_bf16(ah, blo[s4], acc, 0, 0, 0); acc = __builtin_amdgcn_mfma_f32_16x16x32_bf16(al, bhi[s4], acc, 0, 0, 0); }
#pragma unroll
        for (int r4 = 0; r4 < 4; ++r4) red[(wid * 16 + 4 * fq + r4) * 16 + fr] = acc[r4];
        __syncthreads();
        if (tid < 256) {
            float lg = 0.f;
#pragma unroll
            for (int w = 0; w < 8; ++w) lg += red[w * 256 + tid];
            float mx = lg;
#pragma unroll
            for (int o = 1; o <= 8; o <<= 1) mx = fmaxf(mx, __shfl_xor(mx, o));
            const float ex = expf(lg - mx); float sum = ex;
#pragma unroll
            for (int o = 1; o <= 8; o <<= 1) sum += __shfl_xor(sum, o);
            scl[(tid & 15) * 16 + (tid >> 4)] = ex / sum; }
        __syncthreads();
        if (tid < 128) { const int e = tid >> 3, q = tid & 7; const u64_t v2 = *(const LAS u64_t*)(scl + e * 16 + 2 * q);
            __hip_atomic_store((__attribute__((address_space(1))) u64_t*)(scores + ((size_t)b * 16 + e) * 4096 + ((row0 - 2 * wid) & 4095) + 2 * q), v2, __ATOMIC_RELAXED, __HIP_MEMORY_SCOPE_AGENT); }
        if (wid < 2) asm volatile("s_waitcnt vmcnt(17)" ::: "memory"); else asm volatile("s_waitcnt vmcnt(16)" ::: "memory");
        __syncthreads();
        if (tid == 0 && pend_b >= 0) (void)__hip_atomic_fetch_add(cnt7 + pend_b * 64, 1u, __ATOMIC_RELAXED, __HIP_MEMORY_SCOPE_AGENT);
        pend_b = b;
    };
    { int row0 = (blockIdx.x * 8 + wid) * 2;
      if (row0 < MLAT) { trip(row0); for (row0 += gridDim.x * 16; row0 < MLAT; row0 += gridDim.x * 16) trip(row0); } }
#undef P7_LOAD
    asm volatile("s_waitcnt vmcnt(0)" ::: "memory");
    __syncthreads();
    if (tid == 0 && pend_b >= 0) (void)__hip_atomic_fetch_add(cnt7 + pend_b * 64, 1u, __ATOMIC_RELAXED, __HIP_MEMORY_SCOPE_AGENT);
    __syncthreads();
}
__device__ __forceinline__ void phase7_topk(const Params& p, LAS unsigned char* lds) {
    const int bid = blockIdx.x; if (bid >= NB * NE) return;
    unsigned* c = (unsigned*)(p.ws + WS_BAR + 44 * KiB) + (bid >> 4) * 64;
    if (threadIdx.x < 64) { unsigned sp = 0;
        while ((unsigned)__builtin_amdgcn_readfirstlane(__hip_atomic_load(c, __ATOMIC_RELAXED, __HIP_MEMORY_SCOPE_AGENT)) < 256u) { __builtin_amdgcn_s_sleep(1); if (++sp > (1u << 22)) break; }
        __builtin_amdgcn_fence(__ATOMIC_ACQUIRE, "agent");
        asm volatile("s_waitcnt vmcnt(0)" ::: "memory"); }
    __syncthreads();
    topk_task(p, lds, bid);
}
__device__ __forceinline__ void phase7_weights(const Params& p) {
    constexpr int N_G = 16 * 16 * 6, N_D = 16 * 24 * 4;
    const bool fused = gridDim.x == 256;
    for (int j = 0; ; ++j) {
        int it;
        if (!fused) it = blockIdx.x + j * gridDim.x;
        else if (blockIdx.x >= 128) it = j < 4 ? (blockIdx.x - 128) + 128 * j : 512 + blockIdx.x + (j - 4) * 256;
        else it = 512 + blockIdx.x + j * 256;
        if (it >= 2 * N_G + N_D) break;
        if (it < 2 * N_G) { const int up = it >= N_G, j = up ? it - N_G : it, e = j / 96, r = j % 96, kb = r / 6, nb = r % 6;
            xpose_item<4>((up ? p.w_up_e : p.w_gate_e) + (size_t)e * 1024 * 1536, 1536, (bf16_t*)(p.ws + WS_WGU) + (size_t)e * 3072 * 1024, 1024, kb * 64, nb * 256, up ? 2 : 1); }
        else { const int j = it - 2 * N_G, e = j / 96, r = j % 96, kb = r >> 2, nb = r & 3;
            xpose_item<4>(p.w_down_e + (size_t)e * 1536 * 1024, 1024, (bf16_t*)(p.ws + WS_WD) + (size_t)e * 1024 * 1536, 1536, kb * 64, nb * 256, 0); }
    }
}

__device__ __forceinline__ void phase11(const Params& p, float* dst) {
    const int tid = tid_opaque(), lane = tid & 63, wid = tid >> 6;
    const float* ada = (const float*)(p.ws + WS_ADA); const int* slot_of = (const int*)(p.ws + WS_SLOT); const bf16_t* oute = (const bf16_t*)(p.ws + WS_OUTE); const bf16_t* x2b = (const bf16_t*)(p.ws + WS_X2B);
    const int stride = gridDim.x * 16;
    int row0 = (blockIdx.x * 8 + wid) * 2;
    int myslot = row0 < MLAT ? slot_of[((size_t)(row0 >> 12) * 16 + (lane & 15)) * 4096 + ((row0 & 4095) + ((lane >> 4) & 1))] : -1;
    for (; row0 < MLAT; row0 += stride) {
        const int b = row0 >> 12;
        const int nrow = row0 + stride; const int nslot = nrow < MLAT ? slot_of[((size_t)(nrow >> 12) * 16 + (lane & 15)) * 4096 + ((nrow & 4095) + ((lane >> 4) & 1))] : -1;
        f32x4 xv[2][4], acc[2][4];
#pragma unroll
        for (int r = 0; r < 2; ++r)
#pragma unroll
            for (int i = 0; i < 4; ++i) { const u32x2 w = __builtin_nontemporal_load((const u32x2*)(x2b + (size_t)(row0 + r) * 1024 + 256 * i + 4 * lane)); xv[r][i] = (f32x4){bf_lo(w.x), bf_hi(w.x), bf_lo(w.y), bf_hi(w.y)}; acc[r][i] = (f32x4){0.f, 0.f, 0.f, 0.f}; }
        const unsigned long long bal = __ballot(myslot >= 0);
        unsigned mask0 = (unsigned)(bal & 0xffffull), mask1 = (unsigned)((bal >> 16) & 0xffffull);
        while (mask0 | mask1) {
            int m[2][2];
#pragma unroll
            for (int j = 0; j < 2; ++j) { if (mask0) { const int e = __builtin_ctz(mask0); mask0 &= mask0 - 1; m[0][j] = __builtin_amdgcn_readlane(myslot, e); } else m[0][j] = MMOE;
                                          if (mask1) { const int e = __builtin_ctz(mask1); mask1 &= mask1 - 1; m[1][j] = __builtin_amdgcn_readlane(myslot, 16 + e); } else m[1][j] = MMOE; }
            u32x2 w[2][2][4];
#pragma unroll
            for (int r = 0; r < 2; ++r)
#pragma unroll
                for (int j = 0; j < 2; ++j)
#pragma unroll
                    for (int i = 0; i < 4; ++i) w[r][j][i] = __builtin_nontemporal_load((const u32x2*)(oute + (size_t)m[r][j] * 1024 + 256 * i + 4 * lane));
#pragma unroll
            for (int r = 0; r < 2; ++r)
#pragma unroll
                for (int j = 0; j < 2; ++j)
#pragma unroll
                    for (int i = 0; i < 4; ++i) { acc[r][i][0] += bf_lo(w[r][j][i].x); acc[r][i][1] += bf_hi(w[r][j][i].x); acc[r][i][2] += bf_lo(w[r][j][i].y); acc[r][i][3] += bf_hi(w[r][j][i].y); }
        }
        float ss[2];
#pragma unroll
        for (int r = 0; r < 2; ++r) { float a = 0.f;
#pragma unroll
            for (int i = 0; i < 4; ++i) { const int d = 256 * i + 4 * lane; const f32x4 g2 = *(const f32x4*)(ada + b * 6144 + 5120 + d); xv[r][i] += g2 * acc[r][i];
                a += xv[r][i][0] * xv[r][i][0] + xv[r][i][1] * xv[r][i][1] + xv[r][i][2] * xv[r][i][2] + xv[r][i][3] * xv[r][i][3]; }
            ss[r] = a; }
#pragma unroll
        for (int o = 32; o >= 1; o >>= 1) { ss[0] += __shfl_xor(ss[0], o); ss[1] += __shfl_xor(ss[1], o); }
#pragma unroll
        for (int r = 0; r < 2; ++r) { const float rs = rsqrtf(ss[r] * (1.0f / 1024.0f) + 1e-6f);
#pragma unroll
            for (int i = 0; i < 4; ++i) { const int d = 256 * i + 4 * lane; __builtin_nontemporal_store(xv[r][i] * rs * *(const f32x4*)(p.final_g + d), (f32x4*)(dst + (size_t)(row0 + r) * 1024 + d)); } }
        myslot = nslot;
    }
}

#define XB_TMO      128
#define XB_XCNT(j)  (256  + 64 * (j))
#define XB_XSUB(j)  (1280 + 64 * (j))
#define XB_XGEN(j)  (2304 + 64 * (j))
#define XB_TOP      3328
#define XB_TOPGEN   3392
#define XCD_BAR_WORDS 3456
#define XB_SPIN_CAP (1u << 22)
__device__ __forceinline__ unsigned xb_ld(unsigned* p)              { return __hip_atomic_load(p, __ATOMIC_RELAXED, __HIP_MEMORY_SCOPE_AGENT); }
__device__ __forceinline__ unsigned xb_add(unsigned* p, unsigned v) { return __hip_atomic_fetch_add(p, v, __ATOMIC_RELAXED, __HIP_MEMORY_SCOPE_AGENT); }
__device__ __forceinline__ unsigned xb_xcc_id() { return (unsigned)__builtin_amdgcn_s_getreg((3 << 11) | 20) & 0xFu; }
#define XB_SPIN(cond, bar) do { unsigned _sp = 0; while (cond) { __builtin_amdgcn_s_sleep(1); \
    if ((++_sp & 255u) == 0u) { if (xb_ld(&(bar)[XB_TMO])) break; if (_sp > XB_SPIN_CAP) { atomicAdd(&(bar)[XB_TMO], 1u); break; } } } } while (0)
struct XcdBarrier { unsigned* bar; unsigned x; volatile LAS unsigned* st; };
__device__ __forceinline__ XcdBarrier xcd_barrier_post(unsigned* bar, volatile LAS unsigned* st) {
    XcdBarrier b; b.bar = bar; b.x = xb_xcc_id(); b.st = st;
    if (threadIdx.x == 0) (void)xb_add(&bar[XB_XCNT(b.x)], 1u);
    return b;
}
__device__ __forceinline__ void xcd_barrier_complete(unsigned* bar, unsigned x, unsigned& nloc, unsigned& nx) {
    const unsigned G = gridDim.x * gridDim.y * gridDim.z;
    unsigned sum, cnt, mine, sp = 0u;
    for (;;) {
        sum = 0u; cnt = 0u; mine = 0u;
#pragma unroll
        for (unsigned j = 0; j < 16; ++j) { const unsigned c = xb_ld(&bar[XB_XCNT(j)]); sum += c; cnt += (c > 0u) ? 1u : 0u; mine = (j == x) ? c : mine; }
        if (sum == G) break;
        __builtin_amdgcn_s_sleep(1);
        if ((++sp & 255u) == 0u) { if (xb_ld(&bar[XB_TMO])) break; if (sp > XB_SPIN_CAP) { atomicAdd(&bar[XB_TMO], 1u); break; } }
    }
    nloc = mine > 0u ? mine : 1u; nx = cnt > 0u ? cnt : 1u;
}
__device__ __forceinline__ void xcd_barrier(const XcdBarrier& b) {
    asm volatile("s_waitcnt vmcnt(0)" ::: "memory");
    __syncthreads();
    if (threadIdx.x == 0) {
        unsigned* bar = b.bar;
        __builtin_amdgcn_s_waitcnt(0);
        unsigned nloc = b.st[0], nx = b.st[1];
        if (nloc == 0u) { xcd_barrier_complete(bar, b.x, nloc, nx); b.st[0] = nloc; b.st[1] = nx; }
        const unsigned old = xb_add(&bar[XB_XSUB(b.x)], 1u);
        const unsigned gen = old / nloc;
        if (old + 1u == (gen + 1u) * nloc) {
            __builtin_amdgcn_fence(__ATOMIC_RELEASE, "agent");
            asm volatile("s_waitcnt vmcnt(0)" ::: "memory");
            const unsigned og = xb_add(&bar[XB_TOP], 1u);
            const unsigned tg = og / nx;
            if (og + 1u == (tg + 1u) * nx) xb_add(&bar[XB_TOPGEN], 1u);
            else XB_SPIN(xb_ld(&bar[XB_TOPGEN]) == tg, bar);
            __builtin_amdgcn_fence(__ATOMIC_ACQUIRE, "agent");
            xb_add(&bar[XB_XGEN(b.x)], 1u);
            asm volatile("s_waitcnt vmcnt(0)" ::: "memory");
        } else {
            XB_SPIN(xb_ld(&bar[XB_XGEN(b.x)]) == gen, bar);
            __builtin_amdgcn_fence(__ATOMIC_ACQUIRE, "agent");
            asm volatile("s_waitcnt vmcnt(0)" ::: "memory");
        }
    }
    __syncthreads();
}

__global__ void __launch_bounds__(NTHR, 2) fwd_megakernel(Params p_in) {
    Params p = p_in;
    extern __shared__ __attribute__((aligned(16))) unsigned char lds_raw[];
    LAS unsigned char* lds = (LAS unsigned char*)lds_raw;
    cg::grid_group grid = cg::this_grid();
    const int G = gridDim.x, bid = blockIdx.x;
    unsigned char* ws = p.ws;
    bf16_t* const R1 = (bf16_t*)(ws + WS_R1); bf16_t* const Zb = (bf16_t*)(ws + WS_RZ); bf16_t* const PQt = (bf16_t*)(ws + WS_RPQ); bf16_t* const MRG = (bf16_t*)(ws + WS_R2);
    bf16_t* const Fb = (bf16_t*)((unsigned char*)p.out + OUT_F); bf16_t* const Ytb = (bf16_t*)((unsigned char*)p.out + OUT_YT);
#ifdef ONLY_PH
#define PH(k) ((k) == ONLY_PH && p.ph_lo <= (k) && (k) < p.ph_hi)
#else
#define PH(k) (p.ph_lo <= (k) && (k) < p.ph_hi)
#endif
    volatile LAS unsigned* xst = (volatile LAS unsigned*)(lds + LDS_BYTES - 16);
    if (threadIdx.x < 4) xst[threadIdx.x] = 0u;
    __syncthreads();
    XcdBarrier xbar = xcd_barrier_post((unsigned*)(ws + WS_BAR), xst);
    if (p.ph_lo < 0) grid.sync();
#ifdef TS_A
    unsigned long long* tsb = (unsigned long long*)(ws + WS_BAR + 40 * KiB);
#define STAMP(i) do { if (bid == 0 && threadIdx.x == 0) tsb[i] = __builtin_amdgcn_s_memrealtime(); } while (0)
#else
#define STAMP(i) do { } while (0)
#endif
    STAMP(0);
#define LAUNDER() do { asm volatile("" : "+s"(p.ws), "+s"(p.out), "+s"(p.x)); ws = p.ws; } while (0)
#define SYNC(k) do { if (PH(k) && PH((k) + 1)) xcd_barrier(xbar); STAMP((k) + 1); LAUNDER(); } while (0)
#ifndef REPMASK
#define REPMASK 0
#endif
#define REP(k) for (int rep_ = 0; rep_ <= ((REPMASK >> (k)) & 1); ++rep_)
    const bool fuse01 = PH(0) && PH(1);
    if (PH(0)) phase0(p, lds);
    if (fuse01) block_wait_ge((unsigned*)(ws + WS_BAR + 46 * KiB), 256u + 16u);
    else SYNC(0);
    if (PH(1)) REP(1) phase1(p);
    SYNC(1);
    if (PH(2)) REP(2) {
        { ProbPQ pr{(const bf16_t*)(ws + WS_WPQ), R1, 1024, 1024, 16384}; pg8::Order S; S.init(2, 128, G, bid); EpiPQ E{PQt}; pg8::gemm_phase(lds, pr, S, E); }
        STAMP(28);
        { ProbPlain pr{R1, (const bf16_t*)(ws + WS_WIN), 1024, 1024, 1024}; pg8::Order S; S.init(128, 16, G, bid); EpiZ E{Zb, 4096, -1}; pg8::gemm_phase(lds, pr, S, E); }
        STAMP(29);
        { ProbPlain pr{(const bf16_t*)(ws + WS_HCTX), (const bf16_t*)(ws + WS_WIN), 1024, 1024, 1024}; pg8::Order S; S.init(8, 4, G, bid); EpiZ E{(bf16_t*)(ws + WS_ZXC), 1024, 0}; pg8::gemm_phase(lds, pr, S, E); }
    }
    SYNC(2);
    if (PH(3)) REP(3) {
        {
            ProbPlain pr{(const bf16_t*)(ws + WS_D1T), PQt, 512, 512, 512}; pg8::Order S; S.init(2, FCOLS / 256, G, bid);
            if (G == 256) { if (bid >= 128) { S.G = 128; S.c = bid - 128; S.base = 0; S.lim = 2; } else { S.G = 128; S.c = bid; S.base = 256; S.lim = bid < 4 ? 1 : 0; } }
            EpiPlain E{Ytb, FCOLS}; pg8::gemm_phase(lds, pr, S, E); }
        for (int it = bid; it < NB * 2 * 8; it += G) lru_tile<false>(p, lds, it);
    }
    SYNC(3);
    if (PH(4)) {
        fft_stage2_all(p, lds);
        const int ngr = G >> 5;
        if (ngr > 0 && bid < ngr * 32) lru2_block(p, lds, bid % ngr, bid / ngr, ngr);
    }
    SYNC(4);
    if (PH(5)) REP(5) {
        { ProbMerge pr{Fb, (const bf16_t*)(ws + WS_WFOUR), R1, (const bf16_t*)(ws + WS_WLRU), 512, 1024, 512, 512, 1024, 1024}; pg8::Order S; S.init(128, 4, G, bid); EpiMerge E{MRG, Zb}; pg8::gemm_phase2(lds, pr, S, E); }
    }
    SYNC(5);
    if (PH(6)) REP(6) { ProbPlain pr{MRG, (const bf16_t*)(ws + WS_WOUT), 1024, 1024, 1024}; pg8::Order S; S.init(128, 4, G, bid); if (512 % G == 0) S.rev = 512 / G;
        EpiOut E{(bf16_t*)(ws + WS_X2B), p.x, (const float*)(ws + WS_POS), (const float*)(ws + WS_ADA)}; pg8::gemm_phase(lds, pr, S, E); }
    SYNC(6);
    if (PH(7)) { phase7_rows(p, lds); if (G == 256) phase7_topk(p, lds); phase7_weights(p); }
    SYNC(7);
    if (PH(8) && G != 256) { for (int it = bid; it < NB * NE; it += G) topk_task(p, lds, it); }
    if (G != 256) SYNC(8);
    if (PH(9)) REP(9) { ProbMoeUp pr{(const bf16_t*)(ws + WS_H2), (const bf16_t*)(ws + WS_WGU), (const int*)(ws + WS_IDX), 1024, 1024, 1024}; pg8::Order S; S.init(256, 12, G, bid); S.wgm = P9_WGM; EpiGU E{(bf16_t*)(ws + WS_HID)}; pg8::gemm_phase(lds, pr, S, E); }
    SYNC(9);
    if (PH(10)) { if (bid == 0 && threadIdx.x < 128) *(u32x4*)(ws + WS_OUTE + (size_t)MMOE * 2048 + threadIdx.x * 16) = (u32x4){0u, 0u, 0u, 0u}; }
    if (PH(10)) REP(10) { ProbMoeDown pr{(const bf16_t*)(ws + WS_HID), (const bf16_t*)(ws + WS_WD), 1536, 1536, 1536}; pg8::Order S; S.init(256, 4, G, bid); if (1024 % G == 0) S.rev = 1024 / G; EpiDown E{(bf16_t*)(ws + WS_OUTE), (const float*)(ws + WS_GATE)}; pg8::gemm_phase(lds, pr, S, E); }
    SYNC(10);
    if (PH(11)) phase11(p, p.out);
#ifdef TS_A
    xcd_barrier(xbar); STAMP(12);
    if (bid == 0 && threadIdx.x == 0) {

#ifndef TS_AE
#define TS_AE (TS_A + 1)
#endif
#ifndef TS_BE
#define TS_BE (TS_B + 1)
#endif
        const float ta = (float)(tsb[TS_AE] - tsb[TS_A]) * 0.01f * (float)(TS_SA), tb = (float)(tsb[TS_BE] - tsb[TS_B]) * 0.01f * (float)(TS_SB);
        p.out[7] = fminf(ta, 97.f); p.out[1024 * 5 + 9] = fminf(tb, 97.f); }
#endif
}

#ifndef N_LAUNCHES
#define N_LAUNCHES 1
#endif
#ifndef PROBE_DUP
#define PROBE_DUP 0x0
#endif
extern "C" void kernel_launch(void* const* d_in, const int* in_sizes, int n_in, void* d_out, int out_size, void* d_ws, size_t ws_size, hipStream_t stream) {
    static int grid = 0;
    if (grid == 0) {
        if (n_in != 24 || out_size != MLAT * DM || ws_size < WS_END) { fprintf(stderr, "kernel_launch: unexpected shapes (n_in %d out %d ws %zu)\n", n_in, out_size, ws_size); grid = -1; return; }
        int dev = 0, cus = 0, per_cu = 0;
        hipGetDevice(&dev); hipDeviceGetAttribute(&cus, hipDeviceAttributeMultiprocessorCount, dev);
        hipFuncSetAttribute((const void*)fwd_megakernel, hipFuncAttributeMaxDynamicSharedMemorySize, LDS_BYTES);
        hipOccupancyMaxActiveBlocksPerMultiprocessor(&per_cu, (const void*)fwd_megakernel, NTHR, LDS_BYTES);
        if (per_cu < 1) { fprintf(stderr, "kernel_launch: occupancy query reports %d blocks per CU\n", per_cu); per_cu = 1; }
        grid = cus * 1;
        (void)hipGetLastError();
    }
    if (grid < 0) return;
    Params p{};
    const float** f = (const float**)&p;
    for (int i = 0; i < 24; ++i) f[i] = (const float*)d_in[i];
    p.out = (float*)d_out; p.ws = (unsigned char*)d_ws;
    (void)hipMemsetAsync((unsigned char*)d_ws + WS_BAR, 0, 48 * KiB, stream);
#if N_LAUNCHES == 1
    p.ph_lo = 0; p.ph_hi = 12;
    void* args[] = {&p};
    hipError_t e = hipLaunchCooperativeKernel((const void*)fwd_megakernel, dim3(grid), dim3(NTHR), args, LDS_BYTES, stream);
    if (e != hipSuccess) fprintf(stderr, "cooperative launch failed: %s (grid %d)\n", hipGetErrorString(e), grid);
#else
    for (int k = 0; k < 12; ++k) for (int r = 0; r <= ((PROBE_DUP >> k) & 1); ++r) { p.ph_lo = k; p.ph_hi = k + 1; if (k == 11 && r == 0 && ((PROBE_DUP >> 11) & 1)) { p.ph_lo = 12; p.ph_hi = 13; } hipLaunchKernelGGL(fwd_megakernel, dim3(grid), dim3(NTHR), LDS_BYTES, stream, p); }
#endif
}
```

```cpp
#include <hip/hip_runtime.h>
#include <hip/hip_cooperative_groups.h>
#include <cstdio>
namespace cg = cooperative_groups;

#ifndef P9_WGM
#define P9_WGM 2
#endif
#define LAS __attribute__((address_space(3)))
typedef unsigned short bf16_t;
typedef short bf16x8 __attribute__((ext_vector_type(8)));
typedef float f32x4 __attribute__((ext_vector_type(4)));
typedef float f32x16 __attribute__((ext_vector_type(16)));
typedef unsigned u32x4 __attribute__((ext_vector_type(4)));
typedef unsigned u32x2 __attribute__((ext_vector_type(2)));
typedef unsigned long long u64_t;

constexpr int NB = 8, TT = 4096, DM = 1024, CTXL = 256, MLAT = NB * TT, MCTX = NB * CTXL;
constexpr int NE = 16, CAP = 512, DE = 1536, MMOE = NE * NB * CAP;
constexpr int NSEQ = 34;
constexpr int NTHR = 512;
constexpr float NLOG2E = -1.4426950408889634f;
constexpr int LDS_BYTES = 144 * 1024;

constexpr size_t KiB = 1024, MiB = 1024 * 1024;
constexpr size_t WS_ADA = 0;
constexpr size_t WS_POS = 256 * KiB;
constexpr size_t WS_AGG = 512 * KiB;
constexpr size_t WS_LRUP = 4 * MiB + 768 * KiB;
constexpr int FCOLS = 32768 + 512;
constexpr size_t WS_WPQ = 5 * MiB;
constexpr size_t WS_WIN = 7 * MiB;
constexpr size_t WS_WFOUR = 15 * MiB;
constexpr size_t WS_WLRU = 16 * MiB;
constexpr size_t WS_WOUT = 18 * MiB;
constexpr size_t WS_WAT = 20 * MiB;
constexpr size_t WS_WIT = 20 * MiB + 512 * KiB;
constexpr size_t WS_SCORES = 21 * MiB;
constexpr size_t WS_IDX = 23 * MiB;
constexpr size_t WS_GATE = 23 * MiB + 256 * KiB;
constexpr size_t WS_SLOT = 23 * MiB + 512 * KiB;
constexpr size_t WS_BAR = 25 * MiB + 512 * KiB;
constexpr size_t WS_D1T = 34 * MiB;
constexpr size_t WS_D2T = 34 * MiB + 512 * KiB;
constexpr size_t WS_HCTX = 26 * MiB;
constexpr size_t WS_ZXC = 30 * MiB;
constexpr size_t WS_R1 = 40 * MiB;
constexpr size_t WS_RPQ = 104 * MiB;
constexpr size_t WS_R2 = 168 * MiB;
constexpr size_t WS_RZ = 232 * MiB;
constexpr size_t WS_END = 512 * MiB;
constexpr size_t WS_X2B = WS_R1, WS_H2 = WS_R2, WS_HID = 240 * MiB, WS_OUTE = WS_RPQ;
__device__ __forceinline__ bf16_t* wgu_ptr(unsigned char* ws, float* out, int e) {
    unsigned char* o = (unsigned char*)out;
    return (bf16_t*)(e < 10 ? ws + 104 * MiB + (size_t)e * 6 * MiB : (e < 14 ? ws + 488 * MiB + (size_t)(e - 10) * 6 * MiB : o + 96 * MiB + (size_t)(e - 14) * 6 * MiB)); }
__device__ __forceinline__ bf16_t* wd_ptr(unsigned char* ws, float* out, int e) {
    unsigned char* o = (unsigned char*)out;
    (void)ws; return (bf16_t*)(e < 6 ? o + 108 * MiB + (size_t)e * 3 * MiB : o + 33 * MiB + (size_t)(e - 6) * 3 * MiB); }
constexpr size_t OUT_YT = 0, OUT_F = 64 * MiB;

struct Params {
    const float *x, *c, *ctx, *c_ctx, *w_ada, *b_ada, *norm1_g, *norm2_g, *w_in, *w_four, *conv_w, *conv_b, *lru_lambda,
        *lru_wa, *lru_ba, *lru_wi, *lru_bi, *w_lru, *w_out, *w_router, *w_gate_e, *w_up_e, *w_down_e, *final_g;
    float* out; unsigned char* ws; int ph_lo, ph_hi;
};

__device__ __forceinline__ int tid_opaque() { int t = threadIdx.x; asm volatile("" : "+v"(t)); return t; }
__device__ __forceinline__ unsigned cvt_pk_bf16(float lo, float hi) { unsigned r; asm volatile("v_cvt_pk_bf16_f32 %0, %1, %2" : "=v"(r) : "v"(lo), "v"(hi)); return r; }
__device__ __forceinline__ void mfma_settle(f32x4& a) { asm volatile("s_nop 15\n\ts_nop 7" : "+v"(a)); }
__device__ __forceinline__ void block_wait_ge(unsigned* cnt, unsigned need) {
    if (threadIdx.x < 64) { unsigned sp = 0;
        while ((unsigned)__builtin_amdgcn_readfirstlane(__hip_atomic_load(cnt, __ATOMIC_RELAXED, __HIP_MEMORY_SCOPE_AGENT)) < need) { __builtin_amdgcn_s_sleep(2); if (++sp > (1u << 22)) break; }
        __builtin_amdgcn_fence(__ATOMIC_ACQUIRE, "agent"); asm volatile("s_waitcnt vmcnt(0)" ::: "memory"); }
    __syncthreads();
}
__device__ __forceinline__ float bf_lo(unsigned w) { return __uint_as_float(w << 16); }
__device__ __forceinline__ float bf_hi(unsigned w) { return __uint_as_float(w & 0xffff0000u); }
__device__ __forceinline__ float bf2f(bf16_t h) { return __uint_as_float(((unsigned)h) << 16); }
__device__ __forceinline__ float sigmoidf_(float v) { return __builtin_amdgcn_rcpf(1.0f + __expf(-v)); }
__device__ __forceinline__ float gelu_tanh(float v) { const float y = 1.5957691216f * (v + 0.044715f * v * v * v); return v * sigmoidf_(y); }
__device__ __forceinline__ float wave_sum(float v) {
#pragma unroll
    for (int o = 32; o >= 1; o >>= 1) v += __shfl_xor(v, o);
    return v;
}
__device__ __forceinline__ void unpack8(const u32x4 w, float (&f)[8]) { f[0] = bf_lo(w.x); f[1] = bf_hi(w.x); f[2] = bf_lo(w.y); f[3] = bf_hi(w.y); f[4] = bf_lo(w.z); f[5] = bf_hi(w.z); f[6] = bf_lo(w.w); f[7] = bf_hi(w.w); }

namespace pg8 {
constexpr int BM = 256, BK = 64, HALF = 128, HTB = HALF * BK * 2, STAGE_BYTES = 8 * HTB, NXCD = 8, WGM = 2;
__device__ __forceinline__ int lds_byte(int r, int c) { const int st = (r >> 4) * 2 + (c >> 5), rr = r & 15, cc = c & 31, ob = rr * 64 + cc * 2; return st * 1024 + (ob ^ (((ob >> 9) & 1) << 5)); }
__device__ __forceinline__ void stage_rc(int b, int& R, int& C) { const int st = b / 1024, sb = b % 1024, swz = sb ^ (((sb >> 9) & 1) << 5); R = (st >> 1) * 16 + swz / 64; C = (st & 1) * 32 + (swz % 64) / 2; }
__device__ __forceinline__ int perm32(int rho) { const int n = rho >> 4, i = rho & 15; return 8 * (i >> 2) + 4 * n + (i & 3); }
struct Unit { int pm, pn; };
struct Order {
    int nM, nN, nwg, G, c, base, lim, rev, wgm;
    __device__ void init(int nM_, int nN_, int G_, int c_) { nM = nM_; nN = nN_; nwg = nM * nN; G = G_; c = c_; base = 0; lim = 0x7fffffff; rev = 0; wgm = WGM; }
    __device__ bool next(int i, Unit& u) const {
        if (rev > 0 && i >= rev) return false;
        const long L = (long)base + (long)(rev > 0 ? rev - 1 - i : i) * G + c; if (i >= lim || L >= nwg) return false;
        int wgid = (int)L; { const int q = nwg / NXCD, r = nwg % NXCD, xcd = wgid % NXCD, off = wgid / NXCD; wgid = (xcd < r ? xcd * (q + 1) : r * (q + 1) + (xcd - r) * q) + off; }
        const int nig = wgm * nN, gid = wgid / nig, fm = gid * wgm, gsz = (nM - fm) < wgm ? (nM - fm) : wgm;
        u.pm = fm + ((wgid % nig) % gsz); u.pn = (wgid % nig) / gsz; return true;
    }
};
template <class P, class Epi>
__device__ __forceinline__ void gemm_phase(LAS unsigned char* lds, const P& pr, const Order& S, const Epi& E) {
    const int tid = tid_opaque(), wid = __builtin_amdgcn_readfirstlane(tid >> 6), lane = tid & 63, wr = wid >> 2, wc = wid & 3, fr = lane & 15, fq = lane >> 4;
    const int nt = pr.K / BK;
    int RA[2], CA[2]; unsigned voffB[2];
#pragma unroll
    for (int i = 0; i < 2; ++i) { int R, C; stage_rc(tid * 16 + i * 8192, R, C); RA[i] = R; CA[i] = C; const int Rb = Epi::PERM ? ((R & ~31) + perm32(R & 31)) : R; voffB[i] = (unsigned)(Rb * pr.ldb + C) * 2u; }
    const size_t kstep = (size_t)(BK * 2);
    const size_t hstepB = (size_t)HALF * pr.ldb * 2;
    const unsigned ldsw = (unsigned)wid * 1024u;
    const int aoff = lds_byte(wr * 64 + fr, fq * 8), boff = lds_byte(wc * 32 + fr, fq * 8);
#define PG8_SA(b, h) (((b) * 2 + (h)) * HTB)
#define PG8_SB(b, h) ((4 + (b) * 2 + (h)) * HTB)
#define PG8_STAGE(bufoff, gbase, voff) do { _Pragma("unroll") for (int _i = 0; _i < 2; ++_i) \
        __builtin_amdgcn_global_load_lds((const unsigned*)((const char*)(gbase) + (voff)[_i]), (LAS unsigned*)(lds + (bufoff) + ldsw + _i * 8192), 16, 0, 0); } while (0)
#define PG8_LDA(dst, b, h) do { _Pragma("unroll") for (int m = 0; m < 4; ++m) _Pragma("unroll") for (int k = 0; k < 2; ++k) dst[m][k] = *(const LAS bf16x8*)(lds + PG8_SA(b, h) + aoff + m * 2048 + k * 1024); } while (0)
#define PG8_LDB(dst, b, h) do { _Pragma("unroll") for (int n = 0; n < 2; ++n) _Pragma("unroll") for (int k = 0; k < 2; ++k) dst[n][k] = *(const LAS bf16x8*)(lds + PG8_SB(b, h) + boff + n * 2048 + k * 1024); } while (0)
#define PG8_MMA(ai, bj, At, Bt) do { __builtin_amdgcn_s_setprio(1); _Pragma("unroll") for (int m = 0; m < 4; ++m) _Pragma("unroll") for (int n = 0; n < 2; ++n) _Pragma("unroll") for (int k = 0; k < 2; ++k) \
        acc[ai][bj][m][n] = __builtin_amdgcn_mfma_f32_16x16x32_bf16(Bt[n][k], At[m][k], acc[ai][bj][m][n], 0, 0, 0); __builtin_amdgcn_s_setprio(0); } while (0)
#define PG8_WAIT_V(n) asm volatile("s_waitcnt vmcnt(" #n ")" ::: "memory")
#define PG8_WAIT_L(n) asm volatile("s_waitcnt lgkmcnt(" #n ")" ::: "memory")
#define PG8_BAR __builtin_amdgcn_s_barrier()
#define PG8_SCHED __builtin_amdgcn_sched_barrier(0)
    Unit cur, nxt; int ui = 0;
    if (!S.next(0, cur)) return;
    f32x4 acc[2][2][4][2];
#pragma unroll
    for (int a = 0; a < 2; ++a)
#pragma unroll
        for (int b = 0; b < 2; ++b)
#pragma unroll
            for (int m = 0; m < 4; ++m)
#pragma unroll
                for (int n = 0; n < 2; ++n) acc[a][b][m][n] = (f32x4){0.f, 0.f, 0.f, 0.f};
    bf16x8 At[4][2], B0[2][2], B1[2][2];
    unsigned vA[2][2], vN[2][2];
    pr.avoff(cur, RA, CA, vA);
#pragma unroll
    for (int h = 0; h < 2; ++h)
#pragma unroll
        for (int i = 0; i < 2; ++i) vN[h][i] = vA[h][i];
    const char* cA = pr.abase(cur); const char* cB = pr.bbase(cur);
#define PG8_ROT(u) 0
#define PG8_KT(tt, rot) ((size_t)(((tt) + (rot)) >= nt ? ((tt) + (rot)) - nt : ((tt) + (rot))) * kstep)
    int rot = PG8_ROT(cur);
    { const char* pA = cA + PG8_KT(0, rot); const char* pB = cB + PG8_KT(0, rot);
    PG8_STAGE(PG8_SB(0, 0), pB, voffB); PG8_STAGE(PG8_SA(0, 0), pA, vA[0]); PG8_STAGE(PG8_SB(0, 1), pB + hstepB, voffB); PG8_STAGE(PG8_SA(0, 1), pA, vA[1]);
    if (wr == 1) PG8_BAR;
    PG8_WAIT_V(4); PG8_BAR;
    PG8_STAGE(PG8_SB(1, 0), pB + kstep, voffB); PG8_STAGE(PG8_SA(1, 0), pA + kstep, vA[0]); PG8_STAGE(PG8_SB(1, 1), pB + hstepB + kstep, voffB); }
    PG8_WAIT_V(6); PG8_BAR;
    for (;;) {
        const bool has_next = S.next(ui + 1, nxt);
        const char* nA = has_next ? pr.abase(nxt) : cA; const char* nB = has_next ? pr.bbase(nxt) : cB; const int nrot = has_next ? PG8_ROT(nxt) : rot;
        if (P::GATHER) { if (has_next) pr.avoff(nxt, RA, CA, vN); }
        for (int t = 0; t < nt; t += 2) {
            const bool last = (t == nt - 2);
            const char* a1 = cA + PG8_KT(t + 1, rot);
            const char* a2 = last ? nA + PG8_KT(0, nrot) : cA + PG8_KT(t + 2, rot); const char* b2 = last ? nB + PG8_KT(0, nrot) : cB + PG8_KT(t + 2, rot);
            const char* a3 = a2 + kstep; const char* b3 = b2 + kstep;
            unsigned v2[2][2];
#pragma unroll
            for (int h = 0; h < 2; ++h)
#pragma unroll
                for (int i = 0; i < 2; ++i) v2[h][i] = (P::GATHER && last) ? vN[h][i] : vA[h][i];
            PG8_LDB(B0, 0, 0); PG8_SCHED; PG8_LDA(At, 0, 0); PG8_STAGE(PG8_SA(1, 1), a1, vA[1]);
            PG8_WAIT_L(8); PG8_BAR; PG8_WAIT_L(0); PG8_MMA(0, 0, At, B0); PG8_BAR; PG8_SCHED;
            PG8_LDB(B1, 0, 1); PG8_STAGE(PG8_SB(0, 0), b2, voffB);
            PG8_BAR; PG8_WAIT_L(0); PG8_MMA(0, 1, At, B1); PG8_BAR;
            PG8_LDA(At, 0, 1); PG8_STAGE(PG8_SA(0, 0), a2, v2[0]);
            PG8_BAR; PG8_WAIT_L(0); PG8_MMA(1, 0, At, B0); PG8_BAR; PG8_SCHED;
            PG8_STAGE(PG8_SB(0, 1), b2 + hstepB, voffB);
            PG8_WAIT_V(6); PG8_BAR; PG8_MMA(1, 1, At, B1); PG8_BAR;
            PG8_LDB(B0, 1, 0); PG8_SCHED; PG8_LDA(At, 1, 0); PG8_STAGE(PG8_SA(0, 1), a2, v2[1]);
            PG8_WAIT_L(8); PG8_BAR; PG8_WAIT_L(0); PG8_MMA(0, 0, At, B0); PG8_BAR; PG8_SCHED;
            PG8_LDB(B1, 1, 1); PG8_STAGE(PG8_SB(1, 0), b3, voffB);
            PG8_BAR; PG8_WAIT_L(0); PG8_MMA(0, 1, At, B1); PG8_BAR;
            PG8_LDA(At, 1, 1); PG8_STAGE(PG8_SA(1, 0), a3, v2[0]);
            PG8_BAR; PG8_WAIT_L(0); PG8_MMA(1, 0, At, B0); PG8_BAR; PG8_SCHED;
            PG8_STAGE(PG8_SB(1, 1), b3 + hstepB, voffB);
            PG8_WAIT_V(6); PG8_BAR; PG8_MMA(1, 1, At, B1); PG8_BAR;
            if (P::GATHER && last) {
#pragma unroll
                for (int h = 0; h < 2; ++h)
#pragma unroll
                    for (int i = 0; i < 2; ++i) vA[h][i] = vN[h][i];
            }
        }
        E(acc, cur, wr, wc, fr, fq);
        if (!has_next) break;
#pragma unroll
        for (int a = 0; a < 2; ++a)
#pragma unroll
            for (int b = 0; b < 2; ++b)
#pragma unroll
                for (int m = 0; m < 4; ++m)
#pragma unroll
                    for (int n = 0; n < 2; ++n) acc[a][b][m][n] = (f32x4){0.f, 0.f, 0.f, 0.f};
        cur = nxt; cA = nA; cB = nB; rot = nrot; ++ui;
    }
    PG8_WAIT_V(0);
    if (wr == 0) PG8_BAR;
    PG8_BAR;
#undef PG8_ROT
#undef PG8_KT
#undef PG8_SA
#undef PG8_SB
#undef PG8_STAGE
#undef PG8_LDA
#undef PG8_LDB
#undef PG8_MMA
#undef PG8_WAIT_V
#undef PG8_WAIT_L
#undef PG8_BAR
#undef PG8_SCHED
}
template <class P, class Epi>
__device__ __forceinline__ void gemm_phase2(LAS unsigned char* lds, const P& pr, const Order& S, const Epi& E) {
    const int tid = tid_opaque(), wid = __builtin_amdgcn_readfirstlane(tid >> 6), lane = tid & 63, wr = wid >> 2, wc = wid & 3, fr = lane & 15, fq = lane >> 4;
    const int nt1 = pr.K1 / BK, nt = (pr.K1 + pr.K2) / BK;
    unsigned R2[2], Rb2[2], C2[2];
#pragma unroll
    for (int i = 0; i < 2; ++i) { int R, C; stage_rc(tid * 16 + i * 8192, R, C); const int Rb = Epi::PERM ? ((R & ~31) + perm32(R & 31)) : R; R2[i] = (unsigned)R * 2u; Rb2[i] = (unsigned)Rb * 2u; C2[i] = (unsigned)C * 2u; }
#define OFF_A(ld, h, i) ((R2[i] + (unsigned)((h) * 256)) * (unsigned)(ld) + C2[i])
#define OFF_B(ld, i) (Rb2[i] * (unsigned)(ld) + C2[i])
    const size_t kstep = (size_t)(BK * 2);
    const size_t hB1 = (size_t)HALF * pr.ldb1 * 2, hB2 = (size_t)HALF * pr.ldb2 * 2;
    const unsigned ldsw = (unsigned)wid * 1024u;
    const int aoff = lds_byte(wr * 64 + fr, fq * 8), boff = lds_byte(wc * 32 + fr, fq * 8);
#define PG8_SA(b, h) (((b) * 2 + (h)) * HTB)
#define PG8_SB(b, h) ((4 + (b) * 2 + (h)) * HTB)
#define PG8_STAGE(bufoff, gbase, voff) do { _Pragma("unroll") for (int _i = 0; _i < 2; ++_i) \
        __builtin_amdgcn_global_load_lds((const unsigned*)((const char*)(gbase) + (voff)[_i]), (LAS unsigned*)(lds + (bufoff) + ldsw + _i * 8192), 16, 0, 0); } while (0)
#define PG8_LDA(dst, b, h) do { _Pragma("unroll") for (int m = 0; m < 4; ++m) _Pragma("unroll") for (int k = 0; k < 2; ++k) dst[m][k] = *(const LAS bf16x8*)(lds + PG8_SA(b, h) + aoff + m * 2048 + k * 1024); } while (0)
#define PG8_LDB(dst, b, h) do { _Pragma("unroll") for (int n = 0; n < 2; ++n) _Pragma("unroll") for (int k = 0; k < 2; ++k) dst[n][k] = *(const LAS bf16x8*)(lds + PG8_SB(b, h) + boff + n * 2048 + k * 1024); } while (0)
#define PG8_MMA(ai, bj, At, Bt) do { __builtin_amdgcn_s_setprio(1); _Pragma("unroll") for (int m = 0; m < 4; ++m) _Pragma("unroll") for (int n = 0; n < 2; ++n) _Pragma("unroll") for (int k = 0; k < 2; ++k) \
        acc[ai][bj][m][n] = __builtin_amdgcn_mfma_f32_16x16x32_bf16(Bt[n][k], At[m][k], acc[ai][bj][m][n], 0, 0, 0); __builtin_amdgcn_s_setprio(0); } while (0)
#define PG8_WAIT_V(n) asm volatile("s_waitcnt vmcnt(" #n ")" ::: "memory")
#define PG8_WAIT_L(n) asm volatile("s_waitcnt lgkmcnt(" #n ")" ::: "memory")
#define PG8_BAR __builtin_amdgcn_s_barrier()
#define PG8_SCHED __builtin_amdgcn_sched_barrier(0)
    Unit cur, nxt; int ui = 0;
    if (!S.next(0, cur)) return;
    f32x4 acc[2][2][4][2];
#pragma unroll
    for (int a = 0; a < 2; ++a)
#pragma unroll
        for (int b = 0; b < 2; ++b)
#pragma unroll
            for (int m = 0; m < 4; ++m)
#pragma unroll
                for (int n = 0; n < 2; ++n) acc[a][b][m][n] = (f32x4){0.f, 0.f, 0.f, 0.f};
    bf16x8 At[4][2], B0[2][2], B1[2][2];
    const char* cA1 = pr.abase1(cur); const char* cB1 = pr.bbase1(cur); const char* cA2 = pr.abase2(cur); const char* cB2 = pr.bbase2(cur);
#define T_A(tt) ((tt) < nt1 ? cA1 + (size_t)(tt) * kstep : cA2 + (size_t)((tt) - nt1) * kstep)
#define T_B(tt) ((tt) < nt1 ? cB1 + (size_t)(tt) * kstep : cB2 + (size_t)((tt) - nt1) * kstep)
    { unsigned vb[2] = {OFF_B(pr.ldb1, 0), OFF_B(pr.ldb1, 1)}, va0[2] = {OFF_A(pr.lda1, 0, 0), OFF_A(pr.lda1, 0, 1)}, va1[2] = {OFF_A(pr.lda1, 1, 0), OFF_A(pr.lda1, 1, 1)};
    PG8_STAGE(PG8_SB(0, 0), cB1, vb); PG8_STAGE(PG8_SA(0, 0), cA1, va0); PG8_STAGE(PG8_SB(0, 1), cB1 + hB1, vb); PG8_STAGE(PG8_SA(0, 1), cA1, va1);
    if (wr == 1) PG8_BAR;
    PG8_WAIT_V(4); PG8_BAR;
    PG8_STAGE(PG8_SB(1, 0), cB1 + kstep, vb); PG8_STAGE(PG8_SA(1, 0), cA1 + kstep, va0); PG8_STAGE(PG8_SB(1, 1), cB1 + hB1 + kstep, vb); }
    PG8_WAIT_V(6); PG8_BAR;
    for (;;) {
        const bool has_next = S.next(ui + 1, nxt);
        const char* nA = has_next ? pr.abase1(nxt) : cA1; const char* nB = has_next ? pr.bbase1(nxt) : cB1;
        for (int t = 0; t < nt; t += 2) {
            const bool last = (t == nt - 2);
            const bool s1 = (t + 1 < nt1), s2 = last || (t + 2 < nt1);
            const char* a1 = T_A(t + 1);
            const char* a2 = last ? nA : T_A(t + 2); const char* b2 = last ? nB : T_B(t + 2);
            const char* a3 = a2 + kstep; const char* b3 = b2 + kstep;
            const size_t hstepB = s2 ? hB1 : hB2; const int ldaT1 = s1 ? pr.lda1 : pr.lda2, ldaT2 = s2 ? pr.lda1 : pr.lda2, ldbT2 = s2 ? pr.ldb1 : pr.ldb2;
            unsigned v2[2][2], voffB[2], vA1s[2];
#pragma unroll
            for (int i = 0; i < 2; ++i) { voffB[i] = OFF_B(ldbT2, i); vA1s[i] = OFF_A(ldaT1, 1, i);
#pragma unroll
                for (int h = 0; h < 2; ++h) v2[h][i] = OFF_A(ldaT2, h, i); }
            PG8_LDB(B0, 0, 0); PG8_SCHED; PG8_LDA(At, 0, 0); PG8_STAGE(PG8_SA(1, 1), a1, vA1s);
            PG8_WAIT_L(8); PG8_BAR; PG8_WAIT_L(0); PG8_MMA(0, 0, At, B0); PG8_BAR; PG8_SCHED;
            PG8_LDB(B1, 0, 1); PG8_STAGE(PG8_SB(0, 0), b2, voffB);
            PG8_BAR; PG8_WAIT_L(0); PG8_MMA(0, 1, At, B1); PG8_BAR;
            PG8_LDA(At, 0, 1); PG8_STAGE(PG8_SA(0, 0), a2, v2[0]);
            PG8_BAR; PG8_WAIT_L(0); PG8_MMA(1, 0, At, B0); PG8_BAR; PG8_SCHED;
            PG8_STAGE(PG8_SB(0, 1), b2 + hstepB, voffB);
            PG8_WAIT_V(6); PG8_BAR; PG8_MMA(1, 1, At, B1); PG8_BAR;
            PG8_LDB(B0, 1, 0); PG8_SCHED; PG8_LDA(At, 1, 0); PG8_STAGE(PG8_SA(0, 1), a2, v2[1]);
            PG8_WAIT_L(8); PG8_BAR; PG8_WAIT_L(0); PG8_MMA(0, 0, At, B0); PG8_BAR; PG8_SCHED;
            PG8_LDB(B1, 1, 1); PG8_STAGE(PG8_SB(1, 0), b3, voffB);
            PG8_BAR; PG8_WAIT_L(0); PG8_MMA(0, 1, At, B1); PG8_BAR;
            PG8_LDA(At, 1, 1); PG8_STAGE(PG8_SA(1, 0), a3, v2[0]);
            PG8_BAR; PG8_WAIT_L(0); PG8_MMA(1, 0, At, B0); PG8_BAR; PG8_SCHED;
            PG8_STAGE(PG8_SB(1, 1), b3 + hstepB, voffB);
            PG8_WAIT_V(6); PG8_BAR; PG8_MMA(1, 1, At, B1); PG8_BAR;
            if (t == nt1 - 2) E.mid(acc, cur, wr, wc, fr, fq);
        }
        E(acc, cur, wr, wc, fr, fq);
        if (!has_next) break;
#pragma unroll
        for (int a = 0; a < 2; ++a)
#pragma unroll
            for (int b = 0; b < 2; ++b)
#pragma unroll
                for (int m = 0; m < 4; ++m)
#pragma unroll
                    for (int n = 0; n < 2; ++n) acc[a][b][m][n] = (f32x4){0.f, 0.f, 0.f, 0.f};
        cur = nxt; cA1 = nA; cB1 = nB; cA2 = pr.abase2(cur); cB2 = pr.bbase2(cur); ++ui;
    }
    PG8_WAIT_V(0);
    if (wr == 0) PG8_BAR;
    PG8_BAR;
#undef T_A
#undef T_B
#undef OFF_A
#undef OFF_B
#undef PG8_SA
#undef PG8_SB
#undef PG8_STAGE
#undef PG8_LDA
#undef PG8_LDB
#undef PG8_MMA
#undef PG8_WAIT_V
#undef PG8_WAIT_L
#undef PG8_BAR
#undef PG8_SCHED
}
}
using pg8::Unit;

struct ProbPlain {
    static constexpr bool GATHER = false;
    const bf16_t* A; const bf16_t* B; int K, lda, ldb;
    __device__ __forceinline__ const char* abase(const Unit& u) const { return (const char*)(A + (size_t)u.pm * 256 * lda); }
    __device__ __forceinline__ const char* bbase(const Unit& u) const { return (const char*)(B + (size_t)u.pn * 256 * ldb); }
    __device__ __forceinline__ void avoff(const Unit&, const int (&RA)[2], const int (&CA)[2], unsigned (&v)[2][2]) const {
#pragma unroll
        for (int h = 0; h < 2; ++h)
#pragma unroll
            for (int i = 0; i < 2; ++i) v[h][i] = (unsigned)((h * 128 + RA[i]) * lda + CA[i]) * 2u;
    }
};
struct ProbMerge {
    const bf16_t* A1; const bf16_t* B1; const bf16_t* A2; const bf16_t* B2; int K1, K2, lda1, ldb1, lda2, ldb2;
    __device__ __forceinline__ const char* abase1(const Unit& u) const { return (const char*)(A1 + (size_t)u.pm * 256 * lda1); }
    __device__ __forceinline__ const char* bbase1(const Unit& u) const { return (const char*)(B1 + (size_t)u.pn * 256 * ldb1); }
    __device__ __forceinline__ const char* abase2(const Unit& u) const { return (const char*)(A2 + (size_t)u.pm * 256 * lda2); }
    __device__ __forceinline__ const char* bbase2(const Unit& u) const { return (const char*)(B2 + (size_t)u.pn * 256 * ldb2); }
};
struct ProbPQ {
    static constexpr bool GATHER = false;
    const bf16_t* A; const bf16_t* B; int K, lda, ldb;
    __device__ __forceinline__ const char* abase(const Unit& u) const { return (const char*)(A + (size_t)u.pm * 256 * lda); }
    __device__ __forceinline__ const char* bbase(const Unit& u) const { return (const char*)(B + ((size_t)(u.pn >> 4) * 4096 + (u.pn & 15)) * 1024); }
    __device__ __forceinline__ void avoff(const Unit&, const int (&RA)[2], const int (&CA)[2], unsigned (&v)[2][2]) const {
#pragma unroll
        for (int h = 0; h < 2; ++h)
#pragma unroll
            for (int i = 0; i < 2; ++i) v[h][i] = (unsigned)((h * 128 + RA[i]) * lda + CA[i]) * 2u;
    }
};
struct ProbMoeUp {
    static constexpr bool GATHER = true;
    const bf16_t* A; unsigned char* ws; float* out; const int* idx; int K, lda, ldb;
    __device__ __forceinline__ const char* abase(const Unit&) const { return (const char*)A; }
    __device__ __forceinline__ const char* bbase(const Unit& u) const { return (const char*)(wgu_ptr(ws, out, u.pm >> 4) + (size_t)u.pn * 256 * ldb); }
    __device__ __forceinline__ void avoff(const Unit& u, const int (&RA)[2], const int (&CA)[2], unsigned (&v)[2][2]) const {
#pragma unroll
        for (int h = 0; h < 2; ++h)
#pragma unroll
            for (int i = 0; i < 2; ++i) { const int g = idx[u.pm * 256 + h * 128 + RA[i]]; v[h][i] = (unsigned)(g * lda + CA[i]) * 2u; }
    }
};
struct ProbMoeDown {
    static constexpr bool GATHER = false;
    const bf16_t* A; unsigned char* ws; float* out; int K, lda, ldb;
    __device__ __forceinline__ const char* abase(const Unit& u) const { return (const char*)(A + (size_t)u.pm * 256 * lda); }
    __device__ __forceinline__ const char* bbase(const Unit& u) const { return (const char*)(wd_ptr(ws, out, u.pm >> 4) + (size_t)u.pn * 256 * ldb); }
    __device__ __forceinline__ void avoff(const Unit&, const int (&RA)[2], const int (&CA)[2], unsigned (&v)[2][2]) const {
#pragma unroll
        for (int h = 0; h < 2; ++h)
#pragma unroll
            for (int i = 0; i < 2; ++i) v[h][i] = (unsigned)((h * 128 + RA[i]) * lda + CA[i]) * 2u;
    }
};

#define EPI_ROWS(...) _Pragma("unroll") for (int ai = 0; ai < 2; ++ai) _Pragma("unroll") for (int m = 0; m < 4; ++m) { const int row = u.pm * 256 + ai * 128 + wr * 64 + m * 16 + fr; __VA_ARGS__ }
__device__ __forceinline__ u32x4 pack8(const f32x4 v0, const f32x4 v1) { u32x4 w; w.x = cvt_pk_bf16(v0[0], v0[1]); w.y = cvt_pk_bf16(v0[2], v0[3]); w.z = cvt_pk_bf16(v1[0], v1[1]); w.w = cvt_pk_bf16(v1[2], v1[3]); return w; }

__device__ __forceinline__ void st_wt16(bf16_t* p, const u32x4 w) {
    asm volatile("global_store_dwordx4 %0, %1, off sc1\n\ts_nop 3" :: "v"(p), "v"(w) : "memory"); }
struct EpiPQ {
    static constexpr bool PERM = true; bf16_t* O;
    __device__ __forceinline__ void operator()(const f32x4 (&acc)[2][2][4][2], const Unit& u, int wr, int wc, int fr, int fq) const {
        const int t10 = wc * 32 + 8 * fq, b = u.pn >> 4, t2 = u.pn & 15;
        EPI_ROWS(
            bf16_t* rp = O + ((size_t)((b * 256 + (row >> 1)) * 16 + t2) * 512 + (row & 1) * 256 + t10);
            if (m == 0 && wr == 0 && fr == 1) {
                bf16_t* sp = O + ((size_t)(32768 + (b * 4 + (row >> 7)) * 16 + t2) * 512 + t10);
                _Pragma("unroll") for (int bj = 0; bj < 2; ++bj) { st_wt16(sp + bj * 128, pack8(acc[ai][bj][m][0], acc[ai][bj][m][1])); st_wt16(sp + 256 + bj * 128, (u32x4){0u, 0u, 0u, 0u}); st_wt16(rp + bj * 128, (u32x4){0u, 0u, 0u, 0u}); }
            } else {
                _Pragma("unroll") for (int bj = 0; bj < 2; ++bj) st_wt16(rp + bj * 128, pack8(acc[ai][bj][m][0], acc[ai][bj][m][1]));
            }
        )
    }
};
struct EpiPlain {
    static constexpr bool PERM = true; bf16_t* O; size_t ldc;
    __device__ __forceinline__ void operator()(const f32x4 (&acc)[2][2][4][2], const Unit& u, int wr, int wc, int fr, int fq) const {
        const int col0 = u.pn * 256 + wc * 32 + 8 * fq;
        EPI_ROWS(
            bf16_t* rp = O + (size_t)row * ldc + col0;
            _Pragma("unroll") for (int bj = 0; bj < 2; ++bj) st_wt16(rp + bj * 128, pack8(acc[ai][bj][m][0], acc[ai][bj][m][1]));
        )
    }
};
struct EpiZ {
    static constexpr bool PERM = true; bf16_t* O; int ldc; int fixed_act;
    __device__ __forceinline__ void operator()(const f32x4 (&acc)[2][2][4][2], const Unit& u, int wr, int wc, int fr, int fq) const {
        const int col0 = u.pn * 256 + wc * 32 + 8 * fq; const int act = fixed_act >= 0 ? fixed_act : (u.pn >> 2);
        if (act >= 2) {
            const int cg = (u.pn - 8) * 128 + wc * 32 + 8 * fq;
            EPI_ROWS(
                bf16_t* rp = O + (size_t)row * ldc + cg;
                f32x4 r0, r1, s0, s1;
                _Pragma("unroll") for (int j = 0; j < 4; ++j) {
                    const float ea0 = __builtin_amdgcn_exp2f(-1.4426950408889634f * acc[ai][0][m][0][j]), ea1 = __builtin_amdgcn_exp2f(-1.4426950408889634f * acc[ai][0][m][1][j]);
                    const float eb0 = fminf(__builtin_amdgcn_exp2f(-1.4426950408889634f * acc[ai][1][m][0][j]), 1e30f), eb1 = fminf(__builtin_amdgcn_exp2f(-1.4426950408889634f * acc[ai][1][m][1][j]), 1e30f);
                    s0[j] = __builtin_amdgcn_rcpf(1.0f + eb0); s1[j] = __builtin_amdgcn_rcpf(1.0f + eb1);
                    r0[j] = (1.0f + eb0) * __builtin_amdgcn_rcpf(1.0f + ea0); r1[j] = (1.0f + eb1) * __builtin_amdgcn_rcpf(1.0f + ea1); }
                *(u32x4*)(rp + 2048) = pack8(r0, r1); *(u32x4*)(rp + 3072) = pack8(s0, s1);
            )
            return;
        }
        EPI_ROWS(
            bf16_t* rp = O + (size_t)row * ldc + col0;
            _Pragma("unroll") for (int bj = 0; bj < 2; ++bj) {
                f32x4 v0 = acc[ai][bj][m][0], v1 = acc[ai][bj][m][1];
                if (act == 1) { _Pragma("unroll") for (int j = 0; j < 4; ++j) { v0[j] = gelu_tanh(v0[j]); v1[j] = gelu_tanh(v1[j]); } }
                *(u32x4*)(rp + bj * 128) = pack8(v0, v1); }
        )
    }
};
struct EpiWT {
    static constexpr bool PERM = true; bf16_t* O; size_t ldc;
    __device__ __forceinline__ void operator()(const f32x4 (&acc)[2][2][4][2], const Unit& u, int wr, int wc, int fr, int fq) const {
        const int col0 = u.pn * 256 + wc * 32 + 8 * fq;
        EPI_ROWS(
            bf16_t* rp = O + (size_t)row * ldc + col0;
            _Pragma("unroll") for (int bj = 0; bj < 2; ++bj) st_wt16(rp + bj * 128, pack8(acc[ai][bj][m][0], acc[ai][bj][m][1]));
        )
    }
};
struct EpiMerge {
    static constexpr bool PERM = true; bf16_t* O; const bf16_t* Z;
    __device__ __forceinline__ void mid(f32x4 (&acc)[2][2][4][2], const Unit& u, int wr, int wc, int fr, int fq) const {
        unsigned eo = (unsigned)((u.pm * 256 + wr * 64 + fr) * 4096 + 2048 + u.pn * 256 + wc * 32 + 8 * fq);
        asm volatile("" : "+v"(eo));
#pragma unroll
        for (int ai = 0; ai < 2; ++ai) {
            u32x4 wa[4][2];
#pragma unroll
            for (int m = 0; m < 4; ++m)
#pragma unroll
                for (int bj = 0; bj < 2; ++bj) { const unsigned o = eo + (unsigned)((ai * 128 + m * 16) * 4096 + bj * 128); wa[m][bj] = __builtin_nontemporal_load((const u32x4*)(Z + o)); }
#pragma unroll
            for (int m = 0; m < 4; ++m)
#pragma unroll
                for (int bj = 0; bj < 2; ++bj) { float ga[8]; unpack8(wa[m][bj], ga);
#pragma unroll
                    for (int j = 0; j < 4; ++j) { acc[ai][bj][m][0][j] *= ga[j]; acc[ai][bj][m][1][j] *= ga[4 + j]; } }
            __builtin_amdgcn_sched_barrier(0); }
    }
    __device__ __forceinline__ void operator()(const f32x4 (&acc)[2][2][4][2], const Unit& u, int wr, int wc, int fr, int fq) const {
        unsigned eo = (unsigned)((u.pm * 256 + wr * 64 + fr) * 4096 + 3072 + u.pn * 256 + wc * 32 + 8 * fq); asm volatile("" : "+v"(eo));
        unsigned oo = (unsigned)((u.pm * 256 + wr * 64 + fr) * 1024 + u.pn * 256 + wc * 32 + 8 * fq); asm volatile("" : "+v"(oo));
        u32x4 wb[2][4][2];
#pragma unroll
        for (int ai = 0; ai < 2; ++ai)
#pragma unroll
            for (int m = 0; m < 4; ++m)
#pragma unroll
                for (int bj = 0; bj < 2; ++bj) wb[ai][m][bj] = __builtin_nontemporal_load((const u32x4*)(Z + eo + (unsigned)((ai * 128 + m * 16) * 4096 + bj * 128)));
#pragma unroll
        for (int ai = 0; ai < 2; ++ai)
#pragma unroll
            for (int m = 0; m < 4; ++m)
#pragma unroll
                for (int bj = 0; bj < 2; ++bj) { float g[8]; unpack8(wb[ai][m][bj], g);
                    f32x4 v0 = acc[ai][bj][m][0], v1 = acc[ai][bj][m][1];
#pragma unroll
                    for (int j = 0; j < 4; ++j) { v0[j] *= g[j]; v1[j] *= g[4 + j]; }
                    *(u32x4*)(O + oo + (unsigned)((ai * 128 + m * 16) * 1024 + bj * 128)) = pack8(v0, v1); }
    }
};
struct EpiOut {
    static constexpr bool PERM = true; bf16_t* O; const float* X; const float* pos; const float* ada;
    __device__ __forceinline__ void operator()(const f32x4 (&acc)[2][2][4][2], const Unit& u, int wr, int wc, int fr, int fq) const {
        const int col0 = u.pn * 256 + wc * 32 + 8 * fq; const int b = u.pm >> 4;
        unsigned ro = (unsigned)((u.pm * 256 + wr * 64 + fr) * 1024 + col0); asm volatile("" : "+v"(ro));
#pragma unroll
        for (int ai = 0; ai < 2; ++ai)
#pragma unroll
            for (int mh = 0; mh < 2; ++mh) {
                f32x4 xv[2][2][2];
#pragma unroll
                for (int m2 = 0; m2 < 2; ++m2)
#pragma unroll
                    for (int bj = 0; bj < 2; ++bj)
#pragma unroll
                        for (int n = 0; n < 2; ++n) xv[m2][bj][n] = __builtin_nontemporal_load((const f32x4*)(X + ro + (unsigned)((ai * 128 + (mh * 2 + m2) * 16) * 1024 + bj * 128 + n * 4)));
#pragma unroll
                for (int m2 = 0; m2 < 2; ++m2) { const int m = mh * 2 + m2; const int row = u.pm * 256 + ai * 128 + wr * 64 + m * 16 + fr; const int t = row & 4095;
#pragma unroll
                    for (int bj = 0; bj < 2; ++bj) { f32x4 o[2];
#pragma unroll
                        for (int n = 0; n < 2; ++n) { const int col = col0 + bj * 128 + n * 4;
                            const f32x4 pv = *(const f32x4*)(pos + (col < 512 ? (t >> 6) * 512 + col : (t & 63) * 512 + (col - 512)));
                            const f32x4 gv = *(const f32x4*)(ada + b * 6144 + 2048 + col);
                            o[n] = xv[m2][bj][n] + pv + gv * acc[ai][bj][m][n]; }
                        *(u32x4*)(O + ro + (unsigned)((ai * 128 + m * 16) * 1024 + bj * 128)) = pack8(o[0], o[1]); } }
                __builtin_amdgcn_sched_barrier(0); }
    }
};
struct EpiGU {
    static constexpr bool PERM = true; bf16_t* O;
    __device__ __forceinline__ void operator()(const f32x4 (&acc)[2][2][4][2], const Unit& u, int wr, int wc, int fr, int fq) const {
        const int col0 = u.pn * 128 + wc * 32 + 8 * fq;
        EPI_ROWS(
            f32x4 v0, v1;
            _Pragma("unroll") for (int j = 0; j < 4; ++j) { const float g0 = acc[ai][0][m][0][j], g1 = acc[ai][0][m][1][j];
                v0[j] = g0 * sigmoidf_(g0) * acc[ai][1][m][0][j]; v1[j] = g1 * sigmoidf_(g1) * acc[ai][1][m][1][j]; }
            *(u32x4*)(O + (size_t)row * DE + col0) = pack8(v0, v1);
        )
    }
};
struct EpiDown {
    static constexpr bool PERM = true; bf16_t* O; const float* gate;
    __device__ __forceinline__ void operator()(const f32x4 (&acc)[2][2][4][2], const Unit& u, int wr, int wc, int fr, int fq) const {
        const int col0 = u.pn * 256 + wc * 32 + 8 * fq;
        EPI_ROWS(
            const float g = gate[row];
            _Pragma("unroll") for (int bj = 0; bj < 2; ++bj) *(u32x4*)(O + (size_t)row * 1024 + col0 + bj * 128) = pack8(acc[ai][bj][m][0] * g, acc[ai][bj][m][1] * g);
        )
    }
};

__device__ __forceinline__ void p0_ada(const Params& p, LAS unsigned char* lds, int item) {
    const int tid = threadIdx.x, lane = tid & 63, wv = tid >> 6;
    LAS float* s = (LAS float*)lds; LAS float* red = s + 9 * 1024;
    { float cv[18];
#pragma unroll
      for (int k = 0; k < 18; ++k) { const int i = tid + NTHR * k, r = i >> 10, d = i & 1023; cv[k] = r < 8 ? p.c[r * 1024 + d] : p.c_ctx[d]; }
#pragma unroll
      for (int k = 0; k < 18; ++k) s[tid + NTHR * k] = cv[k] * __builtin_amdgcn_rcpf(1.0f + __expf(-cv[k])); }
    __syncthreads();
    const int col = lane % 24, dh = lane / 24;
    const int dsl = wv * 128 + dh * 64;
    float a[9];
#pragma unroll
    for (int r = 0; r < 9; ++r) a[r] = 0.f;
    if (dh < 2) {
        const float* w = p.w_ada + (size_t)dsl * 6144 + item * 24 + col;
        for (int d0 = 0; d0 < 64; d0 += 32) { float wv2[32];
#pragma unroll
            for (int j = 0; j < 32; ++j) wv2[j] = __builtin_nontemporal_load(w + (size_t)(d0 + j) * 6144);
#pragma unroll
            for (int j = 0; j < 32; ++j)
#pragma unroll
                for (int r = 0; r < 9; ++r) a[r] += s[r * 1024 + dsl + d0 + j] * wv2[j]; }
#pragma unroll
        for (int r = 0; r < 9; ++r) red[((wv * 2 + dh) * 9 + r) * 24 + col] = a[r];
    }
    __syncthreads();
    float* ada = (float*)(p.ws + WS_ADA);
    if (tid < 9 * 24) { const int r = tid / 24, cc = tid % 24; float v = 0.f;
#pragma unroll
        for (int k = 0; k < 16; ++k) v += red[(k * 9 + r) * 24 + cc];
        __hip_atomic_store(ada + r * 6144 + item * 24 + cc, v + p.b_ada[item * 24 + cc], __ATOMIC_RELAXED, __HIP_MEMORY_SCOPE_AGENT); }
    asm volatile("s_waitcnt vmcnt(0)" ::: "memory");
    __syncthreads();
    if (tid == 0) (void)__hip_atomic_fetch_add((unsigned*)(p.ws + WS_BAR + 46 * KiB), 1u, __ATOMIC_RELAXED, __HIP_MEMORY_SCOPE_AGENT);
}
template <int NS, bool WTST = false>
__device__ __forceinline__ void xpose_item(const float* src, int ldsrc, bf16_t* dst, int lddst, int k0, int n0, int mode, float scale = 1.0f) {
    const int tid = threadIdx.x, k8 = tid & 7, nq = tid >> 3;
    if (nq >= 16 * NS) return;
    f32x4 v[8];
#pragma unroll
    for (int j = 0; j < 8; ++j) v[j] = __builtin_nontemporal_load((const f32x4*)(src + (size_t)(k0 + 8 * k8 + j) * ldsrc + n0 + 4 * nq));
#pragma unroll
    for (int c = 0; c < 4; ++c) { const int n = n0 + 4 * nq + c; int row = n;
        if (mode) row = (n >> 7) * 256 + (n & 127) + (mode == 2 ? 128 : 0);
        u32x4 w; w.x = cvt_pk_bf16(v[0][c] * scale, v[1][c] * scale); w.y = cvt_pk_bf16(v[2][c] * scale, v[3][c] * scale); w.z = cvt_pk_bf16(v[4][c] * scale, v[5][c] * scale); w.w = cvt_pk_bf16(v[6][c] * scale, v[7][c] * scale);
        if (WTST) st_wt16(dst + (size_t)row * lddst + k0 + 8 * k8, w); else *(u32x4*)(dst + (size_t)row * lddst + k0 + 8 * k8) = w; }
}
__device__ __forceinline__ void p0_wpq(const Params& p, LAS unsigned char* lds, int item) {
    const int tid = threadIdx.x, g = item >> 5, db = item & 31;
    LAS float* wl = (LAS float*)lds; LAS float* ct = wl + 32 * 129;
    for (int i = tid; i < 32 * 128; i += NTHR) { const int d = i >> 7, cc = i & 127; wl[d * 129 + cc] = p.w_in[(size_t)(db * 32 + d) * 4608 + g * 128 + cc]; }
    if (tid < 128) { float sn, cs; sincospif((float)tid * (1.0f / 64.0f), &sn, &cs); ct[tid] = cs; ct[128 + tid] = sn; }
    __syncthreads();
    const int q = tid & 127, kc = q >> 1, pq = q & 1, dh = tid >> 7; const int n = (g * 64 + kc) * 2 + pq;
    const bool spec = (kc == 0 && pq == 1); const int kce = spec ? 64 : kc, tsel = spec ? 0 : pq * 128;
    bf16_t* dst = (bf16_t*)(p.ws + WS_WPQ) + (size_t)n * 1024 + db * 32 + dh * 8;
    const float scale = 0.001381067932f;
    float a[8];
#pragma unroll
    for (int j = 0; j < 8; ++j) a[j] = 0.f;
    for (int cc = 0; cc < 128; ++cc) { const float tv = ct[tsel + ((cc * kce) & 127)];
#pragma unroll
        for (int j = 0; j < 8; ++j) a[j] += wl[(dh * 8 + j) * 129 + cc] * tv; }
    u32x4 w; w.x = cvt_pk_bf16(a[0] * scale, a[1] * scale); w.y = cvt_pk_bf16(a[2] * scale, a[3] * scale); w.z = cvt_pk_bf16(a[4] * scale, a[5] * scale); w.w = cvt_pk_bf16(a[6] * scale, a[7] * scale);
    *(u32x4*)dst = w;
    __syncthreads();
}
__device__ __forceinline__ void p0_d1t(const Params& p, int item) {
    bf16_t* dst = (bf16_t*)(p.ws + WS_D1T);
    const int row = item * 64 + (threadIdx.x >> 3), k1 = row >> 1, ri = row & 1, c0 = (threadIdx.x & 7) * 64;
    for (int c8 = 0; c8 < 64; c8 += 8) { float v[8];
#pragma unroll
        for (int j = 0; j < 8; ++j) { const int col = c0 + c8 + j, pq = col >> 8, t1 = col & 255; float sn, cs; sincospif((float)((k1 * t1) & 255) * (1.0f / 128.0f), &sn, &cs);
            v[j] = (ri == 0) ? (pq == 0 ? cs : -sn) : (pq == 0 ? -sn : -cs); }
        u32x4 w; w.x = cvt_pk_bf16(v[0], v[1]); w.y = cvt_pk_bf16(v[2], v[3]); w.z = cvt_pk_bf16(v[4], v[5]); w.w = cvt_pk_bf16(v[6], v[7]);
        *(u32x4*)(dst + (size_t)row * 512 + c0 + c8) = w; }
}
__device__ __forceinline__ void p0_d2t(const Params& p, int item) {
    bf16_t* dst = (bf16_t*)(p.ws + WS_D2T);
#pragma unroll
    for (int ps = 0; ps < 4; ++ps) { const int pc = (item * 4 + ps) * NTHR + threadIdx.x, tp = pc >> 2, kk0 = (pc & 3) * 8; float v[8];
#pragma unroll
        for (int j = 0; j < 8; ++j) { const int kk = kk0 + j, ri = kk >> 4, t2 = kk & 15; float sn, cs; sincospif((float)((tp * t2) & 4095) * (1.0f / 2048.0f), &sn, &cs); v[j] = ri ? sn : cs; }
        u32x4 w; w.x = cvt_pk_bf16(v[0], v[1]); w.y = cvt_pk_bf16(v[2], v[3]); w.z = cvt_pk_bf16(v[4], v[5]); w.w = cvt_pk_bf16(v[6], v[7]);
        *(u32x4*)(dst + (size_t)tp * 32 + kk0) = w; }
}
__device__ __forceinline__ void p0_pos(const Params& p, int item) {
    float* tab = (float*)(p.ws + WS_POS);
    for (int i = item * 2048 + threadIdx.x; i < (item + 1) * 2048; i += NTHR) { const int ii = i >> 9, j = i & 511, jj = j & 255; const float f = expf(-9.210340371976184f * (float)jj / 256.0f); const float a = (float)ii * f;
        __hip_atomic_store(tab + i, j < 256 ? sinf(a) : cosf(a), __ATOMIC_RELAXED, __HIP_MEMORY_SCOPE_AGENT); }
    asm volatile("s_waitcnt vmcnt(0)" ::: "memory");
    __syncthreads();
    if (threadIdx.x == 0) (void)__hip_atomic_fetch_add((unsigned*)(p.ws + WS_BAR + 46 * KiB), 1u, __ATOMIC_RELAXED, __HIP_MEMORY_SCOPE_AGENT);
}
__device__ __forceinline__ void p0_lrup(const Params& p) {
    float* t = (float*)(p.ws + WS_LRUP);
    for (int i = threadIdx.x; i < 2048; i += NTHR) { const float lam = p.lru_lambda[i]; t[i] = NLOG2E * 8.0f * log1pf(expf(-lam)); t[2048 + i] = NLOG2E * p.lru_ba[i]; t[4096 + i] = NLOG2E * p.lru_bi[i]; }
}
__device__ __forceinline__ void phase0(const Params& p, LAS unsigned char* lds) {
    constexpr int N_ADA = 256, N_WIN = 16 * 16, N_WFOUR = 8 * 4, N_SQ = 16 * 4, N_LRU = 16 * 2, N_WPQ = 128, N_DFT = 8 + 8, N_POS = 16;
    constexpr int O1 = N_ADA, O2 = O1 + N_WIN, O3 = O2 + N_WFOUR, O4 = O3 + N_SQ, O5 = O4 + N_SQ, O6 = O5 + N_LRU, O7 = O6 + N_LRU, O8 = O7 + N_WPQ, O9 = O8 + N_DFT, O10 = O9 + N_POS + 1;
    for (int it0 = blockIdx.x; it0 < O10; it0 += gridDim.x) {
        if (it0 < O1) { p0_ada(p, lds, it0); continue; }
        if (it0 < O1 + N_POS) { p0_pos(p, it0 - O1); continue; }
        const int it = it0 - N_POS;
        if (it < O2) { const int j = it - O1, ct = j & 15;
            if (ct < 8) xpose_item<4>(p.w_in + 512, 4608, (bf16_t*)(p.ws + WS_WIN), 1024, (j >> 4) * 64, ct * 256, 0);
            else if (ct < 12) xpose_item<4>(p.w_in + 512 + 2048, 4608, (bf16_t*)(p.ws + WS_WIN) + (size_t)2048 * 1024, 1024, (j >> 4) * 64, (ct - 8) * 256, 1);
            else xpose_item<4>(p.w_in + 512 + 3072, 4608, (bf16_t*)(p.ws + WS_WIN) + (size_t)2048 * 1024, 1024, (j >> 4) * 64, (ct - 12) * 256, 2); }
        else if (it < O3) { const int j = it - O2; xpose_item<4>(p.w_four, 1024, (bf16_t*)(p.ws + WS_WFOUR), 512, (j >> 2) * 64, (j & 3) * 256, 0); }
        else if (it < O4) { const int j = it - O3; xpose_item<4>(p.w_lru, 1024, (bf16_t*)(p.ws + WS_WLRU), 1024, (j >> 2) * 64, (j & 3) * 256, 0); }
        else if (it < O5) { const int j = it - O4; xpose_item<4>(p.w_out, 1024, (bf16_t*)(p.ws + WS_WOUT), 1024, (j >> 2) * 64, (j & 3) * 256, 0); }
        else if (it < O6) { const int j = it - O5, mtx = j >> 1; xpose_item<2>(p.lru_wa + (size_t)mtx * 16384, 128, (bf16_t*)(p.ws + WS_WAT) + (size_t)mtx * 16384, 128, (j & 1) * 64, 0, 0, NLOG2E); }
        else if (it < O7) { const int j = it - O6, mtx = j >> 1; xpose_item<2>(p.lru_wi + (size_t)mtx * 16384, 128, (bf16_t*)(p.ws + WS_WIT) + (size_t)mtx * 16384, 128, (j & 1) * 64, 0, 0, NLOG2E); }
        else if (it < O8) p0_wpq(p, lds, it - O7);
        else { if (it - O8 < 8) p0_d1t(p, it - O8); else if (it - O8 < 16) p0_d2t(p, it - O8 - 8); else p0_lrup(p); }
    }
}

__device__ __forceinline__ void phase1(const Params& p) {
    const int tid = tid_opaque(), lane = tid & 63, wid = tid >> 6;
    const float* ada = (const float*)(p.ws + WS_ADA); const float* tab = (const float*)(p.ws + WS_POS);
    bf16_t* h1 = (bf16_t*)(p.ws + WS_R1); bf16_t* hc = (bf16_t*)(p.ws + WS_HCTX);
    constexpr int NR = MLAT + MCTX, RW = 4;
    for (int row0 = (blockIdx.x * 8 + wid) * RW; row0 < NR; row0 += gridDim.x * 8 * RW) {
        const bool lat = row0 < MLAT; const int mrow = lat ? (row0 >> 12) : 8;
        f32x4 v[RW][4]; float ss[RW];
#pragma unroll
        for (int r = 0; r < RW; ++r) { const int row = row0 + r; const float* xr = lat ? p.x + (size_t)row * 1024 : p.ctx + (size_t)(row - MLAT) * 1024;
#pragma unroll
            for (int i = 0; i < 4; ++i) v[r][i] = __builtin_nontemporal_load((const f32x4*)(xr + 256 * i + 4 * lane)); }
#pragma unroll
        for (int r = 0; r < RW; ++r) { const int t = (row0 + r) & 4095; float a = 0.f;
#pragma unroll
            for (int i = 0; i < 4; ++i) { const int d = 256 * i + 4 * lane;
                if (lat) v[r][i] += *(const f32x4*)(tab + (i < 2 ? (t >> 6) * 512 + d : (t & 63) * 512 + d - 512));
                a += v[r][i][0] * v[r][i][0] + v[r][i][1] * v[r][i][1] + v[r][i][2] * v[r][i][2] + v[r][i][3] * v[r][i][3]; }
            ss[r] = a; }
#pragma unroll
        for (int o = 32; o >= 1; o >>= 1) {
#pragma unroll
            for (int r = 0; r < RW; ++r) ss[r] += __shfl_xor(ss[r], o); }
#pragma unroll
        for (int i = 0; i < 4; ++i) { const int d = 256 * i + 4 * lane;
            const f32x4 g = *(const f32x4*)(p.norm1_g + d), sh = *(const f32x4*)(ada + mrow * 6144 + d), sc = *(const f32x4*)(ada + mrow * 6144 + 1024 + d);
#pragma unroll
            for (int r = 0; r < RW; ++r) { const int row = row0 + r; const float rs = rsqrtf(ss[r] * (1.0f / 1024.0f) + 1e-6f);
                bf16_t* dst = lat ? h1 + (size_t)row * 1024 : hc + (size_t)(row - MLAT) * 1024;
                const f32x4 h = v[r][i] * rs * g * (sc + 1.0f) + sh;
                u32x2 w; w.x = cvt_pk_bf16(h[0], h[1]); w.y = cvt_pk_bf16(h[2], h[3]); *(u32x2*)(dst + d) = w; } }
    }
}

#define LRU_CST(mb, r) (32 * (mb) + 8 * ((r) >> 2) + ((r) & 3))
template <bool FINAL, int DIR>
__device__ __forceinline__ void lru_wave(const Params& p, LAS unsigned char* ul, int b, int sc, int head, int cb, int lane, f32x16 (&accI)[4]) {
    constexpr int SG = DIR ? -1 : 1;
    const int lr = lane & 31, lh = lane >> 5;
    const int chl = cb * 32 + lr, ch = head * 128 + chl;
    const int tbase = DIR ? 127 - 4 * lh : 4 * lh;
    f32x16 accA[4];
#pragma unroll
    for (int mb = 0; mb < 4; ++mb)
#pragma unroll
        for (int r = 0; r < 16; ++r) { accA[mb][r] = 0.f; accI[mb][r] = 0.f; }
    {
        const bf16_t* wa = (const bf16_t*)(p.ws + WS_WAT) + ((size_t)(DIR * 8 + head) * 128 + chl) * 128 + 8 * lh;
        const bf16_t* wi = (const bf16_t*)(p.ws + WS_WIT) + ((size_t)(DIR * 8 + head) * 128 + chl) * 128 + 8 * lh;
        LAS unsigned char* arow0 = ul + (DIR ? 127 - lr : lr) * 272 + lh * 16;
#pragma unroll
        for (int kc = 0; kc < 2; ++kc) { bf16x8 bA[4], bI[4];
#pragma unroll
            for (int k4 = 0; k4 < 4; ++k4) { bA[k4] = *(const bf16x8*)(wa + 16 * (kc * 4 + k4)); bI[k4] = *(const bf16x8*)(wi + 16 * (kc * 4 + k4)); }
#pragma unroll
            for (int mb = 0; mb < 4; ++mb)
#pragma unroll
                for (int k4 = 0; k4 < 4; ++k4) { const bf16x8 af = *(const LAS bf16x8*)(arow0 + SG * 32 * mb * 272 + 32 * (kc * 4 + k4));
                    accA[mb] = __builtin_amdgcn_mfma_f32_32x32x16_bf16(af, bA[k4], accA[mb], 0, 0, 0);
                    accI[mb] = __builtin_amdgcn_mfma_f32_32x32x16_bf16(af, bI[k4], accI[mb], 0, 0, 0); }
            __builtin_amdgcn_sched_barrier(0); }
    }
    {
        const float lam = p.lru_lambda[DIR * 1024 + ch]; const float sp8 = 8.0f * log1pf(expf(-lam));
        const float ba = p.lru_ba[DIR * 1024 + ch], bi = p.lru_bi[DIR * 1024 + ch];
        LAS unsigned char* up = ul + tbase * 272 + chl * 2;
#pragma unroll
        for (int mb = 0; mb < 4; ++mb) {
#pragma unroll
            for (int r = 0; r < 16; ++r) {
                const float uv = bf2f(*(const LAS bf16_t*)(up + SG * LRU_CST(mb, r) * 272));
                const float rg = __builtin_amdgcn_rcpf(1.0f + __builtin_amdgcn_exp2f(accA[mb][r] + NLOG2E * ba)), ig = __builtin_amdgcn_rcpf(1.0f + __builtin_amdgcn_exp2f(accI[mb][r] + NLOG2E * bi));
                const float a = __expf(-sp8 * rg); accA[mb][r] = a; accI[mb][r] = __builtin_amdgcn_sqrtf(fmaxf(1.0f - a * a, 0.f)) * ig * uv; }
            __builtin_amdgcn_sched_barrier(0); }
    }
    float rA[16], rH[16];
#pragma unroll
    for (int mb = 0; mb < 4; ++mb)
#pragma unroll
        for (int q = 0; q < 4; ++q) { float pa = 1.f, hh = 0.f;
#pragma unroll
            for (int j = 0; j < 4; ++j) { const int r = 4 * q + j; const float a = accA[mb][r], bb = accI[mb][r]; hh = a * hh + bb; pa *= a; accA[mb][r] = pa; accI[mb][r] = hh; }
            rA[mb * 4 + q] = pa; rH[mb * 4 + q] = hh; }
    const int agg_dir_off = ((b * NSEQ) * 2 + DIR) * 1024 + ch;
    const float* agg = (const float*)(p.ws + WS_AGG);
    float carry = 0.f;
    if (FINAL) {
        if (DIR == 0) { for (int q = 0; q < sc; ++q) { const float* a2 = agg + (size_t)(agg_dir_off + q * 2048) * 2; carry = a2[0] * carry + a2[1]; } }
        else { { const float* a2 = agg + (size_t)(agg_dir_off + 1 * 2048) * 2; carry = a2[0] * carry + a2[1]; } { const float* a2 = agg + (size_t)(agg_dir_off + 0 * 2048) * 2; carry = a2[0] * carry + a2[1]; }
            for (int q = NSEQ - 1; q > sc; --q) { const float* a2 = agg + (size_t)(agg_dir_off + q * 2048) * 2; carry = a2[0] * carry + a2[1]; } }
    }
    float cin[16];
#pragma unroll
    for (int i = 0; i < 16; ++i) cin[i] = 0.f;
    float s = carry, At = 1.f;
#pragma unroll
    for (int i = 0; i < 16; ++i) { const float oA = __shfl_xor(rA[i], 32), oH = __shfl_xor(rH[i], 32);
        { const bool mine = (lh == 0); const float a = mine ? rA[i] : oA, hh = mine ? rH[i] : oH; cin[i] = mine ? s : cin[i]; s = a * s + hh; At *= a; }
        { const bool mine = (lh == 1); const float a = mine ? rA[i] : oA, hh = mine ? rH[i] : oH; cin[i] = mine ? s : cin[i]; s = a * s + hh; At *= a; } }
    if (!FINAL) {
        if (lh == 0) { float* o = (float*)(p.ws + WS_AGG) + (size_t)(agg_dir_off + sc * 2048) * 2; o[0] = At; o[1] = s; }
        return;
    }
#pragma unroll
    for (int mb = 0; mb < 4; ++mb)
#pragma unroll
        for (int r = 0; r < 16; ++r) accI[mb][r] += accA[mb][r] * cin[mb * 4 + (r >> 2)];
}
template <bool FINAL>
__device__ __forceinline__ void lru_tile(const Params& p, LAS unsigned char* lds, int item) {
    const int tid = threadIdx.x, lane = tid & 63, wid = __builtin_amdgcn_readfirstlane(tid >> 6);
    int b, sc, head;
    if (FINAL) { head = item & 7; sc = 2 + ((item >> 3) & 31); b = item >> 8; }
    else { head = item & 7; const int r = item >> 3; sc = r & 1; b = r >> 1; }
    const bf16_t* src; int Tseq, t0, ld;
    if (sc < 2) { src = (const bf16_t*)(p.ws + WS_ZXC) + (size_t)b * 256 * 1024; Tseq = 256; t0 = sc * 128; ld = 1024; }
    else { src = (const bf16_t*)(p.ws + WS_RZ) + (size_t)b * 4096 * 4096; Tseq = 4096; t0 = (sc - 2) * 128; ld = 4096; }
    LAS unsigned char* ul = lds;
    LAS float* ybuf = (LAS float*)(lds + 36 * 1024);
    {
        const int c8 = tid & 15, tb = tid >> 4; const int ch0 = head * 128 + 8 * c8;
        float w[4][8], bias[8];
#pragma unroll
        for (int k = 0; k < 4; ++k) { const f32x4 a = *(const f32x4*)(p.conv_w + k * 1024 + ch0), c2 = *(const f32x4*)(p.conv_w + k * 1024 + ch0 + 4);
#pragma unroll
            for (int j = 0; j < 4; ++j) { w[k][j] = a[j]; w[k][4 + j] = c2[j]; } }
        { const f32x4 a = *(const f32x4*)(p.conv_b + ch0), c2 = *(const f32x4*)(p.conv_b + ch0 + 4);
#pragma unroll
            for (int j = 0; j < 4; ++j) { bias[j] = a[j]; bias[4 + j] = c2[j]; } }
#pragma unroll
        for (int i = 0; i < 4; ++i) { const int t = tb + 32 * i; float a[8];
#pragma unroll
            for (int j = 0; j < 8; ++j) a[j] = bias[j];
#pragma unroll
            for (int k = 0; k < 4; ++k) { const int tt = t0 + t + k - 2;
                if (tt >= 0 && tt < Tseq) { float f[8]; unpack8(*(const u32x4*)(src + (size_t)tt * ld + ch0), f);
#pragma unroll
                    for (int j = 0; j < 8; ++j) a[j] += w[k][j] * f[j]; } }
            u32x4 wv; wv.x = cvt_pk_bf16(a[0], a[1]); wv.y = cvt_pk_bf16(a[2], a[3]); wv.z = cvt_pk_bf16(a[4], a[5]); wv.w = cvt_pk_bf16(a[6], a[7]);
            *(LAS u32x4*)(ul + t * 272 + c8 * 16) = wv; }
    }
    __syncthreads();
    f32x16 hacc[4];
    if (wid < 4) lru_wave<FINAL, 0>(p, ul, b, sc, head, wid & 3, lane, hacc);
    else lru_wave<FINAL, 1>(p, ul, b, sc, head, wid & 3, lane, hacc);
    if (FINAL) {
        const int lr = lane & 31, lh = lane >> 5, chl = (wid & 3) * 32 + lr;
        if (wid >= 4) { LAS float* yp = ybuf + (127 - 4 * lh) * 129 + chl;
#pragma unroll
            for (int mb = 0; mb < 4; ++mb)
#pragma unroll
                for (int r = 0; r < 16; ++r) yp[-LRU_CST(mb, r) * 129] = hacc[mb][r]; }
        __syncthreads();
        if (wid < 4) {
            const LAS float* yp = ybuf + (4 * lh) * 129 + chl;
            const bf16_t* Zu = (const bf16_t*)(p.ws + WS_RZ) + ((size_t)(b * 4096 + t0) * 4096 + 1024 + head * 128);
            bf16_t* Ou = (bf16_t*)(p.ws + WS_R1) + ((size_t)(b * 4096 + t0) * 1024 + head * 128);
            const unsigned zo = (unsigned)(4 * lh * 4096 + chl), oo = (unsigned)(4 * lh * 1024 + chl);
#pragma unroll
            for (int mb = 0; mb < 4; ++mb) {
#pragma unroll
                for (int r = 0; r < 16; ++r) {
                    const float y = hacc[mb][r] + yp[LRU_CST(mb, r) * 129];
                    const float gz = bf2f(Zu[zo + LRU_CST(mb, r) * 4096]);
                    Ou[oo + LRU_CST(mb, r) * 1024] = (bf16_t)(cvt_pk_bf16(gz * y, 0.f) & 0xffffu);
                    if ((r & 7) == 7) __builtin_amdgcn_sched_barrier(0); } }
        }
    }
    __syncthreads();
}

#ifndef LRU_PF_FRAG
#define LRU_PF_FRAG true
#endif
#ifndef LRU_PF_TILE
#define LRU_PF_TILE true
#endif
__device__ __forceinline__ float shfl_lane(float v, int src) { return __int_as_float(__builtin_amdgcn_ds_bpermute(src << 2, __float_as_int(v))); }
template <int DIR, bool PREF>
__device__ __forceinline__ void lru2_dir(const Params& p, LAS unsigned char* ul, int head, int w, int lane, const bf16x8 (&bA)[4], const bf16x8 (&bI)[4], bf16x8 (&nA)[4], bf16x8 (&nI)[4],
                                         f32x4 (&hl)[8], f32x4 (&pp)[8], float& Atot, float& Htot, const float k2, const float ba2, const float bi2) {
    constexpr int SG = DIR ? -1 : 1;
    const int fr = lane & 15, fq = lane >> 4, chl = 16 * w + fr, ch = head * 128 + chl;
    f32x4 accA[8], accI[8];
    {
#pragma unroll
      for (int rb = 0; rb < 8; ++rb) { accA[rb] = (f32x4){ba2, ba2, ba2, ba2}; accI[rb] = (f32x4){bi2, bi2, bi2, bi2}; } }
    {
        LAS unsigned char* arow0 = ul + (DIR ? 127 - fr : fr) * 272 + fq * 16;
#pragma unroll
        for (int rb = 0; rb < 8; ++rb)
#pragma unroll
            for (int ks = 0; ks < 4; ++ks) { const bf16x8 af = *(const LAS bf16x8*)(arow0 + SG * 16 * rb * 272 + 64 * ks);
                accA[rb] = __builtin_amdgcn_mfma_f32_16x16x32_bf16(af, bA[ks], accA[rb], 0, 0, 0);
                accI[rb] = __builtin_amdgcn_mfma_f32_16x16x32_bf16(af, bI[ks], accI[rb], 0, 0, 0); }
    }
    if (PREF) {
        const bf16_t* wa = (const bf16_t*)(p.ws + WS_WAT) + ((size_t)((1 - DIR) * 8 + head) * 128 + chl) * 128 + 8 * fq;
        const bf16_t* wi = (const bf16_t*)(p.ws + WS_WIT) + ((size_t)((1 - DIR) * 8 + head) * 128 + chl) * 128 + 8 * fq;
#pragma unroll
        for (int ks = 0; ks < 4; ++ks) { nA[ks] = *(const bf16x8*)(wa + 32 * ks); nI[ks] = *(const bf16x8*)(wi + 32 * ks); }
    }
    {
        typedef float f32x2 __attribute__((ext_vector_type(2)));
        LAS unsigned char* up = ul + (DIR ? 127 - 4 * fq : 4 * fq) * 272 + chl * 2;
#pragma unroll
        for (int rb = 0; rb < 8; ++rb)
#pragma unroll
            for (int r = 0; r < 4; r += 2) {
                f32x2 uv; uv.x = bf2f(*(const LAS bf16_t*)(up + SG * (16 * rb + r) * 272)); uv.y = bf2f(*(const LAS bf16_t*)(up + SG * (16 * rb + r + 1) * 272));
                f32x2 ea, ei; ea.x = __builtin_amdgcn_exp2f(accA[rb][r]); ea.y = __builtin_amdgcn_exp2f(accA[rb][r + 1]); ei.x = __builtin_amdgcn_exp2f(accI[rb][r]); ei.y = __builtin_amdgcn_exp2f(accI[rb][r + 1]);
                const f32x2 da = ea + 1.0f, di = ei + 1.0f;
                f32x2 rg, ig; rg.x = __builtin_amdgcn_rcpf(da.x); rg.y = __builtin_amdgcn_rcpf(da.y); ig.x = __builtin_amdgcn_rcpf(di.x); ig.y = __builtin_amdgcn_rcpf(di.y);
                const f32x2 ka = rg * k2;
                f32x2 a; a.x = __builtin_amdgcn_exp2f(ka.x); a.y = __builtin_amdgcn_exp2f(ka.y);
                const f32x2 om = 1.0f - a * a;
                f32x2 sq; sq.x = __builtin_amdgcn_sqrtf(om.x); sq.y = __builtin_amdgcn_sqrtf(om.y);
                const f32x2 bb = sq * ig * uv;
                accA[rb][r] = a.x; accA[rb][r + 1] = a.y; accI[rb][r] = bb.x; accI[rb][r + 1] = bb.y; }
    }
    float rA[8], rH[8];
#pragma unroll
    for (int rb = 0; rb < 8; ++rb) { float pa = 1.f, hh = 0.f;
#pragma unroll
        for (int r = 0; r < 4; ++r) { const float a = accA[rb][r], bb = accI[rb][r]; hh = a * hh + bb; pa *= a; accA[rb][r] = pa; accI[rb][r] = hh; }
        rA[rb] = pa; rH[rb] = hh; }
    float Pc = 1.f, s = 0.f;
#pragma unroll
    for (int rb = 0; rb < 8; ++rb) { float Pin = 1.f, Hin = 0.f;
#pragma unroll
        for (int q = 0; q < 4; ++q) { const float a = shfl_lane(rA[rb], fr + 16 * q), hh = shfl_lane(rH[rb], fr + 16 * q);
            if (q == fq) { Pin = Pc; Hin = s; }
            s = a * s + hh; Pc *= a; }
#pragma unroll
        for (int r = 0; r < 4; ++r) { hl[rb][r] = accI[rb][r] + accA[rb][r] * Hin; pp[rb][r] = accA[rb][r] * Pin; }
        __builtin_amdgcn_sched_barrier(0); }
    Atot = Pc; Htot = s;
}
__device__ __forceinline__ u64_t agg_ld(const u64_t* a) { return __hip_atomic_load(a, __ATOMIC_RELAXED, __HIP_MEMORY_SCOPE_AGENT); }
template <int DIR>
__device__ __forceinline__ float lru2_carry(const u64_t* aggc, int n, int fr, int fq) {
    float Ap = 1.f, Hp = 0.f; u64_t v[9];
#pragma unroll
    for (int k = 0; k < 9; ++k) { const int j = fq * 9 + k; const int seq = DIR ? (j == 0 ? 1 : (j == 1 ? 0 : 35 - j)) : j;
        v[k] = (j < n) ? agg_ld(aggc + (size_t)seq * 2048) : 0x000000003f800000ull; }
#pragma unroll
    for (int k = 0; k < 9; ++k) { const float a = __uint_as_float((unsigned)v[k]), hh = __uint_as_float((unsigned)(v[k] >> 32)); Hp = a * Hp + hh; Ap *= a; }
    float s = 0.f;
#pragma unroll
    for (int q = 0; q < 4; ++q) { const float a = shfl_lane(Ap, fr + 16 * q), hh = shfl_lane(Hp, fr + 16 * q); s = a * s + hh; }
    return s;
}
__device__ __forceinline__ void lru2_block(const Params& p, LAS unsigned char* lds, int slot, int c, int ngr) {
    int tid = threadIdx.x;
    const int sc = c + 2, t0 = c * 128;
    LAS unsigned char* raw = lds;
    LAS unsigned char* ul = lds + 33792;
    LAS unsigned char* gzl = lds + 68608;
    LAS unsigned char* outl = lds + 103424;
    u32x4 nr[5], ng[4];
#define LRU2_LOAD_R(gg) do { const bf16_t* Zb_ = (const bf16_t*)(p.ws + WS_RZ) + (size_t)((gg) >> 3) * 4096 * 4096 + ((gg) & 7) * 128; \
        _Pragma("unroll") for (int k = 0; k < 5; ++k) { const int pc = tid + NTHR * k; nr[k] = (u32x4){0u, 0u, 0u, 0u}; \
            if (pc < 131 * 16) { const int row = pc >> 4, c8 = pc & 15, tt = t0 - 2 + row; if (tt >= 0 && tt < TT) nr[k] = __builtin_nontemporal_load((const u32x4*)(Zb_ + (size_t)tt * 4096 + c8 * 8)); } } } while (0)
#define LRU2_LOAD_G(gg) do { const bf16_t* Zb_ = (const bf16_t*)(p.ws + WS_RZ) + (size_t)((gg) >> 3) * 4096 * 4096 + ((gg) & 7) * 128; \
        _Pragma("unroll") for (int k = 0; k < 4; ++k) { const int pc = tid + NTHR * k, row = pc >> 4, c8 = pc & 15; ng[k] = __builtin_nontemporal_load((const u32x4*)(Zb_ + (size_t)(t0 + row) * 4096 + 1024 + c8 * 8)); } } while (0)
    LRU2_LOAD_R(slot); LRU2_LOAD_G(slot);
    for (int g = slot; g < NB * 8; g += ngr) {
        asm volatile("" : "+v"(tid));
        const int lane = tid & 63, wid = __builtin_amdgcn_readfirstlane(tid >> 6), fr = lane & 15, fq = lane >> 4, chl = 16 * wid + fr;
        const int b = g >> 3, head = g & 7, ch = head * 128 + chl;
        unsigned* gcnt = (unsigned*)(p.ws + WS_BAR + 16 * KiB) + g * 64;
        bf16x8 bA1[4], bI1[4], bA0[4], bI0[4];
        { const bf16_t* wa = (const bf16_t*)(p.ws + WS_WAT) + ((size_t)(8 + head) * 128 + chl) * 128 + 8 * fq; const bf16_t* wi = (const bf16_t*)(p.ws + WS_WIT) + ((size_t)(8 + head) * 128 + chl) * 128 + 8 * fq;
#pragma unroll
          for (int ks = 0; ks < 4; ++ks) { bA1[ks] = *(const bf16x8*)(wa + 32 * ks); bI1[ks] = *(const bf16x8*)(wi + 32 * ks); } }
        float lk2[2], lba[2], lbi[2];
        { const float* lp = (const float*)(p.ws + WS_LRUP);
#pragma unroll
          for (int d = 0; d < 2; ++d) { lk2[d] = lp[d * 1024 + ch]; lba[d] = lp[2048 + d * 1024 + ch]; lbi[d] = lp[4096 + d * 1024 + ch]; } }
        const int c8 = tid & 15, tb = tid >> 4; const int ch0 = head * 128 + 8 * c8;
        float w[4][8], bias[8];
#pragma unroll
        for (int k = 0; k < 4; ++k) { const f32x4 a = *(const f32x4*)(p.conv_w + k * 1024 + ch0), c2 = *(const f32x4*)(p.conv_w + k * 1024 + ch0 + 4);
#pragma unroll
            for (int j = 0; j < 4; ++j) { w[k][j] = a[j]; w[k][4 + j] = c2[j]; } }
        { const f32x4 a = *(const f32x4*)(p.conv_b + ch0), c2 = *(const f32x4*)(p.conv_b + ch0 + 4);
#pragma unroll
            for (int j = 0; j < 4; ++j) { bias[j] = a[j]; bias[4 + j] = c2[j]; } }
        __builtin_amdgcn_sched_barrier(0);
#pragma unroll
        for (int k = 0; k < 5; ++k) { const int pc = tid + NTHR * k; if (pc < 131 * 16) *(LAS u32x4*)(raw + (pc >> 4) * 256 + (pc & 15) * 16) = nr[k]; }
#pragma unroll
        for (int k = 0; k < 4; ++k) { const int pc = tid + NTHR * k; *(LAS u32x4*)(gzl + (pc >> 4) * 272 + (pc & 15) * 16) = ng[k]; }
        __syncthreads();
        {
#pragma unroll
            for (int i = 0; i < 4; ++i) { const int t = tb + 32 * i; float a[8];
#pragma unroll
                for (int j = 0; j < 8; ++j) a[j] = bias[j];
#pragma unroll
                for (int k = 0; k < 4; ++k) { float f[8]; unpack8(*(const LAS u32x4*)(raw + (t + k) * 256 + c8 * 16), f);
#pragma unroll
                    for (int j = 0; j < 8; ++j) a[j] += w[k][j] * f[j]; }
                u32x4 wv; wv.x = cvt_pk_bf16(a[0], a[1]); wv.y = cvt_pk_bf16(a[2], a[3]); wv.z = cvt_pk_bf16(a[4], a[5]); wv.w = cvt_pk_bf16(a[6], a[7]);
                *(LAS u32x4*)(ul + t * 272 + c8 * 16) = wv; }
        }
        __syncthreads();
        float A0, H0, A1, H1;
        {
            f32x4 hl1[8], pp1[8];
            lru2_dir<1, LRU_PF_FRAG>(p, ul, head, wid, lane, bA1, bI1, bA0, bI0, hl1, pp1, A1, H1, lk2[1], lba[1], lbi[1]);
            LAS unsigned char* hp = outl + chl * 264 + (124 - 4 * fq) * 2; LAS unsigned char* qp = raw + chl * 264 + (124 - 4 * fq) * 2;
#pragma unroll
            for (int rb = 0; rb < 8; ++rb) { u32x2 wh, wq; wh.x = cvt_pk_bf16(hl1[rb][3], hl1[rb][2]); wh.y = cvt_pk_bf16(hl1[rb][1], hl1[rb][0]); wq.x = cvt_pk_bf16(pp1[rb][3], pp1[rb][2]); wq.y = cvt_pk_bf16(pp1[rb][1], pp1[rb][0]);
                *(LAS u32x2*)(hp - 32 * rb) = wh; *(LAS u32x2*)(qp - 32 * rb) = wq; }
        }
        __builtin_amdgcn_sched_barrier(0);
        if (!LRU_PF_FRAG) { const bf16_t* wa = (const bf16_t*)(p.ws + WS_WAT) + ((size_t)(head) * 128 + chl) * 128 + 8 * fq; const bf16_t* wi = (const bf16_t*)(p.ws + WS_WIT) + ((size_t)(head) * 128 + chl) * 128 + 8 * fq;
#pragma unroll
          for (int ks = 0; ks < 4; ++ks) { bA0[ks] = *(const bf16x8*)(wa + 32 * ks); bI0[ks] = *(const bf16x8*)(wi + 32 * ks); } }
        f32x4 hl0[8], pp0[8];
        lru2_dir<0, false>(p, ul, head, wid, lane, bA0, bI0, bA1, bI1, hl0, pp0, A0, H0, lk2[0], lba[0], lbi[0]);
        u64_t* agg = (u64_t*)(p.ws + WS_AGG);
        const size_t ai0 = ((size_t)(b * NSEQ) * 2 + 0) * 1024 + ch, ai1 = ((size_t)(b * NSEQ) * 2 + 1) * 1024 + ch;
        if (fq == 0) {
            __hip_atomic_store(agg + ai0 + (size_t)sc * 2048, ((u64_t)__float_as_uint(H0) << 32) | __float_as_uint(A0), __ATOMIC_RELAXED, __HIP_MEMORY_SCOPE_AGENT);
            __hip_atomic_store(agg + ai1 + (size_t)sc * 2048, ((u64_t)__float_as_uint(H1) << 32) | __float_as_uint(A1), __ATOMIC_RELAXED, __HIP_MEMORY_SCOPE_AGENT); }
        asm volatile("s_waitcnt vmcnt(0)" ::: "memory");
        __syncthreads();
        if (tid == 0) (void)__hip_atomic_fetch_add(gcnt, 1u, __ATOMIC_RELAXED, __HIP_MEMORY_SCOPE_AGENT);
        f32x4 gb[8], gp[8]; u32x2 gq[8];
        { const LAS unsigned char* gp_ = gzl + (4 * fq) * 272 + chl * 2;
          const LAS unsigned char* hp1 = outl + chl * 264 + (4 * fq) * 2; const LAS unsigned char* qp1 = raw + chl * 264 + (4 * fq) * 2;
#pragma unroll
          for (int rb = 0; rb < 8; ++rb) { const u32x2 wh = *(const LAS u32x2*)(hp1 + 32 * rb), wq = *(const LAS u32x2*)(qp1 + 32 * rb);
              const float h1v[4] = {bf_lo(wh.x), bf_hi(wh.x), bf_lo(wh.y), bf_hi(wh.y)}, q1v[4] = {bf_lo(wq.x), bf_hi(wq.x), bf_lo(wq.y), bf_hi(wq.y)};
              float gqf[4];
#pragma unroll
              for (int r = 0; r < 4; ++r) { const float gz = bf2f(*(const LAS bf16_t*)(gp_ + (16 * rb + r) * 272));
                  gb[rb][r] = gz * (hl0[rb][r] + h1v[r]); gp[rb][r] = gz * pp0[rb][r]; gqf[r] = gz * q1v[r]; }
              gq[rb].x = cvt_pk_bf16(gqf[0], gqf[1]); gq[rb].y = cvt_pk_bf16(gqf[2], gqf[3]); } }
        __builtin_amdgcn_sched_barrier(0);
        if (wid == 0) { unsigned sp = 0;
            while ((unsigned)__builtin_amdgcn_readfirstlane(__hip_atomic_load(gcnt, __ATOMIC_RELAXED, __HIP_MEMORY_SCOPE_AGENT)) < 32u) { __builtin_amdgcn_s_sleep(1); if (++sp > (1u << 22)) break; }
            asm volatile("s_waitcnt vmcnt(0)" ::: "memory"); }
        __syncthreads();
        const float C0 = lru2_carry<0>(agg + ai0, sc, fr, fq);
        const float C1 = lru2_carry<1>(agg + ai1, 2 + (NSEQ - 1 - sc), fr, fq);
        __builtin_amdgcn_sched_barrier(0);
        if (LRU_PF_TILE) { const int gn = (g + ngr < NB * 8) ? g + ngr : g; LRU2_LOAD_R(gn); LRU2_LOAD_G(gn); }
        __builtin_amdgcn_sched_barrier(0);
        LAS unsigned char* op = outl + (4 * fq) * 272 + chl * 2;
        unsigned ov[16];
#pragma unroll
        for (int rb = 0; rb < 8; ++rb) { float o[4];
            const float gqv[4] = {bf_lo(gq[rb].x), bf_hi(gq[rb].x), bf_lo(gq[rb].y), bf_hi(gq[rb].y)};
#pragma unroll
            for (int r = 0; r < 4; ++r) o[r] = gb[rb][r] + gp[rb][r] * C0 + gqv[r] * C1;
            ov[2 * rb] = cvt_pk_bf16(o[0], o[1]); ov[2 * rb + 1] = cvt_pk_bf16(o[2], o[3]); }
#pragma unroll
        for (int rb = 0; rb < 8; ++rb) { *(LAS bf16_t*)(op + (16 * rb + 0) * 272) = (bf16_t)(ov[2 * rb] & 0xffffu); *(LAS bf16_t*)(op + (16 * rb + 1) * 272) = (bf16_t)(ov[2 * rb] >> 16);
            *(LAS bf16_t*)(op + (16 * rb + 2) * 272) = (bf16_t)(ov[2 * rb + 1] & 0xffffu); *(LAS bf16_t*)(op + (16 * rb + 3) * 272) = (bf16_t)(ov[2 * rb + 1] >> 16); }
        __syncthreads();
        bf16_t* Ob = (bf16_t*)(p.ws + WS_R1) + ((size_t)(b * 4096 + t0)) * 1024 + head * 128;
#pragma unroll
        for (int k = 0; k < 4; ++k) { const int pc = tid + NTHR * k, row = pc >> 4, c8 = pc & 15;
            st_wt16(Ob + (size_t)row * 1024 + c8 * 8, *(const LAS u32x4*)(outl + row * 272 + c8 * 16)); }
        __syncthreads();
        if (!LRU_PF_TILE && g + ngr < NB * 8) LRU2_LOAD_R(g + ngr);
    }
#undef LRU2_LOAD_R
#undef LRU2_LOAD_G
}

__device__ __forceinline__ void fft_stage2_all(const Params& p, LAS unsigned char* lds) {
    const int tid = tid_opaque(), lane = tid & 63, wid = tid >> 6, fr = lane & 15, fq = lane >> 4;
    const bf16_t* Yt = (const bf16_t*)((const unsigned char*)p.out + OUT_YT); const bf16_t* D2 = (const bf16_t*)(p.ws + WS_D2T);
    bf16_t* Fo = (bf16_t*)((unsigned char*)p.out + OUT_F);
    const int G = gridDim.x;
    int it = blockIdx.x; bf16x8 dfr, yfr[3];
    LAS unsigned char* own = lds; LAS unsigned char* mir = lds + 16 * 528;
#define S2_LOAD(item) do { const int b_ = (item) & 7, k1_ = (item) >> 3; dfr = *(const bf16x8*)(D2 + (size_t)(k1_ + 256 * fr) * 32 + 8 * fq); \
        const bf16_t* yrow_ = Yt + (size_t)(k1_ * 2 + (fq >> 1)) * FCOLS + 8 * (fq & 1); \
        _Pragma("unroll") for (int n = 0; n < 2; ++n) yfr[n] = __builtin_nontemporal_load((const bf16x8*)(yrow_ + (size_t)(b_ * 256 + 16 * (2 * wid + n) + fr) * 16)); \
        yfr[2] = __builtin_nontemporal_load((const bf16x8*)(yrow_ + (size_t)(32768 + (b_ * 4 + (fr & 3)) * 16))); } while (0)
    if (it < NB * 256) S2_LOAD(it);
    for (; it < NB * 256; it += G) {
        const int b = it & 7, k1 = it >> 3;
        f32x4 acc[3];
#pragma unroll
        for (int n = 0; n < 3; ++n) acc[n] = __builtin_amdgcn_mfma_f32_16x16x32_bf16(yfr[n], dfr, (f32x4){0.f, 0.f, 0.f, 0.f}, 0, 0, 0);
        const int nx = it + G; if (nx < NB * 256) S2_LOAD(nx);
#pragma unroll
        for (int n = 0; n < 3; ++n) mfma_settle(acc[n]);
#pragma unroll
        for (int n = 0; n < 2; ++n) { const int c0 = 16 * (2 * wid + n) + 4 * fq, g = c0 >> 6, kb = c0 & 63;
            u32x2 w; w.x = cvt_pk_bf16(acc[n][0], acc[n][1]); w.y = cvt_pk_bf16(acc[n][2], acc[n][3]);
            *(LAS u32x2*)(own + fr * 528 + c0 * 2) = w;
            LAS bf16_t* mp = (LAS bf16_t*)(mir + fr * 528) + g * 64 + 64 - kb;
            if (kb != 0) mp[0] = (bf16_t)(w.x & 0xffffu);
            mp[-1] = (bf16_t)(w.x >> 16); mp[-2] = (bf16_t)(w.y & 0xffffu); mp[-3] = (bf16_t)(w.y >> 16); }
        if (wid == 0 && fq == 0) {
            u32x2 w; w.x = cvt_pk_bf16(acc[2][0], acc[2][1]); w.y = cvt_pk_bf16(acc[2][2], acc[2][3]);
            LAS bf16_t* mp = (LAS bf16_t*)(mir + fr * 528);
            mp[0] = (bf16_t)(w.x & 0xffffu); mp[64] = (bf16_t)(w.x >> 16); mp[128] = (bf16_t)(w.y & 0xffffu); mp[192] = (bf16_t)(w.y >> 16); }
        __syncthreads();
        { const int k2 = tid >> 5, c8 = tid & 31, tp = k1 + 256 * k2, tm = (4096 - tp) & 4095, col = (c8 >> 3) * 128 + (c8 & 7) * 8;
          st_wt16(Fo + ((size_t)b * 4096 + tp) * 512 + col, *(const LAS u32x4*)(own + k2 * 528 + c8 * 16));
          st_wt16(Fo + ((size_t)b * 4096 + tm) * 512 + col + 64, *(const LAS u32x4*)(mir + k2 * 528 + c8 * 16)); }
        __syncthreads();
    }
#undef S2_LOAD
}

__device__ __forceinline__ void topk_task(const Params& p, LAS unsigned char* lds, int it) {
    const int tid = tid_opaque(), lane = tid & 63, wid = tid >> 6;
    LAS unsigned* cnt = (LAS unsigned*)lds;
    LAS unsigned* wsum = cnt + 64;
    const float* scores = (const float*)(p.ws + WS_SCORES);
    int* idx = (int*)(p.ws + WS_IDX); float* gate = (float*)(p.ws + WS_GATE); int* slot_of = (int*)(p.ws + WS_SLOT);
    const int b = it >> 4, e = it & 15;
    unsigned key[8];
    { const u64_t* sp = (const u64_t*)(scores + (size_t)it * 4096 + tid * 8);
#pragma unroll
      for (int j = 0; j < 4; ++j) { const u64_t v = __hip_atomic_load(sp + j, __ATOMIC_RELAXED, __HIP_MEMORY_SCOPE_AGENT); key[2 * j] = (unsigned)v; key[2 * j + 1] = (unsigned)(v >> 32); } }
    unsigned thr = 0;
    for (int step = 0; step < 16; ++step) {
        const int sh = 29 - 2 * step;
        const unsigned c1 = sh >= 0 ? (thr | (1u << sh)) : (thr | 1u), c2 = sh >= 0 ? (thr | (2u << sh)) : 0xffffffffu, c3 = sh >= 0 ? (thr | (3u << sh)) : 0xffffffffu;
        unsigned n1 = 0, n2 = 0, n3 = 0;
#pragma unroll
        for (int j = 0; j < 8; ++j) { n1 += (unsigned)__popcll(__ballot(key[j] >= c1)); n2 += (unsigned)__popcll(__ballot(key[j] >= c2)); n3 += (unsigned)__popcll(__ballot(key[j] >= c3)); }
        LAS unsigned* cb = cnt + (step & 1) * 32;
        if (lane == 0) { cb[wid] = n1; cb[8 + wid] = n2; cb[16 + wid] = n3; }
        __syncthreads();
        unsigned t1 = 0, t2 = 0, t3 = 0;
#pragma unroll
        for (int w = 0; w < 8; ++w) { t1 += cb[w]; t2 += cb[8 + w]; t3 += cb[16 + w]; }
        if (sh >= 0) thr = t3 >= (unsigned)CAP ? c3 : (t2 >= (unsigned)CAP ? c2 : (t1 >= (unsigned)CAP ? c1 : thr));
        else thr = t1 >= (unsigned)CAP ? c1 : thr;
    }
    unsigned cg_ = 0, ce = 0;
#pragma unroll
    for (int j = 0; j < 8; ++j) { cg_ += key[j] > thr; ce += key[j] == thr; }
    unsigned pk = cg_ | (ce << 16), incl = pk;
#pragma unroll
    for (int o = 1; o < 64; o <<= 1) { const unsigned n = __shfl_up(incl, o); if (lane >= o) incl += n; }
    if (lane == 63) wsum[wid] = incl;
    __syncthreads();
    unsigned base = 0, total = 0;
#pragma unroll
    for (int w = 0; w < 8; ++w) { const unsigned s2 = wsum[w]; if (w < wid) base += s2; total += s2; }
    const unsigned excl = base + incl - pk; unsigned og = excl & 0xffffu, oe = excl >> 16; const unsigned ngt = total & 0xffffu, krem = (unsigned)CAP - ngt;
    int mm[8];
#pragma unroll
    for (int j = 0; j < 8; ++j) { const int t = tid * 8 + j; int m = -1;
        if (key[j] > thr) { m = (e * 8 + b) * 512 + (int)og; ++og; }
        else if (key[j] == thr) { if (oe < krem) m = (e * 8 + b) * 512 + (int)(ngt + oe); ++oe; }
        mm[j] = m;
        if (m >= 0) { idx[m] = b * 4096 + t; gate[m] = __uint_as_float(key[j]); } }
    { u32x4* so = (u32x4*)(slot_of + (size_t)it * 4096 + tid * 8);
      so[0] = (u32x4){(unsigned)mm[0], (unsigned)mm[1], (unsigned)mm[2], (unsigned)mm[3]}; so[1] = (u32x4){(unsigned)mm[4], (unsigned)mm[5], (unsigned)mm[6], (unsigned)mm[7]}; }
    __syncthreads();
}

__device__ __forceinline__ void phase7_rows(const Params& p, LAS unsigned char* lds) {
    const int tid = threadIdx.x, lane = tid & 63, wid = tid >> 6, fr = lane & 15, fq = lane >> 4;
    LAS unsigned char* ahi = lds; LAS unsigned char* alo = lds + 16 * 2064;
    LAS float* modl = (LAS float*)(lds + 65 * 1024);
    LAS float* scl = (LAS float*)(lds + 129 * 1024);
    LAS float* red = (LAS float*)(lds + 130 * 1024);
    { const float* ada0 = (const float*)(p.ws + WS_ADA);
      for (int i = tid; i < 8 * 1024; i += NTHR) { const int bb = i >> 10, d = i & 1023; modl[(bb * 2) * 1024 + d] = p.norm2_g[d] * (ada0[bb * 6144 + 4096 + d] + 1.0f); modl[(bb * 2 + 1) * 1024 + d] = ada0[bb * 6144 + 3072 + d]; } }
    bf16x8 bhi[4], blo[4];
#pragma unroll
    for (int s4 = 0; s4 < 4; ++s4) { float wv[8];
#pragma unroll
        for (int j = 0; j < 8; ++j) wv[j] = p.w_router[(size_t)(128 * wid + 32 * s4 + 8 * fq + j) * 16 + fr];
        u32x4 h, l;
#pragma unroll
        for (int jj = 0; jj < 4; ++jj) { const unsigned hp = cvt_pk_bf16(wv[2 * jj], wv[2 * jj + 1]); h[jj] = hp; l[jj] = cvt_pk_bf16(wv[2 * jj] - bf_lo(hp), wv[2 * jj + 1] - bf_hi(hp)); }
        bhi[s4] = __builtin_bit_cast(bf16x8, h); blo[s4] = __builtin_bit_cast(bf16x8, l); }
    __syncthreads();
    typedef __attribute__((address_space(1))) bf16_t gbf16_t; typedef __attribute__((address_space(1))) float gfloat_t; typedef __attribute__((address_space(1))) unsigned guint_t;
    gbf16_t* h2 = (gbf16_t*)(p.ws + WS_H2); const gbf16_t* x2b = (const gbf16_t*)(p.ws + WS_X2B); gfloat_t* scores = (gfloat_t*)(p.ws + WS_SCORES); guint_t* cnt7 = (guint_t*)(p.ws + WS_BAR + 44 * KiB);
    u32x2 nw[2][4]; int pend_b = -1;
#define P7_LOAD(rw) do { _Pragma("unroll") for (int r = 0; r < 2; ++r) _Pragma("unroll") for (int i = 0; i < 4; ++i) nw[r][i] = *(const __attribute__((address_space(1))) u32x2*)(x2b + (size_t)((rw) + r) * 1024 + 256 * i + 4 * lane); } while (0)
    { const int r0 = (blockIdx.x * 8 + wid) * 2; if (r0 < MLAT) P7_LOAD(r0); }
    auto trip = [&](const int row0) __attribute__((always_inline)) {
        const int b = row0 >> 12;
        f32x4 v[2][4]; float ss[2];
#pragma unroll
        for (int r = 0; r < 2; ++r)
#pragma unroll
            for (int i = 0; i < 4; ++i) { const u32x2 w = nw[r][i]; v[r][i] = (f32x4){bf_lo(w.x), bf_hi(w.x), bf_lo(w.y), bf_hi(w.y)}; }
        { const int nrow = row0 + (int)gridDim.x * 16 < MLAT ? row0 + (int)gridDim.x * 16 : row0; P7_LOAD(nrow); }
        __builtin_amdgcn_sched_barrier(0);
#pragma unroll
        for (int r = 0; r < 2; ++r) { float a = 0.f;
#pragma unroll
            for (int i = 0; i < 4; ++i) a += v[r][i][0] * v[r][i][0] + v[r][i][1] * v[r][i][1] + v[r][i][2] * v[r][i][2] + v[r][i][3] * v[r][i][3];
            ss[r] = a; }
#pragma unroll
        for (int o = 32; o >= 1; o >>= 1) { ss[0] += __shfl_xor(ss[0], o); ss[1] += __shfl_xor(ss[1], o); }
#pragma unroll
        for (int i = 0; i < 4; ++i) { const int d = 256 * i + 4 * lane;
            const f32x4 gg = *(const LAS f32x4*)(modl + (b * 2) * 1024 + d), sh = *(const LAS f32x4*)(modl + (b * 2 + 1) * 1024 + d);
#pragma unroll
            for (int r = 0; r < 2; ++r) { const float rs = rsqrtf(ss[r] * (1.0f / 1024.0f) + 1e-6f);
                const f32x4 hv = v[r][i] * rs * gg + sh;
                u32x2 w; w.x = cvt_pk_bf16(hv[0], hv[1]); w.y = cvt_pk_bf16(hv[2], hv[3]); *(__attribute__((address_space(1))) u32x2*)(h2 + (size_t)(row0 + r) * 1024 + d) = w;
                u32x2 l; l.x = cvt_pk_bf16(hv[0] - bf_lo(w.x), hv[1] - bf_hi(w.x)); l.y = cvt_pk_bf16(hv[2] - bf_lo(w.y), hv[3] - bf_hi(w.y));
                *(LAS u32x2*)(ahi + (2 * wid + r) * 2064 + d * 2) = w; *(LAS u32x2*)(alo + (2 * wid + r) * 2064 + d * 2) = l; } }
        __syncthreads();
        f32x4 acc = (f32x4){0.f, 0.f, 0.f, 0.f};
#pragma unroll
        for (int s4 = 0; s4 < 4; ++s4) { const int ko = (128 * wid + 32 * s4 + 8 * fq) * 2;
            const bf16x8 ah = *(const LAS bf16x8*)(ahi + fr * 2064 + ko), al = *(const LAS bf16x8*)(alo + fr * 2064 + ko);
            acc = __builtin_amdgcn_mfma_f32_16x16x32_bf16(ah, bhi[s4], acc, 0, 0, 0); acc = __builtin_amdgcn_mfma_f32_16x16x32_bf16(ah, blo[s4], acc, 0, 0, 0); acc = __builtin_amdgcn_mfma_f32_16x16x32_bf16(al, bhi[s4], acc, 0, 0, 0); }
#pragma unroll
        for (int r4 = 0; r4 < 4; ++r4) red[(wid * 16 + 4 * fq + r4) * 16 + fr] = acc[r4];
        __syncthreads();
        if (tid < 256) {
            float lg = 0.f;
#pragma unroll
            for (int w = 0; w < 8; ++w) lg += red[w * 256 + tid];
            float mx = lg;
#pragma unroll
            for (int o = 1; o <= 8; o <<= 1) mx = fmaxf(mx, __shfl_xor(mx, o));
            const float ex = expf(lg - mx); float sum = ex;
#pragma unroll
            for (int o = 1; o <= 8; o <<= 1) sum += __shfl_xor(sum, o);
            scl[(tid & 15) * 16 + (tid >> 4)] = ex / sum; }
        __syncthreads();
        if (tid < 128) { const int e = tid >> 3, q = tid & 7; const u64_t v2 = *(const LAS u64_t*)(scl + e * 16 + 2 * q);
            __hip_atomic_store((__attribute__((address_space(1))) u64_t*)(scores + ((size_t)b * 16 + e) * 4096 + ((row0 - 2 * wid) & 4095) + 2 * q), v2, __ATOMIC_RELAXED, __HIP_MEMORY_SCOPE_AGENT); }
        if (wid < 2) asm volatile("s_waitcnt vmcnt(17)" ::: "memory"); else asm volatile("s_waitcnt vmcnt(16)" ::: "memory");
        __syncthreads();
        if (tid == 0 && pend_b >= 0) (void)__hip_atomic_fetch_add(cnt7 + pend_b * 64, 1u, __ATOMIC_RELAXED, __HIP_MEMORY_SCOPE_AGENT);
        pend_b = b;
    };
    { int row0 = (blockIdx.x * 8 + wid) * 2;
      if (row0 < MLAT) { trip(row0); for (row0 += gridDim.x * 16; row0 < MLAT; row0 += gridDim.x * 16) trip(row0); } }
#undef P7_LOAD
    asm volatile("s_waitcnt vmcnt(0)" ::: "memory");
    __syncthreads();
    if (tid == 0 && pend_b >= 0) (void)__hip_atomic_fetch_add(cnt7 + pend_b * 64, 1u, __ATOMIC_RELAXED, __HIP_MEMORY_SCOPE_AGENT);
    __syncthreads();
}
__device__ __forceinline__ void phase7_topk(const Params& p, LAS unsigned char* lds) {
    const int bid = blockIdx.x; if (bid >= NB * NE) return;
    unsigned* c = (unsigned*)(p.ws + WS_BAR + 44 * KiB) + (bid >> 4) * 64;
    if (threadIdx.x < 64) { unsigned sp = 0;
        while ((unsigned)__builtin_amdgcn_readfirstlane(__hip_atomic_load(c, __ATOMIC_RELAXED, __HIP_MEMORY_SCOPE_AGENT)) < 256u) { __builtin_amdgcn_s_sleep(1); if (++sp > (1u << 22)) break; }
        __builtin_amdgcn_fence(__ATOMIC_ACQUIRE, "agent");
        asm volatile("s_waitcnt vmcnt(0)" ::: "memory"); }
    __syncthreads();
    topk_task(p, lds, bid);
}
constexpr int CVT_NG = 16 * 16 * 6, CVT_ND = 16 * 24 * 4;
constexpr int CVT_NA = 8;
constexpr int CVT_EARLY_A = 92 * CVT_NA, CVT_EARLY = CVT_EARLY_A + 36 * 2;
__device__ __forceinline__ void cvt_down_item(const Params& p, int dj) { const int e = dj / 96, r = dj % 96, kb = r >> 2, nb = r & 3;
    xpose_item<4, true>(p.w_down_e + (size_t)e * 1536 * 1024, 1024, wd_ptr(p.ws, p.out, e), 1536, kb * 64, nb * 256, 0); }
__device__ __forceinline__ void cvt_any(const Params& p, int it) {
    if (it < 2 * CVT_NG) { const int up = it >= CVT_NG, jj = up ? it - CVT_NG : it, e = jj / 96, r = jj % 96, kb = r / 6, nb = r % 6;
        xpose_item<4, true>((up ? p.w_up_e : p.w_gate_e) + (size_t)e * 1024 * 1536, 1536, wgu_ptr(p.ws, p.out, e), 1024, kb * 64, nb * 256, up ? 2 : 1); }
    else cvt_down_item(p, it - 2 * CVT_NG);
}
constexpr int CVT_SLOTS = 5, CVT_S0_DJ = CVT_EARLY, CVT_S1_Q = 960, CVT_S2_Q = 0;
__device__ __forceinline__ int cvt_slot_item(int slot, int bid) { return slot == 0 ? 2 * CVT_NG + CVT_S0_DJ + bid : (slot == 1 ? CVT_S1_Q + bid : CVT_S2_Q + (slot - 2) * 256 + bid); }
__device__ __forceinline__ void phase7_weights(const Params& p, unsigned skipmask) {
    const bool fused = gridDim.x == 256;
    if (!fused) { for (int it = blockIdx.x; it < 2 * CVT_NG + CVT_ND; it += gridDim.x) cvt_any(p, it); return; }
    for (int sl = 0; sl < CVT_SLOTS; ++sl) if ((skipmask >> sl) & 1u) cvt_any(p, cvt_slot_item(sl, blockIdx.x));
    constexpr int NGU = 2 * CVT_NG - 768 - 256, R = NGU + CVT_ND - CVT_EARLY - 256;
    for (int j = 0; ; ++j) {
        int q;
        if (blockIdx.x >= 128) q = j < 4 ? (blockIdx.x - 128) + 128 * j : 512 + blockIdx.x + (j - 4) * 256;
        else q = 512 + blockIdx.x + j * 256;
        if (q >= R) break;
        if (q < NGU) cvt_any(p, q < 192 ? 768 + q : 1216 + (q - 192));
        else cvt_any(p, 2 * CVT_NG + CVT_EARLY + 256 + (q - NGU));
    }
}

__device__ __forceinline__ void phase11(const Params& p, float* dst_, LAS unsigned char* lds) {
    const int tid = tid_opaque(), lane = tid & 63, wid = tid >> 6;
    typedef __attribute__((address_space(1))) bf16_t gbf16_t; typedef __attribute__((address_space(1))) float gfloat_t; typedef __attribute__((address_space(1))) int gint_t;
    const gint_t* slot_of = (const gint_t*)(p.ws + WS_SLOT); const gbf16_t* oute = (const gbf16_t*)(p.ws + WS_OUTE); const gbf16_t* x2b = (const gbf16_t*)(p.ws + WS_X2B); gfloat_t* dst = (gfloat_t*)dst_;
    LAS float* g2l = (LAS float*)lds;
    LAS float* fgl = g2l + 8 * 1024;
    { const float* ada = (const float*)(p.ws + WS_ADA);
      for (int i = tid; i < 8 * 1024; i += NTHR) g2l[i] = ada[(i >> 10) * 6144 + 5120 + (i & 1023)];
      for (int i = tid; i < 1024; i += NTHR) fgl[i] = p.final_g[i]; }
    __syncthreads();
    const int stride = gridDim.x * 16;
    const int first = (blockIdx.x * 8 + wid) * 2;
    if (first >= MLAT) return;
    typedef const __attribute__((address_space(1))) u32x2 gu32x2_t;
#define P11_SLOT(row) ((row) < MLAT ? slot_of[((size_t)((row) >> 12) * 16 + (lane & 15)) * 4096 + (((row) & 4095) + ((lane >> 4) & 1))] : -1)
#define P11_ISSUE(row, sl, XO, GO, M0, M1) do { \
        _Pragma("unroll") for (int r = 0; r < 2; ++r) _Pragma("unroll") for (int i = 0; i < 4; ++i) XO[r][i] = __builtin_nontemporal_load((gu32x2_t*)(x2b + (size_t)((row) + r) * 1024 + 256 * i + 4 * lane)); \
        const unsigned long long bal_ = __ballot((sl) >= 0); M0 = (unsigned)(bal_ & 0xffffull); M1 = (unsigned)((bal_ >> 16) & 0xffffull); \
        P11_GATHER(sl, GO, M0, M1); } while (0)
#define P11_GATHER(sl, GO, M0, M1) do { int m_[2][2]; \
        _Pragma("unroll") for (int j = 0; j < 2; ++j) { if (M0) { const int e = __builtin_ctz(M0); M0 &= M0 - 1; m_[0][j] = __builtin_amdgcn_readlane((sl), e); } else m_[0][j] = MMOE; \
                                                        if (M1) { const int e = __builtin_ctz(M1); M1 &= M1 - 1; m_[1][j] = __builtin_amdgcn_readlane((sl), 16 + e); } else m_[1][j] = MMOE; } \
        _Pragma("unroll") for (int r = 0; r < 2; ++r) _Pragma("unroll") for (int j = 0; j < 2; ++j) _Pragma("unroll") for (int i = 0; i < 4; ++i) \
            GO[r][j][i] = __builtin_nontemporal_load((gu32x2_t*)(oute + (size_t)m_[r][j] * 1024 + 256 * i + 4 * lane)); } while (0)
    u32x2 xw[2][4], gw[2][2][4]; unsigned mk0, mk1; int s_cur = P11_SLOT(first), s_nxt;
    P11_ISSUE(first, s_cur, xw, gw, mk0, mk1);
    s_nxt = P11_SLOT(first + stride);
    auto trip = [&](const int row0) __attribute__((always_inline)) {
        const int b = row0 >> 12, nrow = row0 + stride; const bool has = nrow < MLAT;
        u32x2 nx[2][4], ng[2][2][4]; unsigned nm0, nm1;
        { const int rw = has ? nrow : row0, sl = has ? s_nxt : -1; P11_ISSUE(rw, sl, nx, ng, nm0, nm1); }
        const int s_nn = P11_SLOT(nrow + stride);
        __builtin_amdgcn_sched_barrier(0);
        f32x4 xv[2][4], acc[2][4];
#pragma unroll
        for (int r = 0; r < 2; ++r)
#pragma unroll
            for (int i = 0; i < 4; ++i) { const u32x2 w = xw[r][i]; xv[r][i] = (f32x4){bf_lo(w.x), bf_hi(w.x), bf_lo(w.y), bf_hi(w.y)};
                acc[r][i] = (f32x4){bf_lo(gw[r][0][i].x) + bf_lo(gw[r][1][i].x), bf_hi(gw[r][0][i].x) + bf_hi(gw[r][1][i].x), bf_lo(gw[r][0][i].y) + bf_lo(gw[r][1][i].y), bf_hi(gw[r][0][i].y) + bf_hi(gw[r][1][i].y)}; }
        while (mk0 | mk1) {
            u32x2 w[2][2][4];
            P11_GATHER(s_cur, w, mk0, mk1);
#pragma unroll
            for (int r = 0; r < 2; ++r)
#pragma unroll
                for (int j = 0; j < 2; ++j)
#pragma unroll
                    for (int i = 0; i < 4; ++i) { acc[r][i][0] += bf_lo(w[r][j][i].x); acc[r][i][1] += bf_hi(w[r][j][i].x); acc[r][i][2] += bf_lo(w[r][j][i].y); acc[r][i][3] += bf_hi(w[r][j][i].y); }
        }
        float ss[2];
#pragma unroll
        for (int r = 0; r < 2; ++r) { float a = 0.f;
#pragma unroll
            for (int i = 0; i < 4; ++i) { const int d = 256 * i + 4 * lane; const f32x4 g2 = *(const LAS f32x4*)(g2l + b * 1024 + d); xv[r][i] += g2 * acc[r][i];
                a += xv[r][i][0] * xv[r][i][0] + xv[r][i][1] * xv[r][i][1] + xv[r][i][2] * xv[r][i][2] + xv[r][i][3] * xv[r][i][3]; }
            ss[r] = a; }
#pragma unroll
        for (int o = 32; o >= 1; o >>= 1) { ss[0] += __shfl_xor(ss[0], o); ss[1] += __shfl_xor(ss[1], o); }
#pragma unroll
        for (int r = 0; r < 2; ++r) { const float rs = rsqrtf(ss[r] * (1.0f / 1024.0f) + 1e-6f);
#pragma unroll
            for (int i = 0; i < 4; ++i) { const int d = 256 * i + 4 * lane; __builtin_nontemporal_store(xv[r][i] * rs * *(const LAS f32x4*)(fgl + d), (__attribute__((address_space(1))) f32x4*)(dst + (size_t)(row0 + r) * 1024 + d)); } }
#pragma unroll
        for (int r = 0; r < 2; ++r)
#pragma unroll
            for (int i = 0; i < 4; ++i) { xw[r][i] = nx[r][i]; gw[r][0][i] = ng[r][0][i]; gw[r][1][i] = ng[r][1][i]; }
        mk0 = nm0; mk1 = nm1; s_cur = s_nxt; s_nxt = s_nn;
    };
    { int row0 = first; trip(row0); for (row0 += stride; row0 < MLAT; row0 += stride) trip(row0); }
#undef P11_SLOT
#undef P11_ISSUE
#undef P11_GATHER
}

#define XB_TMO      128
#define XB_XCNT(j)  (256  + 64 * (j))
#define XB_XSUB(j)  (1280 + 64 * (j))
#define XB_XGEN(j)  (2304 + 64 * (j))
#define XB_TOP      3328
#define XB_TOPGEN   3392
#define XCD_BAR_WORDS 3456
#define XB_SPIN_CAP (1u << 22)
__device__ __forceinline__ unsigned xb_ld(unsigned* p)              { return __hip_atomic_load(p, __ATOMIC_RELAXED, __HIP_MEMORY_SCOPE_AGENT); }
__device__ __forceinline__ unsigned xb_add(unsigned* p, unsigned v) { return __hip_atomic_fetch_add(p, v, __ATOMIC_RELAXED, __HIP_MEMORY_SCOPE_AGENT); }
__device__ __forceinline__ unsigned xb_xcc_id() { return (unsigned)__builtin_amdgcn_s_getreg((3 << 11) | 20) & 0xFu; }
#define XB_SPIN(cond, bar) do { unsigned _sp = 0; while (cond) { __builtin_amdgcn_s_sleep(1); \
    if ((++_sp & 255u) == 0u) { if (xb_ld(&(bar)[XB_TMO])) break; if (_sp > XB_SPIN_CAP) { atomicAdd(&(bar)[XB_TMO], 1u); break; } } } } while (0)
struct XcdBarrier { unsigned* bar; unsigned x; volatile LAS unsigned* st; };
__device__ __forceinline__ XcdBarrier xcd_barrier_post(unsigned* bar, volatile LAS unsigned* st) {
    XcdBarrier b; b.bar = bar; b.x = xb_xcc_id(); b.st = st;
    if (threadIdx.x == 0) (void)xb_add(&bar[XB_XCNT(b.x)], 1u);
    return b;
}
__device__ __forceinline__ void xcd_barrier_complete(unsigned* bar, unsigned x, unsigned& nloc, unsigned& nx) {
    const unsigned G = gridDim.x * gridDim.y * gridDim.z;
    unsigned sum, cnt, mine, sp = 0u;
    for (;;) {
        sum = 0u; cnt = 0u; mine = 0u;
#pragma unroll
        for (unsigned j = 0; j < 16; ++j) { const unsigned c = xb_ld(&bar[XB_XCNT(j)]); sum += c; cnt += (c > 0u) ? 1u : 0u; mine = (j == x) ? c : mine; }
        if (sum == G) break;
        __builtin_amdgcn_s_sleep(1);
        if ((++sp & 255u) == 0u) { if (xb_ld(&bar[XB_TMO])) break; if (sp > XB_SPIN_CAP) { atomicAdd(&bar[XB_TMO], 1u); break; } }
    }
    nloc = mine > 0u ? mine : 1u; nx = cnt > 0u ? cnt : 1u;
}
__device__ __forceinline__ void xcd_barrier(const XcdBarrier& b) {
    asm volatile("s_waitcnt vmcnt(0)" ::: "memory");
    __syncthreads();
    if (threadIdx.x == 0) {
        unsigned* bar = b.bar;
        __builtin_amdgcn_s_waitcnt(0);
        unsigned nloc = b.st[0], nx = b.st[1];
        if (nloc == 0u) { xcd_barrier_complete(bar, b.x, nloc, nx); b.st[0] = nloc; b.st[1] = nx; }
        const unsigned old = xb_add(&bar[XB_XSUB(b.x)], 1u);
        const unsigned gen = old / nloc;
        if (old + 1u == (gen + 1u) * nloc) {
            __builtin_amdgcn_fence(__ATOMIC_RELEASE, "agent");
            asm volatile("s_waitcnt vmcnt(0)" ::: "memory");
            const unsigned og = xb_add(&bar[XB_TOP], 1u);
            const unsigned tg = og / nx;
            if (og + 1u == (tg + 1u) * nx) xb_add(&bar[XB_TOPGEN], 1u);
            else XB_SPIN(xb_ld(&bar[XB_TOPGEN]) == tg, bar);
            __builtin_amdgcn_fence(__ATOMIC_ACQUIRE, "agent");
            xb_add(&bar[XB_XGEN(b.x)], 1u);
            asm volatile("s_waitcnt vmcnt(0)" ::: "memory");
        } else {
            XB_SPIN(xb_ld(&bar[XB_XGEN(b.x)]) == gen, bar);
            __builtin_amdgcn_fence(__ATOMIC_ACQUIRE, "agent");
            asm volatile("s_waitcnt vmcnt(0)" ::: "memory");
        }
    }
    __syncthreads();
}

__device__ __forceinline__ bool xcd_barrier_work(const XcdBarrier& b, const Params& p, int item) {
    asm volatile("s_waitcnt vmcnt(0)" ::: "memory");
    __syncthreads();
    if (threadIdx.x == 0) {
        unsigned* bar = b.bar;
        __builtin_amdgcn_s_waitcnt(0);
        unsigned nloc = b.st[0], nx = b.st[1];
        if (nloc == 0u) { xcd_barrier_complete(bar, b.x, nloc, nx); b.st[0] = nloc; b.st[1] = nx; }
        const unsigned old = xb_add(&bar[XB_XSUB(b.x)], 1u);
        const unsigned gen = old / nloc;
        b.st[2] = (old + 1u == (gen + 1u) * nloc) ? 1u : 0u; b.st[3] = gen;
    }
    __syncthreads();
    const bool leader = b.st[2] != 0u;
    if (!leader) cvt_any(p, item);
    if (threadIdx.x == 0) {
        unsigned* bar = b.bar; const unsigned nx = b.st[1], gen = b.st[3];
        if (leader) {
            __builtin_amdgcn_fence(__ATOMIC_RELEASE, "agent");
            asm volatile("s_waitcnt vmcnt(0)" ::: "memory");
            const unsigned og = xb_add(&bar[XB_TOP], 1u);
            const unsigned tg = og / nx;
            if (og + 1u == (tg + 1u) * nx) xb_add(&bar[XB_TOPGEN], 1u);
            else XB_SPIN(xb_ld(&bar[XB_TOPGEN]) == tg, bar);
            __builtin_amdgcn_fence(__ATOMIC_ACQUIRE, "agent");
            xb_add(&bar[XB_XGEN(b.x)], 1u);
            asm volatile("s_waitcnt vmcnt(0)" ::: "memory");
        } else {
            XB_SPIN(xb_ld(&bar[XB_XGEN(b.x)]) == gen, bar);
            __builtin_amdgcn_fence(__ATOMIC_ACQUIRE, "agent");
            asm volatile("s_waitcnt vmcnt(0)" ::: "memory");
        }
    }
    __syncthreads();
    return leader;
}

__global__ void __launch_bounds__(NTHR, 2) fwd_megakernel(Params p_in) {
    Params p = p_in;
    extern __shared__ __attribute__((aligned(16))) unsigned char lds_raw[];
    LAS unsigned char* lds = (LAS unsigned char*)lds_raw;
    cg::grid_group grid = cg::this_grid();
    const int G = gridDim.x, bid = blockIdx.x;
    unsigned char* ws = p.ws;
    bf16_t* const R1 = (bf16_t*)(ws + WS_R1); bf16_t* const Zb = (bf16_t*)(ws + WS_RZ); bf16_t* const PQt = (bf16_t*)(ws + WS_RPQ); bf16_t* const MRG = (bf16_t*)(ws + WS_R2);
    bf16_t* const Fb = (bf16_t*)((unsigned char*)p.out + OUT_F); bf16_t* const Ytb = (bf16_t*)((unsigned char*)p.out + OUT_YT);
#ifdef ONLY_PH
#define PH(k) ((k) == ONLY_PH && p.ph_lo <= (k) && (k) < p.ph_hi)
#else
#define PH(k) (p.ph_lo <= (k) && (k) < p.ph_hi)
#endif
    volatile LAS unsigned* xst = (volatile LAS unsigned*)(lds + LDS_BYTES - 16);
    if (threadIdx.x < 4) xst[threadIdx.x] = 0u;
    __syncthreads();
    XcdBarrier xbar = xcd_barrier_post((unsigned*)(ws + WS_BAR), xst);
    if (p.ph_lo < 0) grid.sync();
#ifdef TS_A
    unsigned long long* tsb = (unsigned long long*)(ws + WS_BAR + 40 * KiB);
#define STAMP(i) do { if (bid == 0 && threadIdx.x == 0) tsb[i] = __builtin_amdgcn_s_memrealtime(); } while (0)
#else
#define STAMP(i) do { } while (0)
#endif
    STAMP(0);
#define LAUNDER() do { asm volatile("" : "+s"(p.ws), "+s"(p.out), "+s"(p.x)); ws = p.ws; } while (0)
#define SYNC(k) do { if (PH(k) && PH((k) + 1)) xcd_barrier(xbar); STAMP((k) + 1); LAUNDER(); } while (0)
    unsigned skipmask = 0u;
#define SYNCW(k, slot) do { if (PH(k) && PH((k) + 1)) { if (G == 256) { if (xcd_barrier_work(xbar, p, cvt_slot_item(slot, bid))) skipmask |= 1u << (slot); } else xcd_barrier(xbar); } STAMP((k) + 1); LAUNDER(); } while (0)
#ifndef REPMASK
#define REPMASK 0
#endif
#define REP(k) for (int rep_ = 0; rep_ <= ((REPMASK >> (k)) & 1); ++rep_)
    const bool fuse01 = PH(0) && PH(1);
    if (PH(0)) phase0(p, lds);
    if (fuse01) block_wait_ge((unsigned*)(ws + WS_BAR + 46 * KiB), 256u + 16u);
    else SYNC(0);
    if (PH(1)) REP(1) phase1(p);
    SYNCW(1, 0);
    if (PH(2)) REP(2) {
        { ProbPQ pr{(const bf16_t*)(ws + WS_WPQ), R1, 1024, 1024, 16384}; pg8::Order S; S.init(2, 128, G, bid); EpiPQ E{PQt}; pg8::gemm_phase(lds, pr, S, E); }
        if (threadIdx.x == 0) (void)__hip_atomic_fetch_add((unsigned*)(ws + WS_BAR + 47 * KiB), 1u, __ATOMIC_RELAXED, __HIP_MEMORY_SCOPE_AGENT);
        STAMP(28);
        { ProbPlain pr{R1, (const bf16_t*)(ws + WS_WIN), 1024, 1024, 1024}; pg8::Order S; S.init(128, 16, G, bid); EpiZ E{Zb, 4096, -1}; pg8::gemm_phase(lds, pr, S, E); }
        STAMP(29);
        { ProbPlain pr{(const bf16_t*)(ws + WS_HCTX), (const bf16_t*)(ws + WS_WIN), 1024, 1024, 1024}; pg8::Order S; S.init(8, 4, G, bid); EpiWT E{(bf16_t*)(ws + WS_ZXC), 1024}; pg8::gemm_phase(lds, pr, S, E); }
        if (G == 256 && bid < 32 && threadIdx.x == 0) {
            (void)__hip_atomic_fetch_add((unsigned*)(ws + WS_BAR + 47 * KiB + 256), 1u, __ATOMIC_RELAXED, __HIP_MEMORY_SCOPE_AGENT); }
        if (G == 256 && bid >= 32) {
            block_wait_ge((unsigned*)(ws + WS_BAR + 47 * KiB), 256u);
            ProbPlain pr{(const bf16_t*)(ws + WS_D1T), PQt, 512, 512, 512}; pg8::Order S; S.init(2, FCOLS / 256, G, bid); S.G = 224; S.c = bid - 32; S.base = 0; S.lim = 1;
            EpiPlain E{Ytb, FCOLS}; pg8::gemm_phase(lds, pr, S, E); }
    }
    if (G == 256 && PH(2) && PH(3)) { STAMP(3); LAUNDER(); } else SYNC(2);
    if (PH(3)) REP(3) {
        {
            ProbPlain pr{(const bf16_t*)(ws + WS_D1T), PQt, 512, 512, 512}; pg8::Order S; S.init(2, FCOLS / 256, G, bid);
            if (G == 256) { S.G = 36; S.c = bid - 128; S.base = 224; S.lim = (bid >= 128 && bid < 164) ? 1 : 0; }
            EpiPlain E{Ytb, FCOLS}; pg8::gemm_phase(lds, pr, S, E); }
        if (G == 256 && bid < NB * 2 * 8) block_wait_ge((unsigned*)(ws + WS_BAR + 47 * KiB + 256), 32u);
        for (int it = bid; it < NB * 2 * 8; it += G) lru_tile<false>(p, lds, it);
        if (G == 256 && bid >= 128) {
            if (bid >= 164) { for (int j = 0; j < CVT_NA; ++j) cvt_down_item(p, (bid - 164) + 92 * j); }
            else { for (int j = 0; j < 2; ++j) cvt_down_item(p, CVT_EARLY_A + (bid - 128) + 36 * j); } }
    }
    SYNCW(3, 1);
    if (PH(4)) {
        fft_stage2_all(p, lds);
        STAMP(20);
        const int ngr = G >> 5;
        if (ngr > 0 && bid < ngr * 32) lru2_block(p, lds, bid % ngr, bid / ngr, ngr);
    }
    SYNCW(4, 2);
    if (PH(5)) REP(5) {
        { ProbMerge pr{Fb, (const bf16_t*)(ws + WS_WFOUR), R1, (const bf16_t*)(ws + WS_WLRU), 512, 1024, 512, 512, 1024, 1024}; pg8::Order S; S.init(128, 4, G, bid); EpiMerge E{MRG, Zb}; pg8::gemm_phase2(lds, pr, S, E); }
    }
    SYNCW(5, 3);
    if (PH(6)) REP(6) { ProbPlain pr{MRG, (const bf16_t*)(ws + WS_WOUT), 1024, 1024, 1024}; pg8::Order S; S.init(128, 4, G, bid); if (512 % G == 0) S.rev = 512 / G;
        EpiOut E{(bf16_t*)(ws + WS_X2B), p.x, (const float*)(ws + WS_POS), (const float*)(ws + WS_ADA)}; pg8::gemm_phase(lds, pr, S, E); }
    SYNCW(6, 4);
    if (PH(7)) { phase7_rows(p, lds); if (G == 256) phase7_topk(p, lds); phase7_weights(p, skipmask); }
    SYNC(7);
    if (PH(8) && G != 256) { for (int it = bid; it < NB * NE; it += G) topk_task(p, lds, it); }
    if (G != 256) SYNC(8);
    if (PH(9)) REP(9) { ProbMoeUp pr{(const bf16_t*)(ws + WS_H2), ws, p.out, (const int*)(ws + WS_IDX), 1024, 1024, 1024}; pg8::Order S; S.init(256, 12, G, bid); S.wgm = P9_WGM; EpiGU E{(bf16_t*)(ws + WS_HID)}; pg8::gemm_phase(lds, pr, S, E); }
    SYNC(9);
    if (PH(10)) { if (bid == 0 && threadIdx.x < 128) *(u32x4*)(ws + WS_OUTE + (size_t)MMOE * 2048 + threadIdx.x * 16) = (u32x4){0u, 0u, 0u, 0u}; }
    if (PH(10)) REP(10) { ProbMoeDown pr{(const bf16_t*)(ws + WS_HID), ws, p.out, 1536, 1536, 1536}; pg8::Order S; S.init(256, 4, G, bid); if (1024 % G == 0) S.rev = 1024 / G; EpiDown E{(bf16_t*)(ws + WS_OUTE), (const float*)(ws + WS_GATE)}; pg8::gemm_phase(lds, pr, S, E); }
    SYNC(10);
    if (PH(11)) phase11(p, p.out, lds);
#ifdef TS_A
    xcd_barrier(xbar); STAMP(12);
    if (bid == 0 && threadIdx.x == 0) {

#ifndef TS_AE
#define TS_AE (TS_A + 1)
#endif
#ifndef TS_BE
#define TS_BE (TS_B + 1)
#endif
        const float ta = (float)(tsb[TS_AE] - tsb[TS_A]) * 0.01f * (float)(TS_SA), tb = (float)(tsb[TS_BE] - tsb[TS_B]) * 0.01f * (float)(TS_SB);
        p.out[7] = fminf(ta, 97.f); p.out[1024 * 5 + 9] = fminf(tb, 97.f); }
#endif
}

#ifndef N_LAUNCHES
#define N_LAUNCHES 1
#endif
#ifndef PROBE_DUP
#define PROBE_DUP 0x0
#endif
extern "C" void kernel_launch(void* const* d_in, const int* in_sizes, int n_in, void* d_out, int out_size, void* d_ws, size_t ws_size, hipStream_t stream) {
    static int grid = 0;
    if (grid == 0) {
        if (n_in != 24 || out_size != MLAT * DM || ws_size < WS_END) { fprintf(stderr, "kernel_launch: unexpected shapes (n_in %d out %d ws %zu)\n", n_in, out_size, ws_size); grid = -1; return; }
        int dev = 0, cus = 0, per_cu = 0;
        hipGetDevice(&dev); hipDeviceGetAttribute(&cus, hipDeviceAttributeMultiprocessorCount, dev);
        hipFuncSetAttribute((const void*)fwd_megakernel, hipFuncAttributeMaxDynamicSharedMemorySize, LDS_BYTES);
        hipOccupancyMaxActiveBlocksPerMultiprocessor(&per_cu, (const void*)fwd_megakernel, NTHR, LDS_BYTES);
        if (per_cu < 1) { fprintf(stderr, "kernel_launch: occupancy query reports %d blocks per CU\n", per_cu); per_cu = 1; }
        grid = cus * 1;
        (void)hipGetLastError();
    }
    if (grid < 0) return;
    Params p{};
    const float** f = (const float**)&p;
    for (int i = 0; i < 24; ++i) f[i] = (const float*)d_in[i];
    p.out = (float*)d_out; p.ws = (unsigned char*)d_ws;
    (void)hipMemsetAsync((unsigned char*)d_ws + WS_BAR, 0, 48 * KiB, stream);
#if N_LAUNCHES == 1
    p.ph_lo = 0; p.ph_hi = 12;
    void* args[] = {&p};
    hipError_t e = hipLaunchCooperativeKernel((const void*)fwd_megakernel, dim3(grid), dim3(NTHR), args, LDS_BYTES, stream);
    if (e != hipSuccess) fprintf(stderr, "cooperative launch failed: %s (grid %d)\n", hipGetErrorString(e), grid);
#else
    for (int k = 0; k < 12; ++k) for (int r = 0; r <= ((PROBE_DUP >> k) & 1); ++r) { p.ph_lo = k; p.ph_hi = k + 1; if (k == 11 && r == 0 && ((PROBE_DUP >> 11) & 1)) { p.ph_lo = 12; p.ph_hi = 13; } hipLaunchKernelGGL(fwd_megakernel, dim3(grid), dim3(NTHR), LDS_BYTES, stream, p); }
#endif
}
```
